# Optimizing an MI355X kernel written in HIP

```python
import math
import jax, jax.numpy as jnp
from jax import lax
import numpy as np

D_MODEL = 1024
BATCH = 8
SEQ = 8192
DEPTH = 1

MEM_LEN = 256
HEAD_DIM = 64
N_FOX_HEADS = (D_MODEL // 2) // HEAD_DIM
N_MOBA_HEADS = (D_MODEL // 2) // HEAD_DIM
FOX_WIDTH = N_FOX_HEADS * HEAD_DIM
MOBA_WIDTH = N_MOBA_HEADS * HEAD_DIM
MIX_WIDTH = FOX_WIDTH + MOBA_WIDTH
IN_COLS = 3 * FOX_WIDTH + N_FOX_HEADS + 3 * MOBA_WIDTH
FOX_Q_BLOCK = 128
MOBA_BLOCK = 256
MOBA_TOP_K = 3
MOBA_Q_BLOCK = 32
N_CROSS_HEADS = 4
CROSS_HEAD_DIM = D_MODEL // N_CROSS_HEADS
D_FF = 128 * (-(-(8 * D_MODEL // 3) // 128))
CONV_WIDTH = 3
EPS = 1e-6

kernel_name = "hymba_fox_moba_convffn_layer"


def rmsnorm(x, g):
    xf = x.astype(jnp.float32)
    y = xf * lax.rsqrt(jnp.mean(xf * xf, axis=-1, keepdims=True) + EPS)
    return (y * g.astype(jnp.float32)).astype(x.dtype)


def to_heads(t, n_heads):
    b, s, _ = t.shape
    return t.reshape(b, s, n_heads, HEAD_DIM).transpose(0, 2, 1, 3)


def from_heads(t):
    b, h, s, d = t.shape
    return t.transpose(0, 2, 1, 3).reshape(b, s, h * d)


def fox_attention(q, k, v, log_f):
    B, H, S, dh = q.shape
    c = jnp.cumsum(log_f, axis=-1)
    scale = dh ** -0.5
    kpos = jnp.arange(S)

    def block(i):
        start = i * FOX_Q_BLOCK
        qb = lax.dynamic_slice_in_dim(q, start, FOX_Q_BLOCK, axis=2)
        cb = lax.dynamic_slice_in_dim(c, start, FOX_Q_BLOCK, axis=2)
        qpos = start + jnp.arange(FOX_Q_BLOCK)
        s = jnp.einsum('bhqd,bhkd->bhqk', qb, k, preferred_element_type=jnp.float32) * scale
        s = s + cb[..., :, None] - c[..., None, :]
        s = jnp.where(kpos[None, :] <= qpos[:, None], s, -jnp.inf)
        p = jax.nn.softmax(s, axis=-1)
        return jnp.einsum('bhqk,bhkd->bhqd', p.astype(v.dtype), v)

    out = lax.map(block, jnp.arange(S // FOX_Q_BLOCK))
    return jnp.moveaxis(out, 0, 2).reshape(B, H, S, dh)


def moba_attention(q, k, v, slopes):
    B, H, S, dh = q.shape
    n_blk = -(-S // MOBA_BLOCK)
    s_pad = n_blk * MOBA_BLOCK
    pad = ((0, 0), (0, 0), (0, s_pad - S), (0, 0))
    kb = jnp.pad(k, pad).reshape(B, H, n_blk, MOBA_BLOCK, dh)
    vb = jnp.pad(v, pad).reshape(B, H, n_blk, MOBA_BLOCK, dh)
    k_mean = jnp.mean(kb.astype(jnp.float32), axis=3)
    top_k = min(MOBA_TOP_K, n_blk)
    scale = dh ** -0.5
    offs = jnp.arange(MOBA_BLOCK)
    blk_ids = jnp.arange(n_blk)
    bidx = jnp.arange(B)[:, None, None, None]
    hidx = jnp.arange(H)[None, :, None, None]
    sl5 = slopes[None, :, None, None, None]
    sl4 = slopes[None, :, None, None]

    def chunk(i):
        start = i * MOBA_Q_BLOCK
        qb = lax.dynamic_slice_in_dim(q, start, MOBA_Q_BLOCK, axis=2)
        qpos = start + jnp.arange(MOBA_Q_BLOCK)
        own = start // MOBA_BLOCK
        gate = jnp.einsum('bhqd,bhnd->bhqn', qb.astype(jnp.float32), k_mean)
        gate = jnp.where(blk_ids < own, gate, -jnp.inf)
        _, sel = lax.top_k(gate, top_k)
        valid = sel < own
        k_sel = kb[bidx, hidx, sel]
        v_sel = vb[bidx, hidx, sel]
        s_sel = jnp.einsum('bhqd,bhqnkd->bhqnk', qb, k_sel,
                           preferred_element_type=jnp.float32) * scale
        dist_sel = (qpos[None, None, :, None, None]
                    - (sel[..., None] * MOBA_BLOCK + offs)).astype(jnp.float32)
        s_sel = jnp.where(valid[..., None], s_sel - sl5 * dist_sel, -jnp.inf)
        s_sel = s_sel.reshape(B, H, MOBA_Q_BLOCK, top_k * MOBA_BLOCK)
        k_own = kb[:, :, own]
        v_own = vb[:, :, own]
        s_own = jnp.einsum('bhqd,bhkd->bhqk', qb, k_own,
                           preferred_element_type=jnp.float32) * scale
        dist_own = (qpos[:, None] - (own * MOBA_BLOCK + offs)[None, :]).astype(jnp.float32)
        s_own = jnp.where(dist_own >= 0, s_own - sl4 * dist_own, -jnp.inf)
        p = jax.nn.softmax(jnp.concatenate([s_sel, s_own], axis=-1), axis=-1).astype(v.dtype)
        p_sel = p[..., :top_k * MOBA_BLOCK].reshape(B, H, MOBA_Q_BLOCK, top_k, MOBA_BLOCK)
        p_own = p[..., top_k * MOBA_BLOCK:]
        return (jnp.einsum('bhqnk,bhqnkd->bhqd', p_sel, v_sel)
                + jnp.einsum('bhqk,bhkd->bhqd', p_own, v_own))

    out = lax.map(chunk, jnp.arange(S // MOBA_Q_BLOCK))
    return jnp.moveaxis(out, 0, 2).reshape(B, H, S, dh)


def alibi_slopes(n_heads):
    return 2.0 ** (-8.0 * jnp.arange(1, n_heads + 1, dtype=jnp.float32) / n_heads)


def hybrid_mixer(a, w_in, b_forget, g_fox, g_moba, w_out):
    proj = a @ w_in
    cuts = [int(c) for c in np.cumsum([FOX_WIDTH, FOX_WIDTH, FOX_WIDTH, N_FOX_HEADS,
                                       MOBA_WIDTH, MOBA_WIDTH])]
    q_f, k_f, v_f, f_logit, q_m, k_m, v_m = jnp.split(proj, cuts, axis=-1)
    log_f = jax.nn.log_sigmoid(f_logit.astype(jnp.float32)
                               + b_forget.astype(jnp.float32)).transpose(0, 2, 1)
    o_f = fox_attention(to_heads(q_f, N_FOX_HEADS), to_heads(k_f, N_FOX_HEADS),
                        to_heads(v_f, N_FOX_HEADS), log_f)
    o_m = moba_attention(to_heads(q_m, N_MOBA_HEADS), to_heads(k_m, N_MOBA_HEADS),
                         to_heads(v_m, N_MOBA_HEADS), alibi_slopes(N_MOBA_HEADS))
    y = jnp.concatenate([rmsnorm(from_heads(o_f), g_fox),
                         rmsnorm(from_heads(o_m), g_moba)], axis=-1)
    return y @ w_out


def memory_cross_attention(a, mem_n, w_q, w_kv, w_o):
    B, S, _ = a.shape
    M = mem_n.shape[1]
    q = (a @ w_q).reshape(B, S, N_CROSS_HEADS, CROSS_HEAD_DIM)
    k, v = jnp.split(mem_n @ w_kv, 2, axis=-1)
    k = k.reshape(B, M, N_CROSS_HEADS, CROSS_HEAD_DIM)
    v = v.reshape(B, M, N_CROSS_HEADS, CROSS_HEAD_DIM)
    s = jnp.einsum('bshd,bmhd->bhsm', q, k,
                   preferred_element_type=jnp.float32) * CROSS_HEAD_DIM ** -0.5
    p = jax.nn.softmax(s, axis=-1).astype(v.dtype)
    o = jnp.einsum('bhsm,bmhd->bshd', p, v).reshape(B, S, D_MODEL)
    return o @ w_o


def conv_glu_ffn(a, w_up, conv_w, conv_b, w_down):
    S = a.shape[1]
    g, u = jnp.split(a @ w_up, 2, axis=-1)
    gp = jnp.pad(g, ((0, 0), (CONV_WIDTH - 1, 0), (0, 0)))
    gc = conv_b + sum(conv_w[j] * gp[:, j:j + S] for j in range(CONV_WIDTH))
    return (jax.nn.silu(gc) * u) @ w_down


def setup_inputs(seed: int = 0) -> dict:
    key = jax.random.key(seed)
    ks = jax.random.split(key, 24)
    f32 = jnp.float32
    nrm = lambda k, shape, s: jax.random.normal(k, shape, f32) * s
    gain = lambda k, shape: 1.0 + 0.02 * jax.random.normal(k, shape, f32)
    L = DEPTH
    return {
        "x": jax.random.normal(ks[0], (BATCH, SEQ, D_MODEL), f32),
        "mem": jax.random.normal(ks[1], (BATCH, MEM_LEN, D_MODEL), f32),
        "g_mix": gain(ks[2], (L, D_MODEL)),
        "w_in": nrm(ks[3], (L, D_MODEL, IN_COLS), D_MODEL ** -0.5),
        "b_forget": 3.0 + 0.5 * jax.random.normal(ks[4], (L, N_FOX_HEADS), f32),
        "g_fox": gain(ks[5], (L, FOX_WIDTH)),
        "g_moba": gain(ks[6], (L, MOBA_WIDTH)),
        "w_out": nrm(ks[7], (L, MIX_WIDTH, D_MODEL), MIX_WIDTH ** -0.5),
        "g_cross": gain(ks[8], (L, D_MODEL)),
        "g_mem": gain(ks[9], (L, D_MODEL)),
        "w_q_mem": nrm(ks[10], (L, D_MODEL, D_MODEL), D_MODEL ** -0.5),
        "w_kv_mem": nrm(ks[11], (L, D_MODEL, 2 * D_MODEL), D_MODEL ** -0.5),
        "w_o_mem": nrm(ks[12], (L, D_MODEL, D_MODEL), D_MODEL ** -0.5),
        "g_ffn": gain(ks[13], (L, D_MODEL)),
        "w_up": nrm(ks[14], (L, D_MODEL, 2 * D_FF), D_MODEL ** -0.5),
        "conv_w": nrm(ks[15], (L, CONV_WIDTH, D_FF), CONV_WIDTH ** -0.5),
        "conv_b": nrm(ks[16], (L, D_FF), 0.02),
        "w_down": nrm(ks[17], (L, D_FF, D_MODEL), D_FF ** -0.5),
        "g_final": gain(ks[18], (D_MODEL,)),
    }


def reference(x, mem, g_mix, w_in, b_forget, g_fox, g_moba, w_out, g_cross, g_mem,
              w_q_mem, w_kv_mem, w_o_mem, g_ffn, w_up, conv_w, conv_b, w_down, g_final):
    h = x
    for l in range(DEPTH):
        h = h + hybrid_mixer(rmsnorm(h, g_mix[l]), w_in[l], b_forget[l],
                             g_fox[l], g_moba[l], w_out[l])
        h = h + memory_cross_attention(rmsnorm(h, g_cross[l]), rmsnorm(mem, g_mem[l]),
                                       w_q_mem[l], w_kv_mem[l], w_o_mem[l])
        h = h + conv_glu_ffn(rmsnorm(h, g_ffn[l]), w_up[l], conv_w[l], conv_b[l], w_down[l])
    return rmsnorm(h, g_final)
```

```cpp
#include <hip/hip_runtime.h>
#include <hip/hip_bf16.h>
#include <cstdio>
#include <cstdint>

namespace pg8 {
#define PG8_LAS __attribute__((address_space(3)))
typedef unsigned short bf16_t;
typedef short bf16x8 __attribute__((ext_vector_type(8)));
typedef float f32x4 __attribute__((ext_vector_type(4)));
typedef float f32x2 __attribute__((ext_vector_type(2)));
typedef unsigned u32x4 __attribute__((ext_vector_type(4)));
typedef unsigned u32x2 __attribute__((ext_vector_type(2)));
constexpr int BM = 256, BK = 64, HALF = 128, HTB = HALF * BK * 2  , STAGE_BYTES = 8 * HTB, NXCD = 8, WGM = 8;

__host__ __device__ __forceinline__ int lds_byte(int r, int c) { const int st = (r >> 4) * 2 + (c >> 5), rr = r & 15, cc = c & 31, ob = rr * 64 + cc * 2; return st * 1024 + (ob ^ (((ob >> 9) & 1) << 5)); }
__host__ __device__ __forceinline__ void stage_rc(int b, int& R, int& C) { const int st = b / 1024, sb = b % 1024, swz = sb ^ (((sb >> 9) & 1) << 5); R = (st >> 1) * 16 + swz / 64; C = (st & 1) * 32 + (swz % 64) / 2; }
__host__ __device__ __forceinline__ int perm32(int rho) { const int n = rho >> 4, i = rho & 15; return 8 * (i >> 2) + 4 * n + (i & 3); }

struct Unit { int pm, pn; size_t aoff, boff; };
struct Gemm { const bf16_t* A; const bf16_t* Bt; int K, lda, ldb; unsigned wrapmask; };

struct TileOrder {
    int nM, nN, nwg, G, c; size_t a_tile, b_tile, b_batch; int pmb;
    __device__ __forceinline__ void init(int M, int N, int G_, int c_, int lda, int ldb, size_t b_batch_elems, int pm_per_batch) {
        nM = M / BM; nN = N / BM; nwg = nM * nN; G = G_; c = c_; a_tile = (size_t)BM * lda * 2; b_tile = (size_t)BM * ldb * 2; b_batch = b_batch_elems * 2; pmb = pm_per_batch; }
    __device__ __forceinline__ bool next(int i, Unit& u) const {
        const long L = (long)i * G + c; if (L >= nwg) return false;
        int wgid = (int)L; { const int q = nwg / NXCD, r = nwg % NXCD, xcd = wgid % NXCD, off = wgid / NXCD; wgid = (xcd < r ? xcd * (q + 1) : r * (q + 1) + (xcd - r) * q) + off; }
        const int nig = WGM * nN, gid = wgid / nig, fm = gid * WGM, gsz = (nM - fm) < WGM ? (nM - fm) : WGM;
        u.pm = fm + ((wgid % nig) % gsz); u.pn = (wgid % nig) / gsz;
        u.aoff = (size_t)u.pm * a_tile; u.boff = (size_t)u.pn * b_tile + (size_t)(u.pm / pmb) * b_batch; return true;
    }
};

__device__ __forceinline__ unsigned cvt_pk_bf16(float lo, float hi) { unsigned r; asm volatile("v_cvt_pk_bf16_f32 %0, %1, %2" : "=v"(r) : "v"(lo), "v"(hi)); return r; }

typedef f32x4 AccT[2][2][4][2];

struct EpiBf16 {
    static constexpr bool PERM = true;
    bf16_t* O; int ldc; unsigned scalemask; float scale0;
    __device__ __forceinline__ void operator()(AccT& acc, const Unit& u, int wr, int wc, int fr, int fq, PG8_LAS unsigned char*) const {
        const int row0 = u.pm * BM + wr * 64 + fr, col0 = u.pn * BM + wc * 32 + 8 * fq;
        const float sc = ((scalemask >> u.pn) & 1u) ? scale0 : 1.f;
#pragma unroll
        for (int ai = 0; ai < 2; ++ai)
#pragma unroll
            for (int m = 0; m < 4; ++m) { bf16_t* rowp = O + (size_t)(row0 + ai * HALF + m * 16) * ldc + col0;
#pragma unroll
                for (int bj = 0; bj < 2; ++bj) { const f32x4 v0 = acc[ai][bj][m][0] * sc, v1 = acc[ai][bj][m][1] * sc;
                    u32x4 w; w.x = cvt_pk_bf16(v0[0], v0[1]); w.y = cvt_pk_bf16(v0[2], v0[3]); w.z = cvt_pk_bf16(v1[0], v1[1]); w.w = cvt_pk_bf16(v1[2], v1[3]);
                    *(u32x4*)(rowp + bj * HALF) = w; } }
    }
};
__device__ __forceinline__ float rstd_from_slots(const float* slots) {
    const f32x4 a = *(const f32x4*)slots, b = *(const f32x4*)(slots + 4), c = *(const f32x4*)(slots + 8), d = *(const f32x4*)(slots + 12);
    const float s = ((a[0] + a[1]) + (a[2] + a[3])) + ((b[0] + b[1]) + (b[2] + b[3])) + ((c[0] + c[1]) + (c[2] + c[3])) + ((d[0] + d[1]) + (d[2] + d[3]));
    return __builtin_amdgcn_rsqf(s * (1.0f / 1024.0f) + 1e-6f);
}
struct EpiUp {
    static constexpr bool PERM = true;
    bf16_t* Gb; bf16_t* Ub; const float* ssq;
    __device__ __forceinline__ void operator()(AccT& acc, const Unit& u, int wr, int wc, int fr, int fq, PG8_LAS unsigned char*) const {
        const int row0 = u.pm * BM + wr * 64 + fr; const int pn = u.pn >= 11 ? u.pn - 11 : u.pn; bf16_t* base = u.pn >= 11 ? Ub : Gb;
        const int col0 = pn * BM + wc * 32 + 8 * fq;
#pragma unroll
        for (int ai = 0; ai < 2; ++ai)
#pragma unroll
            for (int m = 0; m < 4; ++m) { const int row = row0 + ai * HALF + m * 16; const float rs = rstd_from_slots(ssq + (size_t)row * 16); bf16_t* rowp = base + (size_t)row * 2816 + col0;
#pragma unroll
                for (int bj = 0; bj < 2; ++bj) { const f32x4 v0 = acc[ai][bj][m][0] * rs, v1 = acc[ai][bj][m][1] * rs;
                    u32x4 w; w.x = cvt_pk_bf16(v0[0], v0[1]); w.y = cvt_pk_bf16(v0[2], v0[3]); w.z = cvt_pk_bf16(v1[0], v1[1]); w.w = cvt_pk_bf16(v1[2], v1[3]);
                    *(u32x4*)(rowp + bj * HALF) = w; } }
    }
};
struct EpiRes {
    static constexpr bool PERM = true;
    const float* base; float* out; bf16_t* hb; float* ssq;
    __device__ __forceinline__ void operator()(AccT& acc, const Unit& u, int wr, int wc, int fr, int fq, PG8_LAS unsigned char*) const {
        const int row0 = u.pm * BM + wr * 64 + fr, col0 = u.pn * BM + wc * 32 + 8 * fq;
#pragma unroll
        for (int ai = 0; ai < 2; ++ai)
#pragma unroll
            for (int m = 0; m < 4; ++m) { const int row = row0 + ai * HALF + m * 16; const size_t off = (size_t)row * 1024 + col0; float q = 0.f;
#pragma unroll
                for (int bj = 0; bj < 2; ++bj) {
                    const f32x4 b0 = *(const f32x4*)(base + off + bj * HALF), b1 = *(const f32x4*)(base + off + bj * HALF + 4);
                    const f32x4 v0 = acc[ai][bj][m][0] + b0, v1 = acc[ai][bj][m][1] + b1;
                    *(f32x4*)(out + off + bj * HALF) = v0; *(f32x4*)(out + off + bj * HALF + 4) = v1;
                    q += (v0[0] * v0[0] + v0[1] * v0[1]) + (v0[2] * v0[2] + v0[3] * v0[3]) + (v1[0] * v1[0] + v1[1] * v1[1]) + (v1[2] * v1[2] + v1[3] * v1[3]);
                    if (hb) { u32x4 w; w.x = cvt_pk_bf16(v0[0], v0[1]); w.y = cvt_pk_bf16(v0[2], v0[3]); w.z = cvt_pk_bf16(v1[0], v1[1]); w.w = cvt_pk_bf16(v1[2], v1[3]); *(u32x4*)(hb + off + bj * HALF) = w; } }
                q += __shfl_xor(q, 16); q += __shfl_xor(q, 32);
                if (fq == 0) ssq[(size_t)row * 16 + u.pn * 4 + wc] = q; }
    }
};
struct EpiSoftmax {
    static constexpr bool PERM = true;
    bf16_t* P; const float* ssq;
    __device__ __forceinline__ void operator()(AccT& acc, const Unit& u, int wr, int wc, int fr, int fq, PG8_LAS unsigned char* xl) const {
        PG8_LAS f32x2* X = (PG8_LAS f32x2*)xl;
        const int row0 = u.pm * BM + wr * 64 + fr, col0 = u.pn * BM + wc * 32 + 8 * fq;
        float ml[2][4];
#pragma unroll
        for (int ai = 0; ai < 2; ++ai)
#pragma unroll
            for (int m = 0; m < 4; ++m) { const int row = row0 + ai * HALF + m * 16; const float rs = rstd_from_slots(ssq + (size_t)row * 16);
                float mx = -3.0e38f;
#pragma unroll
                for (int bj = 0; bj < 2; ++bj)
#pragma unroll
                    for (int n = 0; n < 2; ++n) { f32x4 v = acc[ai][bj][m][n] * rs; acc[ai][bj][m][n] = v; mx = fmaxf(fmaxf(mx, fmaxf(v[0], v[1])), fmaxf(v[2], v[3])); }
                mx = fmaxf(mx, __shfl_xor(mx, 16)); mx = fmaxf(mx, __shfl_xor(mx, 32));
                float s = 0.f;
#pragma unroll
                for (int bj = 0; bj < 2; ++bj)
#pragma unroll
                    for (int n = 0; n < 2; ++n) { f32x4 v = acc[ai][bj][m][n];
                        v[0] = __builtin_amdgcn_exp2f(v[0] - mx); v[1] = __builtin_amdgcn_exp2f(v[1] - mx); v[2] = __builtin_amdgcn_exp2f(v[2] - mx); v[3] = __builtin_amdgcn_exp2f(v[3] - mx);
                        acc[ai][bj][m][n] = v; s += (v[0] + v[1]) + (v[2] + v[3]); }
                s += __shfl_xor(s, 16); s += __shfl_xor(s, 32);
                ml[ai][m] = mx;
                if (fq == 0) X[(ai * HALF + wr * 64 + m * 16 + fr) * 4 + wc] = (f32x2){mx, s}; }
        asm volatile("s_waitcnt lgkmcnt(0)" ::: "memory"); __builtin_amdgcn_s_barrier(); asm volatile("" ::: "memory");
#pragma unroll
        for (int ai = 0; ai < 2; ++ai)
#pragma unroll
            for (int m = 0; m < 4; ++m) { const int rl = ai * HALF + wr * 64 + m * 16 + fr; const int row = u.pm * BM + rl;
                const f32x2 a = X[rl * 4 + 0], b = X[rl * 4 + 1], c = X[rl * 4 + 2], d = X[rl * 4 + 3];
                const float Mx = fmaxf(fmaxf(a.x, b.x), fmaxf(c.x, d.x));
                const float L = a.y * __builtin_amdgcn_exp2f(a.x - Mx) + b.y * __builtin_amdgcn_exp2f(b.x - Mx) + c.y * __builtin_amdgcn_exp2f(c.x - Mx) + d.y * __builtin_amdgcn_exp2f(d.x - Mx);
                const float f = __builtin_amdgcn_exp2f(ml[ai][m] - Mx) * __builtin_amdgcn_rcpf(L);
                bf16_t* rowp = P + (size_t)row * 1024 + col0;
#pragma unroll
                for (int bj = 0; bj < 2; ++bj) { const f32x4 v0 = acc[ai][bj][m][0] * f, v1 = acc[ai][bj][m][1] * f;
                    u32x4 w; w.x = cvt_pk_bf16(v0[0], v0[1]); w.y = cvt_pk_bf16(v0[2], v0[3]); w.z = cvt_pk_bf16(v1[0], v1[1]); w.w = cvt_pk_bf16(v1[2], v1[3]);
                    *(u32x4*)(rowp + bj * HALF) = w; } }
    }
};
struct EpiGate {
    static constexpr bool PERM = false;
    unsigned* sel;
    __device__ __forceinline__ void operator()(AccT& acc, const Unit& u, int wr, int wc, int fr, int fq, PG8_LAS unsigned char*) const {
        const int own = u.pm & 31;
#pragma unroll
        for (int ai = 0; ai < 2; ++ai)
#pragma unroll
            for (int m = 0; m < 4; ++m) { const int row = u.pm * BM + ai * HALF + wr * 64 + m * 16 + fr;
#pragma unroll
                for (int bj = 0; bj < 2; ++bj) { unsigned mask = 0u;
#pragma unroll
                    for (int round = 0; round < 3; ++round) { float bv = -3.0e38f; int bi = 32;
#pragma unroll
                        for (int n = 0; n < 2; ++n)
#pragma unroll
                            for (int i = 0; i < 4; ++i) { const int nb = 16 * n + 4 * fq + i; const float v = acc[ai][bj][m][n][i];
                                if (nb < own && !((mask >> nb) & 1u) && v > bv) { bv = v; bi = nb; } }
#pragma unroll
                        for (int off = 16; off <= 32; off <<= 1) { const float ov = __shfl_xor(bv, off); const int oi = __shfl_xor(bi, off); if (ov > bv || (ov == bv && oi < bi)) { bv = ov; bi = oi; } }
                        if (bi < 32) mask |= 1u << bi; }
                    if (fq == 0) sel[(size_t)row * 8 + 4 * bj + wc] = mask; } }
    }
};

template <class Epi, class Sched, bool ALIGN_EPI>
__device__ __forceinline__ void gemm_phase(PG8_LAS unsigned char* lds, PG8_LAS unsigned char* xl, const Gemm g, const Sched& S, const Epi& E) {
    int tid_ = threadIdx.x; asm volatile("" : "+v"(tid_));
    const int tid = tid_, wid = __builtin_amdgcn_readfirstlane(tid >> 6), lane = tid & 63, wr = wid >> 2, wc = wid & 3, fr = lane & 15, fq = lane >> 4;
    const int K = g.K, nt = K / BK;
    unsigned voffA[2], voffB[2];
#pragma unroll
    for (int i = 0; i < 2; ++i) { int R, C; stage_rc(tid * 16 + i * 8192, R, C); const int Rb = Epi::PERM ? ((R & ~31) + perm32(R & 31)) : R;
        voffA[i] = (unsigned)(R * g.lda + C) * 2u; voffB[i] = (unsigned)(Rb * g.ldb + C) * 2u; }
    const size_t kstep = (size_t)(BK * 2);
    const size_t hstepA = (size_t)HALF * g.lda * 2, hstepB = (size_t)HALF * g.ldb * 2;
    const unsigned wmask = g.wrapmask;
    const unsigned ldsw = (unsigned)wid * 1024u;
    const int aoff = lds_byte(wr * 64 + fr, fq * 8), boff = lds_byte(wc * 32 + fr, fq * 8);
#define PG8_SA(b, h) (((b) * 2 + (h)) * HTB)
#define PG8_SB(b, h) ((4 + (b) * 2 + (h)) * HTB)
#define PG8_STAGE(bufoff, gbase, voff) do { _Pragma("unroll") for (int _i = 0; _i < 2; ++_i) \
        __builtin_amdgcn_global_load_lds((const unsigned*)((const char*)(gbase) + (voff)[_i]), (PG8_LAS unsigned*)(lds + (bufoff) + ldsw + _i * 8192), 16, 0, 0); } while (0)
#define PG8_LDA(dst, b, h) do { _Pragma("unroll") for (int m = 0; m < 4; ++m) _Pragma("unroll") for (int k = 0; k < 2; ++k) dst[m][k] = *(const PG8_LAS bf16x8*)(lds + PG8_SA(b, h) + aoff + m * 2048 + k * 1024); } while (0)
#define PG8_LDB(dst, b, h) do { _Pragma("unroll") for (int n = 0; n < 2; ++n) _Pragma("unroll") for (int k = 0; k < 2; ++k) dst[n][k] = *(const PG8_LAS bf16x8*)(lds + PG8_SB(b, h) + boff + n * 2048 + k * 1024); } while (0)
#define PG8_MMA(ai, bj, At, Bt) do { __builtin_amdgcn_s_setprio(1); _Pragma("unroll") for (int m = 0; m < 4; ++m) _Pragma("unroll") for (int n = 0; n < 2; ++n) _Pragma("unroll") for (int k = 0; k < 2; ++k) \
        acc[ai][bj][m][n] = __builtin_amdgcn_mfma_f32_16x16x32_bf16(Bt[n][k], At[m][k], acc[ai][bj][m][n], 0, 0, 0); __builtin_amdgcn_s_setprio(0); } while (0)
#define PG8_WAIT_V(n) asm volatile("s_waitcnt vmcnt(" #n ")" ::: "memory")
#define PG8_WAIT_L(n) asm volatile("s_waitcnt lgkmcnt(" #n ")" ::: "memory")
#define PG8_BAR __builtin_amdgcn_s_barrier()
#define PG8_SCHED __builtin_amdgcn_sched_barrier(0)
    Unit cur, nxt; int ui = 0;
    if (!S.next(0, cur)) return;
    AccT acc;
#pragma unroll
    for (int a = 0; a < 2; ++a)
#pragma unroll
        for (int b = 0; b < 2; ++b)
#pragma unroll
            for (int m = 0; m < 4; ++m)
#pragma unroll
                for (int n = 0; n < 2; ++n) acc[a][b][m][n] = (f32x4){0.f, 0.f, 0.f, 0.f};
    bf16x8 At[4][2], B0[2][2], B1[2][2];
    const char* cA = (const char*)g.A + cur.aoff; const char* cB = (const char*)g.Bt + cur.boff;
    PG8_STAGE(PG8_SB(0, 0), cB, voffB); PG8_STAGE(PG8_SB(0, 1), cB + hstepB, voffB); PG8_STAGE(PG8_SA(0, 0), cA, voffA); PG8_STAGE(PG8_SA(0, 1), cA + hstepA, voffA);
    if (wr == 1) PG8_BAR;
    PG8_WAIT_V(2); PG8_BAR;
    PG8_STAGE(PG8_SB(1, 0), cB + kstep, voffB); PG8_STAGE(PG8_SA(1, 0), cA + kstep, voffA); PG8_STAGE(PG8_SB(1, 1), cB + hstepB + kstep, voffB);
    PG8_WAIT_V(6); PG8_BAR;
    for (;;) {
        const bool has_next = S.next(ui + 1, nxt);
        const char* nA = has_next ? (const char*)g.A + nxt.aoff : cA; const char* nB = has_next ? (const char*)g.Bt + nxt.boff : cB;
        for (int t = 0; t < nt; t += 2) {
            const bool last = (t == nt - 2);
            const char* a1 = cA + (size_t)(((unsigned)(t * BK) & wmask) * 2u) + kstep;
            const char* a2 = last ? nA : cA + (size_t)(((unsigned)((t + 2) * BK) & wmask) * 2u); const char* b2 = last ? nB : cB + (size_t)(t + 2) * kstep;
            const char* a3 = a2 + kstep; const char* b3 = b2 + kstep;
            PG8_LDB(B0, 0, 0); PG8_LDB(B1, 0, 1); PG8_SCHED; PG8_LDA(At, 0, 0); PG8_STAGE(PG8_SA(1, 1), a1 + hstepA, voffA);
            PG8_WAIT_V(8); PG8_WAIT_L(0); PG8_BAR; PG8_MMA(0, 0, At, B0); PG8_MMA(0, 1, At, B1); PG8_BAR; PG8_SCHED;
            PG8_LDA(At, 0, 1); PG8_STAGE(PG8_SB(0, 0), b2, voffB); PG8_STAGE(PG8_SB(0, 1), b2 + hstepB, voffB); PG8_STAGE(PG8_SA(0, 0), a2, voffA);
            PG8_WAIT_V(8); PG8_WAIT_L(0); PG8_BAR; PG8_MMA(1, 0, At, B0); PG8_MMA(1, 1, At, B1); PG8_BAR; PG8_SCHED;
            PG8_LDB(B0, 1, 0); PG8_LDB(B1, 1, 1); PG8_SCHED; PG8_LDA(At, 1, 0); PG8_STAGE(PG8_SA(0, 1), a2 + hstepA, voffA);
            PG8_WAIT_V(8); PG8_WAIT_L(0); PG8_BAR; PG8_MMA(0, 0, At, B0); PG8_MMA(0, 1, At, B1); PG8_BAR; PG8_SCHED;
            PG8_LDA(At, 1, 1); PG8_STAGE(PG8_SB(1, 0), b3, voffB); PG8_STAGE(PG8_SB(1, 1), b3 + hstepB, voffB); PG8_STAGE(PG8_SA(1, 0), a3, voffA);
            PG8_WAIT_V(8); PG8_WAIT_L(0); PG8_BAR; PG8_MMA(1, 0, At, B0); PG8_MMA(1, 1, At, B1); PG8_BAR; PG8_SCHED;
        }
        if constexpr (ALIGN_EPI) { if (wr == 0) PG8_BAR; }
        E(acc, cur, wr, wc, fr, fq, xl);
        if (!has_next) break;
#pragma unroll
        for (int a = 0; a < 2; ++a)
#pragma unroll
            for (int b = 0; b < 2; ++b)
#pragma unroll
                for (int m = 0; m < 4; ++m)
#pragma unroll
                    for (int n = 0; n < 2; ++n) acc[a][b][m][n] = (f32x4){0.f, 0.f, 0.f, 0.f};
        cur = nxt; cA = nA; cB = nB; ++ui;
        if constexpr (ALIGN_EPI) { if (wr == 1) PG8_BAR; }
    }
    PG8_WAIT_V(0);
    if constexpr (!ALIGN_EPI) { if (wr == 0) PG8_BAR; }
    PG8_BAR;
#undef PG8_SA
#undef PG8_SB
#undef PG8_STAGE
#undef PG8_LDA
#undef PG8_LDB
#undef PG8_MMA
#undef PG8_WAIT_V
#undef PG8_WAIT_L
#undef PG8_BAR
#undef PG8_SCHED
}
}

constexpr int NWAVES = 8;
constexpr int NB = 8, T = 8192, D = 1024, M = NB * T;
constexpr int INC = 3080, NQKV = 3072, FF = 2816;
constexpr int C_F = 1536, C_QM = 1544, C_KM = 2056;
constexpr float LOG2E = 1.4426950408889634f;
constexpr float C2 = 0.125f * LOG2E;
constexpr float RMS_EPS = 1e-6f;

constexpr size_t MiB = 1u << 20;
constexpr size_t WS_CTL = 0, CTL_ZERO_BYTES = 1 * MiB;
constexpr size_t WS_LOGF = 2 * MiB, WS_C = 4 * MiB, WS_ABAR = 6 * MiB, WS_KM = 7 * MiB, WS_SEL = 8 * MiB;
constexpr size_t WS_SSQ1 = 10 * MiB, WS_SSQ2 = 14 * MiB, WS_SSQ3 = 18 * MiB;
constexpr size_t WS_MEMN = 22 * MiB, WS_KV = 26 * MiB, WS_WQS = 34 * MiB, WS_WOT = 36 * MiB, WS_WKVT = 38 * MiB, WS_WINT = 42 * MiB, WS_WOUTT = 48 * MiB;
constexpr size_t WS_WUPT = 50 * MiB, WS_WDT = 62 * MiB, WS_ZT = 68 * MiB, WS_WQK = 80 * MiB, WS_VWO = 96 * MiB;
constexpr size_t WS_A1 = 112 * MiB;
constexpr size_t WS_QKV = 368 * MiB;
constexpr size_t WS_Y = WS_A1, WS_HB1 = WS_A1 + 128 * MiB, WS_P = WS_QKV, WS_HB2 = WS_A1;
constexpr size_t WS_G = 240 * MiB, WS_U = 592 * MiB, WS_END = 944 * MiB;
static_assert(WS_WDT + (size_t)D * FF * 2 <= WS_ZT && WS_ZT + (size_t)8 * 256 * 3072 * 2 <= WS_WQK && WS_VWO + 16 * MiB <= WS_A1, "ws map");
static_assert(WS_G + (size_t)M * FF * 2 <= WS_U && WS_U + (size_t)M * FF * 2 <= WS_END, "ws map 2");
constexpr int CW_BAR = 4096;

constexpr int RING_OFF = 0, RING_BYTES = 131072;
constexpr int LDSCTL_OFF = RING_BYTES, MISC_OFF = LDSCTL_OFF + 320;
constexpr int XL_OFF = RING_BYTES + 512;
constexpr int LDS_BYTES = 147456;
static_assert(XL_OFF + 8192 <= LDS_BYTES, "LDS map");

#define GAS __attribute__((address_space(1)))
#define LAS __attribute__((address_space(3)))
typedef unsigned short bf16;
typedef unsigned v4u __attribute__((ext_vector_type(4)));
typedef float f32x4 __attribute__((ext_vector_type(4)));
typedef GAS unsigned gu32;
#define RLX_AGENT __ATOMIC_RELAXED, __HIP_MEMORY_SCOPE_AGENT
#define LDS_WAIT() asm volatile("s_waitcnt lgkmcnt(0)" ::: "memory")
__device__ __forceinline__ unsigned f2bf(float f) { unsigned u = __builtin_bit_cast(unsigned, f); return (u + 0x7fffu + ((u >> 16) & 1u)) >> 16; }
__device__ __forceinline__ unsigned pk2(float lo, float hi) { return f2bf(lo) | (f2bf(hi) << 16); }
__device__ __forceinline__ float bf2f(unsigned b) { return __builtin_bit_cast(float, b << 16); }
__device__ __forceinline__ float bflo(unsigned w) { return __builtin_bit_cast(float, w << 16); }
__device__ __forceinline__ float bfhi(unsigned w) { return __builtin_bit_cast(float, w & 0xffff0000u); }

#define XB_TMO      128
#define XB_XCNT(j)  (256  + 64 * (j))
#define XB_XSUB(j)  (1280 + 64 * (j))
#define XB_XGEN(j)  (2304 + 64 * (j))
#define XB_TOP      3328
#define XB_TOPGEN   3392
#define XCD_BAR_WORDS 3456
#define XB_SPIN_CAP (1u << 18)

__device__ __forceinline__ unsigned xb_ld(unsigned* p)              { return __hip_atomic_load(p, __ATOMIC_RELAXED, __HIP_MEMORY_SCOPE_AGENT); }
__device__ __forceinline__ unsigned xb_add(unsigned* p, unsigned v) { return __hip_atomic_fetch_add(p, v, __ATOMIC_RELAXED, __HIP_MEMORY_SCOPE_AGENT); }
__device__ __forceinline__ unsigned xb_xcc_id() { return (unsigned)__builtin_amdgcn_s_getreg((3 << 11) | 20) & 0xFu; }
#define XB_SPIN(cond, bar) do { unsigned _sp = 0; while (cond) { __builtin_amdgcn_s_sleep(1); \
    if ((++_sp & 255u) == 0u) { if (xb_ld(&(bar)[XB_TMO])) break; if (_sp > XB_SPIN_CAP) { atomicAdd(&(bar)[XB_TMO], 1u); break; } } } } while (0)

struct XcdBarrier { unsigned* bar; unsigned x; volatile LAS unsigned* st; };

__device__ __forceinline__ XcdBarrier xcd_barrier_post(unsigned* bar, volatile LAS unsigned* st) {
    XcdBarrier b; b.bar = bar; b.x = xb_xcc_id(); b.st = st;
    if (threadIdx.x == 0) (void)xb_add(&bar[XB_XCNT(b.x)], 1u);
    return b;
}
__device__ __forceinline__ void xcd_barrier_complete(unsigned* bar, unsigned x, unsigned& nloc, unsigned& nx) {
    const unsigned G = gridDim.x * gridDim.y * gridDim.z;
    unsigned sum, cnt, mine, sp = 0u;
    for (;;) {
        sum = 0u; cnt = 0u; mine = 0u;
#pragma unroll
        for (unsigned j = 0; j < 16; ++j) { const unsigned c = xb_ld(&bar[XB_XCNT(j)]); sum += c; cnt += (c > 0u) ? 1u : 0u; mine = (j == x) ? c : mine; }
        if (sum == G) break;
        __builtin_amdgcn_s_sleep(1);
        if ((++sp & 255u) == 0u) { if (xb_ld(&bar[XB_TMO])) break; if (sp > XB_SPIN_CAP) { atomicAdd(&bar[XB_TMO], 1u); break; } }
    }
    nloc = mine > 0u ? mine : 1u; nx = cnt > 0u ? cnt : 1u;
}
__device__ __forceinline__ void xcd_barrier(const XcdBarrier& b) {
    asm volatile("s_waitcnt vmcnt(0)" ::: "memory");
    __syncthreads();
    if (threadIdx.x == 0) {
        unsigned* bar = b.bar;
        __builtin_amdgcn_s_waitcnt(0);
        unsigned nloc = b.st[0], nx = b.st[1];
        if (nloc == 0u) { xcd_barrier_complete(bar, b.x, nloc, nx); b.st[0] = nloc; b.st[1] = nx; }
        const unsigned old = xb_add(&bar[XB_XSUB(b.x)], 1u);
        const unsigned gen = old / nloc;
        if (old + 1u == (gen + 1u) * nloc) {
            __builtin_amdgcn_fence(__ATOMIC_RELEASE, "agent");
            asm volatile("s_waitcnt vmcnt(0)" ::: "memory");
            const unsigned og = xb_add(&bar[XB_TOP], 1u);
            const unsigned tg = og / nx;
            if (og + 1u == (tg + 1u) * nx) xb_add(&bar[XB_TOPGEN], 1u);
            else XB_SPIN(xb_ld(&bar[XB_TOPGEN]) == tg, bar);
            __builtin_amdgcn_fence(__ATOMIC_ACQUIRE, "agent");
            xb_add(&bar[XB_XGEN(b.x)], 1u);
            asm volatile("s_waitcnt vmcnt(0)" ::: "memory");
        } else {
            XB_SPIN(xb_ld(&bar[XB_XGEN(b.x)]) == gen, bar);
            __builtin_amdgcn_fence(__ATOMIC_ACQUIRE, "agent");
            asm volatile("s_waitcnt vmcnt(0)" ::: "memory");
        }
    }
    __syncthreads();
}

__device__ __forceinline__ float wave_sum(float v) {
#pragma unroll
    for (int o = 1; o < 64; o <<= 1) v += __shfl_xor(v, o);
    return v;
}
__device__ __forceinline__ void p0_transpose_item(const float* W, int ldw, int K, int N, bf16* WT, const float* kscale, bool remap, LAS float* scr, int item, int lane) {
    const int nblk = N / 32, kb = item / nblk, nb = item % nblk, k0 = 64 * kb, n0 = 32 * nb;
    const int sn0 = (remap && n0 >= 1536) ? n0 + 8 : n0;
#pragma unroll 8
    for (int i = 0; i < 32; ++i) { const int kk = 2 * i + (lane >> 5); float v = W[(size_t)(k0 + kk) * ldw + sn0 + (lane & 31)]; if (kscale) v *= kscale[k0 + kk]; scr[kk * 33 + (lane & 31)] = v; }
    LDS_WAIT(); asm volatile("" ::: "memory");
    const int c = lane & 7;
#pragma unroll
    for (int j = 0; j < 4; ++j) { const int n = (lane >> 3) + 8 * j; const LAS float* s = scr + (8 * c) * 33 + n;
        v4u o; o.x = pk2(s[0 * 33], s[1 * 33]); o.y = pk2(s[2 * 33], s[3 * 33]); o.z = pk2(s[4 * 33], s[5 * 33]); o.w = pk2(s[6 * 33], s[7 * 33]);
        *(GAS v4u*)(WT + (size_t)(n0 + n) * K + k0 + 8 * c) = o; }
    LDS_WAIT(); asm volatile("" ::: "memory");
}

struct Args { const float* in[19]; float* out; unsigned char* ws; };

template <int MODE>
__device__ __forceinline__ void naive_attn_phase(LAS unsigned char* ldsb, int G, bf16* QKV, const float* Cc, const unsigned* sel) {
    LAS float* Ks = (LAS float*)ldsb; LAS float* Vs = Ks + 4096; LAS float* Cs = Vs + 4096;
    int tid_ = threadIdx.x; asm volatile("" : "+v"(tid_));
    const int tid = tid_, wave = tid >> 6;
    constexpr int qcol = MODE == 0 ? 0 : 1536, kcol = qcol + 512, vcol = qcol + 1024;
    for (int it = 0;; ++it) {
        const int idx = it * G + (int)blockIdx.x; if (idx >= 1024) break;
        const int bh = idx >> 4, c0 = idx & 15, c = (it & 1) ? 15 - c0 : c0, b = bh >> 3, h = bh & 7;
        const int t = c * 512 + tid; const size_t row = (size_t)b * T + t;
        float q[64], o[64];
        { const v4u* qp = (const v4u*)(QKV + row * NQKV + qcol + h * 64);
#pragma unroll
          for (int i = 0; i < 8; ++i) { const v4u w = qp[i]; q[8 * i] = bflo(w.x); q[8 * i + 1] = bfhi(w.x); q[8 * i + 2] = bflo(w.y); q[8 * i + 3] = bfhi(w.y); q[8 * i + 4] = bflo(w.z); q[8 * i + 5] = bfhi(w.z); q[8 * i + 6] = bflo(w.w); q[8 * i + 7] = bfhi(w.w); } }
#pragma unroll
        for (int i = 0; i < 64; ++i) o[i] = 0.f;
        float mrun = -1.0e30f, l = 0.f;
        const int own = t >> 8; const unsigned smask = MODE == 1 ? sel[row * 8 + h] : 0u;
        const float c_t = MODE == 0 ? Cc[(size_t)bh * T + t] : 0.f;
        const float slope2 = __builtin_amdgcn_exp2f(-(float)(h + 1)) * LOG2E;
        const int tmax_wave = c * 512 + wave * 64 + 63;
        const int nkt = c * 8 + 8;
        for (int kt = 0; kt < nkt; ++kt) {
            { const int kk = tid >> 3, ch = tid & 7; const size_t krow = (size_t)b * T + kt * 64 + kk;
              const v4u kw = *(const v4u*)(QKV + krow * NQKV + kcol + h * 64 + ch * 8); const v4u vw = *(const v4u*)(QKV + krow * NQKV + vcol + h * 64 + ch * 8);
              LAS f32x4* kd = (LAS f32x4*)(Ks + kk * 64 + ch * 8); LAS f32x4* vd = (LAS f32x4*)(Vs + kk * 64 + ch * 8);
              kd[0] = (f32x4){bflo(kw.x), bfhi(kw.x), bflo(kw.y), bfhi(kw.y)}; kd[1] = (f32x4){bflo(kw.z), bfhi(kw.z), bflo(kw.w), bfhi(kw.w)};
              vd[0] = (f32x4){bflo(vw.x), bfhi(vw.x), bflo(vw.y), bfhi(vw.y)}; vd[1] = (f32x4){bflo(vw.z), bfhi(vw.z), bflo(vw.w), bfhi(vw.w)};
              if (MODE == 0 && tid < 64) Cs[tid] = Cc[(size_t)bh * T + kt * 64 + tid]; }
            __syncthreads();
            const int nblk = kt >> 2;
            const bool lane_on = MODE == 0 ? true : (nblk == own || ((smask >> nblk) & 1u));
            const bool wave_on = (kt * 64 <= tmax_wave) && __any(lane_on);
            if (wave_on) {
#pragma unroll 1
                for (int j = 0; j < 64; ++j) { const LAS f32x4* kp = (const LAS f32x4*)(Ks + j * 64); float d0 = 0.f, d1 = 0.f;
#pragma unroll
                    for (int dd = 0; dd < 16; dd += 2) { const f32x4 ka = kp[dd], kb = kp[dd + 1];
                        d0 += (q[4 * dd] * ka[0] + q[4 * dd + 1] * ka[1]) + (q[4 * dd + 2] * ka[2] + q[4 * dd + 3] * ka[3]);
                        d1 += (q[4 * dd + 4] * kb[0] + q[4 * dd + 5] * kb[1]) + (q[4 * dd + 6] * kb[2] + q[4 * dd + 7] * kb[3]); }
                    const int sidx = kt * 64 + j; const bool ok = (sidx <= t) && lane_on;
                    const float bias = MODE == 0 ? (c_t - Cs[j]) * LOG2E : -slope2 * (float)(t - sidx);
                    const float sv = d0 + d1 + bias;
                    if (__any(ok && sv > mrun + 8.0f)) {
                        const float newm = (ok && sv > mrun) ? sv : mrun; const float alpha = __builtin_amdgcn_exp2f(mrun - newm); mrun = newm; l *= alpha;
#pragma unroll
                        for (int i = 0; i < 64; ++i) o[i] *= alpha; }
                    const float p = ok ? __builtin_amdgcn_exp2f(sv - mrun) : 0.f; l += p; const LAS f32x4* vp = (const LAS f32x4*)(Vs + j * 64);
#pragma unroll
                    for (int dd = 0; dd < 16; ++dd) { const f32x4 vv = vp[dd]; o[4 * dd] += p * vv[0]; o[4 * dd + 1] += p * vv[1]; o[4 * dd + 2] += p * vv[2]; o[4 * dd + 3] += p * vv[3]; } }
            }
            __syncthreads();
        }
        const float inv = 1.0f / l;
        { v4u* op = (v4u*)(QKV + row * NQKV + qcol + h * 64);
#pragma unroll
          for (int i = 0; i < 8; ++i) { v4u w; w.x = pk2(o[8 * i] * inv, o[8 * i + 1] * inv); w.y = pk2(o[8 * i + 2] * inv, o[8 * i + 3] * inv); w.z = pk2(o[8 * i + 4] * inv, o[8 * i + 5] * inv); w.w = pk2(o[8 * i + 6] * inv, o[8 * i + 7] * inv); op[i] = w; } }
    }
}

struct WqkOrder {
    int G, c;
    __device__ __forceinline__ bool next(int i, pg8::Unit& u) const { const int L = i * G + c; if (L >= 128) return false; const int z = L >> 2, pn = L & 3, b = z >> 2, h = z & 3;
        u.pm = b * 4 + h; u.pn = pn; u.aoff = ((size_t)(b * 256) * 2048 + h * 256) * 2; u.boff = ((size_t)(pn * 256) * 1024 + h * 256) * 2; return true; }
};
struct VwoOrder {
    int G, c;
    __device__ __forceinline__ bool next(int i, pg8::Unit& u) const { const int L = i * G + c; if (L >= 128) return false; const int z = L >> 2, pmq = L & 3, b = z >> 2, h = z & 3;
        u.pm = b * 4 + pmq; u.pn = h; u.aoff = ((size_t)(pmq * 256) * 1024 + h * 256) * 2; u.boff = ((size_t)(b * 256) * 2048 + 1024 + h * 256) * 2; return true; }
};

#define DECL_PTRS const __attribute__((address_space(4))) Args* KA_; { auto p_ = __builtin_amdgcn_kernarg_segment_ptr(); asm volatile("" : "+s"(p_)); KA_ = (const __attribute__((address_space(4))) Args*)p_; } \
    int tidp_ = threadIdx.x; asm volatile("" : "+v"(tidp_)); const int tid = tidp_, lane = tid & 63; (void)lane; \
    unsigned char* ws = KA_->ws; gu32* ctl = (gu32*)(ws + WS_CTL); const float* x = KA_->in[0]; const float* mem = KA_->in[1]; const float* g_mix = KA_->in[2]; const float* w_in = KA_->in[3]; const float* b_forget = KA_->in[4]; const float* g_fox = KA_->in[5]; const float* g_moba = KA_->in[6]; const float* w_out = KA_->in[7]; const float* g_cross = KA_->in[8]; const float* g_mem = KA_->in[9]; const float* w_q_mem = KA_->in[10]; const float* w_kv_mem = KA_->in[11]; const float* w_o_mem = KA_->in[12]; const float* g_ffn = KA_->in[13]; const float* w_up = KA_->in[14]; const float* conv_w = KA_->in[15]; const float* conv_b = KA_->in[16]; const float* w_down = KA_->in[17]; const float* g_final = KA_->in[18]; float* out = KA_->out; float* LOGF = (float*)(ws + WS_LOGF); float* CC = (float*)(ws + WS_C); float* ABAR = (float*)(ws + WS_ABAR); float* KM = (float*)(ws + WS_KM); unsigned* SEL = (unsigned*)(ws + WS_SEL); float* SSQ1 = (float*)(ws + WS_SSQ1); float* SSQ2 = (float*)(ws + WS_SSQ2); float* SSQ3 = (float*)(ws + WS_SSQ3); bf16* MEMN = (bf16*)(ws + WS_MEMN); bf16* KV = (bf16*)(ws + WS_KV); bf16* WQS = (bf16*)(ws + WS_WQS); bf16* WOT = (bf16*)(ws + WS_WOT); bf16* WKVT = (bf16*)(ws + WS_WKVT); bf16* WINT = (bf16*)(ws + WS_WINT); bf16* WOUTT = (bf16*)(ws + WS_WOUTT); bf16* WUPT = (bf16*)(ws + WS_WUPT); bf16* WDT = (bf16*)(ws + WS_WDT); bf16* ZT = (bf16*)(ws + WS_ZT); bf16* WQK = (bf16*)(ws + WS_WQK); bf16* VWO = (bf16*)(ws + WS_VWO); bf16* A1 = (bf16*)(ws + WS_A1); bf16* QKV = (bf16*)(ws + WS_QKV); bf16* Y = (bf16*)(ws + WS_Y); bf16* HB1 = (bf16*)(ws + WS_HB1); bf16* PB = (bf16*)(ws + WS_P); bf16* HB2 = (bf16*)(ws + WS_HB2); bf16* GB = (bf16*)(ws + WS_G); bf16* UB = (bf16*)(ws + WS_U);
__global__ void __launch_bounds__(NWAVES * 64, 2) fwd(Args args) {
    extern __shared__ __attribute__((aligned(16))) unsigned char lds[];
    LAS unsigned char* L = (LAS unsigned char*)lds;
    LAS unsigned char* XL = L + XL_OFF;
    volatile LAS unsigned* MISC = (volatile LAS unsigned*)(L + MISC_OFF);
    const int tid = threadIdx.x, lane = tid & 63, wave = __builtin_amdgcn_readfirstlane(tid >> 6);
    const int G = gridDim.x, bx = blockIdx.x;
    const int gw = bx * NWAVES + wave, NGW = G * NWAVES;
    for (int u = tid; u < (LDS_BYTES - LDSCTL_OFF) / 4; u += NWAVES * 64) ((LAS unsigned*)(L + LDSCTL_OFF))[u] = 0u;
    __syncthreads();
    XcdBarrier bar; { DECL_PTRS; bar = xcd_barrier_post((unsigned*)(ctl + CW_BAR), MISC + 8); }

    { DECL_PTRS;
        LAS float* scr = (LAS float*)(L + RING_OFF + wave * 16384);
        constexpr int I_IN = (D / 64) * (NQKV / 32), I_OUT = (D / 64) * (D / 32), I_KV = (D / 64) * (2048 / 32), I_O = I_OUT, I_UP = (D / 64) * (2 * FF / 32), I_DN = (FF / 64) * (D / 32);
        constexpr int NITEMS = I_IN + I_OUT + I_KV + I_O + I_UP + I_DN;
        for (int it = gw; it < NITEMS; it += NGW) {
            int r = it;
            if (r < I_IN) { p0_transpose_item(w_in, INC, D, NQKV, WINT, nullptr, true, scr, r, lane); continue; } r -= I_IN;
            if (r < I_OUT) { p0_transpose_item(w_out, D, D, D, WOUTT, nullptr, false, scr, r, lane); continue; } r -= I_OUT;
            if (r < I_KV) { p0_transpose_item(w_kv_mem, 2048, D, 2048, WKVT, nullptr, false, scr, r, lane); continue; } r -= I_KV;
            if (r < I_O) { p0_transpose_item(w_o_mem, D, D, D, WOT, nullptr, false, scr, r, lane); continue; } r -= I_O;
            if (r < I_UP) { p0_transpose_item(w_up, 2 * FF, D, 2 * FF, WUPT, g_ffn, false, scr, r, lane); continue; } r -= I_UP;
            p0_transpose_item(w_down, D, FF, D, WDT, nullptr, false, scr, r, lane);
        }
        for (int i = bx * 512 + tid; i < D * D / 4; i += G * 512) { const int kk = (i * 4) >> 10; const f32x4 v = *(const f32x4*)(w_q_mem + (size_t)i * 4) * (g_cross[kk] * (LOG2E / 16.0f));
            *(unsigned long long*)(WQS + (size_t)i * 4) = (unsigned long long)pk2(v[0], v[1]) | ((unsigned long long)pk2(v[2], v[3]) << 32); }
        for (int r = gw; r < NB * 256; r += NGW) { const GAS f32x4* xr = (const GAS f32x4*)(mem + (size_t)r * D) + lane; f32x4 v[4]; float s = 0.f;
#pragma unroll
            for (int j = 0; j < 4; ++j) { v[j] = xr[64 * j]; s += (v[j][0] * v[j][0] + v[j][1] * v[j][1]) + (v[j][2] * v[j][2] + v[j][3] * v[j][3]); }
            const float rs = __builtin_amdgcn_rsqf(wave_sum(s) * (1.f / D) + RMS_EPS);
            GAS unsigned long long* o8 = (GAS unsigned long long*)(MEMN + (size_t)r * D) + lane;
#pragma unroll
            for (int j = 0; j < 4; ++j) { const f32x4 gg = *((const f32x4*)g_mem + 64 * j + lane); const f32x4 a = v[j] * rs * gg; o8[64 * j] = (unsigned long long)pk2(a[0], a[1]) | ((unsigned long long)pk2(a[2], a[3]) << 32); } }
        __syncthreads();
        LAS float* wf = (LAS float*)(L + RING_OFF);
        LAS float* part = (LAS float*)(L + RING_OFF + 32768);
        for (int i = tid; i < 8 * 1024; i += 512) { const int h = i >> 10, kk = i & 1023; wf[i] = w_in[(size_t)kk * INC + C_F + h]; }
        __syncthreads();
        f32x4 gm[4];
#pragma unroll
        for (int j = 0; j < 4; ++j) gm[j] = *((const f32x4*)g_mix + 64 * j + lane);
        for (int blk = bx; blk < M / 256; blk += G) {
            f32x4 accm[4];
#pragma unroll
            for (int j = 0; j < 4; ++j) accm[j] = (f32x4){0.f, 0.f, 0.f, 0.f};
            for (int i = 0; i < 32; ++i) {
                const size_t r = (size_t)blk * 256 + wave * 32 + i;
                const GAS f32x4* xr = (const GAS f32x4*)(x + r * D) + lane; f32x4 v[4]; float s = 0.f;
#pragma unroll
                for (int j = 0; j < 4; ++j) { v[j] = xr[64 * j]; s += (v[j][0] * v[j][0] + v[j][1] * v[j][1]) + (v[j][2] * v[j][2] + v[j][3] * v[j][3]); }
                const float rs = __builtin_amdgcn_rsqf(wave_sum(s) * (1.f / D) + RMS_EPS);
                GAS unsigned long long* o8 = (GAS unsigned long long*)(A1 + r * 2048) + lane;
                float fl[8];
#pragma unroll
                for (int h = 0; h < 8; ++h) fl[h] = 0.f;
#pragma unroll
                for (int j = 0; j < 4; ++j) { const f32x4 a = v[j] * rs * gm[j]; accm[j] += a;
                    const unsigned h0 = pk2(a[0], a[1]), h1 = pk2(a[2], a[3]);
                    o8[64 * j] = (unsigned long long)h0 | ((unsigned long long)h1 << 32);
                    const unsigned l0 = pk2(a[0] - bflo(h0), a[1] - bfhi(h0)), l1 = pk2(a[2] - bflo(h1), a[3] - bfhi(h1));
                    o8[256 + 64 * j] = (unsigned long long)l0 | ((unsigned long long)l1 << 32);
#pragma unroll
                    for (int h = 0; h < 8; ++h) { const f32x4 w = *((const LAS f32x4*)(wf + h * 1024) + 64 * j + lane); fl[h] += (a[0] * w[0] + a[1] * w[1]) + (a[2] * w[2] + a[3] * w[3]); } }
#pragma unroll
                for (int h = 0; h < 8; ++h) fl[h] = wave_sum(fl[h]);
                if (lane < 8) { float z = fl[0];
#pragma unroll
                    for (int h = 1; h < 8; ++h) z = (lane == h) ? fl[h] : z;
                    z += b_forget[lane];
                    LOGF[r * 8 + lane] = fminf(z, 0.f) - log1pf(__expf(-fabsf(z))); }
            }
#pragma unroll
            for (int j = 0; j < 4; ++j) *((LAS f32x4*)(part + wave * 1024) + 64 * j + lane) = accm[j];
            __syncthreads();
            for (int col = tid; col < 1024; col += 512) { float s = 0.f;
#pragma unroll
                for (int w = 0; w < 8; ++w) s += part[w * 1024 + col];
                ABAR[(size_t)blk * 1024 + col] = s * (1.0f / 256.0f); }
            __syncthreads();
        }
    }
    xcd_barrier(bar);

    { DECL_PTRS;
        LAS float* sc = (LAS float*)(L + RING_OFF);
        for (int w = bx; w < 64; w += G) {
            const int b = w >> 3, h = w & 7; float v[16]; float run = 0.f;
#pragma unroll
            for (int i = 0; i < 16; ++i) { run += LOGF[((size_t)b * T + tid * 16 + i) * 8 + h]; v[i] = run; }
            float incl = run;
#pragma unroll
            for (int o = 1; o < 64; o <<= 1) { const float n = __shfl_up(incl, o); if (lane >= o) incl += n; }
            if (lane == 63) sc[wave] = incl;
            __syncthreads();
            float pre = incl - run;
            for (int ww = 0; ww < wave; ++ww) pre += sc[ww];
#pragma unroll
            for (int i = 0; i < 16; ++i) CC[(size_t)w * T + tid * 16 + i] = pre + v[i];
            __syncthreads();
        }
        for (int n = bx; n < 256; n += G) {
            for (int i = tid; i < 1024; i += 512) sc[i] = ABAR[(size_t)n * 1024 + i];
            __syncthreads();
            float s = 0.f;
            for (int kk = 0; kk < 1024; ++kk) s += sc[kk] * w_in[(size_t)kk * INC + C_KM + tid];
            KM[(size_t)n * 512 + tid] = s;
            __syncthreads();
        }
        pg8::Gemm g{MEMN, WKVT, D, D, D, 0xffffffffu}; pg8::TileOrder S; S.init(NB * 256, 2048, G, bx, D, D, 0, 1 << 30);
        pg8::EpiBf16 E{KV, 2048, 0u, 1.f};
        pg8::gemm_phase<pg8::EpiBf16, pg8::TileOrder, true>(L + RING_OFF, XL, g, S, E);
    }
    xcd_barrier(bar);

    { DECL_PTRS;
        LAS float* sc = (LAS float*)(L + RING_OFF);
        for (int n = bx; n < 256; n += G) {
            const int b = n >> 5, nb = n & 31;
            sc[tid] = KM[(size_t)n * 512 + tid];
            __syncthreads();
            f32x4 k0 = *(const LAS f32x4*)(sc + lane * 8), k1 = *(const LAS f32x4*)(sc + lane * 8 + 4);
            for (int i = 0; i < 128; ++i) { const int kk = wave * 128 + i;
                const f32x4 w0 = *(const f32x4*)(w_in + (size_t)kk * INC + C_QM + lane * 8), w1 = *(const f32x4*)(w_in + (size_t)kk * INC + C_QM + lane * 8 + 4);
                float s = (w0[0] * k0[0] + w0[1] * k0[1]) + (w0[2] * k0[2] + w0[3] * k0[3]) + (w1[0] * k1[0] + w1[1] * k1[1]) + (w1[2] * k1[2] + w1[3] * k1[3]);
                s += __shfl_xor(s, 1); s += __shfl_xor(s, 2); s += __shfl_xor(s, 4);
                if ((lane & 7) == 0) { const int h = lane >> 3; const unsigned hi = f2bf(s); const unsigned lo = f2bf(s - bf2f(hi));
                    bf16* zr = ZT + ((size_t)b * 256 + h * 32 + nb) * 3072; zr[kk] = (bf16)hi; zr[1024 + kk] = (bf16)hi; zr[2048 + kk] = (bf16)lo; } }
            __syncthreads();
        }
        { pg8::Gemm g{KV, WQS, 256, 2048, 1024, 0xffffffffu}; WqkOrder S{G, bx}; pg8::EpiBf16 E{WQK, 1024, 0u, 1.f};
          pg8::gemm_phase<pg8::EpiBf16, WqkOrder, true>(L + RING_OFF, XL, g, S, E); }
        { pg8::Gemm g{WOT, KV, 256, 1024, 2048, 0xffffffffu}; VwoOrder S{G, (bx + 128) % G}; pg8::EpiBf16 E{VWO, 1024, 0u, 1.f};
          pg8::gemm_phase<pg8::EpiBf16, VwoOrder, true>(L + RING_OFF, XL, g, S, E); }
    }
    xcd_barrier(bar);

    { DECL_PTRS;
        { pg8::Gemm g{A1, WINT, D, 2048, D, 0xffffffffu}; pg8::TileOrder S; S.init(M, NQKV, G, bx, 2048, D, 0, 1 << 30);
          pg8::EpiBf16 E{QKV, NQKV, 0xC3u, C2};
          pg8::gemm_phase<pg8::EpiBf16, pg8::TileOrder, true>(L + RING_OFF, XL, g, S, E); }
        { pg8::Gemm g{A1, ZT, 3072, 2048, 3072, 2047u}; pg8::TileOrder S; S.init(M, 256, G, bx, 2048, 3072, (size_t)256 * 3072, 32);
          pg8::EpiGate E{SEL};
          pg8::gemm_phase<pg8::EpiGate, pg8::TileOrder, true>(L + RING_OFF, XL, g, S, E); }
    }
    xcd_barrier(bar);

    { DECL_PTRS; naive_attn_phase<0>(L + RING_OFF, G, QKV, CC, SEL); }
    { DECL_PTRS; naive_attn_phase<1>(L + RING_OFF, G, QKV, CC, SEL); }
    xcd_barrier(bar);

    { DECL_PTRS;
    for (int r = gw; r < M; r += NGW) {
        const v4u wa = *((const v4u*)(QKV + (size_t)r * NQKV) + lane), wb = *((const v4u*)(QKV + (size_t)r * NQKV + 1536) + lane);
        float a[8] = {bflo(wa.x), bfhi(wa.x), bflo(wa.y), bfhi(wa.y), bflo(wa.z), bfhi(wa.z), bflo(wa.w), bfhi(wa.w)};
        float c[8] = {bflo(wb.x), bfhi(wb.x), bflo(wb.y), bfhi(wb.y), bflo(wb.z), bfhi(wb.z), bflo(wb.w), bfhi(wb.w)};
        float sa = 0.f, sb = 0.f;
#pragma unroll
        for (int i = 0; i < 8; ++i) { sa += a[i] * a[i]; sb += c[i] * c[i]; }
        const float ra = __builtin_amdgcn_rsqf(wave_sum(sa) * (1.f / 512.f) + RMS_EPS), rb = __builtin_amdgcn_rsqf(wave_sum(sb) * (1.f / 512.f) + RMS_EPS);
        const f32x4 ga0 = *((const f32x4*)g_fox + 2 * lane), ga1 = *((const f32x4*)g_fox + 2 * lane + 1), gb0 = *((const f32x4*)g_moba + 2 * lane), gb1 = *((const f32x4*)g_moba + 2 * lane + 1);
        v4u oa, ob;
        oa.x = pk2(a[0] * ra * ga0[0], a[1] * ra * ga0[1]); oa.y = pk2(a[2] * ra * ga0[2], a[3] * ra * ga0[3]); oa.z = pk2(a[4] * ra * ga1[0], a[5] * ra * ga1[1]); oa.w = pk2(a[6] * ra * ga1[2], a[7] * ra * ga1[3]);
        ob.x = pk2(c[0] * rb * gb0[0], c[1] * rb * gb0[1]); ob.y = pk2(c[2] * rb * gb0[2], c[3] * rb * gb0[3]); ob.z = pk2(c[4] * rb * gb1[0], c[5] * rb * gb1[1]); ob.w = pk2(c[6] * rb * gb1[2], c[7] * rb * gb1[3]);
        *((v4u*)(Y + (size_t)r * D) + lane) = oa; *((v4u*)(Y + (size_t)r * D + 512) + lane) = ob;
    } }
    xcd_barrier(bar);

    { DECL_PTRS; pg8::Gemm g{Y, WOUTT, D, D, D, 0xffffffffu}; pg8::TileOrder S; S.init(M, D, G, bx, D, D, 0, 1 << 30);
      pg8::EpiRes E{x, out, HB1, SSQ1};
      pg8::gemm_phase<pg8::EpiRes, pg8::TileOrder, true>(L + RING_OFF, XL, g, S, E); }
    xcd_barrier(bar);

    { DECL_PTRS; pg8::Gemm g{HB1, WQK, D, D, D, 0xffffffffu}; pg8::TileOrder S; S.init(M, D, G, bx, D, D, (size_t)D * D, 32);
      pg8::EpiSoftmax E{PB, SSQ1};
      pg8::gemm_phase<pg8::EpiSoftmax, pg8::TileOrder, true>(L + RING_OFF, XL, g, S, E); }
    xcd_barrier(bar);

    { DECL_PTRS; pg8::Gemm g{PB, VWO, D, D, D, 0xffffffffu}; pg8::TileOrder S; S.init(M, D, G, bx, D, D, (size_t)D * D, 32);
      pg8::EpiRes E{out, out, HB2, SSQ2};
      pg8::gemm_phase<pg8::EpiRes, pg8::TileOrder, true>(L + RING_OFF, XL, g, S, E); }
    xcd_barrier(bar);

    { DECL_PTRS; pg8::Gemm g{HB2, WUPT, D, D, D, 0xffffffffu}; pg8::TileOrder S; S.init(M, 2 * FF, G, bx, D, D, 0, 1 << 30);
      pg8::EpiUp E{GB, UB, SSQ2};
      pg8::gemm_phase<pg8::EpiUp, pg8::TileOrder, true>(L + RING_OFF, XL, g, S, E); }
    xcd_barrier(bar);

    { DECL_PTRS;
    for (size_t i = (size_t)bx * 512 + tid; i < (size_t)M * (FF / 8); i += (size_t)G * 512) {
        const size_t r = i / (FF / 8); const int cg = (int)(i % (FF / 8)) * 8; const int tt = (int)(r & (T - 1));
        const v4u g2 = *(const v4u*)(GB + r * FF + cg), uu = *(const v4u*)(UB + r * FF + cg);
        v4u g1 = (v4u){0u, 0u, 0u, 0u}, g0 = (v4u){0u, 0u, 0u, 0u};
        if (tt >= 1) g1 = *(const v4u*)(GB + (r - 1) * FF + cg);
        if (tt >= 2) g0 = *(const v4u*)(GB + (r - 2) * FF + cg);
        const unsigned G2[4] = {g2.x, g2.y, g2.z, g2.w}, G1[4] = {g1.x, g1.y, g1.z, g1.w}, G0[4] = {g0.x, g0.y, g0.z, g0.w}, UU[4] = {uu.x, uu.y, uu.z, uu.w};
        unsigned o[4];
#pragma unroll
        for (int k = 0; k < 4; ++k) { float res[2];
#pragma unroll
            for (int e = 0; e < 2; ++e) { const int col = cg + 2 * k + e;
                const float a2 = e ? bfhi(G2[k]) : bflo(G2[k]), a1 = e ? bfhi(G1[k]) : bflo(G1[k]), a0 = e ? bfhi(G0[k]) : bflo(G0[k]), uv = e ? bfhi(UU[k]) : bflo(UU[k]);
                const float gc = conv_b[col] + conv_w[col] * a0 + conv_w[FF + col] * a1 + conv_w[2 * FF + col] * a2;
                res[e] = gc * __builtin_amdgcn_rcpf(1.0f + __expf(-gc)) * uv; }
            o[k] = pk2(res[0], res[1]); }
        *(v4u*)(UB + r * FF + cg) = (v4u){o[0], o[1], o[2], o[3]};
    } }
    xcd_barrier(bar);

    { DECL_PTRS; pg8::Gemm g{UB, WDT, FF, FF, FF, 0xffffffffu}; pg8::TileOrder S; S.init(M, D, G, bx, FF, FF, 0, 1 << 30);
      pg8::EpiRes E{out, out, nullptr, SSQ3};
      pg8::gemm_phase<pg8::EpiRes, pg8::TileOrder, true>(L + RING_OFF, XL, g, S, E); }
    xcd_barrier(bar);

    { DECL_PTRS;
    for (int r = gw; r < M; r += NGW) {
        const float rs = pg8::rstd_from_slots(SSQ3 + (size_t)r * 16);
        GAS f32x4* o = (GAS f32x4*)(out + (size_t)r * D) + lane;
#pragma unroll
        for (int j = 0; j < 4; ++j) { const f32x4 gg = *((const f32x4*)g_final + 64 * j + lane); o[64 * j] = o[64 * j] * rs * gg; }
    } }
}

extern "C" void kernel_launch(void* const* d_in, const int* in_sizes, int n_in, void* d_out, int out_size, void* d_ws, size_t ws_size, hipStream_t stream) {
    static int grid = 0;
    if (grid == 0) {
        if (n_in != 19 || in_sizes[0] != M * D || out_size != M * D || ws_size < WS_END) { fprintf(stderr, "kernel_launch: unexpected problem shape (n_in %d, in0 %d, out %d, ws %zu); nothing launched\n", n_in, n_in > 0 ? in_sizes[0] : -1, out_size, ws_size); grid = -1; return; }
        int dev = 0, cus = 0, per_cu = 0;
        if (hipGetDevice(&dev) != hipSuccess || hipDeviceGetAttribute(&cus, hipDeviceAttributeMultiprocessorCount, dev) != hipSuccess) { grid = -1; return; }
        if (hipFuncSetAttribute((const void*)fwd, hipFuncAttributeMaxDynamicSharedMemorySize, LDS_BYTES) != hipSuccess) { fprintf(stderr, "kernel_launch: hipFuncSetAttribute failed\n"); grid = -1; return; }
        if (hipOccupancyMaxActiveBlocksPerMultiprocessor(&per_cu, (const void*)fwd, NWAVES * 64, LDS_BYTES) != hipSuccess || per_cu < 1) { fprintf(stderr, "kernel_launch: occupancy query reports %d\n", per_cu); }
        (void)hipGetLastError();
        grid = cus;
    }
    if (grid < 0) return;
    if (hipMemsetAsync((char*)d_ws + WS_CTL, 0, CTL_ZERO_BYTES, stream) != hipSuccess) return;
    Args a{};
    for (int i = 0; i < 19; ++i) a.in[i] = (const float*)d_in[i];
    a.out = (float*)d_out; a.ws = (unsigned char*)d_ws;
    hipLaunchKernelGGL(fwd, dim3(grid), dim3(NWAVES * 64), LDS_BYTES, stream, a);
}
```

```cpp
#include <hip/hip_runtime.h>
#include <hip/hip_bf16.h>
#include <cstdio>
#include <cstdint>

namespace pg8 {
#define PG8_LAS __attribute__((address_space(3)))
typedef unsigned short bf16_t;
typedef short bf16x8 __attribute__((ext_vector_type(8)));
typedef float f32x4 __attribute__((ext_vector_type(4)));
typedef float f32x2 __attribute__((ext_vector_type(2)));
typedef unsigned u32x4 __attribute__((ext_vector_type(4)));
typedef unsigned u32x2 __attribute__((ext_vector_type(2)));
constexpr int BM = 256, BK = 64, HALF = 128, HTB = HALF * BK * 2  , STAGE_BYTES = 8 * HTB, NXCD = 8, WGM = 8;

__host__ __device__ __forceinline__ int lds_byte(int r, int c) { const int st = (r >> 4) * 2 + (c >> 5), rr = r & 15, cc = c & 31, ob = rr * 64 + cc * 2; return st * 1024 + (ob ^ (((ob >> 9) & 1) << 5)); }
__host__ __device__ __forceinline__ void stage_rc(int b, int& R, int& C) { const int st = b / 1024, sb = b % 1024, swz = sb ^ (((sb >> 9) & 1) << 5); R = (st >> 1) * 16 + swz / 64; C = (st & 1) * 32 + (swz % 64) / 2; }
__host__ __device__ __forceinline__ int perm32(int rho) { const int n = rho >> 4, i = rho & 15; return 8 * (i >> 2) + 4 * n + (i & 3); }

struct Unit { int pm, pn; size_t aoff, boff; };
struct Gemm { const bf16_t* A; const bf16_t* Bt; int K, lda, ldb; unsigned wrapmask; };

struct TileOrder {
    int nM, nN, nwg, G, c; size_t a_tile, b_tile, b_batch; int pmb;
    __device__ __forceinline__ void init(int M, int N, int G_, int c_, int lda, int ldb, size_t b_batch_elems, int pm_per_batch) {
        nM = M / BM; nN = N / BM; nwg = nM * nN; G = G_; c = c_; a_tile = (size_t)BM * lda * 2; b_tile = (size_t)BM * ldb * 2; b_batch = b_batch_elems * 2; pmb = pm_per_batch; }
    __device__ __forceinline__ bool next(int i, Unit& u) const {
        const long L = (long)i * G + c; if (L >= nwg) return false;
        int wgid = (int)L; { const int q = nwg / NXCD, r = nwg % NXCD, xcd = wgid % NXCD, off = wgid / NXCD; wgid = (xcd < r ? xcd * (q + 1) : r * (q + 1) + (xcd - r) * q) + off; }
        const int nig = WGM * nN, gid = wgid / nig, fm = gid * WGM, gsz = (nM - fm) < WGM ? (nM - fm) : WGM;
        u.pm = fm + ((wgid % nig) % gsz); u.pn = (wgid % nig) / gsz;
        u.aoff = (size_t)u.pm * a_tile; u.boff = (size_t)u.pn * b_tile + (size_t)(u.pm / pmb) * b_batch; return true;
    }
};

__device__ __forceinline__ unsigned cvt_pk_bf16(float lo, float hi) { unsigned r; asm volatile("v_cvt_pk_bf16_f32 %0, %1, %2" : "=v"(r) : "v"(lo), "v"(hi)); return r; }

typedef f32x4 AccT[2][2][4][2];

struct EpiBf16 {
    static constexpr bool PERM = true;
    bf16_t* O; int ldc; unsigned scalemask; float scale0;
    __device__ __forceinline__ void operator()(AccT& acc, const Unit& u, int wr, int wc, int fr, int fq, PG8_LAS unsigned char*) const {
        const int row0 = u.pm * BM + wr * 64 + fr, col0 = u.pn * BM + wc * 32 + 8 * fq;
        const float sc = ((scalemask >> u.pn) & 1u) ? scale0 : 1.f;
#pragma unroll
        for (int ai = 0; ai < 2; ++ai)
#pragma unroll
            for (int m = 0; m < 4; ++m) { bf16_t* rowp = O + (size_t)(row0 + ai * HALF + m * 16) * ldc + col0;
#pragma unroll
                for (int bj = 0; bj < 2; ++bj) { const f32x4 v0 = acc[ai][bj][m][0] * sc, v1 = acc[ai][bj][m][1] * sc;
                    u32x4 w; w.x = cvt_pk_bf16(v0[0], v0[1]); w.y = cvt_pk_bf16(v0[2], v0[3]); w.z = cvt_pk_bf16(v1[0], v1[1]); w.w = cvt_pk_bf16(v1[2], v1[3]);
                    *(u32x4*)(rowp + bj * HALF) = w; } }
    }
};
__device__ __forceinline__ float rstd_from_slots(const float* slots) {
    const f32x4 a = *(const f32x4*)slots, b = *(const f32x4*)(slots + 4), c = *(const f32x4*)(slots + 8), d = *(const f32x4*)(slots + 12);
    const float s = ((a[0] + a[1]) + (a[2] + a[3])) + ((b[0] + b[1]) + (b[2] + b[3])) + ((c[0] + c[1]) + (c[2] + c[3])) + ((d[0] + d[1]) + (d[2] + d[3]));
    return __builtin_amdgcn_rsqf(s * (1.0f / 1024.0f) + 1e-6f);
}
struct EpiUp {
    static constexpr bool PERM = true;
    bf16_t* Gb; bf16_t* Ub; const float* ssq;
    __device__ __forceinline__ void operator()(AccT& acc, const Unit& u, int wr, int wc, int fr, int fq, PG8_LAS unsigned char*) const {
        const int row0 = u.pm * BM + wr * 64 + fr; const int pn = u.pn >= 11 ? u.pn - 11 : u.pn; bf16_t* base = u.pn >= 11 ? Ub : Gb;
        const int col0 = pn * BM + wc * 32 + 8 * fq;
#pragma unroll
        for (int ai = 0; ai < 2; ++ai)
#pragma unroll
            for (int m = 0; m < 4; ++m) { const int row = row0 + ai * HALF + m * 16; const float rs = rstd_from_slots(ssq + (size_t)row * 16); bf16_t* rowp = base + (size_t)row * 2816 + col0;
#pragma unroll
                for (int bj = 0; bj < 2; ++bj) { const f32x4 v0 = acc[ai][bj][m][0] * rs, v1 = acc[ai][bj][m][1] * rs;
                    u32x4 w; w.x = cvt_pk_bf16(v0[0], v0[1]); w.y = cvt_pk_bf16(v0[2], v0[3]); w.z = cvt_pk_bf16(v1[0], v1[1]); w.w = cvt_pk_bf16(v1[2], v1[3]);
                    *(u32x4*)(rowp + bj * HALF) = w; } }
    }
};
struct EpiRes {
    static constexpr bool PERM = true;
    const float* base; float* out; bf16_t* hb; float* ssq;
    __device__ __forceinline__ void operator()(AccT& acc, const Unit& u, int wr, int wc, int fr, int fq, PG8_LAS unsigned char*) const {
        const int row0 = u.pm * BM + wr * 64 + fr, col0 = u.pn * BM + wc * 32 + 8 * fq;
#pragma unroll
        for (int ai = 0; ai < 2; ++ai)
#pragma unroll
            for (int m = 0; m < 4; ++m) { const int row = row0 + ai * HALF + m * 16; const size_t off = (size_t)row * 1024 + col0; float q = 0.f;
#pragma unroll
                for (int bj = 0; bj < 2; ++bj) {
                    const f32x4 b0 = *(const f32x4*)(base + off + bj * HALF), b1 = *(const f32x4*)(base + off + bj * HALF + 4);
                    const f32x4 v0 = acc[ai][bj][m][0] + b0, v1 = acc[ai][bj][m][1] + b1;
                    *(f32x4*)(out + off + bj * HALF) = v0; *(f32x4*)(out + off + bj * HALF + 4) = v1;
                    q += (v0[0] * v0[0] + v0[1] * v0[1]) + (v0[2] * v0[2] + v0[3] * v0[3]) + (v1[0] * v1[0] + v1[1] * v1[1]) + (v1[2] * v1[2] + v1[3] * v1[3]);
                    if (hb) { u32x4 w; w.x = cvt_pk_bf16(v0[0], v0[1]); w.y = cvt_pk_bf16(v0[2], v0[3]); w.z = cvt_pk_bf16(v1[0], v1[1]); w.w = cvt_pk_bf16(v1[2], v1[3]); *(u32x4*)(hb + off + bj * HALF) = w; } }
                q += __shfl_xor(q, 16); q += __shfl_xor(q, 32);
                if (fq == 0) ssq[(size_t)row * 16 + u.pn * 4 + wc] = q; }
    }
};
struct EpiSoftmax {
    static constexpr bool PERM = true;
    bf16_t* P; const float* ssq;
    __device__ __forceinline__ void operator()(AccT& acc, const Unit& u, int wr, int wc, int fr, int fq, PG8_LAS unsigned char* xl) const {
        PG8_LAS f32x2* X = (PG8_LAS f32x2*)xl;
        const int row0 = u.pm * BM + wr * 64 + fr, col0 = u.pn * BM + wc * 32 + 8 * fq;
        float ml[2][4];
#pragma unroll
        for (int ai = 0; ai < 2; ++ai)
#pragma unroll
            for (int m = 0; m < 4; ++m) { const int row = row0 + ai * HALF + m * 16; const float rs = rstd_from_slots(ssq + (size_t)row * 16);
                float mx = -3.0e38f;
#pragma unroll
                for (int bj = 0; bj < 2; ++bj)
#pragma unroll
                    for (int n = 0; n < 2; ++n) { f32x4 v = acc[ai][bj][m][n] * rs; acc[ai][bj][m][n] = v; mx = fmaxf(fmaxf(mx, fmaxf(v[0], v[1])), fmaxf(v[2], v[3])); }
                mx = fmaxf(mx, __shfl_xor(mx, 16)); mx = fmaxf(mx, __shfl_xor(mx, 32));
                float s = 0.f;
#pragma unroll
                for (int bj = 0; bj < 2; ++bj)
#pragma unroll
                    for (int n = 0; n < 2; ++n) { f32x4 v = acc[ai][bj][m][n];
                        v[0] = __builtin_amdgcn_exp2f(v[0] - mx); v[1] = __builtin_amdgcn_exp2f(v[1] - mx); v[2] = __builtin_amdgcn_exp2f(v[2] - mx); v[3] = __builtin_amdgcn_exp2f(v[3] - mx);
                        acc[ai][bj][m][n] = v; s += (v[0] + v[1]) + (v[2] + v[3]); }
                s += __shfl_xor(s, 16); s += __shfl_xor(s, 32);
                ml[ai][m] = mx;
                if (fq == 0) X[(ai * HALF + wr * 64 + m * 16 + fr) * 4 + wc] = (f32x2){mx, s}; }
        asm volatile("s_waitcnt lgkmcnt(0)" ::: "memory"); __builtin_amdgcn_s_barrier(); asm volatile("" ::: "memory");
#pragma unroll
        for (int ai = 0; ai < 2; ++ai)
#pragma unroll
            for (int m = 0; m < 4; ++m) { const int rl = ai * HALF + wr * 64 + m * 16 + fr; const int row = u.pm * BM + rl;
                const f32x2 a = X[rl * 4 + 0], b = X[rl * 4 + 1], c = X[rl * 4 + 2], d = X[rl * 4 + 3];
                const float Mx = fmaxf(fmaxf(a.x, b.x), fmaxf(c.x, d.x));
                const float L = a.y * __builtin_amdgcn_exp2f(a.x - Mx) + b.y * __builtin_amdgcn_exp2f(b.x - Mx) + c.y * __builtin_amdgcn_exp2f(c.x - Mx) + d.y * __builtin_amdgcn_exp2f(d.x - Mx);
                const float f = __builtin_amdgcn_exp2f(ml[ai][m] - Mx) * __builtin_amdgcn_rcpf(L);
                bf16_t* rowp = P + (size_t)row * 1024 + col0;
#pragma unroll
                for (int bj = 0; bj < 2; ++bj) { const f32x4 v0 = acc[ai][bj][m][0] * f, v1 = acc[ai][bj][m][1] * f;
                    u32x4 w; w.x = cvt_pk_bf16(v0[0], v0[1]); w.y = cvt_pk_bf16(v0[2], v0[3]); w.z = cvt_pk_bf16(v1[0], v1[1]); w.w = cvt_pk_bf16(v1[2], v1[3]);
                    *(u32x4*)(rowp + bj * HALF) = w; } }
    }
};
struct EpiGate {
    static constexpr bool PERM = false;
    unsigned* sel;
    __device__ __forceinline__ void operator()(AccT& acc, const Unit& u, int wr, int wc, int fr, int fq, PG8_LAS unsigned char*) const {
        const int own = u.pm & 31;
#pragma unroll
        for (int ai = 0; ai < 2; ++ai)
#pragma unroll
            for (int m = 0; m < 4; ++m) { const int row = u.pm * BM + ai * HALF + wr * 64 + m * 16 + fr;
#pragma unroll
                for (int bj = 0; bj < 2; ++bj) { unsigned mask = 0u;
#pragma unroll
                    for (int round = 0; round < 3; ++round) { float bv = -3.0e38f; int bi = 32;
#pragma unroll
                        for (int n = 0; n < 2; ++n)
#pragma unroll
                            for (int i = 0; i < 4; ++i) { const int nb = 16 * n + 4 * fq + i; const float v = acc[ai][bj][m][n][i];
                                if (nb < own && !((mask >> nb) & 1u) && v > bv) { bv = v; bi = nb; } }
#pragma unroll
                        for (int off = 16; off <= 32; off <<= 1) { const float ov = __shfl_xor(bv, off); const int oi = __shfl_xor(bi, off); if (ov > bv || (ov == bv && oi < bi)) { bv = ov; bi = oi; } }
                        if (bi < 32) mask |= 1u << bi; }
                    if (fq == 0) sel[((size_t)((u.pm >> 5) * 8 + 4 * bj + wc)) * 8192 + (row & 8191)] = mask; } }
    }
};

template <class Epi, class Sched, bool ALIGN_EPI>
__device__ __forceinline__ void gemm_phase(PG8_LAS unsigned char* lds, PG8_LAS unsigned char* xl, const Gemm g, const Sched& S, const Epi& E) {
    int tid_ = threadIdx.x; asm volatile("" : "+v"(tid_));
    const int tid = tid_, wid = __builtin_amdgcn_readfirstlane(tid >> 6), lane = tid & 63, wr = wid >> 2, wc = wid & 3, fr = lane & 15, fq = lane >> 4;
    const int K = g.K, nt = K / BK;
    unsigned voffA[2], voffB[2];
#pragma unroll
    for (int i = 0; i < 2; ++i) { int R, C; stage_rc(tid * 16 + i * 8192, R, C); const int Rb = Epi::PERM ? ((R & ~31) + perm32(R & 31)) : R;
        voffA[i] = (unsigned)(R * g.lda + C) * 2u; voffB[i] = (unsigned)(Rb * g.ldb + C) * 2u; }
    const size_t kstep = (size_t)(BK * 2);
    const size_t hstepA = (size_t)HALF * g.lda * 2, hstepB = (size_t)HALF * g.ldb * 2;
    const unsigned wmask = g.wrapmask;
    const unsigned ldsw = (unsigned)wid * 1024u;
    const int aoff = lds_byte(wr * 64 + fr, fq * 8), boff = lds_byte(wc * 32 + fr, fq * 8);
#define PG8_SA(b, h) (((b) * 2 + (h)) * HTB)
#define PG8_SB(b, h) ((4 + (b) * 2 + (h)) * HTB)
#define PG8_STAGE(bufoff, gbase, voff) do { _Pragma("unroll") for (int _i = 0; _i < 2; ++_i) \
        __builtin_amdgcn_global_load_lds((const unsigned*)((const char*)(gbase) + (voff)[_i]), (PG8_LAS unsigned*)(lds + (bufoff) + ldsw + _i * 8192), 16, 0, 0); } while (0)
#define PG8_LDA(dst, b, h) do { _Pragma("unroll") for (int m = 0; m < 4; ++m) _Pragma("unroll") for (int k = 0; k < 2; ++k) dst[m][k] = *(const PG8_LAS bf16x8*)(lds + PG8_SA(b, h) + aoff + m * 2048 + k * 1024); } while (0)
#define PG8_LDB(dst, b, h) do { _Pragma("unroll") for (int n = 0; n < 2; ++n) _Pragma("unroll") for (int k = 0; k < 2; ++k) dst[n][k] = *(const PG8_LAS bf16x8*)(lds + PG8_SB(b, h) + boff + n * 2048 + k * 1024); } while (0)
#define PG8_MMA(ai, bj, At, Bt) do { __builtin_amdgcn_s_setprio(1); _Pragma("unroll") for (int m = 0; m < 4; ++m) _Pragma("unroll") for (int n = 0; n < 2; ++n) _Pragma("unroll") for (int k = 0; k < 2; ++k) \
        acc[ai][bj][m][n] = __builtin_amdgcn_mfma_f32_16x16x32_bf16(Bt[n][k], At[m][k], acc[ai][bj][m][n], 0, 0, 0); __builtin_amdgcn_s_setprio(0); } while (0)
#define PG8_WAIT_V(n) asm volatile("s_waitcnt vmcnt(" #n ")" ::: "memory")
#define PG8_WAIT_L(n) asm volatile("s_waitcnt lgkmcnt(" #n ")" ::: "memory")
#define PG8_BAR __builtin_amdgcn_s_barrier()
#define PG8_SCHED __builtin_amdgcn_sched_barrier(0)
    Unit cur, nxt; int ui = 0;
    if (!S.next(0, cur)) return;
    AccT acc;
#pragma unroll
    for (int a = 0; a < 2; ++a)
#pragma unroll
        for (int b = 0; b < 2; ++b)
#pragma unroll
            for (int m = 0; m < 4; ++m)
#pragma unroll
                for (int n = 0; n < 2; ++n) acc[a][b][m][n] = (f32x4){0.f, 0.f, 0.f, 0.f};
    bf16x8 At[4][2], B0[2][2], B1[2][2];
    const char* cA = (const char*)g.A + cur.aoff; const char* cB = (const char*)g.Bt + cur.boff;
    PG8_STAGE(PG8_SB(0, 0), cB, voffB); PG8_STAGE(PG8_SB(0, 1), cB + hstepB, voffB); PG8_STAGE(PG8_SA(0, 0), cA, voffA); PG8_STAGE(PG8_SA(0, 1), cA + hstepA, voffA);
    if (wr == 1) PG8_BAR;
    PG8_WAIT_V(2); PG8_BAR;
    PG8_STAGE(PG8_SB(1, 0), cB + kstep, voffB); PG8_STAGE(PG8_SA(1, 0), cA + kstep, voffA); PG8_STAGE(PG8_SB(1, 1), cB + hstepB + kstep, voffB);
    PG8_WAIT_V(6); PG8_BAR;
    for (;;) {
        const bool has_next = S.next(ui + 1, nxt);
        const char* nA = has_next ? (const char*)g.A + nxt.aoff : cA; const char* nB = has_next ? (const char*)g.Bt + nxt.boff : cB;
        for (int t = 0; t < nt; t += 2) {
            const bool last = (t == nt - 2);
            const char* a1 = cA + (size_t)(((unsigned)(t * BK) & wmask) * 2u) + kstep;
            const char* a2 = last ? nA : cA + (size_t)(((unsigned)((t + 2) * BK) & wmask) * 2u); const char* b2 = last ? nB : cB + (size_t)(t + 2) * kstep;
            const char* a3 = a2 + kstep; const char* b3 = b2 + kstep;
            PG8_LDB(B0, 0, 0); PG8_LDB(B1, 0, 1); PG8_SCHED; PG8_LDA(At, 0, 0); PG8_STAGE(PG8_SA(1, 1), a1 + hstepA, voffA);
            PG8_WAIT_V(8); PG8_WAIT_L(0); PG8_BAR; PG8_MMA(0, 0, At, B0); PG8_MMA(0, 1, At, B1); PG8_BAR; PG8_SCHED;
            PG8_LDA(At, 0, 1); PG8_STAGE(PG8_SB(0, 0), b2, voffB); PG8_STAGE(PG8_SB(0, 1), b2 + hstepB, voffB); PG8_STAGE(PG8_SA(0, 0), a2, voffA);
            PG8_WAIT_V(8); PG8_WAIT_L(0); PG8_BAR; PG8_MMA(1, 0, At, B0); PG8_MMA(1, 1, At, B1); PG8_BAR; PG8_SCHED;
            PG8_LDB(B0, 1, 0); PG8_LDB(B1, 1, 1); PG8_SCHED; PG8_LDA(At, 1, 0); PG8_STAGE(PG8_SA(0, 1), a2 + hstepA, voffA);
            PG8_WAIT_V(8); PG8_WAIT_L(0); PG8_BAR; PG8_MMA(0, 0, At, B0); PG8_MMA(0, 1, At, B1); PG8_BAR; PG8_SCHED;
            PG8_LDA(At, 1, 1); PG8_STAGE(PG8_SB(1, 0), b3, voffB); PG8_STAGE(PG8_SB(1, 1), b3 + hstepB, voffB); PG8_STAGE(PG8_SA(1, 0), a3, voffA);
            PG8_WAIT_V(8); PG8_WAIT_L(0); PG8_BAR; PG8_MMA(1, 0, At, B0); PG8_MMA(1, 1, At, B1); PG8_BAR; PG8_SCHED;
        }
        if constexpr (ALIGN_EPI) { if (wr == 0) PG8_BAR; }
        E(acc, cur, wr, wc, fr, fq, xl);
        if (!has_next) break;
#pragma unroll
        for (int a = 0; a < 2; ++a)
#pragma unroll
            for (int b = 0; b < 2; ++b)
#pragma unroll
                for (int m = 0; m < 4; ++m)
#pragma unroll
                    for (int n = 0; n < 2; ++n) acc[a][b][m][n] = (f32x4){0.f, 0.f, 0.f, 0.f};
        cur = nxt; cA = nA; cB = nB; ++ui;
        if constexpr (ALIGN_EPI) { if (wr == 1) PG8_BAR; }
    }
    PG8_WAIT_V(0);
    if constexpr (!ALIGN_EPI) { if (wr == 0) PG8_BAR; }
    PG8_BAR;
#undef PG8_SA
#undef PG8_SB
#undef PG8_STAGE
#undef PG8_LDA
#undef PG8_LDB
#undef PG8_MMA
#undef PG8_WAIT_V
#undef PG8_WAIT_L
#undef PG8_BAR
#undef PG8_SCHED
}
}

constexpr int NWAVES = 8;
constexpr int NB = 8, T = 8192, D = 1024, M = NB * T;
constexpr int INC = 3080, NQKV = 3072, FF = 2816;
constexpr int C_F = 1536, C_QM = 1544, C_KM = 2056;
constexpr float LOG2E = 1.4426950408889634f;
constexpr float C2 = 0.125f * LOG2E;
constexpr float RMS_EPS = 1e-6f;

constexpr size_t MiB = 1u << 20;
constexpr size_t WS_CTL = 0, CTL_ZERO_BYTES = 1 * MiB;
constexpr size_t WS_LOGF = 2 * MiB, WS_C = 4 * MiB, WS_ABAR = 6 * MiB, WS_KM = 7 * MiB, WS_SEL = 8 * MiB;
constexpr size_t WS_SSQ1 = 10 * MiB, WS_SSQ2 = 14 * MiB, WS_SSQ3 = 18 * MiB;
constexpr size_t WS_MEMN = 22 * MiB, WS_KV = 26 * MiB, WS_WQS = 34 * MiB, WS_WOT = 36 * MiB, WS_WKVT = 38 * MiB, WS_WINT = 42 * MiB, WS_WOUTT = 48 * MiB;
constexpr size_t WS_WUPT = 50 * MiB, WS_WDT = 62 * MiB, WS_ZT = 68 * MiB, WS_WQK = 80 * MiB, WS_VWO = 96 * MiB;
constexpr size_t WS_A1 = 112 * MiB;
constexpr size_t WS_QKV = 368 * MiB;
constexpr size_t WS_Y = 752 * MiB, WS_HB1 = WS_A1 + 128 * MiB, WS_P = WS_QKV, WS_HB2 = WS_A1;
constexpr size_t WS_PO = WS_A1;
constexpr size_t WS_LIST = 880 * MiB, WS_PML = 944 * MiB, WS_KXF = 960 * MiB, WS_KXM = 968 * MiB, WS_CNT = 969 * MiB;
constexpr size_t WS_G = 240 * MiB, WS_U = 592 * MiB, WS_END = 1024 * MiB;
static_assert(WS_WDT + (size_t)D * FF * 2 <= WS_ZT && WS_ZT + (size_t)8 * 256 * 3072 * 2 <= WS_WQK && WS_VWO + 16 * MiB <= WS_A1, "ws map");
static_assert(WS_G + (size_t)M * FF * 2 <= WS_U && WS_U + (size_t)M * FF * 2 <= WS_END && WS_Y + (size_t)M * D * 2 <= WS_LIST && WS_LIST + (size_t)2048 * 8192 * 4 <= WS_PML && WS_PML + (size_t)M * 32 * 8 <= WS_KXF && WS_KXF + (size_t)64 * 8192 * 16 <= WS_KXM, "ws map 2");
constexpr int CW_BAR = 4096;

constexpr int RING_OFF = 0, RING_BYTES = 131072;
constexpr int LDSCTL_OFF = RING_BYTES, MISC_OFF = LDSCTL_OFF + 320;
constexpr int XL_OFF = RING_BYTES + 512;
constexpr int LDS_BYTES = 147456;
static_assert(XL_OFF + 8192 <= LDS_BYTES, "LDS map");

#define GAS __attribute__((address_space(1)))
#define LAS __attribute__((address_space(3)))
typedef unsigned short bf16;
typedef unsigned v4u __attribute__((ext_vector_type(4)));
typedef float f32x4 __attribute__((ext_vector_type(4)));
typedef GAS unsigned gu32;
#define RLX_AGENT __ATOMIC_RELAXED, __HIP_MEMORY_SCOPE_AGENT
#define LDS_WAIT() asm volatile("s_waitcnt lgkmcnt(0)" ::: "memory")
__device__ __forceinline__ unsigned f2bf(float f) { unsigned u = __builtin_bit_cast(unsigned, f); return (u + 0x7fffu + ((u >> 16) & 1u)) >> 16; }
__device__ __forceinline__ unsigned pk2(float lo, float hi) { return f2bf(lo) | (f2bf(hi) << 16); }
__device__ __forceinline__ float bf2f(unsigned b) { return __builtin_bit_cast(float, b << 16); }
__device__ __forceinline__ float bflo(unsigned w) { return __builtin_bit_cast(float, w << 16); }
__device__ __forceinline__ float bfhi(unsigned w) { return __builtin_bit_cast(float, w & 0xffff0000u); }

#define XB_TMO      128
#define XB_XCNT(j)  (256  + 64 * (j))
#define XB_XSUB(j)  (1280 + 64 * (j))
#define XB_XGEN(j)  (2304 + 64 * (j))
#define XB_TOP      3328
#define XB_TOPGEN   3392
#define XCD_BAR_WORDS 3456
#define XB_SPIN_CAP (1u << 18)

__device__ __forceinline__ unsigned xb_ld(unsigned* p)              { return __hip_atomic_load(p, __ATOMIC_RELAXED, __HIP_MEMORY_SCOPE_AGENT); }
__device__ __forceinline__ unsigned xb_add(unsigned* p, unsigned v) { return __hip_atomic_fetch_add(p, v, __ATOMIC_RELAXED, __HIP_MEMORY_SCOPE_AGENT); }
__device__ __forceinline__ unsigned xb_xcc_id() { return (unsigned)__builtin_amdgcn_s_getreg((3 << 11) | 20) & 0xFu; }
#define XB_SPIN(cond, bar) do { unsigned _sp = 0; while (cond) { __builtin_amdgcn_s_sleep(1); \
    if ((++_sp & 255u) == 0u) { if (xb_ld(&(bar)[XB_TMO])) break; if (_sp > XB_SPIN_CAP) { atomicAdd(&(bar)[XB_TMO], 1u); break; } } } } while (0)

struct XcdBarrier { unsigned* bar; unsigned x; volatile LAS unsigned* st; };

__device__ __forceinline__ XcdBarrier xcd_barrier_post(unsigned* bar, volatile LAS unsigned* st) {
    XcdBarrier b; b.bar = bar; b.x = xb_xcc_id(); b.st = st;
    if (threadIdx.x == 0) (void)xb_add(&bar[XB_XCNT(b.x)], 1u);
    return b;
}
__device__ __forceinline__ void xcd_barrier_complete(unsigned* bar, unsigned x, unsigned& nloc, unsigned& nx) {
    const unsigned G = gridDim.x * gridDim.y * gridDim.z;
    unsigned sum, cnt, mine, sp = 0u;
    for (;;) {
        sum = 0u; cnt = 0u; mine = 0u;
#pragma unroll
        for (unsigned j = 0; j < 16; ++j) { const unsigned c = xb_ld(&bar[XB_XCNT(j)]); sum += c; cnt += (c > 0u) ? 1u : 0u; mine = (j == x) ? c : mine; }
        if (sum == G) break;
        __builtin_amdgcn_s_sleep(1);
        if ((++sp & 255u) == 0u) { if (xb_ld(&bar[XB_TMO])) break; if (sp > XB_SPIN_CAP) { atomicAdd(&bar[XB_TMO], 1u); break; } }
    }
    nloc = mine > 0u ? mine : 1u; nx = cnt > 0u ? cnt : 1u;
}
__device__ __forceinline__ void xcd_barrier(const XcdBarrier& b) {
    asm volatile("s_waitcnt vmcnt(0)" ::: "memory");
    __syncthreads();
    if (threadIdx.x == 0) {
        unsigned* bar = b.bar;
        __builtin_amdgcn_s_waitcnt(0);
        unsigned nloc = b.st[0], nx = b.st[1];
        if (nloc == 0u) { xcd_barrier_complete(bar, b.x, nloc, nx); b.st[0] = nloc; b.st[1] = nx; }
        const unsigned old = xb_add(&bar[XB_XSUB(b.x)], 1u);
        const unsigned gen = old / nloc;
        if (old + 1u == (gen + 1u) * nloc) {
            __builtin_amdgcn_fence(__ATOMIC_RELEASE, "agent");
            asm volatile("s_waitcnt vmcnt(0)" ::: "memory");
            const unsigned og = xb_add(&bar[XB_TOP], 1u);
            const unsigned tg = og / nx;
            if (og + 1u == (tg + 1u) * nx) xb_add(&bar[XB_TOPGEN], 1u);
            else XB_SPIN(xb_ld(&bar[XB_TOPGEN]) == tg, bar);
            __builtin_amdgcn_fence(__ATOMIC_ACQUIRE, "agent");
            xb_add(&bar[XB_XGEN(b.x)], 1u);
            asm volatile("s_waitcnt vmcnt(0)" ::: "memory");
        } else {
            XB_SPIN(xb_ld(&bar[XB_XGEN(b.x)]) == gen, bar);
            __builtin_amdgcn_fence(__ATOMIC_ACQUIRE, "agent");
            asm volatile("s_waitcnt vmcnt(0)" ::: "memory");
        }
    }
    __syncthreads();
}

__device__ __forceinline__ float wave_sum(float v) {
#pragma unroll
    for (int o = 1; o < 64; o <<= 1) v += __shfl_xor(v, o);
    return v;
}
__device__ __forceinline__ void p0_transpose_item(const float* W, int ldw, int K, int N, bf16* WT, const float* kscale, bool remap, LAS float* scr, int item, int lane) {
    const int nblk = N / 32, kb = item / nblk, nb = item % nblk, k0 = 64 * kb, n0 = 32 * nb;
    const int sn0 = (remap && n0 >= 1536) ? n0 + 8 : n0;
#pragma unroll 8
    for (int i = 0; i < 32; ++i) { const int kk = 2 * i + (lane >> 5); float v = W[(size_t)(k0 + kk) * ldw + sn0 + (lane & 31)]; if (kscale) v *= kscale[k0 + kk]; scr[kk * 33 + (lane & 31)] = v; }
    LDS_WAIT(); asm volatile("" ::: "memory");
    const int c = lane & 7;
#pragma unroll
    for (int j = 0; j < 4; ++j) { const int n = (lane >> 3) + 8 * j; const LAS float* s = scr + (8 * c) * 33 + n;
        v4u o; o.x = pk2(s[0 * 33], s[1 * 33]); o.y = pk2(s[2 * 33], s[3 * 33]); o.z = pk2(s[4 * 33], s[5 * 33]); o.w = pk2(s[6 * 33], s[7 * 33]);
        *(GAS v4u*)(WT + (size_t)(n0 + n) * K + k0 + 8 * c) = o; }
    LDS_WAIT(); asm volatile("" ::: "memory");
}

struct Args { const float* in[19]; float* out; unsigned char* ws; };

namespace attn_body {
using hb16=__hip_bfloat16;
using bf16x8=__attribute__((ext_vector_type(8)))short;
using s16x4=__attribute__((ext_vector_type(4)))short;
using f32x16=__attribute__((ext_vector_type(16)))float;
using u32x4=__attribute__((ext_vector_type(4)))unsigned;
constexpr int PITCH=3072;
constexpr int NW=8,QBLK=32,QB=QBLK*NW,KVBLK=64;
__device__ __forceinline__ int crow(int r,int hi){return (r&3)+8*(r>>2)+4*hi;}
#define SBAR() __builtin_amdgcn_sched_barrier(0)
__device__ __forceinline__ void cmask(f32x16&p0,f32x16&p1,int jb,int qrel,int hi){
  const float NEG=-INFINITY; int kb=64*jb+4*hi;
  #pragma unroll
  for(int r=0;r<16;++r){int kv=kb+(r&3)+8*(r>>2); if(kv>qrel)p0[r]=NEG; if(kv+32>qrel)p1[r]=NEG;}
}
constexpr int NSLOT=3, SLOTB=9216;
constexpr int LDS_K=0, LDS_V=NSLOT*SLOTB, LDS_WS=2*NSLOT*SLOTB, LDS_OST=LDS_WS+NW*64*4, LDS_BYTES=LDS_OST+NW*4096;
__device__ __forceinline__ void glds16(const void*gsrc,unsigned lds_dst){unsigned keep;
  asm volatile("s_mov_b32 %0, m0\n\ts_mov_b32 m0, %2\n\ts_nop 0\n\tglobal_load_lds_dwordx4 %1, off\n\ts_mov_b32 m0, %0":"=&s"(keep):"v"(gsrc),"s"(lds_dst):"memory");}
__device__ __forceinline__ void glds16x(const void*gsrc,unsigned lds_dst){unsigned keep;unsigned long long ex;
  asm volatile("s_mov_b32 %0, m0\n\ts_mov_b64 %1, exec\n\ts_mov_b64 exec, 0xff\n\ts_mov_b32 m0, %3\n\ts_nop 0\n\tglobal_load_lds_dwordx4 %2, off\n\ts_mov_b64 exec, %1\n\ts_mov_b32 m0, %0":"=&s"(keep),"=&s"(ex):"v"(gsrc),"s"(lds_dst):"memory");}
__device__ __forceinline__ float max3f(float a,float b,float c){float r;asm("v_max3_f32 %0, %1, %2, %3":"=v"(r):"v"(a),"v"(b),"v"(c));return r;}
__device__ __forceinline__ float max2f(float a,float b){float r;asm("v_max_f32_e32 %0, %1, %2":"=v"(r):"v"(a),"v"(b));return r;}
__device__ __forceinline__ float fsub_s(float a,float b){float r;asm("v_sub_f32_e32 %0, %1, %2":"=v"(r):"v"(a),"v"(b));return r;}
typedef float f32x2_t __attribute__((ext_vector_type(2))); typedef __bf16 bf16x2_t __attribute__((ext_vector_type(2)));
__device__ __forceinline__ unsigned cvtpk_s(float lo,float hi){f32x2_t v={lo,hi};bf16x2_t b=__builtin_convertvector(v,bf16x2_t);return __builtin_bit_cast(unsigned,b);}
__device__ __forceinline__ float rbf(float x){return __builtin_bit_cast(float,cvtpk_s(x,0.f)<<16);}
#define WAIT_BAR(N) asm volatile("s_waitcnt vmcnt(" #N ") lgkmcnt(0)\n\ts_barrier":::"memory")

__device__ __forceinline__ void qkt(f32x16&p0,f32x16&p1,const char*Kslot,const bf16x8*qr,int r32,int hi){
  const char*kb=Kslot+hi*1024+r32*16; const f32x16 zf={};
  #pragma unroll
  for(int d0=0;d0<4;++d0){
    const bf16x8 b0=*reinterpret_cast<const bf16x8*>(kb+d0*2048);
    const bf16x8 b1=*reinterpret_cast<const bf16x8*>(kb+d0*2048+512);
    if(d0==0){p0=__builtin_amdgcn_mfma_f32_32x32x16_bf16(b0,qr[0],zf,0,0,0);p1=__builtin_amdgcn_mfma_f32_32x32x16_bf16(b1,qr[0],zf,0,0,0);}
    else{p0=__builtin_amdgcn_mfma_f32_32x32x16_bf16(b0,qr[d0],p0,0,0,0);p1=__builtin_amdgcn_mfma_f32_32x32x16_bf16(b1,qr[d0],p1,0,0,0);}}
  const char*kx=Kslot+8192+r32*16;
  const bf16x8 x0=*reinterpret_cast<const bf16x8*>(kx), x1=*reinterpret_cast<const bf16x8*>(kx+512);
  p0=__builtin_amdgcn_mfma_f32_32x32x16_bf16(x0,qr[4],p0,0,0,0);p1=__builtin_amdgcn_mfma_f32_32x32x16_bf16(x1,qr[4],p1,0,0,0);
}
typedef __attribute__((address_space(3))) const char* lds_cptr;
typedef short v4i16_t __attribute__((ext_vector_type(4)));
__device__ __forceinline__ void kload10(bf16x8*kf,lds_cptr kp,lds_cptr kx){
  kf[0]=*(const __attribute__((address_space(3))) bf16x8*)(kp);      kf[1]=*(const __attribute__((address_space(3))) bf16x8*)(kp+512);
  kf[2]=*(const __attribute__((address_space(3))) bf16x8*)(kp+2048); kf[3]=*(const __attribute__((address_space(3))) bf16x8*)(kp+2560);
  kf[4]=*(const __attribute__((address_space(3))) bf16x8*)(kp+4096); kf[5]=*(const __attribute__((address_space(3))) bf16x8*)(kp+4608);
  kf[6]=*(const __attribute__((address_space(3))) bf16x8*)(kp+6144); kf[7]=*(const __attribute__((address_space(3))) bf16x8*)(kp+6656);
  kf[8]=*(const __attribute__((address_space(3))) bf16x8*)(kx);      kf[9]=*(const __attribute__((address_space(3))) bf16x8*)(kx+512);
}
__device__ __forceinline__ void kload2(bf16x8*kf,lds_cptr kp,int j){ kf[2*j]=*(const __attribute__((address_space(3))) bf16x8*)(kp+j*2048); kf[2*j+1]=*(const __attribute__((address_space(3))) bf16x8*)(kp+j*2048+512); }
__device__ __forceinline__ s16x4 vtr(lds_cptr p){ return __builtin_bit_cast(s16x4,__builtin_amdgcn_ds_read_tr16_b64_v4i16((__attribute__((address_space(3))) v4i16_t*)p)); }
__device__ __forceinline__ float rowmax(const f32x16&p0,const f32x16&p1){
  float a=max3f(p0[0],p0[1],p1[0]),b=max3f(p0[2],p0[3],p1[1]);a=max3f(a,p1[2],p1[3]);
  #pragma unroll
  for(int r=4;r<16;r+=4){a=max3f(a,p0[r],p0[r+1]);b=max3f(b,p0[r+2],p0[r+3]);a=max3f(a,p1[r],p1[r+1]);b=max3f(b,p1[r+2],p1[r+3]);}
  const float m=max2f(a,b);
  auto rr=__builtin_amdgcn_permlane32_swap(__float_as_uint(m),__float_as_uint(m),false,false);
  return max2f(__uint_as_float(rr[0]),__uint_as_float(rr[1]));
}
__device__ __forceinline__ void pv(f32x16*o,int vb,bf16x8 pa0,bf16x8 pa1,bf16x8 pa2,bf16x8 pa3){
  #pragma unroll
  for(int d0=0;d0<2;++d0){s16x4 lo[4],hi[4];
    #pragma unroll
    for(int ks=0;ks<4;++ks){
      asm volatile("ds_read_b64_tr_b16 %0,%1 offset:%c2":"=&v"(lo[ks]):"v"(vb),"i"(d0*4096+ks*1024):"memory");
      asm volatile("ds_read_b64_tr_b16 %0,%1 offset:%c2":"=&v"(hi[ks]):"v"(vb),"i"(d0*4096+ks*1024+512):"memory");}
    asm volatile("s_waitcnt lgkmcnt(0)":::"memory");SBAR();
    #define PK(k) (bf16x8){lo[k][0],lo[k][1],lo[k][2],lo[k][3],hi[k][0],hi[k][1],hi[k][2],hi[k][3]}
    o[d0]=__builtin_amdgcn_mfma_f32_32x32x16_bf16(pa0,PK(0),o[d0],0,0,0);
    o[d0]=__builtin_amdgcn_mfma_f32_32x32x16_bf16(pa1,PK(1),o[d0],0,0,0);
    o[d0]=__builtin_amdgcn_mfma_f32_32x32x16_bf16(pa2,PK(2),o[d0],0,0,0);
    o[d0]=__builtin_amdgcn_mfma_f32_32x32x16_bf16(pa3,PK(3),o[d0],0,0,0);
    #undef PK
  }
}

template<int THRL> __device__ __forceinline__ void attn_unit(char*shm,const int KIND,const hb16*Qc,int qrow,int oslot,const hb16*__restrict__ Kt0,const hb16*__restrict__ Vt0,const hb16*__restrict__ KXt0,int NT,int band0,hb16*Oc,hb16*PO,float*PML){
  const int tid=threadIdx.x,lane=tid&63,r32=lane&31,hi=lane>>5; const int wid=__builtin_amdgcn_readfirstlane(tid>>6);
  const unsigned lds0=(unsigned)(uintptr_t)shm;
  float*wsf=(float*)(shm+LDS_WS)+wid*64;
  const hb16*ksrc=Kt0+(long)lane*PITCH+wid*8;
  const hb16*vsrc=Vt0+(long)(16*(wid&3)+(lane>>2))*PITCH+(wid>>2)*32+(lane&3)*8;
  const hb16*xsrc=KXt0+(long)(8*wid+(lane&7))*8;
  const unsigned kdst=lds0+LDS_K+wid*1024, vdst=lds0+LDS_V+wid*1024, xdst=lds0+LDS_K+8192+wid*128;
  #define DMA_K(t,slot) do{ glds16(ksrc+(long)(t)*KVBLK*PITCH,(unsigned)__builtin_amdgcn_readfirstlane(kdst+(slot))); glds16x(xsrc+(long)(t)*KVBLK*8,(unsigned)__builtin_amdgcn_readfirstlane(xdst+(slot))); }while(0)
  #define DMA_V(t,slot) glds16(vsrc+(long)(t)*KVBLK*PITCH,(unsigned)__builtin_amdgcn_readfirstlane(vdst+(slot)))
  const int vb0=(int)(lds0+LDS_V)+((lane>>4)&1)*32+(lane&3)*8+(4*hi+((lane&15)>>2))*64;
  const char*Kbase=shm+LDS_K; bf16x8 kf[10];
  const lds_cptr shm3=(lds_cptr)shm; const lds_cptr kp0=shm3+LDS_K+hi*1024+r32*16; const lds_cptr kx0=shm3+LDS_K+8192+r32*16; const lds_cptr vp0=shm3+LDS_V+((lane>>4)&1)*32+(lane&3)*8+(4*hi+((lane&15)>>2))*64;
  DMA_K(0,0);DMA_V(0,0);DMA_K(1,SLOTB);
  bf16x8 qr[5];
  { const hb16*Qw=Qc+(long)qrow*PITCH;
    #pragma unroll
    for(int d0=0;d0<4;++d0)qr[d0]=*reinterpret_cast<const bf16x8*>(&Qw[d0*16+hi*8]); }
  float mhat=0.f,l_reg=0.f;f32x16 o[2];o[0]=f32x16{};o[1]=f32x16{};
  #define SETQX(mh_,ml_) do{ const unsigned bh_=cvtpk_s(-(mh_),-(ml_)); u32x4 qx_; qx_.x=0x3F803F80u; qx_.y=0x3F80u|(bh_<<16); qx_.z=(bh_>>16); qx_.w=0u; if(hi){qx_.x=0u;qx_.y=0u;qx_.z=0u;} qr[4]=__builtin_bit_cast(bf16x8,qx_); asm volatile("":"+v"(qr[4])); }while(0)
  #define MOVEREF(gain) const float mraw_=mhat+(gain); const float mh_=rbf(mraw_); const float ml_=rbf(mraw_-mh_); const float mnew_=mh_+ml_; const float dl=mnew_-mhat; mhat=mnew_; SETQX(mh_,ml_);
  SETQX(0.f,0.f);
  const int qrel=wid*QBLK+r32;
  #define CMASK(P0,P1,t) do{int jb_=(t)-band0; if(jb_>=0)cmask(P0,P1,jb_,qrel,hi);}while(0)
  bool resc=false;
  #define START(P0,P1) do{ const float rm=rowmax(P0,P1); resc=false; \
    { MOVEREF(rm) \
      _Pragma("unroll") for(int r=0;r<16;++r){P0[r]=fsub_s(P0[r],dl);P1[r]=fsub_s(P1[r],dl);} } \
    _Pragma("unroll") for(int r=0;r<16;++r)P0[r]=__builtin_amdgcn_exp2f(P0[r]); }while(0)
  #define RESC() do{ if(resc){ asm volatile("s_waitcnt lgkmcnt(0)":::"memory"); \
      _Pragma("unroll") for(int d_=0;d_<2;++d_) _Pragma("unroll") for(int r=0;r<16;++r)o[d_][r]*=wsf[crow(r,hi)]; } }while(0)
  f32x16 pA0,pA1,pB0,pB1;
  int sl_prev=0,sl_cur=0,sl_next=SLOTB;
  #define ROT() do{sl_prev=sl_cur;sl_cur=sl_next;sl_next=(sl_next==(NSLOT-1)*SLOTB)?0:sl_next+SLOTB;}while(0)
  DMA_K(2,2*SLOTB);
  WAIT_BAR(5);
  qkt(pA0,pA1,Kbase,qr,r32,hi);asm volatile("s_nop 15\n\ts_nop 7":"+v"(pA0),"+v"(pA1));CMASK(pA0,pA1,0);
  START(pA0,pA1);
  _Pragma("unroll") for(int r=0;r<16;++r)pA1[r]=__builtin_amdgcn_exp2f(pA1[r]);
  WAIT_BAR(0);
  DMA_K(3,0);DMA_V(1,SLOTB);
  ROT();
  kload10(kf,kp0+sl_cur,kx0+sl_cur);
  WAIT_BAR(3);
  s16x4 vlo[8],vhi[8]; u32x4 pw0,pw1,pw2,pw3; const f32x16 zf={};
  #define PKW(P,B) cvtpk_s(P[B],P[B+1])
  #define PAF(k) __builtin_bit_cast(bf16x8,pw##k)
  #define VFR(i) (bf16x8){vlo[i][0],vlo[i][1],vlo[i][2],vlo[i][3],vhi[i][0],vhi[i][1],vhi[i][2],vhi[i][3]}
  #define PIN(x) asm volatile("":"+v"(x))
  #define MX3(a,b,c) __builtin_fmaxf(__builtin_fmaxf((a),(b)),(c))
  #define GAPA(MF,A0,A1,A2,A3,W0,W1,PW) do{ MF; sacc+=A0; sacc+=A1; sacc+=A2; sacc+=A3; PIN(sacc); W0; W1; PIN(PW); SBAR(); }while(0)
  #define EX(v) __builtin_amdgcn_exp2f(v)
  #define GAPB(MF,X,B) do{ MF; X[B]=EX(X[B]); X[B+1]=EX(X[B+1]); X[B+2]=EX(X[B+2]); X[B+3]=EX(X[B+3]); PIN(X); SBAR(); }while(0)
  #define VRD(i) do{ vlo[i]=vtr(vp_+(((i)>>2)*4096+((i)&3)*1024)); vhi[i]=vtr(vp_+(((i)>>2)*4096+((i)&3)*1024+512)); }while(0)
  #define KRD(G,j) do{ if(G){ kload2(kf,kp0+sl_next,j); SBAR(); } }while(0)
  #define KRDX(G) do{ if(G){ kf[8]=*(const __attribute__((address_space(3))) bf16x8*)(kx0+sl_next); kf[9]=*(const __attribute__((address_space(3))) bf16x8*)(kx0+sl_next+512); SBAR(); } }while(0)
  #define STEP(C0,C1,P0,P1,t,GK,GV,GL) do{ SBAR(); \
    const lds_cptr vp_=vp0+sl_prev; \
    VRD(0); SBAR(); float sacc=(P0[0]+P0[1]); \
    GAPA(C0=__builtin_amdgcn_mfma_f32_32x32x16_bf16(kf[0],qr[0],zf,0,0,0), P0[2],P0[3],P0[4],P0[5],     pw0[0]=PKW(P0,0), pw0[1]=PKW(P0,2), pw0); \
    VRD(4); SBAR(); GAPA(C1=__builtin_amdgcn_mfma_f32_32x32x16_bf16(kf[1],qr[0],zf,0,0,0), P0[6],P0[7],P0[8],P0[9],     pw0[2]=PKW(P0,4), pw0[3]=PKW(P0,6), pw0); \
    VRD(1); SBAR(); GAPA(C0=__builtin_amdgcn_mfma_f32_32x32x16_bf16(kf[2],qr[1],C0,0,0,0),   P0[10],P0[11],P0[12],P0[13], pw1[0]=PKW(P0,8), pw1[1]=PKW(P0,10), pw1); \
    VRD(5); SBAR(); GAPA(C1=__builtin_amdgcn_mfma_f32_32x32x16_bf16(kf[3],qr[1],C1,0,0,0),   P0[14],P0[15],P1[0],P1[1],   pw1[2]=PKW(P0,12),pw1[3]=PKW(P0,14), pw1); \
    VRD(2); SBAR(); GAPA(C0=__builtin_amdgcn_mfma_f32_32x32x16_bf16(kf[4],qr[2],C0,0,0,0),   P1[2],P1[3],P1[4],P1[5],     pw2[0]=PKW(P1,0), pw2[1]=PKW(P1,2), pw2); \
    VRD(6); SBAR(); GAPA(C1=__builtin_amdgcn_mfma_f32_32x32x16_bf16(kf[5],qr[2],C1,0,0,0),   P1[6],P1[7],P1[8],P1[9],     pw2[2]=PKW(P1,4), pw2[3]=PKW(P1,6), pw2); \
    VRD(3); SBAR(); GAPA(C0=__builtin_amdgcn_mfma_f32_32x32x16_bf16(kf[6],qr[3],C0,0,0,0),   P1[10],P1[11],P1[12],P1[13], pw3[0]=PKW(P1,8), pw3[1]=PKW(P1,10), pw3); \
    VRD(7); SBAR(); GAPA(C1=__builtin_amdgcn_mfma_f32_32x32x16_bf16(kf[7],qr[3],C1,0,0,0),   P1[14],P1[15],0.f,0.f,       pw3[2]=PKW(P1,12),pw3[3]=PKW(P1,14), pw3); \
    C0=__builtin_amdgcn_mfma_f32_32x32x16_bf16(kf[8],qr[4],C0,0,0,0); SBAR(); \
    C1=__builtin_amdgcn_mfma_f32_32x32x16_bf16(kf[9],qr[4],C1,0,0,0); SBAR(); \
    l_reg+=sacc; \
    if(GK){DMA_K((t)+3,sl_cur);} if(GV){DMA_V((t)+1,sl_next);} \
    CMASK(C0,C1,t); \
    { float a=MX3(C0[0],C0[1],C1[0]),b=MX3(C0[2],C0[3],C1[1]); a=MX3(a,C1[2],C1[3]); \
      _Pragma("unroll") for(int r=4;r<16;r+=4){a=MX3(a,C0[r],C0[r+1]);b=MX3(b,C0[r+2],C0[r+3]);a=MX3(a,C1[r],C1[r+1]);b=MX3(b,C1[r+2],C1[r+3]);} \
      float rm=__builtin_fmaxf(a,b); { auto rr=__builtin_amdgcn_permlane32_swap(__float_as_uint(rm),__float_as_uint(rm),false,false); rm=__builtin_fmaxf(__uint_as_float(rr[0]),__uint_as_float(rr[1])); } \
      resc=false; \
      if(__builtin_expect(__any(rm>(float)THRL),0)){ MOVEREF(__builtin_fmaxf(rm,0.f)) \
        _Pragma("unroll") for(int r=0;r<16;++r){C0[r]-=dl;C1[r]-=dl;} \
        const float f=__builtin_amdgcn_exp2f(-dl); l_reg*=f; if(hi==0)wsf[r32]=f; resc=true; } } \
    SBAR(); \
    GAPB(o[0]=__builtin_amdgcn_mfma_f32_32x32x16_bf16(PAF(0),VFR(0),o[0],0,0,0), C0,0); \
    GAPB(o[1]=__builtin_amdgcn_mfma_f32_32x32x16_bf16(PAF(0),VFR(4),o[1],0,0,0), C0,4); \
    KRD(GL,0); GAPB(o[0]=__builtin_amdgcn_mfma_f32_32x32x16_bf16(PAF(1),VFR(1),o[0],0,0,0), C0,8); \
    KRD(GL,1); GAPB(o[1]=__builtin_amdgcn_mfma_f32_32x32x16_bf16(PAF(1),VFR(5),o[1],0,0,0), C0,12); \
    KRD(GL,2); GAPB(o[0]=__builtin_amdgcn_mfma_f32_32x32x16_bf16(PAF(2),VFR(2),o[0],0,0,0), C1,0); \
    KRD(GL,3); GAPB(o[1]=__builtin_amdgcn_mfma_f32_32x32x16_bf16(PAF(2),VFR(6),o[1],0,0,0), C1,4); \
    KRDX(GL); GAPB(o[0]=__builtin_amdgcn_mfma_f32_32x32x16_bf16(PAF(3),VFR(3),o[0],0,0,0), C1,8); \
    GAPB(o[1]=__builtin_amdgcn_mfma_f32_32x32x16_bf16(PAF(3),VFR(7),o[1],0,0,0), C1,12); \
    }while(0)
  int t=1;
  for(;t+5<NT&&t+1<band0;t+=2){
    #undef CMASK
    #define CMASK(P0,P1,t) do{}while(0)
    STEP(pB0,pB1,pA0,pA1,t,true,true,true);     WAIT_BAR(3); RESC(); ROT();
    STEP(pA0,pA1,pB0,pB1,t+1,true,true,true);   WAIT_BAR(3); RESC(); ROT();
  }
  #undef CMASK
  #define CMASK(P0,P1,t) do{int jb_=(t)-band0; if(jb_>=0)cmask(P0,P1,jb_,qrel,hi);}while(0)
  #define ENDW(tt) do{ if((tt)+3<NT){WAIT_BAR(3);} else if((tt)+2<NT){WAIT_BAR(1);} else {WAIT_BAR(0);} }while(0)
  for(;t+1<NT;t+=2){
    STEP(pB0,pB1,pA0,pA1,t,(t+3<NT),(t+1<NT),(t+1<NT));       ENDW(t);   RESC(); ROT();
    STEP(pA0,pA1,pB0,pB1,t+1,(t+4<NT),(t+2<NT),(t+2<NT));     ENDW(t+1); RESC(); ROT();
  }
  STEP(pB0,pB1,pA0,pA1,NT-1,false,false,false); RESC();
  { float sacc=pB0[0]+pB0[1]; _Pragma("unroll") for(int r=2;r<16;++r)sacc+=pB0[r]; _Pragma("unroll") for(int r=0;r<16;++r)sacc+=pB1[r]; l_reg+=sacc;
    pw0=(u32x4){PKW(pB0,0),PKW(pB0,2),PKW(pB0,4),PKW(pB0,6)};pw1=(u32x4){PKW(pB0,8),PKW(pB0,10),PKW(pB0,12),PKW(pB0,14)};pw2=(u32x4){PKW(pB1,0),PKW(pB1,2),PKW(pB1,4),PKW(pB1,6)};pw3=(u32x4){PKW(pB1,8),PKW(pB1,10),PKW(pB1,12),PKW(pB1,14)};
    SBAR(); pv(o,vb0+sl_cur,PAF(0),PAF(1),PAF(2),PAF(3)); }
  #undef PKW
  #undef PAF
  #undef VFR
  #undef PIN
  #undef MX3
  #undef GAPA
  #undef GAPB
  #undef EX
  #undef VRD
  #undef KRD
  #undef KRDX
  #undef STEP
  #undef ENDW
  {auto rr=__builtin_amdgcn_permlane32_swap(__float_as_uint(l_reg),__float_as_uint(l_reg),false,false);l_reg=__uint_as_float(rr[0])+__uint_as_float(rr[1]);}
  if(hi==0)wsf[32+r32]=l_reg;asm volatile("s_waitcnt lgkmcnt(0)":::"memory");
  float rli[16];
  #pragma unroll
  for(int r=0;r<16;++r)rli[r]=__builtin_amdgcn_rcpf(wsf[32+crow(r,hi)]);
  if(KIND==1){ if(hi==0&&oslot>=0){ f32x2_t ml={mhat,l_reg}; *(f32x2_t*)(PML+(long)oslot*2)=ml; } }
  { hb16*stg=(hb16*)(shm+LDS_OST)+wid*2048;
    #pragma unroll
    for(int r=0;r<16;++r){const int orow=crow(r,hi);
      #pragma unroll
      for(int d0=0;d0<2;++d0)stg[orow*64+d0*32+r32]=__float2bfloat16(o[d0][r]*rli[r]);}
    asm volatile("s_waitcnt lgkmcnt(0)":::"memory");
    #pragma unroll
    for(int i=0;i<4;++i){const int row=i*8+(lane>>3),ch=lane&7; const u32x4 v=*(const u32x4*)(stg+row*64+ch*8);
      if(KIND==0){ const int gr=__shfl(qrow,row); *(u32x4*)(Oc+(long)gr*PITCH+ch*8)=v; }
      else { const int gs=__shfl(oslot,row); if(gs>=0) *(u32x4*)(PO+(long)gs*64+ch*8)=v; } } }
  asm volatile("s_waitcnt lgkmcnt(0)\n\ts_barrier":::"memory");
  #undef DMA_K
  #undef DMA_V
  #undef CMASK
  #undef START
  #undef RESC
  #undef ROT
  #undef SETQX
  #undef MOVEREF
}
constexpr int ATTN_LDS_BYTES=LDS_BYTES;
#undef SBAR
#undef WAIT_BAR
}

struct WqkOrder {
    int G, c;
    __device__ __forceinline__ bool next(int i, pg8::Unit& u) const { const int L = i * G + c; if (L >= 128) return false; const int z = L >> 2, pn = L & 3, b = z >> 2, h = z & 3;
        u.pm = b * 4 + h; u.pn = pn; u.aoff = ((size_t)(b * 256) * 2048 + h * 256) * 2; u.boff = ((size_t)(pn * 256) * 1024 + h * 256) * 2; return true; }
};
struct VwoOrder {
    int G, c;
    __device__ __forceinline__ bool next(int i, pg8::Unit& u) const { const int L = i * G + c; if (L >= 128) return false; const int z = L >> 2, pmq = L & 3, b = z >> 2, h = z & 3;
        u.pm = b * 4 + pmq; u.pn = h; u.aoff = ((size_t)(pmq * 256) * 1024 + h * 256) * 2; u.boff = ((size_t)(b * 256) * 2048 + 1024 + h * 256) * 2; return true; }
};

#define DECL_PTRS const __attribute__((address_space(4))) Args* KA_; { auto p_ = __builtin_amdgcn_kernarg_segment_ptr(); asm volatile("" : "+s"(p_)); KA_ = (const __attribute__((address_space(4))) Args*)p_; } \
    int tidp_ = threadIdx.x; asm volatile("" : "+v"(tidp_)); const int tid = tidp_, lane = tid & 63; (void)lane; \
    unsigned char* ws = KA_->ws; gu32* ctl = (gu32*)(ws + WS_CTL); const float* x = KA_->in[0]; const float* mem = KA_->in[1]; const float* g_mix = KA_->in[2]; const float* w_in = KA_->in[3]; const float* b_forget = KA_->in[4]; const float* g_fox = KA_->in[5]; const float* g_moba = KA_->in[6]; const float* w_out = KA_->in[7]; const float* g_cross = KA_->in[8]; const float* g_mem = KA_->in[9]; const float* w_q_mem = KA_->in[10]; const float* w_kv_mem = KA_->in[11]; const float* w_o_mem = KA_->in[12]; const float* g_ffn = KA_->in[13]; const float* w_up = KA_->in[14]; const float* conv_w = KA_->in[15]; const float* conv_b = KA_->in[16]; const float* w_down = KA_->in[17]; const float* g_final = KA_->in[18]; float* out = KA_->out; float* LOGF = (float*)(ws + WS_LOGF); float* CC = (float*)(ws + WS_C); float* ABAR = (float*)(ws + WS_ABAR); float* KM = (float*)(ws + WS_KM); unsigned* SEL = (unsigned*)(ws + WS_SEL); float* SSQ1 = (float*)(ws + WS_SSQ1); float* SSQ2 = (float*)(ws + WS_SSQ2); float* SSQ3 = (float*)(ws + WS_SSQ3); bf16* MEMN = (bf16*)(ws + WS_MEMN); bf16* KV = (bf16*)(ws + WS_KV); bf16* WQS = (bf16*)(ws + WS_WQS); bf16* WOT = (bf16*)(ws + WS_WOT); bf16* WKVT = (bf16*)(ws + WS_WKVT); bf16* WINT = (bf16*)(ws + WS_WINT); bf16* WOUTT = (bf16*)(ws + WS_WOUTT); bf16* WUPT = (bf16*)(ws + WS_WUPT); bf16* WDT = (bf16*)(ws + WS_WDT); bf16* ZT = (bf16*)(ws + WS_ZT); bf16* WQK = (bf16*)(ws + WS_WQK); bf16* VWO = (bf16*)(ws + WS_VWO); bf16* A1 = (bf16*)(ws + WS_A1); bf16* QKV = (bf16*)(ws + WS_QKV); bf16* Y = (bf16*)(ws + WS_Y); bf16* HB1 = (bf16*)(ws + WS_HB1); bf16* PB = (bf16*)(ws + WS_P); bf16* HB2 = (bf16*)(ws + WS_HB2); bf16* GB = (bf16*)(ws + WS_G); bf16* UB = (bf16*)(ws + WS_U); bf16* PO = (bf16*)(ws + WS_PO); unsigned* LIST = (unsigned*)(ws + WS_LIST); float* PML = (float*)(ws + WS_PML); bf16* KXF = (bf16*)(ws + WS_KXF); bf16* KXM = (bf16*)(ws + WS_KXM); unsigned* CNT = (unsigned*)(ws + WS_CNT);
__global__ void __launch_bounds__(NWAVES * 64, 2) fwd(Args args) {
    extern __shared__ __attribute__((aligned(16))) unsigned char lds[];
    LAS unsigned char* L = (LAS unsigned char*)lds;
    LAS unsigned char* XL = L + XL_OFF;
    volatile LAS unsigned* MISC = (volatile LAS unsigned*)(L + MISC_OFF);
    const int tid = threadIdx.x, lane = tid & 63, wave = __builtin_amdgcn_readfirstlane(tid >> 6);
    const int G = gridDim.x, bx = blockIdx.x;
    const int gw = bx * NWAVES + wave, NGW = G * NWAVES;
    for (int u = tid; u < (LDS_BYTES - LDSCTL_OFF) / 4; u += NWAVES * 64) ((LAS unsigned*)(L + LDSCTL_OFF))[u] = 0u;
    __syncthreads();
    XcdBarrier bar; { DECL_PTRS; bar = xcd_barrier_post((unsigned*)(ctl + CW_BAR), MISC + 8); }

    { DECL_PTRS;
        LAS float* scr = (LAS float*)(L + RING_OFF + wave * 16384);
        constexpr int I_IN = (D / 64) * (NQKV / 32), I_OUT = (D / 64) * (D / 32), I_KV = (D / 64) * (2048 / 32), I_O = I_OUT, I_UP = (D / 64) * (2 * FF / 32), I_DN = (FF / 64) * (D / 32);
        constexpr int NITEMS = I_IN + I_OUT + I_KV + I_O + I_UP + I_DN;
        for (int it = gw; it < NITEMS; it += NGW) {
            int r = it;
            if (r < I_IN) { p0_transpose_item(w_in, INC, D, NQKV, WINT, nullptr, true, scr, r, lane); continue; } r -= I_IN;
            if (r < I_OUT) { p0_transpose_item(w_out, D, D, D, WOUTT, nullptr, false, scr, r, lane); continue; } r -= I_OUT;
            if (r < I_KV) { p0_transpose_item(w_kv_mem, 2048, D, 2048, WKVT, nullptr, false, scr, r, lane); continue; } r -= I_KV;
            if (r < I_O) { p0_transpose_item(w_o_mem, D, D, D, WOT, nullptr, false, scr, r, lane); continue; } r -= I_O;
            if (r < I_UP) { p0_transpose_item(w_up, 2 * FF, D, 2 * FF, WUPT, g_ffn, false, scr, r, lane); continue; } r -= I_UP;
            p0_transpose_item(w_down, D, FF, D, WDT, nullptr, false, scr, r, lane);
        }
        for (int i = bx * 512 + tid; i < D * D / 4; i += G * 512) { const int kk = (i * 4) >> 10; const f32x4 v = *(const f32x4*)(w_q_mem + (size_t)i * 4) * (g_cross[kk] * (LOG2E / 16.0f));
            *(unsigned long long*)(WQS + (size_t)i * 4) = (unsigned long long)pk2(v[0], v[1]) | ((unsigned long long)pk2(v[2], v[3]) << 32); }
        for (int r = gw; r < NB * 256; r += NGW) { const GAS f32x4* xr = (const GAS f32x4*)(mem + (size_t)r * D) + lane; f32x4 v[4]; float s = 0.f;
#pragma unroll
            for (int j = 0; j < 4; ++j) { v[j] = xr[64 * j]; s += (v[j][0] * v[j][0] + v[j][1] * v[j][1]) + (v[j][2] * v[j][2] + v[j][3] * v[j][3]); }
            const float rs = __builtin_amdgcn_rsqf(wave_sum(s) * (1.f / D) + RMS_EPS);
            GAS unsigned long long* o8 = (GAS unsigned long long*)(MEMN + (size_t)r * D) + lane;
#pragma unroll
            for (int j = 0; j < 4; ++j) { const f32x4 gg = *((const f32x4*)g_mem + 64 * j + lane); const f32x4 a = v[j] * rs * gg; o8[64 * j] = (unsigned long long)pk2(a[0], a[1]) | ((unsigned long long)pk2(a[2], a[3]) << 32); } }
        __syncthreads();
        LAS float* wf = (LAS float*)(L + RING_OFF);
        LAS float* part = (LAS float*)(L + RING_OFF + 32768);
        for (int i = tid; i < 8 * 1024; i += 512) { const int h = i >> 10, kk = i & 1023; wf[i] = w_in[(size_t)kk * INC + C_F + h]; }
        __syncthreads();
        f32x4 gm[4];
#pragma unroll
        for (int j = 0; j < 4; ++j) gm[j] = *((const f32x4*)g_mix + 64 * j + lane);
        for (int blk = bx; blk < M / 256; blk += G) {
            f32x4 accm[4];
#pragma unroll
            for (int j = 0; j < 4; ++j) accm[j] = (f32x4){0.f, 0.f, 0.f, 0.f};
            for (int i = 0; i < 32; ++i) {
                const size_t r = (size_t)blk * 256 + wave * 32 + i;
                const GAS f32x4* xr = (const GAS f32x4*)(x + r * D) + lane; f32x4 v[4]; float s = 0.f;
#pragma unroll
                for (int j = 0; j < 4; ++j) { v[j] = xr[64 * j]; s += (v[j][0] * v[j][0] + v[j][1] * v[j][1]) + (v[j][2] * v[j][2] + v[j][3] * v[j][3]); }
                const float rs = __builtin_amdgcn_rsqf(wave_sum(s) * (1.f / D) + RMS_EPS);
                GAS unsigned long long* o8 = (GAS unsigned long long*)(A1 + r * 2048) + lane;
                float fl[8];
#pragma unroll
                for (int h = 0; h < 8; ++h) fl[h] = 0.f;
#pragma unroll
                for (int j = 0; j < 4; ++j) { const f32x4 a = v[j] * rs * gm[j]; accm[j] += a;
                    const unsigned h0 = pk2(a[0], a[1]), h1 = pk2(a[2], a[3]);
                    o8[64 * j] = (unsigned long long)h0 | ((unsigned long long)h1 << 32);
                    const unsigned l0 = pk2(a[0] - bflo(h0), a[1] - bfhi(h0)), l1 = pk2(a[2] - bflo(h1), a[3] - bfhi(h1));
                    o8[256 + 64 * j] = (unsigned long long)l0 | ((unsigned long long)l1 << 32);
#pragma unroll
                    for (int h = 0; h < 8; ++h) { const f32x4 w = *((const LAS f32x4*)(wf + h * 1024) + 64 * j + lane); fl[h] += (a[0] * w[0] + a[1] * w[1]) + (a[2] * w[2] + a[3] * w[3]); } }
#pragma unroll
                for (int h = 0; h < 8; ++h) fl[h] = wave_sum(fl[h]);
                if (lane < 8) { float z = fl[0];
#pragma unroll
                    for (int h = 1; h < 8; ++h) z = (lane == h) ? fl[h] : z;
                    z += b_forget[lane];
                    LOGF[r * 8 + lane] = fminf(z, 0.f) - log1pf(__expf(-fabsf(z))); }
            }
#pragma unroll
            for (int j = 0; j < 4; ++j) *((LAS f32x4*)(part + wave * 1024) + 64 * j + lane) = accm[j];
            __syncthreads();
            for (int col = tid; col < 1024; col += 512) { float s = 0.f;
#pragma unroll
                for (int w = 0; w < 8; ++w) s += part[w * 1024 + col];
                ABAR[(size_t)blk * 1024 + col] = s * (1.0f / 256.0f); }
            __syncthreads();
        }
    }
    xcd_barrier(bar);

    { DECL_PTRS;
        LAS float* sc = (LAS float*)(L + RING_OFF);
        for (int w = bx; w < 64; w += G) {
            const int b = w >> 3, h = w & 7; float v[16]; float run = 0.f;
#pragma unroll
            for (int i = 0; i < 16; ++i) { run += LOGF[((size_t)b * T + tid * 16 + i) * 8 + h]; v[i] = run; }
            float incl = run;
#pragma unroll
            for (int o = 1; o < 64; o <<= 1) { const float n = __shfl_up(incl, o); if (lane >= o) incl += n; }
            if (lane == 63) sc[wave] = incl;
            __syncthreads();
            float pre = incl - run;
            for (int ww = 0; ww < wave; ++ww) pre += sc[ww];
#pragma unroll
            for (int i = 0; i < 16; ++i) CC[(size_t)w * T + tid * 16 + i] = pre + v[i];
            __syncthreads();
        }
        for (int n = bx; n < 256; n += G) {
            for (int i = tid; i < 1024; i += 512) sc[i] = ABAR[(size_t)n * 1024 + i];
            __syncthreads();
            float s = 0.f;
            for (int kk = 0; kk < 1024; ++kk) s += sc[kk] * w_in[(size_t)kk * INC + C_KM + tid];
            KM[(size_t)n * 512 + tid] = s;
            __syncthreads();
        }
        pg8::Gemm g{MEMN, WKVT, D, D, D, 0xffffffffu}; pg8::TileOrder S; S.init(NB * 256, 2048, G, bx, D, D, 0, 1 << 30);
        pg8::EpiBf16 E{KV, 2048, 0u, 1.f};
        pg8::gemm_phase<pg8::EpiBf16, pg8::TileOrder, true>(L + RING_OFF, XL, g, S, E);
    }
    xcd_barrier(bar);

    { DECL_PTRS;
        LAS float* sc = (LAS float*)(L + RING_OFF);
        for (int n = bx; n < 256; n += G) {
            const int b = n >> 5, nb = n & 31;
            sc[tid] = KM[(size_t)n * 512 + tid];
            __syncthreads();
            f32x4 k0 = *(const LAS f32x4*)(sc + lane * 8), k1 = *(const LAS f32x4*)(sc + lane * 8 + 4);
            for (int i = 0; i < 128; ++i) { const int kk = wave * 128 + i;
                const f32x4 w0 = *(const f32x4*)(w_in + (size_t)kk * INC + C_QM + lane * 8), w1 = *(const f32x4*)(w_in + (size_t)kk * INC + C_QM + lane * 8 + 4);
                float s = (w0[0] * k0[0] + w0[1] * k0[1]) + (w0[2] * k0[2] + w0[3] * k0[3]) + (w1[0] * k1[0] + w1[1] * k1[1]) + (w1[2] * k1[2] + w1[3] * k1[3]);
                s += __shfl_xor(s, 1); s += __shfl_xor(s, 2); s += __shfl_xor(s, 4);
                if ((lane & 7) == 0) { const int h = lane >> 3; const unsigned hi = f2bf(s); const unsigned lo = f2bf(s - bf2f(hi));
                    bf16* zr = ZT + ((size_t)b * 256 + h * 32 + nb) * 3072; zr[kk] = (bf16)hi; zr[1024 + kk] = (bf16)hi; zr[2048 + kk] = (bf16)lo; } }
            __syncthreads();
        }
        for (int i = bx * 512 + tid; i < 64 * T + 8 * 256; i += G * 512) {
            float bv; bf16* dst;
            if (i < 64 * T) { bv = -CC[i] * LOG2E; dst = KXF + (size_t)i * 8; }
            else { const int j = i - 64 * T; bv = __builtin_amdgcn_exp2f(-(float)((j >> 8) + 1)) * LOG2E * (float)(j & 255); dst = KXM + (size_t)j * 8; }
            const unsigned h0 = f2bf(bv); const float r1 = bv - bf2f(h0); const unsigned h1 = f2bf(r1); const unsigned h2 = f2bf(r1 - bf2f(h1));
            *(v4u*)dst = (v4u){h0 | (h1 << 16), h2 | (0x3F80u << 16), 0x3F80u, 0u}; }
        { pg8::Gemm g{KV, WQS, 256, 2048, 1024, 0xffffffffu}; WqkOrder S{G, bx}; pg8::EpiBf16 E{WQK, 1024, 0u, 1.f};
          pg8::gemm_phase<pg8::EpiBf16, WqkOrder, true>(L + RING_OFF, XL, g, S, E); }
        { pg8::Gemm g{WOT, KV, 256, 1024, 2048, 0xffffffffu}; VwoOrder S{G, (bx + 128) % G}; pg8::EpiBf16 E{VWO, 1024, 0u, 1.f};
          pg8::gemm_phase<pg8::EpiBf16, VwoOrder, true>(L + RING_OFF, XL, g, S, E); }
    }
    xcd_barrier(bar);

    { DECL_PTRS;
        { pg8::Gemm g{A1, WINT, D, 2048, D, 0xffffffffu}; pg8::TileOrder S; S.init(M, NQKV, G, bx, 2048, D, 0, 1 << 30);
          pg8::EpiBf16 E{QKV, NQKV, 0xC3u, C2};
          pg8::gemm_phase<pg8::EpiBf16, pg8::TileOrder, true>(L + RING_OFF, XL, g, S, E); }
        { pg8::Gemm g{A1, ZT, 3072, 2048, 3072, 2047u}; pg8::TileOrder S; S.init(M, 256, G, bx, 2048, 3072, (size_t)256 * 3072, 32);
          pg8::EpiGate E{SEL};
          pg8::gemm_phase<pg8::EpiGate, pg8::TileOrder, true>(L + RING_OFF, XL, g, S, E); }
    }
    xcd_barrier(bar);

    { DECL_PTRS;
        LAS unsigned* wc = (LAS unsigned*)(L + RING_OFF);
        for (int w = bx; w < 2048; w += G) {
            const int bh = w >> 5, n = w & 31; const unsigned* selrow = SEL + (size_t)bh * T; unsigned base = 0u;
            for (int t0 = (n + 1) * 256; t0 < T; t0 += 512) {
                const int t = t0 + tid; unsigned m = 0u; if (t < T) m = selrow[t];
                const bool hit = (m >> n) & 1u;
                const unsigned long long bal = __ballot(hit);
                if (lane == 0) wc[wave] = (unsigned)__popcll(bal);
                __syncthreads();
                unsigned pre = 0u, tot = 0u;
#pragma unroll
                for (int ww = 0; ww < 8; ++ww) { const unsigned c = wc[ww]; tot += c; if (ww < wave) pre += c; }
                if (hit) { const unsigned pos = base + pre + (unsigned)__popcll(bal & ((1ull << lane) - 1ull)); const unsigned k = (unsigned)__popc(m & ((1u << n) - 1u));
                    LIST[(size_t)w * 8192 + pos] = (unsigned)t | (k << 16); }
                base += tot;
                __syncthreads();
            }
            if (tid == 0) CNT[w] = base;
        }
    }
    xcd_barrier(bar);

    { DECL_PTRS;
        LAS int* upre = (LAS int*)(L + RING_OFF + attn_body::ATTN_LDS_BYTES);
        LAS int* wsum = upre + 2052;
        { int c4[4]; int run = 0;
#pragma unroll
          for (int i = 0; i < 4; ++i) { c4[i] = run; run += (int)((CNT[tid * 4 + i] + 255u) >> 8); }
          int incl = run;
#pragma unroll
          for (int o = 1; o < 64; o <<= 1) { const int nn = __shfl_up(incl, o); if (lane >= o) incl += nn; }
          if (lane == 63) wsum[wave] = incl;
          __syncthreads();
          int pre = incl - run;
          for (int ww = 0; ww < wave; ++ww) pre += wsum[ww];
#pragma unroll
          for (int i = 0; i < 4; ++i) upre[tid * 4 + i] = pre + c4[i];
          if (tid == 511) upre[2048] = pre + run;
          __syncthreads(); }
        const int ntot = 4096 + upre[2048];
        const attn_body::hb16* Qb = (const attn_body::hb16*)QKV;
        const int r32 = lane & 31;
        for (int u = bx; u < ntot; u += G) {
            int kind, qrow, oslot = -1, NT, band0; const attn_body::hb16 *Qc, *Kt0, *Vt0, *KXt0;
            if (u < 2048) {
                const int i = u >> 8, v = u & 255, bh = (i >> 2) * 32 + (v >> 3), s = v & 7, ii = i & 3, qb = ii == 0 ? s : ii == 1 ? 15 - s : ii == 2 ? 16 + s : 31 - s;
                const int b = bh >> 3, h = bh & 7;
                kind = 0; qrow = b * T + qb * 256 + wave * 32 + r32; NT = 4 * (qb + 1); band0 = NT - 4;
                Qc = Qb + h * 64; Kt0 = Qb + (size_t)(b * T) * NQKV + 512 + h * 64; Vt0 = Kt0 + 512; KXt0 = (const attn_body::hb16*)KXF + (size_t)bh * T * 8;
            } else if (u < 4096) {
                const int w = u - 2048, bh = w >> 5, j = w & 31, b = bh >> 3, h = bh & 7;
                kind = 1; qrow = b * T + j * 256 + wave * 32 + r32; oslot = (qrow * 8 + h) * 4 + 3; NT = 4; band0 = 0;
                Qc = Qb + 1536 + h * 64; Kt0 = Qb + (size_t)(b * T + j * 256) * NQKV + 2048 + h * 64; Vt0 = Kt0 + 512; KXt0 = (const attn_body::hb16*)KXM + h * 256 * 8;
            } else {
                const int g = u - 4096; int lo = 0, hi2 = 2048;
                while (hi2 - lo > 1) { const int mid = (lo + hi2) >> 1; if (upre[mid] <= g) lo = mid; else hi2 = mid; }
                const int w = lo, c = g - upre[lo], bh = w >> 5, n = w & 31, b = bh >> 3, h = bh & 7; const int cnt = (int)CNT[w];
                int idx = c * 256 + wave * 32 + r32; const bool valid = idx < cnt; if (!valid) idx = cnt - 1;
                const unsigned e = LIST[(size_t)w * 8192 + idx];
                kind = 1; qrow = b * T + (int)(e & 0xffffu); oslot = valid ? (qrow * 8 + h) * 4 + (int)(e >> 16) : -1; NT = 4; band0 = 1 << 20;
                Qc = Qb + 1536 + h * 64; Kt0 = Qb + (size_t)(b * T + n * 256) * NQKV + 2048 + h * 64; Vt0 = Kt0 + 512; KXt0 = (const attn_body::hb16*)KXM + h * 256 * 8;
            }
            attn_body::attn_unit<8>((char*)lds + RING_OFF, kind, Qc, qrow, oslot, Kt0, Vt0, KXt0, NT, band0, (attn_body::hb16*)QKV + (Qc - Qb), (attn_body::hb16*)PO, PML);
        }
    }
    xcd_barrier(bar);

    { DECL_PTRS;
    for (int r = gw; r < M; r += NGW) {
        const v4u wa = *((const v4u*)(QKV + (size_t)r * NQKV) + lane);
        float a[8] = {bflo(wa.x), bfhi(wa.x), bflo(wa.y), bfhi(wa.y), bflo(wa.z), bfhi(wa.z), bflo(wa.w), bfhi(wa.w)};
        float c[8];
        { const int h = lane >> 3, cc = lane & 7, b = r >> 13, t = r & (T - 1), own = t >> 8;
          unsigned mm = SEL[((size_t)(b * 8 + h)) * T + t]; const int cnt = __popc(mm);
          const float s2 = __builtin_amdgcn_exp2f(-(float)(h + 1)) * LOG2E * 256.0f;
          const size_t sb = ((size_t)r * 8 + h) * 4;
          float mk[4], lk[4];
          mk[3] = PML[(sb + 3) * 2] + s2 * (float)own; lk[3] = PML[(sb + 3) * 2 + 1]; float Mx = mk[3];
#pragma unroll
          for (int k = 0; k < 3; ++k) { mk[k] = -3.0e38f; lk[k] = 0.f; if (k < cnt) { const int nb = __ffs(mm) - 1; mm &= mm - 1u; mk[k] = PML[(sb + k) * 2] + s2 * (float)nb; lk[k] = PML[(sb + k) * 2 + 1]; Mx = fmaxf(Mx, mk[k]); } }
          float W = 0.f;
#pragma unroll
          for (int i = 0; i < 8; ++i) c[i] = 0.f;
#pragma unroll
          for (int k = 0; k < 4; ++k) { if (k == 3 || k < cnt) { const float w = lk[k] * __builtin_amdgcn_exp2f(mk[k] - Mx); W += w; const v4u pw = *((const v4u*)(PO + (sb + k) * 64) + cc);
              c[0] += w * bflo(pw.x); c[1] += w * bfhi(pw.x); c[2] += w * bflo(pw.y); c[3] += w * bfhi(pw.y); c[4] += w * bflo(pw.z); c[5] += w * bfhi(pw.z); c[6] += w * bflo(pw.w); c[7] += w * bfhi(pw.w); } }
          const float iw = 1.0f / W;
#pragma unroll
          for (int i = 0; i < 8; ++i) c[i] *= iw; }
        float sa = 0.f, sb2 = 0.f;
#pragma unroll
        for (int i = 0; i < 8; ++i) { sa += a[i] * a[i]; sb2 += c[i] * c[i]; }
        const float ra = __builtin_amdgcn_rsqf(wave_sum(sa) * (1.f / 512.f) + RMS_EPS), rb = __builtin_amdgcn_rsqf(wave_sum(sb2) * (1.f / 512.f) + RMS_EPS);
        const f32x4 ga0 = *((const f32x4*)g_fox + 2 * lane), ga1 = *((const f32x4*)g_fox + 2 * lane + 1), gb0 = *((const f32x4*)g_moba + 2 * lane), gb1 = *((const f32x4*)g_moba + 2 * lane + 1);
        v4u oa, ob;
        oa.x = pk2(a[0] * ra * ga0[0], a[1] * ra * ga0[1]); oa.y = pk2(a[2] * ra * ga0[2], a[3] * ra * ga0[3]); oa.z = pk2(a[4] * ra * ga1[0], a[5] * ra * ga1[1]); oa.w = pk2(a[6] * ra * ga1[2], a[7] * ra * ga1[3]);
        ob.x = pk2(c[0] * rb * gb0[0], c[1] * rb * gb0[1]); ob.y = pk2(c[2] * rb * gb0[2], c[3] * rb * gb0[3]); ob.z = pk2(c[4] * rb * gb1[0], c[5] * rb * gb1[1]); ob.w = pk2(c[6] * rb * gb1[2], c[7] * rb * gb1[3]);
        *((v4u*)(Y + (size_t)r * D) + lane) = oa; *((v4u*)(Y + (size_t)r * D + 512) + lane) = ob;
    } }
    xcd_barrier(bar);

    { DECL_PTRS; pg8::Gemm g{Y, WOUTT, D, D, D, 0xffffffffu}; pg8::TileOrder S; S.init(M, D, G, bx, D, D, 0, 1 << 30);
      pg8::EpiRes E{x, out, HB1, SSQ1};
      pg8::gemm_phase<pg8::EpiRes, pg8::TileOrder, true>(L + RING_OFF, XL, g, S, E); }
    xcd_barrier(bar);

    { DECL_PTRS; pg8::Gemm g{HB1, WQK, D, D, D, 0xffffffffu}; pg8::TileOrder S; S.init(M, D, G, bx, D, D, (size_t)D * D, 32);
      pg8::EpiSoftmax E{PB, SSQ1};
      pg8::gemm_phase<pg8::EpiSoftmax, pg8::TileOrder, true>(L + RING_OFF, XL, g, S, E); }
    xcd_barrier(bar);

    { DECL_PTRS; pg8::Gemm g{PB, VWO, D, D, D, 0xffffffffu}; pg8::TileOrder S; S.init(M, D, G, bx, D, D, (size_t)D * D, 32);
      pg8::EpiRes E{out, out, HB2, SSQ2};
      pg8::gemm_phase<pg8::EpiRes, pg8::TileOrder, true>(L + RING_OFF, XL, g, S, E); }
    xcd_barrier(bar);

    { DECL_PTRS; pg8::Gemm g{HB2, WUPT, D, D, D, 0xffffffffu}; pg8::TileOrder S; S.init(M, 2 * FF, G, bx, D, D, 0, 1 << 30);
      pg8::EpiUp E{GB, UB, SSQ2};
      pg8::gemm_phase<pg8::EpiUp, pg8::TileOrder, true>(L + RING_OFF, XL, g, S, E); }
    xcd_barrier(bar);

    { DECL_PTRS;
    for (size_t i = (size_t)bx * 512 + tid; i < (size_t)M * (FF / 8); i += (size_t)G * 512) {
        const size_t r = i / (FF / 8); const int cg = (int)(i % (FF / 8)) * 8; const int tt = (int)(r & (T - 1));
        const v4u g2 = *(const v4u*)(GB + r * FF + cg), uu = *(const v4u*)(UB + r * FF + cg);
        v4u g1 = (v4u){0u, 0u, 0u, 0u}, g0 = (v4u){0u, 0u, 0u, 0u};
        if (tt >= 1) g1 = *(const v4u*)(GB + (r - 1) * FF + cg);
        if (tt >= 2) g0 = *(const v4u*)(GB + (r - 2) * FF + cg);
        const unsigned G2[4] = {g2.x, g2.y, g2.z, g2.w}, G1[4] = {g1.x, g1.y, g1.z, g1.w}, G0[4] = {g0.x, g0.y, g0.z, g0.w}, UU[4] = {uu.x, uu.y, uu.z, uu.w};
        unsigned o[4];
#pragma unroll
        for (int k = 0; k < 4; ++k) { float res[2];
#pragma unroll
            for (int e = 0; e < 2; ++e) { const int col = cg + 2 * k + e;
                const float a2 = e ? bfhi(G2[k]) : bflo(G2[k]), a1 = e ? bfhi(G1[k]) : bflo(G1[k]), a0 = e ? bfhi(G0[k]) : bflo(G0[k]), uv = e ? bfhi(UU[k]) : bflo(UU[k]);
                const float gc = conv_b[col] + conv_w[col] * a0 + conv_w[FF + col] * a1 + conv_w[2 * FF + col] * a2;
                res[e] = gc * __builtin_amdgcn_rcpf(1.0f + __expf(-gc)) * uv; }
            o[k] = pk2(res[0], res[1]); }
        *(v4u*)(UB + r * FF + cg) = (v4u){o[0], o[1], o[2], o[3]};
    } }
    xcd_barrier(bar);

    { DECL_PTRS; pg8::Gemm g{UB, WDT, FF, FF, FF, 0xffffffffu}; pg8::TileOrder S; S.init(M, D, G, bx, FF, FF, 0, 1 << 30);
      pg8::EpiRes E{out, out, nullptr, SSQ3};
      pg8::gemm_phase<pg8::EpiRes, pg8::TileOrder, true>(L + RING_OFF, XL, g, S, E); }
    xcd_barrier(bar);

    { DECL_PTRS;
    for (int r = gw; r < M; r += NGW) {
        const float rs = pg8::rstd_from_slots(SSQ3 + (size_t)r * 16);
        GAS f32x4* o = (GAS f32x4*)(out + (size_t)r * D) + lane;
#pragma unroll
        for (int j = 0; j < 4; ++j) { const f32x4 gg = *((const f32x4*)g_final + 64 * j + lane); o[64 * j] = o[64 * j] * rs * gg; }
    } }
}

extern "C" void kernel_launch(void* const* d_in, const int* in_sizes, int n_in, void* d_out, int out_size, void* d_ws, size_t ws_size, hipStream_t stream) {
    static int grid = 0;
    if (grid == 0) {
        if (n_in != 19 || in_sizes[0] != M * D || out_size != M * D || ws_size < WS_END) { fprintf(stderr, "kernel_launch: unexpected problem shape (n_in %d, in0 %d, out %d, ws %zu); nothing launched\n", n_in, n_in > 0 ? in_sizes[0] : -1, out_size, ws_size); grid = -1; return; }
        int dev = 0, cus = 0, per_cu = 0;
        if (hipGetDevice(&dev) != hipSuccess || hipDeviceGetAttribute(&cus, hipDeviceAttributeMultiprocessorCount, dev) != hipSuccess) { grid = -1; return; }
        if (hipFuncSetAttribute((const void*)fwd, hipFuncAttributeMaxDynamicSharedMemorySize, LDS_BYTES) != hipSuccess) { fprintf(stderr, "kernel_launch: hipFuncSetAttribute failed\n"); grid = -1; return; }
        if (hipOccupancyMaxActiveBlocksPerMultiprocessor(&per_cu, (const void*)fwd, NWAVES * 64, LDS_BYTES) != hipSuccess || per_cu < 1) { fprintf(stderr, "kernel_launch: occupancy query reports %d\n", per_cu); }
        (void)hipGetLastError();
        grid = cus;
    }
    if (grid < 0) return;
    if (hipMemsetAsync((char*)d_ws + WS_CTL, 0, CTL_ZERO_BYTES, stream) != hipSuccess) return;
    Args a{};
    for (int i = 0; i < 19; ++i) a.in[i] = (const float*)d_in[i];
    a.out = (float*)d_out; a.ws = (unsigned char*)d_ws;
    hipLaunchKernelGGL(fwd, dim3(grid), dim3(NWAVES * 64), LDS_BYTES, stream, a);
}
```

```cpp
#include <hip/hip_runtime.h>
#include <hip/hip_bf16.h>
#include <cstdio>
#include <cstdint>

namespace pg8 {
#define PG8_LAS __attribute__((address_space(3)))
typedef unsigned short bf16_t;
typedef short bf16x8 __attribute__((ext_vector_type(8)));
typedef float f32x4 __attribute__((ext_vector_type(4)));
typedef float f32x2 __attribute__((ext_vector_type(2)));
typedef unsigned u32x4 __attribute__((ext_vector_type(4)));
typedef unsigned u32x2 __attribute__((ext_vector_type(2)));
constexpr int BM = 256, BK = 64, HALF = 128, HTB = HALF * BK * 2  , STAGE_BYTES = 8 * HTB, NXCD = 8, WGM = 8;

__host__ __device__ __forceinline__ int lds_byte(int r, int c) { const int st = (r >> 4) * 2 + (c >> 5), rr = r & 15, cc = c & 31, ob = rr * 64 + cc * 2; return st * 1024 + (ob ^ (((ob >> 9) & 1) << 5)); }
__host__ __device__ __forceinline__ void stage_rc(int b, int& R, int& C) { const int st = b / 1024, sb = b % 1024, swz = sb ^ (((sb >> 9) & 1) << 5); R = (st >> 1) * 16 + swz / 64; C = (st & 1) * 32 + (swz % 64) / 2; }
__host__ __device__ __forceinline__ int perm32(int rho) { const int n = rho >> 4, i = rho & 15; return 8 * (i >> 2) + 4 * n + (i & 3); }

struct Unit { int pm, pn; size_t aoff, boff; };
struct Gemm { const bf16_t* A; const bf16_t* Bt; int K, lda, ldb; unsigned wrapmask; };

struct TileOrder {
    int nM, nN, nwg, G, c; size_t a_tile, b_tile, b_batch; int pmb;
    __device__ __forceinline__ void init(int M, int N, int G_, int c_, int lda, int ldb, size_t b_batch_elems, int pm_per_batch) {
        nM = M / BM; nN = N / BM; nwg = nM * nN; G = G_; c = c_; a_tile = (size_t)BM * lda * 2; b_tile = (size_t)BM * ldb * 2; b_batch = b_batch_elems * 2; pmb = pm_per_batch; }
    __device__ __forceinline__ bool next(int i, Unit& u) const {
        const long L = (long)i * G + c; if (L >= nwg) return false;
        int wgid = (int)L; { const int q = nwg / NXCD, r = nwg % NXCD, xcd = wgid % NXCD, off = wgid / NXCD; wgid = (xcd < r ? xcd * (q + 1) : r * (q + 1) + (xcd - r) * q) + off; }
        const int nig = WGM * nN, gid = wgid / nig, fm = gid * WGM, gsz = (nM - fm) < WGM ? (nM - fm) : WGM;
        u.pm = fm + ((wgid % nig) % gsz); u.pn = (wgid % nig) / gsz;
        u.aoff = (size_t)u.pm * a_tile; u.boff = (size_t)u.pn * b_tile + (size_t)(u.pm / pmb) * b_batch; return true;
    }
};

__device__ __forceinline__ unsigned cvt_pk_bf16(float lo, float hi) { unsigned r; asm volatile("v_cvt_pk_bf16_f32 %0, %1, %2" : "=v"(r) : "v"(lo), "v"(hi)); return r; }

typedef f32x4 AccT[2][2][4][2];

struct EpiBf16 {
    static constexpr bool PERM = true;
    bf16_t* O; int ldc; unsigned scalemask; float scale0;
    __device__ __forceinline__ void operator()(AccT& acc, const Unit& u, int wr, int wc, int fr, int fq, PG8_LAS unsigned char*) const {
        const int row0 = u.pm * BM + wr * 64 + fr, col0 = u.pn * BM + wc * 32 + 8 * fq;
        const float sc = ((scalemask >> u.pn) & 1u) ? scale0 : 1.f;
#pragma unroll
        for (int ai = 0; ai < 2; ++ai)
#pragma unroll
            for (int m = 0; m < 4; ++m) { bf16_t* rowp = O + (size_t)(row0 + ai * HALF + m * 16) * ldc + col0;
#pragma unroll
                for (int bj = 0; bj < 2; ++bj) { const f32x4 v0 = acc[ai][bj][m][0] * sc, v1 = acc[ai][bj][m][1] * sc;
                    u32x4 w; w.x = cvt_pk_bf16(v0[0], v0[1]); w.y = cvt_pk_bf16(v0[2], v0[3]); w.z = cvt_pk_bf16(v1[0], v1[1]); w.w = cvt_pk_bf16(v1[2], v1[3]);
                    *(u32x4*)(rowp + bj * HALF) = w; } }
    }
};
__device__ __forceinline__ float rstd_from_slots(const float* slots) {
    const f32x4 a = *(const f32x4*)slots, b = *(const f32x4*)(slots + 4), c = *(const f32x4*)(slots + 8), d = *(const f32x4*)(slots + 12);
    const float s = ((a[0] + a[1]) + (a[2] + a[3])) + ((b[0] + b[1]) + (b[2] + b[3])) + ((c[0] + c[1]) + (c[2] + c[3])) + ((d[0] + d[1]) + (d[2] + d[3]));
    return __builtin_amdgcn_rsqf(s * (1.0f / 1024.0f) + 1e-6f);
}
struct EpiUp {
    static constexpr bool PERM = true;
    bf16_t* Gb; bf16_t* Ub; const float* ssq;
    __device__ __forceinline__ void operator()(AccT& acc, const Unit& u, int wr, int wc, int fr, int fq, PG8_LAS unsigned char*) const {
        const int row0 = u.pm * BM + wr * 64 + fr; const int pn = u.pn >= 11 ? u.pn - 11 : u.pn; bf16_t* base = u.pn >= 11 ? Ub : Gb;
        const int col0 = pn * BM + wc * 32 + 8 * fq;
#pragma unroll
        for (int ai = 0; ai < 2; ++ai)
#pragma unroll
            for (int m = 0; m < 4; ++m) { const int row = row0 + ai * HALF + m * 16; const float rs = rstd_from_slots(ssq + (size_t)row * 16); bf16_t* rowp = base + (size_t)row * 2816 + col0;
#pragma unroll
                for (int bj = 0; bj < 2; ++bj) { const f32x4 v0 = acc[ai][bj][m][0] * rs, v1 = acc[ai][bj][m][1] * rs;
                    u32x4 w; w.x = cvt_pk_bf16(v0[0], v0[1]); w.y = cvt_pk_bf16(v0[2], v0[3]); w.z = cvt_pk_bf16(v1[0], v1[1]); w.w = cvt_pk_bf16(v1[2], v1[3]);
                    *(u32x4*)(rowp + bj * HALF) = w; } }
    }
};
struct EpiRes {
    static constexpr bool PERM = true;
    const float* base; float* out; bf16_t* hb; float* ssq;
    __device__ __forceinline__ void operator()(AccT& acc, const Unit& u, int wr, int wc, int fr, int fq, PG8_LAS unsigned char*) const {
        const int row0 = u.pm * BM + wr * 64 + fr, col0 = u.pn * BM + wc * 32 + 8 * fq;
#pragma unroll
        for (int ai = 0; ai < 2; ++ai)
#pragma unroll
            for (int m = 0; m < 4; ++m) { const int row = row0 + ai * HALF + m * 16; const size_t off = (size_t)row * 1024 + col0; float q = 0.f;
#pragma unroll
                for (int bj = 0; bj < 2; ++bj) {
                    const f32x4 b0 = *(const f32x4*)(base + off + bj * HALF), b1 = *(const f32x4*)(base + off + bj * HALF + 4);
                    const f32x4 v0 = acc[ai][bj][m][0] + b0, v1 = acc[ai][bj][m][1] + b1;
                    *(f32x4*)(out + off + bj * HALF) = v0; *(f32x4*)(out + off + bj * HALF + 4) = v1;
                    q += (v0[0] * v0[0] + v0[1] * v0[1]) + (v0[2] * v0[2] + v0[3] * v0[3]) + (v1[0] * v1[0] + v1[1] * v1[1]) + (v1[2] * v1[2] + v1[3] * v1[3]);
                    if (hb) { u32x4 w; w.x = cvt_pk_bf16(v0[0], v0[1]); w.y = cvt_pk_bf16(v0[2], v0[3]); w.z = cvt_pk_bf16(v1[0], v1[1]); w.w = cvt_pk_bf16(v1[2], v1[3]); *(u32x4*)(hb + off + bj * HALF) = w; } }
                q += __shfl_xor(q, 16); q += __shfl_xor(q, 32);
                if (fq == 0) ssq[(size_t)row * 16 + u.pn * 4 + wc] = q; }
    }
};
struct EpiSoftmax {
    static constexpr bool PERM = true;
    bf16_t* P; const float* ssq;
    __device__ __forceinline__ void operator()(AccT& acc, const Unit& u, int wr, int wc, int fr, int fq, PG8_LAS unsigned char* xl) const {
        PG8_LAS f32x2* X = (PG8_LAS f32x2*)xl;
        const int row0 = u.pm * BM + wr * 64 + fr, col0 = u.pn * BM + wc * 32 + 8 * fq;
        float ml[2][4];
#pragma unroll
        for (int ai = 0; ai < 2; ++ai)
#pragma unroll
            for (int m = 0; m < 4; ++m) { const int row = row0 + ai * HALF + m * 16; const float rs = rstd_from_slots(ssq + (size_t)row * 16);
                float mx = -3.0e38f;
#pragma unroll
                for (int bj = 0; bj < 2; ++bj)
#pragma unroll
                    for (int n = 0; n < 2; ++n) { f32x4 v = acc[ai][bj][m][n] * rs; acc[ai][bj][m][n] = v; mx = fmaxf(fmaxf(mx, fmaxf(v[0], v[1])), fmaxf(v[2], v[3])); }
                mx = fmaxf(mx, __shfl_xor(mx, 16)); mx = fmaxf(mx, __shfl_xor(mx, 32));
                float s = 0.f;
#pragma unroll
                for (int bj = 0; bj < 2; ++bj)
#pragma unroll
                    for (int n = 0; n < 2; ++n) { f32x4 v = acc[ai][bj][m][n];
                        v[0] = __builtin_amdgcn_exp2f(v[0] - mx); v[1] = __builtin_amdgcn_exp2f(v[1] - mx); v[2] = __builtin_amdgcn_exp2f(v[2] - mx); v[3] = __builtin_amdgcn_exp2f(v[3] - mx);
                        acc[ai][bj][m][n] = v; s += (v[0] + v[1]) + (v[2] + v[3]); }
                s += __shfl_xor(s, 16); s += __shfl_xor(s, 32);
                ml[ai][m] = mx;
                if (fq == 0) X[(ai * HALF + wr * 64 + m * 16 + fr) * 4 + wc] = (f32x2){mx, s}; }
        asm volatile("s_waitcnt lgkmcnt(0)" ::: "memory"); __builtin_amdgcn_s_barrier(); asm volatile("" ::: "memory");
#pragma unroll
        for (int ai = 0; ai < 2; ++ai)
#pragma unroll
            for (int m = 0; m < 4; ++m) { const int rl = ai * HALF + wr * 64 + m * 16 + fr; const int row = u.pm * BM + rl;
                const f32x2 a = X[rl * 4 + 0], b = X[rl * 4 + 1], c = X[rl * 4 + 2], d = X[rl * 4 + 3];
                const float Mx = fmaxf(fmaxf(a.x, b.x), fmaxf(c.x, d.x));
                const float L = a.y * __builtin_amdgcn_exp2f(a.x - Mx) + b.y * __builtin_amdgcn_exp2f(b.x - Mx) + c.y * __builtin_amdgcn_exp2f(c.x - Mx) + d.y * __builtin_amdgcn_exp2f(d.x - Mx);
                const float f = __builtin_amdgcn_exp2f(ml[ai][m] - Mx) * __builtin_amdgcn_rcpf(L);
                bf16_t* rowp = P + (size_t)row * 1024 + col0;
#pragma unroll
                for (int bj = 0; bj < 2; ++bj) { const f32x4 v0 = acc[ai][bj][m][0] * f, v1 = acc[ai][bj][m][1] * f;
                    u32x4 w; w.x = cvt_pk_bf16(v0[0], v0[1]); w.y = cvt_pk_bf16(v0[2], v0[3]); w.z = cvt_pk_bf16(v1[0], v1[1]); w.w = cvt_pk_bf16(v1[2], v1[3]);
                    *(u32x4*)(rowp + bj * HALF) = w; } }
    }
};
struct EpiGate {
    static constexpr bool PERM = false;
    unsigned* sel;
    __device__ __forceinline__ void operator()(AccT& acc, const Unit& u, int wr, int wc, int fr, int fq, PG8_LAS unsigned char*) const {
        const int own = u.pm & 31;
#pragma unroll
        for (int ai = 0; ai < 2; ++ai)
#pragma unroll
            for (int m = 0; m < 4; ++m) { const int row = u.pm * BM + ai * HALF + wr * 64 + m * 16 + fr;
#pragma unroll
                for (int bj = 0; bj < 2; ++bj) { unsigned mask = 0u;
#pragma unroll
                    for (int round = 0; round < 3; ++round) { float bv = -3.0e38f; int bi = 32;
#pragma unroll
                        for (int n = 0; n < 2; ++n)
#pragma unroll
                            for (int i = 0; i < 4; ++i) { const int nb = 16 * n + 4 * fq + i; const float v = acc[ai][bj][m][n][i];
                                if (nb < own && !((mask >> nb) & 1u) && v > bv) { bv = v; bi = nb; } }
#pragma unroll
                        for (int off = 16; off <= 32; off <<= 1) { const float ov = __shfl_xor(bv, off); const int oi = __shfl_xor(bi, off); if (ov > bv || (ov == bv && oi < bi)) { bv = ov; bi = oi; } }
                        if (bi < 32) mask |= 1u << bi; }
                    if (fq == 0) sel[((size_t)((u.pm >> 5) * 8 + 4 * bj + wc)) * 8192 + (row & 8191)] = mask; } }
    }
};

template <class Epi, class Sched, bool ALIGN_EPI>
__device__ __forceinline__ void gemm_phase(PG8_LAS unsigned char* lds, PG8_LAS unsigned char* xl, const Gemm g, const Sched& S, const Epi& E) {
    int tid_ = threadIdx.x; asm volatile("" : "+v"(tid_));
    const int tid = tid_, wid = __builtin_amdgcn_readfirstlane(tid >> 6), lane = tid & 63, wr = wid >> 2, wc = wid & 3, fr = lane & 15, fq = lane >> 4;
    const int K = g.K, nt = K / BK;
    unsigned voffA[2], voffB[2];
#pragma unroll
    for (int i = 0; i < 2; ++i) { int R, C; stage_rc(tid * 16 + i * 8192, R, C); const int Rb = Epi::PERM ? ((R & ~31) + perm32(R & 31)) : R;
        voffA[i] = (unsigned)(R * g.lda + C) * 2u; voffB[i] = (unsigned)(Rb * g.ldb + C) * 2u; }
    const size_t kstep = (size_t)(BK * 2);
    const size_t hstepA = (size_t)HALF * g.lda * 2, hstepB = (size_t)HALF * g.ldb * 2;
    const unsigned wmask = g.wrapmask;
    const unsigned ldsw = (unsigned)wid * 1024u;
    const int aoff = lds_byte(wr * 64 + fr, fq * 8), boff = lds_byte(wc * 32 + fr, fq * 8);
#define PG8_SA(b, h) (((b) * 2 + (h)) * HTB)
#define PG8_SB(b, h) ((4 + (b) * 2 + (h)) * HTB)
#define PG8_STAGE(bufoff, gbase, voff) do { _Pragma("unroll") for (int _i = 0; _i < 2; ++_i) \
        __builtin_amdgcn_global_load_lds((const unsigned*)((const char*)(gbase) + (voff)[_i]), (PG8_LAS unsigned*)(lds + (bufoff) + ldsw + _i * 8192), 16, 0, 0); } while (0)
#define PG8_LDA(dst, b, h) do { _Pragma("unroll") for (int m = 0; m < 4; ++m) _Pragma("unroll") for (int k = 0; k < 2; ++k) dst[m][k] = *(const PG8_LAS bf16x8*)(lds + PG8_SA(b, h) + aoff + m * 2048 + k * 1024); } while (0)
#define PG8_LDB(dst, b, h) do { _Pragma("unroll") for (int n = 0; n < 2; ++n) _Pragma("unroll") for (int k = 0; k < 2; ++k) dst[n][k] = *(const PG8_LAS bf16x8*)(lds + PG8_SB(b, h) + boff + n * 2048 + k * 1024); } while (0)
#define PG8_MMA(ai, bj, At, Bt) do { __builtin_amdgcn_s_setprio(1); _Pragma("unroll") for (int m = 0; m < 4; ++m) _Pragma("unroll") for (int n = 0; n < 2; ++n) _Pragma("unroll") for (int k = 0; k < 2; ++k) \
        acc[ai][bj][m][n] = __builtin_amdgcn_mfma_f32_16x16x32_bf16(Bt[n][k], At[m][k], acc[ai][bj][m][n], 0, 0, 0); __builtin_amdgcn_s_setprio(0); } while (0)
#define PG8_WAIT_V(n) asm volatile("s_waitcnt vmcnt(" #n ")" ::: "memory")
#define PG8_WAIT_L(n) asm volatile("s_waitcnt lgkmcnt(" #n ")" ::: "memory")
#define PG8_BAR __builtin_amdgcn_s_barrier()
#define PG8_SCHED __builtin_amdgcn_sched_barrier(0)
    Unit cur, nxt; int ui = 0;
    if (!S.next(0, cur)) return;
    AccT acc;
#pragma unroll
    for (int a = 0; a < 2; ++a)
#pragma unroll
        for (int b = 0; b < 2; ++b)
#pragma unroll
            for (int m = 0; m < 4; ++m)
#pragma unroll
                for (int n = 0; n < 2; ++n) acc[a][b][m][n] = (f32x4){0.f, 0.f, 0.f, 0.f};
    bf16x8 At[4][2], B0[2][2], B1[2][2];
    const char* cA = (const char*)g.A + cur.aoff; const char* cB = (const char*)g.Bt + cur.boff;
    PG8_STAGE(PG8_SB(0, 0), cB, voffB); PG8_STAGE(PG8_SB(0, 1), cB + hstepB, voffB); PG8_STAGE(PG8_SA(0, 0), cA, voffA); PG8_STAGE(PG8_SA(0, 1), cA + hstepA, voffA);
    if (wr == 1) PG8_BAR;
    PG8_WAIT_V(2); PG8_BAR;
    PG8_STAGE(PG8_SB(1, 0), cB + kstep, voffB); PG8_STAGE(PG8_SA(1, 0), cA + kstep, voffA); PG8_STAGE(PG8_SB(1, 1), cB + hstepB + kstep, voffB);
    PG8_WAIT_V(6); PG8_BAR;
    for (;;) {
        const bool has_next = S.next(ui + 1, nxt);
        const char* nA = has_next ? (const char*)g.A + nxt.aoff : cA; const char* nB = has_next ? (const char*)g.Bt + nxt.boff : cB;
        for (int t = 0; t < nt; t += 2) {
            const bool last = (t == nt - 2);
            const char* a1 = cA + (size_t)(((unsigned)(t * BK) & wmask) * 2u) + kstep;
            const char* a2 = last ? nA : cA + (size_t)(((unsigned)((t + 2) * BK) & wmask) * 2u); const char* b2 = last ? nB : cB + (size_t)(t + 2) * kstep;
            const char* a3 = a2 + kstep; const char* b3 = b2 + kstep;
            PG8_LDB(B0, 0, 0); PG8_LDB(B1, 0, 1); PG8_SCHED; PG8_LDA(At, 0, 0); PG8_STAGE(PG8_SA(1, 1), a1 + hstepA, voffA);
            PG8_WAIT_V(8); PG8_WAIT_L(0); PG8_BAR; PG8_MMA(0, 0, At, B0); PG8_MMA(0, 1, At, B1); PG8_BAR; PG8_SCHED;
            PG8_LDA(At, 0, 1); PG8_STAGE(PG8_SB(0, 0), b2, voffB); PG8_STAGE(PG8_SB(0, 1), b2 + hstepB, voffB); PG8_STAGE(PG8_SA(0, 0), a2, voffA);
            PG8_WAIT_V(8); PG8_WAIT_L(0); PG8_BAR; PG8_MMA(1, 0, At, B0); PG8_MMA(1, 1, At, B1); PG8_BAR; PG8_SCHED;
            PG8_LDB(B0, 1, 0); PG8_LDB(B1, 1, 1); PG8_SCHED; PG8_LDA(At, 1, 0); PG8_STAGE(PG8_SA(0, 1), a2 + hstepA, voffA);
            PG8_WAIT_V(8); PG8_WAIT_L(0); PG8_BAR; PG8_MMA(0, 0, At, B0); PG8_MMA(0, 1, At, B1); PG8_BAR; PG8_SCHED;
            PG8_LDA(At, 1, 1); PG8_STAGE(PG8_SB(1, 0), b3, voffB); PG8_STAGE(PG8_SB(1, 1), b3 + hstepB, voffB); PG8_STAGE(PG8_SA(1, 0), a3, voffA);
            PG8_WAIT_V(8); PG8_WAIT_L(0); PG8_BAR; PG8_MMA(1, 0, At, B0); PG8_MMA(1, 1, At, B1); PG8_BAR; PG8_SCHED;
        }
        if constexpr (ALIGN_EPI) { if (wr == 0) PG8_BAR; }
        E(acc, cur, wr, wc, fr, fq, xl);
        if (!has_next) break;
#pragma unroll
        for (int a = 0; a < 2; ++a)
#pragma unroll
            for (int b = 0; b < 2; ++b)
#pragma unroll
                for (int m = 0; m < 4; ++m)
#pragma unroll
                    for (int n = 0; n < 2; ++n) acc[a][b][m][n] = (f32x4){0.f, 0.f, 0.f, 0.f};
        cur = nxt; cA = nA; cB = nB; ++ui;
        if constexpr (ALIGN_EPI) { if (wr == 1) PG8_BAR; }
    }
    PG8_WAIT_V(0);
    if constexpr (!ALIGN_EPI) { if (wr == 0) PG8_BAR; }
    PG8_BAR;
#undef PG8_SA
#undef PG8_SB
#undef PG8_STAGE
#undef PG8_LDA
#undef PG8_LDB
#undef PG8_MMA
#undef PG8_WAIT_V
#undef PG8_WAIT_L
#undef PG8_BAR
#undef PG8_SCHED
}
}

constexpr int NWAVES = 8;
constexpr int NB = 8, T = 8192, D = 1024, M = NB * T;
constexpr int INC = 3080, NQKV = 3072, FF = 2816;
constexpr int C_F = 1536, C_QM = 1544, C_KM = 2056;
constexpr float LOG2E = 1.4426950408889634f;
constexpr float C2 = 0.125f * LOG2E;
constexpr float RMS_EPS = 1e-6f;

constexpr size_t MiB = 1u << 20;
constexpr size_t WS_CTL = 0, CTL_ZERO_BYTES = 1 * MiB;
constexpr size_t WS_LOGF = 2 * MiB, WS_C = 4 * MiB, WS_ABAR = 6 * MiB, WS_KM = 7 * MiB, WS_SEL = 8 * MiB;
constexpr size_t WS_SSQ1 = 10 * MiB, WS_SSQ2 = 14 * MiB, WS_SSQ3 = 18 * MiB;
constexpr size_t WS_MEMN = 22 * MiB, WS_KV = 26 * MiB, WS_WQS = 34 * MiB, WS_WOT = 36 * MiB, WS_WKVT = 38 * MiB, WS_WINT = 42 * MiB, WS_WOUTT = 48 * MiB;
constexpr size_t WS_WUPT = 50 * MiB, WS_WDT = 62 * MiB, WS_ZT = 68 * MiB, WS_WQK = 80 * MiB, WS_VWO = 96 * MiB;
constexpr size_t WS_A1 = 112 * MiB;
constexpr size_t WS_QKV = 368 * MiB;
constexpr size_t WS_Y = 752 * MiB, WS_HB1 = WS_A1 + 128 * MiB, WS_P = WS_QKV, WS_HB2 = WS_A1;
constexpr size_t WS_PO = WS_A1;
constexpr size_t WS_LIST = 880 * MiB, WS_PML = 944 * MiB, WS_KXF = 960 * MiB, WS_KXM = 968 * MiB, WS_CNT = 969 * MiB;
constexpr size_t WS_G = 240 * MiB, WS_U = 592 * MiB, WS_END = 1024 * MiB;
static_assert(WS_WDT + (size_t)D * FF * 2 <= WS_ZT && WS_ZT + (size_t)8 * 256 * 3072 * 2 <= WS_WQK && WS_VWO + 16 * MiB <= WS_A1, "ws map");
static_assert(WS_G + (size_t)M * FF * 2 <= WS_U && WS_U + (size_t)M * FF * 2 <= WS_END && WS_Y + (size_t)M * D * 2 <= WS_LIST && WS_LIST + (size_t)2048 * 8192 * 4 <= WS_PML && WS_PML + (size_t)M * 32 * 8 <= WS_KXF && WS_KXF + (size_t)64 * 8192 * 16 <= WS_KXM, "ws map 2");
constexpr int CW_BAR = 4096;
constexpr int CW_QKN = 8192;

constexpr int RING_OFF = 0, RING_BYTES = 131072;
constexpr int LDSCTL_OFF = RING_BYTES, MISC_OFF = LDSCTL_OFF + 320;
constexpr int XL_OFF = RING_BYTES + 512;
constexpr int LDS_BYTES = 147456;
static_assert(XL_OFF + 8192 <= LDS_BYTES, "LDS map");

#define GAS __attribute__((address_space(1)))
#define LAS __attribute__((address_space(3)))
typedef unsigned short bf16;
typedef unsigned v4u __attribute__((ext_vector_type(4)));
typedef float f32x4 __attribute__((ext_vector_type(4)));
typedef GAS unsigned gu32;
#define RLX_AGENT __ATOMIC_RELAXED, __HIP_MEMORY_SCOPE_AGENT
#define LDS_WAIT() asm volatile("s_waitcnt lgkmcnt(0)" ::: "memory")
__device__ __forceinline__ unsigned f2bf(float f) { unsigned u = __builtin_bit_cast(unsigned, f); return (u + 0x7fffu + ((u >> 16) & 1u)) >> 16; }
__device__ __forceinline__ unsigned pk2(float lo, float hi) { return f2bf(lo) | (f2bf(hi) << 16); }
__device__ __forceinline__ float bf2f(unsigned b) { return __builtin_bit_cast(float, b << 16); }
__device__ __forceinline__ float bflo(unsigned w) { return __builtin_bit_cast(float, w << 16); }
__device__ __forceinline__ float bfhi(unsigned w) { return __builtin_bit_cast(float, w & 0xffff0000u); }

#define XB_TMO      128
#define XB_XCNT(j)  (256  + 64 * (j))
#define XB_XSUB(j)  (1280 + 64 * (j))
#define XB_XGEN(j)  (2304 + 64 * (j))
#define XB_TOP      3328
#define XB_TOPGEN   3392
#define XCD_BAR_WORDS 3456
#define XB_SPIN_CAP (1u << 18)

__device__ __forceinline__ unsigned xb_ld(unsigned* p)              { return __hip_atomic_load(p, __ATOMIC_RELAXED, __HIP_MEMORY_SCOPE_AGENT); }
__device__ __forceinline__ unsigned xb_add(unsigned* p, unsigned v) { return __hip_atomic_fetch_add(p, v, __ATOMIC_RELAXED, __HIP_MEMORY_SCOPE_AGENT); }
__device__ __forceinline__ unsigned xb_xcc_id() { return (unsigned)__builtin_amdgcn_s_getreg((3 << 11) | 20) & 0xFu; }
#define XB_SPIN(cond, bar) do { unsigned _sp = 0; while (cond) { __builtin_amdgcn_s_sleep(1); \
    if ((++_sp & 255u) == 0u) { if (xb_ld(&(bar)[XB_TMO])) break; if (_sp > XB_SPIN_CAP) { atomicAdd(&(bar)[XB_TMO], 1u); break; } } } } while (0)

struct XcdBarrier { unsigned* bar; unsigned x; volatile LAS unsigned* st; };

__device__ __forceinline__ XcdBarrier xcd_barrier_post(unsigned* bar, volatile LAS unsigned* st) {
    XcdBarrier b; b.bar = bar; b.x = xb_xcc_id(); b.st = st;
    if (threadIdx.x == 0) (void)xb_add(&bar[XB_XCNT(b.x)], 1u);
    return b;
}
__device__ __forceinline__ void xcd_barrier_complete(unsigned* bar, unsigned x, unsigned& nloc, unsigned& nx) {
    const unsigned G = gridDim.x * gridDim.y * gridDim.z;
    unsigned sum, cnt, mine, sp = 0u;
    for (;;) {
        sum = 0u; cnt = 0u; mine = 0u;
#pragma unroll
        for (unsigned j = 0; j < 16; ++j) { const unsigned c = xb_ld(&bar[XB_XCNT(j)]); sum += c; cnt += (c > 0u) ? 1u : 0u; mine = (j == x) ? c : mine; }
        if (sum == G) break;
        __builtin_amdgcn_s_sleep(1);
        if ((++sp & 255u) == 0u) { if (xb_ld(&bar[XB_TMO])) break; if (sp > XB_SPIN_CAP) { atomicAdd(&bar[XB_TMO], 1u); break; } }
    }
    nloc = mine > 0u ? mine : 1u; nx = cnt > 0u ? cnt : 1u;
}
__device__ __forceinline__ void xcd_barrier(const XcdBarrier& b) {
    asm volatile("s_waitcnt vmcnt(0)" ::: "memory");
    __syncthreads();
    if (threadIdx.x == 0) {
        unsigned* bar = b.bar;
        __builtin_amdgcn_s_waitcnt(0);
        unsigned nloc = b.st[0], nx = b.st[1];
        if (nloc == 0u) { xcd_barrier_complete(bar, b.x, nloc, nx); b.st[0] = nloc; b.st[1] = nx; }
        const unsigned old = xb_add(&bar[XB_XSUB(b.x)], 1u);
        const unsigned gen = old / nloc;
        if (old + 1u == (gen + 1u) * nloc) {
            __builtin_amdgcn_fence(__ATOMIC_RELEASE, "agent");
            asm volatile("s_waitcnt vmcnt(0)" ::: "memory");
            const unsigned og = xb_add(&bar[XB_TOP], 1u);
            const unsigned tg = og / nx;
            if (og + 1u == (tg + 1u) * nx) xb_add(&bar[XB_TOPGEN], 1u);
            else XB_SPIN(xb_ld(&bar[XB_TOPGEN]) == tg, bar);
            __builtin_amdgcn_fence(__ATOMIC_ACQUIRE, "agent");
            xb_add(&bar[XB_XGEN(b.x)], 1u);
            asm volatile("s_waitcnt vmcnt(0)" ::: "memory");
        } else {
            XB_SPIN(xb_ld(&bar[XB_XGEN(b.x)]) == gen, bar);
            __builtin_amdgcn_fence(__ATOMIC_ACQUIRE, "agent");
            asm volatile("s_waitcnt vmcnt(0)" ::: "memory");
        }
    }
    __syncthreads();
}

__device__ __forceinline__ float wave_sum(float v) {
#pragma unroll
    for (int o = 1; o < 64; o <<= 1) v += __shfl_xor(v, o);
    return v;
}
__device__ __forceinline__ void p0_transpose_item(const float* W, int ldw, int K, int N, bf16* WT, const float* kscale, bool remap, LAS float* scr, int item, int lane) {
    const int nblk = N / 32, kb = item / nblk, nb = item % nblk, k0 = 64 * kb, n0 = 32 * nb;
    const int sn0 = (remap && n0 >= 1536) ? n0 + 8 : n0;
#pragma unroll 8
    for (int i = 0; i < 32; ++i) { const int kk = 2 * i + (lane >> 5); float v = W[(size_t)(k0 + kk) * ldw + sn0 + (lane & 31)]; if (kscale) v *= kscale[k0 + kk]; scr[kk * 33 + (lane & 31)] = v; }
    LDS_WAIT(); asm volatile("" ::: "memory");
    const int c = lane & 7;
#pragma unroll
    for (int j = 0; j < 4; ++j) { const int n = (lane >> 3) + 8 * j; const LAS float* s = scr + (8 * c) * 33 + n;
        v4u o; o.x = pk2(s[0 * 33], s[1 * 33]); o.y = pk2(s[2 * 33], s[3 * 33]); o.z = pk2(s[4 * 33], s[5 * 33]); o.w = pk2(s[6 * 33], s[7 * 33]);
        *(GAS v4u*)(WT + (size_t)(n0 + n) * K + k0 + 8 * c) = o; }
    LDS_WAIT(); asm volatile("" ::: "memory");
}

struct Args { const float* in[19]; float* out; unsigned char* ws; };

namespace attn_body {
using hb16=__hip_bfloat16;
using bf16x8=__attribute__((ext_vector_type(8)))short;
using s16x4=__attribute__((ext_vector_type(4)))short;
using f32x16=__attribute__((ext_vector_type(16)))float;
using u32x4=__attribute__((ext_vector_type(4)))unsigned;
constexpr int PITCH=3072;
constexpr int NW=8,QBLK=32,QB=QBLK*NW,KVBLK=64;
__device__ __forceinline__ int crow(int r,int hi){return (r&3)+8*(r>>2)+4*hi;}
#define SBAR() __builtin_amdgcn_sched_barrier(0)
__device__ __forceinline__ void cmask(f32x16&p0,f32x16&p1,int jb,int qrel,int hi){
  const float NEG=-INFINITY; int kb=64*jb+4*hi;
  #pragma unroll
  for(int r=0;r<16;++r){int kv=kb+(r&3)+8*(r>>2); if(kv>qrel)p0[r]=NEG; if(kv+32>qrel)p1[r]=NEG;}
}
constexpr int NSLOT=3, SLOTB=9216;
constexpr int LDS_K=0, LDS_V=NSLOT*SLOTB, LDS_WS=2*NSLOT*SLOTB, LDS_OST=LDS_WS+NW*64*4, LDS_BYTES=LDS_OST+NW*4096;
__device__ __forceinline__ void glds16(const void*gsrc,unsigned lds_dst){unsigned keep;
  asm volatile("s_mov_b32 %0, m0\n\ts_mov_b32 m0, %2\n\ts_nop 0\n\tglobal_load_lds_dwordx4 %1, off\n\ts_mov_b32 m0, %0":"=&s"(keep):"v"(gsrc),"s"(lds_dst):"memory");}
__device__ __forceinline__ void glds16x(const void*gsrc,unsigned lds_dst){unsigned keep;unsigned long long ex;
  asm volatile("s_mov_b32 %0, m0\n\ts_mov_b64 %1, exec\n\ts_mov_b64 exec, 0xff\n\ts_mov_b32 m0, %3\n\ts_nop 0\n\tglobal_load_lds_dwordx4 %2, off\n\ts_mov_b64 exec, %1\n\ts_mov_b32 m0, %0":"=&s"(keep),"=&s"(ex):"v"(gsrc),"s"(lds_dst):"memory");}
__device__ __forceinline__ float max3f(float a,float b,float c){float r;asm("v_max3_f32 %0, %1, %2, %3":"=v"(r):"v"(a),"v"(b),"v"(c));return r;}
__device__ __forceinline__ float max2f(float a,float b){float r;asm("v_max_f32_e32 %0, %1, %2":"=v"(r):"v"(a),"v"(b));return r;}
__device__ __forceinline__ float fsub_s(float a,float b){float r;asm("v_sub_f32_e32 %0, %1, %2":"=v"(r):"v"(a),"v"(b));return r;}
typedef float f32x2_t __attribute__((ext_vector_type(2))); typedef __bf16 bf16x2_t __attribute__((ext_vector_type(2)));
__device__ __forceinline__ unsigned cvtpk_s(float lo,float hi){f32x2_t v={lo,hi};bf16x2_t b=__builtin_convertvector(v,bf16x2_t);return __builtin_bit_cast(unsigned,b);}
__device__ __forceinline__ float rbf(float x){return __builtin_bit_cast(float,cvtpk_s(x,0.f)<<16);}
#define WAIT_BAR(N) asm volatile("s_waitcnt vmcnt(" #N ") lgkmcnt(0)\n\ts_barrier":::"memory")

__device__ __forceinline__ void qkt(f32x16&p0,f32x16&p1,const char*Kslot,const bf16x8*qr,int r32,int hi){
  const char*kb=Kslot+hi*1024+r32*16; const f32x16 zf={};
  #pragma unroll
  for(int d0=0;d0<4;++d0){
    const bf16x8 b0=*reinterpret_cast<const bf16x8*>(kb+d0*2048);
    const bf16x8 b1=*reinterpret_cast<const bf16x8*>(kb+d0*2048+512);
    if(d0==0){p0=__builtin_amdgcn_mfma_f32_32x32x16_bf16(b0,qr[0],zf,0,0,0);p1=__builtin_amdgcn_mfma_f32_32x32x16_bf16(b1,qr[0],zf,0,0,0);}
    else{p0=__builtin_amdgcn_mfma_f32_32x32x16_bf16(b0,qr[d0],p0,0,0,0);p1=__builtin_amdgcn_mfma_f32_32x32x16_bf16(b1,qr[d0],p1,0,0,0);}}
  const char*kx=Kslot+8192+r32*16;
  const bf16x8 x0=*reinterpret_cast<const bf16x8*>(kx), x1=*reinterpret_cast<const bf16x8*>(kx+512);
  p0=__builtin_amdgcn_mfma_f32_32x32x16_bf16(x0,qr[4],p0,0,0,0);p1=__builtin_amdgcn_mfma_f32_32x32x16_bf16(x1,qr[4],p1,0,0,0);
}
typedef __attribute__((address_space(3))) const char* lds_cptr;
typedef short v4i16_t __attribute__((ext_vector_type(4)));
__device__ __forceinline__ void kload10(bf16x8*kf,lds_cptr kp,lds_cptr kx){
  kf[0]=*(const __attribute__((address_space(3))) bf16x8*)(kp);      kf[1]=*(const __attribute__((address_space(3))) bf16x8*)(kp+512);
  kf[2]=*(const __attribute__((address_space(3))) bf16x8*)(kp+2048); kf[3]=*(const __attribute__((address_space(3))) bf16x8*)(kp+2560);
  kf[4]=*(const __attribute__((address_space(3))) bf16x8*)(kp+4096); kf[5]=*(const __attribute__((address_space(3))) bf16x8*)(kp+4608);
  kf[6]=*(const __attribute__((address_space(3))) bf16x8*)(kp+6144); kf[7]=*(const __attribute__((address_space(3))) bf16x8*)(kp+6656);
  kf[8]=*(const __attribute__((address_space(3))) bf16x8*)(kx);      kf[9]=*(const __attribute__((address_space(3))) bf16x8*)(kx+512);
}
__device__ __forceinline__ void kload2(bf16x8*kf,lds_cptr kp,int j){ kf[2*j]=*(const __attribute__((address_space(3))) bf16x8*)(kp+j*2048); kf[2*j+1]=*(const __attribute__((address_space(3))) bf16x8*)(kp+j*2048+512); }
__device__ __forceinline__ s16x4 vtr(lds_cptr p){ return __builtin_bit_cast(s16x4,__builtin_amdgcn_ds_read_tr16_b64_v4i16((__attribute__((address_space(3))) v4i16_t*)p)); }
__device__ __forceinline__ float rowmax(const f32x16&p0,const f32x16&p1){
  float a=max3f(p0[0],p0[1],p1[0]),b=max3f(p0[2],p0[3],p1[1]);a=max3f(a,p1[2],p1[3]);
  #pragma unroll
  for(int r=4;r<16;r+=4){a=max3f(a,p0[r],p0[r+1]);b=max3f(b,p0[r+2],p0[r+3]);a=max3f(a,p1[r],p1[r+1]);b=max3f(b,p1[r+2],p1[r+3]);}
  const float m=max2f(a,b);
  auto rr=__builtin_amdgcn_permlane32_swap(__float_as_uint(m),__float_as_uint(m),false,false);
  return max2f(__uint_as_float(rr[0]),__uint_as_float(rr[1]));
}
__device__ __forceinline__ void pv(f32x16*o,int vb,bf16x8 pa0,bf16x8 pa1,bf16x8 pa2,bf16x8 pa3){
  #pragma unroll
  for(int d0=0;d0<2;++d0){s16x4 lo[4],hi[4];
    #pragma unroll
    for(int ks=0;ks<4;++ks){
      asm volatile("ds_read_b64_tr_b16 %0,%1 offset:%c2":"=&v"(lo[ks]):"v"(vb),"i"(d0*4096+ks*1024):"memory");
      asm volatile("ds_read_b64_tr_b16 %0,%1 offset:%c2":"=&v"(hi[ks]):"v"(vb),"i"(d0*4096+ks*1024+512):"memory");}
    asm volatile("s_waitcnt lgkmcnt(0)":::"memory");SBAR();
    #define PK(k) (bf16x8){lo[k][0],lo[k][1],lo[k][2],lo[k][3],hi[k][0],hi[k][1],hi[k][2],hi[k][3]}
    o[d0]=__builtin_amdgcn_mfma_f32_32x32x16_bf16(pa0,PK(0),o[d0],0,0,0);
    o[d0]=__builtin_amdgcn_mfma_f32_32x32x16_bf16(pa1,PK(1),o[d0],0,0,0);
    o[d0]=__builtin_amdgcn_mfma_f32_32x32x16_bf16(pa2,PK(2),o[d0],0,0,0);
    o[d0]=__builtin_amdgcn_mfma_f32_32x32x16_bf16(pa3,PK(3),o[d0],0,0,0);
    #undef PK
  }
}

template<int THRL> __device__ __forceinline__ void attn_unit(char*shm,const int KIND,const hb16*Qc,int qrow,int oslot,const hb16*__restrict__ Kt0,const hb16*__restrict__ Vt0,const hb16*__restrict__ KXt0,int NT,int band0,hb16*Oc,hb16*PO,float*PML){
  const int tid=threadIdx.x,lane=tid&63,r32=lane&31,hi=lane>>5; const int wid=__builtin_amdgcn_readfirstlane(tid>>6);
  const unsigned lds0=(unsigned)(uintptr_t)shm;
  float*wsf=(float*)(shm+LDS_WS)+wid*64;
  const hb16*ksrc=Kt0+(long)lane*PITCH+wid*8;
  const hb16*vsrc=Vt0+(long)(16*(wid&3)+(lane>>2))*PITCH+(wid>>2)*32+(lane&3)*8;
  const hb16*xsrc=KXt0+(long)(8*wid+(lane&7))*8;
  const unsigned kdst=lds0+LDS_K+wid*1024, vdst=lds0+LDS_V+wid*1024, xdst=lds0+LDS_K+8192+wid*128;
  #define DMA_K(t,slot) do{ glds16(ksrc+(long)(t)*KVBLK*PITCH,(unsigned)__builtin_amdgcn_readfirstlane(kdst+(slot))); glds16x(xsrc+(long)(t)*KVBLK*8,(unsigned)__builtin_amdgcn_readfirstlane(xdst+(slot))); }while(0)
  #define DMA_V(t,slot) glds16(vsrc+(long)(t)*KVBLK*PITCH,(unsigned)__builtin_amdgcn_readfirstlane(vdst+(slot)))
  const int vb0=(int)(lds0+LDS_V)+((lane>>4)&1)*32+(lane&3)*8+(4*hi+((lane&15)>>2))*64;
  const char*Kbase=shm+LDS_K; bf16x8 kf[10];
  const lds_cptr shm3=(lds_cptr)shm; const lds_cptr kp0=shm3+LDS_K+hi*1024+r32*16; const lds_cptr kx0=shm3+LDS_K+8192+r32*16; const lds_cptr vp0=shm3+LDS_V+((lane>>4)&1)*32+(lane&3)*8+(4*hi+((lane&15)>>2))*64;
  DMA_K(0,0);DMA_V(0,0);DMA_K(1,SLOTB);
  bf16x8 qr[5];
  { const hb16*Qw=Qc+(long)qrow*PITCH;
    #pragma unroll
    for(int d0=0;d0<4;++d0)qr[d0]=*reinterpret_cast<const bf16x8*>(&Qw[d0*16+hi*8]); }
  float mhat=0.f,l_reg=0.f;f32x16 o[2];o[0]=f32x16{};o[1]=f32x16{};
  #define SETQX(mh_,ml_) do{ const unsigned bh_=cvtpk_s(-(mh_),-(ml_)); u32x4 qx_; qx_.x=0x3F803F80u; qx_.y=0x3F80u|(bh_<<16); qx_.z=(bh_>>16); qx_.w=0u; if(hi){qx_.x=0u;qx_.y=0u;qx_.z=0u;} qr[4]=__builtin_bit_cast(bf16x8,qx_); asm volatile("":"+v"(qr[4])); }while(0)
  #define MOVEREF(gain) const float mraw_=mhat+(gain); const float mh_=rbf(mraw_); const float ml_=rbf(mraw_-mh_); const float mnew_=mh_+ml_; const float dl=mnew_-mhat; mhat=mnew_; SETQX(mh_,ml_);
  SETQX(0.f,0.f);
  const int qrel=wid*QBLK+r32;
  #define CMASK(P0,P1,t) do{int jb_=(t)-band0; if(jb_>=0)cmask(P0,P1,jb_,qrel,hi);}while(0)
  bool resc=false;
  #define START(P0,P1) do{ const float rm=rowmax(P0,P1); resc=false; \
    { MOVEREF(rm) \
      _Pragma("unroll") for(int r=0;r<16;++r){P0[r]=fsub_s(P0[r],dl);P1[r]=fsub_s(P1[r],dl);} } \
    _Pragma("unroll") for(int r=0;r<16;++r)P0[r]=__builtin_amdgcn_exp2f(P0[r]); }while(0)
  #define RESC() do{ if(resc){ asm volatile("s_waitcnt lgkmcnt(0)":::"memory"); \
      _Pragma("unroll") for(int d_=0;d_<2;++d_) _Pragma("unroll") for(int r=0;r<16;++r)o[d_][r]*=wsf[crow(r,hi)]; } }while(0)
  f32x16 pA0,pA1,pB0,pB1;
  int sl_prev=0,sl_cur=0,sl_next=SLOTB;
  #define ROT() do{sl_prev=sl_cur;sl_cur=sl_next;sl_next=(sl_next==(NSLOT-1)*SLOTB)?0:sl_next+SLOTB;}while(0)
  DMA_K(2,2*SLOTB);
  WAIT_BAR(5);
  qkt(pA0,pA1,Kbase,qr,r32,hi);asm volatile("s_nop 15\n\ts_nop 7":"+v"(pA0),"+v"(pA1));CMASK(pA0,pA1,0);
  START(pA0,pA1);
  _Pragma("unroll") for(int r=0;r<16;++r)pA1[r]=__builtin_amdgcn_exp2f(pA1[r]);
  WAIT_BAR(0);
  DMA_K(3,0);DMA_V(1,SLOTB);
  ROT();
  kload10(kf,kp0+sl_cur,kx0+sl_cur);
  WAIT_BAR(3);
  s16x4 vlo[8],vhi[8]; u32x4 pw0,pw1,pw2,pw3; const f32x16 zf={};
  #define PKW(P,B) cvtpk_s(P[B],P[B+1])
  #define PAF(k) __builtin_bit_cast(bf16x8,pw##k)
  #define VFR(i) (bf16x8){vlo[i][0],vlo[i][1],vlo[i][2],vlo[i][3],vhi[i][0],vhi[i][1],vhi[i][2],vhi[i][3]}
  #define PIN(x) asm volatile("":"+v"(x))
  #define MX3(a,b,c) __builtin_fmaxf(__builtin_fmaxf((a),(b)),(c))
  #define GAPA(MF,A0,A1,A2,A3,W0,W1,PW) do{ MF; sacc+=A0; sacc+=A1; sacc+=A2; sacc+=A3; PIN(sacc); W0; W1; PIN(PW); SBAR(); }while(0)
  #define EX(v) __builtin_amdgcn_exp2f(v)
  #define GAPB(MF,X,B) do{ MF; X[B]=EX(X[B]); X[B+1]=EX(X[B+1]); X[B+2]=EX(X[B+2]); X[B+3]=EX(X[B+3]); PIN(X); SBAR(); }while(0)
  #define VRD(i) do{ vlo[i]=vtr(vp_+(((i)>>2)*4096+((i)&3)*1024)); vhi[i]=vtr(vp_+(((i)>>2)*4096+((i)&3)*1024+512)); }while(0)
  #define KRD(G,j) do{ if(G){ kload2(kf,kp0+sl_next,j); SBAR(); } }while(0)
  #define KRDX(G) do{ if(G){ kf[8]=*(const __attribute__((address_space(3))) bf16x8*)(kx0+sl_next); kf[9]=*(const __attribute__((address_space(3))) bf16x8*)(kx0+sl_next+512); SBAR(); } }while(0)
  #define STEP(C0,C1,P0,P1,t,GK,GV,GL) do{ SBAR(); \
    const lds_cptr vp_=vp0+sl_prev; \
    VRD(0); SBAR(); float sacc=(P0[0]+P0[1]); \
    GAPA(C0=__builtin_amdgcn_mfma_f32_32x32x16_bf16(kf[0],qr[0],zf,0,0,0), P0[2],P0[3],P0[4],P0[5],     pw0[0]=PKW(P0,0), pw0[1]=PKW(P0,2), pw0); \
    VRD(4); SBAR(); GAPA(C1=__builtin_amdgcn_mfma_f32_32x32x16_bf16(kf[1],qr[0],zf,0,0,0), P0[6],P0[7],P0[8],P0[9],     pw0[2]=PKW(P0,4), pw0[3]=PKW(P0,6), pw0); \
    VRD(1); SBAR(); GAPA(C0=__builtin_amdgcn_mfma_f32_32x32x16_bf16(kf[2],qr[1],C0,0,0,0),   P0[10],P0[11],P0[12],P0[13], pw1[0]=PKW(P0,8), pw1[1]=PKW(P0,10), pw1); \
    VRD(5); SBAR(); GAPA(C1=__builtin_amdgcn_mfma_f32_32x32x16_bf16(kf[3],qr[1],C1,0,0,0),   P0[14],P0[15],P1[0],P1[1],   pw1[2]=PKW(P0,12),pw1[3]=PKW(P0,14), pw1); \
    VRD(2); SBAR(); GAPA(C0=__builtin_amdgcn_mfma_f32_32x32x16_bf16(kf[4],qr[2],C0,0,0,0),   P1[2],P1[3],P1[4],P1[5],     pw2[0]=PKW(P1,0), pw2[1]=PKW(P1,2), pw2); \
    VRD(6); SBAR(); GAPA(C1=__builtin_amdgcn_mfma_f32_32x32x16_bf16(kf[5],qr[2],C1,0,0,0),   P1[6],P1[7],P1[8],P1[9],     pw2[2]=PKW(P1,4), pw2[3]=PKW(P1,6), pw2); \
    VRD(3); SBAR(); GAPA(C0=__builtin_amdgcn_mfma_f32_32x32x16_bf16(kf[6],qr[3],C0,0,0,0),   P1[10],P1[11],P1[12],P1[13], pw3[0]=PKW(P1,8), pw3[1]=PKW(P1,10), pw3); \
    VRD(7); SBAR(); GAPA(C1=__builtin_amdgcn_mfma_f32_32x32x16_bf16(kf[7],qr[3],C1,0,0,0),   P1[14],P1[15],0.f,0.f,       pw3[2]=PKW(P1,12),pw3[3]=PKW(P1,14), pw3); \
    C0=__builtin_amdgcn_mfma_f32_32x32x16_bf16(kf[8],qr[4],C0,0,0,0); SBAR(); \
    C1=__builtin_amdgcn_mfma_f32_32x32x16_bf16(kf[9],qr[4],C1,0,0,0); SBAR(); \
    l_reg+=sacc; \
    if(GK){DMA_K((t)+3,sl_cur);} if(GV){DMA_V((t)+1,sl_next);} \
    CMASK(C0,C1,t); \
    { float a=MX3(C0[0],C0[1],C1[0]),b=MX3(C0[2],C0[3],C1[1]); a=MX3(a,C1[2],C1[3]); \
      _Pragma("unroll") for(int r=4;r<16;r+=4){a=MX3(a,C0[r],C0[r+1]);b=MX3(b,C0[r+2],C0[r+3]);a=MX3(a,C1[r],C1[r+1]);b=MX3(b,C1[r+2],C1[r+3]);} \
      float rm=__builtin_fmaxf(a,b); { auto rr=__builtin_amdgcn_permlane32_swap(__float_as_uint(rm),__float_as_uint(rm),false,false); rm=__builtin_fmaxf(__uint_as_float(rr[0]),__uint_as_float(rr[1])); } \
      resc=false; \
      if(__builtin_expect(__any(rm>(float)THRL),0)){ MOVEREF(__builtin_fmaxf(rm,0.f)) \
        _Pragma("unroll") for(int r=0;r<16;++r){C0[r]-=dl;C1[r]-=dl;} \
        const float f=__builtin_amdgcn_exp2f(-dl); l_reg*=f; if(hi==0)wsf[r32]=f; resc=true; } } \
    SBAR(); \
    GAPB(o[0]=__builtin_amdgcn_mfma_f32_32x32x16_bf16(PAF(0),VFR(0),o[0],0,0,0), C0,0); \
    GAPB(o[1]=__builtin_amdgcn_mfma_f32_32x32x16_bf16(PAF(0),VFR(4),o[1],0,0,0), C0,4); \
    KRD(GL,0); GAPB(o[0]=__builtin_amdgcn_mfma_f32_32x32x16_bf16(PAF(1),VFR(1),o[0],0,0,0), C0,8); \
    KRD(GL,1); GAPB(o[1]=__builtin_amdgcn_mfma_f32_32x32x16_bf16(PAF(1),VFR(5),o[1],0,0,0), C0,12); \
    KRD(GL,2); GAPB(o[0]=__builtin_amdgcn_mfma_f32_32x32x16_bf16(PAF(2),VFR(2),o[0],0,0,0), C1,0); \
    KRD(GL,3); GAPB(o[1]=__builtin_amdgcn_mfma_f32_32x32x16_bf16(PAF(2),VFR(6),o[1],0,0,0), C1,4); \
    KRDX(GL); GAPB(o[0]=__builtin_amdgcn_mfma_f32_32x32x16_bf16(PAF(3),VFR(3),o[0],0,0,0), C1,8); \
    GAPB(o[1]=__builtin_amdgcn_mfma_f32_32x32x16_bf16(PAF(3),VFR(7),o[1],0,0,0), C1,12); \
    }while(0)
  int t=1;
  for(;t+5<NT&&t+1<band0;t+=2){
    #undef CMASK
    #define CMASK(P0,P1,t) do{}while(0)
    STEP(pB0,pB1,pA0,pA1,t,true,true,true);     WAIT_BAR(3); RESC(); ROT();
    STEP(pA0,pA1,pB0,pB1,t+1,true,true,true);   WAIT_BAR(3); RESC(); ROT();
  }
  #undef CMASK
  #define CMASK(P0,P1,t) do{int jb_=(t)-band0; if(jb_>=0)cmask(P0,P1,jb_,qrel,hi);}while(0)
  #define ENDW(tt) do{ if((tt)+3<NT){WAIT_BAR(3);} else if((tt)+2<NT){WAIT_BAR(1);} else {WAIT_BAR(0);} }while(0)
  for(;t+1<NT;t+=2){
    STEP(pB0,pB1,pA0,pA1,t,(t+3<NT),(t+1<NT),(t+1<NT));       ENDW(t);   RESC(); ROT();
    STEP(pA0,pA1,pB0,pB1,t+1,(t+4<NT),(t+2<NT),(t+2<NT));     ENDW(t+1); RESC(); ROT();
  }
  STEP(pB0,pB1,pA0,pA1,NT-1,false,false,false); RESC();
  { float sacc=pB0[0]+pB0[1]; _Pragma("unroll") for(int r=2;r<16;++r)sacc+=pB0[r]; _Pragma("unroll") for(int r=0;r<16;++r)sacc+=pB1[r]; l_reg+=sacc;
    pw0=(u32x4){PKW(pB0,0),PKW(pB0,2),PKW(pB0,4),PKW(pB0,6)};pw1=(u32x4){PKW(pB0,8),PKW(pB0,10),PKW(pB0,12),PKW(pB0,14)};pw2=(u32x4){PKW(pB1,0),PKW(pB1,2),PKW(pB1,4),PKW(pB1,6)};pw3=(u32x4){PKW(pB1,8),PKW(pB1,10),PKW(pB1,12),PKW(pB1,14)};
    SBAR(); pv(o,vb0+sl_cur,PAF(0),PAF(1),PAF(2),PAF(3)); }
  #undef PKW
  #undef PAF
  #undef VFR
  #undef PIN
  #undef MX3
  #undef GAPA
  #undef GAPB
  #undef EX
  #undef VRD
  #undef KRD
  #undef KRDX
  #undef STEP
  #undef ENDW
  {auto rr=__builtin_amdgcn_permlane32_swap(__float_as_uint(l_reg),__float_as_uint(l_reg),false,false);l_reg=__uint_as_float(rr[0])+__uint_as_float(rr[1]);}
  if(hi==0)wsf[32+r32]=l_reg;asm volatile("s_waitcnt lgkmcnt(0)":::"memory");
  float rli[16];
  #pragma unroll
  for(int r=0;r<16;++r)rli[r]=__builtin_amdgcn_rcpf(wsf[32+crow(r,hi)]);
  if(KIND==1){ if(hi==0&&oslot>=0){ f32x2_t ml={mhat,l_reg}; *(f32x2_t*)(PML+(long)oslot*2)=ml; } }
  { hb16*stg=(hb16*)(shm+LDS_OST)+wid*2048;
    #pragma unroll
    for(int r=0;r<16;++r){const int orow=crow(r,hi);
      #pragma unroll
      for(int d0=0;d0<2;++d0)stg[orow*64+d0*32+r32]=__float2bfloat16(o[d0][r]*rli[r]);}
    asm volatile("s_waitcnt lgkmcnt(0)":::"memory");
    #pragma unroll
    for(int i=0;i<4;++i){const int row=i*8+(lane>>3),ch=lane&7; const u32x4 v=*(const u32x4*)(stg+row*64+ch*8);
      if(KIND==0){ const int gr=__shfl(qrow,row); *(u32x4*)(Oc+(long)gr*PITCH+ch*8)=v; }
      else { const int gs=__shfl(oslot,row); if(gs>=0) *(u32x4*)(PO+(long)gs*64+ch*8)=v; } } }
  asm volatile("s_waitcnt lgkmcnt(0)\n\ts_barrier":::"memory");
  #undef DMA_K
  #undef DMA_V
  #undef CMASK
  #undef START
  #undef RESC
  #undef ROT
  #undef SETQX
  #undef MOVEREF
}
constexpr int ATTN_LDS_BYTES=LDS_BYTES;
#undef SBAR
#undef WAIT_BAR
}

struct WqkOrder {
    int G, c;
    __device__ __forceinline__ bool next(int i, pg8::Unit& u) const { const int L = i * G + c; if (L >= 128) return false; const int z = L >> 2, pn = L & 3, b = z >> 2, h = z & 3;
        u.pm = b * 4 + h; u.pn = pn; u.aoff = ((size_t)(b * 256) * 2048 + h * 256) * 2; u.boff = ((size_t)(pn * 256) * 1024 + h * 256) * 2; return true; }
};
struct VwoOrder {
    int G, c;
    __device__ __forceinline__ bool next(int i, pg8::Unit& u) const { const int L = i * G + c; if (L >= 128) return false; const int z = L >> 2, pmq = L & 3, b = z >> 2, h = z & 3;
        u.pm = b * 4 + pmq; u.pn = h; u.aoff = ((size_t)(pmq * 256) * 1024 + h * 256) * 2; u.boff = ((size_t)(b * 256) * 2048 + 1024 + h * 256) * 2; return true; }
};

#define DECL_PTRS const __attribute__((address_space(4))) Args* KA_; { auto p_ = __builtin_amdgcn_kernarg_segment_ptr(); asm volatile("" : "+s"(p_)); KA_ = (const __attribute__((address_space(4))) Args*)p_; } \
    int tidp_ = threadIdx.x; asm volatile("" : "+v"(tidp_)); const int tid = tidp_, lane = tid & 63; (void)lane; \
    unsigned char* ws = KA_->ws; gu32* ctl = (gu32*)(ws + WS_CTL); const float* x = KA_->in[0]; const float* mem = KA_->in[1]; const float* g_mix = KA_->in[2]; const float* w_in = KA_->in[3]; const float* b_forget = KA_->in[4]; const float* g_fox = KA_->in[5]; const float* g_moba = KA_->in[6]; const float* w_out = KA_->in[7]; const float* g_cross = KA_->in[8]; const float* g_mem = KA_->in[9]; const float* w_q_mem = KA_->in[10]; const float* w_kv_mem = KA_->in[11]; const float* w_o_mem = KA_->in[12]; const float* g_ffn = KA_->in[13]; const float* w_up = KA_->in[14]; const float* conv_w = KA_->in[15]; const float* conv_b = KA_->in[16]; const float* w_down = KA_->in[17]; const float* g_final = KA_->in[18]; float* out = KA_->out; float* LOGF = (float*)(ws + WS_LOGF); float* CC = (float*)(ws + WS_C); float* ABAR = (float*)(ws + WS_ABAR); float* KM = (float*)(ws + WS_KM); unsigned* SEL = (unsigned*)(ws + WS_SEL); float* SSQ1 = (float*)(ws + WS_SSQ1); float* SSQ2 = (float*)(ws + WS_SSQ2); float* SSQ3 = (float*)(ws + WS_SSQ3); bf16* MEMN = (bf16*)(ws + WS_MEMN); bf16* KV = (bf16*)(ws + WS_KV); bf16* WQS = (bf16*)(ws + WS_WQS); bf16* WOT = (bf16*)(ws + WS_WOT); bf16* WKVT = (bf16*)(ws + WS_WKVT); bf16* WINT = (bf16*)(ws + WS_WINT); bf16* WOUTT = (bf16*)(ws + WS_WOUTT); bf16* WUPT = (bf16*)(ws + WS_WUPT); bf16* WDT = (bf16*)(ws + WS_WDT); bf16* ZT = (bf16*)(ws + WS_ZT); bf16* WQK = (bf16*)(ws + WS_WQK); bf16* VWO = (bf16*)(ws + WS_VWO); bf16* A1 = (bf16*)(ws + WS_A1); bf16* QKV = (bf16*)(ws + WS_QKV); bf16* Y = (bf16*)(ws + WS_Y); bf16* HB1 = (bf16*)(ws + WS_HB1); bf16* PB = (bf16*)(ws + WS_P); bf16* HB2 = (bf16*)(ws + WS_HB2); bf16* GB = (bf16*)(ws + WS_G); bf16* UB = (bf16*)(ws + WS_U); bf16* PO = (bf16*)(ws + WS_PO); unsigned* LIST = (unsigned*)(ws + WS_LIST); float* PML = (float*)(ws + WS_PML); bf16* KXF = (bf16*)(ws + WS_KXF); bf16* KXM = (bf16*)(ws + WS_KXM); unsigned* CNT = (unsigned*)(ws + WS_CNT);
__global__ void __launch_bounds__(NWAVES * 64, 2) fwd(Args args) {
    extern __shared__ __attribute__((aligned(16))) unsigned char lds[];
    LAS unsigned char* L = (LAS unsigned char*)lds;
    LAS unsigned char* XL = L + XL_OFF;
    volatile LAS unsigned* MISC = (volatile LAS unsigned*)(L + MISC_OFF);
    const int tid = threadIdx.x, lane = tid & 63, wave = __builtin_amdgcn_readfirstlane(tid >> 6);
    const int G = gridDim.x, bx = blockIdx.x;
    const int gw = bx * NWAVES + wave, NGW = G * NWAVES;
    for (int u = tid; u < (LDS_BYTES - LDSCTL_OFF) / 4; u += NWAVES * 64) ((LAS unsigned*)(L + LDSCTL_OFF))[u] = 0u;
    __syncthreads();
    XcdBarrier bar; { DECL_PTRS; bar = xcd_barrier_post((unsigned*)(ctl + CW_BAR), MISC + 8); }

    { DECL_PTRS;
        LAS float* scr = (LAS float*)(L + RING_OFF + wave * 16384);
        constexpr int I_IN = (D / 64) * (NQKV / 32), I_OUT = (D / 64) * (D / 32), I_KV = (D / 64) * (2048 / 32), I_O = I_OUT, I_UP = (D / 64) * (2 * FF / 32), I_DN = (FF / 64) * (D / 32);
        constexpr int NITEMS = I_IN + I_OUT + I_KV + I_O + I_UP + I_DN;
        for (int it = gw; it < NITEMS; it += NGW) {
            int r = it;
            if (r < I_IN) { p0_transpose_item(w_in, INC, D, NQKV, WINT, nullptr, true, scr, r, lane); continue; } r -= I_IN;
            if (r < I_OUT) { p0_transpose_item(w_out, D, D, D, WOUTT, nullptr, false, scr, r, lane); continue; } r -= I_OUT;
            if (r < I_KV) { p0_transpose_item(w_kv_mem, 2048, D, 2048, WKVT, nullptr, false, scr, r, lane); continue; } r -= I_KV;
            if (r < I_O) { p0_transpose_item(w_o_mem, D, D, D, WOT, nullptr, false, scr, r, lane); continue; } r -= I_O;
            if (r < I_UP) { p0_transpose_item(w_up, 2 * FF, D, 2 * FF, WUPT, g_ffn, false, scr, r, lane); continue; } r -= I_UP;
            p0_transpose_item(w_down, D, FF, D, WDT, nullptr, false, scr, r, lane);
        }
        for (int i = bx * 512 + tid; i < D * D / 4; i += G * 512) { const int kk = (i * 4) >> 10; const f32x4 v = *(const f32x4*)(w_q_mem + (size_t)i * 4) * (g_cross[kk] * (LOG2E / 16.0f));
            *(unsigned long long*)(WQS + (size_t)i * 4) = (unsigned long long)pk2(v[0], v[1]) | ((unsigned long long)pk2(v[2], v[3]) << 32); }
        for (int r = gw; r < NB * 256; r += NGW) { const GAS f32x4* xr = (const GAS f32x4*)(mem + (size_t)r * D) + lane; f32x4 v[4]; float s = 0.f;
#pragma unroll
            for (int j = 0; j < 4; ++j) { v[j] = xr[64 * j]; s += (v[j][0] * v[j][0] + v[j][1] * v[j][1]) + (v[j][2] * v[j][2] + v[j][3] * v[j][3]); }
            const float rs = __builtin_amdgcn_rsqf(wave_sum(s) * (1.f / D) + RMS_EPS);
            GAS unsigned long long* o8 = (GAS unsigned long long*)(MEMN + (size_t)r * D) + lane;
#pragma unroll
            for (int j = 0; j < 4; ++j) { const f32x4 gg = *((const f32x4*)g_mem + 64 * j + lane); const f32x4 a = v[j] * rs * gg; o8[64 * j] = (unsigned long long)pk2(a[0], a[1]) | ((unsigned long long)pk2(a[2], a[3]) << 32); } }
        __syncthreads();
        LAS float* wf = (LAS float*)(L + RING_OFF);
        LAS float* part = (LAS float*)(L + RING_OFF + 32768);
        for (int i = tid; i < 8 * 1024; i += 512) { const int h = i >> 10, kk = i & 1023; wf[i] = w_in[(size_t)kk * INC + C_F + h]; }
        __syncthreads();
        f32x4 gm[4];
#pragma unroll
        for (int j = 0; j < 4; ++j) gm[j] = *((const f32x4*)g_mix + 64 * j + lane);
        for (int blk = bx; blk < M / 256; blk += G) {
            f32x4 accm[4];
#pragma unroll
            for (int j = 0; j < 4; ++j) accm[j] = (f32x4){0.f, 0.f, 0.f, 0.f};
            for (int i = 0; i < 32; ++i) {
                const size_t r = (size_t)blk * 256 + wave * 32 + i;
                const GAS f32x4* xr = (const GAS f32x4*)(x + r * D) + lane; f32x4 v[4]; float s = 0.f;
#pragma unroll
                for (int j = 0; j < 4; ++j) { v[j] = xr[64 * j]; s += (v[j][0] * v[j][0] + v[j][1] * v[j][1]) + (v[j][2] * v[j][2] + v[j][3] * v[j][3]); }
                const float rs = __builtin_amdgcn_rsqf(wave_sum(s) * (1.f / D) + RMS_EPS);
                GAS unsigned long long* o8 = (GAS unsigned long long*)(A1 + r * 2048) + lane;
                float fl[8];
#pragma unroll
                for (int h = 0; h < 8; ++h) fl[h] = 0.f;
#pragma unroll
                for (int j = 0; j < 4; ++j) { const f32x4 a = v[j] * rs * gm[j]; accm[j] += a;
                    const unsigned h0 = pk2(a[0], a[1]), h1 = pk2(a[2], a[3]);
                    o8[64 * j] = (unsigned long long)h0 | ((unsigned long long)h1 << 32);
                    const unsigned l0 = pk2(a[0] - bflo(h0), a[1] - bfhi(h0)), l1 = pk2(a[2] - bflo(h1), a[3] - bfhi(h1));
                    o8[256 + 64 * j] = (unsigned long long)l0 | ((unsigned long long)l1 << 32);
#pragma unroll
                    for (int h = 0; h < 8; ++h) { const f32x4 w = *((const LAS f32x4*)(wf + h * 1024) + 64 * j + lane); fl[h] += (a[0] * w[0] + a[1] * w[1]) + (a[2] * w[2] + a[3] * w[3]); } }
#pragma unroll
                for (int h = 0; h < 8; ++h) fl[h] = wave_sum(fl[h]);
                if (lane < 8) { float z = fl[0];
#pragma unroll
                    for (int h = 1; h < 8; ++h) z = (lane == h) ? fl[h] : z;
                    z += b_forget[lane];
                    LOGF[r * 8 + lane] = fminf(z, 0.f) - log1pf(__expf(-fabsf(z))); }
            }
#pragma unroll
            for (int j = 0; j < 4; ++j) *((LAS f32x4*)(part + wave * 1024) + 64 * j + lane) = accm[j];
            __syncthreads();
            for (int col = tid; col < 1024; col += 512) { float s = 0.f;
#pragma unroll
                for (int w = 0; w < 8; ++w) s += part[w * 1024 + col];
                ABAR[(size_t)blk * 1024 + col] = s * (1.0f / 256.0f); }
            __syncthreads();
        }
    }
    xcd_barrier(bar);

    { DECL_PTRS;
        LAS float* sc = (LAS float*)(L + RING_OFF);
        for (int w = bx; w < 64; w += G) {
            const int b = w >> 3, h = w & 7; float v[16]; float run = 0.f;
#pragma unroll
            for (int i = 0; i < 16; ++i) { run += LOGF[((size_t)b * T + tid * 16 + i) * 8 + h]; v[i] = run; }
            float incl = run;
#pragma unroll
            for (int o = 1; o < 64; o <<= 1) { const float n = __shfl_up(incl, o); if (lane >= o) incl += n; }
            if (lane == 63) sc[wave] = incl;
            __syncthreads();
            float pre = incl - run;
            for (int ww = 0; ww < wave; ++ww) pre += sc[ww];
#pragma unroll
            for (int i = 0; i < 16; ++i) CC[(size_t)w * T + tid * 16 + i] = pre + v[i];
            __syncthreads();
        }
        for (int n = bx; n < 256; n += G) {
            for (int i = tid; i < 1024; i += 512) sc[i] = ABAR[(size_t)n * 1024 + i];
            __syncthreads();
            float s = 0.f;
            for (int kk = 0; kk < 1024; ++kk) s += sc[kk] * w_in[(size_t)kk * INC + C_KM + tid];
            KM[(size_t)n * 512 + tid] = s;
            __syncthreads();
        }
        pg8::Gemm g{MEMN, WKVT, D, D, D, 0xffffffffu}; pg8::TileOrder S; S.init(NB * 256, 2048, G, bx, D, D, 0, 1 << 30);
        pg8::EpiBf16 E{KV, 2048, 0u, 1.f};
        pg8::gemm_phase<pg8::EpiBf16, pg8::TileOrder, true>(L + RING_OFF, XL, g, S, E);
    }
    xcd_barrier(bar);

    { DECL_PTRS;
        LAS float* sc = (LAS float*)(L + RING_OFF);
        for (int n = bx; n < 256; n += G) {
            const int b = n >> 5, nb = n & 31;
            sc[tid] = KM[(size_t)n * 512 + tid];
            __syncthreads();
            f32x4 k0 = *(const LAS f32x4*)(sc + lane * 8), k1 = *(const LAS f32x4*)(sc + lane * 8 + 4);
            for (int i = 0; i < 128; ++i) { const int kk = wave * 128 + i;
                const f32x4 w0 = *(const f32x4*)(w_in + (size_t)kk * INC + C_QM + lane * 8), w1 = *(const f32x4*)(w_in + (size_t)kk * INC + C_QM + lane * 8 + 4);
                float s = (w0[0] * k0[0] + w0[1] * k0[1]) + (w0[2] * k0[2] + w0[3] * k0[3]) + (w1[0] * k1[0] + w1[1] * k1[1]) + (w1[2] * k1[2] + w1[3] * k1[3]);
                s += __shfl_xor(s, 1); s += __shfl_xor(s, 2); s += __shfl_xor(s, 4);
                if ((lane & 7) == 0) { const int h = lane >> 3; const unsigned hi = f2bf(s); const unsigned lo = f2bf(s - bf2f(hi));
                    bf16* zr = ZT + ((size_t)b * 256 + h * 32 + nb) * 3072; zr[kk] = (bf16)hi; zr[1024 + kk] = (bf16)hi; zr[2048 + kk] = (bf16)lo; } }
            __syncthreads();
        }
        for (int i = bx * 512 + tid; i < 64 * T + 8 * 256; i += G * 512) {
            float bv; bf16* dst;
            if (i < 64 * T) { bv = -CC[i] * LOG2E; dst = KXF + (size_t)i * 8; }
            else { const int j = i - 64 * T; bv = __builtin_amdgcn_exp2f(-(float)((j >> 8) + 1)) * LOG2E * (float)(j & 255); dst = KXM + (size_t)j * 8; }
            const unsigned h0 = f2bf(bv); const float r1 = bv - bf2f(h0); const unsigned h1 = f2bf(r1); const unsigned h2 = f2bf(r1 - bf2f(h1));
            *(v4u*)dst = (v4u){h0 | (h1 << 16), h2 | (0x3F80u << 16), 0x3F80u, 0u}; }
        { pg8::Gemm g{KV, WQS, 256, 2048, 1024, 0xffffffffu}; WqkOrder S{G, bx}; pg8::EpiBf16 E{WQK, 1024, 0u, 1.f};
          pg8::gemm_phase<pg8::EpiBf16, WqkOrder, true>(L + RING_OFF, XL, g, S, E); }
        { pg8::Gemm g{WOT, KV, 256, 1024, 2048, 0xffffffffu}; VwoOrder S{G, (bx + 128) % G}; pg8::EpiBf16 E{VWO, 1024, 0u, 1.f};
          pg8::gemm_phase<pg8::EpiBf16, VwoOrder, true>(L + RING_OFF, XL, g, S, E); }
    }
    xcd_barrier(bar);

    { DECL_PTRS;
        { pg8::Gemm g{A1, WINT, D, 2048, D, 0xffffffffu}; pg8::TileOrder S; S.init(M, NQKV, G, bx, 2048, D, 0, 1 << 30);
          pg8::EpiBf16 E{QKV, NQKV, 0xC3u, C2};
          pg8::gemm_phase<pg8::EpiBf16, pg8::TileOrder, true>(L + RING_OFF, XL, g, S, E); }
        { pg8::Gemm g{A1, ZT, 3072, 2048, 3072, 2047u}; pg8::TileOrder S; S.init(M, 256, G, bx, 2048, 3072, (size_t)256 * 3072, 32);
          pg8::EpiGate E{SEL};
          pg8::gemm_phase<pg8::EpiGate, pg8::TileOrder, true>(L + RING_OFF, XL, g, S, E); }
    }
    xcd_barrier(bar);

    { DECL_PTRS;
        for (int blk = bx; blk < M / 256; blk += G) { const int b = blk >> 5; float qm = 0.f, km = 0.f;
            for (int i0 = 0; i0 < 32; i0 += 4) { v4u qw[4], kw[4];
#pragma unroll
                for (int j = 0; j < 4; ++j) { const size_t r = (size_t)blk * 256 + wave * 32 + i0 + j; qw[j] = *((const v4u*)(QKV + r * NQKV) + lane); kw[j] = *((const v4u*)(QKV + r * NQKV + 512) + lane); }
#pragma unroll
                for (int j = 0; j < 4; ++j) { const unsigned qq[4] = {qw[j].x, qw[j].y, qw[j].z, qw[j].w}, kk2[4] = {kw[j].x, kw[j].y, kw[j].z, kw[j].w}; float sq = 0.f, sk = 0.f;
#pragma unroll
                    for (int e = 0; e < 4; ++e) { sq += bflo(qq[e]) * bflo(qq[e]) + bfhi(qq[e]) * bfhi(qq[e]); sk += bflo(kk2[e]) * bflo(kk2[e]) + bfhi(kk2[e]) * bfhi(kk2[e]); }
                    sq += __shfl_xor(sq, 1); sq += __shfl_xor(sq, 2); sq += __shfl_xor(sq, 4); sk += __shfl_xor(sk, 1); sk += __shfl_xor(sk, 2); sk += __shfl_xor(sk, 4);
                    qm = fmaxf(qm, sq); km = fmaxf(km, sk); } }
            if ((lane & 7) == 0) { unsigned* qk = (unsigned*)(ctl + CW_QKN) + (b * 8 + (lane >> 3)) * 2; atomicMax(qk, __float_as_uint(qm)); atomicMax(qk + 1, __float_as_uint(km)); } }
        LAS unsigned* wc = (LAS unsigned*)(L + RING_OFF);
        for (int w = bx; w < 2048; w += G) {
            const int bh = (w & 255) >> 2, n = (w & 3) + 4 * (w >> 8), trip = bh * 32 + n; const unsigned* selrow = SEL + (size_t)bh * T; unsigned base = 0u;
            for (int t0 = (n + 1) * 256; t0 < T; t0 += 2048) {
                unsigned m[4]; unsigned long long bal[4];
#pragma unroll
                for (int j = 0; j < 4; ++j) { const int t = t0 + j * 512 + tid; m[j] = 0u; if (t < T) m[j] = selrow[t]; }
#pragma unroll
                for (int j = 0; j < 4; ++j) { bal[j] = __ballot((m[j] >> n) & 1u); if (lane == 0) wc[j * 8 + wave] = (unsigned)__popcll(bal[j]); }
                __syncthreads();
                unsigned run = base;
#pragma unroll
                for (int j = 0; j < 4; ++j) { unsigned pre = 0u, tot = 0u;
#pragma unroll
                    for (int ww = 0; ww < 8; ++ww) { const unsigned c = wc[j * 8 + ww]; tot += c; if (ww < wave) pre += c; }
                    if ((m[j] >> n) & 1u) { const unsigned pos = run + pre + (unsigned)__popcll(bal[j] & ((1ull << lane) - 1ull)); const unsigned k = (unsigned)__popc(m[j] & ((1u << n) - 1u));
                        LIST[(size_t)trip * 8192 + pos] = (unsigned)(t0 + j * 512 + tid) | (k << 16); }
                    run += tot; }
                base = run;
                __syncthreads();
            }
            if (tid == 0) CNT[trip] = base;
        }
    }
    xcd_barrier(bar);

    { DECL_PTRS;
        LAS int* upre = (LAS int*)(L + RING_OFF + attn_body::ATTN_LDS_BYTES);
        LAS int* wsum = upre + 2052;
        { int c4[4]; int run = 0;
#pragma unroll
          for (int i = 0; i < 4; ++i) { c4[i] = run; run += (int)((CNT[tid * 4 + i] + 255u) >> 8); }
          int incl = run;
#pragma unroll
          for (int o = 1; o < 64; o <<= 1) { const int nn = __shfl_up(incl, o); if (lane >= o) incl += nn; }
          if (lane == 63) wsum[wave] = incl;
          __syncthreads();
          int pre = incl - run;
          for (int ww = 0; ww < wave; ++ww) pre += wsum[ww];
#pragma unroll
          for (int i = 0; i < 4; ++i) upre[tid * 4 + i] = pre + c4[i];
          if (tid == 511) upre[2048] = pre + run;
          __syncthreads(); }
        LAS int* t0tab = wsum + 16;
        if (tid < 64) { const int u = bx + tid * G; if (u < 2048) {
            const int i = u >> 8, v = u & 255, bh = (i >> 2) * 32 + (v >> 3), sdeal = v & 7, ii = i & 3, qb = ii == 0 ? sdeal : ii == 1 ? 15 - sdeal : ii == 2 ? 16 + sdeal : 31 - sdeal;
            const unsigned* qk = (const unsigned*)(ctl + CW_QKN) + bh * 2;
            const float qn = sqrtf(__uint_as_float(__hip_atomic_load(qk, RLX_AGENT))), kn = sqrtf(__uint_as_float(__hip_atomic_load(qk + 1, RLX_AGENT)));
            const float thr = (2.0f * qn * kn * 1.01f + 40.0f) * (1.0f / LOG2E);
            const float* crow_ = CC + (size_t)bh * T; const int t0 = qb * 256; const float target = crow_[t0] + thr;
            int lo = 0, hi2 = t0;
            while (lo < hi2) { const int mid = (lo + hi2) >> 1; if (crow_[mid] >= target) lo = mid + 1; else hi2 = mid; }
            t0tab[tid] = (lo >> 6) & ~1; } }
        __syncthreads();
        const int ntot = 4096 + upre[2048];
        const attn_body::hb16* Qb = (const attn_body::hb16*)QKV;
        const int r32 = lane & 31;
        for (int u = bx; u < ntot; u += G) {
            int kind, qrow, oslot = -1, NT, band0; const attn_body::hb16 *Qc, *Kt0, *Vt0, *KXt0;
            if (u < 2048) {
                const int i = u >> 8, v = u & 255, bh = (i >> 2) * 32 + (v >> 3), s = v & 7, ii = i & 3, qb = ii == 0 ? s : ii == 1 ? 15 - s : ii == 2 ? 16 + s : 31 - s;
                const int b = bh >> 3, h = bh & 7;
                const int T0 = t0tab[(u - bx) / G];
                kind = 0; qrow = b * T + qb * 256 + wave * 32 + r32; NT = 4 * (qb + 1) - T0; band0 = NT - 4;
                Qc = Qb + h * 64; Kt0 = Qb + (size_t)(b * T + T0 * 64) * NQKV + 512 + h * 64; Vt0 = Kt0 + 512; KXt0 = (const attn_body::hb16*)KXF + ((size_t)bh * T + T0 * 64) * 8;
            } else if (u < 4096) {
                const int w = u - 2048, bh = w >> 5, j = w & 31, b = bh >> 3, h = bh & 7;
                kind = 1; qrow = b * T + j * 256 + wave * 32 + r32; oslot = (qrow * 8 + h) * 4 + 3; NT = 4; band0 = 0;
                Qc = Qb + 1536 + h * 64; Kt0 = Qb + (size_t)(b * T + j * 256) * NQKV + 2048 + h * 64; Vt0 = Kt0 + 512; KXt0 = (const attn_body::hb16*)KXM + h * 256 * 8;
            } else {
                const int g = u - 4096; int lo = 0, hi2 = 2048;
                while (hi2 - lo > 1) { const int mid = (lo + hi2) >> 1; if (upre[mid] <= g) lo = mid; else hi2 = mid; }
                const int w = lo, c = g - upre[lo], bh = w >> 5, n = w & 31, b = bh >> 3, h = bh & 7; const int cnt = (int)CNT[w];
                int idx = c * 256 + wave * 32 + r32; const bool valid = idx < cnt; if (!valid) idx = cnt - 1;
                const unsigned e = LIST[(size_t)w * 8192 + idx];
                kind = 1; qrow = b * T + (int)(e & 0xffffu); oslot = valid ? (qrow * 8 + h) * 4 + (int)(e >> 16) : -1; NT = 4; band0 = 1 << 20;
                Qc = Qb + 1536 + h * 64; Kt0 = Qb + (size_t)(b * T + n * 256) * NQKV + 2048 + h * 64; Vt0 = Kt0 + 512; KXt0 = (const attn_body::hb16*)KXM + h * 256 * 8;
            }
            attn_body::attn_unit<8>((char*)lds + RING_OFF, kind, Qc, qrow, oslot, Kt0, Vt0, KXt0, NT, band0, (attn_body::hb16*)QKV + (Qc - Qb), (attn_body::hb16*)PO, PML);
        }
    }
    xcd_barrier(bar);

    { DECL_PTRS;
    for (int r = gw; r < M; r += NGW) {
        const v4u wa = *((const v4u*)(QKV + (size_t)r * NQKV) + lane);
        float a[8] = {bflo(wa.x), bfhi(wa.x), bflo(wa.y), bfhi(wa.y), bflo(wa.z), bfhi(wa.z), bflo(wa.w), bfhi(wa.w)};
        float c[8];
        { const int h = lane >> 3, cc = lane & 7, b = r >> 13, t = r & (T - 1), own = t >> 8;
          unsigned mm = SEL[((size_t)(b * 8 + h)) * T + t]; const int cnt = __popc(mm);
          const float s2 = __builtin_amdgcn_exp2f(-(float)(h + 1)) * LOG2E * 256.0f;
          const size_t sb = ((size_t)r * 8 + h) * 4;
          float mk[4], lk[4]; v4u pw[4];
#pragma unroll
          for (int k = 0; k < 4; ++k) { const pg8::f32x2 ml = *(const pg8::f32x2*)(PML + (sb + k) * 2); mk[k] = ml.x; lk[k] = ml.y; pw[k] = *((const v4u*)(PO + (sb + k) * 64) + cc); }
          mk[3] += s2 * (float)own; float Mx = mk[3];
#pragma unroll
          for (int k = 0; k < 3; ++k) { if (k < cnt) { const int nb = __ffs(mm) - 1; mm &= mm - 1u; mk[k] += s2 * (float)nb; Mx = fmaxf(Mx, mk[k]); } }
          float W = 0.f;
#pragma unroll
          for (int i = 0; i < 8; ++i) c[i] = 0.f;
#pragma unroll
          for (int k = 0; k < 4; ++k) { if (k == 3 || k < cnt) { const float w = lk[k] * __builtin_amdgcn_exp2f(mk[k] - Mx); W += w;
              c[0] += w * bflo(pw[k].x); c[1] += w * bfhi(pw[k].x); c[2] += w * bflo(pw[k].y); c[3] += w * bfhi(pw[k].y); c[4] += w * bflo(pw[k].z); c[5] += w * bfhi(pw[k].z); c[6] += w * bflo(pw[k].w); c[7] += w * bfhi(pw[k].w); } }
          const float iw = 1.0f / W;
#pragma unroll
          for (int i = 0; i < 8; ++i) c[i] *= iw; }
        float sa = 0.f, sb2 = 0.f;
#pragma unroll
        for (int i = 0; i < 8; ++i) { sa += a[i] * a[i]; sb2 += c[i] * c[i]; }
        const float ra = __builtin_amdgcn_rsqf(wave_sum(sa) * (1.f / 512.f) + RMS_EPS), rb = __builtin_amdgcn_rsqf(wave_sum(sb2) * (1.f / 512.f) + RMS_EPS);
        const f32x4 ga0 = *((const f32x4*)g_fox + 2 * lane), ga1 = *((const f32x4*)g_fox + 2 * lane + 1), gb0 = *((const f32x4*)g_moba + 2 * lane), gb1 = *((const f32x4*)g_moba + 2 * lane + 1);
        v4u oa, ob;
        oa.x = pk2(a[0] * ra * ga0[0], a[1] * ra * ga0[1]); oa.y = pk2(a[2] * ra * ga0[2], a[3] * ra * ga0[3]); oa.z = pk2(a[4] * ra * ga1[0], a[5] * ra * ga1[1]); oa.w = pk2(a[6] * ra * ga1[2], a[7] * ra * ga1[3]);
        ob.x = pk2(c[0] * rb * gb0[0], c[1] * rb * gb0[1]); ob.y = pk2(c[2] * rb * gb0[2], c[3] * rb * gb0[3]); ob.z = pk2(c[4] * rb * gb1[0], c[5] * rb * gb1[1]); ob.w = pk2(c[6] * rb * gb1[2], c[7] * rb * gb1[3]);
        *((v4u*)(Y + (size_t)r * D) + lane) = oa; *((v4u*)(Y + (size_t)r * D + 512) + lane) = ob;
    } }
    xcd_barrier(bar);

    { DECL_PTRS; pg8::Gemm g{Y, WOUTT, D, D, D, 0xffffffffu}; pg8::TileOrder S; S.init(M, D, G, bx, D, D, 0, 1 << 30);
      pg8::EpiRes E{x, out, HB1, SSQ1};
      pg8::gemm_phase<pg8::EpiRes, pg8::TileOrder, true>(L + RING_OFF, XL, g, S, E); }
    xcd_barrier(bar);

    { DECL_PTRS; pg8::Gemm g{HB1, WQK, D, D, D, 0xffffffffu}; pg8::TileOrder S; S.init(M, D, G, bx, D, D, (size_t)D * D, 32);
      pg8::EpiSoftmax E{PB, SSQ1};
      pg8::gemm_phase<pg8::EpiSoftmax, pg8::TileOrder, true>(L + RING_OFF, XL, g, S, E); }
    xcd_barrier(bar);

    { DECL_PTRS; pg8::Gemm g{PB, VWO, D, D, D, 0xffffffffu}; pg8::TileOrder S; S.init(M, D, G, bx, D, D, (size_t)D * D, 32);
      pg8::EpiRes E{out, out, HB2, SSQ2};
      pg8::gemm_phase<pg8::EpiRes, pg8::TileOrder, true>(L + RING_OFF, XL, g, S, E); }
    xcd_barrier(bar);

    { DECL_PTRS; pg8::Gemm g{HB2, WUPT, D, D, D, 0xffffffffu}; pg8::TileOrder S; S.init(M, 2 * FF, G, bx, D, D, 0, 1 << 30);
      pg8::EpiUp E{GB, UB, SSQ2};
      pg8::gemm_phase<pg8::EpiUp, pg8::TileOrder, true>(L + RING_OFF, XL, g, S, E); }
    xcd_barrier(bar);

    { DECL_PTRS;
    for (int it = bx * 512 + tid; it < (M / 32) * (FF / 8); it += G * 512) {
        const int rc = it / (FF / 8), cg = (it - rc * (FF / 8)) * 8; const size_t r0 = (size_t)rc * 32; const int tt0 = (int)(r0 & (T - 1));
        float w0[8], w1[8], w2[8], cb[8], g0[8], g1[8];
#pragma unroll
        for (int q = 0; q < 2; ++q) { const f32x4 a0 = *(const f32x4*)(conv_w + cg + 4 * q), a1 = *(const f32x4*)(conv_w + FF + cg + 4 * q), a2 = *(const f32x4*)(conv_w + 2 * FF + cg + 4 * q), bb = *(const f32x4*)(conv_b + cg + 4 * q);
#pragma unroll
            for (int e = 0; e < 4; ++e) { w0[4 * q + e] = a0[e]; w1[4 * q + e] = a1[e]; w2[4 * q + e] = a2[e]; cb[4 * q + e] = bb[e]; } }
        if (tt0 >= 2) { const v4u p1 = *(const v4u*)(GB + (r0 - 1) * FF + cg), p0 = *(const v4u*)(GB + (r0 - 2) * FF + cg);
            g1[0] = bflo(p1.x); g1[1] = bfhi(p1.x); g1[2] = bflo(p1.y); g1[3] = bfhi(p1.y); g1[4] = bflo(p1.z); g1[5] = bfhi(p1.z); g1[6] = bflo(p1.w); g1[7] = bfhi(p1.w);
            g0[0] = bflo(p0.x); g0[1] = bfhi(p0.x); g0[2] = bflo(p0.y); g0[3] = bfhi(p0.y); g0[4] = bflo(p0.z); g0[5] = bfhi(p0.z); g0[6] = bflo(p0.w); g0[7] = bfhi(p0.w); }
        else {
#pragma unroll
            for (int e = 0; e < 8; ++e) { g0[e] = 0.f; g1[e] = 0.f; } }
#pragma unroll 4
        for (int i = 0; i < 32; ++i) { const size_t off = (r0 + i) * FF + cg;
            const v4u gw2 = *(const v4u*)(GB + off), uw = *(const v4u*)(UB + off);
            const float g2[8] = {bflo(gw2.x), bfhi(gw2.x), bflo(gw2.y), bfhi(gw2.y), bflo(gw2.z), bfhi(gw2.z), bflo(gw2.w), bfhi(gw2.w)};
            const float uu[8] = {bflo(uw.x), bfhi(uw.x), bflo(uw.y), bfhi(uw.y), bflo(uw.z), bfhi(uw.z), bflo(uw.w), bfhi(uw.w)};
            float res[8];
#pragma unroll
            for (int e = 0; e < 8; ++e) { const float gc = cb[e] + w0[e] * g0[e] + w1[e] * g1[e] + w2[e] * g2[e];
                res[e] = gc * __builtin_amdgcn_rcpf(1.0f + __builtin_amdgcn_exp2f(-LOG2E * gc)) * uu[e]; g0[e] = g1[e]; g1[e] = g2[e]; }
            *(v4u*)(UB + off) = (v4u){pk2(res[0], res[1]), pk2(res[2], res[3]), pk2(res[4], res[5]), pk2(res[6], res[7])}; }
    } }
    xcd_barrier(bar);

    { DECL_PTRS; pg8::Gemm g{UB, WDT, FF, FF, FF, 0xffffffffu}; pg8::TileOrder S; S.init(M, D, G, bx, FF, FF, 0, 1 << 30);
      pg8::EpiRes E{out, out, nullptr, SSQ3};
      pg8::gemm_phase<pg8::EpiRes, pg8::TileOrder, true>(L + RING_OFF, XL, g, S, E); }
    xcd_barrier(bar);

    { DECL_PTRS;
    for (int r = gw; r < M; r += NGW) {
        const float rs = pg8::rstd_from_slots(SSQ3 + (size_t)r * 16);
        GAS f32x4* o = (GAS f32x4*)(out + (size_t)r * D) + lane;
#pragma unroll
        for (int j = 0; j < 4; ++j) { const f32x4 gg = *((const f32x4*)g_final + 64 * j + lane); o[64 * j] = o[64 * j] * rs * gg; }
    } }
}

extern "C" void kernel_launch(void* const* d_in, const int* in_sizes, int n_in, void* d_out, int out_size, void* d_ws, size_t ws_size, hipStream_t stream) {
    static int grid = 0;
    if (grid == 0) {
        if (n_in != 19 || in_sizes[0] != M * D || out_size != M * D || ws_size < WS_END) { fprintf(stderr, "kernel_launch: unexpected problem shape (n_in %d, in0 %d, out %d, ws %zu); nothing launched\n", n_in, n_in > 0 ? in_sizes[0] : -1, out_size, ws_size); grid = -1; return; }
        int dev = 0, cus = 0, per_cu = 0;
        if (hipGetDevice(&dev) != hipSuccess || hipDeviceGetAttribute(&cus, hipDeviceAttributeMultiprocessorCount, dev) != hipSuccess) { grid = -1; return; }
        if (hipFuncSetAttribute((const void*)fwd, hipFuncAttributeMaxDynamicSharedMemorySize, LDS_BYTES) != hipSuccess) { fprintf(stderr, "kernel_launch: hipFuncSetAttribute failed\n"); grid = -1; return; }
        if (hipOccupancyMaxActiveBlocksPerMultiprocessor(&per_cu, (const void*)fwd, NWAVES * 64, LDS_BYTES) != hipSuccess || per_cu < 1) { fprintf(stderr, "kernel_launch: occupancy query reports %d\n", per_cu); }
        (void)hipGetLastError();
        grid = cus;
    }
    if (grid < 0) return;
    if (hipMemsetAsync((char*)d_ws + WS_CTL, 0, CTL_ZERO_BYTES, stream) != hipSuccess) return;
    Args a{};
    for (int i = 0; i < 19; ++i) a.in[i] = (const float*)d_in[i];
    a.out = (float*)d_out; a.ws = (unsigned char*)d_ws;
    hipLaunchKernelGGL(fwd, dim3(grid), dim3(NWAVES * 64), LDS_BYTES, stream, a);
}
```

```cpp
#include <hip/hip_runtime.h>
#include <hip/hip_bf16.h>
#include <cstdio>
#include <cstdint>

namespace pg8 {
#define PG8_LAS __attribute__((address_space(3)))
typedef unsigned short bf16_t;
typedef short bf16x8 __attribute__((ext_vector_type(8)));
typedef float f32x4 __attribute__((ext_vector_type(4)));
typedef float f32x2 __attribute__((ext_vector_type(2)));
typedef unsigned u32x4 __attribute__((ext_vector_type(4)));
typedef unsigned u32x2 __attribute__((ext_vector_type(2)));
typedef int i32x4 __attribute__((ext_vector_type(4)));
typedef int i32x8 __attribute__((ext_vector_type(8)));
constexpr int BM = 256, BK = 64, HALF = 128, HTB = HALF * BK * 2  , STAGE_BYTES = 8 * HTB, NXCD = 8, WGM = 8;

__host__ __device__ __forceinline__ int lds_byte(int r, int c) { const int st = (r >> 4) * 2 + (c >> 5), rr = r & 15, cc = c & 31, ob = rr * 64 + cc * 2; return st * 1024 + (ob ^ (((ob >> 9) & 1) << 5)); }
__host__ __device__ __forceinline__ void stage_rc(int b, int& R, int& C) { const int st = b / 1024, sb = b % 1024, swz = sb ^ (((sb >> 9) & 1) << 5); R = (st >> 1) * 16 + swz / 64; C = (st & 1) * 32 + (swz % 64) / 2; }
__host__ __device__ __forceinline__ int perm32(int rho) { const int n = rho >> 4, i = rho & 15; return 8 * (i >> 2) + 4 * n + (i & 3); }

struct Unit { int pm, pn; size_t aoff, boff; };
struct Gemm { const void* A; const void* Bt; int nt, lda, ldb; unsigned wrapmask; };

struct TileOrder {
    int nM, nN, nwg, G, c; size_t a_tile, b_tile, b_batch; int pmb;
    __device__ __forceinline__ void init(int M, int N, int G_, int c_, int lda_bytes, int ldb_bytes, size_t b_batch_bytes, int pm_per_batch) {
        nM = M / BM; nN = N / BM; nwg = nM * nN; G = G_; c = c_; a_tile = (size_t)BM * lda_bytes; b_tile = (size_t)BM * ldb_bytes; b_batch = b_batch_bytes; pmb = pm_per_batch; }
    __device__ __forceinline__ bool next(int i, Unit& u) const {
        const long L = (long)i * G + c; if (L >= nwg) return false;
        int wgid = (int)L; { const int q = nwg / NXCD, r = nwg % NXCD, xcd = wgid % NXCD, off = wgid / NXCD; wgid = (xcd < r ? xcd * (q + 1) : r * (q + 1) + (xcd - r) * q) + off; }
        const int nig = WGM * nN, gid = wgid / nig, fm = gid * WGM, gsz = (nM - fm) < WGM ? (nM - fm) : WGM;
        u.pm = fm + ((wgid % nig) % gsz); u.pn = (wgid % nig) / gsz;
        u.aoff = (size_t)u.pm * a_tile; u.boff = (size_t)u.pn * b_tile + (size_t)(u.pm / pmb) * b_batch; return true;
    }
};

__device__ __forceinline__ unsigned cvt_pk_bf16(float lo, float hi) { unsigned r; asm volatile("v_cvt_pk_bf16_f32 %0, %1, %2" : "=v"(r) : "v"(lo), "v"(hi)); return r; }

typedef f32x4 AccT[2][2][4][2];

struct EpiBf16 {
    static constexpr bool PERM = true;
    bf16_t* O; int ldc; unsigned scalemask; float scale0; unsigned* nrm;
    __device__ __forceinline__ void operator()(AccT& acc, const Unit& u, int wr, int wc, int fr, int fq, PG8_LAS unsigned char*) const {
        const int row0 = u.pm * BM + wr * 64 + fr, col0 = u.pn * BM + wc * 32 + 8 * fq;
        const float sc = ((scalemask >> u.pn) & 1u) ? scale0 : 1.f;
        if (nrm && u.pn < 4) {
#pragma unroll
            for (int bj = 0; bj < 2; ++bj) { float mx = 0.f;
#pragma unroll
                for (int ai = 0; ai < 2; ++ai)
#pragma unroll
                    for (int m = 0; m < 4; ++m) { const f32x4 v0 = acc[ai][bj][m][0] * sc, v1 = acc[ai][bj][m][1] * sc;
                        float q = (v0[0] * v0[0] + v0[1] * v0[1]) + (v0[2] * v0[2] + v0[3] * v0[3]) + (v1[0] * v1[0] + v1[1] * v1[1]) + (v1[2] * v1[2] + v1[3] * v1[3]);
                        q += __shfl_xor(q, 16); q += __shfl_xor(q, 32); mx = fmaxf(mx, q); }
                mx = fmaxf(mx, __shfl_xor(mx, 1)); mx = fmaxf(mx, __shfl_xor(mx, 2)); mx = fmaxf(mx, __shfl_xor(mx, 4)); mx = fmaxf(mx, __shfl_xor(mx, 8));
                if (fr == 0 && fq == 0) { const int head = (u.pn & 1) * 4 + 2 * bj + (wc >> 1); atomicMax(nrm + (((u.pm >> 5) * 8 + head) * 2 + (u.pn >> 1)) * 2 + (wc & 1), __float_as_uint(mx)); } } }
#pragma unroll
        for (int ai = 0; ai < 2; ++ai)
#pragma unroll
            for (int m = 0; m < 4; ++m) { bf16_t* rowp = O + (size_t)(row0 + ai * HALF + m * 16) * ldc + col0;
#pragma unroll
                for (int bj = 0; bj < 2; ++bj) { const f32x4 v0 = acc[ai][bj][m][0] * sc, v1 = acc[ai][bj][m][1] * sc;
                    u32x4 w; w.x = cvt_pk_bf16(v0[0], v0[1]); w.y = cvt_pk_bf16(v0[2], v0[3]); w.z = cvt_pk_bf16(v1[0], v1[1]); w.w = cvt_pk_bf16(v1[2], v1[3]);
                    *(u32x4*)(rowp + bj * HALF) = w; } }
    }
};
__device__ __forceinline__ unsigned pk4_fp8(float a, float b, float c, float d) { int w = 0; w = __builtin_amdgcn_cvt_pk_fp8_f32(a, b, w, false); w = __builtin_amdgcn_cvt_pk_fp8_f32(c, d, w, true); return (unsigned)w; }
struct EpiF8 {
    static constexpr bool PERM = true;
    unsigned char* O; int ldc; float sc;
    __device__ __forceinline__ void operator()(AccT& acc, const Unit& u, int wr, int wc, int fr, int fq, PG8_LAS unsigned char*) const {
        const int row0 = u.pm * BM + wr * 64 + fr, col0 = u.pn * BM + wc * 32 + 8 * fq;
#pragma unroll
        for (int ai = 0; ai < 2; ++ai)
#pragma unroll
            for (int m = 0; m < 4; ++m) { unsigned char* rowp = O + (size_t)(row0 + ai * HALF + m * 16) * ldc + col0;
#pragma unroll
                for (int bj = 0; bj < 2; ++bj) { const f32x4 v0 = acc[ai][bj][m][0] * sc, v1 = acc[ai][bj][m][1] * sc;
                    *(u32x2*)(rowp + bj * HALF) = (u32x2){pk4_fp8(v0[0], v0[1], v0[2], v0[3]), pk4_fp8(v1[0], v1[1], v1[2], v1[3])}; } }
    }
};
__device__ __forceinline__ float rstd_from_slots(const float* slots) {
    const f32x4 a = *(const f32x4*)slots, b = *(const f32x4*)(slots + 4), c = *(const f32x4*)(slots + 8), d = *(const f32x4*)(slots + 12);
    const float s = ((a[0] + a[1]) + (a[2] + a[3])) + ((b[0] + b[1]) + (b[2] + b[3])) + ((c[0] + c[1]) + (c[2] + c[3])) + ((d[0] + d[1]) + (d[2] + d[3]));
    return __builtin_amdgcn_rsqf(s * (1.0f / 1024.0f) + 1e-6f);
}
struct EpiUp {
    static constexpr bool PERM = true;
    bf16_t* Gb; bf16_t* Ub; const float* ssq;
    __device__ __forceinline__ void operator()(AccT& acc, const Unit& u, int wr, int wc, int fr, int fq, PG8_LAS unsigned char*) const {
        const int row0 = u.pm * BM + wr * 64 + fr; const int pn = u.pn >= 11 ? u.pn - 11 : u.pn; bf16_t* base = u.pn >= 11 ? Ub : Gb;
        const int col0 = pn * BM + wc * 32 + 8 * fq;
#pragma unroll
        for (int ai = 0; ai < 2; ++ai)
#pragma unroll
            for (int m = 0; m < 4; ++m) { const int row = row0 + ai * HALF + m * 16; const float rs = rstd_from_slots(ssq + (size_t)row * 16); bf16_t* rowp = base + (size_t)row * 2816 + col0;
#pragma unroll
                for (int bj = 0; bj < 2; ++bj) { const f32x4 v0 = acc[ai][bj][m][0] * rs, v1 = acc[ai][bj][m][1] * rs;
                    u32x4 w; w.x = cvt_pk_bf16(v0[0], v0[1]); w.y = cvt_pk_bf16(v0[2], v0[3]); w.z = cvt_pk_bf16(v1[0], v1[1]); w.w = cvt_pk_bf16(v1[2], v1[3]);
                    *(u32x4*)(rowp + bj * HALF) = w; } }
    }
};
struct EpiRes {
    static constexpr bool PERM = true;
    const float* base; float* out; bf16_t* hb; unsigned char* hb8; float* ssq; float accs;
    __device__ __forceinline__ void operator()(AccT& acc, const Unit& u, int wr, int wc, int fr, int fq, PG8_LAS unsigned char*) const {
        const int row0 = u.pm * BM + wr * 64 + fr, col0 = u.pn * BM + wc * 32 + 8 * fq;
#pragma unroll
        for (int ai = 0; ai < 2; ++ai)
#pragma unroll
            for (int m = 0; m < 4; ++m) { const int row = row0 + ai * HALF + m * 16; const size_t off = (size_t)row * 1024 + col0; float q = 0.f;
#pragma unroll
                for (int bj = 0; bj < 2; ++bj) {
                    const f32x4 b0 = *(const f32x4*)(base + off + bj * HALF), b1 = *(const f32x4*)(base + off + bj * HALF + 4);
                    const f32x4 v0 = acc[ai][bj][m][0] * accs + b0, v1 = acc[ai][bj][m][1] * accs + b1;
                    *(f32x4*)(out + off + bj * HALF) = v0; *(f32x4*)(out + off + bj * HALF + 4) = v1;
                    q += (v0[0] * v0[0] + v0[1] * v0[1]) + (v0[2] * v0[2] + v0[3] * v0[3]) + (v1[0] * v1[0] + v1[1] * v1[1]) + (v1[2] * v1[2] + v1[3] * v1[3]);
                    if (hb) { u32x4 w; w.x = cvt_pk_bf16(v0[0], v0[1]); w.y = cvt_pk_bf16(v0[2], v0[3]); w.z = cvt_pk_bf16(v1[0], v1[1]); w.w = cvt_pk_bf16(v1[2], v1[3]); *(u32x4*)(hb + off + bj * HALF) = w; }
                    if (hb8) *(u32x2*)(hb8 + off + bj * HALF) = (u32x2){pk4_fp8(v0[0], v0[1], v0[2], v0[3]), pk4_fp8(v1[0], v1[1], v1[2], v1[3])}; }
                q += __shfl_xor(q, 16); q += __shfl_xor(q, 32);
                if (fq == 0) ssq[(size_t)row * 16 + u.pn * 4 + wc] = q; }
    }
};
struct EpiSoftmax {
    static constexpr bool PERM = true;
    unsigned char* P; const float* ssq; float sscale;
    __device__ __forceinline__ void operator()(AccT& acc, const Unit& u, int wr, int wc, int fr, int fq, PG8_LAS unsigned char* xl) const {
        PG8_LAS f32x2* X = (PG8_LAS f32x2*)xl;
        const int row0 = u.pm * BM + wr * 64 + fr, col0 = u.pn * BM + wc * 32 + 8 * fq;
        float ml[2][4];
#pragma unroll
        for (int ai = 0; ai < 2; ++ai)
#pragma unroll
            for (int m = 0; m < 4; ++m) { const int row = row0 + ai * HALF + m * 16; const float rs = rstd_from_slots(ssq + (size_t)row * 16) * sscale;
                float mx = -3.0e38f;
#pragma unroll
                for (int bj = 0; bj < 2; ++bj)
#pragma unroll
                    for (int n = 0; n < 2; ++n) { f32x4 v = acc[ai][bj][m][n] * rs; acc[ai][bj][m][n] = v; mx = fmaxf(fmaxf(mx, fmaxf(v[0], v[1])), fmaxf(v[2], v[3])); }
                mx = fmaxf(mx, __shfl_xor(mx, 16)); mx = fmaxf(mx, __shfl_xor(mx, 32));
                float s = 0.f;
#pragma unroll
                for (int bj = 0; bj < 2; ++bj)
#pragma unroll
                    for (int n = 0; n < 2; ++n) { f32x4 v = acc[ai][bj][m][n];
                        v[0] = __builtin_amdgcn_exp2f(v[0] - mx); v[1] = __builtin_amdgcn_exp2f(v[1] - mx); v[2] = __builtin_amdgcn_exp2f(v[2] - mx); v[3] = __builtin_amdgcn_exp2f(v[3] - mx);
                        acc[ai][bj][m][n] = v; s += (v[0] + v[1]) + (v[2] + v[3]); }
                s += __shfl_xor(s, 16); s += __shfl_xor(s, 32);
                ml[ai][m] = mx;
                if (fq == 0) X[(ai * HALF + wr * 64 + m * 16 + fr) * 4 + wc] = (f32x2){mx, s}; }
        asm volatile("s_waitcnt lgkmcnt(0)" ::: "memory"); __builtin_amdgcn_s_barrier(); asm volatile("" ::: "memory");
#pragma unroll
        for (int ai = 0; ai < 2; ++ai)
#pragma unroll
            for (int m = 0; m < 4; ++m) { const int rl = ai * HALF + wr * 64 + m * 16 + fr; const int row = u.pm * BM + rl;
                const f32x2 a = X[rl * 4 + 0], b = X[rl * 4 + 1], c = X[rl * 4 + 2], d = X[rl * 4 + 3];
                const float Mx = fmaxf(fmaxf(a.x, b.x), fmaxf(c.x, d.x));
                const float L = a.y * __builtin_amdgcn_exp2f(a.x - Mx) + b.y * __builtin_amdgcn_exp2f(b.x - Mx) + c.y * __builtin_amdgcn_exp2f(c.x - Mx) + d.y * __builtin_amdgcn_exp2f(d.x - Mx);
                const float f = __builtin_amdgcn_exp2f(ml[ai][m] - Mx) * __builtin_amdgcn_rcpf(L) * 256.0f;
                unsigned char* rowp = P + (size_t)row * 1024 + col0;
#pragma unroll
                for (int bj = 0; bj < 2; ++bj) { const f32x4 v0 = acc[ai][bj][m][0] * f, v1 = acc[ai][bj][m][1] * f;
                    *(u32x2*)(rowp + bj * HALF) = (u32x2){pk4_fp8(v0[0], v0[1], v0[2], v0[3]), pk4_fp8(v1[0], v1[1], v1[2], v1[3])}; } }
    }
};
struct EpiGate {
    static constexpr bool PERM = false;
    unsigned* sel;
    __device__ __forceinline__ void operator()(AccT& acc, const Unit& u, int wr, int wc, int fr, int fq, PG8_LAS unsigned char*) const {
        const int own = u.pm & 31;
#pragma unroll
        for (int ai = 0; ai < 2; ++ai)
#pragma unroll
            for (int m = 0; m < 4; ++m) { const int row = u.pm * BM + ai * HALF + wr * 64 + m * 16 + fr;
#pragma unroll
                for (int bj = 0; bj < 2; ++bj) { unsigned mask = 0u;
#pragma unroll
                    for (int round = 0; round < 3; ++round) { float bv = -3.0e38f; int bi = 32;
#pragma unroll
                        for (int n = 0; n < 2; ++n)
#pragma unroll
                            for (int i = 0; i < 4; ++i) { const int nb = 16 * n + 4 * fq + i; const float v = acc[ai][bj][m][n][i];
                                if (nb < own && !((mask >> nb) & 1u) && v > bv) { bv = v; bi = nb; } }
#pragma unroll
                        for (int off = 16; off <= 32; off <<= 1) { const float ov = __shfl_xor(bv, off); const int oi = __shfl_xor(bi, off); if (ov > bv || (ov == bv && oi < bi)) { bv = ov; bi = oi; } }
                        if (bi < 32) mask |= 1u << bi; }
                    if (fq == 0) sel[((size_t)((u.pm >> 5) * 8 + 4 * bj + wc)) * 8192 + (row & 8191)] = mask; } }
    }
};

template <class Epi, class Sched, bool ALIGN_EPI, bool F8 = false>
__device__ __forceinline__ void gemm_phase(PG8_LAS unsigned char* lds, PG8_LAS unsigned char* xl, const Gemm g, const Sched& S, const Epi& E) {
    int tid_ = threadIdx.x; asm volatile("" : "+v"(tid_));
    const int tid = tid_, wid = __builtin_amdgcn_readfirstlane(tid >> 6), lane = tid & 63, wr = wid >> 2, wc = wid & 3, fr = lane & 15, fq = lane >> 4;
    int nt = g.nt; asm volatile("" : "+s"(nt));
    unsigned voffA[2], voffB[2];
#pragma unroll
    for (int i = 0; i < 2; ++i) { int R, C; stage_rc(tid * 16 + i * 8192, R, C); const int Rb = Epi::PERM ? ((R & ~31) + perm32(R & 31)) : R;
        voffA[i] = (unsigned)(R * g.lda + C * 2); voffB[i] = (unsigned)(Rb * g.ldb + C * 2); }
    const size_t kstep = (size_t)(BK * 2);
    const size_t hstepA = (size_t)HALF * g.lda, hstepB = (size_t)HALF * g.ldb;
    const unsigned wmask = g.wrapmask;
    const unsigned ldsw = (unsigned)wid * 1024u;
    const int aoff = lds_byte(wr * 64 + fr, fq * 8), boff = lds_byte(wc * 32 + fr, fq * 8);
#define PG8_SA(b, h) (((b) * 2 + (h)) * HTB)
#define PG8_SB(b, h) ((4 + (b) * 2 + (h)) * HTB)
#define PG8_STAGE(bufoff, gbase, voff) do { _Pragma("unroll") for (int _i = 0; _i < 2; ++_i) \
        __builtin_amdgcn_global_load_lds((const unsigned*)((const char*)(gbase) + (voff)[_i]), (PG8_LAS unsigned*)(lds + (bufoff) + ldsw + _i * 8192), 16, 0, 0); } while (0)
#define PG8_LDA(dst, b, h) do { if constexpr (F8) { _Pragma("unroll") for (int m = 0; m < 4; ++m) { dst##8[m].lo = *(const PG8_LAS i32x4*)(lds + PG8_SA(b, h) + aoff + m * 2048); dst##8[m].hi = *(const PG8_LAS i32x4*)(lds + PG8_SA(b, h) + aoff + m * 2048 + 1024); } } \
        else { _Pragma("unroll") for (int m = 0; m < 4; ++m) _Pragma("unroll") for (int k = 0; k < 2; ++k) dst[m][k] = *(const PG8_LAS bf16x8*)(lds + PG8_SA(b, h) + aoff + m * 2048 + k * 1024); } } while (0)
#define PG8_LDB(dst, b, h) do { if constexpr (F8) { _Pragma("unroll") for (int n = 0; n < 2; ++n) { dst##8[n].lo = *(const PG8_LAS i32x4*)(lds + PG8_SB(b, h) + boff + n * 2048); dst##8[n].hi = *(const PG8_LAS i32x4*)(lds + PG8_SB(b, h) + boff + n * 2048 + 1024); } } \
        else { _Pragma("unroll") for (int n = 0; n < 2; ++n) _Pragma("unroll") for (int k = 0; k < 2; ++k) dst[n][k] = *(const PG8_LAS bf16x8*)(lds + PG8_SB(b, h) + boff + n * 2048 + k * 1024); } } while (0)
#define PG8_MMA(ai, bj, At, Bt) do { __builtin_amdgcn_s_setprio(1); \
        if constexpr (F8) { _Pragma("unroll") for (int m = 0; m < 4; ++m) _Pragma("unroll") for (int n = 0; n < 2; ++n) \
            asm volatile("v_mfma_f32_16x16x128_f8f6f4 %0, %1, %2, %0" : "+v"(acc[ai][bj][m][n]) : "v"(Bt##8[n]), "v"(At##8[m])); } \
        else { _Pragma("unroll") for (int m = 0; m < 4; ++m) _Pragma("unroll") for (int n = 0; n < 2; ++n) _Pragma("unroll") for (int k = 0; k < 2; ++k) \
            acc[ai][bj][m][n] = __builtin_amdgcn_mfma_f32_16x16x32_bf16(Bt[n][k], At[m][k], acc[ai][bj][m][n], 0, 0, 0); } \
        __builtin_amdgcn_s_setprio(0); } while (0)
#define PG8_WAIT_V(n) asm volatile("s_waitcnt vmcnt(" #n ")" ::: "memory")
#define PG8_WAIT_L(n) asm volatile("s_waitcnt lgkmcnt(" #n ")" ::: "memory")
#define PG8_BAR __builtin_amdgcn_s_barrier()
#define PG8_SCHED __builtin_amdgcn_sched_barrier(0)
    Unit cur, nxt; int ui = 0;
    if (!S.next(0, cur)) return;
    AccT acc;
    bf16x8 At[4][2], B0[2][2], B1[2][2]; i32x8 At8[4], B08[2], B18[2];
    const char* cA = (const char*)g.A + cur.aoff; const char* cB = (const char*)g.Bt + cur.boff;
    PG8_STAGE(PG8_SB(0, 0), cB, voffB); PG8_STAGE(PG8_SB(0, 1), cB + hstepB, voffB); PG8_STAGE(PG8_SA(0, 0), cA, voffA); PG8_STAGE(PG8_SA(0, 1), cA + hstepA, voffA);
    if (wr == 1) PG8_BAR;
    PG8_WAIT_V(2); PG8_BAR;
    PG8_STAGE(PG8_SB(1, 0), cB + kstep, voffB); PG8_STAGE(PG8_SA(1, 0), cA + kstep, voffA); PG8_STAGE(PG8_SB(1, 1), cB + hstepB + kstep, voffB);
    PG8_WAIT_V(6); PG8_BAR;
    { float z0; asm volatile("v_mov_b32 %0, 0" : "=v"(z0));
#pragma unroll
    for (int a = 0; a < 2; ++a)
#pragma unroll
        for (int b = 0; b < 2; ++b)
#pragma unroll
            for (int m = 0; m < 4; ++m)
#pragma unroll
                for (int n = 0; n < 2; ++n) acc[a][b][m][n] = (f32x4){z0, z0, z0, z0}; }
    for (;;) {
        const bool has_next = S.next(ui + 1, nxt);
        const char* nA = has_next ? (const char*)g.A + nxt.aoff : cA; const char* nB = has_next ? (const char*)g.Bt + nxt.boff : cB;
#pragma unroll 1
        for (int t = 0; t < nt; t += 2) {
            const bool last = (t == nt - 2);
            const char* a1 = cA + (size_t)((unsigned)(t * 128) & wmask) + kstep;
            const char* a2 = last ? nA : cA + (size_t)((unsigned)((t + 2) * 128) & wmask); const char* b2 = last ? nB : cB + (size_t)(t + 2) * kstep;
            const char* a3 = a2 + kstep; const char* b3 = b2 + kstep;
            PG8_LDB(B0, 0, 0); PG8_LDB(B1, 0, 1); PG8_SCHED; PG8_LDA(At, 0, 0); PG8_STAGE(PG8_SA(1, 1), a1 + hstepA, voffA);
            PG8_WAIT_V(8); PG8_WAIT_L(0); PG8_BAR; PG8_MMA(0, 0, At, B0); PG8_MMA(0, 1, At, B1); PG8_BAR; PG8_SCHED;
            PG8_LDA(At, 0, 1); PG8_STAGE(PG8_SB(0, 0), b2, voffB); PG8_STAGE(PG8_SB(0, 1), b2 + hstepB, voffB); PG8_STAGE(PG8_SA(0, 0), a2, voffA);
            PG8_WAIT_V(8); PG8_WAIT_L(0); PG8_BAR; PG8_MMA(1, 0, At, B0); PG8_MMA(1, 1, At, B1); PG8_BAR; PG8_SCHED;
            PG8_LDB(B0, 1, 0); PG8_LDB(B1, 1, 1); PG8_SCHED; PG8_LDA(At, 1, 0); PG8_STAGE(PG8_SA(0, 1), a2 + hstepA, voffA);
            PG8_WAIT_V(8); PG8_WAIT_L(0); PG8_BAR; PG8_MMA(0, 0, At, B0); PG8_MMA(0, 1, At, B1); PG8_BAR; PG8_SCHED;
            PG8_LDA(At, 1, 1); PG8_STAGE(PG8_SB(1, 0), b3, voffB); PG8_STAGE(PG8_SB(1, 1), b3 + hstepB, voffB); PG8_STAGE(PG8_SA(1, 0), a3, voffA);
            PG8_WAIT_V(8); PG8_WAIT_L(0); PG8_BAR; PG8_MMA(1, 0, At, B0); PG8_MMA(1, 1, At, B1); PG8_BAR; PG8_SCHED;
        }
        if constexpr (F8) asm volatile("s_nop 15\n\ts_nop 15" ::: "memory");
        if constexpr (ALIGN_EPI) { if (wr == 0) PG8_BAR; }
        E(acc, cur, wr, wc, fr, fq, xl);
        if (!has_next) break;
#pragma unroll
        for (int a = 0; a < 2; ++a)
#pragma unroll
            for (int b = 0; b < 2; ++b)
#pragma unroll
                for (int m = 0; m < 4; ++m)
#pragma unroll
                    for (int n = 0; n < 2; ++n) acc[a][b][m][n] = (f32x4){0.f, 0.f, 0.f, 0.f};
        cur = nxt; cA = nA; cB = nB; ++ui;
        if constexpr (ALIGN_EPI) { if (wr == 1) PG8_BAR; }
    }
    PG8_WAIT_V(0);
    if constexpr (!ALIGN_EPI) { if (wr == 0) PG8_BAR; }
    PG8_BAR;
#undef PG8_SA
#undef PG8_SB
#undef PG8_STAGE
#undef PG8_LDA
#undef PG8_LDB
#undef PG8_MMA
#undef PG8_WAIT_V
#undef PG8_WAIT_L
#undef PG8_BAR
#undef PG8_SCHED
}
}

constexpr int NWAVES = 8;
constexpr int NB = 8, T = 8192, D = 1024, M = NB * T;
constexpr int INC = 3080, NQKV = 3072, FF = 2816;
constexpr int C_F = 1536, C_QM = 1544, C_KM = 2056;
constexpr float LOG2E = 1.4426950408889634f;
constexpr float C2 = 0.125f * LOG2E;
constexpr float RMS_EPS = 1e-6f;

constexpr size_t MiB = 1u << 20;
constexpr size_t WS_CTL = 0, CTL_ZERO_BYTES = 1 * MiB;
constexpr size_t WS_LOGF = 2 * MiB, WS_C = 4 * MiB, WS_ABAR = 6 * MiB, WS_KM = 7 * MiB, WS_SEL = 8 * MiB;
constexpr size_t WS_SSQ1 = 10 * MiB, WS_SSQ2 = 14 * MiB, WS_SSQ3 = 18 * MiB;
constexpr size_t WS_MEMN = 22 * MiB, WS_KV = 26 * MiB, WS_WQS = 34 * MiB, WS_WOT = 36 * MiB, WS_WKVT = 38 * MiB, WS_WINT = 42 * MiB, WS_WOUTT = 48 * MiB;
constexpr size_t WS_WUPT = 50 * MiB, WS_WDT = 62 * MiB, WS_ZT = 68 * MiB, WS_WQK = 80 * MiB, WS_VWO = 96 * MiB;
constexpr size_t WS_A1 = 112 * MiB;
constexpr size_t WS_QKV = 368 * MiB;
constexpr size_t WS_Y = 752 * MiB, WS_HB1 = WS_A1 + 128 * MiB, WS_P = WS_QKV, WS_HB2 = WS_A1;
constexpr size_t WS_PO = WS_A1;
constexpr size_t WS_LIST = 880 * MiB, WS_PML = 944 * MiB, WS_KXF = 960 * MiB, WS_KXM = 968 * MiB, WS_CNT = 969 * MiB;
constexpr size_t WS_G = 240 * MiB, WS_U = 592 * MiB, WS_END = 1024 * MiB;
static_assert(WS_WDT + (size_t)D * FF * 2 <= WS_ZT && WS_ZT + (size_t)8 * 256 * 3072 * 2 <= WS_WQK && WS_VWO + 16 * MiB <= WS_A1, "ws map");
static_assert(WS_G + (size_t)M * FF * 2 <= WS_U && WS_U + (size_t)M * FF * 2 <= WS_END && WS_Y + (size_t)M * D * 2 <= WS_LIST && WS_LIST + (size_t)2048 * 8192 * 4 <= WS_PML && WS_PML + (size_t)M * 32 * 8 <= WS_KXF && WS_KXF + (size_t)64 * 8192 * 16 <= WS_KXM, "ws map 2");
constexpr int CW_BAR = 4096;
constexpr int CW_QKN = 8192;
constexpr int CW_QUEUE = 12288;
constexpr int CW_T0TAB = 16384;

constexpr int RING_OFF = 0, RING_BYTES = 131072;
constexpr int LDSCTL_OFF = RING_BYTES, MISC_OFF = LDSCTL_OFF + 320;
constexpr int XL_OFF = RING_BYTES + 512;
constexpr int LDS_BYTES = 147456;
static_assert(XL_OFF + 8192 <= LDS_BYTES, "LDS map");

#define GAS __attribute__((address_space(1)))
#define LAS __attribute__((address_space(3)))
typedef unsigned short bf16;
typedef unsigned v4u __attribute__((ext_vector_type(4)));
typedef float f32x4 __attribute__((ext_vector_type(4)));
typedef GAS unsigned gu32;
#define RLX_AGENT __ATOMIC_RELAXED, __HIP_MEMORY_SCOPE_AGENT
#define LDS_WAIT() asm volatile("s_waitcnt lgkmcnt(0)" ::: "memory")
__device__ __forceinline__ unsigned f2bf(float f) { unsigned u = __builtin_bit_cast(unsigned, f); return (u + 0x7fffu + ((u >> 16) & 1u)) >> 16; }
__device__ __forceinline__ unsigned pk2(float lo, float hi) { return f2bf(lo) | (f2bf(hi) << 16); }
__device__ __forceinline__ float bf2f(unsigned b) { return __builtin_bit_cast(float, b << 16); }
__device__ __forceinline__ float bflo(unsigned w) { return __builtin_bit_cast(float, w << 16); }
__device__ __forceinline__ float bfhi(unsigned w) { return __builtin_bit_cast(float, w & 0xffff0000u); }

#define XB_TMO      128
#define XB_XCNT(j)  (256  + 64 * (j))
#define XB_XSUB(j)  (1280 + 64 * (j))
#define XB_XGEN(j)  (2304 + 64 * (j))
#define XB_TOP      3328
#define XB_TOPGEN   3392
#define XCD_BAR_WORDS 3456
#define XB_SPIN_CAP (1u << 18)

__device__ __forceinline__ unsigned xb_ld(unsigned* p)              { return __hip_atomic_load(p, __ATOMIC_RELAXED, __HIP_MEMORY_SCOPE_AGENT); }
__device__ __forceinline__ unsigned xb_add(unsigned* p, unsigned v) { return __hip_atomic_fetch_add(p, v, __ATOMIC_RELAXED, __HIP_MEMORY_SCOPE_AGENT); }
__device__ __forceinline__ unsigned xb_xcc_id() { return (unsigned)__builtin_amdgcn_s_getreg((3 << 11) | 20) & 0xFu; }
#define XB_SPIN(cond, bar) do { unsigned _sp = 0; while (cond) { __builtin_amdgcn_s_sleep(1); \
    if ((++_sp & 255u) == 0u) { if (xb_ld(&(bar)[XB_TMO])) break; if (_sp > XB_SPIN_CAP) { atomicAdd(&(bar)[XB_TMO], 1u); break; } } } } while (0)

struct XcdBarrier { unsigned* bar; unsigned x; volatile LAS unsigned* st; };

__device__ __forceinline__ XcdBarrier xcd_barrier_post(unsigned* bar, volatile LAS unsigned* st) {
    XcdBarrier b; b.bar = bar; b.x = xb_xcc_id(); b.st = st;
    if (threadIdx.x == 0) (void)xb_add(&bar[XB_XCNT(b.x)], 1u);
    return b;
}
__device__ __forceinline__ void xcd_barrier_complete(unsigned* bar, unsigned x, unsigned& nloc, unsigned& nx) {
    const unsigned G = gridDim.x * gridDim.y * gridDim.z;
    unsigned sum, cnt, mine, sp = 0u;
    for (;;) {
        sum = 0u; cnt = 0u; mine = 0u;
#pragma unroll
        for (unsigned j = 0; j < 16; ++j) { const unsigned c = xb_ld(&bar[XB_XCNT(j)]); sum += c; cnt += (c > 0u) ? 1u : 0u; mine = (j == x) ? c : mine; }
        if (sum == G) break;
        __builtin_amdgcn_s_sleep(1);
        if ((++sp & 255u) == 0u) { if (xb_ld(&bar[XB_TMO])) break; if (sp > XB_SPIN_CAP) { atomicAdd(&bar[XB_TMO], 1u); break; } }
    }
    nloc = mine > 0u ? mine : 1u; nx = cnt > 0u ? cnt : 1u;
}
__device__ __forceinline__ void xcd_barrier(const XcdBarrier& b) {
    asm volatile("s_waitcnt vmcnt(0)" ::: "memory");
    __syncthreads();
    if (threadIdx.x == 0) {
        unsigned* bar = b.bar;
        __builtin_amdgcn_s_waitcnt(0);
        unsigned nloc = b.st[0], nx = b.st[1];
        if (nloc == 0u) { xcd_barrier_complete(bar, b.x, nloc, nx); b.st[0] = nloc; b.st[1] = nx; }
        const unsigned old = xb_add(&bar[XB_XSUB(b.x)], 1u);
        const unsigned gen = old / nloc;
        if (old + 1u == (gen + 1u) * nloc) {
            __builtin_amdgcn_fence(__ATOMIC_RELEASE, "agent");
            asm volatile("s_waitcnt vmcnt(0)" ::: "memory");
            const unsigned og = xb_add(&bar[XB_TOP], 1u);
            const unsigned tg = og / nx;
            if (og + 1u == (tg + 1u) * nx) xb_add(&bar[XB_TOPGEN], 1u);
            else XB_SPIN(xb_ld(&bar[XB_TOPGEN]) == tg, bar);
            __builtin_amdgcn_fence(__ATOMIC_ACQUIRE, "agent");
            xb_add(&bar[XB_XGEN(b.x)], 1u);
            asm volatile("s_waitcnt vmcnt(0)" ::: "memory");
        } else {
            XB_SPIN(xb_ld(&bar[XB_XGEN(b.x)]) == gen, bar);
            __builtin_amdgcn_fence(__ATOMIC_ACQUIRE, "agent");
            asm volatile("s_waitcnt vmcnt(0)" ::: "memory");
        }
    }
    __syncthreads();
}

__device__ __forceinline__ float wave_sum(float v) {
#pragma unroll
    for (int o = 1; o < 64; o <<= 1) v += __shfl_xor(v, o);
    return v;
}
__device__ __forceinline__ void p0_transpose_item(const float* W, int ldw, int K, int N, bf16* WT, const float* kscale, bool remap, LAS float* scr, int item, int lane) {
    const int nblk = N / 32, kb = item / nblk, nb = item % nblk, k0 = 64 * kb, n0 = 32 * nb;
    const int sn0 = (remap && n0 >= 1536) ? n0 + 8 : n0;
#pragma unroll 8
    for (int i = 0; i < 32; ++i) { const int kk = 2 * i + (lane >> 5); float v = W[(size_t)(k0 + kk) * ldw + sn0 + (lane & 31)]; if (kscale) v *= kscale[k0 + kk]; scr[kk * 33 + (lane & 31)] = v; }
    LDS_WAIT(); asm volatile("" ::: "memory");
    const int c = lane & 7;
#pragma unroll
    for (int j = 0; j < 4; ++j) { const int n = (lane >> 3) + 8 * j; const LAS float* s = scr + (8 * c) * 33 + n;
        v4u o; o.x = pk2(s[0 * 33], s[1 * 33]); o.y = pk2(s[2 * 33], s[3 * 33]); o.z = pk2(s[4 * 33], s[5 * 33]); o.w = pk2(s[6 * 33], s[7 * 33]);
        *(GAS v4u*)(WT + (size_t)(n0 + n) * K + k0 + 8 * c) = o; }
    LDS_WAIT(); asm volatile("" ::: "memory");
}

struct Args { const float* in[19]; float* out; unsigned char* ws; };

namespace attn_body {
using hb16=__hip_bfloat16;
using bf16x8=__attribute__((ext_vector_type(8)))short;
using s16x4=__attribute__((ext_vector_type(4)))short;
using f32x16=__attribute__((ext_vector_type(16)))float;
using u32x4=__attribute__((ext_vector_type(4)))unsigned;
constexpr int PITCH=3072;
constexpr int NW=8,QBLK=32,QB=QBLK*NW,KVBLK=64;
__device__ __forceinline__ int crow(int r,int hi){return (r&3)+8*(r>>2)+4*hi;}
#define SBAR() __builtin_amdgcn_sched_barrier(0)
__device__ __forceinline__ void cmask(f32x16&p0,f32x16&p1,int jb,int qrel,int hi){
  const float NEG=-INFINITY; int kb=64*jb+4*hi;
  #pragma unroll
  for(int r=0;r<16;++r){int kv=kb+(r&3)+8*(r>>2); if(kv>qrel)p0[r]=NEG; if(kv+32>qrel)p1[r]=NEG;}
}
constexpr int NSLOT=3, SLOTB=9216;
constexpr int LDS_K=0, LDS_V=NSLOT*SLOTB, LDS_WS=2*NSLOT*SLOTB, LDS_OST=LDS_WS+NW*64*4, LDS_BYTES=LDS_OST+NW*4096;
__device__ __forceinline__ void glds16(const void*gsrc,unsigned lds_dst){unsigned keep;
  asm volatile("s_mov_b32 %0, m0\n\ts_mov_b32 m0, %2\n\ts_nop 0\n\tglobal_load_lds_dwordx4 %1, off\n\ts_mov_b32 m0, %0":"=&s"(keep):"v"(gsrc),"s"(lds_dst):"memory");}
__device__ __forceinline__ void glds16x(const void*gsrc,unsigned lds_dst){unsigned keep;unsigned long long ex;
  asm volatile("s_mov_b32 %0, m0\n\ts_mov_b64 %1, exec\n\ts_mov_b64 exec, 0xff\n\ts_mov_b32 m0, %3\n\ts_nop 0\n\tglobal_load_lds_dwordx4 %2, off\n\ts_mov_b64 exec, %1\n\ts_mov_b32 m0, %0":"=&s"(keep),"=&s"(ex):"v"(gsrc),"s"(lds_dst):"memory");}
__device__ __forceinline__ float max3f(float a,float b,float c){float r;asm("v_max3_f32 %0, %1, %2, %3":"=v"(r):"v"(a),"v"(b),"v"(c));return r;}
__device__ __forceinline__ float max2f(float a,float b){float r;asm("v_max_f32_e32 %0, %1, %2":"=v"(r):"v"(a),"v"(b));return r;}
__device__ __forceinline__ float fsub_s(float a,float b){float r;asm("v_sub_f32_e32 %0, %1, %2":"=v"(r):"v"(a),"v"(b));return r;}
typedef float f32x2_t __attribute__((ext_vector_type(2))); typedef __bf16 bf16x2_t __attribute__((ext_vector_type(2)));
__device__ __forceinline__ unsigned cvtpk_s(float lo,float hi){f32x2_t v={lo,hi};bf16x2_t b=__builtin_convertvector(v,bf16x2_t);return __builtin_bit_cast(unsigned,b);}
__device__ __forceinline__ float rbf(float x){return __builtin_bit_cast(float,cvtpk_s(x,0.f)<<16);}
#define WAIT_BAR(N) asm volatile("s_waitcnt vmcnt(" #N ") lgkmcnt(0)\n\ts_barrier":::"memory")

__device__ __forceinline__ void qkt(f32x16&p0,f32x16&p1,const char*Kslot,const bf16x8*qr,int r32,int hi){
  const char*kb=Kslot+hi*1024+r32*16; const f32x16 zf={};
  #pragma unroll
  for(int d0=0;d0<4;++d0){
    const bf16x8 b0=*reinterpret_cast<const bf16x8*>(kb+d0*2048);
    const bf16x8 b1=*reinterpret_cast<const bf16x8*>(kb+d0*2048+512);
    if(d0==0){p0=__builtin_amdgcn_mfma_f32_32x32x16_bf16(b0,qr[0],zf,0,0,0);p1=__builtin_amdgcn_mfma_f32_32x32x16_bf16(b1,qr[0],zf,0,0,0);}
    else{p0=__builtin_amdgcn_mfma_f32_32x32x16_bf16(b0,qr[d0],p0,0,0,0);p1=__builtin_amdgcn_mfma_f32_32x32x16_bf16(b1,qr[d0],p1,0,0,0);}}
  const char*kx=Kslot+8192+r32*16;
  const bf16x8 x0=*reinterpret_cast<const bf16x8*>(kx), x1=*reinterpret_cast<const bf16x8*>(kx+512);
  p0=__builtin_amdgcn_mfma_f32_32x32x16_bf16(x0,qr[4],p0,0,0,0);p1=__builtin_amdgcn_mfma_f32_32x32x16_bf16(x1,qr[4],p1,0,0,0);
}
typedef __attribute__((address_space(3))) const char* lds_cptr;
typedef short v4i16_t __attribute__((ext_vector_type(4)));
__device__ __forceinline__ void kload10(bf16x8*kf,lds_cptr kp,lds_cptr kx){
  kf[0]=*(const __attribute__((address_space(3))) bf16x8*)(kp);      kf[1]=*(const __attribute__((address_space(3))) bf16x8*)(kp+512);
  kf[2]=*(const __attribute__((address_space(3))) bf16x8*)(kp+2048); kf[3]=*(const __attribute__((address_space(3))) bf16x8*)(kp+2560);
  kf[4]=*(const __attribute__((address_space(3))) bf16x8*)(kp+4096); kf[5]=*(const __attribute__((address_space(3))) bf16x8*)(kp+4608);
  kf[6]=*(const __attribute__((address_space(3))) bf16x8*)(kp+6144); kf[7]=*(const __attribute__((address_space(3))) bf16x8*)(kp+6656);
  kf[8]=*(const __attribute__((address_space(3))) bf16x8*)(kx);      kf[9]=*(const __attribute__((address_space(3))) bf16x8*)(kx+512);
}
__device__ __forceinline__ void kload2(bf16x8*kf,lds_cptr kp,int j){ kf[2*j]=*(const __attribute__((address_space(3))) bf16x8*)(kp+j*2048); kf[2*j+1]=*(const __attribute__((address_space(3))) bf16x8*)(kp+j*2048+512); }
__device__ __forceinline__ s16x4 vtr(lds_cptr p){ return __builtin_bit_cast(s16x4,__builtin_amdgcn_ds_read_tr16_b64_v4i16((__attribute__((address_space(3))) v4i16_t*)p)); }
__device__ __forceinline__ float rowmax(const f32x16&p0,const f32x16&p1){
  float a=max3f(p0[0],p0[1],p1[0]),b=max3f(p0[2],p0[3],p1[1]);a=max3f(a,p1[2],p1[3]);
  #pragma unroll
  for(int r=4;r<16;r+=4){a=max3f(a,p0[r],p0[r+1]);b=max3f(b,p0[r+2],p0[r+3]);a=max3f(a,p1[r],p1[r+1]);b=max3f(b,p1[r+2],p1[r+3]);}
  const float m=max2f(a,b);
  auto rr=__builtin_amdgcn_permlane32_swap(__float_as_uint(m),__float_as_uint(m),false,false);
  return max2f(__uint_as_float(rr[0]),__uint_as_float(rr[1]));
}
__device__ __forceinline__ void pv(f32x16*o,int vb,bf16x8 pa0,bf16x8 pa1,bf16x8 pa2,bf16x8 pa3){
  #pragma unroll
  for(int d0=0;d0<2;++d0){s16x4 lo[4],hi[4];
    #pragma unroll
    for(int ks=0;ks<4;++ks){
      asm volatile("ds_read_b64_tr_b16 %0,%1 offset:%c2":"=&v"(lo[ks]):"v"(vb),"i"(d0*4096+ks*1024):"memory");
      asm volatile("ds_read_b64_tr_b16 %0,%1 offset:%c2":"=&v"(hi[ks]):"v"(vb),"i"(d0*4096+ks*1024+512):"memory");}
    asm volatile("s_waitcnt lgkmcnt(0)":::"memory");SBAR();
    #define PK(k) (bf16x8){lo[k][0],lo[k][1],lo[k][2],lo[k][3],hi[k][0],hi[k][1],hi[k][2],hi[k][3]}
    o[d0]=__builtin_amdgcn_mfma_f32_32x32x16_bf16(pa0,PK(0),o[d0],0,0,0);
    o[d0]=__builtin_amdgcn_mfma_f32_32x32x16_bf16(pa1,PK(1),o[d0],0,0,0);
    o[d0]=__builtin_amdgcn_mfma_f32_32x32x16_bf16(pa2,PK(2),o[d0],0,0,0);
    o[d0]=__builtin_amdgcn_mfma_f32_32x32x16_bf16(pa3,PK(3),o[d0],0,0,0);
    #undef PK
  }
}

template<int THRL> __device__ __forceinline__ void attn_unit(char*shm,const int KIND,const hb16*Qc,int qrow,int oslot,const hb16*__restrict__ Kt0,const hb16*__restrict__ Vt0,const hb16*__restrict__ KXt0,int NT,int band0,hb16*Oc,hb16*PO,float*PML){
  const int tid=threadIdx.x,lane=tid&63,r32=lane&31,hi=lane>>5; const int wid=__builtin_amdgcn_readfirstlane(tid>>6);
  const unsigned lds0=(unsigned)(uintptr_t)shm;
  float*wsf=(float*)(shm+LDS_WS)+wid*64;
  const hb16*ksrc=Kt0+(long)lane*PITCH+wid*8;
  const hb16*vsrc=Vt0+(long)(16*(wid&3)+(lane>>2))*PITCH+(wid>>2)*32+(lane&3)*8;
  const hb16*xsrc=KXt0+(long)(8*wid+(lane&7))*8;
  const unsigned kdst=lds0+LDS_K+wid*1024, vdst=lds0+LDS_V+wid*1024, xdst=lds0+LDS_K+8192+wid*128;
  #define DMA_K(t,slot) do{ glds16(ksrc+(long)(t)*KVBLK*PITCH,(unsigned)__builtin_amdgcn_readfirstlane(kdst+(slot))); glds16x(xsrc+(long)(t)*KVBLK*8,(unsigned)__builtin_amdgcn_readfirstlane(xdst+(slot))); }while(0)
  #define DMA_V(t,slot) glds16(vsrc+(long)(t)*KVBLK*PITCH,(unsigned)__builtin_amdgcn_readfirstlane(vdst+(slot)))
  const int vb0=(int)(lds0+LDS_V)+((lane>>4)&1)*32+(lane&3)*8+(4*hi+((lane&15)>>2))*64;
  const char*Kbase=shm+LDS_K; bf16x8 kf[10];
  const lds_cptr shm3=(lds_cptr)shm; const lds_cptr kp0=shm3+LDS_K+hi*1024+r32*16; const lds_cptr kx0=shm3+LDS_K+8192+r32*16; const lds_cptr vp0=shm3+LDS_V+((lane>>4)&1)*32+(lane&3)*8+(4*hi+((lane&15)>>2))*64;
  DMA_K(0,0);DMA_V(0,0);DMA_K(1,SLOTB);
  bf16x8 qr[5];
  { const hb16*Qw=Qc+(long)qrow*PITCH;
    #pragma unroll
    for(int d0=0;d0<4;++d0)qr[d0]=*reinterpret_cast<const bf16x8*>(&Qw[d0*16+hi*8]); }
  float mhat=0.f,l_reg=0.f;f32x16 o[2];o[0]=f32x16{};o[1]=f32x16{};
  #define SETQX(mh_,ml_) do{ const unsigned bh_=cvtpk_s(-(mh_),-(ml_)); u32x4 qx_; qx_.x=0x3F803F80u; qx_.y=0x3F80u|(bh_<<16); qx_.z=(bh_>>16); qx_.w=0u; if(hi){qx_.x=0u;qx_.y=0u;qx_.z=0u;} qr[4]=__builtin_bit_cast(bf16x8,qx_); asm volatile("":"+v"(qr[4])); }while(0)
  #define MOVEREF(gain) const float mraw_=mhat+(gain); const float mh_=rbf(mraw_); const float ml_=rbf(mraw_-mh_); const float mnew_=mh_+ml_; const float dl=mnew_-mhat; mhat=mnew_; SETQX(mh_,ml_);
  SETQX(0.f,0.f);
  const int qrel=wid*QBLK+r32;
  #define CMASK(P0,P1,t) do{int jb_=(t)-band0; if(jb_>=0)cmask(P0,P1,jb_,qrel,hi);}while(0)
  bool resc=false;
  #define START(P0,P1) do{ const float rm=rowmax(P0,P1); resc=false; \
    { MOVEREF(rm) \
      _Pragma("unroll") for(int r=0;r<16;++r){P0[r]=fsub_s(P0[r],dl);P1[r]=fsub_s(P1[r],dl);} } \
    _Pragma("unroll") for(int r=0;r<16;++r)P0[r]=__builtin_amdgcn_exp2f(P0[r]); }while(0)
  #define RESC() do{ if(resc){ asm volatile("s_waitcnt lgkmcnt(0)":::"memory"); \
      _Pragma("unroll") for(int d_=0;d_<2;++d_) _Pragma("unroll") for(int r=0;r<16;++r)o[d_][r]*=wsf[crow(r,hi)]; } }while(0)
  f32x16 pA0,pA1,pB0,pB1;
  int sl_prev=0,sl_cur=0,sl_next=SLOTB;
  #define ROT() do{sl_prev=sl_cur;sl_cur=sl_next;sl_next=(sl_next==(NSLOT-1)*SLOTB)?0:sl_next+SLOTB;}while(0)
  DMA_K(2,2*SLOTB);
  WAIT_BAR(5);
  qkt(pA0,pA1,Kbase,qr,r32,hi);asm volatile("s_nop 15\n\ts_nop 7":"+v"(pA0),"+v"(pA1));CMASK(pA0,pA1,0);
  START(pA0,pA1);
  _Pragma("unroll") for(int r=0;r<16;++r)pA1[r]=__builtin_amdgcn_exp2f(pA1[r]);
  WAIT_BAR(0);
  DMA_K(3,0);DMA_V(1,SLOTB);
  ROT();
  kload10(kf,kp0+sl_cur,kx0+sl_cur);
  WAIT_BAR(3);
  s16x4 vlo[8],vhi[8]; u32x4 pw0,pw1,pw2,pw3; const f32x16 zf={};
  #define PKW(P,B) cvtpk_s(P[B],P[B+1])
  #define PAF(k) __builtin_bit_cast(bf16x8,pw##k)
  #define VFR(i) (bf16x8){vlo[i][0],vlo[i][1],vlo[i][2],vlo[i][3],vhi[i][0],vhi[i][1],vhi[i][2],vhi[i][3]}
  #define PIN(x) asm volatile("":"+v"(x))
  #define MX3(a,b,c) __builtin_fmaxf(__builtin_fmaxf((a),(b)),(c))
  #define GAPA(MF,A0,A1,A2,A3,W0,W1,PW) do{ MF; sacc+=A0; sacc+=A1; sacc+=A2; sacc+=A3; PIN(sacc); W0; W1; PIN(PW); SBAR(); }while(0)
  #define EX(v) __builtin_amdgcn_exp2f(v)
  #define GAPB(MF,X,B) do{ MF; X[B]=EX(X[B]); X[B+1]=EX(X[B+1]); X[B+2]=EX(X[B+2]); X[B+3]=EX(X[B+3]); PIN(X); SBAR(); }while(0)
  #define VRD(i) do{ vlo[i]=vtr(vp_+(((i)>>2)*4096+((i)&3)*1024)); vhi[i]=vtr(vp_+(((i)>>2)*4096+((i)&3)*1024+512)); }while(0)
  #define KRD(G,j) do{ if(G){ kload2(kf,kp0+sl_next,j); SBAR(); } }while(0)
  #define KRDX(G) do{ if(G){ kf[8]=*(const __attribute__((address_space(3))) bf16x8*)(kx0+sl_next); kf[9]=*(const __attribute__((address_space(3))) bf16x8*)(kx0+sl_next+512); SBAR(); } }while(0)
  #define STEP(C0,C1,P0,P1,t,GK,GV,GL) do{ SBAR(); \
    const lds_cptr vp_=vp0+sl_prev; \
    VRD(0); SBAR(); float sacc=(P0[0]+P0[1]); \
    GAPA(C0=__builtin_amdgcn_mfma_f32_32x32x16_bf16(kf[0],qr[0],zf,0,0,0), P0[2],P0[3],P0[4],P0[5],     pw0[0]=PKW(P0,0), pw0[1]=PKW(P0,2), pw0); \
    VRD(4); SBAR(); GAPA(C1=__builtin_amdgcn_mfma_f32_32x32x16_bf16(kf[1],qr[0],zf,0,0,0), P0[6],P0[7],P0[8],P0[9],     pw0[2]=PKW(P0,4), pw0[3]=PKW(P0,6), pw0); \
    VRD(1); SBAR(); GAPA(C0=__builtin_amdgcn_mfma_f32_32x32x16_bf16(kf[2],qr[1],C0,0,0,0),   P0[10],P0[11],P0[12],P0[13], pw1[0]=PKW(P0,8), pw1[1]=PKW(P0,10), pw1); \
    VRD(5); SBAR(); GAPA(C1=__builtin_amdgcn_mfma_f32_32x32x16_bf16(kf[3],qr[1],C1,0,0,0),   P0[14],P0[15],P1[0],P1[1],   pw1[2]=PKW(P0,12),pw1[3]=PKW(P0,14), pw1); \
    VRD(2); SBAR(); GAPA(C0=__builtin_amdgcn_mfma_f32_32x32x16_bf16(kf[4],qr[2],C0,0,0,0),   P1[2],P1[3],P1[4],P1[5],     pw2[0]=PKW(P1,0), pw2[1]=PKW(P1,2), pw2); \
    VRD(6); SBAR(); GAPA(C1=__builtin_amdgcn_mfma_f32_32x32x16_bf16(kf[5],qr[2],C1,0,0,0),   P1[6],P1[7],P1[8],P1[9],     pw2[2]=PKW(P1,4), pw2[3]=PKW(P1,6), pw2); \
    VRD(3); SBAR(); GAPA(C0=__builtin_amdgcn_mfma_f32_32x32x16_bf16(kf[6],qr[3],C0,0,0,0),   P1[10],P1[11],P1[12],P1[13], pw3[0]=PKW(P1,8), pw3[1]=PKW(P1,10), pw3); \
    VRD(7); SBAR(); GAPA(C1=__builtin_amdgcn_mfma_f32_32x32x16_bf16(kf[7],qr[3],C1,0,0,0),   P1[14],P1[15],0.f,0.f,       pw3[2]=PKW(P1,12),pw3[3]=PKW(P1,14), pw3); \
    C0=__builtin_amdgcn_mfma_f32_32x32x16_bf16(kf[8],qr[4],C0,0,0,0); SBAR(); \
    C1=__builtin_amdgcn_mfma_f32_32x32x16_bf16(kf[9],qr[4],C1,0,0,0); SBAR(); \
    l_reg+=sacc; \
    if(GK){DMA_K((t)+3,sl_cur);} if(GV){DMA_V((t)+1,sl_next);} \
    CMASK(C0,C1,t); \
    { float a=MX3(C0[0],C0[1],C1[0]),b=MX3(C0[2],C0[3],C1[1]); a=MX3(a,C1[2],C1[3]); \
      _Pragma("unroll") for(int r=4;r<16;r+=4){a=MX3(a,C0[r],C0[r+1]);b=MX3(b,C0[r+2],C0[r+3]);a=MX3(a,C1[r],C1[r+1]);b=MX3(b,C1[r+2],C1[r+3]);} \
      float rm=__builtin_fmaxf(a,b); { auto rr=__builtin_amdgcn_permlane32_swap(__float_as_uint(rm),__float_as_uint(rm),false,false); rm=__builtin_fmaxf(__uint_as_float(rr[0]),__uint_as_float(rr[1])); } \
      resc=false; \
      if(__builtin_expect(__any(rm>(float)THRL),0)){ MOVEREF(__builtin_fmaxf(rm,0.f)) \
        _Pragma("unroll") for(int r=0;r<16;++r){C0[r]-=dl;C1[r]-=dl;} \
        const float f=__builtin_amdgcn_exp2f(-dl); l_reg*=f; if(hi==0)wsf[r32]=f; resc=true; } } \
    SBAR(); \
    GAPB(o[0]=__builtin_amdgcn_mfma_f32_32x32x16_bf16(PAF(0),VFR(0),o[0],0,0,0), C0,0); \
    GAPB(o[1]=__builtin_amdgcn_mfma_f32_32x32x16_bf16(PAF(0),VFR(4),o[1],0,0,0), C0,4); \
    KRD(GL,0); GAPB(o[0]=__builtin_amdgcn_mfma_f32_32x32x16_bf16(PAF(1),VFR(1),o[0],0,0,0), C0,8); \
    KRD(GL,1); GAPB(o[1]=__builtin_amdgcn_mfma_f32_32x32x16_bf16(PAF(1),VFR(5),o[1],0,0,0), C0,12); \
    KRD(GL,2); GAPB(o[0]=__builtin_amdgcn_mfma_f32_32x32x16_bf16(PAF(2),VFR(2),o[0],0,0,0), C1,0); \
    KRD(GL,3); GAPB(o[1]=__builtin_amdgcn_mfma_f32_32x32x16_bf16(PAF(2),VFR(6),o[1],0,0,0), C1,4); \
    KRDX(GL); GAPB(o[0]=__builtin_amdgcn_mfma_f32_32x32x16_bf16(PAF(3),VFR(3),o[0],0,0,0), C1,8); \
    GAPB(o[1]=__builtin_amdgcn_mfma_f32_32x32x16_bf16(PAF(3),VFR(7),o[1],0,0,0), C1,12); \
    }while(0)
  int t=1;
  for(;t+5<NT&&t+1<band0;t+=2){
    #undef CMASK
    #define CMASK(P0,P1,t) do{}while(0)
    STEP(pB0,pB1,pA0,pA1,t,true,true,true);     WAIT_BAR(3); RESC(); ROT();
    STEP(pA0,pA1,pB0,pB1,t+1,true,true,true);   WAIT_BAR(3); RESC(); ROT();
  }
  #undef CMASK
  #define CMASK(P0,P1,t) do{int jb_=(t)-band0; if(jb_>=0)cmask(P0,P1,jb_,qrel,hi);}while(0)
  #define ENDW(tt) do{ if((tt)+3<NT){WAIT_BAR(3);} else if((tt)+2<NT){WAIT_BAR(1);} else {WAIT_BAR(0);} }while(0)
  for(;t+1<NT;t+=2){
    STEP(pB0,pB1,pA0,pA1,t,(t+3<NT),(t+1<NT),(t+1<NT));       ENDW(t);   RESC(); ROT();
    STEP(pA0,pA1,pB0,pB1,t+1,(t+4<NT),(t+2<NT),(t+2<NT));     ENDW(t+1); RESC(); ROT();
  }
  STEP(pB0,pB1,pA0,pA1,NT-1,false,false,false); RESC();
  { float sacc=pB0[0]+pB0[1]; _Pragma("unroll") for(int r=2;r<16;++r)sacc+=pB0[r]; _Pragma("unroll") for(int r=0;r<16;++r)sacc+=pB1[r]; l_reg+=sacc;
    pw0=(u32x4){PKW(pB0,0),PKW(pB0,2),PKW(pB0,4),PKW(pB0,6)};pw1=(u32x4){PKW(pB0,8),PKW(pB0,10),PKW(pB0,12),PKW(pB0,14)};pw2=(u32x4){PKW(pB1,0),PKW(pB1,2),PKW(pB1,4),PKW(pB1,6)};pw3=(u32x4){PKW(pB1,8),PKW(pB1,10),PKW(pB1,12),PKW(pB1,14)};
    SBAR(); pv(o,vb0+sl_cur,PAF(0),PAF(1),PAF(2),PAF(3)); }
  #undef PKW
  #undef PAF
  #undef VFR
  #undef PIN
  #undef MX3
  #undef GAPA
  #undef GAPB
  #undef EX
  #undef VRD
  #undef KRD
  #undef KRDX
  #undef STEP
  #undef ENDW
  {auto rr=__builtin_amdgcn_permlane32_swap(__float_as_uint(l_reg),__float_as_uint(l_reg),false,false);l_reg=__uint_as_float(rr[0])+__uint_as_float(rr[1]);}
  if(hi==0)wsf[32+r32]=l_reg;asm volatile("s_waitcnt lgkmcnt(0)":::"memory");
  float rli[16];
  #pragma unroll
  for(int r=0;r<16;++r)rli[r]=__builtin_amdgcn_rcpf(wsf[32+crow(r,hi)]);
  if(KIND==1){ if(hi==0&&oslot>=0){ f32x2_t ml={mhat,l_reg}; *(f32x2_t*)(PML+(long)oslot*2)=ml; } }
  { hb16*stg=(hb16*)(shm+LDS_OST)+wid*2048;
    #pragma unroll
    for(int r=0;r<16;++r){const int orow=crow(r,hi);
      #pragma unroll
      for(int d0=0;d0<2;++d0)stg[orow*64+d0*32+r32]=__float2bfloat16(o[d0][r]*rli[r]);}
    asm volatile("s_waitcnt lgkmcnt(0)":::"memory");
    #pragma unroll
    for(int i=0;i<4;++i){const int row=i*8+(lane>>3),ch=lane&7; const u32x4 v=*(const u32x4*)(stg+row*64+ch*8);
      if(KIND==0){ const int gr=__shfl(qrow,row); *(u32x4*)(Oc+(long)gr*PITCH+ch*8)=v; }
      else { const int gs=__shfl(oslot,row); if(gs>=0) *(u32x4*)(PO+(long)gs*64+ch*8)=v; } } }
  asm volatile("s_waitcnt lgkmcnt(0)\n\ts_barrier":::"memory");
  #undef DMA_K
  #undef DMA_V
  #undef CMASK
  #undef START
  #undef RESC
  #undef ROT
  #undef SETQX
  #undef MOVEREF
}
constexpr int ATTN_LDS_BYTES=LDS_BYTES;
#undef SBAR
#undef WAIT_BAR
}

struct WqkOrder {
    int G, c;
    __device__ __forceinline__ bool next(int i, pg8::Unit& u) const { const int L = i * G + c; if (L >= 128) return false; const int z = L >> 2, pn = L & 3, b = z >> 2, h = z & 3;
        u.pm = b * 4 + h; u.pn = pn; u.aoff = ((size_t)(b * 256) * 2048 + h * 256) * 2; u.boff = ((size_t)(pn * 256) * 1024 + h * 256) * 2; return true; }
};
struct VwoOrder {
    int G, c;
    __device__ __forceinline__ bool next(int i, pg8::Unit& u) const { const int L = i * G + c; if (L >= 128) return false; const int z = L >> 2, pmq = L & 3, b = z >> 2, h = z & 3;
        u.pm = b * 4 + pmq; u.pn = h; u.aoff = ((size_t)(pmq * 256) * 1024 + h * 256) * 2; u.boff = ((size_t)(b * 256) * 2048 + 1024 + h * 256) * 2; return true; }
};

#define DECL_PTRS const __attribute__((address_space(4))) Args* KA_; { auto p_ = __builtin_amdgcn_kernarg_segment_ptr(); asm volatile("" : "+s"(p_)); KA_ = (const __attribute__((address_space(4))) Args*)p_; } \
    int tidp_ = threadIdx.x; asm volatile("" : "+v"(tidp_)); const int tid = tidp_, lane = tid & 63; (void)lane; \
    unsigned char* ws = KA_->ws; gu32* ctl = (gu32*)(ws + WS_CTL); const float* x = KA_->in[0]; const float* mem = KA_->in[1]; const float* g_mix = KA_->in[2]; const float* w_in = KA_->in[3]; const float* b_forget = KA_->in[4]; const float* g_fox = KA_->in[5]; const float* g_moba = KA_->in[6]; const float* w_out = KA_->in[7]; const float* g_cross = KA_->in[8]; const float* g_mem = KA_->in[9]; const float* w_q_mem = KA_->in[10]; const float* w_kv_mem = KA_->in[11]; const float* w_o_mem = KA_->in[12]; const float* g_ffn = KA_->in[13]; const float* w_up = KA_->in[14]; const float* conv_w = KA_->in[15]; const float* conv_b = KA_->in[16]; const float* w_down = KA_->in[17]; const float* g_final = KA_->in[18]; float* out = KA_->out; float* LOGF = (float*)(ws + WS_LOGF); float* CC = (float*)(ws + WS_C); float* ABAR = (float*)(ws + WS_ABAR); float* KM = (float*)(ws + WS_KM); unsigned* SEL = (unsigned*)(ws + WS_SEL); float* SSQ1 = (float*)(ws + WS_SSQ1); float* SSQ2 = (float*)(ws + WS_SSQ2); float* SSQ3 = (float*)(ws + WS_SSQ3); bf16* MEMN = (bf16*)(ws + WS_MEMN); bf16* KV = (bf16*)(ws + WS_KV); bf16* WQS = (bf16*)(ws + WS_WQS); bf16* WOT = (bf16*)(ws + WS_WOT); bf16* WKVT = (bf16*)(ws + WS_WKVT); bf16* WINT = (bf16*)(ws + WS_WINT); bf16* WOUTT = (bf16*)(ws + WS_WOUTT); bf16* WUPT = (bf16*)(ws + WS_WUPT); bf16* WDT = (bf16*)(ws + WS_WDT); bf16* ZT = (bf16*)(ws + WS_ZT); bf16* WQK = (bf16*)(ws + WS_WQK); bf16* VWO = (bf16*)(ws + WS_VWO); bf16* A1 = (bf16*)(ws + WS_A1); bf16* QKV = (bf16*)(ws + WS_QKV); bf16* Y = (bf16*)(ws + WS_Y); bf16* HB1 = (bf16*)(ws + WS_HB1); bf16* PB = (bf16*)(ws + WS_P); bf16* HB2 = (bf16*)(ws + WS_HB2); bf16* GB = (bf16*)(ws + WS_G); bf16* UB = (bf16*)(ws + WS_U); bf16* PO = (bf16*)(ws + WS_PO); unsigned* LIST = (unsigned*)(ws + WS_LIST); float* PML = (float*)(ws + WS_PML); bf16* KXF = (bf16*)(ws + WS_KXF); bf16* KXM = (bf16*)(ws + WS_KXM); unsigned* CNT = (unsigned*)(ws + WS_CNT);
__global__ void __launch_bounds__(NWAVES * 64, 2) fwd(Args args) {
    extern __shared__ __attribute__((aligned(16))) unsigned char lds[];
    LAS unsigned char* L = (LAS unsigned char*)lds;
    LAS unsigned char* XL = L + XL_OFF;
    volatile LAS unsigned* MISC = (volatile LAS unsigned*)(L + MISC_OFF);
    const int tid = threadIdx.x, lane = tid & 63, wave = __builtin_amdgcn_readfirstlane(tid >> 6);
    const int G = gridDim.x, bx = blockIdx.x;
    const int gw = bx * NWAVES + wave, NGW = G * NWAVES;
    for (int u = tid; u < (LDS_BYTES - LDSCTL_OFF) / 4; u += NWAVES * 64) ((LAS unsigned*)(L + LDSCTL_OFF))[u] = 0u;
    __syncthreads();
    XcdBarrier bar; { DECL_PTRS; bar = xcd_barrier_post((unsigned*)(ctl + CW_BAR), MISC + 8); }

    { DECL_PTRS;
        LAS float* scr = (LAS float*)(L + RING_OFF + wave * 16384);
        constexpr int I_IN = (D / 64) * (NQKV / 32), I_OUT = (D / 64) * (D / 32), I_KV = (D / 64) * (2048 / 32), I_O = I_OUT, I_UP = (D / 64) * (2 * FF / 32), I_DN = (FF / 64) * (D / 32);
        constexpr int NITEMS = I_IN + I_OUT + I_KV + I_O + I_UP + I_DN;
        for (int it = gw; it < NITEMS; it += NGW) {
            int r = it;
            if (r < I_IN) { p0_transpose_item(w_in, INC, D, NQKV, WINT, nullptr, true, scr, r, lane); continue; } r -= I_IN;
            if (r < I_OUT) { p0_transpose_item(w_out, D, D, D, WOUTT, nullptr, false, scr, r, lane); continue; } r -= I_OUT;
            if (r < I_KV) { p0_transpose_item(w_kv_mem, 2048, D, 2048, WKVT, nullptr, false, scr, r, lane); continue; } r -= I_KV;
            if (r < I_O) { p0_transpose_item(w_o_mem, D, D, D, WOT, nullptr, false, scr, r, lane); continue; } r -= I_O;
            if (r < I_UP) { p0_transpose_item(w_up, 2 * FF, D, 2 * FF, WUPT, g_ffn, false, scr, r, lane); continue; } r -= I_UP;
            p0_transpose_item(w_down, D, FF, D, WDT, nullptr, false, scr, r, lane);
        }
        for (int i = bx * 512 + tid; i < D * D / 4; i += G * 512) { const int kk = (i * 4) >> 10; const f32x4 v = *(const f32x4*)(w_q_mem + (size_t)i * 4) * (g_cross[kk] * (LOG2E / 16.0f));
            *(unsigned long long*)(WQS + (size_t)i * 4) = (unsigned long long)pk2(v[0], v[1]) | ((unsigned long long)pk2(v[2], v[3]) << 32); }
        for (int r = gw; r < NB * 256; r += NGW) { const GAS f32x4* xr = (const GAS f32x4*)(mem + (size_t)r * D) + lane; f32x4 v[4]; float s = 0.f;
#pragma unroll
            for (int j = 0; j < 4; ++j) { v[j] = xr[64 * j]; s += (v[j][0] * v[j][0] + v[j][1] * v[j][1]) + (v[j][2] * v[j][2] + v[j][3] * v[j][3]); }
            const float rs = __builtin_amdgcn_rsqf(wave_sum(s) * (1.f / D) + RMS_EPS);
            GAS unsigned long long* o8 = (GAS unsigned long long*)(MEMN + (size_t)r * D) + lane;
#pragma unroll
            for (int j = 0; j < 4; ++j) { const f32x4 gg = *((const f32x4*)g_mem + 64 * j + lane); const f32x4 a = v[j] * rs * gg; o8[64 * j] = (unsigned long long)pk2(a[0], a[1]) | ((unsigned long long)pk2(a[2], a[3]) << 32); } }
        __syncthreads();
        LAS float* wf = (LAS float*)(L + RING_OFF);
        LAS float* part = (LAS float*)(L + RING_OFF + 32768);
        for (int i = tid; i < 8 * 1024; i += 512) { const int h = i >> 10, kk = i & 1023; wf[i] = w_in[(size_t)kk * INC + C_F + h]; }
        __syncthreads();
        f32x4 gm[4];
#pragma unroll
        for (int j = 0; j < 4; ++j) gm[j] = *((const f32x4*)g_mix + 64 * j + lane);
        for (int blk = bx; blk < M / 256; blk += G) {
            f32x4 accm[4];
#pragma unroll
            for (int j = 0; j < 4; ++j) accm[j] = (f32x4){0.f, 0.f, 0.f, 0.f};
            for (int i0 = 0; i0 < 32; i0 += 2) {
              f32x4 vv[2][4];
#pragma unroll
              for (int rr = 0; rr < 2; ++rr) { const GAS f32x4* xr = (const GAS f32x4*)(x + ((size_t)blk * 256 + wave * 32 + i0 + rr) * D) + lane;
#pragma unroll
                  for (int j = 0; j < 4; ++j) vv[rr][j] = xr[64 * j]; }
#pragma unroll
              for (int rr = 0; rr < 2; ++rr) {
                const size_t r = (size_t)blk * 256 + wave * 32 + i0 + rr;
                f32x4 v[4]; float s = 0.f;
#pragma unroll
                for (int j = 0; j < 4; ++j) { v[j] = vv[rr][j]; s += (v[j][0] * v[j][0] + v[j][1] * v[j][1]) + (v[j][2] * v[j][2] + v[j][3] * v[j][3]); }
                const float rs = __builtin_amdgcn_rsqf(wave_sum(s) * (1.f / D) + RMS_EPS);
                GAS unsigned long long* o8 = (GAS unsigned long long*)(A1 + r * 2048) + lane;
                float fl[8];
#pragma unroll
                for (int h = 0; h < 8; ++h) fl[h] = 0.f;
#pragma unroll
                for (int j = 0; j < 4; ++j) { const f32x4 a = v[j] * rs * gm[j]; accm[j] += a;
                    const unsigned h0 = pk2(a[0], a[1]), h1 = pk2(a[2], a[3]);
                    o8[64 * j] = (unsigned long long)h0 | ((unsigned long long)h1 << 32);
                    const unsigned l0 = pk2(a[0] - bflo(h0), a[1] - bfhi(h0)), l1 = pk2(a[2] - bflo(h1), a[3] - bfhi(h1));
                    o8[256 + 64 * j] = (unsigned long long)l0 | ((unsigned long long)l1 << 32);
#pragma unroll
                    for (int h = 0; h < 8; ++h) { const f32x4 w = *((const LAS f32x4*)(wf + h * 1024) + 64 * j + lane); fl[h] += (a[0] * w[0] + a[1] * w[1]) + (a[2] * w[2] + a[3] * w[3]); } }
#pragma unroll
                for (int h = 0; h < 8; ++h) fl[h] = wave_sum(fl[h]);
                if (lane < 8) { float z = fl[0];
#pragma unroll
                    for (int h = 1; h < 8; ++h) z = (lane == h) ? fl[h] : z;
                    z += b_forget[lane];
                    LOGF[r * 8 + lane] = fminf(z, 0.f) - log1pf(__expf(-fabsf(z))); }
              }
            }
#pragma unroll
            for (int j = 0; j < 4; ++j) *((LAS f32x4*)(part + wave * 1024) + 64 * j + lane) = accm[j];
            __syncthreads();
            for (int col = tid; col < 1024; col += 512) { float s = 0.f;
#pragma unroll
                for (int w = 0; w < 8; ++w) s += part[w * 1024 + col];
                ABAR[(size_t)blk * 1024 + col] = s * (1.0f / 256.0f); }
            __syncthreads();
        }
    }
    xcd_barrier(bar);

    { DECL_PTRS;
        LAS float* sc = (LAS float*)(L + RING_OFF);
        for (int w = bx; w < 64; w += G) {
            const int b = w >> 3, h = w & 7; float v[16]; float run = 0.f;
#pragma unroll
            for (int i = 0; i < 16; ++i) { run += LOGF[((size_t)b * T + tid * 16 + i) * 8 + h]; v[i] = run; }
            float incl = run;
#pragma unroll
            for (int o = 1; o < 64; o <<= 1) { const float n = __shfl_up(incl, o); if (lane >= o) incl += n; }
            if (lane == 63) sc[wave] = incl;
            __syncthreads();
            float pre = incl - run;
            for (int ww = 0; ww < wave; ++ww) pre += sc[ww];
#pragma unroll
            for (int i = 0; i < 16; ++i) CC[(size_t)w * T + tid * 16 + i] = pre + v[i];
            __syncthreads();
        }
        for (int n = bx; n < 256; n += G) {
            for (int i = tid; i < 1024; i += 512) sc[i] = ABAR[(size_t)n * 1024 + i];
            __syncthreads();
            float s = 0.f;
            for (int kk = 0; kk < 1024; ++kk) s += sc[kk] * w_in[(size_t)kk * INC + C_KM + tid];
            KM[(size_t)n * 512 + tid] = s;
            __syncthreads();
        }
        pg8::Gemm g{MEMN, WKVT, D / 64, D * 2, D * 2, 0xffffffffu}; pg8::TileOrder S; S.init(NB * 256, 2048, G, bx, D * 2, D * 2, 0, 1 << 30);
        pg8::EpiBf16 E{KV, 2048, 0u, 1.f, nullptr};
        pg8::gemm_phase<pg8::EpiBf16, pg8::TileOrder, true>(L + RING_OFF, XL, g, S, E);
    }
    xcd_barrier(bar);

    { DECL_PTRS;
        LAS float* sc = (LAS float*)(L + RING_OFF);
        for (int n = bx; n < 256; n += G) {
            const int b = n >> 5, nb = n & 31;
            sc[tid] = KM[(size_t)n * 512 + tid];
            __syncthreads();
            f32x4 k0 = *(const LAS f32x4*)(sc + lane * 8), k1 = *(const LAS f32x4*)(sc + lane * 8 + 4);
            for (int i = 0; i < 128; ++i) { const int kk = wave * 128 + i;
                const f32x4 w0 = *(const f32x4*)(w_in + (size_t)kk * INC + C_QM + lane * 8), w1 = *(const f32x4*)(w_in + (size_t)kk * INC + C_QM + lane * 8 + 4);
                float s = (w0[0] * k0[0] + w0[1] * k0[1]) + (w0[2] * k0[2] + w0[3] * k0[3]) + (w1[0] * k1[0] + w1[1] * k1[1]) + (w1[2] * k1[2] + w1[3] * k1[3]);
                s += __shfl_xor(s, 1); s += __shfl_xor(s, 2); s += __shfl_xor(s, 4);
                if ((lane & 7) == 0) { const int h = lane >> 3; const unsigned hi = f2bf(s); const unsigned lo = f2bf(s - bf2f(hi));
                    bf16* zr = ZT + ((size_t)b * 256 + h * 32 + nb) * 3072; zr[kk] = (bf16)hi; zr[1024 + kk] = (bf16)hi; zr[2048 + kk] = (bf16)lo; } }
            __syncthreads();
        }
        for (int i = bx * 512 + tid; i < 64 * T + 8 * 256; i += G * 512) {
            float bv; bf16* dst;
            if (i < 64 * T) { bv = -CC[i] * LOG2E; dst = KXF + (size_t)i * 8; }
            else { const int j = i - 64 * T; bv = __builtin_amdgcn_exp2f(-(float)((j >> 8) + 1)) * LOG2E * (float)(j & 255); dst = KXM + (size_t)j * 8; }
            const unsigned h0 = f2bf(bv); const float r1 = bv - bf2f(h0); const unsigned h1 = f2bf(r1); const unsigned h2 = f2bf(r1 - bf2f(h1));
            *(v4u*)dst = (v4u){h0 | (h1 << 16), h2 | (0x3F80u << 16), 0x3F80u, 0u}; }
        { pg8::Gemm g{KV, WQS, 4, 4096, 2048, 0xffffffffu}; WqkOrder S{G, bx}; pg8::EpiF8 E{(unsigned char*)WQK, 1024, 32.0f};
          pg8::gemm_phase<pg8::EpiF8, WqkOrder, true>(L + RING_OFF, XL, g, S, E); }
        { pg8::Gemm g{WOT, KV, 4, 2048, 4096, 0xffffffffu}; VwoOrder S{G, (bx + 128) % G}; pg8::EpiF8 E{(unsigned char*)VWO, 1024, 4.0f};
          pg8::gemm_phase<pg8::EpiF8, VwoOrder, true>(L + RING_OFF, XL, g, S, E); }
    }
    xcd_barrier(bar);

    { DECL_PTRS;
        { pg8::Gemm g{A1, WINT, D / 64, 4096, D * 2, 0xffffffffu}; pg8::TileOrder S; S.init(M, NQKV, G, bx, 4096, D * 2, 0, 1 << 30);
          pg8::EpiBf16 E{QKV, NQKV, 0xC3u, C2, (unsigned*)(ctl + CW_QKN)};
          pg8::gemm_phase<pg8::EpiBf16, pg8::TileOrder, true>(L + RING_OFF, XL, g, S, E); }
        { pg8::Gemm g{A1, ZT, 3072 / 64, 4096, 6144, 4095u}; pg8::TileOrder S; S.init(M, 256, G, bx, 4096, 6144, (size_t)256 * 6144, 32);
          pg8::EpiGate E{SEL};
          pg8::gemm_phase<pg8::EpiGate, pg8::TileOrder, true>(L + RING_OFF, XL, g, S, E); }
    }
    xcd_barrier(bar);

    { DECL_PTRS;
        for (int e = bx * 512 + tid; e < 2048; e += G * 512) { const int bh = e >> 5, qb = e & 31;
            const unsigned* qk = (const unsigned*)(ctl + CW_QKN) + bh * 4;
            const float qn = sqrtf(__uint_as_float(__hip_atomic_load(qk, RLX_AGENT)) + __uint_as_float(__hip_atomic_load(qk + 1, RLX_AGENT))), kn = sqrtf(__uint_as_float(__hip_atomic_load(qk + 2, RLX_AGENT)) + __uint_as_float(__hip_atomic_load(qk + 3, RLX_AGENT)));
            const float thr = (2.0f * qn * kn * 1.02f + 40.0f) * (1.0f / LOG2E);
            const float* crow_ = CC + (size_t)bh * T; const int t0 = qb * 256; const float target = crow_[t0] + thr;
            int lo = 0, hi2 = t0;
            while (lo < hi2) { const int mid = (lo + hi2) >> 1; if (crow_[mid] >= target) lo = mid + 1; else hi2 = mid; }
            ((int*)(ctl + CW_T0TAB))[e] = (lo >> 6) & ~1; }
        LAS unsigned* wc = (LAS unsigned*)(L + RING_OFF);
        for (int w = bx; w < 2048; w += G) {
            const int bh = (w & 255) >> 2, n = (w & 3) + 4 * (w >> 8), trip = bh * 32 + n; const unsigned* selrow = SEL + (size_t)bh * T; unsigned base = 0u;
            for (int t0 = (n + 1) * 256; t0 < T; t0 += 2048) {
                unsigned m[4]; unsigned long long bal[4];
#pragma unroll
                for (int j = 0; j < 4; ++j) { const int t = t0 + j * 512 + tid; m[j] = 0u; if (t < T) m[j] = selrow[t]; }
#pragma unroll
                for (int j = 0; j < 4; ++j) { bal[j] = __ballot((m[j] >> n) & 1u); if (lane == 0) wc[j * 8 + wave] = (unsigned)__popcll(bal[j]); }
                __syncthreads();
                unsigned run = base;
#pragma unroll
                for (int j = 0; j < 4; ++j) { unsigned pre = 0u, tot = 0u;
#pragma unroll
                    for (int ww = 0; ww < 8; ++ww) { const unsigned c = wc[j * 8 + ww]; tot += c; if (ww < wave) pre += c; }
                    if ((m[j] >> n) & 1u) { const unsigned pos = run + pre + (unsigned)__popcll(bal[j] & ((1ull << lane) - 1ull)); const unsigned k = (unsigned)__popc(m[j] & ((1u << n) - 1u));
                        LIST[(size_t)trip * 8192 + pos] = (unsigned)(t0 + j * 512 + tid) | (k << 16); }
                    run += tot; }
                base = run;
                __syncthreads();
            }
            if (tid == 0) CNT[trip] = base;
        }
    }
    xcd_barrier(bar);

    { DECL_PTRS;
        LAS int* upre = (LAS int*)(L + RING_OFF + attn_body::ATTN_LDS_BYTES);
        LAS int* wsum = upre + 2052;
        { int c4[4]; int run = 0;
#pragma unroll
          for (int i = 0; i < 4; ++i) { c4[i] = run; run += (int)((CNT[tid * 4 + i] + 255u) >> 8); }
          int incl = run;
#pragma unroll
          for (int o = 1; o < 64; o <<= 1) { const int nn = __shfl_up(incl, o); if (lane >= o) incl += nn; }
          if (lane == 63) wsum[wave] = incl;
          __syncthreads();
          int pre = incl - run;
          for (int ww = 0; ww < wave; ++ww) pre += wsum[ww];
#pragma unroll
          for (int i = 0; i < 4; ++i) upre[tid * 4 + i] = pre + c4[i];
          if (tid == 511) upre[2048] = pre + run;
          __syncthreads(); }
        const int ntot = 4096 + upre[2048];
        const attn_body::hb16* Qb = (const attn_body::hb16*)QKV;
        const int r32 = lane & 31;
        LAS unsigned* qnext = (LAS unsigned*)(wsum + 16);
        unsigned* qhead = (unsigned*)(ctl + CW_QUEUE);
        if (tid == 0) qnext[0] = atomicAdd(qhead, 1u);
        __syncthreads();
        for (;;) {
            const int u = (int)qnext[0];
            if (u >= ntot) break;
            __syncthreads();
            unsigned nxt_ = 0u; if (tid == 0) nxt_ = atomicAdd(qhead, 1u);
            int kind, qrow, oslot = -1, NT, band0; const attn_body::hb16 *Qc, *Kt0, *Vt0, *KXt0;
            if (u < 2048) {
                const int qb = 31 - (u >> 6), bh = u & 63;
                const int b = bh >> 3, h = bh & 7;
                const int T0 = ((const int*)(ctl + CW_T0TAB))[bh * 32 + qb];
                kind = 0; qrow = b * T + qb * 256 + wave * 32 + r32; NT = 4 * (qb + 1) - T0; band0 = NT - 4;
                Qc = Qb + h * 64; Kt0 = Qb + (size_t)(b * T + T0 * 64) * NQKV + 512 + h * 64; Vt0 = Kt0 + 512; KXt0 = (const attn_body::hb16*)KXF + ((size_t)bh * T + T0 * 64) * 8;
            } else if (u < 4096) {
                const int w = u - 2048, bh = w >> 5, j = w & 31, b = bh >> 3, h = bh & 7;
                kind = 1; qrow = b * T + j * 256 + wave * 32 + r32; oslot = (qrow * 8 + h) * 4 + 3; NT = 4; band0 = 0;
                Qc = Qb + 1536 + h * 64; Kt0 = Qb + (size_t)(b * T + j * 256) * NQKV + 2048 + h * 64; Vt0 = Kt0 + 512; KXt0 = (const attn_body::hb16*)KXM + h * 256 * 8;
            } else {
                const int g = u - 4096; int lo = 0, hi2 = 2048;
                while (hi2 - lo > 1) { const int mid = (lo + hi2) >> 1; if (upre[mid] <= g) lo = mid; else hi2 = mid; }
                const int w = lo, c = g - upre[lo], bh = w >> 5, n = w & 31, b = bh >> 3, h = bh & 7; const int cnt = (int)CNT[w];
                int idx = c * 256 + wave * 32 + r32; const bool valid = idx < cnt; if (!valid) idx = cnt - 1;
                const unsigned e = LIST[(size_t)w * 8192 + idx];
                kind = 1; qrow = b * T + (int)(e & 0xffffu); oslot = valid ? (qrow * 8 + h) * 4 + (int)(e >> 16) : -1; NT = 4; band0 = 1 << 20;
                Qc = Qb + 1536 + h * 64; Kt0 = Qb + (size_t)(b * T + n * 256) * NQKV + 2048 + h * 64; Vt0 = Kt0 + 512; KXt0 = (const attn_body::hb16*)KXM + h * 256 * 8;
            }
            attn_body::attn_unit<8>((char*)lds + RING_OFF, kind, Qc, qrow, oslot, Kt0, Vt0, KXt0, NT, band0, (attn_body::hb16*)QKV + (Qc - Qb), (attn_body::hb16*)PO, PML);
            if (tid == 0) qnext[0] = nxt_;
            __syncthreads();
        }
    }
    xcd_barrier(bar);

    { DECL_PTRS;
    const f32x4 ga0 = *((const f32x4*)g_fox + 2 * lane), ga1 = *((const f32x4*)g_fox + 2 * lane + 1), gb0 = *((const f32x4*)g_moba + 2 * lane), gb1 = *((const f32x4*)g_moba + 2 * lane + 1);
    const int h = lane >> 3, cc = lane & 7; const float s2 = __builtin_amdgcn_exp2f(-(float)(h + 1)) * LOG2E * 256.0f;
    for (int r0 = gw * 2; r0 < M; r0 += NGW * 2) {
        v4u wa[2], pw[2][4]; unsigned mmv[2]; pg8::f32x2 ml[2][4];
#pragma unroll
        for (int rr = 0; rr < 2; ++rr) { const int r = r0 + rr, b = r >> 13, t = r & (T - 1); const size_t sb = ((size_t)r * 8 + h) * 4;
            wa[rr] = *((const v4u*)(QKV + (size_t)r * NQKV) + lane); mmv[rr] = SEL[((size_t)(b * 8 + h)) * T + t];
#pragma unroll
            for (int k = 0; k < 4; ++k) { ml[rr][k] = *(const pg8::f32x2*)(PML + (sb + k) * 2); pw[rr][k] = *((const v4u*)(PO + (sb + k) * 64) + cc); } }
#pragma unroll
        for (int rr = 0; rr < 2; ++rr) { const int r = r0 + rr, t = r & (T - 1), own = t >> 8;
            const float a[8] = {bflo(wa[rr].x), bfhi(wa[rr].x), bflo(wa[rr].y), bfhi(wa[rr].y), bflo(wa[rr].z), bfhi(wa[rr].z), bflo(wa[rr].w), bfhi(wa[rr].w)};
            float c[8]; unsigned mm = mmv[rr]; const int cnt = __popc(mm);
            float mk[4], lk[4];
#pragma unroll
            for (int k = 0; k < 4; ++k) { mk[k] = ml[rr][k].x; lk[k] = ml[rr][k].y; }
            mk[3] += s2 * (float)own; float Mx = mk[3];
#pragma unroll
            for (int k = 0; k < 3; ++k) { if (k < cnt) { const int nb = __ffs(mm) - 1; mm &= mm - 1u; mk[k] += s2 * (float)nb; Mx = fmaxf(Mx, mk[k]); } }
            float W = 0.f;
#pragma unroll
            for (int i = 0; i < 8; ++i) c[i] = 0.f;
#pragma unroll
            for (int k = 0; k < 4; ++k) { if (k == 3 || k < cnt) { const float w = lk[k] * __builtin_amdgcn_exp2f(mk[k] - Mx); W += w; const v4u p = pw[rr][k];
                c[0] += w * bflo(p.x); c[1] += w * bfhi(p.x); c[2] += w * bflo(p.y); c[3] += w * bfhi(p.y); c[4] += w * bflo(p.z); c[5] += w * bfhi(p.z); c[6] += w * bflo(p.w); c[7] += w * bfhi(p.w); } }
            const float iw = 1.0f / W;
#pragma unroll
            for (int i = 0; i < 8; ++i) c[i] *= iw;
            float sa = 0.f, sb2 = 0.f;
#pragma unroll
            for (int i = 0; i < 8; ++i) { sa += a[i] * a[i]; sb2 += c[i] * c[i]; }
            const float ra = __builtin_amdgcn_rsqf(wave_sum(sa) * (1.f / 512.f) + RMS_EPS), rb = __builtin_amdgcn_rsqf(wave_sum(sb2) * (1.f / 512.f) + RMS_EPS);
            v4u oa, ob;
            oa.x = pk2(a[0] * ra * ga0[0], a[1] * ra * ga0[1]); oa.y = pk2(a[2] * ra * ga0[2], a[3] * ra * ga0[3]); oa.z = pk2(a[4] * ra * ga1[0], a[5] * ra * ga1[1]); oa.w = pk2(a[6] * ra * ga1[2], a[7] * ra * ga1[3]);
            ob.x = pk2(c[0] * rb * gb0[0], c[1] * rb * gb0[1]); ob.y = pk2(c[2] * rb * gb0[2], c[3] * rb * gb0[3]); ob.z = pk2(c[4] * rb * gb1[0], c[5] * rb * gb1[1]); ob.w = pk2(c[6] * rb * gb1[2], c[7] * rb * gb1[3]);
            *((v4u*)(Y + (size_t)r * D) + lane) = oa; *((v4u*)(Y + (size_t)r * D + 512) + lane) = ob; }
    } }
    xcd_barrier(bar);

    { DECL_PTRS; pg8::Gemm g{Y, WOUTT, D / 64, D * 2, D * 2, 0xffffffffu}; pg8::TileOrder S; S.init(M, D, G, bx, D * 2, D * 2, 0, 1 << 30);
      pg8::EpiRes E{x, out, nullptr, (unsigned char*)HB1, SSQ1, 1.0f};
      pg8::gemm_phase<pg8::EpiRes, pg8::TileOrder, true>(L + RING_OFF, XL, g, S, E); }
    xcd_barrier(bar);

    { DECL_PTRS; pg8::Gemm g{HB1, WQK, D / 128, D, D, 0xffffffffu}; pg8::TileOrder S; S.init(M, D, G, bx, D, D, (size_t)D * D, 32);
      pg8::EpiSoftmax E{(unsigned char*)PB, SSQ1, 1.0f / 32.0f};
      pg8::gemm_phase<pg8::EpiSoftmax, pg8::TileOrder, true, true>(L + RING_OFF, XL, g, S, E); }
    xcd_barrier(bar);

    { DECL_PTRS; pg8::Gemm g{PB, VWO, D / 128, D, D, 0xffffffffu}; pg8::TileOrder S; S.init(M, D, G, bx, D, D, (size_t)D * D, 32);
      pg8::EpiRes E{out, out, HB2, nullptr, SSQ2, 1.0f / 1024.0f};
      pg8::gemm_phase<pg8::EpiRes, pg8::TileOrder, true, true>(L + RING_OFF, XL, g, S, E); }
    xcd_barrier(bar);

    { DECL_PTRS; pg8::Gemm g{HB2, WUPT, D / 64, D * 2, D * 2, 0xffffffffu}; pg8::TileOrder S; S.init(M, 2 * FF, G, bx, D * 2, D * 2, 0, 1 << 30);
      pg8::EpiUp E{GB, UB, SSQ2};
      pg8::gemm_phase<pg8::EpiUp, pg8::TileOrder, true>(L + RING_OFF, XL, g, S, E); }
    xcd_barrier(bar);

    { DECL_PTRS;
    for (int it = bx * 512 + tid; it < (M / 32) * (FF / 8); it += G * 512) {
        const int rc = it / (FF / 8), cg = (it - rc * (FF / 8)) * 8; const size_t r0 = (size_t)rc * 32; const int tt0 = (int)(r0 & (T - 1));
        float w0[8], w1[8], w2[8], cb[8], g0[8], g1[8];
#pragma unroll
        for (int q = 0; q < 2; ++q) { const f32x4 a0 = *(const f32x4*)(conv_w + cg + 4 * q), a1 = *(const f32x4*)(conv_w + FF + cg + 4 * q), a2 = *(const f32x4*)(conv_w + 2 * FF + cg + 4 * q), bb = *(const f32x4*)(conv_b + cg + 4 * q);
#pragma unroll
            for (int e = 0; e < 4; ++e) { w0[4 * q + e] = a0[e]; w1[4 * q + e] = a1[e]; w2[4 * q + e] = a2[e]; cb[4 * q + e] = bb[e]; } }
        if (tt0 >= 2) { const v4u p1 = *(const v4u*)(GB + (r0 - 1) * FF + cg), p0 = *(const v4u*)(GB + (r0 - 2) * FF + cg);
            g1[0] = bflo(p1.x); g1[1] = bfhi(p1.x); g1[2] = bflo(p1.y); g1[3] = bfhi(p1.y); g1[4] = bflo(p1.z); g1[5] = bfhi(p1.z); g1[6] = bflo(p1.w); g1[7] = bfhi(p1.w);
            g0[0] = bflo(p0.x); g0[1] = bfhi(p0.x); g0[2] = bflo(p0.y); g0[3] = bfhi(p0.y); g0[4] = bflo(p0.z); g0[5] = bfhi(p0.z); g0[6] = bflo(p0.w); g0[7] = bfhi(p0.w); }
        else {
#pragma unroll
            for (int e = 0; e < 8; ++e) { g0[e] = 0.f; g1[e] = 0.f; } }
#pragma unroll 4
        for (int i = 0; i < 32; ++i) { const size_t off = (r0 + i) * FF + cg;
            const v4u gw2 = *(const v4u*)(GB + off), uw = *(const v4u*)(UB + off);
            const float g2[8] = {bflo(gw2.x), bfhi(gw2.x), bflo(gw2.y), bfhi(gw2.y), bflo(gw2.z), bfhi(gw2.z), bflo(gw2.w), bfhi(gw2.w)};
            const float uu[8] = {bflo(uw.x), bfhi(uw.x), bflo(uw.y), bfhi(uw.y), bflo(uw.z), bfhi(uw.z), bflo(uw.w), bfhi(uw.w)};
            float res[8];
#pragma unroll
            for (int e = 0; e < 8; ++e) { const float gc = cb[e] + w0[e] * g0[e] + w1[e] * g1[e] + w2[e] * g2[e];
                res[e] = gc * __builtin_amdgcn_rcpf(1.0f + __builtin_amdgcn_exp2f(-LOG2E * gc)) * uu[e]; g0[e] = g1[e]; g1[e] = g2[e]; }
            *(v4u*)(UB + off) = (v4u){pk2(res[0], res[1]), pk2(res[2], res[3]), pk2(res[4], res[5]), pk2(res[6], res[7])}; }
    } }
    xcd_barrier(bar);

    { DECL_PTRS; pg8::Gemm g{UB, WDT, FF / 64, FF * 2, FF * 2, 0xffffffffu}; pg8::TileOrder S; S.init(M, D, G, bx, FF * 2, FF * 2, 0, 1 << 30);
      pg8::EpiRes E{out, out, nullptr, nullptr, SSQ3, 1.0f};
      pg8::gemm_phase<pg8::EpiRes, pg8::TileOrder, true>(L + RING_OFF, XL, g, S, E); }
    xcd_barrier(bar);

    { DECL_PTRS;
    f32x4 gf[4];
#pragma unroll
    for (int j = 0; j < 4; ++j) gf[j] = *((const f32x4*)g_final + 64 * j + lane);
    for (int r0 = gw * 4; r0 < M; r0 += NGW * 4) {
        f32x4 v[4][4]; float rs[4];
#pragma unroll
        for (int k = 0; k < 4; ++k) { rs[k] = pg8::rstd_from_slots(SSQ3 + (size_t)(r0 + k) * 16); const GAS f32x4* o = (const GAS f32x4*)(out + (size_t)(r0 + k) * D) + lane;
#pragma unroll
            for (int j = 0; j < 4; ++j) v[k][j] = o[64 * j]; }
#pragma unroll
        for (int k = 0; k < 4; ++k) { GAS f32x4* o = (GAS f32x4*)(out + (size_t)(r0 + k) * D) + lane;
#pragma unroll
            for (int j = 0; j < 4; ++j) o[64 * j] = v[k][j] * rs[k] * gf[j]; }
    } }
}

extern "C" void kernel_launch(void* const* d_in, const int* in_sizes, int n_in, void* d_out, int out_size, void* d_ws, size_t ws_size, hipStream_t stream) {
    static int grid = 0;
    if (grid == 0) {
        if (n_in != 19 || in_sizes[0] != M * D || out_size != M * D || ws_size < WS_END) { fprintf(stderr, "kernel_launch: unexpected problem shape (n_in %d, in0 %d, out %d, ws %zu); nothing launched\n", n_in, n_in > 0 ? in_sizes[0] : -1, out_size, ws_size); grid = -1; return; }
        int dev = 0, cus = 0, per_cu = 0;
        if (hipGetDevice(&dev) != hipSuccess || hipDeviceGetAttribute(&cus, hipDeviceAttributeMultiprocessorCount, dev) != hipSuccess) { grid = -1; return; }
        if (hipFuncSetAttribute((const void*)fwd, hipFuncAttributeMaxDynamicSharedMemorySize, LDS_BYTES) != hipSuccess) { fprintf(stderr, "kernel_launch: hipFuncSetAttribute failed\n"); grid = -1; return; }
        if (hipOccupancyMaxActiveBlocksPerMultiprocessor(&per_cu, (const void*)fwd, NWAVES * 64, LDS_BYTES) != hipSuccess || per_cu < 1) { fprintf(stderr, "kernel_launch: occupancy query reports %d\n", per_cu); }
        (void)hipGetLastError();
        grid = cus;
    }
    if (grid < 0) return;
    if (hipMemsetAsync((char*)d_ws + WS_CTL, 0, CTL_ZERO_BYTES, stream) != hipSuccess) return;
    Args a{};
    for (int i = 0; i < 19; ++i) a.in[i] = (const float*)d_in[i];
    a.out = (float*)d_out; a.ws = (unsigned char*)d_ws;
    hipLaunchKernelGGL(fwd, dim3(grid), dim3(NWAVES * 64), LDS_BYTES, stream, a);
}
```

```cpp
#include <hip/hip_runtime.h>
#include <hip/hip_bf16.h>
#include <cstdio>
#include <cstdint>

namespace pg8 {
#define PG8_LAS __attribute__((address_space(3)))
typedef unsigned short bf16_t;
typedef short bf16x8 __attribute__((ext_vector_type(8)));
typedef float f32x4 __attribute__((ext_vector_type(4)));
typedef float f32x2 __attribute__((ext_vector_type(2)));
typedef unsigned u32x4 __attribute__((ext_vector_type(4)));
typedef unsigned u32x2 __attribute__((ext_vector_type(2)));
typedef int i32x4 __attribute__((ext_vector_type(4)));
typedef int i32x8 __attribute__((ext_vector_type(8)));
constexpr int BM = 256, BK = 64, HALF = 128, HTB = HALF * BK * 2  , STAGE_BYTES = 8 * HTB, NXCD = 8, WGM = 8;

__host__ __device__ __forceinline__ int lds_byte(int r, int c) { const int st = (r >> 4) * 2 + (c >> 5), rr = r & 15, cc = c & 31, ob = rr * 64 + cc * 2; return st * 1024 + (ob ^ (((ob >> 9) & 1) << 5)); }
__host__ __device__ __forceinline__ void stage_rc(int b, int& R, int& C) { const int st = b / 1024, sb = b % 1024, swz = sb ^ (((sb >> 9) & 1) << 5); R = (st >> 1) * 16 + swz / 64; C = (st & 1) * 32 + (swz % 64) / 2; }
__host__ __device__ __forceinline__ int perm32(int rho) { const int n = rho >> 4, i = rho & 15; return 8 * (i >> 2) + 4 * n + (i & 3); }

struct Unit { int pm, pn; size_t aoff, boff; };
struct Gemm { const void* A; const void* Bt; int nt, lda, ldb; unsigned wrapmask; };

struct TileOrder {
    int nM, nN, nwg, G, c; size_t a_tile, b_tile, b_batch; int pmb;
    __device__ __forceinline__ void init(int M, int N, int G_, int c_, int lda_bytes, int ldb_bytes, size_t b_batch_bytes, int pm_per_batch) {
        nM = M / BM; nN = N / BM; nwg = nM * nN; G = G_; c = c_; a_tile = (size_t)BM * lda_bytes; b_tile = (size_t)BM * ldb_bytes; b_batch = b_batch_bytes; pmb = pm_per_batch; }
    __device__ __forceinline__ bool next(int i, Unit& u) const {
        const long L = (long)i * G + c; if (L >= nwg) return false;
        int wgid = (int)L; { const int q = nwg / NXCD, r = nwg % NXCD, xcd = wgid % NXCD, off = wgid / NXCD; wgid = (xcd < r ? xcd * (q + 1) : r * (q + 1) + (xcd - r) * q) + off; }
        const int nig = WGM * nN, gid = wgid / nig, fm = gid * WGM, gsz = (nM - fm) < WGM ? (nM - fm) : WGM;
        u.pm = fm + ((wgid % nig) % gsz); u.pn = (wgid % nig) / gsz;
        u.aoff = (size_t)u.pm * a_tile; u.boff = (size_t)u.pn * b_tile + (size_t)(u.pm / pmb) * b_batch; return true;
    }
};

__device__ __forceinline__ unsigned cvt_pk_bf16(float lo, float hi) { unsigned r; asm volatile("v_cvt_pk_bf16_f32 %0, %1, %2" : "=v"(r) : "v"(lo), "v"(hi)); return r; }

typedef f32x4 AccT[2][2][4][2];

struct EpiBf16 {
    static constexpr bool PERM = true;
    bf16_t* O; int ldc; unsigned scalemask; float scale0; unsigned* nrm;
    __device__ __forceinline__ void operator()(AccT& acc, const Unit& u, int wr, int wc, int fr, int fq, PG8_LAS unsigned char*) const {
        const int row0 = u.pm * BM + wr * 64 + fr, col0 = u.pn * BM + wc * 32 + 8 * fq;
        const float sc = ((scalemask >> u.pn) & 1u) ? scale0 : 1.f;
        if (nrm && u.pn < 4) {
#pragma unroll
            for (int bj = 0; bj < 2; ++bj) { float mx = 0.f;
#pragma unroll
                for (int ai = 0; ai < 2; ++ai)
#pragma unroll
                    for (int m = 0; m < 4; ++m) { const f32x4 v0 = acc[ai][bj][m][0] * sc, v1 = acc[ai][bj][m][1] * sc;
                        float q = (v0[0] * v0[0] + v0[1] * v0[1]) + (v0[2] * v0[2] + v0[3] * v0[3]) + (v1[0] * v1[0] + v1[1] * v1[1]) + (v1[2] * v1[2] + v1[3] * v1[3]);
                        q += __shfl_xor(q, 16); q += __shfl_xor(q, 32); mx = fmaxf(mx, q); }
                mx = fmaxf(mx, __shfl_xor(mx, 1)); mx = fmaxf(mx, __shfl_xor(mx, 2)); mx = fmaxf(mx, __shfl_xor(mx, 4)); mx = fmaxf(mx, __shfl_xor(mx, 8));
                if (fr == 0 && fq == 0) { const int head = (u.pn & 1) * 4 + 2 * bj + (wc >> 1); atomicMax(nrm + (((u.pm >> 5) * 8 + head) * 2 + (u.pn >> 1)) * 2 + (wc & 1), __float_as_uint(mx)); } } }
#pragma unroll
        for (int ai = 0; ai < 2; ++ai)
#pragma unroll
            for (int m = 0; m < 4; ++m) { bf16_t* rowp = O + (size_t)(row0 + ai * HALF + m * 16) * ldc + col0;
#pragma unroll
                for (int bj = 0; bj < 2; ++bj) { const f32x4 v0 = acc[ai][bj][m][0] * sc, v1 = acc[ai][bj][m][1] * sc;
                    u32x4 w; w.x = cvt_pk_bf16(v0[0], v0[1]); w.y = cvt_pk_bf16(v0[2], v0[3]); w.z = cvt_pk_bf16(v1[0], v1[1]); w.w = cvt_pk_bf16(v1[2], v1[3]);
                    *(u32x4*)(rowp + bj * HALF) = w; } }
    }
};
__device__ __forceinline__ unsigned pk4_fp8(float a, float b, float c, float d) { int w = 0; w = __builtin_amdgcn_cvt_pk_fp8_f32(a, b, w, false); w = __builtin_amdgcn_cvt_pk_fp8_f32(c, d, w, true); return (unsigned)w; }
struct EpiF8 {
    static constexpr bool PERM = true;
    unsigned char* O; int ldc; float sc;
    __device__ __forceinline__ void operator()(AccT& acc, const Unit& u, int wr, int wc, int fr, int fq, PG8_LAS unsigned char*) const {
        const int row0 = u.pm * BM + wr * 64 + fr, col0 = u.pn * BM + wc * 32 + 8 * fq;
#pragma unroll
        for (int ai = 0; ai < 2; ++ai)
#pragma unroll
            for (int m = 0; m < 4; ++m) { unsigned char* rowp = O + (size_t)(row0 + ai * HALF + m * 16) * ldc + col0;
#pragma unroll
                for (int bj = 0; bj < 2; ++bj) { const f32x4 v0 = acc[ai][bj][m][0] * sc, v1 = acc[ai][bj][m][1] * sc;
                    *(u32x2*)(rowp + bj * HALF) = (u32x2){pk4_fp8(v0[0], v0[1], v0[2], v0[3]), pk4_fp8(v1[0], v1[1], v1[2], v1[3])}; } }
    }
};
__device__ __forceinline__ float rstd_from_slots(const float* slots) {
    const f32x4 a = *(const f32x4*)slots, b = *(const f32x4*)(slots + 4), c = *(const f32x4*)(slots + 8), d = *(const f32x4*)(slots + 12);
    const float s = ((a[0] + a[1]) + (a[2] + a[3])) + ((b[0] + b[1]) + (b[2] + b[3])) + ((c[0] + c[1]) + (c[2] + c[3])) + ((d[0] + d[1]) + (d[2] + d[3]));
    return __builtin_amdgcn_rsqf(s * (1.0f / 1024.0f) + 1e-6f);
}
struct EpiUp {
    static constexpr bool PERM = true;
    bf16_t* Gb; bf16_t* Ub; const float* ssq;
    __device__ __forceinline__ void operator()(AccT& acc, const Unit& u, int wr, int wc, int fr, int fq, PG8_LAS unsigned char*) const {
        const int row0 = u.pm * BM + wr * 64 + fr; const int pn = u.pn >= 11 ? u.pn - 11 : u.pn; bf16_t* base = u.pn >= 11 ? Ub : Gb;
        const int col0 = pn * BM + wc * 32 + 8 * fq;
#pragma unroll
        for (int ai = 0; ai < 2; ++ai)
#pragma unroll
            for (int m = 0; m < 4; ++m) { const int row = row0 + ai * HALF + m * 16; const float rs = rstd_from_slots(ssq + (size_t)row * 16); bf16_t* rowp = base + (size_t)row * 2816 + col0;
#pragma unroll
                for (int bj = 0; bj < 2; ++bj) { const f32x4 v0 = acc[ai][bj][m][0] * rs, v1 = acc[ai][bj][m][1] * rs;
                    u32x4 w; w.x = cvt_pk_bf16(v0[0], v0[1]); w.y = cvt_pk_bf16(v0[2], v0[3]); w.z = cvt_pk_bf16(v1[0], v1[1]); w.w = cvt_pk_bf16(v1[2], v1[3]);
                    *(u32x4*)(rowp + bj * HALF) = w; } }
    }
};
struct EpiRes {
    static constexpr bool PERM = true;
    const float* base; float* out; bf16_t* hb; unsigned char* hb8; float* ssq; float accs;
    __device__ __forceinline__ void operator()(AccT& acc, const Unit& u, int wr, int wc, int fr, int fq, PG8_LAS unsigned char*) const {
        const int row0 = u.pm * BM + wr * 64 + fr, col0 = u.pn * BM + wc * 32 + 8 * fq;
#pragma unroll
        for (int ai = 0; ai < 2; ++ai)
#pragma unroll
            for (int m = 0; m < 4; ++m) { const int row = row0 + ai * HALF + m * 16; const size_t off = (size_t)row * 1024 + col0; float q = 0.f;
#pragma unroll
                for (int bj = 0; bj < 2; ++bj) {
                    const f32x4 b0 = *(const f32x4*)(base + off + bj * HALF), b1 = *(const f32x4*)(base + off + bj * HALF + 4);
                    const f32x4 v0 = acc[ai][bj][m][0] * accs + b0, v1 = acc[ai][bj][m][1] * accs + b1;
                    *(f32x4*)(out + off + bj * HALF) = v0; *(f32x4*)(out + off + bj * HALF + 4) = v1;
                    q += (v0[0] * v0[0] + v0[1] * v0[1]) + (v0[2] * v0[2] + v0[3] * v0[3]) + (v1[0] * v1[0] + v1[1] * v1[1]) + (v1[2] * v1[2] + v1[3] * v1[3]);
                    if (hb) { u32x4 w; w.x = cvt_pk_bf16(v0[0], v0[1]); w.y = cvt_pk_bf16(v0[2], v0[3]); w.z = cvt_pk_bf16(v1[0], v1[1]); w.w = cvt_pk_bf16(v1[2], v1[3]); *(u32x4*)(hb + off + bj * HALF) = w; }
                    if (hb8) *(u32x2*)(hb8 + off + bj * HALF) = (u32x2){pk4_fp8(v0[0], v0[1], v0[2], v0[3]), pk4_fp8(v1[0], v1[1], v1[2], v1[3])}; }
                q += __shfl_xor(q, 16); q += __shfl_xor(q, 32);
                if (fq == 0) ssq[(size_t)row * 16 + u.pn * 4 + wc] = q; }
    }
};
struct EpiSoftmax {
    static constexpr bool PERM = true;
    unsigned char* P; const float* ssq; float sscale;
    __device__ __forceinline__ void operator()(AccT& acc, const Unit& u, int wr, int wc, int fr, int fq, PG8_LAS unsigned char* xl) const {
        PG8_LAS f32x2* X = (PG8_LAS f32x2*)xl;
        const int row0 = u.pm * BM + wr * 64 + fr, col0 = u.pn * BM + wc * 32 + 8 * fq;
        float ml[2][4];
#pragma unroll
        for (int ai = 0; ai < 2; ++ai)
#pragma unroll
            for (int m = 0; m < 4; ++m) { const int row = row0 + ai * HALF + m * 16; const float rs = rstd_from_slots(ssq + (size_t)row * 16) * sscale;
                float mx = -3.0e38f;
#pragma unroll
                for (int bj = 0; bj < 2; ++bj)
#pragma unroll
                    for (int n = 0; n < 2; ++n) { f32x4 v = acc[ai][bj][m][n] * rs; acc[ai][bj][m][n] = v; mx = fmaxf(fmaxf(mx, fmaxf(v[0], v[1])), fmaxf(v[2], v[3])); }
                mx = fmaxf(mx, __shfl_xor(mx, 16)); mx = fmaxf(mx, __shfl_xor(mx, 32));
                float s = 0.f;
#pragma unroll
                for (int bj = 0; bj < 2; ++bj)
#pragma unroll
                    for (int n = 0; n < 2; ++n) { f32x4 v = acc[ai][bj][m][n];
                        v[0] = __builtin_amdgcn_exp2f(v[0] - mx); v[1] = __builtin_amdgcn_exp2f(v[1] - mx); v[2] = __builtin_amdgcn_exp2f(v[2] - mx); v[3] = __builtin_amdgcn_exp2f(v[3] - mx);
                        acc[ai][bj][m][n] = v; s += (v[0] + v[1]) + (v[2] + v[3]); }
                s += __shfl_xor(s, 16); s += __shfl_xor(s, 32);
                ml[ai][m] = mx;
                if (fq == 0) X[(ai * HALF + wr * 64 + m * 16 + fr) * 4 + wc] = (f32x2){mx, s}; }
        asm volatile("s_waitcnt lgkmcnt(0)" ::: "memory"); __builtin_amdgcn_s_barrier(); asm volatile("" ::: "memory");
#pragma unroll
        for (int ai = 0; ai < 2; ++ai)
#pragma unroll
            for (int m = 0; m < 4; ++m) { const int rl = ai * HALF + wr * 64 + m * 16 + fr; const int row = u.pm * BM + rl;
                const f32x2 a = X[rl * 4 + 0], b = X[rl * 4 + 1], c = X[rl * 4 + 2], d = X[rl * 4 + 3];
                const float Mx = fmaxf(fmaxf(a.x, b.x), fmaxf(c.x, d.x));
                const float L = a.y * __builtin_amdgcn_exp2f(a.x - Mx) + b.y * __builtin_amdgcn_exp2f(b.x - Mx) + c.y * __builtin_amdgcn_exp2f(c.x - Mx) + d.y * __builtin_amdgcn_exp2f(d.x - Mx);
                const float f = __builtin_amdgcn_exp2f(ml[ai][m] - Mx) * __builtin_amdgcn_rcpf(L) * 256.0f;
                unsigned char* rowp = P + (size_t)row * 1024 + col0;
#pragma unroll
                for (int bj = 0; bj < 2; ++bj) { const f32x4 v0 = acc[ai][bj][m][0] * f, v1 = acc[ai][bj][m][1] * f;
                    *(u32x2*)(rowp + bj * HALF) = (u32x2){pk4_fp8(v0[0], v0[1], v0[2], v0[3]), pk4_fp8(v1[0], v1[1], v1[2], v1[3])}; } }
    }
};
struct EpiGate {
    static constexpr bool PERM = false;
    unsigned* sel;
    __device__ __forceinline__ void operator()(AccT& acc, const Unit& u, int wr, int wc, int fr, int fq, PG8_LAS unsigned char*) const {
        const int own = u.pm & 31;
#pragma unroll
        for (int ai = 0; ai < 2; ++ai)
#pragma unroll
            for (int m = 0; m < 4; ++m) { const int row = u.pm * BM + ai * HALF + wr * 64 + m * 16 + fr;
#pragma unroll
                for (int bj = 0; bj < 2; ++bj) { unsigned mask = 0u;
#pragma unroll
                    for (int round = 0; round < 3; ++round) { float bv = -3.0e38f; int bi = 32;
#pragma unroll
                        for (int n = 0; n < 2; ++n)
#pragma unroll
                            for (int i = 0; i < 4; ++i) { const int nb = 16 * n + 4 * fq + i; const float v = acc[ai][bj][m][n][i];
                                if (nb < own && !((mask >> nb) & 1u) && v > bv) { bv = v; bi = nb; } }
#pragma unroll
                        for (int off = 16; off <= 32; off <<= 1) { const float ov = __shfl_xor(bv, off); const int oi = __shfl_xor(bi, off); if (ov > bv || (ov == bv && oi < bi)) { bv = ov; bi = oi; } }
                        if (bi < 32) mask |= 1u << bi; }
                    if (fq == 0) sel[((size_t)((u.pm >> 5) * 8 + 4 * bj + wc)) * 8192 + (row & 8191)] = mask; } }
    }
};

template <class Epi, class Sched, bool ALIGN_EPI, bool F8 = false>
__device__ __forceinline__ void gemm_phase(PG8_LAS unsigned char* lds, PG8_LAS unsigned char* xl, const Gemm g, const Sched& S, const Epi& E) {
    int tid_ = threadIdx.x; asm volatile("" : "+v"(tid_));
    const int tid = tid_, wid = __builtin_amdgcn_readfirstlane(tid >> 6), lane = tid & 63, wr = wid >> 2, wc = wid & 3, fr = lane & 15, fq = lane >> 4;
    int nt = g.nt; asm volatile("" : "+s"(nt));
    unsigned voffA[2], voffB[2];
#pragma unroll
    for (int i = 0; i < 2; ++i) { int R, C; stage_rc(tid * 16 + i * 8192, R, C); const int Rb = Epi::PERM ? ((R & ~31) + perm32(R & 31)) : R;
        voffA[i] = (unsigned)(R * g.lda + C * 2); voffB[i] = (unsigned)(Rb * g.ldb + C * 2); }
    const size_t kstep = (size_t)(BK * 2);
    const size_t hstepA = (size_t)HALF * g.lda, hstepB = (size_t)HALF * g.ldb;
    const unsigned wmask = g.wrapmask;
    const unsigned ldsw = (unsigned)wid * 1024u;
    const int aoff = lds_byte(wr * 64 + fr, fq * 8), boff = lds_byte(wc * 32 + fr, fq * 8);
#define PG8_SA(b, h) (((b) * 2 + (h)) * HTB)
#define PG8_SB(b, h) ((4 + (b) * 2 + (h)) * HTB)
#define PG8_STAGE(bufoff, gbase, voff) do { _Pragma("unroll") for (int _i = 0; _i < 2; ++_i) \
        __builtin_amdgcn_global_load_lds((const unsigned*)((const char*)(gbase) + (voff)[_i]), (PG8_LAS unsigned*)(lds + (bufoff) + ldsw + _i * 8192), 16, 0, 0); } while (0)
#define PG8_LDA(dst, b, h) do { if constexpr (F8) { _Pragma("unroll") for (int m = 0; m < 4; ++m) { dst##8[m].lo = *(const PG8_LAS i32x4*)(lds + PG8_SA(b, h) + aoff + m * 2048); dst##8[m].hi = *(const PG8_LAS i32x4*)(lds + PG8_SA(b, h) + aoff + m * 2048 + 1024); } } \
        else { _Pragma("unroll") for (int m = 0; m < 4; ++m) _Pragma("unroll") for (int k = 0; k < 2; ++k) dst[m][k] = *(const PG8_LAS bf16x8*)(lds + PG8_SA(b, h) + aoff + m * 2048 + k * 1024); } } while (0)
#define PG8_LDB(dst, b, h) do { if constexpr (F8) { _Pragma("unroll") for (int n = 0; n < 2; ++n) { dst##8[n].lo = *(const PG8_LAS i32x4*)(lds + PG8_SB(b, h) + boff + n * 2048); dst##8[n].hi = *(const PG8_LAS i32x4*)(lds + PG8_SB(b, h) + boff + n * 2048 + 1024); } } \
        else { _Pragma("unroll") for (int n = 0; n < 2; ++n) _Pragma("unroll") for (int k = 0; k < 2; ++k) dst[n][k] = *(const PG8_LAS bf16x8*)(lds + PG8_SB(b, h) + boff + n * 2048 + k * 1024); } } while (0)
#define PG8_MMA(ai, bj, At, Bt) do { __builtin_amdgcn_s_setprio(1); \
        if constexpr (F8) { _Pragma("unroll") for (int m = 0; m < 4; ++m) _Pragma("unroll") for (int n = 0; n < 2; ++n) \
            asm volatile("v_mfma_f32_16x16x128_f8f6f4 %0, %1, %2, %0" : "+v"(acc[ai][bj][m][n]) : "v"(Bt##8[n]), "v"(At##8[m])); } \
        else { _Pragma("unroll") for (int m = 0; m < 4; ++m) _Pragma("unroll") for (int n = 0; n < 2; ++n) _Pragma("unroll") for (int k = 0; k < 2; ++k) \
            acc[ai][bj][m][n] = __builtin_amdgcn_mfma_f32_16x16x32_bf16(Bt[n][k], At[m][k], acc[ai][bj][m][n], 0, 0, 0); } \
        __builtin_amdgcn_s_setprio(0); } while (0)
#define PG8_WAIT_V(n) asm volatile("s_waitcnt vmcnt(" #n ")" ::: "memory")
#define PG8_WAIT_L(n) asm volatile("s_waitcnt lgkmcnt(" #n ")" ::: "memory")
#define PG8_BAR __builtin_amdgcn_s_barrier()
#define PG8_SCHED __builtin_amdgcn_sched_barrier(0)
    Unit cur, nxt; int ui = 0;
    if (!S.next(0, cur)) return;
    AccT acc;
    bf16x8 At[4][2], B0[2][2], B1[2][2]; i32x8 At8[4], B08[2], B18[2];
    const char* cA = (const char*)g.A + cur.aoff; const char* cB = (const char*)g.Bt + cur.boff;
    PG8_STAGE(PG8_SB(0, 0), cB, voffB); PG8_STAGE(PG8_SB(0, 1), cB + hstepB, voffB); PG8_STAGE(PG8_SA(0, 0), cA, voffA); PG8_STAGE(PG8_SA(0, 1), cA + hstepA, voffA);
    if (wr == 1) PG8_BAR;
    PG8_WAIT_V(2); PG8_BAR;
    PG8_STAGE(PG8_SB(1, 0), cB + kstep, voffB); PG8_STAGE(PG8_SA(1, 0), cA + kstep, voffA); PG8_STAGE(PG8_SB(1, 1), cB + hstepB + kstep, voffB);
    PG8_WAIT_V(6); PG8_BAR;
    { float z0; asm volatile("v_mov_b32 %0, 0" : "=v"(z0));
#pragma unroll
    for (int a = 0; a < 2; ++a)
#pragma unroll
        for (int b = 0; b < 2; ++b)
#pragma unroll
            for (int m = 0; m < 4; ++m)
#pragma unroll
                for (int n = 0; n < 2; ++n) acc[a][b][m][n] = (f32x4){z0, z0, z0, z0}; }
    for (;;) {
        const bool has_next = S.next(ui + 1, nxt);
        const char* nA = has_next ? (const char*)g.A + nxt.aoff : cA; const char* nB = has_next ? (const char*)g.Bt + nxt.boff : cB;
#pragma unroll 1
        for (int t = 0; t < nt; t += 2) {
            const bool last = (t == nt - 2);
            const char* a1 = cA + (size_t)((unsigned)(t * 128) & wmask) + kstep;
            const char* a2 = last ? nA : cA + (size_t)((unsigned)((t + 2) * 128) & wmask); const char* b2 = last ? nB : cB + (size_t)(t + 2) * kstep;
            const char* a3 = a2 + kstep; const char* b3 = b2 + kstep;
            PG8_LDB(B0, 0, 0); PG8_LDB(B1, 0, 1); PG8_SCHED; PG8_LDA(At, 0, 0); PG8_STAGE(PG8_SA(1, 1), a1 + hstepA, voffA);
            PG8_WAIT_V(8); PG8_WAIT_L(0); PG8_BAR; PG8_MMA(0, 0, At, B0); PG8_MMA(0, 1, At, B1); PG8_BAR; PG8_SCHED;
            PG8_LDA(At, 0, 1); PG8_STAGE(PG8_SB(0, 0), b2, voffB); PG8_STAGE(PG8_SB(0, 1), b2 + hstepB, voffB); PG8_STAGE(PG8_SA(0, 0), a2, voffA);
            PG8_WAIT_V(8); PG8_WAIT_L(0); PG8_BAR; PG8_MMA(1, 0, At, B0); PG8_MMA(1, 1, At, B1); PG8_BAR; PG8_SCHED;
            PG8_LDB(B0, 1, 0); PG8_LDB(B1, 1, 1); PG8_SCHED; PG8_LDA(At, 1, 0); PG8_STAGE(PG8_SA(0, 1), a2 + hstepA, voffA);
            PG8_WAIT_V(8); PG8_WAIT_L(0); PG8_BAR; PG8_MMA(0, 0, At, B0); PG8_MMA(0, 1, At, B1); PG8_BAR; PG8_SCHED;
            PG8_LDA(At, 1, 1); PG8_STAGE(PG8_SB(1, 0), b3, voffB); PG8_STAGE(PG8_SB(1, 1), b3 + hstepB, voffB); PG8_STAGE(PG8_SA(1, 0), a3, voffA);
            PG8_WAIT_V(8); PG8_WAIT_L(0); PG8_BAR; PG8_MMA(1, 0, At, B0); PG8_MMA(1, 1, At, B1); PG8_BAR; PG8_SCHED;
        }
        if constexpr (F8) asm volatile("s_nop 15\n\ts_nop 15" ::: "memory");
        if constexpr (ALIGN_EPI) { if (wr == 0) PG8_BAR; }
        E(acc, cur, wr, wc, fr, fq, xl);
        if (!has_next) break;
#pragma unroll
        for (int a = 0; a < 2; ++a)
#pragma unroll
            for (int b = 0; b < 2; ++b)
#pragma unroll
                for (int m = 0; m < 4; ++m)
#pragma unroll
                    for (int n = 0; n < 2; ++n) acc[a][b][m][n] = (f32x4){0.f, 0.f, 0.f, 0.f};
        cur = nxt; cA = nA; cB = nB; ++ui;
        if constexpr (ALIGN_EPI) { if (wr == 1) PG8_BAR; }
    }
    PG8_WAIT_V(0);
    if constexpr (!ALIGN_EPI) { if (wr == 0) PG8_BAR; }
    PG8_BAR;
#undef PG8_SA
#undef PG8_SB
#undef PG8_STAGE
#undef PG8_LDA
#undef PG8_LDB
#undef PG8_MMA
#undef PG8_WAIT_V
#undef PG8_WAIT_L
#undef PG8_BAR
#undef PG8_SCHED
}
}

constexpr int NWAVES = 8;
constexpr int NB = 8, T = 8192, D = 1024, M = NB * T;
constexpr int INC = 3080, NQKV = 3072, FF = 2816;
constexpr int C_F = 1536, C_QM = 1544, C_KM = 2056;
constexpr float LOG2E = 1.4426950408889634f;
constexpr float C2 = 0.125f * LOG2E;
constexpr float RMS_EPS = 1e-6f;

constexpr size_t MiB = 1u << 20;
constexpr size_t WS_CTL = 0, CTL_ZERO_BYTES = 1 * MiB;
constexpr size_t WS_LOGF = 2 * MiB, WS_C = 4 * MiB, WS_ABAR = 6 * MiB, WS_KM = 7 * MiB, WS_SEL = 8 * MiB;
constexpr size_t WS_SSQ1 = 10 * MiB, WS_SSQ2 = 14 * MiB, WS_SSQ3 = 18 * MiB;
constexpr size_t WS_MEMN = 22 * MiB, WS_KV = 26 * MiB, WS_WQS = 34 * MiB, WS_WOT = 36 * MiB, WS_WKVT = 38 * MiB, WS_WINT = 42 * MiB, WS_WOUTT = 48 * MiB;
constexpr size_t WS_WUPT = 50 * MiB, WS_WDT = 976 * MiB  , WS_ZT = 68 * MiB, WS_WQK = 80 * MiB, WS_VWO = 96 * MiB;
constexpr size_t WS_ACT8 = 64 * MiB;
constexpr size_t WS_A1 = 112 * MiB;
constexpr size_t WS_QKV = 368 * MiB;
constexpr size_t WS_Y = 752 * MiB, WS_HB1 = WS_A1 + 128 * MiB, WS_P = WS_QKV, WS_HB2 = WS_A1;
constexpr size_t WS_PO = WS_A1;
constexpr size_t WS_LIST = 880 * MiB, WS_PML = 944 * MiB, WS_KXF = 960 * MiB, WS_KXM = 968 * MiB, WS_CNT = 969 * MiB;
constexpr size_t WS_G = 240 * MiB, WS_U = 592 * MiB, WS_END = 1024 * MiB;
static_assert(WS_WUPT + (size_t)2 * FF * D * 2 <= WS_ZT && WS_ACT8 + (size_t)M * FF <= 240 * MiB && WS_WDT + (size_t)D * FF <= WS_END && WS_CNT + 8192 <= WS_WDT && WS_ZT + (size_t)8 * 256 * 3072 * 2 <= WS_WQK && WS_VWO + 16 * MiB <= WS_A1, "ws map");
static_assert(WS_G + (size_t)M * FF * 2 <= WS_U && WS_U + (size_t)M * FF * 2 <= WS_END && WS_Y + (size_t)M * D * 2 <= WS_LIST && WS_LIST + (size_t)2048 * 8192 * 4 <= WS_PML && WS_PML + (size_t)M * 32 * 8 <= WS_KXF && WS_KXF + (size_t)64 * 8192 * 16 <= WS_KXM, "ws map 2");
constexpr int CW_BAR = 4096;
constexpr int CW_QKN = 8192;
constexpr int CW_QUEUE = 12288;
constexpr int CW_T0TAB = 16384;

constexpr int RING_OFF = 0, RING_BYTES = 131072;
constexpr int LDSCTL_OFF = RING_BYTES, MISC_OFF = LDSCTL_OFF + 320;
constexpr int XL_OFF = RING_BYTES + 512;
constexpr int LDS_BYTES = 147456;
static_assert(XL_OFF + 8192 <= LDS_BYTES, "LDS map");

#define GAS __attribute__((address_space(1)))
#define LAS __attribute__((address_space(3)))
typedef unsigned short bf16;
typedef unsigned v4u __attribute__((ext_vector_type(4)));
typedef float f32x4 __attribute__((ext_vector_type(4)));
typedef GAS unsigned gu32;
#define RLX_AGENT __ATOMIC_RELAXED, __HIP_MEMORY_SCOPE_AGENT
#define LDS_WAIT() asm volatile("s_waitcnt lgkmcnt(0)" ::: "memory")
__device__ __forceinline__ unsigned f2bf(float f) { unsigned u = __builtin_bit_cast(unsigned, f); return (u + 0x7fffu + ((u >> 16) & 1u)) >> 16; }
__device__ __forceinline__ unsigned pk2(float lo, float hi) { return f2bf(lo) | (f2bf(hi) << 16); }
__device__ __forceinline__ float bf2f(unsigned b) { return __builtin_bit_cast(float, b << 16); }
__device__ __forceinline__ float bflo(unsigned w) { return __builtin_bit_cast(float, w << 16); }
__device__ __forceinline__ float bfhi(unsigned w) { return __builtin_bit_cast(float, w & 0xffff0000u); }

#define XB_TMO      128
#define XB_XCNT(j)  (256  + 64 * (j))
#define XB_XSUB(j)  (1280 + 64 * (j))
#define XB_XGEN(j)  (2304 + 64 * (j))
#define XB_TOP      3328
#define XB_TOPGEN   3392
#define XCD_BAR_WORDS 3456
#define XB_SPIN_CAP (1u << 18)

__device__ __forceinline__ unsigned xb_ld(unsigned* p)              { return __hip_atomic_load(p, __ATOMIC_RELAXED, __HIP_MEMORY_SCOPE_AGENT); }
__device__ __forceinline__ unsigned xb_add(unsigned* p, unsigned v) { return __hip_atomic_fetch_add(p, v, __ATOMIC_RELAXED, __HIP_MEMORY_SCOPE_AGENT); }
__device__ __forceinline__ unsigned xb_xcc_id() { return (unsigned)__builtin_amdgcn_s_getreg((3 << 11) | 20) & 0xFu; }
#define XB_SPIN(cond, bar) do { unsigned _sp = 0; while (cond) { __builtin_amdgcn_s_sleep(1); \
    if ((++_sp & 255u) == 0u) { if (xb_ld(&(bar)[XB_TMO])) break; if (_sp > XB_SPIN_CAP) { atomicAdd(&(bar)[XB_TMO], 1u); break; } } } } while (0)

struct XcdBarrier { unsigned* bar; unsigned x; volatile LAS unsigned* st; };

__device__ __forceinline__ XcdBarrier xcd_barrier_post(unsigned* bar, volatile LAS unsigned* st) {
    XcdBarrier b; b.bar = bar; b.x = xb_xcc_id(); b.st = st;
    if (threadIdx.x == 0) (void)xb_add(&bar[XB_XCNT(b.x)], 1u);
    return b;
}
__device__ __forceinline__ void xcd_barrier_complete(unsigned* bar, unsigned x, unsigned& nloc, unsigned& nx) {
    const unsigned G = gridDim.x * gridDim.y * gridDim.z;
    unsigned sum, cnt, mine, sp = 0u;
    for (;;) {
        sum = 0u; cnt = 0u; mine = 0u;
#pragma unroll
        for (unsigned j = 0; j < 16; ++j) { const unsigned c = xb_ld(&bar[XB_XCNT(j)]); sum += c; cnt += (c > 0u) ? 1u : 0u; mine = (j == x) ? c : mine; }
        if (sum == G) break;
        __builtin_amdgcn_s_sleep(1);
        if ((++sp & 255u) == 0u) { if (xb_ld(&bar[XB_TMO])) break; if (sp > XB_SPIN_CAP) { atomicAdd(&bar[XB_TMO], 1u); break; } }
    }
    nloc = mine > 0u ? mine : 1u; nx = cnt > 0u ? cnt : 1u;
}
__device__ __forceinline__ void xcd_barrier(const XcdBarrier& b) {
    asm volatile("s_waitcnt vmcnt(0)" ::: "memory");
    __syncthreads();
    if (threadIdx.x == 0) {
        unsigned* bar = b.bar;
        __builtin_amdgcn_s_waitcnt(0);
        unsigned nloc = b.st[0], nx = b.st[1];
        if (nloc == 0u) { xcd_barrier_complete(bar, b.x, nloc, nx); b.st[0] = nloc; b.st[1] = nx; }
        const unsigned old = xb_add(&bar[XB_XSUB(b.x)], 1u);
        const unsigned gen = old / nloc;
        if (old + 1u == (gen + 1u) * nloc) {
            __builtin_amdgcn_fence(__ATOMIC_RELEASE, "agent");
            asm volatile("s_waitcnt vmcnt(0)" ::: "memory");
            const unsigned og = xb_add(&bar[XB_TOP], 1u);
            const unsigned tg = og / nx;
            if (og + 1u == (tg + 1u) * nx) xb_add(&bar[XB_TOPGEN], 1u);
            else XB_SPIN(xb_ld(&bar[XB_TOPGEN]) == tg, bar);
            __builtin_amdgcn_fence(__ATOMIC_ACQUIRE, "agent");
            xb_add(&bar[XB_XGEN(b.x)], 1u);
            asm volatile("s_waitcnt vmcnt(0)" ::: "memory");
        } else {
            XB_SPIN(xb_ld(&bar[XB_XGEN(b.x)]) == gen, bar);
            __builtin_amdgcn_fence(__ATOMIC_ACQUIRE, "agent");
            asm volatile("s_waitcnt vmcnt(0)" ::: "memory");
        }
    }
    __syncthreads();
}

__device__ __forceinline__ float wave_sum(float v) {
#pragma unroll
    for (int o = 1; o < 64; o <<= 1) v += __shfl_xor(v, o);
    return v;
}
__device__ __forceinline__ void p0_transpose_item(const float* W, int ldw, int K, int N, bf16* WT, const float* kscale, bool remap, LAS float* scr, int item, int lane, float f8scale = 0.f) {
    const int nblk = N / 32, kb = item / nblk, nb = item % nblk, k0 = 64 * kb, n0 = 32 * nb;
    const int sn0 = (remap && n0 >= 1536) ? n0 + 8 : n0;
#pragma unroll 8
    for (int i = 0; i < 32; ++i) { const int kk = 2 * i + (lane >> 5); float v = W[(size_t)(k0 + kk) * ldw + sn0 + (lane & 31)]; if (kscale) v *= kscale[k0 + kk]; scr[kk * 33 + (lane & 31)] = v; }
    LDS_WAIT(); asm volatile("" ::: "memory");
    const int c = lane & 7;
#pragma unroll
    for (int j = 0; j < 4; ++j) { const int n = (lane >> 3) + 8 * j; const LAS float* s = scr + (8 * c) * 33 + n;
        if (f8scale != 0.f) { const unsigned lo = pg8::pk4_fp8(s[0 * 33] * f8scale, s[1 * 33] * f8scale, s[2 * 33] * f8scale, s[3 * 33] * f8scale), hi = pg8::pk4_fp8(s[4 * 33] * f8scale, s[5 * 33] * f8scale, s[6 * 33] * f8scale, s[7 * 33] * f8scale);
            *(GAS unsigned long long*)((unsigned char*)WT + (size_t)(n0 + n) * K + k0 + 8 * c) = (unsigned long long)lo | ((unsigned long long)hi << 32); }
        else { v4u o; o.x = pk2(s[0 * 33], s[1 * 33]); o.y = pk2(s[2 * 33], s[3 * 33]); o.z = pk2(s[4 * 33], s[5 * 33]); o.w = pk2(s[6 * 33], s[7 * 33]);
            *(GAS v4u*)(WT + (size_t)(n0 + n) * K + k0 + 8 * c) = o; } }
    LDS_WAIT(); asm volatile("" ::: "memory");
}

struct Args { const float* in[19]; float* out; unsigned char* ws; };

namespace attn_body {
using hb16=__hip_bfloat16;
using bf16x8=__attribute__((ext_vector_type(8)))short;
using s16x4=__attribute__((ext_vector_type(4)))short;
using f32x16=__attribute__((ext_vector_type(16)))float;
using u32x4=__attribute__((ext_vector_type(4)))unsigned;
constexpr int PITCH=3072;
constexpr int NW=8,QBLK=32,QB=QBLK*NW,KVBLK=64;
__device__ __forceinline__ int crow(int r,int hi){return (r&3)+8*(r>>2)+4*hi;}
#define SBAR() __builtin_amdgcn_sched_barrier(0)
__device__ __forceinline__ void cmask(f32x16&p0,f32x16&p1,int jb,int qrel,int hi){
  const float NEG=-INFINITY; int kb=64*jb+4*hi;
  #pragma unroll
  for(int r=0;r<16;++r){int kv=kb+(r&3)+8*(r>>2); if(kv>qrel)p0[r]=NEG; if(kv+32>qrel)p1[r]=NEG;}
}
constexpr int NSLOT=3, SLOTB=9216;
constexpr int LDS_K=0, LDS_V=NSLOT*SLOTB, LDS_WS=2*NSLOT*SLOTB, LDS_OST=LDS_WS+NW*64*4, LDS_BYTES=LDS_OST+NW*4096;
__device__ __forceinline__ void glds16(const void*gsrc,unsigned lds_dst){unsigned keep;
  asm volatile("s_mov_b32 %0, m0\n\ts_mov_b32 m0, %2\n\ts_nop 0\n\tglobal_load_lds_dwordx4 %1, off\n\ts_mov_b32 m0, %0":"=&s"(keep):"v"(gsrc),"s"(lds_dst):"memory");}
__device__ __forceinline__ void glds16x(const void*gsrc,unsigned lds_dst){unsigned keep;unsigned long long ex;
  asm volatile("s_mov_b32 %0, m0\n\ts_mov_b64 %1, exec\n\ts_mov_b64 exec, 0xff\n\ts_mov_b32 m0, %3\n\ts_nop 0\n\tglobal_load_lds_dwordx4 %2, off\n\ts_mov_b64 exec, %1\n\ts_mov_b32 m0, %0":"=&s"(keep),"=&s"(ex):"v"(gsrc),"s"(lds_dst):"memory");}
__device__ __forceinline__ float max3f(float a,float b,float c){float r;asm("v_max3_f32 %0, %1, %2, %3":"=v"(r):"v"(a),"v"(b),"v"(c));return r;}
__device__ __forceinline__ float max2f(float a,float b){float r;asm("v_max_f32_e32 %0, %1, %2":"=v"(r):"v"(a),"v"(b));return r;}
__device__ __forceinline__ float fsub_s(float a,float b){float r;asm("v_sub_f32_e32 %0, %1, %2":"=v"(r):"v"(a),"v"(b));return r;}
typedef float f32x2_t __attribute__((ext_vector_type(2))); typedef __bf16 bf16x2_t __attribute__((ext_vector_type(2)));
__device__ __forceinline__ unsigned cvtpk_s(float lo,float hi){f32x2_t v={lo,hi};bf16x2_t b=__builtin_convertvector(v,bf16x2_t);return __builtin_bit_cast(unsigned,b);}
__device__ __forceinline__ float rbf(float x){return __builtin_bit_cast(float,cvtpk_s(x,0.f)<<16);}
#define WAIT_BAR(N) asm volatile("s_waitcnt vmcnt(" #N ") lgkmcnt(0)\n\ts_barrier":::"memory")

__device__ __forceinline__ void qkt(f32x16&p0,f32x16&p1,const char*Kslot,const bf16x8*qr,int r32,int hi){
  const char*kb=Kslot+hi*1024+r32*16; const f32x16 zf={};
  #pragma unroll
  for(int d0=0;d0<4;++d0){
    const bf16x8 b0=*reinterpret_cast<const bf16x8*>(kb+d0*2048);
    const bf16x8 b1=*reinterpret_cast<const bf16x8*>(kb+d0*2048+512);
    if(d0==0){p0=__builtin_amdgcn_mfma_f32_32x32x16_bf16(b0,qr[0],zf,0,0,0);p1=__builtin_amdgcn_mfma_f32_32x32x16_bf16(b1,qr[0],zf,0,0,0);}
    else{p0=__builtin_amdgcn_mfma_f32_32x32x16_bf16(b0,qr[d0],p0,0,0,0);p1=__builtin_amdgcn_mfma_f32_32x32x16_bf16(b1,qr[d0],p1,0,0,0);}}
  const char*kx=Kslot+8192+r32*16;
  const bf16x8 x0=*reinterpret_cast<const bf16x8*>(kx), x1=*reinterpret_cast<const bf16x8*>(kx+512);
  p0=__builtin_amdgcn_mfma_f32_32x32x16_bf16(x0,qr[4],p0,0,0,0);p1=__builtin_amdgcn_mfma_f32_32x32x16_bf16(x1,qr[4],p1,0,0,0);
}
typedef __attribute__((address_space(3))) const char* lds_cptr;
typedef short v4i16_t __attribute__((ext_vector_type(4)));
__device__ __forceinline__ void kload10(bf16x8*kf,lds_cptr kp,lds_cptr kx){
  kf[0]=*(const __attribute__((address_space(3))) bf16x8*)(kp);      kf[1]=*(const __attribute__((address_space(3))) bf16x8*)(kp+512);
  kf[2]=*(const __attribute__((address_space(3))) bf16x8*)(kp+2048); kf[3]=*(const __attribute__((address_space(3))) bf16x8*)(kp+2560);
  kf[4]=*(const __attribute__((address_space(3))) bf16x8*)(kp+4096); kf[5]=*(const __attribute__((address_space(3))) bf16x8*)(kp+4608);
  kf[6]=*(const __attribute__((address_space(3))) bf16x8*)(kp+6144); kf[7]=*(const __attribute__((address_space(3))) bf16x8*)(kp+6656);
  kf[8]=*(const __attribute__((address_space(3))) bf16x8*)(kx);      kf[9]=*(const __attribute__((address_space(3))) bf16x8*)(kx+512);
}
__device__ __forceinline__ void kload2(bf16x8*kf,lds_cptr kp,int j){ kf[2*j]=*(const __attribute__((address_space(3))) bf16x8*)(kp+j*2048); kf[2*j+1]=*(const __attribute__((address_space(3))) bf16x8*)(kp+j*2048+512); }
__device__ __forceinline__ s16x4 vtr(lds_cptr p){ return __builtin_bit_cast(s16x4,__builtin_amdgcn_ds_read_tr16_b64_v4i16((__attribute__((address_space(3))) v4i16_t*)p)); }
__device__ __forceinline__ float rowmax(const f32x16&p0,const f32x16&p1){
  float a=max3f(p0[0],p0[1],p1[0]),b=max3f(p0[2],p0[3],p1[1]);a=max3f(a,p1[2],p1[3]);
  #pragma unroll
  for(int r=4;r<16;r+=4){a=max3f(a,p0[r],p0[r+1]);b=max3f(b,p0[r+2],p0[r+3]);a=max3f(a,p1[r],p1[r+1]);b=max3f(b,p1[r+2],p1[r+3]);}
  const float m=max2f(a,b);
  auto rr=__builtin_amdgcn_permlane32_swap(__float_as_uint(m),__float_as_uint(m),false,false);
  return max2f(__uint_as_float(rr[0]),__uint_as_float(rr[1]));
}
__device__ __forceinline__ void pv(f32x16*o,int vb,bf16x8 pa0,bf16x8 pa1,bf16x8 pa2,bf16x8 pa3){
  #pragma unroll
  for(int d0=0;d0<2;++d0){s16x4 lo[4],hi[4];
    #pragma unroll
    for(int ks=0;ks<4;++ks){
      asm volatile("ds_read_b64_tr_b16 %0,%1 offset:%c2":"=&v"(lo[ks]):"v"(vb),"i"(d0*4096+ks*1024):"memory");
      asm volatile("ds_read_b64_tr_b16 %0,%1 offset:%c2":"=&v"(hi[ks]):"v"(vb),"i"(d0*4096+ks*1024+512):"memory");}
    asm volatile("s_waitcnt lgkmcnt(0)":::"memory");SBAR();
    #define PK(k) (bf16x8){lo[k][0],lo[k][1],lo[k][2],lo[k][3],hi[k][0],hi[k][1],hi[k][2],hi[k][3]}
    o[d0]=__builtin_amdgcn_mfma_f32_32x32x16_bf16(pa0,PK(0),o[d0],0,0,0);
    o[d0]=__builtin_amdgcn_mfma_f32_32x32x16_bf16(pa1,PK(1),o[d0],0,0,0);
    o[d0]=__builtin_amdgcn_mfma_f32_32x32x16_bf16(pa2,PK(2),o[d0],0,0,0);
    o[d0]=__builtin_amdgcn_mfma_f32_32x32x16_bf16(pa3,PK(3),o[d0],0,0,0);
    #undef PK
  }
}

template<int THRL> __device__ __forceinline__ void attn_unit(char*shm,const int KIND,const hb16*Qc,int qrow,int oslot,const hb16*__restrict__ Kt0,const hb16*__restrict__ Vt0,const hb16*__restrict__ KXt0,int NT,int band0,hb16*Oc,hb16*PO,float*PML){
  const int tid=threadIdx.x,lane=tid&63,r32=lane&31,hi=lane>>5; const int wid=__builtin_amdgcn_readfirstlane(tid>>6);
  const unsigned lds0=(unsigned)(uintptr_t)shm;
  float*wsf=(float*)(shm+LDS_WS)+wid*64;
  const hb16*ksrc=Kt0+(long)lane*PITCH+wid*8;
  const hb16*vsrc=Vt0+(long)(16*(wid&3)+(lane>>2))*PITCH+(wid>>2)*32+(lane&3)*8;
  const hb16*xsrc=KXt0+(long)(8*wid+(lane&7))*8;
  const unsigned kdst=lds0+LDS_K+wid*1024, vdst=lds0+LDS_V+wid*1024, xdst=lds0+LDS_K+8192+wid*128;
  #define DMA_K(t,slot) do{ glds16(ksrc+(long)(t)*KVBLK*PITCH,(unsigned)__builtin_amdgcn_readfirstlane(kdst+(slot))); glds16x(xsrc+(long)(t)*KVBLK*8,(unsigned)__builtin_amdgcn_readfirstlane(xdst+(slot))); }while(0)
  #define DMA_V(t,slot) glds16(vsrc+(long)(t)*KVBLK*PITCH,(unsigned)__builtin_amdgcn_readfirstlane(vdst+(slot)))
  const int vb0=(int)(lds0+LDS_V)+((lane>>4)&1)*32+(lane&3)*8+(4*hi+((lane&15)>>2))*64;
  const char*Kbase=shm+LDS_K; bf16x8 kf[10];
  const lds_cptr shm3=(lds_cptr)shm; const lds_cptr kp0=shm3+LDS_K+hi*1024+r32*16; const lds_cptr kx0=shm3+LDS_K+8192+r32*16; const lds_cptr vp0=shm3+LDS_V+((lane>>4)&1)*32+(lane&3)*8+(4*hi+((lane&15)>>2))*64;
  DMA_K(0,0);DMA_V(0,0);DMA_K(1,SLOTB);
  bf16x8 qr[5];
  { const hb16*Qw=Qc+(long)qrow*PITCH;
    #pragma unroll
    for(int d0=0;d0<4;++d0)qr[d0]=*reinterpret_cast<const bf16x8*>(&Qw[d0*16+hi*8]); }
  float mhat=0.f,l_reg=0.f;f32x16 o[2];o[0]=f32x16{};o[1]=f32x16{};
  #define SETQX(mh_,ml_) do{ const unsigned bh_=cvtpk_s(-(mh_),-(ml_)); u32x4 qx_; qx_.x=0x3F803F80u; qx_.y=0x3F80u|(bh_<<16); qx_.z=(bh_>>16); qx_.w=0u; if(hi){qx_.x=0u;qx_.y=0u;qx_.z=0u;} qr[4]=__builtin_bit_cast(bf16x8,qx_); asm volatile("":"+v"(qr[4])); }while(0)
  #define MOVEREF(gain) const float mraw_=mhat+(gain); const float mh_=rbf(mraw_); const float ml_=rbf(mraw_-mh_); const float mnew_=mh_+ml_; const float dl=mnew_-mhat; mhat=mnew_; SETQX(mh_,ml_);
  SETQX(0.f,0.f);
  const int qrel=wid*QBLK+r32;
  #define CMASK(P0,P1,t) do{int jb_=(t)-band0; if(jb_>=0)cmask(P0,P1,jb_,qrel,hi);}while(0)
  bool resc=false;
  #define START(P0,P1) do{ const float rm=rowmax(P0,P1); resc=false; \
    { MOVEREF(rm) \
      _Pragma("unroll") for(int r=0;r<16;++r){P0[r]=fsub_s(P0[r],dl);P1[r]=fsub_s(P1[r],dl);} } \
    _Pragma("unroll") for(int r=0;r<16;++r)P0[r]=__builtin_amdgcn_exp2f(P0[r]); }while(0)
  #define RESC() do{ if(resc){ asm volatile("s_waitcnt lgkmcnt(0)":::"memory"); \
      _Pragma("unroll") for(int d_=0;d_<2;++d_) _Pragma("unroll") for(int r=0;r<16;++r)o[d_][r]*=wsf[crow(r,hi)]; } }while(0)
  f32x16 pA0,pA1,pB0,pB1;
  int sl_prev=0,sl_cur=0,sl_next=SLOTB;
  #define ROT() do{sl_prev=sl_cur;sl_cur=sl_next;sl_next=(sl_next==(NSLOT-1)*SLOTB)?0:sl_next+SLOTB;}while(0)
  DMA_K(2,2*SLOTB);
  WAIT_BAR(5);
  qkt(pA0,pA1,Kbase,qr,r32,hi);asm volatile("s_nop 15\n\ts_nop 7":"+v"(pA0),"+v"(pA1));CMASK(pA0,pA1,0);
  START(pA0,pA1);
  _Pragma("unroll") for(int r=0;r<16;++r)pA1[r]=__builtin_amdgcn_exp2f(pA1[r]);
  WAIT_BAR(0);
  DMA_K(3,0);DMA_V(1,SLOTB);
  ROT();
  kload10(kf,kp0+sl_cur,kx0+sl_cur);
  WAIT_BAR(3);
  s16x4 vlo[8],vhi[8]; u32x4 pw0,pw1,pw2,pw3; const f32x16 zf={};
  #define PKW(P,B) cvtpk_s(P[B],P[B+1])
  #define PAF(k) __builtin_bit_cast(bf16x8,pw##k)
  #define VFR(i) (bf16x8){vlo[i][0],vlo[i][1],vlo[i][2],vlo[i][3],vhi[i][0],vhi[i][1],vhi[i][2],vhi[i][3]}
  #define PIN(x) asm volatile("":"+v"(x))
  #define MX3(a,b,c) __builtin_fmaxf(__builtin_fmaxf((a),(b)),(c))
  #define GAPA(MF,A0,A1,A2,A3,W0,W1,PW) do{ MF; sacc+=A0; sacc+=A1; sacc+=A2; sacc+=A3; PIN(sacc); W0; W1; PIN(PW); SBAR(); }while(0)
  #define EX(v) __builtin_amdgcn_exp2f(v)
  #define GAPB(MF,X,B) do{ MF; X[B]=EX(X[B]); X[B+1]=EX(X[B+1]); X[B+2]=EX(X[B+2]); X[B+3]=EX(X[B+3]); PIN(X); SBAR(); }while(0)
  #define VRD(i) do{ vlo[i]=vtr(vp_+(((i)>>2)*4096+((i)&3)*1024)); vhi[i]=vtr(vp_+(((i)>>2)*4096+((i)&3)*1024+512)); }while(0)
  #define KRD(G,j) do{ if(G){ kload2(kf,kp0+sl_next,j); SBAR(); } }while(0)
  #define KRDX(G) do{ if(G){ kf[8]=*(const __attribute__((address_space(3))) bf16x8*)(kx0+sl_next); kf[9]=*(const __attribute__((address_space(3))) bf16x8*)(kx0+sl_next+512); SBAR(); } }while(0)
  #define STEP(C0,C1,P0,P1,t,GK,GV,GL) do{ SBAR(); \
    const lds_cptr vp_=vp0+sl_prev; \
    VRD(0); SBAR(); float sacc=(P0[0]+P0[1]); \
    GAPA(C0=__builtin_amdgcn_mfma_f32_32x32x16_bf16(kf[0],qr[0],zf,0,0,0), P0[2],P0[3],P0[4],P0[5],     pw0[0]=PKW(P0,0), pw0[1]=PKW(P0,2), pw0); \
    VRD(4); SBAR(); GAPA(C1=__builtin_amdgcn_mfma_f32_32x32x16_bf16(kf[1],qr[0],zf,0,0,0), P0[6],P0[7],P0[8],P0[9],     pw0[2]=PKW(P0,4), pw0[3]=PKW(P0,6), pw0); \
    VRD(1); SBAR(); GAPA(C0=__builtin_amdgcn_mfma_f32_32x32x16_bf16(kf[2],qr[1],C0,0,0,0),   P0[10],P0[11],P0[12],P0[13], pw1[0]=PKW(P0,8), pw1[1]=PKW(P0,10), pw1); \
    VRD(5); SBAR(); GAPA(C1=__builtin_amdgcn_mfma_f32_32x32x16_bf16(kf[3],qr[1],C1,0,0,0),   P0[14],P0[15],P1[0],P1[1],   pw1[2]=PKW(P0,12),pw1[3]=PKW(P0,14), pw1); \
    VRD(2); SBAR(); GAPA(C0=__builtin_amdgcn_mfma_f32_32x32x16_bf16(kf[4],qr[2],C0,0,0,0),   P1[2],P1[3],P1[4],P1[5],     pw2[0]=PKW(P1,0), pw2[1]=PKW(P1,2), pw2); \
    VRD(6); SBAR(); GAPA(C1=__builtin_amdgcn_mfma_f32_32x32x16_bf16(kf[5],qr[2],C1,0,0,0),   P1[6],P1[7],P1[8],P1[9],     pw2[2]=PKW(P1,4), pw2[3]=PKW(P1,6), pw2); \
    VRD(3); SBAR(); GAPA(C0=__builtin_amdgcn_mfma_f32_32x32x16_bf16(kf[6],qr[3],C0,0,0,0),   P1[10],P1[11],P1[12],P1[13], pw3[0]=PKW(P1,8), pw3[1]=PKW(P1,10), pw3); \
    VRD(7); SBAR(); GAPA(C1=__builtin_amdgcn_mfma_f32_32x32x16_bf16(kf[7],qr[3],C1,0,0,0),   P1[14],P1[15],0.f,0.f,       pw3[2]=PKW(P1,12),pw3[3]=PKW(P1,14), pw3); \
    C0=__builtin_amdgcn_mfma_f32_32x32x16_bf16(kf[8],qr[4],C0,0,0,0); SBAR(); \
    C1=__builtin_amdgcn_mfma_f32_32x32x16_bf16(kf[9],qr[4],C1,0,0,0); SBAR(); \
    l_reg+=sacc; \
    if(GK){DMA_K((t)+3,sl_cur);} if(GV){DMA_V((t)+1,sl_next);} \
    CMASK(C0,C1,t); \
    { float a=MX3(C0[0],C0[1],C1[0]),b=MX3(C0[2],C0[3],C1[1]); a=MX3(a,C1[2],C1[3]); \
      _Pragma("unroll") for(int r=4;r<16;r+=4){a=MX3(a,C0[r],C0[r+1]);b=MX3(b,C0[r+2],C0[r+3]);a=MX3(a,C1[r],C1[r+1]);b=MX3(b,C1[r+2],C1[r+3]);} \
      float rm=__builtin_fmaxf(a,b); { auto rr=__builtin_amdgcn_permlane32_swap(__float_as_uint(rm),__float_as_uint(rm),false,false); rm=__builtin_fmaxf(__uint_as_float(rr[0]),__uint_as_float(rr[1])); } \
      resc=false; \
      if(__builtin_expect(__any(rm>(float)THRL),0)){ MOVEREF(__builtin_fmaxf(rm,0.f)) \
        _Pragma("unroll") for(int r=0;r<16;++r){C0[r]-=dl;C1[r]-=dl;} \
        const float f=__builtin_amdgcn_exp2f(-dl); l_reg*=f; if(hi==0)wsf[r32]=f; resc=true; } } \
    SBAR(); \
    GAPB(o[0]=__builtin_amdgcn_mfma_f32_32x32x16_bf16(PAF(0),VFR(0),o[0],0,0,0), C0,0); \
    GAPB(o[1]=__builtin_amdgcn_mfma_f32_32x32x16_bf16(PAF(0),VFR(4),o[1],0,0,0), C0,4); \
    KRD(GL,0); GAPB(o[0]=__builtin_amdgcn_mfma_f32_32x32x16_bf16(PAF(1),VFR(1),o[0],0,0,0), C0,8); \
    KRD(GL,1); GAPB(o[1]=__builtin_amdgcn_mfma_f32_32x32x16_bf16(PAF(1),VFR(5),o[1],0,0,0), C0,12); \
    KRD(GL,2); GAPB(o[0]=__builtin_amdgcn_mfma_f32_32x32x16_bf16(PAF(2),VFR(2),o[0],0,0,0), C1,0); \
    KRD(GL,3); GAPB(o[1]=__builtin_amdgcn_mfma_f32_32x32x16_bf16(PAF(2),VFR(6),o[1],0,0,0), C1,4); \
    KRDX(GL); GAPB(o[0]=__builtin_amdgcn_mfma_f32_32x32x16_bf16(PAF(3),VFR(3),o[0],0,0,0), C1,8); \
    GAPB(o[1]=__builtin_amdgcn_mfma_f32_32x32x16_bf16(PAF(3),VFR(7),o[1],0,0,0), C1,12); \
    }while(0)
  int t=1;
  for(;t+5<NT&&t+1<band0;t+=2){
    #undef CMASK
    #define CMASK(P0,P1,t) do{}while(0)
    STEP(pB0,pB1,pA0,pA1,t,true,true,true);     WAIT_BAR(3); RESC(); ROT();
    STEP(pA0,pA1,pB0,pB1,t+1,true,true,true);   WAIT_BAR(3); RESC(); ROT();
  }
  #undef CMASK
  #define CMASK(P0,P1,t) do{int jb_=(t)-band0; if(jb_>=0)cmask(P0,P1,jb_,qrel,hi);}while(0)
  #define ENDW(tt) do{ if((tt)+3<NT){WAIT_BAR(3);} else if((tt)+2<NT){WAIT_BAR(1);} else {WAIT_BAR(0);} }while(0)
  for(;t+1<NT;t+=2){
    STEP(pB0,pB1,pA0,pA1,t,(t+3<NT),(t+1<NT),(t+1<NT));       ENDW(t);   RESC(); ROT();
    STEP(pA0,pA1,pB0,pB1,t+1,(t+4<NT),(t+2<NT),(t+2<NT));     ENDW(t+1); RESC(); ROT();
  }
  STEP(pB0,pB1,pA0,pA1,NT-1,false,false,false); RESC();
  { float sacc=pB0[0]+pB0[1]; _Pragma("unroll") for(int r=2;r<16;++r)sacc+=pB0[r]; _Pragma("unroll") for(int r=0;r<16;++r)sacc+=pB1[r]; l_reg+=sacc;
    pw0=(u32x4){PKW(pB0,0),PKW(pB0,2),PKW(pB0,4),PKW(pB0,6)};pw1=(u32x4){PKW(pB0,8),PKW(pB0,10),PKW(pB0,12),PKW(pB0,14)};pw2=(u32x4){PKW(pB1,0),PKW(pB1,2),PKW(pB1,4),PKW(pB1,6)};pw3=(u32x4){PKW(pB1,8),PKW(pB1,10),PKW(pB1,12),PKW(pB1,14)};
    SBAR(); pv(o,vb0+sl_cur,PAF(0),PAF(1),PAF(2),PAF(3)); }
  #undef PKW
  #undef PAF
  #undef VFR
  #undef PIN
  #undef MX3
  #undef GAPA
  #undef GAPB
  #undef EX
  #undef VRD
  #undef KRD
  #undef KRDX
  #undef STEP
  #undef ENDW
  {auto rr=__builtin_amdgcn_permlane32_swap(__float_as_uint(l_reg),__float_as_uint(l_reg),false,false);l_reg=__uint_as_float(rr[0])+__uint_as_float(rr[1]);}
  if(hi==0)wsf[32+r32]=l_reg;asm volatile("s_waitcnt lgkmcnt(0)":::"memory");
  float rli[16];
  #pragma unroll
  for(int r=0;r<16;++r)rli[r]=__builtin_amdgcn_rcpf(wsf[32+crow(r,hi)]);
  if(KIND==1){ if(hi==0&&oslot>=0){ f32x2_t ml={mhat,l_reg}; *(f32x2_t*)(PML+(long)oslot*2)=ml; } }
  { hb16*stg=(hb16*)(shm+LDS_OST)+wid*2048;
    #pragma unroll
    for(int r=0;r<16;++r){const int orow=crow(r,hi);
      #pragma unroll
      for(int d0=0;d0<2;++d0)stg[orow*64+d0*32+r32]=__float2bfloat16(o[d0][r]*rli[r]);}
    asm volatile("s_waitcnt lgkmcnt(0)":::"memory");
    #pragma unroll
    for(int i=0;i<4;++i){const int row=i*8+(lane>>3),ch=lane&7; const u32x4 v=*(const u32x4*)(stg+row*64+ch*8);
      if(KIND==0){ const int gr=__shfl(qrow,row); *(u32x4*)(Oc+(long)gr*PITCH+ch*8)=v; }
      else { const int gs=__shfl(oslot,row); if(gs>=0) *(u32x4*)(PO+(long)gs*64+ch*8)=v; } } }
  asm volatile("s_waitcnt lgkmcnt(0)\n\ts_barrier":::"memory");
  #undef DMA_K
  #undef DMA_V
  #undef CMASK
  #undef START
  #undef RESC
  #undef ROT
  #undef SETQX
  #undef MOVEREF
}
constexpr int ATTN_LDS_BYTES=LDS_BYTES;
#undef SBAR
#undef WAIT_BAR
}

struct WqkOrder {
    int G, c;
    __device__ __forceinline__ bool next(int i, pg8::Unit& u) const { const int L = i * G + c; if (L >= 128) return false; const int z = L >> 2, pn = L & 3, b = z >> 2, h = z & 3;
        u.pm = b * 4 + h; u.pn = pn; u.aoff = ((size_t)(b * 256) * 2048 + h * 256) * 2; u.boff = ((size_t)(pn * 256) * 1024 + h * 256) * 2; return true; }
};
struct VwoOrder {
    int G, c;
    __device__ __forceinline__ bool next(int i, pg8::Unit& u) const { const int L = i * G + c; if (L >= 128) return false; const int z = L >> 2, pmq = L & 3, b = z >> 2, h = z & 3;
        u.pm = b * 4 + pmq; u.pn = h; u.aoff = ((size_t)(pmq * 256) * 1024 + h * 256) * 2; u.boff = ((size_t)(b * 256) * 2048 + 1024 + h * 256) * 2; return true; }
};

#define DECL_PTRS const __attribute__((address_space(4))) Args* KA_; { auto p_ = __builtin_amdgcn_kernarg_segment_ptr(); asm volatile("" : "+s"(p_)); KA_ = (const __attribute__((address_space(4))) Args*)p_; } \
    int tidp_ = threadIdx.x; asm volatile("" : "+v"(tidp_)); const int tid = tidp_, lane = tid & 63; (void)lane; \
    unsigned char* ws = KA_->ws; gu32* ctl = (gu32*)(ws + WS_CTL); const float* x = KA_->in[0]; const float* mem = KA_->in[1]; const float* g_mix = KA_->in[2]; const float* w_in = KA_->in[3]; const float* b_forget = KA_->in[4]; const float* g_fox = KA_->in[5]; const float* g_moba = KA_->in[6]; const float* w_out = KA_->in[7]; const float* g_cross = KA_->in[8]; const float* g_mem = KA_->in[9]; const float* w_q_mem = KA_->in[10]; const float* w_kv_mem = KA_->in[11]; const float* w_o_mem = KA_->in[12]; const float* g_ffn = KA_->in[13]; const float* w_up = KA_->in[14]; const float* conv_w = KA_->in[15]; const float* conv_b = KA_->in[16]; const float* w_down = KA_->in[17]; const float* g_final = KA_->in[18]; float* out = KA_->out; float* LOGF = (float*)(ws + WS_LOGF); float* CC = (float*)(ws + WS_C); float* ABAR = (float*)(ws + WS_ABAR); float* KM = (float*)(ws + WS_KM); unsigned* SEL = (unsigned*)(ws + WS_SEL); float* SSQ1 = (float*)(ws + WS_SSQ1); float* SSQ2 = (float*)(ws + WS_SSQ2); float* SSQ3 = (float*)(ws + WS_SSQ3); bf16* MEMN = (bf16*)(ws + WS_MEMN); bf16* KV = (bf16*)(ws + WS_KV); bf16* WQS = (bf16*)(ws + WS_WQS); bf16* WOT = (bf16*)(ws + WS_WOT); bf16* WKVT = (bf16*)(ws + WS_WKVT); bf16* WINT = (bf16*)(ws + WS_WINT); bf16* WOUTT = (bf16*)(ws + WS_WOUTT); bf16* WUPT = (bf16*)(ws + WS_WUPT); unsigned char* WDT = ws + WS_WDT; unsigned char* ACT8 = ws + WS_ACT8; bf16* ZT = (bf16*)(ws + WS_ZT); bf16* WQK = (bf16*)(ws + WS_WQK); bf16* VWO = (bf16*)(ws + WS_VWO); bf16* A1 = (bf16*)(ws + WS_A1); bf16* QKV = (bf16*)(ws + WS_QKV); bf16* Y = (bf16*)(ws + WS_Y); bf16* HB1 = (bf16*)(ws + WS_HB1); bf16* PB = (bf16*)(ws + WS_P); bf16* HB2 = (bf16*)(ws + WS_HB2); bf16* GB = (bf16*)(ws + WS_G); bf16* UB = (bf16*)(ws + WS_U); bf16* PO = (bf16*)(ws + WS_PO); unsigned* LIST = (unsigned*)(ws + WS_LIST); float* PML = (float*)(ws + WS_PML); bf16* KXF = (bf16*)(ws + WS_KXF); bf16* KXM = (bf16*)(ws + WS_KXM); unsigned* CNT = (unsigned*)(ws + WS_CNT);
__global__ void __launch_bounds__(NWAVES * 64, 2) fwd(Args args) {
    extern __shared__ __attribute__((aligned(16))) unsigned char lds[];
    LAS unsigned char* L = (LAS unsigned char*)lds;
    LAS unsigned char* XL = L + XL_OFF;
    volatile LAS unsigned* MISC = (volatile LAS unsigned*)(L + MISC_OFF);
    const int tid = threadIdx.x, lane = tid & 63, wave = __builtin_amdgcn_readfirstlane(tid >> 6);
    const int G = gridDim.x, bx = blockIdx.x;
    const int gw = bx * NWAVES + wave, NGW = G * NWAVES;
    for (int u = tid; u < (LDS_BYTES - LDSCTL_OFF) / 4; u += NWAVES * 64) ((LAS unsigned*)(L + LDSCTL_OFF))[u] = 0u;
    __syncthreads();
    XcdBarrier bar; { DECL_PTRS; bar = xcd_barrier_post((unsigned*)(ctl + CW_BAR), MISC + 8); }

    { DECL_PTRS;
        LAS float* scr = (LAS float*)(L + RING_OFF + wave * 16384);
        constexpr int I_IN = (D / 64) * (NQKV / 32), I_OUT = (D / 64) * (D / 32), I_KV = (D / 64) * (2048 / 32), I_O = I_OUT, I_UP = (D / 64) * (2 * FF / 32), I_DN = (FF / 64) * (D / 32);
        constexpr int NITEMS = I_IN + I_OUT + I_KV + I_O + I_UP + I_DN;
        for (int it = gw; it < NITEMS; it += NGW) {
            int r = it;
            if (r < I_IN) { p0_transpose_item(w_in, INC, D, NQKV, WINT, nullptr, true, scr, r, lane); continue; } r -= I_IN;
            if (r < I_OUT) { p0_transpose_item(w_out, D, D, D, WOUTT, nullptr, false, scr, r, lane); continue; } r -= I_OUT;
            if (r < I_KV) { p0_transpose_item(w_kv_mem, 2048, D, 2048, WKVT, nullptr, false, scr, r, lane); continue; } r -= I_KV;
            if (r < I_O) { p0_transpose_item(w_o_mem, D, D, D, WOT, nullptr, false, scr, r, lane); continue; } r -= I_O;
            if (r < I_UP) { p0_transpose_item(w_up, 2 * FF, D, 2 * FF, WUPT, g_ffn, false, scr, r, lane); continue; } r -= I_UP;
            p0_transpose_item(w_down, D, FF, D, (bf16*)WDT, nullptr, false, scr, r, lane, 64.0f);
        }
        for (int i = bx * 512 + tid; i < D * D / 4; i += G * 512) { const int kk = (i * 4) >> 10; const f32x4 v = *(const f32x4*)(w_q_mem + (size_t)i * 4) * (g_cross[kk] * (LOG2E / 16.0f));
            *(unsigned long long*)(WQS + (size_t)i * 4) = (unsigned long long)pk2(v[0], v[1]) | ((unsigned long long)pk2(v[2], v[3]) << 32); }
        for (int r = gw; r < NB * 256; r += NGW) { const GAS f32x4* xr = (const GAS f32x4*)(mem + (size_t)r * D) + lane; f32x4 v[4]; float s = 0.f;
#pragma unroll
            for (int j = 0; j < 4; ++j) { v[j] = xr[64 * j]; s += (v[j][0] * v[j][0] + v[j][1] * v[j][1]) + (v[j][2] * v[j][2] + v[j][3] * v[j][3]); }
            const float rs = __builtin_amdgcn_rsqf(wave_sum(s) * (1.f / D) + RMS_EPS);
            GAS unsigned long long* o8 = (GAS unsigned long long*)(MEMN + (size_t)r * D) + lane;
#pragma unroll
            for (int j = 0; j < 4; ++j) { const f32x4 gg = *((const f32x4*)g_mem + 64 * j + lane); const f32x4 a = v[j] * rs * gg; o8[64 * j] = (unsigned long long)pk2(a[0], a[1]) | ((unsigned long long)pk2(a[2], a[3]) << 32); } }
        __syncthreads();
        LAS float* wf = (LAS float*)(L + RING_OFF);
        LAS float* part = (LAS float*)(L + RING_OFF + 32768);
        for (int i = tid; i < 8 * 1024; i += 512) { const int h = i >> 10, kk = i & 1023; wf[i] = w_in[(size_t)kk * INC + C_F + h]; }
        __syncthreads();
        f32x4 gm[4];
#pragma unroll
        for (int j = 0; j < 4; ++j) gm[j] = *((const f32x4*)g_mix + 64 * j + lane);
        for (int blk = bx; blk < M / 256; blk += G) {
            f32x4 accm[4];
#pragma unroll
            for (int j = 0; j < 4; ++j) accm[j] = (f32x4){0.f, 0.f, 0.f, 0.f};
            for (int i0 = 0; i0 < 32; i0 += 2) {
              f32x4 vv[2][4];
#pragma unroll
              for (int rr = 0; rr < 2; ++rr) { const GAS f32x4* xr = (const GAS f32x4*)(x + ((size_t)blk * 256 + wave * 32 + i0 + rr) * D) + lane;
#pragma unroll
                  for (int j = 0; j < 4; ++j) vv[rr][j] = xr[64 * j]; }
#pragma unroll
              for (int rr = 0; rr < 2; ++rr) {
                const size_t r = (size_t)blk * 256 + wave * 32 + i0 + rr;
                f32x4 v[4]; float s = 0.f;
#pragma unroll
                for (int j = 0; j < 4; ++j) { v[j] = vv[rr][j]; s += (v[j][0] * v[j][0] + v[j][1] * v[j][1]) + (v[j][2] * v[j][2] + v[j][3] * v[j][3]); }
                const float rs = __builtin_amdgcn_rsqf(wave_sum(s) * (1.f / D) + RMS_EPS);
                GAS unsigned long long* o8 = (GAS unsigned long long*)(A1 + r * 2048) + lane;
                float fl[8];
#pragma unroll
                for (int h = 0; h < 8; ++h) fl[h] = 0.f;
#pragma unroll
                for (int j = 0; j < 4; ++j) { const f32x4 a = v[j] * rs * gm[j]; accm[j] += a;
                    const unsigned h0 = pk2(a[0], a[1]), h1 = pk2(a[2], a[3]);
                    o8[64 * j] = (unsigned long long)h0 | ((unsigned long long)h1 << 32);
                    const unsigned l0 = pk2(a[0] - bflo(h0), a[1] - bfhi(h0)), l1 = pk2(a[2] - bflo(h1), a[3] - bfhi(h1));
                    o8[256 + 64 * j] = (unsigned long long)l0 | ((unsigned long long)l1 << 32);
#pragma unroll
                    for (int h = 0; h < 8; ++h) { const f32x4 w = *((const LAS f32x4*)(wf + h * 1024) + 64 * j + lane); fl[h] += (a[0] * w[0] + a[1] * w[1]) + (a[2] * w[2] + a[3] * w[3]); } }
#pragma unroll
                for (int h = 0; h < 8; ++h) fl[h] = wave_sum(fl[h]);
                if (lane < 8) { float z = fl[0];
#pragma unroll
                    for (int h = 1; h < 8; ++h) z = (lane == h) ? fl[h] : z;
                    z += b_forget[lane];
                    LOGF[r * 8 + lane] = fminf(z, 0.f) - log1pf(__expf(-fabsf(z))); }
              }
            }
#pragma unroll
            for (int j = 0; j < 4; ++j) *((LAS f32x4*)(part + wave * 1024) + 64 * j + lane) = accm[j];
            __syncthreads();
            for (int col = tid; col < 1024; col += 512) { float s = 0.f;
#pragma unroll
                for (int w = 0; w < 8; ++w) s += part[w * 1024 + col];
                ABAR[(size_t)blk * 1024 + col] = s * (1.0f / 256.0f); }
            __syncthreads();
        }
    }
    xcd_barrier(bar);

    { DECL_PTRS;
        LAS float* sc = (LAS float*)(L + RING_OFF);
        for (int w = bx; w < 64; w += G) {
            const int b = w >> 3, h = w & 7; float v[16]; float run = 0.f;
#pragma unroll
            for (int i = 0; i < 16; ++i) { run += LOGF[((size_t)b * T + tid * 16 + i) * 8 + h]; v[i] = run; }
            float incl = run;
#pragma unroll
            for (int o = 1; o < 64; o <<= 1) { const float n = __shfl_up(incl, o); if (lane >= o) incl += n; }
            if (lane == 63) sc[wave] = incl;
            __syncthreads();
            float pre = incl - run;
            for (int ww = 0; ww < wave; ++ww) pre += sc[ww];
#pragma unroll
            for (int i = 0; i < 16; ++i) CC[(size_t)w * T + tid * 16 + i] = pre + v[i];
            __syncthreads();
        }
        for (int n = bx; n < 256; n += G) {
            for (int i = tid; i < 1024; i += 512) sc[i] = ABAR[(size_t)n * 1024 + i];
            __syncthreads();
            float s = 0.f;
            for (int kk = 0; kk < 1024; ++kk) s += sc[kk] * w_in[(size_t)kk * INC + C_KM + tid];
            KM[(size_t)n * 512 + tid] = s;
            __syncthreads();
        }
        pg8::Gemm g{MEMN, WKVT, D / 64, D * 2, D * 2, 0xffffffffu}; pg8::TileOrder S; S.init(NB * 256, 2048, G, bx, D * 2, D * 2, 0, 1 << 30);
        pg8::EpiBf16 E{KV, 2048, 0u, 1.f, nullptr};
        pg8::gemm_phase<pg8::EpiBf16, pg8::TileOrder, true>(L + RING_OFF, XL, g, S, E);
    }
    xcd_barrier(bar);

    { DECL_PTRS;
        LAS float* sc = (LAS float*)(L + RING_OFF);
        for (int n = bx; n < 256; n += G) {
            const int b = n >> 5, nb = n & 31;
            sc[tid] = KM[(size_t)n * 512 + tid];
            __syncthreads();
            f32x4 k0 = *(const LAS f32x4*)(sc + lane * 8), k1 = *(const LAS f32x4*)(sc + lane * 8 + 4);
            for (int i = 0; i < 128; ++i) { const int kk = wave * 128 + i;
                const f32x4 w0 = *(const f32x4*)(w_in + (size_t)kk * INC + C_QM + lane * 8), w1 = *(const f32x4*)(w_in + (size_t)kk * INC + C_QM + lane * 8 + 4);
                float s = (w0[0] * k0[0] + w0[1] * k0[1]) + (w0[2] * k0[2] + w0[3] * k0[3]) + (w1[0] * k1[0] + w1[1] * k1[1]) + (w1[2] * k1[2] + w1[3] * k1[3]);
                s += __shfl_xor(s, 1); s += __shfl_xor(s, 2); s += __shfl_xor(s, 4);
                if ((lane & 7) == 0) { const int h = lane >> 3; const unsigned hi = f2bf(s); const unsigned lo = f2bf(s - bf2f(hi));
                    bf16* zr = ZT + ((size_t)b * 256 + h * 32 + nb) * 3072; zr[kk] = (bf16)hi; zr[1024 + kk] = (bf16)hi; zr[2048 + kk] = (bf16)lo; } }
            __syncthreads();
        }
        for (int i = bx * 512 + tid; i < 64 * T + 8 * 256; i += G * 512) {
            float bv; bf16* dst;
            if (i < 64 * T) { bv = -CC[i] * LOG2E; dst = KXF + (size_t)i * 8; }
            else { const int j = i - 64 * T; bv = __builtin_amdgcn_exp2f(-(float)((j >> 8) + 1)) * LOG2E * (float)(j & 255); dst = KXM + (size_t)j * 8; }
            const unsigned h0 = f2bf(bv); const float r1 = bv - bf2f(h0); const unsigned h1 = f2bf(r1); const unsigned h2 = f2bf(r1 - bf2f(h1));
            *(v4u*)dst = (v4u){h0 | (h1 << 16), h2 | (0x3F80u << 16), 0x3F80u, 0u}; }
        { pg8::Gemm g{KV, WQS, 4, 4096, 2048, 0xffffffffu}; WqkOrder S{G, bx}; pg8::EpiF8 E{(unsigned char*)WQK, 1024, 32.0f};
          pg8::gemm_phase<pg8::EpiF8, WqkOrder, true>(L + RING_OFF, XL, g, S, E); }
        { pg8::Gemm g{WOT, KV, 4, 2048, 4096, 0xffffffffu}; VwoOrder S{G, (bx + 128) % G}; pg8::EpiF8 E{(unsigned char*)VWO, 1024, 4.0f};
          pg8::gemm_phase<pg8::EpiF8, VwoOrder, true>(L + RING_OFF, XL, g, S, E); }
    }
    xcd_barrier(bar);

    { DECL_PTRS;
        { pg8::Gemm g{A1, WINT, D / 64, 4096, D * 2, 0xffffffffu}; pg8::TileOrder S; S.init(M, NQKV, G, bx, 4096, D * 2, 0, 1 << 30);
          pg8::EpiBf16 E{QKV, NQKV, 0xC3u, C2, (unsigned*)(ctl + CW_QKN)};
          pg8::gemm_phase<pg8::EpiBf16, pg8::TileOrder, true>(L + RING_OFF, XL, g, S, E); }
        { pg8::Gemm g{A1, ZT, 3072 / 64, 4096, 6144, 4095u}; pg8::TileOrder S; S.init(M, 256, G, bx, 4096, 6144, (size_t)256 * 6144, 32);
          pg8::EpiGate E{SEL};
          pg8::gemm_phase<pg8::EpiGate, pg8::TileOrder, true>(L + RING_OFF, XL, g, S, E); }
    }
    xcd_barrier(bar);

    { DECL_PTRS;
        for (int e = bx * 512 + tid; e < 2048; e += G * 512) { const int bh = e >> 5, qb = e & 31;
            const unsigned* qk = (const unsigned*)(ctl + CW_QKN) + bh * 4;
            const float qn = sqrtf(__uint_as_float(__hip_atomic_load(qk, RLX_AGENT)) + __uint_as_float(__hip_atomic_load(qk + 1, RLX_AGENT))), kn = sqrtf(__uint_as_float(__hip_atomic_load(qk + 2, RLX_AGENT)) + __uint_as_float(__hip_atomic_load(qk + 3, RLX_AGENT)));
            const float thr = (2.0f * qn * kn * 1.02f + 40.0f) * (1.0f / LOG2E);
            const float* crow_ = CC + (size_t)bh * T; const int t0 = qb * 256; const float target = crow_[t0] + thr;
            int lo = 0, hi2 = t0;
            while (lo < hi2) { const int mid = (lo + hi2) >> 1; if (crow_[mid] >= target) lo = mid + 1; else hi2 = mid; }
            ((int*)(ctl + CW_T0TAB))[e] = (lo >> 6) & ~1; }
        LAS unsigned* wc = (LAS unsigned*)(L + RING_OFF);
        for (int w = bx; w < 2048; w += G) {
            const int bh = (w & 255) >> 2, n = (w & 3) + 4 * (w >> 8), trip = bh * 32 + n; const unsigned* selrow = SEL + (size_t)bh * T; unsigned base = 0u;
            for (int t0 = (n + 1) * 256; t0 < T; t0 += 2048) {
                unsigned m[4]; unsigned long long bal[4];
#pragma unroll
                for (int j = 0; j < 4; ++j) { const int t = t0 + j * 512 + tid; m[j] = 0u; if (t < T) m[j] = selrow[t]; }
#pragma unroll
                for (int j = 0; j < 4; ++j) { bal[j] = __ballot((m[j] >> n) & 1u); if (lane == 0) wc[j * 8 + wave] = (unsigned)__popcll(bal[j]); }
                __syncthreads();
                unsigned run = base;
#pragma unroll
                for (int j = 0; j < 4; ++j) { unsigned pre = 0u, tot = 0u;
#pragma unroll
                    for (int ww = 0; ww < 8; ++ww) { const unsigned c = wc[j * 8 + ww]; tot += c; if (ww < wave) pre += c; }
                    if ((m[j] >> n) & 1u) { const unsigned pos = run + pre + (unsigned)__popcll(bal[j] & ((1ull << lane) - 1ull)); const unsigned k = (unsigned)__popc(m[j] & ((1u << n) - 1u));
                        LIST[(size_t)trip * 8192 + pos] = (unsigned)(t0 + j * 512 + tid) | (k << 16); }
                    run += tot; }
                base = run;
                __syncthreads();
            }
            if (tid == 0) CNT[trip] = base;
        }
    }
    xcd_barrier(bar);

    { DECL_PTRS;
        LAS int* upre = (LAS int*)(L + RING_OFF + attn_body::ATTN_LDS_BYTES);
        LAS int* wsum = upre + 2052;
        { int c4[4]; int run = 0;
#pragma unroll
          for (int i = 0; i < 4; ++i) { c4[i] = run; run += (int)((CNT[tid * 4 + i] + 255u) >> 8); }
          int incl = run;
#pragma unroll
          for (int o = 1; o < 64; o <<= 1) { const int nn = __shfl_up(incl, o); if (lane >= o) incl += nn; }
          if (lane == 63) wsum[wave] = incl;
          __syncthreads();
          int pre = incl - run;
          for (int ww = 0; ww < wave; ++ww) pre += wsum[ww];
#pragma unroll
          for (int i = 0; i < 4; ++i) upre[tid * 4 + i] = pre + c4[i];
          if (tid == 511) upre[2048] = pre + run;
          __syncthreads(); }
        const int ntot = 4096 + upre[2048];
        const attn_body::hb16* Qb = (const attn_body::hb16*)QKV;
        const int r32 = lane & 31;
        LAS unsigned* qnext = (LAS unsigned*)(wsum + 16);
        unsigned* qhead = (unsigned*)(ctl + CW_QUEUE);
        if (tid == 0) qnext[0] = atomicAdd(qhead, 1u);
        __syncthreads();
        for (;;) {
            const int u = (int)qnext[0];
            if (u >= ntot) break;
            __syncthreads();
            unsigned nxt_ = 0u; if (tid == 0) nxt_ = atomicAdd(qhead, 1u);
            int kind, qrow, oslot = -1, NT, band0; const attn_body::hb16 *Qc, *Kt0, *Vt0, *KXt0;
            if (u < 2048) {
                const int qb = 31 - (u >> 6), bh = u & 63;
                const int b = bh >> 3, h = bh & 7;
                const int T0 = ((const int*)(ctl + CW_T0TAB))[bh * 32 + qb];
                kind = 0; qrow = b * T + qb * 256 + wave * 32 + r32; NT = 4 * (qb + 1) - T0; band0 = NT - 4;
                Qc = Qb + h * 64; Kt0 = Qb + (size_t)(b * T + T0 * 64) * NQKV + 512 + h * 64; Vt0 = Kt0 + 512; KXt0 = (const attn_body::hb16*)KXF + ((size_t)bh * T + T0 * 64) * 8;
            } else if (u < 4096) {
                const int w = u - 2048, bh = w >> 5, j = w & 31, b = bh >> 3, h = bh & 7;
                kind = 1; qrow = b * T + j * 256 + wave * 32 + r32; oslot = (qrow * 8 + h) * 4 + 3; NT = 4; band0 = 0;
                Qc = Qb + 1536 + h * 64; Kt0 = Qb + (size_t)(b * T + j * 256) * NQKV + 2048 + h * 64; Vt0 = Kt0 + 512; KXt0 = (const attn_body::hb16*)KXM + h * 256 * 8;
            } else {
                const int g = u - 4096; int lo = 0, hi2 = 2048;
                while (hi2 - lo > 1) { const int mid = (lo + hi2) >> 1; if (upre[mid] <= g) lo = mid; else hi2 = mid; }
                const int w = lo, c = g - upre[lo], bh = w >> 5, n = w & 31, b = bh >> 3, h = bh & 7; const int cnt = (int)CNT[w];
                int idx = c * 256 + wave * 32 + r32; const bool valid = idx < cnt; if (!valid) idx = cnt - 1;
                const unsigned e = LIST[(size_t)w * 8192 + idx];
                kind = 1; qrow = b * T + (int)(e & 0xffffu); oslot = valid ? (qrow * 8 + h) * 4 + (int)(e >> 16) : -1; NT = 4; band0 = 1 << 20;
                Qc = Qb + 1536 + h * 64; Kt0 = Qb + (size_t)(b * T + n * 256) * NQKV + 2048 + h * 64; Vt0 = Kt0 + 512; KXt0 = (const attn_body::hb16*)KXM + h * 256 * 8;
            }
            attn_body::attn_unit<8>((char*)lds + RING_OFF, kind, Qc, qrow, oslot, Kt0, Vt0, KXt0, NT, band0, (attn_body::hb16*)QKV + (Qc - Qb), (attn_body::hb16*)PO, PML);
            if (tid == 0) qnext[0] = nxt_;
            __syncthreads();
        }
    }
    xcd_barrier(bar);

    { DECL_PTRS;
    const f32x4 ga0 = *((const f32x4*)g_fox + 2 * lane), ga1 = *((const f32x4*)g_fox + 2 * lane + 1), gb0 = *((const f32x4*)g_moba + 2 * lane), gb1 = *((const f32x4*)g_moba + 2 * lane + 1);
    const int h = lane >> 3, cc = lane & 7; const float s2 = __builtin_amdgcn_exp2f(-(float)(h + 1)) * LOG2E * 256.0f;
    for (int r0 = gw * 2; r0 < M; r0 += NGW * 2) {
        v4u wa[2], pw[2][4]; unsigned mmv[2]; pg8::f32x2 ml[2][4];
#pragma unroll
        for (int rr = 0; rr < 2; ++rr) { const int r = r0 + rr, b = r >> 13, t = r & (T - 1); const size_t sb = ((size_t)r * 8 + h) * 4;
            wa[rr] = *((const v4u*)(QKV + (size_t)r * NQKV) + lane); mmv[rr] = SEL[((size_t)(b * 8 + h)) * T + t];
#pragma unroll
            for (int k = 0; k < 4; ++k) { ml[rr][k] = *(const pg8::f32x2*)(PML + (sb + k) * 2); pw[rr][k] = *((const v4u*)(PO + (sb + k) * 64) + cc); } }
#pragma unroll
        for (int rr = 0; rr < 2; ++rr) { const int r = r0 + rr, t = r & (T - 1), own = t >> 8;
            const float a[8] = {bflo(wa[rr].x), bfhi(wa[rr].x), bflo(wa[rr].y), bfhi(wa[rr].y), bflo(wa[rr].z), bfhi(wa[rr].z), bflo(wa[rr].w), bfhi(wa[rr].w)};
            float c[8]; unsigned mm = mmv[rr]; const int cnt = __popc(mm);
            float mk[4], lk[4];
#pragma unroll
            for (int k = 0; k < 4; ++k) { mk[k] = ml[rr][k].x; lk[k] = ml[rr][k].y; }
            mk[3] += s2 * (float)own; float Mx = mk[3];
#pragma unroll
            for (int k = 0; k < 3; ++k) { if (k < cnt) { const int nb = __ffs(mm) - 1; mm &= mm - 1u; mk[k] += s2 * (float)nb; Mx = fmaxf(Mx, mk[k]); } }
            float W = 0.f;
#pragma unroll
            for (int i = 0; i < 8; ++i) c[i] = 0.f;
#pragma unroll
            for (int k = 0; k < 4; ++k) { if (k == 3 || k < cnt) { const float w = lk[k] * __builtin_amdgcn_exp2f(mk[k] - Mx); W += w; const v4u p = pw[rr][k];
                c[0] += w * bflo(p.x); c[1] += w * bfhi(p.x); c[2] += w * bflo(p.y); c[3] += w * bfhi(p.y); c[4] += w * bflo(p.z); c[5] += w * bfhi(p.z); c[6] += w * bflo(p.w); c[7] += w * bfhi(p.w); } }
            const float iw = 1.0f / W;
#pragma unroll
            for (int i = 0; i < 8; ++i) c[i] *= iw;
            float sa = 0.f, sb2 = 0.f;
#pragma unroll
            for (int i = 0; i < 8; ++i) { sa += a[i] * a[i]; sb2 += c[i] * c[i]; }
            const float ra = __builtin_amdgcn_rsqf(wave_sum(sa) * (1.f / 512.f) + RMS_EPS), rb = __builtin_amdgcn_rsqf(wave_sum(sb2) * (1.f / 512.f) + RMS_EPS);
            v4u oa, ob;
            oa.x = pk2(a[0] * ra * ga0[0], a[1] * ra * ga0[1]); oa.y = pk2(a[2] * ra * ga0[2], a[3] * ra * ga0[3]); oa.z = pk2(a[4] * ra * ga1[0], a[5] * ra * ga1[1]); oa.w = pk2(a[6] * ra * ga1[2], a[7] * ra * ga1[3]);
            ob.x = pk2(c[0] * rb * gb0[0], c[1] * rb * gb0[1]); ob.y = pk2(c[2] * rb * gb0[2], c[3] * rb * gb0[3]); ob.z = pk2(c[4] * rb * gb1[0], c[5] * rb * gb1[1]); ob.w = pk2(c[6] * rb * gb1[2], c[7] * rb * gb1[3]);
            *((v4u*)(Y + (size_t)r * D) + lane) = oa; *((v4u*)(Y + (size_t)r * D + 512) + lane) = ob; }
    } }
    xcd_barrier(bar);

    { DECL_PTRS; pg8::Gemm g{Y, WOUTT, D / 64, D * 2, D * 2, 0xffffffffu}; pg8::TileOrder S; S.init(M, D, G, bx, D * 2, D * 2, 0, 1 << 30);
      pg8::EpiRes E{x, out, nullptr, (unsigned char*)HB1, SSQ1, 1.0f};
      pg8::gemm_phase<pg8::EpiRes, pg8::TileOrder, true>(L + RING_OFF, XL, g, S, E); }
    xcd_barrier(bar);

    { DECL_PTRS; pg8::Gemm g{HB1, WQK, D / 128, D, D, 0xffffffffu}; pg8::TileOrder S; S.init(M, D, G, bx, D, D, (size_t)D * D, 32);
      pg8::EpiSoftmax E{(unsigned char*)PB, SSQ1, 1.0f / 32.0f};
      pg8::gemm_phase<pg8::EpiSoftmax, pg8::TileOrder, true, true>(L + RING_OFF, XL, g, S, E); }
    xcd_barrier(bar);

    { DECL_PTRS; pg8::Gemm g{PB, VWO, D / 128, D, D, 0xffffffffu}; pg8::TileOrder S; S.init(M, D, G, bx, D, D, (size_t)D * D, 32);
      pg8::EpiRes E{out, out, HB2, nullptr, SSQ2, 1.0f / 1024.0f};
      pg8::gemm_phase<pg8::EpiRes, pg8::TileOrder, true, true>(L + RING_OFF, XL, g, S, E); }
    xcd_barrier(bar);

    { DECL_PTRS; pg8::Gemm g{HB2, WUPT, D / 64, D * 2, D * 2, 0xffffffffu}; pg8::TileOrder S; S.init(M, 2 * FF, G, bx, D * 2, D * 2, 0, 1 << 30);
      pg8::EpiUp E{GB, UB, SSQ2};
      pg8::gemm_phase<pg8::EpiUp, pg8::TileOrder, true>(L + RING_OFF, XL, g, S, E); }
    xcd_barrier(bar);

    { DECL_PTRS;
    for (int it = bx * 512 + tid; it < (M / 32) * (FF / 8); it += G * 512) {
        const int rc = it / (FF / 8), cg = (it - rc * (FF / 8)) * 8; const size_t r0 = (size_t)rc * 32; const int tt0 = (int)(r0 & (T - 1));
        float w0[8], w1[8], w2[8], cb[8], g0[8], g1[8];
#pragma unroll
        for (int q = 0; q < 2; ++q) { const f32x4 a0 = *(const f32x4*)(conv_w + cg + 4 * q), a1 = *(const f32x4*)(conv_w + FF + cg + 4 * q), a2 = *(const f32x4*)(conv_w + 2 * FF + cg + 4 * q), bb = *(const f32x4*)(conv_b + cg + 4 * q);
#pragma unroll
            for (int e = 0; e < 4; ++e) { w0[4 * q + e] = a0[e]; w1[4 * q + e] = a1[e]; w2[4 * q + e] = a2[e]; cb[4 * q + e] = bb[e]; } }
        if (tt0 >= 2) { const v4u p1 = *(const v4u*)(GB + (r0 - 1) * FF + cg), p0 = *(const v4u*)(GB + (r0 - 2) * FF + cg);
            g1[0] = bflo(p1.x); g1[1] = bfhi(p1.x); g1[2] = bflo(p1.y); g1[3] = bfhi(p1.y); g1[4] = bflo(p1.z); g1[5] = bfhi(p1.z); g1[6] = bflo(p1.w); g1[7] = bfhi(p1.w);
            g0[0] = bflo(p0.x); g0[1] = bfhi(p0.x); g0[2] = bflo(p0.y); g0[3] = bfhi(p0.y); g0[4] = bflo(p0.z); g0[5] = bfhi(p0.z); g0[6] = bflo(p0.w); g0[7] = bfhi(p0.w); }
        else {
#pragma unroll
            for (int e = 0; e < 8; ++e) { g0[e] = 0.f; g1[e] = 0.f; } }
#pragma unroll 4
        for (int i = 0; i < 32; ++i) { const size_t off = (r0 + i) * FF + cg;
            const v4u gw2 = *(const v4u*)(GB + off), uw = *(const v4u*)(UB + off);
            const float g2[8] = {bflo(gw2.x), bfhi(gw2.x), bflo(gw2.y), bfhi(gw2.y), bflo(gw2.z), bfhi(gw2.z), bflo(gw2.w), bfhi(gw2.w)};
            const float uu[8] = {bflo(uw.x), bfhi(uw.x), bflo(uw.y), bfhi(uw.y), bflo(uw.z), bfhi(uw.z), bflo(uw.w), bfhi(uw.w)};
            float res[8];
#pragma unroll
            for (int e = 0; e < 8; ++e) { const float gc = cb[e] + w0[e] * g0[e] + w1[e] * g1[e] + w2[e] * g2[e];
                res[e] = gc * __builtin_amdgcn_rcpf(1.0f + __builtin_amdgcn_exp2f(-LOG2E * gc)) * uu[e]; g0[e] = g1[e]; g1[e] = g2[e]; }
            *(unsigned long long*)(ACT8 + off) = (unsigned long long)pg8::pk4_fp8(res[0], res[1], res[2], res[3]) | ((unsigned long long)pg8::pk4_fp8(res[4], res[5], res[6], res[7]) << 32); }
    } }
    xcd_barrier(bar);

    { DECL_PTRS; pg8::Gemm g{ACT8, WDT, FF / 128, FF, FF, 0xffffffffu}; pg8::TileOrder S; S.init(M, D, G, bx, FF, FF, 0, 1 << 30);
      pg8::EpiRes E{out, out, nullptr, nullptr, SSQ3, 1.0f / 64.0f};
      pg8::gemm_phase<pg8::EpiRes, pg8::TileOrder, true, true>(L + RING_OFF, XL, g, S, E); }
    xcd_barrier(bar);

    { DECL_PTRS;
    f32x4 gf[4];
#pragma unroll
    for (int j = 0; j < 4; ++j) gf[j] = *((const f32x4*)g_final + 64 * j + lane);
    for (int r0 = gw * 4; r0 < M; r0 += NGW * 4) {
        f32x4 v[4][4]; float rs[4];
#pragma unroll
        for (int k = 0; k < 4; ++k) { rs[k] = pg8::rstd_from_slots(SSQ3 + (size_t)(r0 + k) * 16); const GAS f32x4* o = (const GAS f32x4*)(out + (size_t)(r0 + k) * D) + lane;
#pragma unroll
            for (int j = 0; j < 4; ++j) v[k][j] = o[64 * j]; }
#pragma unroll
        for (int k = 0; k < 4; ++k) { GAS f32x4* o = (GAS f32x4*)(out + (size_t)(r0 + k) * D) + lane;
#pragma unroll
            for (int j = 0; j < 4; ++j) o[64 * j] = v[k][j] * rs[k] * gf[j]; }
    } }
}

extern "C" void kernel_launch(void* const* d_in, const int* in_sizes, int n_in, void* d_out, int out_size, void* d_ws, size_t ws_size, hipStream_t stream) {
    static int grid = 0;
    if (grid == 0) {
        if (n_in != 19 || in_sizes[0] != M * D || out_size != M * D || ws_size < WS_END) { fprintf(stderr, "kernel_launch: unexpected problem shape (n_in %d, in0 %d, out %d, ws %zu); nothing launched\n", n_in, n_in > 0 ? in_sizes[0] : -1, out_size, ws_size); grid = -1; return; }
        int dev = 0, cus = 0, per_cu = 0;
        if (hipGetDevice(&dev) != hipSuccess || hipDeviceGetAttribute(&cus, hipDeviceAttributeMultiprocessorCount, dev) != hipSuccess) { grid = -1; return; }
        if (hipFuncSetAttribute((const void*)fwd, hipFuncAttributeMaxDynamicSharedMemorySize, LDS_BYTES) != hipSuccess) { fprintf(stderr, "kernel_launch: hipFuncSetAttribute failed\n"); grid = -1; return; }
        if (hipOccupancyMaxActiveBlocksPerMultiprocessor(&per_cu, (const void*)fwd, NWAVES * 64, LDS_BYTES) != hipSuccess || per_cu < 1) { fprintf(stderr, "kernel_launch: occupancy query reports %d\n", per_cu); }
        (void)hipGetLastError();
        grid = cus;
    }
    if (grid < 0) return;
    if (hipMemsetAsync((char*)d_ws + WS_CTL, 0, CTL_ZERO_BYTES, stream) != hipSuccess) return;
    Args a{};
    for (int i = 0; i < 19; ++i) a.in[i] = (const float*)d_in[i];
    a.out = (float*)d_out; a.ws = (unsigned char*)d_ws;
    hipLaunchKernelGGL(fwd, dim3(grid), dim3(NWAVES * 64), LDS_BYTES, stream, a);
}
```

```cpp
#include <hip/hip_runtime.h>
#include <hip/hip_bf16.h>
#include <cstdio>
#include <cstdint>

namespace pg8 {
#define PG8_LAS __attribute__((address_space(3)))
typedef unsigned short bf16_t;
typedef short bf16x8 __attribute__((ext_vector_type(8)));
typedef float f32x4 __attribute__((ext_vector_type(4)));
typedef float f32x2 __attribute__((ext_vector_type(2)));
typedef unsigned u32x4 __attribute__((ext_vector_type(4)));
typedef unsigned u32x2 __attribute__((ext_vector_type(2)));
typedef int i32x4 __attribute__((ext_vector_type(4)));
typedef int i32x8 __attribute__((ext_vector_type(8)));
constexpr int BM = 256, BK = 64, HALF = 128, HTB = HALF * BK * 2  , STAGE_BYTES = 8 * HTB, NXCD = 8, WGM = 8;

__host__ __device__ __forceinline__ int lds_byte(int r, int c) { const int st = (r >> 4) * 2 + (c >> 5), rr = r & 15, cc = c & 31, ob = rr * 64 + cc * 2; return st * 1024 + (ob ^ (((ob >> 9) & 1) << 5)); }
__host__ __device__ __forceinline__ void stage_rc(int b, int& R, int& C) { const int st = b / 1024, sb = b % 1024, swz = sb ^ (((sb >> 9) & 1) << 5); R = (st >> 1) * 16 + swz / 64; C = (st & 1) * 32 + (swz % 64) / 2; }
__host__ __device__ __forceinline__ int perm32(int rho) { const int n = rho >> 4, i = rho & 15; return 8 * (i >> 2) + 4 * n + (i & 3); }

struct Unit { int pm, pn; size_t aoff, boff; };
struct Gemm { const void* A; const void* Bt; int nt, lda, ldb; unsigned wrapmask; };

struct TileOrder {
    int nM, nN, nwg, G, c; size_t a_tile, b_tile, b_batch; int pmb;
    __device__ __forceinline__ void init(int M, int N, int G_, int c_, int lda_bytes, int ldb_bytes, size_t b_batch_bytes, int pm_per_batch) {
        nM = M / BM; nN = N / BM; nwg = nM * nN; G = G_; c = c_; a_tile = (size_t)BM * lda_bytes; b_tile = (size_t)BM * ldb_bytes; b_batch = b_batch_bytes; pmb = pm_per_batch; }
    __device__ __forceinline__ bool next(int i, Unit& u) const {
        const long L = (long)i * G + c; if (L >= nwg) return false;
        int wgid = (int)L; { const int q = nwg / NXCD, r = nwg % NXCD, xcd = wgid % NXCD, off = wgid / NXCD; wgid = (xcd < r ? xcd * (q + 1) : r * (q + 1) + (xcd - r) * q) + off; }
        const int nig = WGM * nN, gid = wgid / nig, fm = gid * WGM, gsz = (nM - fm) < WGM ? (nM - fm) : WGM;
        u.pm = fm + ((wgid % nig) % gsz); u.pn = (wgid % nig) / gsz;
        u.aoff = (size_t)u.pm * a_tile; u.boff = (size_t)u.pn * b_tile + (size_t)(u.pm / pmb) * b_batch; return true;
    }
};

__device__ __forceinline__ unsigned cvt_pk_bf16(float lo, float hi) { unsigned r; asm volatile("v_cvt_pk_bf16_f32 %0, %1, %2" : "=v"(r) : "v"(lo), "v"(hi)); return r; }

typedef f32x4 AccT[2][2][4][2];

struct EpiBf16 {
    static constexpr bool PERM = true;
    bf16_t* O; int ldc; unsigned scalemask; float scale0; unsigned* nrm;
    __device__ __forceinline__ void operator()(AccT& acc, const Unit& u, int wr, int wc, int fr, int fq, PG8_LAS unsigned char*) const {
        const int row0 = u.pm * BM + wr * 64 + fr, col0 = u.pn * BM + wc * 32 + 8 * fq;
        const float sc = ((scalemask >> u.pn) & 1u) ? scale0 : 1.f;
        if (nrm && (u.pn < 4 || (u.pn >= 6 && u.pn < 10))) {
#pragma unroll
            for (int bj = 0; bj < 2; ++bj) { float mx = 0.f;
#pragma unroll
                for (int ai = 0; ai < 2; ++ai)
#pragma unroll
                    for (int m = 0; m < 4; ++m) { const f32x4 v0 = acc[ai][bj][m][0] * sc, v1 = acc[ai][bj][m][1] * sc;
                        float q = (v0[0] * v0[0] + v0[1] * v0[1]) + (v0[2] * v0[2] + v0[3] * v0[3]) + (v1[0] * v1[0] + v1[1] * v1[1]) + (v1[2] * v1[2] + v1[3] * v1[3]);
                        q += __shfl_xor(q, 16); q += __shfl_xor(q, 32); mx = fmaxf(mx, q); }
                mx = fmaxf(mx, __shfl_xor(mx, 1)); mx = fmaxf(mx, __shfl_xor(mx, 2)); mx = fmaxf(mx, __shfl_xor(mx, 4)); mx = fmaxf(mx, __shfl_xor(mx, 8));
                if (fr == 0 && fq == 0) { const int head = (u.pn & 1) * 4 + 2 * bj + (wc >> 1); const int grp = u.pn < 4 ? (u.pn >> 1) : (u.pn >> 1) - 1; atomicMax(nrm + (((u.pm >> 5) * 8 + head) * 4 + grp) * 2 + (wc & 1), __float_as_uint(mx)); } } }
#pragma unroll
        for (int ai = 0; ai < 2; ++ai)
#pragma unroll
            for (int m = 0; m < 4; ++m) { bf16_t* rowp = O + (size_t)(row0 + ai * HALF + m * 16) * ldc + col0;
#pragma unroll
                for (int bj = 0; bj < 2; ++bj) { const f32x4 v0 = acc[ai][bj][m][0] * sc, v1 = acc[ai][bj][m][1] * sc;
                    u32x4 w; w.x = cvt_pk_bf16(v0[0], v0[1]); w.y = cvt_pk_bf16(v0[2], v0[3]); w.z = cvt_pk_bf16(v1[0], v1[1]); w.w = cvt_pk_bf16(v1[2], v1[3]);
                    *(u32x4*)(rowp + bj * HALF) = w; } }
    }
};
__device__ __forceinline__ unsigned pk4_fp8(float a, float b, float c, float d) { int w = 0; w = __builtin_amdgcn_cvt_pk_fp8_f32(a, b, w, false); w = __builtin_amdgcn_cvt_pk_fp8_f32(c, d, w, true); return (unsigned)w; }
struct EpiF8 {
    static constexpr bool PERM = true;
    unsigned char* O; int ldc; float sc;
    __device__ __forceinline__ void operator()(AccT& acc, const Unit& u, int wr, int wc, int fr, int fq, PG8_LAS unsigned char*) const {
        const int row0 = u.pm * BM + wr * 64 + fr, col0 = u.pn * BM + wc * 32 + 8 * fq;
#pragma unroll
        for (int ai = 0; ai < 2; ++ai)
#pragma unroll
            for (int m = 0; m < 4; ++m) { unsigned char* rowp = O + (size_t)(row0 + ai * HALF + m * 16) * ldc + col0;
#pragma unroll
                for (int bj = 0; bj < 2; ++bj) { const f32x4 v0 = acc[ai][bj][m][0] * sc, v1 = acc[ai][bj][m][1] * sc;
                    *(u32x2*)(rowp + bj * HALF) = (u32x2){pk4_fp8(v0[0], v0[1], v0[2], v0[3]), pk4_fp8(v1[0], v1[1], v1[2], v1[3])}; } }
    }
};
__device__ __forceinline__ float rstd_from_slots(const float* slots) {
    const f32x4 a = *(const f32x4*)slots, b = *(const f32x4*)(slots + 4), c = *(const f32x4*)(slots + 8), d = *(const f32x4*)(slots + 12);
    const float s = ((a[0] + a[1]) + (a[2] + a[3])) + ((b[0] + b[1]) + (b[2] + b[3])) + ((c[0] + c[1]) + (c[2] + c[3])) + ((d[0] + d[1]) + (d[2] + d[3]));
    return __builtin_amdgcn_rsqf(s * (1.0f / 1024.0f) + 1e-6f);
}
struct EpiUp {
    static constexpr bool PERM = true;
    bf16_t* Gb; bf16_t* Ub; const float* ssq;
    __device__ __forceinline__ void operator()(AccT& acc, const Unit& u, int wr, int wc, int fr, int fq, PG8_LAS unsigned char*) const {
        const int row0 = u.pm * BM + wr * 64 + fr; const int pn = u.pn >= 11 ? u.pn - 11 : u.pn; bf16_t* base = u.pn >= 11 ? Ub : Gb;
        const int col0 = pn * BM + wc * 32 + 8 * fq;
#pragma unroll
        for (int ai = 0; ai < 2; ++ai)
#pragma unroll
            for (int m = 0; m < 4; ++m) { const int row = row0 + ai * HALF + m * 16; const float rs = rstd_from_slots(ssq + (size_t)row * 16); bf16_t* rowp = base + (size_t)row * 2816 + col0;
#pragma unroll
                for (int bj = 0; bj < 2; ++bj) { const f32x4 v0 = acc[ai][bj][m][0] * rs, v1 = acc[ai][bj][m][1] * rs;
                    u32x4 w; w.x = cvt_pk_bf16(v0[0], v0[1]); w.y = cvt_pk_bf16(v0[2], v0[3]); w.z = cvt_pk_bf16(v1[0], v1[1]); w.w = cvt_pk_bf16(v1[2], v1[3]);
                    *(u32x4*)(rowp + bj * HALF) = w; } }
    }
};
struct EpiRes {
    static constexpr bool PERM = true;
    const float* base; float* out; bf16_t* hb; unsigned char* hb8; float* ssq; float accs;
    __device__ __forceinline__ void operator()(AccT& acc, const Unit& u, int wr, int wc, int fr, int fq, PG8_LAS unsigned char*) const {
        const int row0 = u.pm * BM + wr * 64 + fr, col0 = u.pn * BM + wc * 32 + 8 * fq;
#pragma unroll
        for (int ai = 0; ai < 2; ++ai)
#pragma unroll
            for (int m = 0; m < 4; ++m) { const int row = row0 + ai * HALF + m * 16; const size_t off = (size_t)row * 1024 + col0; float q = 0.f;
#pragma unroll
                for (int bj = 0; bj < 2; ++bj) {
                    const f32x4 b0 = *(const f32x4*)(base + off + bj * HALF), b1 = *(const f32x4*)(base + off + bj * HALF + 4);
                    const f32x4 v0 = acc[ai][bj][m][0] * accs + b0, v1 = acc[ai][bj][m][1] * accs + b1;
                    *(f32x4*)(out + off + bj * HALF) = v0; *(f32x4*)(out + off + bj * HALF + 4) = v1;
                    q += (v0[0] * v0[0] + v0[1] * v0[1]) + (v0[2] * v0[2] + v0[3] * v0[3]) + (v1[0] * v1[0] + v1[1] * v1[1]) + (v1[2] * v1[2] + v1[3] * v1[3]);
                    if (hb) { u32x4 w; w.x = cvt_pk_bf16(v0[0], v0[1]); w.y = cvt_pk_bf16(v0[2], v0[3]); w.z = cvt_pk_bf16(v1[0], v1[1]); w.w = cvt_pk_bf16(v1[2], v1[3]); *(u32x4*)(hb + off + bj * HALF) = w; }
                    if (hb8) *(u32x2*)(hb8 + off + bj * HALF) = (u32x2){pk4_fp8(v0[0], v0[1], v0[2], v0[3]), pk4_fp8(v1[0], v1[1], v1[2], v1[3])}; }
                q += __shfl_xor(q, 16); q += __shfl_xor(q, 32);
                if (fq == 0) ssq[(size_t)row * 16 + u.pn * 4 + wc] = q; }
    }
};
struct EpiResNorm {
    static constexpr bool PERM = true;
    const float* base; float* out; const float* gfin; float accs; float* xbuf; unsigned* cnt; unsigned* tmo;
    __device__ __forceinline__ void operator()(AccT& acc, const Unit& u, int wr, int wc, int fr, int fq, PG8_LAS unsigned char* xl) const {
        PG8_LAS float* Pp = (PG8_LAS float*)xl;
        PG8_LAS float* Sr = Pp + 1024;
        PG8_LAS unsigned* flag = (PG8_LAS unsigned*)(Sr + 256);
        const int tid = threadIdx.x, wid = tid >> 6, lane = tid & 63;
        const int row0 = u.pm * BM + wr * 64 + fr, col0 = u.pn * BM + wc * 32 + 8 * fq;
#pragma unroll
        for (int ai = 0; ai < 2; ++ai)
#pragma unroll
            for (int m = 0; m < 4; ++m) { const int row = row0 + ai * HALF + m * 16; const size_t off = (size_t)row * 1024 + col0; float q = 0.f;
#pragma unroll
                for (int bj = 0; bj < 2; ++bj) {
                    const f32x4 b0 = *(const f32x4*)(base + off + bj * HALF), b1 = *(const f32x4*)(base + off + bj * HALF + 4);
                    const f32x4 v0 = acc[ai][bj][m][0] * accs + b0, v1 = acc[ai][bj][m][1] * accs + b1; acc[ai][bj][m][0] = v0; acc[ai][bj][m][1] = v1;
                    q += (v0[0] * v0[0] + v0[1] * v0[1]) + (v0[2] * v0[2] + v0[3] * v0[3]) + (v1[0] * v1[0] + v1[1] * v1[1]) + (v1[2] * v1[2] + v1[3] * v1[3]); }
                q += __shfl_xor(q, 16); q += __shfl_xor(q, 32);
                if (fq == 0) Pp[(ai * HALF + wr * 64 + m * 16 + fr) * 4 + wc] = q; }
        asm volatile("s_waitcnt lgkmcnt(0)" ::: "memory"); __builtin_amdgcn_s_barrier(); asm volatile("" ::: "memory");
        if (wid < 4) { const int r = wid * 64 + lane; const f32x4 p = *(const PG8_LAS f32x4*)(Pp + r * 4);
            __hip_atomic_store(xbuf + (size_t)(u.pm * BM + r) * 4 + u.pn, (p[0] + p[1]) + (p[2] + p[3]), __ATOMIC_RELAXED, __HIP_MEMORY_SCOPE_AGENT);
            asm volatile("s_waitcnt vmcnt(0)" ::: "memory");
            if (lane == 0) __hip_atomic_fetch_add(cnt + 64 * u.pm, 1u, __ATOMIC_RELAXED, __HIP_MEMORY_SCOPE_AGENT); }
        if (wid == 0) { unsigned sp = 0u; bool dead = false;
            for (;;) { if ((unsigned)__builtin_amdgcn_readfirstlane(__hip_atomic_load(cnt + 64 * u.pm, __ATOMIC_RELAXED, __HIP_MEMORY_SCOPE_AGENT)) >= 16u) break;
                if (++sp > (1u << 20)) { if (lane == 0) __hip_atomic_store(tmo, 1u, __ATOMIC_RELAXED, __HIP_MEMORY_SCOPE_AGENT); dead = true; break; }
                __builtin_amdgcn_s_sleep(2); }
            __builtin_amdgcn_fence(__ATOMIC_ACQUIRE, "agent");
            if (lane == 0) flag[0] = dead ? 1u : 0u; }
        asm volatile("s_waitcnt vmcnt(0) lgkmcnt(0)" ::: "memory"); __builtin_amdgcn_s_barrier(); asm volatile("" ::: "memory");
        if (wid < 4) { const int r = wid * 64 + lane; const float* xs = xbuf + (size_t)(u.pm * BM + r) * 4; float s = 0.f;
#pragma unroll
            for (int t = 0; t < 4; ++t) s += __hip_atomic_load(xs + t, __ATOMIC_RELAXED, __HIP_MEMORY_SCOPE_AGENT);
            Sr[r] = __builtin_amdgcn_rsqf(s * (1.0f / 1024.0f) + 1e-6f); }
        asm volatile("s_waitcnt vmcnt(0) lgkmcnt(0)" ::: "memory"); __builtin_amdgcn_s_barrier(); asm volatile("" ::: "memory");
        f32x4 gg[2][2];
#pragma unroll
        for (int bj = 0; bj < 2; ++bj) { gg[bj][0] = *(const f32x4*)(gfin + col0 + bj * HALF); gg[bj][1] = *(const f32x4*)(gfin + col0 + bj * HALF + 4); }
#pragma unroll
        for (int ai = 0; ai < 2; ++ai)
#pragma unroll
            for (int m = 0; m < 4; ++m) { const int rl = ai * HALF + wr * 64 + m * 16 + fr; const float rs = Sr[rl]; const size_t off = (size_t)(u.pm * BM + rl) * 1024 + col0;
#pragma unroll
                for (int bj = 0; bj < 2; ++bj) { *(f32x4*)(out + off + bj * HALF) = acc[ai][bj][m][0] * rs * gg[bj][0]; *(f32x4*)(out + off + bj * HALF + 4) = acc[ai][bj][m][1] * rs * gg[bj][1]; } }
    }
};
struct EpiSoftmax {
    static constexpr bool PERM = true;
    unsigned char* P; const float* ssq; float sscale;
    __device__ __forceinline__ void operator()(AccT& acc, const Unit& u, int wr, int wc, int fr, int fq, PG8_LAS unsigned char* xl) const {
        PG8_LAS f32x2* X = (PG8_LAS f32x2*)xl;
        const int row0 = u.pm * BM + wr * 64 + fr, col0 = u.pn * BM + wc * 32 + 8 * fq;
        float ml[2][4];
#pragma unroll
        for (int ai = 0; ai < 2; ++ai)
#pragma unroll
            for (int m = 0; m < 4; ++m) { const int row = row0 + ai * HALF + m * 16; const float rs = rstd_from_slots(ssq + (size_t)row * 16) * sscale;
                float mx = -3.0e38f;
#pragma unroll
                for (int bj = 0; bj < 2; ++bj)
#pragma unroll
                    for (int n = 0; n < 2; ++n) { f32x4 v = acc[ai][bj][m][n] * rs; acc[ai][bj][m][n] = v; mx = fmaxf(fmaxf(mx, fmaxf(v[0], v[1])), fmaxf(v[2], v[3])); }
                mx = fmaxf(mx, __shfl_xor(mx, 16)); mx = fmaxf(mx, __shfl_xor(mx, 32));
                float s = 0.f;
#pragma unroll
                for (int bj = 0; bj < 2; ++bj)
#pragma unroll
                    for (int n = 0; n < 2; ++n) { f32x4 v = acc[ai][bj][m][n];
                        v[0] = __builtin_amdgcn_exp2f(v[0] - mx); v[1] = __builtin_amdgcn_exp2f(v[1] - mx); v[2] = __builtin_amdgcn_exp2f(v[2] - mx); v[3] = __builtin_amdgcn_exp2f(v[3] - mx);
                        acc[ai][bj][m][n] = v; s += (v[0] + v[1]) + (v[2] + v[3]); }
                s += __shfl_xor(s, 16); s += __shfl_xor(s, 32);
                ml[ai][m] = mx;
                if (fq == 0) X[(ai * HALF + wr * 64 + m * 16 + fr) * 4 + wc] = (f32x2){mx, s}; }
        asm volatile("s_waitcnt lgkmcnt(0)" ::: "memory"); __builtin_amdgcn_s_barrier(); asm volatile("" ::: "memory");
#pragma unroll
        for (int ai = 0; ai < 2; ++ai)
#pragma unroll
            for (int m = 0; m < 4; ++m) { const int rl = ai * HALF + wr * 64 + m * 16 + fr; const int row = u.pm * BM + rl;
                const f32x2 a = X[rl * 4 + 0], b = X[rl * 4 + 1], c = X[rl * 4 + 2], d = X[rl * 4 + 3];
                const float Mx = fmaxf(fmaxf(a.x, b.x), fmaxf(c.x, d.x));
                const float L = a.y * __builtin_amdgcn_exp2f(a.x - Mx) + b.y * __builtin_amdgcn_exp2f(b.x - Mx) + c.y * __builtin_amdgcn_exp2f(c.x - Mx) + d.y * __builtin_amdgcn_exp2f(d.x - Mx);
                const float f = __builtin_amdgcn_exp2f(ml[ai][m] - Mx) * __builtin_amdgcn_rcpf(L) * 256.0f;
                unsigned char* rowp = P + (size_t)row * 1024 + col0;
#pragma unroll
                for (int bj = 0; bj < 2; ++bj) { const f32x4 v0 = acc[ai][bj][m][0] * f, v1 = acc[ai][bj][m][1] * f;
                    *(u32x2*)(rowp + bj * HALF) = (u32x2){pk4_fp8(v0[0], v0[1], v0[2], v0[3]), pk4_fp8(v1[0], v1[1], v1[2], v1[3])}; } }
    }
};
struct EpiGate {
    static constexpr bool PERM = false;
    unsigned* sel;
    __device__ __forceinline__ void operator()(AccT& acc, const Unit& u, int wr, int wc, int fr, int fq, PG8_LAS unsigned char*) const {
        const int own = u.pm & 31;
#pragma unroll
        for (int ai = 0; ai < 2; ++ai)
#pragma unroll
            for (int m = 0; m < 4; ++m) { const int row = u.pm * BM + ai * HALF + wr * 64 + m * 16 + fr;
#pragma unroll
                for (int bj = 0; bj < 2; ++bj) { unsigned mask = 0u;
#pragma unroll
                    for (int round = 0; round < 3; ++round) { float bv = -3.0e38f; int bi = 32;
#pragma unroll
                        for (int n = 0; n < 2; ++n)
#pragma unroll
                            for (int i = 0; i < 4; ++i) { const int nb = 16 * n + 4 * fq + i; const float v = acc[ai][bj][m][n][i];
                                if (nb < own && !((mask >> nb) & 1u) && v > bv) { bv = v; bi = nb; } }
#pragma unroll
                        for (int off = 16; off <= 32; off <<= 1) { const float ov = __shfl_xor(bv, off); const int oi = __shfl_xor(bi, off); if (ov > bv || (ov == bv && oi < bi)) { bv = ov; bi = oi; } }
                        if (bi < 32) mask |= 1u << bi; }
                    if (fq == 0) sel[((size_t)((u.pm >> 5) * 8 + 4 * bj + wc)) * 8192 + (row & 8191)] = mask; } }
    }
};

template <class Epi, class Sched, bool ALIGN_EPI, bool F8 = false>
__device__ __forceinline__ void gemm_phase(PG8_LAS unsigned char* lds, PG8_LAS unsigned char* xl, const Gemm g, const Sched& S, const Epi& E) {
    int tid_ = threadIdx.x; asm volatile("" : "+v"(tid_));
    const int tid = tid_, wid = __builtin_amdgcn_readfirstlane(tid >> 6), lane = tid & 63, wr = wid >> 2, wc = wid & 3, fr = lane & 15, fq = lane >> 4;
    int nt = g.nt; asm volatile("" : "+s"(nt));
    unsigned voffA[2], voffB[2];
#pragma unroll
    for (int i = 0; i < 2; ++i) { int R, C; stage_rc(tid * 16 + i * 8192, R, C); const int Rb = Epi::PERM ? ((R & ~31) + perm32(R & 31)) : R;
        voffA[i] = (unsigned)(R * g.lda + C * 2); voffB[i] = (unsigned)(Rb * g.ldb + C * 2); }
    const size_t kstep = (size_t)(BK * 2);
    const size_t hstepA = (size_t)HALF * g.lda, hstepB = (size_t)HALF * g.ldb;
    const unsigned wmask = g.wrapmask;
    const unsigned ldsw = (unsigned)wid * 1024u;
    const int aoff = lds_byte(wr * 64 + fr, fq * 8), boff = lds_byte(wc * 32 + fr, fq * 8);
#define PG8_SA(b, h) (((b) * 2 + (h)) * HTB)
#define PG8_SB(b, h) ((4 + (b) * 2 + (h)) * HTB)
#define PG8_STAGE(bufoff, gbase, voff) do { _Pragma("unroll") for (int _i = 0; _i < 2; ++_i) \
        __builtin_amdgcn_global_load_lds((const unsigned*)((const char*)(gbase) + (voff)[_i]), (PG8_LAS unsigned*)(lds + (bufoff) + ldsw + _i * 8192), 16, 0, 0); } while (0)
#define PG8_LDA(dst, b, h) do { if constexpr (F8) { _Pragma("unroll") for (int m = 0; m < 4; ++m) { dst##8[m].lo = *(const PG8_LAS i32x4*)(lds + PG8_SA(b, h) + aoff + m * 2048); dst##8[m].hi = *(const PG8_LAS i32x4*)(lds + PG8_SA(b, h) + aoff + m * 2048 + 1024); } } \
        else { _Pragma("unroll") for (int m = 0; m < 4; ++m) _Pragma("unroll") for (int k = 0; k < 2; ++k) dst[m][k] = *(const PG8_LAS bf16x8*)(lds + PG8_SA(b, h) + aoff + m * 2048 + k * 1024); } } while (0)
#define PG8_LDB(dst, b, h) do { if constexpr (F8) { _Pragma("unroll") for (int n = 0; n < 2; ++n) { dst##8[n].lo = *(const PG8_LAS i32x4*)(lds + PG8_SB(b, h) + boff + n * 2048); dst##8[n].hi = *(const PG8_LAS i32x4*)(lds + PG8_SB(b, h) + boff + n * 2048 + 1024); } } \
        else { _Pragma("unroll") for (int n = 0; n < 2; ++n) _Pragma("unroll") for (int k = 0; k < 2; ++k) dst[n][k] = *(const PG8_LAS bf16x8*)(lds + PG8_SB(b, h) + boff + n * 2048 + k * 1024); } } while (0)
#define PG8_MMA(ai, bj, At, Bt) do { __builtin_amdgcn_s_setprio(1); \
        if constexpr (F8) { _Pragma("unroll") for (int m = 0; m < 4; ++m) _Pragma("unroll") for (int n = 0; n < 2; ++n) \
            asm volatile("v_mfma_f32_16x16x128_f8f6f4 %0, %1, %2, %0" : "+v"(acc[ai][bj][m][n]) : "v"(Bt##8[n]), "v"(At##8[m])); } \
        else { _Pragma("unroll") for (int m = 0; m < 4; ++m) _Pragma("unroll") for (int n = 0; n < 2; ++n) _Pragma("unroll") for (int k = 0; k < 2; ++k) \
            acc[ai][bj][m][n] = __builtin_amdgcn_mfma_f32_16x16x32_bf16(Bt[n][k], At[m][k], acc[ai][bj][m][n], 0, 0, 0); } \
        __builtin_amdgcn_s_setprio(0); } while (0)
#define PG8_WAIT_V(n) asm volatile("s_waitcnt vmcnt(" #n ")" ::: "memory")
#define PG8_WAIT_L(n) asm volatile("s_waitcnt lgkmcnt(" #n ")" ::: "memory")
#define PG8_BAR __builtin_amdgcn_s_barrier()
#define PG8_SCHED __builtin_amdgcn_sched_barrier(0)
    Unit cur, nxt; int ui = 0;
    if (!S.next(0, cur)) return;
    AccT acc;
    bf16x8 At[4][2], B0[2][2], B1[2][2]; i32x8 At8[4], B08[2], B18[2];
    const char* cA = (const char*)g.A + cur.aoff; const char* cB = (const char*)g.Bt + cur.boff;
    PG8_STAGE(PG8_SB(0, 0), cB, voffB); PG8_STAGE(PG8_SB(0, 1), cB + hstepB, voffB); PG8_STAGE(PG8_SA(0, 0), cA, voffA); PG8_STAGE(PG8_SA(0, 1), cA + hstepA, voffA);
    if (wr == 1) PG8_BAR;
    PG8_WAIT_V(2); PG8_BAR;
    PG8_STAGE(PG8_SB(1, 0), cB + kstep, voffB); PG8_STAGE(PG8_SA(1, 0), cA + kstep, voffA); PG8_STAGE(PG8_SB(1, 1), cB + hstepB + kstep, voffB);
    PG8_WAIT_V(6); PG8_BAR;
    { float z0; asm volatile("v_mov_b32 %0, 0" : "=v"(z0));
#pragma unroll
    for (int a = 0; a < 2; ++a)
#pragma unroll
        for (int b = 0; b < 2; ++b)
#pragma unroll
            for (int m = 0; m < 4; ++m)
#pragma unroll
                for (int n = 0; n < 2; ++n) acc[a][b][m][n] = (f32x4){z0, z0, z0, z0}; }
    for (;;) {
        const bool has_next = S.next(ui + 1, nxt);
        const char* nA = has_next ? (const char*)g.A + nxt.aoff : cA; const char* nB = has_next ? (const char*)g.Bt + nxt.boff : cB;
#pragma unroll 1
        for (int t = 0; t < nt; t += 2) {
            const bool last = (t == nt - 2);
            const char* a1 = cA + (size_t)((unsigned)(t * 128) & wmask) + kstep;
            const char* a2 = last ? nA : cA + (size_t)((unsigned)((t + 2) * 128) & wmask); const char* b2 = last ? nB : cB + (size_t)(t + 2) * kstep;
            const char* a3 = a2 + kstep; const char* b3 = b2 + kstep;
            PG8_LDB(B0, 0, 0); PG8_LDB(B1, 0, 1); PG8_SCHED; PG8_LDA(At, 0, 0); PG8_STAGE(PG8_SA(1, 1), a1 + hstepA, voffA);
            PG8_WAIT_V(8); PG8_WAIT_L(0); PG8_BAR; PG8_MMA(0, 0, At, B0); PG8_MMA(0, 1, At, B1); PG8_BAR; PG8_SCHED;
            PG8_LDA(At, 0, 1); PG8_STAGE(PG8_SB(0, 0), b2, voffB); PG8_STAGE(PG8_SB(0, 1), b2 + hstepB, voffB); PG8_STAGE(PG8_SA(0, 0), a2, voffA);
            PG8_WAIT_V(8); PG8_WAIT_L(0); PG8_BAR; PG8_MMA(1, 0, At, B0); PG8_MMA(1, 1, At, B1); PG8_BAR; PG8_SCHED;
            PG8_LDB(B0, 1, 0); PG8_LDB(B1, 1, 1); PG8_SCHED; PG8_LDA(At, 1, 0); PG8_STAGE(PG8_SA(0, 1), a2 + hstepA, voffA);
            PG8_WAIT_V(8); PG8_WAIT_L(0); PG8_BAR; PG8_MMA(0, 0, At, B0); PG8_MMA(0, 1, At, B1); PG8_BAR; PG8_SCHED;
            PG8_LDA(At, 1, 1); PG8_STAGE(PG8_SB(1, 0), b3, voffB); PG8_STAGE(PG8_SB(1, 1), b3 + hstepB, voffB); PG8_STAGE(PG8_SA(1, 0), a3, voffA);
            PG8_WAIT_V(8); PG8_WAIT_L(0); PG8_BAR; PG8_MMA(1, 0, At, B0); PG8_MMA(1, 1, At, B1); PG8_BAR; PG8_SCHED;
        }
        if constexpr (F8) asm volatile("s_nop 15\n\ts_nop 15" ::: "memory");
        if constexpr (ALIGN_EPI) { if (wr == 0) PG8_BAR; }
        E(acc, cur, wr, wc, fr, fq, xl);
        if (!has_next) break;
#pragma unroll
        for (int a = 0; a < 2; ++a)
#pragma unroll
            for (int b = 0; b < 2; ++b)
#pragma unroll
                for (int m = 0; m < 4; ++m)
#pragma unroll
                    for (int n = 0; n < 2; ++n) acc[a][b][m][n] = (f32x4){0.f, 0.f, 0.f, 0.f};
        cur = nxt; cA = nA; cB = nB; ++ui;
        if constexpr (ALIGN_EPI) { if (wr == 1) PG8_BAR; }
    }
    PG8_WAIT_V(0);
    if constexpr (!ALIGN_EPI) { if (wr == 0) PG8_BAR; }
    PG8_BAR;
#undef PG8_SA
#undef PG8_SB
#undef PG8_STAGE
#undef PG8_LDA
#undef PG8_LDB
#undef PG8_MMA
#undef PG8_WAIT_V
#undef PG8_WAIT_L
#undef PG8_BAR
#undef PG8_SCHED
}
}

constexpr int NWAVES = 8;
constexpr int NB = 8, T = 8192, D = 1024, M = NB * T;
constexpr int INC = 3080, NQKV = 3072, FF = 2816;
constexpr int C_F = 1536, C_QM = 1544, C_KM = 2056;
constexpr float LOG2E = 1.4426950408889634f;
constexpr float C2 = 0.125f * LOG2E;
constexpr float RMS_EPS = 1e-6f;

constexpr size_t MiB = 1u << 20;
constexpr size_t WS_CTL = 0, CTL_ZERO_BYTES = 1 * MiB;
constexpr size_t WS_LOGF = 2 * MiB, WS_C = 4 * MiB, WS_ABAR = 6 * MiB, WS_KM = 7 * MiB, WS_SEL = 8 * MiB;
constexpr size_t WS_SSQ1 = 10 * MiB, WS_SSQ2 = 14 * MiB, WS_SSQ3 = 18 * MiB;
constexpr size_t WS_MEMN = 22 * MiB, WS_KV = 26 * MiB, WS_WQS = 34 * MiB, WS_WOT = 36 * MiB, WS_WKVT = 38 * MiB, WS_WINT = 42 * MiB, WS_WOUTT = 48 * MiB;
constexpr size_t WS_WUPT = 50 * MiB, WS_WDT = 976 * MiB  , WS_ZT = 68 * MiB, WS_WQK = 80 * MiB, WS_VWO = 96 * MiB;
constexpr size_t WS_ACT8 = 64 * MiB;
constexpr size_t WS_A1 = 112 * MiB;
constexpr size_t WS_QKV = 368 * MiB;
constexpr size_t WS_Y = 752 * MiB, WS_HB1 = WS_A1 + 128 * MiB, WS_P = WS_QKV, WS_HB2 = WS_A1;
constexpr size_t WS_PO = WS_A1;
constexpr size_t WS_LIST = 880 * MiB, WS_PML = 944 * MiB, WS_KXF = 960 * MiB, WS_KXM = 968 * MiB, WS_CNT = 969 * MiB;
constexpr size_t WS_G = 240 * MiB, WS_U = 592 * MiB, WS_END = 1024 * MiB;
static_assert(WS_WUPT + (size_t)2 * FF * D * 2 <= WS_ZT && WS_ACT8 + (size_t)M * FF <= 240 * MiB && WS_WDT + (size_t)D * FF <= WS_END && WS_CNT + 8192 <= WS_WDT && WS_ZT + (size_t)8 * 256 * 3072 * 2 <= WS_WQK && WS_VWO + 16 * MiB <= WS_A1, "ws map");
static_assert(WS_G + (size_t)M * FF * 2 <= WS_U && WS_U + (size_t)M * FF * 2 <= WS_END && WS_Y + (size_t)M * D * 2 <= WS_LIST && WS_LIST + (size_t)2048 * 8192 * 4 <= WS_PML && WS_PML + (size_t)M * 32 * 8 <= WS_KXF && WS_KXF + (size_t)64 * 8192 * 16 <= WS_KXM, "ws map 2");
constexpr int CW_BAR = 4096;
constexpr int CW_QKN = 8192;
constexpr int CW_QUEUE = 12288;
constexpr int CW_T0TAB = 16384;
constexpr int CW_PANEL = 32768, CW_TMO2 = 20480;

constexpr int RING_OFF = 0, RING_BYTES = 131072;
constexpr int LDSCTL_OFF = RING_BYTES, MISC_OFF = LDSCTL_OFF + 320;
constexpr int XL_OFF = RING_BYTES + 512;
constexpr int LDS_BYTES = 147456;
static_assert(XL_OFF + 8192 <= LDS_BYTES, "LDS map");

#define GAS __attribute__((address_space(1)))
#define LAS __attribute__((address_space(3)))
typedef unsigned short bf16;
typedef unsigned v4u __attribute__((ext_vector_type(4)));
typedef float f32x4 __attribute__((ext_vector_type(4)));
typedef GAS unsigned gu32;
#define RLX_AGENT __ATOMIC_RELAXED, __HIP_MEMORY_SCOPE_AGENT
#define LDS_WAIT() asm volatile("s_waitcnt lgkmcnt(0)" ::: "memory")
__device__ __forceinline__ unsigned f2bf(float f) { unsigned u = __builtin_bit_cast(unsigned, f); return (u + 0x7fffu + ((u >> 16) & 1u)) >> 16; }
__device__ __forceinline__ unsigned pk2(float lo, float hi) { return f2bf(lo) | (f2bf(hi) << 16); }
__device__ __forceinline__ float bf2f(unsigned b) { return __builtin_bit_cast(float, b << 16); }
__device__ __forceinline__ float bflo(unsigned w) { return __builtin_bit_cast(float, w << 16); }
__device__ __forceinline__ float bfhi(unsigned w) { return __builtin_bit_cast(float, w & 0xffff0000u); }

#define XB_TMO      128
#define XB_XCNT(j)  (256  + 64 * (j))
#define XB_XSUB(j)  (1280 + 64 * (j))
#define XB_XGEN(j)  (2304 + 64 * (j))
#define XB_TOP      3328
#define XB_TOPGEN   3392
#define XCD_BAR_WORDS 3456
#define XB_SPIN_CAP (1u << 18)

__device__ __forceinline__ unsigned xb_ld(unsigned* p)              { return __hip_atomic_load(p, __ATOMIC_RELAXED, __HIP_MEMORY_SCOPE_AGENT); }
__device__ __forceinline__ unsigned xb_add(unsigned* p, unsigned v) { return __hip_atomic_fetch_add(p, v, __ATOMIC_RELAXED, __HIP_MEMORY_SCOPE_AGENT); }
__device__ __forceinline__ unsigned xb_xcc_id() { return (unsigned)__builtin_amdgcn_s_getreg((3 << 11) | 20) & 0xFu; }
#define XB_SPIN(cond, bar) do { unsigned _sp = 0; while (cond) { __builtin_amdgcn_s_sleep(1); \
    if ((++_sp & 255u) == 0u) { if (xb_ld(&(bar)[XB_TMO])) break; if (_sp > XB_SPIN_CAP) { atomicAdd(&(bar)[XB_TMO], 1u); break; } } } } while (0)

struct XcdBarrier { unsigned* bar; unsigned x; volatile LAS unsigned* st; };

__device__ __forceinline__ XcdBarrier xcd_barrier_post(unsigned* bar, volatile LAS unsigned* st) {
    XcdBarrier b; b.bar = bar; b.x = xb_xcc_id(); b.st = st;
    if (threadIdx.x == 0) (void)xb_add(&bar[XB_XCNT(b.x)], 1u);
    return b;
}
__device__ __forceinline__ void xcd_barrier_complete(unsigned* bar, unsigned x, unsigned& nloc, unsigned& nx) {
    const unsigned G = gridDim.x * gridDim.y * gridDim.z;
    unsigned sum, cnt, mine, sp = 0u;
    for (;;) {
        sum = 0u; cnt = 0u; mine = 0u;
#pragma unroll
        for (unsigned j = 0; j < 16; ++j) { const unsigned c = xb_ld(&bar[XB_XCNT(j)]); sum += c; cnt += (c > 0u) ? 1u : 0u; mine = (j == x) ? c : mine; }
        if (sum == G) break;
        __builtin_amdgcn_s_sleep(1);
        if ((++sp & 255u) == 0u) { if (xb_ld(&bar[XB_TMO])) break; if (sp > XB_SPIN_CAP) { atomicAdd(&bar[XB_TMO], 1u); break; } }
    }
    nloc = mine > 0u ? mine : 1u; nx = cnt > 0u ? cnt : 1u;
}
__device__ __forceinline__ void xcd_barrier(const XcdBarrier& b) {
    asm volatile("s_waitcnt vmcnt(0)" ::: "memory");
    __syncthreads();
    if (threadIdx.x == 0) {
        unsigned* bar = b.bar;
        __builtin_amdgcn_s_waitcnt(0);
        unsigned nloc = b.st[0], nx = b.st[1];
        if (nloc == 0u) { xcd_barrier_complete(bar, b.x, nloc, nx); b.st[0] = nloc; b.st[1] = nx; }
        const unsigned old = xb_add(&bar[XB_XSUB(b.x)], 1u);
        const unsigned gen = old / nloc;
        if (old + 1u == (gen + 1u) * nloc) {
            __builtin_amdgcn_fence(__ATOMIC_RELEASE, "agent");
            asm volatile("s_waitcnt vmcnt(0)" ::: "memory");
            const unsigned og = xb_add(&bar[XB_TOP], 1u);
            const unsigned tg = og / nx;
            if (og + 1u == (tg + 1u) * nx) xb_add(&bar[XB_TOPGEN], 1u);
            else XB_SPIN(xb_ld(&bar[XB_TOPGEN]) == tg, bar);
            __builtin_amdgcn_fence(__ATOMIC_ACQUIRE, "agent");
            xb_add(&bar[XB_XGEN(b.x)], 1u);
            asm volatile("s_waitcnt vmcnt(0)" ::: "memory");
        } else {
            XB_SPIN(xb_ld(&bar[XB_XGEN(b.x)]) == gen, bar);
            __builtin_amdgcn_fence(__ATOMIC_ACQUIRE, "agent");
            asm volatile("s_waitcnt vmcnt(0)" ::: "memory");
        }
    }
    __syncthreads();
}

__device__ __forceinline__ float wave_sum(float v) {
#pragma unroll
    for (int o = 1; o < 64; o <<= 1) v += __shfl_xor(v, o);
    return v;
}
__device__ __forceinline__ void p0_transpose_item(const float* W, int ldw, int K, int N, bf16* WT, const float* kscale, bool remap, LAS float* scr, int item, int lane, float f8scale = 0.f) {
    const int nblk = N / 32, kb = item / nblk, nb = item % nblk, k0 = 64 * kb, n0 = 32 * nb;
    const int sn0 = (remap && n0 >= 1536) ? n0 + 8 : n0;
#pragma unroll 8
    for (int i = 0; i < 32; ++i) { const int kk = 2 * i + (lane >> 5); float v = W[(size_t)(k0 + kk) * ldw + sn0 + (lane & 31)]; if (kscale) v *= kscale[k0 + kk]; scr[kk * 33 + (lane & 31)] = v; }
    LDS_WAIT(); asm volatile("" ::: "memory");
    const int c = lane & 7;
#pragma unroll
    for (int j = 0; j < 4; ++j) { const int n = (lane >> 3) + 8 * j; const LAS float* s = scr + (8 * c) * 33 + n;
        if (f8scale != 0.f) { const unsigned lo = pg8::pk4_fp8(s[0 * 33] * f8scale, s[1 * 33] * f8scale, s[2 * 33] * f8scale, s[3 * 33] * f8scale), hi = pg8::pk4_fp8(s[4 * 33] * f8scale, s[5 * 33] * f8scale, s[6 * 33] * f8scale, s[7 * 33] * f8scale);
            *(GAS unsigned long long*)((unsigned char*)WT + (size_t)(n0 + n) * K + k0 + 8 * c) = (unsigned long long)lo | ((unsigned long long)hi << 32); }
        else { v4u o; o.x = pk2(s[0 * 33], s[1 * 33]); o.y = pk2(s[2 * 33], s[3 * 33]); o.z = pk2(s[4 * 33], s[5 * 33]); o.w = pk2(s[6 * 33], s[7 * 33]);
            *(GAS v4u*)(WT + (size_t)(n0 + n) * K + k0 + 8 * c) = o; } }
    LDS_WAIT(); asm volatile("" ::: "memory");
}

struct Args { const float* in[19]; float* out; unsigned char* ws; };
__device__ __forceinline__ float skip_thr(const unsigned* qk8, int moba) {
    const unsigned* p = qk8 + 4 * moba;
    const float qn = sqrtf(__uint_as_float(__hip_atomic_load(p, RLX_AGENT)) + __uint_as_float(__hip_atomic_load(p + 1, RLX_AGENT))), kn = sqrtf(__uint_as_float(__hip_atomic_load(p + 2, RLX_AGENT)) + __uint_as_float(__hip_atomic_load(p + 3, RLX_AGENT)));
    return 2.0f * qn * kn * 1.02f + 40.0f;
}
__device__ __forceinline__ bool moba_skip(int h, int j, int n, float thr) { return __builtin_amdgcn_exp2f(-(float)(h + 1)) * LOG2E * (float)(256 * (j - n - 1) + 1) >= thr; }

namespace attn_body {
using hb16=__hip_bfloat16;
using bf16x8=__attribute__((ext_vector_type(8)))short;
using s16x4=__attribute__((ext_vector_type(4)))short;
using f32x16=__attribute__((ext_vector_type(16)))float;
using u32x4=__attribute__((ext_vector_type(4)))unsigned;
constexpr int PITCH=3072;
constexpr int NW=8,QBLK=32,QB=QBLK*NW,KVBLK=64;
__device__ __forceinline__ int crow(int r,int hi){return (r&3)+8*(r>>2)+4*hi;}
#define SBAR() __builtin_amdgcn_sched_barrier(0)
__device__ __forceinline__ void cmask(f32x16&p0,f32x16&p1,int jb,int qrel,int hi){
  const float NEG=-INFINITY; int kb=64*jb+4*hi;
  #pragma unroll
  for(int r=0;r<16;++r){int kv=kb+(r&3)+8*(r>>2); if(kv>qrel)p0[r]=NEG; if(kv+32>qrel)p1[r]=NEG;}
}
constexpr int NSLOT=3, SLOTB=9216;
constexpr int LDS_K=0, LDS_V=NSLOT*SLOTB, LDS_WS=2*NSLOT*SLOTB, LDS_OST=LDS_WS+NW*64*4, LDS_BYTES=LDS_OST+NW*4096;
__device__ __forceinline__ void glds16(const void*gsrc,unsigned lds_dst){unsigned keep;
  asm volatile("s_mov_b32 %0, m0\n\ts_mov_b32 m0, %2\n\ts_nop 0\n\tglobal_load_lds_dwordx4 %1, off\n\ts_mov_b32 m0, %0":"=&s"(keep):"v"(gsrc),"s"(lds_dst):"memory");}
__device__ __forceinline__ void glds16x(const void*gsrc,unsigned lds_dst){unsigned keep;unsigned long long ex;
  asm volatile("s_mov_b32 %0, m0\n\ts_mov_b64 %1, exec\n\ts_mov_b64 exec, 0xff\n\ts_mov_b32 m0, %3\n\ts_nop 0\n\tglobal_load_lds_dwordx4 %2, off\n\ts_mov_b64 exec, %1\n\ts_mov_b32 m0, %0":"=&s"(keep),"=&s"(ex):"v"(gsrc),"s"(lds_dst):"memory");}
__device__ __forceinline__ float max3f(float a,float b,float c){float r;asm("v_max3_f32 %0, %1, %2, %3":"=v"(r):"v"(a),"v"(b),"v"(c));return r;}
__device__ __forceinline__ float max2f(float a,float b){float r;asm("v_max_f32_e32 %0, %1, %2":"=v"(r):"v"(a),"v"(b));return r;}
__device__ __forceinline__ float fsub_s(float a,float b){float r;asm("v_sub_f32_e32 %0, %1, %2":"=v"(r):"v"(a),"v"(b));return r;}
typedef float f32x2_t __attribute__((ext_vector_type(2))); typedef __bf16 bf16x2_t __attribute__((ext_vector_type(2)));
__device__ __forceinline__ unsigned cvtpk_s(float lo,float hi){f32x2_t v={lo,hi};bf16x2_t b=__builtin_convertvector(v,bf16x2_t);return __builtin_bit_cast(unsigned,b);}
__device__ __forceinline__ float rbf(float x){return __builtin_bit_cast(float,cvtpk_s(x,0.f)<<16);}
#define WAIT_BAR(N) asm volatile("s_waitcnt vmcnt(" #N ") lgkmcnt(0)\n\ts_barrier":::"memory")

__device__ __forceinline__ void qkt(f32x16&p0,f32x16&p1,const char*Kslot,const bf16x8*qr,int r32,int hi){
  const char*kb=Kslot+hi*1024+r32*16; const f32x16 zf={};
  #pragma unroll
  for(int d0=0;d0<4;++d0){
    const bf16x8 b0=*reinterpret_cast<const bf16x8*>(kb+d0*2048);
    const bf16x8 b1=*reinterpret_cast<const bf16x8*>(kb+d0*2048+512);
    if(d0==0){p0=__builtin_amdgcn_mfma_f32_32x32x16_bf16(b0,qr[0],zf,0,0,0);p1=__builtin_amdgcn_mfma_f32_32x32x16_bf16(b1,qr[0],zf,0,0,0);}
    else{p0=__builtin_amdgcn_mfma_f32_32x32x16_bf16(b0,qr[d0],p0,0,0,0);p1=__builtin_amdgcn_mfma_f32_32x32x16_bf16(b1,qr[d0],p1,0,0,0);}}
  const char*kx=Kslot+8192+r32*16;
  const bf16x8 x0=*reinterpret_cast<const bf16x8*>(kx), x1=*reinterpret_cast<const bf16x8*>(kx+512);
  p0=__builtin_amdgcn_mfma_f32_32x32x16_bf16(x0,qr[4],p0,0,0,0);p1=__builtin_amdgcn_mfma_f32_32x32x16_bf16(x1,qr[4],p1,0,0,0);
}
typedef __attribute__((address_space(3))) const char* lds_cptr;
typedef short v4i16_t __attribute__((ext_vector_type(4)));
__device__ __forceinline__ void kload10(bf16x8*kf,lds_cptr kp,lds_cptr kx){
  kf[0]=*(const __attribute__((address_space(3))) bf16x8*)(kp);      kf[1]=*(const __attribute__((address_space(3))) bf16x8*)(kp+512);
  kf[2]=*(const __attribute__((address_space(3))) bf16x8*)(kp+2048); kf[3]=*(const __attribute__((address_space(3))) bf16x8*)(kp+2560);
  kf[4]=*(const __attribute__((address_space(3))) bf16x8*)(kp+4096); kf[5]=*(const __attribute__((address_space(3))) bf16x8*)(kp+4608);
  kf[6]=*(const __attribute__((address_space(3))) bf16x8*)(kp+6144); kf[7]=*(const __attribute__((address_space(3))) bf16x8*)(kp+6656);
  kf[8]=*(const __attribute__((address_space(3))) bf16x8*)(kx);      kf[9]=*(const __attribute__((address_space(3))) bf16x8*)(kx+512);
}
__device__ __forceinline__ void kload2(bf16x8*kf,lds_cptr kp,int j){ kf[2*j]=*(const __attribute__((address_space(3))) bf16x8*)(kp+j*2048); kf[2*j+1]=*(const __attribute__((address_space(3))) bf16x8*)(kp+j*2048+512); }
__device__ __forceinline__ s16x4 vtr(lds_cptr p){ return __builtin_bit_cast(s16x4,__builtin_amdgcn_ds_read_tr16_b64_v4i16((__attribute__((address_space(3))) v4i16_t*)p)); }
__device__ __forceinline__ float rowmax(const f32x16&p0,const f32x16&p1){
  float a=max3f(p0[0],p0[1],p1[0]),b=max3f(p0[2],p0[3],p1[1]);a=max3f(a,p1[2],p1[3]);
  #pragma unroll
  for(int r=4;r<16;r+=4){a=max3f(a,p0[r],p0[r+1]);b=max3f(b,p0[r+2],p0[r+3]);a=max3f(a,p1[r],p1[r+1]);b=max3f(b,p1[r+2],p1[r+3]);}
  const float m=max2f(a,b);
  auto rr=__builtin_amdgcn_permlane32_swap(__float_as_uint(m),__float_as_uint(m),false,false);
  return max2f(__uint_as_float(rr[0]),__uint_as_float(rr[1]));
}
__device__ __forceinline__ void pv(f32x16*o,int vb,bf16x8 pa0,bf16x8 pa1,bf16x8 pa2,bf16x8 pa3){
  #pragma unroll
  for(int d0=0;d0<2;++d0){s16x4 lo[4],hi[4];
    #pragma unroll
    for(int ks=0;ks<4;++ks){
      asm volatile("ds_read_b64_tr_b16 %0,%1 offset:%c2":"=&v"(lo[ks]):"v"(vb),"i"(d0*4096+ks*1024):"memory");
      asm volatile("ds_read_b64_tr_b16 %0,%1 offset:%c2":"=&v"(hi[ks]):"v"(vb),"i"(d0*4096+ks*1024+512):"memory");}
    asm volatile("s_waitcnt lgkmcnt(0)":::"memory");SBAR();
    #define PK(k) (bf16x8){lo[k][0],lo[k][1],lo[k][2],lo[k][3],hi[k][0],hi[k][1],hi[k][2],hi[k][3]}
    o[d0]=__builtin_amdgcn_mfma_f32_32x32x16_bf16(pa0,PK(0),o[d0],0,0,0);
    o[d0]=__builtin_amdgcn_mfma_f32_32x32x16_bf16(pa1,PK(1),o[d0],0,0,0);
    o[d0]=__builtin_amdgcn_mfma_f32_32x32x16_bf16(pa2,PK(2),o[d0],0,0,0);
    o[d0]=__builtin_amdgcn_mfma_f32_32x32x16_bf16(pa3,PK(3),o[d0],0,0,0);
    #undef PK
  }
}

template<int THRL> __device__ __forceinline__ void attn_unit(char*shm,const int KIND,const hb16*Qc,int qrow,int oslot,const hb16*__restrict__ Kt0,const hb16*__restrict__ Vt0,const hb16*__restrict__ KXt0,int NT,int band0,hb16*Oc,hb16*PO,float*PML){
  const int tid=threadIdx.x,lane=tid&63,r32=lane&31,hi=lane>>5; const int wid=__builtin_amdgcn_readfirstlane(tid>>6);
  const unsigned lds0=(unsigned)(uintptr_t)shm;
  float*wsf=(float*)(shm+LDS_WS)+wid*64;
  const hb16*ksrc=Kt0+(long)lane*PITCH+wid*8;
  const hb16*vsrc=Vt0+(long)(16*(wid&3)+(lane>>2))*PITCH+(wid>>2)*32+(lane&3)*8;
  const hb16*xsrc=KXt0+(long)(8*wid+(lane&7))*8;
  const unsigned kdst=lds0+LDS_K+wid*1024, vdst=lds0+LDS_V+wid*1024, xdst=lds0+LDS_K+8192+wid*128;
  #define DMA_K(t,slot) do{ glds16(ksrc+(long)(t)*KVBLK*PITCH,(unsigned)__builtin_amdgcn_readfirstlane(kdst+(slot))); glds16x(xsrc+(long)(t)*KVBLK*8,(unsigned)__builtin_amdgcn_readfirstlane(xdst+(slot))); }while(0)
  #define DMA_V(t,slot) glds16(vsrc+(long)(t)*KVBLK*PITCH,(unsigned)__builtin_amdgcn_readfirstlane(vdst+(slot)))
  const int vb0=(int)(lds0+LDS_V)+((lane>>4)&1)*32+(lane&3)*8+(4*hi+((lane&15)>>2))*64;
  const char*Kbase=shm+LDS_K; bf16x8 kf[10];
  const lds_cptr shm3=(lds_cptr)shm; const lds_cptr kp0=shm3+LDS_K+hi*1024+r32*16; const lds_cptr kx0=shm3+LDS_K+8192+r32*16; const lds_cptr vp0=shm3+LDS_V+((lane>>4)&1)*32+(lane&3)*8+(4*hi+((lane&15)>>2))*64;
  DMA_K(0,0);DMA_V(0,0);DMA_K(1,SLOTB);
  bf16x8 qr[5];
  { const hb16*Qw=Qc+(long)qrow*PITCH;
    #pragma unroll
    for(int d0=0;d0<4;++d0)qr[d0]=*reinterpret_cast<const bf16x8*>(&Qw[d0*16+hi*8]); }
  float mhat=0.f,l_reg=0.f;f32x16 o[2];o[0]=f32x16{};o[1]=f32x16{};
  #define SETQX(mh_,ml_) do{ const unsigned bh_=cvtpk_s(-(mh_),-(ml_)); u32x4 qx_; qx_.x=0x3F803F80u; qx_.y=0x3F80u|(bh_<<16); qx_.z=(bh_>>16); qx_.w=0u; if(hi){qx_.x=0u;qx_.y=0u;qx_.z=0u;} qr[4]=__builtin_bit_cast(bf16x8,qx_); asm volatile("":"+v"(qr[4])); }while(0)
  #define MOVEREF(gain) const float mraw_=mhat+(gain); const float mh_=rbf(mraw_); const float ml_=rbf(mraw_-mh_); const float mnew_=mh_+ml_; const float dl=mnew_-mhat; mhat=mnew_; SETQX(mh_,ml_);
  SETQX(0.f,0.f);
  const int qrel=wid*QBLK+r32;
  #define CMASK(P0,P1,t) do{int jb_=(t)-band0; if(jb_>=0)cmask(P0,P1,jb_,qrel,hi);}while(0)
  bool resc=false;
  #define START(P0,P1) do{ const float rm=rowmax(P0,P1); resc=false; \
    { MOVEREF(rm) \
      _Pragma("unroll") for(int r=0;r<16;++r){P0[r]=fsub_s(P0[r],dl);P1[r]=fsub_s(P1[r],dl);} } \
    _Pragma("unroll") for(int r=0;r<16;++r)P0[r]=__builtin_amdgcn_exp2f(P0[r]); }while(0)
  #define RESC() do{ if(resc){ asm volatile("s_waitcnt lgkmcnt(0)":::"memory"); \
      _Pragma("unroll") for(int d_=0;d_<2;++d_) _Pragma("unroll") for(int r=0;r<16;++r)o[d_][r]*=wsf[crow(r,hi)]; } }while(0)
  f32x16 pA0,pA1,pB0,pB1;
  int sl_prev=0,sl_cur=0,sl_next=SLOTB;
  #define ROT() do{sl_prev=sl_cur;sl_cur=sl_next;sl_next=(sl_next==(NSLOT-1)*SLOTB)?0:sl_next+SLOTB;}while(0)
  DMA_K(2,2*SLOTB);
  WAIT_BAR(5);
  qkt(pA0,pA1,Kbase,qr,r32,hi);asm volatile("s_nop 15\n\ts_nop 7":"+v"(pA0),"+v"(pA1));CMASK(pA0,pA1,0);
  START(pA0,pA1);
  _Pragma("unroll") for(int r=0;r<16;++r)pA1[r]=__builtin_amdgcn_exp2f(pA1[r]);
  WAIT_BAR(0);
  DMA_K(3,0);DMA_V(1,SLOTB);
  ROT();
  kload10(kf,kp0+sl_cur,kx0+sl_cur);
  WAIT_BAR(3);
  s16x4 vlo[8],vhi[8]; u32x4 pw0,pw1,pw2,pw3; const f32x16 zf={};
  #define PKW(P,B) cvtpk_s(P[B],P[B+1])
  #define PAF(k) __builtin_bit_cast(bf16x8,pw##k)
  #define VFR(i) (bf16x8){vlo[i][0],vlo[i][1],vlo[i][2],vlo[i][3],vhi[i][0],vhi[i][1],vhi[i][2],vhi[i][3]}
  #define PIN(x) asm volatile("":"+v"(x))
  #define MX3(a,b,c) __builtin_fmaxf(__builtin_fmaxf((a),(b)),(c))
  #define GAPA(MF,A0,A1,A2,A3,W0,W1,PW) do{ MF; sacc+=A0; sacc+=A1; sacc+=A2; sacc+=A3; PIN(sacc); W0; W1; PIN(PW); SBAR(); }while(0)
  #define EX(v) __builtin_amdgcn_exp2f(v)
  #define GAPB(MF,X,B) do{ MF; X[B]=EX(X[B]); X[B+1]=EX(X[B+1]); X[B+2]=EX(X[B+2]); X[B+3]=EX(X[B+3]); PIN(X); SBAR(); }while(0)
  #define VRD(i) do{ vlo[i]=vtr(vp_+(((i)>>2)*4096+((i)&3)*1024)); vhi[i]=vtr(vp_+(((i)>>2)*4096+((i)&3)*1024+512)); }while(0)
  #define KRD(G,j) do{ if(G){ kload2(kf,kp0+sl_next,j); SBAR(); } }while(0)
  #define KRDX(G) do{ if(G){ kf[8]=*(const __attribute__((address_space(3))) bf16x8*)(kx0+sl_next); kf[9]=*(const __attribute__((address_space(3))) bf16x8*)(kx0+sl_next+512); SBAR(); } }while(0)
  #define STEP(C0,C1,P0,P1,t,GK,GV,GL) do{ SBAR(); \
    const lds_cptr vp_=vp0+sl_prev; \
    VRD(0); SBAR(); float sacc=(P0[0]+P0[1]); \
    GAPA(C0=__builtin_amdgcn_mfma_f32_32x32x16_bf16(kf[0],qr[0],zf,0,0,0), P0[2],P0[3],P0[4],P0[5],     pw0[0]=PKW(P0,0), pw0[1]=PKW(P0,2), pw0); \
    VRD(4); SBAR(); GAPA(C1=__builtin_amdgcn_mfma_f32_32x32x16_bf16(kf[1],qr[0],zf,0,0,0), P0[6],P0[7],P0[8],P0[9],     pw0[2]=PKW(P0,4), pw0[3]=PKW(P0,6), pw0); \
    VRD(1); SBAR(); GAPA(C0=__builtin_amdgcn_mfma_f32_32x32x16_bf16(kf[2],qr[1],C0,0,0,0),   P0[10],P0[11],P0[12],P0[13], pw1[0]=PKW(P0,8), pw1[1]=PKW(P0,10), pw1); \
    VRD(5); SBAR(); GAPA(C1=__builtin_amdgcn_mfma_f32_32x32x16_bf16(kf[3],qr[1],C1,0,0,0),   P0[14],P0[15],P1[0],P1[1],   pw1[2]=PKW(P0,12),pw1[3]=PKW(P0,14), pw1); \
    VRD(2); SBAR(); GAPA(C0=__builtin_amdgcn_mfma_f32_32x32x16_bf16(kf[4],qr[2],C0,0,0,0),   P1[2],P1[3],P1[4],P1[5],     pw2[0]=PKW(P1,0), pw2[1]=PKW(P1,2), pw2); \
    VRD(6); SBAR(); GAPA(C1=__builtin_amdgcn_mfma_f32_32x32x16_bf16(kf[5],qr[2],C1,0,0,0),   P1[6],P1[7],P1[8],P1[9],     pw2[2]=PKW(P1,4), pw2[3]=PKW(P1,6), pw2); \
    VRD(3); SBAR(); GAPA(C0=__builtin_amdgcn_mfma_f32_32x32x16_bf16(kf[6],qr[3],C0,0,0,0),   P1[10],P1[11],P1[12],P1[13], pw3[0]=PKW(P1,8), pw3[1]=PKW(P1,10), pw3); \
    VRD(7); SBAR(); GAPA(C1=__builtin_amdgcn_mfma_f32_32x32x16_bf16(kf[7],qr[3],C1,0,0,0),   P1[14],P1[15],0.f,0.f,       pw3[2]=PKW(P1,12),pw3[3]=PKW(P1,14), pw3); \
    C0=__builtin_amdgcn_mfma_f32_32x32x16_bf16(kf[8],qr[4],C0,0,0,0); SBAR(); \
    C1=__builtin_amdgcn_mfma_f32_32x32x16_bf16(kf[9],qr[4],C1,0,0,0); SBAR(); \
    l_reg+=sacc; \
    if(GK){DMA_K((t)+3,sl_cur);} if(GV){DMA_V((t)+1,sl_next);} \
    CMASK(C0,C1,t); \
    { float a=MX3(C0[0],C0[1],C1[0]),b=MX3(C0[2],C0[3],C1[1]); a=MX3(a,C1[2],C1[3]); \
      _Pragma("unroll") for(int r=4;r<16;r+=4){a=MX3(a,C0[r],C0[r+1]);b=MX3(b,C0[r+2],C0[r+3]);a=MX3(a,C1[r],C1[r+1]);b=MX3(b,C1[r+2],C1[r+3]);} \
      float rm=__builtin_fmaxf(a,b); { auto rr=__builtin_amdgcn_permlane32_swap(__float_as_uint(rm),__float_as_uint(rm),false,false); rm=__builtin_fmaxf(__uint_as_float(rr[0]),__uint_as_float(rr[1])); } \
      resc=false; \
      if(__builtin_expect(__any(rm>(float)THRL),0)){ MOVEREF(__builtin_fmaxf(rm,0.f)) \
        _Pragma("unroll") for(int r=0;r<16;++r){C0[r]-=dl;C1[r]-=dl;} \
        const float f=__builtin_amdgcn_exp2f(-dl); l_reg*=f; if(hi==0)wsf[r32]=f; resc=true; } } \
    SBAR(); \
    GAPB(o[0]=__builtin_amdgcn_mfma_f32_32x32x16_bf16(PAF(0),VFR(0),o[0],0,0,0), C0,0); \
    GAPB(o[1]=__builtin_amdgcn_mfma_f32_32x32x16_bf16(PAF(0),VFR(4),o[1],0,0,0), C0,4); \
    KRD(GL,0); GAPB(o[0]=__builtin_amdgcn_mfma_f32_32x32x16_bf16(PAF(1),VFR(1),o[0],0,0,0), C0,8); \
    KRD(GL,1); GAPB(o[1]=__builtin_amdgcn_mfma_f32_32x32x16_bf16(PAF(1),VFR(5),o[1],0,0,0), C0,12); \
    KRD(GL,2); GAPB(o[0]=__builtin_amdgcn_mfma_f32_32x32x16_bf16(PAF(2),VFR(2),o[0],0,0,0), C1,0); \
    KRD(GL,3); GAPB(o[1]=__builtin_amdgcn_mfma_f32_32x32x16_bf16(PAF(2),VFR(6),o[1],0,0,0), C1,4); \
    KRDX(GL); GAPB(o[0]=__builtin_amdgcn_mfma_f32_32x32x16_bf16(PAF(3),VFR(3),o[0],0,0,0), C1,8); \
    GAPB(o[1]=__builtin_amdgcn_mfma_f32_32x32x16_bf16(PAF(3),VFR(7),o[1],0,0,0), C1,12); \
    }while(0)
  int t=1;
  for(;t+5<NT&&t+1<band0;t+=2){
    #undef CMASK
    #define CMASK(P0,P1,t) do{}while(0)
    STEP(pB0,pB1,pA0,pA1,t,true,true,true);     WAIT_BAR(3); RESC(); ROT();
    STEP(pA0,pA1,pB0,pB1,t+1,true,true,true);   WAIT_BAR(3); RESC(); ROT();
  }
  #undef CMASK
  #define CMASK(P0,P1,t) do{int jb_=(t)-band0; if(jb_>=0)cmask(P0,P1,jb_,qrel,hi);}while(0)
  #define ENDW(tt) do{ if((tt)+3<NT){WAIT_BAR(3);} else if((tt)+2<NT){WAIT_BAR(1);} else {WAIT_BAR(0);} }while(0)
  for(;t+1<NT;t+=2){
    STEP(pB0,pB1,pA0,pA1,t,(t+3<NT),(t+1<NT),(t+1<NT));       ENDW(t);   RESC(); ROT();
    STEP(pA0,pA1,pB0,pB1,t+1,(t+4<NT),(t+2<NT),(t+2<NT));     ENDW(t+1); RESC(); ROT();
  }
  STEP(pB0,pB1,pA0,pA1,NT-1,false,false,false); RESC();
  { float sacc=pB0[0]+pB0[1]; _Pragma("unroll") for(int r=2;r<16;++r)sacc+=pB0[r]; _Pragma("unroll") for(int r=0;r<16;++r)sacc+=pB1[r]; l_reg+=sacc;
    pw0=(u32x4){PKW(pB0,0),PKW(pB0,2),PKW(pB0,4),PKW(pB0,6)};pw1=(u32x4){PKW(pB0,8),PKW(pB0,10),PKW(pB0,12),PKW(pB0,14)};pw2=(u32x4){PKW(pB1,0),PKW(pB1,2),PKW(pB1,4),PKW(pB1,6)};pw3=(u32x4){PKW(pB1,8),PKW(pB1,10),PKW(pB1,12),PKW(pB1,14)};
    SBAR(); pv(o,vb0+sl_cur,PAF(0),PAF(1),PAF(2),PAF(3)); }
  #undef PKW
  #undef PAF
  #undef VFR
  #undef PIN
  #undef MX3
  #undef GAPA
  #undef GAPB
  #undef EX
  #undef VRD
  #undef KRD
  #undef KRDX
  #undef STEP
  #undef ENDW
  {auto rr=__builtin_amdgcn_permlane32_swap(__float_as_uint(l_reg),__float_as_uint(l_reg),false,false);l_reg=__uint_as_float(rr[0])+__uint_as_float(rr[1]);}
  if(hi==0)wsf[32+r32]=l_reg;asm volatile("s_waitcnt lgkmcnt(0)":::"memory");
  float rli[16];
  #pragma unroll
  for(int r=0;r<16;++r)rli[r]=__builtin_amdgcn_rcpf(wsf[32+crow(r,hi)]);
  if(KIND==1){ if(hi==0&&oslot>=0){ f32x2_t ml={mhat,l_reg}; *(f32x2_t*)(PML+(long)oslot*2)=ml; } }
  { hb16*stg=(hb16*)(shm+LDS_OST)+wid*2048;
    #pragma unroll
    for(int r=0;r<16;++r){const int orow=crow(r,hi);
      #pragma unroll
      for(int d0=0;d0<2;++d0)stg[orow*64+d0*32+r32]=__float2bfloat16(o[d0][r]*rli[r]);}
    asm volatile("s_waitcnt lgkmcnt(0)":::"memory");
    #pragma unroll
    for(int i=0;i<4;++i){const int row=i*8+(lane>>3),ch=lane&7; const u32x4 v=*(const u32x4*)(stg+row*64+ch*8);
      if(KIND==0){ const int gr=__shfl(qrow,row); *(u32x4*)(Oc+(long)gr*PITCH+ch*8)=v; }
      else { const int gs=__shfl(oslot,row); if(gs>=0) *(u32x4*)(PO+(long)gs*64+ch*8)=v; } } }
  asm volatile("s_waitcnt lgkmcnt(0)\n\ts_barrier":::"memory");
  #undef DMA_K
  #undef DMA_V
  #undef CMASK
  #undef START
  #undef RESC
  #undef ROT
  #undef SETQX
  #undef MOVEREF
}
constexpr int ATTN_LDS_BYTES=LDS_BYTES;
#undef SBAR
#undef WAIT_BAR
}

struct WqkOrder {
    int G, c;
    __device__ __forceinline__ bool next(int i, pg8::Unit& u) const { const int L = i * G + c; if (L >= 128) return false; const int z = L >> 2, pn = L & 3, b = z >> 2, h = z & 3;
        u.pm = b * 4 + h; u.pn = pn; u.aoff = ((size_t)(b * 256) * 2048 + h * 256) * 2; u.boff = ((size_t)(pn * 256) * 1024 + h * 256) * 2; return true; }
};
struct VwoOrder {
    int G, c;
    __device__ __forceinline__ bool next(int i, pg8::Unit& u) const { const int L = i * G + c; if (L >= 128) return false; const int z = L >> 2, pmq = L & 3, b = z >> 2, h = z & 3;
        u.pm = b * 4 + pmq; u.pn = h; u.aoff = ((size_t)(pmq * 256) * 1024 + h * 256) * 2; u.boff = ((size_t)(b * 256) * 2048 + 1024 + h * 256) * 2; return true; }
};

#define DECL_PTRS const __attribute__((address_space(4))) Args* KA_; { auto p_ = __builtin_amdgcn_kernarg_segment_ptr(); asm volatile("" : "+s"(p_)); KA_ = (const __attribute__((address_space(4))) Args*)p_; } \
    int tidp_ = threadIdx.x; asm volatile("" : "+v"(tidp_)); const int tid = tidp_, lane = tid & 63; (void)lane; \
    unsigned char* ws = KA_->ws; gu32* ctl = (gu32*)(ws + WS_CTL); const float* x = KA_->in[0]; const float* mem = KA_->in[1]; const float* g_mix = KA_->in[2]; const float* w_in = KA_->in[3]; const float* b_forget = KA_->in[4]; const float* g_fox = KA_->in[5]; const float* g_moba = KA_->in[6]; const float* w_out = KA_->in[7]; const float* g_cross = KA_->in[8]; const float* g_mem = KA_->in[9]; const float* w_q_mem = KA_->in[10]; const float* w_kv_mem = KA_->in[11]; const float* w_o_mem = KA_->in[12]; const float* g_ffn = KA_->in[13]; const float* w_up = KA_->in[14]; const float* conv_w = KA_->in[15]; const float* conv_b = KA_->in[16]; const float* w_down = KA_->in[17]; const float* g_final = KA_->in[18]; float* out = KA_->out; float* LOGF = (float*)(ws + WS_LOGF); float* CC = (float*)(ws + WS_C); float* ABAR = (float*)(ws + WS_ABAR); float* KM = (float*)(ws + WS_KM); unsigned* SEL = (unsigned*)(ws + WS_SEL); float* SSQ1 = (float*)(ws + WS_SSQ1); float* SSQ2 = (float*)(ws + WS_SSQ2); float* SSQ3 = (float*)(ws + WS_SSQ3); bf16* MEMN = (bf16*)(ws + WS_MEMN); bf16* KV = (bf16*)(ws + WS_KV); bf16* WQS = (bf16*)(ws + WS_WQS); bf16* WOT = (bf16*)(ws + WS_WOT); bf16* WKVT = (bf16*)(ws + WS_WKVT); bf16* WINT = (bf16*)(ws + WS_WINT); bf16* WOUTT = (bf16*)(ws + WS_WOUTT); bf16* WUPT = (bf16*)(ws + WS_WUPT); unsigned char* WDT = ws + WS_WDT; unsigned char* ACT8 = ws + WS_ACT8; bf16* ZT = (bf16*)(ws + WS_ZT); bf16* WQK = (bf16*)(ws + WS_WQK); bf16* VWO = (bf16*)(ws + WS_VWO); bf16* A1 = (bf16*)(ws + WS_A1); bf16* QKV = (bf16*)(ws + WS_QKV); bf16* Y = (bf16*)(ws + WS_Y); bf16* HB1 = (bf16*)(ws + WS_HB1); bf16* PB = (bf16*)(ws + WS_P); bf16* HB2 = (bf16*)(ws + WS_HB2); bf16* GB = (bf16*)(ws + WS_G); bf16* UB = (bf16*)(ws + WS_U); bf16* PO = (bf16*)(ws + WS_PO); unsigned* LIST = (unsigned*)(ws + WS_LIST); float* PML = (float*)(ws + WS_PML); bf16* KXF = (bf16*)(ws + WS_KXF); bf16* KXM = (bf16*)(ws + WS_KXM); unsigned* CNT = (unsigned*)(ws + WS_CNT);
__global__ void __launch_bounds__(NWAVES * 64, 2) fwd(Args args) {
    extern __shared__ __attribute__((aligned(16))) unsigned char lds[];
    LAS unsigned char* L = (LAS unsigned char*)lds;
    LAS unsigned char* XL = L + XL_OFF;
    volatile LAS unsigned* MISC = (volatile LAS unsigned*)(L + MISC_OFF);
    const int tid = threadIdx.x, lane = tid & 63, wave = __builtin_amdgcn_readfirstlane(tid >> 6);
    const int G = gridDim.x, bx = blockIdx.x;
    const int gw = bx * NWAVES + wave, NGW = G * NWAVES;
    for (int u = tid; u < (LDS_BYTES - LDSCTL_OFF) / 4; u += NWAVES * 64) ((LAS unsigned*)(L + LDSCTL_OFF))[u] = 0u;
    __syncthreads();
    XcdBarrier bar; { DECL_PTRS; bar = xcd_barrier_post((unsigned*)(ctl + CW_BAR), MISC + 8); }

    { DECL_PTRS;
        LAS float* scr = (LAS float*)(L + RING_OFF + wave * 16384);
        constexpr int I_IN = (D / 64) * (NQKV / 32), I_OUT = (D / 64) * (D / 32), I_KV = (D / 64) * (2048 / 32), I_O = I_OUT, I_UP = (D / 64) * (2 * FF / 32), I_DN = (FF / 64) * (D / 32);
        constexpr int NITEMS = I_IN + I_OUT + I_KV + I_O + I_UP + I_DN;
        for (int it = gw; it < NITEMS; it += NGW) {
            int r = it;
            if (r < I_IN) { p0_transpose_item(w_in, INC, D, NQKV, WINT, nullptr, true, scr, r, lane); continue; } r -= I_IN;
            if (r < I_OUT) { p0_transpose_item(w_out, D, D, D, WOUTT, nullptr, false, scr, r, lane); continue; } r -= I_OUT;
            if (r < I_KV) { p0_transpose_item(w_kv_mem, 2048, D, 2048, WKVT, nullptr, false, scr, r, lane); continue; } r -= I_KV;
            if (r < I_O) { p0_transpose_item(w_o_mem, D, D, D, WOT, nullptr, false, scr, r, lane); continue; } r -= I_O;
            if (r < I_UP) { p0_transpose_item(w_up, 2 * FF, D, 2 * FF, WUPT, g_ffn, false, scr, r, lane); continue; } r -= I_UP;
            p0_transpose_item(w_down, D, FF, D, (bf16*)WDT, nullptr, false, scr, r, lane, 64.0f);
        }
        for (int i = bx * 512 + tid; i < D * D / 4; i += G * 512) { const int kk = (i * 4) >> 10; const f32x4 v = *(const f32x4*)(w_q_mem + (size_t)i * 4) * (g_cross[kk] * (LOG2E / 16.0f));
            *(unsigned long long*)(WQS + (size_t)i * 4) = (unsigned long long)pk2(v[0], v[1]) | ((unsigned long long)pk2(v[2], v[3]) << 32); }
        for (int r = gw; r < NB * 256; r += NGW) { const GAS f32x4* xr = (const GAS f32x4*)(mem + (size_t)r * D) + lane; f32x4 v[4]; float s = 0.f;
#pragma unroll
            for (int j = 0; j < 4; ++j) { v[j] = xr[64 * j]; s += (v[j][0] * v[j][0] + v[j][1] * v[j][1]) + (v[j][2] * v[j][2] + v[j][3] * v[j][3]); }
            const float rs = __builtin_amdgcn_rsqf(wave_sum(s) * (1.f / D) + RMS_EPS);
            GAS unsigned long long* o8 = (GAS unsigned long long*)(MEMN + (size_t)r * D) + lane;
#pragma unroll
            for (int j = 0; j < 4; ++j) { const f32x4 gg = *((const f32x4*)g_mem + 64 * j + lane); const f32x4 a = v[j] * rs * gg; o8[64 * j] = (unsigned long long)pk2(a[0], a[1]) | ((unsigned long long)pk2(a[2], a[3]) << 32); } }
        __syncthreads();
        LAS float* wf = (LAS float*)(L + RING_OFF);
        LAS float* part = (LAS float*)(L + RING_OFF + 32768);
        for (int i = tid; i < 8 * 1024; i += 512) { const int h = i >> 10, kk = i & 1023; wf[i] = w_in[(size_t)kk * INC + C_F + h]; }
        __syncthreads();
        f32x4 gm[4];
#pragma unroll
        for (int j = 0; j < 4; ++j) gm[j] = *((const f32x4*)g_mix + 64 * j + lane);
        for (int blk = bx; blk < M / 256; blk += G) {
            f32x4 accm[4];
#pragma unroll
            for (int j = 0; j < 4; ++j) accm[j] = (f32x4){0.f, 0.f, 0.f, 0.f};
            for (int i0 = 0; i0 < 32; i0 += 2) {
              f32x4 vv[2][4];
#pragma unroll
              for (int rr = 0; rr < 2; ++rr) { const GAS f32x4* xr = (const GAS f32x4*)(x + ((size_t)blk * 256 + wave * 32 + i0 + rr) * D) + lane;
#pragma unroll
                  for (int j = 0; j < 4; ++j) vv[rr][j] = xr[64 * j]; }
#pragma unroll
              for (int rr = 0; rr < 2; ++rr) {
                const size_t r = (size_t)blk * 256 + wave * 32 + i0 + rr;
                f32x4 v[4]; float s = 0.f;
#pragma unroll
                for (int j = 0; j < 4; ++j) { v[j] = vv[rr][j]; s += (v[j][0] * v[j][0] + v[j][1] * v[j][1]) + (v[j][2] * v[j][2] + v[j][3] * v[j][3]); }
                const float rs = __builtin_amdgcn_rsqf(wave_sum(s) * (1.f / D) + RMS_EPS);
                GAS unsigned long long* o8 = (GAS unsigned long long*)(A1 + r * 2048) + lane;
                float fl[8];
#pragma unroll
                for (int h = 0; h < 8; ++h) fl[h] = 0.f;
#pragma unroll
                for (int j = 0; j < 4; ++j) { const f32x4 a = v[j] * rs * gm[j]; accm[j] += a;
                    const unsigned h0 = pk2(a[0], a[1]), h1 = pk2(a[2], a[3]);
                    o8[64 * j] = (unsigned long long)h0 | ((unsigned long long)h1 << 32);
                    const unsigned l0 = pk2(a[0] - bflo(h0), a[1] - bfhi(h0)), l1 = pk2(a[2] - bflo(h1), a[3] - bfhi(h1));
                    o8[256 + 64 * j] = (unsigned long long)l0 | ((unsigned long long)l1 << 32);
#pragma unroll
                    for (int h = 0; h < 8; ++h) { const f32x4 w = *((const LAS f32x4*)(wf + h * 1024) + 64 * j + lane); fl[h] += (a[0] * w[0] + a[1] * w[1]) + (a[2] * w[2] + a[3] * w[3]); } }
#pragma unroll
                for (int h = 0; h < 8; ++h) fl[h] = wave_sum(fl[h]);
                if (lane < 8) { float z = fl[0];
#pragma unroll
                    for (int h = 1; h < 8; ++h) z = (lane == h) ? fl[h] : z;
                    z += b_forget[lane];
                    LOGF[r * 8 + lane] = fminf(z, 0.f) - log1pf(__expf(-fabsf(z))); }
              }
            }
#pragma unroll
            for (int j = 0; j < 4; ++j) *((LAS f32x4*)(part + wave * 1024) + 64 * j + lane) = accm[j];
            __syncthreads();
            for (int col = tid; col < 1024; col += 512) { float s = 0.f;
#pragma unroll
                for (int w = 0; w < 8; ++w) s += part[w * 1024 + col];
                ABAR[(size_t)blk * 1024 + col] = s * (1.0f / 256.0f); }
            __syncthreads();
        }
    }
    xcd_barrier(bar);

    { DECL_PTRS;
        LAS float* sc = (LAS float*)(L + RING_OFF);
        for (int w = bx; w < 64; w += G) {
            const int b = w >> 3, h = w & 7; float v[16]; float run = 0.f;
#pragma unroll
            for (int i = 0; i < 16; ++i) { run += LOGF[((size_t)b * T + tid * 16 + i) * 8 + h]; v[i] = run; }
            float incl = run;
#pragma unroll
            for (int o = 1; o < 64; o <<= 1) { const float n = __shfl_up(incl, o); if (lane >= o) incl += n; }
            if (lane == 63) sc[wave] = incl;
            __syncthreads();
            float pre = incl - run;
            for (int ww = 0; ww < wave; ++ww) pre += sc[ww];
#pragma unroll
            for (int i = 0; i < 16; ++i) CC[(size_t)w * T + tid * 16 + i] = pre + v[i];
            __syncthreads();
        }
        for (int n = bx; n < 256; n += G) {
            for (int i = tid; i < 1024; i += 512) sc[i] = ABAR[(size_t)n * 1024 + i];
            __syncthreads();
            float s = 0.f;
            for (int kk = 0; kk < 1024; ++kk) s += sc[kk] * w_in[(size_t)kk * INC + C_KM + tid];
            KM[(size_t)n * 512 + tid] = s;
            __syncthreads();
        }
        pg8::Gemm g{MEMN, WKVT, D / 64, D * 2, D * 2, 0xffffffffu}; pg8::TileOrder S; S.init(NB * 256, 2048, G, bx, D * 2, D * 2, 0, 1 << 30);
        pg8::EpiBf16 E{KV, 2048, 0u, 1.f, nullptr};
        pg8::gemm_phase<pg8::EpiBf16, pg8::TileOrder, true>(L + RING_OFF, XL, g, S, E);
    }
    xcd_barrier(bar);

    { DECL_PTRS;
        LAS float* sc = (LAS float*)(L + RING_OFF);
        for (int n = bx; n < 256; n += G) {
            const int b = n >> 5, nb = n & 31;
            sc[tid] = KM[(size_t)n * 512 + tid];
            __syncthreads();
            f32x4 k0 = *(const LAS f32x4*)(sc + lane * 8), k1 = *(const LAS f32x4*)(sc + lane * 8 + 4);
            for (int i = 0; i < 128; ++i) { const int kk = wave * 128 + i;
                const f32x4 w0 = *(const f32x4*)(w_in + (size_t)kk * INC + C_QM + lane * 8), w1 = *(const f32x4*)(w_in + (size_t)kk * INC + C_QM + lane * 8 + 4);
                float s = (w0[0] * k0[0] + w0[1] * k0[1]) + (w0[2] * k0[2] + w0[3] * k0[3]) + (w1[0] * k1[0] + w1[1] * k1[1]) + (w1[2] * k1[2] + w1[3] * k1[3]);
                s += __shfl_xor(s, 1); s += __shfl_xor(s, 2); s += __shfl_xor(s, 4);
                if ((lane & 7) == 0) { const int h = lane >> 3; const unsigned hi = f2bf(s); const unsigned lo = f2bf(s - bf2f(hi));
                    bf16* zr = ZT + ((size_t)b * 256 + h * 32 + nb) * 3072; zr[kk] = (bf16)hi; zr[1024 + kk] = (bf16)hi; zr[2048 + kk] = (bf16)lo; } }
            __syncthreads();
        }
        for (int i = bx * 512 + tid; i < 64 * T + 8 * 256; i += G * 512) {
            float bv; bf16* dst;
            if (i < 64 * T) { bv = -CC[i] * LOG2E; dst = KXF + (size_t)i * 8; }
            else { const int j = i - 64 * T; bv = __builtin_amdgcn_exp2f(-(float)((j >> 8) + 1)) * LOG2E * (float)(j & 255); dst = KXM + (size_t)j * 8; }
            const unsigned h0 = f2bf(bv); const float r1 = bv - bf2f(h0); const unsigned h1 = f2bf(r1); const unsigned h2 = f2bf(r1 - bf2f(h1));
            *(v4u*)dst = (v4u){h0 | (h1 << 16), h2 | (0x3F80u << 16), 0x3F80u, 0u}; }
        { pg8::Gemm g{KV, WQS, 4, 4096, 2048, 0xffffffffu}; WqkOrder S{G, bx}; pg8::EpiF8 E{(unsigned char*)WQK, 1024, 32.0f};
          pg8::gemm_phase<pg8::EpiF8, WqkOrder, true>(L + RING_OFF, XL, g, S, E); }
        { pg8::Gemm g{WOT, KV, 4, 2048, 4096, 0xffffffffu}; VwoOrder S{G, (bx + 128) % G}; pg8::EpiF8 E{(unsigned char*)VWO, 1024, 4.0f};
          pg8::gemm_phase<pg8::EpiF8, VwoOrder, true>(L + RING_OFF, XL, g, S, E); }
    }
    xcd_barrier(bar);

    { DECL_PTRS;
        { pg8::Gemm g{A1, WINT, D / 64, 4096, D * 2, 0xffffffffu}; pg8::TileOrder S; S.init(M, NQKV, G, bx, 4096, D * 2, 0, 1 << 30);
          pg8::EpiBf16 E{QKV, NQKV, 0xC3u, C2, (unsigned*)(ctl + CW_QKN)};
          pg8::gemm_phase<pg8::EpiBf16, pg8::TileOrder, true>(L + RING_OFF, XL, g, S, E); }
        { pg8::Gemm g{A1, ZT, 3072 / 64, 4096, 6144, 4095u}; pg8::TileOrder S; S.init(M, 256, G, bx, 4096, 6144, (size_t)256 * 6144, 32);
          pg8::EpiGate E{SEL};
          pg8::gemm_phase<pg8::EpiGate, pg8::TileOrder, true>(L + RING_OFF, XL, g, S, E); }
    }
    xcd_barrier(bar);

    { DECL_PTRS;
        for (int e = bx * 512 + tid; e < 2048; e += G * 512) { const int bh = e >> 5, qb = e & 31;
            const float thr = skip_thr((const unsigned*)(ctl + CW_QKN) + bh * 8, 0) * (1.0f / LOG2E);
            const float* crow_ = CC + (size_t)bh * T; const int t0 = qb * 256; const float target = crow_[t0] + thr;
            int lo = 0, hi2 = t0;
            while (lo < hi2) { const int mid = (lo + hi2) >> 1; if (crow_[mid] >= target) lo = mid + 1; else hi2 = mid; }
            ((int*)(ctl + CW_T0TAB))[e] = (lo >> 6) & ~1; }
        LAS unsigned* wc = (LAS unsigned*)(L + RING_OFF);
        for (int w = bx; w < 2048; w += G) {
            const int bh = (w & 255) >> 2, n = (w & 3) + 4 * (w >> 8), trip = bh * 32 + n; const unsigned* selrow = SEL + (size_t)bh * T; unsigned base = 0u;
            const float mthr = skip_thr((const unsigned*)(ctl + CW_QKN) + bh * 8, 1); const int hh = bh & 7;
            for (int t0 = (n + 1) * 256; t0 < T; t0 += 2048) {
                unsigned m[4], mo[4]; unsigned long long bal[4];
#pragma unroll
                for (int j = 0; j < 4; ++j) { const int t = t0 + j * 512 + tid; m[j] = 0u; if (t < T) m[j] = selrow[t]; mo[j] = m[j]; if (moba_skip(hh, t >> 8, n, mthr)) m[j] &= ~(1u << n); }
#pragma unroll
                for (int j = 0; j < 4; ++j) { bal[j] = __ballot((m[j] >> n) & 1u); if (lane == 0) wc[j * 8 + wave] = (unsigned)__popcll(bal[j]); }
                __syncthreads();
                unsigned run = base;
#pragma unroll
                for (int j = 0; j < 4; ++j) { unsigned pre = 0u, tot = 0u;
#pragma unroll
                    for (int ww = 0; ww < 8; ++ww) { const unsigned c = wc[j * 8 + ww]; tot += c; if (ww < wave) pre += c; }
                    if ((m[j] >> n) & 1u) { const unsigned pos = run + pre + (unsigned)__popcll(bal[j] & ((1ull << lane) - 1ull)); const unsigned k = (unsigned)__popc(mo[j] & ((1u << n) - 1u));
                        LIST[(size_t)trip * 8192 + pos] = (unsigned)(t0 + j * 512 + tid) | (k << 16); }
                    run += tot; }
                base = run;
                __syncthreads();
            }
            if (tid == 0) CNT[trip] = base;
        }
    }
    xcd_barrier(bar);

    { DECL_PTRS;
        LAS int* upre = (LAS int*)(L + RING_OFF + attn_body::ATTN_LDS_BYTES);
        LAS int* wsum = upre + 2052;
        { int c4[4]; int run = 0;
#pragma unroll
          for (int i = 0; i < 4; ++i) { c4[i] = run; run += (int)((CNT[tid * 4 + i] + 255u) >> 8); }
          int incl = run;
#pragma unroll
          for (int o = 1; o < 64; o <<= 1) { const int nn = __shfl_up(incl, o); if (lane >= o) incl += nn; }
          if (lane == 63) wsum[wave] = incl;
          __syncthreads();
          int pre = incl - run;
          for (int ww = 0; ww < wave; ++ww) pre += wsum[ww];
#pragma unroll
          for (int i = 0; i < 4; ++i) upre[tid * 4 + i] = pre + c4[i];
          if (tid == 511) upre[2048] = pre + run;
          __syncthreads(); }
        const int ntot = 4096 + upre[2048];
        const attn_body::hb16* Qb = (const attn_body::hb16*)QKV;
        const int r32 = lane & 31;
        LAS unsigned* qnext = (LAS unsigned*)(wsum + 16);
        unsigned* qhead = (unsigned*)(ctl + CW_QUEUE);
        if (tid == 0) qnext[0] = atomicAdd(qhead, 1u);
        __syncthreads();
        for (;;) {
            const int u = (int)qnext[0];
            if (u >= ntot) break;
            __syncthreads();
            unsigned nxt_ = 0u; if (tid == 0) nxt_ = atomicAdd(qhead, 1u);
            int kind, qrow, oslot = -1, NT, band0; const attn_body::hb16 *Qc, *Kt0, *Vt0, *KXt0;
            if (u < 2048) {
                const int qb = 31 - (u >> 6), bh = u & 63;
                const int b = bh >> 3, h = bh & 7;
                const int T0 = ((const int*)(ctl + CW_T0TAB))[bh * 32 + qb];
                kind = 0; qrow = b * T + qb * 256 + wave * 32 + r32; NT = 4 * (qb + 1) - T0; band0 = NT - 4;
                Qc = Qb + h * 64; Kt0 = Qb + (size_t)(b * T + T0 * 64) * NQKV + 512 + h * 64; Vt0 = Kt0 + 512; KXt0 = (const attn_body::hb16*)KXF + ((size_t)bh * T + T0 * 64) * 8;
            } else if (u < 4096) {
                const int w = u - 2048, bh = w >> 5, j = w & 31, b = bh >> 3, h = bh & 7;
                kind = 1; qrow = b * T + j * 256 + wave * 32 + r32; oslot = (qrow * 8 + h) * 4 + 3; NT = 4; band0 = 0;
                Qc = Qb + 1536 + h * 64; Kt0 = Qb + (size_t)(b * T + j * 256) * NQKV + 2048 + h * 64; Vt0 = Kt0 + 512; KXt0 = (const attn_body::hb16*)KXM + h * 256 * 8;
            } else {
                const int g = u - 4096; int lo = 0, hi2 = 2048;
                while (hi2 - lo > 1) { const int mid = (lo + hi2) >> 1; if (upre[mid] <= g) lo = mid; else hi2 = mid; }
                const int w = lo, c = g - upre[lo], bh = w >> 5, n = w & 31, b = bh >> 3, h = bh & 7; const int cnt = (int)CNT[w];
                int idx = c * 256 + wave * 32 + r32; const bool valid = idx < cnt; if (!valid) idx = cnt - 1;
                const unsigned e = LIST[(size_t)w * 8192 + idx];
                kind = 1; qrow = b * T + (int)(e & 0xffffu); oslot = valid ? (qrow * 8 + h) * 4 + (int)(e >> 16) : -1; NT = 4; band0 = 1 << 20;
                Qc = Qb + 1536 + h * 64; Kt0 = Qb + (size_t)(b * T + n * 256) * NQKV + 2048 + h * 64; Vt0 = Kt0 + 512; KXt0 = (const attn_body::hb16*)KXM + h * 256 * 8;
            }
            attn_body::attn_unit<8>((char*)lds + RING_OFF, kind, Qc, qrow, oslot, Kt0, Vt0, KXt0, NT, band0, (attn_body::hb16*)QKV + (Qc - Qb), (attn_body::hb16*)PO, PML);
            if (tid == 0) qnext[0] = nxt_;
            __syncthreads();
        }
    }
    xcd_barrier(bar);

    { DECL_PTRS;
    const f32x4 ga0 = *((const f32x4*)g_fox + 2 * lane), ga1 = *((const f32x4*)g_fox + 2 * lane + 1), gb0 = *((const f32x4*)g_moba + 2 * lane), gb1 = *((const f32x4*)g_moba + 2 * lane + 1);
    const int h = lane >> 3, cc = lane & 7; const float s2 = __builtin_amdgcn_exp2f(-(float)(h + 1)) * LOG2E * 256.0f;
    float mthr[NB];
#pragma unroll
    for (int b = 0; b < NB; ++b) mthr[b] = skip_thr((const unsigned*)(ctl + CW_QKN) + (b * 8 + h) * 8, 1);
    for (int r0 = gw * 2; r0 < M; r0 += NGW * 2) {
        v4u wa[2], pw[2][4]; unsigned mmv[2]; pg8::f32x2 ml[2][4];
#pragma unroll
        for (int rr = 0; rr < 2; ++rr) { const int r = r0 + rr, b = r >> 13, t = r & (T - 1); const size_t sb = ((size_t)r * 8 + h) * 4;
            wa[rr] = *((const v4u*)(QKV + (size_t)r * NQKV) + lane); mmv[rr] = SEL[((size_t)(b * 8 + h)) * T + t];
#pragma unroll
            for (int k = 0; k < 4; ++k) { ml[rr][k] = *(const pg8::f32x2*)(PML + (sb + k) * 2); pw[rr][k] = *((const v4u*)(PO + (sb + k) * 64) + cc); } }
#pragma unroll
        for (int rr = 0; rr < 2; ++rr) { const int r = r0 + rr, t = r & (T - 1), own = t >> 8;
            const float a[8] = {bflo(wa[rr].x), bfhi(wa[rr].x), bflo(wa[rr].y), bfhi(wa[rr].y), bflo(wa[rr].z), bfhi(wa[rr].z), bflo(wa[rr].w), bfhi(wa[rr].w)};
            float c[8]; unsigned mm = mmv[rr]; const int cnt = __popc(mm);
            float mk[4], lk[4];
#pragma unroll
            for (int k = 0; k < 4; ++k) { mk[k] = ml[rr][k].x; lk[k] = ml[rr][k].y; }
            mk[3] += s2 * (float)own; float Mx = mk[3];
            bool vk[4]; vk[3] = true; float thb = mthr[0];
#pragma unroll
            for (int b = 1; b < NB; ++b) thb = ((r >> 13) == b) ? mthr[b] : thb;
#pragma unroll
            for (int k = 0; k < 3; ++k) { vk[k] = false; if (k < cnt) { const int nb = __ffs(mm) - 1; mm &= mm - 1u; vk[k] = !moba_skip(h, own, nb, thb); if (vk[k]) { mk[k] += s2 * (float)nb; Mx = fmaxf(Mx, mk[k]); } } }
            float W = 0.f;
#pragma unroll
            for (int i = 0; i < 8; ++i) c[i] = 0.f;
#pragma unroll
            for (int k = 0; k < 4; ++k) { if (vk[k]) { const float w = lk[k] * __builtin_amdgcn_exp2f(mk[k] - Mx); W += w; const v4u p = pw[rr][k];
                c[0] += w * bflo(p.x); c[1] += w * bfhi(p.x); c[2] += w * bflo(p.y); c[3] += w * bfhi(p.y); c[4] += w * bflo(p.z); c[5] += w * bfhi(p.z); c[6] += w * bflo(p.w); c[7] += w * bfhi(p.w); } }
            const float iw = 1.0f / W;
#pragma unroll
            for (int i = 0; i < 8; ++i) c[i] *= iw;
            float sa = 0.f, sb2 = 0.f;
#pragma unroll
            for (int i = 0; i < 8; ++i) { sa += a[i] * a[i]; sb2 += c[i] * c[i]; }
            const float ra = __builtin_amdgcn_rsqf(wave_sum(sa) * (1.f / 512.f) + RMS_EPS), rb = __builtin_amdgcn_rsqf(wave_sum(sb2) * (1.f / 512.f) + RMS_EPS);
            v4u oa, ob;
            oa.x = pk2(a[0] * ra * ga0[0], a[1] * ra * ga0[1]); oa.y = pk2(a[2] * ra * ga0[2], a[3] * ra * ga0[3]); oa.z = pk2(a[4] * ra * ga1[0], a[5] * ra * ga1[1]); oa.w = pk2(a[6] * ra * ga1[2], a[7] * ra * ga1[3]);
            ob.x = pk2(c[0] * rb * gb0[0], c[1] * rb * gb0[1]); ob.y = pk2(c[2] * rb * gb0[2], c[3] * rb * gb0[3]); ob.z = pk2(c[4] * rb * gb1[0], c[5] * rb * gb1[1]); ob.w = pk2(c[6] * rb * gb1[2], c[7] * rb * gb1[3]);
            *((v4u*)(Y + (size_t)r * D) + lane) = oa; *((v4u*)(Y + (size_t)r * D + 512) + lane) = ob; }
    } }
    xcd_barrier(bar);

    { DECL_PTRS; pg8::Gemm g{Y, WOUTT, D / 64, D * 2, D * 2, 0xffffffffu}; pg8::TileOrder S; S.init(M, D, G, bx, D * 2, D * 2, 0, 1 << 30);
      pg8::EpiRes E{x, out, nullptr, (unsigned char*)HB1, SSQ1, 1.0f};
      pg8::gemm_phase<pg8::EpiRes, pg8::TileOrder, true>(L + RING_OFF, XL, g, S, E); }
    xcd_barrier(bar);

    { DECL_PTRS; pg8::Gemm g{HB1, WQK, D / 128, D, D, 0xffffffffu}; pg8::TileOrder S; S.init(M, D, G, bx, D, D, (size_t)D * D, 32);
      pg8::EpiSoftmax E{(unsigned char*)PB, SSQ1, 1.0f / 32.0f};
      pg8::gemm_phase<pg8::EpiSoftmax, pg8::TileOrder, true, true>(L + RING_OFF, XL, g, S, E); }
    xcd_barrier(bar);

    { DECL_PTRS; pg8::Gemm g{PB, VWO, D / 128, D, D, 0xffffffffu}; pg8::TileOrder S; S.init(M, D, G, bx, D, D, (size_t)D * D, 32);
      pg8::EpiRes E{out, out, HB2, nullptr, SSQ2, 1.0f / 1024.0f};
      pg8::gemm_phase<pg8::EpiRes, pg8::TileOrder, true, true>(L + RING_OFF, XL, g, S, E); }
    xcd_barrier(bar);

    { DECL_PTRS; pg8::Gemm g{HB2, WUPT, D / 64, D * 2, D * 2, 0xffffffffu}; pg8::TileOrder S; S.init(M, 2 * FF, G, bx, D * 2, D * 2, 0, 1 << 30);
      pg8::EpiUp E{GB, UB, SSQ2};
      pg8::gemm_phase<pg8::EpiUp, pg8::TileOrder, true>(L + RING_OFF, XL, g, S, E); }
    xcd_barrier(bar);

    { DECL_PTRS;
    for (int it = bx * 512 + tid; it < (M / 32) * (FF / 8); it += G * 512) {
        const int rc = it / (FF / 8), cg = (it - rc * (FF / 8)) * 8; const size_t r0 = (size_t)rc * 32; const int tt0 = (int)(r0 & (T - 1));
        float w0[8], w1[8], w2[8], cb[8], g0[8], g1[8];
#pragma unroll
        for (int q = 0; q < 2; ++q) { const f32x4 a0 = *(const f32x4*)(conv_w + cg + 4 * q), a1 = *(const f32x4*)(conv_w + FF + cg + 4 * q), a2 = *(const f32x4*)(conv_w + 2 * FF + cg + 4 * q), bb = *(const f32x4*)(conv_b + cg + 4 * q);
#pragma unroll
            for (int e = 0; e < 4; ++e) { w0[4 * q + e] = a0[e]; w1[4 * q + e] = a1[e]; w2[4 * q + e] = a2[e]; cb[4 * q + e] = bb[e]; } }
        if (tt0 >= 2) { const v4u p1 = *(const v4u*)(GB + (r0 - 1) * FF + cg), p0 = *(const v4u*)(GB + (r0 - 2) * FF + cg);
            g1[0] = bflo(p1.x); g1[1] = bfhi(p1.x); g1[2] = bflo(p1.y); g1[3] = bfhi(p1.y); g1[4] = bflo(p1.z); g1[5] = bfhi(p1.z); g1[6] = bflo(p1.w); g1[7] = bfhi(p1.w);
            g0[0] = bflo(p0.x); g0[1] = bfhi(p0.x); g0[2] = bflo(p0.y); g0[3] = bfhi(p0.y); g0[4] = bflo(p0.z); g0[5] = bfhi(p0.z); g0[6] = bflo(p0.w); g0[7] = bfhi(p0.w); }
        else {
#pragma unroll
            for (int e = 0; e < 8; ++e) { g0[e] = 0.f; g1[e] = 0.f; } }
#pragma unroll 4
        for (int i = 0; i < 32; ++i) { const size_t off = (r0 + i) * FF + cg;
            const v4u gw2 = *(const v4u*)(GB + off), uw = *(const v4u*)(UB + off);
            const float g2[8] = {bflo(gw2.x), bfhi(gw2.x), bflo(gw2.y), bfhi(gw2.y), bflo(gw2.z), bfhi(gw2.z), bflo(gw2.w), bfhi(gw2.w)};
            const float uu[8] = {bflo(uw.x), bfhi(uw.x), bflo(uw.y), bfhi(uw.y), bflo(uw.z), bfhi(uw.z), bflo(uw.w), bfhi(uw.w)};
            float res[8];
#pragma unroll
            for (int e = 0; e < 8; ++e) { const float gc = cb[e] + w0[e] * g0[e] + w1[e] * g1[e] + w2[e] * g2[e];
                res[e] = gc * __builtin_amdgcn_rcpf(1.0f + __builtin_amdgcn_exp2f(-LOG2E * gc)) * uu[e]; g0[e] = g1[e]; g1[e] = g2[e]; }
            *(unsigned long long*)(ACT8 + off) = (unsigned long long)pg8::pk4_fp8(res[0], res[1], res[2], res[3]) | ((unsigned long long)pg8::pk4_fp8(res[4], res[5], res[6], res[7]) << 32); }
    } }
    xcd_barrier(bar);

    { DECL_PTRS; pg8::Gemm g{ACT8, WDT, FF / 128, FF, FF, 0xffffffffu}; pg8::TileOrder S; S.init(M, D, G, bx, FF, FF, 0, 1 << 30);
      pg8::EpiResNorm E{out, out, g_final, 1.0f / 64.0f, SSQ3, (unsigned*)(ctl + CW_PANEL), (unsigned*)(ctl + CW_TMO2)};
      pg8::gemm_phase<pg8::EpiResNorm, pg8::TileOrder, true, true>(L + RING_OFF, XL, g, S, E); }
}

extern "C" void kernel_launch(void* const* d_in, const int* in_sizes, int n_in, void* d_out, int out_size, void* d_ws, size_t ws_size, hipStream_t stream) {
    static int grid = 0;
    if (grid == 0) {
        if (n_in != 19 || in_sizes[0] != M * D || out_size != M * D || ws_size < WS_END) { fprintf(stderr, "kernel_launch: unexpected problem shape (n_in %d, in0 %d, out %d, ws %zu); nothing launched\n", n_in, n_in > 0 ? in_sizes[0] : -1, out_size, ws_size); grid = -1; return; }
        int dev = 0, cus = 0, per_cu = 0;
        if (hipGetDevice(&dev) != hipSuccess || hipDeviceGetAttribute(&cus, hipDeviceAttributeMultiprocessorCount, dev) != hipSuccess) { grid = -1; return; }
        if (hipFuncSetAttribute((const void*)fwd, hipFuncAttributeMaxDynamicSharedMemorySize, LDS_BYTES) != hipSuccess) { fprintf(stderr, "kernel_launch: hipFuncSetAttribute failed\n"); grid = -1; return; }
        if (hipOccupancyMaxActiveBlocksPerMultiprocessor(&per_cu, (const void*)fwd, NWAVES * 64, LDS_BYTES) != hipSuccess || per_cu < 1) { fprintf(stderr, "kernel_launch: occupancy query reports %d\n", per_cu); }
        (void)hipGetLastError();
        grid = cus;
    }
    if (grid < 0) return;
    if (hipMemsetAsync((char*)d_ws + WS_CTL, 0, CTL_ZERO_BYTES, stream) != hipSuccess) return;
    Args a{};
    for (int i = 0; i < 19; ++i) a.in[i] = (const float*)d_in[i];
    a.out = (float*)d_out; a.ws = (unsigned char*)d_ws;
    hipLaunchKernelGGL(fwd, dim3(grid), dim3(NWAVES * 64), LDS_BYTES, stream, a);
}
```

```cpp
#include <hip/hip_runtime.h>
#include <hip/hip_bf16.h>
#include <cstdio>
#include <cstdint>

namespace pg8 {
#define PG8_LAS __attribute__((address_space(3)))
typedef unsigned short bf16_t;
typedef short bf16x8 __attribute__((ext_vector_type(8)));
typedef float f32x4 __attribute__((ext_vector_type(4)));
typedef float f32x2 __attribute__((ext_vector_type(2)));
typedef unsigned u32x4 __attribute__((ext_vector_type(4)));
typedef unsigned u32x2 __attribute__((ext_vector_type(2)));
typedef int i32x4 __attribute__((ext_vector_type(4)));
typedef int i32x8 __attribute__((ext_vector_type(8)));
constexpr int BM = 256, BK = 64, HALF = 128, HTB = HALF * BK * 2  , STAGE_BYTES = 8 * HTB, NXCD = 8, WGM = 8;

__host__ __device__ __forceinline__ int lds_byte(int r, int c) { const int st = (r >> 4) * 2 + (c >> 5), rr = r & 15, cc = c & 31, ob = rr * 64 + cc * 2; return st * 1024 + (ob ^ (((ob >> 9) & 1) << 5)); }
__host__ __device__ __forceinline__ void stage_rc(int b, int& R, int& C) { const int st = b / 1024, sb = b % 1024, swz = sb ^ (((sb >> 9) & 1) << 5); R = (st >> 1) * 16 + swz / 64; C = (st & 1) * 32 + (swz % 64) / 2; }
__host__ __device__ __forceinline__ int perm32(int rho) { const int n = rho >> 4, i = rho & 15; return 8 * (i >> 2) + 4 * n + (i & 3); }

struct Unit { int pm, pn; size_t aoff, boff; };
struct Gemm { const void* A; const void* Bt; int nt, lda, ldb; unsigned wrapmask; };

struct TileOrder {
    int nM, nN, nwg, G, c; size_t a_tile, b_tile, b_batch; int pmb;
    __device__ __forceinline__ void init(int M, int N, int G_, int c_, int lda_bytes, int ldb_bytes, size_t b_batch_bytes, int pm_per_batch) {
        nM = M / BM; nN = N / BM; nwg = nM * nN; G = G_; c = c_; a_tile = (size_t)BM * lda_bytes; b_tile = (size_t)BM * ldb_bytes; b_batch = b_batch_bytes; pmb = pm_per_batch; }
    __device__ __forceinline__ bool next(int i, Unit& u) const {
        const long L = (long)i * G + c; if (L >= nwg) return false;
        int wgid = (int)L; { const int q = nwg / NXCD, r = nwg % NXCD, xcd = wgid % NXCD, off = wgid / NXCD; wgid = (xcd < r ? xcd * (q + 1) : r * (q + 1) + (xcd - r) * q) + off; }
        const int nig = WGM * nN, gid = wgid / nig, fm = gid * WGM, gsz = (nM - fm) < WGM ? (nM - fm) : WGM;
        u.pm = fm + ((wgid % nig) % gsz); u.pn = (wgid % nig) / gsz;
        u.aoff = (size_t)u.pm * a_tile; u.boff = (size_t)u.pn * b_tile + (size_t)(u.pm / pmb) * b_batch; return true;
    }
};

__device__ __forceinline__ unsigned cvt_pk_bf16(float lo, float hi) { unsigned r; asm volatile("v_cvt_pk_bf16_f32 %0, %1, %2" : "=v"(r) : "v"(lo), "v"(hi)); return r; }

typedef f32x4 AccT[2][2][4][2];

struct EpiBf16 {
    static constexpr bool PERM = true;
    bf16_t* O; int ldc; unsigned scalemask; float scale0; unsigned* nrm;
    __device__ __forceinline__ void operator()(AccT& acc, const Unit& u, int wr, int wc, int fr, int fq, PG8_LAS unsigned char*) const {
        const int row0 = u.pm * BM + wr * 64 + fr, col0 = u.pn * BM + wc * 32 + 8 * fq;
        const float sc = ((scalemask >> u.pn) & 1u) ? scale0 : 1.f;
        if (nrm && (u.pn < 4 || (u.pn >= 6 && u.pn < 10))) {
#pragma unroll
            for (int bj = 0; bj < 2; ++bj) { float mx = 0.f;
#pragma unroll
                for (int ai = 0; ai < 2; ++ai)
#pragma unroll
                    for (int m = 0; m < 4; ++m) { const f32x4 v0 = acc[ai][bj][m][0] * sc, v1 = acc[ai][bj][m][1] * sc;
                        float q = (v0[0] * v0[0] + v0[1] * v0[1]) + (v0[2] * v0[2] + v0[3] * v0[3]) + (v1[0] * v1[0] + v1[1] * v1[1]) + (v1[2] * v1[2] + v1[3] * v1[3]);
                        q += __shfl_xor(q, 16); q += __shfl_xor(q, 32); mx = fmaxf(mx, q); }
                mx = fmaxf(mx, __shfl_xor(mx, 1)); mx = fmaxf(mx, __shfl_xor(mx, 2)); mx = fmaxf(mx, __shfl_xor(mx, 4)); mx = fmaxf(mx, __shfl_xor(mx, 8));
                if (fr == 0 && fq == 0) { const int head = (u.pn & 1) * 4 + 2 * bj + (wc >> 1); const int grp = u.pn < 4 ? (u.pn >> 1) : (u.pn >> 1) - 1; atomicMax(nrm + (((u.pm >> 5) * 8 + head) * 4 + grp) * 2 + (wc & 1), __float_as_uint(mx)); } } }
#pragma unroll
        for (int ai = 0; ai < 2; ++ai)
#pragma unroll
            for (int m = 0; m < 4; ++m) { bf16_t* rowp = O + (size_t)(row0 + ai * HALF + m * 16) * ldc + col0;
#pragma unroll
                for (int bj = 0; bj < 2; ++bj) { const f32x4 v0 = acc[ai][bj][m][0] * sc, v1 = acc[ai][bj][m][1] * sc;
                    u32x4 w; w.x = cvt_pk_bf16(v0[0], v0[1]); w.y = cvt_pk_bf16(v0[2], v0[3]); w.z = cvt_pk_bf16(v1[0], v1[1]); w.w = cvt_pk_bf16(v1[2], v1[3]);
                    *(u32x4*)(rowp + bj * HALF) = w; } }
    }
};
__device__ __forceinline__ unsigned pk4_fp8(float a, float b, float c, float d) { int w = 0; w = __builtin_amdgcn_cvt_pk_fp8_f32(a, b, w, false); w = __builtin_amdgcn_cvt_pk_fp8_f32(c, d, w, true); return (unsigned)w; }
struct EpiF8 {
    static constexpr bool PERM = true;
    unsigned char* O; int ldc; float sc;
    __device__ __forceinline__ void operator()(AccT& acc, const Unit& u, int wr, int wc, int fr, int fq, PG8_LAS unsigned char*) const {
        const int row0 = u.pm * BM + wr * 64 + fr, col0 = u.pn * BM + wc * 32 + 8 * fq;
#pragma unroll
        for (int ai = 0; ai < 2; ++ai)
#pragma unroll
            for (int m = 0; m < 4; ++m) { unsigned char* rowp = O + (size_t)(row0 + ai * HALF + m * 16) * ldc + col0;
#pragma unroll
                for (int bj = 0; bj < 2; ++bj) { const f32x4 v0 = acc[ai][bj][m][0] * sc, v1 = acc[ai][bj][m][1] * sc;
                    *(u32x2*)(rowp + bj * HALF) = (u32x2){pk4_fp8(v0[0], v0[1], v0[2], v0[3]), pk4_fp8(v1[0], v1[1], v1[2], v1[3])}; } }
    }
};
__device__ __forceinline__ float rstd_from_slots(const float* slots) {
    const f32x4 a = *(const f32x4*)slots, b = *(const f32x4*)(slots + 4), c = *(const f32x4*)(slots + 8), d = *(const f32x4*)(slots + 12);
    const float s = ((a[0] + a[1]) + (a[2] + a[3])) + ((b[0] + b[1]) + (b[2] + b[3])) + ((c[0] + c[1]) + (c[2] + c[3])) + ((d[0] + d[1]) + (d[2] + d[3]));
    return __builtin_amdgcn_rsqf(s * (1.0f / 1024.0f) + 1e-6f);
}
struct EpiUp {
    static constexpr bool PERM = true;
    bf16_t* Gb; bf16_t* Ub; const float* ssq;
    __device__ __forceinline__ void operator()(AccT& acc, const Unit& u, int wr, int wc, int fr, int fq, PG8_LAS unsigned char*) const {
        const int row0 = u.pm * BM + wr * 64 + fr; const int pn = u.pn >= 11 ? u.pn - 11 : u.pn; bf16_t* base = u.pn >= 11 ? Ub : Gb;
        const int col0 = pn * BM + wc * 32 + 8 * fq;
#pragma unroll
        for (int ai = 0; ai < 2; ++ai)
#pragma unroll
            for (int m = 0; m < 4; ++m) { const int row = row0 + ai * HALF + m * 16; const float rs = rstd_from_slots(ssq + (size_t)row * 16); bf16_t* rowp = base + (size_t)row * 2816 + col0;
#pragma unroll
                for (int bj = 0; bj < 2; ++bj) { const f32x4 v0 = acc[ai][bj][m][0] * rs, v1 = acc[ai][bj][m][1] * rs;
                    u32x4 w; w.x = cvt_pk_bf16(v0[0], v0[1]); w.y = cvt_pk_bf16(v0[2], v0[3]); w.z = cvt_pk_bf16(v1[0], v1[1]); w.w = cvt_pk_bf16(v1[2], v1[3]);
                    *(u32x4*)(rowp + bj * HALF) = w; } }
    }
};
template <bool BASEB, bool OUTF> struct EpiRes {
    static constexpr bool PERM = true;
    const float* base; const bf16_t* baseb; float* out; bf16_t* hb; unsigned char* hb8; float* ssq; float accs;
    __device__ __forceinline__ void operator()(AccT& acc, const Unit& u, int wr, int wc, int fr, int fq, PG8_LAS unsigned char*) const {
        const int row0 = u.pm * BM + wr * 64 + fr, col0 = u.pn * BM + wc * 32 + 8 * fq;
#pragma unroll
        for (int ai = 0; ai < 2; ++ai)
#pragma unroll
            for (int m = 0; m < 4; ++m) { const int row = row0 + ai * HALF + m * 16; const size_t off = (size_t)row * 1024 + col0; float q = 0.f;
#pragma unroll
                for (int bj = 0; bj < 2; ++bj) {
                    f32x4 b0, b1;
                    if constexpr (BASEB) { const u32x4 bw = *(const u32x4*)(baseb + off + bj * HALF);
                        b0 = (f32x4){__builtin_bit_cast(float, bw.x << 16), __builtin_bit_cast(float, bw.x & 0xffff0000u), __builtin_bit_cast(float, bw.y << 16), __builtin_bit_cast(float, bw.y & 0xffff0000u)};
                        b1 = (f32x4){__builtin_bit_cast(float, bw.z << 16), __builtin_bit_cast(float, bw.z & 0xffff0000u), __builtin_bit_cast(float, bw.w << 16), __builtin_bit_cast(float, bw.w & 0xffff0000u)}; }
                    else { b0 = *(const f32x4*)(base + off + bj * HALF); b1 = *(const f32x4*)(base + off + bj * HALF + 4); }
                    const f32x4 v0 = acc[ai][bj][m][0] * accs + b0, v1 = acc[ai][bj][m][1] * accs + b1;
                    if constexpr (OUTF) { *(f32x4*)(out + off + bj * HALF) = v0; *(f32x4*)(out + off + bj * HALF + 4) = v1; }
                    q += (v0[0] * v0[0] + v0[1] * v0[1]) + (v0[2] * v0[2] + v0[3] * v0[3]) + (v1[0] * v1[0] + v1[1] * v1[1]) + (v1[2] * v1[2] + v1[3] * v1[3]);
                    if (hb) { u32x4 w; w.x = cvt_pk_bf16(v0[0], v0[1]); w.y = cvt_pk_bf16(v0[2], v0[3]); w.z = cvt_pk_bf16(v1[0], v1[1]); w.w = cvt_pk_bf16(v1[2], v1[3]); *(u32x4*)(hb + off + bj * HALF) = w; }
                    if (hb8) *(u32x2*)(hb8 + off + bj * HALF) = (u32x2){pk4_fp8(v0[0], v0[1], v0[2], v0[3]), pk4_fp8(v1[0], v1[1], v1[2], v1[3])}; }
                q += __shfl_xor(q, 16); q += __shfl_xor(q, 32);
                if (fq == 0) ssq[(size_t)row * 16 + u.pn * 4 + wc] = q; }
    }
};
struct EpiResNorm {
    static constexpr bool PERM = true;
    const float* base; float* out; const float* gfin; float accs; float* xbuf; unsigned* cnt; unsigned* tmo;
    __device__ __forceinline__ void operator()(AccT& acc, const Unit& u, int wr, int wc, int fr, int fq, PG8_LAS unsigned char* xl) const {
        PG8_LAS float* Pp = (PG8_LAS float*)xl;
        PG8_LAS float* Sr = Pp + 1024;
        PG8_LAS unsigned* flag = (PG8_LAS unsigned*)(Sr + 256);
        const int tid = threadIdx.x, wid = tid >> 6, lane = tid & 63;
        const int row0 = u.pm * BM + wr * 64 + fr, col0 = u.pn * BM + wc * 32 + 8 * fq;
#pragma unroll
        for (int ai = 0; ai < 2; ++ai)
#pragma unroll
            for (int m = 0; m < 4; ++m) { const int row = row0 + ai * HALF + m * 16; const size_t off = (size_t)row * 1024 + col0; float q = 0.f;
#pragma unroll
                for (int bj = 0; bj < 2; ++bj) {
                    const f32x4 b0 = *(const f32x4*)(base + off + bj * HALF), b1 = *(const f32x4*)(base + off + bj * HALF + 4);
                    const f32x4 v0 = acc[ai][bj][m][0] * accs + b0, v1 = acc[ai][bj][m][1] * accs + b1; acc[ai][bj][m][0] = v0; acc[ai][bj][m][1] = v1;
                    q += (v0[0] * v0[0] + v0[1] * v0[1]) + (v0[2] * v0[2] + v0[3] * v0[3]) + (v1[0] * v1[0] + v1[1] * v1[1]) + (v1[2] * v1[2] + v1[3] * v1[3]); }
                q += __shfl_xor(q, 16); q += __shfl_xor(q, 32);
                if (fq == 0) Pp[(ai * HALF + wr * 64 + m * 16 + fr) * 4 + wc] = q; }
        asm volatile("s_waitcnt lgkmcnt(0)" ::: "memory"); __builtin_amdgcn_s_barrier(); asm volatile("" ::: "memory");
        if (wid < 4) { const int r = wid * 64 + lane; const f32x4 p = *(const PG8_LAS f32x4*)(Pp + r * 4);
            __hip_atomic_store(xbuf + (size_t)(u.pm * BM + r) * 4 + u.pn, (p[0] + p[1]) + (p[2] + p[3]), __ATOMIC_RELAXED, __HIP_MEMORY_SCOPE_AGENT);
            asm volatile("s_waitcnt vmcnt(0)" ::: "memory");
            if (lane == 0) __hip_atomic_fetch_add(cnt + 64 * u.pm, 1u, __ATOMIC_RELAXED, __HIP_MEMORY_SCOPE_AGENT); }
        if (wid == 0) { unsigned sp = 0u; bool dead = false;
            for (;;) { if ((unsigned)__builtin_amdgcn_readfirstlane(__hip_atomic_load(cnt + 64 * u.pm, __ATOMIC_RELAXED, __HIP_MEMORY_SCOPE_AGENT)) >= 16u) break;
                if (++sp > (1u << 20)) { if (lane == 0) __hip_atomic_store(tmo, 1u, __ATOMIC_RELAXED, __HIP_MEMORY_SCOPE_AGENT); dead = true; break; }
                __builtin_amdgcn_s_sleep(2); }
            __builtin_amdgcn_fence(__ATOMIC_ACQUIRE, "agent");
            if (lane == 0) flag[0] = dead ? 1u : 0u; }
        asm volatile("s_waitcnt vmcnt(0) lgkmcnt(0)" ::: "memory"); __builtin_amdgcn_s_barrier(); asm volatile("" ::: "memory");
        if (wid < 4) { const int r = wid * 64 + lane; const float* xs = xbuf + (size_t)(u.pm * BM + r) * 4; float s = 0.f;
#pragma unroll
            for (int t = 0; t < 4; ++t) s += __hip_atomic_load(xs + t, __ATOMIC_RELAXED, __HIP_MEMORY_SCOPE_AGENT);
            Sr[r] = __builtin_amdgcn_rsqf(s * (1.0f / 1024.0f) + 1e-6f); }
        asm volatile("s_waitcnt vmcnt(0) lgkmcnt(0)" ::: "memory"); __builtin_amdgcn_s_barrier(); asm volatile("" ::: "memory");
        f32x4 gg[2][2];
#pragma unroll
        for (int bj = 0; bj < 2; ++bj) { gg[bj][0] = *(const f32x4*)(gfin + col0 + bj * HALF); gg[bj][1] = *(const f32x4*)(gfin + col0 + bj * HALF + 4); }
#pragma unroll
        for (int ai = 0; ai < 2; ++ai)
#pragma unroll
            for (int m = 0; m < 4; ++m) { const int rl = ai * HALF + wr * 64 + m * 16 + fr; const float rs = Sr[rl]; const size_t off = (size_t)(u.pm * BM + rl) * 1024 + col0;
#pragma unroll
                for (int bj = 0; bj < 2; ++bj) { *(f32x4*)(out + off + bj * HALF) = acc[ai][bj][m][0] * rs * gg[bj][0]; *(f32x4*)(out + off + bj * HALF + 4) = acc[ai][bj][m][1] * rs * gg[bj][1]; } }
    }
};
struct EpiSoftmax {
    static constexpr bool PERM = true;
    unsigned char* P; const float* ssq; float sscale;
    __device__ __forceinline__ void operator()(AccT& acc, const Unit& u, int wr, int wc, int fr, int fq, PG8_LAS unsigned char* xl) const {
        PG8_LAS f32x2* X = (PG8_LAS f32x2*)xl;
        const int row0 = u.pm * BM + wr * 64 + fr, col0 = u.pn * BM + wc * 32 + 8 * fq;
        float ml[2][4];
#pragma unroll
        for (int ai = 0; ai < 2; ++ai)
#pragma unroll
            for (int m = 0; m < 4; ++m) { const int row = row0 + ai * HALF + m * 16; const float rs = rstd_from_slots(ssq + (size_t)row * 16) * sscale;
                float mx = -3.0e38f;
#pragma unroll
                for (int bj = 0; bj < 2; ++bj)
#pragma unroll
                    for (int n = 0; n < 2; ++n) { f32x4 v = acc[ai][bj][m][n] * rs; acc[ai][bj][m][n] = v; mx = fmaxf(fmaxf(mx, fmaxf(v[0], v[1])), fmaxf(v[2], v[3])); }
                mx = fmaxf(mx, __shfl_xor(mx, 16)); mx = fmaxf(mx, __shfl_xor(mx, 32));
                float s = 0.f;
#pragma unroll
                for (int bj = 0; bj < 2; ++bj)
#pragma unroll
                    for (int n = 0; n < 2; ++n) { f32x4 v = acc[ai][bj][m][n];
                        v[0] = __builtin_amdgcn_exp2f(v[0] - mx); v[1] = __builtin_amdgcn_exp2f(v[1] - mx); v[2] = __builtin_amdgcn_exp2f(v[2] - mx); v[3] = __builtin_amdgcn_exp2f(v[3] - mx);
                        acc[ai][bj][m][n] = v; s += (v[0] + v[1]) + (v[2] + v[3]); }
                s += __shfl_xor(s, 16); s += __shfl_xor(s, 32);
                ml[ai][m] = mx;
                if (fq == 0) X[(ai * HALF + wr * 64 + m * 16 + fr) * 4 + wc] = (f32x2){mx, s}; }
        asm volatile("s_waitcnt lgkmcnt(0)" ::: "memory"); __builtin_amdgcn_s_barrier(); asm volatile("" ::: "memory");
#pragma unroll
        for (int ai = 0; ai < 2; ++ai)
#pragma unroll
            for (int m = 0; m < 4; ++m) { const int rl = ai * HALF + wr * 64 + m * 16 + fr; const int row = u.pm * BM + rl;
                const f32x2 a = X[rl * 4 + 0], b = X[rl * 4 + 1], c = X[rl * 4 + 2], d = X[rl * 4 + 3];
                const float Mx = fmaxf(fmaxf(a.x, b.x), fmaxf(c.x, d.x));
                const float L = a.y * __builtin_amdgcn_exp2f(a.x - Mx) + b.y * __builtin_amdgcn_exp2f(b.x - Mx) + c.y * __builtin_amdgcn_exp2f(c.x - Mx) + d.y * __builtin_amdgcn_exp2f(d.x - Mx);
                const float f = __builtin_amdgcn_exp2f(ml[ai][m] - Mx) * __builtin_amdgcn_rcpf(L) * 256.0f;
                unsigned char* rowp = P + (size_t)row * 1024 + col0;
#pragma unroll
                for (int bj = 0; bj < 2; ++bj) { const f32x4 v0 = acc[ai][bj][m][0] * f, v1 = acc[ai][bj][m][1] * f;
                    *(u32x2*)(rowp + bj * HALF) = (u32x2){pk4_fp8(v0[0], v0[1], v0[2], v0[3]), pk4_fp8(v1[0], v1[1], v1[2], v1[3])}; } }
    }
};
struct EpiGate {
    static constexpr bool PERM = false;
    unsigned* sel;
    __device__ __forceinline__ void operator()(AccT& acc, const Unit& u, int wr, int wc, int fr, int fq, PG8_LAS unsigned char*) const {
        const int own = u.pm & 31;
#pragma unroll
        for (int ai = 0; ai < 2; ++ai)
#pragma unroll
            for (int m = 0; m < 4; ++m) { const int row = u.pm * BM + ai * HALF + wr * 64 + m * 16 + fr;
#pragma unroll
                for (int bj = 0; bj < 2; ++bj) { unsigned mask = 0u;
#pragma unroll
                    for (int round = 0; round < 3; ++round) { float bv = -3.0e38f; int bi = 32;
#pragma unroll
                        for (int n = 0; n < 2; ++n)
#pragma unroll
                            for (int i = 0; i < 4; ++i) { const int nb = 16 * n + 4 * fq + i; const float v = acc[ai][bj][m][n][i];
                                if (nb < own && !((mask >> nb) & 1u) && v > bv) { bv = v; bi = nb; } }
#pragma unroll
                        for (int off = 16; off <= 32; off <<= 1) { const float ov = __shfl_xor(bv, off); const int oi = __shfl_xor(bi, off); if (ov > bv || (ov == bv && oi < bi)) { bv = ov; bi = oi; } }
                        if (bi < 32) mask |= 1u << bi; }
                    if (fq == 0) sel[((size_t)((u.pm >> 5) * 8 + 4 * bj + wc)) * 8192 + (row & 8191)] = mask; } }
    }
};

template <class Epi, class Sched, bool ALIGN_EPI, bool F8 = false>
__device__ __forceinline__ void gemm_phase(PG8_LAS unsigned char* lds, PG8_LAS unsigned char* xl, const Gemm g, const Sched& S, const Epi& E) {
    int tid_ = threadIdx.x; asm volatile("" : "+v"(tid_));
    const int tid = tid_, wid = __builtin_amdgcn_readfirstlane(tid >> 6), lane = tid & 63, wr = wid >> 2, wc = wid & 3, fr = lane & 15, fq = lane >> 4;
    int nt = g.nt; asm volatile("" : "+s"(nt));
    unsigned voffA[2], voffB[2];
#pragma unroll
    for (int i = 0; i < 2; ++i) { int R, C; stage_rc(tid * 16 + i * 8192, R, C); const int Rb = Epi::PERM ? ((R & ~31) + perm32(R & 31)) : R;
        voffA[i] = (unsigned)(R * g.lda + C * 2); voffB[i] = (unsigned)(Rb * g.ldb + C * 2); }
    const size_t kstep = (size_t)(BK * 2);
    const size_t hstepA = (size_t)HALF * g.lda, hstepB = (size_t)HALF * g.ldb;
    const unsigned wmask = g.wrapmask;
    const unsigned ldsw = (unsigned)wid * 1024u;
    const int aoff = lds_byte(wr * 64 + fr, fq * 8), boff = lds_byte(wc * 32 + fr, fq * 8);
#define PG8_SA(b, h) (((b) * 2 + (h)) * HTB)
#define PG8_SB(b, h) ((4 + (b) * 2 + (h)) * HTB)
#define PG8_STAGE(bufoff, gbase, voff) do { _Pragma("unroll") for (int _i = 0; _i < 2; ++_i) \
        __builtin_amdgcn_global_load_lds((const unsigned*)((const char*)(gbase) + (voff)[_i]), (PG8_LAS unsigned*)(lds + (bufoff) + ldsw + _i * 8192), 16, 0, 0); } while (0)
#define PG8_LDA(dst, b, h) do { if constexpr (F8) { _Pragma("unroll") for (int m = 0; m < 4; ++m) { dst##8[m].lo = *(const PG8_LAS i32x4*)(lds + PG8_SA(b, h) + aoff + m * 2048); dst##8[m].hi = *(const PG8_LAS i32x4*)(lds + PG8_SA(b, h) + aoff + m * 2048 + 1024); } } \
        else { _Pragma("unroll") for (int m = 0; m < 4; ++m) _Pragma("unroll") for (int k = 0; k < 2; ++k) dst[m][k] = *(const PG8_LAS bf16x8*)(lds + PG8_SA(b, h) + aoff + m * 2048 + k * 1024); } } while (0)
#define PG8_LDB(dst, b, h) do { if constexpr (F8) { _Pragma("unroll") for (int n = 0; n < 2; ++n) { dst##8[n].lo = *(const PG8_LAS i32x4*)(lds + PG8_SB(b, h) + boff + n * 2048); dst##8[n].hi = *(const PG8_LAS i32x4*)(lds + PG8_SB(b, h) + boff + n * 2048 + 1024); } } \
        else { _Pragma("unroll") for (int n = 0; n < 2; ++n) _Pragma("unroll") for (int k = 0; k < 2; ++k) dst[n][k] = *(const PG8_LAS bf16x8*)(lds + PG8_SB(b, h) + boff + n * 2048 + k * 1024); } } while (0)
#define PG8_MMA(ai, bj, At, Bt) do { __builtin_amdgcn_s_setprio(1); \
        if constexpr (F8) { _Pragma("unroll") for (int m = 0; m < 4; ++m) _Pragma("unroll") for (int n = 0; n < 2; ++n) \
            asm volatile("v_mfma_f32_16x16x128_f8f6f4 %0, %1, %2, %0" : "+v"(acc[ai][bj][m][n]) : "v"(Bt##8[n]), "v"(At##8[m])); } \
        else { _Pragma("unroll") for (int m = 0; m < 4; ++m) _Pragma("unroll") for (int n = 0; n < 2; ++n) _Pragma("unroll") for (int k = 0; k < 2; ++k) \
            acc[ai][bj][m][n] = __builtin_amdgcn_mfma_f32_16x16x32_bf16(Bt[n][k], At[m][k], acc[ai][bj][m][n], 0, 0, 0); } \
        __builtin_amdgcn_s_setprio(0); } while (0)
#define PG8_WAIT_V(n) asm volatile("s_waitcnt vmcnt(" #n ")" ::: "memory")
#define PG8_WAIT_L(n) asm volatile("s_waitcnt lgkmcnt(" #n ")" ::: "memory")
#define PG8_BAR __builtin_amdgcn_s_barrier()
#define PG8_SCHED __builtin_amdgcn_sched_barrier(0)
    Unit cur, nxt; int ui = 0;
    if (!S.next(0, cur)) return;
    AccT acc;
    bf16x8 At[4][2], B0[2][2], B1[2][2]; i32x8 At8[4], B08[2], B18[2];
    const char* cA = (const char*)g.A + cur.aoff; const char* cB = (const char*)g.Bt + cur.boff;
    PG8_STAGE(PG8_SB(0, 0), cB, voffB); PG8_STAGE(PG8_SB(0, 1), cB + hstepB, voffB); PG8_STAGE(PG8_SA(0, 0), cA, voffA); PG8_STAGE(PG8_SA(0, 1), cA + hstepA, voffA);
    if (wr == 1) PG8_BAR;
    PG8_WAIT_V(2); PG8_BAR;
    PG8_STAGE(PG8_SB(1, 0), cB + kstep, voffB); PG8_STAGE(PG8_SA(1, 0), cA + kstep, voffA); PG8_STAGE(PG8_SB(1, 1), cB + hstepB + kstep, voffB);
    PG8_WAIT_V(6); PG8_BAR;
    { float z0; asm volatile("v_mov_b32 %0, 0" : "=v"(z0));
#pragma unroll
    for (int a = 0; a < 2; ++a)
#pragma unroll
        for (int b = 0; b < 2; ++b)
#pragma unroll
            for (int m = 0; m < 4; ++m)
#pragma unroll
                for (int n = 0; n < 2; ++n) acc[a][b][m][n] = (f32x4){z0, z0, z0, z0}; }
    for (;;) {
        const bool has_next = S.next(ui + 1, nxt);
        const char* nA = has_next ? (const char*)g.A + nxt.aoff : cA; const char* nB = has_next ? (const char*)g.Bt + nxt.boff : cB;
#pragma unroll 1
        for (int t = 0; t < nt; t += 2) {
            const bool last = (t == nt - 2);
            const char* a1 = cA + (size_t)((unsigned)(t * 128) & wmask) + kstep;
            const char* a2 = last ? nA : cA + (size_t)((unsigned)((t + 2) * 128) & wmask); const char* b2 = last ? nB : cB + (size_t)(t + 2) * kstep;
            const char* a3 = a2 + kstep; const char* b3 = b2 + kstep;
            PG8_LDB(B0, 0, 0); PG8_LDB(B1, 0, 1); PG8_SCHED; PG8_LDA(At, 0, 0); PG8_STAGE(PG8_SA(1, 1), a1 + hstepA, voffA);
            PG8_WAIT_V(8); PG8_WAIT_L(0); PG8_BAR; PG8_MMA(0, 0, At, B0); PG8_MMA(0, 1, At, B1); PG8_BAR; PG8_SCHED;
            PG8_LDA(At, 0, 1); PG8_STAGE(PG8_SB(0, 0), b2, voffB); PG8_STAGE(PG8_SB(0, 1), b2 + hstepB, voffB); PG8_STAGE(PG8_SA(0, 0), a2, voffA);
            PG8_WAIT_V(8); PG8_WAIT_L(0); PG8_BAR; PG8_MMA(1, 0, At, B0); PG8_MMA(1, 1, At, B1); PG8_BAR; PG8_SCHED;
            PG8_LDB(B0, 1, 0); PG8_LDB(B1, 1, 1); PG8_SCHED; PG8_LDA(At, 1, 0); PG8_STAGE(PG8_SA(0, 1), a2 + hstepA, voffA);
            PG8_WAIT_V(8); PG8_WAIT_L(0); PG8_BAR; PG8_MMA(0, 0, At, B0); PG8_MMA(0, 1, At, B1); PG8_BAR; PG8_SCHED;
            PG8_LDA(At, 1, 1); PG8_STAGE(PG8_SB(1, 0), b3, voffB); PG8_STAGE(PG8_SB(1, 1), b3 + hstepB, voffB); PG8_STAGE(PG8_SA(1, 0), a3, voffA);
            PG8_WAIT_V(8); PG8_WAIT_L(0); PG8_BAR; PG8_MMA(1, 0, At, B0); PG8_MMA(1, 1, At, B1); PG8_BAR; PG8_SCHED;
        }
        if constexpr (F8) asm volatile("s_nop 15\n\ts_nop 15" ::: "memory");
        if constexpr (ALIGN_EPI) { if (wr == 0) PG8_BAR; }
        E(acc, cur, wr, wc, fr, fq, xl);
        if (!has_next) break;
#pragma unroll
        for (int a = 0; a < 2; ++a)
#pragma unroll
            for (int b = 0; b < 2; ++b)
#pragma unroll
                for (int m = 0; m < 4; ++m)
#pragma unroll
                    for (int n = 0; n < 2; ++n) acc[a][b][m][n] = (f32x4){0.f, 0.f, 0.f, 0.f};
        cur = nxt; cA = nA; cB = nB; ++ui;
        if constexpr (ALIGN_EPI) { if (wr == 1) PG8_BAR; }
    }
    PG8_WAIT_V(0);
    if constexpr (!ALIGN_EPI) { if (wr == 0) PG8_BAR; }
    PG8_BAR;
#undef PG8_SA
#undef PG8_SB
#undef PG8_STAGE
#undef PG8_LDA
#undef PG8_LDB
#undef PG8_MMA
#undef PG8_WAIT_V
#undef PG8_WAIT_L
#undef PG8_BAR
#undef PG8_SCHED
}
}

constexpr int NWAVES = 8;
constexpr int NB = 8, T = 8192, D = 1024, M = NB * T;
constexpr int INC = 3080, NQKV = 3072, FF = 2816;
constexpr int C_F = 1536, C_QM = 1544, C_KM = 2056;
constexpr float LOG2E = 1.4426950408889634f;
constexpr float C2 = 0.125f * LOG2E;
constexpr float RMS_EPS = 1e-6f;

constexpr size_t MiB = 1u << 20;
constexpr size_t WS_CTL = 0, CTL_ZERO_BYTES = 1 * MiB;
constexpr size_t WS_LOGF = 2 * MiB, WS_C = 4 * MiB, WS_ABAR = 6 * MiB, WS_KM = 7 * MiB, WS_SEL = 8 * MiB;
constexpr size_t WS_SSQ1 = 10 * MiB, WS_SSQ2 = 14 * MiB, WS_SSQ3 = 18 * MiB;
constexpr size_t WS_MEMN = 22 * MiB, WS_KV = 26 * MiB, WS_WQS = 34 * MiB, WS_WOT = 36 * MiB, WS_WKVT = 38 * MiB, WS_WINT = 42 * MiB, WS_WOUTT = 48 * MiB;
constexpr size_t WS_WUPT = 50 * MiB, WS_WDT = 976 * MiB  , WS_ZT = 68 * MiB, WS_WQK = 80 * MiB, WS_VWO = 96 * MiB;
constexpr size_t WS_ACT8 = 64 * MiB;
constexpr size_t WS_A1 = 112 * MiB;
constexpr size_t WS_QKV = 368 * MiB;
constexpr size_t WS_Y = 752 * MiB, WS_HB1 = WS_A1 + 128 * MiB, WS_P = WS_QKV, WS_HB2 = WS_A1;
constexpr size_t WS_HB1F = WS_A1;
constexpr size_t WS_PO = WS_A1;
constexpr size_t WS_LIST = 880 * MiB, WS_PML = 944 * MiB, WS_KXF = 960 * MiB, WS_KXM = 968 * MiB, WS_CNT = 969 * MiB;
constexpr size_t WS_G = 240 * MiB, WS_U = 592 * MiB, WS_END = 1024 * MiB;
static_assert(WS_WUPT + (size_t)2 * FF * D * 2 <= WS_ZT && WS_ACT8 + (size_t)M * FF <= 240 * MiB && WS_WDT + (size_t)D * FF <= WS_END && WS_CNT + 8192 <= WS_WDT && WS_ZT + (size_t)8 * 256 * 3072 * 2 <= WS_WQK && WS_VWO + 16 * MiB <= WS_A1, "ws map");
static_assert(WS_G + (size_t)M * FF * 2 <= WS_U && WS_U + (size_t)M * FF * 2 <= WS_END && WS_Y + (size_t)M * D * 2 <= WS_LIST && WS_LIST + (size_t)2048 * 8192 * 4 <= WS_PML && WS_PML + (size_t)M * 32 * 8 <= WS_KXF && WS_KXF + (size_t)64 * 8192 * 16 <= WS_KXM, "ws map 2");
constexpr int CW_BAR = 4096;
constexpr int CW_QKN = 8192;
constexpr int CW_QUEUE = 12288;
constexpr int CW_T0TAB = 16384;
constexpr int CW_PANEL = 32768, CW_TMO2 = 20480;

constexpr int RING_OFF = 0, RING_BYTES = 131072;
constexpr int LDSCTL_OFF = RING_BYTES, MISC_OFF = LDSCTL_OFF + 320;
constexpr int XL_OFF = RING_BYTES + 512;
constexpr int LDS_BYTES = 147456;
static_assert(XL_OFF + 8192 <= LDS_BYTES, "LDS map");

#define GAS __attribute__((address_space(1)))
#define LAS __attribute__((address_space(3)))
typedef unsigned short bf16;
typedef unsigned v4u __attribute__((ext_vector_type(4)));
typedef float f32x4 __attribute__((ext_vector_type(4)));
typedef GAS unsigned gu32;
#define RLX_AGENT __ATOMIC_RELAXED, __HIP_MEMORY_SCOPE_AGENT
#define LDS_WAIT() asm volatile("s_waitcnt lgkmcnt(0)" ::: "memory")
__device__ __forceinline__ unsigned f2bf(float f) { unsigned u = __builtin_bit_cast(unsigned, f); return (u + 0x7fffu + ((u >> 16) & 1u)) >> 16; }
__device__ __forceinline__ unsigned pk2(float lo, float hi) { unsigned r; asm("v_cvt_pk_bf16_f32 %0, %1, %2" : "=v"(r) : "v"(lo), "v"(hi)); return r; }
__device__ __forceinline__ float bf2f(unsigned b) { return __builtin_bit_cast(float, b << 16); }
__device__ __forceinline__ float bflo(unsigned w) { return __builtin_bit_cast(float, w << 16); }
__device__ __forceinline__ float bfhi(unsigned w) { return __builtin_bit_cast(float, w & 0xffff0000u); }

#define XB_TMO      128
#define XB_XCNT(j)  (256  + 64 * (j))
#define XB_XSUB(j)  (1280 + 64 * (j))
#define XB_XGEN(j)  (2304 + 64 * (j))
#define XB_TOP      3328
#define XB_TOPGEN   3392
#define XCD_BAR_WORDS 3456
#define XB_SPIN_CAP (1u << 18)

__device__ __forceinline__ unsigned xb_ld(unsigned* p)              { return __hip_atomic_load(p, __ATOMIC_RELAXED, __HIP_MEMORY_SCOPE_AGENT); }
__device__ __forceinline__ unsigned xb_add(unsigned* p, unsigned v) { return __hip_atomic_fetch_add(p, v, __ATOMIC_RELAXED, __HIP_MEMORY_SCOPE_AGENT); }
__device__ __forceinline__ unsigned xb_xcc_id() { return (unsigned)__builtin_amdgcn_s_getreg((3 << 11) | 20) & 0xFu; }
#define XB_SPIN(cond, bar) do { unsigned _sp = 0; while (cond) { __builtin_amdgcn_s_sleep(1); \
    if ((++_sp & 255u) == 0u) { if (xb_ld(&(bar)[XB_TMO])) break; if (_sp > XB_SPIN_CAP) { atomicAdd(&(bar)[XB_TMO], 1u); break; } } } } while (0)

struct XcdBarrier { unsigned* bar; unsigned x; volatile LAS unsigned* st; };

__device__ __forceinline__ XcdBarrier xcd_barrier_post(unsigned* bar, volatile LAS unsigned* st) {
    XcdBarrier b; b.bar = bar; b.x = xb_xcc_id(); b.st = st;
    if (threadIdx.x == 0) (void)xb_add(&bar[XB_XCNT(b.x)], 1u);
    return b;
}
__device__ __forceinline__ void xcd_barrier_complete(unsigned* bar, unsigned x, unsigned& nloc, unsigned& nx) {
    const unsigned G = gridDim.x * gridDim.y * gridDim.z;
    unsigned sum, cnt, mine, sp = 0u;
    for (;;) {
        sum = 0u; cnt = 0u; mine = 0u;
#pragma unroll
        for (unsigned j = 0; j < 16; ++j) { const unsigned c = xb_ld(&bar[XB_XCNT(j)]); sum += c; cnt += (c > 0u) ? 1u : 0u; mine = (j == x) ? c : mine; }
        if (sum == G) break;
        __builtin_amdgcn_s_sleep(1);
        if ((++sp & 255u) == 0u) { if (xb_ld(&bar[XB_TMO])) break; if (sp > XB_SPIN_CAP) { atomicAdd(&bar[XB_TMO], 1u); break; } }
    }
    nloc = mine > 0u ? mine : 1u; nx = cnt > 0u ? cnt : 1u;
}
__device__ __forceinline__ void xcd_barrier(const XcdBarrier& b) {
    asm volatile("s_waitcnt vmcnt(0)" ::: "memory");
    __syncthreads();
    if (threadIdx.x == 0) {
        unsigned* bar = b.bar;
        __builtin_amdgcn_s_waitcnt(0);
        unsigned nloc = b.st[0], nx = b.st[1];
        if (nloc == 0u) { xcd_barrier_complete(bar, b.x, nloc, nx); b.st[0] = nloc; b.st[1] = nx; }
        const unsigned old = xb_add(&bar[XB_XSUB(b.x)], 1u);
        const unsigned gen = old / nloc;
        if (old + 1u == (gen + 1u) * nloc) {
            __builtin_amdgcn_fence(__ATOMIC_RELEASE, "agent");
            asm volatile("s_waitcnt vmcnt(0)" ::: "memory");
            const unsigned og = xb_add(&bar[XB_TOP], 1u);
            const unsigned tg = og / nx;
            if (og + 1u == (tg + 1u) * nx) xb_add(&bar[XB_TOPGEN], 1u);
            else XB_SPIN(xb_ld(&bar[XB_TOPGEN]) == tg, bar);
            __builtin_amdgcn_fence(__ATOMIC_ACQUIRE, "agent");
            xb_add(&bar[XB_XGEN(b.x)], 1u);
            asm volatile("s_waitcnt vmcnt(0)" ::: "memory");
        } else {
            XB_SPIN(xb_ld(&bar[XB_XGEN(b.x)]) == gen, bar);
            __builtin_amdgcn_fence(__ATOMIC_ACQUIRE, "agent");
            asm volatile("s_waitcnt vmcnt(0)" ::: "memory");
        }
    }
    __syncthreads();
}

__device__ __forceinline__ float wave_sum(float v) {
#pragma unroll
    for (int o = 1; o < 64; o <<= 1) v += __shfl_xor(v, o);
    return v;
}
__device__ __forceinline__ void p0_transpose_item(const float* W, int ldw, int K, int N, bf16* WT, const float* kscale, bool remap, LAS float* scr, int item, int lane, float f8scale = 0.f) {
    const int nblk = N / 32, kb = item / nblk, nb = item % nblk, k0 = 64 * kb, n0 = 32 * nb;
    const int sn0 = (remap && n0 >= 1536) ? n0 + 8 : n0;
#pragma unroll 8
    for (int i = 0; i < 32; ++i) { const int kk = 2 * i + (lane >> 5); float v = W[(size_t)(k0 + kk) * ldw + sn0 + (lane & 31)]; if (kscale) v *= kscale[k0 + kk]; scr[kk * 33 + (lane & 31)] = v; }
    LDS_WAIT(); asm volatile("" ::: "memory");
    const int c = lane & 7;
#pragma unroll
    for (int j = 0; j < 4; ++j) { const int n = (lane >> 3) + 8 * j; const LAS float* s = scr + (8 * c) * 33 + n;
        if (f8scale != 0.f) { const unsigned lo = pg8::pk4_fp8(s[0 * 33] * f8scale, s[1 * 33] * f8scale, s[2 * 33] * f8scale, s[3 * 33] * f8scale), hi = pg8::pk4_fp8(s[4 * 33] * f8scale, s[5 * 33] * f8scale, s[6 * 33] * f8scale, s[7 * 33] * f8scale);
            *(GAS unsigned long long*)((unsigned char*)WT + (size_t)(n0 + n) * K + k0 + 8 * c) = (unsigned long long)lo | ((unsigned long long)hi << 32); }
        else { v4u o; o.x = pk2(s[0 * 33], s[1 * 33]); o.y = pk2(s[2 * 33], s[3 * 33]); o.z = pk2(s[4 * 33], s[5 * 33]); o.w = pk2(s[6 * 33], s[7 * 33]);
            *(GAS v4u*)(WT + (size_t)(n0 + n) * K + k0 + 8 * c) = o; } }
    LDS_WAIT(); asm volatile("" ::: "memory");
}

struct Args { const float* in[19]; float* out; unsigned char* ws; };
__device__ __forceinline__ float skip_thr(const unsigned* qk8, int moba) {
    const unsigned* p = qk8 + 4 * moba;
    const float qn = sqrtf(__uint_as_float(__hip_atomic_load(p, RLX_AGENT)) + __uint_as_float(__hip_atomic_load(p + 1, RLX_AGENT))), kn = sqrtf(__uint_as_float(__hip_atomic_load(p + 2, RLX_AGENT)) + __uint_as_float(__hip_atomic_load(p + 3, RLX_AGENT)));
    return 2.0f * qn * kn * 1.02f + 40.0f;
}
__device__ __forceinline__ bool moba_skip(int h, int j, int n, float thr) { return __builtin_amdgcn_exp2f(-(float)(h + 1)) * LOG2E * (float)(256 * (j - n - 1) + 1) >= thr; }

namespace attn_body {
using hb16=__hip_bfloat16;
using bf16x8=__attribute__((ext_vector_type(8)))short;
using s16x4=__attribute__((ext_vector_type(4)))short;
using f32x16=__attribute__((ext_vector_type(16)))float;
using u32x4=__attribute__((ext_vector_type(4)))unsigned;
constexpr int PITCH=3072;
constexpr int NW=8,QBLK=32,QB=QBLK*NW,KVBLK=64;
__device__ __forceinline__ int crow(int r,int hi){return (r&3)+8*(r>>2)+4*hi;}
#define SBAR() __builtin_amdgcn_sched_barrier(0)
__device__ __forceinline__ void cmask(f32x16&p0,f32x16&p1,int jb,int qrel,int hi){
  const float NEG=-INFINITY; int kb=64*jb+4*hi;
  #pragma unroll
  for(int r=0;r<16;++r){int kv=kb+(r&3)+8*(r>>2); if(kv>qrel)p0[r]=NEG; if(kv+32>qrel)p1[r]=NEG;}
}
constexpr int NSLOT=3, SLOTB=9216;
constexpr int LDS_K=0, LDS_V=NSLOT*SLOTB, LDS_WS=2*NSLOT*SLOTB, LDS_OST=LDS_WS+NW*64*4, LDS_BYTES=LDS_OST+NW*4096;
__device__ __forceinline__ void glds16(const void*gsrc,unsigned lds_dst){unsigned keep;
  asm volatile("s_mov_b32 %0, m0\n\ts_mov_b32 m0, %2\n\ts_nop 0\n\tglobal_load_lds_dwordx4 %1, off\n\ts_mov_b32 m0, %0":"=&s"(keep):"v"(gsrc),"s"(lds_dst):"memory");}
__device__ __forceinline__ void glds16x(const void*gsrc,unsigned lds_dst){unsigned keep;unsigned long long ex;
  asm volatile("s_mov_b32 %0, m0\n\ts_mov_b64 %1, exec\n\ts_mov_b64 exec, 0xff\n\ts_mov_b32 m0, %3\n\ts_nop 0\n\tglobal_load_lds_dwordx4 %2, off\n\ts_mov_b64 exec, %1\n\ts_mov_b32 m0, %0":"=&s"(keep),"=&s"(ex):"v"(gsrc),"s"(lds_dst):"memory");}
__device__ __forceinline__ float max3f(float a,float b,float c){float r;asm("v_max3_f32 %0, %1, %2, %3":"=v"(r):"v"(a),"v"(b),"v"(c));return r;}
__device__ __forceinline__ float max2f(float a,float b){float r;asm("v_max_f32_e32 %0, %1, %2":"=v"(r):"v"(a),"v"(b));return r;}
__device__ __forceinline__ float fsub_s(float a,float b){float r;asm("v_sub_f32_e32 %0, %1, %2":"=v"(r):"v"(a),"v"(b));return r;}
typedef float f32x2_t __attribute__((ext_vector_type(2))); typedef __bf16 bf16x2_t __attribute__((ext_vector_type(2)));
__device__ __forceinline__ unsigned cvtpk_s(float lo,float hi){f32x2_t v={lo,hi};bf16x2_t b=__builtin_convertvector(v,bf16x2_t);return __builtin_bit_cast(unsigned,b);}
__device__ __forceinline__ float rbf(float x){return __builtin_bit_cast(float,cvtpk_s(x,0.f)<<16);}
#define WAIT_BAR(N) asm volatile("s_waitcnt vmcnt(" #N ") lgkmcnt(0)\n\ts_barrier":::"memory")

__device__ __forceinline__ void qkt(f32x16&p0,f32x16&p1,const char*Kslot,const bf16x8*qr,int r32,int hi){
  const char*kb=Kslot+hi*1024+r32*16; const f32x16 zf={};
  #pragma unroll
  for(int d0=0;d0<4;++d0){
    const bf16x8 b0=*reinterpret_cast<const bf16x8*>(kb+d0*2048);
    const bf16x8 b1=*reinterpret_cast<const bf16x8*>(kb+d0*2048+512);
    if(d0==0){p0=__builtin_amdgcn_mfma_f32_32x32x16_bf16(b0,qr[0],zf,0,0,0);p1=__builtin_amdgcn_mfma_f32_32x32x16_bf16(b1,qr[0],zf,0,0,0);}
    else{p0=__builtin_amdgcn_mfma_f32_32x32x16_bf16(b0,qr[d0],p0,0,0,0);p1=__builtin_amdgcn_mfma_f32_32x32x16_bf16(b1,qr[d0],p1,0,0,0);}}
  const char*kx=Kslot+8192+r32*16;
  const bf16x8 x0=*reinterpret_cast<const bf16x8*>(kx), x1=*reinterpret_cast<const bf16x8*>(kx+512);
  p0=__builtin_amdgcn_mfma_f32_32x32x16_bf16(x0,qr[4],p0,0,0,0);p1=__builtin_amdgcn_mfma_f32_32x32x16_bf16(x1,qr[4],p1,0,0,0);
}
typedef __attribute__((address_space(3))) const char* lds_cptr;
typedef short v4i16_t __attribute__((ext_vector_type(4)));
__device__ __forceinline__ void kload10(bf16x8*kf,lds_cptr kp,lds_cptr kx){
  kf[0]=*(const __attribute__((address_space(3))) bf16x8*)(kp);      kf[1]=*(const __attribute__((address_space(3))) bf16x8*)(kp+512);
  kf[2]=*(const __attribute__((address_space(3))) bf16x8*)(kp+2048); kf[3]=*(const __attribute__((address_space(3))) bf16x8*)(kp+2560);
  kf[4]=*(const __attribute__((address_space(3))) bf16x8*)(kp+4096); kf[5]=*(const __attribute__((address_space(3))) bf16x8*)(kp+4608);
  kf[6]=*(const __attribute__((address_space(3))) bf16x8*)(kp+6144); kf[7]=*(const __attribute__((address_space(3))) bf16x8*)(kp+6656);
  kf[8]=*(const __attribute__((address_space(3))) bf16x8*)(kx);      kf[9]=*(const __attribute__((address_space(3))) bf16x8*)(kx+512);
}
__device__ __forceinline__ void kload2(bf16x8*kf,lds_cptr kp,int j){ kf[2*j]=*(const __attribute__((address_space(3))) bf16x8*)(kp+j*2048); kf[2*j+1]=*(const __attribute__((address_space(3))) bf16x8*)(kp+j*2048+512); }
__device__ __forceinline__ s16x4 vtr(lds_cptr p){ return __builtin_bit_cast(s16x4,__builtin_amdgcn_ds_read_tr16_b64_v4i16((__attribute__((address_space(3))) v4i16_t*)p)); }
__device__ __forceinline__ float rowmax(const f32x16&p0,const f32x16&p1){
  float a=max3f(p0[0],p0[1],p1[0]),b=max3f(p0[2],p0[3],p1[1]);a=max3f(a,p1[2],p1[3]);
  #pragma unroll
  for(int r=4;r<16;r+=4){a=max3f(a,p0[r],p0[r+1]);b=max3f(b,p0[r+2],p0[r+3]);a=max3f(a,p1[r],p1[r+1]);b=max3f(b,p1[r+2],p1[r+3]);}
  const float m=max2f(a,b);
  auto rr=__builtin_amdgcn_permlane32_swap(__float_as_uint(m),__float_as_uint(m),false,false);
  return max2f(__uint_as_float(rr[0]),__uint_as_float(rr[1]));
}
__device__ __forceinline__ void pv(f32x16*o,int vb,bf16x8 pa0,bf16x8 pa1,bf16x8 pa2,bf16x8 pa3){
  #pragma unroll
  for(int d0=0;d0<2;++d0){s16x4 lo[4],hi[4];
    #pragma unroll
    for(int ks=0;ks<4;++ks){
      asm volatile("ds_read_b64_tr_b16 %0,%1 offset:%c2":"=&v"(lo[ks]):"v"(vb),"i"(d0*4096+ks*1024):"memory");
      asm volatile("ds_read_b64_tr_b16 %0,%1 offset:%c2":"=&v"(hi[ks]):"v"(vb),"i"(d0*4096+ks*1024+512):"memory");}
    asm volatile("s_waitcnt lgkmcnt(0)":::"memory");SBAR();
    #define PK(k) (bf16x8){lo[k][0],lo[k][1],lo[k][2],lo[k][3],hi[k][0],hi[k][1],hi[k][2],hi[k][3]}
    o[d0]=__builtin_amdgcn_mfma_f32_32x32x16_bf16(pa0,PK(0),o[d0],0,0,0);
    o[d0]=__builtin_amdgcn_mfma_f32_32x32x16_bf16(pa1,PK(1),o[d0],0,0,0);
    o[d0]=__builtin_amdgcn_mfma_f32_32x32x16_bf16(pa2,PK(2),o[d0],0,0,0);
    o[d0]=__builtin_amdgcn_mfma_f32_32x32x16_bf16(pa3,PK(3),o[d0],0,0,0);
    #undef PK
  }
}

template<int THRL> __device__ __forceinline__ void attn_unit(char*shm,const int KIND,const hb16*Qc,int qrow,int oslot,const hb16*__restrict__ Kt0,const hb16*__restrict__ Vt0,const hb16*__restrict__ KXt0,int NT,int band0,hb16*Oc,hb16*PO,float*PML){
  const int tid=threadIdx.x,lane=tid&63,r32=lane&31,hi=lane>>5; const int wid=__builtin_amdgcn_readfirstlane(tid>>6);
  const unsigned lds0=(unsigned)(uintptr_t)shm;
  float*wsf=(float*)(shm+LDS_WS)+wid*64;
  const hb16*ksrc=Kt0+(long)lane*PITCH+wid*8;
  const hb16*vsrc=Vt0+(long)(16*(wid&3)+(lane>>2))*PITCH+(wid>>2)*32+(lane&3)*8;
  const hb16*xsrc=KXt0+(long)(8*wid+(lane&7))*8;
  const unsigned kdst=lds0+LDS_K+wid*1024, vdst=lds0+LDS_V+wid*1024, xdst=lds0+LDS_K+8192+wid*128;
  #define DMA_K(t,slot) do{ glds16(ksrc+(long)(t)*KVBLK*PITCH,(unsigned)__builtin_amdgcn_readfirstlane(kdst+(slot))); glds16x(xsrc+(long)(t)*KVBLK*8,(unsigned)__builtin_amdgcn_readfirstlane(xdst+(slot))); }while(0)
  #define DMA_V(t,slot) glds16(vsrc+(long)(t)*KVBLK*PITCH,(unsigned)__builtin_amdgcn_readfirstlane(vdst+(slot)))
  const int vb0=(int)(lds0+LDS_V)+((lane>>4)&1)*32+(lane&3)*8+(4*hi+((lane&15)>>2))*64;
  const char*Kbase=shm+LDS_K; bf16x8 kf[10];
  const lds_cptr shm3=(lds_cptr)shm; const lds_cptr kp0=shm3+LDS_K+hi*1024+r32*16; const lds_cptr kx0=shm3+LDS_K+8192+r32*16; const lds_cptr vp0=shm3+LDS_V+((lane>>4)&1)*32+(lane&3)*8+(4*hi+((lane&15)>>2))*64;
  DMA_K(0,0);DMA_V(0,0);DMA_K(1,SLOTB);
  bf16x8 qr[5];
  { const hb16*Qw=Qc+(long)qrow*PITCH;
    #pragma unroll
    for(int d0=0;d0<4;++d0)qr[d0]=*reinterpret_cast<const bf16x8*>(&Qw[d0*16+hi*8]); }
  float mhat=0.f,l_reg=0.f;f32x16 o[2];o[0]=f32x16{};o[1]=f32x16{};
  #define SETQX(mh_,ml_) do{ const unsigned bh_=cvtpk_s(-(mh_),-(ml_)); u32x4 qx_; qx_.x=0x3F803F80u; qx_.y=0x3F80u|(bh_<<16); qx_.z=(bh_>>16); qx_.w=0u; if(hi){qx_.x=0u;qx_.y=0u;qx_.z=0u;} qr[4]=__builtin_bit_cast(bf16x8,qx_); asm volatile("":"+v"(qr[4])); }while(0)
  #define MOVEREF(gain) const float mraw_=mhat+(gain); const float mh_=rbf(mraw_); const float ml_=rbf(mraw_-mh_); const float mnew_=mh_+ml_; const float dl=mnew_-mhat; mhat=mnew_; SETQX(mh_,ml_);
  SETQX(0.f,0.f);
  const int qrel=wid*QBLK+r32;
  #define CMASK(P0,P1,t) do{int jb_=(t)-band0; if(jb_>=0)cmask(P0,P1,jb_,qrel,hi);}while(0)
  bool resc=false;
  #define START(P0,P1) do{ const float rm=rowmax(P0,P1); resc=false; \
    { MOVEREF(rm) \
      _Pragma("unroll") for(int r=0;r<16;++r){P0[r]=fsub_s(P0[r],dl);P1[r]=fsub_s(P1[r],dl);} } \
    _Pragma("unroll") for(int r=0;r<16;++r)P0[r]=__builtin_amdgcn_exp2f(P0[r]); }while(0)
  #define RESC() do{ if(resc){ asm volatile("s_waitcnt lgkmcnt(0)":::"memory"); \
      _Pragma("unroll") for(int d_=0;d_<2;++d_) _Pragma("unroll") for(int r=0;r<16;++r)o[d_][r]*=wsf[crow(r,hi)]; } }while(0)
  f32x16 pA0,pA1,pB0,pB1;
  int sl_prev=0,sl_cur=0,sl_next=SLOTB;
  #define ROT() do{sl_prev=sl_cur;sl_cur=sl_next;sl_next=(sl_next==(NSLOT-1)*SLOTB)?0:sl_next+SLOTB;}while(0)
  DMA_K(2,2*SLOTB);
  WAIT_BAR(5);
  qkt(pA0,pA1,Kbase,qr,r32,hi);asm volatile("s_nop 15\n\ts_nop 7":"+v"(pA0),"+v"(pA1));CMASK(pA0,pA1,0);
  START(pA0,pA1);
  _Pragma("unroll") for(int r=0;r<16;++r)pA1[r]=__builtin_amdgcn_exp2f(pA1[r]);
  WAIT_BAR(0);
  DMA_K(3,0);DMA_V(1,SLOTB);
  ROT();
  kload10(kf,kp0+sl_cur,kx0+sl_cur);
  WAIT_BAR(3);
  s16x4 vlo[8],vhi[8]; u32x4 pw0,pw1,pw2,pw3; const f32x16 zf={};
  #define PKW(P,B) cvtpk_s(P[B],P[B+1])
  #define PAF(k) __builtin_bit_cast(bf16x8,pw##k)
  #define VFR(i) (bf16x8){vlo[i][0],vlo[i][1],vlo[i][2],vlo[i][3],vhi[i][0],vhi[i][1],vhi[i][2],vhi[i][3]}
  #define PIN(x) asm volatile("":"+v"(x))
  #define MX3(a,b,c) __builtin_fmaxf(__builtin_fmaxf((a),(b)),(c))
  #define GAPA(MF,A0,A1,A2,A3,W0,W1,PW) do{ MF; sacc+=A0; sacc+=A1; sacc+=A2; sacc+=A3; PIN(sacc); W0; W1; PIN(PW); SBAR(); }while(0)
  #define EX(v) __builtin_amdgcn_exp2f(v)
  #define GAPB(MF,X,B) do{ MF; X[B]=EX(X[B]); X[B+1]=EX(X[B+1]); X[B+2]=EX(X[B+2]); X[B+3]=EX(X[B+3]); PIN(X); SBAR(); }while(0)
  #define VRD(i) do{ vlo[i]=vtr(vp_+(((i)>>2)*4096+((i)&3)*1024)); vhi[i]=vtr(vp_+(((i)>>2)*4096+((i)&3)*1024+512)); }while(0)
  #define KRD(G,j) do{ if(G){ kload2(kf,kp0+sl_next,j); SBAR(); } }while(0)
  #define KRDX(G) do{ if(G){ kf[8]=*(const __attribute__((address_space(3))) bf16x8*)(kx0+sl_next); kf[9]=*(const __attribute__((address_space(3))) bf16x8*)(kx0+sl_next+512); SBAR(); } }while(0)
  #define STEP(C0,C1,P0,P1,t,GK,GV,GL) do{ SBAR(); \
    const lds_cptr vp_=vp0+sl_prev; \
    VRD(0); SBAR(); float sacc=(P0[0]+P0[1]); \
    GAPA(C0=__builtin_amdgcn_mfma_f32_32x32x16_bf16(kf[0],qr[0],zf,0,0,0), P0[2],P0[3],P0[4],P0[5],     pw0[0]=PKW(P0,0), pw0[1]=PKW(P0,2), pw0); \
    VRD(4); SBAR(); GAPA(C1=__builtin_amdgcn_mfma_f32_32x32x16_bf16(kf[1],qr[0],zf,0,0,0), P0[6],P0[7],P0[8],P0[9],     pw0[2]=PKW(P0,4), pw0[3]=PKW(P0,6), pw0); \
    VRD(1); SBAR(); GAPA(C0=__builtin_amdgcn_mfma_f32_32x32x16_bf16(kf[2],qr[1],C0,0,0,0),   P0[10],P0[11],P0[12],P0[13], pw1[0]=PKW(P0,8), pw1[1]=PKW(P0,10), pw1); \
    VRD(5); SBAR(); GAPA(C1=__builtin_amdgcn_mfma_f32_32x32x16_bf16(kf[3],qr[1],C1,0,0,0),   P0[14],P0[15],P1[0],P1[1],   pw1[2]=PKW(P0,12),pw1[3]=PKW(P0,14), pw1); \
    VRD(2); SBAR(); GAPA(C0=__builtin_amdgcn_mfma_f32_32x32x16_bf16(kf[4],qr[2],C0,0,0,0),   P1[2],P1[3],P1[4],P1[5],     pw2[0]=PKW(P1,0), pw2[1]=PKW(P1,2), pw2); \
    VRD(6); SBAR(); GAPA(C1=__builtin_amdgcn_mfma_f32_32x32x16_bf16(kf[5],qr[2],C1,0,0,0),   P1[6],P1[7],P1[8],P1[9],     pw2[2]=PKW(P1,4), pw2[3]=PKW(P1,6), pw2); \
    VRD(3); SBAR(); GAPA(C0=__builtin_amdgcn_mfma_f32_32x32x16_bf16(kf[6],qr[3],C0,0,0,0),   P1[10],P1[11],P1[12],P1[13], pw3[0]=PKW(P1,8), pw3[1]=PKW(P1,10), pw3); \
    VRD(7); SBAR(); GAPA(C1=__builtin_amdgcn_mfma_f32_32x32x16_bf16(kf[7],qr[3],C1,0,0,0),   P1[14],P1[15],0.f,0.f,       pw3[2]=PKW(P1,12),pw3[3]=PKW(P1,14), pw3); \
    C0=__builtin_amdgcn_mfma_f32_32x32x16_bf16(kf[8],qr[4],C0,0,0,0); SBAR(); \
    C1=__builtin_amdgcn_mfma_f32_32x32x16_bf16(kf[9],qr[4],C1,0,0,0); SBAR(); \
    l_reg+=sacc; \
    if(GK){DMA_K((t)+3,sl_cur);} if(GV){DMA_V((t)+1,sl_next);} \
    CMASK(C0,C1,t); \
    { float a=MX3(C0[0],C0[1],C1[0]),b=MX3(C0[2],C0[3],C1[1]); a=MX3(a,C1[2],C1[3]); \
      _Pragma("unroll") for(int r=4;r<16;r+=4){a=MX3(a,C0[r],C0[r+1]);b=MX3(b,C0[r+2],C0[r+3]);a=MX3(a,C1[r],C1[r+1]);b=MX3(b,C1[r+2],C1[r+3]);} \
      float rm=__builtin_fmaxf(a,b); { auto rr=__builtin_amdgcn_permlane32_swap(__float_as_uint(rm),__float_as_uint(rm),false,false); rm=__builtin_fmaxf(__uint_as_float(rr[0]),__uint_as_float(rr[1])); } \
      resc=false; \
      if(__builtin_expect(__any(rm>(float)THRL),0)){ MOVEREF(__builtin_fmaxf(rm,0.f)) \
        _Pragma("unroll") for(int r=0;r<16;++r){C0[r]-=dl;C1[r]-=dl;} \
        const float f=__builtin_amdgcn_exp2f(-dl); l_reg*=f; if(hi==0)wsf[r32]=f; resc=true; } } \
    SBAR(); \
    GAPB(o[0]=__builtin_amdgcn_mfma_f32_32x32x16_bf16(PAF(0),VFR(0),o[0],0,0,0), C0,0); \
    GAPB(o[1]=__builtin_amdgcn_mfma_f32_32x32x16_bf16(PAF(0),VFR(4),o[1],0,0,0), C0,4); \
    KRD(GL,0); GAPB(o[0]=__builtin_amdgcn_mfma_f32_32x32x16_bf16(PAF(1),VFR(1),o[0],0,0,0), C0,8); \
    KRD(GL,1); GAPB(o[1]=__builtin_amdgcn_mfma_f32_32x32x16_bf16(PAF(1),VFR(5),o[1],0,0,0), C0,12); \
    KRD(GL,2); GAPB(o[0]=__builtin_amdgcn_mfma_f32_32x32x16_bf16(PAF(2),VFR(2),o[0],0,0,0), C1,0); \
    KRD(GL,3); GAPB(o[1]=__builtin_amdgcn_mfma_f32_32x32x16_bf16(PAF(2),VFR(6),o[1],0,0,0), C1,4); \
    KRDX(GL); GAPB(o[0]=__builtin_amdgcn_mfma_f32_32x32x16_bf16(PAF(3),VFR(3),o[0],0,0,0), C1,8); \
    GAPB(o[1]=__builtin_amdgcn_mfma_f32_32x32x16_bf16(PAF(3),VFR(7),o[1],0,0,0), C1,12); \
    }while(0)
  int t=1;
  for(;t+5<NT&&t+1<band0;t+=2){
    #undef CMASK
    #define CMASK(P0,P1,t) do{}while(0)
    STEP(pB0,pB1,pA0,pA1,t,true,true,true);     WAIT_BAR(3); RESC(); ROT();
    STEP(pA0,pA1,pB0,pB1,t+1,true,true,true);   WAIT_BAR(3); RESC(); ROT();
  }
  #undef CMASK
  #define CMASK(P0,P1,t) do{int jb_=(t)-band0; if(jb_>=0)cmask(P0,P1,jb_,qrel,hi);}while(0)
  #define ENDW(tt) do{ if((tt)+3<NT){WAIT_BAR(3);} else if((tt)+2<NT){WAIT_BAR(1);} else {WAIT_BAR(0);} }while(0)
  for(;t+1<NT;t+=2){
    STEP(pB0,pB1,pA0,pA1,t,(t+3<NT),(t+1<NT),(t+1<NT));       ENDW(t);   RESC(); ROT();
    STEP(pA0,pA1,pB0,pB1,t+1,(t+4<NT),(t+2<NT),(t+2<NT));     ENDW(t+1); RESC(); ROT();
  }
  STEP(pB0,pB1,pA0,pA1,NT-1,false,false,false); RESC();
  { float sacc=pB0[0]+pB0[1]; _Pragma("unroll") for(int r=2;r<16;++r)sacc+=pB0[r]; _Pragma("unroll") for(int r=0;r<16;++r)sacc+=pB1[r]; l_reg+=sacc;
    pw0=(u32x4){PKW(pB0,0),PKW(pB0,2),PKW(pB0,4),PKW(pB0,6)};pw1=(u32x4){PKW(pB0,8),PKW(pB0,10),PKW(pB0,12),PKW(pB0,14)};pw2=(u32x4){PKW(pB1,0),PKW(pB1,2),PKW(pB1,4),PKW(pB1,6)};pw3=(u32x4){PKW(pB1,8),PKW(pB1,10),PKW(pB1,12),PKW(pB1,14)};
    SBAR(); pv(o,vb0+sl_cur,PAF(0),PAF(1),PAF(2),PAF(3)); }
  #undef PKW
  #undef PAF
  #undef VFR
  #undef PIN
  #undef MX3
  #undef GAPA
  #undef GAPB
  #undef EX
  #undef VRD
  #undef KRD
  #undef KRDX
  #undef STEP
  #undef ENDW
  {auto rr=__builtin_amdgcn_permlane32_swap(__float_as_uint(l_reg),__float_as_uint(l_reg),false,false);l_reg=__uint_as_float(rr[0])+__uint_as_float(rr[1]);}
  if(hi==0)wsf[32+r32]=l_reg;asm volatile("s_waitcnt lgkmcnt(0)":::"memory");
  float rli[16];
  #pragma unroll
  for(int r=0;r<16;++r)rli[r]=__builtin_amdgcn_rcpf(wsf[32+crow(r,hi)]);
  if(KIND==1){ if(hi==0&&oslot>=0){ f32x2_t ml={mhat,l_reg}; *(f32x2_t*)(PML+(long)oslot*2)=ml; } }
  { hb16*stg=(hb16*)(shm+LDS_OST)+wid*2048;
    #pragma unroll
    for(int r=0;r<16;++r){const int orow=crow(r,hi);
      #pragma unroll
      for(int d0=0;d0<2;++d0)stg[orow*64+d0*32+r32]=__float2bfloat16(o[d0][r]*rli[r]);}
    asm volatile("s_waitcnt lgkmcnt(0)":::"memory");
    #pragma unroll
    for(int i=0;i<4;++i){const int row=i*8+(lane>>3),ch=lane&7; const u32x4 v=*(const u32x4*)(stg+row*64+ch*8);
      if(KIND==0){ const int gr=__shfl(qrow,row); *(u32x4*)(Oc+(long)gr*PITCH+ch*8)=v; }
      else { const int gs=__shfl(oslot,row); if(gs>=0) *(u32x4*)(PO+(long)gs*64+ch*8)=v; } } }
  asm volatile("s_waitcnt lgkmcnt(0)\n\ts_barrier":::"memory");
  #undef DMA_K
  #undef DMA_V
  #undef CMASK
  #undef START
  #undef RESC
  #undef ROT
  #undef SETQX
  #undef MOVEREF
}
constexpr int ATTN_LDS_BYTES=LDS_BYTES;
#undef SBAR
#undef WAIT_BAR
}

struct WqkOrder {
    int G, c;
    __device__ __forceinline__ bool next(int i, pg8::Unit& u) const { const int L = i * G + c; if (L >= 128) return false; const int z = L >> 2, pn = L & 3, b = z >> 2, h = z & 3;
        u.pm = b * 4 + h; u.pn = pn; u.aoff = ((size_t)(b * 256) * 2048 + h * 256) * 2; u.boff = ((size_t)(pn * 256) * 1024 + h * 256) * 2; return true; }
};
struct VwoOrder {
    int G, c;
    __device__ __forceinline__ bool next(int i, pg8::Unit& u) const { const int L = i * G + c; if (L >= 128) return false; const int z = L >> 2, pmq = L & 3, b = z >> 2, h = z & 3;
        u.pm = b * 4 + pmq; u.pn = h; u.aoff = ((size_t)(pmq * 256) * 1024 + h * 256) * 2; u.boff = ((size_t)(b * 256) * 2048 + 1024 + h * 256) * 2; return true; }
};

#define DECL_PTRS const __attribute__((address_space(4))) Args* KA_; { auto p_ = __builtin_amdgcn_kernarg_segment_ptr(); asm volatile("" : "+s"(p_)); KA_ = (const __attribute__((address_space(4))) Args*)p_; } \
    int tidp_ = threadIdx.x; asm volatile("" : "+v"(tidp_)); const int tid = tidp_, lane = tid & 63; (void)lane; \
    unsigned char* ws = KA_->ws; gu32* ctl = (gu32*)(ws + WS_CTL); const float* x = KA_->in[0]; const float* mem = KA_->in[1]; const float* g_mix = KA_->in[2]; const float* w_in = KA_->in[3]; const float* b_forget = KA_->in[4]; const float* g_fox = KA_->in[5]; const float* g_moba = KA_->in[6]; const float* w_out = KA_->in[7]; const float* g_cross = KA_->in[8]; const float* g_mem = KA_->in[9]; const float* w_q_mem = KA_->in[10]; const float* w_kv_mem = KA_->in[11]; const float* w_o_mem = KA_->in[12]; const float* g_ffn = KA_->in[13]; const float* w_up = KA_->in[14]; const float* conv_w = KA_->in[15]; const float* conv_b = KA_->in[16]; const float* w_down = KA_->in[17]; const float* g_final = KA_->in[18]; float* out = KA_->out; float* LOGF = (float*)(ws + WS_LOGF); float* CC = (float*)(ws + WS_C); float* ABAR = (float*)(ws + WS_ABAR); float* KM = (float*)(ws + WS_KM); unsigned* SEL = (unsigned*)(ws + WS_SEL); float* SSQ1 = (float*)(ws + WS_SSQ1); float* SSQ2 = (float*)(ws + WS_SSQ2); float* SSQ3 = (float*)(ws + WS_SSQ3); bf16* MEMN = (bf16*)(ws + WS_MEMN); bf16* KV = (bf16*)(ws + WS_KV); bf16* WQS = (bf16*)(ws + WS_WQS); bf16* WOT = (bf16*)(ws + WS_WOT); bf16* WKVT = (bf16*)(ws + WS_WKVT); bf16* WINT = (bf16*)(ws + WS_WINT); bf16* WOUTT = (bf16*)(ws + WS_WOUTT); bf16* WUPT = (bf16*)(ws + WS_WUPT); unsigned char* WDT = ws + WS_WDT; unsigned char* ACT8 = ws + WS_ACT8; bf16* ZT = (bf16*)(ws + WS_ZT); bf16* WQK = (bf16*)(ws + WS_WQK); bf16* VWO = (bf16*)(ws + WS_VWO); bf16* A1 = (bf16*)(ws + WS_A1); bf16* QKV = (bf16*)(ws + WS_QKV); bf16* Y = (bf16*)(ws + WS_Y); bf16* HB1 = (bf16*)(ws + WS_HB1); bf16* PB = (bf16*)(ws + WS_P); bf16* HB2 = (bf16*)(ws + WS_HB2); bf16* GB = (bf16*)(ws + WS_G); bf16* UB = (bf16*)(ws + WS_U); bf16* PO = (bf16*)(ws + WS_PO); unsigned* LIST = (unsigned*)(ws + WS_LIST); float* PML = (float*)(ws + WS_PML); bf16* KXF = (bf16*)(ws + WS_KXF); bf16* KXM = (bf16*)(ws + WS_KXM); unsigned* CNT = (unsigned*)(ws + WS_CNT);
__global__ void __launch_bounds__(NWAVES * 64, 2) fwd(Args args) {
    extern __shared__ __attribute__((aligned(16))) unsigned char lds[];
    LAS unsigned char* L = (LAS unsigned char*)lds;
    LAS unsigned char* XL = L + XL_OFF;
    volatile LAS unsigned* MISC = (volatile LAS unsigned*)(L + MISC_OFF);
    const int tid = threadIdx.x, lane = tid & 63, wave = __builtin_amdgcn_readfirstlane(tid >> 6);
    const int G = gridDim.x, bx = blockIdx.x;
    const int gw = bx * NWAVES + wave, NGW = G * NWAVES;
    for (int u = tid; u < (LDS_BYTES - LDSCTL_OFF) / 4; u += NWAVES * 64) ((LAS unsigned*)(L + LDSCTL_OFF))[u] = 0u;
    __syncthreads();
    XcdBarrier bar; { DECL_PTRS; bar = xcd_barrier_post((unsigned*)(ctl + CW_BAR), MISC + 8); }

    { DECL_PTRS;
        LAS float* scr = (LAS float*)(L + RING_OFF + wave * 16384);
        constexpr int I_IN = (D / 64) * (NQKV / 32), I_OUT = (D / 64) * (D / 32), I_KV = (D / 64) * (2048 / 32), I_O = I_OUT, I_UP = (D / 64) * (2 * FF / 32), I_DN = (FF / 64) * (D / 32);
        constexpr int NITEMS = I_IN + I_OUT + I_KV + I_O + I_UP + I_DN;
        for (int it = gw; it < NITEMS; it += NGW) {
            int r = it;
            if (r < I_IN) { p0_transpose_item(w_in, INC, D, NQKV, WINT, nullptr, true, scr, r, lane); continue; } r -= I_IN;
            if (r < I_OUT) { p0_transpose_item(w_out, D, D, D, WOUTT, nullptr, false, scr, r, lane); continue; } r -= I_OUT;
            if (r < I_KV) { p0_transpose_item(w_kv_mem, 2048, D, 2048, WKVT, nullptr, false, scr, r, lane); continue; } r -= I_KV;
            if (r < I_O) { p0_transpose_item(w_o_mem, D, D, D, WOT, nullptr, false, scr, r, lane); continue; } r -= I_O;
            if (r < I_UP) { p0_transpose_item(w_up, 2 * FF, D, 2 * FF, WUPT, g_ffn, false, scr, r, lane); continue; } r -= I_UP;
            p0_transpose_item(w_down, D, FF, D, (bf16*)WDT, nullptr, false, scr, r, lane, 64.0f);
        }
        for (int i = bx * 512 + tid; i < D * D / 4; i += G * 512) { const int kk = (i * 4) >> 10; const f32x4 v = *(const f32x4*)(w_q_mem + (size_t)i * 4) * (g_cross[kk] * (LOG2E / 16.0f));
            *(unsigned long long*)(WQS + (size_t)i * 4) = (unsigned long long)pk2(v[0], v[1]) | ((unsigned long long)pk2(v[2], v[3]) << 32); }
        for (int r = gw; r < NB * 256; r += NGW) { const GAS f32x4* xr = (const GAS f32x4*)(mem + (size_t)r * D) + lane; f32x4 v[4]; float s = 0.f;
#pragma unroll
            for (int j = 0; j < 4; ++j) { v[j] = xr[64 * j]; s += (v[j][0] * v[j][0] + v[j][1] * v[j][1]) + (v[j][2] * v[j][2] + v[j][3] * v[j][3]); }
            const float rs = __builtin_amdgcn_rsqf(wave_sum(s) * (1.f / D) + RMS_EPS);
            GAS unsigned long long* o8 = (GAS unsigned long long*)(MEMN + (size_t)r * D) + lane;
#pragma unroll
            for (int j = 0; j < 4; ++j) { const f32x4 gg = *((const f32x4*)g_mem + 64 * j + lane); const f32x4 a = v[j] * rs * gg; o8[64 * j] = (unsigned long long)pk2(a[0], a[1]) | ((unsigned long long)pk2(a[2], a[3]) << 32); } }
        __syncthreads();
        LAS float* part = (LAS float*)(L + RING_OFF + 32768);
        f32x4 wfr[4][4][2];
#pragma unroll
        for (int j = 0; j < 4; ++j)
#pragma unroll
            for (int i = 0; i < 4; ++i) { const float* wp = w_in + (size_t)(256 * j + 4 * lane + i) * INC + C_F; wfr[j][i][0] = *(const f32x4*)wp; wfr[j][i][1] = *(const f32x4*)(wp + 4); }
        f32x4 gm[4];
#pragma unroll
        for (int j = 0; j < 4; ++j) gm[j] = *((const f32x4*)g_mix + 64 * j + lane);
        for (int blk = bx; blk < M / 256; blk += G) {
            f32x4 accm[4];
#pragma unroll
            for (int j = 0; j < 4; ++j) accm[j] = (f32x4){0.f, 0.f, 0.f, 0.f};
            for (int i0 = 0; i0 < 32; i0 += 2) {
              f32x4 vv[2][4];
#pragma unroll
              for (int rr = 0; rr < 2; ++rr) { const GAS f32x4* xr = (const GAS f32x4*)(x + ((size_t)blk * 256 + wave * 32 + i0 + rr) * D) + lane;
#pragma unroll
                  for (int j = 0; j < 4; ++j) vv[rr][j] = xr[64 * j]; }
#pragma unroll
              for (int rr = 0; rr < 2; ++rr) {
                const size_t r = (size_t)blk * 256 + wave * 32 + i0 + rr;
                f32x4 v[4]; float s = 0.f;
#pragma unroll
                for (int j = 0; j < 4; ++j) { v[j] = vv[rr][j]; s += (v[j][0] * v[j][0] + v[j][1] * v[j][1]) + (v[j][2] * v[j][2] + v[j][3] * v[j][3]); }
                const float rs = __builtin_amdgcn_rsqf(wave_sum(s) * (1.f / D) + RMS_EPS);
                GAS unsigned long long* o8 = (GAS unsigned long long*)(A1 + r * 2048) + lane;
                float fl[8];
#pragma unroll
                for (int h = 0; h < 8; ++h) fl[h] = 0.f;
#pragma unroll
                for (int j = 0; j < 4; ++j) { const f32x4 a = v[j] * rs * gm[j]; accm[j] += a;
                    const unsigned h0 = pk2(a[0], a[1]), h1 = pk2(a[2], a[3]);
                    o8[64 * j] = (unsigned long long)h0 | ((unsigned long long)h1 << 32);
                    const unsigned l0 = pk2(a[0] - bflo(h0), a[1] - bfhi(h0)), l1 = pk2(a[2] - bflo(h1), a[3] - bfhi(h1));
                    o8[256 + 64 * j] = (unsigned long long)l0 | ((unsigned long long)l1 << 32);
#pragma unroll
                    for (int i = 0; i < 4; ++i)
#pragma unroll
                        for (int h = 0; h < 8; ++h) fl[h] += a[i] * wfr[j][i][h >> 2][h & 3]; }
                float t4[4], t2[2], z;
                { const bool up = (lane & 32) != 0;
#pragma unroll
                  for (int k = 0; k < 4; ++k) { const float snd = up ? fl[k] : fl[k + 4]; const float rcv = __shfl_xor(snd, 32); t4[k] = (up ? fl[k + 4] : fl[k]) + rcv; } }
                { const bool up = (lane & 16) != 0;
#pragma unroll
                  for (int k = 0; k < 2; ++k) { const float snd = up ? t4[k] : t4[k + 2]; const float rcv = __shfl_xor(snd, 16); t2[k] = (up ? t4[k + 2] : t4[k]) + rcv; } }
                { const bool up = (lane & 8) != 0; const float snd = up ? t2[0] : t2[1]; const float rcv = __shfl_xor(snd, 8); z = (up ? t2[1] : t2[0]) + rcv; }
                z += __shfl_xor(z, 1); z += __shfl_xor(z, 2); z += __shfl_xor(z, 4);
                if ((lane & 7) == 0) { const int hh = 4 * (lane >> 5) + 2 * ((lane >> 4) & 1) + ((lane >> 3) & 1);
                    z += b_forget[hh];
                    LOGF[r * 8 + hh] = fminf(z, 0.f) - log1pf(__expf(-fabsf(z))); }
              }
            }
#pragma unroll
            for (int j = 0; j < 4; ++j) *((LAS f32x4*)(part + wave * 1024) + 64 * j + lane) = accm[j];
            __syncthreads();
            for (int col = tid; col < 1024; col += 512) { float s = 0.f;
#pragma unroll
                for (int w = 0; w < 8; ++w) s += part[w * 1024 + col];
                ABAR[(size_t)blk * 1024 + col] = s * (1.0f / 256.0f); }
            __syncthreads();
        }
    }
    xcd_barrier(bar);

    { DECL_PTRS;
        LAS float* sc = (LAS float*)(L + RING_OFF);
        for (int w = (bx + G - 64) % G; w < 64; w += G) {
            const int b = w >> 3, h = w & 7; float v[16]; float run = 0.f;
#pragma unroll
            for (int i = 0; i < 16; ++i) { run += LOGF[((size_t)b * T + tid * 16 + i) * 8 + h]; v[i] = run; }
            float incl = run;
#pragma unroll
            for (int o = 1; o < 64; o <<= 1) { const float n = __shfl_up(incl, o); if (lane >= o) incl += n; }
            if (lane == 63) sc[wave] = incl;
            __syncthreads();
            float pre = incl - run;
            for (int ww = 0; ww < wave; ++ww) pre += sc[ww];
#pragma unroll
            for (int i = 0; i < 16; ++i) CC[(size_t)w * T + tid * 16 + i] = pre + v[i];
            __syncthreads();
        }
        for (int w = bx; w < 64; w += G) {
            const int ib = w >> 3, jb = w & 7, r = tid >> 4, cq = tid & 15; LAS float* As = sc; LAS float* Bs = sc + 32 * 33;
            f32x4 acc = (f32x4){0.f, 0.f, 0.f, 0.f};
            for (int k0 = 0; k0 < 1024; k0 += 32) {
                { const int idx = tid * 2, row = idx >> 5, kk = idx & 31; const pg8::f32x2 a2 = *(const pg8::f32x2*)(ABAR + (size_t)(ib * 32 + row) * 1024 + k0 + kk); As[row * 33 + kk] = a2.x; As[row * 33 + kk + 1] = a2.y; }
                { const int idx = tid * 4, kk = idx >> 6, c = idx & 63; *(LAS f32x4*)(Bs + kk * 64 + c) = *(const f32x4*)(w_in + (size_t)(k0 + kk) * INC + C_KM + jb * 64 + c); }
                __syncthreads();
#pragma unroll 8
                for (int kk = 0; kk < 32; ++kk) acc += *(const LAS f32x4*)(Bs + kk * 64 + cq * 4) * As[r * 33 + kk];
                __syncthreads();
            }
            *(f32x4*)(KM + (size_t)(ib * 32 + r) * 512 + jb * 64 + cq * 4) = acc;
        }
        pg8::Gemm g{MEMN, WKVT, D / 64, D * 2, D * 2, 0xffffffffu}; pg8::TileOrder S; S.init(NB * 256, 2048, G, (bx + G - 128) % G, D * 2, D * 2, 0, 1 << 30);
        pg8::EpiBf16 E{KV, 2048, 0u, 1.f, nullptr};
        pg8::gemm_phase<pg8::EpiBf16, pg8::TileOrder, true>(L + RING_OFF, XL, g, S, E);
    }
    xcd_barrier(bar);

    { DECL_PTRS;
        LAS float* sc = (LAS float*)(L + RING_OFF);
        for (int w = bx; w < 64; w += G) {
            const int h = w >> 3, kq = w & 7, kk = kq * 128 + (tid & 127), ng = tid >> 7;
            for (int i = tid; i < 256 * 16; i += 512) { const int n = i >> 4, c4 = (i & 15) * 4; *(LAS f32x4*)(sc + n * 64 + c4) = *(const f32x4*)(KM + (size_t)n * 512 + h * 64 + c4); }
            f32x4 wq[16];
#pragma unroll
            for (int c = 0; c < 16; ++c) wq[c] = *(const f32x4*)(w_in + (size_t)kk * INC + C_QM + h * 64 + c * 4);
            __syncthreads();
            for (int i = 0; i < 64; ++i) { const int n = ng * 64 + i; const LAS f32x4* kp = (const LAS f32x4*)(sc + n * 64); float s0 = 0.f, s1 = 0.f;
#pragma unroll
                for (int c = 0; c < 16; c += 2) { const f32x4 ka = kp[c], kb = kp[c + 1];
                    s0 += (wq[c][0] * ka[0] + wq[c][1] * ka[1]) + (wq[c][2] * ka[2] + wq[c][3] * ka[3]); s1 += (wq[c + 1][0] * kb[0] + wq[c + 1][1] * kb[1]) + (wq[c + 1][2] * kb[2] + wq[c + 1][3] * kb[3]); }
                const float sv = s0 + s1; const unsigned hi = f2bf(sv); const unsigned lo = f2bf(sv - bf2f(hi));
                bf16* zr = ZT + ((size_t)(n >> 5) * 256 + h * 32 + (n & 31)) * 3072; zr[kk] = (bf16)hi; zr[1024 + kk] = (bf16)hi; zr[2048 + kk] = (bf16)lo; }
            __syncthreads();
        }
        for (int i = bx * 512 + tid; i < 64 * T + 8 * 256; i += G * 512) {
            float bv; bf16* dst;
            if (i < 64 * T) { bv = -CC[i] * LOG2E; dst = KXF + (size_t)i * 8; }
            else { const int j = i - 64 * T; bv = __builtin_amdgcn_exp2f(-(float)((j >> 8) + 1)) * LOG2E * (float)(j & 255); dst = KXM + (size_t)j * 8; }
            const unsigned h0 = f2bf(bv); const float r1 = bv - bf2f(h0); const unsigned h1 = f2bf(r1); const unsigned h2 = f2bf(r1 - bf2f(h1));
            *(v4u*)dst = (v4u){h0 | (h1 << 16), h2 | (0x3F80u << 16), 0x3F80u, 0u}; }
        { pg8::Gemm g{KV, WQS, 4, 4096, 2048, 0xffffffffu}; WqkOrder S{G, bx}; pg8::EpiF8 E{(unsigned char*)WQK, 1024, 32.0f};
          pg8::gemm_phase<pg8::EpiF8, WqkOrder, true>(L + RING_OFF, XL, g, S, E); }
        { pg8::Gemm g{WOT, KV, 4, 2048, 4096, 0xffffffffu}; VwoOrder S{G, (bx + 128) % G}; pg8::EpiF8 E{(unsigned char*)VWO, 1024, 4.0f};
          pg8::gemm_phase<pg8::EpiF8, VwoOrder, true>(L + RING_OFF, XL, g, S, E); }
    }
    xcd_barrier(bar);

    { DECL_PTRS;
        { pg8::Gemm g{A1, WINT, D / 64, 4096, D * 2, 0xffffffffu}; pg8::TileOrder S; S.init(M, NQKV, G, bx, 4096, D * 2, 0, 1 << 30);
          pg8::EpiBf16 E{QKV, NQKV, 0xC3u, C2, (unsigned*)(ctl + CW_QKN)};
          pg8::gemm_phase<pg8::EpiBf16, pg8::TileOrder, true>(L + RING_OFF, XL, g, S, E); }
        { pg8::Gemm g{A1, ZT, 3072 / 64, 4096, 6144, 4095u}; pg8::TileOrder S; S.init(M, 256, G, bx, 4096, 6144, (size_t)256 * 6144, 32);
          pg8::EpiGate E{SEL};
          pg8::gemm_phase<pg8::EpiGate, pg8::TileOrder, true>(L + RING_OFF, XL, g, S, E); }
    }
    xcd_barrier(bar);

    { DECL_PTRS;
        for (int e = bx * 512 + tid; e < 2048; e += G * 512) { const int bh = e >> 5, qb = e & 31;
            const float thr = skip_thr((const unsigned*)(ctl + CW_QKN) + bh * 8, 0) * (1.0f / LOG2E);
            const float* crow_ = CC + (size_t)bh * T; const int t0 = qb * 256; const float target = crow_[t0] + thr;
            int lo = 0, hi2 = t0;
            while (lo < hi2) { const int mid = (lo + hi2) >> 1; if (crow_[mid] >= target) lo = mid + 1; else hi2 = mid; }
            ((int*)(ctl + CW_T0TAB))[e] = (lo >> 6) & ~1; }
        LAS unsigned* wc = (LAS unsigned*)(L + RING_OFF);
        for (int w = bx; w < 2048; w += G) {
            const int bh = (w & 255) >> 2, n = (w & 3) + 4 * (w >> 8), trip = bh * 32 + n; const unsigned* selrow = SEL + (size_t)bh * T; unsigned base = 0u;
            const float mthr = skip_thr((const unsigned*)(ctl + CW_QKN) + bh * 8, 1); const int hh = bh & 7;
            for (int t0 = (n + 1) * 256; t0 < T; t0 += 2048) {
                unsigned m[4], mo[4]; unsigned long long bal[4];
#pragma unroll
                for (int j = 0; j < 4; ++j) { const int t = t0 + j * 512 + tid; m[j] = 0u; if (t < T) m[j] = selrow[t]; mo[j] = m[j]; if (moba_skip(hh, t >> 8, n, mthr)) m[j] &= ~(1u << n); }
#pragma unroll
                for (int j = 0; j < 4; ++j) { bal[j] = __ballot((m[j] >> n) & 1u); if (lane == 0) wc[j * 8 + wave] = (unsigned)__popcll(bal[j]); }
                __syncthreads();
                unsigned run = base;
#pragma unroll
                for (int j = 0; j < 4; ++j) { unsigned pre = 0u, tot = 0u;
#pragma unroll
                    for (int ww = 0; ww < 8; ++ww) { const unsigned c = wc[j * 8 + ww]; tot += c; if (ww < wave) pre += c; }
                    if ((m[j] >> n) & 1u) { const unsigned pos = run + pre + (unsigned)__popcll(bal[j] & ((1ull << lane) - 1ull)); const unsigned k = (unsigned)__popc(mo[j] & ((1u << n) - 1u));
                        LIST[(size_t)trip * 8192 + pos] = (unsigned)(t0 + j * 512 + tid) | (k << 16); }
                    run += tot; }
                base = run;
                __syncthreads();
            }
            if (tid == 0) CNT[trip] = base;
        }
    }
    xcd_barrier(bar);

    { DECL_PTRS;
        LAS int* upre = (LAS int*)(L + RING_OFF + attn_body::ATTN_LDS_BYTES);
        LAS int* wsum = upre + 2052;
        { int c4[4]; int run = 0;
#pragma unroll
          for (int i = 0; i < 4; ++i) { c4[i] = run; run += (int)((CNT[tid * 4 + i] + 255u) >> 8); }
          int incl = run;
#pragma unroll
          for (int o = 1; o < 64; o <<= 1) { const int nn = __shfl_up(incl, o); if (lane >= o) incl += nn; }
          if (lane == 63) wsum[wave] = incl;
          __syncthreads();
          int pre = incl - run;
          for (int ww = 0; ww < wave; ++ww) pre += wsum[ww];
#pragma unroll
          for (int i = 0; i < 4; ++i) upre[tid * 4 + i] = pre + c4[i];
          if (tid == 511) upre[2048] = pre + run;
          __syncthreads(); }
        const int ntot = 4096 + upre[2048];
        const attn_body::hb16* Qb = (const attn_body::hb16*)QKV;
        const int r32 = lane & 31;
        LAS unsigned* qnext = (LAS unsigned*)(wsum + 16);
        unsigned* qhead = (unsigned*)(ctl + CW_QUEUE);
        if (tid == 0) qnext[0] = atomicAdd(qhead, 1u);
        __syncthreads();
        for (;;) {
            const int u = (int)qnext[0];
            if (u >= ntot) break;
            __syncthreads();
            unsigned nxt_ = 0u; if (tid == 0) nxt_ = atomicAdd(qhead, 1u);
            int kind, qrow, oslot = -1, NT, band0; const attn_body::hb16 *Qc, *Kt0, *Vt0, *KXt0;
            if (u < 2048) {
                const int qb = 31 - (u >> 6), bh = u & 63;
                const int b = bh >> 3, h = bh & 7;
                const int T0 = ((const int*)(ctl + CW_T0TAB))[bh * 32 + qb];
                kind = 0; qrow = b * T + qb * 256 + wave * 32 + r32; NT = 4 * (qb + 1) - T0; band0 = NT - 4;
                Qc = Qb + h * 64; Kt0 = Qb + (size_t)(b * T + T0 * 64) * NQKV + 512 + h * 64; Vt0 = Kt0 + 512; KXt0 = (const attn_body::hb16*)KXF + ((size_t)bh * T + T0 * 64) * 8;
            } else if (u < 4096) {
                const int w = u - 2048, bh = w >> 5, j = w & 31, b = bh >> 3, h = bh & 7;
                kind = 1; qrow = b * T + j * 256 + wave * 32 + r32; oslot = (qrow * 8 + h) * 4 + 3; NT = 4; band0 = 0;
                Qc = Qb + 1536 + h * 64; Kt0 = Qb + (size_t)(b * T + j * 256) * NQKV + 2048 + h * 64; Vt0 = Kt0 + 512; KXt0 = (const attn_body::hb16*)KXM + h * 256 * 8;
            } else {
                const int g = u - 4096; int lo = 0, hi2 = 2048;
                while (hi2 - lo > 1) { const int mid = (lo + hi2) >> 1; if (upre[mid] <= g) lo = mid; else hi2 = mid; }
                const int w = lo, c = g - upre[lo], bh = w >> 5, n = w & 31, b = bh >> 3, h = bh & 7; const int cnt = (int)CNT[w];
                int idx = c * 256 + wave * 32 + r32; const bool valid = idx < cnt; if (!valid) idx = cnt - 1;
                const unsigned e = LIST[(size_t)w * 8192 + idx];
                kind = 1; qrow = b * T + (int)(e & 0xffffu); oslot = valid ? (qrow * 8 + h) * 4 + (int)(e >> 16) : -1; NT = 4; band0 = 1 << 20;
                Qc = Qb + 1536 + h * 64; Kt0 = Qb + (size_t)(b * T + n * 256) * NQKV + 2048 + h * 64; Vt0 = Kt0 + 512; KXt0 = (const attn_body::hb16*)KXM + h * 256 * 8;
            }
            attn_body::attn_unit<8>((char*)lds + RING_OFF, kind, Qc, qrow, oslot, Kt0, Vt0, KXt0, NT, band0, (attn_body::hb16*)QKV + (Qc - Qb), (attn_body::hb16*)PO, PML);
            if (tid == 0) qnext[0] = nxt_;
            __syncthreads();
        }
    }
    xcd_barrier(bar);

    { DECL_PTRS;
    const f32x4 ga0 = *((const f32x4*)g_fox + 2 * lane), ga1 = *((const f32x4*)g_fox + 2 * lane + 1), gb0 = *((const f32x4*)g_moba + 2 * lane), gb1 = *((const f32x4*)g_moba + 2 * lane + 1);
    const int h = lane >> 3, cc = lane & 7; const float s2 = __builtin_amdgcn_exp2f(-(float)(h + 1)) * LOG2E * 256.0f;
    float mthr[NB];
#pragma unroll
    for (int b = 0; b < NB; ++b) mthr[b] = skip_thr((const unsigned*)(ctl + CW_QKN) + (b * 8 + h) * 8, 1);
    for (int r0 = gw * 2; r0 < M; r0 += NGW * 2) {
        v4u wa[2], pw[2][4]; unsigned mmv[2]; pg8::f32x2 ml[2][4];
#pragma unroll
        for (int rr = 0; rr < 2; ++rr) { const int r = r0 + rr, b = r >> 13, t = r & (T - 1); const size_t sb = ((size_t)r * 8 + h) * 4;
            wa[rr] = *((const v4u*)(QKV + (size_t)r * NQKV) + lane); mmv[rr] = SEL[((size_t)(b * 8 + h)) * T + t];
#pragma unroll
            for (int k = 0; k < 4; ++k) { ml[rr][k] = *(const pg8::f32x2*)(PML + (sb + k) * 2); pw[rr][k] = *((const v4u*)(PO + (sb + k) * 64) + cc); } }
#pragma unroll
        for (int rr = 0; rr < 2; ++rr) { const int r = r0 + rr, t = r & (T - 1), own = t >> 8;
            const float a[8] = {bflo(wa[rr].x), bfhi(wa[rr].x), bflo(wa[rr].y), bfhi(wa[rr].y), bflo(wa[rr].z), bfhi(wa[rr].z), bflo(wa[rr].w), bfhi(wa[rr].w)};
            float c[8]; unsigned mm = mmv[rr]; const int cnt = __popc(mm);
            float mk[4], lk[4];
#pragma unroll
            for (int k = 0; k < 4; ++k) { mk[k] = ml[rr][k].x; lk[k] = ml[rr][k].y; }
            mk[3] += s2 * (float)own; float Mx = mk[3];
            bool vk[4]; vk[3] = true; float thb = mthr[0];
#pragma unroll
            for (int b = 1; b < NB; ++b) thb = ((r >> 13) == b) ? mthr[b] : thb;
#pragma unroll
            for (int k = 0; k < 3; ++k) { vk[k] = false; if (k < cnt) { const int nb = __ffs(mm) - 1; mm &= mm - 1u; vk[k] = !moba_skip(h, own, nb, thb); if (vk[k]) { mk[k] += s2 * (float)nb; Mx = fmaxf(Mx, mk[k]); } } }
            float W = 0.f;
#pragma unroll
            for (int i = 0; i < 8; ++i) c[i] = 0.f;
#pragma unroll
            for (int k = 0; k < 4; ++k) { if (vk[k]) { const float w = lk[k] * __builtin_amdgcn_exp2f(mk[k] - Mx); W += w; const v4u p = pw[rr][k];
                c[0] += w * bflo(p.x); c[1] += w * bfhi(p.x); c[2] += w * bflo(p.y); c[3] += w * bfhi(p.y); c[4] += w * bflo(p.z); c[5] += w * bfhi(p.z); c[6] += w * bflo(p.w); c[7] += w * bfhi(p.w); } }
            const float iw = 1.0f / W;
#pragma unroll
            for (int i = 0; i < 8; ++i) c[i] *= iw;
            float sa = 0.f, sb2 = 0.f;
#pragma unroll
            for (int i = 0; i < 8; ++i) { sa += a[i] * a[i]; sb2 += c[i] * c[i]; }
            const float ra = __builtin_amdgcn_rsqf(wave_sum(sa) * (1.f / 512.f) + RMS_EPS), rb = __builtin_amdgcn_rsqf(wave_sum(sb2) * (1.f / 512.f) + RMS_EPS);
            v4u oa, ob;
            oa.x = pk2(a[0] * ra * ga0[0], a[1] * ra * ga0[1]); oa.y = pk2(a[2] * ra * ga0[2], a[3] * ra * ga0[3]); oa.z = pk2(a[4] * ra * ga1[0], a[5] * ra * ga1[1]); oa.w = pk2(a[6] * ra * ga1[2], a[7] * ra * ga1[3]);
            ob.x = pk2(c[0] * rb * gb0[0], c[1] * rb * gb0[1]); ob.y = pk2(c[2] * rb * gb0[2], c[3] * rb * gb0[3]); ob.z = pk2(c[4] * rb * gb1[0], c[5] * rb * gb1[1]); ob.w = pk2(c[6] * rb * gb1[2], c[7] * rb * gb1[3]);
            *((v4u*)(Y + (size_t)r * D) + lane) = oa; *((v4u*)(Y + (size_t)r * D + 512) + lane) = ob; }
    } }
    xcd_barrier(bar);

    { DECL_PTRS; pg8::Gemm g{Y, WOUTT, D / 64, D * 2, D * 2, 0xffffffffu}; pg8::TileOrder S; S.init(M, D, G, bx, D * 2, D * 2, 0, 1 << 30);
      pg8::EpiRes<false, false> E{x, nullptr, nullptr, HB1, ws + WS_HB1F, SSQ1, 1.0f};
      pg8::gemm_phase<pg8::EpiRes<false, false>, pg8::TileOrder, true>(L + RING_OFF, XL, g, S, E); }
    xcd_barrier(bar);

    { DECL_PTRS; pg8::Gemm g{ws + WS_HB1F, WQK, D / 128, D, D, 0xffffffffu}; pg8::TileOrder S; S.init(M, D, G, bx, D, D, (size_t)D * D, 32);
      pg8::EpiSoftmax E{(unsigned char*)PB, SSQ1, 1.0f / 32.0f};
      pg8::gemm_phase<pg8::EpiSoftmax, pg8::TileOrder, true, true>(L + RING_OFF, XL, g, S, E); }
    xcd_barrier(bar);

    { DECL_PTRS; pg8::Gemm g{PB, VWO, D / 128, D, D, 0xffffffffu}; pg8::TileOrder S; S.init(M, D, G, bx, D, D, (size_t)D * D, 32);
      pg8::EpiRes<true, true> E{nullptr, HB1, out, HB2, nullptr, SSQ2, 1.0f / 1024.0f};
      pg8::gemm_phase<pg8::EpiRes<true, true>, pg8::TileOrder, true, true>(L + RING_OFF, XL, g, S, E); }
    xcd_barrier(bar);

    { DECL_PTRS; pg8::Gemm g{HB2, WUPT, D / 64, D * 2, D * 2, 0xffffffffu}; pg8::TileOrder S; S.init(M, 2 * FF, G, bx, D * 2, D * 2, 0, 1 << 30);
      pg8::EpiUp E{GB, UB, SSQ2};
      pg8::gemm_phase<pg8::EpiUp, pg8::TileOrder, true>(L + RING_OFF, XL, g, S, E); }
    xcd_barrier(bar);

    { DECL_PTRS;
    for (int it = bx * 512 + tid; it < (M / 32) * (FF / 8); it += G * 512) {
        const int rc = it / (FF / 8), cg = (it - rc * (FF / 8)) * 8; const size_t r0 = (size_t)rc * 32; const int tt0 = (int)(r0 & (T - 1));
        float w0[8], w1[8], w2[8], cb[8], g0[8], g1[8];
#pragma unroll
        for (int q = 0; q < 2; ++q) { const f32x4 a0 = *(const f32x4*)(conv_w + cg + 4 * q), a1 = *(const f32x4*)(conv_w + FF + cg + 4 * q), a2 = *(const f32x4*)(conv_w + 2 * FF + cg + 4 * q), bb = *(const f32x4*)(conv_b + cg + 4 * q);
#pragma unroll
            for (int e = 0; e < 4; ++e) { w0[4 * q + e] = a0[e]; w1[4 * q + e] = a1[e]; w2[4 * q + e] = a2[e]; cb[4 * q + e] = bb[e]; } }
        if (tt0 >= 2) { const v4u p1 = *(const v4u*)(GB + (r0 - 1) * FF + cg), p0 = *(const v4u*)(GB + (r0 - 2) * FF + cg);
            g1[0] = bflo(p1.x); g1[1] = bfhi(p1.x); g1[2] = bflo(p1.y); g1[3] = bfhi(p1.y); g1[4] = bflo(p1.z); g1[5] = bfhi(p1.z); g1[6] = bflo(p1.w); g1[7] = bfhi(p1.w);
            g0[0] = bflo(p0.x); g0[1] = bfhi(p0.x); g0[2] = bflo(p0.y); g0[3] = bfhi(p0.y); g0[4] = bflo(p0.z); g0[5] = bfhi(p0.z); g0[6] = bflo(p0.w); g0[7] = bfhi(p0.w); }
        else {
#pragma unroll
            for (int e = 0; e < 8; ++e) { g0[e] = 0.f; g1[e] = 0.f; } }
        for (int i0 = 0; i0 < 32; i0 += 8) {
            v4u gq[8], uq[8];
#pragma unroll
            for (int k = 0; k < 8; ++k) { const size_t off = (r0 + i0 + k) * FF + cg; gq[k] = *(const v4u*)(GB + off); uq[k] = *(const v4u*)(UB + off); }
#pragma unroll
            for (int k = 0; k < 8; ++k) { const size_t off = (r0 + i0 + k) * FF + cg; const v4u gw2 = gq[k], uw = uq[k];
                const float g2[8] = {bflo(gw2.x), bfhi(gw2.x), bflo(gw2.y), bfhi(gw2.y), bflo(gw2.z), bfhi(gw2.z), bflo(gw2.w), bfhi(gw2.w)};
                const float uu[8] = {bflo(uw.x), bfhi(uw.x), bflo(uw.y), bfhi(uw.y), bflo(uw.z), bfhi(uw.z), bflo(uw.w), bfhi(uw.w)};
                float res[8];
#pragma unroll
                for (int e = 0; e < 8; ++e) { const float gc = cb[e] + w0[e] * g0[e] + w1[e] * g1[e] + w2[e] * g2[e];
                    res[e] = gc * __builtin_amdgcn_rcpf(1.0f + __builtin_amdgcn_exp2f(-LOG2E * gc)) * uu[e]; g0[e] = g1[e]; g1[e] = g2[e]; }
                *(unsigned long long*)(ACT8 + off) = (unsigned long long)pg8::pk4_fp8(res[0], res[1], res[2], res[3]) | ((unsigned long long)pg8::pk4_fp8(res[4], res[5], res[6], res[7]) << 32); } }
    } }
    xcd_barrier(bar);

    { DECL_PTRS; pg8::Gemm g{ACT8, WDT, FF / 128, FF, FF, 0xffffffffu}; pg8::TileOrder S; S.init(M, D, G, bx, FF, FF, 0, 1 << 30);
      pg8::EpiResNorm E{out, out, g_final, 1.0f / 64.0f, SSQ3, (unsigned*)(ctl + CW_PANEL), (unsigned*)(ctl + CW_TMO2)};
      pg8::gemm_phase<pg8::EpiResNorm, pg8::TileOrder, true, true>(L + RING_OFF, XL, g, S, E); }
}

extern "C" void kernel_launch(void* const* d_in, const int* in_sizes, int n_in, void* d_out, int out_size, void* d_ws, size_t ws_size, hipStream_t stream) {
    static int grid = 0;
    if (grid == 0) {
        if (n_in != 19 || in_sizes[0] != M * D || out_size != M * D || ws_size < WS_END) { fprintf(stderr, "kernel_launch: unexpected problem shape (n_in %d, in0 %d, out %d, ws %zu); nothing launched\n", n_in, n_in > 0 ? in_sizes[0] : -1, out_size, ws_size); grid = -1; return; }
        int dev = 0, cus = 0, per_cu = 0;
        if (hipGetDevice(&dev) != hipSuccess || hipDeviceGetAttribute(&cus, hipDeviceAttributeMultiprocessorCount, dev) != hipSuccess) { grid = -1; return; }
        if (hipFuncSetAttribute((const void*)fwd, hipFuncAttributeMaxDynamicSharedMemorySize, LDS_BYTES) != hipSuccess) { fprintf(stderr, "kernel_launch: hipFuncSetAttribute failed\n"); grid = -1; return; }
        if (hipOccupancyMaxActiveBlocksPerMultiprocessor(&per_cu, (const void*)fwd, NWAVES * 64, LDS_BYTES) != hipSuccess || per_cu < 1) { fprintf(stderr, "kernel_launch: occupancy query reports %d\n", per_cu); }
        (void)hipGetLastError();
        grid = cus;
    }
    if (grid < 0) return;
    if (hipMemsetAsync((char*)d_ws + WS_CTL, 0, CTL_ZERO_BYTES, stream) != hipSuccess) return;
    Args a{};
    for (int i = 0; i < 19; ++i) a.in[i] = (const float*)d_in[i];
    a.out = (float*)d_out; a.ws = (unsigned char*)d_ws;
    hipLaunchKernelGGL(fwd, dim3(grid), dim3(NWAVES * 64), LDS_BYTES, stream, a);
}
```

```cpp
#include <hip/hip_runtime.h>
#include <hip/hip_bf16.h>
#include <cstdio>
#include <cstdint>

namespace pg8 {
#define PG8_LAS __attribute__((address_space(3)))
typedef unsigned short bf16_t;
typedef short bf16x8 __attribute__((ext_vector_type(8)));
typedef float f32x4 __attribute__((ext_vector_type(4)));
typedef float f32x2 __attribute__((ext_vector_type(2)));
typedef unsigned u32x4 __attribute__((ext_vector_type(4)));
typedef unsigned u32x2 __attribute__((ext_vector_type(2)));
typedef int i32x4 __attribute__((ext_vector_type(4)));
typedef int i32x8 __attribute__((ext_vector_type(8)));
constexpr int BM = 256, BK = 64, HALF = 128, HTB = HALF * BK * 2  , STAGE_BYTES = 8 * HTB, NXCD = 8, WGM = 8;

__host__ __device__ __forceinline__ int lds_byte(int r, int c) { const int st = (r >> 4) * 2 + (c >> 5), rr = r & 15, cc = c & 31, ob = rr * 64 + cc * 2; return st * 1024 + (ob ^ (((ob >> 9) & 1) << 5)); }
__host__ __device__ __forceinline__ void stage_rc(int b, int& R, int& C) { const int st = b / 1024, sb = b % 1024, swz = sb ^ (((sb >> 9) & 1) << 5); R = (st >> 1) * 16 + swz / 64; C = (st & 1) * 32 + (swz % 64) / 2; }
__host__ __device__ __forceinline__ int perm32(int rho) { const int n = rho >> 4, i = rho & 15; return 8 * (i >> 2) + 4 * n + (i & 3); }

struct Unit { int pm, pn; size_t aoff, boff; };
struct Gemm { const void* A; const void* Bt; int nt, lda, ldb; unsigned wrapmask; };

struct TileOrder {
    int nM, nN, nwg, G, c; size_t a_tile, b_tile, b_batch; int pmb;
    __device__ __forceinline__ void init(int M, int N, int G_, int c_, int lda_bytes, int ldb_bytes, size_t b_batch_bytes, int pm_per_batch) {
        nM = M / BM; nN = N / BM; nwg = nM * nN; G = G_; c = c_; a_tile = (size_t)BM * lda_bytes; b_tile = (size_t)BM * ldb_bytes; b_batch = b_batch_bytes; pmb = pm_per_batch; }
    __device__ __forceinline__ bool next(int i, Unit& u) const {
        const long L = (long)i * G + c; if (L >= nwg) return false;
        int wgid = (int)L; { const int q = nwg / NXCD, r = nwg % NXCD, xcd = wgid % NXCD, off = wgid / NXCD; wgid = (xcd < r ? xcd * (q + 1) : r * (q + 1) + (xcd - r) * q) + off; }
        const int nig = WGM * nN, gid = wgid / nig, fm = gid * WGM, gsz = (nM - fm) < WGM ? (nM - fm) : WGM;
        u.pm = fm + ((wgid % nig) % gsz); u.pn = (wgid % nig) / gsz;
        u.aoff = (size_t)u.pm * a_tile; u.boff = (size_t)u.pn * b_tile + (size_t)(u.pm / pmb) * b_batch; return true;
    }
};

__device__ __forceinline__ unsigned cvt_pk_bf16(float lo, float hi) { unsigned r; asm volatile("v_cvt_pk_bf16_f32 %0, %1, %2" : "=v"(r) : "v"(lo), "v"(hi)); return r; }

typedef f32x4 AccT[2][2][4][2];

struct EpiBf16 {
    static constexpr bool PERM = true;
    bf16_t* O; int ldc; unsigned scalemask; float scale0; unsigned* nrm;
    __device__ __forceinline__ void operator()(AccT& acc, const Unit& u, int wr, int wc, int fr, int fq, PG8_LAS unsigned char*) const {
        const int row0 = u.pm * BM + wr * 64 + fr, col0 = u.pn * BM + wc * 32 + 8 * fq;
        const float sc = ((scalemask >> u.pn) & 1u) ? scale0 : 1.f;
        if (nrm && (u.pn < 4 || (u.pn >= 6 && u.pn < 10))) {
#pragma unroll
            for (int bj = 0; bj < 2; ++bj) { float mx = 0.f;
#pragma unroll
                for (int ai = 0; ai < 2; ++ai)
#pragma unroll
                    for (int m = 0; m < 4; ++m) { const f32x4 v0 = acc[ai][bj][m][0] * sc, v1 = acc[ai][bj][m][1] * sc;
                        float q = (v0[0] * v0[0] + v0[1] * v0[1]) + (v0[2] * v0[2] + v0[3] * v0[3]) + (v1[0] * v1[0] + v1[1] * v1[1]) + (v1[2] * v1[2] + v1[3] * v1[3]);
                        q += __shfl_xor(q, 16); q += __shfl_xor(q, 32); mx = fmaxf(mx, q); }
                mx = fmaxf(mx, __shfl_xor(mx, 1)); mx = fmaxf(mx, __shfl_xor(mx, 2)); mx = fmaxf(mx, __shfl_xor(mx, 4)); mx = fmaxf(mx, __shfl_xor(mx, 8));
                if (fr == 0 && fq == 0) { const int head = (u.pn & 1) * 4 + 2 * bj + (wc >> 1); const int grp = u.pn < 4 ? (u.pn >> 1) : (u.pn >> 1) - 1; atomicMax(nrm + (((u.pm >> 5) * 8 + head) * 4 + grp) * 2 + (wc & 1), __float_as_uint(mx)); } } }
#pragma unroll
        for (int ai = 0; ai < 2; ++ai)
#pragma unroll
            for (int m = 0; m < 4; ++m) { bf16_t* rowp = O + (size_t)(row0 + ai * HALF + m * 16) * ldc + col0;
#pragma unroll
                for (int bj = 0; bj < 2; ++bj) { const f32x4 v0 = acc[ai][bj][m][0] * sc, v1 = acc[ai][bj][m][1] * sc;
                    u32x4 w; w.x = cvt_pk_bf16(v0[0], v0[1]); w.y = cvt_pk_bf16(v0[2], v0[3]); w.z = cvt_pk_bf16(v1[0], v1[1]); w.w = cvt_pk_bf16(v1[2], v1[3]);
                    *(u32x4*)(rowp + bj * HALF) = w; } }
    }
};
__device__ __forceinline__ unsigned pk4_fp8(float a, float b, float c, float d) { int w = 0; w = __builtin_amdgcn_cvt_pk_fp8_f32(a, b, w, false); w = __builtin_amdgcn_cvt_pk_fp8_f32(c, d, w, true); return (unsigned)w; }
struct EpiF8 {
    static constexpr bool PERM = true;
    unsigned char* O; int ldc; float sc;
    __device__ __forceinline__ void operator()(AccT& acc, const Unit& u, int wr, int wc, int fr, int fq, PG8_LAS unsigned char*) const {
        const int row0 = u.pm * BM + wr * 64 + fr, col0 = u.pn * BM + wc * 32 + 8 * fq;
#pragma unroll
        for (int ai = 0; ai < 2; ++ai)
#pragma unroll
            for (int m = 0; m < 4; ++m) { unsigned char* rowp = O + (size_t)(row0 + ai * HALF + m * 16) * ldc + col0;
#pragma unroll
                for (int bj = 0; bj < 2; ++bj) { const f32x4 v0 = acc[ai][bj][m][0] * sc, v1 = acc[ai][bj][m][1] * sc;
                    *(u32x2*)(rowp + bj * HALF) = (u32x2){pk4_fp8(v0[0], v0[1], v0[2], v0[3]), pk4_fp8(v1[0], v1[1], v1[2], v1[3])}; } }
    }
};
__device__ __forceinline__ float rstd_from_slots(const float* slots) {
    const f32x4 a = *(const f32x4*)slots, b = *(const f32x4*)(slots + 4), c = *(const f32x4*)(slots + 8), d = *(const f32x4*)(slots + 12);
    const float s = ((a[0] + a[1]) + (a[2] + a[3])) + ((b[0] + b[1]) + (b[2] + b[3])) + ((c[0] + c[1]) + (c[2] + c[3])) + ((d[0] + d[1]) + (d[2] + d[3]));
    return __builtin_amdgcn_rsqf(s * (1.0f / 1024.0f) + 1e-6f);
}
#define PG8_DPP(old, src, ctrl) __builtin_bit_cast(float, __builtin_amdgcn_update_dpp(__builtin_bit_cast(int, (float)(old)), __builtin_bit_cast(int, (float)(src)), (ctrl), 0xf, 0xf, false))
struct EpiConv {
    static constexpr bool PERM = true;
    unsigned char* act; const float* ssq; const float* cw; const float* cbias; float* GH; float* UH; float* GT;
    __device__ __forceinline__ void operator()(AccT& acc, const Unit& u, int wr, int wc, int fr, int fq, PG8_LAS unsigned char* xl) const {
        PG8_LAS float* H = (PG8_LAS float*)xl;
        const int cl = wc * 32 + 8 * fq;
        const int row0 = u.pm * BM + wr * 64 + fr;
        PG8_LAS float* Sr = H + 1024;
        { const int t_ = threadIdx.x; if (t_ < 256) Sr[t_] = rstd_from_slots(ssq + (size_t)(u.pm * BM + t_) * 16); }
        asm volatile("s_waitcnt vmcnt(0) lgkmcnt(0)" ::: "memory"); __builtin_amdgcn_s_barrier(); asm volatile("" ::: "memory");
#pragma unroll
        for (int ai = 0; ai < 2; ++ai)
#pragma unroll
            for (int m = 0; m < 4; ++m) { const float rs = Sr[ai * HALF + wr * 64 + m * 16 + fr];
#pragma unroll
                for (int bj = 0; bj < 2; ++bj)
#pragma unroll
                    for (int n = 0; n < 2; ++n) acc[ai][bj][m][n] *= rs; }
        const size_t sb = ((size_t)(u.pm * 22 + u.pn) * 2) * 128 + cl;
        if (fr >= 14) {
#pragma unroll
            for (int ai = 0; ai < 2; ++ai)
#pragma unroll
                for (int n = 0; n < 2; ++n) *(PG8_LAS f32x4*)(H + ((ai * 2 + wr) * 2 + (fr - 14)) * 128 + cl + 4 * n) = acc[ai][0][3][n];
            if (wr == 1) {
#pragma unroll
                for (int n = 0; n < 2; ++n) *(f32x4*)(GT + sb + (fr - 14) * 128 + 4 * n) = acc[1][0][3][n]; } }
        if (wr == 0 && fr < 2) {
#pragma unroll
            for (int n = 0; n < 2; ++n) { *(f32x4*)(GH + sb + fr * 128 + 4 * n) = acc[0][0][0][n]; *(f32x4*)(UH + sb + fr * 128 + 4 * n) = acc[0][1][0][n]; } }
        asm volatile("s_waitcnt lgkmcnt(0)" ::: "memory"); __builtin_amdgcn_s_barrier(); asm volatile("" ::: "memory");
#pragma unroll
        for (int n = 0; n < 2; ++n) {
            const int c0 = u.pn * 128 + cl + 4 * n;
            const f32x4 w0 = *(const f32x4*)(cw + c0), w1 = *(const f32x4*)(cw + 2816 + c0), w2 = *(const f32x4*)(cw + 2 * 2816 + c0), cbv = *(const f32x4*)(cbias + c0);
#pragma unroll
            for (int ai = 0; ai < 2; ++ai) {
                const int hsrc = wr == 1 ? ai * 2 : (ai == 1 ? 1 : 0);
                const f32x4 h14 = *(const PG8_LAS f32x4*)(H + (hsrc * 2 + 0) * 128 + cl + 4 * n), h15 = *(const PG8_LAS f32x4*)(H + (hsrc * 2 + 1) * 128 + cl + 4 * n);
#pragma unroll
                for (int m = 3; m >= 0; --m) {
                    float res[4];
#pragma unroll
                    for (int i = 0; i < 4; ++i) { const float X = acc[ai][0][m][n][i];
                        float o1, o2;
                        if (m > 0) { const float Xp = acc[ai][0][m > 0 ? m - 1 : 0][n][i]; o1 = PG8_DPP(0.f, Xp, 0x121); o2 = PG8_DPP(0.f, Xp, 0x122); }
                        else { o1 = h15[i]; o2 = fr == 0 ? h14[i] : h15[i]; }
                        const float g1 = PG8_DPP(o1, X, 0x111), g0 = PG8_DPP(o2, X, 0x112);
                        const float gc = cbv[i] + w0[i] * g0 + w1[i] * g1 + w2[i] * X;
                        res[i] = gc * __builtin_amdgcn_rcpf(1.0f + __builtin_amdgcn_exp2f(-1.4426950408889634f * gc)) * acc[ai][1][m][n][i]; }
                    const int row = row0 + ai * HALF + m * 16;
                    if (!(ai == 0 && m == 0 && wr == 0 && fr < 2))
                        *(unsigned*)(act + (size_t)row * 2816 + c0) = pk4_fp8(res[0], res[1], res[2], res[3]);
                } } }
    }
};
template <bool BASEB, bool OUTF> struct EpiRes {
    static constexpr bool PERM = true;
    const float* base; const bf16_t* baseb; float* out; bf16_t* hb; unsigned char* hb8; float* ssq; float accs;
    __device__ __forceinline__ void operator()(AccT& acc, const Unit& u, int wr, int wc, int fr, int fq, PG8_LAS unsigned char*) const {
        const int row0 = u.pm * BM + wr * 64 + fr, col0 = u.pn * BM + wc * 32 + 8 * fq;
#pragma unroll
        for (int ai = 0; ai < 2; ++ai)
#pragma unroll
            for (int m = 0; m < 4; ++m) { const int row = row0 + ai * HALF + m * 16; const size_t off = (size_t)row * 1024 + col0; float q = 0.f;
#pragma unroll
                for (int bj = 0; bj < 2; ++bj) {
                    f32x4 b0, b1;
                    if constexpr (BASEB) { const u32x4 bw = *(const u32x4*)(baseb + off + bj * HALF);
                        b0 = (f32x4){__builtin_bit_cast(float, bw.x << 16), __builtin_bit_cast(float, bw.x & 0xffff0000u), __builtin_bit_cast(float, bw.y << 16), __builtin_bit_cast(float, bw.y & 0xffff0000u)};
                        b1 = (f32x4){__builtin_bit_cast(float, bw.z << 16), __builtin_bit_cast(float, bw.z & 0xffff0000u), __builtin_bit_cast(float, bw.w << 16), __builtin_bit_cast(float, bw.w & 0xffff0000u)}; }
                    else { b0 = *(const f32x4*)(base + off + bj * HALF); b1 = *(const f32x4*)(base + off + bj * HALF + 4); }
                    const f32x4 v0 = acc[ai][bj][m][0] * accs + b0, v1 = acc[ai][bj][m][1] * accs + b1;
                    if constexpr (OUTF) { *(f32x4*)(out + off + bj * HALF) = v0; *(f32x4*)(out + off + bj * HALF + 4) = v1; }
                    q += (v0[0] * v0[0] + v0[1] * v0[1]) + (v0[2] * v0[2] + v0[3] * v0[3]) + (v1[0] * v1[0] + v1[1] * v1[1]) + (v1[2] * v1[2] + v1[3] * v1[3]);
                    if (hb) { u32x4 w; w.x = cvt_pk_bf16(v0[0], v0[1]); w.y = cvt_pk_bf16(v0[2], v0[3]); w.z = cvt_pk_bf16(v1[0], v1[1]); w.w = cvt_pk_bf16(v1[2], v1[3]); *(u32x4*)(hb + off + bj * HALF) = w; }
                    if (hb8) *(u32x2*)(hb8 + off + bj * HALF) = (u32x2){pk4_fp8(v0[0], v0[1], v0[2], v0[3]), pk4_fp8(v1[0], v1[1], v1[2], v1[3])}; }
                q += __shfl_xor(q, 16); q += __shfl_xor(q, 32);
                if (fq == 0) ssq[(size_t)row * 16 + u.pn * 4 + wc] = q; }
    }
};
struct EpiResNorm {
    static constexpr bool PERM = true;
    const float* base; float* out; const float* gfin; float accs; float* xbuf; unsigned* cnt; unsigned* tmo;
    __device__ __forceinline__ void operator()(AccT& acc, const Unit& u, int wr, int wc, int fr, int fq, PG8_LAS unsigned char* xl) const {
        PG8_LAS float* Pp = (PG8_LAS float*)xl;
        PG8_LAS float* Sr = Pp + 1024;
        PG8_LAS unsigned* flag = (PG8_LAS unsigned*)(Sr + 256);
        const int tid = threadIdx.x, wid = tid >> 6, lane = tid & 63;
        const int row0 = u.pm * BM + wr * 64 + fr, col0 = u.pn * BM + wc * 32 + 8 * fq;
#pragma unroll
        for (int ai = 0; ai < 2; ++ai)
#pragma unroll
            for (int m = 0; m < 4; ++m) { const int row = row0 + ai * HALF + m * 16; const size_t off = (size_t)row * 1024 + col0; float q = 0.f;
#pragma unroll
                for (int bj = 0; bj < 2; ++bj) {
                    const f32x4 b0 = *(const f32x4*)(base + off + bj * HALF), b1 = *(const f32x4*)(base + off + bj * HALF + 4);
                    const f32x4 v0 = acc[ai][bj][m][0] * accs + b0, v1 = acc[ai][bj][m][1] * accs + b1; acc[ai][bj][m][0] = v0; acc[ai][bj][m][1] = v1;
                    q += (v0[0] * v0[0] + v0[1] * v0[1]) + (v0[2] * v0[2] + v0[3] * v0[3]) + (v1[0] * v1[0] + v1[1] * v1[1]) + (v1[2] * v1[2] + v1[3] * v1[3]); }
                q += __shfl_xor(q, 16); q += __shfl_xor(q, 32);
                if (fq == 0) Pp[(ai * HALF + wr * 64 + m * 16 + fr) * 4 + wc] = q; }
        asm volatile("s_waitcnt lgkmcnt(0)" ::: "memory"); __builtin_amdgcn_s_barrier(); asm volatile("" ::: "memory");
        if (wid < 4) { const int r = wid * 64 + lane; const f32x4 p = *(const PG8_LAS f32x4*)(Pp + r * 4);
            __hip_atomic_store(xbuf + (size_t)(u.pm * BM + r) * 4 + u.pn, (p[0] + p[1]) + (p[2] + p[3]), __ATOMIC_RELAXED, __HIP_MEMORY_SCOPE_AGENT);
            asm volatile("s_waitcnt vmcnt(0)" ::: "memory");
            if (lane == 0) __hip_atomic_fetch_add(cnt + 64 * u.pm, 1u, __ATOMIC_RELAXED, __HIP_MEMORY_SCOPE_AGENT); }
        if (wid == 0) { unsigned sp = 0u; bool dead = false;
            for (;;) { if ((unsigned)__builtin_amdgcn_readfirstlane(__hip_atomic_load(cnt + 64 * u.pm, __ATOMIC_RELAXED, __HIP_MEMORY_SCOPE_AGENT)) >= 16u) break;
                if (++sp > (1u << 20)) { if (lane == 0) __hip_atomic_store(tmo, 1u, __ATOMIC_RELAXED, __HIP_MEMORY_SCOPE_AGENT); dead = true; break; }
                __builtin_amdgcn_s_sleep(2); }
            __builtin_amdgcn_fence(__ATOMIC_ACQUIRE, "agent");
            if (lane == 0) flag[0] = dead ? 1u : 0u; }
        asm volatile("s_waitcnt vmcnt(0) lgkmcnt(0)" ::: "memory"); __builtin_amdgcn_s_barrier(); asm volatile("" ::: "memory");
        if (wid < 4) { const int r = wid * 64 + lane; const float* xs = xbuf + (size_t)(u.pm * BM + r) * 4; float s = 0.f;
#pragma unroll
            for (int t = 0; t < 4; ++t) s += __hip_atomic_load(xs + t, __ATOMIC_RELAXED, __HIP_MEMORY_SCOPE_AGENT);
            Sr[r] = __builtin_amdgcn_rsqf(s * (1.0f / 1024.0f) + 1e-6f); }
        asm volatile("s_waitcnt vmcnt(0) lgkmcnt(0)" ::: "memory"); __builtin_amdgcn_s_barrier(); asm volatile("" ::: "memory");
        f32x4 gg[2][2];
#pragma unroll
        for (int bj = 0; bj < 2; ++bj) { gg[bj][0] = *(const f32x4*)(gfin + col0 + bj * HALF); gg[bj][1] = *(const f32x4*)(gfin + col0 + bj * HALF + 4); }
#pragma unroll
        for (int ai = 0; ai < 2; ++ai)
#pragma unroll
            for (int m = 0; m < 4; ++m) { const int rl = ai * HALF + wr * 64 + m * 16 + fr; const float rs = Sr[rl]; const size_t off = (size_t)(u.pm * BM + rl) * 1024 + col0;
#pragma unroll
                for (int bj = 0; bj < 2; ++bj) { *(f32x4*)(out + off + bj * HALF) = acc[ai][bj][m][0] * rs * gg[bj][0]; *(f32x4*)(out + off + bj * HALF + 4) = acc[ai][bj][m][1] * rs * gg[bj][1]; } }
    }
};
struct EpiSoftmax {
    static constexpr bool PERM = true;
    unsigned char* P; const float* ssq; float sscale;
    __device__ __forceinline__ void operator()(AccT& acc, const Unit& u, int wr, int wc, int fr, int fq, PG8_LAS unsigned char* xl) const {
        PG8_LAS f32x2* X = (PG8_LAS f32x2*)xl;
        const int row0 = u.pm * BM + wr * 64 + fr, col0 = u.pn * BM + wc * 32 + 8 * fq;
        float ml[2][4];
#pragma unroll
        for (int ai = 0; ai < 2; ++ai)
#pragma unroll
            for (int m = 0; m < 4; ++m) { const int row = row0 + ai * HALF + m * 16; const float rs = rstd_from_slots(ssq + (size_t)row * 16) * sscale;
                float mx = -3.0e38f;
#pragma unroll
                for (int bj = 0; bj < 2; ++bj)
#pragma unroll
                    for (int n = 0; n < 2; ++n) { f32x4 v = acc[ai][bj][m][n] * rs; acc[ai][bj][m][n] = v; mx = fmaxf(fmaxf(mx, fmaxf(v[0], v[1])), fmaxf(v[2], v[3])); }
                mx = fmaxf(mx, __shfl_xor(mx, 16)); mx = fmaxf(mx, __shfl_xor(mx, 32));
                float s = 0.f;
#pragma unroll
                for (int bj = 0; bj < 2; ++bj)
#pragma unroll
                    for (int n = 0; n < 2; ++n) { f32x4 v = acc[ai][bj][m][n];
                        v[0] = __builtin_amdgcn_exp2f(v[0] - mx); v[1] = __builtin_amdgcn_exp2f(v[1] - mx); v[2] = __builtin_amdgcn_exp2f(v[2] - mx); v[3] = __builtin_amdgcn_exp2f(v[3] - mx);
                        acc[ai][bj][m][n] = v; s += (v[0] + v[1]) + (v[2] + v[3]); }
                s += __shfl_xor(s, 16); s += __shfl_xor(s, 32);
                ml[ai][m] = mx;
                if (fq == 0) X[(ai * HALF + wr * 64 + m * 16 + fr) * 4 + wc] = (f32x2){mx, s}; }
        asm volatile("s_waitcnt lgkmcnt(0)" ::: "memory"); __builtin_amdgcn_s_barrier(); asm volatile("" ::: "memory");
#pragma unroll
        for (int ai = 0; ai < 2; ++ai)
#pragma unroll
            for (int m = 0; m < 4; ++m) { const int rl = ai * HALF + wr * 64 + m * 16 + fr; const int row = u.pm * BM + rl;
                const f32x2 a = X[rl * 4 + 0], b = X[rl * 4 + 1], c = X[rl * 4 + 2], d = X[rl * 4 + 3];
                const float Mx = fmaxf(fmaxf(a.x, b.x), fmaxf(c.x, d.x));
                const float L = a.y * __builtin_amdgcn_exp2f(a.x - Mx) + b.y * __builtin_amdgcn_exp2f(b.x - Mx) + c.y * __builtin_amdgcn_exp2f(c.x - Mx) + d.y * __builtin_amdgcn_exp2f(d.x - Mx);
                const float f = __builtin_amdgcn_exp2f(ml[ai][m] - Mx) * __builtin_amdgcn_rcpf(L) * 256.0f;
                unsigned char* rowp = P + (size_t)row * 1024 + col0;
#pragma unroll
                for (int bj = 0; bj < 2; ++bj) { const f32x4 v0 = acc[ai][bj][m][0] * f, v1 = acc[ai][bj][m][1] * f;
                    *(u32x2*)(rowp + bj * HALF) = (u32x2){pk4_fp8(v0[0], v0[1], v0[2], v0[3]), pk4_fp8(v1[0], v1[1], v1[2], v1[3])}; } }
    }
};
struct EpiGate {
    static constexpr bool PERM = false;
    unsigned* sel;
    __device__ __forceinline__ void operator()(AccT& acc, const Unit& u, int wr, int wc, int fr, int fq, PG8_LAS unsigned char*) const {
        const int own = u.pm & 31;
#pragma unroll
        for (int ai = 0; ai < 2; ++ai)
#pragma unroll
            for (int m = 0; m < 4; ++m) { const int row = u.pm * BM + ai * HALF + wr * 64 + m * 16 + fr;
#pragma unroll
                for (int bj = 0; bj < 2; ++bj) { unsigned mask = 0u;
#pragma unroll
                    for (int round = 0; round < 3; ++round) { float bv = -3.0e38f; int bi = 32;
#pragma unroll
                        for (int n = 0; n < 2; ++n)
#pragma unroll
                            for (int i = 0; i < 4; ++i) { const int nb = 16 * n + 4 * fq + i; const float v = acc[ai][bj][m][n][i];
                                if (nb < own && !((mask >> nb) & 1u) && v > bv) { bv = v; bi = nb; } }
#pragma unroll
                        for (int off = 16; off <= 32; off <<= 1) { const float ov = __shfl_xor(bv, off); const int oi = __shfl_xor(bi, off); if (ov > bv || (ov == bv && oi < bi)) { bv = ov; bi = oi; } }
                        if (bi < 32) mask |= 1u << bi; }
                    if (fq == 0) sel[((size_t)((u.pm >> 5) * 8 + 4 * bj + wc)) * 8192 + (row & 8191)] = mask; } }
    }
};

template <class Epi, class Sched, bool ALIGN_EPI, bool F8 = false>
__device__ __forceinline__ void gemm_phase(PG8_LAS unsigned char* lds, PG8_LAS unsigned char* xl, const Gemm g, const Sched& S, const Epi& E) {
    int tid_ = threadIdx.x; asm volatile("" : "+v"(tid_));
    const int tid = tid_, wid = __builtin_amdgcn_readfirstlane(tid >> 6), lane = tid & 63, wr = wid >> 2, wc = wid & 3, fr = lane & 15, fq = lane >> 4;
    int nt = g.nt; asm volatile("" : "+s"(nt));
    unsigned voffA[2], voffB[2];
#pragma unroll
    for (int i = 0; i < 2; ++i) { int R, C; stage_rc(tid * 16 + i * 8192, R, C); const int Rb = Epi::PERM ? ((R & ~31) + perm32(R & 31)) : R;
        voffA[i] = (unsigned)(R * g.lda + C * 2); voffB[i] = (unsigned)(Rb * g.ldb + C * 2); }
    const size_t kstep = (size_t)(BK * 2);
    const size_t hstepA = (size_t)HALF * g.lda, hstepB = (size_t)HALF * g.ldb;
    const unsigned wmask = g.wrapmask;
    const unsigned ldsw = (unsigned)wid * 1024u;
    const int aoff = lds_byte(wr * 64 + fr, fq * 8), boff = lds_byte(wc * 32 + fr, fq * 8);
#define PG8_SA(b, h) (((b) * 2 + (h)) * HTB)
#define PG8_SB(b, h) ((4 + (b) * 2 + (h)) * HTB)
#define PG8_STAGE(bufoff, gbase, voff) do { _Pragma("unroll") for (int _i = 0; _i < 2; ++_i) \
        __builtin_amdgcn_global_load_lds((const unsigned*)((const char*)(gbase) + (voff)[_i]), (PG8_LAS unsigned*)(lds + (bufoff) + ldsw + _i * 8192), 16, 0, 0); } while (0)
#define PG8_LDA(dst, b, h) do { if constexpr (F8) { _Pragma("unroll") for (int m = 0; m < 4; ++m) { dst##8[m].lo = *(const PG8_LAS i32x4*)(lds + PG8_SA(b, h) + aoff + m * 2048); dst##8[m].hi = *(const PG8_LAS i32x4*)(lds + PG8_SA(b, h) + aoff + m * 2048 + 1024); } } \
        else { _Pragma("unroll") for (int m = 0; m < 4; ++m) _Pragma("unroll") for (int k = 0; k < 2; ++k) dst[m][k] = *(const PG8_LAS bf16x8*)(lds + PG8_SA(b, h) + aoff + m * 2048 + k * 1024); } } while (0)
#define PG8_LDB(dst, b, h) do { if constexpr (F8) { _Pragma("unroll") for (int n = 0; n < 2; ++n) { dst##8[n].lo = *(const PG8_LAS i32x4*)(lds + PG8_SB(b, h) + boff + n * 2048); dst##8[n].hi = *(const PG8_LAS i32x4*)(lds + PG8_SB(b, h) + boff + n * 2048 + 1024); } } \
        else { _Pragma("unroll") for (int n = 0; n < 2; ++n) _Pragma("unroll") for (int k = 0; k < 2; ++k) dst[n][k] = *(const PG8_LAS bf16x8*)(lds + PG8_SB(b, h) + boff + n * 2048 + k * 1024); } } while (0)
#define PG8_MMA(ai, bj, At, Bt) do { __builtin_amdgcn_s_setprio(1); \
        if constexpr (F8) { _Pragma("unroll") for (int m = 0; m < 4; ++m) _Pragma("unroll") for (int n = 0; n < 2; ++n) \
            asm volatile("v_mfma_f32_16x16x128_f8f6f4 %0, %1, %2, %0" : "+v"(acc[ai][bj][m][n]) : "v"(Bt##8[n]), "v"(At##8[m])); } \
        else { _Pragma("unroll") for (int m = 0; m < 4; ++m) _Pragma("unroll") for (int n = 0; n < 2; ++n) _Pragma("unroll") for (int k = 0; k < 2; ++k) \
            acc[ai][bj][m][n] = __builtin_amdgcn_mfma_f32_16x16x32_bf16(Bt[n][k], At[m][k], acc[ai][bj][m][n], 0, 0, 0); } \
        __builtin_amdgcn_s_setprio(0); } while (0)
#define PG8_WAIT_V(n) asm volatile("s_waitcnt vmcnt(" #n ")" ::: "memory")
#define PG8_WAIT_L(n) asm volatile("s_waitcnt lgkmcnt(" #n ")" ::: "memory")
#define PG8_BAR __builtin_amdgcn_s_barrier()
#define PG8_SCHED __builtin_amdgcn_sched_barrier(0)
    Unit cur, nxt; int ui = 0;
    if (!S.next(0, cur)) return;
    AccT acc;
    bf16x8 At[4][2], B0[2][2], B1[2][2]; i32x8 At8[4], B08[2], B18[2];
    const char* cA = (const char*)g.A + cur.aoff; const char* cB = (const char*)g.Bt + cur.boff;
    PG8_STAGE(PG8_SB(0, 0), cB, voffB); PG8_STAGE(PG8_SB(0, 1), cB + hstepB, voffB); PG8_STAGE(PG8_SA(0, 0), cA, voffA); PG8_STAGE(PG8_SA(0, 1), cA + hstepA, voffA);
    if (wr == 1) PG8_BAR;
    PG8_WAIT_V(2); PG8_BAR;
    PG8_STAGE(PG8_SB(1, 0), cB + kstep, voffB); PG8_STAGE(PG8_SA(1, 0), cA + kstep, voffA); PG8_STAGE(PG8_SB(1, 1), cB + hstepB + kstep, voffB);
    PG8_WAIT_V(6); PG8_BAR;
    { float z0; asm volatile("v_mov_b32 %0, 0" : "=v"(z0));
#pragma unroll
    for (int a = 0; a < 2; ++a)
#pragma unroll
        for (int b = 0; b < 2; ++b)
#pragma unroll
            for (int m = 0; m < 4; ++m)
#pragma unroll
                for (int n = 0; n < 2; ++n) acc[a][b][m][n] = (f32x4){z0, z0, z0, z0}; }
    for (;;) {
        const bool has_next = S.next(ui + 1, nxt);
        const char* nA = has_next ? (const char*)g.A + nxt.aoff : cA; const char* nB = has_next ? (const char*)g.Bt + nxt.boff : cB;
#pragma unroll 1
        for (int t = 0; t < nt; t += 2) {
            const bool last = (t == nt - 2);
            const char* a1 = cA + (size_t)((unsigned)(t * 128) & wmask) + kstep;
            const char* a2 = last ? nA : cA + (size_t)((unsigned)((t + 2) * 128) & wmask); const char* b2 = last ? nB : cB + (size_t)(t + 2) * kstep;
            const char* a3 = a2 + kstep; const char* b3 = b2 + kstep;
            PG8_LDB(B0, 0, 0); PG8_LDB(B1, 0, 1); PG8_SCHED; PG8_LDA(At, 0, 0); PG8_STAGE(PG8_SA(1, 1), a1 + hstepA, voffA);
            PG8_WAIT_V(8); PG8_WAIT_L(0); PG8_BAR; PG8_MMA(0, 0, At, B0); PG8_MMA(0, 1, At, B1); PG8_BAR; PG8_SCHED;
            PG8_LDA(At, 0, 1); PG8_STAGE(PG8_SB(0, 0), b2, voffB); PG8_STAGE(PG8_SB(0, 1), b2 + hstepB, voffB); PG8_STAGE(PG8_SA(0, 0), a2, voffA);
            PG8_WAIT_V(8); PG8_WAIT_L(0); PG8_BAR; PG8_MMA(1, 0, At, B0); PG8_MMA(1, 1, At, B1); PG8_BAR; PG8_SCHED;
            PG8_LDB(B0, 1, 0); PG8_LDB(B1, 1, 1); PG8_SCHED; PG8_LDA(At, 1, 0); PG8_STAGE(PG8_SA(0, 1), a2 + hstepA, voffA);
            PG8_WAIT_V(8); PG8_WAIT_L(0); PG8_BAR; PG8_MMA(0, 0, At, B0); PG8_MMA(0, 1, At, B1); PG8_BAR; PG8_SCHED;
            PG8_LDA(At, 1, 1); PG8_STAGE(PG8_SB(1, 0), b3, voffB); PG8_STAGE(PG8_SB(1, 1), b3 + hstepB, voffB); PG8_STAGE(PG8_SA(1, 0), a3, voffA);
            PG8_WAIT_V(8); PG8_WAIT_L(0); PG8_BAR; PG8_MMA(1, 0, At, B0); PG8_MMA(1, 1, At, B1); PG8_BAR; PG8_SCHED;
        }
        if constexpr (F8) asm volatile("s_nop 15\n\ts_nop 15" ::: "memory");
        if constexpr (ALIGN_EPI) { if (wr == 0) PG8_BAR; }
        E(acc, cur, wr, wc, fr, fq, xl);
        if (!has_next) break;
#pragma unroll
        for (int a = 0; a < 2; ++a)
#pragma unroll
            for (int b = 0; b < 2; ++b)
#pragma unroll
                for (int m = 0; m < 4; ++m)
#pragma unroll
                    for (int n = 0; n < 2; ++n) acc[a][b][m][n] = (f32x4){0.f, 0.f, 0.f, 0.f};
        cur = nxt; cA = nA; cB = nB; ++ui;
        if constexpr (ALIGN_EPI) { if (wr == 1) PG8_BAR; }
    }
    PG8_WAIT_V(0);
    if constexpr (!ALIGN_EPI) { if (wr == 0) PG8_BAR; }
    PG8_BAR;
#undef PG8_SA
#undef PG8_SB
#undef PG8_STAGE
#undef PG8_LDA
#undef PG8_LDB
#undef PG8_MMA
#undef PG8_WAIT_V
#undef PG8_WAIT_L
#undef PG8_BAR
#undef PG8_SCHED
}
}

constexpr int NWAVES = 8;
constexpr int NB = 8, T = 8192, D = 1024, M = NB * T;
constexpr int INC = 3080, NQKV = 3072, FF = 2816;
constexpr int C_F = 1536, C_QM = 1544, C_KM = 2056;
constexpr float LOG2E = 1.4426950408889634f;
constexpr float C2 = 0.125f * LOG2E;
constexpr float RMS_EPS = 1e-6f;

constexpr size_t MiB = 1u << 20;
constexpr size_t WS_CTL = 0, CTL_ZERO_BYTES = 1 * MiB;
constexpr size_t WS_LOGF = 2 * MiB, WS_C = 4 * MiB, WS_ABAR = 6 * MiB, WS_KM = 7 * MiB, WS_SEL = 8 * MiB;
constexpr size_t WS_SSQ1 = 10 * MiB, WS_SSQ2 = 14 * MiB, WS_SSQ3 = 18 * MiB;
constexpr size_t WS_MEMN = 22 * MiB, WS_KV = 26 * MiB, WS_WQS = 34 * MiB, WS_WOT = 36 * MiB, WS_WKVT = 38 * MiB, WS_WINT = 42 * MiB, WS_WOUTT = 48 * MiB;
constexpr size_t WS_WUPT = 50 * MiB, WS_WDT = 976 * MiB  , WS_ZT = 68 * MiB, WS_WQK = 80 * MiB, WS_VWO = 96 * MiB;
constexpr size_t WS_ACT8 = 240 * MiB;
constexpr size_t WS_GH = 416 * MiB, WS_UH = 424 * MiB, WS_GT = 432 * MiB;
constexpr size_t WS_A1 = 112 * MiB;
constexpr size_t WS_QKV = 368 * MiB;
constexpr size_t WS_Y = 752 * MiB, WS_HB1 = WS_A1 + 128 * MiB, WS_P = WS_QKV, WS_HB2 = WS_A1;
constexpr size_t WS_HB1F = WS_A1;
constexpr size_t WS_PO = WS_A1;
constexpr size_t WS_LIST = 880 * MiB, WS_PML = 944 * MiB, WS_KXF = 960 * MiB, WS_KXM = 968 * MiB, WS_CNT = 969 * MiB;
constexpr size_t WS_G = 240 * MiB, WS_U = 592 * MiB, WS_END = 1024 * MiB;
static_assert(WS_WUPT + (size_t)2 * FF * D * 2 <= WS_ZT && WS_ACT8 + (size_t)M * FF <= WS_GH && WS_WDT + (size_t)D * FF <= WS_END && WS_CNT + 8192 <= WS_WDT && WS_ZT + (size_t)8 * 256 * 3072 * 2 <= WS_WQK && WS_VWO + 16 * MiB <= WS_A1, "ws map");
static_assert(WS_G + (size_t)M * FF * 2 <= WS_U && WS_U + (size_t)M * FF * 2 <= WS_END && WS_Y + (size_t)M * D * 2 <= WS_LIST && WS_LIST + (size_t)2048 * 8192 * 4 <= WS_PML && WS_PML + (size_t)M * 32 * 8 <= WS_KXF && WS_KXF + (size_t)64 * 8192 * 16 <= WS_KXM, "ws map 2");
constexpr int CW_BAR = 4096;
constexpr int CW_QKN = 8192;
constexpr int CW_QUEUE = 12288;
constexpr int CW_T0TAB = 16384;
constexpr int CW_PANEL = 32768, CW_TMO2 = 20480;

constexpr int RING_OFF = 0, RING_BYTES = 131072;
constexpr int LDSCTL_OFF = RING_BYTES, MISC_OFF = LDSCTL_OFF + 320;
constexpr int XL_OFF = RING_BYTES + 512;
constexpr int LDS_BYTES = 147456;
static_assert(XL_OFF + 8192 <= LDS_BYTES, "LDS map");

#define GAS __attribute__((address_space(1)))
#define LAS __attribute__((address_space(3)))
typedef unsigned short bf16;
typedef unsigned v4u __attribute__((ext_vector_type(4)));
typedef float f32x4 __attribute__((ext_vector_type(4)));
typedef GAS unsigned gu32;
#define RLX_AGENT __ATOMIC_RELAXED, __HIP_MEMORY_SCOPE_AGENT
#define LDS_WAIT() asm volatile("s_waitcnt lgkmcnt(0)" ::: "memory")
__device__ __forceinline__ unsigned f2bf(float f) { unsigned u = __builtin_bit_cast(unsigned, f); return (u + 0x7fffu + ((u >> 16) & 1u)) >> 16; }
__device__ __forceinline__ unsigned pk2(float lo, float hi) { unsigned r; asm("v_cvt_pk_bf16_f32 %0, %1, %2" : "=v"(r) : "v"(lo), "v"(hi)); return r; }
__device__ __forceinline__ float bf2f(unsigned b) { return __builtin_bit_cast(float, b << 16); }
__device__ __forceinline__ float bflo(unsigned w) { return __builtin_bit_cast(float, w << 16); }
__device__ __forceinline__ float bfhi(unsigned w) { return __builtin_bit_cast(float, w & 0xffff0000u); }

#define XB_TMO      128
#define XB_XCNT(j)  (256  + 64 * (j))
#define XB_XSUB(j)  (1280 + 64 * (j))
#define XB_XGEN(j)  (2304 + 64 * (j))
#define XB_TOP      3328
#define XB_TOPGEN   3392
#define XCD_BAR_WORDS 3456
#define XB_SPIN_CAP (1u << 18)

__device__ __forceinline__ unsigned xb_ld(unsigned* p)              { return __hip_atomic_load(p, __ATOMIC_RELAXED, __HIP_MEMORY_SCOPE_AGENT); }
__device__ __forceinline__ unsigned xb_add(unsigned* p, unsigned v) { return __hip_atomic_fetch_add(p, v, __ATOMIC_RELAXED, __HIP_MEMORY_SCOPE_AGENT); }
__device__ __forceinline__ unsigned xb_xcc_id() { return (unsigned)__builtin_amdgcn_s_getreg((3 << 11) | 20) & 0xFu; }
#define XB_SPIN(cond, bar) do { unsigned _sp = 0; while (cond) { __builtin_amdgcn_s_sleep(1); \
    if ((++_sp & 255u) == 0u) { if (xb_ld(&(bar)[XB_TMO])) break; if (_sp > XB_SPIN_CAP) { atomicAdd(&(bar)[XB_TMO], 1u); break; } } } } while (0)

struct XcdBarrier { unsigned* bar; unsigned x; volatile LAS unsigned* st; };

__device__ __forceinline__ XcdBarrier xcd_barrier_post(unsigned* bar, volatile LAS unsigned* st) {
    XcdBarrier b; b.bar = bar; b.x = xb_xcc_id(); b.st = st;
    if (threadIdx.x == 0) (void)xb_add(&bar[XB_XCNT(b.x)], 1u);
    return b;
}
__device__ __forceinline__ void xcd_barrier_complete(unsigned* bar, unsigned x, unsigned& nloc, unsigned& nx) {
    const unsigned G = gridDim.x * gridDim.y * gridDim.z;
    unsigned sum, cnt, mine, sp = 0u;
    for (;;) {
        sum = 0u; cnt = 0u; mine = 0u;
#pragma unroll
        for (unsigned j = 0; j < 16; ++j) { const unsigned c = xb_ld(&bar[XB_XCNT(j)]); sum += c; cnt += (c > 0u) ? 1u : 0u; mine = (j == x) ? c : mine; }
        if (sum == G) break;
        __builtin_amdgcn_s_sleep(1);
        if ((++sp & 255u) == 0u) { if (xb_ld(&bar[XB_TMO])) break; if (sp > XB_SPIN_CAP) { atomicAdd(&bar[XB_TMO], 1u); break; } }
    }
    nloc = mine > 0u ? mine : 1u; nx = cnt > 0u ? cnt : 1u;
}
__device__ __forceinline__ void xcd_barrier(const XcdBarrier& b) {
    asm volatile("s_waitcnt vmcnt(0)" ::: "memory");
    __syncthreads();
    if (threadIdx.x == 0) {
        unsigned* bar = b.bar;
        __builtin_amdgcn_s_waitcnt(0);
        unsigned nloc = b.st[0], nx = b.st[1];
        if (nloc == 0u) { xcd_barrier_complete(bar, b.x, nloc, nx); b.st[0] = nloc; b.st[1] = nx; }
        const unsigned old = xb_add(&bar[XB_XSUB(b.x)], 1u);
        const unsigned gen = old / nloc;
        if (old + 1u == (gen + 1u) * nloc) {
            __builtin_amdgcn_fence(__ATOMIC_RELEASE, "agent");
            asm volatile("s_waitcnt vmcnt(0)" ::: "memory");
            const unsigned og = xb_add(&bar[XB_TOP], 1u);
            const unsigned tg = og / nx;
            if (og + 1u == (tg + 1u) * nx) xb_add(&bar[XB_TOPGEN], 1u);
            else XB_SPIN(xb_ld(&bar[XB_TOPGEN]) == tg, bar);
            __builtin_amdgcn_fence(__ATOMIC_ACQUIRE, "agent");
            xb_add(&bar[XB_XGEN(b.x)], 1u);
            asm volatile("s_waitcnt vmcnt(0)" ::: "memory");
        } else {
            XB_SPIN(xb_ld(&bar[XB_XGEN(b.x)]) == gen, bar);
            __builtin_amdgcn_fence(__ATOMIC_ACQUIRE, "agent");
            asm volatile("s_waitcnt vmcnt(0)" ::: "memory");
        }
    }
    __syncthreads();
}

__device__ __forceinline__ float wave_sum(float v) {
#pragma unroll
    for (int o = 1; o < 64; o <<= 1) v += __shfl_xor(v, o);
    return v;
}
__device__ __forceinline__ void p0_transpose_item(const float* W, int ldw, int K, int N, bf16* WT, const float* kscale, bool remap, LAS float* scr, int item, int lane, float f8scale = 0.f, bool upmap = false) {
    const int nblk = N / 32, kb = item / nblk, nb = item % nblk, k0 = 64 * kb, n0 = 32 * nb;
    int sn0 = (remap && n0 >= 1536) ? n0 + 8 : n0;
    if (upmap) { const int within = n0 & 255, pt = n0 >> 8; sn0 = within < 128 ? 128 * pt + within : 2816 + 128 * pt + (within - 128); }
#pragma unroll 8
    for (int i = 0; i < 32; ++i) { const int kk = 2 * i + (lane >> 5); float v = W[(size_t)(k0 + kk) * ldw + sn0 + (lane & 31)]; if (kscale) v *= kscale[k0 + kk]; scr[kk * 33 + (lane & 31)] = v; }
    LDS_WAIT(); asm volatile("" ::: "memory");
    const int c = lane & 7;
#pragma unroll
    for (int j = 0; j < 4; ++j) { const int n = (lane >> 3) + 8 * j; const LAS float* s = scr + (8 * c) * 33 + n;
        if (f8scale != 0.f) { const unsigned lo = pg8::pk4_fp8(s[0 * 33] * f8scale, s[1 * 33] * f8scale, s[2 * 33] * f8scale, s[3 * 33] * f8scale), hi = pg8::pk4_fp8(s[4 * 33] * f8scale, s[5 * 33] * f8scale, s[6 * 33] * f8scale, s[7 * 33] * f8scale);
            *(GAS unsigned long long*)((unsigned char*)WT + (size_t)(n0 + n) * K + k0 + 8 * c) = (unsigned long long)lo | ((unsigned long long)hi << 32); }
        else { v4u o; o.x = pk2(s[0 * 33], s[1 * 33]); o.y = pk2(s[2 * 33], s[3 * 33]); o.z = pk2(s[4 * 33], s[5 * 33]); o.w = pk2(s[6 * 33], s[7 * 33]);
            *(GAS v4u*)(WT + (size_t)(n0 + n) * K + k0 + 8 * c) = o; } }
    LDS_WAIT(); asm volatile("" ::: "memory");
}

struct Args { const float* in[19]; float* out; unsigned char* ws; };
__device__ __forceinline__ float skip_thr(const unsigned* qk8, int moba) {
    const unsigned* p = qk8 + 4 * moba;
    const float qn = sqrtf(__uint_as_float(__hip_atomic_load(p, RLX_AGENT)) + __uint_as_float(__hip_atomic_load(p + 1, RLX_AGENT))), kn = sqrtf(__uint_as_float(__hip_atomic_load(p + 2, RLX_AGENT)) + __uint_as_float(__hip_atomic_load(p + 3, RLX_AGENT)));
    return 2.0f * qn * kn * 1.02f + 40.0f;
}
__device__ __forceinline__ bool moba_skip(int h, int j, int n, float thr) { return __builtin_amdgcn_exp2f(-(float)(h + 1)) * LOG2E * (float)(256 * (j - n - 1) + 1) >= thr; }

namespace attn_body {
using hb16=__hip_bfloat16;
using bf16x8=__attribute__((ext_vector_type(8)))short;
using s16x4=__attribute__((ext_vector_type(4)))short;
using f32x16=__attribute__((ext_vector_type(16)))float;
using u32x4=__attribute__((ext_vector_type(4)))unsigned;
constexpr int PITCH=3072;
constexpr int NW=8,QBLK=32,QB=QBLK*NW,KVBLK=64;
__device__ __forceinline__ int crow(int r,int hi){return (r&3)+8*(r>>2)+4*hi;}
#define SBAR() __builtin_amdgcn_sched_barrier(0)
__device__ __forceinline__ void cmask(f32x16&p0,f32x16&p1,int jb,int qrel,int hi){
  const float NEG=-INFINITY; int kb=64*jb+4*hi;
  #pragma unroll
  for(int r=0;r<16;++r){int kv=kb+(r&3)+8*(r>>2); if(kv>qrel)p0[r]=NEG; if(kv+32>qrel)p1[r]=NEG;}
}
constexpr int NSLOT=3, SLOTB=9216;
constexpr int LDS_K=0, LDS_V=NSLOT*SLOTB, LDS_WS=2*NSLOT*SLOTB, LDS_OST=LDS_WS+NW*64*4, LDS_BYTES=LDS_OST+NW*4096;
__device__ __forceinline__ void glds16(const void*gsrc,unsigned lds_dst){unsigned keep;
  asm volatile("s_mov_b32 %0, m0\n\ts_mov_b32 m0, %2\n\ts_nop 0\n\tglobal_load_lds_dwordx4 %1, off\n\ts_mov_b32 m0, %0":"=&s"(keep):"v"(gsrc),"s"(lds_dst):"memory");}
__device__ __forceinline__ void glds16x(const void*gsrc,unsigned lds_dst){unsigned keep;unsigned long long ex;
  asm volatile("s_mov_b32 %0, m0\n\ts_mov_b64 %1, exec\n\ts_mov_b64 exec, 0xff\n\ts_mov_b32 m0, %3\n\ts_nop 0\n\tglobal_load_lds_dwordx4 %2, off\n\ts_mov_b64 exec, %1\n\ts_mov_b32 m0, %0":"=&s"(keep),"=&s"(ex):"v"(gsrc),"s"(lds_dst):"memory");}
__device__ __forceinline__ float max3f(float a,float b,float c){float r;asm("v_max3_f32 %0, %1, %2, %3":"=v"(r):"v"(a),"v"(b),"v"(c));return r;}
__device__ __forceinline__ float max2f(float a,float b){float r;asm("v_max_f32_e32 %0, %1, %2":"=v"(r):"v"(a),"v"(b));return r;}
__device__ __forceinline__ float fsub_s(float a,float b){float r;asm("v_sub_f32_e32 %0, %1, %2":"=v"(r):"v"(a),"v"(b));return r;}
typedef float f32x2_t __attribute__((ext_vector_type(2))); typedef __bf16 bf16x2_t __attribute__((ext_vector_type(2)));
__device__ __forceinline__ unsigned cvtpk_s(float lo,float hi){f32x2_t v={lo,hi};bf16x2_t b=__builtin_convertvector(v,bf16x2_t);return __builtin_bit_cast(unsigned,b);}
__device__ __forceinline__ float rbf(float x){return __builtin_bit_cast(float,cvtpk_s(x,0.f)<<16);}
#define WAIT_BAR(N) asm volatile("s_waitcnt vmcnt(" #N ") lgkmcnt(0)\n\ts_barrier":::"memory")

__device__ __forceinline__ void qkt(f32x16&p0,f32x16&p1,const char*Kslot,const bf16x8*qr,int r32,int hi){
  const char*kb=Kslot+hi*1024+r32*16; const f32x16 zf={};
  #pragma unroll
  for(int d0=0;d0<4;++d0){
    const bf16x8 b0=*reinterpret_cast<const bf16x8*>(kb+d0*2048);
    const bf16x8 b1=*reinterpret_cast<const bf16x8*>(kb+d0*2048+512);
    if(d0==0){p0=__builtin_amdgcn_mfma_f32_32x32x16_bf16(b0,qr[0],zf,0,0,0);p1=__builtin_amdgcn_mfma_f32_32x32x16_bf16(b1,qr[0],zf,0,0,0);}
    else{p0=__builtin_amdgcn_mfma_f32_32x32x16_bf16(b0,qr[d0],p0,0,0,0);p1=__builtin_amdgcn_mfma_f32_32x32x16_bf16(b1,qr[d0],p1,0,0,0);}}
  const char*kx=Kslot+8192+r32*16;
  const bf16x8 x0=*reinterpret_cast<const bf16x8*>(kx), x1=*reinterpret_cast<const bf16x8*>(kx+512);
  p0=__builtin_amdgcn_mfma_f32_32x32x16_bf16(x0,qr[4],p0,0,0,0);p1=__builtin_amdgcn_mfma_f32_32x32x16_bf16(x1,qr[4],p1,0,0,0);
}
typedef __attribute__((address_space(3))) const char* lds_cptr;
typedef short v4i16_t __attribute__((ext_vector_type(4)));
__device__ __forceinline__ void kload10(bf16x8*kf,lds_cptr kp,lds_cptr kx){
  kf[0]=*(const __attribute__((address_space(3))) bf16x8*)(kp);      kf[1]=*(const __attribute__((address_space(3))) bf16x8*)(kp+512);
  kf[2]=*(const __attribute__((address_space(3))) bf16x8*)(kp+2048); kf[3]=*(const __attribute__((address_space(3))) bf16x8*)(kp+2560);
  kf[4]=*(const __attribute__((address_space(3))) bf16x8*)(kp+4096); kf[5]=*(const __attribute__((address_space(3))) bf16x8*)(kp+4608);
  kf[6]=*(const __attribute__((address_space(3))) bf16x8*)(kp+6144); kf[7]=*(const __attribute__((address_space(3))) bf16x8*)(kp+6656);
  kf[8]=*(const __attribute__((address_space(3))) bf16x8*)(kx);      kf[9]=*(const __attribute__((address_space(3))) bf16x8*)(kx+512);
}
__device__ __forceinline__ void kload2(bf16x8*kf,lds_cptr kp,int j){ kf[2*j]=*(const __attribute__((address_space(3))) bf16x8*)(kp+j*2048); kf[2*j+1]=*(const __attribute__((address_space(3))) bf16x8*)(kp+j*2048+512); }
__device__ __forceinline__ s16x4 vtr(lds_cptr p){ return __builtin_bit_cast(s16x4,__builtin_amdgcn_ds_read_tr16_b64_v4i16((__attribute__((address_space(3))) v4i16_t*)p)); }
__device__ __forceinline__ float rowmax(const f32x16&p0,const f32x16&p1){
  float a=max3f(p0[0],p0[1],p1[0]),b=max3f(p0[2],p0[3],p1[1]);a=max3f(a,p1[2],p1[3]);
  #pragma unroll
  for(int r=4;r<16;r+=4){a=max3f(a,p0[r],p0[r+1]);b=max3f(b,p0[r+2],p0[r+3]);a=max3f(a,p1[r],p1[r+1]);b=max3f(b,p1[r+2],p1[r+3]);}
  const float m=max2f(a,b);
  auto rr=__builtin_amdgcn_permlane32_swap(__float_as_uint(m),__float_as_uint(m),false,false);
  return max2f(__uint_as_float(rr[0]),__uint_as_float(rr[1]));
}
__device__ __forceinline__ void pv(f32x16*o,int vb,bf16x8 pa0,bf16x8 pa1,bf16x8 pa2,bf16x8 pa3){
  #pragma unroll
  for(int d0=0;d0<2;++d0){s16x4 lo[4],hi[4];
    #pragma unroll
    for(int ks=0;ks<4;++ks){
      asm volatile("ds_read_b64_tr_b16 %0,%1 offset:%c2":"=&v"(lo[ks]):"v"(vb),"i"(d0*4096+ks*1024):"memory");
      asm volatile("ds_read_b64_tr_b16 %0,%1 offset:%c2":"=&v"(hi[ks]):"v"(vb),"i"(d0*4096+ks*1024+512):"memory");}
    asm volatile("s_waitcnt lgkmcnt(0)":::"memory");SBAR();
    #define PK(k) (bf16x8){lo[k][0],lo[k][1],lo[k][2],lo[k][3],hi[k][0],hi[k][1],hi[k][2],hi[k][3]}
    o[d0]=__builtin_amdgcn_mfma_f32_32x32x16_bf16(pa0,PK(0),o[d0],0,0,0);
    o[d0]=__builtin_amdgcn_mfma_f32_32x32x16_bf16(pa1,PK(1),o[d0],0,0,0);
    o[d0]=__builtin_amdgcn_mfma_f32_32x32x16_bf16(pa2,PK(2),o[d0],0,0,0);
    o[d0]=__builtin_amdgcn_mfma_f32_32x32x16_bf16(pa3,PK(3),o[d0],0,0,0);
    #undef PK
  }
}

template<int THRL> __device__ __forceinline__ void attn_unit(char*shm,const int KIND,const hb16*Qc,int qrow,int oslot,const hb16*__restrict__ Kt0,const hb16*__restrict__ Vt0,const hb16*__restrict__ KXt0,int NT,int band0,hb16*Oc,hb16*PO,float*PML){
  const int tid=threadIdx.x,lane=tid&63,r32=lane&31,hi=lane>>5; const int wid=__builtin_amdgcn_readfirstlane(tid>>6);
  const unsigned lds0=(unsigned)(uintptr_t)shm;
  float*wsf=(float*)(shm+LDS_WS)+wid*64;
  const hb16*ksrc=Kt0+(long)lane*PITCH+wid*8;
  const hb16*vsrc=Vt0+(long)(16*(wid&3)+(lane>>2))*PITCH+(wid>>2)*32+(lane&3)*8;
  const hb16*xsrc=KXt0+(long)(8*wid+(lane&7))*8;
  const unsigned kdst=lds0+LDS_K+wid*1024, vdst=lds0+LDS_V+wid*1024, xdst=lds0+LDS_K+8192+wid*128;
  #define DMA_K(t,slot) do{ glds16(ksrc+(long)(t)*KVBLK*PITCH,(unsigned)__builtin_amdgcn_readfirstlane(kdst+(slot))); glds16x(xsrc+(long)(t)*KVBLK*8,(unsigned)__builtin_amdgcn_readfirstlane(xdst+(slot))); }while(0)
  #define DMA_V(t,slot) glds16(vsrc+(long)(t)*KVBLK*PITCH,(unsigned)__builtin_amdgcn_readfirstlane(vdst+(slot)))
  const int vb0=(int)(lds0+LDS_V)+((lane>>4)&1)*32+(lane&3)*8+(4*hi+((lane&15)>>2))*64;
  const char*Kbase=shm+LDS_K; bf16x8 kf[10];
  const lds_cptr shm3=(lds_cptr)shm; const lds_cptr kp0=shm3+LDS_K+hi*1024+r32*16; const lds_cptr kx0=shm3+LDS_K+8192+r32*16; const lds_cptr vp0=shm3+LDS_V+((lane>>4)&1)*32+(lane&3)*8+(4*hi+((lane&15)>>2))*64;
  DMA_K(0,0);DMA_V(0,0);DMA_K(1,SLOTB);
  bf16x8 qr[5];
  { const hb16*Qw=Qc+(long)qrow*PITCH;
    #pragma unroll
    for(int d0=0;d0<4;++d0)qr[d0]=*reinterpret_cast<const bf16x8*>(&Qw[d0*16+hi*8]); }
  float mhat=0.f,l_reg=0.f;f32x16 o[2];o[0]=f32x16{};o[1]=f32x16{};
  #define SETQX(mh_,ml_) do{ const unsigned bh_=cvtpk_s(-(mh_),-(ml_)); u32x4 qx_; qx_.x=0x3F803F80u; qx_.y=0x3F80u|(bh_<<16); qx_.z=(bh_>>16); qx_.w=0u; if(hi){qx_.x=0u;qx_.y=0u;qx_.z=0u;} qr[4]=__builtin_bit_cast(bf16x8,qx_); asm volatile("":"+v"(qr[4])); }while(0)
  #define MOVEREF(gain) const float mraw_=mhat+(gain); const float mh_=rbf(mraw_); const float ml_=rbf(mraw_-mh_); const float mnew_=mh_+ml_; const float dl=mnew_-mhat; mhat=mnew_; SETQX(mh_,ml_);
  SETQX(0.f,0.f);
  const int qrel=wid*QBLK+r32;
  #define CMASK(P0,P1,t) do{int jb_=(t)-band0; if(jb_>=0)cmask(P0,P1,jb_,qrel,hi);}while(0)
  bool resc=false;
  #define START(P0,P1) do{ const float rm=rowmax(P0,P1); resc=false; \
    { MOVEREF(rm) \
      _Pragma("unroll") for(int r=0;r<16;++r){P0[r]=fsub_s(P0[r],dl);P1[r]=fsub_s(P1[r],dl);} } \
    _Pragma("unroll") for(int r=0;r<16;++r)P0[r]=__builtin_amdgcn_exp2f(P0[r]); }while(0)
  #define RESC() do{ if(resc){ asm volatile("s_waitcnt lgkmcnt(0)":::"memory"); \
      _Pragma("unroll") for(int d_=0;d_<2;++d_) _Pragma("unroll") for(int r=0;r<16;++r)o[d_][r]*=wsf[crow(r,hi)]; } }while(0)
  f32x16 pA0,pA1,pB0,pB1;
  int sl_prev=0,sl_cur=0,sl_next=SLOTB;
  #define ROT() do{sl_prev=sl_cur;sl_cur=sl_next;sl_next=(sl_next==(NSLOT-1)*SLOTB)?0:sl_next+SLOTB;}while(0)
  DMA_K(2,2*SLOTB);
  WAIT_BAR(5);
  qkt(pA0,pA1,Kbase,qr,r32,hi);asm volatile("s_nop 15\n\ts_nop 7":"+v"(pA0),"+v"(pA1));CMASK(pA0,pA1,0);
  START(pA0,pA1);
  _Pragma("unroll") for(int r=0;r<16;++r)pA1[r]=__builtin_amdgcn_exp2f(pA1[r]);
  WAIT_BAR(0);
  DMA_K(3,0);DMA_V(1,SLOTB);
  ROT();
  kload10(kf,kp0+sl_cur,kx0+sl_cur);
  WAIT_BAR(3);
  s16x4 vlo[8],vhi[8]; u32x4 pw0,pw1,pw2,pw3; const f32x16 zf={};
  #define PKW(P,B) cvtpk_s(P[B],P[B+1])
  #define PAF(k) __builtin_bit_cast(bf16x8,pw##k)
  #define VFR(i) (bf16x8){vlo[i][0],vlo[i][1],vlo[i][2],vlo[i][3],vhi[i][0],vhi[i][1],vhi[i][2],vhi[i][3]}
  #define PIN(x) asm volatile("":"+v"(x))
  #define MX3(a,b,c) __builtin_fmaxf(__builtin_fmaxf((a),(b)),(c))
  #define GAPA(MF,A0,A1,A2,A3,W0,W1,PW) do{ MF; sacc+=A0; sacc+=A1; sacc+=A2; sacc+=A3; PIN(sacc); W0; W1; PIN(PW); SBAR(); }while(0)
  #define EX(v) __builtin_amdgcn_exp2f(v)
  #define GAPB(MF,X,B) do{ MF; X[B]=EX(X[B]); X[B+1]=EX(X[B+1]); X[B+2]=EX(X[B+2]); X[B+3]=EX(X[B+3]); PIN(X); SBAR(); }while(0)
  #define VRD(i) do{ vlo[i]=vtr(vp_+(((i)>>2)*4096+((i)&3)*1024)); vhi[i]=vtr(vp_+(((i)>>2)*4096+((i)&3)*1024+512)); }while(0)
  #define KRD(G,j) do{ if(G){ kload2(kf,kp0+sl_next,j); SBAR(); } }while(0)
  #define KRDX(G) do{ if(G){ kf[8]=*(const __attribute__((address_space(3))) bf16x8*)(kx0+sl_next); kf[9]=*(const __attribute__((address_space(3))) bf16x8*)(kx0+sl_next+512); SBAR(); } }while(0)
  #define STEP(C0,C1,P0,P1,t,GK,GV,GL) do{ SBAR(); \
    const lds_cptr vp_=vp0+sl_prev; \
    VRD(0); SBAR(); float sacc=(P0[0]+P0[1]); \
    GAPA(C0=__builtin_amdgcn_mfma_f32_32x32x16_bf16(kf[0],qr[0],zf,0,0,0), P0[2],P0[3],P0[4],P0[5],     pw0[0]=PKW(P0,0), pw0[1]=PKW(P0,2), pw0); \
    VRD(4); SBAR(); GAPA(C1=__builtin_amdgcn_mfma_f32_32x32x16_bf16(kf[1],qr[0],zf,0,0,0), P0[6],P0[7],P0[8],P0[9],     pw0[2]=PKW(P0,4), pw0[3]=PKW(P0,6), pw0); \
    VRD(1); SBAR(); GAPA(C0=__builtin_amdgcn_mfma_f32_32x32x16_bf16(kf[2],qr[1],C0,0,0,0),   P0[10],P0[11],P0[12],P0[13], pw1[0]=PKW(P0,8), pw1[1]=PKW(P0,10), pw1); \
    VRD(5); SBAR(); GAPA(C1=__builtin_amdgcn_mfma_f32_32x32x16_bf16(kf[3],qr[1],C1,0,0,0),   P0[14],P0[15],P1[0],P1[1],   pw1[2]=PKW(P0,12),pw1[3]=PKW(P0,14), pw1); \
    VRD(2); SBAR(); GAPA(C0=__builtin_amdgcn_mfma_f32_32x32x16_bf16(kf[4],qr[2],C0,0,0,0),   P1[2],P1[3],P1[4],P1[5],     pw2[0]=PKW(P1,0), pw2[1]=PKW(P1,2), pw2); \
    VRD(6); SBAR(); GAPA(C1=__builtin_amdgcn_mfma_f32_32x32x16_bf16(kf[5],qr[2],C1,0,0,0),   P1[6],P1[7],P1[8],P1[9],     pw2[2]=PKW(P1,4), pw2[3]=PKW(P1,6), pw2); \
    VRD(3); SBAR(); GAPA(C0=__builtin_amdgcn_mfma_f32_32x32x16_bf16(kf[6],qr[3],C0,0,0,0),   P1[10],P1[11],P1[12],P1[13], pw3[0]=PKW(P1,8), pw3[1]=PKW(P1,10), pw3); \
    VRD(7); SBAR(); GAPA(C1=__builtin_amdgcn_mfma_f32_32x32x16_bf16(kf[7],qr[3],C1,0,0,0),   P1[14],P1[15],0.f,0.f,       pw3[2]=PKW(P1,12),pw3[3]=PKW(P1,14), pw3); \
    C0=__builtin_amdgcn_mfma_f32_32x32x16_bf16(kf[8],qr[4],C0,0,0,0); SBAR(); \
    C1=__builtin_amdgcn_mfma_f32_32x32x16_bf16(kf[9],qr[4],C1,0,0,0); SBAR(); \
    l_reg+=sacc; \
    if(GK){DMA_K((t)+3,sl_cur);} if(GV){DMA_V((t)+1,sl_next);} \
    CMASK(C0,C1,t); \
    { float a=MX3(C0[0],C0[1],C1[0]),b=MX3(C0[2],C0[3],C1[1]); a=MX3(a,C1[2],C1[3]); \
      _Pragma("unroll") for(int r=4;r<16;r+=4){a=MX3(a,C0[r],C0[r+1]);b=MX3(b,C0[r+2],C0[r+3]);a=MX3(a,C1[r],C1[r+1]);b=MX3(b,C1[r+2],C1[r+3]);} \
      float rm=__builtin_fmaxf(a,b); { auto rr=__builtin_amdgcn_permlane32_swap(__float_as_uint(rm),__float_as_uint(rm),false,false); rm=__builtin_fmaxf(__uint_as_float(rr[0]),__uint_as_float(rr[1])); } \
      resc=false; \
      if(__builtin_expect(__any(rm>(float)THRL),0)){ MOVEREF(__builtin_fmaxf(rm,0.f)) \
        _Pragma("unroll") for(int r=0;r<16;++r){C0[r]-=dl;C1[r]-=dl;} \
        const float f=__builtin_amdgcn_exp2f(-dl); l_reg*=f; if(hi==0)wsf[r32]=f; resc=true; } } \
    SBAR(); \
    GAPB(o[0]=__builtin_amdgcn_mfma_f32_32x32x16_bf16(PAF(0),VFR(0),o[0],0,0,0), C0,0); \
    GAPB(o[1]=__builtin_amdgcn_mfma_f32_32x32x16_bf16(PAF(0),VFR(4),o[1],0,0,0), C0,4); \
    KRD(GL,0); GAPB(o[0]=__builtin_amdgcn_mfma_f32_32x32x16_bf16(PAF(1),VFR(1),o[0],0,0,0), C0,8); \
    KRD(GL,1); GAPB(o[1]=__builtin_amdgcn_mfma_f32_32x32x16_bf16(PAF(1),VFR(5),o[1],0,0,0), C0,12); \
    KRD(GL,2); GAPB(o[0]=__builtin_amdgcn_mfma_f32_32x32x16_bf16(PAF(2),VFR(2),o[0],0,0,0), C1,0); \
    KRD(GL,3); GAPB(o[1]=__builtin_amdgcn_mfma_f32_32x32x16_bf16(PAF(2),VFR(6),o[1],0,0,0), C1,4); \
    KRDX(GL); GAPB(o[0]=__builtin_amdgcn_mfma_f32_32x32x16_bf16(PAF(3),VFR(3),o[0],0,0,0), C1,8); \
    GAPB(o[1]=__builtin_amdgcn_mfma_f32_32x32x16_bf16(PAF(3),VFR(7),o[1],0,0,0), C1,12); \
    }while(0)
  int t=1;
  for(;t+5<NT&&t+1<band0;t+=2){
    #undef CMASK
    #define CMASK(P0,P1,t) do{}while(0)
    STEP(pB0,pB1,pA0,pA1,t,true,true,true);     WAIT_BAR(3); RESC(); ROT();
    STEP(pA0,pA1,pB0,pB1,t+1,true,true,true);   WAIT_BAR(3); RESC(); ROT();
  }
  #undef CMASK
  #define CMASK(P0,P1,t) do{int jb_=(t)-band0; if(jb_>=0)cmask(P0,P1,jb_,qrel,hi);}while(0)
  #define ENDW(tt) do{ if((tt)+3<NT){WAIT_BAR(3);} else if((tt)+2<NT){WAIT_BAR(1);} else {WAIT_BAR(0);} }while(0)
  for(;t+1<NT;t+=2){
    STEP(pB0,pB1,pA0,pA1,t,(t+3<NT),(t+1<NT),(t+1<NT));       ENDW(t);   RESC(); ROT();
    STEP(pA0,pA1,pB0,pB1,t+1,(t+4<NT),(t+2<NT),(t+2<NT));     ENDW(t+1); RESC(); ROT();
  }
  STEP(pB0,pB1,pA0,pA1,NT-1,false,false,false); RESC();
  { float sacc=pB0[0]+pB0[1]; _Pragma("unroll") for(int r=2;r<16;++r)sacc+=pB0[r]; _Pragma("unroll") for(int r=0;r<16;++r)sacc+=pB1[r]; l_reg+=sacc;
    pw0=(u32x4){PKW(pB0,0),PKW(pB0,2),PKW(pB0,4),PKW(pB0,6)};pw1=(u32x4){PKW(pB0,8),PKW(pB0,10),PKW(pB0,12),PKW(pB0,14)};pw2=(u32x4){PKW(pB1,0),PKW(pB1,2),PKW(pB1,4),PKW(pB1,6)};pw3=(u32x4){PKW(pB1,8),PKW(pB1,10),PKW(pB1,12),PKW(pB1,14)};
    SBAR(); pv(o,vb0+sl_cur,PAF(0),PAF(1),PAF(2),PAF(3)); }
  #undef PKW
  #undef PAF
  #undef VFR
  #undef PIN
  #undef MX3
  #undef GAPA
  #undef GAPB
  #undef EX
  #undef VRD
  #undef KRD
  #undef KRDX
  #undef STEP
  #undef ENDW
  {auto rr=__builtin_amdgcn_permlane32_swap(__float_as_uint(l_reg),__float_as_uint(l_reg),false,false);l_reg=__uint_as_float(rr[0])+__uint_as_float(rr[1]);}
  if(hi==0)wsf[32+r32]=l_reg;asm volatile("s_waitcnt lgkmcnt(0)":::"memory");
  float rli[16];
  #pragma unroll
  for(int r=0;r<16;++r)rli[r]=__builtin_amdgcn_rcpf(wsf[32+crow(r,hi)]);
  if(KIND==1){ if(hi==0&&oslot>=0){ f32x2_t ml={mhat,l_reg}; *(f32x2_t*)(PML+(long)oslot*2)=ml; } }
  { hb16*stg=(hb16*)(shm+LDS_OST)+wid*2048;
    #pragma unroll
    for(int r=0;r<16;++r){const int orow=crow(r,hi);
      #pragma unroll
      for(int d0=0;d0<2;++d0)stg[orow*64+d0*32+r32]=__float2bfloat16(o[d0][r]*rli[r]);}
    asm volatile("s_waitcnt lgkmcnt(0)":::"memory");
    #pragma unroll
    for(int i=0;i<4;++i){const int row=i*8+(lane>>3),ch=lane&7; const u32x4 v=*(const u32x4*)(stg+row*64+ch*8);
      if(KIND==0){ const int gr=__shfl(qrow,row); *(u32x4*)(Oc+(long)gr*PITCH+ch*8)=v; }
      else { const int gs=__shfl(oslot,row); if(gs>=0) *(u32x4*)(PO+(long)gs*64+ch*8)=v; } } }
  asm volatile("s_waitcnt lgkmcnt(0)\n\ts_barrier":::"memory");
  #undef DMA_K
  #undef DMA_V
  #undef CMASK
  #undef START
  #undef RESC
  #undef ROT
  #undef SETQX
  #undef MOVEREF
}
constexpr int ATTN_LDS_BYTES=LDS_BYTES;
#undef SBAR
#undef WAIT_BAR
}

struct WqkOrder {
    int G, c;
    __device__ __forceinline__ bool next(int i, pg8::Unit& u) const { const int L = i * G + c; if (L >= 128) return false; const int z = L >> 2, pn = L & 3, b = z >> 2, h = z & 3;
        u.pm = b * 4 + h; u.pn = pn; u.aoff = ((size_t)(b * 256) * 2048 + h * 256) * 2; u.boff = ((size_t)(pn * 256) * 1024 + h * 256) * 2; return true; }
};
struct VwoOrder {
    int G, c;
    __device__ __forceinline__ bool next(int i, pg8::Unit& u) const { const int L = i * G + c; if (L >= 128) return false; const int z = L >> 2, pmq = L & 3, b = z >> 2, h = z & 3;
        u.pm = b * 4 + pmq; u.pn = h; u.aoff = ((size_t)(pmq * 256) * 1024 + h * 256) * 2; u.boff = ((size_t)(b * 256) * 2048 + 1024 + h * 256) * 2; return true; }
};

#define DECL_PTRS const __attribute__((address_space(4))) Args* KA_; { auto p_ = __builtin_amdgcn_kernarg_segment_ptr(); asm volatile("" : "+s"(p_)); KA_ = (const __attribute__((address_space(4))) Args*)p_; } \
    int tidp_ = threadIdx.x; asm volatile("" : "+v"(tidp_)); const int tid = tidp_, lane = tid & 63; (void)lane; \
    unsigned char* ws = KA_->ws; gu32* ctl = (gu32*)(ws + WS_CTL); const float* x = KA_->in[0]; const float* mem = KA_->in[1]; const float* g_mix = KA_->in[2]; const float* w_in = KA_->in[3]; const float* b_forget = KA_->in[4]; const float* g_fox = KA_->in[5]; const float* g_moba = KA_->in[6]; const float* w_out = KA_->in[7]; const float* g_cross = KA_->in[8]; const float* g_mem = KA_->in[9]; const float* w_q_mem = KA_->in[10]; const float* w_kv_mem = KA_->in[11]; const float* w_o_mem = KA_->in[12]; const float* g_ffn = KA_->in[13]; const float* w_up = KA_->in[14]; const float* conv_w = KA_->in[15]; const float* conv_b = KA_->in[16]; const float* w_down = KA_->in[17]; const float* g_final = KA_->in[18]; float* out = KA_->out; float* LOGF = (float*)(ws + WS_LOGF); float* CC = (float*)(ws + WS_C); float* ABAR = (float*)(ws + WS_ABAR); float* KM = (float*)(ws + WS_KM); unsigned* SEL = (unsigned*)(ws + WS_SEL); float* SSQ1 = (float*)(ws + WS_SSQ1); float* SSQ2 = (float*)(ws + WS_SSQ2); float* SSQ3 = (float*)(ws + WS_SSQ3); bf16* MEMN = (bf16*)(ws + WS_MEMN); bf16* KV = (bf16*)(ws + WS_KV); bf16* WQS = (bf16*)(ws + WS_WQS); bf16* WOT = (bf16*)(ws + WS_WOT); bf16* WKVT = (bf16*)(ws + WS_WKVT); bf16* WINT = (bf16*)(ws + WS_WINT); bf16* WOUTT = (bf16*)(ws + WS_WOUTT); bf16* WUPT = (bf16*)(ws + WS_WUPT); unsigned char* WDT = ws + WS_WDT; unsigned char* ACT8 = ws + WS_ACT8; float* GHB = (float*)(ws + WS_GH); float* UHB = (float*)(ws + WS_UH); float* GTB = (float*)(ws + WS_GT); bf16* ZT = (bf16*)(ws + WS_ZT); bf16* WQK = (bf16*)(ws + WS_WQK); bf16* VWO = (bf16*)(ws + WS_VWO); bf16* A1 = (bf16*)(ws + WS_A1); bf16* QKV = (bf16*)(ws + WS_QKV); bf16* Y = (bf16*)(ws + WS_Y); bf16* HB1 = (bf16*)(ws + WS_HB1); bf16* PB = (bf16*)(ws + WS_P); bf16* HB2 = (bf16*)(ws + WS_HB2); bf16* GB = (bf16*)(ws + WS_G); bf16* UB = (bf16*)(ws + WS_U); bf16* PO = (bf16*)(ws + WS_PO); unsigned* LIST = (unsigned*)(ws + WS_LIST); float* PML = (float*)(ws + WS_PML); bf16* KXF = (bf16*)(ws + WS_KXF); bf16* KXM = (bf16*)(ws + WS_KXM); unsigned* CNT = (unsigned*)(ws + WS_CNT);
__global__ void __launch_bounds__(NWAVES * 64, 2) fwd(Args args) {
    extern __shared__ __attribute__((aligned(16))) unsigned char lds[];
    LAS unsigned char* L = (LAS unsigned char*)lds;
    LAS unsigned char* XL = L + XL_OFF;
    volatile LAS unsigned* MISC = (volatile LAS unsigned*)(L + MISC_OFF);
    const int tid = threadIdx.x, lane = tid & 63, wave = __builtin_amdgcn_readfirstlane(tid >> 6);
    const int G = gridDim.x, bx = blockIdx.x;
    const int gw = bx * NWAVES + wave, NGW = G * NWAVES;
    for (int u = tid; u < (LDS_BYTES - LDSCTL_OFF) / 4; u += NWAVES * 64) ((LAS unsigned*)(L + LDSCTL_OFF))[u] = 0u;
    __syncthreads();
    XcdBarrier bar; { DECL_PTRS; bar = xcd_barrier_post((unsigned*)(ctl + CW_BAR), MISC + 8); }

    { DECL_PTRS;
        LAS float* scr = (LAS float*)(L + RING_OFF + wave * 16384);
        constexpr int I_IN = (D / 64) * (NQKV / 32), I_OUT = (D / 64) * (D / 32), I_KV = (D / 64) * (2048 / 32), I_O = I_OUT, I_UP = (D / 64) * (2 * FF / 32), I_DN = (FF / 64) * (D / 32);
        constexpr int NITEMS = I_IN + I_OUT + I_KV + I_O + I_UP + I_DN;
        for (int it = gw; it < NITEMS; it += NGW) {
            int r = it;
            if (r < I_IN) { p0_transpose_item(w_in, INC, D, NQKV, WINT, nullptr, true, scr, r, lane); continue; } r -= I_IN;
            if (r < I_OUT) { p0_transpose_item(w_out, D, D, D, WOUTT, nullptr, false, scr, r, lane); continue; } r -= I_OUT;
            if (r < I_KV) { p0_transpose_item(w_kv_mem, 2048, D, 2048, WKVT, nullptr, false, scr, r, lane); continue; } r -= I_KV;
            if (r < I_O) { p0_transpose_item(w_o_mem, D, D, D, WOT, nullptr, false, scr, r, lane); continue; } r -= I_O;
            if (r < I_UP) { p0_transpose_item(w_up, 2 * FF, D, 2 * FF, WUPT, g_ffn, false, scr, r, lane, 0.f, true); continue; } r -= I_UP;
            p0_transpose_item(w_down, D, FF, D, (bf16*)WDT, nullptr, false, scr, r, lane, 64.0f);
        }
        for (int i = bx * 512 + tid; i < D * D / 4; i += G * 512) { const int kk = (i * 4) >> 10; const f32x4 v = *(const f32x4*)(w_q_mem + (size_t)i * 4) * (g_cross[kk] * (LOG2E / 16.0f));
            *(unsigned long long*)(WQS + (size_t)i * 4) = (unsigned long long)pk2(v[0], v[1]) | ((unsigned long long)pk2(v[2], v[3]) << 32); }
        for (int r = gw; r < NB * 256; r += NGW) { const GAS f32x4* xr = (const GAS f32x4*)(mem + (size_t)r * D) + lane; f32x4 v[4]; float s = 0.f;
#pragma unroll
            for (int j = 0; j < 4; ++j) { v[j] = xr[64 * j]; s += (v[j][0] * v[j][0] + v[j][1] * v[j][1]) + (v[j][2] * v[j][2] + v[j][3] * v[j][3]); }
            const float rs = __builtin_amdgcn_rsqf(wave_sum(s) * (1.f / D) + RMS_EPS);
            GAS unsigned long long* o8 = (GAS unsigned long long*)(MEMN + (size_t)r * D) + lane;
#pragma unroll
            for (int j = 0; j < 4; ++j) { const f32x4 gg = *((const f32x4*)g_mem + 64 * j + lane); const f32x4 a = v[j] * rs * gg; o8[64 * j] = (unsigned long long)pk2(a[0], a[1]) | ((unsigned long long)pk2(a[2], a[3]) << 32); } }
        __syncthreads();
        LAS float* part = (LAS float*)(L + RING_OFF + 32768);
        f32x4 wfr[4][4][2];
#pragma unroll
        for (int j = 0; j < 4; ++j)
#pragma unroll
            for (int i = 0; i < 4; ++i) { const float* wp = w_in + (size_t)(256 * j + 4 * lane + i) * INC + C_F; wfr[j][i][0] = *(const f32x4*)wp; wfr[j][i][1] = *(const f32x4*)(wp + 4); }
        f32x4 gm[4];
#pragma unroll
        for (int j = 0; j < 4; ++j) gm[j] = *((const f32x4*)g_mix + 64 * j + lane);
        for (int blk = bx; blk < M / 256; blk += G) {
            f32x4 accm[4];
#pragma unroll
            for (int j = 0; j < 4; ++j) accm[j] = (f32x4){0.f, 0.f, 0.f, 0.f};
            for (int i0 = 0; i0 < 32; i0 += 2) {
              f32x4 vv[2][4];
#pragma unroll
              for (int rr = 0; rr < 2; ++rr) { const GAS f32x4* xr = (const GAS f32x4*)(x + ((size_t)blk * 256 + wave * 32 + i0 + rr) * D) + lane;
#pragma unroll
                  for (int j = 0; j < 4; ++j) vv[rr][j] = xr[64 * j]; }
#pragma unroll
              for (int rr = 0; rr < 2; ++rr) {
                const size_t r = (size_t)blk * 256 + wave * 32 + i0 + rr;
                f32x4 v[4]; float s = 0.f;
#pragma unroll
                for (int j = 0; j < 4; ++j) { v[j] = vv[rr][j]; s += (v[j][0] * v[j][0] + v[j][1] * v[j][1]) + (v[j][2] * v[j][2] + v[j][3] * v[j][3]); }
                const float rs = __builtin_amdgcn_rsqf(wave_sum(s) * (1.f / D) + RMS_EPS);
                GAS unsigned long long* o8 = (GAS unsigned long long*)(A1 + r * 2048) + lane;
                float fl[8];
#pragma unroll
                for (int h = 0; h < 8; ++h) fl[h] = 0.f;
#pragma unroll
                for (int j = 0; j < 4; ++j) { const f32x4 a = v[j] * rs * gm[j]; accm[j] += a;
                    const unsigned h0 = pk2(a[0], a[1]), h1 = pk2(a[2], a[3]);
                    o8[64 * j] = (unsigned long long)h0 | ((unsigned long long)h1 << 32);
                    const unsigned l0 = pk2(a[0] - bflo(h0), a[1] - bfhi(h0)), l1 = pk2(a[2] - bflo(h1), a[3] - bfhi(h1));
                    o8[256 + 64 * j] = (unsigned long long)l0 | ((unsigned long long)l1 << 32);
#pragma unroll
                    for (int i = 0; i < 4; ++i)
#pragma unroll
                        for (int h = 0; h < 8; ++h) fl[h] += a[i] * wfr[j][i][h >> 2][h & 3]; }
                float t4[4], t2[2], z;
                { const bool up = (lane & 32) != 0;
#pragma unroll
                  for (int k = 0; k < 4; ++k) { const float snd = up ? fl[k] : fl[k + 4]; const float rcv = __shfl_xor(snd, 32); t4[k] = (up ? fl[k + 4] : fl[k]) + rcv; } }
                { const bool up = (lane & 16) != 0;
#pragma unroll
                  for (int k = 0; k < 2; ++k) { const float snd = up ? t4[k] : t4[k + 2]; const float rcv = __shfl_xor(snd, 16); t2[k] = (up ? t4[k + 2] : t4[k]) + rcv; } }
                { const bool up = (lane & 8) != 0; const float snd = up ? t2[0] : t2[1]; const float rcv = __shfl_xor(snd, 8); z = (up ? t2[1] : t2[0]) + rcv; }
                z += __shfl_xor(z, 1); z += __shfl_xor(z, 2); z += __shfl_xor(z, 4);
                if ((lane & 7) == 0) { const int hh = 4 * (lane >> 5) + 2 * ((lane >> 4) & 1) + ((lane >> 3) & 1);
                    z += b_forget[hh];
                    LOGF[r * 8 + hh] = fminf(z, 0.f) - log1pf(__expf(-fabsf(z))); }
              }
            }
#pragma unroll
            for (int j = 0; j < 4; ++j) *((LAS f32x4*)(part + wave * 1024) + 64 * j + lane) = accm[j];
            __syncthreads();
            for (int col = tid; col < 1024; col += 512) { float s = 0.f;
#pragma unroll
                for (int w = 0; w < 8; ++w) s += part[w * 1024 + col];
                ABAR[(size_t)blk * 1024 + col] = s * (1.0f / 256.0f); }
            __syncthreads();
        }
    }
    xcd_barrier(bar);

    { DECL_PTRS;
        LAS float* sc = (LAS float*)(L + RING_OFF);
        for (int w = (bx + G - 64) % G; w < 64; w += G) {
            const int b = w >> 3, h = w & 7; float v[16]; float run = 0.f;
#pragma unroll
            for (int i = 0; i < 16; ++i) { run += LOGF[((size_t)b * T + tid * 16 + i) * 8 + h]; v[i] = run; }
            float incl = run;
#pragma unroll
            for (int o = 1; o < 64; o <<= 1) { const float n = __shfl_up(incl, o); if (lane >= o) incl += n; }
            if (lane == 63) sc[wave] = incl;
            __syncthreads();
            float pre = incl - run;
            for (int ww = 0; ww < wave; ++ww) pre += sc[ww];
#pragma unroll
            for (int i = 0; i < 16; ++i) CC[(size_t)w * T + tid * 16 + i] = pre + v[i];
            __syncthreads();
        }
        for (int w = bx; w < 64; w += G) {
            const int ib = w >> 3, jb = w & 7, r = tid >> 4, cq = tid & 15; LAS float* As = sc; LAS float* Bs = sc + 32 * 33;
            f32x4 acc = (f32x4){0.f, 0.f, 0.f, 0.f};
            for (int k0 = 0; k0 < 1024; k0 += 32) {
                { const int idx = tid * 2, row = idx >> 5, kk = idx & 31; const pg8::f32x2 a2 = *(const pg8::f32x2*)(ABAR + (size_t)(ib * 32 + row) * 1024 + k0 + kk); As[row * 33 + kk] = a2.x; As[row * 33 + kk + 1] = a2.y; }
                { const int idx = tid * 4, kk = idx >> 6, c = idx & 63; *(LAS f32x4*)(Bs + kk * 64 + c) = *(const f32x4*)(w_in + (size_t)(k0 + kk) * INC + C_KM + jb * 64 + c); }
                __syncthreads();
#pragma unroll 8
                for (int kk = 0; kk < 32; ++kk) acc += *(const LAS f32x4*)(Bs + kk * 64 + cq * 4) * As[r * 33 + kk];
                __syncthreads();
            }
            *(f32x4*)(KM + (size_t)(ib * 32 + r) * 512 + jb * 64 + cq * 4) = acc;
        }
        pg8::Gemm g{MEMN, WKVT, D / 64, D * 2, D * 2, 0xffffffffu}; pg8::TileOrder S; S.init(NB * 256, 2048, G, (bx + G - 128) % G, D * 2, D * 2, 0, 1 << 30);
        pg8::EpiBf16 E{KV, 2048, 0u, 1.f, nullptr};
        pg8::gemm_phase<pg8::EpiBf16, pg8::TileOrder, true>(L + RING_OFF, XL, g, S, E);
    }
    xcd_barrier(bar);

    { DECL_PTRS;
        LAS float* sc = (LAS float*)(L + RING_OFF);
        for (int w = bx; w < 64; w += G) {
            const int h = w >> 3, kq = w & 7, kk = kq * 128 + (tid & 127), ng = tid >> 7;
            for (int i = tid; i < 256 * 16; i += 512) { const int n = i >> 4, c4 = (i & 15) * 4; *(LAS f32x4*)(sc + n * 64 + c4) = *(const f32x4*)(KM + (size_t)n * 512 + h * 64 + c4); }
            f32x4 wq[16];
#pragma unroll
            for (int c = 0; c < 16; ++c) wq[c] = *(const f32x4*)(w_in + (size_t)kk * INC + C_QM + h * 64 + c * 4);
            __syncthreads();
            for (int i = 0; i < 64; ++i) { const int n = ng * 64 + i; const LAS f32x4* kp = (const LAS f32x4*)(sc + n * 64); float s0 = 0.f, s1 = 0.f;
#pragma unroll
                for (int c = 0; c < 16; c += 2) { const f32x4 ka = kp[c], kb = kp[c + 1];
                    s0 += (wq[c][0] * ka[0] + wq[c][1] * ka[1]) + (wq[c][2] * ka[2] + wq[c][3] * ka[3]); s1 += (wq[c + 1][0] * kb[0] + wq[c + 1][1] * kb[1]) + (wq[c + 1][2] * kb[2] + wq[c + 1][3] * kb[3]); }
                const float sv = s0 + s1; const unsigned hi = f2bf(sv); const unsigned lo = f2bf(sv - bf2f(hi));
                bf16* zr = ZT + ((size_t)(n >> 5) * 256 + h * 32 + (n & 31)) * 3072; zr[kk] = (bf16)hi; zr[1024 + kk] = (bf16)hi; zr[2048 + kk] = (bf16)lo; }
            __syncthreads();
        }
        for (int i = bx * 512 + tid; i < 64 * T + 8 * 256; i += G * 512) {
            float bv; bf16* dst;
            if (i < 64 * T) { bv = -CC[i] * LOG2E; dst = KXF + (size_t)i * 8; }
            else { const int j = i - 64 * T; bv = __builtin_amdgcn_exp2f(-(float)((j >> 8) + 1)) * LOG2E * (float)(j & 255); dst = KXM + (size_t)j * 8; }
            const unsigned h0 = f2bf(bv); const float r1 = bv - bf2f(h0); const unsigned h1 = f2bf(r1); const unsigned h2 = f2bf(r1 - bf2f(h1));
            *(v4u*)dst = (v4u){h0 | (h1 << 16), h2 | (0x3F80u << 16), 0x3F80u, 0u}; }
        { pg8::Gemm g{KV, WQS, 4, 4096, 2048, 0xffffffffu}; WqkOrder S{G, bx}; pg8::EpiF8 E{(unsigned char*)WQK, 1024, 32.0f};
          pg8::gemm_phase<pg8::EpiF8, WqkOrder, true>(L + RING_OFF, XL, g, S, E); }
        { pg8::Gemm g{WOT, KV, 4, 2048, 4096, 0xffffffffu}; VwoOrder S{G, (bx + 128) % G}; pg8::EpiF8 E{(unsigned char*)VWO, 1024, 4.0f};
          pg8::gemm_phase<pg8::EpiF8, VwoOrder, true>(L + RING_OFF, XL, g, S, E); }
    }
    xcd_barrier(bar);

    { DECL_PTRS;
        { pg8::Gemm g{A1, WINT, D / 64, 4096, D * 2, 0xffffffffu}; pg8::TileOrder S; S.init(M, NQKV, G, bx, 4096, D * 2, 0, 1 << 30);
          pg8::EpiBf16 E{QKV, NQKV, 0xC3u, C2, (unsigned*)(ctl + CW_QKN)};
          pg8::gemm_phase<pg8::EpiBf16, pg8::TileOrder, true>(L + RING_OFF, XL, g, S, E); }
        { pg8::Gemm g{A1, ZT, 3072 / 64, 4096, 6144, 4095u}; pg8::TileOrder S; S.init(M, 256, G, bx, 4096, 6144, (size_t)256 * 6144, 32);
          pg8::EpiGate E{SEL};
          pg8::gemm_phase<pg8::EpiGate, pg8::TileOrder, true>(L + RING_OFF, XL, g, S, E); }
    }
    xcd_barrier(bar);

    { DECL_PTRS;
        for (int e = bx * 512 + tid; e < 2048; e += G * 512) { const int bh = e >> 5, qb = e & 31;
            const float thr = skip_thr((const unsigned*)(ctl + CW_QKN) + bh * 8, 0) * (1.0f / LOG2E);
            const float* crow_ = CC + (size_t)bh * T; const int t0 = qb * 256; const float target = crow_[t0] + thr;
            int lo = 0, hi2 = t0;
            while (lo < hi2) { const int mid = (lo + hi2) >> 1; if (crow_[mid] >= target) lo = mid + 1; else hi2 = mid; }
            ((int*)(ctl + CW_T0TAB))[e] = (lo >> 6) & ~1; }
        LAS unsigned* wc = (LAS unsigned*)(L + RING_OFF);
        for (int w = bx; w < 2048; w += G) {
            const int bh = (w & 255) >> 2, n = (w & 3) + 4 * (w >> 8), trip = bh * 32 + n; const unsigned* selrow = SEL + (size_t)bh * T; unsigned base = 0u;
            const float mthr = skip_thr((const unsigned*)(ctl + CW_QKN) + bh * 8, 1); const int hh = bh & 7;
            for (int t0 = (n + 1) * 256; t0 < T; t0 += 2048) {
                unsigned m[4], mo[4]; unsigned long long bal[4];
#pragma unroll
                for (int j = 0; j < 4; ++j) { const int t = t0 + j * 512 + tid; m[j] = 0u; if (t < T) m[j] = selrow[t]; mo[j] = m[j]; if (moba_skip(hh, t >> 8, n, mthr)) m[j] &= ~(1u << n); }
#pragma unroll
                for (int j = 0; j < 4; ++j) { bal[j] = __ballot((m[j] >> n) & 1u); if (lane == 0) wc[j * 8 + wave] = (unsigned)__popcll(bal[j]); }
                __syncthreads();
                unsigned run = base;
#pragma unroll
                for (int j = 0; j < 4; ++j) { unsigned pre = 0u, tot = 0u;
#pragma unroll
                    for (int ww = 0; ww < 8; ++ww) { const unsigned c = wc[j * 8 + ww]; tot += c; if (ww < wave) pre += c; }
                    if ((m[j] >> n) & 1u) { const unsigned pos = run + pre + (unsigned)__popcll(bal[j] & ((1ull << lane) - 1ull)); const unsigned k = (unsigned)__popc(mo[j] & ((1u << n) - 1u));
                        LIST[(size_t)trip * 8192 + pos] = (unsigned)(t0 + j * 512 + tid) | (k << 16); }
                    run += tot; }
                base = run;
                __syncthreads();
            }
            if (tid == 0) CNT[trip] = base;
        }
    }
    xcd_barrier(bar);

    { DECL_PTRS;
        LAS int* upre = (LAS int*)(L + RING_OFF + attn_body::ATTN_LDS_BYTES);
        LAS int* wsum = upre + 2052;
        { int c4[4]; int run = 0;
#pragma unroll
          for (int i = 0; i < 4; ++i) { c4[i] = run; run += (int)((CNT[tid * 4 + i] + 255u) >> 8); }
          int incl = run;
#pragma unroll
          for (int o = 1; o < 64; o <<= 1) { const int nn = __shfl_up(incl, o); if (lane >= o) incl += nn; }
          if (lane == 63) wsum[wave] = incl;
          __syncthreads();
          int pre = incl - run;
          for (int ww = 0; ww < wave; ++ww) pre += wsum[ww];
#pragma unroll
          for (int i = 0; i < 4; ++i) upre[tid * 4 + i] = pre + c4[i];
          if (tid == 511) upre[2048] = pre + run;
          __syncthreads(); }
        const int ntot = 4096 + upre[2048];
        const attn_body::hb16* Qb = (const attn_body::hb16*)QKV;
        const int r32 = lane & 31;
        LAS unsigned* qnext = (LAS unsigned*)(wsum + 16);
        unsigned* qhead = (unsigned*)(ctl + CW_QUEUE);
        if (tid == 0) qnext[0] = atomicAdd(qhead, 1u);
        __syncthreads();
        for (;;) {
            const int u = (int)qnext[0];
            if (u >= ntot) break;
            __syncthreads();
            unsigned nxt_ = 0u; if (tid == 0) nxt_ = atomicAdd(qhead, 1u);
            int kind, qrow, oslot = -1, NT, band0; const attn_body::hb16 *Qc, *Kt0, *Vt0, *KXt0;
            if (u < 2048) {
                const int qb = 31 - (u >> 6), bh = u & 63;
                const int b = bh >> 3, h = bh & 7;
                const int T0 = ((const int*)(ctl + CW_T0TAB))[bh * 32 + qb];
                kind = 0; qrow = b * T + qb * 256 + wave * 32 + r32; NT = 4 * (qb + 1) - T0; band0 = NT - 4;
                Qc = Qb + h * 64; Kt0 = Qb + (size_t)(b * T + T0 * 64) * NQKV + 512 + h * 64; Vt0 = Kt0 + 512; KXt0 = (const attn_body::hb16*)KXF + ((size_t)bh * T + T0 * 64) * 8;
            } else if (u < 4096) {
                const int w = u - 2048, bh = w >> 5, j = w & 31, b = bh >> 3, h = bh & 7;
                kind = 1; qrow = b * T + j * 256 + wave * 32 + r32; oslot = (qrow * 8 + h) * 4 + 3; NT = 4; band0 = 0;
                Qc = Qb + 1536 + h * 64; Kt0 = Qb + (size_t)(b * T + j * 256) * NQKV + 2048 + h * 64; Vt0 = Kt0 + 512; KXt0 = (const attn_body::hb16*)KXM + h * 256 * 8;
            } else {
                const int g = u - 4096; int lo = 0, hi2 = 2048;
                while (hi2 - lo > 1) { const int mid = (lo + hi2) >> 1; if (upre[mid] <= g) lo = mid; else hi2 = mid; }
                const int w = lo, c = g - upre[lo], bh = w >> 5, n = w & 31, b = bh >> 3, h = bh & 7; const int cnt = (int)CNT[w];
                int idx = c * 256 + wave * 32 + r32; const bool valid = idx < cnt; if (!valid) idx = cnt - 1;
                const unsigned e = LIST[(size_t)w * 8192 + idx];
                kind = 1; qrow = b * T + (int)(e & 0xffffu); oslot = valid ? (qrow * 8 + h) * 4 + (int)(e >> 16) : -1; NT = 4; band0 = 1 << 20;
                Qc = Qb + 1536 + h * 64; Kt0 = Qb + (size_t)(b * T + n * 256) * NQKV + 2048 + h * 64; Vt0 = Kt0 + 512; KXt0 = (const attn_body::hb16*)KXM + h * 256 * 8;
            }
            attn_body::attn_unit<8>((char*)lds + RING_OFF, kind, Qc, qrow, oslot, Kt0, Vt0, KXt0, NT, band0, (attn_body::hb16*)QKV + (Qc - Qb), (attn_body::hb16*)PO, PML);
            if (tid == 0) qnext[0] = nxt_;
            __syncthreads();
        }
    }
    xcd_barrier(bar);

    { DECL_PTRS;
    const f32x4 ga0 = *((const f32x4*)g_fox + 2 * lane), ga1 = *((const f32x4*)g_fox + 2 * lane + 1), gb0 = *((const f32x4*)g_moba + 2 * lane), gb1 = *((const f32x4*)g_moba + 2 * lane + 1);
    const int h = lane >> 3, cc = lane & 7; const float s2 = __builtin_amdgcn_exp2f(-(float)(h + 1)) * LOG2E * 256.0f;
    float mthr[NB];
#pragma unroll
    for (int b = 0; b < NB; ++b) mthr[b] = skip_thr((const unsigned*)(ctl + CW_QKN) + (b * 8 + h) * 8, 1);
    for (int r0 = gw * 2; r0 < M; r0 += NGW * 2) {
        v4u wa[2], pw[2][4]; unsigned mmv[2]; pg8::f32x2 ml[2][4];
#pragma unroll
        for (int rr = 0; rr < 2; ++rr) { const int r = r0 + rr, b = r >> 13, t = r & (T - 1); const size_t sb = ((size_t)r * 8 + h) * 4;
            wa[rr] = *((const v4u*)(QKV + (size_t)r * NQKV) + lane); mmv[rr] = SEL[((size_t)(b * 8 + h)) * T + t];
#pragma unroll
            for (int k = 0; k < 4; ++k) { ml[rr][k] = *(const pg8::f32x2*)(PML + (sb + k) * 2); pw[rr][k] = *((const v4u*)(PO + (sb + k) * 64) + cc); } }
#pragma unroll
        for (int rr = 0; rr < 2; ++rr) { const int r = r0 + rr, t = r & (T - 1), own = t >> 8;
            const float a[8] = {bflo(wa[rr].x), bfhi(wa[rr].x), bflo(wa[rr].y), bfhi(wa[rr].y), bflo(wa[rr].z), bfhi(wa[rr].z), bflo(wa[rr].w), bfhi(wa[rr].w)};
            float c[8]; unsigned mm = mmv[rr]; const int cnt = __popc(mm);
            float mk[4], lk[4];
#pragma unroll
            for (int k = 0; k < 4; ++k) { mk[k] = ml[rr][k].x; lk[k] = ml[rr][k].y; }
            mk[3] += s2 * (float)own; float Mx = mk[3];
            bool vk[4]; vk[3] = true; float thb = mthr[0];
#pragma unroll
            for (int b = 1; b < NB; ++b) thb = ((r >> 13) == b) ? mthr[b] : thb;
#pragma unroll
            for (int k = 0; k < 3; ++k) { vk[k] = false; if (k < cnt) { const int nb = __ffs(mm) - 1; mm &= mm - 1u; vk[k] = !moba_skip(h, own, nb, thb); if (vk[k]) { mk[k] += s2 * (float)nb; Mx = fmaxf(Mx, mk[k]); } } }
            float W = 0.f;
#pragma unroll
            for (int i = 0; i < 8; ++i) c[i] = 0.f;
#pragma unroll
            for (int k = 0; k < 4; ++k) { if (vk[k]) { const float w = lk[k] * __builtin_amdgcn_exp2f(mk[k] - Mx); W += w; const v4u p = pw[rr][k];
                c[0] += w * bflo(p.x); c[1] += w * bfhi(p.x); c[2] += w * bflo(p.y); c[3] += w * bfhi(p.y); c[4] += w * bflo(p.z); c[5] += w * bfhi(p.z); c[6] += w * bflo(p.w); c[7] += w * bfhi(p.w); } }
            const float iw = 1.0f / W;
#pragma unroll
            for (int i = 0; i < 8; ++i) c[i] *= iw;
            float sa = 0.f, sb2 = 0.f;
#pragma unroll
            for (int i = 0; i < 8; ++i) { sa += a[i] * a[i]; sb2 += c[i] * c[i]; }
            const float ra = __builtin_amdgcn_rsqf(wave_sum(sa) * (1.f / 512.f) + RMS_EPS), rb = __builtin_amdgcn_rsqf(wave_sum(sb2) * (1.f / 512.f) + RMS_EPS);
            v4u oa, ob;
            oa.x = pk2(a[0] * ra * ga0[0], a[1] * ra * ga0[1]); oa.y = pk2(a[2] * ra * ga0[2], a[3] * ra * ga0[3]); oa.z = pk2(a[4] * ra * ga1[0], a[5] * ra * ga1[1]); oa.w = pk2(a[6] * ra * ga1[2], a[7] * ra * ga1[3]);
            ob.x = pk2(c[0] * rb * gb0[0], c[1] * rb * gb0[1]); ob.y = pk2(c[2] * rb * gb0[2], c[3] * rb * gb0[3]); ob.z = pk2(c[4] * rb * gb1[0], c[5] * rb * gb1[1]); ob.w = pk2(c[6] * rb * gb1[2], c[7] * rb * gb1[3]);
            *((v4u*)(Y + (size_t)r * D) + lane) = oa; *((v4u*)(Y + (size_t)r * D + 512) + lane) = ob; }
    } }
    xcd_barrier(bar);

    { DECL_PTRS; pg8::Gemm g{Y, WOUTT, D / 64, D * 2, D * 2, 0xffffffffu}; pg8::TileOrder S; S.init(M, D, G, bx, D * 2, D * 2, 0, 1 << 30);
      pg8::EpiRes<false, false> E{x, nullptr, nullptr, HB1, ws + WS_HB1F, SSQ1, 1.0f};
      pg8::gemm_phase<pg8::EpiRes<false, false>, pg8::TileOrder, true>(L + RING_OFF, XL, g, S, E); }
    xcd_barrier(bar);

    { DECL_PTRS; pg8::Gemm g{ws + WS_HB1F, WQK, D / 128, D, D, 0xffffffffu}; pg8::TileOrder S; S.init(M, D, G, bx, D, D, (size_t)D * D, 32);
      pg8::EpiSoftmax E{(unsigned char*)PB, SSQ1, 1.0f / 32.0f};
      pg8::gemm_phase<pg8::EpiSoftmax, pg8::TileOrder, true, true>(L + RING_OFF, XL, g, S, E); }
    xcd_barrier(bar);

    { DECL_PTRS; pg8::Gemm g{PB, VWO, D / 128, D, D, 0xffffffffu}; pg8::TileOrder S; S.init(M, D, G, bx, D, D, (size_t)D * D, 32);
      pg8::EpiRes<true, true> E{nullptr, HB1, out, HB2, nullptr, SSQ2, 1.0f / 1024.0f};
      pg8::gemm_phase<pg8::EpiRes<true, true>, pg8::TileOrder, true, true>(L + RING_OFF, XL, g, S, E); }
    xcd_barrier(bar);

    { DECL_PTRS; pg8::Gemm g{HB2, WUPT, D / 64, D * 2, D * 2, 0xffffffffu}; pg8::TileOrder S; S.init(M, 2 * FF, G, bx, D * 2, D * 2, 0, 1 << 30);
      pg8::EpiConv E{ACT8, SSQ2, conv_w, conv_b, GHB, UHB, GTB};
      pg8::gemm_phase<pg8::EpiConv, pg8::TileOrder, true>(L + RING_OFF, XL, g, S, E); }
    xcd_barrier(bar);

    { DECL_PTRS;
    for (int it = bx * 512 + tid; it < 256 * 22 * 2 * 32; it += G * 512) {
        const int c4 = (it & 31) * 4, rr = (it >> 5) & 1, tile = it >> 6, pm = tile / 22, pn = tile - pm * 22; const bool top = (pm & 31) == 0;
        const size_t sb = (size_t)tile * 256; const int col = pn * 128 + c4;
        const f32x4 g2 = *(const f32x4*)(GHB + sb + rr * 128 + c4), uu = *(const f32x4*)(UHB + sb + rr * 128 + c4);
        f32x4 g1 = (f32x4){0.f, 0.f, 0.f, 0.f}, g0 = (f32x4){0.f, 0.f, 0.f, 0.f};
        if (rr == 1) g1 = *(const f32x4*)(GHB + sb + c4); else if (!top) g1 = *(const f32x4*)(GTB + sb - 22 * 256 + 128 + c4);
        if (!top) g0 = *(const f32x4*)(GTB + sb - 22 * 256 + (rr == 1 ? 128 : 0) + c4);
        const f32x4 w0 = *(const f32x4*)(conv_w + col), w1 = *(const f32x4*)(conv_w + FF + col), w2 = *(const f32x4*)(conv_w + 2 * FF + col), cbv = *(const f32x4*)(conv_b + col);
        float res[4];
#pragma unroll
        for (int e = 0; e < 4; ++e) { const float gc = cbv[e] + w0[e] * g0[e] + w1[e] * g1[e] + w2[e] * g2[e]; res[e] = gc * __builtin_amdgcn_rcpf(1.0f + __builtin_amdgcn_exp2f(-LOG2E * gc)) * uu[e]; }
        *(unsigned*)(ACT8 + (size_t)(pm * 256 + rr) * FF + col) = pg8::pk4_fp8(res[0], res[1], res[2], res[3]);
    } }
    xcd_barrier(bar);

    { DECL_PTRS; pg8::Gemm g{ACT8, WDT, FF / 128, FF, FF, 0xffffffffu}; pg8::TileOrder S; S.init(M, D, G, bx, FF, FF, 0, 1 << 30);
      pg8::EpiResNorm E{out, out, g_final, 1.0f / 64.0f, SSQ3, (unsigned*)(ctl + CW_PANEL), (unsigned*)(ctl + CW_TMO2)};
      pg8::gemm_phase<pg8::EpiResNorm, pg8::TileOrder, true, true>(L + RING_OFF, XL, g, S, E); }
}

extern "C" void kernel_launch(void* const* d_in, const int* in_sizes, int n_in, void* d_out, int out_size, void* d_ws, size_t ws_size, hipStream_t stream) {
    static int grid = 0;
    if (grid == 0) {
        if (n_in != 19 || in_sizes[0] != M * D || out_size != M * D || ws_size < WS_END) { fprintf(stderr, "kernel_launch: unexpected problem shape (n_in %d, in0 %d, out %d, ws %zu); nothing launched\n", n_in, n_in > 0 ? in_sizes[0] : -1, out_size, ws_size); grid = -1; return; }
        int dev = 0, cus = 0, per_cu = 0;
        if (hipGetDevice(&dev) != hipSuccess || hipDeviceGetAttribute(&cus, hipDeviceAttributeMultiprocessorCount, dev) != hipSuccess) { grid = -1; return; }
        if (hipFuncSetAttribute((const void*)fwd, hipFuncAttributeMaxDynamicSharedMemorySize, LDS_BYTES) != hipSuccess) { fprintf(stderr, "kernel_launch: hipFuncSetAttribute failed\n"); grid = -1; return; }
        if (hipOccupancyMaxActiveBlocksPerMultiprocessor(&per_cu, (const void*)fwd, NWAVES * 64, LDS_BYTES) != hipSuccess || per_cu < 1) { fprintf(stderr, "kernel_launch: occupancy query reports %d\n", per_cu); }
        (void)hipGetLastError();
        grid = cus;
    }
    if (grid < 0) return;
    if (hipMemsetAsync((char*)d_ws + WS_CTL, 0, CTL_ZERO_BYTES, stream) != hipSuccess) return;
    Args a{};
    for (int i = 0; i < 19; ++i) a.in[i] = (const float*)d_in[i];
    a.out = (float*)d_out; a.ws = (unsigned char*)d_ws;
    hipLaunchKernelGGL(fwd, dim3(grid), dim3(NWAVES * 64), LDS_BYTES, stream, a);
}
```

```cpp
#include <hip/hip_runtime.h>
#include <hip/hip_bf16.h>
#include <cstdio>
#include <cstdint>

namespace pg8 {
#define PG8_LAS __attribute__((address_space(3)))
typedef unsigned short bf16_t;
typedef short bf16x8 __attribute__((ext_vector_type(8)));
typedef float f32x4 __attribute__((ext_vector_type(4)));
typedef float f32x2 __attribute__((ext_vector_type(2)));
typedef unsigned u32x4 __attribute__((ext_vector_type(4)));
typedef unsigned u32x2 __attribute__((ext_vector_type(2)));
typedef int i32x4 __attribute__((ext_vector_type(4)));
typedef int i32x8 __attribute__((ext_vector_type(8)));
constexpr int BM = 256, BK = 64, HALF = 128, HTB = HALF * BK * 2  , STAGE_BYTES = 8 * HTB, NXCD = 8, WGM = 8;

__host__ __device__ __forceinline__ int lds_byte(int r, int c) { const int st = (r >> 4) * 2 + (c >> 5), rr = r & 15, cc = c & 31, ob = rr * 64 + cc * 2; return st * 1024 + (ob ^ (((ob >> 9) & 1) << 5)); }
__host__ __device__ __forceinline__ void stage_rc(int b, int& R, int& C) { const int st = b / 1024, sb = b % 1024, swz = sb ^ (((sb >> 9) & 1) << 5); R = (st >> 1) * 16 + swz / 64; C = (st & 1) * 32 + (swz % 64) / 2; }
__host__ __device__ __forceinline__ int perm32(int rho) { const int n = rho >> 4, i = rho & 15; return 8 * (i >> 2) + 4 * n + (i & 3); }

struct Unit { int pm, pn; size_t aoff, boff; };
struct Gemm { const void* A; const void* Bt; int nt, lda, ldb; unsigned wrapmask; };

struct TileOrder {
    int nM, nN, nwg, G, c; size_t a_tile, b_tile, b_batch; int pmb;
    __device__ __forceinline__ void init(int M, int N, int G_, int c_, int lda_bytes, int ldb_bytes, size_t b_batch_bytes, int pm_per_batch) {
        nM = M / BM; nN = N / BM; nwg = nM * nN; G = G_; c = c_; a_tile = (size_t)BM * lda_bytes; b_tile = (size_t)BM * ldb_bytes; b_batch = b_batch_bytes; pmb = pm_per_batch; }
    __device__ __forceinline__ bool next(int i, Unit& u) const {
        const long L = (long)i * G + c; if (L >= nwg) return false;
        int wgid = (int)L; { const int q = nwg / NXCD, r = nwg % NXCD, xcd = wgid % NXCD, off = wgid / NXCD; wgid = (xcd < r ? xcd * (q + 1) : r * (q + 1) + (xcd - r) * q) + off; }
        const int nig = WGM * nN, gid = wgid / nig, fm = gid * WGM, gsz = (nM - fm) < WGM ? (nM - fm) : WGM;
        u.pm = fm + ((wgid % nig) % gsz); u.pn = (wgid % nig) / gsz;
        u.aoff = (size_t)u.pm * a_tile; u.boff = (size_t)u.pn * b_tile + (size_t)(u.pm / pmb) * b_batch; return true;
    }
};

__device__ __forceinline__ unsigned cvt_pk_bf16(float lo, float hi) { unsigned r; asm volatile("v_cvt_pk_bf16_f32 %0, %1, %2" : "=v"(r) : "v"(lo), "v"(hi)); return r; }

typedef f32x4 AccT[2][2][4][2];

struct EpiBf16 {
    static constexpr bool PERM = true;
    bf16_t* O; int ldc; unsigned scalemask; float scale0; unsigned* nrm;
    __device__ __forceinline__ void operator()(AccT& acc, const Unit& u, int wr, int wc, int fr, int fq, PG8_LAS unsigned char*) const {
        const int row0 = u.pm * BM + wr * 64 + fr, col0 = u.pn * BM + wc * 32 + 8 * fq;
        const float sc = ((scalemask >> u.pn) & 1u) ? scale0 : 1.f;
        if (nrm && (u.pn < 4 || (u.pn >= 6 && u.pn < 10))) {
#pragma unroll
            for (int bj = 0; bj < 2; ++bj) { float mx = 0.f;
#pragma unroll
                for (int ai = 0; ai < 2; ++ai)
#pragma unroll
                    for (int m = 0; m < 4; ++m) { const f32x4 v0 = acc[ai][bj][m][0] * sc, v1 = acc[ai][bj][m][1] * sc;
                        float q = (v0[0] * v0[0] + v0[1] * v0[1]) + (v0[2] * v0[2] + v0[3] * v0[3]) + (v1[0] * v1[0] + v1[1] * v1[1]) + (v1[2] * v1[2] + v1[3] * v1[3]);
                        q += __shfl_xor(q, 16); q += __shfl_xor(q, 32); mx = fmaxf(mx, q); }
                mx = fmaxf(mx, __shfl_xor(mx, 1)); mx = fmaxf(mx, __shfl_xor(mx, 2)); mx = fmaxf(mx, __shfl_xor(mx, 4)); mx = fmaxf(mx, __shfl_xor(mx, 8));
                if (fr == 0 && fq == 0) { const int head = (u.pn & 1) * 4 + 2 * bj + (wc >> 1); const int grp = u.pn < 4 ? (u.pn >> 1) : (u.pn >> 1) - 1; atomicMax(nrm + (((u.pm >> 5) * 8 + head) * 4 + grp) * 2 + (wc & 1), __float_as_uint(mx)); } } }
#pragma unroll
        for (int ai = 0; ai < 2; ++ai)
#pragma unroll
            for (int m = 0; m < 4; ++m) { bf16_t* rowp = O + (size_t)(row0 + ai * HALF + m * 16) * ldc + col0;
#pragma unroll
                for (int bj = 0; bj < 2; ++bj) { const f32x4 v0 = acc[ai][bj][m][0] * sc, v1 = acc[ai][bj][m][1] * sc;
                    u32x4 w; w.x = cvt_pk_bf16(v0[0], v0[1]); w.y = cvt_pk_bf16(v0[2], v0[3]); w.z = cvt_pk_bf16(v1[0], v1[1]); w.w = cvt_pk_bf16(v1[2], v1[3]);
                    *(u32x4*)(rowp + bj * HALF) = w; } }
    }
};
__device__ __forceinline__ unsigned pk4_fp8(float a, float b, float c, float d) { a = __builtin_amdgcn_fmed3f(a, -448.f, 448.f); b = __builtin_amdgcn_fmed3f(b, -448.f, 448.f); c = __builtin_amdgcn_fmed3f(c, -448.f, 448.f); d = __builtin_amdgcn_fmed3f(d, -448.f, 448.f); int w = 0;
    w = __builtin_amdgcn_cvt_pk_fp8_f32(a, b, w, false); w = __builtin_amdgcn_cvt_pk_fp8_f32(c, d, w, true); return (unsigned)w; }
struct EpiF8 {
    static constexpr bool PERM = true;
    unsigned char* O; int ldc; float sc;
    __device__ __forceinline__ void operator()(AccT& acc, const Unit& u, int wr, int wc, int fr, int fq, PG8_LAS unsigned char*) const {
        const int row0 = u.pm * BM + wr * 64 + fr, col0 = u.pn * BM + wc * 32 + 8 * fq;
#pragma unroll
        for (int ai = 0; ai < 2; ++ai)
#pragma unroll
            for (int m = 0; m < 4; ++m) { unsigned char* rowp = O + (size_t)(row0 + ai * HALF + m * 16) * ldc + col0;
#pragma unroll
                for (int bj = 0; bj < 2; ++bj) { const f32x4 v0 = acc[ai][bj][m][0] * sc, v1 = acc[ai][bj][m][1] * sc;
                    *(u32x2*)(rowp + bj * HALF) = (u32x2){pk4_fp8(v0[0], v0[1], v0[2], v0[3]), pk4_fp8(v1[0], v1[1], v1[2], v1[3])}; } }
    }
};
__device__ __forceinline__ float rstd_from_slots(const float* slots) {
    const f32x4 a = *(const f32x4*)slots, b = *(const f32x4*)(slots + 4), c = *(const f32x4*)(slots + 8), d = *(const f32x4*)(slots + 12);
    const float s = ((a[0] + a[1]) + (a[2] + a[3])) + ((b[0] + b[1]) + (b[2] + b[3])) + ((c[0] + c[1]) + (c[2] + c[3])) + ((d[0] + d[1]) + (d[2] + d[3]));
    return __builtin_amdgcn_rsqf(s * (1.0f / 1024.0f) + 1e-6f);
}
#define PG8_DPP(old, src, ctrl) __builtin_bit_cast(float, __builtin_amdgcn_update_dpp(__builtin_bit_cast(int, (float)(old)), __builtin_bit_cast(int, (float)(src)), (ctrl), 0xf, 0xf, false))
struct EpiConv {
    static constexpr bool PERM = true;
    unsigned char* act; const float* ssq; const float* cw; const float* cbias; float* GH; float* UH; float* GT;
    __device__ __forceinline__ void operator()(AccT& acc, const Unit& u, int wr, int wc, int fr, int fq, PG8_LAS unsigned char* xl) const {
        PG8_LAS float* H = (PG8_LAS float*)xl;
        const int cl = wc * 32 + 8 * fq;
        const int row0 = u.pm * BM + wr * 64 + fr;
        PG8_LAS float* Sr = H + 1024;
        { const int t_ = threadIdx.x; if (t_ < 256) Sr[t_] = rstd_from_slots(ssq + (size_t)(u.pm * BM + t_) * 16); }
        asm volatile("s_waitcnt vmcnt(0) lgkmcnt(0)" ::: "memory"); __builtin_amdgcn_s_barrier(); asm volatile("" ::: "memory");
#pragma unroll
        for (int ai = 0; ai < 2; ++ai)
#pragma unroll
            for (int m = 0; m < 4; ++m) { const float rs = Sr[ai * HALF + wr * 64 + m * 16 + fr];
#pragma unroll
                for (int bj = 0; bj < 2; ++bj)
#pragma unroll
                    for (int n = 0; n < 2; ++n) acc[ai][bj][m][n] *= rs; }
        const size_t sb = ((size_t)(u.pm * 22 + u.pn) * 2) * 128 + cl;
        if (fr >= 14) {
#pragma unroll
            for (int ai = 0; ai < 2; ++ai)
#pragma unroll
                for (int n = 0; n < 2; ++n) *(PG8_LAS f32x4*)(H + ((ai * 2 + wr) * 2 + (fr - 14)) * 128 + cl + 4 * n) = acc[ai][0][3][n];
            if (wr == 1) {
#pragma unroll
                for (int n = 0; n < 2; ++n) *(f32x4*)(GT + sb + (fr - 14) * 128 + 4 * n) = acc[1][0][3][n]; } }
        if (wr == 0 && fr < 2) {
#pragma unroll
            for (int n = 0; n < 2; ++n) { *(f32x4*)(GH + sb + fr * 128 + 4 * n) = acc[0][0][0][n]; *(f32x4*)(UH + sb + fr * 128 + 4 * n) = acc[0][1][0][n]; } }
        asm volatile("s_waitcnt lgkmcnt(0)" ::: "memory"); __builtin_amdgcn_s_barrier(); asm volatile("" ::: "memory");
#pragma unroll
        for (int n = 0; n < 2; ++n) {
            const int c0 = u.pn * 128 + cl + 4 * n;
            const f32x4 w0 = *(const f32x4*)(cw + c0), w1 = *(const f32x4*)(cw + 2816 + c0), w2 = *(const f32x4*)(cw + 2 * 2816 + c0), cbv = *(const f32x4*)(cbias + c0);
#pragma unroll
            for (int ai = 0; ai < 2; ++ai) {
                const int hsrc = wr == 1 ? ai * 2 : (ai == 1 ? 1 : 0);
                const f32x4 h14 = *(const PG8_LAS f32x4*)(H + (hsrc * 2 + 0) * 128 + cl + 4 * n), h15 = *(const PG8_LAS f32x4*)(H + (hsrc * 2 + 1) * 128 + cl + 4 * n);
#pragma unroll
                for (int m = 3; m >= 0; --m) {
                    float res[4];
#pragma unroll
                    for (int i = 0; i < 4; ++i) { const float X = acc[ai][0][m][n][i];
                        float o1, o2;
                        if (m > 0) { const float Xp = acc[ai][0][m > 0 ? m - 1 : 0][n][i]; o1 = PG8_DPP(0.f, Xp, 0x121); o2 = PG8_DPP(0.f, Xp, 0x122); }
                        else { o1 = h15[i]; o2 = fr == 0 ? h14[i] : h15[i]; }
                        const float g1 = PG8_DPP(o1, X, 0x111), g0 = PG8_DPP(o2, X, 0x112);
                        const float gc = cbv[i] + w0[i] * g0 + w1[i] * g1 + w2[i] * X;
                        res[i] = gc * __builtin_amdgcn_rcpf(1.0f + __builtin_amdgcn_exp2f(-1.4426950408889634f * gc)) * acc[ai][1][m][n][i]; }
                    const int row = row0 + ai * HALF + m * 16;
                    if (!(ai == 0 && m == 0 && wr == 0 && fr < 2))
                        *(unsigned*)(act + (size_t)row * 2816 + c0) = pk4_fp8(res[0], res[1], res[2], res[3]);
                } } }
    }
};
template <bool BASEB, bool OUTF> struct EpiRes {
    static constexpr bool PERM = true;
    const float* base; const bf16_t* baseb; float* out; bf16_t* hb; unsigned char* hb8; float* ssq; float accs;
    __device__ __forceinline__ void operator()(AccT& acc, const Unit& u, int wr, int wc, int fr, int fq, PG8_LAS unsigned char*) const {
        const int row0 = u.pm * BM + wr * 64 + fr, col0 = u.pn * BM + wc * 32 + 8 * fq;
#pragma unroll
        for (int ai = 0; ai < 2; ++ai)
#pragma unroll
            for (int m = 0; m < 4; ++m) { const int row = row0 + ai * HALF + m * 16; const size_t off = (size_t)row * 1024 + col0; float q = 0.f;
#pragma unroll
                for (int bj = 0; bj < 2; ++bj) {
                    f32x4 b0, b1;
                    if constexpr (BASEB) { const u32x4 bw = *(const u32x4*)(baseb + off + bj * HALF);
                        b0 = (f32x4){__builtin_bit_cast(float, bw.x << 16), __builtin_bit_cast(float, bw.x & 0xffff0000u), __builtin_bit_cast(float, bw.y << 16), __builtin_bit_cast(float, bw.y & 0xffff0000u)};
                        b1 = (f32x4){__builtin_bit_cast(float, bw.z << 16), __builtin_bit_cast(float, bw.z & 0xffff0000u), __builtin_bit_cast(float, bw.w << 16), __builtin_bit_cast(float, bw.w & 0xffff0000u)}; }
                    else { b0 = *(const f32x4*)(base + off + bj * HALF); b1 = *(const f32x4*)(base + off + bj * HALF + 4); }
                    const f32x4 v0 = acc[ai][bj][m][0] * accs + b0, v1 = acc[ai][bj][m][1] * accs + b1;
                    if constexpr (OUTF) { *(f32x4*)(out + off + bj * HALF) = v0; *(f32x4*)(out + off + bj * HALF + 4) = v1; }
                    q += (v0[0] * v0[0] + v0[1] * v0[1]) + (v0[2] * v0[2] + v0[3] * v0[3]) + (v1[0] * v1[0] + v1[1] * v1[1]) + (v1[2] * v1[2] + v1[3] * v1[3]);
                    if (hb) { u32x4 w; w.x = cvt_pk_bf16(v0[0], v0[1]); w.y = cvt_pk_bf16(v0[2], v0[3]); w.z = cvt_pk_bf16(v1[0], v1[1]); w.w = cvt_pk_bf16(v1[2], v1[3]); *(u32x4*)(hb + off + bj * HALF) = w; }
                    if (hb8) *(u32x2*)(hb8 + off + bj * HALF) = (u32x2){pk4_fp8(v0[0], v0[1], v0[2], v0[3]), pk4_fp8(v1[0], v1[1], v1[2], v1[3])}; }
                q += __shfl_xor(q, 16); q += __shfl_xor(q, 32);
                if (fq == 0) ssq[(size_t)row * 16 + u.pn * 4 + wc] = q; }
    }
};
struct EpiResNorm {
    static constexpr bool PERM = true;
    const bf16_t* baseb; float* out; const float* gfin; float accs; float* xbuf; unsigned* cnt; unsigned* tmo;
    __device__ __forceinline__ void operator()(AccT& acc, const Unit& u, int wr, int wc, int fr, int fq, PG8_LAS unsigned char* xl) const {
        PG8_LAS float* Pp = (PG8_LAS float*)xl;
        PG8_LAS float* Sr = Pp + 1024;
        PG8_LAS unsigned* flag = (PG8_LAS unsigned*)(Sr + 256);
        const int tid = threadIdx.x, wid = tid >> 6, lane = tid & 63;
        const int row0 = u.pm * BM + wr * 64 + fr, col0 = u.pn * BM + wc * 32 + 8 * fq;
#pragma unroll
        for (int ai = 0; ai < 2; ++ai)
#pragma unroll
            for (int m = 0; m < 4; ++m) { const int row = row0 + ai * HALF + m * 16; const size_t off = (size_t)row * 1024 + col0; float q = 0.f;
#pragma unroll
                for (int bj = 0; bj < 2; ++bj) {
                    const u32x4 bw = *(const u32x4*)(baseb + off + bj * HALF);
                    const f32x4 b0 = (f32x4){__builtin_bit_cast(float, bw.x << 16), __builtin_bit_cast(float, bw.x & 0xffff0000u), __builtin_bit_cast(float, bw.y << 16), __builtin_bit_cast(float, bw.y & 0xffff0000u)};
                    const f32x4 b1 = (f32x4){__builtin_bit_cast(float, bw.z << 16), __builtin_bit_cast(float, bw.z & 0xffff0000u), __builtin_bit_cast(float, bw.w << 16), __builtin_bit_cast(float, bw.w & 0xffff0000u)};
                    const f32x4 v0 = acc[ai][bj][m][0] * accs + b0, v1 = acc[ai][bj][m][1] * accs + b1; acc[ai][bj][m][0] = v0; acc[ai][bj][m][1] = v1;
                    q += (v0[0] * v0[0] + v0[1] * v0[1]) + (v0[2] * v0[2] + v0[3] * v0[3]) + (v1[0] * v1[0] + v1[1] * v1[1]) + (v1[2] * v1[2] + v1[3] * v1[3]); }
                q += __shfl_xor(q, 16); q += __shfl_xor(q, 32);
                if (fq == 0) Pp[(ai * HALF + wr * 64 + m * 16 + fr) * 4 + wc] = q; }
        asm volatile("s_waitcnt lgkmcnt(0)" ::: "memory"); __builtin_amdgcn_s_barrier(); asm volatile("" ::: "memory");
        if (wid < 4) { const int r = wid * 64 + lane; const f32x4 p = *(const PG8_LAS f32x4*)(Pp + r * 4);
            __hip_atomic_store(xbuf + (size_t)(u.pm * BM + r) * 4 + u.pn, (p[0] + p[1]) + (p[2] + p[3]), __ATOMIC_RELAXED, __HIP_MEMORY_SCOPE_AGENT);
            asm volatile("s_waitcnt vmcnt(0)" ::: "memory");
            if (lane == 0) __hip_atomic_fetch_add(cnt + 64 * u.pm, 1u, __ATOMIC_RELAXED, __HIP_MEMORY_SCOPE_AGENT); }
        if (wid == 0) { unsigned sp = 0u; bool dead = false;
            for (;;) { if ((unsigned)__builtin_amdgcn_readfirstlane(__hip_atomic_load(cnt + 64 * u.pm, __ATOMIC_RELAXED, __HIP_MEMORY_SCOPE_AGENT)) >= 16u) break;
                if (++sp > (1u << 20)) { if (lane == 0) __hip_atomic_store(tmo, 1u, __ATOMIC_RELAXED, __HIP_MEMORY_SCOPE_AGENT); dead = true; break; }
                __builtin_amdgcn_s_sleep(2); }
            __builtin_amdgcn_fence(__ATOMIC_ACQUIRE, "agent");
            if (lane == 0) flag[0] = dead ? 1u : 0u; }
        asm volatile("s_waitcnt vmcnt(0) lgkmcnt(0)" ::: "memory"); __builtin_amdgcn_s_barrier(); asm volatile("" ::: "memory");
        if (wid < 4) { const int r = wid * 64 + lane; const float* xs = xbuf + (size_t)(u.pm * BM + r) * 4; float s = 0.f;
#pragma unroll
            for (int t = 0; t < 4; ++t) s += __hip_atomic_load(xs + t, __ATOMIC_RELAXED, __HIP_MEMORY_SCOPE_AGENT);
            Sr[r] = __builtin_amdgcn_rsqf(s * (1.0f / 1024.0f) + 1e-6f); }
        asm volatile("s_waitcnt vmcnt(0) lgkmcnt(0)" ::: "memory"); __builtin_amdgcn_s_barrier(); asm volatile("" ::: "memory");
        f32x4 gg[2][2];
#pragma unroll
        for (int bj = 0; bj < 2; ++bj) { gg[bj][0] = *(const f32x4*)(gfin + col0 + bj * HALF); gg[bj][1] = *(const f32x4*)(gfin + col0 + bj * HALF + 4); }
#pragma unroll
        for (int ai = 0; ai < 2; ++ai)
#pragma unroll
            for (int m = 0; m < 4; ++m) { const int rl = ai * HALF + wr * 64 + m * 16 + fr; const float rs = Sr[rl]; const size_t off = (size_t)(u.pm * BM + rl) * 1024 + col0;
#pragma unroll
                for (int bj = 0; bj < 2; ++bj) { *(f32x4*)(out + off + bj * HALF) = acc[ai][bj][m][0] * rs * gg[bj][0]; *(f32x4*)(out + off + bj * HALF + 4) = acc[ai][bj][m][1] * rs * gg[bj][1]; } }
    }
};
struct EpiSoftmax {
    static constexpr bool PERM = true;
    unsigned char* P; const float* ssq; float sscale;
    __device__ __forceinline__ void operator()(AccT& acc, const Unit& u, int wr, int wc, int fr, int fq, PG8_LAS unsigned char* xl) const {
        PG8_LAS f32x2* X = (PG8_LAS f32x2*)xl;
        const int row0 = u.pm * BM + wr * 64 + fr, col0 = u.pn * BM + wc * 32 + 8 * fq;
        float ml[2][4];
#pragma unroll
        for (int ai = 0; ai < 2; ++ai)
#pragma unroll
            for (int m = 0; m < 4; ++m) { const int row = row0 + ai * HALF + m * 16; const float rs = rstd_from_slots(ssq + (size_t)row * 16) * sscale;
                float mx = -3.0e38f;
#pragma unroll
                for (int bj = 0; bj < 2; ++bj)
#pragma unroll
                    for (int n = 0; n < 2; ++n) { f32x4 v = acc[ai][bj][m][n] * rs; acc[ai][bj][m][n] = v; mx = fmaxf(fmaxf(mx, fmaxf(v[0], v[1])), fmaxf(v[2], v[3])); }
                mx = fmaxf(mx, __shfl_xor(mx, 16)); mx = fmaxf(mx, __shfl_xor(mx, 32));
                float s = 0.f;
#pragma unroll
                for (int bj = 0; bj < 2; ++bj)
#pragma unroll
                    for (int n = 0; n < 2; ++n) { f32x4 v = acc[ai][bj][m][n];
                        v[0] = __builtin_amdgcn_exp2f(v[0] - mx); v[1] = __builtin_amdgcn_exp2f(v[1] - mx); v[2] = __builtin_amdgcn_exp2f(v[2] - mx); v[3] = __builtin_amdgcn_exp2f(v[3] - mx);
                        acc[ai][bj][m][n] = v; s += (v[0] + v[1]) + (v[2] + v[3]); }
                s += __shfl_xor(s, 16); s += __shfl_xor(s, 32);
                ml[ai][m] = mx;
                if (fq == 0) X[(ai * HALF + wr * 64 + m * 16 + fr) * 4 + wc] = (f32x2){mx, s}; }
        asm volatile("s_waitcnt lgkmcnt(0)" ::: "memory"); __builtin_amdgcn_s_barrier(); asm volatile("" ::: "memory");
#pragma unroll
        for (int ai = 0; ai < 2; ++ai)
#pragma unroll
            for (int m = 0; m < 4; ++m) { const int rl = ai * HALF + wr * 64 + m * 16 + fr; const int row = u.pm * BM + rl;
                const f32x2 a = X[rl * 4 + 0], b = X[rl * 4 + 1], c = X[rl * 4 + 2], d = X[rl * 4 + 3];
                const float Mx = fmaxf(fmaxf(a.x, b.x), fmaxf(c.x, d.x));
                const float L = a.y * __builtin_amdgcn_exp2f(a.x - Mx) + b.y * __builtin_amdgcn_exp2f(b.x - Mx) + c.y * __builtin_amdgcn_exp2f(c.x - Mx) + d.y * __builtin_amdgcn_exp2f(d.x - Mx);
                const float f = __builtin_amdgcn_exp2f(ml[ai][m] - Mx) * __builtin_amdgcn_rcpf(L) * 256.0f;
                unsigned char* rowp = P + (size_t)row * 1024 + col0;
#pragma unroll
                for (int bj = 0; bj < 2; ++bj) { const f32x4 v0 = acc[ai][bj][m][0] * f, v1 = acc[ai][bj][m][1] * f;
                    *(u32x2*)(rowp + bj * HALF) = (u32x2){pk4_fp8(v0[0], v0[1], v0[2], v0[3]), pk4_fp8(v1[0], v1[1], v1[2], v1[3])}; } }
    }
};
struct EpiGate {
    static constexpr bool PERM = false;
    unsigned* sel;
    __device__ __forceinline__ void operator()(AccT& acc, const Unit& u, int wr, int wc, int fr, int fq, PG8_LAS unsigned char*) const {
        const int own = u.pm & 31;
#pragma unroll
        for (int ai = 0; ai < 2; ++ai)
#pragma unroll
            for (int m = 0; m < 4; ++m) { const int row = u.pm * BM + ai * HALF + wr * 64 + m * 16 + fr;
#pragma unroll
                for (int bj = 0; bj < 2; ++bj) { unsigned mask = 0u;
#pragma unroll
                    for (int round = 0; round < 3; ++round) { float bv = -3.0e38f; int bi = 32;
#pragma unroll
                        for (int n = 0; n < 2; ++n)
#pragma unroll
                            for (int i = 0; i < 4; ++i) { const int nb = 16 * n + 4 * fq + i; const float v = acc[ai][bj][m][n][i];
                                if (nb < own && !((mask >> nb) & 1u) && v > bv) { bv = v; bi = nb; } }
#pragma unroll
                        for (int off = 16; off <= 32; off <<= 1) { const float ov = __shfl_xor(bv, off); const int oi = __shfl_xor(bi, off); if (ov > bv || (ov == bv && oi < bi)) { bv = ov; bi = oi; } }
                        if (bi < 32) mask |= 1u << bi; }
                    if (fq == 0) sel[((size_t)((u.pm >> 5) * 8 + 4 * bj + wc)) * 8192 + (row & 8191)] = mask; } }
    }
};

template <class Epi, class Sched, bool ALIGN_EPI, bool F8 = false>
__device__ __forceinline__ void gemm_phase(PG8_LAS unsigned char* lds, PG8_LAS unsigned char* xl, const Gemm g, const Sched& S, const Epi& E) {
    int tid_ = threadIdx.x; asm volatile("" : "+v"(tid_));
    const int tid = tid_, wid = __builtin_amdgcn_readfirstlane(tid >> 6), lane = tid & 63, wr = wid >> 2, wc = wid & 3, fr = lane & 15, fq = lane >> 4;
    int nt = g.nt; asm volatile("" : "+s"(nt));
    unsigned voffA[2], voffB[2];
#pragma unroll
    for (int i = 0; i < 2; ++i) { int R, C; stage_rc(tid * 16 + i * 8192, R, C); const int Rb = Epi::PERM ? ((R & ~31) + perm32(R & 31)) : R;
        voffA[i] = (unsigned)(R * g.lda + C * 2); voffB[i] = (unsigned)(Rb * g.ldb + C * 2); }
    const size_t kstep = (size_t)(BK * 2);
    const size_t hstepA = (size_t)HALF * g.lda, hstepB = (size_t)HALF * g.ldb;
    const unsigned wmask = g.wrapmask;
    const unsigned ldsw = (unsigned)wid * 1024u;
    const int aoff = lds_byte(wr * 64 + fr, fq * 8), boff = lds_byte(wc * 32 + fr, fq * 8);
#define PG8_SA(b, h) (((b) * 2 + (h)) * HTB)
#define PG8_SB(b, h) ((4 + (b) * 2 + (h)) * HTB)
#define PG8_STAGE(bufoff, gbase, voff) do { _Pragma("unroll") for (int _i = 0; _i < 2; ++_i) \
        __builtin_amdgcn_global_load_lds((const unsigned*)((const char*)(gbase) + (voff)[_i]), (PG8_LAS unsigned*)(lds + (bufoff) + ldsw + _i * 8192), 16, 0, 0); } while (0)
#define PG8_LDA(dst, b, h) do { if constexpr (F8) { _Pragma("unroll") for (int m = 0; m < 4; ++m) { dst##8[m].lo = *(const PG8_LAS i32x4*)(lds + PG8_SA(b, h) + aoff + m * 2048); dst##8[m].hi = *(const PG8_LAS i32x4*)(lds + PG8_SA(b, h) + aoff + m * 2048 + 1024); } } \
        else { _Pragma("unroll") for (int m = 0; m < 4; ++m) _Pragma("unroll") for (int k = 0; k < 2; ++k) dst[m][k] = *(const PG8_LAS bf16x8*)(lds + PG8_SA(b, h) + aoff + m * 2048 + k * 1024); } } while (0)
#define PG8_LDB(dst, b, h) do { if constexpr (F8) { _Pragma("unroll") for (int n = 0; n < 2; ++n) { dst##8[n].lo = *(const PG8_LAS i32x4*)(lds + PG8_SB(b, h) + boff + n * 2048); dst##8[n].hi = *(const PG8_LAS i32x4*)(lds + PG8_SB(b, h) + boff + n * 2048 + 1024); } } \
        else { _Pragma("unroll") for (int n = 0; n < 2; ++n) _Pragma("unroll") for (int k = 0; k < 2; ++k) dst[n][k] = *(const PG8_LAS bf16x8*)(lds + PG8_SB(b, h) + boff + n * 2048 + k * 1024); } } while (0)
#define PG8_MMA(ai, bj, At, Bt) do { __builtin_amdgcn_s_setprio(1); \
        if constexpr (F8) { _Pragma("unroll") for (int m = 0; m < 4; ++m) _Pragma("unroll") for (int n = 0; n < 2; ++n) \
            asm volatile("v_mfma_f32_16x16x128_f8f6f4 %0, %1, %2, %0" : "+v"(acc[ai][bj][m][n]) : "v"(Bt##8[n]), "v"(At##8[m])); } \
        else { _Pragma("unroll") for (int m = 0; m < 4; ++m) _Pragma("unroll") for (int n = 0; n < 2; ++n) _Pragma("unroll") for (int k = 0; k < 2; ++k) \
            acc[ai][bj][m][n] = __builtin_amdgcn_mfma_f32_16x16x32_bf16(Bt[n][k], At[m][k], acc[ai][bj][m][n], 0, 0, 0); } \
        __builtin_amdgcn_s_setprio(0); } while (0)
#define PG8_WAIT_V(n) asm volatile("s_waitcnt vmcnt(" #n ")" ::: "memory")
#define PG8_WAIT_L(n) asm volatile("s_waitcnt lgkmcnt(" #n ")" ::: "memory")
#define PG8_BAR __builtin_amdgcn_s_barrier()
#define PG8_SCHED __builtin_amdgcn_sched_barrier(0)
    Unit cur, nxt; int ui = 0;
    if (!S.next(0, cur)) return;
    AccT acc;
    bf16x8 At[4][2], B0[2][2], B1[2][2]; i32x8 At8[4], B08[2], B18[2];
    const char* cA = (const char*)g.A + cur.aoff; const char* cB = (const char*)g.Bt + cur.boff;
    PG8_STAGE(PG8_SB(0, 0), cB, voffB); PG8_STAGE(PG8_SB(0, 1), cB + hstepB, voffB); PG8_STAGE(PG8_SA(0, 0), cA, voffA); PG8_STAGE(PG8_SA(0, 1), cA + hstepA, voffA);
    if (wr == 1) PG8_BAR;
    PG8_WAIT_V(2); PG8_BAR;
    PG8_STAGE(PG8_SB(1, 0), cB + kstep, voffB); PG8_STAGE(PG8_SA(1, 0), cA + kstep, voffA); PG8_STAGE(PG8_SB(1, 1), cB + hstepB + kstep, voffB);
    PG8_WAIT_V(6); PG8_BAR;
    { float z0; asm volatile("v_mov_b32 %0, 0" : "=v"(z0));
#pragma unroll
    for (int a = 0; a < 2; ++a)
#pragma unroll
        for (int b = 0; b < 2; ++b)
#pragma unroll
            for (int m = 0; m < 4; ++m)
#pragma unroll
                for (int n = 0; n < 2; ++n) acc[a][b][m][n] = (f32x4){z0, z0, z0, z0}; }
    for (;;) {
        const bool has_next = S.next(ui + 1, nxt);
        const char* nA = has_next ? (const char*)g.A + nxt.aoff : cA; const char* nB = has_next ? (const char*)g.Bt + nxt.boff : cB;
#pragma unroll 1
        for (int t = 0; t < nt; t += 2) {
            const bool last = (t == nt - 2);
            const char* a1 = cA + (size_t)((unsigned)(t * 128) & wmask) + kstep;
            const char* a2 = last ? nA : cA + (size_t)((unsigned)((t + 2) * 128) & wmask); const char* b2 = last ? nB : cB + (size_t)(t + 2) * kstep;
            const char* a3 = a2 + kstep; const char* b3 = b2 + kstep;
            PG8_LDB(B0, 0, 0); PG8_LDB(B1, 0, 1); PG8_SCHED; PG8_LDA(At, 0, 0); PG8_STAGE(PG8_SA(1, 1), a1 + hstepA, voffA);
            PG8_WAIT_V(8); PG8_WAIT_L(0); PG8_BAR; PG8_MMA(0, 0, At, B0); PG8_MMA(0, 1, At, B1); PG8_BAR; PG8_SCHED;
            PG8_LDA(At, 0, 1); PG8_STAGE(PG8_SB(0, 0), b2, voffB); PG8_STAGE(PG8_SB(0, 1), b2 + hstepB, voffB); PG8_STAGE(PG8_SA(0, 0), a2, voffA);
            PG8_WAIT_V(8); PG8_WAIT_L(0); PG8_BAR; PG8_MMA(1, 0, At, B0); PG8_MMA(1, 1, At, B1); PG8_BAR; PG8_SCHED;
            PG8_LDB(B0, 1, 0); PG8_LDB(B1, 1, 1); PG8_SCHED; PG8_LDA(At, 1, 0); PG8_STAGE(PG8_SA(0, 1), a2 + hstepA, voffA);
            PG8_WAIT_V(8); PG8_WAIT_L(0); PG8_BAR; PG8_MMA(0, 0, At, B0); PG8_MMA(0, 1, At, B1); PG8_BAR; PG8_SCHED;
            PG8_LDA(At, 1, 1); PG8_STAGE(PG8_SB(1, 0), b3, voffB); PG8_STAGE(PG8_SB(1, 1), b3 + hstepB, voffB); PG8_STAGE(PG8_SA(1, 0), a3, voffA);
            PG8_WAIT_V(8); PG8_WAIT_L(0); PG8_BAR; PG8_MMA(1, 0, At, B0); PG8_MMA(1, 1, At, B1); PG8_BAR; PG8_SCHED;
        }
        if constexpr (F8) asm volatile("s_nop 15\n\ts_nop 15" ::: "memory");
        if constexpr (ALIGN_EPI) { if (wr == 0) PG8_BAR; }
        E(acc, cur, wr, wc, fr, fq, xl);
        if (!has_next) break;
#pragma unroll
        for (int a = 0; a < 2; ++a)
#pragma unroll
            for (int b = 0; b < 2; ++b)
#pragma unroll
                for (int m = 0; m < 4; ++m)
#pragma unroll
                    for (int n = 0; n < 2; ++n) acc[a][b][m][n] = (f32x4){0.f, 0.f, 0.f, 0.f};
        cur = nxt; cA = nA; cB = nB; ++ui;
        if constexpr (ALIGN_EPI) { if (wr == 1) PG8_BAR; }
    }
    PG8_WAIT_V(0);
    if constexpr (!ALIGN_EPI) { if (wr == 0) PG8_BAR; }
    PG8_BAR;
#undef PG8_SA
#undef PG8_SB
#undef PG8_STAGE
#undef PG8_LDA
#undef PG8_LDB
#undef PG8_MMA
#undef PG8_WAIT_V
#undef PG8_WAIT_L
#undef PG8_BAR
#undef PG8_SCHED
}
}

constexpr int NWAVES = 8;
constexpr int NB = 8, T = 8192, D = 1024, M = NB * T;
constexpr int INC = 3080, NQKV = 3072, FF = 2816;
constexpr int C_F = 1536, C_QM = 1544, C_KM = 2056;
constexpr float LOG2E = 1.4426950408889634f;
constexpr float C2 = 0.125f * LOG2E;
constexpr float RMS_EPS = 1e-6f;

constexpr size_t MiB = 1u << 20;
constexpr size_t WS_CTL = 0, CTL_ZERO_BYTES = 1 * MiB;
constexpr size_t WS_LOGF = 2 * MiB, WS_C = 4 * MiB, WS_ABAR = 6 * MiB, WS_KM = 7 * MiB, WS_SEL = 8 * MiB;
constexpr size_t WS_SSQ1 = 10 * MiB, WS_SSQ2 = 14 * MiB, WS_SSQ3 = 18 * MiB;
constexpr size_t WS_MEMN = 22 * MiB, WS_KV = 26 * MiB, WS_WQS = 34 * MiB, WS_WOT = 36 * MiB, WS_WKVT = 38 * MiB, WS_WINT = 42 * MiB, WS_WOUTT = 48 * MiB;
constexpr size_t WS_WUPT = 50 * MiB, WS_WDT = 976 * MiB  , WS_ZT = 68 * MiB, WS_WQK = 80 * MiB, WS_VWO = 96 * MiB;
constexpr size_t WS_ACT8 = 240 * MiB;
constexpr size_t WS_GH = 416 * MiB, WS_UH = 424 * MiB, WS_GT = 432 * MiB;
constexpr size_t WS_A1 = 112 * MiB;
constexpr size_t WS_QKV = 368 * MiB;
constexpr size_t WS_Y = 752 * MiB, WS_HB1 = WS_A1 + 128 * MiB, WS_P = WS_QKV, WS_HB2 = WS_A1;
constexpr size_t WS_HB1F = WS_A1;
constexpr size_t WS_PO = WS_A1;
constexpr size_t WS_LIST = 880 * MiB, WS_PML = 944 * MiB, WS_KXF = 960 * MiB, WS_KXM = 968 * MiB, WS_CNT = 969 * MiB;
constexpr size_t WS_G = 240 * MiB, WS_U = 592 * MiB, WS_END = 1024 * MiB;
static_assert(WS_WUPT + (size_t)2 * FF * D * 2 <= WS_ZT && WS_ACT8 + (size_t)M * FF <= WS_GH && WS_WDT + (size_t)D * FF <= WS_END && WS_CNT + 8192 <= WS_WDT && WS_ZT + (size_t)8 * 256 * 3072 * 2 <= WS_WQK && WS_VWO + 16 * MiB <= WS_A1, "ws map");
static_assert(WS_G + (size_t)M * FF * 2 <= WS_U && WS_U + (size_t)M * FF * 2 <= WS_END && WS_Y + (size_t)M * D * 2 <= WS_LIST && WS_LIST + (size_t)2048 * 8192 * 4 <= WS_PML && WS_PML + (size_t)M * 32 * 8 <= WS_KXF && WS_KXF + (size_t)64 * 8192 * 16 <= WS_KXM, "ws map 2");
constexpr int CW_BAR = 4096;
constexpr int CW_QKN = 8192;
constexpr int CW_QUEUE = 12288;
constexpr int CW_T0TAB = 16384;
constexpr int CW_PANEL = 32768, CW_TMO2 = 20480;

constexpr int RING_OFF = 0, RING_BYTES = 131072;
constexpr int LDSCTL_OFF = RING_BYTES, MISC_OFF = LDSCTL_OFF + 320;
constexpr int XL_OFF = RING_BYTES + 512;
constexpr int LDS_BYTES = 147456;
static_assert(XL_OFF + 8192 <= LDS_BYTES, "LDS map");

#define GAS __attribute__((address_space(1)))
#define LAS __attribute__((address_space(3)))
typedef unsigned short bf16;
typedef unsigned v4u __attribute__((ext_vector_type(4)));
typedef float f32x4 __attribute__((ext_vector_type(4)));
typedef GAS unsigned gu32;
#define RLX_AGENT __ATOMIC_RELAXED, __HIP_MEMORY_SCOPE_AGENT
#define LDS_WAIT() asm volatile("s_waitcnt lgkmcnt(0)" ::: "memory")
__device__ __forceinline__ unsigned f2bf(float f) { unsigned u = __builtin_bit_cast(unsigned, f); return (u + 0x7fffu + ((u >> 16) & 1u)) >> 16; }
__device__ __forceinline__ unsigned pk2(float lo, float hi) { unsigned r; asm("v_cvt_pk_bf16_f32 %0, %1, %2" : "=v"(r) : "v"(lo), "v"(hi)); return r; }
__device__ __forceinline__ float bf2f(unsigned b) { return __builtin_bit_cast(float, b << 16); }
__device__ __forceinline__ float bflo(unsigned w) { return __builtin_bit_cast(float, w << 16); }
__device__ __forceinline__ float bfhi(unsigned w) { return __builtin_bit_cast(float, w & 0xffff0000u); }

#define XB_TMO      128
#define XB_XCNT(j)  (256  + 64 * (j))
#define XB_XSUB(j)  (1280 + 64 * (j))
#define XB_XGEN(j)  (2304 + 64 * (j))
#define XB_TOP      3328
#define XB_TOPGEN   3392
#define XCD_BAR_WORDS 3456
#define XB_SPIN_CAP (1u << 18)

__device__ __forceinline__ unsigned xb_ld(unsigned* p)              { return __hip_atomic_load(p, __ATOMIC_RELAXED, __HIP_MEMORY_SCOPE_AGENT); }
__device__ __forceinline__ unsigned xb_add(unsigned* p, unsigned v) { return __hip_atomic_fetch_add(p, v, __ATOMIC_RELAXED, __HIP_MEMORY_SCOPE_AGENT); }
__device__ __forceinline__ unsigned xb_xcc_id() { return (unsigned)__builtin_amdgcn_s_getreg((3 << 11) | 20) & 0xFu; }
#define XB_SPIN(cond, bar) do { unsigned _sp = 0; while (cond) { __builtin_amdgcn_s_sleep(1); \
    if ((++_sp & 255u) == 0u) { if (xb_ld(&(bar)[XB_TMO])) break; if (_sp > XB_SPIN_CAP) { atomicAdd(&(bar)[XB_TMO], 1u); break; } } } } while (0)

struct XcdBarrier { unsigned* bar; unsigned x; volatile LAS unsigned* st; };

__device__ __forceinline__ XcdBarrier xcd_barrier_post(unsigned* bar, volatile LAS unsigned* st) {
    XcdBarrier b; b.bar = bar; b.x = xb_xcc_id(); b.st = st;
    if (threadIdx.x == 0) (void)xb_add(&bar[XB_XCNT(b.x)], 1u);
    return b;
}
__device__ __forceinline__ void xcd_barrier_complete(unsigned* bar, unsigned x, unsigned& nloc, unsigned& nx) {
    const unsigned G = gridDim.x * gridDim.y * gridDim.z;
    unsigned sum, cnt, mine, sp = 0u;
    for (;;) {
        sum = 0u; cnt = 0u; mine = 0u;
#pragma unroll
        for (unsigned j = 0; j < 16; ++j) { const unsigned c = xb_ld(&bar[XB_XCNT(j)]); sum += c; cnt += (c > 0u) ? 1u : 0u; mine = (j == x) ? c : mine; }
        if (sum == G) break;
        __builtin_amdgcn_s_sleep(1);
        if ((++sp & 255u) == 0u) { if (xb_ld(&bar[XB_TMO])) break; if (sp > XB_SPIN_CAP) { atomicAdd(&bar[XB_TMO], 1u); break; } }
    }
    nloc = mine > 0u ? mine : 1u; nx = cnt > 0u ? cnt : 1u;
}
__device__ __forceinline__ void xcd_barrier(const XcdBarrier& b) {
    asm volatile("s_waitcnt vmcnt(0)" ::: "memory");
    __syncthreads();
    if (threadIdx.x == 0) {
        unsigned* bar = b.bar;
        __builtin_amdgcn_s_waitcnt(0);
        unsigned nloc = b.st[0], nx = b.st[1];
        if (nloc == 0u) { xcd_barrier_complete(bar, b.x, nloc, nx); b.st[0] = nloc; b.st[1] = nx; }
        const unsigned old = xb_add(&bar[XB_XSUB(b.x)], 1u);
        const unsigned gen = old / nloc;
        if (old + 1u == (gen + 1u) * nloc) {
            __builtin_amdgcn_fence(__ATOMIC_RELEASE, "agent");
            asm volatile("s_waitcnt vmcnt(0)" ::: "memory");
            const unsigned og = xb_add(&bar[XB_TOP], 1u);
            const unsigned tg = og / nx;
            if (og + 1u == (tg + 1u) * nx) xb_add(&bar[XB_TOPGEN], 1u);
            else XB_SPIN(xb_ld(&bar[XB_TOPGEN]) == tg, bar);
            __builtin_amdgcn_fence(__ATOMIC_ACQUIRE, "agent");
            xb_add(&bar[XB_XGEN(b.x)], 1u);
            asm volatile("s_waitcnt vmcnt(0)" ::: "memory");
        } else {
            XB_SPIN(xb_ld(&bar[XB_XGEN(b.x)]) == gen, bar);
            __builtin_amdgcn_fence(__ATOMIC_ACQUIRE, "agent");
            asm volatile("s_waitcnt vmcnt(0)" ::: "memory");
        }
    }
    __syncthreads();
}

__device__ __forceinline__ float wave_sum(float v) {
#pragma unroll
    for (int o = 1; o < 64; o <<= 1) v += __shfl_xor(v, o);
    return v;
}
__device__ __forceinline__ void p0_transpose_item(const float* W, int ldw, int K, int N, bf16* WT, const float* kscale, bool remap, LAS float* scr, int item, int lane, float f8scale = 0.f, bool upmap = false) {
    const int nblk = N / 64, kb = item / nblk, nb = item % nblk, k0 = 32 * kb, n0 = 64 * nb;
    int sn0 = (remap && n0 >= 1536) ? n0 + 8 : n0;
    if (upmap) { const int within = n0 & 255, pt = n0 >> 8; sn0 = within < 128 ? 128 * pt + within : 2816 + 128 * pt + (within - 128); }
    float v[32];
#pragma unroll
    for (int i = 0; i < 32; ++i) v[i] = W[(size_t)(k0 + i) * ldw + sn0 + lane];
#pragma unroll
    for (int i = 0; i < 32; ++i) { float x = v[i]; if (kscale) x *= kscale[k0 + i]; scr[i * 65 + lane] = x; }
    LDS_WAIT(); asm volatile("" ::: "memory");
    const int kq = lane & 3;
#pragma unroll
    for (int j = 0; j < 4; ++j) { const int n = (lane >> 2) + 16 * j; const LAS float* sp = scr + (8 * kq) * 65 + n;
        if (f8scale != 0.f) { const unsigned lo = pg8::pk4_fp8(sp[0 * 65] * f8scale, sp[1 * 65] * f8scale, sp[2 * 65] * f8scale, sp[3 * 65] * f8scale), hi = pg8::pk4_fp8(sp[4 * 65] * f8scale, sp[5 * 65] * f8scale, sp[6 * 65] * f8scale, sp[7 * 65] * f8scale);
            *(GAS unsigned long long*)((unsigned char*)WT + (size_t)(n0 + n) * K + k0 + 8 * kq) = (unsigned long long)lo | ((unsigned long long)hi << 32); }
        else { v4u o; o.x = pk2(sp[0 * 65], sp[1 * 65]); o.y = pk2(sp[2 * 65], sp[3 * 65]); o.z = pk2(sp[4 * 65], sp[5 * 65]); o.w = pk2(sp[6 * 65], sp[7 * 65]);
            *(GAS v4u*)(WT + (size_t)(n0 + n) * K + k0 + 8 * kq) = o; } }
    LDS_WAIT(); asm volatile("" ::: "memory");
}

struct Args { const float* in[19]; float* out; unsigned char* ws; };
__device__ __forceinline__ float skip_thr(const unsigned* qk8, int moba) {
    const unsigned* p = qk8 + 4 * moba;
    const float qn = sqrtf(__uint_as_float(__hip_atomic_load(p, RLX_AGENT)) + __uint_as_float(__hip_atomic_load(p + 1, RLX_AGENT))), kn = sqrtf(__uint_as_float(__hip_atomic_load(p + 2, RLX_AGENT)) + __uint_as_float(__hip_atomic_load(p + 3, RLX_AGENT)));
    return 2.0f * qn * kn * 1.02f + 40.0f;
}
__device__ __forceinline__ bool moba_skip(int h, int j, int n, float thr) { return __builtin_amdgcn_exp2f(-(float)(h + 1)) * LOG2E * (float)(256 * (j - n - 1) + 1) >= thr; }

namespace attn_body {
using hb16=__hip_bfloat16;
using bf16x8=__attribute__((ext_vector_type(8)))short;
using s16x4=__attribute__((ext_vector_type(4)))short;
using f32x16=__attribute__((ext_vector_type(16)))float;
using u32x4=__attribute__((ext_vector_type(4)))unsigned;
constexpr int PITCH=3072;
constexpr int NW=8,QBLK=32,QB=QBLK*NW,KVBLK=64;
__device__ __forceinline__ int crow(int r,int hi){return (r&3)+8*(r>>2)+4*hi;}
#define SBAR() __builtin_amdgcn_sched_barrier(0)
__device__ __forceinline__ void cmask(f32x16&p0,f32x16&p1,int jb,int qrel,int hi){
  const float NEG=-INFINITY; int kb=64*jb+4*hi;
  #pragma unroll
  for(int r=0;r<16;++r){int kv=kb+(r&3)+8*(r>>2); if(kv>qrel)p0[r]=NEG; if(kv+32>qrel)p1[r]=NEG;}
}
constexpr int NSLOT=3, SLOTB=9216;
constexpr int LDS_K=0, LDS_V=NSLOT*SLOTB, LDS_WS=2*NSLOT*SLOTB, LDS_OST=LDS_WS+NW*64*4, LDS_BYTES=LDS_OST+NW*4096;
__device__ __forceinline__ void glds16(const void*gsrc,unsigned lds_dst){unsigned keep;
  asm volatile("s_mov_b32 %0, m0\n\ts_mov_b32 m0, %2\n\ts_nop 0\n\tglobal_load_lds_dwordx4 %1, off\n\ts_mov_b32 m0, %0":"=&s"(keep):"v"(gsrc),"s"(lds_dst):"memory");}
__device__ __forceinline__ void glds16x(const void*gsrc,unsigned lds_dst){unsigned keep;unsigned long long ex;
  asm volatile("s_mov_b32 %0, m0\n\ts_mov_b64 %1, exec\n\ts_mov_b64 exec, 0xff\n\ts_mov_b32 m0, %3\n\ts_nop 0\n\tglobal_load_lds_dwordx4 %2, off\n\ts_mov_b64 exec, %1\n\ts_mov_b32 m0, %0":"=&s"(keep),"=&s"(ex):"v"(gsrc),"s"(lds_dst):"memory");}
__device__ __forceinline__ float max3f(float a,float b,float c){float r;asm("v_max3_f32 %0, %1, %2, %3":"=v"(r):"v"(a),"v"(b),"v"(c));return r;}
__device__ __forceinline__ float max2f(float a,float b){float r;asm("v_max_f32_e32 %0, %1, %2":"=v"(r):"v"(a),"v"(b));return r;}
__device__ __forceinline__ float fsub_s(float a,float b){float r;asm("v_sub_f32_e32 %0, %1, %2":"=v"(r):"v"(a),"v"(b));return r;}
typedef float f32x2_t __attribute__((ext_vector_type(2))); typedef __bf16 bf16x2_t __attribute__((ext_vector_type(2)));
__device__ __forceinline__ unsigned cvtpk_s(float lo,float hi){f32x2_t v={lo,hi};bf16x2_t b=__builtin_convertvector(v,bf16x2_t);return __builtin_bit_cast(unsigned,b);}
__device__ __forceinline__ float rbf(float x){return __builtin_bit_cast(float,cvtpk_s(x,0.f)<<16);}
#define WAIT_BAR(N) asm volatile("s_waitcnt vmcnt(" #N ") lgkmcnt(0)\n\ts_barrier":::"memory")

__device__ __forceinline__ void qkt(f32x16&p0,f32x16&p1,const char*Kslot,const bf16x8*qr,int r32,int hi){
  const char*kb=Kslot+hi*1024+r32*16; const f32x16 zf={};
  #pragma unroll
  for(int d0=0;d0<4;++d0){
    const bf16x8 b0=*reinterpret_cast<const bf16x8*>(kb+d0*2048);
    const bf16x8 b1=*reinterpret_cast<const bf16x8*>(kb+d0*2048+512);
    if(d0==0){p0=__builtin_amdgcn_mfma_f32_32x32x16_bf16(b0,qr[0],zf,0,0,0);p1=__builtin_amdgcn_mfma_f32_32x32x16_bf16(b1,qr[0],zf,0,0,0);}
    else{p0=__builtin_amdgcn_mfma_f32_32x32x16_bf16(b0,qr[d0],p0,0,0,0);p1=__builtin_amdgcn_mfma_f32_32x32x16_bf16(b1,qr[d0],p1,0,0,0);}}
  const char*kx=Kslot+8192+r32*16;
  const bf16x8 x0=*reinterpret_cast<const bf16x8*>(kx), x1=*reinterpret_cast<const bf16x8*>(kx+512);
  p0=__builtin_amdgcn_mfma_f32_32x32x16_bf16(x0,qr[4],p0,0,0,0);p1=__builtin_amdgcn_mfma_f32_32x32x16_bf16(x1,qr[4],p1,0,0,0);
}
typedef __attribute__((address_space(3))) const char* lds_cptr;
typedef short v4i16_t __attribute__((ext_vector_type(4)));
__device__ __forceinline__ void kload10(bf16x8*kf,lds_cptr kp,lds_cptr kx){
  kf[0]=*(const __attribute__((address_space(3))) bf16x8*)(kp);      kf[1]=*(const __attribute__((address_space(3))) bf16x8*)(kp+512);
  kf[2]=*(const __attribute__((address_space(3))) bf16x8*)(kp+2048); kf[3]=*(const __attribute__((address_space(3))) bf16x8*)(kp+2560);
  kf[4]=*(const __attribute__((address_space(3))) bf16x8*)(kp+4096); kf[5]=*(const __attribute__((address_space(3))) bf16x8*)(kp+4608);
  kf[6]=*(const __attribute__((address_space(3))) bf16x8*)(kp+6144); kf[7]=*(const __attribute__((address_space(3))) bf16x8*)(kp+6656);
  kf[8]=*(const __attribute__((address_space(3))) bf16x8*)(kx);      kf[9]=*(const __attribute__((address_space(3))) bf16x8*)(kx+512);
}
__device__ __forceinline__ void kload2(bf16x8*kf,lds_cptr kp,int j){ kf[2*j]=*(const __attribute__((address_space(3))) bf16x8*)(kp+j*2048); kf[2*j+1]=*(const __attribute__((address_space(3))) bf16x8*)(kp+j*2048+512); }
__device__ __forceinline__ s16x4 vtr(lds_cptr p){ return __builtin_bit_cast(s16x4,__builtin_amdgcn_ds_read_tr16_b64_v4i16((__attribute__((address_space(3))) v4i16_t*)p)); }
__device__ __forceinline__ float rowmax(const f32x16&p0,const f32x16&p1){
  float a=max3f(p0[0],p0[1],p1[0]),b=max3f(p0[2],p0[3],p1[1]);a=max3f(a,p1[2],p1[3]);
  #pragma unroll
  for(int r=4;r<16;r+=4){a=max3f(a,p0[r],p0[r+1]);b=max3f(b,p0[r+2],p0[r+3]);a=max3f(a,p1[r],p1[r+1]);b=max3f(b,p1[r+2],p1[r+3]);}
  const float m=max2f(a,b);
  auto rr=__builtin_amdgcn_permlane32_swap(__float_as_uint(m),__float_as_uint(m),false,false);
  return max2f(__uint_as_float(rr[0]),__uint_as_float(rr[1]));
}
__device__ __forceinline__ void pv(f32x16*o,int vb,bf16x8 pa0,bf16x8 pa1,bf16x8 pa2,bf16x8 pa3){
  #pragma unroll
  for(int d0=0;d0<2;++d0){s16x4 lo[4],hi[4];
    #pragma unroll
    for(int ks=0;ks<4;++ks){
      asm volatile("ds_read_b64_tr_b16 %0,%1 offset:%c2":"=&v"(lo[ks]):"v"(vb),"i"(d0*4096+ks*1024):"memory");
      asm volatile("ds_read_b64_tr_b16 %0,%1 offset:%c2":"=&v"(hi[ks]):"v"(vb),"i"(d0*4096+ks*1024+512):"memory");}
    asm volatile("s_waitcnt lgkmcnt(0)":::"memory");SBAR();
    #define PK(k) (bf16x8){lo[k][0],lo[k][1],lo[k][2],lo[k][3],hi[k][0],hi[k][1],hi[k][2],hi[k][3]}
    o[d0]=__builtin_amdgcn_mfma_f32_32x32x16_bf16(pa0,PK(0),o[d0],0,0,0);
    o[d0]=__builtin_amdgcn_mfma_f32_32x32x16_bf16(pa1,PK(1),o[d0],0,0,0);
    o[d0]=__builtin_amdgcn_mfma_f32_32x32x16_bf16(pa2,PK(2),o[d0],0,0,0);
    o[d0]=__builtin_amdgcn_mfma_f32_32x32x16_bf16(pa3,PK(3),o[d0],0,0,0);
    #undef PK
  }
}

template<int THRL> __device__ __forceinline__ void attn_unit(char*shm,const int KIND,const hb16*Qc,int qrow,int oslot,const hb16*__restrict__ Kt0,const hb16*__restrict__ Vt0,const hb16*__restrict__ KXt0,int NT,int band0,hb16*Oc,hb16*PO,float*PML){
  const int tid=threadIdx.x,lane=tid&63,r32=lane&31,hi=lane>>5; const int wid=__builtin_amdgcn_readfirstlane(tid>>6);
  const unsigned lds0=(unsigned)(uintptr_t)shm;
  float*wsf=(float*)(shm+LDS_WS)+wid*64;
  const hb16*ksrc=Kt0+(long)lane*PITCH+wid*8;
  const hb16*vsrc=Vt0+(long)(16*(wid&3)+(lane>>2))*PITCH+(wid>>2)*32+(lane&3)*8;
  const hb16*xsrc=KXt0+(long)(8*wid+(lane&7))*8;
  const unsigned kdst=lds0+LDS_K+wid*1024, vdst=lds0+LDS_V+wid*1024, xdst=lds0+LDS_K+8192+wid*128;
  #define DMA_K(t,slot) do{ glds16(ksrc+(long)(t)*KVBLK*PITCH,(unsigned)__builtin_amdgcn_readfirstlane(kdst+(slot))); glds16x(xsrc+(long)(t)*KVBLK*8,(unsigned)__builtin_amdgcn_readfirstlane(xdst+(slot))); }while(0)
  #define DMA_V(t,slot) glds16(vsrc+(long)(t)*KVBLK*PITCH,(unsigned)__builtin_amdgcn_readfirstlane(vdst+(slot)))
  const int vb0=(int)(lds0+LDS_V)+((lane>>4)&1)*32+(lane&3)*8+(4*hi+((lane&15)>>2))*64;
  const char*Kbase=shm+LDS_K; bf16x8 kf[10];
  const lds_cptr shm3=(lds_cptr)shm; const lds_cptr kp0=shm3+LDS_K+hi*1024+r32*16; const lds_cptr kx0=shm3+LDS_K+8192+r32*16; const lds_cptr vp0=shm3+LDS_V+((lane>>4)&1)*32+(lane&3)*8+(4*hi+((lane&15)>>2))*64;
  DMA_K(0,0);DMA_V(0,0);DMA_K(1,SLOTB);
  bf16x8 qr[5];
  { const hb16*Qw=Qc+(long)qrow*PITCH;
    #pragma unroll
    for(int d0=0;d0<4;++d0)qr[d0]=*reinterpret_cast<const bf16x8*>(&Qw[d0*16+hi*8]); }
  float mhat=0.f,l_reg=0.f;f32x16 o[2];o[0]=f32x16{};o[1]=f32x16{};
  #define SETQX(mh_,ml_) do{ const unsigned bh_=cvtpk_s(-(mh_),-(ml_)); u32x4 qx_; qx_.x=0x3F803F80u; qx_.y=0x3F80u|(bh_<<16); qx_.z=(bh_>>16); qx_.w=0u; if(hi){qx_.x=0u;qx_.y=0u;qx_.z=0u;} qr[4]=__builtin_bit_cast(bf16x8,qx_); asm volatile("":"+v"(qr[4])); }while(0)
  #define MOVEREF(gain) const float mraw_=mhat+(gain); const float mh_=rbf(mraw_); const float ml_=rbf(mraw_-mh_); const float mnew_=mh_+ml_; const float dl=mnew_-mhat; mhat=mnew_; SETQX(mh_,ml_);
  SETQX(0.f,0.f);
  const int qrel=wid*QBLK+r32;
  #define CMASK(P0,P1,t) do{int jb_=(t)-band0; if(jb_>=0)cmask(P0,P1,jb_,qrel,hi);}while(0)
  bool resc=false;
  #define START(P0,P1) do{ const float rm=rowmax(P0,P1); resc=false; \
    { MOVEREF(rm) \
      _Pragma("unroll") for(int r=0;r<16;++r){P0[r]=fsub_s(P0[r],dl);P1[r]=fsub_s(P1[r],dl);} } \
    _Pragma("unroll") for(int r=0;r<16;++r)P0[r]=__builtin_amdgcn_exp2f(P0[r]); }while(0)
  #define RESC() do{ if(resc){ asm volatile("s_waitcnt lgkmcnt(0)":::"memory"); \
      _Pragma("unroll") for(int d_=0;d_<2;++d_) _Pragma("unroll") for(int r=0;r<16;++r)o[d_][r]*=wsf[crow(r,hi)]; } }while(0)
  f32x16 pA0,pA1,pB0,pB1;
  int sl_prev=0,sl_cur=0,sl_next=SLOTB;
  #define ROT() do{sl_prev=sl_cur;sl_cur=sl_next;sl_next=(sl_next==(NSLOT-1)*SLOTB)?0:sl_next+SLOTB;}while(0)
  DMA_K(2,2*SLOTB);
  WAIT_BAR(5);
  qkt(pA0,pA1,Kbase,qr,r32,hi);asm volatile("s_nop 15\n\ts_nop 7":"+v"(pA0),"+v"(pA1));CMASK(pA0,pA1,0);
  START(pA0,pA1);
  _Pragma("unroll") for(int r=0;r<16;++r)pA1[r]=__builtin_amdgcn_exp2f(pA1[r]);
  WAIT_BAR(0);
  DMA_K(3,0);DMA_V(1,SLOTB);
  ROT();
  kload10(kf,kp0+sl_cur,kx0+sl_cur);
  WAIT_BAR(3);
  s16x4 vlo[8],vhi[8]; u32x4 pw0,pw1,pw2,pw3; const f32x16 zf={};
  #define PKW(P,B) cvtpk_s(P[B],P[B+1])
  #define PAF(k) __builtin_bit_cast(bf16x8,pw##k)
  #define VFR(i) (bf16x8){vlo[i][0],vlo[i][1],vlo[i][2],vlo[i][3],vhi[i][0],vhi[i][1],vhi[i][2],vhi[i][3]}
  #define PIN(x) asm volatile("":"+v"(x))
  #define MX3(a,b,c) __builtin_fmaxf(__builtin_fmaxf((a),(b)),(c))
  #define GAPA(MF,A0,A1,A2,A3,W0,W1,PW) do{ MF; sacc+=A0; sacc+=A1; sacc+=A2; sacc+=A3; PIN(sacc); W0; W1; PIN(PW); SBAR(); }while(0)
  #define EX(v) __builtin_amdgcn_exp2f(v)
  #define GAPB(MF,X,B) do{ MF; X[B]=EX(X[B]); X[B+1]=EX(X[B+1]); X[B+2]=EX(X[B+2]); X[B+3]=EX(X[B+3]); PIN(X); SBAR(); }while(0)
  #define VRD(i) do{ vlo[i]=vtr(vp_+(((i)>>2)*4096+((i)&3)*1024)); vhi[i]=vtr(vp_+(((i)>>2)*4096+((i)&3)*1024+512)); }while(0)
  #define KRD(G,j) do{ if(G){ kload2(kf,kp0+sl_next,j); SBAR(); } }while(0)
  #define KRDX(G) do{ if(G){ kf[8]=*(const __attribute__((address_space(3))) bf16x8*)(kx0+sl_next); kf[9]=*(const __attribute__((address_space(3))) bf16x8*)(kx0+sl_next+512); SBAR(); } }while(0)
  #define STEP(C0,C1,P0,P1,t,GK,GV,GL) do{ SBAR(); \
    const lds_cptr vp_=vp0+sl_prev; \
    VRD(0); SBAR(); float sacc=(P0[0]+P0[1]); \
    GAPA(C0=__builtin_amdgcn_mfma_f32_32x32x16_bf16(kf[0],qr[0],zf,0,0,0), P0[2],P0[3],P0[4],P0[5],     pw0[0]=PKW(P0,0), pw0[1]=PKW(P0,2), pw0); \
    VRD(4); SBAR(); GAPA(C1=__builtin_amdgcn_mfma_f32_32x32x16_bf16(kf[1],qr[0],zf,0,0,0), P0[6],P0[7],P0[8],P0[9],     pw0[2]=PKW(P0,4), pw0[3]=PKW(P0,6), pw0); \
    VRD(1); SBAR(); GAPA(C0=__builtin_amdgcn_mfma_f32_32x32x16_bf16(kf[2],qr[1],C0,0,0,0),   P0[10],P0[11],P0[12],P0[13], pw1[0]=PKW(P0,8), pw1[1]=PKW(P0,10), pw1); \
    VRD(5); SBAR(); GAPA(C1=__builtin_amdgcn_mfma_f32_32x32x16_bf16(kf[3],qr[1],C1,0,0,0),   P0[14],P0[15],P1[0],P1[1],   pw1[2]=PKW(P0,12),pw1[3]=PKW(P0,14), pw1); \
    VRD(2); SBAR(); GAPA(C0=__builtin_amdgcn_mfma_f32_32x32x16_bf16(kf[4],qr[2],C0,0,0,0),   P1[2],P1[3],P1[4],P1[5],     pw2[0]=PKW(P1,0), pw2[1]=PKW(P1,2), pw2); \
    VRD(6); SBAR(); GAPA(C1=__builtin_amdgcn_mfma_f32_32x32x16_bf16(kf[5],qr[2],C1,0,0,0),   P1[6],P1[7],P1[8],P1[9],     pw2[2]=PKW(P1,4), pw2[3]=PKW(P1,6), pw2); \
    VRD(3); SBAR(); GAPA(C0=__builtin_amdgcn_mfma_f32_32x32x16_bf16(kf[6],qr[3],C0,0,0,0),   P1[10],P1[11],P1[12],P1[13], pw3[0]=PKW(P1,8), pw3[1]=PKW(P1,10), pw3); \
    VRD(7); SBAR(); GAPA(C1=__builtin_amdgcn_mfma_f32_32x32x16_bf16(kf[7],qr[3],C1,0,0,0),   P1[14],P1[15],0.f,0.f,       pw3[2]=PKW(P1,12),pw3[3]=PKW(P1,14), pw3); \
    C0=__builtin_amdgcn_mfma_f32_32x32x16_bf16(kf[8],qr[4],C0,0,0,0); SBAR(); \
    C1=__builtin_amdgcn_mfma_f32_32x32x16_bf16(kf[9],qr[4],C1,0,0,0); SBAR(); \
    l_reg+=sacc; \
    if(GK){DMA_K((t)+3,sl_cur);} if(GV){DMA_V((t)+1,sl_next);} \
    CMASK(C0,C1,t); \
    { float a=MX3(C0[0],C0[1],C1[0]),b=MX3(C0[2],C0[3],C1[1]); a=MX3(a,C1[2],C1[3]); \
      _Pragma("unroll") for(int r=4;r<16;r+=4){a=MX3(a,C0[r],C0[r+1]);b=MX3(b,C0[r+2],C0[r+3]);a=MX3(a,C1[r],C1[r+1]);b=MX3(b,C1[r+2],C1[r+3]);} \
      float rm=__builtin_fmaxf(a,b); { auto rr=__builtin_amdgcn_permlane32_swap(__float_as_uint(rm),__float_as_uint(rm),false,false); rm=__builtin_fmaxf(__uint_as_float(rr[0]),__uint_as_float(rr[1])); } \
      resc=false; \
      if(__builtin_expect(__any(rm>(float)THRL),0)){ MOVEREF(__builtin_fmaxf(rm,0.f)) \
        _Pragma("unroll") for(int r=0;r<16;++r){C0[r]-=dl;C1[r]-=dl;} \
        const float f=__builtin_amdgcn_exp2f(-dl); l_reg*=f; if(hi==0)wsf[r32]=f; resc=true; } } \
    SBAR(); \
    GAPB(o[0]=__builtin_amdgcn_mfma_f32_32x32x16_bf16(PAF(0),VFR(0),o[0],0,0,0), C0,0); \
    GAPB(o[1]=__builtin_amdgcn_mfma_f32_32x32x16_bf16(PAF(0),VFR(4),o[1],0,0,0), C0,4); \
    KRD(GL,0); GAPB(o[0]=__builtin_amdgcn_mfma_f32_32x32x16_bf16(PAF(1),VFR(1),o[0],0,0,0), C0,8); \
    KRD(GL,1); GAPB(o[1]=__builtin_amdgcn_mfma_f32_32x32x16_bf16(PAF(1),VFR(5),o[1],0,0,0), C0,12); \
    KRD(GL,2); GAPB(o[0]=__builtin_amdgcn_mfma_f32_32x32x16_bf16(PAF(2),VFR(2),o[0],0,0,0), C1,0); \
    KRD(GL,3); GAPB(o[1]=__builtin_amdgcn_mfma_f32_32x32x16_bf16(PAF(2),VFR(6),o[1],0,0,0), C1,4); \
    KRDX(GL); GAPB(o[0]=__builtin_amdgcn_mfma_f32_32x32x16_bf16(PAF(3),VFR(3),o[0],0,0,0), C1,8); \
    GAPB(o[1]=__builtin_amdgcn_mfma_f32_32x32x16_bf16(PAF(3),VFR(7),o[1],0,0,0), C1,12); \
    }while(0)
  int t=1;
  for(;t+5<NT&&t+1<band0;t+=2){
    #undef CMASK
    #define CMASK(P0,P1,t) do{}while(0)
    STEP(pB0,pB1,pA0,pA1,t,true,true,true);     WAIT_BAR(3); RESC(); ROT();
    STEP(pA0,pA1,pB0,pB1,t+1,true,true,true);   WAIT_BAR(3); RESC(); ROT();
  }
  #undef CMASK
  #define CMASK(P0,P1,t) do{int jb_=(t)-band0; if(jb_>=0)cmask(P0,P1,jb_,qrel,hi);}while(0)
  #define ENDW(tt) do{ if((tt)+3<NT){WAIT_BAR(3);} else if((tt)+2<NT){WAIT_BAR(1);} else {WAIT_BAR(0);} }while(0)
  for(;t+1<NT;t+=2){
    STEP(pB0,pB1,pA0,pA1,t,(t+3<NT),(t+1<NT),(t+1<NT));       ENDW(t);   RESC(); ROT();
    STEP(pA0,pA1,pB0,pB1,t+1,(t+4<NT),(t+2<NT),(t+2<NT));     ENDW(t+1); RESC(); ROT();
  }
  STEP(pB0,pB1,pA0,pA1,NT-1,false,false,false); RESC();
  { float sacc=pB0[0]+pB0[1]; _Pragma("unroll") for(int r=2;r<16;++r)sacc+=pB0[r]; _Pragma("unroll") for(int r=0;r<16;++r)sacc+=pB1[r]; l_reg+=sacc;
    pw0=(u32x4){PKW(pB0,0),PKW(pB0,2),PKW(pB0,4),PKW(pB0,6)};pw1=(u32x4){PKW(pB0,8),PKW(pB0,10),PKW(pB0,12),PKW(pB0,14)};pw2=(u32x4){PKW(pB1,0),PKW(pB1,2),PKW(pB1,4),PKW(pB1,6)};pw3=(u32x4){PKW(pB1,8),PKW(pB1,10),PKW(pB1,12),PKW(pB1,14)};
    SBAR(); pv(o,vb0+sl_cur,PAF(0),PAF(1),PAF(2),PAF(3)); }
  #undef PKW
  #undef PAF
  #undef VFR
  #undef PIN
  #undef MX3
  #undef GAPA
  #undef GAPB
  #undef EX
  #undef VRD
  #undef KRD
  #undef KRDX
  #undef STEP
  #undef ENDW
  {auto rr=__builtin_amdgcn_permlane32_swap(__float_as_uint(l_reg),__float_as_uint(l_reg),false,false);l_reg=__uint_as_float(rr[0])+__uint_as_float(rr[1]);}
  if(hi==0)wsf[32+r32]=l_reg;asm volatile("s_waitcnt lgkmcnt(0)":::"memory");
  float rli[16];
  #pragma unroll
  for(int r=0;r<16;++r)rli[r]=__builtin_amdgcn_rcpf(wsf[32+crow(r,hi)]);
  if(KIND==1){ if(hi==0&&oslot>=0){ f32x2_t ml={mhat,l_reg}; *(f32x2_t*)(PML+(long)oslot*2)=ml; } }
  { hb16*stg=(hb16*)(shm+LDS_OST)+wid*2048;
    #pragma unroll
    for(int r=0;r<16;++r){const int orow=crow(r,hi);
      #pragma unroll
      for(int d0=0;d0<2;++d0)stg[orow*64+d0*32+r32]=__float2bfloat16(o[d0][r]*rli[r]);}
    asm volatile("s_waitcnt lgkmcnt(0)":::"memory");
    #pragma unroll
    for(int i=0;i<4;++i){const int row=i*8+(lane>>3),ch=lane&7; const u32x4 v=*(const u32x4*)(stg+row*64+ch*8);
      if(KIND==0){ const int gr=__shfl(qrow,row); *(u32x4*)(Oc+(long)gr*PITCH+ch*8)=v; }
      else { const int gs=__shfl(oslot,row); if(gs>=0) *(u32x4*)(PO+(long)gs*64+ch*8)=v; } } }
  asm volatile("s_waitcnt lgkmcnt(0)\n\ts_barrier":::"memory");
  #undef DMA_K
  #undef DMA_V
  #undef CMASK
  #undef START
  #undef RESC
  #undef ROT
  #undef SETQX
  #undef MOVEREF
}
constexpr int ATTN_LDS_BYTES=LDS_BYTES;
#undef SBAR
#undef WAIT_BAR
}

struct WqkOrder {
    int G, c;
    __device__ __forceinline__ bool next(int i, pg8::Unit& u) const { const int L = i * G + c; if (L >= 128) return false; const int z = L >> 2, pn = L & 3, b = z >> 2, h = z & 3;
        u.pm = b * 4 + h; u.pn = pn; u.aoff = ((size_t)(b * 256) * 2048 + h * 256) * 2; u.boff = ((size_t)(pn * 256) * 1024 + h * 256) * 2; return true; }
};
struct VwoOrder {
    int G, c;
    __device__ __forceinline__ bool next(int i, pg8::Unit& u) const { const int L = i * G + c; if (L >= 128) return false; const int z = L >> 2, pmq = L & 3, b = z >> 2, h = z & 3;
        u.pm = b * 4 + pmq; u.pn = h; u.aoff = ((size_t)(pmq * 256) * 1024 + h * 256) * 2; u.boff = ((size_t)(b * 256) * 2048 + 1024 + h * 256) * 2; return true; }
};

#define DECL_PTRS const __attribute__((address_space(4))) Args* KA_; { auto p_ = __builtin_amdgcn_kernarg_segment_ptr(); asm volatile("" : "+s"(p_)); KA_ = (const __attribute__((address_space(4))) Args*)p_; } \
    int tidp_ = threadIdx.x; asm volatile("" : "+v"(tidp_)); const int tid = tidp_, lane = tid & 63; (void)lane; \
    unsigned char* ws = KA_->ws; gu32* ctl = (gu32*)(ws + WS_CTL); const float* x = KA_->in[0]; const float* mem = KA_->in[1]; const float* g_mix = KA_->in[2]; const float* w_in = KA_->in[3]; const float* b_forget = KA_->in[4]; const float* g_fox = KA_->in[5]; const float* g_moba = KA_->in[6]; const float* w_out = KA_->in[7]; const float* g_cross = KA_->in[8]; const float* g_mem = KA_->in[9]; const float* w_q_mem = KA_->in[10]; const float* w_kv_mem = KA_->in[11]; const float* w_o_mem = KA_->in[12]; const float* g_ffn = KA_->in[13]; const float* w_up = KA_->in[14]; const float* conv_w = KA_->in[15]; const float* conv_b = KA_->in[16]; const float* w_down = KA_->in[17]; const float* g_final = KA_->in[18]; float* out = KA_->out; float* LOGF = (float*)(ws + WS_LOGF); float* CC = (float*)(ws + WS_C); float* ABAR = (float*)(ws + WS_ABAR); float* KM = (float*)(ws + WS_KM); unsigned* SEL = (unsigned*)(ws + WS_SEL); float* SSQ1 = (float*)(ws + WS_SSQ1); float* SSQ2 = (float*)(ws + WS_SSQ2); float* SSQ3 = (float*)(ws + WS_SSQ3); bf16* MEMN = (bf16*)(ws + WS_MEMN); bf16* KV = (bf16*)(ws + WS_KV); bf16* WQS = (bf16*)(ws + WS_WQS); bf16* WOT = (bf16*)(ws + WS_WOT); bf16* WKVT = (bf16*)(ws + WS_WKVT); bf16* WINT = (bf16*)(ws + WS_WINT); bf16* WOUTT = (bf16*)(ws + WS_WOUTT); bf16* WUPT = (bf16*)(ws + WS_WUPT); unsigned char* WDT = ws + WS_WDT; unsigned char* ACT8 = ws + WS_ACT8; float* GHB = (float*)(ws + WS_GH); float* UHB = (float*)(ws + WS_UH); float* GTB = (float*)(ws + WS_GT); bf16* ZT = (bf16*)(ws + WS_ZT); bf16* WQK = (bf16*)(ws + WS_WQK); bf16* VWO = (bf16*)(ws + WS_VWO); bf16* A1 = (bf16*)(ws + WS_A1); bf16* QKV = (bf16*)(ws + WS_QKV); bf16* Y = (bf16*)(ws + WS_Y); bf16* HB1 = (bf16*)(ws + WS_HB1); bf16* PB = (bf16*)(ws + WS_P); bf16* HB2 = (bf16*)(ws + WS_HB2); bf16* GB = (bf16*)(ws + WS_G); bf16* UB = (bf16*)(ws + WS_U); bf16* PO = (bf16*)(ws + WS_PO); unsigned* LIST = (unsigned*)(ws + WS_LIST); float* PML = (float*)(ws + WS_PML); bf16* KXF = (bf16*)(ws + WS_KXF); bf16* KXM = (bf16*)(ws + WS_KXM); unsigned* CNT = (unsigned*)(ws + WS_CNT);
__global__ void __launch_bounds__(NWAVES * 64, 2) fwd(Args args) {
    extern __shared__ __attribute__((aligned(16))) unsigned char lds[];
    LAS unsigned char* L = (LAS unsigned char*)lds;
    LAS unsigned char* XL = L + XL_OFF;
    volatile LAS unsigned* MISC = (volatile LAS unsigned*)(L + MISC_OFF);
    const int tid = threadIdx.x, lane = tid & 63, wave = __builtin_amdgcn_readfirstlane(tid >> 6);
    const int G = gridDim.x, bx = blockIdx.x;
    const int gw = bx * NWAVES + wave, NGW = G * NWAVES;
    for (int u = tid; u < (LDS_BYTES - LDSCTL_OFF) / 4; u += NWAVES * 64) ((LAS unsigned*)(L + LDSCTL_OFF))[u] = 0u;
    __syncthreads();
    XcdBarrier bar; { DECL_PTRS; bar = xcd_barrier_post((unsigned*)(ctl + CW_BAR), MISC + 8); }

    { DECL_PTRS;
        LAS float* scr = (LAS float*)(L + RING_OFF + wave * 16384);
        constexpr int I_IN = (D / 32) * (NQKV / 64), I_OUT = (D / 32) * (D / 64), I_KV = (D / 32) * (2048 / 64), I_O = I_OUT, I_UP = (D / 32) * (2 * FF / 64), I_DN = (FF / 32) * (D / 64);
        constexpr int NITEMS = I_IN + I_OUT + I_KV + I_O + I_UP + I_DN;
        for (int it = gw; it < NITEMS; it += NGW) {
            int r = it;
            if (r < I_IN) { p0_transpose_item(w_in, INC, D, NQKV, WINT, nullptr, true, scr, r, lane); continue; } r -= I_IN;
            if (r < I_OUT) { p0_transpose_item(w_out, D, D, D, WOUTT, nullptr, false, scr, r, lane); continue; } r -= I_OUT;
            if (r < I_KV) { p0_transpose_item(w_kv_mem, 2048, D, 2048, WKVT, nullptr, false, scr, r, lane); continue; } r -= I_KV;
            if (r < I_O) { p0_transpose_item(w_o_mem, D, D, D, WOT, nullptr, false, scr, r, lane); continue; } r -= I_O;
            if (r < I_UP) { p0_transpose_item(w_up, 2 * FF, D, 2 * FF, WUPT, g_ffn, false, scr, r, lane, 0.f, true); continue; } r -= I_UP;
            p0_transpose_item(w_down, D, FF, D, (bf16*)WDT, nullptr, false, scr, r, lane, 64.0f);
        }
        for (int i = bx * 512 + tid; i < D * D / 4; i += G * 512) { const int kk = (i * 4) >> 10; const f32x4 v = *(const f32x4*)(w_q_mem + (size_t)i * 4) * (g_cross[kk] * (LOG2E / 16.0f));
            *(unsigned long long*)(WQS + (size_t)i * 4) = (unsigned long long)pk2(v[0], v[1]) | ((unsigned long long)pk2(v[2], v[3]) << 32); }
        for (int r = gw; r < NB * 256; r += NGW) { const GAS f32x4* xr = (const GAS f32x4*)(mem + (size_t)r * D) + lane; f32x4 v[4]; float s = 0.f;
#pragma unroll
            for (int j = 0; j < 4; ++j) { v[j] = xr[64 * j]; s += (v[j][0] * v[j][0] + v[j][1] * v[j][1]) + (v[j][2] * v[j][2] + v[j][3] * v[j][3]); }
            const float rs = __builtin_amdgcn_rsqf(wave_sum(s) * (1.f / D) + RMS_EPS);
            GAS unsigned long long* o8 = (GAS unsigned long long*)(MEMN + (size_t)r * D) + lane;
#pragma unroll
            for (int j = 0; j < 4; ++j) { const f32x4 gg = *((const f32x4*)g_mem + 64 * j + lane); const f32x4 a = v[j] * rs * gg; o8[64 * j] = (unsigned long long)pk2(a[0], a[1]) | ((unsigned long long)pk2(a[2], a[3]) << 32); } }
        __syncthreads();
        LAS float* part = (LAS float*)(L + RING_OFF + 32768);
        LAS float* wf = (LAS float*)(L + RING_OFF);
        for (int i = tid; i < 8 * 1024; i += 512) { const int h = i >> 10, kk = i & 1023; wf[i] = w_in[(size_t)kk * INC + C_F + h]; }
        __syncthreads();
        f32x4 gm[4];
#pragma unroll
        for (int j = 0; j < 4; ++j) gm[j] = *((const f32x4*)g_mix + 64 * j + lane);
        for (int blk = bx; blk < M / 256; blk += G) {
            f32x4 accm[4];
#pragma unroll
            for (int j = 0; j < 4; ++j) accm[j] = (f32x4){0.f, 0.f, 0.f, 0.f};
            f32x4 vn[2][4];
#pragma unroll
            for (int rr = 0; rr < 2; ++rr) { const GAS f32x4* xr = (const GAS f32x4*)(x + ((size_t)blk * 256 + wave * 32 + rr) * D) + lane;
#pragma unroll
                for (int j = 0; j < 4; ++j) vn[rr][j] = xr[64 * j]; }
            for (int i0 = 0; i0 < 32; i0 += 2) {
              f32x4 vv[2][4];
#pragma unroll
              for (int rr = 0; rr < 2; ++rr)
#pragma unroll
                  for (int j = 0; j < 4; ++j) vv[rr][j] = vn[rr][j];
              { const int inx = i0 + 2 < 32 ? i0 + 2 : i0;
#pragma unroll
                for (int rr = 0; rr < 2; ++rr) { const GAS f32x4* xr = (const GAS f32x4*)(x + ((size_t)blk * 256 + wave * 32 + inx + rr) * D) + lane;
#pragma unroll
                    for (int j = 0; j < 4; ++j) vn[rr][j] = xr[64 * j]; } }
#pragma unroll
              for (int rr = 0; rr < 2; ++rr) {
                const size_t r = (size_t)blk * 256 + wave * 32 + i0 + rr;
                f32x4 v[4]; float s = 0.f;
#pragma unroll
                for (int j = 0; j < 4; ++j) { v[j] = vv[rr][j]; s += (v[j][0] * v[j][0] + v[j][1] * v[j][1]) + (v[j][2] * v[j][2] + v[j][3] * v[j][3]); }
                const float rs = __builtin_amdgcn_rsqf(wave_sum(s) * (1.f / D) + RMS_EPS);
                GAS unsigned long long* o8 = (GAS unsigned long long*)(A1 + r * 2048) + lane;
                float fl[8];
#pragma unroll
                for (int h = 0; h < 8; ++h) fl[h] = 0.f;
#pragma unroll
                for (int j = 0; j < 4; ++j) { const f32x4 a = v[j] * rs * gm[j]; accm[j] += a;
                    const unsigned h0 = pk2(a[0], a[1]), h1 = pk2(a[2], a[3]);
                    o8[64 * j] = (unsigned long long)h0 | ((unsigned long long)h1 << 32);
                    const unsigned l0 = pk2(a[0] - bflo(h0), a[1] - bfhi(h0)), l1 = pk2(a[2] - bflo(h1), a[3] - bfhi(h1));
                    o8[256 + 64 * j] = (unsigned long long)l0 | ((unsigned long long)l1 << 32);
#pragma unroll
                    for (int h = 0; h < 8; ++h) { const f32x4 w = *((const LAS f32x4*)(wf + h * 1024) + 64 * j + lane); fl[h] += (a[0] * w[0] + a[1] * w[1]) + (a[2] * w[2] + a[3] * w[3]); } }
                float t4[4], t2[2], z;
                { const bool up = (lane & 32) != 0;
#pragma unroll
                  for (int k = 0; k < 4; ++k) { const float snd = up ? fl[k] : fl[k + 4]; const float rcv = __shfl_xor(snd, 32); t4[k] = (up ? fl[k + 4] : fl[k]) + rcv; } }
                { const bool up = (lane & 16) != 0;
#pragma unroll
                  for (int k = 0; k < 2; ++k) { const float snd = up ? t4[k] : t4[k + 2]; const float rcv = __shfl_xor(snd, 16); t2[k] = (up ? t4[k + 2] : t4[k]) + rcv; } }
                { const bool up = (lane & 8) != 0; const float snd = up ? t2[0] : t2[1]; const float rcv = __shfl_xor(snd, 8); z = (up ? t2[1] : t2[0]) + rcv; }
                z += __shfl_xor(z, 1); z += __shfl_xor(z, 2); z += __shfl_xor(z, 4);
                if ((lane & 7) == 0) { const int hh = 4 * (lane >> 5) + 2 * ((lane >> 4) & 1) + ((lane >> 3) & 1);
                    z += b_forget[hh];
                    LOGF[r * 8 + hh] = fminf(z, 0.f) - log1pf(__expf(-fabsf(z))); }
              }
            }
#pragma unroll
            for (int j = 0; j < 4; ++j) *((LAS f32x4*)(part + wave * 1024) + 64 * j + lane) = accm[j];
            __syncthreads();
            for (int col = tid; col < 1024; col += 512) { float s = 0.f;
#pragma unroll
                for (int w = 0; w < 8; ++w) s += part[w * 1024 + col];
                ABAR[(size_t)blk * 1024 + col] = s * (1.0f / 256.0f); }
            __syncthreads();
        }
    }
    xcd_barrier(bar);

    { DECL_PTRS;
        LAS float* sc = (LAS float*)(L + RING_OFF);
        for (int w = (bx + G - 64) % G; w < 64; w += G) {
            const int b = w >> 3, h = w & 7; float v[16]; float run = 0.f;
#pragma unroll
            for (int i = 0; i < 16; ++i) { run += LOGF[((size_t)b * T + tid * 16 + i) * 8 + h]; v[i] = run; }
            float incl = run;
#pragma unroll
            for (int o = 1; o < 64; o <<= 1) { const float n = __shfl_up(incl, o); if (lane >= o) incl += n; }
            if (lane == 63) sc[wave] = incl;
            __syncthreads();
            float pre = incl - run;
            for (int ww = 0; ww < wave; ++ww) pre += sc[ww];
#pragma unroll
            for (int i = 0; i < 16; ++i) CC[(size_t)w * T + tid * 16 + i] = pre + v[i];
            __syncthreads();
        }
        for (int w = bx; w < 64; w += G) {
            const int ib = w >> 3, jb = w & 7, r = tid >> 4, cq = tid & 15; LAS float* As = sc; LAS float* Bs = sc + 32 * 33;
            f32x4 acc = (f32x4){0.f, 0.f, 0.f, 0.f};
            for (int k0 = 0; k0 < 1024; k0 += 32) {
                { const int idx = tid * 2, row = idx >> 5, kk = idx & 31; const pg8::f32x2 a2 = *(const pg8::f32x2*)(ABAR + (size_t)(ib * 32 + row) * 1024 + k0 + kk); As[row * 33 + kk] = a2.x; As[row * 33 + kk + 1] = a2.y; }
                { const int idx = tid * 4, kk = idx >> 6, c = idx & 63; *(LAS f32x4*)(Bs + kk * 64 + c) = *(const f32x4*)(w_in + (size_t)(k0 + kk) * INC + C_KM + jb * 64 + c); }
                __syncthreads();
#pragma unroll 8
                for (int kk = 0; kk < 32; ++kk) acc += *(const LAS f32x4*)(Bs + kk * 64 + cq * 4) * As[r * 33 + kk];
                __syncthreads();
            }
            *(f32x4*)(KM + (size_t)(ib * 32 + r) * 512 + jb * 64 + cq * 4) = acc;
        }
        pg8::Gemm g{MEMN, WKVT, D / 64, D * 2, D * 2, 0xffffffffu}; pg8::TileOrder S; S.init(NB * 256, 2048, G, (bx + G - 128) % G, D * 2, D * 2, 0, 1 << 30);
        pg8::EpiBf16 E{KV, 2048, 0u, 1.f, nullptr};
        pg8::gemm_phase<pg8::EpiBf16, pg8::TileOrder, true>(L + RING_OFF, XL, g, S, E);
    }
    xcd_barrier(bar);

    { DECL_PTRS;
        LAS float* sc = (LAS float*)(L + RING_OFF);
        for (int w = bx; w < 64; w += G) {
            const int h = w >> 3, kq = w & 7, kk = kq * 128 + (tid & 127), ng = tid >> 7;
            for (int i = tid; i < 256 * 16; i += 512) { const int n = i >> 4, c4 = (i & 15) * 4; *(LAS f32x4*)(sc + n * 64 + c4) = *(const f32x4*)(KM + (size_t)n * 512 + h * 64 + c4); }
            f32x4 wq[16];
#pragma unroll
            for (int c = 0; c < 16; ++c) wq[c] = *(const f32x4*)(w_in + (size_t)kk * INC + C_QM + h * 64 + c * 4);
            __syncthreads();
            for (int i = 0; i < 64; ++i) { const int n = ng * 64 + i; const LAS f32x4* kp = (const LAS f32x4*)(sc + n * 64); float s0 = 0.f, s1 = 0.f;
#pragma unroll
                for (int c = 0; c < 16; c += 2) { const f32x4 ka = kp[c], kb = kp[c + 1];
                    s0 += (wq[c][0] * ka[0] + wq[c][1] * ka[1]) + (wq[c][2] * ka[2] + wq[c][3] * ka[3]); s1 += (wq[c + 1][0] * kb[0] + wq[c + 1][1] * kb[1]) + (wq[c + 1][2] * kb[2] + wq[c + 1][3] * kb[3]); }
                const float sv = s0 + s1; const unsigned hi = f2bf(sv); const unsigned lo = f2bf(sv - bf2f(hi));
                bf16* zr = ZT + ((size_t)(n >> 5) * 256 + h * 32 + (n & 31)) * 3072; zr[kk] = (bf16)hi; zr[1024 + kk] = (bf16)hi; zr[2048 + kk] = (bf16)lo; }
            __syncthreads();
        }
        for (int i = bx * 512 + tid; i < 64 * T + 8 * 256; i += G * 512) {
            float bv; bf16* dst;
            if (i < 64 * T) { bv = -CC[i] * LOG2E; dst = KXF + (size_t)i * 8; }
            else { const int j = i - 64 * T; bv = __builtin_amdgcn_exp2f(-(float)((j >> 8) + 1)) * LOG2E * (float)(j & 255); dst = KXM + (size_t)j * 8; }
            const unsigned h0 = f2bf(bv); const float r1 = bv - bf2f(h0); const unsigned h1 = f2bf(r1); const unsigned h2 = f2bf(r1 - bf2f(h1));
            *(v4u*)dst = (v4u){h0 | (h1 << 16), h2 | (0x3F80u << 16), 0x3F80u, 0u}; }
        { pg8::Gemm g{KV, WQS, 4, 4096, 2048, 0xffffffffu}; WqkOrder S{G, bx}; pg8::EpiF8 E{(unsigned char*)WQK, 1024, 32.0f};
          pg8::gemm_phase<pg8::EpiF8, WqkOrder, true>(L + RING_OFF, XL, g, S, E); }
        { pg8::Gemm g{WOT, KV, 4, 2048, 4096, 0xffffffffu}; VwoOrder S{G, (bx + 128) % G}; pg8::EpiF8 E{(unsigned char*)VWO, 1024, 4.0f};
          pg8::gemm_phase<pg8::EpiF8, VwoOrder, true>(L + RING_OFF, XL, g, S, E); }
    }
    xcd_barrier(bar);

    { DECL_PTRS;
        { pg8::Gemm g{A1, WINT, D / 64, 4096, D * 2, 0xffffffffu}; pg8::TileOrder S; S.init(M, NQKV, G, bx, 4096, D * 2, 0, 1 << 30);
          pg8::EpiBf16 E{QKV, NQKV, 0xC3u, C2, (unsigned*)(ctl + CW_QKN)};
          pg8::gemm_phase<pg8::EpiBf16, pg8::TileOrder, true>(L + RING_OFF, XL, g, S, E); }
        { pg8::Gemm g{A1, ZT, 3072 / 64, 4096, 6144, 4095u}; pg8::TileOrder S; S.init(M, 256, G, bx, 4096, 6144, (size_t)256 * 6144, 32);
          pg8::EpiGate E{SEL};
          pg8::gemm_phase<pg8::EpiGate, pg8::TileOrder, true>(L + RING_OFF, XL, g, S, E); }
    }
    xcd_barrier(bar);

    { DECL_PTRS;
        { LAS float* wqm = (LAS float*)(L + RING_OFF + 2048); LAS float* wdm = wqm + 8; LAS float* bq = wdm + 8; LAS float* bd = bq + 64;
          int li = 0;
          for (int e = bx; e < 2048; e += G, ++li) { const int bh = e >> 5, qb = e & 31, b = bh >> 3, h = bh & 7;
              const size_t row = (size_t)b * T + qb * 256 + (tid >> 1); const bf16* qp = QKV + row * NQKV + h * 64 + (tid & 1) * 32;
              float dot = 0.f, qn2 = 0.f;
#pragma unroll
              for (int c = 0; c < 4; ++c) { const v4u qw = *((const v4u*)qp + c), kw = *((const v4u*)(qp + 512) + c); const unsigned qq[4] = {qw.x, qw.y, qw.z, qw.w}, kk2[4] = {kw.x, kw.y, kw.z, kw.w};
#pragma unroll
                  for (int x4 = 0; x4 < 4; ++x4) { const float q0 = bflo(qq[x4]), q1 = bfhi(qq[x4]); dot += q0 * bflo(kk2[x4]) + q1 * bfhi(kk2[x4]); qn2 += q0 * q0 + q1 * q1; } }
              dot += __shfl_xor(dot, 1); qn2 += __shfl_xor(qn2, 1);
#pragma unroll
              for (int o = 2; o < 64; o <<= 1) { dot = fminf(dot, __shfl_xor(dot, o)); qn2 = fmaxf(qn2, __shfl_xor(qn2, o)); }
              if (lane == 0) { wqm[wave] = qn2; wdm[wave] = dot; }
              __syncthreads();
              if (tid == 0) { float qm = wqm[0], dm = wdm[0];
#pragma unroll
                  for (int ww = 1; ww < 8; ++ww) { qm = fmaxf(qm, wqm[ww]); dm = fminf(dm, wdm[ww]); }
                  bq[li] = qm; bd[li] = dm; }
              __syncthreads(); }
          if (tid < li) { const int e = bx + tid * G, bh = e >> 5, qb = e & 31;
              const unsigned* kp = (const unsigned*)(ctl + CW_QKN) + bh * 8 + 2;
              const float kn = sqrtf(__uint_as_float(__hip_atomic_load(kp, RLX_AGENT)) + __uint_as_float(__hip_atomic_load(kp + 1, RLX_AGENT)));
              const float thr = (sqrtf(bq[tid]) * kn * 1.02f - bd[tid] + 40.5f) * (1.0f / LOG2E);
              const float* crow_ = CC + (size_t)bh * T; const int t0 = qb * 256; const float target = crow_[t0] + thr;
              int lo = 0, hi2 = t0;
              while (lo < hi2) { const int mid = (lo + hi2) >> 1; if (crow_[mid] >= target) lo = mid + 1; else hi2 = mid; }
              ((int*)(ctl + CW_T0TAB))[e] = (lo >> 6) & ~1; } }
        LAS unsigned* wc = (LAS unsigned*)(L + RING_OFF);
        for (int w = bx; w < 2048; w += G) {
            const int bh = (w & 255) >> 2, n = (w & 3) + 4 * (w >> 8), trip = bh * 32 + n; const unsigned* selrow = SEL + (size_t)bh * T; unsigned base = 0u;
            const float mthr = skip_thr((const unsigned*)(ctl + CW_QKN) + bh * 8, 1); const int hh = bh & 7;
            for (int t0 = (n + 1) * 256; t0 < T; t0 += 2048) {
                unsigned m[4], mo[4]; unsigned long long bal[4];
#pragma unroll
                for (int j = 0; j < 4; ++j) { const int t = t0 + j * 512 + tid; m[j] = 0u; if (t < T) m[j] = selrow[t]; mo[j] = m[j]; if (moba_skip(hh, t >> 8, n, mthr)) m[j] &= ~(1u << n); }
#pragma unroll
                for (int j = 0; j < 4; ++j) { bal[j] = __ballot((m[j] >> n) & 1u); if (lane == 0) wc[j * 8 + wave] = (unsigned)__popcll(bal[j]); }
                __syncthreads();
                unsigned run = base;
#pragma unroll
                for (int j = 0; j < 4; ++j) { unsigned pre = 0u, tot = 0u;
#pragma unroll
                    for (int ww = 0; ww < 8; ++ww) { const unsigned c = wc[j * 8 + ww]; tot += c; if (ww < wave) pre += c; }
                    if ((m[j] >> n) & 1u) { const unsigned pos = run + pre + (unsigned)__popcll(bal[j] & ((1ull << lane) - 1ull)); const unsigned k = (unsigned)__popc(mo[j] & ((1u << n) - 1u));
                        LIST[(size_t)trip * 8192 + pos] = (unsigned)(t0 + j * 512 + tid) | (k << 16); }
                    run += tot; }
                base = run;
                __syncthreads();
            }
            if (tid == 0) CNT[trip] = base;
        }
    }
    xcd_barrier(bar);

    { DECL_PTRS;
        LAS int* upre = (LAS int*)(L + RING_OFF + attn_body::ATTN_LDS_BYTES);
        LAS int* wsum = upre + 2052;
        { int c4[4]; int run = 0;
#pragma unroll
          for (int i = 0; i < 4; ++i) { c4[i] = run; run += (int)((CNT[tid * 4 + i] + 255u) >> 8); }
          int incl = run;
#pragma unroll
          for (int o = 1; o < 64; o <<= 1) { const int nn = __shfl_up(incl, o); if (lane >= o) incl += nn; }
          if (lane == 63) wsum[wave] = incl;
          __syncthreads();
          int pre = incl - run;
          for (int ww = 0; ww < wave; ++ww) pre += wsum[ww];
#pragma unroll
          for (int i = 0; i < 4; ++i) upre[tid * 4 + i] = pre + c4[i];
          if (tid == 511) upre[2048] = pre + run;
          __syncthreads(); }
        const int ntot = 4096 + upre[2048];
        const attn_body::hb16* Qb = (const attn_body::hb16*)QKV;
        const int r32 = lane & 31;
        LAS unsigned* qnext = (LAS unsigned*)(wsum + 16);
        unsigned* qhead = (unsigned*)(ctl + CW_QUEUE);
        if (tid == 0) qnext[0] = atomicAdd(qhead, 1u);
        __syncthreads();
        for (;;) {
            const int u = (int)qnext[0];
            if (u >= ntot) break;
            __syncthreads();
            unsigned nxt_ = 0u; if (tid == 0) nxt_ = atomicAdd(qhead, 1u);
            int kind, qrow, oslot = -1, NT, band0; const attn_body::hb16 *Qc, *Kt0, *Vt0, *KXt0;
            if (u < 2048) {
                const int qb = 31 - (u >> 6), bh = u & 63;
                const int b = bh >> 3, h = bh & 7;
                const int T0 = ((const int*)(ctl + CW_T0TAB))[bh * 32 + qb];
                kind = 0; qrow = b * T + qb * 256 + wave * 32 + r32; NT = 4 * (qb + 1) - T0; band0 = NT - 4;
                Qc = Qb + h * 64; Kt0 = Qb + (size_t)(b * T + T0 * 64) * NQKV + 512 + h * 64; Vt0 = Kt0 + 512; KXt0 = (const attn_body::hb16*)KXF + ((size_t)bh * T + T0 * 64) * 8;
            } else if (u < 4096) {
                const int w = u - 2048, bh = w >> 5, j = w & 31, b = bh >> 3, h = bh & 7;
                kind = 1; qrow = b * T + j * 256 + wave * 32 + r32; oslot = (qrow * 8 + h) * 4 + 3; NT = 4; band0 = 0;
                Qc = Qb + 1536 + h * 64; Kt0 = Qb + (size_t)(b * T + j * 256) * NQKV + 2048 + h * 64; Vt0 = Kt0 + 512; KXt0 = (const attn_body::hb16*)KXM + h * 256 * 8;
            } else {
                const int g = u - 4096; int lo = 0, hi2 = 2048;
                while (hi2 - lo > 1) { const int mid = (lo + hi2) >> 1; if (upre[mid] <= g) lo = mid; else hi2 = mid; }
                const int w = lo, c = g - upre[lo], bh = w >> 5, n = w & 31, b = bh >> 3, h = bh & 7; const int cnt = (int)CNT[w];
                int idx = c * 256 + wave * 32 + r32; const bool valid = idx < cnt; if (!valid) idx = cnt - 1;
                const unsigned e = LIST[(size_t)w * 8192 + idx];
                kind = 1; qrow = b * T + (int)(e & 0xffffu); oslot = valid ? (qrow * 8 + h) * 4 + (int)(e >> 16) : -1; NT = 4; band0 = 1 << 20;
                Qc = Qb + 1536 + h * 64; Kt0 = Qb + (size_t)(b * T + n * 256) * NQKV + 2048 + h * 64; Vt0 = Kt0 + 512; KXt0 = (const attn_body::hb16*)KXM + h * 256 * 8;
            }
            attn_body::attn_unit<8>((char*)lds + RING_OFF, kind, Qc, qrow, oslot, Kt0, Vt0, KXt0, NT, band0, (attn_body::hb16*)QKV + (Qc - Qb), (attn_body::hb16*)PO, PML);
            if (tid == 0) qnext[0] = nxt_;
            __syncthreads();
        }
    }
    xcd_barrier(bar);

    { DECL_PTRS;
    const f32x4 ga0 = *((const f32x4*)g_fox + 2 * lane), ga1 = *((const f32x4*)g_fox + 2 * lane + 1), gb0 = *((const f32x4*)g_moba + 2 * lane), gb1 = *((const f32x4*)g_moba + 2 * lane + 1);
    const int h = lane >> 3, cc = lane & 7; const float s2 = __builtin_amdgcn_exp2f(-(float)(h + 1)) * LOG2E * 256.0f;
    float mthr[NB];
#pragma unroll
    for (int b = 0; b < NB; ++b) mthr[b] = skip_thr((const unsigned*)(ctl + CW_QKN) + (b * 8 + h) * 8, 1);
    v4u wan[2], pwn[2][4]; unsigned mmn[2]; pg8::f32x2 mln[2][4];
#define P3_LOAD(rbase) do { _Pragma("unroll") for (int rr = 0; rr < 2; ++rr) { const int r = (rbase) + rr, b = r >> 13, t = r & (T - 1); const size_t sb = ((size_t)r * 8 + h) * 4; \
            wan[rr] = *((const v4u*)(QKV + (size_t)r * NQKV) + lane); mmn[rr] = SEL[((size_t)(b * 8 + h)) * T + t]; \
            _Pragma("unroll") for (int k = 0; k < 4; ++k) { mln[rr][k] = *(const pg8::f32x2*)(PML + (sb + k) * 2); pwn[rr][k] = *((const v4u*)(PO + (sb + k) * 64) + cc); } } } while (0)
    if (gw * 2 < M) P3_LOAD(gw * 2);
    for (int r0 = gw * 2; r0 < M; r0 += NGW * 2) {
        v4u wa[2], pw[2][4]; unsigned mmv[2]; pg8::f32x2 ml[2][4];
#pragma unroll
        for (int rr = 0; rr < 2; ++rr) { wa[rr] = wan[rr]; mmv[rr] = mmn[rr];
#pragma unroll
            for (int k = 0; k < 4; ++k) { ml[rr][k] = mln[rr][k]; pw[rr][k] = pwn[rr][k]; } }
        { const int rn = r0 + NGW * 2 < M ? r0 + NGW * 2 : r0; P3_LOAD(rn); }
#pragma unroll
        for (int rr = 0; rr < 2; ++rr) { const int r = r0 + rr, t = r & (T - 1), own = t >> 8;
            const float a[8] = {bflo(wa[rr].x), bfhi(wa[rr].x), bflo(wa[rr].y), bfhi(wa[rr].y), bflo(wa[rr].z), bfhi(wa[rr].z), bflo(wa[rr].w), bfhi(wa[rr].w)};
            float c[8]; unsigned mm = mmv[rr]; const int cnt = __popc(mm);
            float mk[4], lk[4];
#pragma unroll
            for (int k = 0; k < 4; ++k) { mk[k] = ml[rr][k].x; lk[k] = ml[rr][k].y; }
            mk[3] += s2 * (float)own; float Mx = mk[3];
            bool vk[4]; vk[3] = true; float thb = mthr[0];
#pragma unroll
            for (int b = 1; b < NB; ++b) thb = ((r >> 13) == b) ? mthr[b] : thb;
#pragma unroll
            for (int k = 0; k < 3; ++k) { vk[k] = false; if (k < cnt) { const int nb = __ffs(mm) - 1; mm &= mm - 1u; vk[k] = !moba_skip(h, own, nb, thb); if (vk[k]) { mk[k] += s2 * (float)nb; Mx = fmaxf(Mx, mk[k]); } } }
            float W = 0.f;
#pragma unroll
            for (int i = 0; i < 8; ++i) c[i] = 0.f;
#pragma unroll
            for (int k = 0; k < 4; ++k) { if (vk[k]) { const float w = lk[k] * __builtin_amdgcn_exp2f(mk[k] - Mx); W += w; const v4u p = pw[rr][k];
                c[0] += w * bflo(p.x); c[1] += w * bfhi(p.x); c[2] += w * bflo(p.y); c[3] += w * bfhi(p.y); c[4] += w * bflo(p.z); c[5] += w * bfhi(p.z); c[6] += w * bflo(p.w); c[7] += w * bfhi(p.w); } }
            const float iw = 1.0f / W;
#pragma unroll
            for (int i = 0; i < 8; ++i) c[i] *= iw;
            float sa = 0.f, sb2 = 0.f;
#pragma unroll
            for (int i = 0; i < 8; ++i) { sa += a[i] * a[i]; sb2 += c[i] * c[i]; }
            const float ra = __builtin_amdgcn_rsqf(wave_sum(sa) * (1.f / 512.f) + RMS_EPS), rb = __builtin_amdgcn_rsqf(wave_sum(sb2) * (1.f / 512.f) + RMS_EPS);
            v4u oa, ob;
            oa.x = pk2(a[0] * ra * ga0[0], a[1] * ra * ga0[1]); oa.y = pk2(a[2] * ra * ga0[2], a[3] * ra * ga0[3]); oa.z = pk2(a[4] * ra * ga1[0], a[5] * ra * ga1[1]); oa.w = pk2(a[6] * ra * ga1[2], a[7] * ra * ga1[3]);
            ob.x = pk2(c[0] * rb * gb0[0], c[1] * rb * gb0[1]); ob.y = pk2(c[2] * rb * gb0[2], c[3] * rb * gb0[3]); ob.z = pk2(c[4] * rb * gb1[0], c[5] * rb * gb1[1]); ob.w = pk2(c[6] * rb * gb1[2], c[7] * rb * gb1[3]);
            *((v4u*)(Y + (size_t)r * D) + lane) = oa; *((v4u*)(Y + (size_t)r * D + 512) + lane) = ob; }
    } }
    xcd_barrier(bar);

#undef P3_LOAD
    { DECL_PTRS; pg8::Gemm g{Y, WOUTT, D / 64, D * 2, D * 2, 0xffffffffu}; pg8::TileOrder S; S.init(M, D, G, bx, D * 2, D * 2, 0, 1 << 30);
      pg8::EpiRes<false, false> E{x, nullptr, nullptr, HB1, ws + WS_HB1F, SSQ1, 1.0f};
      pg8::gemm_phase<pg8::EpiRes<false, false>, pg8::TileOrder, true>(L + RING_OFF, XL, g, S, E); }
    xcd_barrier(bar);

    { DECL_PTRS; pg8::Gemm g{ws + WS_HB1F, WQK, D / 128, D, D, 0xffffffffu}; pg8::TileOrder S; S.init(M, D, G, bx, D, D, (size_t)D * D, 32);
      pg8::EpiSoftmax E{(unsigned char*)PB, SSQ1, 1.0f / 32.0f};
      pg8::gemm_phase<pg8::EpiSoftmax, pg8::TileOrder, true, true>(L + RING_OFF, XL, g, S, E); }
    xcd_barrier(bar);

    { DECL_PTRS; pg8::Gemm g{PB, VWO, D / 128, D, D, 0xffffffffu}; pg8::TileOrder S; S.init(M, D, G, bx, D, D, (size_t)D * D, 32);
      pg8::EpiRes<true, false> E{nullptr, HB1, nullptr, HB2, nullptr, SSQ2, 1.0f / 1024.0f};
      pg8::gemm_phase<pg8::EpiRes<true, false>, pg8::TileOrder, true, true>(L + RING_OFF, XL, g, S, E); }
    xcd_barrier(bar);

    { DECL_PTRS; pg8::Gemm g{HB2, WUPT, D / 64, D * 2, D * 2, 0xffffffffu}; pg8::TileOrder S; S.init(M, 2 * FF, G, bx, D * 2, D * 2, 0, 1 << 30);
      pg8::EpiConv E{ACT8, SSQ2, conv_w, conv_b, GHB, UHB, GTB};
      pg8::gemm_phase<pg8::EpiConv, pg8::TileOrder, true>(L + RING_OFF, XL, g, S, E); }
    xcd_barrier(bar);

    { DECL_PTRS;
    for (int it = bx * 512 + tid; it < 256 * 22 * 2 * 32; it += G * 512) {
        const int c4 = (it & 31) * 4, rr = (it >> 5) & 1, tile = it >> 6, pm = tile / 22, pn = tile - pm * 22; const bool top = (pm & 31) == 0;
        const size_t sb = (size_t)tile * 256; const int col = pn * 128 + c4;
        const f32x4 g2 = *(const f32x4*)(GHB + sb + rr * 128 + c4), uu = *(const f32x4*)(UHB + sb + rr * 128 + c4);
        f32x4 g1 = (f32x4){0.f, 0.f, 0.f, 0.f}, g0 = (f32x4){0.f, 0.f, 0.f, 0.f};
        if (rr == 1) g1 = *(const f32x4*)(GHB + sb + c4); else if (!top) g1 = *(const f32x4*)(GTB + sb - 22 * 256 + 128 + c4);
        if (!top) g0 = *(const f32x4*)(GTB + sb - 22 * 256 + (rr == 1 ? 128 : 0) + c4);
        const f32x4 w0 = *(const f32x4*)(conv_w + col), w1 = *(const f32x4*)(conv_w + FF + col), w2 = *(const f32x4*)(conv_w + 2 * FF + col), cbv = *(const f32x4*)(conv_b + col);
        float res[4];
#pragma unroll
        for (int e = 0; e < 4; ++e) { const float gc = cbv[e] + w0[e] * g0[e] + w1[e] * g1[e] + w2[e] * g2[e]; res[e] = gc * __builtin_amdgcn_rcpf(1.0f + __builtin_amdgcn_exp2f(-LOG2E * gc)) * uu[e]; }
        *(unsigned*)(ACT8 + (size_t)(pm * 256 + rr) * FF + col) = pg8::pk4_fp8(res[0], res[1], res[2], res[3]);
    } }
    xcd_barrier(bar);

    { DECL_PTRS; pg8::Gemm g{ACT8, WDT, FF / 128, FF, FF, 0xffffffffu}; pg8::TileOrder S; S.init(M, D, G, bx, FF, FF, 0, 1 << 30);
      pg8::EpiResNorm E{HB2, out, g_final, 1.0f / 64.0f, SSQ3, (unsigned*)(ctl + CW_PANEL), (unsigned*)(ctl + CW_TMO2)};
      pg8::gemm_phase<pg8::EpiResNorm, pg8::TileOrder, true, true>(L + RING_OFF, XL, g, S, E); }
}

extern "C" void kernel_launch(void* const* d_in, const int* in_sizes, int n_in, void* d_out, int out_size, void* d_ws, size_t ws_size, hipStream_t stream) {
    static int grid = 0;
    if (grid == 0) {
        if (n_in != 19 || in_sizes[0] != M * D || out_size != M * D || ws_size < WS_END) { fprintf(stderr, "kernel_launch: unexpected problem shape (n_in %d, in0 %d, out %d, ws %zu); nothing launched\n", n_in, n_in > 0 ? in_sizes[0] : -1, out_size, ws_size); grid = -1; return; }
        int dev = 0, cus = 0, per_cu = 0;
        if (hipGetDevice(&dev) != hipSuccess || hipDeviceGetAttribute(&cus, hipDeviceAttributeMultiprocessorCount, dev) != hipSuccess) { grid = -1; return; }
        if (hipFuncSetAttribute((const void*)fwd, hipFuncAttributeMaxDynamicSharedMemorySize, LDS_BYTES) != hipSuccess) { fprintf(stderr, "kernel_launch: hipFuncSetAttribute failed\n"); grid = -1; return; }
        if (hipOccupancyMaxActiveBlocksPerMultiprocessor(&per_cu, (const void*)fwd, NWAVES * 64, LDS_BYTES) != hipSuccess || per_cu < 1) { fprintf(stderr, "kernel_launch: occupancy query reports %d\n", per_cu); }
        (void)hipGetLastError();
        grid = cus;
    }
    if (grid < 0) return;
    if (hipMemsetAsync((char*)d_ws + WS_CTL, 0, CTL_ZERO_BYTES, stream) != hipSuccess) return;
    Args a{};
    for (int i = 0; i < 19; ++i) a.in[i] = (const float*)d_in[i];
    a.out = (float*)d_out; a.ws = (unsigned char*)d_ws;
    hipLaunchKernelGGL(fwd, dim3(grid), dim3(NWAVES * 64), LDS_BYTES, stream, a);
}
```

```cpp
#include <hip/hip_runtime.h>
#include <hip/hip_bf16.h>
#include <cstdio>
#include <cstdint>

namespace pg8 {
#define PG8_LAS __attribute__((address_space(3)))
typedef unsigned short bf16_t;
typedef short bf16x8 __attribute__((ext_vector_type(8)));
typedef float f32x4 __attribute__((ext_vector_type(4)));
typedef float f32x2 __attribute__((ext_vector_type(2)));
typedef unsigned u32x4 __attribute__((ext_vector_type(4)));
typedef unsigned u32x2 __attribute__((ext_vector_type(2)));
typedef int i32x4 __attribute__((ext_vector_type(4)));
typedef int i32x8 __attribute__((ext_vector_type(8)));
constexpr int BM = 256, BK = 64, HALF = 128, HTB = HALF * BK * 2  , STAGE_BYTES = 8 * HTB, NXCD = 8, WGM = 8;

__host__ __device__ __forceinline__ int lds_byte(int r, int c) { const int st = (r >> 4) * 2 + (c >> 5), rr = r & 15, cc = c & 31, ob = rr * 64 + cc * 2; return st * 1024 + (ob ^ (((ob >> 9) & 1) << 5)); }
__host__ __device__ __forceinline__ void stage_rc(int b, int& R, int& C) { const int st = b / 1024, sb = b % 1024, swz = sb ^ (((sb >> 9) & 1) << 5); R = (st >> 1) * 16 + swz / 64; C = (st & 1) * 32 + (swz % 64) / 2; }
__host__ __device__ __forceinline__ int perm32(int rho) { const int n = rho >> 4, i = rho & 15; return 8 * (i >> 2) + 4 * n + (i & 3); }

struct Unit { int pm, pn; size_t aoff, boff; };
struct Gemm { const void* A; const void* Bt; int nt, lda, ldb; unsigned wrapmask; };

struct TileOrder {
    int nM, nN, nwg, G, c; size_t a_tile, b_tile, b_batch; int pmb;
    __device__ __forceinline__ void init(int M, int N, int G_, int c_, int lda_bytes, int ldb_bytes, size_t b_batch_bytes, int pm_per_batch) {
        nM = M / BM; nN = N / BM; nwg = nM * nN; G = G_; c = c_; deal = 0; a_tile = (size_t)BM * lda_bytes; b_tile = (size_t)BM * ldb_bytes; b_batch = b_batch_bytes; pmb = pm_per_batch; }
    int deal;
    __device__ __forceinline__ bool next(int i, Unit& u) const {
        long L = (long)i * G + c;
        if (deal == 1) { const int n = 11 + (c < 128 ? 1 : (c >= 192 ? 2 : 0)); if (i >= n) return false; if (i >= 11) L = c < 128 ? 2816 + c : 2944 + (i - 11) * 64 + (c - 192); }
        if (L >= nwg) return false;
        int wgid = (int)L; { const int q = nwg / NXCD, r = nwg % NXCD, xcd = wgid % NXCD, off = wgid / NXCD; wgid = (xcd < r ? xcd * (q + 1) : r * (q + 1) + (xcd - r) * q) + off; }
        const int nig = WGM * nN, gid = wgid / nig, fm = gid * WGM, gsz = (nM - fm) < WGM ? (nM - fm) : WGM;
        u.pm = fm + ((wgid % nig) % gsz); u.pn = (wgid % nig) / gsz;
        u.aoff = (size_t)u.pm * a_tile; u.boff = (size_t)u.pn * b_tile + (size_t)(u.pm / pmb) * b_batch; return true;
    }
};

__device__ __forceinline__ unsigned cvt_pk_bf16(float lo, float hi) { unsigned r; asm volatile("v_cvt_pk_bf16_f32 %0, %1, %2" : "=v"(r) : "v"(lo), "v"(hi)); return r; }

typedef f32x4 AccT[2][2][4][2];

struct EpiBf16 {
    static constexpr bool PERM = true;
    bf16_t* O; int ldc; unsigned scalemask; float scale0; unsigned* nrm;
    __device__ __forceinline__ void operator()(AccT& acc, const Unit& u, int wr, int wc, int fr, int fq, PG8_LAS unsigned char*) const {
        const int row0 = u.pm * BM + wr * 64 + fr, col0 = u.pn * BM + wc * 32 + 8 * fq;
        const float sc = ((scalemask >> u.pn) & 1u) ? scale0 : 1.f;
        if (nrm && (u.pn < 4 || (u.pn >= 6 && u.pn < 10))) {
#pragma unroll
            for (int bj = 0; bj < 2; ++bj) { float mx = 0.f;
#pragma unroll
                for (int ai = 0; ai < 2; ++ai)
#pragma unroll
                    for (int m = 0; m < 4; ++m) { const f32x4 v0 = acc[ai][bj][m][0] * sc, v1 = acc[ai][bj][m][1] * sc;
                        float q = (v0[0] * v0[0] + v0[1] * v0[1]) + (v0[2] * v0[2] + v0[3] * v0[3]) + (v1[0] * v1[0] + v1[1] * v1[1]) + (v1[2] * v1[2] + v1[3] * v1[3]);
                        q += __shfl_xor(q, 16); q += __shfl_xor(q, 32); mx = fmaxf(mx, q); }
                mx = fmaxf(mx, __shfl_xor(mx, 1)); mx = fmaxf(mx, __shfl_xor(mx, 2)); mx = fmaxf(mx, __shfl_xor(mx, 4)); mx = fmaxf(mx, __shfl_xor(mx, 8));
                if (fr == 0 && fq == 0) { const int head = (u.pn & 1) * 4 + 2 * bj + (wc >> 1); const int grp = u.pn < 4 ? (u.pn >> 1) : (u.pn >> 1) - 1; atomicMax(nrm + (((u.pm >> 5) * 8 + head) * 4 + grp) * 2 + (wc & 1), __float_as_uint(mx)); } } }
#pragma unroll
        for (int ai = 0; ai < 2; ++ai)
#pragma unroll
            for (int m = 0; m < 4; ++m) { bf16_t* rowp = O + (size_t)(row0 + ai * HALF + m * 16) * ldc + col0;
#pragma unroll
                for (int bj = 0; bj < 2; ++bj) { const f32x4 v0 = acc[ai][bj][m][0] * sc, v1 = acc[ai][bj][m][1] * sc;
                    u32x4 w; w.x = cvt_pk_bf16(v0[0], v0[1]); w.y = cvt_pk_bf16(v0[2], v0[3]); w.z = cvt_pk_bf16(v1[0], v1[1]); w.w = cvt_pk_bf16(v1[2], v1[3]);
                    *(u32x4*)(rowp + bj * HALF) = w; } }
    }
};
__device__ __forceinline__ unsigned pk4_fp8(float a, float b, float c, float d) { a = __builtin_amdgcn_fmed3f(a, -448.f, 448.f); b = __builtin_amdgcn_fmed3f(b, -448.f, 448.f); c = __builtin_amdgcn_fmed3f(c, -448.f, 448.f); d = __builtin_amdgcn_fmed3f(d, -448.f, 448.f); int w = 0;
    w = __builtin_amdgcn_cvt_pk_fp8_f32(a, b, w, false); w = __builtin_amdgcn_cvt_pk_fp8_f32(c, d, w, true); return (unsigned)w; }
struct EpiF8 {
    static constexpr bool PERM = true;
    unsigned char* O; int ldc; float sc;
    __device__ __forceinline__ void operator()(AccT& acc, const Unit& u, int wr, int wc, int fr, int fq, PG8_LAS unsigned char*) const {
        const int row0 = u.pm * BM + wr * 64 + fr, col0 = u.pn * BM + wc * 32 + 8 * fq;
#pragma unroll
        for (int ai = 0; ai < 2; ++ai)
#pragma unroll
            for (int m = 0; m < 4; ++m) { unsigned char* rowp = O + (size_t)(row0 + ai * HALF + m * 16) * ldc + col0;
#pragma unroll
                for (int bj = 0; bj < 2; ++bj) { const f32x4 v0 = acc[ai][bj][m][0] * sc, v1 = acc[ai][bj][m][1] * sc;
                    *(u32x2*)(rowp + bj * HALF) = (u32x2){pk4_fp8(v0[0], v0[1], v0[2], v0[3]), pk4_fp8(v1[0], v1[1], v1[2], v1[3])}; } }
    }
};
__device__ __forceinline__ float rstd_from_slots(const float* slots) {
    const f32x4 a = *(const f32x4*)slots, b = *(const f32x4*)(slots + 4), c = *(const f32x4*)(slots + 8), d = *(const f32x4*)(slots + 12);
    const float s = ((a[0] + a[1]) + (a[2] + a[3])) + ((b[0] + b[1]) + (b[2] + b[3])) + ((c[0] + c[1]) + (c[2] + c[3])) + ((d[0] + d[1]) + (d[2] + d[3]));
    return __builtin_amdgcn_rsqf(s * (1.0f / 1024.0f) + 1e-6f);
}
#define PG8_DPP(old, src, ctrl) __builtin_bit_cast(float, __builtin_amdgcn_update_dpp(__builtin_bit_cast(int, (float)(old)), __builtin_bit_cast(int, (float)(src)), (ctrl), 0xf, 0xf, false))
struct EpiConv {
    static constexpr bool PERM = true;
    unsigned char* act; const float* ssq; const float* cw; const float* cbias; float* GH; float* UH; float* GT;
    __device__ __forceinline__ void operator()(AccT& acc, const Unit& u, int wr, int wc, int fr, int fq, PG8_LAS unsigned char* xl) const {
        PG8_LAS float* H = (PG8_LAS float*)xl;
        const int cl = wc * 32 + 8 * fq;
        const int row0 = u.pm * BM + wr * 64 + fr;
        PG8_LAS float* Sr = H + 1024;
        { const int t_ = threadIdx.x; if (t_ < 256) Sr[t_] = rstd_from_slots(ssq + (size_t)(u.pm * BM + t_) * 16); }
        asm volatile("s_waitcnt vmcnt(0) lgkmcnt(0)" ::: "memory"); __builtin_amdgcn_s_barrier(); asm volatile("" ::: "memory");
#pragma unroll
        for (int ai = 0; ai < 2; ++ai)
#pragma unroll
            for (int m = 0; m < 4; ++m) { const float rs = Sr[ai * HALF + wr * 64 + m * 16 + fr];
#pragma unroll
                for (int bj = 0; bj < 2; ++bj)
#pragma unroll
                    for (int n = 0; n < 2; ++n) acc[ai][bj][m][n] *= rs; }
        const size_t sb = ((size_t)(u.pm * 22 + u.pn) * 2) * 128 + cl;
        if (fr >= 14) {
#pragma unroll
            for (int ai = 0; ai < 2; ++ai)
#pragma unroll
                for (int n = 0; n < 2; ++n) *(PG8_LAS f32x4*)(H + ((ai * 2 + wr) * 2 + (fr - 14)) * 128 + cl + 4 * n) = acc[ai][0][3][n];
            if (wr == 1) {
#pragma unroll
                for (int n = 0; n < 2; ++n) *(f32x4*)(GT + sb + (fr - 14) * 128 + 4 * n) = acc[1][0][3][n]; } }
        if (wr == 0 && fr < 2) {
#pragma unroll
            for (int n = 0; n < 2; ++n) { *(f32x4*)(GH + sb + fr * 128 + 4 * n) = acc[0][0][0][n]; *(f32x4*)(UH + sb + fr * 128 + 4 * n) = acc[0][1][0][n]; } }
        asm volatile("s_waitcnt lgkmcnt(0)" ::: "memory"); __builtin_amdgcn_s_barrier(); asm volatile("" ::: "memory");
#pragma unroll
        for (int n = 0; n < 2; ++n) {
            const int c0 = u.pn * 128 + cl + 4 * n;
            const f32x4 w0 = *(const f32x4*)(cw + c0), w1 = *(const f32x4*)(cw + 2816 + c0), w2 = *(const f32x4*)(cw + 2 * 2816 + c0), cbv = *(const f32x4*)(cbias + c0);
#pragma unroll
            for (int ai = 0; ai < 2; ++ai) {
                const int hsrc = wr == 1 ? ai * 2 : (ai == 1 ? 1 : 0);
                const f32x4 h14 = *(const PG8_LAS f32x4*)(H + (hsrc * 2 + 0) * 128 + cl + 4 * n), h15 = *(const PG8_LAS f32x4*)(H + (hsrc * 2 + 1) * 128 + cl + 4 * n);
#pragma unroll
                for (int m = 3; m >= 0; --m) {
                    float res[4];
#pragma unroll
                    for (int i = 0; i < 4; ++i) { const float X = acc[ai][0][m][n][i];
                        float o1, o2;
                        if (m > 0) { const float Xp = acc[ai][0][m > 0 ? m - 1 : 0][n][i]; o1 = PG8_DPP(0.f, Xp, 0x121); o2 = PG8_DPP(0.f, Xp, 0x122); }
                        else { o1 = h15[i]; o2 = fr == 0 ? h14[i] : h15[i]; }
                        const float g1 = PG8_DPP(o1, X, 0x111), g0 = PG8_DPP(o2, X, 0x112);
                        const float gc = cbv[i] + w0[i] * g0 + w1[i] * g1 + w2[i] * X;
                        res[i] = gc * __builtin_amdgcn_rcpf(1.0f + __builtin_amdgcn_exp2f(-1.4426950408889634f * gc)) * acc[ai][1][m][n][i]; }
                    const int row = row0 + ai * HALF + m * 16;
                    if (!(ai == 0 && m == 0 && wr == 0 && fr < 2))
                        *(unsigned*)(act + (size_t)row * 2816 + c0) = pk4_fp8(res[0], res[1], res[2], res[3]);
                } } }
    }
};
template <bool BASEB, bool OUTF> struct EpiRes {
    static constexpr bool PERM = true;
    const float* base; const bf16_t* baseb; float* out; bf16_t* hb; unsigned char* hb8; float* ssq; float accs;
    __device__ __forceinline__ void operator()(AccT& acc, const Unit& u, int wr, int wc, int fr, int fq, PG8_LAS unsigned char*) const {
        const int row0 = u.pm * BM + wr * 64 + fr, col0 = u.pn * BM + wc * 32 + 8 * fq;
#pragma unroll
        for (int ai = 0; ai < 2; ++ai)
#pragma unroll
            for (int m = 0; m < 4; ++m) { const int row = row0 + ai * HALF + m * 16; const size_t off = (size_t)row * 1024 + col0; float q = 0.f;
#pragma unroll
                for (int bj = 0; bj < 2; ++bj) {
                    f32x4 b0, b1;
                    if constexpr (BASEB) { const u32x4 bw = *(const u32x4*)(baseb + off + bj * HALF);
                        b0 = (f32x4){__builtin_bit_cast(float, bw.x << 16), __builtin_bit_cast(float, bw.x & 0xffff0000u), __builtin_bit_cast(float, bw.y << 16), __builtin_bit_cast(float, bw.y & 0xffff0000u)};
                        b1 = (f32x4){__builtin_bit_cast(float, bw.z << 16), __builtin_bit_cast(float, bw.z & 0xffff0000u), __builtin_bit_cast(float, bw.w << 16), __builtin_bit_cast(float, bw.w & 0xffff0000u)}; }
                    else { b0 = *(const f32x4*)(base + off + bj * HALF); b1 = *(const f32x4*)(base + off + bj * HALF + 4); }
                    const f32x4 v0 = acc[ai][bj][m][0] * accs + b0, v1 = acc[ai][bj][m][1] * accs + b1;
                    if constexpr (OUTF) { *(f32x4*)(out + off + bj * HALF) = v0; *(f32x4*)(out + off + bj * HALF + 4) = v1; }
                    q += (v0[0] * v0[0] + v0[1] * v0[1]) + (v0[2] * v0[2] + v0[3] * v0[3]) + (v1[0] * v1[0] + v1[1] * v1[1]) + (v1[2] * v1[2] + v1[3] * v1[3]);
                    if (hb) { u32x4 w; w.x = cvt_pk_bf16(v0[0], v0[1]); w.y = cvt_pk_bf16(v0[2], v0[3]); w.z = cvt_pk_bf16(v1[0], v1[1]); w.w = cvt_pk_bf16(v1[2], v1[3]); *(u32x4*)(hb + off + bj * HALF) = w; }
                    if (hb8) *(u32x2*)(hb8 + off + bj * HALF) = (u32x2){pk4_fp8(v0[0], v0[1], v0[2], v0[3]), pk4_fp8(v1[0], v1[1], v1[2], v1[3])}; }
                q += __shfl_xor(q, 16); q += __shfl_xor(q, 32);
                if (fq == 0) ssq[(size_t)row * 16 + u.pn * 4 + wc] = q; }
    }
};
struct EpiResNorm {
    static constexpr bool PERM = true;
    const bf16_t* baseb; float* out; const float* gfin; float accs; float* xbuf; unsigned* cnt; unsigned* tmo;
    __device__ __forceinline__ void operator()(AccT& acc, const Unit& u, int wr, int wc, int fr, int fq, PG8_LAS unsigned char* xl) const {
        PG8_LAS float* Pp = (PG8_LAS float*)xl;
        PG8_LAS float* Sr = Pp + 1024;
        PG8_LAS unsigned* flag = (PG8_LAS unsigned*)(Sr + 256);
        const int tid = threadIdx.x, wid = tid >> 6, lane = tid & 63;
        const int row0 = u.pm * BM + wr * 64 + fr, col0 = u.pn * BM + wc * 32 + 8 * fq;
#pragma unroll
        for (int ai = 0; ai < 2; ++ai)
#pragma unroll
            for (int m = 0; m < 4; ++m) { const int row = row0 + ai * HALF + m * 16; const size_t off = (size_t)row * 1024 + col0; float q = 0.f;
#pragma unroll
                for (int bj = 0; bj < 2; ++bj) {
                    const u32x4 bw = *(const u32x4*)(baseb + off + bj * HALF);
                    const f32x4 b0 = (f32x4){__builtin_bit_cast(float, bw.x << 16), __builtin_bit_cast(float, bw.x & 0xffff0000u), __builtin_bit_cast(float, bw.y << 16), __builtin_bit_cast(float, bw.y & 0xffff0000u)};
                    const f32x4 b1 = (f32x4){__builtin_bit_cast(float, bw.z << 16), __builtin_bit_cast(float, bw.z & 0xffff0000u), __builtin_bit_cast(float, bw.w << 16), __builtin_bit_cast(float, bw.w & 0xffff0000u)};
                    const f32x4 v0 = acc[ai][bj][m][0] * accs + b0, v1 = acc[ai][bj][m][1] * accs + b1; acc[ai][bj][m][0] = v0; acc[ai][bj][m][1] = v1;
                    q += (v0[0] * v0[0] + v0[1] * v0[1]) + (v0[2] * v0[2] + v0[3] * v0[3]) + (v1[0] * v1[0] + v1[1] * v1[1]) + (v1[2] * v1[2] + v1[3] * v1[3]); }
                q += __shfl_xor(q, 16); q += __shfl_xor(q, 32);
                if (fq == 0) Pp[(ai * HALF + wr * 64 + m * 16 + fr) * 4 + wc] = q; }
        asm volatile("s_waitcnt lgkmcnt(0)" ::: "memory"); __builtin_amdgcn_s_barrier(); asm volatile("" ::: "memory");
        if (wid < 4) { const int r = wid * 64 + lane; const f32x4 p = *(const PG8_LAS f32x4*)(Pp + r * 4);
            __hip_atomic_store(xbuf + (size_t)(u.pm * BM + r) * 4 + u.pn, (p[0] + p[1]) + (p[2] + p[3]), __ATOMIC_RELAXED, __HIP_MEMORY_SCOPE_AGENT);
            asm volatile("s_waitcnt vmcnt(0)" ::: "memory");
            if (lane == 0) __hip_atomic_fetch_add(cnt + 64 * u.pm, 1u, __ATOMIC_RELAXED, __HIP_MEMORY_SCOPE_AGENT); }
        if (wid == 0) { unsigned sp = 0u; bool dead = false;
            for (;;) { if ((unsigned)__builtin_amdgcn_readfirstlane(__hip_atomic_load(cnt + 64 * u.pm, __ATOMIC_RELAXED, __HIP_MEMORY_SCOPE_AGENT)) >= 16u) break;
                if (++sp > (1u << 20)) { if (lane == 0) __hip_atomic_store(tmo, 1u, __ATOMIC_RELAXED, __HIP_MEMORY_SCOPE_AGENT); dead = true; break; }
                __builtin_amdgcn_s_sleep(2); }
            __builtin_amdgcn_fence(__ATOMIC_ACQUIRE, "agent");
            if (lane == 0) flag[0] = dead ? 1u : 0u; }
        asm volatile("s_waitcnt vmcnt(0) lgkmcnt(0)" ::: "memory"); __builtin_amdgcn_s_barrier(); asm volatile("" ::: "memory");
        if (wid < 4) { const int r = wid * 64 + lane; const float* xs = xbuf + (size_t)(u.pm * BM + r) * 4; float s = 0.f;
#pragma unroll
            for (int t = 0; t < 4; ++t) s += __hip_atomic_load(xs + t, __ATOMIC_RELAXED, __HIP_MEMORY_SCOPE_AGENT);
            Sr[r] = __builtin_amdgcn_rsqf(s * (1.0f / 1024.0f) + 1e-6f); }
        asm volatile("s_waitcnt vmcnt(0) lgkmcnt(0)" ::: "memory"); __builtin_amdgcn_s_barrier(); asm volatile("" ::: "memory");
        f32x4 gg[2][2];
#pragma unroll
        for (int bj = 0; bj < 2; ++bj) { gg[bj][0] = *(const f32x4*)(gfin + col0 + bj * HALF); gg[bj][1] = *(const f32x4*)(gfin + col0 + bj * HALF + 4); }
#pragma unroll
        for (int ai = 0; ai < 2; ++ai)
#pragma unroll
            for (int m = 0; m < 4; ++m) { const int rl = ai * HALF + wr * 64 + m * 16 + fr; const float rs = Sr[rl]; const size_t off = (size_t)(u.pm * BM + rl) * 1024 + col0;
#pragma unroll
                for (int bj = 0; bj < 2; ++bj) { *(f32x4*)(out + off + bj * HALF) = acc[ai][bj][m][0] * rs * gg[bj][0]; *(f32x4*)(out + off + bj * HALF + 4) = acc[ai][bj][m][1] * rs * gg[bj][1]; } }
    }
};
struct EpiSoftmax {
    static constexpr bool PERM = true;
    unsigned char* P; const float* ssq; float sscale;
    __device__ __forceinline__ void operator()(AccT& acc, const Unit& u, int wr, int wc, int fr, int fq, PG8_LAS unsigned char* xl) const {
        PG8_LAS f32x2* X = (PG8_LAS f32x2*)xl;
        const int row0 = u.pm * BM + wr * 64 + fr, col0 = u.pn * BM + wc * 32 + 8 * fq;
        float ml[2][4];
#pragma unroll
        for (int ai = 0; ai < 2; ++ai)
#pragma unroll
            for (int m = 0; m < 4; ++m) { const int row = row0 + ai * HALF + m * 16; const float rs = rstd_from_slots(ssq + (size_t)row * 16) * sscale;
                float mx = -3.0e38f;
#pragma unroll
                for (int bj = 0; bj < 2; ++bj)
#pragma unroll
                    for (int n = 0; n < 2; ++n) { f32x4 v = acc[ai][bj][m][n] * rs; acc[ai][bj][m][n] = v; mx = fmaxf(fmaxf(mx, fmaxf(v[0], v[1])), fmaxf(v[2], v[3])); }
                mx = fmaxf(mx, __shfl_xor(mx, 16)); mx = fmaxf(mx, __shfl_xor(mx, 32));
                float s = 0.f;
#pragma unroll
                for (int bj = 0; bj < 2; ++bj)
#pragma unroll
                    for (int n = 0; n < 2; ++n) { f32x4 v = acc[ai][bj][m][n];
                        v[0] = __builtin_amdgcn_exp2f(v[0] - mx); v[1] = __builtin_amdgcn_exp2f(v[1] - mx); v[2] = __builtin_amdgcn_exp2f(v[2] - mx); v[3] = __builtin_amdgcn_exp2f(v[3] - mx);
                        acc[ai][bj][m][n] = v; s += (v[0] + v[1]) + (v[2] + v[3]); }
                s += __shfl_xor(s, 16); s += __shfl_xor(s, 32);
                ml[ai][m] = mx;
                if (fq == 0) X[(ai * HALF + wr * 64 + m * 16 + fr) * 4 + wc] = (f32x2){mx, s}; }
        asm volatile("s_waitcnt lgkmcnt(0)" ::: "memory"); __builtin_amdgcn_s_barrier(); asm volatile("" ::: "memory");
#pragma unroll
        for (int ai = 0; ai < 2; ++ai)
#pragma unroll
            for (int m = 0; m < 4; ++m) { const int rl = ai * HALF + wr * 64 + m * 16 + fr; const int row = u.pm * BM + rl;
                const f32x2 a = X[rl * 4 + 0], b = X[rl * 4 + 1], c = X[rl * 4 + 2], d = X[rl * 4 + 3];
                const float Mx = fmaxf(fmaxf(a.x, b.x), fmaxf(c.x, d.x));
                const float L = a.y * __builtin_amdgcn_exp2f(a.x - Mx) + b.y * __builtin_amdgcn_exp2f(b.x - Mx) + c.y * __builtin_amdgcn_exp2f(c.x - Mx) + d.y * __builtin_amdgcn_exp2f(d.x - Mx);
                const float f = __builtin_amdgcn_exp2f(ml[ai][m] - Mx) * __builtin_amdgcn_rcpf(L) * 256.0f;
                unsigned char* rowp = P + (size_t)row * 1024 + col0;
#pragma unroll
                for (int bj = 0; bj < 2; ++bj) { const f32x4 v0 = acc[ai][bj][m][0] * f, v1 = acc[ai][bj][m][1] * f;
                    *(u32x2*)(rowp + bj * HALF) = (u32x2){pk4_fp8(v0[0], v0[1], v0[2], v0[3]), pk4_fp8(v1[0], v1[1], v1[2], v1[3])}; } }
    }
};
struct EpiGate {
    static constexpr bool PERM = false;
    unsigned* sel;
    __device__ __forceinline__ void operator()(AccT& acc, const Unit& u, int wr, int wc, int fr, int fq, PG8_LAS unsigned char*) const {
        const int own = u.pm & 31;
#pragma unroll
        for (int ai = 0; ai < 2; ++ai)
#pragma unroll
            for (int m = 0; m < 4; ++m) { const int row = u.pm * BM + ai * HALF + wr * 64 + m * 16 + fr;
#pragma unroll
                for (int bj = 0; bj < 2; ++bj) { unsigned mask = 0u;
#pragma unroll
                    for (int round = 0; round < 3; ++round) { float bv = -3.0e38f; int bi = 32;
#pragma unroll
                        for (int n = 0; n < 2; ++n)
#pragma unroll
                            for (int i = 0; i < 4; ++i) { const int nb = 16 * n + 4 * fq + i; const float v = acc[ai][bj][m][n][i];
                                if (nb < own && !((mask >> nb) & 1u) && v > bv) { bv = v; bi = nb; } }
#pragma unroll
                        for (int off = 16; off <= 32; off <<= 1) { const float ov = __shfl_xor(bv, off); const int oi = __shfl_xor(bi, off); if (ov > bv || (ov == bv && oi < bi)) { bv = ov; bi = oi; } }
                        if (bi < 32) mask |= 1u << bi; }
                    if (fq == 0) sel[((size_t)((u.pm >> 5) * 8 + 4 * bj + wc)) * 8192 + (row & 8191)] = mask; } }
    }
};

template <class Epi, class Sched, bool ALIGN_EPI, bool F8 = false>
__device__ __forceinline__ void gemm_phase(PG8_LAS unsigned char* lds, PG8_LAS unsigned char* xl, const Gemm g, const Sched& S, const Epi& E) {
    int tid_ = threadIdx.x; asm volatile("" : "+v"(tid_));
    const int tid = tid_, wid = __builtin_amdgcn_readfirstlane(tid >> 6), lane = tid & 63, wr = wid >> 2, wc = wid & 3, fr = lane & 15, fq = lane >> 4;
    int nt = g.nt; asm volatile("" : "+s"(nt));
    unsigned voffA[2], voffB[2];
#pragma unroll
    for (int i = 0; i < 2; ++i) { int R, C; stage_rc(tid * 16 + i * 8192, R, C); const int Rb = Epi::PERM ? ((R & ~31) + perm32(R & 31)) : R;
        voffA[i] = (unsigned)(R * g.lda + C * 2); voffB[i] = (unsigned)(Rb * g.ldb + C * 2); }
    const size_t kstep = (size_t)(BK * 2);
    const size_t hstepA = (size_t)HALF * g.lda, hstepB = (size_t)HALF * g.ldb;
    const unsigned wmask = g.wrapmask;
    const unsigned ldsw = (unsigned)wid * 1024u;
    const int aoff = lds_byte(wr * 64 + fr, fq * 8), boff = lds_byte(wc * 32 + fr, fq * 8);
#define PG8_SA(b, h) (((b) * 2 + (h)) * HTB)
#define PG8_SB(b, h) ((4 + (b) * 2 + (h)) * HTB)
#define PG8_STAGE(bufoff, gbase, voff) do { _Pragma("unroll") for (int _i = 0; _i < 2; ++_i) \
        __builtin_amdgcn_global_load_lds((const unsigned*)((const char*)(gbase) + (voff)[_i]), (PG8_LAS unsigned*)(lds + (bufoff) + ldsw + _i * 8192), 16, 0, 0); } while (0)
#define PG8_LDA(dst, b, h) do { if constexpr (F8) { _Pragma("unroll") for (int m = 0; m < 4; ++m) { dst##8[m].lo = *(const PG8_LAS i32x4*)(lds + PG8_SA(b, h) + aoff + m * 2048); dst##8[m].hi = *(const PG8_LAS i32x4*)(lds + PG8_SA(b, h) + aoff + m * 2048 + 1024); } } \
        else { _Pragma("unroll") for (int m = 0; m < 4; ++m) _Pragma("unroll") for (int k = 0; k < 2; ++k) dst[m][k] = *(const PG8_LAS bf16x8*)(lds + PG8_SA(b, h) + aoff + m * 2048 + k * 1024); } } while (0)
#define PG8_LDB(dst, b, h) do { if constexpr (F8) { _Pragma("unroll") for (int n = 0; n < 2; ++n) { dst##8[n].lo = *(const PG8_LAS i32x4*)(lds + PG8_SB(b, h) + boff + n * 2048); dst##8[n].hi = *(const PG8_LAS i32x4*)(lds + PG8_SB(b, h) + boff + n * 2048 + 1024); } } \
        else { _Pragma("unroll") for (int n = 0; n < 2; ++n) _Pragma("unroll") for (int k = 0; k < 2; ++k) dst[n][k] = *(const PG8_LAS bf16x8*)(lds + PG8_SB(b, h) + boff + n * 2048 + k * 1024); } } while (0)
#define PG8_MMA(ai, bj, At, Bt) do { __builtin_amdgcn_s_setprio(1); \
        if constexpr (F8) { _Pragma("unroll") for (int m = 0; m < 4; ++m) _Pragma("unroll") for (int n = 0; n < 2; ++n) \
            asm volatile("v_mfma_f32_16x16x128_f8f6f4 %0, %1, %2, %0" : "+v"(acc[ai][bj][m][n]) : "v"(Bt##8[n]), "v"(At##8[m])); } \
        else { _Pragma("unroll") for (int m = 0; m < 4; ++m) _Pragma("unroll") for (int n = 0; n < 2; ++n) _Pragma("unroll") for (int k = 0; k < 2; ++k) \
            acc[ai][bj][m][n] = __builtin_amdgcn_mfma_f32_16x16x32_bf16(Bt[n][k], At[m][k], acc[ai][bj][m][n], 0, 0, 0); } \
        __builtin_amdgcn_s_setprio(0); } while (0)
#define PG8_WAIT_V(n) asm volatile("s_waitcnt vmcnt(" #n ")" ::: "memory")
#define PG8_WAIT_L(n) asm volatile("s_waitcnt lgkmcnt(" #n ")" ::: "memory")
#define PG8_BAR __builtin_amdgcn_s_barrier()
#define PG8_SCHED __builtin_amdgcn_sched_barrier(0)
    Unit cur, nxt; int ui = 0;
    if (!S.next(0, cur)) return;
    AccT acc;
    bf16x8 At[4][2], B0[2][2], B1[2][2]; i32x8 At8[4], B08[2], B18[2];
    const char* cA = (const char*)g.A + cur.aoff; const char* cB = (const char*)g.Bt + cur.boff;
    PG8_STAGE(PG8_SB(0, 0), cB, voffB); PG8_STAGE(PG8_SB(0, 1), cB + hstepB, voffB); PG8_STAGE(PG8_SA(0, 0), cA, voffA); PG8_STAGE(PG8_SA(0, 1), cA + hstepA, voffA);
    if (wr == 1) PG8_BAR;
    PG8_WAIT_V(2); PG8_BAR;
    PG8_STAGE(PG8_SB(1, 0), cB + kstep, voffB); PG8_STAGE(PG8_SA(1, 0), cA + kstep, voffA); PG8_STAGE(PG8_SB(1, 1), cB + hstepB + kstep, voffB);
    PG8_WAIT_V(6); PG8_BAR;
    { float z0; asm volatile("v_mov_b32 %0, 0" : "=v"(z0));
#pragma unroll
    for (int a = 0; a < 2; ++a)
#pragma unroll
        for (int b = 0; b < 2; ++b)
#pragma unroll
            for (int m = 0; m < 4; ++m)
#pragma unroll
                for (int n = 0; n < 2; ++n) acc[a][b][m][n] = (f32x4){z0, z0, z0, z0}; }
    for (;;) {
        const bool has_next = S.next(ui + 1, nxt);
        const char* nA = has_next ? (const char*)g.A + nxt.aoff : cA; const char* nB = has_next ? (const char*)g.Bt + nxt.boff : cB;
#pragma unroll 1
        for (int t = 0; t < nt; t += 2) {
            const bool last = (t == nt - 2);
            const char* a1 = cA + (size_t)((unsigned)(t * 128) & wmask) + kstep;
            const char* a2 = last ? nA : cA + (size_t)((unsigned)((t + 2) * 128) & wmask); const char* b2 = last ? nB : cB + (size_t)(t + 2) * kstep;
            const char* a3 = a2 + kstep; const char* b3 = b2 + kstep;
            PG8_LDB(B0, 0, 0); PG8_LDB(B1, 0, 1); PG8_SCHED; PG8_LDA(At, 0, 0); PG8_STAGE(PG8_SA(1, 1), a1 + hstepA, voffA);
            PG8_WAIT_V(8); PG8_WAIT_L(0); PG8_BAR; PG8_MMA(0, 0, At, B0); PG8_MMA(0, 1, At, B1); PG8_BAR; PG8_SCHED;
            PG8_LDA(At, 0, 1); PG8_STAGE(PG8_SB(0, 0), b2, voffB); PG8_STAGE(PG8_SB(0, 1), b2 + hstepB, voffB); PG8_STAGE(PG8_SA(0, 0), a2, voffA);
            PG8_WAIT_V(8); PG8_WAIT_L(0); PG8_BAR; PG8_MMA(1, 0, At, B0); PG8_MMA(1, 1, At, B1); PG8_BAR; PG8_SCHED;
            PG8_LDB(B0, 1, 0); PG8_LDB(B1, 1, 1); PG8_SCHED; PG8_LDA(At, 1, 0); PG8_STAGE(PG8_SA(0, 1), a2 + hstepA, voffA);
            PG8_WAIT_V(8); PG8_WAIT_L(0); PG8_BAR; PG8_MMA(0, 0, At, B0); PG8_MMA(0, 1, At, B1); PG8_BAR; PG8_SCHED;
            PG8_LDA(At, 1, 1); PG8_STAGE(PG8_SB(1, 0), b3, voffB); PG8_STAGE(PG8_SB(1, 1), b3 + hstepB, voffB); PG8_STAGE(PG8_SA(1, 0), a3, voffA);
            PG8_WAIT_V(8); PG8_WAIT_L(0); PG8_BAR; PG8_MMA(1, 0, At, B0); PG8_MMA(1, 1, At, B1); PG8_BAR; PG8_SCHED;
        }
        if constexpr (F8) asm volatile("s_nop 15\n\ts_nop 15" ::: "memory");
        if constexpr (ALIGN_EPI) { if (wr == 0) PG8_BAR; }
        E(acc, cur, wr, wc, fr, fq, xl);
        if (!has_next) break;
#pragma unroll
        for (int a = 0; a < 2; ++a)
#pragma unroll
            for (int b = 0; b < 2; ++b)
#pragma unroll
                for (int m = 0; m < 4; ++m)
#pragma unroll
                    for (int n = 0; n < 2; ++n) acc[a][b][m][n] = (f32x4){0.f, 0.f, 0.f, 0.f};
        cur = nxt; cA = nA; cB = nB; ++ui;
        if constexpr (ALIGN_EPI) { if (wr == 1) PG8_BAR; }
    }
    PG8_WAIT_V(0);
    if constexpr (!ALIGN_EPI) { if (wr == 0) PG8_BAR; }
    PG8_BAR;
#undef PG8_SA
#undef PG8_SB
#undef PG8_STAGE
#undef PG8_LDA
#undef PG8_LDB
#undef PG8_MMA
#undef PG8_WAIT_V
#undef PG8_WAIT_L
#undef PG8_BAR
#undef PG8_SCHED
}
}

constexpr int NWAVES = 8;
constexpr int NB = 8, T = 8192, D = 1024, M = NB * T;
constexpr int INC = 3080, NQKV = 3072, FF = 2816;
constexpr int C_F = 1536, C_QM = 1544, C_KM = 2056;
constexpr float LOG2E = 1.4426950408889634f;
constexpr float C2 = 0.125f * LOG2E;
constexpr float RMS_EPS = 1e-6f;

constexpr size_t MiB = 1u << 20;
constexpr size_t WS_CTL = 0, CTL_ZERO_BYTES = 1 * MiB;
constexpr size_t WS_LOGF = 2 * MiB, WS_C = 4 * MiB, WS_ABAR = 6 * MiB, WS_KM = 7 * MiB, WS_SEL = 8 * MiB;
constexpr size_t WS_SSQ1 = 10 * MiB, WS_SSQ2 = 14 * MiB, WS_SSQ3 = 18 * MiB;
constexpr size_t WS_MEMN = 22 * MiB, WS_KV = 26 * MiB, WS_WQS = 34 * MiB, WS_WOT = 36 * MiB, WS_WKVT = 38 * MiB, WS_WINT = 42 * MiB, WS_WOUTT = 48 * MiB;
constexpr size_t WS_WUPT = 50 * MiB, WS_WDT = 976 * MiB  , WS_ZT = 68 * MiB, WS_WQK = 80 * MiB, WS_VWO = 96 * MiB;
constexpr size_t WS_ACT8 = 240 * MiB;
constexpr size_t WS_GH = 416 * MiB, WS_UH = 424 * MiB, WS_GT = 432 * MiB;
constexpr size_t WS_A1 = 112 * MiB;
constexpr size_t WS_QKV = 368 * MiB;
constexpr size_t WS_Y = 752 * MiB, WS_HB1 = WS_A1 + 128 * MiB, WS_P = WS_QKV, WS_HB2 = WS_A1;
constexpr size_t WS_HB1F = WS_A1;
constexpr size_t WS_PO = WS_A1;
constexpr size_t WS_LIST = 880 * MiB, WS_PML = 944 * MiB, WS_KXF = 960 * MiB, WS_KXM = 968 * MiB, WS_CNT = 969 * MiB;
constexpr size_t WS_G = 240 * MiB, WS_U = 592 * MiB, WS_END = 1024 * MiB;
static_assert(WS_WUPT + (size_t)2 * FF * D * 2 <= WS_ZT && WS_ACT8 + (size_t)M * FF <= WS_GH && WS_WDT + (size_t)D * FF <= WS_END && WS_CNT + 8192 <= WS_WDT && WS_ZT + (size_t)8 * 256 * 3072 * 2 <= WS_WQK && WS_VWO + 16 * MiB <= WS_A1, "ws map");
static_assert(WS_G + (size_t)M * FF * 2 <= WS_U && WS_U + (size_t)M * FF * 2 <= WS_END && WS_Y + (size_t)M * D * 2 <= WS_LIST && WS_LIST + (size_t)2048 * 8192 * 4 <= WS_PML && WS_PML + (size_t)M * 32 * 8 <= WS_KXF && WS_KXF + (size_t)64 * 8192 * 16 <= WS_KXM, "ws map 2");
constexpr int CW_BAR = 4096;
constexpr int CW_QKN = 8192;
constexpr int CW_QUEUE = 12288;
constexpr int CW_T0TAB = 16384;
constexpr int CW_CNT_KM = 24576, CW_CNT_Z = 24640, CW_CNT_KV = 24704;
constexpr int CW_PANEL = 32768, CW_TMO2 = 20480;

constexpr int RING_OFF = 0, RING_BYTES = 131072;
constexpr int LDSCTL_OFF = RING_BYTES, MISC_OFF = LDSCTL_OFF + 320;
constexpr int XL_OFF = RING_BYTES + 512;
constexpr int LDS_BYTES = 147456;
static_assert(XL_OFF + 8192 <= LDS_BYTES, "LDS map");

#define GAS __attribute__((address_space(1)))
#define LAS __attribute__((address_space(3)))
typedef unsigned short bf16;
typedef unsigned v4u __attribute__((ext_vector_type(4)));
typedef float f32x4 __attribute__((ext_vector_type(4)));
typedef GAS unsigned gu32;
#define RLX_AGENT __ATOMIC_RELAXED, __HIP_MEMORY_SCOPE_AGENT
#define LDS_WAIT() asm volatile("s_waitcnt lgkmcnt(0)" ::: "memory")
__device__ __forceinline__ unsigned f2bf(float f) { unsigned u = __builtin_bit_cast(unsigned, f); return (u + 0x7fffu + ((u >> 16) & 1u)) >> 16; }
__device__ __forceinline__ unsigned pk2(float lo, float hi) { unsigned r; asm("v_cvt_pk_bf16_f32 %0, %1, %2" : "=v"(r) : "v"(lo), "v"(hi)); return r; }
__device__ __forceinline__ float bf2f(unsigned b) { return __builtin_bit_cast(float, b << 16); }
__device__ __forceinline__ float bflo(unsigned w) { return __builtin_bit_cast(float, w << 16); }
__device__ __forceinline__ float bfhi(unsigned w) { return __builtin_bit_cast(float, w & 0xffff0000u); }

#define XB_TMO      128
#define XB_XCNT(j)  (256  + 64 * (j))
#define XB_XSUB(j)  (1280 + 64 * (j))
#define XB_XGEN(j)  (2304 + 64 * (j))
#define XB_TOP      3328
#define XB_TOPGEN   3392
#define XCD_BAR_WORDS 3456
#define XB_SPIN_CAP (1u << 18)

__device__ __forceinline__ unsigned xb_ld(unsigned* p)              { return __hip_atomic_load(p, __ATOMIC_RELAXED, __HIP_MEMORY_SCOPE_AGENT); }
__device__ __forceinline__ unsigned xb_add(unsigned* p, unsigned v) { return __hip_atomic_fetch_add(p, v, __ATOMIC_RELAXED, __HIP_MEMORY_SCOPE_AGENT); }
__device__ __forceinline__ unsigned xb_xcc_id() { return (unsigned)__builtin_amdgcn_s_getreg((3 << 11) | 20) & 0xFu; }
#define XB_SPIN(cond, bar) do { unsigned _sp = 0; while (cond) { __builtin_amdgcn_s_sleep(1); \
    if ((++_sp & 255u) == 0u) { if (xb_ld(&(bar)[XB_TMO])) break; if (_sp > XB_SPIN_CAP) { atomicAdd(&(bar)[XB_TMO], 1u); break; } } } } while (0)

struct XcdBarrier { unsigned* bar; unsigned x; volatile LAS unsigned* st; };

__device__ __forceinline__ XcdBarrier xcd_barrier_post(unsigned* bar, volatile LAS unsigned* st) {
    XcdBarrier b; b.bar = bar; b.x = xb_xcc_id(); b.st = st;
    if (threadIdx.x == 0) (void)xb_add(&bar[XB_XCNT(b.x)], 1u);
    return b;
}
__device__ __forceinline__ void xcd_barrier_complete(unsigned* bar, unsigned x, unsigned& nloc, unsigned& nx) {
    const unsigned G = gridDim.x * gridDim.y * gridDim.z;
    unsigned sum, cnt, mine, sp = 0u;
    for (;;) {
        sum = 0u; cnt = 0u; mine = 0u;
#pragma unroll
        for (unsigned j = 0; j < 16; ++j) { const unsigned c = xb_ld(&bar[XB_XCNT(j)]); sum += c; cnt += (c > 0u) ? 1u : 0u; mine = (j == x) ? c : mine; }
        if (sum == G) break;
        __builtin_amdgcn_s_sleep(1);
        if ((++sp & 255u) == 0u) { if (xb_ld(&bar[XB_TMO])) break; if (sp > XB_SPIN_CAP) { atomicAdd(&bar[XB_TMO], 1u); break; } }
    }
    nloc = mine > 0u ? mine : 1u; nx = cnt > 0u ? cnt : 1u;
}
__device__ __forceinline__ void xcd_barrier(const XcdBarrier& b) {
    asm volatile("s_waitcnt vmcnt(0)" ::: "memory");
    __syncthreads();
    if (threadIdx.x == 0) {
        unsigned* bar = b.bar;
        __builtin_amdgcn_s_waitcnt(0);
        unsigned nloc = b.st[0], nx = b.st[1];
        if (nloc == 0u) { xcd_barrier_complete(bar, b.x, nloc, nx); b.st[0] = nloc; b.st[1] = nx; }
        const unsigned old = xb_add(&bar[XB_XSUB(b.x)], 1u);
        const unsigned gen = old / nloc;
        if (old + 1u == (gen + 1u) * nloc) {
            __builtin_amdgcn_fence(__ATOMIC_RELEASE, "agent");
            asm volatile("s_waitcnt vmcnt(0)" ::: "memory");
            const unsigned og = xb_add(&bar[XB_TOP], 1u);
            const unsigned tg = og / nx;
            if (og + 1u == (tg + 1u) * nx) xb_add(&bar[XB_TOPGEN], 1u);
            else XB_SPIN(xb_ld(&bar[XB_TOPGEN]) == tg, bar);
            __builtin_amdgcn_fence(__ATOMIC_ACQUIRE, "agent");
            xb_add(&bar[XB_XGEN(b.x)], 1u);
            asm volatile("s_waitcnt vmcnt(0)" ::: "memory");
        } else {
            XB_SPIN(xb_ld(&bar[XB_XGEN(b.x)]) == gen, bar);
            __builtin_amdgcn_fence(__ATOMIC_ACQUIRE, "agent");
            asm volatile("s_waitcnt vmcnt(0)" ::: "memory");
        }
    }
    __syncthreads();
}

__device__ __forceinline__ float wave_sum(float v) {
#pragma unroll
    for (int o = 1; o < 64; o <<= 1) v += __shfl_xor(v, o);
    return v;
}
__device__ __forceinline__ void p0_transpose_item(const float* W, int ldw, int K, int N, bf16* WT, const float* kscale, bool remap, LAS float* scr, int item, int lane, float f8scale = 0.f, bool upmap = false) {
    const int nblk = N / 64, kb = item / nblk, nb = item % nblk, k0 = 32 * kb, n0 = 64 * nb;
    int sn0 = (remap && n0 >= 1536) ? n0 + 8 : n0;
    if (upmap) { const int within = n0 & 255, pt = n0 >> 8; sn0 = within < 128 ? 128 * pt + within : 2816 + 128 * pt + (within - 128); }
    float v[32];
#pragma unroll
    for (int i = 0; i < 32; ++i) v[i] = W[(size_t)(k0 + i) * ldw + sn0 + lane];
#pragma unroll
    for (int i = 0; i < 32; ++i) { float x = v[i]; if (kscale) x *= kscale[k0 + i]; scr[i * 65 + lane] = x; }
    LDS_WAIT(); asm volatile("" ::: "memory");
    const int kq = lane & 3;
#pragma unroll
    for (int j = 0; j < 4; ++j) { const int n = (lane >> 2) + 16 * j; const LAS float* sp = scr + (8 * kq) * 65 + n;
        if (f8scale != 0.f) { const unsigned lo = pg8::pk4_fp8(sp[0 * 65] * f8scale, sp[1 * 65] * f8scale, sp[2 * 65] * f8scale, sp[3 * 65] * f8scale), hi = pg8::pk4_fp8(sp[4 * 65] * f8scale, sp[5 * 65] * f8scale, sp[6 * 65] * f8scale, sp[7 * 65] * f8scale);
            *(GAS unsigned long long*)((unsigned char*)WT + (size_t)(n0 + n) * K + k0 + 8 * kq) = (unsigned long long)lo | ((unsigned long long)hi << 32); }
        else { v4u o; o.x = pk2(sp[0 * 65], sp[1 * 65]); o.y = pk2(sp[2 * 65], sp[3 * 65]); o.z = pk2(sp[4 * 65], sp[5 * 65]); o.w = pk2(sp[6 * 65], sp[7 * 65]);
            *(GAS v4u*)(WT + (size_t)(n0 + n) * K + k0 + 8 * kq) = o; } }
    LDS_WAIT(); asm volatile("" ::: "memory");
}

struct Args { const float* in[19]; float* out; unsigned char* ws; };
__device__ __forceinline__ float skip_thr(const unsigned* qk8, int moba) {
    const unsigned* p = qk8 + 4 * moba;
    const float qn = sqrtf(__uint_as_float(__hip_atomic_load(p, RLX_AGENT)) + __uint_as_float(__hip_atomic_load(p + 1, RLX_AGENT))), kn = sqrtf(__uint_as_float(__hip_atomic_load(p + 2, RLX_AGENT)) + __uint_as_float(__hip_atomic_load(p + 3, RLX_AGENT)));
    return 2.0f * qn * kn * 1.02f + 40.0f;
}
__device__ __forceinline__ bool moba_skip(int h, int j, int n, float thr) { return __builtin_amdgcn_exp2f(-(float)(h + 1)) * LOG2E * (float)(256 * (j - n - 1) + 1) >= thr; }

namespace attn_body {
using hb16=__hip_bfloat16;
using bf16x8=__attribute__((ext_vector_type(8)))short;
using s16x4=__attribute__((ext_vector_type(4)))short;
using f32x16=__attribute__((ext_vector_type(16)))float;
using u32x4=__attribute__((ext_vector_type(4)))unsigned;
constexpr int PITCH=3072;
constexpr int NW=8,QBLK=32,QB=QBLK*NW,KVBLK=64;
__device__ __forceinline__ int crow(int r,int hi){return (r&3)+8*(r>>2)+4*hi;}
#define SBAR() __builtin_amdgcn_sched_barrier(0)
__device__ __forceinline__ void cmask(f32x16&p0,f32x16&p1,int jb,int qrel,int hi){
  const float NEG=-INFINITY; int kb=64*jb+4*hi;
  #pragma unroll
  for(int r=0;r<16;++r){int kv=kb+(r&3)+8*(r>>2); if(kv>qrel)p0[r]=NEG; if(kv+32>qrel)p1[r]=NEG;}
}
constexpr int NSLOT=3, SLOTB=9216;
constexpr int LDS_K=0, LDS_V=NSLOT*SLOTB, LDS_WS=2*NSLOT*SLOTB, LDS_OST=LDS_WS+NW*64*4, LDS_BYTES=LDS_OST+NW*4096;
__device__ __forceinline__ void glds16(const void*gsrc,unsigned lds_dst){unsigned keep;
  asm volatile("s_mov_b32 %0, m0\n\ts_mov_b32 m0, %2\n\ts_nop 0\n\tglobal_load_lds_dwordx4 %1, off\n\ts_mov_b32 m0, %0":"=&s"(keep):"v"(gsrc),"s"(lds_dst):"memory");}
__device__ __forceinline__ void glds16x(const void*gsrc,unsigned lds_dst){unsigned keep;unsigned long long ex;
  asm volatile("s_mov_b32 %0, m0\n\ts_mov_b64 %1, exec\n\ts_mov_b64 exec, 0xff\n\ts_mov_b32 m0, %3\n\ts_nop 0\n\tglobal_load_lds_dwordx4 %2, off\n\ts_mov_b64 exec, %1\n\ts_mov_b32 m0, %0":"=&s"(keep),"=&s"(ex):"v"(gsrc),"s"(lds_dst):"memory");}
__device__ __forceinline__ float max3f(float a,float b,float c){float r;asm("v_max3_f32 %0, %1, %2, %3":"=v"(r):"v"(a),"v"(b),"v"(c));return r;}
__device__ __forceinline__ float max2f(float a,float b){float r;asm("v_max_f32_e32 %0, %1, %2":"=v"(r):"v"(a),"v"(b));return r;}
__device__ __forceinline__ float fsub_s(float a,float b){float r;asm("v_sub_f32_e32 %0, %1, %2":"=v"(r):"v"(a),"v"(b));return r;}
typedef float f32x2_t __attribute__((ext_vector_type(2))); typedef __bf16 bf16x2_t __attribute__((ext_vector_type(2)));
__device__ __forceinline__ unsigned cvtpk_s(float lo,float hi){f32x2_t v={lo,hi};bf16x2_t b=__builtin_convertvector(v,bf16x2_t);return __builtin_bit_cast(unsigned,b);}
__device__ __forceinline__ float rbf(float x){return __builtin_bit_cast(float,cvtpk_s(x,0.f)<<16);}
#define WAIT_BAR(N) asm volatile("s_waitcnt vmcnt(" #N ") lgkmcnt(0)\n\ts_barrier":::"memory")

__device__ __forceinline__ void qkt(f32x16&p0,f32x16&p1,const char*Kslot,const bf16x8*qr,int r32,int hi){
  const char*kb=Kslot+hi*1024+r32*16; const f32x16 zf={};
  #pragma unroll
  for(int d0=0;d0<4;++d0){
    const bf16x8 b0=*reinterpret_cast<const bf16x8*>(kb+d0*2048);
    const bf16x8 b1=*reinterpret_cast<const bf16x8*>(kb+d0*2048+512);
    if(d0==0){p0=__builtin_amdgcn_mfma_f32_32x32x16_bf16(b0,qr[0],zf,0,0,0);p1=__builtin_amdgcn_mfma_f32_32x32x16_bf16(b1,qr[0],zf,0,0,0);}
    else{p0=__builtin_amdgcn_mfma_f32_32x32x16_bf16(b0,qr[d0],p0,0,0,0);p1=__builtin_amdgcn_mfma_f32_32x32x16_bf16(b1,qr[d0],p1,0,0,0);}}
  const char*kx=Kslot+8192+r32*16;
  const bf16x8 x0=*reinterpret_cast<const bf16x8*>(kx), x1=*reinterpret_cast<const bf16x8*>(kx+512);
  p0=__builtin_amdgcn_mfma_f32_32x32x16_bf16(x0,qr[4],p0,0,0,0);p1=__builtin_amdgcn_mfma_f32_32x32x16_bf16(x1,qr[4],p1,0,0,0);
}
typedef __attribute__((address_space(3))) const char* lds_cptr;
typedef short v4i16_t __attribute__((ext_vector_type(4)));
__device__ __forceinline__ void kload10(bf16x8*kf,lds_cptr kp,lds_cptr kx){
  kf[0]=*(const __attribute__((address_space(3))) bf16x8*)(kp);      kf[1]=*(const __attribute__((address_space(3))) bf16x8*)(kp+512);
  kf[2]=*(const __attribute__((address_space(3))) bf16x8*)(kp+2048); kf[3]=*(const __attribute__((address_space(3))) bf16x8*)(kp+2560);
  kf[4]=*(const __attribute__((address_space(3))) bf16x8*)(kp+4096); kf[5]=*(const __attribute__((address_space(3))) bf16x8*)(kp+4608);
  kf[6]=*(const __attribute__((address_space(3))) bf16x8*)(kp+6144); kf[7]=*(const __attribute__((address_space(3))) bf16x8*)(kp+6656);
  kf[8]=*(const __attribute__((address_space(3))) bf16x8*)(kx);      kf[9]=*(const __attribute__((address_space(3))) bf16x8*)(kx+512);
}
__device__ __forceinline__ void kload2(bf16x8*kf,lds_cptr kp,int j){ kf[2*j]=*(const __attribute__((address_space(3))) bf16x8*)(kp+j*2048); kf[2*j+1]=*(const __attribute__((address_space(3))) bf16x8*)(kp+j*2048+512); }
__device__ __forceinline__ s16x4 vtr(lds_cptr p){ return __builtin_bit_cast(s16x4,__builtin_amdgcn_ds_read_tr16_b64_v4i16((__attribute__((address_space(3))) v4i16_t*)p)); }
__device__ __forceinline__ float rowmax(const f32x16&p0,const f32x16&p1){
  float a=max3f(p0[0],p0[1],p1[0]),b=max3f(p0[2],p0[3],p1[1]);a=max3f(a,p1[2],p1[3]);
  #pragma unroll
  for(int r=4;r<16;r+=4){a=max3f(a,p0[r],p0[r+1]);b=max3f(b,p0[r+2],p0[r+3]);a=max3f(a,p1[r],p1[r+1]);b=max3f(b,p1[r+2],p1[r+3]);}
  const float m=max2f(a,b);
  auto rr=__builtin_amdgcn_permlane32_swap(__float_as_uint(m),__float_as_uint(m),false,false);
  return max2f(__uint_as_float(rr[0]),__uint_as_float(rr[1]));
}
__device__ __forceinline__ void pv(f32x16*o,int vb,bf16x8 pa0,bf16x8 pa1,bf16x8 pa2,bf16x8 pa3){
  #pragma unroll
  for(int d0=0;d0<2;++d0){s16x4 lo[4],hi[4];
    #pragma unroll
    for(int ks=0;ks<4;++ks){
      asm volatile("ds_read_b64_tr_b16 %0,%1 offset:%c2":"=&v"(lo[ks]):"v"(vb),"i"(d0*4096+ks*1024):"memory");
      asm volatile("ds_read_b64_tr_b16 %0,%1 offset:%c2":"=&v"(hi[ks]):"v"(vb),"i"(d0*4096+ks*1024+512):"memory");}
    asm volatile("s_waitcnt lgkmcnt(0)":::"memory");SBAR();
    #define PK(k) (bf16x8){lo[k][0],lo[k][1],lo[k][2],lo[k][3],hi[k][0],hi[k][1],hi[k][2],hi[k][3]}
    o[d0]=__builtin_amdgcn_mfma_f32_32x32x16_bf16(pa0,PK(0),o[d0],0,0,0);
    o[d0]=__builtin_amdgcn_mfma_f32_32x32x16_bf16(pa1,PK(1),o[d0],0,0,0);
    o[d0]=__builtin_amdgcn_mfma_f32_32x32x16_bf16(pa2,PK(2),o[d0],0,0,0);
    o[d0]=__builtin_amdgcn_mfma_f32_32x32x16_bf16(pa3,PK(3),o[d0],0,0,0);
    #undef PK
  }
}

template<int THRL> __device__ __forceinline__ void attn_unit(char*shm,const int KIND,const hb16*Qc,int qrow,int oslot,const hb16*__restrict__ Kt0,const hb16*__restrict__ Vt0,const hb16*__restrict__ KXt0,int NT,int band0,hb16*Oc,hb16*PO,float*PML){
  const int tid=threadIdx.x,lane=tid&63,r32=lane&31,hi=lane>>5; const int wid=__builtin_amdgcn_readfirstlane(tid>>6);
  const unsigned lds0=(unsigned)(uintptr_t)shm;
  float*wsf=(float*)(shm+LDS_WS)+wid*64;
  const hb16*ksrc=Kt0+(long)lane*PITCH+wid*8;
  const hb16*vsrc=Vt0+(long)(16*(wid&3)+(lane>>2))*PITCH+(wid>>2)*32+(lane&3)*8;
  const hb16*xsrc=KXt0+(long)(8*wid+(lane&7))*8;
  const unsigned kdst=lds0+LDS_K+wid*1024, vdst=lds0+LDS_V+wid*1024, xdst=lds0+LDS_K+8192+wid*128;
  #define DMA_K(t,slot) do{ glds16(ksrc+(long)(t)*KVBLK*PITCH,(unsigned)__builtin_amdgcn_readfirstlane(kdst+(slot))); glds16x(xsrc+(long)(t)*KVBLK*8,(unsigned)__builtin_amdgcn_readfirstlane(xdst+(slot))); }while(0)
  #define DMA_V(t,slot) glds16(vsrc+(long)(t)*KVBLK*PITCH,(unsigned)__builtin_amdgcn_readfirstlane(vdst+(slot)))
  const int vb0=(int)(lds0+LDS_V)+((lane>>4)&1)*32+(lane&3)*8+(4*hi+((lane&15)>>2))*64;
  const char*Kbase=shm+LDS_K; bf16x8 kf[10];
  const lds_cptr shm3=(lds_cptr)shm; const lds_cptr kp0=shm3+LDS_K+hi*1024+r32*16; const lds_cptr kx0=shm3+LDS_K+8192+r32*16; const lds_cptr vp0=shm3+LDS_V+((lane>>4)&1)*32+(lane&3)*8+(4*hi+((lane&15)>>2))*64;
  DMA_K(0,0);DMA_V(0,0);DMA_K(1,SLOTB);
  bf16x8 qr[5];
  { const hb16*Qw=Qc+(long)qrow*PITCH;
    #pragma unroll
    for(int d0=0;d0<4;++d0)qr[d0]=*reinterpret_cast<const bf16x8*>(&Qw[d0*16+hi*8]); }
  float mhat=0.f,l_reg=0.f;f32x16 o[2];o[0]=f32x16{};o[1]=f32x16{};
  #define SETQX(mh_,ml_) do{ const unsigned bh_=cvtpk_s(-(mh_),-(ml_)); u32x4 qx_; qx_.x=0x3F803F80u; qx_.y=0x3F80u|(bh_<<16); qx_.z=(bh_>>16); qx_.w=0u; if(hi){qx_.x=0u;qx_.y=0u;qx_.z=0u;} qr[4]=__builtin_bit_cast(bf16x8,qx_); asm volatile("":"+v"(qr[4])); }while(0)
  #define MOVEREF(gain) const float mraw_=mhat+(gain); const float mh_=rbf(mraw_); const float ml_=rbf(mraw_-mh_); const float mnew_=mh_+ml_; const float dl=mnew_-mhat; mhat=mnew_; SETQX(mh_,ml_);
  SETQX(0.f,0.f);
  const int qrel=wid*QBLK+r32;
  #define CMASK(P0,P1,t) do{int jb_=(t)-band0; if(jb_>=0)cmask(P0,P1,jb_,qrel,hi);}while(0)
  bool resc=false;
  #define START(P0,P1) do{ const float rm=rowmax(P0,P1); resc=false; \
    { MOVEREF(rm) \
      _Pragma("unroll") for(int r=0;r<16;++r){P0[r]=fsub_s(P0[r],dl);P1[r]=fsub_s(P1[r],dl);} } \
    _Pragma("unroll") for(int r=0;r<16;++r)P0[r]=__builtin_amdgcn_exp2f(P0[r]); }while(0)
  #define RESC() do{ if(resc){ asm volatile("s_waitcnt lgkmcnt(0)":::"memory"); \
      _Pragma("unroll") for(int d_=0;d_<2;++d_) _Pragma("unroll") for(int r=0;r<16;++r)o[d_][r]*=wsf[crow(r,hi)]; } }while(0)
  f32x16 pA0,pA1,pB0,pB1;
  int sl_prev=0,sl_cur=0,sl_next=SLOTB;
  #define ROT() do{sl_prev=sl_cur;sl_cur=sl_next;sl_next=(sl_next==(NSLOT-1)*SLOTB)?0:sl_next+SLOTB;}while(0)
  DMA_K(2,2*SLOTB);
  WAIT_BAR(5);
  qkt(pA0,pA1,Kbase,qr,r32,hi);asm volatile("s_nop 15\n\ts_nop 7":"+v"(pA0),"+v"(pA1));CMASK(pA0,pA1,0);
  START(pA0,pA1);
  _Pragma("unroll") for(int r=0;r<16;++r)pA1[r]=__builtin_amdgcn_exp2f(pA1[r]);
  WAIT_BAR(0);
  DMA_K(3,0);DMA_V(1,SLOTB);
  ROT();
  kload10(kf,kp0+sl_cur,kx0+sl_cur);
  WAIT_BAR(3);
  s16x4 vlo[8],vhi[8]; u32x4 pw0,pw1,pw2,pw3; const f32x16 zf={};
  #define PKW(P,B) cvtpk_s(P[B],P[B+1])
  #define PAF(k) __builtin_bit_cast(bf16x8,pw##k)
  #define VFR(i) (bf16x8){vlo[i][0],vlo[i][1],vlo[i][2],vlo[i][3],vhi[i][0],vhi[i][1],vhi[i][2],vhi[i][3]}
  #define PIN(x) asm volatile("":"+v"(x))
  #define MX3(a,b,c) __builtin_fmaxf(__builtin_fmaxf((a),(b)),(c))
  #define GAPA(MF,A0,A1,A2,A3,W0,W1,PW) do{ MF; sacc+=A0; sacc+=A1; sacc+=A2; sacc+=A3; PIN(sacc); W0; W1; PIN(PW); SBAR(); }while(0)
  #define EX(v) __builtin_amdgcn_exp2f(v)
  #define GAPB(MF,X,B) do{ MF; X[B]=EX(X[B]); X[B+1]=EX(X[B+1]); X[B+2]=EX(X[B+2]); X[B+3]=EX(X[B+3]); PIN(X); SBAR(); }while(0)
  #define VRD(i) do{ vlo[i]=vtr(vp_+(((i)>>2)*4096+((i)&3)*1024)); vhi[i]=vtr(vp_+(((i)>>2)*4096+((i)&3)*1024+512)); }while(0)
  #define KRD(G,j) do{ if(G){ kload2(kf,kp0+sl_next,j); SBAR(); } }while(0)
  #define KRDX(G) do{ if(G){ kf[8]=*(const __attribute__((address_space(3))) bf16x8*)(kx0+sl_next); kf[9]=*(const __attribute__((address_space(3))) bf16x8*)(kx0+sl_next+512); SBAR(); } }while(0)
  #define STEP(C0,C1,P0,P1,t,GK,GV,GL) do{ SBAR(); \
    const lds_cptr vp_=vp0+sl_prev; \
    VRD(0); SBAR(); float sacc=(P0[0]+P0[1]); \
    GAPA(C0=__builtin_amdgcn_mfma_f32_32x32x16_bf16(kf[0],qr[0],zf,0,0,0), P0[2],P0[3],P0[4],P0[5],     pw0[0]=PKW(P0,0), pw0[1]=PKW(P0,2), pw0); \
    VRD(4); SBAR(); GAPA(C1=__builtin_amdgcn_mfma_f32_32x32x16_bf16(kf[1],qr[0],zf,0,0,0), P0[6],P0[7],P0[8],P0[9],     pw0[2]=PKW(P0,4), pw0[3]=PKW(P0,6), pw0); \
    VRD(1); SBAR(); GAPA(C0=__builtin_amdgcn_mfma_f32_32x32x16_bf16(kf[2],qr[1],C0,0,0,0),   P0[10],P0[11],P0[12],P0[13], pw1[0]=PKW(P0,8), pw1[1]=PKW(P0,10), pw1); \
    VRD(5); SBAR(); GAPA(C1=__builtin_amdgcn_mfma_f32_32x32x16_bf16(kf[3],qr[1],C1,0,0,0),   P0[14],P0[15],P1[0],P1[1],   pw1[2]=PKW(P0,12),pw1[3]=PKW(P0,14), pw1); \
    VRD(2); SBAR(); GAPA(C0=__builtin_amdgcn_mfma_f32_32x32x16_bf16(kf[4],qr[2],C0,0,0,0),   P1[2],P1[3],P1[4],P1[5],     pw2[0]=PKW(P1,0), pw2[1]=PKW(P1,2), pw2); \
    VRD(6); SBAR(); GAPA(C1=__builtin_amdgcn_mfma_f32_32x32x16_bf16(kf[5],qr[2],C1,0,0,0),   P1[6],P1[7],P1[8],P1[9],     pw2[2]=PKW(P1,4), pw2[3]=PKW(P1,6), pw2); \
    VRD(3); SBAR(); GAPA(C0=__builtin_amdgcn_mfma_f32_32x32x16_bf16(kf[6],qr[3],C0,0,0,0),   P1[10],P1[11],P1[12],P1[13], pw3[0]=PKW(P1,8), pw3[1]=PKW(P1,10), pw3); \
    VRD(7); SBAR(); GAPA(C1=__builtin_amdgcn_mfma_f32_32x32x16_bf16(kf[7],qr[3],C1,0,0,0),   P1[14],P1[15],0.f,0.f,       pw3[2]=PKW(P1,12),pw3[3]=PKW(P1,14), pw3); \
    C0=__builtin_amdgcn_mfma_f32_32x32x16_bf16(kf[8],qr[4],C0,0,0,0); SBAR(); \
    C1=__builtin_amdgcn_mfma_f32_32x32x16_bf16(kf[9],qr[4],C1,0,0,0); SBAR(); \
    l_reg+=sacc; \
    if(GK){DMA_K((t)+3,sl_cur);} if(GV){DMA_V((t)+1,sl_next);} \
    CMASK(C0,C1,t); \
    { float a=MX3(C0[0],C0[1],C1[0]),b=MX3(C0[2],C0[3],C1[1]); a=MX3(a,C1[2],C1[3]); \
      _Pragma("unroll") for(int r=4;r<16;r+=4){a=MX3(a,C0[r],C0[r+1]);b=MX3(b,C0[r+2],C0[r+3]);a=MX3(a,C1[r],C1[r+1]);b=MX3(b,C1[r+2],C1[r+3]);} \
      float rm=__builtin_fmaxf(a,b); { auto rr=__builtin_amdgcn_permlane32_swap(__float_as_uint(rm),__float_as_uint(rm),false,false); rm=__builtin_fmaxf(__uint_as_float(rr[0]),__uint_as_float(rr[1])); } \
      resc=false; \
      if(__builtin_expect(__any(rm>(float)THRL),0)){ MOVEREF(__builtin_fmaxf(rm,0.f)) \
        _Pragma("unroll") for(int r=0;r<16;++r){C0[r]-=dl;C1[r]-=dl;} \
        const float f=__builtin_amdgcn_exp2f(-dl); l_reg*=f; if(hi==0)wsf[r32]=f; resc=true; } } \
    SBAR(); \
    GAPB(o[0]=__builtin_amdgcn_mfma_f32_32x32x16_bf16(PAF(0),VFR(0),o[0],0,0,0), C0,0); \
    GAPB(o[1]=__builtin_amdgcn_mfma_f32_32x32x16_bf16(PAF(0),VFR(4),o[1],0,0,0), C0,4); \
    KRD(GL,0); GAPB(o[0]=__builtin_amdgcn_mfma_f32_32x32x16_bf16(PAF(1),VFR(1),o[0],0,0,0), C0,8); \
    KRD(GL,1); GAPB(o[1]=__builtin_amdgcn_mfma_f32_32x32x16_bf16(PAF(1),VFR(5),o[1],0,0,0), C0,12); \
    KRD(GL,2); GAPB(o[0]=__builtin_amdgcn_mfma_f32_32x32x16_bf16(PAF(2),VFR(2),o[0],0,0,0), C1,0); \
    KRD(GL,3); GAPB(o[1]=__builtin_amdgcn_mfma_f32_32x32x16_bf16(PAF(2),VFR(6),o[1],0,0,0), C1,4); \
    KRDX(GL); GAPB(o[0]=__builtin_amdgcn_mfma_f32_32x32x16_bf16(PAF(3),VFR(3),o[0],0,0,0), C1,8); \
    GAPB(o[1]=__builtin_amdgcn_mfma_f32_32x32x16_bf16(PAF(3),VFR(7),o[1],0,0,0), C1,12); \
    }while(0)
  int t=1;
  for(;t+5<NT&&t+1<band0;t+=2){
    #undef CMASK
    #define CMASK(P0,P1,t) do{}while(0)
    STEP(pB0,pB1,pA0,pA1,t,true,true,true);     WAIT_BAR(3); RESC(); ROT();
    STEP(pA0,pA1,pB0,pB1,t+1,true,true,true);   WAIT_BAR(3); RESC(); ROT();
  }
  #undef CMASK
  #define CMASK(P0,P1,t) do{int jb_=(t)-band0; if(jb_>=0)cmask(P0,P1,jb_,qrel,hi);}while(0)
  #define ENDW(tt) do{ if((tt)+3<NT){WAIT_BAR(3);} else if((tt)+2<NT){WAIT_BAR(1);} else {WAIT_BAR(0);} }while(0)
  for(;t+1<NT;t+=2){
    STEP(pB0,pB1,pA0,pA1,t,(t+3<NT),(t+1<NT),(t+1<NT));       ENDW(t);   RESC(); ROT();
    STEP(pA0,pA1,pB0,pB1,t+1,(t+4<NT),(t+2<NT),(t+2<NT));     ENDW(t+1); RESC(); ROT();
  }
  STEP(pB0,pB1,pA0,pA1,NT-1,false,false,false); RESC();
  { float sacc=pB0[0]+pB0[1]; _Pragma("unroll") for(int r=2;r<16;++r)sacc+=pB0[r]; _Pragma("unroll") for(int r=0;r<16;++r)sacc+=pB1[r]; l_reg+=sacc;
    pw0=(u32x4){PKW(pB0,0),PKW(pB0,2),PKW(pB0,4),PKW(pB0,6)};pw1=(u32x4){PKW(pB0,8),PKW(pB0,10),PKW(pB0,12),PKW(pB0,14)};pw2=(u32x4){PKW(pB1,0),PKW(pB1,2),PKW(pB1,4),PKW(pB1,6)};pw3=(u32x4){PKW(pB1,8),PKW(pB1,10),PKW(pB1,12),PKW(pB1,14)};
    SBAR(); pv(o,vb0+sl_cur,PAF(0),PAF(1),PAF(2),PAF(3)); }
  #undef PKW
  #undef PAF
  #undef VFR
  #undef PIN
  #undef MX3
  #undef GAPA
  #undef GAPB
  #undef EX
  #undef VRD
  #undef KRD
  #undef KRDX
  #undef STEP
  #undef ENDW
  {auto rr=__builtin_amdgcn_permlane32_swap(__float_as_uint(l_reg),__float_as_uint(l_reg),false,false);l_reg=__uint_as_float(rr[0])+__uint_as_float(rr[1]);}
  if(hi==0)wsf[32+r32]=l_reg;asm volatile("s_waitcnt lgkmcnt(0)":::"memory");
  float rli[16];
  #pragma unroll
  for(int r=0;r<16;++r)rli[r]=__builtin_amdgcn_rcpf(wsf[32+crow(r,hi)]);
  if(KIND==1){ if(hi==0&&oslot>=0){ f32x2_t ml={mhat,l_reg}; *(f32x2_t*)(PML+(long)oslot*2)=ml; } }
  { hb16*stg=(hb16*)(shm+LDS_OST)+wid*2048;
    #pragma unroll
    for(int r=0;r<16;++r){const int orow=crow(r,hi);
      #pragma unroll
      for(int d0=0;d0<2;++d0)stg[orow*64+d0*32+r32]=__float2bfloat16(o[d0][r]*rli[r]);}
    asm volatile("s_waitcnt lgkmcnt(0)":::"memory");
    #pragma unroll
    for(int i=0;i<4;++i){const int row=i*8+(lane>>3),ch=lane&7; const u32x4 v=*(const u32x4*)(stg+row*64+ch*8);
      if(KIND==0){ const int gr=__shfl(qrow,row); *(u32x4*)(Oc+(long)gr*PITCH+ch*8)=v; }
      else { const int gs=__shfl(oslot,row); if(gs>=0) *(u32x4*)(PO+(long)gs*64+ch*8)=v; } } }
  asm volatile("s_waitcnt lgkmcnt(0)\n\ts_barrier":::"memory");
  #undef DMA_K
  #undef DMA_V
  #undef CMASK
  #undef START
  #undef RESC
  #undef ROT
  #undef SETQX
  #undef MOVEREF
}
constexpr int MB_K=0, MB_V=4*SLOTB, MB_WS=MB_V+4*8192, MB_OST=MB_WS+NW*64*4, MB_BYTES=MB_OST+NW*4096;
template<int THRL> __device__ __forceinline__ void moba_item(char*shm,const hb16*Qc,const int browbase,const int h,const int nblk,const unsigned*lst,const int cnt,const int g0,const int g1,
    const hb16*Kt0,const hb16*KXt0,hb16*PO,float*PML){
  const int tid=threadIdx.x,lane=tid&63,r32=lane&31,hi=lane>>5; const int wid=__builtin_amdgcn_readfirstlane(tid>>6);
  const unsigned lds0=(unsigned)(uintptr_t)shm;
  float*wsf=(float*)(shm+MB_WS)+wid*64;
  asm volatile("s_waitcnt lgkmcnt(0)\n\ts_barrier":::"memory");
  { const hb16*ksrc=Kt0+(long)lane*PITCH+wid*8; const hb16*vsrc=Kt0+512+(long)(16*(wid&3)+(lane>>2))*PITCH+(wid>>2)*32+(lane&3)*8; const hb16*xsrc=KXt0+(long)(8*wid+(lane&7))*8;
    #pragma unroll
    for(int t=0;t<4;++t){ glds16(ksrc+(long)t*KVBLK*PITCH,(unsigned)__builtin_amdgcn_readfirstlane(lds0+MB_K+t*SLOTB+wid*1024)); glds16x(xsrc+(long)t*KVBLK*8,(unsigned)__builtin_amdgcn_readfirstlane(lds0+MB_K+t*SLOTB+8192+wid*128));
      glds16(vsrc+(long)t*KVBLK*PITCH,(unsigned)__builtin_amdgcn_readfirstlane(lds0+MB_V+t*8192+wid*1024)); } }
  asm volatile("s_waitcnt vmcnt(0)\n\ts_barrier":::"memory");
  const int vb0=(int)(lds0+MB_V)+((lane>>4)&1)*32+(lane&3)*8+(4*hi+((lane&15)>>2))*64;
  #define SETQX(mh_,ml_) do{ const unsigned bh_=cvtpk_s(-(mh_),-(ml_)); u32x4 qx_; qx_.x=0x3F803F80u; qx_.y=0x3F80u|(bh_<<16); qx_.z=(bh_>>16); qx_.w=0u; if(hi){qx_.x=0u;qx_.y=0u;qx_.z=0u;} qr[4]=__builtin_bit_cast(bf16x8,qx_); asm volatile("":"+v"(qr[4])); }while(0)
  #define MOVEREF(gain) const float mraw_=mhat+(gain); const float mh_=rbf(mraw_); const float ml_=rbf(mraw_-mh_); const float mnew_=mh_+ml_; const float dl=mnew_-mhat; mhat=mnew_; SETQX(mh_,ml_);
  #define LENT(gg) (((gg)>=8&&(gg)<g1)?lst[((gg)-8)*32+r32]:0u)
  #define GROW(gg,ee) (((gg)<8)?(browbase+nblk*256+(gg)*32+r32):(browbase+(int)((ee)&0x1fffu)))
  unsigned e_cur=LENT(g0+wid), e_nxt=LENT(g0+wid+NW);
  bf16x8 qn[4];
  { const hb16*Qw=Qc+(long)GROW(g0+wid,e_cur)*PITCH;
    #pragma unroll
    for(int d0=0;d0<4;++d0)qn[d0]=*reinterpret_cast<const bf16x8*>(&Qw[d0*16+hi*8]); }
  for(int g=g0+wid;g<g1;g+=NW){
    const bool own=g<8; const int qrow=GROW(g,e_cur); int oslot;
    if(own) oslot=(qrow*8+h)*4+3; else oslot=((g-8)*32+r32<cnt)?(qrow*8+h)*4+(int)((e_cur>>16)&3u):-1;
    bf16x8 qr[5];
    #pragma unroll
    for(int d0=0;d0<4;++d0)qr[d0]=qn[d0];
    { const int gn=(g+NW<g1)?g+NW:g; const unsigned en=(g+NW<g1)?e_nxt:e_cur; const hb16*Qw=Qc+(long)GROW(gn,en)*PITCH;
      #pragma unroll
      for(int d0=0;d0<4;++d0)qn[d0]=*reinterpret_cast<const bf16x8*>(&Qw[d0*16+hi*8]); }
    const unsigned e_n2=LENT(g+2*NW); e_cur=e_nxt; e_nxt=e_n2;
    float mhat=0.f,l_reg=0.f;f32x16 o[2];o[0]=f32x16{};o[1]=f32x16{};
    SETQX(0.f,0.f);
    const int tlast=own?((32*g+31)>>6):3;
    #define PKW(P,B) cvtpk_s(P[B],P[B+1])
    #define PROC(P0,P1,T_,ISFIRST,MREF_) do{ \
      if(own)cmask(P0,P1,(T_),32*g+r32,hi); \
      const float adj_=mhat-(MREF_); const float rm=rowmax(P0,P1)-adj_; float sub_=adj_; \
      if(ISFIRST){ MOVEREF(rm) sub_+=dl; } \
      else if(__any(rm>(float)THRL)){ MOVEREF(__builtin_fmaxf(rm,0.f)) sub_+=dl; \
        const float f=__builtin_amdgcn_exp2f(-dl); l_reg*=f; if(hi==0)wsf[r32]=f; asm volatile("s_waitcnt lgkmcnt(0)":::"memory"); \
        _Pragma("unroll") for(int d_=0;d_<2;++d_) _Pragma("unroll") for(int r=0;r<16;++r)o[d_][r]*=wsf[crow(r,hi)]; } \
      float sacc=0.f; \
      _Pragma("unroll") for(int r=0;r<16;++r){P0[r]=__builtin_amdgcn_exp2f(P0[r]-sub_);P1[r]=__builtin_amdgcn_exp2f(P1[r]-sub_);sacc+=P0[r]+P1[r];} \
      l_reg+=sacc; \
      const u32x4 pw0=(u32x4){PKW(P0,0),PKW(P0,2),PKW(P0,4),PKW(P0,6)},pw1=(u32x4){PKW(P0,8),PKW(P0,10),PKW(P0,12),PKW(P0,14)},pw2=(u32x4){PKW(P1,0),PKW(P1,2),PKW(P1,4),PKW(P1,6)},pw3=(u32x4){PKW(P1,8),PKW(P1,10),PKW(P1,12),PKW(P1,14)}; \
      pv(o,vb0+(T_)*8192,__builtin_bit_cast(bf16x8,pw0),__builtin_bit_cast(bf16x8,pw1),__builtin_bit_cast(bf16x8,pw2),__builtin_bit_cast(bf16x8,pw3)); }while(0)
    int t=0;
    for(;t+1<=tlast;t+=2){
      f32x16 a0,a1,b0,b1; const float mref=mhat;
      qkt(a0,a1,shm+MB_K+t*SLOTB,qr,r32,hi); qkt(b0,b1,shm+MB_K+(t+1)*SLOTB,qr,r32,hi);
      asm volatile("s_nop 15\n\ts_nop 7":"+v"(a0),"+v"(a1));
      PROC(a0,a1,t,t==0,mref);
      asm volatile("s_nop 7":"+v"(b0),"+v"(b1));
      PROC(b0,b1,t+1,false,mref);
    }
    if(t<=tlast){ f32x16 a0,a1; const float mref=mhat;
      qkt(a0,a1,shm+MB_K+t*SLOTB,qr,r32,hi); asm volatile("s_nop 15\n\ts_nop 7":"+v"(a0),"+v"(a1));
      PROC(a0,a1,t,t==0,mref); }
    #undef PROC
    #undef PKW
    {auto rr=__builtin_amdgcn_permlane32_swap(__float_as_uint(l_reg),__float_as_uint(l_reg),false,false);l_reg=__uint_as_float(rr[0])+__uint_as_float(rr[1]);}
    if(hi==0)wsf[32+r32]=l_reg;asm volatile("s_waitcnt lgkmcnt(0)":::"memory");
    float rli[16];
    #pragma unroll
    for(int r=0;r<16;++r)rli[r]=__builtin_amdgcn_rcpf(wsf[32+crow(r,hi)]);
    if(hi==0&&oslot>=0){ f32x2_t ml={mhat,l_reg}; *(f32x2_t*)(PML+(long)oslot*2)=ml; }
    { hb16*stg=(hb16*)(shm+MB_OST)+wid*2048;
      #pragma unroll
      for(int r=0;r<16;++r){const int orow=crow(r,hi);
        #pragma unroll
        for(int d0=0;d0<2;++d0)stg[orow*64+d0*32+r32]=__float2bfloat16(o[d0][r]*rli[r]);}
      asm volatile("s_waitcnt lgkmcnt(0)":::"memory");
      #pragma unroll
      for(int i=0;i<4;++i){const int row=i*8+(lane>>3),ch=lane&7; const u32x4 v=*(const u32x4*)(stg+row*64+ch*8);
        const int gs=__shfl(oslot,row); if(gs>=0) *(u32x4*)(PO+(long)gs*64+ch*8)=v; }
      asm volatile("s_waitcnt lgkmcnt(0)":::"memory"); }
  }
  #undef SETQX
  #undef MOVEREF
  #undef LENT
  #undef GROW
}
constexpr int ATTN_LDS_BYTES=(LDS_BYTES>MB_BYTES?LDS_BYTES:MB_BYTES);
#undef SBAR
#undef WAIT_BAR
}

struct WqkOrder {
    int G, c;
    __device__ __forceinline__ bool next(int i, pg8::Unit& u) const { const int L = i * G + c; if (L >= 128) return false; const int z = L >> 2, pn = L & 3, b = z >> 2, h = z & 3;
        u.pm = b * 4 + h; u.pn = pn; u.aoff = ((size_t)(b * 256) * 2048 + h * 256) * 2; u.boff = ((size_t)(pn * 256) * 1024 + h * 256) * 2; return true; }
};
struct VwoOrder {
    int G, c;
    __device__ __forceinline__ bool next(int i, pg8::Unit& u) const { const int L = i * G + c; if (L >= 128) return false; const int z = L >> 2, pmq = L & 3, b = z >> 2, h = z & 3;
        u.pm = b * 4 + pmq; u.pn = h; u.aoff = ((size_t)(pmq * 256) * 1024 + h * 256) * 2; u.boff = ((size_t)(b * 256) * 2048 + 1024 + h * 256) * 2; return true; }
};

#define DECL_PTRS const __attribute__((address_space(4))) Args* KA_; { auto p_ = __builtin_amdgcn_kernarg_segment_ptr(); asm volatile("" : "+s"(p_)); KA_ = (const __attribute__((address_space(4))) Args*)p_; } \
    int tidp_ = threadIdx.x; asm volatile("" : "+v"(tidp_)); const int tid = tidp_, lane = tid & 63; (void)lane; \
    unsigned char* ws = KA_->ws; gu32* ctl = (gu32*)(ws + WS_CTL); const float* x = KA_->in[0]; const float* mem = KA_->in[1]; const float* g_mix = KA_->in[2]; const float* w_in = KA_->in[3]; const float* b_forget = KA_->in[4]; const float* g_fox = KA_->in[5]; const float* g_moba = KA_->in[6]; const float* w_out = KA_->in[7]; const float* g_cross = KA_->in[8]; const float* g_mem = KA_->in[9]; const float* w_q_mem = KA_->in[10]; const float* w_kv_mem = KA_->in[11]; const float* w_o_mem = KA_->in[12]; const float* g_ffn = KA_->in[13]; const float* w_up = KA_->in[14]; const float* conv_w = KA_->in[15]; const float* conv_b = KA_->in[16]; const float* w_down = KA_->in[17]; const float* g_final = KA_->in[18]; float* out = KA_->out; float* LOGF = (float*)(ws + WS_LOGF); float* CC = (float*)(ws + WS_C); float* ABAR = (float*)(ws + WS_ABAR); float* KM = (float*)(ws + WS_KM); unsigned* SEL = (unsigned*)(ws + WS_SEL); float* SSQ1 = (float*)(ws + WS_SSQ1); float* SSQ2 = (float*)(ws + WS_SSQ2); float* SSQ3 = (float*)(ws + WS_SSQ3); bf16* MEMN = (bf16*)(ws + WS_MEMN); bf16* KV = (bf16*)(ws + WS_KV); bf16* WQS = (bf16*)(ws + WS_WQS); bf16* WOT = (bf16*)(ws + WS_WOT); bf16* WKVT = (bf16*)(ws + WS_WKVT); bf16* WINT = (bf16*)(ws + WS_WINT); bf16* WOUTT = (bf16*)(ws + WS_WOUTT); bf16* WUPT = (bf16*)(ws + WS_WUPT); unsigned char* WDT = ws + WS_WDT; unsigned char* ACT8 = ws + WS_ACT8; float* GHB = (float*)(ws + WS_GH); float* UHB = (float*)(ws + WS_UH); float* GTB = (float*)(ws + WS_GT); bf16* ZT = (bf16*)(ws + WS_ZT); bf16* WQK = (bf16*)(ws + WS_WQK); bf16* VWO = (bf16*)(ws + WS_VWO); bf16* A1 = (bf16*)(ws + WS_A1); bf16* QKV = (bf16*)(ws + WS_QKV); bf16* Y = (bf16*)(ws + WS_Y); bf16* HB1 = (bf16*)(ws + WS_HB1); bf16* PB = (bf16*)(ws + WS_P); bf16* HB2 = (bf16*)(ws + WS_HB2); bf16* GB = (bf16*)(ws + WS_G); bf16* UB = (bf16*)(ws + WS_U); bf16* PO = (bf16*)(ws + WS_PO); unsigned* LIST = (unsigned*)(ws + WS_LIST); float* PML = (float*)(ws + WS_PML); bf16* KXF = (bf16*)(ws + WS_KXF); bf16* KXM = (bf16*)(ws + WS_KXM); unsigned* CNT = (unsigned*)(ws + WS_CNT);
__global__ void __launch_bounds__(NWAVES * 64, 2) fwd(Args args) {
    extern __shared__ __attribute__((aligned(16))) unsigned char lds[];
    LAS unsigned char* L = (LAS unsigned char*)lds;
    LAS unsigned char* XL = L + XL_OFF;
    volatile LAS unsigned* MISC = (volatile LAS unsigned*)(L + MISC_OFF);
    const int tid = threadIdx.x, lane = tid & 63, wave = __builtin_amdgcn_readfirstlane(tid >> 6);
    const int G = gridDim.x, bx = blockIdx.x;
    const int gw = bx * NWAVES + wave, NGW = G * NWAVES;
    for (int u = tid; u < (LDS_BYTES - LDSCTL_OFF) / 4; u += NWAVES * 64) ((LAS unsigned*)(L + LDSCTL_OFF))[u] = 0u;
    __syncthreads();
    XcdBarrier bar; { DECL_PTRS; bar = xcd_barrier_post((unsigned*)(ctl + CW_BAR), MISC + 8); }

    { DECL_PTRS;
        LAS float* scr = (LAS float*)(L + RING_OFF + wave * 16384);
        constexpr int I_IN = (D / 32) * (NQKV / 64), I_OUT = (D / 32) * (D / 64), I_KV = (D / 32) * (2048 / 64), I_O = I_OUT, I_UP = (D / 32) * (2 * FF / 64), I_DN = (FF / 32) * (D / 64);
        constexpr int NITEMS = I_IN + I_OUT + I_KV + I_O + I_UP + I_DN;
        for (int it = gw; it < NITEMS; it += NGW) {
            int r = it;
            if (r < I_IN) { p0_transpose_item(w_in, INC, D, NQKV, WINT, nullptr, true, scr, r, lane); continue; } r -= I_IN;
            if (r < I_OUT) { p0_transpose_item(w_out, D, D, D, WOUTT, nullptr, false, scr, r, lane); continue; } r -= I_OUT;
            if (r < I_KV) { p0_transpose_item(w_kv_mem, 2048, D, 2048, WKVT, nullptr, false, scr, r, lane); continue; } r -= I_KV;
            if (r < I_O) { p0_transpose_item(w_o_mem, D, D, D, WOT, nullptr, false, scr, r, lane); continue; } r -= I_O;
            if (r < I_UP) { p0_transpose_item(w_up, 2 * FF, D, 2 * FF, WUPT, g_ffn, false, scr, r, lane, 0.f, true); continue; } r -= I_UP;
            p0_transpose_item(w_down, D, FF, D, (bf16*)WDT, nullptr, false, scr, r, lane, 64.0f);
        }
        for (int i = bx * 512 + tid; i < D * D / 4; i += G * 512) { const int kk = (i * 4) >> 10; const f32x4 v = *(const f32x4*)(w_q_mem + (size_t)i * 4) * (g_cross[kk] * (LOG2E / 16.0f));
            *(unsigned long long*)(WQS + (size_t)i * 4) = (unsigned long long)pk2(v[0], v[1]) | ((unsigned long long)pk2(v[2], v[3]) << 32); }
        for (int r = gw; r < NB * 256; r += NGW) { const GAS f32x4* xr = (const GAS f32x4*)(mem + (size_t)r * D) + lane; f32x4 v[4]; float s = 0.f;
#pragma unroll
            for (int j = 0; j < 4; ++j) { v[j] = xr[64 * j]; s += (v[j][0] * v[j][0] + v[j][1] * v[j][1]) + (v[j][2] * v[j][2] + v[j][3] * v[j][3]); }
            const float rs = __builtin_amdgcn_rsqf(wave_sum(s) * (1.f / D) + RMS_EPS);
            GAS unsigned long long* o8 = (GAS unsigned long long*)(MEMN + (size_t)r * D) + lane;
#pragma unroll
            for (int j = 0; j < 4; ++j) { const f32x4 gg = *((const f32x4*)g_mem + 64 * j + lane); const f32x4 a = v[j] * rs * gg; o8[64 * j] = (unsigned long long)pk2(a[0], a[1]) | ((unsigned long long)pk2(a[2], a[3]) << 32); } }
        __syncthreads();
        LAS float* part = (LAS float*)(L + RING_OFF + 32768);
        LAS float* wf = (LAS float*)(L + RING_OFF);
        for (int i = tid; i < 8 * 1024; i += 512) { const int h = i >> 10, kk = i & 1023; wf[i] = w_in[(size_t)kk * INC + C_F + h]; }
        __syncthreads();
        f32x4 gm[4];
#pragma unroll
        for (int j = 0; j < 4; ++j) gm[j] = *((const f32x4*)g_mix + 64 * j + lane);
        for (int blk = bx; blk < M / 256; blk += G) {
            f32x4 accm[4];
#pragma unroll
            for (int j = 0; j < 4; ++j) accm[j] = (f32x4){0.f, 0.f, 0.f, 0.f};
            f32x4 vn[2][4];
#pragma unroll
            for (int rr = 0; rr < 2; ++rr) { const GAS f32x4* xr = (const GAS f32x4*)(x + ((size_t)blk * 256 + wave * 32 + rr) * D) + lane;
#pragma unroll
                for (int j = 0; j < 4; ++j) vn[rr][j] = xr[64 * j]; }
            for (int i0 = 0; i0 < 32; i0 += 2) {
              f32x4 vv[2][4];
#pragma unroll
              for (int rr = 0; rr < 2; ++rr)
#pragma unroll
                  for (int j = 0; j < 4; ++j) vv[rr][j] = vn[rr][j];
              { const int inx = i0 + 2 < 32 ? i0 + 2 : i0;
#pragma unroll
                for (int rr = 0; rr < 2; ++rr) { const GAS f32x4* xr = (const GAS f32x4*)(x + ((size_t)blk * 256 + wave * 32 + inx + rr) * D) + lane;
#pragma unroll
                    for (int j = 0; j < 4; ++j) vn[rr][j] = xr[64 * j]; } }
#pragma unroll
              for (int rr = 0; rr < 2; ++rr) {
                const size_t r = (size_t)blk * 256 + wave * 32 + i0 + rr;
                f32x4 v[4]; float s = 0.f;
#pragma unroll
                for (int j = 0; j < 4; ++j) { v[j] = vv[rr][j]; s += (v[j][0] * v[j][0] + v[j][1] * v[j][1]) + (v[j][2] * v[j][2] + v[j][3] * v[j][3]); }
                const float rs = __builtin_amdgcn_rsqf(wave_sum(s) * (1.f / D) + RMS_EPS);
                GAS unsigned long long* o8 = (GAS unsigned long long*)(A1 + r * 2048) + lane;
                float fl[8];
#pragma unroll
                for (int h = 0; h < 8; ++h) fl[h] = 0.f;
#pragma unroll
                for (int j = 0; j < 4; ++j) { const f32x4 a = v[j] * rs * gm[j]; accm[j] += a;
                    const unsigned h0 = pk2(a[0], a[1]), h1 = pk2(a[2], a[3]);
                    o8[64 * j] = (unsigned long long)h0 | ((unsigned long long)h1 << 32);
                    const unsigned l0 = pk2(a[0] - bflo(h0), a[1] - bfhi(h0)), l1 = pk2(a[2] - bflo(h1), a[3] - bfhi(h1));
                    o8[256 + 64 * j] = (unsigned long long)l0 | ((unsigned long long)l1 << 32);
#pragma unroll
                    for (int h = 0; h < 8; ++h) { const f32x4 w = *((const LAS f32x4*)(wf + h * 1024) + 64 * j + lane); fl[h] += (a[0] * w[0] + a[1] * w[1]) + (a[2] * w[2] + a[3] * w[3]); } }
                float t4[4], t2[2], z;
                { const bool up = (lane & 32) != 0;
#pragma unroll
                  for (int k = 0; k < 4; ++k) { const float snd = up ? fl[k] : fl[k + 4]; const float rcv = __shfl_xor(snd, 32); t4[k] = (up ? fl[k + 4] : fl[k]) + rcv; } }
                { const bool up = (lane & 16) != 0;
#pragma unroll
                  for (int k = 0; k < 2; ++k) { const float snd = up ? t4[k] : t4[k + 2]; const float rcv = __shfl_xor(snd, 16); t2[k] = (up ? t4[k + 2] : t4[k]) + rcv; } }
                { const bool up = (lane & 8) != 0; const float snd = up ? t2[0] : t2[1]; const float rcv = __shfl_xor(snd, 8); z = (up ? t2[1] : t2[0]) + rcv; }
                z += __shfl_xor(z, 1); z += __shfl_xor(z, 2); z += __shfl_xor(z, 4);
                if ((lane & 7) == 0) { const int hh = 4 * (lane >> 5) + 2 * ((lane >> 4) & 1) + ((lane >> 3) & 1);
                    z += b_forget[hh];
                    LOGF[r * 8 + hh] = fminf(z, 0.f) - log1pf(__expf(-fabsf(z))); }
              }
            }
#pragma unroll
            for (int j = 0; j < 4; ++j) *((LAS f32x4*)(part + wave * 1024) + 64 * j + lane) = accm[j];
            __syncthreads();
            for (int col = tid; col < 1024; col += 512) { float s = 0.f;
#pragma unroll
                for (int w = 0; w < 8; ++w) s += part[w * 1024 + col];
                ABAR[(size_t)blk * 1024 + col] = s * (1.0f / 256.0f); }
            __syncthreads();
        }
    }
    xcd_barrier(bar);

#define WG_SIGNAL(word) do { asm volatile("s_waitcnt vmcnt(0)" ::: "memory"); __syncthreads(); if (tid == 0) { __builtin_amdgcn_fence(__ATOMIC_RELEASE, "agent"); asm volatile("s_waitcnt vmcnt(0)" ::: "memory"); \
        __hip_atomic_fetch_add((unsigned*)(ctl + (word)), 1u, RLX_AGENT); } } while (0)
#define WG_WAIT(word, n) do { if (tid == 0) { unsigned sp_ = 0u; while (__hip_atomic_load((unsigned*)(ctl + (word)), RLX_AGENT) < (unsigned)(n)) { __builtin_amdgcn_s_sleep(2); if (++sp_ > (1u << 22)) break; } } \
        __syncthreads(); __builtin_amdgcn_fence(__ATOMIC_ACQUIRE, "agent"); asm volatile("s_waitcnt vmcnt(0)" ::: "memory"); } while (0)
    { DECL_PTRS;
        LAS float* sc = (LAS float*)(L + RING_OFF);
        for (int w = bx; w < 64; w += G) {
            const int ib = w >> 3, jb = w & 7, r = tid >> 4, cq = tid & 15; LAS float* As = sc; LAS float* Bs = sc + 32 * 33;
            f32x4 acc = (f32x4){0.f, 0.f, 0.f, 0.f};
            for (int k0 = 0; k0 < 1024; k0 += 32) {
                { const int idx = tid * 2, row = idx >> 5, kk = idx & 31; const pg8::f32x2 a2 = *(const pg8::f32x2*)(ABAR + (size_t)(ib * 32 + row) * 1024 + k0 + kk); As[row * 33 + kk] = a2.x; As[row * 33 + kk + 1] = a2.y; }
                { const int idx = tid * 4, kk = idx >> 6, c = idx & 63; *(LAS f32x4*)(Bs + kk * 64 + c) = *(const f32x4*)(w_in + (size_t)(k0 + kk) * INC + C_KM + jb * 64 + c); }
                __syncthreads();
#pragma unroll 8
                for (int kk = 0; kk < 32; ++kk) acc += *(const LAS f32x4*)(Bs + kk * 64 + cq * 4) * As[r * 33 + kk];
                __syncthreads();
            }
            *(f32x4*)(KM + (size_t)(ib * 32 + r) * 512 + jb * 64 + cq * 4) = acc;
            WG_SIGNAL(CW_CNT_KM);
        }
        for (int w = (bx + G - 64) % G; w < 64; w += G) {
            const int b = w >> 3, h = w & 7; float v[16]; float run = 0.f;
#pragma unroll
            for (int i = 0; i < 16; ++i) { run += LOGF[((size_t)b * T + tid * 16 + i) * 8 + h]; v[i] = run; }
            float incl = run;
#pragma unroll
            for (int o = 1; o < 64; o <<= 1) { const float n = __shfl_up(incl, o); if (lane >= o) incl += n; }
            if (lane == 63) sc[wave] = incl;
            __syncthreads();
            float pre = incl - run;
            for (int ww = 0; ww < wave; ++ww) pre += sc[ww];
#pragma unroll
            for (int i = 0; i < 16; ++i) { const float cv = pre + v[i]; const size_t e = (size_t)w * T + tid * 16 + i; CC[e] = cv;
                const float bv = -cv * LOG2E; const unsigned h0 = f2bf(bv); const float r1 = bv - bf2f(h0); const unsigned h1 = f2bf(r1); const unsigned h2 = f2bf(r1 - bf2f(h1));
                *(v4u*)(KXF + e * 8) = (v4u){h0 | (h1 << 16), h2 | (0x3F80u << 16), 0x3F80u, 0u}; }
            if (w == 0) for (int j = tid; j < 8 * 256; j += 512) { const float bv = __builtin_amdgcn_exp2f(-(float)((j >> 8) + 1)) * LOG2E * (float)(j & 255);
                const unsigned h0 = f2bf(bv); const float r1 = bv - bf2f(h0); const unsigned h1 = f2bf(r1); const unsigned h2 = f2bf(r1 - bf2f(h1));
                *(v4u*)(KXM + (size_t)j * 8) = (v4u){h0 | (h1 << 16), h2 | (0x3F80u << 16), 0x3F80u, 0u}; }
            __syncthreads();
        }
        { const int ckv = (bx + G - 128) % G;
          pg8::Gemm g{MEMN, WKVT, D / 64, D * 2, D * 2, 0xffffffffu}; pg8::TileOrder S; S.init(NB * 256, 2048, G, ckv, D * 2, D * 2, 0, 1 << 30);
          pg8::EpiBf16 E{KV, 2048, 0u, 1.f, nullptr};
          pg8::gemm_phase<pg8::EpiBf16, pg8::TileOrder, true>(L + RING_OFF, XL, g, S, E);
          for (int Lk = ckv; Lk < 64; Lk += G) WG_SIGNAL(CW_CNT_KV); }
        if (bx < 64) WG_WAIT(CW_CNT_KM, 64);
        for (int w = bx; w < 64; w += G) {
            const int h = w >> 3, kq = w & 7, kk = kq * 128 + (tid & 127), ng = tid >> 7;
            for (int i = tid; i < 256 * 16; i += 512) { const int n = i >> 4, c4 = (i & 15) * 4; *(LAS f32x4*)(sc + n * 64 + c4) = *(const f32x4*)(KM + (size_t)n * 512 + h * 64 + c4); }
            f32x4 wq[16];
#pragma unroll
            for (int c = 0; c < 16; ++c) wq[c] = *(const f32x4*)(w_in + (size_t)kk * INC + C_QM + h * 64 + c * 4);
            __syncthreads();
            for (int i = 0; i < 64; ++i) { const int n = ng * 64 + i; const LAS f32x4* kp = (const LAS f32x4*)(sc + n * 64); float s0 = 0.f, s1 = 0.f;
#pragma unroll
                for (int c = 0; c < 16; c += 2) { const f32x4 ka = kp[c], kb = kp[c + 1];
                    s0 += (wq[c][0] * ka[0] + wq[c][1] * ka[1]) + (wq[c][2] * ka[2] + wq[c][3] * ka[3]); s1 += (wq[c + 1][0] * kb[0] + wq[c + 1][1] * kb[1]) + (wq[c + 1][2] * kb[2] + wq[c + 1][3] * kb[3]); }
                const float sv = s0 + s1; const unsigned hi = f2bf(sv); const unsigned lo = f2bf(sv - bf2f(hi));
                bf16* zr = ZT + ((size_t)(n >> 5) * 256 + h * 32 + (n & 31)) * 3072; zr[kk] = (bf16)hi; zr[1024 + kk] = (bf16)hi; zr[2048 + kk] = (bf16)lo; }
            WG_SIGNAL(CW_CNT_Z);
        }
        { const int ckv = (bx + G - 128) % G;
          if (ckv < 64) WG_WAIT(CW_CNT_KV, 64);
          const int gx = G < 64 ? G : 64, cx = ckv < 64 ? ckv : (1 << 20);
          { pg8::Gemm g{KV, WQS, 4, 4096, 2048, 0xffffffffu}; WqkOrder S{gx, cx}; pg8::EpiF8 E{(unsigned char*)WQK, 1024, 32.0f};
            pg8::gemm_phase<pg8::EpiF8, WqkOrder, true>(L + RING_OFF, XL, g, S, E); }
          { pg8::Gemm g{WOT, KV, 4, 2048, 4096, 0xffffffffu}; VwoOrder S{gx, cx}; pg8::EpiF8 E{(unsigned char*)VWO, 1024, 4.0f};
            pg8::gemm_phase<pg8::EpiF8, VwoOrder, true>(L + RING_OFF, XL, g, S, E); } }
        { pg8::Gemm g{A1, WINT, D / 64, 4096, D * 2, 0xffffffffu}; pg8::TileOrder S; S.init(M, NQKV, G, bx, 4096, D * 2, 0, 1 << 30); S.deal = (G == 256) ? 1 : 0;
          pg8::EpiBf16 E{QKV, NQKV, 0xC3u, C2, (unsigned*)(ctl + CW_QKN)};
          pg8::gemm_phase<pg8::EpiBf16, pg8::TileOrder, true>(L + RING_OFF, XL, g, S, E); }
        WG_WAIT(CW_CNT_Z, 64);
        { pg8::Gemm g{A1, ZT, 3072 / 64, 4096, 6144, 4095u}; pg8::TileOrder S; S.init(M, 256, G, bx, 4096, 6144, (size_t)256 * 6144, 32);
          pg8::EpiGate E{SEL};
          pg8::gemm_phase<pg8::EpiGate, pg8::TileOrder, true>(L + RING_OFF, XL, g, S, E); }
    }
#undef WG_SIGNAL
#undef WG_WAIT
    xcd_barrier(bar);

    { DECL_PTRS;
        for (int e = bx + wave * G; e < 2048; e += 8 * G) {
            const int bh = e >> 5, qb = e & 31, b = bh >> 3, h = bh & 7; float dmin = 3.0e38f, qmax = 0.f;
#pragma unroll 2
            for (int rr = 0; rr < 4; ++rr) { const bf16* qp = QKV + ((size_t)b * T + qb * 256 + rr * 64 + lane) * NQKV + h * 64; float dot = 0.f, qn2 = 0.f;
#pragma unroll
                for (int c = 0; c < 8; ++c) { const v4u qw = *((const v4u*)qp + c), kw = *((const v4u*)(qp + 512) + c); const unsigned qq[4] = {qw.x, qw.y, qw.z, qw.w}, kk2[4] = {kw.x, kw.y, kw.z, kw.w};
#pragma unroll
                    for (int x4 = 0; x4 < 4; ++x4) { const float q0 = bflo(qq[x4]), q1 = bfhi(qq[x4]); dot += q0 * bflo(kk2[x4]) + q1 * bfhi(kk2[x4]); qn2 += q0 * q0 + q1 * q1; } }
                dmin = fminf(dmin, dot); qmax = fmaxf(qmax, qn2); }
#pragma unroll
            for (int o = 1; o < 64; o <<= 1) { dmin = fminf(dmin, __shfl_xor(dmin, o)); qmax = fmaxf(qmax, __shfl_xor(qmax, o)); }
            const unsigned* kp = (const unsigned*)(ctl + CW_QKN) + bh * 8 + 2;
            const float kn = sqrtf(__uint_as_float(__hip_atomic_load(kp, RLX_AGENT)) + __uint_as_float(__hip_atomic_load(kp + 1, RLX_AGENT)));
            const float thr = (sqrtf(qmax) * kn * 1.02f - dmin + 40.5f) * (1.0f / LOG2E);
            const float* crow_ = CC + (size_t)bh * T; const int t0 = qb * 256; const float target = crow_[t0] + thr;
            int lo = 0, hi2 = t0;
            while (hi2 > lo) { const int step = (hi2 - lo + 63) >> 6, pos = lo + lane * step; const bool pr = pos < hi2 && crow_[pos] >= target; const int k = __popcll(__ballot(pr));
                if (k == 0) hi2 = lo;
                else { const int cand = lo + k * step; lo = lo + (k - 1) * step + 1; if (cand < hi2) hi2 = cand; } }
            if (lane == 0) ((int*)(ctl + CW_T0TAB))[e] = (lo >> 6) & ~1; }
        LAS unsigned* wc = (LAS unsigned*)(L + RING_OFF);
        for (int w = bx; w < 2048; w += G) {
            const int bh = (w & 255) >> 2, n = (w & 3) + 4 * (w >> 8), trip = bh * 32 + n; const unsigned* selrow = SEL + (size_t)bh * T; unsigned base = 0u;
            const float mthr = skip_thr((const unsigned*)(ctl + CW_QKN) + bh * 8, 1); const int hh = bh & 7;
            for (int t0 = (n + 1) * 256; t0 < T; t0 += 2048) {
                unsigned m[4], mo[4]; unsigned long long bal[4];
#pragma unroll
                for (int j = 0; j < 4; ++j) { const int t = t0 + j * 512 + tid; m[j] = 0u; if (t < T) m[j] = selrow[t]; mo[j] = m[j]; if (moba_skip(hh, t >> 8, n, mthr)) m[j] &= ~(1u << n); }
#pragma unroll
                for (int j = 0; j < 4; ++j) { bal[j] = __ballot((m[j] >> n) & 1u); if (lane == 0) wc[j * 8 + wave] = (unsigned)__popcll(bal[j]); }
                __syncthreads();
                unsigned run = base;
#pragma unroll
                for (int j = 0; j < 4; ++j) { unsigned pre = 0u, tot = 0u;
#pragma unroll
                    for (int ww = 0; ww < 8; ++ww) { const unsigned c = wc[j * 8 + ww]; tot += c; if (ww < wave) pre += c; }
                    if ((m[j] >> n) & 1u) { const unsigned pos = run + pre + (unsigned)__popcll(bal[j] & ((1ull << lane) - 1ull)); const unsigned k = (unsigned)__popc(mo[j] & ((1u << n) - 1u));
                        LIST[(size_t)trip * 8192 + pos] = (unsigned)(t0 + j * 512 + tid) | (k << 16); }
                    run += tot; }
                base = run;
                __syncthreads();
            }
            if (tid == 0) CNT[trip] = base;
        }
    }
    xcd_barrier(bar);

    { DECL_PTRS;
        LAS int* upre = (LAS int*)(L + RING_OFF + attn_body::ATTN_LDS_BYTES);
        LAS int* wsum = upre + 2052;
        { int c4[4]; int run = 0;
#pragma unroll
          for (int i = 0; i < 4; ++i) { c4[i] = run; run += (int)((8u + ((CNT[tid * 4 + i] + 31u) >> 5) + 31u) >> 5); }
          int incl = run;
#pragma unroll
          for (int o = 1; o < 64; o <<= 1) { const int nn = __shfl_up(incl, o); if (lane >= o) incl += nn; }
          if (lane == 63) wsum[wave] = incl;
          __syncthreads();
          int pre = incl - run;
          for (int ww = 0; ww < wave; ++ww) pre += wsum[ww];
#pragma unroll
          for (int i = 0; i < 4; ++i) upre[tid * 4 + i] = pre + c4[i];
          if (tid == 511) upre[2048] = pre + run;
          __syncthreads(); }
        const int ntot = 2048 + upre[2048];
        const attn_body::hb16* Qb = (const attn_body::hb16*)QKV;
        const int r32 = lane & 31;
        LAS unsigned* qnext = (LAS unsigned*)(wsum + 16);
        unsigned* qhead = (unsigned*)(ctl + CW_QUEUE);
        if (tid == 0) qnext[0] = atomicAdd(qhead, 1u);
        __syncthreads();
        for (;;) {
            const int u = (int)qnext[0];
            if (u >= ntot) break;
            __syncthreads();
            unsigned nxt_ = 0u; if (tid == 0) nxt_ = atomicAdd(qhead, 1u);
            if (u < 2048) {
                const int qb = 31 - (u >> 6), bh = u & 63;
                const int b = bh >> 3, h = bh & 7;
                const int T0 = ((const int*)(ctl + CW_T0TAB))[bh * 32 + qb];
                const int qrow = b * T + qb * 256 + wave * 32 + r32, NT = 4 * (qb + 1) - T0;
                const attn_body::hb16* Qc = Qb + h * 64; const attn_body::hb16* Kt0 = Qb + (size_t)(b * T + T0 * 64) * NQKV + 512 + h * 64;
                attn_body::attn_unit<8>((char*)lds + RING_OFF, 0, Qc, qrow, -1, Kt0, Kt0 + 512, (const attn_body::hb16*)KXF + ((size_t)bh * T + T0 * 64) * 8, NT, NT - 4, (attn_body::hb16*)QKV + (Qc - Qb), (attn_body::hb16*)PO, PML);
            } else {
                const int g = u - 2048; int lo = 0, hi2 = 2048;
                while (hi2 - lo > 1) { const int mid = (lo + hi2) >> 1; if (upre[mid] <= g) lo = mid; else hi2 = mid; }
                const int w = lo, c = g - upre[lo], bh = w >> 5, n = w & 31, b = bh >> 3, h = bh & 7; const int cnt = (int)CNT[w];
                const int ng = 8 + ((cnt + 31) >> 5), g0 = 32 * c, g1 = g0 + 32 < ng ? g0 + 32 : ng;
                const attn_body::hb16* Kt0 = Qb + (size_t)(b * T + n * 256) * NQKV + 2048 + h * 64;
                attn_body::moba_item<8>((char*)lds + RING_OFF, Qb + 1536 + h * 64, b * T, h, n, LIST + (size_t)w * 8192, cnt, g0, g1, Kt0, (const attn_body::hb16*)KXM + h * 256 * 8, (attn_body::hb16*)PO, PML);
            }
            if (tid == 0) qnext[0] = nxt_;
            __syncthreads();
        }
    }
    xcd_barrier(bar);

    { DECL_PTRS;
    const f32x4 ga0 = *((const f32x4*)g_fox + 2 * lane), ga1 = *((const f32x4*)g_fox + 2 * lane + 1), gb0 = *((const f32x4*)g_moba + 2 * lane), gb1 = *((const f32x4*)g_moba + 2 * lane + 1);
    const int h = lane >> 3, cc = lane & 7; const float s2 = __builtin_amdgcn_exp2f(-(float)(h + 1)) * LOG2E * 256.0f;
    float mthr[NB];
#pragma unroll
    for (int b = 0; b < NB; ++b) mthr[b] = skip_thr((const unsigned*)(ctl + CW_QKN) + (b * 8 + h) * 8, 1);
    v4u wan[2], pwn[2][4]; unsigned mmn[2]; pg8::f32x2 mln[2][4];
#define P3_LOAD(rbase) do { _Pragma("unroll") for (int rr = 0; rr < 2; ++rr) { const int r = (rbase) + rr, b = r >> 13, t = r & (T - 1); const size_t sb = ((size_t)r * 8 + h) * 4; \
            wan[rr] = *((const v4u*)(QKV + (size_t)r * NQKV) + lane); mmn[rr] = SEL[((size_t)(b * 8 + h)) * T + t]; \
            _Pragma("unroll") for (int k = 0; k < 4; ++k) { mln[rr][k] = *(const pg8::f32x2*)(PML + (sb + k) * 2); pwn[rr][k] = *((const v4u*)(PO + (sb + k) * 64) + cc); } } } while (0)
    if (gw * 2 < M) P3_LOAD(gw * 2);
    for (int r0 = gw * 2; r0 < M; r0 += NGW * 2) {
        v4u wa[2], pw[2][4]; unsigned mmv[2]; pg8::f32x2 ml[2][4];
#pragma unroll
        for (int rr = 0; rr < 2; ++rr) { wa[rr] = wan[rr]; mmv[rr] = mmn[rr];
#pragma unroll
            for (int k = 0; k < 4; ++k) { ml[rr][k] = mln[rr][k]; pw[rr][k] = pwn[rr][k]; } }
        { const int rn = r0 + NGW * 2 < M ? r0 + NGW * 2 : r0; P3_LOAD(rn); }
#pragma unroll
        for (int rr = 0; rr < 2; ++rr) { const int r = r0 + rr, t = r & (T - 1), own = t >> 8;
            const float a[8] = {bflo(wa[rr].x), bfhi(wa[rr].x), bflo(wa[rr].y), bfhi(wa[rr].y), bflo(wa[rr].z), bfhi(wa[rr].z), bflo(wa[rr].w), bfhi(wa[rr].w)};
            float c[8]; unsigned mm = mmv[rr]; const int cnt = __popc(mm);
            float mk[4], lk[4];
#pragma unroll
            for (int k = 0; k < 4; ++k) { mk[k] = ml[rr][k].x; lk[k] = ml[rr][k].y; }
            mk[3] += s2 * (float)own; float Mx = mk[3];
            bool vk[4]; vk[3] = true; float thb = mthr[0];
#pragma unroll
            for (int b = 1; b < NB; ++b) thb = ((r >> 13) == b) ? mthr[b] : thb;
#pragma unroll
            for (int k = 0; k < 3; ++k) { vk[k] = false; if (k < cnt) { const int nb = __ffs(mm) - 1; mm &= mm - 1u; vk[k] = !moba_skip(h, own, nb, thb); if (vk[k]) { mk[k] += s2 * (float)nb; Mx = fmaxf(Mx, mk[k]); } } }
            float W = 0.f;
#pragma unroll
            for (int i = 0; i < 8; ++i) c[i] = 0.f;
#pragma unroll
            for (int k = 0; k < 4; ++k) { if (vk[k]) { const float w = lk[k] * __builtin_amdgcn_exp2f(mk[k] - Mx); W += w; const v4u p = pw[rr][k];
                c[0] += w * bflo(p.x); c[1] += w * bfhi(p.x); c[2] += w * bflo(p.y); c[3] += w * bfhi(p.y); c[4] += w * bflo(p.z); c[5] += w * bfhi(p.z); c[6] += w * bflo(p.w); c[7] += w * bfhi(p.w); } }
            const float iw = 1.0f / W;
#pragma unroll
            for (int i = 0; i < 8; ++i) c[i] *= iw;
            float sa = 0.f, sb2 = 0.f;
#pragma unroll
            for (int i = 0; i < 8; ++i) { sa += a[i] * a[i]; sb2 += c[i] * c[i]; }
            const float ra = __builtin_amdgcn_rsqf(wave_sum(sa) * (1.f / 512.f) + RMS_EPS), rb = __builtin_amdgcn_rsqf(wave_sum(sb2) * (1.f / 512.f) + RMS_EPS);
            v4u oa, ob;
            oa.x = pk2(a[0] * ra * ga0[0], a[1] * ra * ga0[1]); oa.y = pk2(a[2] * ra * ga0[2], a[3] * ra * ga0[3]); oa.z = pk2(a[4] * ra * ga1[0], a[5] * ra * ga1[1]); oa.w = pk2(a[6] * ra * ga1[2], a[7] * ra * ga1[3]);
            ob.x = pk2(c[0] * rb * gb0[0], c[1] * rb * gb0[1]); ob.y = pk2(c[2] * rb * gb0[2], c[3] * rb * gb0[3]); ob.z = pk2(c[4] * rb * gb1[0], c[5] * rb * gb1[1]); ob.w = pk2(c[6] * rb * gb1[2], c[7] * rb * gb1[3]);
            *((v4u*)(Y + (size_t)r * D) + lane) = oa; *((v4u*)(Y + (size_t)r * D + 512) + lane) = ob; }
    } }
    xcd_barrier(bar);

#undef P3_LOAD
    { DECL_PTRS; pg8::Gemm g{Y, WOUTT, D / 64, D * 2, D * 2, 0xffffffffu}; pg8::TileOrder S; S.init(M, D, G, bx, D * 2, D * 2, 0, 1 << 30);
      pg8::EpiRes<false, false> E{x, nullptr, nullptr, HB1, ws + WS_HB1F, SSQ1, 1.0f};
      pg8::gemm_phase<pg8::EpiRes<false, false>, pg8::TileOrder, true>(L + RING_OFF, XL, g, S, E); }
    xcd_barrier(bar);

    { DECL_PTRS; pg8::Gemm g{ws + WS_HB1F, WQK, D / 128, D, D, 0xffffffffu}; pg8::TileOrder S; S.init(M, D, G, bx, D, D, (size_t)D * D, 32);
      pg8::EpiSoftmax E{(unsigned char*)PB, SSQ1, 1.0f / 32.0f};
      pg8::gemm_phase<pg8::EpiSoftmax, pg8::TileOrder, true, true>(L + RING_OFF, XL, g, S, E); }
    xcd_barrier(bar);

    { DECL_PTRS; pg8::Gemm g{PB, VWO, D / 128, D, D, 0xffffffffu}; pg8::TileOrder S; S.init(M, D, G, bx, D, D, (size_t)D * D, 32);
      pg8::EpiRes<true, false> E{nullptr, HB1, nullptr, HB2, nullptr, SSQ2, 1.0f / 1024.0f};
      pg8::gemm_phase<pg8::EpiRes<true, false>, pg8::TileOrder, true, true>(L + RING_OFF, XL, g, S, E); }
    xcd_barrier(bar);

    { DECL_PTRS; pg8::Gemm g{HB2, WUPT, D / 64, D * 2, D * 2, 0xffffffffu}; pg8::TileOrder S; S.init(M, 2 * FF, G, bx, D * 2, D * 2, 0, 1 << 30);
      pg8::EpiConv E{ACT8, SSQ2, conv_w, conv_b, GHB, UHB, GTB};
      pg8::gemm_phase<pg8::EpiConv, pg8::TileOrder, true>(L + RING_OFF, XL, g, S, E); }
    xcd_barrier(bar);

    { DECL_PTRS;
    for (int it = bx * 512 + tid; it < 256 * 22 * 2 * 32; it += G * 512) {
        const int c4 = (it & 31) * 4, rr = (it >> 5) & 1, tile = it >> 6, pm = tile / 22, pn = tile - pm * 22; const bool top = (pm & 31) == 0;
        const size_t sb = (size_t)tile * 256; const int col = pn * 128 + c4;
        const f32x4 g2 = *(const f32x4*)(GHB + sb + rr * 128 + c4), uu = *(const f32x4*)(UHB + sb + rr * 128 + c4);
        f32x4 g1 = (f32x4){0.f, 0.f, 0.f, 0.f}, g0 = (f32x4){0.f, 0.f, 0.f, 0.f};
        if (rr == 1) g1 = *(const f32x4*)(GHB + sb + c4); else if (!top) g1 = *(const f32x4*)(GTB + sb - 22 * 256 + 128 + c4);
        if (!top) g0 = *(const f32x4*)(GTB + sb - 22 * 256 + (rr == 1 ? 128 : 0) + c4);
        const f32x4 w0 = *(const f32x4*)(conv_w + col), w1 = *(const f32x4*)(conv_w + FF + col), w2 = *(const f32x4*)(conv_w + 2 * FF + col), cbv = *(const f32x4*)(conv_b + col);
        float res[4];
#pragma unroll
        for (int e = 0; e < 4; ++e) { const float gc = cbv[e] + w0[e] * g0[e] + w1[e] * g1[e] + w2[e] * g2[e]; res[e] = gc * __builtin_amdgcn_rcpf(1.0f + __builtin_amdgcn_exp2f(-LOG2E * gc)) * uu[e]; }
        *(unsigned*)(ACT8 + (size_t)(pm * 256 + rr) * FF + col) = pg8::pk4_fp8(res[0], res[1], res[2], res[3]);
    } }
    xcd_barrier(bar);

    { DECL_PTRS; pg8::Gemm g{ACT8, WDT, FF / 128, FF, FF, 0xffffffffu}; pg8::TileOrder S; S.init(M, D, G, bx, FF, FF, 0, 1 << 30);
      pg8::EpiResNorm E{HB2, out, g_final, 1.0f / 64.0f, SSQ3, (unsigned*)(ctl + CW_PANEL), (unsigned*)(ctl + CW_TMO2)};
      pg8::gemm_phase<pg8::EpiResNorm, pg8::TileOrder, true, true>(L + RING_OFF, XL, g, S, E); }
}

extern "C" void kernel_launch(void* const* d_in, const int* in_sizes, int n_in, void* d_out, int out_size, void* d_ws, size_t ws_size, hipStream_t stream) {
    static int grid = 0;
    if (grid == 0) {
        if (n_in != 19 || in_sizes[0] != M * D || out_size != M * D || ws_size < WS_END) { fprintf(stderr, "kernel_launch: unexpected problem shape (n_in %d, in0 %d, out %d, ws %zu); nothing launched\n", n_in, n_in > 0 ? in_sizes[0] : -1, out_size, ws_size); grid = -1; return; }
        int dev = 0, cus = 0, per_cu = 0;
        if (hipGetDevice(&dev) != hipSuccess || hipDeviceGetAttribute(&cus, hipDeviceAttributeMultiprocessorCount, dev) != hipSuccess) { grid = -1; return; }
        if (hipFuncSetAttribute((const void*)fwd, hipFuncAttributeMaxDynamicSharedMemorySize, LDS_BYTES) != hipSuccess) { fprintf(stderr, "kernel_launch: hipFuncSetAttribute failed\n"); grid = -1; return; }
        if (hipOccupancyMaxActiveBlocksPerMultiprocessor(&per_cu, (const void*)fwd, NWAVES * 64, LDS_BYTES) != hipSuccess || per_cu < 1) { fprintf(stderr, "kernel_launch: occupancy query reports %d\n", per_cu); }
        (void)hipGetLastError();
        grid = cus;
    }
    if (grid < 0) return;
    if (hipMemsetAsync((char*)d_ws + WS_CTL, 0, CTL_ZERO_BYTES, stream) != hipSuccess) return;
    Args a{};
    for (int i = 0; i < 19; ++i) a.in[i] = (const float*)d_in[i];
    a.out = (float*)d_out; a.ws = (unsigned char*)d_ws;
    hipLaunchKernelGGL(fwd, dim3(grid), dim3(NWAVES * 64), LDS_BYTES, stream, a);
}
```

```cpp
#include <hip/hip_runtime.h>
#include <hip/hip_bf16.h>
#include <cstdio>
#include <cstdint>

namespace pg8 {
#define PG8_LAS __attribute__((address_space(3)))
typedef unsigned short bf16_t;
typedef short bf16x8 __attribute__((ext_vector_type(8)));
typedef float f32x4 __attribute__((ext_vector_type(4)));
typedef float f32x2 __attribute__((ext_vector_type(2)));
typedef unsigned u32x4 __attribute__((ext_vector_type(4)));
typedef unsigned u32x2 __attribute__((ext_vector_type(2)));
typedef int i32x4 __attribute__((ext_vector_type(4)));
typedef int i32x8 __attribute__((ext_vector_type(8)));
constexpr int BM = 256, BK = 64, HALF = 128, HTB = HALF * BK * 2  , STAGE_BYTES = 8 * HTB, NXCD = 8, WGM = 8;

__host__ __device__ __forceinline__ int lds_byte(int r, int c) { const int st = (r >> 4) * 2 + (c >> 5), rr = r & 15, cc = c & 31, ob = rr * 64 + cc * 2; return st * 1024 + (ob ^ (((ob >> 9) & 1) << 5)); }
__host__ __device__ __forceinline__ void stage_rc(int b, int& R, int& C) { const int st = b / 1024, sb = b % 1024, swz = sb ^ (((sb >> 9) & 1) << 5); R = (st >> 1) * 16 + swz / 64; C = (st & 1) * 32 + (swz % 64) / 2; }
__host__ __device__ __forceinline__ int perm32(int rho) { const int n = rho >> 4, i = rho & 15; return 8 * (i >> 2) + 4 * n + (i & 3); }

struct Unit { int pm, pn; size_t aoff, boff; int skipb1; };
struct Gemm { const void* A; const void* Bt; int nt, lda, ldb; unsigned wrapmask; };

struct TileOrder {
    int nM, nN, nwg, G, c; size_t a_tile, b_tile, b_batch; int pmb;
    __device__ __forceinline__ void init(int M, int N, int G_, int c_, int lda_bytes, int ldb_bytes, size_t b_batch_bytes, int pm_per_batch) {
        nM = M / BM; nN = N / BM; nwg = nM * nN; G = G_; c = c_; deal = 0; skipmode = 0; a_tile = (size_t)BM * lda_bytes; b_tile = (size_t)BM * ldb_bytes; b_batch = b_batch_bytes; pmb = pm_per_batch; }
    int skipmode;
    int deal;
    __device__ __forceinline__ bool next(int i, Unit& u) const {
        long L = (long)i * G + c;
        if (deal == 1) { const int n = 11 + (c < 128 ? 1 : (c >= 192 ? 2 : 0)); if (i >= n) return false; if (i >= 11) L = c < 128 ? 2816 + c : 2944 + (i - 11) * 64 + (c - 192); }
        if (L >= nwg) return false;
        int wgid = (int)L; { const int q = nwg / NXCD, r = nwg % NXCD, xcd = wgid % NXCD, off = wgid / NXCD; wgid = (xcd < r ? xcd * (q + 1) : r * (q + 1) + (xcd - r) * q) + off; }
        const int nig = WGM * nN, gid = wgid / nig, fm = gid * WGM, gsz = (nM - fm) < WGM ? (nM - fm) : WGM;
        u.pm = fm + ((wgid % nig) % gsz); u.pn = (wgid % nig) / gsz;
        u.aoff = (size_t)u.pm * a_tile; u.boff = (size_t)u.pn * b_tile + (size_t)(u.pm / pmb) * b_batch; u.skipb1 = (skipmode && (u.pm & 31) <= 16) ? 1 : 0; return true;
    }
};

__device__ __forceinline__ unsigned cvt_pk_bf16(float lo, float hi) { unsigned r; asm volatile("v_cvt_pk_bf16_f32 %0, %1, %2" : "=v"(r) : "v"(lo), "v"(hi)); return r; }

typedef f32x4 AccT[2][2][4][2];

struct EpiBf16 {
    static constexpr bool PERM = true;
    bf16_t* O; int ldc; unsigned scalemask; float scale0; unsigned* nrm;
    __device__ __forceinline__ void operator()(AccT& acc, const Unit& u, int wr, int wc, int fr, int fq, PG8_LAS unsigned char*) const {
        const int row0 = u.pm * BM + wr * 64 + fr, col0 = u.pn * BM + wc * 32 + 8 * fq;
        const float sc = ((scalemask >> u.pn) & 1u) ? scale0 : 1.f;
        if (nrm && (u.pn < 4 || (u.pn >= 6 && u.pn < 10))) {
#pragma unroll
            for (int bj = 0; bj < 2; ++bj) { float mx = 0.f;
#pragma unroll
                for (int ai = 0; ai < 2; ++ai)
#pragma unroll
                    for (int m = 0; m < 4; ++m) { const f32x4 v0 = acc[ai][bj][m][0] * sc, v1 = acc[ai][bj][m][1] * sc;
                        float q = (v0[0] * v0[0] + v0[1] * v0[1]) + (v0[2] * v0[2] + v0[3] * v0[3]) + (v1[0] * v1[0] + v1[1] * v1[1]) + (v1[2] * v1[2] + v1[3] * v1[3]);
                        q += __shfl_xor(q, 16); q += __shfl_xor(q, 32); mx = fmaxf(mx, q); }
                mx = fmaxf(mx, __shfl_xor(mx, 1)); mx = fmaxf(mx, __shfl_xor(mx, 2)); mx = fmaxf(mx, __shfl_xor(mx, 4)); mx = fmaxf(mx, __shfl_xor(mx, 8));
                if (fr == 0 && fq == 0) { const int head = (u.pn & 1) * 4 + 2 * bj + (wc >> 1); const int grp = u.pn < 4 ? (u.pn >> 1) : (u.pn >> 1) - 1; atomicMax(nrm + (((u.pm >> 5) * 8 + head) * 4 + grp) * 2 + (wc & 1), __float_as_uint(mx)); } } }
#pragma unroll
        for (int ai = 0; ai < 2; ++ai)
#pragma unroll
            for (int m = 0; m < 4; ++m) { bf16_t* rowp = O + (size_t)(row0 + ai * HALF + m * 16) * ldc + col0;
#pragma unroll
                for (int bj = 0; bj < 2; ++bj) { const f32x4 v0 = acc[ai][bj][m][0] * sc, v1 = acc[ai][bj][m][1] * sc;
                    u32x4 w; w.x = cvt_pk_bf16(v0[0], v0[1]); w.y = cvt_pk_bf16(v0[2], v0[3]); w.z = cvt_pk_bf16(v1[0], v1[1]); w.w = cvt_pk_bf16(v1[2], v1[3]);
                    *(u32x4*)(rowp + bj * HALF) = w; } }
    }
};
__device__ __forceinline__ unsigned pk4_fp8(float a, float b, float c, float d) { a = __builtin_amdgcn_fmed3f(a, -448.f, 448.f); b = __builtin_amdgcn_fmed3f(b, -448.f, 448.f); c = __builtin_amdgcn_fmed3f(c, -448.f, 448.f); d = __builtin_amdgcn_fmed3f(d, -448.f, 448.f); int w = 0;
    w = __builtin_amdgcn_cvt_pk_fp8_f32(a, b, w, false); w = __builtin_amdgcn_cvt_pk_fp8_f32(c, d, w, true); return (unsigned)w; }
struct EpiF8 {
    static constexpr bool PERM = true;
    unsigned char* O; int ldc; float sc;
    __device__ __forceinline__ void operator()(AccT& acc, const Unit& u, int wr, int wc, int fr, int fq, PG8_LAS unsigned char*) const {
        const int row0 = u.pm * BM + wr * 64 + fr, col0 = u.pn * BM + wc * 32 + 8 * fq;
#pragma unroll
        for (int ai = 0; ai < 2; ++ai)
#pragma unroll
            for (int m = 0; m < 4; ++m) { unsigned char* rowp = O + (size_t)(row0 + ai * HALF + m * 16) * ldc + col0;
#pragma unroll
                for (int bj = 0; bj < 2; ++bj) { const f32x4 v0 = acc[ai][bj][m][0] * sc, v1 = acc[ai][bj][m][1] * sc;
                    *(u32x2*)(rowp + bj * HALF) = (u32x2){pk4_fp8(v0[0], v0[1], v0[2], v0[3]), pk4_fp8(v1[0], v1[1], v1[2], v1[3])}; } }
    }
};
__device__ __forceinline__ float rstd_from_slots(const float* slots) {
    const f32x4 a = *(const f32x4*)slots, b = *(const f32x4*)(slots + 4), c = *(const f32x4*)(slots + 8), d = *(const f32x4*)(slots + 12);
    const float s = ((a[0] + a[1]) + (a[2] + a[3])) + ((b[0] + b[1]) + (b[2] + b[3])) + ((c[0] + c[1]) + (c[2] + c[3])) + ((d[0] + d[1]) + (d[2] + d[3]));
    return __builtin_amdgcn_rsqf(s * (1.0f / 1024.0f) + 1e-6f);
}
#define PG8_DPP(old, src, ctrl) __builtin_bit_cast(float, __builtin_amdgcn_update_dpp(__builtin_bit_cast(int, (float)(old)), __builtin_bit_cast(int, (float)(src)), (ctrl), 0xf, 0xf, false))
struct EpiConv {
    static constexpr bool PERM = true;
    unsigned char* act; const float* ssq; const float* cw; const float* cbias; float* GH; float* UH; float* GT;
    __device__ __forceinline__ void operator()(AccT& acc, const Unit& u, int wr, int wc, int fr, int fq, PG8_LAS unsigned char* xl) const {
        PG8_LAS float* H = (PG8_LAS float*)xl;
        const int cl = wc * 32 + 8 * fq;
        const int row0 = u.pm * BM + wr * 64 + fr;
        PG8_LAS float* Sr = H + 1024;
        { const int t_ = threadIdx.x; if (t_ < 256) Sr[t_] = rstd_from_slots(ssq + (size_t)(u.pm * BM + t_) * 16); }
        asm volatile("s_waitcnt vmcnt(0) lgkmcnt(0)" ::: "memory"); __builtin_amdgcn_s_barrier(); asm volatile("" ::: "memory");
#pragma unroll
        for (int ai = 0; ai < 2; ++ai)
#pragma unroll
            for (int m = 0; m < 4; ++m) { const float rs = Sr[ai * HALF + wr * 64 + m * 16 + fr];
#pragma unroll
                for (int bj = 0; bj < 2; ++bj)
#pragma unroll
                    for (int n = 0; n < 2; ++n) acc[ai][bj][m][n] *= rs; }
        const size_t sb = ((size_t)(u.pm * 22 + u.pn) * 2) * 128 + cl;
        if (fr >= 14) {
#pragma unroll
            for (int ai = 0; ai < 2; ++ai)
#pragma unroll
                for (int n = 0; n < 2; ++n) *(PG8_LAS f32x4*)(H + ((ai * 2 + wr) * 2 + (fr - 14)) * 128 + cl + 4 * n) = acc[ai][0][3][n];
            if (wr == 1) {
#pragma unroll
                for (int n = 0; n < 2; ++n) *(f32x4*)(GT + sb + (fr - 14) * 128 + 4 * n) = acc[1][0][3][n]; } }
        if (wr == 0 && fr < 2) {
#pragma unroll
            for (int n = 0; n < 2; ++n) { *(f32x4*)(GH + sb + fr * 128 + 4 * n) = acc[0][0][0][n]; *(f32x4*)(UH + sb + fr * 128 + 4 * n) = acc[0][1][0][n]; } }
        asm volatile("s_waitcnt lgkmcnt(0)" ::: "memory"); __builtin_amdgcn_s_barrier(); asm volatile("" ::: "memory");
#pragma unroll
        for (int n = 0; n < 2; ++n) {
            const int c0 = u.pn * 128 + cl + 4 * n;
            const f32x4 w0 = *(const f32x4*)(cw + c0), w1 = *(const f32x4*)(cw + 2816 + c0), w2 = *(const f32x4*)(cw + 2 * 2816 + c0), cbv = *(const f32x4*)(cbias + c0);
#pragma unroll
            for (int ai = 0; ai < 2; ++ai) {
                const int hsrc = wr == 1 ? ai * 2 : (ai == 1 ? 1 : 0);
                const f32x4 h14 = *(const PG8_LAS f32x4*)(H + (hsrc * 2 + 0) * 128 + cl + 4 * n), h15 = *(const PG8_LAS f32x4*)(H + (hsrc * 2 + 1) * 128 + cl + 4 * n);
#pragma unroll
                for (int m = 3; m >= 0; --m) {
                    float res[4];
#pragma unroll
                    for (int i = 0; i < 4; ++i) { const float X = acc[ai][0][m][n][i];
                        float o1, o2;
                        if (m > 0) { const float Xp = acc[ai][0][m > 0 ? m - 1 : 0][n][i]; o1 = PG8_DPP(0.f, Xp, 0x121); o2 = PG8_DPP(0.f, Xp, 0x122); }
                        else { o1 = h15[i]; o2 = fr == 0 ? h14[i] : h15[i]; }
                        const float g1 = PG8_DPP(o1, X, 0x111), g0 = PG8_DPP(o2, X, 0x112);
                        const float gc = cbv[i] + w0[i] * g0 + w1[i] * g1 + w2[i] * X;
                        res[i] = gc * __builtin_amdgcn_rcpf(1.0f + __builtin_amdgcn_exp2f(-1.4426950408889634f * gc)) * acc[ai][1][m][n][i]; }
                    const int row = row0 + ai * HALF + m * 16;
                    if (!(ai == 0 && m == 0 && wr == 0 && fr < 2))
                        *(unsigned*)(act + (size_t)row * 2816 + c0) = pk4_fp8(res[0], res[1], res[2], res[3]);
                } } }
    }
};
template <bool BASEB, bool OUTF> struct EpiRes {
    static constexpr bool PERM = true;
    const float* base; const bf16_t* baseb; float* out; bf16_t* hb; unsigned char* hb8; float* ssq; float accs;
    __device__ __forceinline__ void operator()(AccT& acc, const Unit& u, int wr, int wc, int fr, int fq, PG8_LAS unsigned char*) const {
        const int row0 = u.pm * BM + wr * 64 + fr, col0 = u.pn * BM + wc * 32 + 8 * fq;
#pragma unroll
        for (int ai = 0; ai < 2; ++ai)
#pragma unroll
            for (int m = 0; m < 4; ++m) { const int row = row0 + ai * HALF + m * 16; const size_t off = (size_t)row * 1024 + col0; float q = 0.f;
#pragma unroll
                for (int bj = 0; bj < 2; ++bj) {
                    f32x4 b0, b1;
                    if constexpr (BASEB) { const u32x4 bw = *(const u32x4*)(baseb + off + bj * HALF);
                        b0 = (f32x4){__builtin_bit_cast(float, bw.x << 16), __builtin_bit_cast(float, bw.x & 0xffff0000u), __builtin_bit_cast(float, bw.y << 16), __builtin_bit_cast(float, bw.y & 0xffff0000u)};
                        b1 = (f32x4){__builtin_bit_cast(float, bw.z << 16), __builtin_bit_cast(float, bw.z & 0xffff0000u), __builtin_bit_cast(float, bw.w << 16), __builtin_bit_cast(float, bw.w & 0xffff0000u)}; }
                    else { b0 = *(const f32x4*)(base + off + bj * HALF); b1 = *(const f32x4*)(base + off + bj * HALF + 4); }
                    const f32x4 v0 = acc[ai][bj][m][0] * accs + b0, v1 = acc[ai][bj][m][1] * accs + b1;
                    if constexpr (OUTF) { *(f32x4*)(out + off + bj * HALF) = v0; *(f32x4*)(out + off + bj * HALF + 4) = v1; }
                    q += (v0[0] * v0[0] + v0[1] * v0[1]) + (v0[2] * v0[2] + v0[3] * v0[3]) + (v1[0] * v1[0] + v1[1] * v1[1]) + (v1[2] * v1[2] + v1[3] * v1[3]);
                    if (hb) { u32x4 w; w.x = cvt_pk_bf16(v0[0], v0[1]); w.y = cvt_pk_bf16(v0[2], v0[3]); w.z = cvt_pk_bf16(v1[0], v1[1]); w.w = cvt_pk_bf16(v1[2], v1[3]); *(u32x4*)(hb + off + bj * HALF) = w; }
                    if (hb8) *(u32x2*)(hb8 + off + bj * HALF) = (u32x2){pk4_fp8(v0[0], v0[1], v0[2], v0[3]), pk4_fp8(v1[0], v1[1], v1[2], v1[3])}; }
                q += __shfl_xor(q, 16); q += __shfl_xor(q, 32);
                if (fq == 0) ssq[(size_t)row * 16 + u.pn * 4 + wc] = q; }
    }
};
struct EpiResNorm {
    static constexpr bool PERM = true;
    const bf16_t* baseb; float* out; const float* gfin; float accs; float* xbuf; unsigned* cnt; unsigned* tmo;
    __device__ __forceinline__ void operator()(AccT& acc, const Unit& u, int wr, int wc, int fr, int fq, PG8_LAS unsigned char* xl) const {
        PG8_LAS float* Pp = (PG8_LAS float*)xl;
        PG8_LAS float* Sr = Pp + 1024;
        PG8_LAS unsigned* flag = (PG8_LAS unsigned*)(Sr + 256);
        const int tid = threadIdx.x, wid = tid >> 6, lane = tid & 63;
        const int row0 = u.pm * BM + wr * 64 + fr, col0 = u.pn * BM + wc * 32 + 8 * fq;
#pragma unroll
        for (int ai = 0; ai < 2; ++ai)
#pragma unroll
            for (int m = 0; m < 4; ++m) { const int row = row0 + ai * HALF + m * 16; const size_t off = (size_t)row * 1024 + col0; float q = 0.f;
#pragma unroll
                for (int bj = 0; bj < 2; ++bj) {
                    const u32x4 bw = *(const u32x4*)(baseb + off + bj * HALF);
                    const f32x4 b0 = (f32x4){__builtin_bit_cast(float, bw.x << 16), __builtin_bit_cast(float, bw.x & 0xffff0000u), __builtin_bit_cast(float, bw.y << 16), __builtin_bit_cast(float, bw.y & 0xffff0000u)};
                    const f32x4 b1 = (f32x4){__builtin_bit_cast(float, bw.z << 16), __builtin_bit_cast(float, bw.z & 0xffff0000u), __builtin_bit_cast(float, bw.w << 16), __builtin_bit_cast(float, bw.w & 0xffff0000u)};
                    const f32x4 v0 = acc[ai][bj][m][0] * accs + b0, v1 = acc[ai][bj][m][1] * accs + b1; acc[ai][bj][m][0] = v0; acc[ai][bj][m][1] = v1;
                    q += (v0[0] * v0[0] + v0[1] * v0[1]) + (v0[2] * v0[2] + v0[3] * v0[3]) + (v1[0] * v1[0] + v1[1] * v1[1]) + (v1[2] * v1[2] + v1[3] * v1[3]); }
                q += __shfl_xor(q, 16); q += __shfl_xor(q, 32);
                if (fq == 0) Pp[(ai * HALF + wr * 64 + m * 16 + fr) * 4 + wc] = q; }
        asm volatile("s_waitcnt lgkmcnt(0)" ::: "memory"); __builtin_amdgcn_s_barrier(); asm volatile("" ::: "memory");
        if (wid < 4) { const int r = wid * 64 + lane; const f32x4 p = *(const PG8_LAS f32x4*)(Pp + r * 4);
            __hip_atomic_store(xbuf + (size_t)(u.pm * BM + r) * 4 + u.pn, (p[0] + p[1]) + (p[2] + p[3]), __ATOMIC_RELAXED, __HIP_MEMORY_SCOPE_AGENT);
            asm volatile("s_waitcnt vmcnt(0)" ::: "memory");
            if (lane == 0) __hip_atomic_fetch_add(cnt + 64 * u.pm, 1u, __ATOMIC_RELAXED, __HIP_MEMORY_SCOPE_AGENT); }
        if (wid == 0) { unsigned sp = 0u; bool dead = false;
            for (;;) { if ((unsigned)__builtin_amdgcn_readfirstlane(__hip_atomic_load(cnt + 64 * u.pm, __ATOMIC_RELAXED, __HIP_MEMORY_SCOPE_AGENT)) >= 16u) break;
                if (++sp > (1u << 20)) { if (lane == 0) __hip_atomic_store(tmo, 1u, __ATOMIC_RELAXED, __HIP_MEMORY_SCOPE_AGENT); dead = true; break; }
                __builtin_amdgcn_s_sleep(2); }
            __builtin_amdgcn_fence(__ATOMIC_ACQUIRE, "agent");
            if (lane == 0) flag[0] = dead ? 1u : 0u; }
        asm volatile("s_waitcnt vmcnt(0) lgkmcnt(0)" ::: "memory"); __builtin_amdgcn_s_barrier(); asm volatile("" ::: "memory");
        if (wid < 4) { const int r = wid * 64 + lane; const float* xs = xbuf + (size_t)(u.pm * BM + r) * 4; float s = 0.f;
#pragma unroll
            for (int t = 0; t < 4; ++t) s += __hip_atomic_load(xs + t, __ATOMIC_RELAXED, __HIP_MEMORY_SCOPE_AGENT);
            Sr[r] = __builtin_amdgcn_rsqf(s * (1.0f / 1024.0f) + 1e-6f); }
        asm volatile("s_waitcnt vmcnt(0) lgkmcnt(0)" ::: "memory"); __builtin_amdgcn_s_barrier(); asm volatile("" ::: "memory");
        f32x4 gg[2][2];
#pragma unroll
        for (int bj = 0; bj < 2; ++bj) { gg[bj][0] = *(const f32x4*)(gfin + col0 + bj * HALF); gg[bj][1] = *(const f32x4*)(gfin + col0 + bj * HALF + 4); }
#pragma unroll
        for (int ai = 0; ai < 2; ++ai)
#pragma unroll
            for (int m = 0; m < 4; ++m) { const int rl = ai * HALF + wr * 64 + m * 16 + fr; const float rs = Sr[rl]; const size_t off = (size_t)(u.pm * BM + rl) * 1024 + col0;
#pragma unroll
                for (int bj = 0; bj < 2; ++bj) { *(f32x4*)(out + off + bj * HALF) = acc[ai][bj][m][0] * rs * gg[bj][0]; *(f32x4*)(out + off + bj * HALF + 4) = acc[ai][bj][m][1] * rs * gg[bj][1]; } }
    }
};
struct EpiSoftmax {
    static constexpr bool PERM = true;
    unsigned char* P; const float* ssq; float sscale;
    __device__ __forceinline__ void operator()(AccT& acc, const Unit& u, int wr, int wc, int fr, int fq, PG8_LAS unsigned char* xl) const {
        PG8_LAS f32x2* X = (PG8_LAS f32x2*)xl;
        const int row0 = u.pm * BM + wr * 64 + fr, col0 = u.pn * BM + wc * 32 + 8 * fq;
        float ml[2][4];
#pragma unroll
        for (int ai = 0; ai < 2; ++ai)
#pragma unroll
            for (int m = 0; m < 4; ++m) { const int row = row0 + ai * HALF + m * 16; const float rs = rstd_from_slots(ssq + (size_t)row * 16) * sscale;
                float mx = -3.0e38f;
#pragma unroll
                for (int bj = 0; bj < 2; ++bj)
#pragma unroll
                    for (int n = 0; n < 2; ++n) { f32x4 v = acc[ai][bj][m][n] * rs; acc[ai][bj][m][n] = v; mx = fmaxf(fmaxf(mx, fmaxf(v[0], v[1])), fmaxf(v[2], v[3])); }
                mx = fmaxf(mx, __shfl_xor(mx, 16)); mx = fmaxf(mx, __shfl_xor(mx, 32));
                float s = 0.f;
#pragma unroll
                for (int bj = 0; bj < 2; ++bj)
#pragma unroll
                    for (int n = 0; n < 2; ++n) { f32x4 v = acc[ai][bj][m][n];
                        v[0] = __builtin_amdgcn_exp2f(v[0] - mx); v[1] = __builtin_amdgcn_exp2f(v[1] - mx); v[2] = __builtin_amdgcn_exp2f(v[2] - mx); v[3] = __builtin_amdgcn_exp2f(v[3] - mx);
                        acc[ai][bj][m][n] = v; s += (v[0] + v[1]) + (v[2] + v[3]); }
                s += __shfl_xor(s, 16); s += __shfl_xor(s, 32);
                ml[ai][m] = mx;
                if (fq == 0) X[(ai * HALF + wr * 64 + m * 16 + fr) * 4 + wc] = (f32x2){mx, s}; }
        asm volatile("s_waitcnt lgkmcnt(0)" ::: "memory"); __builtin_amdgcn_s_barrier(); asm volatile("" ::: "memory");
#pragma unroll
        for (int ai = 0; ai < 2; ++ai)
#pragma unroll
            for (int m = 0; m < 4; ++m) { const int rl = ai * HALF + wr * 64 + m * 16 + fr; const int row = u.pm * BM + rl;
                const f32x2 a = X[rl * 4 + 0], b = X[rl * 4 + 1], c = X[rl * 4 + 2], d = X[rl * 4 + 3];
                const float Mx = fmaxf(fmaxf(a.x, b.x), fmaxf(c.x, d.x));
                const float L = a.y * __builtin_amdgcn_exp2f(a.x - Mx) + b.y * __builtin_amdgcn_exp2f(b.x - Mx) + c.y * __builtin_amdgcn_exp2f(c.x - Mx) + d.y * __builtin_amdgcn_exp2f(d.x - Mx);
                const float f = __builtin_amdgcn_exp2f(ml[ai][m] - Mx) * __builtin_amdgcn_rcpf(L) * 256.0f;
                unsigned char* rowp = P + (size_t)row * 1024 + col0;
#pragma unroll
                for (int bj = 0; bj < 2; ++bj) { const f32x4 v0 = acc[ai][bj][m][0] * f, v1 = acc[ai][bj][m][1] * f;
                    *(u32x2*)(rowp + bj * HALF) = (u32x2){pk4_fp8(v0[0], v0[1], v0[2], v0[3]), pk4_fp8(v1[0], v1[1], v1[2], v1[3])}; } }
    }
};
struct EpiGate {
    static constexpr bool PERM = false;
    unsigned* sel;
    __device__ __forceinline__ void operator()(AccT& acc, const Unit& u, int wr, int wc, int fr, int fq, PG8_LAS unsigned char*) const {
        const int own = u.pm & 31;
#pragma unroll
        for (int ai = 0; ai < 2; ++ai)
#pragma unroll
            for (int m = 0; m < 4; ++m) { const int row = u.pm * BM + ai * HALF + wr * 64 + m * 16 + fr;
#pragma unroll
                for (int n = 0; n < 2; ++n) { unsigned mask = 0u;
#pragma unroll
                    for (int round = 0; round < 3; ++round) { float bv = -3.0e38f; int bi = 32;
#pragma unroll
                        for (int bj = 0; bj < 2; ++bj)
#pragma unroll
                            for (int i = 0; i < 4; ++i) { const int nb = 16 * bj + 4 * fq + i; const float v = acc[ai][bj][m][n][i];
                                if (nb < own && !((mask >> nb) & 1u) && v > bv) { bv = v; bi = nb; } }
#pragma unroll
                        for (int off = 16; off <= 32; off <<= 1) { const float ov = __shfl_xor(bv, off); const int oi = __shfl_xor(bi, off); if (ov > bv || (ov == bv && oi < bi)) { bv = ov; bi = oi; } }
                        if (bi < 32) mask |= 1u << bi; }
                    if (fq == 0) sel[((size_t)((u.pm >> 5) * 8 + 2 * wc + n)) * 8192 + (row & 8191)] = mask; } }
    }
};

template <class Epi, class Sched, bool ALIGN_EPI, bool F8 = false, bool CANSKIP = false>
__device__ __forceinline__ void gemm_phase(PG8_LAS unsigned char* lds, PG8_LAS unsigned char* xl, const Gemm g, const Sched& S, const Epi& E) {
    int tid_ = threadIdx.x; asm volatile("" : "+v"(tid_));
    const int tid = tid_, wid = __builtin_amdgcn_readfirstlane(tid >> 6), lane = tid & 63, wr = wid >> 2, wc = wid & 3, fr = lane & 15, fq = lane >> 4;
    int nt = g.nt; asm volatile("" : "+s"(nt));
    unsigned voffA[2], voffB[2];
#pragma unroll
    for (int i = 0; i < 2; ++i) { int R, C; stage_rc(tid * 16 + i * 8192, R, C); const int Rb = Epi::PERM ? ((R & ~31) + perm32(R & 31)) : R;
        voffA[i] = (unsigned)(R * g.lda + C * 2); voffB[i] = (unsigned)(Rb * g.ldb + C * 2); }
    const size_t kstep = (size_t)(BK * 2);
    const size_t hstepA = (size_t)HALF * g.lda, hstepB = (size_t)HALF * g.ldb;
    const unsigned wmask = g.wrapmask;
    const unsigned ldsw = (unsigned)wid * 1024u;
    const int aoff = lds_byte(wr * 64 + fr, fq * 8), boff = lds_byte(wc * 32 + fr, fq * 8);
#define PG8_SA(b, h) (((b) * 2 + (h)) * HTB)
#define PG8_SB(b, h) ((4 + (b) * 2 + (h)) * HTB)
#define PG8_STAGE(bufoff, gbase, voff) do { _Pragma("unroll") for (int _i = 0; _i < 2; ++_i) \
        __builtin_amdgcn_global_load_lds((const unsigned*)((const char*)(gbase) + (voff)[_i]), (PG8_LAS unsigned*)(lds + (bufoff) + ldsw + _i * 8192), 16, 0, 0); } while (0)
#define PG8_LDA(dst, b, h) do { if constexpr (F8) { _Pragma("unroll") for (int m = 0; m < 4; ++m) { dst##8[m].lo = *(const PG8_LAS i32x4*)(lds + PG8_SA(b, h) + aoff + m * 2048); dst##8[m].hi = *(const PG8_LAS i32x4*)(lds + PG8_SA(b, h) + aoff + m * 2048 + 1024); } } \
        else { _Pragma("unroll") for (int m = 0; m < 4; ++m) _Pragma("unroll") for (int k = 0; k < 2; ++k) dst[m][k] = *(const PG8_LAS bf16x8*)(lds + PG8_SA(b, h) + aoff + m * 2048 + k * 1024); } } while (0)
#define PG8_LDB(dst, b, h) do { if constexpr (F8) { _Pragma("unroll") for (int n = 0; n < 2; ++n) { dst##8[n].lo = *(const PG8_LAS i32x4*)(lds + PG8_SB(b, h) + boff + n * 2048); dst##8[n].hi = *(const PG8_LAS i32x4*)(lds + PG8_SB(b, h) + boff + n * 2048 + 1024); } } \
        else { _Pragma("unroll") for (int n = 0; n < 2; ++n) _Pragma("unroll") for (int k = 0; k < 2; ++k) dst[n][k] = *(const PG8_LAS bf16x8*)(lds + PG8_SB(b, h) + boff + n * 2048 + k * 1024); } } while (0)
#define PG8_MMA(ai, bj, At, Bt) do { __builtin_amdgcn_s_setprio(1); \
        if constexpr (F8) { _Pragma("unroll") for (int m = 0; m < 4; ++m) _Pragma("unroll") for (int n = 0; n < 2; ++n) \
            asm volatile("v_mfma_f32_16x16x128_f8f6f4 %0, %1, %2, %0" : "+v"(acc[ai][bj][m][n]) : "v"(Bt##8[n]), "v"(At##8[m])); } \
        else { _Pragma("unroll") for (int m = 0; m < 4; ++m) _Pragma("unroll") for (int n = 0; n < 2; ++n) _Pragma("unroll") for (int k = 0; k < 2; ++k) \
            acc[ai][bj][m][n] = __builtin_amdgcn_mfma_f32_16x16x32_bf16(Bt[n][k], At[m][k], acc[ai][bj][m][n], 0, 0, 0); } \
        __builtin_amdgcn_s_setprio(0); } while (0)
#define PG8_WAIT_V(n) asm volatile("s_waitcnt vmcnt(" #n ")" ::: "memory")
#define PG8_WAIT_L(n) asm volatile("s_waitcnt lgkmcnt(" #n ")" ::: "memory")
#define PG8_BAR __builtin_amdgcn_s_barrier()
#define PG8_SCHED __builtin_amdgcn_sched_barrier(0)
    Unit cur, nxt; int ui = 0;
    if (!S.next(0, cur)) return;
    AccT acc;
    bf16x8 At[4][2], B0[2][2], B1[2][2]; i32x8 At8[4], B08[2], B18[2];
    const char* cA = (const char*)g.A + cur.aoff; const char* cB = (const char*)g.Bt + cur.boff;
    PG8_STAGE(PG8_SB(0, 0), cB, voffB); PG8_STAGE(PG8_SB(0, 1), cB + hstepB, voffB); PG8_STAGE(PG8_SA(0, 0), cA, voffA); PG8_STAGE(PG8_SA(0, 1), cA + hstepA, voffA);
    if (wr == 1) PG8_BAR;
    PG8_WAIT_V(2); PG8_BAR;
    PG8_STAGE(PG8_SB(1, 0), cB + kstep, voffB); PG8_STAGE(PG8_SA(1, 0), cA + kstep, voffA); PG8_STAGE(PG8_SB(1, 1), cB + hstepB + kstep, voffB);
    PG8_WAIT_V(6); PG8_BAR;
    { float z0; asm volatile("v_mov_b32 %0, 0" : "=v"(z0));
#pragma unroll
    for (int a = 0; a < 2; ++a)
#pragma unroll
        for (int b = 0; b < 2; ++b)
#pragma unroll
            for (int m = 0; m < 4; ++m)
#pragma unroll
                for (int n = 0; n < 2; ++n) acc[a][b][m][n] = (f32x4){z0, z0, z0, z0}; }
    for (;;) {
        const bool has_next = S.next(ui + 1, nxt);
        const char* nA = has_next ? (const char*)g.A + nxt.aoff : cA; const char* nB = has_next ? (const char*)g.Bt + nxt.boff : cB;
#pragma unroll 1
        for (int t = 0; t < nt; t += 2) {
            const bool last = (t == nt - 2);
            const char* a1 = cA + (size_t)((unsigned)(t * 128) & wmask) + kstep;
            const char* a2 = last ? nA : cA + (size_t)((unsigned)((t + 2) * 128) & wmask); const char* b2 = last ? nB : cB + (size_t)(t + 2) * kstep;
            const char* a3 = a2 + kstep; const char* b3 = b2 + kstep;
            PG8_LDB(B0, 0, 0); if (!(CANSKIP && cur.skipb1)) PG8_LDB(B1, 0, 1); PG8_SCHED; PG8_LDA(At, 0, 0); PG8_STAGE(PG8_SA(1, 1), a1 + hstepA, voffA);
            PG8_WAIT_V(8); PG8_WAIT_L(0); PG8_BAR; PG8_MMA(0, 0, At, B0); if (!(CANSKIP && cur.skipb1)) PG8_MMA(0, 1, At, B1); PG8_BAR; PG8_SCHED;
            PG8_LDA(At, 0, 1); PG8_STAGE(PG8_SB(0, 0), b2, voffB); PG8_STAGE(PG8_SB(0, 1), b2 + hstepB, voffB); PG8_STAGE(PG8_SA(0, 0), a2, voffA);
            PG8_WAIT_V(8); PG8_WAIT_L(0); PG8_BAR; PG8_MMA(1, 0, At, B0); if (!(CANSKIP && cur.skipb1)) PG8_MMA(1, 1, At, B1); PG8_BAR; PG8_SCHED;
            PG8_LDB(B0, 1, 0); if (!(CANSKIP && cur.skipb1)) PG8_LDB(B1, 1, 1); PG8_SCHED; PG8_LDA(At, 1, 0); PG8_STAGE(PG8_SA(0, 1), a2 + hstepA, voffA);
            PG8_WAIT_V(8); PG8_WAIT_L(0); PG8_BAR; PG8_MMA(0, 0, At, B0); if (!(CANSKIP && cur.skipb1)) PG8_MMA(0, 1, At, B1); PG8_BAR; PG8_SCHED;
            PG8_LDA(At, 1, 1); PG8_STAGE(PG8_SB(1, 0), b3, voffB); PG8_STAGE(PG8_SB(1, 1), b3 + hstepB, voffB); PG8_STAGE(PG8_SA(1, 0), a3, voffA);
            PG8_WAIT_V(8); PG8_WAIT_L(0); PG8_BAR; PG8_MMA(1, 0, At, B0); if (!(CANSKIP && cur.skipb1)) PG8_MMA(1, 1, At, B1); PG8_BAR; PG8_SCHED;
        }
        if constexpr (F8) asm volatile("s_nop 15\n\ts_nop 15" ::: "memory");
        if constexpr (ALIGN_EPI) { if (wr == 0) PG8_BAR; }
        E(acc, cur, wr, wc, fr, fq, xl);
        if (!has_next) break;
#pragma unroll
        for (int a = 0; a < 2; ++a)
#pragma unroll
            for (int b = 0; b < 2; ++b)
#pragma unroll
                for (int m = 0; m < 4; ++m)
#pragma unroll
                    for (int n = 0; n < 2; ++n) acc[a][b][m][n] = (f32x4){0.f, 0.f, 0.f, 0.f};
        cur = nxt; cA = nA; cB = nB; ++ui;
        if constexpr (ALIGN_EPI) { if (wr == 1) PG8_BAR; }
    }
    PG8_WAIT_V(0);
    if constexpr (!ALIGN_EPI) { if (wr == 0) PG8_BAR; }
    PG8_BAR;
#undef PG8_SA
#undef PG8_SB
#undef PG8_STAGE
#undef PG8_LDA
#undef PG8_LDB
#undef PG8_MMA
#undef PG8_WAIT_V
#undef PG8_WAIT_L
#undef PG8_BAR
#undef PG8_SCHED
}
}

constexpr int NWAVES = 8;
constexpr int NB = 8, T = 8192, D = 1024, M = NB * T;
constexpr int INC = 3080, NQKV = 3072, FF = 2816;
constexpr int C_F = 1536, C_QM = 1544, C_KM = 2056;
constexpr float LOG2E = 1.4426950408889634f;
constexpr float C2 = 0.125f * LOG2E;
constexpr float RMS_EPS = 1e-6f;

constexpr size_t MiB = 1u << 20;
constexpr size_t WS_CTL = 0, CTL_ZERO_BYTES = 1 * MiB;
constexpr size_t WS_LOGF = 2 * MiB, WS_C = 4 * MiB, WS_ABAR = 6 * MiB, WS_KM = 7 * MiB, WS_SEL = 8 * MiB;
constexpr size_t WS_SSQ1 = 10 * MiB, WS_SSQ2 = 14 * MiB, WS_SSQ3 = 18 * MiB;
constexpr size_t WS_MEMN = 22 * MiB, WS_KV = 26 * MiB, WS_WQS = 34 * MiB, WS_WOT = 36 * MiB, WS_WKVT = 38 * MiB, WS_WINT = 42 * MiB, WS_WOUTT = 48 * MiB;
constexpr size_t WS_WUPT = 50 * MiB, WS_WDT = 976 * MiB  , WS_ZT = 68 * MiB, WS_WQK = 80 * MiB, WS_VWO = 96 * MiB;
constexpr size_t WS_ACT8 = 240 * MiB;
constexpr size_t WS_GH = 416 * MiB, WS_UH = 424 * MiB, WS_GT = 432 * MiB;
constexpr size_t WS_A1 = 112 * MiB;
constexpr size_t WS_QKV = 368 * MiB;
constexpr size_t WS_Y = 752 * MiB, WS_HB1 = WS_A1 + 128 * MiB, WS_P = WS_QKV, WS_HB2 = WS_A1;
constexpr size_t WS_HB1F = WS_A1;
constexpr size_t WS_PO = WS_A1;
constexpr size_t WS_LIST = 880 * MiB, WS_PML = 944 * MiB, WS_KXF = 960 * MiB, WS_KXM = 968 * MiB, WS_CNT = 969 * MiB;
constexpr size_t WS_G = 240 * MiB, WS_U = 592 * MiB, WS_END = 1024 * MiB;
static_assert(WS_WUPT + (size_t)2 * FF * D * 2 <= WS_ZT && WS_ACT8 + (size_t)M * FF <= WS_GH && WS_WDT + (size_t)D * FF <= WS_END && WS_CNT + 8192 <= WS_WDT && WS_ZT + (size_t)8 * 256 * 3072 * 2 <= WS_WQK && WS_VWO + 16 * MiB <= WS_A1, "ws map");
static_assert(WS_G + (size_t)M * FF * 2 <= WS_U && WS_U + (size_t)M * FF * 2 <= WS_END && WS_Y + (size_t)M * D * 2 <= WS_LIST && WS_LIST + (size_t)2048 * 8192 * 4 <= WS_PML && WS_PML + (size_t)M * 32 * 8 <= WS_KXF && WS_KXF + (size_t)64 * 8192 * 16 <= WS_KXM, "ws map 2");
constexpr int CW_BAR = 4096;
constexpr int CW_QKN = 8192;
constexpr int CW_QUEUE = 12288;
constexpr int CW_T0TAB = 16384;
constexpr int CW_CNT_KM = 24576, CW_CNT_Z = 24640, CW_CNT_KV = 24704;
constexpr int CW_PANEL = 32768, CW_TMO2 = 20480;

constexpr int RING_OFF = 0, RING_BYTES = 131072;
constexpr int LDSCTL_OFF = RING_BYTES, MISC_OFF = LDSCTL_OFF + 320;
constexpr int XL_OFF = RING_BYTES + 512;
constexpr int LDS_BYTES = 147456;
static_assert(XL_OFF + 8192 <= LDS_BYTES, "LDS map");

#define GAS __attribute__((address_space(1)))
#define LAS __attribute__((address_space(3)))
typedef unsigned short bf16;
typedef unsigned v4u __attribute__((ext_vector_type(4)));
typedef float f32x4 __attribute__((ext_vector_type(4)));
typedef GAS unsigned gu32;
#define RLX_AGENT __ATOMIC_RELAXED, __HIP_MEMORY_SCOPE_AGENT
#define LDS_WAIT() asm volatile("s_waitcnt lgkmcnt(0)" ::: "memory")
__device__ __forceinline__ unsigned f2bf(float f) { unsigned u = __builtin_bit_cast(unsigned, f); return (u + 0x7fffu + ((u >> 16) & 1u)) >> 16; }
__device__ __forceinline__ unsigned pk2(float lo, float hi) { unsigned r; asm("v_cvt_pk_bf16_f32 %0, %1, %2" : "=v"(r) : "v"(lo), "v"(hi)); return r; }
__device__ __forceinline__ float bf2f(unsigned b) { return __builtin_bit_cast(float, b << 16); }
__device__ __forceinline__ float bflo(unsigned w) { return __builtin_bit_cast(float, w << 16); }
__device__ __forceinline__ float bfhi(unsigned w) { return __builtin_bit_cast(float, w & 0xffff0000u); }

#define XB_TMO      128
#define XB_XCNT(j)  (256  + 64 * (j))
#define XB_XSUB(j)  (1280 + 64 * (j))
#define XB_XGEN(j)  (2304 + 64 * (j))
#define XB_TOP      3328
#define XB_TOPGEN   3392
#define XCD_BAR_WORDS 3456
#define XB_SPIN_CAP (1u << 18)

__device__ __forceinline__ unsigned xb_ld(unsigned* p)              { return __hip_atomic_load(p, __ATOMIC_RELAXED, __HIP_MEMORY_SCOPE_AGENT); }
__device__ __forceinline__ unsigned xb_add(unsigned* p, unsigned v) { return __hip_atomic_fetch_add(p, v, __ATOMIC_RELAXED, __HIP_MEMORY_SCOPE_AGENT); }
__device__ __forceinline__ unsigned xb_xcc_id() { return (unsigned)__builtin_amdgcn_s_getreg((3 << 11) | 20) & 0xFu; }
#define XB_SPIN(cond, bar) do { unsigned _sp = 0; while (cond) { __builtin_amdgcn_s_sleep(1); \
    if ((++_sp & 255u) == 0u) { if (xb_ld(&(bar)[XB_TMO])) break; if (_sp > XB_SPIN_CAP) { atomicAdd(&(bar)[XB_TMO], 1u); break; } } } } while (0)

struct XcdBarrier { unsigned* bar; unsigned x; volatile LAS unsigned* st; };

__device__ __forceinline__ XcdBarrier xcd_barrier_post(unsigned* bar, volatile LAS unsigned* st) {
    XcdBarrier b; b.bar = bar; b.x = xb_xcc_id(); b.st = st;
    if (threadIdx.x == 0) (void)xb_add(&bar[XB_XCNT(b.x)], 1u);
    return b;
}
__device__ __forceinline__ void xcd_barrier_complete(unsigned* bar, unsigned x, unsigned& nloc, unsigned& nx) {
    const unsigned G = gridDim.x * gridDim.y * gridDim.z;
    unsigned sum, cnt, mine, sp = 0u;
    for (;;) {
        sum = 0u; cnt = 0u; mine = 0u;
#pragma unroll
        for (unsigned j = 0; j < 16; ++j) { const unsigned c = xb_ld(&bar[XB_XCNT(j)]); sum += c; cnt += (c > 0u) ? 1u : 0u; mine = (j == x) ? c : mine; }
        if (sum == G) break;
        __builtin_amdgcn_s_sleep(1);
        if ((++sp & 255u) == 0u) { if (xb_ld(&bar[XB_TMO])) break; if (sp > XB_SPIN_CAP) { atomicAdd(&bar[XB_TMO], 1u); break; } }
    }
    nloc = mine > 0u ? mine : 1u; nx = cnt > 0u ? cnt : 1u;
}
__device__ __forceinline__ void xcd_barrier(const XcdBarrier& b) {
    asm volatile("s_waitcnt vmcnt(0)" ::: "memory");
    __syncthreads();
    if (threadIdx.x == 0) {
        unsigned* bar = b.bar;
        __builtin_amdgcn_s_waitcnt(0);
        unsigned nloc = b.st[0], nx = b.st[1];
        if (nloc == 0u) { xcd_barrier_complete(bar, b.x, nloc, nx); b.st[0] = nloc; b.st[1] = nx; }
        const unsigned old = xb_add(&bar[XB_XSUB(b.x)], 1u);
        const unsigned gen = old / nloc;
        if (old + 1u == (gen + 1u) * nloc) {
            __builtin_amdgcn_fence(__ATOMIC_RELEASE, "agent");
            asm volatile("s_waitcnt vmcnt(0)" ::: "memory");
            const unsigned og = xb_add(&bar[XB_TOP], 1u);
            const unsigned tg = og / nx;
            if (og + 1u == (tg + 1u) * nx) xb_add(&bar[XB_TOPGEN], 1u);
            else XB_SPIN(xb_ld(&bar[XB_TOPGEN]) == tg, bar);
            __builtin_amdgcn_fence(__ATOMIC_ACQUIRE, "agent");
            xb_add(&bar[XB_XGEN(b.x)], 1u);
            asm volatile("s_waitcnt vmcnt(0)" ::: "memory");
        } else {
            XB_SPIN(xb_ld(&bar[XB_XGEN(b.x)]) == gen, bar);
            __builtin_amdgcn_fence(__ATOMIC_ACQUIRE, "agent");
            asm volatile("s_waitcnt vmcnt(0)" ::: "memory");
        }
    }
    __syncthreads();
}

__device__ __forceinline__ float wave_sum(float v) {
#pragma unroll
    for (int o = 1; o < 64; o <<= 1) v += __shfl_xor(v, o);
    return v;
}
__device__ __forceinline__ void p0_transpose_item(const float* W, int ldw, int K, int N, bf16* WT, const float* kscale, bool remap, LAS float* scr, int item, int lane, float f8scale = 0.f, bool upmap = false) {
    const int nblk = N / 64, kb = item / nblk, nb = item % nblk, k0 = 32 * kb, n0 = 64 * nb;
    int sn0 = (remap && n0 >= 1536) ? n0 + 8 : n0;
    if (upmap) { const int within = n0 & 255, pt = n0 >> 8; sn0 = within < 128 ? 128 * pt + within : 2816 + 128 * pt + (within - 128); }
    float v[32];
#pragma unroll
    for (int i = 0; i < 32; ++i) v[i] = W[(size_t)(k0 + i) * ldw + sn0 + lane];
#pragma unroll
    for (int i = 0; i < 32; ++i) { float x = v[i]; if (kscale) x *= kscale[k0 + i]; scr[i * 65 + lane] = x; }
    LDS_WAIT(); asm volatile("" ::: "memory");
    const int kq = lane & 3;
#pragma unroll
    for (int j = 0; j < 4; ++j) { const int n = (lane >> 2) + 16 * j; const LAS float* sp = scr + (8 * kq) * 65 + n;
        if (f8scale != 0.f) { const unsigned lo = pg8::pk4_fp8(sp[0 * 65] * f8scale, sp[1 * 65] * f8scale, sp[2 * 65] * f8scale, sp[3 * 65] * f8scale), hi = pg8::pk4_fp8(sp[4 * 65] * f8scale, sp[5 * 65] * f8scale, sp[6 * 65] * f8scale, sp[7 * 65] * f8scale);
            *(GAS unsigned long long*)((unsigned char*)WT + (size_t)(n0 + n) * K + k0 + 8 * kq) = (unsigned long long)lo | ((unsigned long long)hi << 32); }
        else { v4u o; o.x = pk2(sp[0 * 65], sp[1 * 65]); o.y = pk2(sp[2 * 65], sp[3 * 65]); o.z = pk2(sp[4 * 65], sp[5 * 65]); o.w = pk2(sp[6 * 65], sp[7 * 65]);
            *(GAS v4u*)(WT + (size_t)(n0 + n) * K + k0 + 8 * kq) = o; } }
    LDS_WAIT(); asm volatile("" ::: "memory");
}

struct Args { const float* in[19]; float* out; unsigned char* ws; };
__device__ __forceinline__ float skip_thr(const unsigned* qk8, int moba) {
    const unsigned* p = qk8 + 4 * moba;
    const float qn = sqrtf(__uint_as_float(__hip_atomic_load(p, RLX_AGENT)) + __uint_as_float(__hip_atomic_load(p + 1, RLX_AGENT))), kn = sqrtf(__uint_as_float(__hip_atomic_load(p + 2, RLX_AGENT)) + __uint_as_float(__hip_atomic_load(p + 3, RLX_AGENT)));
    return 2.0f * qn * kn * 1.02f + 40.0f;
}
__device__ __forceinline__ bool moba_skip(int h, int j, int n, float thr) { return __builtin_amdgcn_exp2f(-(float)(h + 1)) * LOG2E * (float)(256 * (j - n - 1) + 1) >= thr; }

namespace attn_body {
using hb16=__hip_bfloat16;
using bf16x8=__attribute__((ext_vector_type(8)))short;
using s16x4=__attribute__((ext_vector_type(4)))short;
using f32x16=__attribute__((ext_vector_type(16)))float;
using u32x4=__attribute__((ext_vector_type(4)))unsigned;
constexpr int PITCH=3072;
constexpr int NW=8,QBLK=32,QB=QBLK*NW,KVBLK=64;
__device__ __forceinline__ int crow(int r,int hi){return (r&3)+8*(r>>2)+4*hi;}
#define SBAR() __builtin_amdgcn_sched_barrier(0)
__device__ __forceinline__ void cmask(f32x16&p0,f32x16&p1,int jb,int qrel,int hi){
  const float NEG=-INFINITY; int kb=64*jb+4*hi;
  #pragma unroll
  for(int r=0;r<16;++r){int kv=kb+(r&3)+8*(r>>2); if(kv>qrel)p0[r]=NEG; if(kv+32>qrel)p1[r]=NEG;}
}
constexpr int NSLOT=3, SLOTB=9216;
constexpr int LDS_K=0, LDS_V=NSLOT*SLOTB, LDS_WS=2*NSLOT*SLOTB, LDS_OST=LDS_WS+NW*64*4, LDS_BYTES=LDS_OST+NW*4096;
__device__ __forceinline__ void glds16(const void*gsrc,unsigned lds_dst){unsigned keep;
  asm volatile("s_mov_b32 %0, m0\n\ts_mov_b32 m0, %2\n\ts_nop 0\n\tglobal_load_lds_dwordx4 %1, off\n\ts_mov_b32 m0, %0":"=&s"(keep):"v"(gsrc),"s"(lds_dst):"memory");}
__device__ __forceinline__ void glds16x(const void*gsrc,unsigned lds_dst){unsigned keep;unsigned long long ex;
  asm volatile("s_mov_b32 %0, m0\n\ts_mov_b64 %1, exec\n\ts_mov_b64 exec, 0xff\n\ts_mov_b32 m0, %3\n\ts_nop 0\n\tglobal_load_lds_dwordx4 %2, off\n\ts_mov_b64 exec, %1\n\ts_mov_b32 m0, %0":"=&s"(keep),"=&s"(ex):"v"(gsrc),"s"(lds_dst):"memory");}
__device__ __forceinline__ float max3f(float a,float b,float c){float r;asm("v_max3_f32 %0, %1, %2, %3":"=v"(r):"v"(a),"v"(b),"v"(c));return r;}
__device__ __forceinline__ float max2f(float a,float b){float r;asm("v_max_f32_e32 %0, %1, %2":"=v"(r):"v"(a),"v"(b));return r;}
__device__ __forceinline__ float fsub_s(float a,float b){float r;asm("v_sub_f32_e32 %0, %1, %2":"=v"(r):"v"(a),"v"(b));return r;}
typedef float f32x2_t __attribute__((ext_vector_type(2))); typedef __bf16 bf16x2_t __attribute__((ext_vector_type(2)));
__device__ __forceinline__ unsigned cvtpk_s(float lo,float hi){f32x2_t v={lo,hi};bf16x2_t b=__builtin_convertvector(v,bf16x2_t);return __builtin_bit_cast(unsigned,b);}
__device__ __forceinline__ float rbf(float x){return __builtin_bit_cast(float,cvtpk_s(x,0.f)<<16);}
#define WAIT_BAR(N) asm volatile("s_waitcnt vmcnt(" #N ") lgkmcnt(0)\n\ts_barrier":::"memory")

__device__ __forceinline__ void qkt(f32x16&p0,f32x16&p1,const char*Kslot,const bf16x8*qr,int r32,int hi){
  const char*kb=Kslot+hi*1024+r32*16; const f32x16 zf={};
  #pragma unroll
  for(int d0=0;d0<4;++d0){
    const bf16x8 b0=*reinterpret_cast<const bf16x8*>(kb+d0*2048);
    const bf16x8 b1=*reinterpret_cast<const bf16x8*>(kb+d0*2048+512);
    if(d0==0){p0=__builtin_amdgcn_mfma_f32_32x32x16_bf16(b0,qr[0],zf,0,0,0);p1=__builtin_amdgcn_mfma_f32_32x32x16_bf16(b1,qr[0],zf,0,0,0);}
    else{p0=__builtin_amdgcn_mfma_f32_32x32x16_bf16(b0,qr[d0],p0,0,0,0);p1=__builtin_amdgcn_mfma_f32_32x32x16_bf16(b1,qr[d0],p1,0,0,0);}}
  const char*kx=Kslot+8192+r32*16;
  const bf16x8 x0=*reinterpret_cast<const bf16x8*>(kx), x1=*reinterpret_cast<const bf16x8*>(kx+512);
  p0=__builtin_amdgcn_mfma_f32_32x32x16_bf16(x0,qr[4],p0,0,0,0);p1=__builtin_amdgcn_mfma_f32_32x32x16_bf16(x1,qr[4],p1,0,0,0);
}
typedef __attribute__((address_space(3))) const char* lds_cptr;
typedef short v4i16_t __attribute__((ext_vector_type(4)));
__device__ __forceinline__ void kload10(bf16x8*kf,lds_cptr kp,lds_cptr kx){
  kf[0]=*(const __attribute__((address_space(3))) bf16x8*)(kp);      kf[1]=*(const __attribute__((address_space(3))) bf16x8*)(kp+512);
  kf[2]=*(const __attribute__((address_space(3))) bf16x8*)(kp+2048); kf[3]=*(const __attribute__((address_space(3))) bf16x8*)(kp+2560);
  kf[4]=*(const __attribute__((address_space(3))) bf16x8*)(kp+4096); kf[5]=*(const __attribute__((address_space(3))) bf16x8*)(kp+4608);
  kf[6]=*(const __attribute__((address_space(3))) bf16x8*)(kp+6144); kf[7]=*(const __attribute__((address_space(3))) bf16x8*)(kp+6656);
  kf[8]=*(const __attribute__((address_space(3))) bf16x8*)(kx);      kf[9]=*(const __attribute__((address_space(3))) bf16x8*)(kx+512);
}
__device__ __forceinline__ void kload2(bf16x8*kf,lds_cptr kp,int j){ kf[2*j]=*(const __attribute__((address_space(3))) bf16x8*)(kp+j*2048); kf[2*j+1]=*(const __attribute__((address_space(3))) bf16x8*)(kp+j*2048+512); }
__device__ __forceinline__ s16x4 vtr(lds_cptr p){ return __builtin_bit_cast(s16x4,__builtin_amdgcn_ds_read_tr16_b64_v4i16((__attribute__((address_space(3))) v4i16_t*)p)); }
__device__ __forceinline__ float rowmax(const f32x16&p0,const f32x16&p1){
  float a=max3f(p0[0],p0[1],p1[0]),b=max3f(p0[2],p0[3],p1[1]);a=max3f(a,p1[2],p1[3]);
  #pragma unroll
  for(int r=4;r<16;r+=4){a=max3f(a,p0[r],p0[r+1]);b=max3f(b,p0[r+2],p0[r+3]);a=max3f(a,p1[r],p1[r+1]);b=max3f(b,p1[r+2],p1[r+3]);}
  const float m=max2f(a,b);
  auto rr=__builtin_amdgcn_permlane32_swap(__float_as_uint(m),__float_as_uint(m),false,false);
  return max2f(__uint_as_float(rr[0]),__uint_as_float(rr[1]));
}
__device__ __forceinline__ void pv(f32x16*o,int vb,bf16x8 pa0,bf16x8 pa1,bf16x8 pa2,bf16x8 pa3){
  #pragma unroll
  for(int d0=0;d0<2;++d0){s16x4 lo[4],hi[4];
    #pragma unroll
    for(int ks=0;ks<4;++ks){
      asm volatile("ds_read_b64_tr_b16 %0,%1 offset:%c2":"=&v"(lo[ks]):"v"(vb),"i"(d0*4096+ks*1024):"memory");
      asm volatile("ds_read_b64_tr_b16 %0,%1 offset:%c2":"=&v"(hi[ks]):"v"(vb),"i"(d0*4096+ks*1024+512):"memory");}
    asm volatile("s_waitcnt lgkmcnt(0)":::"memory");SBAR();
    #define PK(k) (bf16x8){lo[k][0],lo[k][1],lo[k][2],lo[k][3],hi[k][0],hi[k][1],hi[k][2],hi[k][3]}
    o[d0]=__builtin_amdgcn_mfma_f32_32x32x16_bf16(pa0,PK(0),o[d0],0,0,0);
    o[d0]=__builtin_amdgcn_mfma_f32_32x32x16_bf16(pa1,PK(1),o[d0],0,0,0);
    o[d0]=__builtin_amdgcn_mfma_f32_32x32x16_bf16(pa2,PK(2),o[d0],0,0,0);
    o[d0]=__builtin_amdgcn_mfma_f32_32x32x16_bf16(pa3,PK(3),o[d0],0,0,0);
    #undef PK
  }
}

template<int THRL> __device__ __forceinline__ void attn_unit(char*shm,const int KIND,const hb16*Qc,int qrow,int oslot,const hb16*__restrict__ Kt0,const hb16*__restrict__ Vt0,const hb16*__restrict__ KXt0,int NT,int band0,hb16*Oc,hb16*PO,float*PML){
  const int tid=threadIdx.x,lane=tid&63,r32=lane&31,hi=lane>>5; const int wid=__builtin_amdgcn_readfirstlane(tid>>6);
  const unsigned lds0=(unsigned)(uintptr_t)shm;
  float*wsf=(float*)(shm+LDS_WS)+wid*64;
  const hb16*ksrc=Kt0+(long)lane*PITCH+wid*8;
  const hb16*vsrc=Vt0+(long)(16*(wid&3)+(lane>>2))*PITCH+(wid>>2)*32+(lane&3)*8;
  const hb16*xsrc=KXt0+(long)(8*wid+(lane&7))*8;
  const unsigned kdst=lds0+LDS_K+wid*1024, vdst=lds0+LDS_V+wid*1024, xdst=lds0+LDS_K+8192+wid*128;
  #define DMA_K(t,slot) do{ glds16(ksrc+(long)(t)*KVBLK*PITCH,(unsigned)__builtin_amdgcn_readfirstlane(kdst+(slot))); glds16x(xsrc+(long)(t)*KVBLK*8,(unsigned)__builtin_amdgcn_readfirstlane(xdst+(slot))); }while(0)
  #define DMA_V(t,slot) glds16(vsrc+(long)(t)*KVBLK*PITCH,(unsigned)__builtin_amdgcn_readfirstlane(vdst+(slot)))
  const int vb0=(int)(lds0+LDS_V)+((lane>>4)&1)*32+(lane&3)*8+(4*hi+((lane&15)>>2))*64;
  const char*Kbase=shm+LDS_K; bf16x8 kf[10];
  const lds_cptr shm3=(lds_cptr)shm; const lds_cptr kp0=shm3+LDS_K+hi*1024+r32*16; const lds_cptr kx0=shm3+LDS_K+8192+r32*16; const lds_cptr vp0=shm3+LDS_V+((lane>>4)&1)*32+(lane&3)*8+(4*hi+((lane&15)>>2))*64;
  DMA_K(0,0);DMA_V(0,0);DMA_K(1,SLOTB);
  bf16x8 qr[5];
  { const hb16*Qw=Qc+(long)qrow*PITCH;
    #pragma unroll
    for(int d0=0;d0<4;++d0)qr[d0]=*reinterpret_cast<const bf16x8*>(&Qw[d0*16+hi*8]); }
  float mhat=0.f,l_reg=0.f;f32x16 o[2];o[0]=f32x16{};o[1]=f32x16{};
  #define SETQX(mh_,ml_) do{ const unsigned bh_=cvtpk_s(-(mh_),-(ml_)); u32x4 qx_; qx_.x=0x3F803F80u; qx_.y=0x3F80u|(bh_<<16); qx_.z=(bh_>>16); qx_.w=0u; if(hi){qx_.x=0u;qx_.y=0u;qx_.z=0u;} qr[4]=__builtin_bit_cast(bf16x8,qx_); asm volatile("":"+v"(qr[4])); }while(0)
  #define MOVEREF(gain) const float mraw_=mhat+(gain); const float mh_=rbf(mraw_); const float ml_=rbf(mraw_-mh_); const float mnew_=mh_+ml_; const float dl=mnew_-mhat; mhat=mnew_; SETQX(mh_,ml_);
  SETQX(0.f,0.f);
  const int qrel=wid*QBLK+r32;
  #define CMASK(P0,P1,t) do{int jb_=(t)-band0; if(jb_>=0)cmask(P0,P1,jb_,qrel,hi);}while(0)
  bool resc=false;
  #define START(P0,P1) do{ const float rm=rowmax(P0,P1); resc=false; \
    { MOVEREF(rm) \
      _Pragma("unroll") for(int r=0;r<16;++r){P0[r]=fsub_s(P0[r],dl);P1[r]=fsub_s(P1[r],dl);} } \
    _Pragma("unroll") for(int r=0;r<16;++r)P0[r]=__builtin_amdgcn_exp2f(P0[r]); }while(0)
  #define RESC() do{ if(resc){ asm volatile("s_waitcnt lgkmcnt(0)":::"memory"); \
      _Pragma("unroll") for(int d_=0;d_<2;++d_) _Pragma("unroll") for(int r=0;r<16;++r)o[d_][r]*=wsf[crow(r,hi)]; } }while(0)
  f32x16 pA0,pA1,pB0,pB1;
  int sl_prev=0,sl_cur=0,sl_next=SLOTB;
  #define ROT() do{sl_prev=sl_cur;sl_cur=sl_next;sl_next=(sl_next==(NSLOT-1)*SLOTB)?0:sl_next+SLOTB;}while(0)
  DMA_K(2,2*SLOTB);
  WAIT_BAR(5);
  qkt(pA0,pA1,Kbase,qr,r32,hi);asm volatile("s_nop 15\n\ts_nop 7":"+v"(pA0),"+v"(pA1));CMASK(pA0,pA1,0);
  START(pA0,pA1);
  _Pragma("unroll") for(int r=0;r<16;++r)pA1[r]=__builtin_amdgcn_exp2f(pA1[r]);
  WAIT_BAR(0);
  DMA_K(3,0);DMA_V(1,SLOTB);
  ROT();
  kload10(kf,kp0+sl_cur,kx0+sl_cur);
  WAIT_BAR(3);
  s16x4 vlo[8],vhi[8]; u32x4 pw0,pw1,pw2,pw3; const f32x16 zf={};
  #define PKW(P,B) cvtpk_s(P[B],P[B+1])
  #define PAF(k) __builtin_bit_cast(bf16x8,pw##k)
  #define VFR(i) (bf16x8){vlo[i][0],vlo[i][1],vlo[i][2],vlo[i][3],vhi[i][0],vhi[i][1],vhi[i][2],vhi[i][3]}
  #define PIN(x) asm volatile("":"+v"(x))
  #define MX3(a,b,c) __builtin_fmaxf(__builtin_fmaxf((a),(b)),(c))
  #define GAPA(MF,A0,A1,A2,A3,W0,W1,PW) do{ MF; sacc+=A0; sacc+=A1; sacc+=A2; sacc+=A3; PIN(sacc); W0; W1; PIN(PW); SBAR(); }while(0)
  #define EX(v) __builtin_amdgcn_exp2f(v)
  #define GAPB(MF,X,B) do{ MF; X[B]=EX(X[B]); X[B+1]=EX(X[B+1]); X[B+2]=EX(X[B+2]); X[B+3]=EX(X[B+3]); PIN(X); SBAR(); }while(0)
  #define VRD(i) do{ vlo[i]=vtr(vp_+(((i)>>2)*4096+((i)&3)*1024)); vhi[i]=vtr(vp_+(((i)>>2)*4096+((i)&3)*1024+512)); }while(0)
  #define KRD(G,j) do{ if(G){ kload2(kf,kp0+sl_next,j); SBAR(); } }while(0)
  #define KRDX(G) do{ if(G){ kf[8]=*(const __attribute__((address_space(3))) bf16x8*)(kx0+sl_next); kf[9]=*(const __attribute__((address_space(3))) bf16x8*)(kx0+sl_next+512); SBAR(); } }while(0)
  #define STEP(C0,C1,P0,P1,t,GK,GV,GL) do{ SBAR(); \
    const lds_cptr vp_=vp0+sl_prev; \
    VRD(0); SBAR(); float sacc=(P0[0]+P0[1]); \
    GAPA(C0=__builtin_amdgcn_mfma_f32_32x32x16_bf16(kf[0],qr[0],zf,0,0,0), P0[2],P0[3],P0[4],P0[5],     pw0[0]=PKW(P0,0), pw0[1]=PKW(P0,2), pw0); \
    VRD(4); SBAR(); GAPA(C1=__builtin_amdgcn_mfma_f32_32x32x16_bf16(kf[1],qr[0],zf,0,0,0), P0[6],P0[7],P0[8],P0[9],     pw0[2]=PKW(P0,4), pw0[3]=PKW(P0,6), pw0); \
    VRD(1); SBAR(); GAPA(C0=__builtin_amdgcn_mfma_f32_32x32x16_bf16(kf[2],qr[1],C0,0,0,0),   P0[10],P0[11],P0[12],P0[13], pw1[0]=PKW(P0,8), pw1[1]=PKW(P0,10), pw1); \
    VRD(5); SBAR(); GAPA(C1=__builtin_amdgcn_mfma_f32_32x32x16_bf16(kf[3],qr[1],C1,0,0,0),   P0[14],P0[15],P1[0],P1[1],   pw1[2]=PKW(P0,12),pw1[3]=PKW(P0,14), pw1); \
    VRD(2); SBAR(); GAPA(C0=__builtin_amdgcn_mfma_f32_32x32x16_bf16(kf[4],qr[2],C0,0,0,0),   P1[2],P1[3],P1[4],P1[5],     pw2[0]=PKW(P1,0), pw2[1]=PKW(P1,2), pw2); \
    VRD(6); SBAR(); GAPA(C1=__builtin_amdgcn_mfma_f32_32x32x16_bf16(kf[5],qr[2],C1,0,0,0),   P1[6],P1[7],P1[8],P1[9],     pw2[2]=PKW(P1,4), pw2[3]=PKW(P1,6), pw2); \
    VRD(3); SBAR(); GAPA(C0=__builtin_amdgcn_mfma_f32_32x32x16_bf16(kf[6],qr[3],C0,0,0,0),   P1[10],P1[11],P1[12],P1[13], pw3[0]=PKW(P1,8), pw3[1]=PKW(P1,10), pw3); \
    VRD(7); SBAR(); GAPA(C1=__builtin_amdgcn_mfma_f32_32x32x16_bf16(kf[7],qr[3],C1,0,0,0),   P1[14],P1[15],0.f,0.f,       pw3[2]=PKW(P1,12),pw3[3]=PKW(P1,14), pw3); \
    C0=__builtin_amdgcn_mfma_f32_32x32x16_bf16(kf[8],qr[4],C0,0,0,0); SBAR(); \
    C1=__builtin_amdgcn_mfma_f32_32x32x16_bf16(kf[9],qr[4],C1,0,0,0); SBAR(); \
    l_reg+=sacc; \
    if(GK){DMA_K((t)+3,sl_cur);} if(GV){DMA_V((t)+1,sl_next);} \
    CMASK(C0,C1,t); \
    { float a=MX3(C0[0],C0[1],C1[0]),b=MX3(C0[2],C0[3],C1[1]); a=MX3(a,C1[2],C1[3]); \
      _Pragma("unroll") for(int r=4;r<16;r+=4){a=MX3(a,C0[r],C0[r+1]);b=MX3(b,C0[r+2],C0[r+3]);a=MX3(a,C1[r],C1[r+1]);b=MX3(b,C1[r+2],C1[r+3]);} \
      float rm=__builtin_fmaxf(a,b); { auto rr=__builtin_amdgcn_permlane32_swap(__float_as_uint(rm),__float_as_uint(rm),false,false); rm=__builtin_fmaxf(__uint_as_float(rr[0]),__uint_as_float(rr[1])); } \
      resc=false; \
      if(__builtin_expect(__any(rm>(float)THRL),0)){ MOVEREF(__builtin_fmaxf(rm,0.f)) \
        _Pragma("unroll") for(int r=0;r<16;++r){C0[r]-=dl;C1[r]-=dl;} \
        const float f=__builtin_amdgcn_exp2f(-dl); l_reg*=f; if(hi==0)wsf[r32]=f; resc=true; } } \
    SBAR(); \
    GAPB(o[0]=__builtin_amdgcn_mfma_f32_32x32x16_bf16(PAF(0),VFR(0),o[0],0,0,0), C0,0); \
    GAPB(o[1]=__builtin_amdgcn_mfma_f32_32x32x16_bf16(PAF(0),VFR(4),o[1],0,0,0), C0,4); \
    KRD(GL,0); GAPB(o[0]=__builtin_amdgcn_mfma_f32_32x32x16_bf16(PAF(1),VFR(1),o[0],0,0,0), C0,8); \
    KRD(GL,1); GAPB(o[1]=__builtin_amdgcn_mfma_f32_32x32x16_bf16(PAF(1),VFR(5),o[1],0,0,0), C0,12); \
    KRD(GL,2); GAPB(o[0]=__builtin_amdgcn_mfma_f32_32x32x16_bf16(PAF(2),VFR(2),o[0],0,0,0), C1,0); \
    KRD(GL,3); GAPB(o[1]=__builtin_amdgcn_mfma_f32_32x32x16_bf16(PAF(2),VFR(6),o[1],0,0,0), C1,4); \
    KRDX(GL); GAPB(o[0]=__builtin_amdgcn_mfma_f32_32x32x16_bf16(PAF(3),VFR(3),o[0],0,0,0), C1,8); \
    GAPB(o[1]=__builtin_amdgcn_mfma_f32_32x32x16_bf16(PAF(3),VFR(7),o[1],0,0,0), C1,12); \
    }while(0)
  int t=1;
  for(;t+5<NT&&t+1<band0;t+=2){
    #undef CMASK
    #define CMASK(P0,P1,t) do{}while(0)
    STEP(pB0,pB1,pA0,pA1,t,true,true,true);     WAIT_BAR(3); RESC(); ROT();
    STEP(pA0,pA1,pB0,pB1,t+1,true,true,true);   WAIT_BAR(3); RESC(); ROT();
  }
  #undef CMASK
  #define CMASK(P0,P1,t) do{int jb_=(t)-band0; if(jb_>=0)cmask(P0,P1,jb_,qrel,hi);}while(0)
  #define ENDW(tt) do{ if((tt)+3<NT){WAIT_BAR(3);} else if((tt)+2<NT){WAIT_BAR(1);} else {WAIT_BAR(0);} }while(0)
  for(;t+1<NT;t+=2){
    STEP(pB0,pB1,pA0,pA1,t,(t+3<NT),(t+1<NT),(t+1<NT));       ENDW(t);   RESC(); ROT();
    STEP(pA0,pA1,pB0,pB1,t+1,(t+4<NT),(t+2<NT),(t+2<NT));     ENDW(t+1); RESC(); ROT();
  }
  STEP(pB0,pB1,pA0,pA1,NT-1,false,false,false); RESC();
  { float sacc=pB0[0]+pB0[1]; _Pragma("unroll") for(int r=2;r<16;++r)sacc+=pB0[r]; _Pragma("unroll") for(int r=0;r<16;++r)sacc+=pB1[r]; l_reg+=sacc;
    pw0=(u32x4){PKW(pB0,0),PKW(pB0,2),PKW(pB0,4),PKW(pB0,6)};pw1=(u32x4){PKW(pB0,8),PKW(pB0,10),PKW(pB0,12),PKW(pB0,14)};pw2=(u32x4){PKW(pB1,0),PKW(pB1,2),PKW(pB1,4),PKW(pB1,6)};pw3=(u32x4){PKW(pB1,8),PKW(pB1,10),PKW(pB1,12),PKW(pB1,14)};
    SBAR(); pv(o,vb0+sl_cur,PAF(0),PAF(1),PAF(2),PAF(3)); }
  #undef PKW
  #undef PAF
  #undef VFR
  #undef PIN
  #undef MX3
  #undef GAPA
  #undef GAPB
  #undef EX
  #undef VRD
  #undef KRD
  #undef KRDX
  #undef STEP
  #undef ENDW
  {auto rr=__builtin_amdgcn_permlane32_swap(__float_as_uint(l_reg),__float_as_uint(l_reg),false,false);l_reg=__uint_as_float(rr[0])+__uint_as_float(rr[1]);}
  if(hi==0)wsf[32+r32]=l_reg;asm volatile("s_waitcnt lgkmcnt(0)":::"memory");
  float rli[16];
  #pragma unroll
  for(int r=0;r<16;++r)rli[r]=__builtin_amdgcn_rcpf(wsf[32+crow(r,hi)]);
  if(KIND==1){ if(hi==0&&oslot>=0){ f32x2_t ml={mhat,l_reg}; *(f32x2_t*)(PML+(long)oslot*2)=ml; } }
  { hb16*stg=(hb16*)(shm+LDS_OST)+wid*2048;
    #pragma unroll
    for(int r=0;r<16;++r){const int orow=crow(r,hi);
      #pragma unroll
      for(int d0=0;d0<2;++d0)stg[orow*64+d0*32+r32]=__float2bfloat16(o[d0][r]*rli[r]);}
    asm volatile("s_waitcnt lgkmcnt(0)":::"memory");
    #pragma unroll
    for(int i=0;i<4;++i){const int row=i*8+(lane>>3),ch=lane&7; const u32x4 v=*(const u32x4*)(stg+row*64+ch*8);
      if(KIND==0){ const int gr=__shfl(qrow,row); *(u32x4*)(Oc+(long)gr*PITCH+ch*8)=v; }
      else { const int gs=__shfl(oslot,row); if(gs>=0) *(u32x4*)(PO+(long)gs*64+ch*8)=v; } } }
  asm volatile("s_waitcnt lgkmcnt(0)\n\ts_barrier":::"memory");
  #undef DMA_K
  #undef DMA_V
  #undef CMASK
  #undef START
  #undef RESC
  #undef ROT
  #undef SETQX
  #undef MOVEREF
}
constexpr int MB_K=0, MB_V=4*SLOTB, MB_WS=MB_V+4*8192, MB_OST=MB_WS+NW*64*4, MB_BYTES=MB_OST+NW*4096;
template<int THRL> __device__ __forceinline__ void moba_item(char*shm,const hb16*Qc,const int browbase,const int h,const int nblk,const unsigned*lst,const int cnt,const int g0,const int g1,
    const hb16*Kt0,const hb16*KXt0,hb16*PO,float*PML){
  const int tid=threadIdx.x,lane=tid&63,r32=lane&31,hi=lane>>5; const int wid=__builtin_amdgcn_readfirstlane(tid>>6);
  const unsigned lds0=(unsigned)(uintptr_t)shm;
  float*wsf=(float*)(shm+MB_WS)+wid*64;
  asm volatile("s_waitcnt lgkmcnt(0)\n\ts_barrier":::"memory");
  { const hb16*ksrc=Kt0+(long)lane*PITCH+wid*8; const hb16*vsrc=Kt0+512+(long)(16*(wid&3)+(lane>>2))*PITCH+(wid>>2)*32+(lane&3)*8; const hb16*xsrc=KXt0+(long)(8*wid+(lane&7))*8;
    #pragma unroll
    for(int t=0;t<4;++t){ glds16(ksrc+(long)t*KVBLK*PITCH,(unsigned)__builtin_amdgcn_readfirstlane(lds0+MB_K+t*SLOTB+wid*1024)); glds16x(xsrc+(long)t*KVBLK*8,(unsigned)__builtin_amdgcn_readfirstlane(lds0+MB_K+t*SLOTB+8192+wid*128));
      glds16(vsrc+(long)t*KVBLK*PITCH,(unsigned)__builtin_amdgcn_readfirstlane(lds0+MB_V+t*8192+wid*1024)); } }
  asm volatile("s_waitcnt vmcnt(0)\n\ts_barrier":::"memory");
  const int vb0=(int)(lds0+MB_V)+((lane>>4)&1)*32+(lane&3)*8+(4*hi+((lane&15)>>2))*64;
  #define SETQX(mh_,ml_) do{ const unsigned bh_=cvtpk_s(-(mh_),-(ml_)); u32x4 qx_; qx_.x=0x3F803F80u; qx_.y=0x3F80u|(bh_<<16); qx_.z=(bh_>>16); qx_.w=0u; if(hi){qx_.x=0u;qx_.y=0u;qx_.z=0u;} qr[4]=__builtin_bit_cast(bf16x8,qx_); asm volatile("":"+v"(qr[4])); }while(0)
  #define MOVEREF(gain) const float mraw_=mhat+(gain); const float mh_=rbf(mraw_); const float ml_=rbf(mraw_-mh_); const float mnew_=mh_+ml_; const float dl=mnew_-mhat; mhat=mnew_; SETQX(mh_,ml_);
  #define LENT(gg) (((gg)>=8&&(gg)<g1)?lst[((gg)-8)*32+r32]:0u)
  #define GROW(gg,ee) (((gg)<8)?(browbase+nblk*256+(gg)*32+r32):(browbase+(int)((ee)&0x1fffu)))
  unsigned e_cur=LENT(g0+wid), e_nxt=LENT(g0+wid+NW);
  bf16x8 qn[4];
  { const hb16*Qw=Qc+(long)GROW(g0+wid,e_cur)*PITCH;
    #pragma unroll
    for(int d0=0;d0<4;++d0)qn[d0]=*reinterpret_cast<const bf16x8*>(&Qw[d0*16+hi*8]); }
  for(int g=g0+wid;g<g1;g+=NW){
    const bool own=g<8; const int qrow=GROW(g,e_cur); int oslot;
    if(own) oslot=(qrow*8+h)*4+3; else oslot=((g-8)*32+r32<cnt)?(qrow*8+h)*4+(int)((e_cur>>16)&3u):-1;
    bf16x8 qr[5];
    #pragma unroll
    for(int d0=0;d0<4;++d0)qr[d0]=qn[d0];
    { const int gn=(g+NW<g1)?g+NW:g; const unsigned en=(g+NW<g1)?e_nxt:e_cur; const hb16*Qw=Qc+(long)GROW(gn,en)*PITCH;
      #pragma unroll
      for(int d0=0;d0<4;++d0)qn[d0]=*reinterpret_cast<const bf16x8*>(&Qw[d0*16+hi*8]); }
    const unsigned e_n2=LENT(g+2*NW); e_cur=e_nxt; e_nxt=e_n2;
    float mhat=0.f,l_reg=0.f;f32x16 o[2];o[0]=f32x16{};o[1]=f32x16{};
    SETQX(0.f,0.f);
    const int tlast=own?((32*g+31)>>6):3;
    #define PKW(P,B) cvtpk_s(P[B],P[B+1])
    #define PROC(P0,P1,T_,ISFIRST,MREF_) do{ \
      if(own&&64*(T_)+63>32*g)cmask(P0,P1,(T_),32*g+r32,hi);   \
      const float adj_=mhat-(MREF_); const float rm=rowmax(P0,P1)-adj_; float sub_=adj_; \
      if(ISFIRST){ MOVEREF(rm) sub_+=dl; } \
      else if(__any(rm>(float)THRL)){ MOVEREF(__builtin_fmaxf(rm,0.f)) sub_+=dl; \
        const float f=__builtin_amdgcn_exp2f(-dl); l_reg*=f; if(hi==0)wsf[r32]=f; asm volatile("s_waitcnt lgkmcnt(0)":::"memory"); \
        _Pragma("unroll") for(int d_=0;d_<2;++d_) _Pragma("unroll") for(int r=0;r<16;++r)o[d_][r]*=wsf[crow(r,hi)]; } \
      float sacc=0.f; \
      _Pragma("unroll") for(int r=0;r<16;++r){P0[r]=__builtin_amdgcn_exp2f(P0[r]-sub_);P1[r]=__builtin_amdgcn_exp2f(P1[r]-sub_);sacc+=P0[r]+P1[r];} \
      l_reg+=sacc; \
      const u32x4 pw0=(u32x4){PKW(P0,0),PKW(P0,2),PKW(P0,4),PKW(P0,6)},pw1=(u32x4){PKW(P0,8),PKW(P0,10),PKW(P0,12),PKW(P0,14)},pw2=(u32x4){PKW(P1,0),PKW(P1,2),PKW(P1,4),PKW(P1,6)},pw3=(u32x4){PKW(P1,8),PKW(P1,10),PKW(P1,12),PKW(P1,14)}; \
      pv(o,vb0+(T_)*8192,__builtin_bit_cast(bf16x8,pw0),__builtin_bit_cast(bf16x8,pw1),__builtin_bit_cast(bf16x8,pw2),__builtin_bit_cast(bf16x8,pw3)); }while(0)
    int t=0;
    for(;t+1<=tlast;t+=2){
      f32x16 a0,a1,b0,b1; const float mref=mhat;
      qkt(a0,a1,shm+MB_K+t*SLOTB,qr,r32,hi); qkt(b0,b1,shm+MB_K+(t+1)*SLOTB,qr,r32,hi);
      asm volatile("s_nop 15\n\ts_nop 7":"+v"(a0),"+v"(a1));
      PROC(a0,a1,t,t==0,mref);
      asm volatile("s_nop 7":"+v"(b0),"+v"(b1));
      PROC(b0,b1,t+1,false,mref);
    }
    if(t<=tlast){ f32x16 a0,a1; const float mref=mhat;
      qkt(a0,a1,shm+MB_K+t*SLOTB,qr,r32,hi); asm volatile("s_nop 15\n\ts_nop 7":"+v"(a0),"+v"(a1));
      PROC(a0,a1,t,t==0,mref); }
    #undef PROC
    #undef PKW
    {auto rr=__builtin_amdgcn_permlane32_swap(__float_as_uint(l_reg),__float_as_uint(l_reg),false,false);l_reg=__uint_as_float(rr[0])+__uint_as_float(rr[1]);}
    if(hi==0)wsf[32+r32]=l_reg;asm volatile("s_waitcnt lgkmcnt(0)":::"memory");
    float rli[16];
    #pragma unroll
    for(int r=0;r<16;++r)rli[r]=__builtin_amdgcn_rcpf(wsf[32+crow(r,hi)]);
    if(hi==0&&oslot>=0){ f32x2_t ml={mhat,l_reg}; *(f32x2_t*)(PML+(long)oslot*2)=ml; }
    { hb16*stg=(hb16*)(shm+MB_OST)+wid*2048;
      #pragma unroll
      for(int r=0;r<16;++r){const int orow=crow(r,hi);
        #pragma unroll
        for(int d0=0;d0<2;++d0)stg[orow*64+d0*32+r32]=__float2bfloat16(o[d0][r]*rli[r]);}
      asm volatile("s_waitcnt lgkmcnt(0)":::"memory");
      #pragma unroll
      for(int i=0;i<4;++i){const int row=i*8+(lane>>3),ch=lane&7; const u32x4 v=*(const u32x4*)(stg+row*64+ch*8);
        const int gs=__shfl(oslot,row); if(gs>=0) *(u32x4*)(PO+(long)gs*64+ch*8)=v; }
      asm volatile("s_waitcnt lgkmcnt(0)":::"memory"); }
  }
  #undef SETQX
  #undef MOVEREF
  #undef LENT
  #undef GROW
}
constexpr int ATTN_LDS_BYTES=(LDS_BYTES>MB_BYTES?LDS_BYTES:MB_BYTES);
#undef SBAR
#undef WAIT_BAR
}

struct WqkOrder {
    int G, c;
    __device__ __forceinline__ bool next(int i, pg8::Unit& u) const { const int L = i * G + c; if (L >= 128) return false; const int z = L >> 2, pn = L & 3, b = z >> 2, h = z & 3;
        u.skipb1 = 0; u.pm = b * 4 + h; u.pn = pn; u.aoff = ((size_t)(b * 256) * 2048 + h * 256) * 2; u.boff = ((size_t)(pn * 256) * 1024 + h * 256) * 2; return true; }
};
struct VwoOrder {
    int G, c;
    __device__ __forceinline__ bool next(int i, pg8::Unit& u) const { const int L = i * G + c; if (L >= 128) return false; const int z = L >> 2, pmq = L & 3, b = z >> 2, h = z & 3;
        u.skipb1 = 0; u.pm = b * 4 + pmq; u.pn = h; u.aoff = ((size_t)(pmq * 256) * 1024 + h * 256) * 2; u.boff = ((size_t)(b * 256) * 2048 + 1024 + h * 256) * 2; return true; }
};

#define DECL_PTRS const __attribute__((address_space(4))) Args* KA_; { auto p_ = __builtin_amdgcn_kernarg_segment_ptr(); asm volatile("" : "+s"(p_)); KA_ = (const __attribute__((address_space(4))) Args*)p_; } \
    int tidp_ = threadIdx.x; asm volatile("" : "+v"(tidp_)); const int tid = tidp_, lane = tid & 63; (void)lane; \
    unsigned char* ws = KA_->ws; gu32* ctl = (gu32*)(ws + WS_CTL); const float* x = KA_->in[0]; const float* mem = KA_->in[1]; const float* g_mix = KA_->in[2]; const float* w_in = KA_->in[3]; const float* b_forget = KA_->in[4]; const float* g_fox = KA_->in[5]; const float* g_moba = KA_->in[6]; const float* w_out = KA_->in[7]; const float* g_cross = KA_->in[8]; const float* g_mem = KA_->in[9]; const float* w_q_mem = KA_->in[10]; const float* w_kv_mem = KA_->in[11]; const float* w_o_mem = KA_->in[12]; const float* g_ffn = KA_->in[13]; const float* w_up = KA_->in[14]; const float* conv_w = KA_->in[15]; const float* conv_b = KA_->in[16]; const float* w_down = KA_->in[17]; const float* g_final = KA_->in[18]; float* out = KA_->out; float* LOGF = (float*)(ws + WS_LOGF); float* CC = (float*)(ws + WS_C); float* ABAR = (float*)(ws + WS_ABAR); float* KM = (float*)(ws + WS_KM); unsigned* SEL = (unsigned*)(ws + WS_SEL); float* SSQ1 = (float*)(ws + WS_SSQ1); float* SSQ2 = (float*)(ws + WS_SSQ2); float* SSQ3 = (float*)(ws + WS_SSQ3); bf16* MEMN = (bf16*)(ws + WS_MEMN); bf16* KV = (bf16*)(ws + WS_KV); bf16* WQS = (bf16*)(ws + WS_WQS); bf16* WOT = (bf16*)(ws + WS_WOT); bf16* WKVT = (bf16*)(ws + WS_WKVT); bf16* WINT = (bf16*)(ws + WS_WINT); bf16* WOUTT = (bf16*)(ws + WS_WOUTT); bf16* WUPT = (bf16*)(ws + WS_WUPT); unsigned char* WDT = ws + WS_WDT; unsigned char* ACT8 = ws + WS_ACT8; float* GHB = (float*)(ws + WS_GH); float* UHB = (float*)(ws + WS_UH); float* GTB = (float*)(ws + WS_GT); bf16* ZT = (bf16*)(ws + WS_ZT); bf16* WQK = (bf16*)(ws + WS_WQK); bf16* VWO = (bf16*)(ws + WS_VWO); bf16* A1 = (bf16*)(ws + WS_A1); bf16* QKV = (bf16*)(ws + WS_QKV); bf16* Y = (bf16*)(ws + WS_Y); bf16* HB1 = (bf16*)(ws + WS_HB1); bf16* PB = (bf16*)(ws + WS_P); bf16* HB2 = (bf16*)(ws + WS_HB2); bf16* GB = (bf16*)(ws + WS_G); bf16* UB = (bf16*)(ws + WS_U); bf16* PO = (bf16*)(ws + WS_PO); unsigned* LIST = (unsigned*)(ws + WS_LIST); float* PML = (float*)(ws + WS_PML); bf16* KXF = (bf16*)(ws + WS_KXF); bf16* KXM = (bf16*)(ws + WS_KXM); unsigned* CNT = (unsigned*)(ws + WS_CNT);
__global__ void __launch_bounds__(NWAVES * 64, 2) fwd(Args args) {
    extern __shared__ __attribute__((aligned(16))) unsigned char lds[];
    LAS unsigned char* L = (LAS unsigned char*)lds;
    LAS unsigned char* XL = L + XL_OFF;
    volatile LAS unsigned* MISC = (volatile LAS unsigned*)(L + MISC_OFF);
    const int tid = threadIdx.x, lane = tid & 63, wave = __builtin_amdgcn_readfirstlane(tid >> 6);
    const int G = gridDim.x, bx = blockIdx.x;
    const int gw = bx * NWAVES + wave, NGW = G * NWAVES;
    for (int u = tid; u < (LDS_BYTES - LDSCTL_OFF) / 4; u += NWAVES * 64) ((LAS unsigned*)(L + LDSCTL_OFF))[u] = 0u;
    __syncthreads();
    XcdBarrier bar; { DECL_PTRS; bar = xcd_barrier_post((unsigned*)(ctl + CW_BAR), MISC + 8); }

    { DECL_PTRS;
        LAS float* scr = (LAS float*)(L + RING_OFF + wave * 16384);
        constexpr int I_IN = (D / 32) * (NQKV / 64), I_OUT = (D / 32) * (D / 64), I_KV = (D / 32) * (2048 / 64), I_O = I_OUT, I_UP = (D / 32) * (2 * FF / 64), I_DN = (FF / 32) * (D / 64);
        constexpr int NITEMS = I_IN + I_OUT + I_KV + I_O + I_UP + I_DN;
        for (int it = gw; it < NITEMS; it += NGW) {
            int r = it;
            if (r < I_IN) { p0_transpose_item(w_in, INC, D, NQKV, WINT, nullptr, true, scr, r, lane); continue; } r -= I_IN;
            if (r < I_OUT) { p0_transpose_item(w_out, D, D, D, WOUTT, nullptr, false, scr, r, lane); continue; } r -= I_OUT;
            if (r < I_KV) { p0_transpose_item(w_kv_mem, 2048, D, 2048, WKVT, nullptr, false, scr, r, lane); continue; } r -= I_KV;
            if (r < I_O) { p0_transpose_item(w_o_mem, D, D, D, WOT, nullptr, false, scr, r, lane); continue; } r -= I_O;
            if (r < I_UP) { p0_transpose_item(w_up, 2 * FF, D, 2 * FF, WUPT, g_ffn, false, scr, r, lane, 0.f, true); continue; } r -= I_UP;
            p0_transpose_item(w_down, D, FF, D, (bf16*)WDT, nullptr, false, scr, r, lane, 64.0f);
        }
        for (int i = bx * 512 + tid; i < D * D / 4; i += G * 512) { const int kk = (i * 4) >> 10; const f32x4 v = *(const f32x4*)(w_q_mem + (size_t)i * 4) * (g_cross[kk] * (LOG2E / 16.0f));
            *(unsigned long long*)(WQS + (size_t)i * 4) = (unsigned long long)pk2(v[0], v[1]) | ((unsigned long long)pk2(v[2], v[3]) << 32); }
        for (int r = gw; r < NB * 256; r += NGW) { const GAS f32x4* xr = (const GAS f32x4*)(mem + (size_t)r * D) + lane; f32x4 v[4]; float s = 0.f;
#pragma unroll
            for (int j = 0; j < 4; ++j) { v[j] = xr[64 * j]; s += (v[j][0] * v[j][0] + v[j][1] * v[j][1]) + (v[j][2] * v[j][2] + v[j][3] * v[j][3]); }
            const float rs = __builtin_amdgcn_rsqf(wave_sum(s) * (1.f / D) + RMS_EPS);
            GAS unsigned long long* o8 = (GAS unsigned long long*)(MEMN + (size_t)r * D) + lane;
#pragma unroll
            for (int j = 0; j < 4; ++j) { const f32x4 gg = *((const f32x4*)g_mem + 64 * j + lane); const f32x4 a = v[j] * rs * gg; o8[64 * j] = (unsigned long long)pk2(a[0], a[1]) | ((unsigned long long)pk2(a[2], a[3]) << 32); } }
        __syncthreads();
        LAS float* part = (LAS float*)(L + RING_OFF + 32768);
        LAS float* wf = (LAS float*)(L + RING_OFF);
        for (int i = tid; i < 8 * 1024; i += 512) { const int h = i >> 10, kk = i & 1023; wf[i] = w_in[(size_t)kk * INC + C_F + h]; }
        __syncthreads();
        f32x4 gm[4];
#pragma unroll
        for (int j = 0; j < 4; ++j) gm[j] = *((const f32x4*)g_mix + 64 * j + lane);
        for (int blk = bx; blk < M / 256; blk += G) {
            f32x4 accm[4];
#pragma unroll
            for (int j = 0; j < 4; ++j) accm[j] = (f32x4){0.f, 0.f, 0.f, 0.f};
            f32x4 vn[2][4];
#pragma unroll
            for (int rr = 0; rr < 2; ++rr) { const GAS f32x4* xr = (const GAS f32x4*)(x + ((size_t)blk * 256 + wave * 32 + rr) * D) + lane;
#pragma unroll
                for (int j = 0; j < 4; ++j) vn[rr][j] = xr[64 * j]; }
            for (int i0 = 0; i0 < 32; i0 += 2) {
              f32x4 vv[2][4];
#pragma unroll
              for (int rr = 0; rr < 2; ++rr)
#pragma unroll
                  for (int j = 0; j < 4; ++j) vv[rr][j] = vn[rr][j];
              { const int inx = i0 + 2 < 32 ? i0 + 2 : i0;
#pragma unroll
                for (int rr = 0; rr < 2; ++rr) { const GAS f32x4* xr = (const GAS f32x4*)(x + ((size_t)blk * 256 + wave * 32 + inx + rr) * D) + lane;
#pragma unroll
                    for (int j = 0; j < 4; ++j) vn[rr][j] = xr[64 * j]; } }
#pragma unroll
              for (int rr = 0; rr < 2; ++rr) {
                const size_t r = (size_t)blk * 256 + wave * 32 + i0 + rr;
                f32x4 v[4]; float s = 0.f;
#pragma unroll
                for (int j = 0; j < 4; ++j) { v[j] = vv[rr][j]; s += (v[j][0] * v[j][0] + v[j][1] * v[j][1]) + (v[j][2] * v[j][2] + v[j][3] * v[j][3]); }
                const float rs = __builtin_amdgcn_rsqf(wave_sum(s) * (1.f / D) + RMS_EPS);
                GAS unsigned long long* o8 = (GAS unsigned long long*)(A1 + r * 2048) + lane;
                float fl[8];
#pragma unroll
                for (int h = 0; h < 8; ++h) fl[h] = 0.f;
#pragma unroll
                for (int j = 0; j < 4; ++j) { const f32x4 a = v[j] * rs * gm[j]; accm[j] += a;
                    const unsigned h0 = pk2(a[0], a[1]), h1 = pk2(a[2], a[3]);
                    o8[64 * j] = (unsigned long long)h0 | ((unsigned long long)h1 << 32);
                    const unsigned l0 = pk2(a[0] - bflo(h0), a[1] - bfhi(h0)), l1 = pk2(a[2] - bflo(h1), a[3] - bfhi(h1));
                    o8[256 + 64 * j] = (unsigned long long)l0 | ((unsigned long long)l1 << 32);
#pragma unroll
                    for (int h = 0; h < 8; ++h) { const f32x4 w = *((const LAS f32x4*)(wf + h * 1024) + 64 * j + lane); fl[h] += (a[0] * w[0] + a[1] * w[1]) + (a[2] * w[2] + a[3] * w[3]); } }
                float t4[4], t2[2], z;
                { const bool up = (lane & 32) != 0;
#pragma unroll
                  for (int k = 0; k < 4; ++k) { const float snd = up ? fl[k] : fl[k + 4]; const float rcv = __shfl_xor(snd, 32); t4[k] = (up ? fl[k + 4] : fl[k]) + rcv; } }
                { const bool up = (lane & 16) != 0;
#pragma unroll
                  for (int k = 0; k < 2; ++k) { const float snd = up ? t4[k] : t4[k + 2]; const float rcv = __shfl_xor(snd, 16); t2[k] = (up ? t4[k + 2] : t4[k]) + rcv; } }
                { const bool up = (lane & 8) != 0; const float snd = up ? t2[0] : t2[1]; const float rcv = __shfl_xor(snd, 8); z = (up ? t2[1] : t2[0]) + rcv; }
                z += __shfl_xor(z, 1); z += __shfl_xor(z, 2); z += __shfl_xor(z, 4);
                if ((lane & 7) == 0) { const int hh = 4 * (lane >> 5) + 2 * ((lane >> 4) & 1) + ((lane >> 3) & 1);
                    z += b_forget[hh];
                    LOGF[r * 8 + hh] = fminf(z, 0.f) - log1pf(__expf(-fabsf(z))); }
              }
            }
#pragma unroll
            for (int j = 0; j < 4; ++j) *((LAS f32x4*)(part + wave * 1024) + 64 * j + lane) = accm[j];
            __syncthreads();
            for (int col = tid; col < 1024; col += 512) { float s = 0.f;
#pragma unroll
                for (int w = 0; w < 8; ++w) s += part[w * 1024 + col];
                ABAR[(size_t)blk * 1024 + col] = s * (1.0f / 256.0f); }
            __syncthreads();
        }
    }
    xcd_barrier(bar);

#define WG_SIGNAL(word) do { asm volatile("s_waitcnt vmcnt(0)" ::: "memory"); __syncthreads(); if (tid == 0) { __builtin_amdgcn_fence(__ATOMIC_RELEASE, "agent"); asm volatile("s_waitcnt vmcnt(0)" ::: "memory"); \
        __hip_atomic_fetch_add((unsigned*)(ctl + (word)), 1u, RLX_AGENT); } } while (0)
#define WG_WAIT(word, n) do { if (tid == 0) { unsigned sp_ = 0u; while (__hip_atomic_load((unsigned*)(ctl + (word)), RLX_AGENT) < (unsigned)(n)) { __builtin_amdgcn_s_sleep(2); if (++sp_ > (1u << 22)) break; } } \
        __syncthreads(); __builtin_amdgcn_fence(__ATOMIC_ACQUIRE, "agent"); asm volatile("s_waitcnt vmcnt(0)" ::: "memory"); } while (0)
    { DECL_PTRS;
        LAS float* sc = (LAS float*)(L + RING_OFF);
        for (int w = bx; w < 64; w += G) {
            const int ib = w >> 3, jb = w & 7, r = tid >> 4, cq = tid & 15; LAS float* As = sc; LAS float* Bs = sc + 32 * 33;
            f32x4 acc = (f32x4){0.f, 0.f, 0.f, 0.f};
            for (int k0 = 0; k0 < 1024; k0 += 32) {
                { const int idx = tid * 2, row = idx >> 5, kk = idx & 31; const pg8::f32x2 a2 = *(const pg8::f32x2*)(ABAR + (size_t)(ib * 32 + row) * 1024 + k0 + kk); As[row * 33 + kk] = a2.x; As[row * 33 + kk + 1] = a2.y; }
                { const int idx = tid * 4, kk = idx >> 6, c = idx & 63; *(LAS f32x4*)(Bs + kk * 64 + c) = *(const f32x4*)(w_in + (size_t)(k0 + kk) * INC + C_KM + jb * 64 + c); }
                __syncthreads();
#pragma unroll 8
                for (int kk = 0; kk < 32; ++kk) acc += *(const LAS f32x4*)(Bs + kk * 64 + cq * 4) * As[r * 33 + kk];
                __syncthreads();
            }
            *(f32x4*)(KM + (size_t)(ib * 32 + r) * 512 + jb * 64 + cq * 4) = acc;
            WG_SIGNAL(CW_CNT_KM);
        }
        for (int w = (bx + G - 64) % G; w < 64; w += G) {
            const int b = w >> 3, h = w & 7; float v[16]; float run = 0.f;
#pragma unroll
            for (int i = 0; i < 16; ++i) { run += LOGF[((size_t)b * T + tid * 16 + i) * 8 + h]; v[i] = run; }
            float incl = run;
#pragma unroll
            for (int o = 1; o < 64; o <<= 1) { const float n = __shfl_up(incl, o); if (lane >= o) incl += n; }
            if (lane == 63) sc[wave] = incl;
            __syncthreads();
            float pre = incl - run;
            for (int ww = 0; ww < wave; ++ww) pre += sc[ww];
#pragma unroll
            for (int i = 0; i < 16; ++i) { const float cv = pre + v[i]; const size_t e = (size_t)w * T + tid * 16 + i; CC[e] = cv;
                const float bv = -cv * LOG2E; const unsigned h0 = f2bf(bv); const float r1 = bv - bf2f(h0); const unsigned h1 = f2bf(r1); const unsigned h2 = f2bf(r1 - bf2f(h1));
                *(v4u*)(KXF + e * 8) = (v4u){h0 | (h1 << 16), h2 | (0x3F80u << 16), 0x3F80u, 0u}; }
            if (w == 0) for (int j = tid; j < 8 * 256; j += 512) { const float bv = __builtin_amdgcn_exp2f(-(float)((j >> 8) + 1)) * LOG2E * (float)(j & 255);
                const unsigned h0 = f2bf(bv); const float r1 = bv - bf2f(h0); const unsigned h1 = f2bf(r1); const unsigned h2 = f2bf(r1 - bf2f(h1));
                *(v4u*)(KXM + (size_t)j * 8) = (v4u){h0 | (h1 << 16), h2 | (0x3F80u << 16), 0x3F80u, 0u}; }
            __syncthreads();
        }
        { const int ckv = (bx + G - 128) % G;
          pg8::Gemm g{MEMN, WKVT, D / 64, D * 2, D * 2, 0xffffffffu}; pg8::TileOrder S; S.init(NB * 256, 2048, G, ckv, D * 2, D * 2, 0, 1 << 30);
          pg8::EpiBf16 E{KV, 2048, 0u, 1.f, nullptr};
          pg8::gemm_phase<pg8::EpiBf16, pg8::TileOrder, true>(L + RING_OFF, XL, g, S, E);
          for (int Lk = ckv; Lk < 64; Lk += G) WG_SIGNAL(CW_CNT_KV); }
        if (bx < 64) WG_WAIT(CW_CNT_KM, 64);
        for (int w = bx; w < 64; w += G) {
            const int h = w >> 3, kq = w & 7, kk = kq * 128 + (tid & 127), ng = tid >> 7;
            for (int i = tid; i < 256 * 16; i += 512) { const int n = i >> 4, c4 = (i & 15) * 4; *(LAS f32x4*)(sc + n * 64 + c4) = *(const f32x4*)(KM + (size_t)n * 512 + h * 64 + c4); }
            f32x4 wq[16];
#pragma unroll
            for (int c = 0; c < 16; ++c) wq[c] = *(const f32x4*)(w_in + (size_t)kk * INC + C_QM + h * 64 + c * 4);
            __syncthreads();
            for (int i = 0; i < 64; ++i) { const int n = ng * 64 + i; const LAS f32x4* kp = (const LAS f32x4*)(sc + n * 64); float s0 = 0.f, s1 = 0.f;
#pragma unroll
                for (int c = 0; c < 16; c += 2) { const f32x4 ka = kp[c], kb = kp[c + 1];
                    s0 += (wq[c][0] * ka[0] + wq[c][1] * ka[1]) + (wq[c][2] * ka[2] + wq[c][3] * ka[3]); s1 += (wq[c + 1][0] * kb[0] + wq[c + 1][1] * kb[1]) + (wq[c + 1][2] * kb[2] + wq[c + 1][3] * kb[3]); }
                const float sv = s0 + s1; const unsigned hi = f2bf(sv); const unsigned lo = f2bf(sv - bf2f(hi));
                bf16* zr = ZT + ((size_t)(n >> 5) * 256 + 128 * ((n & 31) >> 4) + 32 * (h >> 1) + 16 * (h & 1) + (n & 15)) * 3072;     zr[kk] = (bf16)hi; zr[1024 + kk] = (bf16)hi; zr[2048 + kk] = (bf16)lo; }
            WG_SIGNAL(CW_CNT_Z);
        }
        { const int ckv = (bx + G - 128) % G;
          if (ckv < 64) WG_WAIT(CW_CNT_KV, 64);
          const int gx = G < 64 ? G : 64, cx = ckv < 64 ? ckv : (1 << 20);
          { pg8::Gemm g{KV, WQS, 4, 4096, 2048, 0xffffffffu}; WqkOrder S{gx, cx}; pg8::EpiF8 E{(unsigned char*)WQK, 1024, 32.0f};
            pg8::gemm_phase<pg8::EpiF8, WqkOrder, true>(L + RING_OFF, XL, g, S, E); }
          { pg8::Gemm g{WOT, KV, 4, 2048, 4096, 0xffffffffu}; VwoOrder S{gx, cx}; pg8::EpiF8 E{(unsigned char*)VWO, 1024, 4.0f};
            pg8::gemm_phase<pg8::EpiF8, VwoOrder, true>(L + RING_OFF, XL, g, S, E); } }
        { pg8::Gemm g{A1, WINT, D / 64, 4096, D * 2, 0xffffffffu}; pg8::TileOrder S; S.init(M, NQKV, G, bx, 4096, D * 2, 0, 1 << 30); S.deal = (G == 256) ? 1 : 0;
          pg8::EpiBf16 E{QKV, NQKV, 0xC3u, C2, (unsigned*)(ctl + CW_QKN)};
          pg8::gemm_phase<pg8::EpiBf16, pg8::TileOrder, true>(L + RING_OFF, XL, g, S, E); }
        WG_WAIT(CW_CNT_Z, 64);
        { pg8::Gemm g{A1, ZT, 3072 / 64, 4096, 6144, 4095u}; pg8::TileOrder S; S.init(M, 256, G, bx, 4096, 6144, (size_t)256 * 6144, 32); S.skipmode = 1;
          pg8::EpiGate E{SEL};
          pg8::gemm_phase<pg8::EpiGate, pg8::TileOrder, true, false, true>(L + RING_OFF, XL, g, S, E); }
    }
#undef WG_SIGNAL
#undef WG_WAIT
    xcd_barrier(bar);

    { DECL_PTRS;
        for (int e = bx + wave * G; e < 2048; e += 8 * G) {
            const int bh = e >> 5, qb = e & 31, b = bh >> 3, h = bh & 7; float dmin = 3.0e38f, qmax = 0.f;
#pragma unroll 2
            for (int rr = 0; rr < 4; ++rr) { const bf16* qp = QKV + ((size_t)b * T + qb * 256 + rr * 64 + lane) * NQKV + h * 64; float dot = 0.f, qn2 = 0.f;
#pragma unroll
                for (int c = 0; c < 8; ++c) { const v4u qw = *((const v4u*)qp + c), kw = *((const v4u*)(qp + 512) + c); const unsigned qq[4] = {qw.x, qw.y, qw.z, qw.w}, kk2[4] = {kw.x, kw.y, kw.z, kw.w};
#pragma unroll
                    for (int x4 = 0; x4 < 4; ++x4) { const float q0 = bflo(qq[x4]), q1 = bfhi(qq[x4]); dot += q0 * bflo(kk2[x4]) + q1 * bfhi(kk2[x4]); qn2 += q0 * q0 + q1 * q1; } }
                dmin = fminf(dmin, dot); qmax = fmaxf(qmax, qn2); }
#pragma unroll
            for (int o = 1; o < 64; o <<= 1) { dmin = fminf(dmin, __shfl_xor(dmin, o)); qmax = fmaxf(qmax, __shfl_xor(qmax, o)); }
            const unsigned* kp = (const unsigned*)(ctl + CW_QKN) + bh * 8 + 2;
            const float kn = sqrtf(__uint_as_float(__hip_atomic_load(kp, RLX_AGENT)) + __uint_as_float(__hip_atomic_load(kp + 1, RLX_AGENT)));
            const float thr = (sqrtf(qmax) * kn * 1.02f - dmin + 40.5f) * (1.0f / LOG2E);
            const float* crow_ = CC + (size_t)bh * T; const int t0 = qb * 256; const float target = crow_[t0] + thr;
            int lo = 0, hi2 = t0;
            while (hi2 > lo) { const int step = (hi2 - lo + 63) >> 6, pos = lo + lane * step; const bool pr = pos < hi2 && crow_[pos] >= target; const int k = __popcll(__ballot(pr));
                if (k == 0) hi2 = lo;
                else { const int cand = lo + k * step; lo = lo + (k - 1) * step + 1; if (cand < hi2) hi2 = cand; } }
            if (lane == 0) ((int*)(ctl + CW_T0TAB))[e] = (lo >> 6) & ~1; }
        for (int ws_ = bx + G * wave; ws_ < 2048; ws_ += 8 * G) {
            const int bh = (ws_ & 255) >> 2, n = (ws_ & 3) + 4 * (ws_ >> 8), trip = bh * 32 + n; const unsigned* selrow = SEL + (size_t)bh * T; unsigned base = 0u;
            const float mthr = skip_thr((const unsigned*)(ctl + CW_QKN) + bh * 8, 1); const int hh = bh & 7;
            for (int t0 = (n + 1) * 256; t0 < T; t0 += 512) {
                unsigned m[8];
#pragma unroll
                for (int j = 0; j < 8; ++j) { const int t = t0 + j * 64 + lane; m[j] = 0u; if (t < T) m[j] = selrow[t]; }
#pragma unroll
                for (int j = 0; j < 8; ++j) { const int t = t0 + j * 64 + lane; const bool hit = ((m[j] >> n) & 1u) && !moba_skip(hh, t >> 8, n, mthr);
                    const unsigned long long bal = __ballot(hit);
                    if (hit) { const unsigned pos = base + (unsigned)__popcll(bal & ((1ull << lane) - 1ull)); const unsigned k = (unsigned)__popc(m[j] & ((1u << n) - 1u));
                        LIST[(size_t)trip * 8192 + pos] = (unsigned)t | (k << 16); }
                    base += (unsigned)__popcll(bal); }
            }
            if (lane == 0) CNT[trip] = base;
        }
    }
    xcd_barrier(bar);

    { DECL_PTRS;
        LAS int* upre = (LAS int*)(L + RING_OFF + attn_body::ATTN_LDS_BYTES);
        LAS int* wsum = upre + 2052;
        { int c4[4]; int run = 0;
#pragma unroll
          for (int i = 0; i < 4; ++i) { const int wq = tid * 4 + i; c4[i] = run; run += (int)((8u + ((CNT[(wq & 63) * 32 + (wq >> 6)] + 31u) >> 5) + 31u) >> 5); }
          int incl = run;
#pragma unroll
          for (int o = 1; o < 64; o <<= 1) { const int nn = __shfl_up(incl, o); if (lane >= o) incl += nn; }
          if (lane == 63) wsum[wave] = incl;
          __syncthreads();
          int pre = incl - run;
          for (int ww = 0; ww < wave; ++ww) pre += wsum[ww];
#pragma unroll
          for (int i = 0; i < 4; ++i) upre[tid * 4 + i] = pre + c4[i];
          if (tid == 511) upre[2048] = pre + run;
          __syncthreads(); }
        const int ntot = 2048 + upre[2048];
        const attn_body::hb16* Qb = (const attn_body::hb16*)QKV;
        const int r32 = lane & 31;
        LAS unsigned* qnext = (LAS unsigned*)(wsum + 16);
        unsigned* qhead = (unsigned*)(ctl + CW_QUEUE);
        if (tid == 0) qnext[0] = atomicAdd(qhead, 1u);
        __syncthreads();
        for (;;) {
            const int u = (int)qnext[0];
            if (u >= ntot) break;
            __syncthreads();
            unsigned nxt_ = 0u; if (tid == 0) nxt_ = atomicAdd(qhead, 1u);
            if (u < 2048) {
                const int qb = 31 - (u >> 6), bh = u & 63;
                const int b = bh >> 3, h = bh & 7;
                const int T0 = ((const int*)(ctl + CW_T0TAB))[bh * 32 + qb];
                const int qrow = b * T + qb * 256 + wave * 32 + r32, NT = 4 * (qb + 1) - T0;
                const attn_body::hb16* Qc = Qb + h * 64; const attn_body::hb16* Kt0 = Qb + (size_t)(b * T + T0 * 64) * NQKV + 512 + h * 64;
                attn_body::attn_unit<8>((char*)lds + RING_OFF, 0, Qc, qrow, -1, Kt0, Kt0 + 512, (const attn_body::hb16*)KXF + ((size_t)bh * T + T0 * 64) * 8, NT, NT - 4, (attn_body::hb16*)QKV + (Qc - Qb), (attn_body::hb16*)PO, PML);
            } else {
                const int g = u - 2048; int lo = 0, hi2 = 2048;
                while (hi2 - lo > 1) { const int mid = (lo + hi2) >> 1; if (upre[mid] <= g) lo = mid; else hi2 = mid; }
                const int c = g - upre[lo], bh = lo & 63, n = lo >> 6, w = bh * 32 + n, b = bh >> 3, h = bh & 7; const int cnt = (int)CNT[w];
                const int ng = 8 + ((cnt + 31) >> 5), g0 = 32 * c, g1 = g0 + 32 < ng ? g0 + 32 : ng;
                const attn_body::hb16* Kt0 = Qb + (size_t)(b * T + n * 256) * NQKV + 2048 + h * 64;
                attn_body::moba_item<8>((char*)lds + RING_OFF, Qb + 1536 + h * 64, b * T, h, n, LIST + (size_t)w * 8192, cnt, g0, g1, Kt0, (const attn_body::hb16*)KXM + h * 256 * 8, (attn_body::hb16*)PO, PML);
            }
            if (tid == 0) qnext[0] = nxt_;
            __syncthreads();
        }
    }
    xcd_barrier(bar);

    { DECL_PTRS;
    const f32x4 ga0 = *((const f32x4*)g_fox + 2 * lane), ga1 = *((const f32x4*)g_fox + 2 * lane + 1), gb0 = *((const f32x4*)g_moba + 2 * lane), gb1 = *((const f32x4*)g_moba + 2 * lane + 1);
    const int h = lane >> 3, cc = lane & 7; const float s2 = __builtin_amdgcn_exp2f(-(float)(h + 1)) * LOG2E * 256.0f;
    float mthr[NB];
#pragma unroll
    for (int b = 0; b < NB; ++b) mthr[b] = skip_thr((const unsigned*)(ctl + CW_QKN) + (b * 8 + h) * 8, 1);
    v4u wan[2], pwn[2][4]; unsigned mmn[2]; pg8::f32x2 mln[2][4];
#define P3_LOAD(rbase) do { _Pragma("unroll") for (int rr = 0; rr < 2; ++rr) { const int r = (rbase) + rr, b = r >> 13, t = r & (T - 1); const size_t sb = ((size_t)r * 8 + h) * 4; \
            wan[rr] = *((const v4u*)(QKV + (size_t)r * NQKV) + lane); mmn[rr] = SEL[((size_t)(b * 8 + h)) * T + t]; \
            _Pragma("unroll") for (int k = 0; k < 4; ++k) { mln[rr][k] = *(const pg8::f32x2*)(PML + (sb + k) * 2); pwn[rr][k] = *((const v4u*)(PO + (sb + k) * 64) + cc); } } } while (0)
    if (gw * 2 < M) P3_LOAD(gw * 2);
    for (int r0 = gw * 2; r0 < M; r0 += NGW * 2) {
        v4u wa[2], pw[2][4]; unsigned mmv[2]; pg8::f32x2 ml[2][4];
#pragma unroll
        for (int rr = 0; rr < 2; ++rr) { wa[rr] = wan[rr]; mmv[rr] = mmn[rr];
#pragma unroll
            for (int k = 0; k < 4; ++k) { ml[rr][k] = mln[rr][k]; pw[rr][k] = pwn[rr][k]; } }
        { const int rn = r0 + NGW * 2 < M ? r0 + NGW * 2 : r0; P3_LOAD(rn); }
#pragma unroll
        for (int rr = 0; rr < 2; ++rr) { const int r = r0 + rr, t = r & (T - 1), own = t >> 8;
            const float a[8] = {bflo(wa[rr].x), bfhi(wa[rr].x), bflo(wa[rr].y), bfhi(wa[rr].y), bflo(wa[rr].z), bfhi(wa[rr].z), bflo(wa[rr].w), bfhi(wa[rr].w)};
            float c[8]; unsigned mm = mmv[rr]; const int cnt = __popc(mm);
            float mk[4], lk[4];
#pragma unroll
            for (int k = 0; k < 4; ++k) { mk[k] = ml[rr][k].x; lk[k] = ml[rr][k].y; }
            mk[3] += s2 * (float)own; float Mx = mk[3];
            bool vk[4]; vk[3] = true; float thb = mthr[0];
#pragma unroll
            for (int b = 1; b < NB; ++b) thb = ((r >> 13) == b) ? mthr[b] : thb;
#pragma unroll
            for (int k = 0; k < 3; ++k) { vk[k] = false; if (k < cnt) { const int nb = __ffs(mm) - 1; mm &= mm - 1u; vk[k] = !moba_skip(h, own, nb, thb); if (vk[k]) { mk[k] += s2 * (float)nb; Mx = fmaxf(Mx, mk[k]); } } }
            float W = 0.f;
#pragma unroll
            for (int i = 0; i < 8; ++i) c[i] = 0.f;
#pragma unroll
            for (int k = 0; k < 4; ++k) { if (vk[k]) { const float w = lk[k] * __builtin_amdgcn_exp2f(mk[k] - Mx); W += w; const v4u p = pw[rr][k];
                c[0] += w * bflo(p.x); c[1] += w * bfhi(p.x); c[2] += w * bflo(p.y); c[3] += w * bfhi(p.y); c[4] += w * bflo(p.z); c[5] += w * bfhi(p.z); c[6] += w * bflo(p.w); c[7] += w * bfhi(p.w); } }
            const float iw = 1.0f / W;
#pragma unroll
            for (int i = 0; i < 8; ++i) c[i] *= iw;
            float sa = 0.f, sb2 = 0.f;
#pragma unroll
            for (int i = 0; i < 8; ++i) { sa += a[i] * a[i]; sb2 += c[i] * c[i]; }
            const float ra = __builtin_amdgcn_rsqf(wave_sum(sa) * (1.f / 512.f) + RMS_EPS), rb = __builtin_amdgcn_rsqf(wave_sum(sb2) * (1.f / 512.f) + RMS_EPS);
            v4u oa, ob;
            oa.x = pk2(a[0] * ra * ga0[0], a[1] * ra * ga0[1]); oa.y = pk2(a[2] * ra * ga0[2], a[3] * ra * ga0[3]); oa.z = pk2(a[4] * ra * ga1[0], a[5] * ra * ga1[1]); oa.w = pk2(a[6] * ra * ga1[2], a[7] * ra * ga1[3]);
            ob.x = pk2(c[0] * rb * gb0[0], c[1] * rb * gb0[1]); ob.y = pk2(c[2] * rb * gb0[2], c[3] * rb * gb0[3]); ob.z = pk2(c[4] * rb * gb1[0], c[5] * rb * gb1[1]); ob.w = pk2(c[6] * rb * gb1[2], c[7] * rb * gb1[3]);
            *((v4u*)(Y + (size_t)r * D) + lane) = oa; *((v4u*)(Y + (size_t)r * D + 512) + lane) = ob; }
    } }
    xcd_barrier(bar);

#undef P3_LOAD
    { DECL_PTRS; pg8::Gemm g{Y, WOUTT, D / 64, D * 2, D * 2, 0xffffffffu}; pg8::TileOrder S; S.init(M, D, G, bx, D * 2, D * 2, 0, 1 << 30);
      pg8::EpiRes<false, false> E{x, nullptr, nullptr, HB1, ws + WS_HB1F, SSQ1, 1.0f};
      pg8::gemm_phase<pg8::EpiRes<false, false>, pg8::TileOrder, true>(L + RING_OFF, XL, g, S, E); }
    xcd_barrier(bar);

    { DECL_PTRS; pg8::Gemm g{ws + WS_HB1F, WQK, D / 128, D, D, 0xffffffffu}; pg8::TileOrder S; S.init(M, D, G, bx, D, D, (size_t)D * D, 32);
      pg8::EpiSoftmax E{(unsigned char*)PB, SSQ1, 1.0f / 32.0f};
      pg8::gemm_phase<pg8::EpiSoftmax, pg8::TileOrder, true, true>(L + RING_OFF, XL, g, S, E); }
    xcd_barrier(bar);

    { DECL_PTRS; pg8::Gemm g{PB, VWO, D / 128, D, D, 0xffffffffu}; pg8::TileOrder S; S.init(M, D, G, bx, D, D, (size_t)D * D, 32);
      pg8::EpiRes<true, false> E{nullptr, HB1, nullptr, HB2, nullptr, SSQ2, 1.0f / 1024.0f};
      pg8::gemm_phase<pg8::EpiRes<true, false>, pg8::TileOrder, true, true>(L + RING_OFF, XL, g, S, E); }
    xcd_barrier(bar);

    { DECL_PTRS; pg8::Gemm g{HB2, WUPT, D / 64, D * 2, D * 2, 0xffffffffu}; pg8::TileOrder S; S.init(M, 2 * FF, G, bx, D * 2, D * 2, 0, 1 << 30);
      pg8::EpiConv E{ACT8, SSQ2, conv_w, conv_b, GHB, UHB, GTB};
      pg8::gemm_phase<pg8::EpiConv, pg8::TileOrder, true>(L + RING_OFF, XL, g, S, E); }
    xcd_barrier(bar);

    { DECL_PTRS;
    for (int it = bx * 512 + tid; it < 256 * 22 * 2 * 32; it += G * 512) {
        const int c4 = (it & 31) * 4, rr = (it >> 5) & 1, tile = it >> 6, pm = tile / 22, pn = tile - pm * 22; const bool top = (pm & 31) == 0;
        const size_t sb = (size_t)tile * 256; const int col = pn * 128 + c4;
        const f32x4 g2 = *(const f32x4*)(GHB + sb + rr * 128 + c4), uu = *(const f32x4*)(UHB + sb + rr * 128 + c4);
        f32x4 g1 = (f32x4){0.f, 0.f, 0.f, 0.f}, g0 = (f32x4){0.f, 0.f, 0.f, 0.f};
        if (rr == 1) g1 = *(const f32x4*)(GHB + sb + c4); else if (!top) g1 = *(const f32x4*)(GTB + sb - 22 * 256 + 128 + c4);
        if (!top) g0 = *(const f32x4*)(GTB + sb - 22 * 256 + (rr == 1 ? 128 : 0) + c4);
        const f32x4 w0 = *(const f32x4*)(conv_w + col), w1 = *(const f32x4*)(conv_w + FF + col), w2 = *(const f32x4*)(conv_w + 2 * FF + col), cbv = *(const f32x4*)(conv_b + col);
        float res[4];
#pragma unroll
        for (int e = 0; e < 4; ++e) { const float gc = cbv[e] + w0[e] * g0[e] + w1[e] * g1[e] + w2[e] * g2[e]; res[e] = gc * __builtin_amdgcn_rcpf(1.0f + __builtin_amdgcn_exp2f(-LOG2E * gc)) * uu[e]; }
        *(unsigned*)(ACT8 + (size_t)(pm * 256 + rr) * FF + col) = pg8::pk4_fp8(res[0], res[1], res[2], res[3]);
    } }
    xcd_barrier(bar);

    { DECL_PTRS; pg8::Gemm g{ACT8, WDT, FF / 128, FF, FF, 0xffffffffu}; pg8::TileOrder S; S.init(M, D, G, bx, FF, FF, 0, 1 << 30);
      pg8::EpiResNorm E{HB2, out, g_final, 1.0f / 64.0f, SSQ3, (unsigned*)(ctl + CW_PANEL), (unsigned*)(ctl + CW_TMO2)};
      pg8::gemm_phase<pg8::EpiResNorm, pg8::TileOrder, true, true>(L + RING_OFF, XL, g, S, E); }
}

extern "C" void kernel_launch(void* const* d_in, const int* in_sizes, int n_in, void* d_out, int out_size, void* d_ws, size_t ws_size, hipStream_t stream) {
    static int grid = 0;
    if (grid == 0) {
        if (n_in != 19 || in_sizes[0] != M * D || out_size != M * D || ws_size < WS_END) { fprintf(stderr, "kernel_launch: unexpected problem shape (n_in %d, in0 %d, out %d, ws %zu); nothing launched\n", n_in, n_in > 0 ? in_sizes[0] : -1, out_size, ws_size); grid = -1; return; }
        int dev = 0, cus = 0, per_cu = 0;
        if (hipGetDevice(&dev) != hipSuccess || hipDeviceGetAttribute(&cus, hipDeviceAttributeMultiprocessorCount, dev) != hipSuccess) { grid = -1; return; }
        if (hipFuncSetAttribute((const void*)fwd, hipFuncAttributeMaxDynamicSharedMemorySize, LDS_BYTES) != hipSuccess) { fprintf(stderr, "kernel_launch: hipFuncSetAttribute failed\n"); grid = -1; return; }
        if (hipOccupancyMaxActiveBlocksPerMultiprocessor(&per_cu, (const void*)fwd, NWAVES * 64, LDS_BYTES) != hipSuccess || per_cu < 1) { fprintf(stderr, "kernel_launch: occupancy query reports %d\n", per_cu); }
        (void)hipGetLastError();
        grid = cus;
    }
    if (grid < 0) return;
    if (hipMemsetAsync((char*)d_ws + WS_CTL, 0, CTL_ZERO_BYTES, stream) != hipSuccess) return;
    Args a{};
    for (int i = 0; i < 19; ++i) a.in[i] = (const float*)d_in[i];
    a.out = (float*)d_out; a.ws = (unsigned char*)d_ws;
    hipLaunchKernelGGL(fwd, dim3(grid), dim3(NWAVES * 64), LDS_BYTES, stream, a);
}
```

```cpp
#include <hip/hip_runtime.h>
#include <hip/hip_bf16.h>
#include <cstdio>
#include <cstdint>

namespace pg8 {
#define PG8_LAS __attribute__((address_space(3)))
typedef unsigned short bf16_t;
typedef short bf16x8 __attribute__((ext_vector_type(8)));
typedef float f32x4 __attribute__((ext_vector_type(4)));
typedef float f32x2 __attribute__((ext_vector_type(2)));
typedef unsigned u32x4 __attribute__((ext_vector_type(4)));
typedef unsigned u32x2 __attribute__((ext_vector_type(2)));
typedef int i32x4 __attribute__((ext_vector_type(4)));
typedef int i32x8 __attribute__((ext_vector_type(8)));
constexpr int BM = 256, BK = 64, HALF = 128, HTB = HALF * BK * 2  , STAGE_BYTES = 8 * HTB, NXCD = 8, WGM = 8;

__host__ __device__ __forceinline__ int lds_byte(int r, int c) { const int st = (r >> 4) * 2 + (c >> 5), rr = r & 15, cc = c & 31, ob = rr * 64 + cc * 2; return st * 1024 + (ob ^ (((ob >> 9) & 1) << 5)); }
__host__ __device__ __forceinline__ void stage_rc(int b, int& R, int& C) { const int st = b / 1024, sb = b % 1024, swz = sb ^ (((sb >> 9) & 1) << 5); R = (st >> 1) * 16 + swz / 64; C = (st & 1) * 32 + (swz % 64) / 2; }
__host__ __device__ __forceinline__ int perm32(int rho) { const int n = rho >> 4, i = rho & 15; return 8 * (i >> 2) + 4 * n + (i & 3); }

struct Unit { int pm, pn; size_t aoff, boff; int skipb1; };
struct Gemm { const void* A; const void* Bt; int nt, lda, ldb; unsigned wrapmask; };

struct TileOrder {
    int nM, nN, nwg, G, c; size_t a_tile, b_tile, b_batch; int pmb;
    __device__ __forceinline__ void init(int M, int N, int G_, int c_, int lda_bytes, int ldb_bytes, size_t b_batch_bytes, int pm_per_batch) {
        nM = M / BM; nN = N / BM; nwg = nM * nN; G = G_; c = c_; deal = 0; skipmode = 0; a_tile = (size_t)BM * lda_bytes; b_tile = (size_t)BM * ldb_bytes; b_batch = b_batch_bytes; pmb = pm_per_batch; }
    int skipmode;
    int deal;
    __device__ __forceinline__ bool next(int i, Unit& u) const {
        long L = (long)i * G + c;
        if (deal == 1) { const int n = 11 + (c < 128 ? 1 : (c >= 192 ? 2 : 0)); if (i >= n) return false; if (i >= 11) L = c < 128 ? 2816 + c : 2944 + (i - 11) * 64 + (c - 192); }
        if (L >= nwg) return false;
        int wgid = (int)L; { const int q = nwg / NXCD, r = nwg % NXCD, xcd = wgid % NXCD, off = wgid / NXCD; wgid = (xcd < r ? xcd * (q + 1) : r * (q + 1) + (xcd - r) * q) + off; }
        const int nig = WGM * nN, gid = wgid / nig, fm = gid * WGM, gsz = (nM - fm) < WGM ? (nM - fm) : WGM;
        u.pm = fm + ((wgid % nig) % gsz); u.pn = (wgid % nig) / gsz;
        u.aoff = (size_t)u.pm * a_tile; u.boff = (size_t)u.pn * b_tile + (size_t)(u.pm / pmb) * b_batch; u.skipb1 = (skipmode && (u.pm & 31) <= 16) ? 1 : 0; return true;
    }
};

__device__ __forceinline__ unsigned cvt_pk_bf16(float lo, float hi) { unsigned r; asm volatile("v_cvt_pk_bf16_f32 %0, %1, %2" : "=v"(r) : "v"(lo), "v"(hi)); return r; }

typedef f32x4 AccT[2][2][4][2];

struct EpiBf16 {
    static constexpr bool PERM = true;
    bf16_t* O; int ldc; unsigned scalemask; float scale0; unsigned* nrm;
    __device__ __forceinline__ void operator()(AccT& acc, const Unit& u, int wr, int wc, int fr, int fq, PG8_LAS unsigned char*) const {
        const int row0 = u.pm * BM + wr * 64 + fr, col0 = u.pn * BM + wc * 32 + 8 * fq;
        const float sc = ((scalemask >> u.pn) & 1u) ? scale0 : 1.f;
        if (nrm && (u.pn < 4 || (u.pn >= 6 && u.pn < 10))) {
#pragma unroll
            for (int bj = 0; bj < 2; ++bj) { float mx = 0.f;
#pragma unroll
                for (int ai = 0; ai < 2; ++ai)
#pragma unroll
                    for (int m = 0; m < 4; ++m) { const f32x4 v0 = acc[ai][bj][m][0] * sc, v1 = acc[ai][bj][m][1] * sc;
                        float q = (v0[0] * v0[0] + v0[1] * v0[1]) + (v0[2] * v0[2] + v0[3] * v0[3]) + (v1[0] * v1[0] + v1[1] * v1[1]) + (v1[2] * v1[2] + v1[3] * v1[3]);
                        q += __shfl_xor(q, 16); q += __shfl_xor(q, 32); mx = fmaxf(mx, q); }
                mx = fmaxf(mx, __shfl_xor(mx, 1)); mx = fmaxf(mx, __shfl_xor(mx, 2)); mx = fmaxf(mx, __shfl_xor(mx, 4)); mx = fmaxf(mx, __shfl_xor(mx, 8));
                if (fr == 0 && fq == 0) { const int head = (u.pn & 1) * 4 + 2 * bj + (wc >> 1); const int grp = u.pn < 4 ? (u.pn >> 1) : (u.pn >> 1) - 1; atomicMax(nrm + (((u.pm >> 5) * 8 + head) * 4 + grp) * 2 + (wc & 1), __float_as_uint(mx)); } } }
#pragma unroll
        for (int ai = 0; ai < 2; ++ai)
#pragma unroll
            for (int m = 0; m < 4; ++m) { bf16_t* rowp = O + (size_t)(row0 + ai * HALF + m * 16) * ldc + col0;
#pragma unroll
                for (int bj = 0; bj < 2; ++bj) { const f32x4 v0 = acc[ai][bj][m][0] * sc, v1 = acc[ai][bj][m][1] * sc;
                    u32x4 w; w.x = cvt_pk_bf16(v0[0], v0[1]); w.y = cvt_pk_bf16(v0[2], v0[3]); w.z = cvt_pk_bf16(v1[0], v1[1]); w.w = cvt_pk_bf16(v1[2], v1[3]);
                    *(u32x4*)(rowp + bj * HALF) = w; } }
    }
};
__device__ __forceinline__ unsigned pk4_fp8(float a, float b, float c, float d) { a = __builtin_amdgcn_fmed3f(a, -448.f, 448.f); b = __builtin_amdgcn_fmed3f(b, -448.f, 448.f); c = __builtin_amdgcn_fmed3f(c, -448.f, 448.f); d = __builtin_amdgcn_fmed3f(d, -448.f, 448.f); int w = 0;
    w = __builtin_amdgcn_cvt_pk_fp8_f32(a, b, w, false); w = __builtin_amdgcn_cvt_pk_fp8_f32(c, d, w, true); return (unsigned)w; }
struct EpiF8 {
    static constexpr bool PERM = true;
    unsigned char* O; int ldc; float sc;
    __device__ __forceinline__ void operator()(AccT& acc, const Unit& u, int wr, int wc, int fr, int fq, PG8_LAS unsigned char*) const {
        const int row0 = u.pm * BM + wr * 64 + fr, col0 = u.pn * BM + wc * 32 + 8 * fq;
#pragma unroll
        for (int ai = 0; ai < 2; ++ai)
#pragma unroll
            for (int m = 0; m < 4; ++m) { unsigned char* rowp = O + (size_t)(row0 + ai * HALF + m * 16) * ldc + col0;
#pragma unroll
                for (int bj = 0; bj < 2; ++bj) { const f32x4 v0 = acc[ai][bj][m][0] * sc, v1 = acc[ai][bj][m][1] * sc;
                    *(u32x2*)(rowp + bj * HALF) = (u32x2){pk4_fp8(v0[0], v0[1], v0[2], v0[3]), pk4_fp8(v1[0], v1[1], v1[2], v1[3])}; } }
    }
};
__device__ __forceinline__ float rstd_from_slots(const float* slots) {
    const f32x4 a = *(const f32x4*)slots, b = *(const f32x4*)(slots + 4), c = *(const f32x4*)(slots + 8), d = *(const f32x4*)(slots + 12);
    const float s = ((a[0] + a[1]) + (a[2] + a[3])) + ((b[0] + b[1]) + (b[2] + b[3])) + ((c[0] + c[1]) + (c[2] + c[3])) + ((d[0] + d[1]) + (d[2] + d[3]));
    return __builtin_amdgcn_rsqf(s * (1.0f / 1024.0f) + 1e-6f);
}
#define PG8_DPP(old, src, ctrl) __builtin_bit_cast(float, __builtin_amdgcn_update_dpp(__builtin_bit_cast(int, (float)(old)), __builtin_bit_cast(int, (float)(src)), (ctrl), 0xf, 0xf, false))
struct EpiConv {
    static constexpr bool PERM = true;
    unsigned char* act; const float* ssq; const float* cw; const float* cbias; float* GH; float* UH; float* GT;
    __device__ __forceinline__ void operator()(AccT& acc, const Unit& u, int wr, int wc, int fr, int fq, PG8_LAS unsigned char* xl) const {
        PG8_LAS float* H = (PG8_LAS float*)xl;
        const int cl = wc * 32 + 8 * fq;
        const int row0 = u.pm * BM + wr * 64 + fr;
        PG8_LAS float* Sr = H + 1024;
        { const int t_ = threadIdx.x; if (t_ < 256) Sr[t_] = rstd_from_slots(ssq + (size_t)(u.pm * BM + t_) * 16); }
        asm volatile("s_waitcnt vmcnt(0) lgkmcnt(0)" ::: "memory"); __builtin_amdgcn_s_barrier(); asm volatile("" ::: "memory");
#pragma unroll
        for (int ai = 0; ai < 2; ++ai)
#pragma unroll
            for (int m = 0; m < 4; ++m) { const float rs = Sr[ai * HALF + wr * 64 + m * 16 + fr];
#pragma unroll
                for (int bj = 0; bj < 2; ++bj)
#pragma unroll
                    for (int n = 0; n < 2; ++n) acc[ai][bj][m][n] *= rs; }
        const size_t sb = ((size_t)(u.pm * 22 + u.pn) * 2) * 128 + cl;
        if (fr >= 14) {
#pragma unroll
            for (int ai = 0; ai < 2; ++ai)
#pragma unroll
                for (int n = 0; n < 2; ++n) *(PG8_LAS f32x4*)(H + ((ai * 2 + wr) * 2 + (fr - 14)) * 128 + cl + 4 * n) = acc[ai][0][3][n];
            if (wr == 1) {
#pragma unroll
                for (int n = 0; n < 2; ++n) *(f32x4*)(GT + sb + (fr - 14) * 128 + 4 * n) = acc[1][0][3][n]; } }
        if (wr == 0 && fr < 2) {
#pragma unroll
            for (int n = 0; n < 2; ++n) { *(f32x4*)(GH + sb + fr * 128 + 4 * n) = acc[0][0][0][n]; *(f32x4*)(UH + sb + fr * 128 + 4 * n) = acc[0][1][0][n]; } }
        asm volatile("s_waitcnt lgkmcnt(0)" ::: "memory"); __builtin_amdgcn_s_barrier(); asm volatile("" ::: "memory");
#pragma unroll
        for (int n = 0; n < 2; ++n) {
            const int c0 = u.pn * 128 + cl + 4 * n;
            const f32x4 w0 = *(const f32x4*)(cw + c0), w1 = *(const f32x4*)(cw + 2816 + c0), w2 = *(const f32x4*)(cw + 2 * 2816 + c0), cbv = *(const f32x4*)(cbias + c0);
#pragma unroll
            for (int ai = 0; ai < 2; ++ai) {
                const int hsrc = wr == 1 ? ai * 2 : (ai == 1 ? 1 : 0);
                const f32x4 h14 = *(const PG8_LAS f32x4*)(H + (hsrc * 2 + 0) * 128 + cl + 4 * n), h15 = *(const PG8_LAS f32x4*)(H + (hsrc * 2 + 1) * 128 + cl + 4 * n);
#pragma unroll
                for (int m = 3; m >= 0; --m) {
                    float res[4];
#pragma unroll
                    for (int i = 0; i < 4; ++i) { const float X = acc[ai][0][m][n][i];
                        float o1, o2;
                        if (m > 0) { const float Xp = acc[ai][0][m > 0 ? m - 1 : 0][n][i]; o1 = PG8_DPP(0.f, Xp, 0x121); o2 = PG8_DPP(0.f, Xp, 0x122); }
                        else { o1 = h15[i]; o2 = fr == 0 ? h14[i] : h15[i]; }
                        const float g1 = PG8_DPP(o1, X, 0x111), g0 = PG8_DPP(o2, X, 0x112);
                        const float gc = cbv[i] + w0[i] * g0 + w1[i] * g1 + w2[i] * X;
                        res[i] = gc * __builtin_amdgcn_rcpf(1.0f + __builtin_amdgcn_exp2f(-1.4426950408889634f * gc)) * acc[ai][1][m][n][i]; }
                    const int row = row0 + ai * HALF + m * 16;
                    if (!(ai == 0 && m == 0 && wr == 0 && fr < 2))
                        *(unsigned*)(act + (size_t)row * 2816 + c0) = pk4_fp8(res[0], res[1], res[2], res[3]);
                } } }
    }
};
template <bool BASEB, bool OUTF> struct EpiRes {
    static constexpr bool PERM = true;
    const float* base; const bf16_t* baseb; float* out; bf16_t* hb; unsigned char* hb8; float* ssq; float accs;
    __device__ __forceinline__ void operator()(AccT& acc, const Unit& u, int wr, int wc, int fr, int fq, PG8_LAS unsigned char*) const {
        const int row0 = u.pm * BM + wr * 64 + fr, col0 = u.pn * BM + wc * 32 + 8 * fq;
        constexpr int DEPTH = BASEB ? 3 : 2;
        u32x4 pb[12][2]; f32x4 pf[12][2][2];
#define PG8_RES_LOAD(it) do { const size_t o_ = (size_t)(row0 + ((it) >> 2) * HALF + ((it) & 3) * 16) * 1024 + col0; \
            if constexpr (BASEB) { pb[it][0] = *(const u32x4*)(baseb + o_); pb[it][1] = *(const u32x4*)(baseb + o_ + HALF); } \
            else { pf[it][0][0] = *(const f32x4*)(base + o_); pf[it][0][1] = *(const f32x4*)(base + o_ + 4); pf[it][1][0] = *(const f32x4*)(base + o_ + HALF); pf[it][1][1] = *(const f32x4*)(base + o_ + HALF + 4); } } while (0)
#pragma unroll
        for (int it = 0; it < DEPTH; ++it) PG8_RES_LOAD(it);
#pragma unroll
        for (int it = 0; it < 8; ++it) { const int ai = it >> 2, m = it & 3;
            if (it + DEPTH < 8) PG8_RES_LOAD(it + DEPTH);
            __builtin_amdgcn_sched_barrier(0);
            const int row = row0 + ai * HALF + m * 16; const size_t off = (size_t)row * 1024 + col0; float q = 0.f;
#pragma unroll
            for (int bj = 0; bj < 2; ++bj) {
                f32x4 b0, b1;
                if constexpr (BASEB) { const u32x4 bw = pb[it][bj];
                    b0 = (f32x4){__builtin_bit_cast(float, bw.x << 16), __builtin_bit_cast(float, bw.x & 0xffff0000u), __builtin_bit_cast(float, bw.y << 16), __builtin_bit_cast(float, bw.y & 0xffff0000u)};
                    b1 = (f32x4){__builtin_bit_cast(float, bw.z << 16), __builtin_bit_cast(float, bw.z & 0xffff0000u), __builtin_bit_cast(float, bw.w << 16), __builtin_bit_cast(float, bw.w & 0xffff0000u)}; }
                else { b0 = pf[it][bj][0]; b1 = pf[it][bj][1]; }
                const f32x4 v0 = acc[ai][bj][m][0] * accs + b0, v1 = acc[ai][bj][m][1] * accs + b1;
                if constexpr (OUTF) { *(f32x4*)(out + off + bj * HALF) = v0; *(f32x4*)(out + off + bj * HALF + 4) = v1; }
                q += (v0[0] * v0[0] + v0[1] * v0[1]) + (v0[2] * v0[2] + v0[3] * v0[3]) + (v1[0] * v1[0] + v1[1] * v1[1]) + (v1[2] * v1[2] + v1[3] * v1[3]);
                if (hb) { u32x4 w; w.x = cvt_pk_bf16(v0[0], v0[1]); w.y = cvt_pk_bf16(v0[2], v0[3]); w.z = cvt_pk_bf16(v1[0], v1[1]); w.w = cvt_pk_bf16(v1[2], v1[3]); *(u32x4*)(hb + off + bj * HALF) = w; }
                if (hb8) *(u32x2*)(hb8 + off + bj * HALF) = (u32x2){pk4_fp8(v0[0], v0[1], v0[2], v0[3]), pk4_fp8(v1[0], v1[1], v1[2], v1[3])}; }
            q += __shfl_xor(q, 16); q += __shfl_xor(q, 32);
            if (fq == 0) ssq[(size_t)row * 16 + u.pn * 4 + wc] = q;
            __builtin_amdgcn_sched_barrier(0); }
#undef PG8_RES_LOAD
    }
};
struct EpiResNorm {
    static constexpr bool PERM = true;
    const bf16_t* baseb; float* out; const float* gfin; float accs; float* xbuf; unsigned* cnt; unsigned* tmo;
    __device__ __forceinline__ void operator()(AccT& acc, const Unit& u, int wr, int wc, int fr, int fq, PG8_LAS unsigned char* xl) const {
        PG8_LAS float* Pp = (PG8_LAS float*)xl;
        PG8_LAS float* Sr = Pp + 1024;
        PG8_LAS unsigned* flag = (PG8_LAS unsigned*)(Sr + 256);
        const int tid = threadIdx.x, wid = tid >> 6, lane = tid & 63;
        const int row0 = u.pm * BM + wr * 64 + fr, col0 = u.pn * BM + wc * 32 + 8 * fq;
        u32x4 pb[12][2];
#define PG8_RN_LOAD(it) do { const size_t o_ = (size_t)(row0 + ((it) >> 2) * HALF + ((it) & 3) * 16) * 1024 + col0; pb[it][0] = *(const u32x4*)(baseb + o_); pb[it][1] = *(const u32x4*)(baseb + o_ + HALF); } while (0)
#pragma unroll
        for (int it = 0; it < 4; ++it) PG8_RN_LOAD(it);
#pragma unroll
        for (int it = 0; it < 8; ++it) { const int ai = it >> 2, m = it & 3;
                if (it + 4 < 8) PG8_RN_LOAD(it + 4);
                __builtin_amdgcn_sched_barrier(0);
                float q = 0.f;
#pragma unroll
                for (int bj = 0; bj < 2; ++bj) {
                    const u32x4 bw = pb[it][bj];
                    const f32x4 b0 = (f32x4){__builtin_bit_cast(float, bw.x << 16), __builtin_bit_cast(float, bw.x & 0xffff0000u), __builtin_bit_cast(float, bw.y << 16), __builtin_bit_cast(float, bw.y & 0xffff0000u)};
                    const f32x4 b1 = (f32x4){__builtin_bit_cast(float, bw.z << 16), __builtin_bit_cast(float, bw.z & 0xffff0000u), __builtin_bit_cast(float, bw.w << 16), __builtin_bit_cast(float, bw.w & 0xffff0000u)};
                    const f32x4 v0 = acc[ai][bj][m][0] * accs + b0, v1 = acc[ai][bj][m][1] * accs + b1; acc[ai][bj][m][0] = v0; acc[ai][bj][m][1] = v1;
                    q += (v0[0] * v0[0] + v0[1] * v0[1]) + (v0[2] * v0[2] + v0[3] * v0[3]) + (v1[0] * v1[0] + v1[1] * v1[1]) + (v1[2] * v1[2] + v1[3] * v1[3]); }
                q += __shfl_xor(q, 16); q += __shfl_xor(q, 32);
                if (fq == 0) Pp[(ai * HALF + wr * 64 + m * 16 + fr) * 4 + wc] = q;
                __builtin_amdgcn_sched_barrier(0); }
#undef PG8_RN_LOAD
        asm volatile("s_waitcnt lgkmcnt(0)" ::: "memory"); __builtin_amdgcn_s_barrier(); asm volatile("" ::: "memory");
        if (wid < 4) { const int r = wid * 64 + lane; const f32x4 p = *(const PG8_LAS f32x4*)(Pp + r * 4);
            __hip_atomic_store(xbuf + (size_t)(u.pm * BM + r) * 4 + u.pn, (p[0] + p[1]) + (p[2] + p[3]), __ATOMIC_RELAXED, __HIP_MEMORY_SCOPE_AGENT);
            asm volatile("s_waitcnt vmcnt(0)" ::: "memory");
            if (lane == 0) __hip_atomic_fetch_add(cnt + 64 * u.pm, 1u, __ATOMIC_RELAXED, __HIP_MEMORY_SCOPE_AGENT); }
        if (wid == 0) { unsigned sp = 0u; bool dead = false;
            for (;;) { if ((unsigned)__builtin_amdgcn_readfirstlane(__hip_atomic_load(cnt + 64 * u.pm, __ATOMIC_RELAXED, __HIP_MEMORY_SCOPE_AGENT)) >= 16u) break;
                if (++sp > (1u << 20)) { if (lane == 0) __hip_atomic_store(tmo, 1u, __ATOMIC_RELAXED, __HIP_MEMORY_SCOPE_AGENT); dead = true; break; }
                __builtin_amdgcn_s_sleep(2); }
            __builtin_amdgcn_fence(__ATOMIC_ACQUIRE, "agent");
            if (lane == 0) flag[0] = dead ? 1u : 0u; }
        asm volatile("s_waitcnt vmcnt(0) lgkmcnt(0)" ::: "memory"); __builtin_amdgcn_s_barrier(); asm volatile("" ::: "memory");
        if (wid < 4) { const int r = wid * 64 + lane; const float* xs = xbuf + (size_t)(u.pm * BM + r) * 4; float s = 0.f;
#pragma unroll
            for (int t = 0; t < 4; ++t) s += __hip_atomic_load(xs + t, __ATOMIC_RELAXED, __HIP_MEMORY_SCOPE_AGENT);
            Sr[r] = __builtin_amdgcn_rsqf(s * (1.0f / 1024.0f) + 1e-6f); }
        asm volatile("s_waitcnt vmcnt(0) lgkmcnt(0)" ::: "memory"); __builtin_amdgcn_s_barrier(); asm volatile("" ::: "memory");
        f32x4 gg[2][2];
#pragma unroll
        for (int bj = 0; bj < 2; ++bj) { gg[bj][0] = *(const f32x4*)(gfin + col0 + bj * HALF); gg[bj][1] = *(const f32x4*)(gfin + col0 + bj * HALF + 4); }
#pragma unroll
        for (int ai = 0; ai < 2; ++ai)
#pragma unroll
            for (int m = 0; m < 4; ++m) { const int rl = ai * HALF + wr * 64 + m * 16 + fr; const float rs = Sr[rl]; const size_t off = (size_t)(u.pm * BM + rl) * 1024 + col0;
#pragma unroll
                for (int bj = 0; bj < 2; ++bj) { *(f32x4*)(out + off + bj * HALF) = acc[ai][bj][m][0] * rs * gg[bj][0]; *(f32x4*)(out + off + bj * HALF + 4) = acc[ai][bj][m][1] * rs * gg[bj][1]; } }
    }
};
struct EpiSoftmax {
    static constexpr bool PERM = true;
    unsigned char* P; const float* ssq; float sscale;
    __device__ __forceinline__ void operator()(AccT& acc, const Unit& u, int wr, int wc, int fr, int fq, PG8_LAS unsigned char* xl) const {
        PG8_LAS f32x2* X = (PG8_LAS f32x2*)xl;
        const int row0 = u.pm * BM + wr * 64 + fr, col0 = u.pn * BM + wc * 32 + 8 * fq;
        float ml[2][4];
        f32x4 sl[8];
#pragma unroll
        for (int it = 0; it < 8; ++it) sl[it] = *(const f32x4*)(ssq + (size_t)(row0 + (it >> 2) * HALF + (it & 3) * 16) * 16 + fq * 4);
        __builtin_amdgcn_sched_barrier(0);
#pragma unroll
        for (int ai = 0; ai < 2; ++ai)
#pragma unroll
            for (int m = 0; m < 4; ++m) { float ps = (sl[ai * 4 + m][0] + sl[ai * 4 + m][1]) + (sl[ai * 4 + m][2] + sl[ai * 4 + m][3]); ps += __shfl_xor(ps, 16); ps += __shfl_xor(ps, 32);
                const float rs = __builtin_amdgcn_rsqf(ps * (1.0f / 1024.0f) + 1e-6f) * sscale;
                float mx = -3.0e38f;
#pragma unroll
                for (int bj = 0; bj < 2; ++bj)
#pragma unroll
                    for (int n = 0; n < 2; ++n) { f32x4 v = acc[ai][bj][m][n] * rs; acc[ai][bj][m][n] = v; mx = fmaxf(fmaxf(mx, fmaxf(v[0], v[1])), fmaxf(v[2], v[3])); }
                mx = fmaxf(mx, __shfl_xor(mx, 16)); mx = fmaxf(mx, __shfl_xor(mx, 32));
                float s = 0.f;
#pragma unroll
                for (int bj = 0; bj < 2; ++bj)
#pragma unroll
                    for (int n = 0; n < 2; ++n) { f32x4 v = acc[ai][bj][m][n];
                        v[0] = __builtin_amdgcn_exp2f(v[0] - mx); v[1] = __builtin_amdgcn_exp2f(v[1] - mx); v[2] = __builtin_amdgcn_exp2f(v[2] - mx); v[3] = __builtin_amdgcn_exp2f(v[3] - mx);
                        acc[ai][bj][m][n] = v; s += (v[0] + v[1]) + (v[2] + v[3]); }
                s += __shfl_xor(s, 16); s += __shfl_xor(s, 32);
                ml[ai][m] = mx;
                if (fq == 0) X[(ai * HALF + wr * 64 + m * 16 + fr) * 4 + wc] = (f32x2){mx, s}; }
        asm volatile("s_waitcnt lgkmcnt(0)" ::: "memory"); __builtin_amdgcn_s_barrier(); asm volatile("" ::: "memory");
#pragma unroll
        for (int ai = 0; ai < 2; ++ai)
#pragma unroll
            for (int m = 0; m < 4; ++m) { const int rl = ai * HALF + wr * 64 + m * 16 + fr; const int row = u.pm * BM + rl;
                const f32x2 a = X[rl * 4 + 0], b = X[rl * 4 + 1], c = X[rl * 4 + 2], d = X[rl * 4 + 3];
                const float Mx = fmaxf(fmaxf(a.x, b.x), fmaxf(c.x, d.x));
                const float L = a.y * __builtin_amdgcn_exp2f(a.x - Mx) + b.y * __builtin_amdgcn_exp2f(b.x - Mx) + c.y * __builtin_amdgcn_exp2f(c.x - Mx) + d.y * __builtin_amdgcn_exp2f(d.x - Mx);
                const float f = __builtin_amdgcn_exp2f(ml[ai][m] - Mx) * __builtin_amdgcn_rcpf(L) * 256.0f;
                unsigned char* rowp = P + (size_t)row * 1024 + col0;
#pragma unroll
                for (int bj = 0; bj < 2; ++bj) { const f32x4 v0 = acc[ai][bj][m][0] * f, v1 = acc[ai][bj][m][1] * f;
                    *(u32x2*)(rowp + bj * HALF) = (u32x2){pk4_fp8(v0[0], v0[1], v0[2], v0[3]), pk4_fp8(v1[0], v1[1], v1[2], v1[3])}; } }
    }
};
struct EpiGate {
    static constexpr bool PERM = false;
    unsigned* sel;
    __device__ __forceinline__ void operator()(AccT& acc, const Unit& u, int wr, int wc, int fr, int fq, PG8_LAS unsigned char*) const {
        const int own = u.pm & 31;
#pragma unroll
        for (int ai = 0; ai < 2; ++ai)
#pragma unroll
            for (int m = 0; m < 4; ++m) { const int row = u.pm * BM + ai * HALF + wr * 64 + m * 16 + fr;
#pragma unroll
                for (int n = 0; n < 2; ++n) { unsigned mask = 0u;
#pragma unroll
                    for (int round = 0; round < 3; ++round) { float bv = -3.0e38f; int bi = 32;
#pragma unroll
                        for (int bj = 0; bj < 2; ++bj)
#pragma unroll
                            for (int i = 0; i < 4; ++i) { const int nb = 16 * bj + 4 * fq + i; const float v = acc[ai][bj][m][n][i];
                                if (nb < own && !((mask >> nb) & 1u) && v > bv) { bv = v; bi = nb; } }
#pragma unroll
                        for (int off = 16; off <= 32; off <<= 1) { const float ov = __shfl_xor(bv, off); const int oi = __shfl_xor(bi, off); if (ov > bv || (ov == bv && oi < bi)) { bv = ov; bi = oi; } }
                        if (bi < 32) mask |= 1u << bi; }
                    if (fq == 0) sel[((size_t)((u.pm >> 5) * 8 + 2 * wc + n)) * 8192 + (row & 8191)] = mask; } }
    }
};

template <class Epi, class Sched, bool ALIGN_EPI, bool F8 = false, bool CANSKIP = false>
__device__ __forceinline__ void gemm_phase(PG8_LAS unsigned char* lds, PG8_LAS unsigned char* xl, const Gemm g, const Sched& S, const Epi& E) {
    int tid_ = threadIdx.x; asm volatile("" : "+v"(tid_));
    const int tid = tid_, wid = __builtin_amdgcn_readfirstlane(tid >> 6), lane = tid & 63, wr = wid >> 2, wc = wid & 3, fr = lane & 15, fq = lane >> 4;
    int nt = g.nt; asm volatile("" : "+s"(nt));
    unsigned voffA[2], voffB[2];
#pragma unroll
    for (int i = 0; i < 2; ++i) { int R, C; stage_rc(tid * 16 + i * 8192, R, C); const int Rb = Epi::PERM ? ((R & ~31) + perm32(R & 31)) : R;
        voffA[i] = (unsigned)(R * g.lda + C * 2); voffB[i] = (unsigned)(Rb * g.ldb + C * 2); }
    const size_t kstep = (size_t)(BK * 2);
    const size_t hstepA = (size_t)HALF * g.lda, hstepB = (size_t)HALF * g.ldb;
    const unsigned wmask = g.wrapmask;
    const unsigned ldsw = (unsigned)wid * 1024u;
    const int aoff = lds_byte(wr * 64 + fr, fq * 8), boff = lds_byte(wc * 32 + fr, fq * 8);
#define PG8_SA(b, h) (((b) * 2 + (h)) * HTB)
#define PG8_SB(b, h) ((4 + (b) * 2 + (h)) * HTB)
#define PG8_STAGE(bufoff, gbase, voff) do { _Pragma("unroll") for (int _i = 0; _i < 2; ++_i) \
        __builtin_amdgcn_global_load_lds((const unsigned*)((const char*)(gbase) + (voff)[_i]), (PG8_LAS unsigned*)(lds + (bufoff) + ldsw + _i * 8192), 16, 0, 0); } while (0)
#define PG8_LDA(dst, b, h) do { if constexpr (F8) { _Pragma("unroll") for (int m = 0; m < 4; ++m) { dst##8[m].lo = *(const PG8_LAS i32x4*)(lds + PG8_SA(b, h) + aoff + m * 2048); dst##8[m].hi = *(const PG8_LAS i32x4*)(lds + PG8_SA(b, h) + aoff + m * 2048 + 1024); } } \
        else { _Pragma("unroll") for (int m = 0; m < 4; ++m) _Pragma("unroll") for (int k = 0; k < 2; ++k) dst[m][k] = *(const PG8_LAS bf16x8*)(lds + PG8_SA(b, h) + aoff + m * 2048 + k * 1024); } } while (0)
#define PG8_LDB(dst, b, h) do { if constexpr (F8) { _Pragma("unroll") for (int n = 0; n < 2; ++n) { dst##8[n].lo = *(const PG8_LAS i32x4*)(lds + PG8_SB(b, h) + boff + n * 2048); dst##8[n].hi = *(const PG8_LAS i32x4*)(lds + PG8_SB(b, h) + boff + n * 2048 + 1024); } } \
        else { _Pragma("unroll") for (int n = 0; n < 2; ++n) _Pragma("unroll") for (int k = 0; k < 2; ++k) dst[n][k] = *(const PG8_LAS bf16x8*)(lds + PG8_SB(b, h) + boff + n * 2048 + k * 1024); } } while (0)
#define PG8_MMA(ai, bj, At, Bt) do { __builtin_amdgcn_s_setprio(1); \
        if constexpr (F8) { _Pragma("unroll") for (int m = 0; m < 4; ++m) _Pragma("unroll") for (int n = 0; n < 2; ++n) \
            asm volatile("v_mfma_f32_16x16x128_f8f6f4 %0, %1, %2, %0" : "+v"(acc[ai][bj][m][n]) : "v"(Bt##8[n]), "v"(At##8[m])); } \
        else { _Pragma("unroll") for (int m = 0; m < 4; ++m) _Pragma("unroll") for (int n = 0; n < 2; ++n) _Pragma("unroll") for (int k = 0; k < 2; ++k) \
            acc[ai][bj][m][n] = __builtin_amdgcn_mfma_f32_16x16x32_bf16(Bt[n][k], At[m][k], acc[ai][bj][m][n], 0, 0, 0); } \
        __builtin_amdgcn_s_setprio(0); } while (0)
#define PG8_WAIT_V(n) asm volatile("s_waitcnt vmcnt(" #n ")" ::: "memory")
#define PG8_WAIT_L(n) asm volatile("s_waitcnt lgkmcnt(" #n ")" ::: "memory")
#define PG8_BAR __builtin_amdgcn_s_barrier()
#define PG8_SCHED __builtin_amdgcn_sched_barrier(0)
    Unit cur, nxt; int ui = 0;
    if (!S.next(0, cur)) return;
    AccT acc;
    bf16x8 At[4][2], B0[2][2], B1[2][2]; i32x8 At8[4], B08[2], B18[2];
    const char* cA = (const char*)g.A + cur.aoff; const char* cB = (const char*)g.Bt + cur.boff;
    PG8_STAGE(PG8_SB(0, 0), cB, voffB); PG8_STAGE(PG8_SB(0, 1), cB + hstepB, voffB); PG8_STAGE(PG8_SA(0, 0), cA, voffA); PG8_STAGE(PG8_SA(0, 1), cA + hstepA, voffA);
    if (wr == 1) PG8_BAR;
    PG8_WAIT_V(2); PG8_BAR;
    PG8_STAGE(PG8_SB(1, 0), cB + kstep, voffB); PG8_STAGE(PG8_SA(1, 0), cA + kstep, voffA); PG8_STAGE(PG8_SB(1, 1), cB + hstepB + kstep, voffB);
    PG8_WAIT_V(6); PG8_BAR;
    { float z0; asm volatile("v_mov_b32 %0, 0" : "=v"(z0));
#pragma unroll
    for (int a = 0; a < 2; ++a)
#pragma unroll
        for (int b = 0; b < 2; ++b)
#pragma unroll
            for (int m = 0; m < 4; ++m)
#pragma unroll
                for (int n = 0; n < 2; ++n) acc[a][b][m][n] = (f32x4){z0, z0, z0, z0}; }
    for (;;) {
        const bool has_next = S.next(ui + 1, nxt);
        const char* nA = has_next ? (const char*)g.A + nxt.aoff : cA; const char* nB = has_next ? (const char*)g.Bt + nxt.boff : cB;
#pragma unroll 1
        for (int t = 0; t < nt; t += 2) {
            const bool last = (t == nt - 2);
            const char* a1 = cA + (size_t)((unsigned)(t * 128) & wmask) + kstep;
            const char* a2 = last ? nA : cA + (size_t)((unsigned)((t + 2) * 128) & wmask); const char* b2 = last ? nB : cB + (size_t)(t + 2) * kstep;
            const char* a3 = a2 + kstep; const char* b3 = b2 + kstep;
            PG8_LDB(B0, 0, 0); if (!(CANSKIP && cur.skipb1)) PG8_LDB(B1, 0, 1); PG8_SCHED; PG8_LDA(At, 0, 0); PG8_STAGE(PG8_SA(1, 1), a1 + hstepA, voffA);
            PG8_WAIT_V(8); PG8_WAIT_L(0); PG8_BAR; PG8_MMA(0, 0, At, B0); if (!(CANSKIP && cur.skipb1)) PG8_MMA(0, 1, At, B1); PG8_BAR; PG8_SCHED;
            PG8_LDA(At, 0, 1); PG8_STAGE(PG8_SB(0, 0), b2, voffB); PG8_STAGE(PG8_SB(0, 1), b2 + hstepB, voffB); PG8_STAGE(PG8_SA(0, 0), a2, voffA);
            PG8_WAIT_V(8); PG8_WAIT_L(0); PG8_BAR; PG8_MMA(1, 0, At, B0); if (!(CANSKIP && cur.skipb1)) PG8_MMA(1, 1, At, B1); PG8_BAR; PG8_SCHED;
            PG8_LDB(B0, 1, 0); if (!(CANSKIP && cur.skipb1)) PG8_LDB(B1, 1, 1); PG8_SCHED; PG8_LDA(At, 1, 0); PG8_STAGE(PG8_SA(0, 1), a2 + hstepA, voffA);
            PG8_WAIT_V(8); PG8_WAIT_L(0); PG8_BAR; PG8_MMA(0, 0, At, B0); if (!(CANSKIP && cur.skipb1)) PG8_MMA(0, 1, At, B1); PG8_BAR; PG8_SCHED;
            PG8_LDA(At, 1, 1); PG8_STAGE(PG8_SB(1, 0), b3, voffB); PG8_STAGE(PG8_SB(1, 1), b3 + hstepB, voffB); PG8_STAGE(PG8_SA(1, 0), a3, voffA);
            PG8_WAIT_V(8); PG8_WAIT_L(0); PG8_BAR; PG8_MMA(1, 0, At, B0); if (!(CANSKIP && cur.skipb1)) PG8_MMA(1, 1, At, B1); PG8_BAR; PG8_SCHED;
        }
        if constexpr (F8) asm volatile("s_nop 15\n\ts_nop 15" ::: "memory");
        if constexpr (ALIGN_EPI) { if (wr == 0) PG8_BAR; }
        E(acc, cur, wr, wc, fr, fq, xl);
        if (!has_next) break;
#pragma unroll
        for (int a = 0; a < 2; ++a)
#pragma unroll
            for (int b = 0; b < 2; ++b)
#pragma unroll
                for (int m = 0; m < 4; ++m)
#pragma unroll
                    for (int n = 0; n < 2; ++n) acc[a][b][m][n] = (f32x4){0.f, 0.f, 0.f, 0.f};
        cur = nxt; cA = nA; cB = nB; ++ui;
        if constexpr (ALIGN_EPI) { if (wr == 1) PG8_BAR; }
    }
    PG8_WAIT_V(0);
    if constexpr (!ALIGN_EPI) { if (wr == 0) PG8_BAR; }
    PG8_BAR;
#undef PG8_SA
#undef PG8_SB
#undef PG8_STAGE
#undef PG8_LDA
#undef PG8_LDB
#undef PG8_MMA
#undef PG8_WAIT_V
#undef PG8_WAIT_L
#undef PG8_BAR
#undef PG8_SCHED
}
}

constexpr int NWAVES = 8;
constexpr int NB = 8, T = 8192, D = 1024, M = NB * T;
constexpr int INC = 3080, NQKV = 3072, FF = 2816;
constexpr int C_F = 1536, C_QM = 1544, C_KM = 2056;
constexpr float LOG2E = 1.4426950408889634f;
constexpr float C2 = 0.125f * LOG2E;
constexpr float RMS_EPS = 1e-6f;

constexpr size_t MiB = 1u << 20;
constexpr size_t WS_CTL = 0, CTL_ZERO_BYTES = 1 * MiB;
constexpr size_t WS_LOGF = 2 * MiB, WS_C = 4 * MiB, WS_ABAR = 6 * MiB, WS_KM = 7 * MiB, WS_SEL = 8 * MiB;
constexpr size_t WS_SSQ1 = 10 * MiB, WS_SSQ2 = 14 * MiB, WS_SSQ3 = 18 * MiB;
constexpr size_t WS_MEMN = 22 * MiB, WS_KV = 26 * MiB, WS_WQS = 34 * MiB, WS_WOT = 36 * MiB, WS_WKVT = 38 * MiB, WS_WINT = 42 * MiB, WS_WOUTT = 48 * MiB;
constexpr size_t WS_WUPT = 50 * MiB, WS_WDT = 976 * MiB  , WS_ZT = 68 * MiB, WS_WQK = 80 * MiB, WS_VWO = 96 * MiB;
constexpr size_t WS_ACT8 = 240 * MiB;
constexpr size_t WS_GH = 416 * MiB, WS_UH = 424 * MiB, WS_GT = 432 * MiB;
constexpr size_t WS_A1 = 112 * MiB;
constexpr size_t WS_QKV = 368 * MiB;
constexpr size_t WS_Y = 752 * MiB, WS_HB1 = WS_A1 + 128 * MiB, WS_P = WS_QKV, WS_HB2 = WS_A1;
constexpr size_t WS_HB1F = WS_A1;
constexpr size_t WS_PO = WS_A1;
constexpr size_t WS_LIST = 880 * MiB, WS_PML = 944 * MiB, WS_KXF = 960 * MiB, WS_KXM = 968 * MiB, WS_CNT = 969 * MiB;
constexpr size_t WS_G = 240 * MiB, WS_U = 592 * MiB, WS_END = 1024 * MiB;
static_assert(WS_WUPT + (size_t)2 * FF * D * 2 <= WS_ZT && WS_ACT8 + (size_t)M * FF <= WS_GH && WS_WDT + (size_t)D * FF <= WS_END && WS_CNT + 8192 <= WS_WDT && WS_ZT + (size_t)8 * 256 * 3072 * 2 <= WS_WQK && WS_VWO + 16 * MiB <= WS_A1, "ws map");
static_assert(WS_G + (size_t)M * FF * 2 <= WS_U && WS_U + (size_t)M * FF * 2 <= WS_END && WS_Y + (size_t)M * D * 2 <= WS_LIST && WS_LIST + (size_t)2048 * 8192 * 4 <= WS_PML && WS_PML + (size_t)M * 32 * 8 <= WS_KXF && WS_KXF + (size_t)64 * 8192 * 16 <= WS_KXM, "ws map 2");
constexpr int CW_BAR = 4096;
constexpr int CW_QKN = 8192;
constexpr int CW_QUEUE = 12288;
constexpr int CW_T0TAB = 16384;
constexpr int CW_CNT_KM = 24576, CW_CNT_Z = 24640, CW_CNT_KV = 24704;
constexpr int CW_PANEL = 32768, CW_TMO2 = 20480;

constexpr int RING_OFF = 0, RING_BYTES = 131072;
constexpr int LDSCTL_OFF = RING_BYTES, MISC_OFF = LDSCTL_OFF + 320;
constexpr int XL_OFF = RING_BYTES + 512;
constexpr int LDS_BYTES = 147456;
static_assert(XL_OFF + 8192 <= LDS_BYTES, "LDS map");

#define GAS __attribute__((address_space(1)))
#define LAS __attribute__((address_space(3)))
typedef unsigned short bf16;
typedef unsigned v4u __attribute__((ext_vector_type(4)));
typedef float f32x4 __attribute__((ext_vector_type(4)));
typedef GAS unsigned gu32;
#define RLX_AGENT __ATOMIC_RELAXED, __HIP_MEMORY_SCOPE_AGENT
#define LDS_WAIT() asm volatile("s_waitcnt lgkmcnt(0)" ::: "memory")
__device__ __forceinline__ unsigned f2bf(float f) { unsigned u = __builtin_bit_cast(unsigned, f); return (u + 0x7fffu + ((u >> 16) & 1u)) >> 16; }
__device__ __forceinline__ unsigned pk2(float lo, float hi) { unsigned r; asm("v_cvt_pk_bf16_f32 %0, %1, %2" : "=v"(r) : "v"(lo), "v"(hi)); return r; }
__device__ __forceinline__ float bf2f(unsigned b) { return __builtin_bit_cast(float, b << 16); }
__device__ __forceinline__ float bflo(unsigned w) { return __builtin_bit_cast(float, w << 16); }
__device__ __forceinline__ float bfhi(unsigned w) { return __builtin_bit_cast(float, w & 0xffff0000u); }

#define XB_TMO      128
#define XB_XCNT(j)  (256  + 64 * (j))
#define XB_XSUB(j)  (1280 + 64 * (j))
#define XB_XGEN(j)  (2304 + 64 * (j))
#define XB_TOP      3328
#define XB_TOPGEN   3392
#define XCD_BAR_WORDS 3456
#define XB_SPIN_CAP (1u << 18)

__device__ __forceinline__ unsigned xb_ld(unsigned* p)              { return __hip_atomic_load(p, __ATOMIC_RELAXED, __HIP_MEMORY_SCOPE_AGENT); }
__device__ __forceinline__ unsigned xb_add(unsigned* p, unsigned v) { return __hip_atomic_fetch_add(p, v, __ATOMIC_RELAXED, __HIP_MEMORY_SCOPE_AGENT); }
__device__ __forceinline__ unsigned xb_xcc_id() { return (unsigned)__builtin_amdgcn_s_getreg((3 << 11) | 20) & 0xFu; }
#define XB_SPIN(cond, bar) do { unsigned _sp = 0; while (cond) { __builtin_amdgcn_s_sleep(1); \
    if ((++_sp & 255u) == 0u) { if (xb_ld(&(bar)[XB_TMO])) break; if (_sp > XB_SPIN_CAP) { atomicAdd(&(bar)[XB_TMO], 1u); break; } } } } while (0)

struct XcdBarrier { unsigned* bar; unsigned x; volatile LAS unsigned* st; };

__device__ __forceinline__ XcdBarrier xcd_barrier_post(unsigned* bar, volatile LAS unsigned* st) {
    XcdBarrier b; b.bar = bar; b.x = xb_xcc_id(); b.st = st;
    if (threadIdx.x == 0) (void)xb_add(&bar[XB_XCNT(b.x)], 1u);
    return b;
}
__device__ __forceinline__ void xcd_barrier_complete(unsigned* bar, unsigned x, unsigned& nloc, unsigned& nx) {
    const unsigned G = gridDim.x * gridDim.y * gridDim.z;
    unsigned sum, cnt, mine, sp = 0u;
    for (;;) {
        sum = 0u; cnt = 0u; mine = 0u;
#pragma unroll
        for (unsigned j = 0; j < 16; ++j) { const unsigned c = xb_ld(&bar[XB_XCNT(j)]); sum += c; cnt += (c > 0u) ? 1u : 0u; mine = (j == x) ? c : mine; }
        if (sum == G) break;
        __builtin_amdgcn_s_sleep(1);
        if ((++sp & 255u) == 0u) { if (xb_ld(&bar[XB_TMO])) break; if (sp > XB_SPIN_CAP) { atomicAdd(&bar[XB_TMO], 1u); break; } }
    }
    nloc = mine > 0u ? mine : 1u; nx = cnt > 0u ? cnt : 1u;
}
__device__ __forceinline__ void xcd_barrier(const XcdBarrier& b) {
    asm volatile("s_waitcnt vmcnt(0)" ::: "memory");
    __syncthreads();
    if (threadIdx.x == 0) {
        unsigned* bar = b.bar;
        __builtin_amdgcn_s_waitcnt(0);
        unsigned nloc = b.st[0], nx = b.st[1];
        if (nloc == 0u) { xcd_barrier_complete(bar, b.x, nloc, nx); b.st[0] = nloc; b.st[1] = nx; }
        const unsigned old = xb_add(&bar[XB_XSUB(b.x)], 1u);
        const unsigned gen = old / nloc;
        if (old + 1u == (gen + 1u) * nloc) {
            __builtin_amdgcn_fence(__ATOMIC_RELEASE, "agent");
            asm volatile("s_waitcnt vmcnt(0)" ::: "memory");
            const unsigned og = xb_add(&bar[XB_TOP], 1u);
            const unsigned tg = og / nx;
            if (og + 1u == (tg + 1u) * nx) xb_add(&bar[XB_TOPGEN], 1u);
            else XB_SPIN(xb_ld(&bar[XB_TOPGEN]) == tg, bar);
            __builtin_amdgcn_fence(__ATOMIC_ACQUIRE, "agent");
            xb_add(&bar[XB_XGEN(b.x)], 1u);
            asm volatile("s_waitcnt vmcnt(0)" ::: "memory");
        } else {
            XB_SPIN(xb_ld(&bar[XB_XGEN(b.x)]) == gen, bar);
            __builtin_amdgcn_fence(__ATOMIC_ACQUIRE, "agent");
            asm volatile("s_waitcnt vmcnt(0)" ::: "memory");
        }
    }
    __syncthreads();
}

__device__ __forceinline__ float wave_sum(float v) {
#pragma unroll
    for (int o = 1; o < 64; o <<= 1) v += __shfl_xor(v, o);
    return v;
}
__device__ __forceinline__ void p0_transpose_item(const float* W, int ldw, int K, int N, bf16* WT, const float* kscale, bool remap, LAS float* scr, int item, int lane, float f8scale = 0.f, bool upmap = false) {
    const int nblk = N / 64, kb = item / nblk, nb = item % nblk, k0 = 32 * kb, n0 = 64 * nb;
    int sn0 = (remap && n0 >= 1536) ? n0 + 8 : n0;
    if (upmap) { const int within = n0 & 255, pt = n0 >> 8; sn0 = within < 128 ? 128 * pt + within : 2816 + 128 * pt + (within - 128); }
    float v[32];
#pragma unroll
    for (int i = 0; i < 32; ++i) v[i] = W[(size_t)(k0 + i) * ldw + sn0 + lane];
#pragma unroll
    for (int i = 0; i < 32; ++i) { float x = v[i]; if (kscale) x *= kscale[k0 + i]; scr[i * 65 + lane] = x; }
    LDS_WAIT(); asm volatile("" ::: "memory");
    const int kq = lane & 3;
#pragma unroll
    for (int j = 0; j < 4; ++j) { const int n = (lane >> 2) + 16 * j; const LAS float* sp = scr + (8 * kq) * 65 + n;
        if (f8scale != 0.f) { const unsigned lo = pg8::pk4_fp8(sp[0 * 65] * f8scale, sp[1 * 65] * f8scale, sp[2 * 65] * f8scale, sp[3 * 65] * f8scale), hi = pg8::pk4_fp8(sp[4 * 65] * f8scale, sp[5 * 65] * f8scale, sp[6 * 65] * f8scale, sp[7 * 65] * f8scale);
            *(GAS unsigned long long*)((unsigned char*)WT + (size_t)(n0 + n) * K + k0 + 8 * kq) = (unsigned long long)lo | ((unsigned long long)hi << 32); }
        else { v4u o; o.x = pk2(sp[0 * 65], sp[1 * 65]); o.y = pk2(sp[2 * 65], sp[3 * 65]); o.z = pk2(sp[4 * 65], sp[5 * 65]); o.w = pk2(sp[6 * 65], sp[7 * 65]);
            *(GAS v4u*)(WT + (size_t)(n0 + n) * K + k0 + 8 * kq) = o; } }
    LDS_WAIT(); asm volatile("" ::: "memory");
}

struct Args { const float* in[19]; float* out; unsigned char* ws; };
__device__ __forceinline__ float skip_thr(const unsigned* qk8, int moba) {
    const unsigned* p = qk8 + 4 * moba;
    const float qn = sqrtf(__uint_as_float(__hip_atomic_load(p, RLX_AGENT)) + __uint_as_float(__hip_atomic_load(p + 1, RLX_AGENT))), kn = sqrtf(__uint_as_float(__hip_atomic_load(p + 2, RLX_AGENT)) + __uint_as_float(__hip_atomic_load(p + 3, RLX_AGENT)));
    return 2.0f * qn * kn * 1.02f + 40.0f;
}
__device__ __forceinline__ bool moba_skip(int h, int j, int n, float thr) { return __builtin_amdgcn_exp2f(-(float)(h + 1)) * LOG2E * (float)(256 * (j - n - 1) + 1) >= thr; }

namespace attn_body {
using hb16=__hip_bfloat16;
using bf16x8=__attribute__((ext_vector_type(8)))short;
using s16x4=__attribute__((ext_vector_type(4)))short;
using f32x16=__attribute__((ext_vector_type(16)))float;
using u32x4=__attribute__((ext_vector_type(4)))unsigned;
constexpr int PITCH=3072;
constexpr int NW=8,QBLK=32,QB=QBLK*NW,KVBLK=64;
__device__ __forceinline__ int crow(int r,int hi){return (r&3)+8*(r>>2)+4*hi;}
#define SBAR() __builtin_amdgcn_sched_barrier(0)
__device__ __forceinline__ void cmask(f32x16&p0,f32x16&p1,int jb,int qrel,int hi){
  const float NEG=-INFINITY; int kb=64*jb+4*hi;
  #pragma unroll
  for(int r=0;r<16;++r){int kv=kb+(r&3)+8*(r>>2); if(kv>qrel)p0[r]=NEG; if(kv+32>qrel)p1[r]=NEG;}
}
constexpr int NSLOT=3, SLOTB=9216;
constexpr int LDS_K=0, LDS_V=NSLOT*SLOTB, LDS_WS=2*NSLOT*SLOTB, LDS_OST=LDS_WS+NW*64*4, LDS_BYTES=LDS_OST+NW*4096;
__device__ __forceinline__ void glds16(const void*gsrc,unsigned lds_dst){unsigned keep;
  asm volatile("s_mov_b32 %0, m0\n\ts_mov_b32 m0, %2\n\ts_nop 0\n\tglobal_load_lds_dwordx4 %1, off\n\ts_mov_b32 m0, %0":"=&s"(keep):"v"(gsrc),"s"(lds_dst):"memory");}
__device__ __forceinline__ void glds16x(const void*gsrc,unsigned lds_dst){unsigned keep;unsigned long long ex;
  asm volatile("s_mov_b32 %0, m0\n\ts_mov_b64 %1, exec\n\ts_mov_b64 exec, 0xff\n\ts_mov_b32 m0, %3\n\ts_nop 0\n\tglobal_load_lds_dwordx4 %2, off\n\ts_mov_b64 exec, %1\n\ts_mov_b32 m0, %0":"=&s"(keep),"=&s"(ex):"v"(gsrc),"s"(lds_dst):"memory");}
__device__ __forceinline__ float max3f(float a,float b,float c){float r;asm("v_max3_f32 %0, %1, %2, %3":"=v"(r):"v"(a),"v"(b),"v"(c));return r;}
__device__ __forceinline__ float max2f(float a,float b){float r;asm("v_max_f32_e32 %0, %1, %2":"=v"(r):"v"(a),"v"(b));return r;}
__device__ __forceinline__ float fsub_s(float a,float b){float r;asm("v_sub_f32_e32 %0, %1, %2":"=v"(r):"v"(a),"v"(b));return r;}
typedef float f32x2_t __attribute__((ext_vector_type(2))); typedef __bf16 bf16x2_t __attribute__((ext_vector_type(2)));
__device__ __forceinline__ unsigned cvtpk_s(float lo,float hi){f32x2_t v={lo,hi};bf16x2_t b=__builtin_convertvector(v,bf16x2_t);return __builtin_bit_cast(unsigned,b);}
__device__ __forceinline__ float rbf(float x){return __builtin_bit_cast(float,cvtpk_s(x,0.f)<<16);}
#define WAIT_BAR(N) asm volatile("s_waitcnt vmcnt(" #N ") lgkmcnt(0)\n\ts_barrier":::"memory")

__device__ __forceinline__ void qkt(f32x16&p0,f32x16&p1,const char*Kslot,const bf16x8*qr,int r32,int hi){
  const char*kb=Kslot+hi*1024+r32*16; const f32x16 zf={};
  #pragma unroll
  for(int d0=0;d0<4;++d0){
    const bf16x8 b0=*reinterpret_cast<const bf16x8*>(kb+d0*2048);
    const bf16x8 b1=*reinterpret_cast<const bf16x8*>(kb+d0*2048+512);
    if(d0==0){p0=__builtin_amdgcn_mfma_f32_32x32x16_bf16(b0,qr[0],zf,0,0,0);p1=__builtin_amdgcn_mfma_f32_32x32x16_bf16(b1,qr[0],zf,0,0,0);}
    else{p0=__builtin_amdgcn_mfma_f32_32x32x16_bf16(b0,qr[d0],p0,0,0,0);p1=__builtin_amdgcn_mfma_f32_32x32x16_bf16(b1,qr[d0],p1,0,0,0);}}
  const char*kx=Kslot+8192+r32*16;
  const bf16x8 x0=*reinterpret_cast<const bf16x8*>(kx), x1=*reinterpret_cast<const bf16x8*>(kx+512);
  p0=__builtin_amdgcn_mfma_f32_32x32x16_bf16(x0,qr[4],p0,0,0,0);p1=__builtin_amdgcn_mfma_f32_32x32x16_bf16(x1,qr[4],p1,0,0,0);
}
typedef __attribute__((address_space(3))) const char* lds_cptr;
typedef short v4i16_t __attribute__((ext_vector_type(4)));
__device__ __forceinline__ void kload10(bf16x8*kf,lds_cptr kp,lds_cptr kx){
  kf[0]=*(const __attribute__((address_space(3))) bf16x8*)(kp);      kf[1]=*(const __attribute__((address_space(3))) bf16x8*)(kp+512);
  kf[2]=*(const __attribute__((address_space(3))) bf16x8*)(kp+2048); kf[3]=*(const __attribute__((address_space(3))) bf16x8*)(kp+2560);
  kf[4]=*(const __attribute__((address_space(3))) bf16x8*)(kp+4096); kf[5]=*(const __attribute__((address_space(3))) bf16x8*)(kp+4608);
  kf[6]=*(const __attribute__((address_space(3))) bf16x8*)(kp+6144); kf[7]=*(const __attribute__((address_space(3))) bf16x8*)(kp+6656);
  kf[8]=*(const __attribute__((address_space(3))) bf16x8*)(kx);      kf[9]=*(const __attribute__((address_space(3))) bf16x8*)(kx+512);
}
__device__ __forceinline__ void kload2(bf16x8*kf,lds_cptr kp,int j){ kf[2*j]=*(const __attribute__((address_space(3))) bf16x8*)(kp+j*2048); kf[2*j+1]=*(const __attribute__((address_space(3))) bf16x8*)(kp+j*2048+512); }
__device__ __forceinline__ s16x4 vtr(lds_cptr p){ return __builtin_bit_cast(s16x4,__builtin_amdgcn_ds_read_tr16_b64_v4i16((__attribute__((address_space(3))) v4i16_t*)p)); }
__device__ __forceinline__ float rowmax(const f32x16&p0,const f32x16&p1){
  float a=max3f(p0[0],p0[1],p1[0]),b=max3f(p0[2],p0[3],p1[1]);a=max3f(a,p1[2],p1[3]);
  #pragma unroll
  for(int r=4;r<16;r+=4){a=max3f(a,p0[r],p0[r+1]);b=max3f(b,p0[r+2],p0[r+3]);a=max3f(a,p1[r],p1[r+1]);b=max3f(b,p1[r+2],p1[r+3]);}
  const float m=max2f(a,b);
  auto rr=__builtin_amdgcn_permlane32_swap(__float_as_uint(m),__float_as_uint(m),false,false);
  return max2f(__uint_as_float(rr[0]),__uint_as_float(rr[1]));
}
__device__ __forceinline__ void pv(f32x16*o,int vb,bf16x8 pa0,bf16x8 pa1,bf16x8 pa2,bf16x8 pa3){
  #pragma unroll
  for(int d0=0;d0<2;++d0){s16x4 lo[4],hi[4];
    #pragma unroll
    for(int ks=0;ks<4;++ks){
      asm volatile("ds_read_b64_tr_b16 %0,%1 offset:%c2":"=&v"(lo[ks]):"v"(vb),"i"(d0*4096+ks*1024):"memory");
      asm volatile("ds_read_b64_tr_b16 %0,%1 offset:%c2":"=&v"(hi[ks]):"v"(vb),"i"(d0*4096+ks*1024+512):"memory");}
    asm volatile("s_waitcnt lgkmcnt(0)":::"memory");SBAR();
    #define PK(k) (bf16x8){lo[k][0],lo[k][1],lo[k][2],lo[k][3],hi[k][0],hi[k][1],hi[k][2],hi[k][3]}
    o[d0]=__builtin_amdgcn_mfma_f32_32x32x16_bf16(pa0,PK(0),o[d0],0,0,0);
    o[d0]=__builtin_amdgcn_mfma_f32_32x32x16_bf16(pa1,PK(1),o[d0],0,0,0);
    o[d0]=__builtin_amdgcn_mfma_f32_32x32x16_bf16(pa2,PK(2),o[d0],0,0,0);
    o[d0]=__builtin_amdgcn_mfma_f32_32x32x16_bf16(pa3,PK(3),o[d0],0,0,0);
    #undef PK
  }
}

template<int THRL> __device__ __forceinline__ void attn_unit(char*shm,const int KIND,const hb16*Qc,int qrow,int oslot,const hb16*__restrict__ Kt0,const hb16*__restrict__ Vt0,const hb16*__restrict__ KXt0,int NT,int band0,hb16*Oc,hb16*PO,float*PML){
  const int tid=threadIdx.x,lane=tid&63,r32=lane&31,hi=lane>>5; const int wid=__builtin_amdgcn_readfirstlane(tid>>6);
  const unsigned lds0=(unsigned)(uintptr_t)shm;
  float*wsf=(float*)(shm+LDS_WS)+wid*64;
  const hb16*ksrc=Kt0+(long)lane*PITCH+wid*8;
  const hb16*vsrc=Vt0+(long)(16*(wid&3)+(lane>>2))*PITCH+(wid>>2)*32+(lane&3)*8;
  const hb16*xsrc=KXt0+(long)(8*wid+(lane&7))*8;
  const unsigned kdst=lds0+LDS_K+wid*1024, vdst=lds0+LDS_V+wid*1024, xdst=lds0+LDS_K+8192+wid*128;
  #define DMA_K(t,slot) do{ glds16(ksrc+(long)(t)*KVBLK*PITCH,(unsigned)__builtin_amdgcn_readfirstlane(kdst+(slot))); glds16x(xsrc+(long)(t)*KVBLK*8,(unsigned)__builtin_amdgcn_readfirstlane(xdst+(slot))); }while(0)
  #define DMA_V(t,slot) glds16(vsrc+(long)(t)*KVBLK*PITCH,(unsigned)__builtin_amdgcn_readfirstlane(vdst+(slot)))
  const int vb0=(int)(lds0+LDS_V)+((lane>>4)&1)*32+(lane&3)*8+(4*hi+((lane&15)>>2))*64;
  const char*Kbase=shm+LDS_K; bf16x8 kf[10];
  const lds_cptr shm3=(lds_cptr)shm; const lds_cptr kp0=shm3+LDS_K+hi*1024+r32*16; const lds_cptr kx0=shm3+LDS_K+8192+r32*16; const lds_cptr vp0=shm3+LDS_V+((lane>>4)&1)*32+(lane&3)*8+(4*hi+((lane&15)>>2))*64;
  DMA_K(0,0);DMA_V(0,0);DMA_K(1,SLOTB);
  bf16x8 qr[5];
  { const hb16*Qw=Qc+(long)qrow*PITCH;
    #pragma unroll
    for(int d0=0;d0<4;++d0)qr[d0]=*reinterpret_cast<const bf16x8*>(&Qw[d0*16+hi*8]); }
  float mhat=0.f,l_reg=0.f;f32x16 o[2];o[0]=f32x16{};o[1]=f32x16{};
  #define SETQX(mh_,ml_) do{ const unsigned bh_=cvtpk_s(-(mh_),-(ml_)); u32x4 qx_; qx_.x=0x3F803F80u; qx_.y=0x3F80u|(bh_<<16); qx_.z=(bh_>>16); qx_.w=0u; if(hi){qx_.x=0u;qx_.y=0u;qx_.z=0u;} qr[4]=__builtin_bit_cast(bf16x8,qx_); asm volatile("":"+v"(qr[4])); }while(0)
  #define MOVEREF(gain) const float mraw_=mhat+(gain); const float mh_=rbf(mraw_); const float ml_=rbf(mraw_-mh_); const float mnew_=mh_+ml_; const float dl=mnew_-mhat; mhat=mnew_; SETQX(mh_,ml_);
  SETQX(0.f,0.f);
  const int qrel=wid*QBLK+r32;
  #define CMASK(P0,P1,t) do{int jb_=(t)-band0; if(jb_>=0)cmask(P0,P1,jb_,qrel,hi);}while(0)
  bool resc=false;
  #define START(P0,P1) do{ const float rm=rowmax(P0,P1); resc=false; \
    { MOVEREF(rm) \
      _Pragma("unroll") for(int r=0;r<16;++r){P0[r]=fsub_s(P0[r],dl);P1[r]=fsub_s(P1[r],dl);} } \
    _Pragma("unroll") for(int r=0;r<16;++r)P0[r]=__builtin_amdgcn_exp2f(P0[r]); }while(0)
  #define RESC() do{ if(resc){ asm volatile("s_waitcnt lgkmcnt(0)":::"memory"); \
      _Pragma("unroll") for(int d_=0;d_<2;++d_) _Pragma("unroll") for(int r=0;r<16;++r)o[d_][r]*=wsf[crow(r,hi)]; } }while(0)
  f32x16 pA0,pA1,pB0,pB1;
  int sl_prev=0,sl_cur=0,sl_next=SLOTB;
  #define ROT() do{sl_prev=sl_cur;sl_cur=sl_next;sl_next=(sl_next==(NSLOT-1)*SLOTB)?0:sl_next+SLOTB;}while(0)
  DMA_K(2,2*SLOTB);
  WAIT_BAR(5);
  qkt(pA0,pA1,Kbase,qr,r32,hi);asm volatile("s_nop 15\n\ts_nop 7":"+v"(pA0),"+v"(pA1));CMASK(pA0,pA1,0);
  START(pA0,pA1);
  _Pragma("unroll") for(int r=0;r<16;++r)pA1[r]=__builtin_amdgcn_exp2f(pA1[r]);
  WAIT_BAR(0);
  DMA_K(3,0);DMA_V(1,SLOTB);
  ROT();
  kload10(kf,kp0+sl_cur,kx0+sl_cur);
  WAIT_BAR(3);
  s16x4 vlo[8],vhi[8]; u32x4 pw0,pw1,pw2,pw3; const f32x16 zf={};
  #define PKW(P,B) cvtpk_s(P[B],P[B+1])
  #define PAF(k) __builtin_bit_cast(bf16x8,pw##k)
  #define VFR(i) (bf16x8){vlo[i][0],vlo[i][1],vlo[i][2],vlo[i][3],vhi[i][0],vhi[i][1],vhi[i][2],vhi[i][3]}
  #define PIN(x) asm volatile("":"+v"(x))
  #define MX3(a,b,c) __builtin_fmaxf(__builtin_fmaxf((a),(b)),(c))
  #define GAPA(MF,A0,A1,A2,A3,W0,W1,PW) do{ MF; sacc+=A0; sacc+=A1; sacc+=A2; sacc+=A3; PIN(sacc); W0; W1; PIN(PW); SBAR(); }while(0)
  #define EX(v) __builtin_amdgcn_exp2f(v)
  #define GAPB(MF,X,B) do{ MF; X[B]=EX(X[B]); X[B+1]=EX(X[B+1]); X[B+2]=EX(X[B+2]); X[B+3]=EX(X[B+3]); PIN(X); SBAR(); }while(0)
  #define VRD(i) do{ vlo[i]=vtr(vp_+(((i)>>2)*4096+((i)&3)*1024)); vhi[i]=vtr(vp_+(((i)>>2)*4096+((i)&3)*1024+512)); }while(0)
  #define KRD(G,j) do{ if(G){ kload2(kf,kp0+sl_next,j); SBAR(); } }while(0)
  #define KRDX(G) do{ if(G){ kf[8]=*(const __attribute__((address_space(3))) bf16x8*)(kx0+sl_next); kf[9]=*(const __attribute__((address_space(3))) bf16x8*)(kx0+sl_next+512); SBAR(); } }while(0)
  #define STEP(C0,C1,P0,P1,t,GK,GV,GL) do{ SBAR(); \
    const lds_cptr vp_=vp0+sl_prev; \
    VRD(0); SBAR(); float sacc=(P0[0]+P0[1]); \
    GAPA(C0=__builtin_amdgcn_mfma_f32_32x32x16_bf16(kf[0],qr[0],zf,0,0,0), P0[2],P0[3],P0[4],P0[5],     pw0[0]=PKW(P0,0), pw0[1]=PKW(P0,2), pw0); \
    VRD(4); SBAR(); GAPA(C1=__builtin_amdgcn_mfma_f32_32x32x16_bf16(kf[1],qr[0],zf,0,0,0), P0[6],P0[7],P0[8],P0[9],     pw0[2]=PKW(P0,4), pw0[3]=PKW(P0,6), pw0); \
    VRD(1); SBAR(); GAPA(C0=__builtin_amdgcn_mfma_f32_32x32x16_bf16(kf[2],qr[1],C0,0,0,0),   P0[10],P0[11],P0[12],P0[13], pw1[0]=PKW(P0,8), pw1[1]=PKW(P0,10), pw1); \
    VRD(5); SBAR(); GAPA(C1=__builtin_amdgcn_mfma_f32_32x32x16_bf16(kf[3],qr[1],C1,0,0,0),   P0[14],P0[15],P1[0],P1[1],   pw1[2]=PKW(P0,12),pw1[3]=PKW(P0,14), pw1); \
    VRD(2); SBAR(); GAPA(C0=__builtin_amdgcn_mfma_f32_32x32x16_bf16(kf[4],qr[2],C0,0,0,0),   P1[2],P1[3],P1[4],P1[5],     pw2[0]=PKW(P1,0), pw2[1]=PKW(P1,2), pw2); \
    VRD(6); SBAR(); GAPA(C1=__builtin_amdgcn_mfma_f32_32x32x16_bf16(kf[5],qr[2],C1,0,0,0),   P1[6],P1[7],P1[8],P1[9],     pw2[2]=PKW(P1,4), pw2[3]=PKW(P1,6), pw2); \
    VRD(3); SBAR(); GAPA(C0=__builtin_amdgcn_mfma_f32_32x32x16_bf16(kf[6],qr[3],C0,0,0,0),   P1[10],P1[11],P1[12],P1[13], pw3[0]=PKW(P1,8), pw3[1]=PKW(P1,10), pw3); \
    VRD(7); SBAR(); GAPA(C1=__builtin_amdgcn_mfma_f32_32x32x16_bf16(kf[7],qr[3],C1,0,0,0),   P1[14],P1[15],0.f,0.f,       pw3[2]=PKW(P1,12),pw3[3]=PKW(P1,14), pw3); \
    C0=__builtin_amdgcn_mfma_f32_32x32x16_bf16(kf[8],qr[4],C0,0,0,0); SBAR(); \
    C1=__builtin_amdgcn_mfma_f32_32x32x16_bf16(kf[9],qr[4],C1,0,0,0); SBAR(); \
    l_reg+=sacc; \
    if(GK){DMA_K((t)+3,sl_cur);} if(GV){DMA_V((t)+1,sl_next);} \
    CMASK(C0,C1,t); \
    { float a=MX3(C0[0],C0[1],C1[0]),b=MX3(C0[2],C0[3],C1[1]); a=MX3(a,C1[2],C1[3]); \
      _Pragma("unroll") for(int r=4;r<16;r+=4){a=MX3(a,C0[r],C0[r+1]);b=MX3(b,C0[r+2],C0[r+3]);a=MX3(a,C1[r],C1[r+1]);b=MX3(b,C1[r+2],C1[r+3]);} \
      float rm=__builtin_fmaxf(a,b); { auto rr=__builtin_amdgcn_permlane32_swap(__float_as_uint(rm),__float_as_uint(rm),false,false); rm=__builtin_fmaxf(__uint_as_float(rr[0]),__uint_as_float(rr[1])); } \
      resc=false; \
      if(__builtin_expect(__any(rm>(float)THRL),0)){ MOVEREF(__builtin_fmaxf(rm,0.f)) \
        _Pragma("unroll") for(int r=0;r<16;++r){C0[r]-=dl;C1[r]-=dl;} \
        const float f=__builtin_amdgcn_exp2f(-dl); l_reg*=f; if(hi==0)wsf[r32]=f; resc=true; } } \
    SBAR(); \
    GAPB(o[0]=__builtin_amdgcn_mfma_f32_32x32x16_bf16(PAF(0),VFR(0),o[0],0,0,0), C0,0); \
    GAPB(o[1]=__builtin_amdgcn_mfma_f32_32x32x16_bf16(PAF(0),VFR(4),o[1],0,0,0), C0,4); \
    KRD(GL,0); GAPB(o[0]=__builtin_amdgcn_mfma_f32_32x32x16_bf16(PAF(1),VFR(1),o[0],0,0,0), C0,8); \
    KRD(GL,1); GAPB(o[1]=__builtin_amdgcn_mfma_f32_32x32x16_bf16(PAF(1),VFR(5),o[1],0,0,0), C0,12); \
    KRD(GL,2); GAPB(o[0]=__builtin_amdgcn_mfma_f32_32x32x16_bf16(PAF(2),VFR(2),o[0],0,0,0), C1,0); \
    KRD(GL,3); GAPB(o[1]=__builtin_amdgcn_mfma_f32_32x32x16_bf16(PAF(2),VFR(6),o[1],0,0,0), C1,4); \
    KRDX(GL); GAPB(o[0]=__builtin_amdgcn_mfma_f32_32x32x16_bf16(PAF(3),VFR(3),o[0],0,0,0), C1,8); \
    GAPB(o[1]=__builtin_amdgcn_mfma_f32_32x32x16_bf16(PAF(3),VFR(7),o[1],0,0,0), C1,12); \
    }while(0)
  int t=1;
  for(;t+5<NT&&t+1<band0;t+=2){
    #undef CMASK
    #define CMASK(P0,P1,t) do{}while(0)
    STEP(pB0,pB1,pA0,pA1,t,true,true,true);     WAIT_BAR(3); RESC(); ROT();
    STEP(pA0,pA1,pB0,pB1,t+1,true,true,true);   WAIT_BAR(3); RESC(); ROT();
  }
  #undef CMASK
  #define CMASK(P0,P1,t) do{int jb_=(t)-band0; if(jb_>=0)cmask(P0,P1,jb_,qrel,hi);}while(0)
  #define ENDW(tt) do{ if((tt)+3<NT){WAIT_BAR(3);} else if((tt)+2<NT){WAIT_BAR(1);} else {WAIT_BAR(0);} }while(0)
  for(;t+1<NT;t+=2){
    STEP(pB0,pB1,pA0,pA1,t,(t+3<NT),(t+1<NT),(t+1<NT));       ENDW(t);   RESC(); ROT();
    STEP(pA0,pA1,pB0,pB1,t+1,(t+4<NT),(t+2<NT),(t+2<NT));     ENDW(t+1); RESC(); ROT();
  }
  STEP(pB0,pB1,pA0,pA1,NT-1,false,false,false); RESC();
  { float sacc=pB0[0]+pB0[1]; _Pragma("unroll") for(int r=2;r<16;++r)sacc+=pB0[r]; _Pragma("unroll") for(int r=0;r<16;++r)sacc+=pB1[r]; l_reg+=sacc;
    pw0=(u32x4){PKW(pB0,0),PKW(pB0,2),PKW(pB0,4),PKW(pB0,6)};pw1=(u32x4){PKW(pB0,8),PKW(pB0,10),PKW(pB0,12),PKW(pB0,14)};pw2=(u32x4){PKW(pB1,0),PKW(pB1,2),PKW(pB1,4),PKW(pB1,6)};pw3=(u32x4){PKW(pB1,8),PKW(pB1,10),PKW(pB1,12),PKW(pB1,14)};
    SBAR(); pv(o,vb0+sl_cur,PAF(0),PAF(1),PAF(2),PAF(3)); }
  #undef PKW
  #undef PAF
  #undef VFR
  #undef PIN
  #undef MX3
  #undef GAPA
  #undef GAPB
  #undef EX
  #undef VRD
  #undef KRD
  #undef KRDX
  #undef STEP
  #undef ENDW
  {auto rr=__builtin_amdgcn_permlane32_swap(__float_as_uint(l_reg),__float_as_uint(l_reg),false,false);l_reg=__uint_as_float(rr[0])+__uint_as_float(rr[1]);}
  if(hi==0)wsf[32+r32]=l_reg;asm volatile("s_waitcnt lgkmcnt(0)":::"memory");
  float rli[16];
  #pragma unroll
  for(int r=0;r<16;++r)rli[r]=__builtin_amdgcn_rcpf(wsf[32+crow(r,hi)]);
  if(KIND==1){ if(hi==0&&oslot>=0){ f32x2_t ml={mhat,l_reg}; *(f32x2_t*)(PML+(long)oslot*2)=ml; } }
  { hb16*stg=(hb16*)(shm+LDS_OST)+wid*2048;
    #pragma unroll
    for(int r=0;r<16;++r){const int orow=crow(r,hi);
      #pragma unroll
      for(int d0=0;d0<2;++d0)stg[orow*64+d0*32+r32]=__float2bfloat16(o[d0][r]*rli[r]);}
    asm volatile("s_waitcnt lgkmcnt(0)":::"memory");
    #pragma unroll
    for(int i=0;i<4;++i){const int row=i*8+(lane>>3),ch=lane&7; const u32x4 v=*(const u32x4*)(stg+row*64+ch*8);
      if(KIND==0){ const int gr=__shfl(qrow,row); *(u32x4*)(Oc+(long)gr*PITCH+ch*8)=v; }
      else { const int gs=__shfl(oslot,row); if(gs>=0) *(u32x4*)(PO+(long)gs*64+ch*8)=v; } } }
  asm volatile("s_waitcnt lgkmcnt(0)\n\ts_barrier":::"memory");
  #undef DMA_K
  #undef DMA_V
  #undef CMASK
  #undef START
  #undef RESC
  #undef ROT
  #undef SETQX
  #undef MOVEREF
}
constexpr int MB_K=0, MB_V=4*SLOTB, MB_WS=MB_V+4*8192, MB_OST=MB_WS+NW*64*4, MB_BYTES=MB_OST+NW*4096;
template<int THRL> __device__ __forceinline__ void moba_item(char*shm,const hb16*Qc,const int browbase,const int h,const int nblk,const unsigned*lst,const int cnt,const int g0,const int g1,
    const hb16*Kt0,const hb16*KXt0,hb16*PO,float*PML){
  const int tid=threadIdx.x,lane=tid&63,r32=lane&31,hi=lane>>5; const int wid=__builtin_amdgcn_readfirstlane(tid>>6);
  const unsigned lds0=(unsigned)(uintptr_t)shm;
  float*wsf=(float*)(shm+MB_WS)+wid*64;
  asm volatile("s_waitcnt lgkmcnt(0)\n\ts_barrier":::"memory");
  { const hb16*ksrc=Kt0+(long)lane*PITCH+wid*8; const hb16*vsrc=Kt0+512+(long)(16*(wid&3)+(lane>>2))*PITCH+(wid>>2)*32+(lane&3)*8; const hb16*xsrc=KXt0+(long)(8*wid+(lane&7))*8;
    #pragma unroll
    for(int t=0;t<4;++t){ glds16(ksrc+(long)t*KVBLK*PITCH,(unsigned)__builtin_amdgcn_readfirstlane(lds0+MB_K+t*SLOTB+wid*1024)); glds16x(xsrc+(long)t*KVBLK*8,(unsigned)__builtin_amdgcn_readfirstlane(lds0+MB_K+t*SLOTB+8192+wid*128));
      glds16(vsrc+(long)t*KVBLK*PITCH,(unsigned)__builtin_amdgcn_readfirstlane(lds0+MB_V+t*8192+wid*1024)); } }
  asm volatile("s_waitcnt vmcnt(0)\n\ts_barrier":::"memory");
  const int vb0=(int)(lds0+MB_V)+((lane>>4)&1)*32+(lane&3)*8+(4*hi+((lane&15)>>2))*64;
  #define SETQX(mh_,ml_) do{ const unsigned bh_=cvtpk_s(-(mh_),-(ml_)); u32x4 qx_; qx_.x=0x3F803F80u; qx_.y=0x3F80u|(bh_<<16); qx_.z=(bh_>>16); qx_.w=0u; if(hi){qx_.x=0u;qx_.y=0u;qx_.z=0u;} qr[4]=__builtin_bit_cast(bf16x8,qx_); asm volatile("":"+v"(qr[4])); }while(0)
  #define MOVEREF(gain) const float mraw_=mhat+(gain); const float mh_=rbf(mraw_); const float ml_=rbf(mraw_-mh_); const float mnew_=mh_+ml_; const float dl=mnew_-mhat; mhat=mnew_; SETQX(mh_,ml_);
  #define LENT(gg) (((gg)>=8&&(gg)<g1)?lst[((gg)-8)*32+r32]:0u)
  #define GROW(gg,ee) (((gg)<8)?(browbase+nblk*256+(gg)*32+r32):(browbase+(int)((ee)&0x1fffu)))
  unsigned e_cur=LENT(g0+wid), e_nxt=LENT(g0+wid+NW);
  bf16x8 qn[4];
  { const hb16*Qw=Qc+(long)GROW(g0+wid,e_cur)*PITCH;
    #pragma unroll
    for(int d0=0;d0<4;++d0)qn[d0]=*reinterpret_cast<const bf16x8*>(&Qw[d0*16+hi*8]); }
  for(int g=g0+wid;g<g1;g+=NW){
    const bool own=g<8; const int qrow=GROW(g,e_cur); int oslot;
    if(own) oslot=(qrow*8+h)*4+3; else oslot=((g-8)*32+r32<cnt)?(qrow*8+h)*4+(int)((e_cur>>16)&3u):-1;
    bf16x8 qr[5];
    #pragma unroll
    for(int d0=0;d0<4;++d0)qr[d0]=qn[d0];
    { const int gn=(g+NW<g1)?g+NW:g; const unsigned en=(g+NW<g1)?e_nxt:e_cur; const hb16*Qw=Qc+(long)GROW(gn,en)*PITCH;
      #pragma unroll
      for(int d0=0;d0<4;++d0)qn[d0]=*reinterpret_cast<const bf16x8*>(&Qw[d0*16+hi*8]); }
    const unsigned e_n2=LENT(g+2*NW); e_cur=e_nxt; e_nxt=e_n2;
    float mhat=0.f,l_reg=0.f;f32x16 o[2];o[0]=f32x16{};o[1]=f32x16{};
    SETQX(0.f,0.f);
    const int tlast=own?((32*g+31)>>6):3;
    #define PKW(P,B) cvtpk_s(P[B],P[B+1])
    #define PROC(P0,P1,T_,ISFIRST,MREF_) do{ \
      if(own&&64*(T_)+63>32*g)cmask(P0,P1,(T_),32*g+r32,hi);   \
      const float adj_=mhat-(MREF_); const float rm=rowmax(P0,P1)-adj_; float sub_=adj_; \
      if(ISFIRST){ MOVEREF(rm) sub_+=dl; } \
      else if(__any(rm>(float)THRL)){ MOVEREF(__builtin_fmaxf(rm,0.f)) sub_+=dl; \
        const float f=__builtin_amdgcn_exp2f(-dl); l_reg*=f; if(hi==0)wsf[r32]=f; asm volatile("s_waitcnt lgkmcnt(0)":::"memory"); \
        _Pragma("unroll") for(int d_=0;d_<2;++d_) _Pragma("unroll") for(int r=0;r<16;++r)o[d_][r]*=wsf[crow(r,hi)]; } \
      float sacc=0.f; \
      _Pragma("unroll") for(int r=0;r<16;++r){P0[r]=__builtin_amdgcn_exp2f(P0[r]-sub_);P1[r]=__builtin_amdgcn_exp2f(P1[r]-sub_);sacc+=P0[r]+P1[r];} \
      l_reg+=sacc; \
      const u32x4 pw0=(u32x4){PKW(P0,0),PKW(P0,2),PKW(P0,4),PKW(P0,6)},pw1=(u32x4){PKW(P0,8),PKW(P0,10),PKW(P0,12),PKW(P0,14)},pw2=(u32x4){PKW(P1,0),PKW(P1,2),PKW(P1,4),PKW(P1,6)},pw3=(u32x4){PKW(P1,8),PKW(P1,10),PKW(P1,12),PKW(P1,14)}; \
      pv(o,vb0+(T_)*8192,__builtin_bit_cast(bf16x8,pw0),__builtin_bit_cast(bf16x8,pw1),__builtin_bit_cast(bf16x8,pw2),__builtin_bit_cast(bf16x8,pw3)); }while(0)
    int t=0;
    for(;t+1<=tlast;t+=2){
      f32x16 a0,a1,b0,b1; const float mref=mhat;
      qkt(a0,a1,shm+MB_K+t*SLOTB,qr,r32,hi); qkt(b0,b1,shm+MB_K+(t+1)*SLOTB,qr,r32,hi);
      asm volatile("s_nop 15\n\ts_nop 7":"+v"(a0),"+v"(a1));
      PROC(a0,a1,t,t==0,mref);
      asm volatile("s_nop 7":"+v"(b0),"+v"(b1));
      PROC(b0,b1,t+1,false,mref);
    }
    if(t<=tlast){ f32x16 a0,a1; const float mref=mhat;
      qkt(a0,a1,shm+MB_K+t*SLOTB,qr,r32,hi); asm volatile("s_nop 15\n\ts_nop 7":"+v"(a0),"+v"(a1));
      PROC(a0,a1,t,t==0,mref); }
    #undef PROC
    #undef PKW
    {auto rr=__builtin_amdgcn_permlane32_swap(__float_as_uint(l_reg),__float_as_uint(l_reg),false,false);l_reg=__uint_as_float(rr[0])+__uint_as_float(rr[1]);}
    if(hi==0)wsf[32+r32]=l_reg;asm volatile("s_waitcnt lgkmcnt(0)":::"memory");
    float rli[16];
    #pragma unroll
    for(int r=0;r<16;++r)rli[r]=__builtin_amdgcn_rcpf(wsf[32+crow(r,hi)]);
    if(hi==0&&oslot>=0){ f32x2_t ml={mhat,l_reg}; *(f32x2_t*)(PML+(long)oslot*2)=ml; }
    { hb16*stg=(hb16*)(shm+MB_OST)+wid*2048;
      #pragma unroll
      for(int r=0;r<16;++r){const int orow=crow(r,hi);
        #pragma unroll
        for(int d0=0;d0<2;++d0)stg[orow*64+d0*32+r32]=__float2bfloat16(o[d0][r]*rli[r]);}
      asm volatile("s_waitcnt lgkmcnt(0)":::"memory");
      #pragma unroll
      for(int i=0;i<4;++i){const int row=i*8+(lane>>3),ch=lane&7; const u32x4 v=*(const u32x4*)(stg+row*64+ch*8);
        const int gs=__shfl(oslot,row); if(gs>=0) *(u32x4*)(PO+(long)gs*64+ch*8)=v; }
      asm volatile("s_waitcnt lgkmcnt(0)":::"memory"); }
  }
  #undef SETQX
  #undef MOVEREF
  #undef LENT
  #undef GROW
}
constexpr int ATTN_LDS_BYTES=(LDS_BYTES>MB_BYTES?LDS_BYTES:MB_BYTES);
#undef SBAR
#undef WAIT_BAR
}

struct WqkOrder {
    int G, c;
    __device__ __forceinline__ bool next(int i, pg8::Unit& u) const { const int L = i * G + c; if (L >= 128) return false; const int z = L >> 2, pn = L & 3, b = z >> 2, h = z & 3;
        u.skipb1 = 0; u.pm = b * 4 + h; u.pn = pn; u.aoff = ((size_t)(b * 256) * 2048 + h * 256) * 2; u.boff = ((size_t)(pn * 256) * 1024 + h * 256) * 2; return true; }
};
struct VwoOrder {
    int G, c;
    __device__ __forceinline__ bool next(int i, pg8::Unit& u) const { const int L = i * G + c; if (L >= 128) return false; const int z = L >> 2, pmq = L & 3, b = z >> 2, h = z & 3;
        u.skipb1 = 0; u.pm = b * 4 + pmq; u.pn = h; u.aoff = ((size_t)(pmq * 256) * 1024 + h * 256) * 2; u.boff = ((size_t)(b * 256) * 2048 + 1024 + h * 256) * 2; return true; }
};

#define DECL_PTRS const __attribute__((address_space(4))) Args* KA_; { auto p_ = __builtin_amdgcn_kernarg_segment_ptr(); asm volatile("" : "+s"(p_)); KA_ = (const __attribute__((address_space(4))) Args*)p_; } \
    int tidp_ = threadIdx.x; asm volatile("" : "+v"(tidp_)); const int tid = tidp_, lane = tid & 63; (void)lane; \
    unsigned char* ws = KA_->ws; gu32* ctl = (gu32*)(ws + WS_CTL); const float* x = KA_->in[0]; const float* mem = KA_->in[1]; const float* g_mix = KA_->in[2]; const float* w_in = KA_->in[3]; const float* b_forget = KA_->in[4]; const float* g_fox = KA_->in[5]; const float* g_moba = KA_->in[6]; const float* w_out = KA_->in[7]; const float* g_cross = KA_->in[8]; const float* g_mem = KA_->in[9]; const float* w_q_mem = KA_->in[10]; const float* w_kv_mem = KA_->in[11]; const float* w_o_mem = KA_->in[12]; const float* g_ffn = KA_->in[13]; const float* w_up = KA_->in[14]; const float* conv_w = KA_->in[15]; const float* conv_b = KA_->in[16]; const float* w_down = KA_->in[17]; const float* g_final = KA_->in[18]; float* out = KA_->out; float* LOGF = (float*)(ws + WS_LOGF); float* CC = (float*)(ws + WS_C); float* ABAR = (float*)(ws + WS_ABAR); float* KM = (float*)(ws + WS_KM); unsigned* SEL = (unsigned*)(ws + WS_SEL); float* SSQ1 = (float*)(ws + WS_SSQ1); float* SSQ2 = (float*)(ws + WS_SSQ2); float* SSQ3 = (float*)(ws + WS_SSQ3); bf16* MEMN = (bf16*)(ws + WS_MEMN); bf16* KV = (bf16*)(ws + WS_KV); bf16* WQS = (bf16*)(ws + WS_WQS); bf16* WOT = (bf16*)(ws + WS_WOT); bf16* WKVT = (bf16*)(ws + WS_WKVT); bf16* WINT = (bf16*)(ws + WS_WINT); bf16* WOUTT = (bf16*)(ws + WS_WOUTT); bf16* WUPT = (bf16*)(ws + WS_WUPT); unsigned char* WDT = ws + WS_WDT; unsigned char* ACT8 = ws + WS_ACT8; float* GHB = (float*)(ws + WS_GH); float* UHB = (float*)(ws + WS_UH); float* GTB = (float*)(ws + WS_GT); bf16* ZT = (bf16*)(ws + WS_ZT); bf16* WQK = (bf16*)(ws + WS_WQK); bf16* VWO = (bf16*)(ws + WS_VWO); bf16* A1 = (bf16*)(ws + WS_A1); bf16* QKV = (bf16*)(ws + WS_QKV); bf16* Y = (bf16*)(ws + WS_Y); bf16* HB1 = (bf16*)(ws + WS_HB1); bf16* PB = (bf16*)(ws + WS_P); bf16* HB2 = (bf16*)(ws + WS_HB2); bf16* GB = (bf16*)(ws + WS_G); bf16* UB = (bf16*)(ws + WS_U); bf16* PO = (bf16*)(ws + WS_PO); unsigned* LIST = (unsigned*)(ws + WS_LIST); float* PML = (float*)(ws + WS_PML); bf16* KXF = (bf16*)(ws + WS_KXF); bf16* KXM = (bf16*)(ws + WS_KXM); unsigned* CNT = (unsigned*)(ws + WS_CNT);
__global__ void __launch_bounds__(NWAVES * 64, 2) fwd(Args args) {
    extern __shared__ __attribute__((aligned(16))) unsigned char lds[];
    LAS unsigned char* L = (LAS unsigned char*)lds;
    LAS unsigned char* XL = L + XL_OFF;
    volatile LAS unsigned* MISC = (volatile LAS unsigned*)(L + MISC_OFF);
    const int tid = threadIdx.x, lane = tid & 63, wave = __builtin_amdgcn_readfirstlane(tid >> 6);
    const int G = gridDim.x, bx = blockIdx.x;
    const int gw = bx * NWAVES + wave, NGW = G * NWAVES;
    for (int u = tid; u < (LDS_BYTES - LDSCTL_OFF) / 4; u += NWAVES * 64) ((LAS unsigned*)(L + LDSCTL_OFF))[u] = 0u;
    __syncthreads();
    XcdBarrier bar; { DECL_PTRS; bar = xcd_barrier_post((unsigned*)(ctl + CW_BAR), MISC + 8); }

    { DECL_PTRS;
        LAS float* scr = (LAS float*)(L + RING_OFF + wave * 16384);
        constexpr int I_IN = (D / 32) * (NQKV / 64), I_OUT = (D / 32) * (D / 64), I_KV = (D / 32) * (2048 / 64), I_O = I_OUT, I_UP = (D / 32) * (2 * FF / 64), I_DN = (FF / 32) * (D / 64);
        constexpr int NITEMS = I_IN + I_OUT + I_KV + I_O + I_UP + I_DN;
        for (int it = gw; it < NITEMS; it += NGW) {
            int r = it;
            if (r < I_IN) { p0_transpose_item(w_in, INC, D, NQKV, WINT, nullptr, true, scr, r, lane); continue; } r -= I_IN;
            if (r < I_OUT) { p0_transpose_item(w_out, D, D, D, WOUTT, nullptr, false, scr, r, lane); continue; } r -= I_OUT;
            if (r < I_KV) { p0_transpose_item(w_kv_mem, 2048, D, 2048, WKVT, nullptr, false, scr, r, lane); continue; } r -= I_KV;
            if (r < I_O) { p0_transpose_item(w_o_mem, D, D, D, WOT, nullptr, false, scr, r, lane); continue; } r -= I_O;
            if (r < I_UP) { p0_transpose_item(w_up, 2 * FF, D, 2 * FF, WUPT, g_ffn, false, scr, r, lane, 0.f, true); continue; } r -= I_UP;
            p0_transpose_item(w_down, D, FF, D, (bf16*)WDT, nullptr, false, scr, r, lane, 64.0f);
        }
        for (int i = bx * 512 + tid; i < D * D / 4; i += G * 512) { const int kk = (i * 4) >> 10; const f32x4 v = *(const f32x4*)(w_q_mem + (size_t)i * 4) * (g_cross[kk] * (LOG2E / 16.0f));
            *(unsigned long long*)(WQS + (size_t)i * 4) = (unsigned long long)pk2(v[0], v[1]) | ((unsigned long long)pk2(v[2], v[3]) << 32); }
        for (int r = gw; r < NB * 256; r += NGW) { const GAS f32x4* xr = (const GAS f32x4*)(mem + (size_t)r * D) + lane; f32x4 v[4]; float s = 0.f;
#pragma unroll
            for (int j = 0; j < 4; ++j) { v[j] = xr[64 * j]; s += (v[j][0] * v[j][0] + v[j][1] * v[j][1]) + (v[j][2] * v[j][2] + v[j][3] * v[j][3]); }
            const float rs = __builtin_amdgcn_rsqf(wave_sum(s) * (1.f / D) + RMS_EPS);
            GAS unsigned long long* o8 = (GAS unsigned long long*)(MEMN + (size_t)r * D) + lane;
#pragma unroll
            for (int j = 0; j < 4; ++j) { const f32x4 gg = *((const f32x4*)g_mem + 64 * j + lane); const f32x4 a = v[j] * rs * gg; o8[64 * j] = (unsigned long long)pk2(a[0], a[1]) | ((unsigned long long)pk2(a[2], a[3]) << 32); } }
        __syncthreads();
        LAS float* part = (LAS float*)(L + RING_OFF + 32768);
        LAS float* wf = (LAS float*)(L + RING_OFF);
        for (int i = tid; i < 8 * 1024; i += 512) { const int h = i >> 10, kk = i & 1023; wf[i] = w_in[(size_t)kk * INC + C_F + h]; }
        __syncthreads();
        f32x4 gm[4];
#pragma unroll
        for (int j = 0; j < 4; ++j) gm[j] = *((const f32x4*)g_mix + 64 * j + lane);
        for (int blk = bx; blk < M / 256; blk += G) {
            f32x4 accm[4];
#pragma unroll
            for (int j = 0; j < 4; ++j) accm[j] = (f32x4){0.f, 0.f, 0.f, 0.f};
            f32x4 vn[2][4];
#pragma unroll
            for (int rr = 0; rr < 2; ++rr) { const GAS f32x4* xr = (const GAS f32x4*)(x + ((size_t)blk * 256 + wave * 32 + rr) * D) + lane;
#pragma unroll
                for (int j = 0; j < 4; ++j) vn[rr][j] = xr[64 * j]; }
            for (int i0 = 0; i0 < 32; i0 += 2) {
              f32x4 vv[2][4];
#pragma unroll
              for (int rr = 0; rr < 2; ++rr)
#pragma unroll
                  for (int j = 0; j < 4; ++j) vv[rr][j] = vn[rr][j];
              { const int inx = i0 + 2 < 32 ? i0 + 2 : i0;
#pragma unroll
                for (int rr = 0; rr < 2; ++rr) { const GAS f32x4* xr = (const GAS f32x4*)(x + ((size_t)blk * 256 + wave * 32 + inx + rr) * D) + lane;
#pragma unroll
                    for (int j = 0; j < 4; ++j) vn[rr][j] = xr[64 * j]; } }
#pragma unroll
              for (int rr = 0; rr < 2; ++rr) {
                const size_t r = (size_t)blk * 256 + wave * 32 + i0 + rr;
                f32x4 v[4]; float s = 0.f;
#pragma unroll
                for (int j = 0; j < 4; ++j) { v[j] = vv[rr][j]; s += (v[j][0] * v[j][0] + v[j][1] * v[j][1]) + (v[j][2] * v[j][2] + v[j][3] * v[j][3]); }
                const float rs = __builtin_amdgcn_rsqf(wave_sum(s) * (1.f / D) + RMS_EPS);
                GAS unsigned long long* o8 = (GAS unsigned long long*)(A1 + r * 2048) + lane;
                float fl[8];
#pragma unroll
                for (int h = 0; h < 8; ++h) fl[h] = 0.f;
#pragma unroll
                for (int j = 0; j < 4; ++j) { const f32x4 a = v[j] * rs * gm[j]; accm[j] += a;
                    const unsigned h0 = pk2(a[0], a[1]), h1 = pk2(a[2], a[3]);
                    o8[64 * j] = (unsigned long long)h0 | ((unsigned long long)h1 << 32);
                    const unsigned l0 = pk2(a[0] - bflo(h0), a[1] - bfhi(h0)), l1 = pk2(a[2] - bflo(h1), a[3] - bfhi(h1));
                    o8[256 + 64 * j] = (unsigned long long)l0 | ((unsigned long long)l1 << 32);
#pragma unroll
                    for (int h = 0; h < 8; ++h) { const f32x4 w = *((const LAS f32x4*)(wf + h * 1024) + 64 * j + lane); fl[h] += (a[0] * w[0] + a[1] * w[1]) + (a[2] * w[2] + a[3] * w[3]); } }
                float t4[4], t2[2], z;
                { const bool up = (lane & 32) != 0;
#pragma unroll
                  for (int k = 0; k < 4; ++k) { const float snd = up ? fl[k] : fl[k + 4]; const float rcv = __shfl_xor(snd, 32); t4[k] = (up ? fl[k + 4] : fl[k]) + rcv; } }
                { const bool up = (lane & 16) != 0;
#pragma unroll
                  for (int k = 0; k < 2; ++k) { const float snd = up ? t4[k] : t4[k + 2]; const float rcv = __shfl_xor(snd, 16); t2[k] = (up ? t4[k + 2] : t4[k]) + rcv; } }
                { const bool up = (lane & 8) != 0; const float snd = up ? t2[0] : t2[1]; const float rcv = __shfl_xor(snd, 8); z = (up ? t2[1] : t2[0]) + rcv; }
                z += __shfl_xor(z, 1); z += __shfl_xor(z, 2); z += __shfl_xor(z, 4);
                if ((lane & 7) == 0) { const int hh = 4 * (lane >> 5) + 2 * ((lane >> 4) & 1) + ((lane >> 3) & 1);
                    z += b_forget[hh];
                    LOGF[r * 8 + hh] = fminf(z, 0.f) - log1pf(__expf(-fabsf(z))); }
              }
            }
#pragma unroll
            for (int j = 0; j < 4; ++j) *((LAS f32x4*)(part + wave * 1024) + 64 * j + lane) = accm[j];
            __syncthreads();
            for (int col = tid; col < 1024; col += 512) { float s = 0.f;
#pragma unroll
                for (int w = 0; w < 8; ++w) s += part[w * 1024 + col];
                ABAR[(size_t)blk * 1024 + col] = s * (1.0f / 256.0f); }
            __syncthreads();
        }
    }
    xcd_barrier(bar);

#define WG_SIGNAL(word) do { asm volatile("s_waitcnt vmcnt(0)" ::: "memory"); __syncthreads(); if (tid == 0) { __builtin_amdgcn_fence(__ATOMIC_RELEASE, "agent"); asm volatile("s_waitcnt vmcnt(0)" ::: "memory"); \
        __hip_atomic_fetch_add((unsigned*)(ctl + (word)), 1u, RLX_AGENT); } } while (0)
#define WG_WAIT(word, n) do { if (tid == 0) { unsigned sp_ = 0u; while (__hip_atomic_load((unsigned*)(ctl + (word)), RLX_AGENT) < (unsigned)(n)) { __builtin_amdgcn_s_sleep(2); if (++sp_ > (1u << 22)) break; } } \
        __syncthreads(); __builtin_amdgcn_fence(__ATOMIC_ACQUIRE, "agent"); asm volatile("s_waitcnt vmcnt(0)" ::: "memory"); } while (0)
    { DECL_PTRS;
        LAS float* sc = (LAS float*)(L + RING_OFF);
        for (int w = bx; w < 64; w += G) {
            const int ib = w >> 3, jb = w & 7, r = tid >> 4, cq = tid & 15; LAS float* As = sc; LAS float* Bs = sc + 32 * 33;
            f32x4 acc = (f32x4){0.f, 0.f, 0.f, 0.f};
            for (int k0 = 0; k0 < 1024; k0 += 32) {
                { const int idx = tid * 2, row = idx >> 5, kk = idx & 31; const pg8::f32x2 a2 = *(const pg8::f32x2*)(ABAR + (size_t)(ib * 32 + row) * 1024 + k0 + kk); As[row * 33 + kk] = a2.x; As[row * 33 + kk + 1] = a2.y; }
                { const int idx = tid * 4, kk = idx >> 6, c = idx & 63; *(LAS f32x4*)(Bs + kk * 64 + c) = *(const f32x4*)(w_in + (size_t)(k0 + kk) * INC + C_KM + jb * 64 + c); }
                __syncthreads();
#pragma unroll 8
                for (int kk = 0; kk < 32; ++kk) acc += *(const LAS f32x4*)(Bs + kk * 64 + cq * 4) * As[r * 33 + kk];
                __syncthreads();
            }
            *(f32x4*)(KM + (size_t)(ib * 32 + r) * 512 + jb * 64 + cq * 4) = acc;
            WG_SIGNAL(CW_CNT_KM);
        }
        for (int w = (bx + G - 64) % G; w < 64; w += G) {
            const int b = w >> 3, h = w & 7; float v[16]; float run = 0.f;
#pragma unroll
            for (int i = 0; i < 16; ++i) { run += LOGF[((size_t)b * T + tid * 16 + i) * 8 + h]; v[i] = run; }
            float incl = run;
#pragma unroll
            for (int o = 1; o < 64; o <<= 1) { const float n = __shfl_up(incl, o); if (lane >= o) incl += n; }
            if (lane == 63) sc[wave] = incl;
            __syncthreads();
            float pre = incl - run;
            for (int ww = 0; ww < wave; ++ww) pre += sc[ww];
#pragma unroll
            for (int i = 0; i < 16; ++i) { const float cv = pre + v[i]; const size_t e = (size_t)w * T + tid * 16 + i; CC[e] = cv;
                const float bv = -cv * LOG2E; const unsigned h0 = f2bf(bv); const float r1 = bv - bf2f(h0); const unsigned h1 = f2bf(r1); const unsigned h2 = f2bf(r1 - bf2f(h1));
                *(v4u*)(KXF + e * 8) = (v4u){h0 | (h1 << 16), h2 | (0x3F80u << 16), 0x3F80u, 0u}; }
            if (w == 0) for (int j = tid; j < 8 * 256; j += 512) { const float bv = __builtin_amdgcn_exp2f(-(float)((j >> 8) + 1)) * LOG2E * (float)(j & 255);
                const unsigned h0 = f2bf(bv); const float r1 = bv - bf2f(h0); const unsigned h1 = f2bf(r1); const unsigned h2 = f2bf(r1 - bf2f(h1));
                *(v4u*)(KXM + (size_t)j * 8) = (v4u){h0 | (h1 << 16), h2 | (0x3F80u << 16), 0x3F80u, 0u}; }
            __syncthreads();
        }
        { const int ckv = (bx + G - 128) % G;
          pg8::Gemm g{MEMN, WKVT, D / 64, D * 2, D * 2, 0xffffffffu}; pg8::TileOrder S; S.init(NB * 256, 2048, G, ckv, D * 2, D * 2, 0, 1 << 30);
          pg8::EpiBf16 E{KV, 2048, 0u, 1.f, nullptr};
          pg8::gemm_phase<pg8::EpiBf16, pg8::TileOrder, true>(L + RING_OFF, XL, g, S, E);
          for (int Lk = ckv; Lk < 64; Lk += G) WG_SIGNAL(CW_CNT_KV); }
        if (bx < 64) WG_WAIT(CW_CNT_KM, 64);
        for (int w = bx; w < 64; w += G) {
            const int h = w >> 3, kq = w & 7, kk = kq * 128 + (tid & 127), ng = tid >> 7;
            for (int i = tid; i < 256 * 16; i += 512) { const int n = i >> 4, c4 = (i & 15) * 4; *(LAS f32x4*)(sc + n * 64 + c4) = *(const f32x4*)(KM + (size_t)n * 512 + h * 64 + c4); }
            f32x4 wq[16];
#pragma unroll
            for (int c = 0; c < 16; ++c) wq[c] = *(const f32x4*)(w_in + (size_t)kk * INC + C_QM + h * 64 + c * 4);
            __syncthreads();
            for (int i = 0; i < 64; ++i) { const int n = ng * 64 + i; const LAS f32x4* kp = (const LAS f32x4*)(sc + n * 64); float s0 = 0.f, s1 = 0.f;
#pragma unroll
                for (int c = 0; c < 16; c += 2) { const f32x4 ka = kp[c], kb = kp[c + 1];
                    s0 += (wq[c][0] * ka[0] + wq[c][1] * ka[1]) + (wq[c][2] * ka[2] + wq[c][3] * ka[3]); s1 += (wq[c + 1][0] * kb[0] + wq[c + 1][1] * kb[1]) + (wq[c + 1][2] * kb[2] + wq[c + 1][3] * kb[3]); }
                const float sv = s0 + s1; const unsigned hi = f2bf(sv); const unsigned lo = f2bf(sv - bf2f(hi));
                bf16* zr = ZT + ((size_t)(n >> 5) * 256 + 128 * ((n & 31) >> 4) + 32 * (h >> 1) + 16 * (h & 1) + (n & 15)) * 3072;     zr[kk] = (bf16)hi; zr[1024 + kk] = (bf16)hi; zr[2048 + kk] = (bf16)lo; }
            WG_SIGNAL(CW_CNT_Z);
        }
        { const int ckv = (bx + G - 128) % G;
          if (ckv < 64) WG_WAIT(CW_CNT_KV, 64);
          const int gx = G < 64 ? G : 64, cx = ckv < 64 ? ckv : (1 << 20);
          { pg8::Gemm g{KV, WQS, 4, 4096, 2048, 0xffffffffu}; WqkOrder S{gx, cx}; pg8::EpiF8 E{(unsigned char*)WQK, 1024, 32.0f};
            pg8::gemm_phase<pg8::EpiF8, WqkOrder, true>(L + RING_OFF, XL, g, S, E); }
          { pg8::Gemm g{WOT, KV, 4, 2048, 4096, 0xffffffffu}; VwoOrder S{gx, cx}; pg8::EpiF8 E{(unsigned char*)VWO, 1024, 4.0f};
            pg8::gemm_phase<pg8::EpiF8, VwoOrder, true>(L + RING_OFF, XL, g, S, E); } }
        { pg8::Gemm g{A1, WINT, D / 64, 4096, D * 2, 0xffffffffu}; pg8::TileOrder S; S.init(M, NQKV, G, bx, 4096, D * 2, 0, 1 << 30); S.deal = (G == 256) ? 1 : 0;
          pg8::EpiBf16 E{QKV, NQKV, 0xC3u, C2, (unsigned*)(ctl + CW_QKN)};
          pg8::gemm_phase<pg8::EpiBf16, pg8::TileOrder, true>(L + RING_OFF, XL, g, S, E); }
        WG_WAIT(CW_CNT_Z, 64);
        { pg8::Gemm g{A1, ZT, 3072 / 64, 4096, 6144, 4095u}; pg8::TileOrder S; S.init(M, 256, G, bx, 4096, 6144, (size_t)256 * 6144, 32); S.skipmode = 1;
          pg8::EpiGate E{SEL};
          pg8::gemm_phase<pg8::EpiGate, pg8::TileOrder, true, false, true>(L + RING_OFF, XL, g, S, E); }
    }
#undef WG_SIGNAL
#undef WG_WAIT
    xcd_barrier(bar);

    { DECL_PTRS;
        for (int e = bx + wave * G; e < 2048; e += 8 * G) {
            const int bh = e >> 5, qb = e & 31, b = bh >> 3, h = bh & 7; float dmin = 3.0e38f, qmax = 0.f;
#pragma unroll 2
            for (int rr = 0; rr < 4; ++rr) { const bf16* qp = QKV + ((size_t)b * T + qb * 256 + rr * 64 + lane) * NQKV + h * 64; float dot = 0.f, qn2 = 0.f;
#pragma unroll
                for (int c = 0; c < 8; ++c) { const v4u qw = *((const v4u*)qp + c), kw = *((const v4u*)(qp + 512) + c); const unsigned qq[4] = {qw.x, qw.y, qw.z, qw.w}, kk2[4] = {kw.x, kw.y, kw.z, kw.w};
#pragma unroll
                    for (int x4 = 0; x4 < 4; ++x4) { const float q0 = bflo(qq[x4]), q1 = bfhi(qq[x4]); dot += q0 * bflo(kk2[x4]) + q1 * bfhi(kk2[x4]); qn2 += q0 * q0 + q1 * q1; } }
                dmin = fminf(dmin, dot); qmax = fmaxf(qmax, qn2); }
#pragma unroll
            for (int o = 1; o < 64; o <<= 1) { dmin = fminf(dmin, __shfl_xor(dmin, o)); qmax = fmaxf(qmax, __shfl_xor(qmax, o)); }
            const unsigned* kp = (const unsigned*)(ctl + CW_QKN) + bh * 8 + 2;
            const float kn = sqrtf(__uint_as_float(__hip_atomic_load(kp, RLX_AGENT)) + __uint_as_float(__hip_atomic_load(kp + 1, RLX_AGENT)));
            const float thr = (sqrtf(qmax) * kn * 1.02f - dmin + 40.5f) * (1.0f / LOG2E);
            const float* crow_ = CC + (size_t)bh * T; const int t0 = qb * 256; const float target = crow_[t0] + thr;
            int lo = 0, hi2 = t0;
            while (hi2 > lo) { const int step = (hi2 - lo + 63) >> 6, pos = lo + lane * step; const bool pr = pos < hi2 && crow_[pos] >= target; const int k = __popcll(__ballot(pr));
                if (k == 0) hi2 = lo;
                else { const int cand = lo + k * step; lo = lo + (k - 1) * step + 1; if (cand < hi2) hi2 = cand; } }
            if (lane == 0) ((int*)(ctl + CW_T0TAB))[e] = (lo >> 6) & ~1; }
        for (int ws_ = bx + G * wave; ws_ < 2048; ws_ += 8 * G) {
            const int bh = (ws_ & 255) >> 2, n = (ws_ & 3) + 4 * (ws_ >> 8), trip = bh * 32 + n; const unsigned* selrow = SEL + (size_t)bh * T; unsigned base = 0u;
            const float mthr = skip_thr((const unsigned*)(ctl + CW_QKN) + bh * 8, 1); const int hh = bh & 7;
            for (int t0 = (n + 1) * 256; t0 < T; t0 += 512) {
                unsigned m[8];
#pragma unroll
                for (int j = 0; j < 8; ++j) { const int t = t0 + j * 64 + lane; m[j] = 0u; if (t < T) m[j] = selrow[t]; }
#pragma unroll
                for (int j = 0; j < 8; ++j) { const int t = t0 + j * 64 + lane; const bool hit = ((m[j] >> n) & 1u) && !moba_skip(hh, t >> 8, n, mthr);
                    const unsigned long long bal = __ballot(hit);
                    if (hit) { const unsigned pos = base + (unsigned)__popcll(bal & ((1ull << lane) - 1ull)); const unsigned k = (unsigned)__popc(m[j] & ((1u << n) - 1u));
                        LIST[(size_t)trip * 8192 + pos] = (unsigned)t | (k << 16); }
                    base += (unsigned)__popcll(bal); }
            }
            if (lane == 0) CNT[trip] = base;
        }
    }
    xcd_barrier(bar);

    { DECL_PTRS;
        LAS int* upre = (LAS int*)(L + RING_OFF + attn_body::ATTN_LDS_BYTES);
        LAS int* wsum = upre + 2052;
        { int c4[4]; int run = 0;
#pragma unroll
          for (int i = 0; i < 4; ++i) { const int wq = tid * 4 + i; c4[i] = run; run += (int)((8u + ((CNT[(wq & 63) * 32 + (wq >> 6)] + 31u) >> 5) + 31u) >> 5); }
          int incl = run;
#pragma unroll
          for (int o = 1; o < 64; o <<= 1) { const int nn = __shfl_up(incl, o); if (lane >= o) incl += nn; }
          if (lane == 63) wsum[wave] = incl;
          __syncthreads();
          int pre = incl - run;
          for (int ww = 0; ww < wave; ++ww) pre += wsum[ww];
#pragma unroll
          for (int i = 0; i < 4; ++i) upre[tid * 4 + i] = pre + c4[i];
          if (tid == 511) upre[2048] = pre + run;
          __syncthreads(); }
        const int ntot = 2048 + upre[2048];
        const attn_body::hb16* Qb = (const attn_body::hb16*)QKV;
        const int r32 = lane & 31;
        LAS unsigned* qnext = (LAS unsigned*)(wsum + 16);
        unsigned* qhead = (unsigned*)(ctl + CW_QUEUE);
        if (tid == 0) qnext[0] = atomicAdd(qhead, 1u);
        __syncthreads();
        for (;;) {
            const int u = (int)qnext[0];
            if (u >= ntot) break;
            __syncthreads();
            unsigned nxt_ = 0u; if (tid == 0) nxt_ = atomicAdd(qhead, 1u);
            if (u < 2048) {
                const int qb = 31 - (u >> 6), bh = u & 63;
                const int b = bh >> 3, h = bh & 7;
                const int T0 = ((const int*)(ctl + CW_T0TAB))[bh * 32 + qb];
                const int qrow = b * T + qb * 256 + wave * 32 + r32, NT = 4 * (qb + 1) - T0;
                const attn_body::hb16* Qc = Qb + h * 64; const attn_body::hb16* Kt0 = Qb + (size_t)(b * T + T0 * 64) * NQKV + 512 + h * 64;
                attn_body::attn_unit<8>((char*)lds + RING_OFF, 0, Qc, qrow, -1, Kt0, Kt0 + 512, (const attn_body::hb16*)KXF + ((size_t)bh * T + T0 * 64) * 8, NT, NT - 4, (attn_body::hb16*)QKV + (Qc - Qb), (attn_body::hb16*)PO, PML);
            } else {
                const int g = u - 2048; int lo = 0, hi2 = 2048;
                while (hi2 - lo > 1) { const int mid = (lo + hi2) >> 1; if (upre[mid] <= g) lo = mid; else hi2 = mid; }
                const int c = g - upre[lo], bh = lo & 63, n = lo >> 6, w = bh * 32 + n, b = bh >> 3, h = bh & 7; const int cnt = (int)CNT[w];
                const int ng = 8 + ((cnt + 31) >> 5), g0 = 32 * c, g1 = g0 + 32 < ng ? g0 + 32 : ng;
                const attn_body::hb16* Kt0 = Qb + (size_t)(b * T + n * 256) * NQKV + 2048 + h * 64;
                attn_body::moba_item<8>((char*)lds + RING_OFF, Qb + 1536 + h * 64, b * T, h, n, LIST + (size_t)w * 8192, cnt, g0, g1, Kt0, (const attn_body::hb16*)KXM + h * 256 * 8, (attn_body::hb16*)PO, PML);
            }
            if (tid == 0) qnext[0] = nxt_;
            __syncthreads();
        }
    }
    xcd_barrier(bar);

    { DECL_PTRS;
    const f32x4 ga0 = *((const f32x4*)g_fox + 2 * lane), ga1 = *((const f32x4*)g_fox + 2 * lane + 1), gb0 = *((const f32x4*)g_moba + 2 * lane), gb1 = *((const f32x4*)g_moba + 2 * lane + 1);
    const int h = lane >> 3, cc = lane & 7; const float s2 = __builtin_amdgcn_exp2f(-(float)(h + 1)) * LOG2E * 256.0f;
    float mthr[NB];
#pragma unroll
    for (int b = 0; b < NB; ++b) mthr[b] = skip_thr((const unsigned*)(ctl + CW_QKN) + (b * 8 + h) * 8, 1);
    v4u wan[2], pwn[2][4]; unsigned mmn[2]; pg8::f32x2 mln[2][4];
#define P3_LOAD(rbase) do { _Pragma("unroll") for (int rr = 0; rr < 2; ++rr) { const int r = (rbase) + rr, b = r >> 13, t = r & (T - 1); const size_t sb = ((size_t)r * 8 + h) * 4; \
            wan[rr] = *((const v4u*)(QKV + (size_t)r * NQKV) + lane); mmn[rr] = SEL[((size_t)(b * 8 + h)) * T + t]; \
            _Pragma("unroll") for (int k = 0; k < 4; ++k) { mln[rr][k] = *(const pg8::f32x2*)(PML + (sb + k) * 2); pwn[rr][k] = *((const v4u*)(PO + (sb + k) * 64) + cc); } } } while (0)
    if (gw * 2 < M) P3_LOAD(gw * 2);
    for (int r0 = gw * 2; r0 < M; r0 += NGW * 2) {
        v4u wa[2], pw[2][4]; unsigned mmv[2]; pg8::f32x2 ml[2][4];
#pragma unroll
        for (int rr = 0; rr < 2; ++rr) { wa[rr] = wan[rr]; mmv[rr] = mmn[rr];
#pragma unroll
            for (int k = 0; k < 4; ++k) { ml[rr][k] = mln[rr][k]; pw[rr][k] = pwn[rr][k]; } }
        { const int rn = r0 + NGW * 2 < M ? r0 + NGW * 2 : r0; P3_LOAD(rn); }
#pragma unroll
        for (int rr = 0; rr < 2; ++rr) { const int r = r0 + rr, t = r & (T - 1), own = t >> 8;
            const float a[8] = {bflo(wa[rr].x), bfhi(wa[rr].x), bflo(wa[rr].y), bfhi(wa[rr].y), bflo(wa[rr].z), bfhi(wa[rr].z), bflo(wa[rr].w), bfhi(wa[rr].w)};
            float c[8]; unsigned mm = mmv[rr]; const int cnt = __popc(mm);
            float mk[4], lk[4];
#pragma unroll
            for (int k = 0; k < 4; ++k) { mk[k] = ml[rr][k].x; lk[k] = ml[rr][k].y; }
            mk[3] += s2 * (float)own; float Mx = mk[3];
            bool vk[4]; vk[3] = true; float thb = mthr[0];
#pragma unroll
            for (int b = 1; b < NB; ++b) thb = ((r >> 13) == b) ? mthr[b] : thb;
#pragma unroll
            for (int k = 0; k < 3; ++k) { vk[k] = false; if (k < cnt) { const int nb = __ffs(mm) - 1; mm &= mm - 1u; vk[k] = !moba_skip(h, own, nb, thb); if (vk[k]) { mk[k] += s2 * (float)nb; Mx = fmaxf(Mx, mk[k]); } } }
            float W = 0.f;
#pragma unroll
            for (int i = 0; i < 8; ++i) c[i] = 0.f;
#pragma unroll
            for (int k = 0; k < 4; ++k) { if (vk[k]) { const float w = lk[k] * __builtin_amdgcn_exp2f(mk[k] - Mx); W += w; const v4u p = pw[rr][k];
                c[0] += w * bflo(p.x); c[1] += w * bfhi(p.x); c[2] += w * bflo(p.y); c[3] += w * bfhi(p.y); c[4] += w * bflo(p.z); c[5] += w * bfhi(p.z); c[6] += w * bflo(p.w); c[7] += w * bfhi(p.w); } }
            const float iw = 1.0f / W;
#pragma unroll
            for (int i = 0; i < 8; ++i) c[i] *= iw;
            float sa = 0.f, sb2 = 0.f;
#pragma unroll
            for (int i = 0; i < 8; ++i) { sa += a[i] * a[i]; sb2 += c[i] * c[i]; }
            const float ra = __builtin_amdgcn_rsqf(wave_sum(sa) * (1.f / 512.f) + RMS_EPS), rb = __builtin_amdgcn_rsqf(wave_sum(sb2) * (1.f / 512.f) + RMS_EPS);
            v4u oa, ob;
            oa.x = pk2(a[0] * ra * ga0[0], a[1] * ra * ga0[1]); oa.y = pk2(a[2] * ra * ga0[2], a[3] * ra * ga0[3]); oa.z = pk2(a[4] * ra * ga1[0], a[5] * ra * ga1[1]); oa.w = pk2(a[6] * ra * ga1[2], a[7] * ra * ga1[3]);
            ob.x = pk2(c[0] * rb * gb0[0], c[1] * rb * gb0[1]); ob.y = pk2(c[2] * rb * gb0[2], c[3] * rb * gb0[3]); ob.z = pk2(c[4] * rb * gb1[0], c[5] * rb * gb1[1]); ob.w = pk2(c[6] * rb * gb1[2], c[7] * rb * gb1[3]);
            *((v4u*)(Y + (size_t)r * D) + lane) = oa; *((v4u*)(Y + (size_t)r * D + 512) + lane) = ob; }
    } }
    xcd_barrier(bar);

#undef P3_LOAD
    { DECL_PTRS; pg8::Gemm g{Y, WOUTT, D / 64, D * 2, D * 2, 0xffffffffu}; pg8::TileOrder S; S.init(M, D, G, bx, D * 2, D * 2, 0, 1 << 30);
      pg8::EpiRes<false, false> E{x, nullptr, nullptr, HB1, ws + WS_HB1F, SSQ1, 1.0f};
      pg8::gemm_phase<pg8::EpiRes<false, false>, pg8::TileOrder, true>(L + RING_OFF, XL, g, S, E); }
    xcd_barrier(bar);

    { DECL_PTRS; pg8::Gemm g{ws + WS_HB1F, WQK, D / 128, D, D, 0xffffffffu}; pg8::TileOrder S; S.init(M, D, G, bx, D, D, (size_t)D * D, 32);
      pg8::EpiSoftmax E{(unsigned char*)PB, SSQ1, 1.0f / 32.0f};
      pg8::gemm_phase<pg8::EpiSoftmax, pg8::TileOrder, true, true>(L + RING_OFF, XL, g, S, E); }
    xcd_barrier(bar);

    { DECL_PTRS; pg8::Gemm g{PB, VWO, D / 128, D, D, 0xffffffffu}; pg8::TileOrder S; S.init(M, D, G, bx, D, D, (size_t)D * D, 32);
      pg8::EpiRes<true, false> E{nullptr, HB1, nullptr, HB2, nullptr, SSQ2, 1.0f / 1024.0f};
      pg8::gemm_phase<pg8::EpiRes<true, false>, pg8::TileOrder, true, true>(L + RING_OFF, XL, g, S, E); }
    xcd_barrier(bar);

    { DECL_PTRS; pg8::Gemm g{HB2, WUPT, D / 64, D * 2, D * 2, 0xffffffffu}; pg8::TileOrder S; S.init(M, 2 * FF, G, bx, D * 2, D * 2, 0, 1 << 30);
      pg8::EpiConv E{ACT8, SSQ2, conv_w, conv_b, GHB, UHB, GTB};
      pg8::gemm_phase<pg8::EpiConv, pg8::TileOrder, true>(L + RING_OFF, XL, g, S, E); }
    xcd_barrier(bar);

    { DECL_PTRS;
    for (int it = bx * 512 + tid; it < 256 * 22 * 2 * 32; it += G * 512) {
        const int c4 = (it & 31) * 4, rr = (it >> 5) & 1, tile = it >> 6, pm = tile / 22, pn = tile - pm * 22; const bool top = (pm & 31) == 0;
        const size_t sb = (size_t)tile * 256; const int col = pn * 128 + c4;
        const f32x4 g2 = *(const f32x4*)(GHB + sb + rr * 128 + c4), uu = *(const f32x4*)(UHB + sb + rr * 128 + c4);
        f32x4 g1 = (f32x4){0.f, 0.f, 0.f, 0.f}, g0 = (f32x4){0.f, 0.f, 0.f, 0.f};
        if (rr == 1) g1 = *(const f32x4*)(GHB + sb + c4); else if (!top) g1 = *(const f32x4*)(GTB + sb - 22 * 256 + 128 + c4);
        if (!top) g0 = *(const f32x4*)(GTB + sb - 22 * 256 + (rr == 1 ? 128 : 0) + c4);
        const f32x4 w0 = *(const f32x4*)(conv_w + col), w1 = *(const f32x4*)(conv_w + FF + col), w2 = *(const f32x4*)(conv_w + 2 * FF + col), cbv = *(const f32x4*)(conv_b + col);
        float res[4];
#pragma unroll
        for (int e = 0; e < 4; ++e) { const float gc = cbv[e] + w0[e] * g0[e] + w1[e] * g1[e] + w2[e] * g2[e]; res[e] = gc * __builtin_amdgcn_rcpf(1.0f + __builtin_amdgcn_exp2f(-LOG2E * gc)) * uu[e]; }
        *(unsigned*)(ACT8 + (size_t)(pm * 256 + rr) * FF + col) = pg8::pk4_fp8(res[0], res[1], res[2], res[3]);
    } }
    xcd_barrier(bar);

    { DECL_PTRS; pg8::Gemm g{ACT8, WDT, FF / 128, FF, FF, 0xffffffffu}; pg8::TileOrder S; S.init(M, D, G, bx, FF, FF, 0, 1 << 30);
      pg8::EpiResNorm E{HB2, out, g_final, 1.0f / 64.0f, SSQ3, (unsigned*)(ctl + CW_PANEL), (unsigned*)(ctl + CW_TMO2)};
      pg8::gemm_phase<pg8::EpiResNorm, pg8::TileOrder, true, true>(L + RING_OFF, XL, g, S, E); }
}

extern "C" void kernel_launch(void* const* d_in, const int* in_sizes, int n_in, void* d_out, int out_size, void* d_ws, size_t ws_size, hipStream_t stream) {
    static int grid = 0;
    if (grid == 0) {
        if (n_in != 19 || in_sizes[0] != M * D || out_size != M * D || ws_size < WS_END) { fprintf(stderr, "kernel_launch: unexpected problem shape (n_in %d, in0 %d, out %d, ws %zu); nothing launched\n", n_in, n_in > 0 ? in_sizes[0] : -1, out_size, ws_size); grid = -1; return; }
        int dev = 0, cus = 0, per_cu = 0;
        if (hipGetDevice(&dev) != hipSuccess || hipDeviceGetAttribute(&cus, hipDeviceAttributeMultiprocessorCount, dev) != hipSuccess) { grid = -1; return; }
        if (hipFuncSetAttribute((const void*)fwd, hipFuncAttributeMaxDynamicSharedMemorySize, LDS_BYTES) != hipSuccess) { fprintf(stderr, "kernel_launch: hipFuncSetAttribute failed\n"); grid = -1; return; }
        if (hipOccupancyMaxActiveBlocksPerMultiprocessor(&per_cu, (const void*)fwd, NWAVES * 64, LDS_BYTES) != hipSuccess || per_cu < 1) { fprintf(stderr, "kernel_launch: occupancy query reports %d\n", per_cu); }
        (void)hipGetLastError();
        grid = cus;
    }
    if (grid < 0) return;
    if (hipMemsetAsync((char*)d_ws + WS_CTL, 0, CTL_ZERO_BYTES, stream) != hipSuccess) return;
    Args a{};
    for (int i = 0; i < 19; ++i) a.in[i] = (const float*)d_in[i];
    a.out = (float*)d_out; a.ws = (unsigned char*)d_ws;
    hipLaunchKernelGGL(fwd, dim3(grid), dim3(NWAVES * 64), LDS_BYTES, stream, a);
}
```

```cpp
#include <hip/hip_runtime.h>
#include <hip/hip_bf16.h>
#include <cstdio>
#include <cstdint>

namespace pg8 {
#define PG8_LAS __attribute__((address_space(3)))
typedef unsigned short bf16_t;
typedef short bf16x8 __attribute__((ext_vector_type(8)));
typedef float f32x4 __attribute__((ext_vector_type(4)));
typedef float f32x2 __attribute__((ext_vector_type(2)));
typedef unsigned u32x4 __attribute__((ext_vector_type(4)));
typedef unsigned u32x2 __attribute__((ext_vector_type(2)));
typedef int i32x4 __attribute__((ext_vector_type(4)));
typedef int i32x8 __attribute__((ext_vector_type(8)));
constexpr int BM = 256, BK = 64, HALF = 128, HTB = HALF * BK * 2  , STAGE_BYTES = 8 * HTB, NXCD = 8, WGM = 8;

__host__ __device__ __forceinline__ int lds_byte(int r, int c) { const int st = (r >> 4) * 2 + (c >> 5), rr = r & 15, cc = c & 31, ob = rr * 64 + cc * 2; return st * 1024 + (ob ^ (((ob >> 9) & 1) << 5)); }
__host__ __device__ __forceinline__ void stage_rc(int b, int& R, int& C) { const int st = b / 1024, sb = b % 1024, swz = sb ^ (((sb >> 9) & 1) << 5); R = (st >> 1) * 16 + swz / 64; C = (st & 1) * 32 + (swz % 64) / 2; }
__host__ __device__ __forceinline__ int perm32(int rho) { const int n = rho >> 4, i = rho & 15; return 8 * (i >> 2) + 4 * n + (i & 3); }

struct Unit { int pm, pn; size_t aoff, boff; int skipb1; };
struct Gemm { const void* A; const void* Bt; int nt, lda, ldb; unsigned wrapmask; };

struct TileOrder {
    int nM, nN, nwg, G, c; size_t a_tile, b_tile, b_batch; int pmb;
    __device__ __forceinline__ void init(int M, int N, int G_, int c_, int lda_bytes, int ldb_bytes, size_t b_batch_bytes, int pm_per_batch) {
        nM = M / BM; nN = N / BM; nwg = nM * nN; G = G_; c = c_; deal = 0; skipmode = 0; a_tile = (size_t)BM * lda_bytes; b_tile = (size_t)BM * ldb_bytes; b_batch = b_batch_bytes; pmb = pm_per_batch; }
    int skipmode;
    int deal;
    __device__ __forceinline__ bool next(int i, Unit& u) const {
        long L = (long)i * G + c;
        if (deal == 1) { const int n = 11 + (c < 128 ? 1 : (c >= 192 ? 2 : 0)); if (i >= n) return false; if (i >= 11) L = c < 128 ? 2816 + c : 2944 + (i - 11) * 64 + (c - 192); }
        if (L >= nwg) return false;
        int wgid = (int)L; { const int q = nwg / NXCD, r = nwg % NXCD, xcd = wgid % NXCD, off = wgid / NXCD; wgid = (xcd < r ? xcd * (q + 1) : r * (q + 1) + (xcd - r) * q) + off; }
        const int nig = WGM * nN, gid = wgid / nig, fm = gid * WGM, gsz = (nM - fm) < WGM ? (nM - fm) : WGM;
        u.pm = fm + ((wgid % nig) % gsz); u.pn = (wgid % nig) / gsz;
        u.aoff = (size_t)u.pm * a_tile; u.boff = (size_t)u.pn * b_tile + (size_t)(u.pm / pmb) * b_batch; u.skipb1 = (skipmode && (u.pm & 31) <= 16) ? 1 : 0; return true;
    }
};

__device__ __forceinline__ unsigned cvt_pk_bf16(float lo, float hi) { unsigned r; asm volatile("v_cvt_pk_bf16_f32 %0, %1, %2" : "=v"(r) : "v"(lo), "v"(hi)); return r; }

typedef f32x4 AccT[2][2][4][2];

struct EpiBf16 {
    static constexpr bool PERM = true; static constexpr bool PERMA = false;
    bf16_t* O; int ldc; unsigned scalemask; float scale0; unsigned* nrm;
    __device__ __forceinline__ void operator()(AccT& acc, const Unit& u, int wr, int wc, int fr, int fq, PG8_LAS unsigned char*) const {
        const int row0 = u.pm * BM + wr * 64 + fr, col0 = u.pn * BM + wc * 32 + 8 * fq;
        const float sc = ((scalemask >> u.pn) & 1u) ? scale0 : 1.f;
        if (nrm && (u.pn < 4 || (u.pn >= 6 && u.pn < 10))) {
#pragma unroll
            for (int bj = 0; bj < 2; ++bj) { float mx = 0.f;
#pragma unroll
                for (int ai = 0; ai < 2; ++ai)
#pragma unroll
                    for (int m = 0; m < 4; ++m) { const f32x4 v0 = acc[ai][bj][m][0] * sc, v1 = acc[ai][bj][m][1] * sc;
                        float q = (v0[0] * v0[0] + v0[1] * v0[1]) + (v0[2] * v0[2] + v0[3] * v0[3]) + (v1[0] * v1[0] + v1[1] * v1[1]) + (v1[2] * v1[2] + v1[3] * v1[3]);
                        q += __shfl_xor(q, 16); q += __shfl_xor(q, 32); mx = fmaxf(mx, q); }
                mx = fmaxf(mx, __shfl_xor(mx, 1)); mx = fmaxf(mx, __shfl_xor(mx, 2)); mx = fmaxf(mx, __shfl_xor(mx, 4)); mx = fmaxf(mx, __shfl_xor(mx, 8));
                if (fr == 0 && fq == 0) { const int head = (u.pn & 1) * 4 + 2 * bj + (wc >> 1); const int grp = u.pn < 4 ? (u.pn >> 1) : (u.pn >> 1) - 1; atomicMax(nrm + (((u.pm >> 5) * 8 + head) * 4 + grp) * 2 + (wc & 1), __float_as_uint(mx)); } } }
#pragma unroll
        for (int ai = 0; ai < 2; ++ai)
#pragma unroll
            for (int m = 0; m < 4; ++m) { bf16_t* rowp = O + (size_t)(row0 + ai * HALF + m * 16) * ldc + col0;
#pragma unroll
                for (int bj = 0; bj < 2; ++bj) { const f32x4 v0 = acc[ai][bj][m][0] * sc, v1 = acc[ai][bj][m][1] * sc;
                    u32x4 w; w.x = cvt_pk_bf16(v0[0], v0[1]); w.y = cvt_pk_bf16(v0[2], v0[3]); w.z = cvt_pk_bf16(v1[0], v1[1]); w.w = cvt_pk_bf16(v1[2], v1[3]);
                    *(u32x4*)(rowp + bj * HALF) = w; } }
    }
};
__device__ __forceinline__ unsigned pk4_fp8(float a, float b, float c, float d) { a = __builtin_amdgcn_fmed3f(a, -448.f, 448.f); b = __builtin_amdgcn_fmed3f(b, -448.f, 448.f); c = __builtin_amdgcn_fmed3f(c, -448.f, 448.f); d = __builtin_amdgcn_fmed3f(d, -448.f, 448.f); int w = 0;
    w = __builtin_amdgcn_cvt_pk_fp8_f32(a, b, w, false); w = __builtin_amdgcn_cvt_pk_fp8_f32(c, d, w, true); return (unsigned)w; }
struct EpiF8 {
    static constexpr bool PERM = true; static constexpr bool PERMA = false;
    unsigned char* O; int ldc; float sc;
    __device__ __forceinline__ void operator()(AccT& acc, const Unit& u, int wr, int wc, int fr, int fq, PG8_LAS unsigned char*) const {
        const int row0 = u.pm * BM + wr * 64 + fr, col0 = u.pn * BM + wc * 32 + 8 * fq;
#pragma unroll
        for (int ai = 0; ai < 2; ++ai)
#pragma unroll
            for (int m = 0; m < 4; ++m) { unsigned char* rowp = O + (size_t)(row0 + ai * HALF + m * 16) * ldc + col0;
#pragma unroll
                for (int bj = 0; bj < 2; ++bj) { const f32x4 v0 = acc[ai][bj][m][0] * sc, v1 = acc[ai][bj][m][1] * sc;
                    *(u32x2*)(rowp + bj * HALF) = (u32x2){pk4_fp8(v0[0], v0[1], v0[2], v0[3]), pk4_fp8(v1[0], v1[1], v1[2], v1[3])}; } }
    }
};
__device__ __forceinline__ float rstd_from_slots(const float* slots) {
    const f32x4 a = *(const f32x4*)slots, b = *(const f32x4*)(slots + 4), c = *(const f32x4*)(slots + 8), d = *(const f32x4*)(slots + 12);
    const float s = ((a[0] + a[1]) + (a[2] + a[3])) + ((b[0] + b[1]) + (b[2] + b[3])) + ((c[0] + c[1]) + (c[2] + c[3])) + ((d[0] + d[1]) + (d[2] + d[3]));
    return __builtin_amdgcn_rsqf(s * (1.0f / 1024.0f) + 1e-6f);
}
#define PG8_DPP(old, src, ctrl) __builtin_bit_cast(float, __builtin_amdgcn_update_dpp(__builtin_bit_cast(int, (float)(old)), __builtin_bit_cast(int, (float)(src)), (ctrl), 0xf, 0xf, false))
struct EpiConv {
    static constexpr bool PERM = true; static constexpr bool PERMA = true;
    unsigned char* act; const float* ssq; const float* cw; const float* cbias; float* GH; float* UH; float* GT;
    __device__ __forceinline__ void operator()(AccT& acc, const Unit& u, int wr, int wc, int fr, int fq, PG8_LAS unsigned char* xl) const {
        PG8_LAS float* H = (PG8_LAS float*)xl;
        const int cl = wc * 32 + 8 * fq;
        PG8_LAS float* Sr = H + 1024;
        f32x4 cwv[2][4];
#pragma unroll
        for (int n = 0; n < 2; ++n) { const int c0 = u.pn * 128 + cl + 4 * n; cwv[n][0] = *(const f32x4*)(cw + c0); cwv[n][1] = *(const f32x4*)(cw + 2816 + c0); cwv[n][2] = *(const f32x4*)(cw + 2 * 2816 + c0); cwv[n][3] = *(const f32x4*)(cbias + c0); }
        { const int t_ = threadIdx.x; if (t_ < 256) Sr[t_] = rstd_from_slots(ssq + (size_t)(u.pm * BM + t_) * 16); }
        asm volatile("s_waitcnt vmcnt(0) lgkmcnt(0)" ::: "memory"); __builtin_amdgcn_s_barrier(); asm volatile("" ::: "memory");
#pragma unroll
        for (int n = 0; n < 2; ++n)
#pragma unroll
            for (int k = 0; k < 4; ++k) asm volatile("" : "+v"(cwv[n][k]));
#pragma unroll
        for (int ai = 0; ai < 2; ++ai) { const f32x4 rs4 = *(const PG8_LAS f32x4*)(Sr + ai * HALF + wr * 64 + 4 * fr);
#pragma unroll
            for (int m = 0; m < 4; ++m)
#pragma unroll
                for (int bj = 0; bj < 2; ++bj)
#pragma unroll
                    for (int n = 0; n < 2; ++n) acc[ai][bj][m][n] *= rs4[m]; }
        const size_t sb = ((size_t)(u.pm * 22 + u.pn) * 2) * 128 + cl;
        if (fr == 15) {
#pragma unroll
            for (int ai = 0; ai < 2; ++ai)
#pragma unroll
                for (int r = 0; r < 2; ++r)
#pragma unroll
                    for (int n = 0; n < 2; ++n) *(PG8_LAS f32x4*)(H + ((ai * 2 + wr) * 2 + r) * 128 + cl + 4 * n) = acc[ai][0][2 + r][n];
            if (wr == 1) {
#pragma unroll
                for (int r = 0; r < 2; ++r)
#pragma unroll
                    for (int n = 0; n < 2; ++n) *(f32x4*)(GT + sb + r * 128 + 4 * n) = acc[1][0][2 + r][n]; } }
        if (wr == 0 && fr == 0) {
#pragma unroll
            for (int r = 0; r < 2; ++r)
#pragma unroll
                for (int n = 0; n < 2; ++n) { *(f32x4*)(GH + sb + r * 128 + 4 * n) = acc[0][0][r][n]; *(f32x4*)(UH + sb + r * 128 + 4 * n) = acc[0][1][r][n]; } }
        asm volatile("s_waitcnt lgkmcnt(0)" ::: "memory"); __builtin_amdgcn_s_barrier(); asm volatile("" ::: "memory");
        const int row0 = u.pm * BM + wr * 64 + 4 * fr;
#pragma unroll
        for (int n = 0; n < 2; ++n) {
            const int c0 = u.pn * 128 + cl + 4 * n;
            const f32x4 w0 = cwv[n][0], w1 = cwv[n][1], w2 = cwv[n][2], cbv = cwv[n][3];
#pragma unroll
            for (int ai = 0; ai < 2; ++ai) {
                const int pblk = ai * 2 + wr - 1;
                f32x4 h62 = (f32x4){0.f, 0.f, 0.f, 0.f}, h63 = h62;
                if (pblk >= 0) { h62 = *(const PG8_LAS f32x4*)(H + (pblk * 2 + 0) * 128 + cl + 4 * n); h63 = *(const PG8_LAS f32x4*)(H + (pblk * 2 + 1) * 128 + cl + 4 * n); }
                float res[4][4];
#pragma unroll
                for (int i = 0; i < 4; ++i) { const float X0 = acc[ai][0][0][n][i], X1 = acc[ai][0][1][n][i], X2 = acc[ai][0][2][n][i], X3 = acc[ai][0][3][n][i];
                    const float A1 = PG8_DPP(h63[i], X3, 0x111), A2 = PG8_DPP(h62[i], X2, 0x111);
                    float gc[4];
                    gc[0] = cbv[i] + w0[i] * A2 + w1[i] * A1 + w2[i] * X0;
                    gc[1] = cbv[i] + w0[i] * A1 + w1[i] * X0 + w2[i] * X1;
                    gc[2] = cbv[i] + w0[i] * X0 + w1[i] * X1 + w2[i] * X2;
                    gc[3] = cbv[i] + w0[i] * X1 + w1[i] * X2 + w2[i] * X3;
#pragma unroll
                    for (int m = 0; m < 4; ++m) res[m][i] = gc[m] * __builtin_amdgcn_rcpf(1.0f + __builtin_amdgcn_exp2f(-1.4426950408889634f * gc[m])) * acc[ai][1][m][n][i]; }
#pragma unroll
                for (int m = 0; m < 4; ++m)
                    if (!(ai == 0 && wr == 0 && fr == 0 && m < 2))
                        *(unsigned*)(act + (size_t)(row0 + ai * HALF + m) * 2816 + c0) = pk4_fp8(res[m][0], res[m][1], res[m][2], res[m][3]);
            } }
    }
};
template <bool BASEB, bool OUTF> struct EpiRes {
    static constexpr bool PERM = true; static constexpr bool PERMA = false;
    const float* base; const bf16_t* baseb; float* out; bf16_t* hb; unsigned char* hb8; float* ssq; float accs;
    __device__ __forceinline__ void operator()(AccT& acc, const Unit& u, int wr, int wc, int fr, int fq, PG8_LAS unsigned char*) const {
        const int row0 = u.pm * BM + wr * 64 + fr, col0 = u.pn * BM + wc * 32 + 8 * fq;
        constexpr int DEPTH = BASEB ? 3 : 2;
        u32x4 pb[12][2]; f32x4 pf[12][2][2];
#define PG8_RES_LOAD(it) do { const size_t o_ = (size_t)(row0 + ((it) >> 2) * HALF + ((it) & 3) * 16) * 1024 + col0; \
            if constexpr (BASEB) { pb[it][0] = *(const u32x4*)(baseb + o_); pb[it][1] = *(const u32x4*)(baseb + o_ + HALF); } \
            else { pf[it][0][0] = *(const f32x4*)(base + o_); pf[it][0][1] = *(const f32x4*)(base + o_ + 4); pf[it][1][0] = *(const f32x4*)(base + o_ + HALF); pf[it][1][1] = *(const f32x4*)(base + o_ + HALF + 4); } } while (0)
#pragma unroll
        for (int it = 0; it < DEPTH; ++it) PG8_RES_LOAD(it);
#pragma unroll
        for (int it = 0; it < 8; ++it) { const int ai = it >> 2, m = it & 3;
            if (it + DEPTH < 8) PG8_RES_LOAD(it + DEPTH);
            __builtin_amdgcn_sched_barrier(0);
            const int row = row0 + ai * HALF + m * 16; const size_t off = (size_t)row * 1024 + col0; float q = 0.f;
#pragma unroll
            for (int bj = 0; bj < 2; ++bj) {
                f32x4 b0, b1;
                if constexpr (BASEB) { const u32x4 bw = pb[it][bj];
                    b0 = (f32x4){__builtin_bit_cast(float, bw.x << 16), __builtin_bit_cast(float, bw.x & 0xffff0000u), __builtin_bit_cast(float, bw.y << 16), __builtin_bit_cast(float, bw.y & 0xffff0000u)};
                    b1 = (f32x4){__builtin_bit_cast(float, bw.z << 16), __builtin_bit_cast(float, bw.z & 0xffff0000u), __builtin_bit_cast(float, bw.w << 16), __builtin_bit_cast(float, bw.w & 0xffff0000u)}; }
                else { b0 = pf[it][bj][0]; b1 = pf[it][bj][1]; }
                const f32x4 v0 = acc[ai][bj][m][0] * accs + b0, v1 = acc[ai][bj][m][1] * accs + b1;
                if constexpr (OUTF) { *(f32x4*)(out + off + bj * HALF) = v0; *(f32x4*)(out + off + bj * HALF + 4) = v1; }
                q += (v0[0] * v0[0] + v0[1] * v0[1]) + (v0[2] * v0[2] + v0[3] * v0[3]) + (v1[0] * v1[0] + v1[1] * v1[1]) + (v1[2] * v1[2] + v1[3] * v1[3]);
                if (hb) { u32x4 w; w.x = cvt_pk_bf16(v0[0], v0[1]); w.y = cvt_pk_bf16(v0[2], v0[3]); w.z = cvt_pk_bf16(v1[0], v1[1]); w.w = cvt_pk_bf16(v1[2], v1[3]); *(u32x4*)(hb + off + bj * HALF) = w; }
                if (hb8) *(u32x2*)(hb8 + off + bj * HALF) = (u32x2){pk4_fp8(v0[0], v0[1], v0[2], v0[3]), pk4_fp8(v1[0], v1[1], v1[2], v1[3])}; }
            q += __shfl_xor(q, 16); q += __shfl_xor(q, 32);
            if (fq == 0) ssq[(size_t)row * 16 + u.pn * 4 + wc] = q;
            __builtin_amdgcn_sched_barrier(0); }
#undef PG8_RES_LOAD
    }
};
struct EpiResNorm {
    static constexpr bool PERM = true; static constexpr bool PERMA = false;
    const bf16_t* baseb; float* out; const float* gfin; float accs; float* xbuf; unsigned* cnt; unsigned* tmo;
    __device__ __forceinline__ void operator()(AccT& acc, const Unit& u, int wr, int wc, int fr, int fq, PG8_LAS unsigned char* xl) const {
        PG8_LAS float* Pp = (PG8_LAS float*)xl;
        PG8_LAS float* Sr = Pp + 1024;
        PG8_LAS unsigned* flag = (PG8_LAS unsigned*)(Sr + 256);
        const int tid = threadIdx.x, wid = tid >> 6, lane = tid & 63;
        const int row0 = u.pm * BM + wr * 64 + fr, col0 = u.pn * BM + wc * 32 + 8 * fq;
        f32x4 gg[2][2];
#pragma unroll
        for (int bj = 0; bj < 2; ++bj) { gg[bj][0] = *(const f32x4*)(gfin + col0 + bj * HALF); gg[bj][1] = *(const f32x4*)(gfin + col0 + bj * HALF + 4); }
        u32x4 pb[12][2];
#define PG8_RN_LOAD(it) do { const size_t o_ = (size_t)(row0 + ((it) >> 2) * HALF + ((it) & 3) * 16) * 1024 + col0; pb[it][0] = *(const u32x4*)(baseb + o_); pb[it][1] = *(const u32x4*)(baseb + o_ + HALF); } while (0)
#pragma unroll
        for (int it = 0; it < 4; ++it) PG8_RN_LOAD(it);
#pragma unroll
        for (int it = 0; it < 8; ++it) { const int ai = it >> 2, m = it & 3;
                if (it + 4 < 8) PG8_RN_LOAD(it + 4);
                __builtin_amdgcn_sched_barrier(0);
                float q = 0.f;
#pragma unroll
                for (int bj = 0; bj < 2; ++bj) {
                    const u32x4 bw = pb[it][bj];
                    const f32x4 b0 = (f32x4){__builtin_bit_cast(float, bw.x << 16), __builtin_bit_cast(float, bw.x & 0xffff0000u), __builtin_bit_cast(float, bw.y << 16), __builtin_bit_cast(float, bw.y & 0xffff0000u)};
                    const f32x4 b1 = (f32x4){__builtin_bit_cast(float, bw.z << 16), __builtin_bit_cast(float, bw.z & 0xffff0000u), __builtin_bit_cast(float, bw.w << 16), __builtin_bit_cast(float, bw.w & 0xffff0000u)};
                    const f32x4 v0 = acc[ai][bj][m][0] * accs + b0, v1 = acc[ai][bj][m][1] * accs + b1; acc[ai][bj][m][0] = v0; acc[ai][bj][m][1] = v1;
                    q += (v0[0] * v0[0] + v0[1] * v0[1]) + (v0[2] * v0[2] + v0[3] * v0[3]) + (v1[0] * v1[0] + v1[1] * v1[1]) + (v1[2] * v1[2] + v1[3] * v1[3]); }
                q += __shfl_xor(q, 16); q += __shfl_xor(q, 32);
                if (fq == 0) Pp[(ai * HALF + wr * 64 + m * 16 + fr) * 4 + wc] = q;
                __builtin_amdgcn_sched_barrier(0); }
#undef PG8_RN_LOAD
        asm volatile("s_waitcnt lgkmcnt(0)" ::: "memory"); __builtin_amdgcn_s_barrier(); asm volatile("" ::: "memory");
        if (wid < 4) { const int r = wid * 64 + lane; const f32x4 p = *(const PG8_LAS f32x4*)(Pp + r * 4);
            __hip_atomic_store(xbuf + (size_t)(u.pm * BM + r) * 4 + u.pn, (p[0] + p[1]) + (p[2] + p[3]), __ATOMIC_RELAXED, __HIP_MEMORY_SCOPE_AGENT);
            asm volatile("s_waitcnt vmcnt(0)" ::: "memory");
            if (lane == 0) __hip_atomic_fetch_add(cnt + 64 * u.pm, 1u, __ATOMIC_RELAXED, __HIP_MEMORY_SCOPE_AGENT); }
        if (wid == 0) { unsigned sp = 0u; bool dead = false;
            for (;;) { if ((unsigned)__builtin_amdgcn_readfirstlane(__hip_atomic_load(cnt + 64 * u.pm, __ATOMIC_RELAXED, __HIP_MEMORY_SCOPE_AGENT)) >= 16u) break;
                if (++sp > (1u << 20)) { if (lane == 0) __hip_atomic_store(tmo, 1u, __ATOMIC_RELAXED, __HIP_MEMORY_SCOPE_AGENT); dead = true; break; }
                __builtin_amdgcn_s_sleep(2); }
            __builtin_amdgcn_fence(__ATOMIC_ACQUIRE, "agent");
            if (lane == 0) flag[0] = dead ? 1u : 0u; }
        asm volatile("s_waitcnt vmcnt(0) lgkmcnt(0)" ::: "memory"); __builtin_amdgcn_s_barrier(); asm volatile("" ::: "memory");
        if (wid < 4) { const int r = wid * 64 + lane; const float* xs = xbuf + (size_t)(u.pm * BM + r) * 4; float s = 0.f;
#pragma unroll
            for (int t = 0; t < 4; ++t) s += __hip_atomic_load(xs + t, __ATOMIC_RELAXED, __HIP_MEMORY_SCOPE_AGENT);
            Sr[r] = __builtin_amdgcn_rsqf(s * (1.0f / 1024.0f) + 1e-6f); }
        asm volatile("s_waitcnt vmcnt(0) lgkmcnt(0)" ::: "memory"); __builtin_amdgcn_s_barrier(); asm volatile("" ::: "memory");
#pragma unroll
        for (int ai = 0; ai < 2; ++ai)
#pragma unroll
            for (int m = 0; m < 4; ++m) { const int rl = ai * HALF + wr * 64 + m * 16 + fr; const float rs = Sr[rl]; const size_t off = (size_t)(u.pm * BM + rl) * 1024 + col0;
#pragma unroll
                for (int bj = 0; bj < 2; ++bj) { *(f32x4*)(out + off + bj * HALF) = acc[ai][bj][m][0] * rs * gg[bj][0]; *(f32x4*)(out + off + bj * HALF + 4) = acc[ai][bj][m][1] * rs * gg[bj][1]; } }
    }
};
struct EpiSoftmax {
    static constexpr bool PERM = true; static constexpr bool PERMA = false;
    unsigned char* P; const float* ssq; float sscale;
    __device__ __forceinline__ void operator()(AccT& acc, const Unit& u, int wr, int wc, int fr, int fq, PG8_LAS unsigned char* xl) const {
        PG8_LAS f32x2* X = (PG8_LAS f32x2*)xl;
        const int row0 = u.pm * BM + wr * 64 + fr, col0 = u.pn * BM + wc * 32 + 8 * fq;
        float ml[2][4];
        f32x4 sl[8];
#pragma unroll
        for (int it = 0; it < 8; ++it) sl[it] = *(const f32x4*)(ssq + (size_t)(row0 + (it >> 2) * HALF + (it & 3) * 16) * 16 + fq * 4);
        __builtin_amdgcn_sched_barrier(0);
#pragma unroll
        for (int ai = 0; ai < 2; ++ai)
#pragma unroll
            for (int m = 0; m < 4; ++m) { float ps = (sl[ai * 4 + m][0] + sl[ai * 4 + m][1]) + (sl[ai * 4 + m][2] + sl[ai * 4 + m][3]); ps += __shfl_xor(ps, 16); ps += __shfl_xor(ps, 32);
                const float rs = __builtin_amdgcn_rsqf(ps * (1.0f / 1024.0f) + 1e-6f) * sscale;
                float mx = -3.0e38f;
#pragma unroll
                for (int bj = 0; bj < 2; ++bj)
#pragma unroll
                    for (int n = 0; n < 2; ++n) { f32x4 v = acc[ai][bj][m][n] * rs; acc[ai][bj][m][n] = v; mx = fmaxf(fmaxf(mx, fmaxf(v[0], v[1])), fmaxf(v[2], v[3])); }
                mx = fmaxf(mx, __shfl_xor(mx, 16)); mx = fmaxf(mx, __shfl_xor(mx, 32));
                float s = 0.f;
#pragma unroll
                for (int bj = 0; bj < 2; ++bj)
#pragma unroll
                    for (int n = 0; n < 2; ++n) { f32x4 v = acc[ai][bj][m][n];
                        v[0] = __builtin_amdgcn_exp2f(v[0] - mx); v[1] = __builtin_amdgcn_exp2f(v[1] - mx); v[2] = __builtin_amdgcn_exp2f(v[2] - mx); v[3] = __builtin_amdgcn_exp2f(v[3] - mx);
                        acc[ai][bj][m][n] = v; s += (v[0] + v[1]) + (v[2] + v[3]); }
                s += __shfl_xor(s, 16); s += __shfl_xor(s, 32);
                ml[ai][m] = mx;
                if (fq == 0) X[(ai * HALF + wr * 64 + m * 16 + fr) * 4 + wc] = (f32x2){mx, s}; }
        asm volatile("s_waitcnt lgkmcnt(0)" ::: "memory"); __builtin_amdgcn_s_barrier(); asm volatile("" ::: "memory");
#pragma unroll
        for (int ai = 0; ai < 2; ++ai)
#pragma unroll
            for (int m = 0; m < 4; ++m) { const int rl = ai * HALF + wr * 64 + m * 16 + fr; const int row = u.pm * BM + rl;
                const f32x2 a = X[rl * 4 + 0], b = X[rl * 4 + 1], c = X[rl * 4 + 2], d = X[rl * 4 + 3];
                const float Mx = fmaxf(fmaxf(a.x, b.x), fmaxf(c.x, d.x));
                const float L = a.y * __builtin_amdgcn_exp2f(a.x - Mx) + b.y * __builtin_amdgcn_exp2f(b.x - Mx) + c.y * __builtin_amdgcn_exp2f(c.x - Mx) + d.y * __builtin_amdgcn_exp2f(d.x - Mx);
                const float f = __builtin_amdgcn_exp2f(ml[ai][m] - Mx) * __builtin_amdgcn_rcpf(L) * 256.0f;
                unsigned char* rowp = P + (size_t)row * 1024 + col0;
#pragma unroll
                for (int bj = 0; bj < 2; ++bj) { const f32x4 v0 = acc[ai][bj][m][0] * f, v1 = acc[ai][bj][m][1] * f;
                    *(u32x2*)(rowp + bj * HALF) = (u32x2){pk4_fp8(v0[0], v0[1], v0[2], v0[3]), pk4_fp8(v1[0], v1[1], v1[2], v1[3])}; } }
    }
};
struct EpiGate {
    static constexpr bool PERM = false; static constexpr bool PERMA = false;
    unsigned* sel;
    __device__ __forceinline__ void operator()(AccT& acc, const Unit& u, int wr, int wc, int fr, int fq, PG8_LAS unsigned char*) const {
        const int own = u.pm & 31;
#pragma unroll
        for (int ai = 0; ai < 2; ++ai)
#pragma unroll
            for (int m = 0; m < 4; ++m) { const int row = u.pm * BM + ai * HALF + wr * 64 + m * 16 + fr;
#pragma unroll
                for (int n = 0; n < 2; ++n) { unsigned mask = 0u;
#pragma unroll
                    for (int round = 0; round < 3; ++round) { float bv = -3.0e38f; int bi = 32;
#pragma unroll
                        for (int bj = 0; bj < 2; ++bj)
#pragma unroll
                            for (int i = 0; i < 4; ++i) { const int nb = 16 * bj + 4 * fq + i; const float v = acc[ai][bj][m][n][i];
                                if (nb < own && !((mask >> nb) & 1u) && v > bv) { bv = v; bi = nb; } }
#pragma unroll
                        for (int off = 16; off <= 32; off <<= 1) { const float ov = __shfl_xor(bv, off); const int oi = __shfl_xor(bi, off); if (ov > bv || (ov == bv && oi < bi)) { bv = ov; bi = oi; } }
                        if (bi < 32) mask |= 1u << bi; }
                    if (fq == 0) sel[((size_t)((u.pm >> 5) * 8 + 2 * wc + n)) * 8192 + (row & 8191)] = mask; } }
    }
};

template <class Epi, class Sched, bool ALIGN_EPI, bool F8 = false, bool CANSKIP = false>
__device__ __forceinline__ void gemm_phase(PG8_LAS unsigned char* lds, PG8_LAS unsigned char* xl, const Gemm g, const Sched& S, const Epi& E) {
    int tid_ = threadIdx.x; asm volatile("" : "+v"(tid_));
    const int tid = tid_, wid = __builtin_amdgcn_readfirstlane(tid >> 6), lane = tid & 63, wr = wid >> 2, wc = wid & 3, fr = lane & 15, fq = lane >> 4;
    int nt = g.nt; asm volatile("" : "+s"(nt));
    unsigned voffA[2], voffB[2];
#pragma unroll
    for (int i = 0; i < 2; ++i) { int R, C; stage_rc(tid * 16 + i * 8192, R, C); const int Rb = Epi::PERM ? ((R & ~31) + perm32(R & 31)) : R;
        const int Ra = Epi::PERMA ? ((R & ~63) + 4 * (R & 15) + ((R >> 4) & 3)) : R;
        voffA[i] = (unsigned)(Ra * g.lda + C * 2); voffB[i] = (unsigned)(Rb * g.ldb + C * 2); }
    const size_t kstep = (size_t)(BK * 2);
    const size_t hstepA = (size_t)HALF * g.lda, hstepB = (size_t)HALF * g.ldb;
    const unsigned wmask = g.wrapmask;
    const unsigned ldsw = (unsigned)wid * 1024u;
    const int aoff = lds_byte(wr * 64 + fr, fq * 8), boff = lds_byte(wc * 32 + fr, fq * 8);
#define PG8_SA(b, h) (((b) * 2 + (h)) * HTB)
#define PG8_SB(b, h) ((4 + (b) * 2 + (h)) * HTB)
#define PG8_STAGE(bufoff, gbase, voff) do { _Pragma("unroll") for (int _i = 0; _i < 2; ++_i) \
        __builtin_amdgcn_global_load_lds((const unsigned*)((const char*)(gbase) + (voff)[_i]), (PG8_LAS unsigned*)(lds + (bufoff) + ldsw + _i * 8192), 16, 0, 0); } while (0)
#define PG8_LDA(dst, b, h) do { if constexpr (F8) { _Pragma("unroll") for (int m = 0; m < 4; ++m) { dst##8[m].lo = *(const PG8_LAS i32x4*)(lds + PG8_SA(b, h) + aoff + m * 2048); dst##8[m].hi = *(const PG8_LAS i32x4*)(lds + PG8_SA(b, h) + aoff + m * 2048 + 1024); } } \
        else { _Pragma("unroll") for (int m = 0; m < 4; ++m) _Pragma("unroll") for (int k = 0; k < 2; ++k) dst[m][k] = *(const PG8_LAS bf16x8*)(lds + PG8_SA(b, h) + aoff + m * 2048 + k * 1024); } } while (0)
#define PG8_LDB(dst, b, h) do { if constexpr (F8) { _Pragma("unroll") for (int n = 0; n < 2; ++n) { dst##8[n].lo = *(const PG8_LAS i32x4*)(lds + PG8_SB(b, h) + boff + n * 2048); dst##8[n].hi = *(const PG8_LAS i32x4*)(lds + PG8_SB(b, h) + boff + n * 2048 + 1024); } } \
        else { _Pragma("unroll") for (int n = 0; n < 2; ++n) _Pragma("unroll") for (int k = 0; k < 2; ++k) dst[n][k] = *(const PG8_LAS bf16x8*)(lds + PG8_SB(b, h) + boff + n * 2048 + k * 1024); } } while (0)
#define PG8_MMA(ai, bj, At, Bt) do { __builtin_amdgcn_s_setprio(1); \
        if constexpr (F8) { _Pragma("unroll") for (int m = 0; m < 4; ++m) _Pragma("unroll") for (int n = 0; n < 2; ++n) \
            asm volatile("v_mfma_f32_16x16x128_f8f6f4 %0, %1, %2, %0" : "+v"(acc[ai][bj][m][n]) : "v"(Bt##8[n]), "v"(At##8[m])); } \
        else { _Pragma("unroll") for (int m = 0; m < 4; ++m) _Pragma("unroll") for (int n = 0; n < 2; ++n) _Pragma("unroll") for (int k = 0; k < 2; ++k) \
            acc[ai][bj][m][n] = __builtin_amdgcn_mfma_f32_16x16x32_bf16(Bt[n][k], At[m][k], acc[ai][bj][m][n], 0, 0, 0); } \
        __builtin_amdgcn_s_setprio(0); } while (0)
#define PG8_WAIT_V(n) asm volatile("s_waitcnt vmcnt(" #n ")" ::: "memory")
#define PG8_WAIT_L(n) asm volatile("s_waitcnt lgkmcnt(" #n ")" ::: "memory")
#define PG8_BAR __builtin_amdgcn_s_barrier()
#define PG8_SCHED __builtin_amdgcn_sched_barrier(0)
    Unit cur, nxt; int ui = 0;
    if (!S.next(0, cur)) return;
    AccT acc;
    bf16x8 At[4][2], B0[2][2], B1[2][2]; i32x8 At8[4], B08[2], B18[2];
    const char* cA = (const char*)g.A + cur.aoff; const char* cB = (const char*)g.Bt + cur.boff;
    PG8_STAGE(PG8_SB(0, 0), cB, voffB); PG8_STAGE(PG8_SB(0, 1), cB + hstepB, voffB); PG8_STAGE(PG8_SA(0, 0), cA, voffA); PG8_STAGE(PG8_SA(0, 1), cA + hstepA, voffA);
    if (wr == 1) PG8_BAR;
    PG8_WAIT_V(2); PG8_BAR;
    PG8_STAGE(PG8_SB(1, 0), cB + kstep, voffB); PG8_STAGE(PG8_SA(1, 0), cA + kstep, voffA); PG8_STAGE(PG8_SB(1, 1), cB + hstepB + kstep, voffB);
    PG8_WAIT_V(6); PG8_BAR;
    { float z0; asm volatile("v_mov_b32 %0, 0" : "=v"(z0));
#pragma unroll
    for (int a = 0; a < 2; ++a)
#pragma unroll
        for (int b = 0; b < 2; ++b)
#pragma unroll
            for (int m = 0; m < 4; ++m)
#pragma unroll
                for (int n = 0; n < 2; ++n) acc[a][b][m][n] = (f32x4){z0, z0, z0, z0}; }
    for (;;) {
        const bool has_next = S.next(ui + 1, nxt);
        const char* nA = has_next ? (const char*)g.A + nxt.aoff : cA; const char* nB = has_next ? (const char*)g.Bt + nxt.boff : cB;
#pragma unroll 1
        for (int t = 0; t < nt; t += 2) {
            const bool last = (t == nt - 2);
            const char* a1 = cA + (size_t)((unsigned)(t * 128) & wmask) + kstep;
            const char* a2 = last ? nA : cA + (size_t)((unsigned)((t + 2) * 128) & wmask); const char* b2 = last ? nB : cB + (size_t)(t + 2) * kstep;
            const char* a3 = a2 + kstep; const char* b3 = b2 + kstep;
            PG8_LDB(B0, 0, 0); if (!(CANSKIP && cur.skipb1)) PG8_LDB(B1, 0, 1); PG8_SCHED; PG8_LDA(At, 0, 0); PG8_STAGE(PG8_SA(1, 1), a1 + hstepA, voffA);
            PG8_WAIT_V(8); PG8_WAIT_L(0); PG8_BAR; PG8_MMA(0, 0, At, B0); if (!(CANSKIP && cur.skipb1)) PG8_MMA(0, 1, At, B1); PG8_BAR; PG8_SCHED;
            PG8_LDA(At, 0, 1); PG8_STAGE(PG8_SB(0, 0), b2, voffB); PG8_STAGE(PG8_SB(0, 1), b2 + hstepB, voffB); PG8_STAGE(PG8_SA(0, 0), a2, voffA);
            PG8_WAIT_V(8); PG8_WAIT_L(0); PG8_BAR; PG8_MMA(1, 0, At, B0); if (!(CANSKIP && cur.skipb1)) PG8_MMA(1, 1, At, B1); PG8_BAR; PG8_SCHED;
            PG8_LDB(B0, 1, 0); if (!(CANSKIP && cur.skipb1)) PG8_LDB(B1, 1, 1); PG8_SCHED; PG8_LDA(At, 1, 0); PG8_STAGE(PG8_SA(0, 1), a2 + hstepA, voffA);
            PG8_WAIT_V(8); PG8_WAIT_L(0); PG8_BAR; PG8_MMA(0, 0, At, B0); if (!(CANSKIP && cur.skipb1)) PG8_MMA(0, 1, At, B1); PG8_BAR; PG8_SCHED;
            PG8_LDA(At, 1, 1); PG8_STAGE(PG8_SB(1, 0), b3, voffB); PG8_STAGE(PG8_SB(1, 1), b3 + hstepB, voffB); PG8_STAGE(PG8_SA(1, 0), a3, voffA);
            PG8_WAIT_V(8); PG8_WAIT_L(0); PG8_BAR; PG8_MMA(1, 0, At, B0); if (!(CANSKIP && cur.skipb1)) PG8_MMA(1, 1, At, B1); PG8_BAR; PG8_SCHED;
        }
        if constexpr (F8) asm volatile("s_nop 15\n\ts_nop 15" ::: "memory");
        if constexpr (ALIGN_EPI) { if (wr == 0) PG8_BAR; }
        E(acc, cur, wr, wc, fr, fq, xl);
        if (!has_next) break;
#pragma unroll
        for (int a = 0; a < 2; ++a)
#pragma unroll
            for (int b = 0; b < 2; ++b)
#pragma unroll
                for (int m = 0; m < 4; ++m)
#pragma unroll
                    for (int n = 0; n < 2; ++n) acc[a][b][m][n] = (f32x4){0.f, 0.f, 0.f, 0.f};
        cur = nxt; cA = nA; cB = nB; ++ui;
        if constexpr (ALIGN_EPI) { if (wr == 1) PG8_BAR; }
    }
    PG8_WAIT_V(0);
    if constexpr (!ALIGN_EPI) { if (wr == 0) PG8_BAR; }
    PG8_BAR;
#undef PG8_SA
#undef PG8_SB
#undef PG8_STAGE
#undef PG8_LDA
#undef PG8_LDB
#undef PG8_MMA
#undef PG8_WAIT_V
#undef PG8_WAIT_L
#undef PG8_BAR
#undef PG8_SCHED
}
}

constexpr int NWAVES = 8;
constexpr int NB = 8, T = 8192, D = 1024, M = NB * T;
constexpr int INC = 3080, NQKV = 3072, FF = 2816;
constexpr int C_F = 1536, C_QM = 1544, C_KM = 2056;
constexpr float LOG2E = 1.4426950408889634f;
constexpr float C2 = 0.125f * LOG2E;
constexpr float RMS_EPS = 1e-6f;

constexpr size_t MiB = 1u << 20;
constexpr size_t WS_CTL = 0, CTL_ZERO_BYTES = 1 * MiB;
constexpr size_t WS_LOGF = 2 * MiB, WS_C = 4 * MiB, WS_ABAR = 6 * MiB, WS_KM = 7 * MiB, WS_SEL = 8 * MiB;
constexpr size_t WS_SSQ1 = 10 * MiB, WS_SSQ2 = 14 * MiB, WS_SSQ3 = 18 * MiB;
constexpr size_t WS_MEMN = 22 * MiB, WS_KV = 26 * MiB, WS_WQS = 34 * MiB, WS_WOT = 36 * MiB, WS_WKVT = 38 * MiB, WS_WINT = 42 * MiB, WS_WOUTT = 48 * MiB;
constexpr size_t WS_WUPT = 50 * MiB, WS_WDT = 976 * MiB  , WS_ZT = 68 * MiB, WS_WQK = 80 * MiB, WS_VWO = 96 * MiB;
constexpr size_t WS_ACT8 = 240 * MiB;
constexpr size_t WS_GH = 416 * MiB, WS_UH = 424 * MiB, WS_GT = 432 * MiB;
constexpr size_t WS_A1 = 112 * MiB;
constexpr size_t WS_QKV = 368 * MiB;
constexpr size_t WS_Y = 752 * MiB, WS_HB1 = WS_A1 + 128 * MiB, WS_P = WS_QKV, WS_HB2 = WS_A1;
constexpr size_t WS_HB1F = WS_A1;
constexpr size_t WS_PO = WS_A1;
constexpr size_t WS_LIST = 880 * MiB, WS_PML = 944 * MiB, WS_KXF = 960 * MiB, WS_KXM = 968 * MiB, WS_CNT = 969 * MiB;
constexpr size_t WS_G = 240 * MiB, WS_U = 592 * MiB, WS_END = 1024 * MiB;
static_assert(WS_WUPT + (size_t)2 * FF * D * 2 <= WS_ZT && WS_ACT8 + (size_t)M * FF <= WS_GH && WS_WDT + (size_t)D * FF <= WS_END && WS_CNT + 8192 <= WS_WDT && WS_ZT + (size_t)8 * 256 * 3072 * 2 <= WS_WQK && WS_VWO + 16 * MiB <= WS_A1, "ws map");
static_assert(WS_G + (size_t)M * FF * 2 <= WS_U && WS_U + (size_t)M * FF * 2 <= WS_END && WS_Y + (size_t)M * D * 2 <= WS_LIST && WS_LIST + (size_t)2048 * 8192 * 4 <= WS_PML && WS_PML + (size_t)M * 32 * 8 <= WS_KXF && WS_KXF + (size_t)64 * 8192 * 16 <= WS_KXM, "ws map 2");
constexpr int CW_BAR = 4096;
constexpr int CW_QKN = 8192;
constexpr int CW_QUEUE = 12288;
constexpr int CW_T0TAB = 16384;
constexpr int CW_CNT_KM = 24576, CW_CNT_Z = 24640, CW_CNT_KV = 24704;
constexpr int CW_PANEL = 32768, CW_TMO2 = 20480;

constexpr int RING_OFF = 0, RING_BYTES = 131072;
constexpr int LDSCTL_OFF = RING_BYTES, MISC_OFF = LDSCTL_OFF + 320;
constexpr int XL_OFF = RING_BYTES + 512;
constexpr int LDS_BYTES = 147456;
static_assert(XL_OFF + 8192 <= LDS_BYTES, "LDS map");

#define GAS __attribute__((address_space(1)))
#define LAS __attribute__((address_space(3)))
typedef unsigned short bf16;
typedef unsigned v4u __attribute__((ext_vector_type(4)));
typedef float f32x4 __attribute__((ext_vector_type(4)));
typedef GAS unsigned gu32;
#define RLX_AGENT __ATOMIC_RELAXED, __HIP_MEMORY_SCOPE_AGENT
#define LDS_WAIT() asm volatile("s_waitcnt lgkmcnt(0)" ::: "memory")
__device__ __forceinline__ unsigned f2bf(float f) { unsigned u = __builtin_bit_cast(unsigned, f); return (u + 0x7fffu + ((u >> 16) & 1u)) >> 16; }
__device__ __forceinline__ unsigned pk2(float lo, float hi) { unsigned r; asm("v_cvt_pk_bf16_f32 %0, %1, %2" : "=v"(r) : "v"(lo), "v"(hi)); return r; }
__device__ __forceinline__ float bf2f(unsigned b) { return __builtin_bit_cast(float, b << 16); }
__device__ __forceinline__ float bflo(unsigned w) { return __builtin_bit_cast(float, w << 16); }
__device__ __forceinline__ float bfhi(unsigned w) { return __builtin_bit_cast(float, w & 0xffff0000u); }

#define XB_TMO      128
#define XB_XCNT(j)  (256  + 64 * (j))
#define XB_XSUB(j)  (1280 + 64 * (j))
#define XB_XGEN(j)  (2304 + 64 * (j))
#define XB_TOP      3328
#define XB_TOPGEN   3392
#define XCD_BAR_WORDS 3456
#define XB_SPIN_CAP (1u << 18)

__device__ __forceinline__ unsigned xb_ld(unsigned* p)              { return __hip_atomic_load(p, __ATOMIC_RELAXED, __HIP_MEMORY_SCOPE_AGENT); }
__device__ __forceinline__ unsigned xb_add(unsigned* p, unsigned v) { return __hip_atomic_fetch_add(p, v, __ATOMIC_RELAXED, __HIP_MEMORY_SCOPE_AGENT); }
__device__ __forceinline__ unsigned xb_xcc_id() { return (unsigned)__builtin_amdgcn_s_getreg((3 << 11) | 20) & 0xFu; }
#define XB_SPIN(cond, bar) do { unsigned _sp = 0; while (cond) { __builtin_amdgcn_s_sleep(1); \
    if ((++_sp & 255u) == 0u) { if (xb_ld(&(bar)[XB_TMO])) break; if (_sp > XB_SPIN_CAP) { atomicAdd(&(bar)[XB_TMO], 1u); break; } } } } while (0)

struct XcdBarrier { unsigned* bar; unsigned x; volatile LAS unsigned* st; };

__device__ __forceinline__ XcdBarrier xcd_barrier_post(unsigned* bar, volatile LAS unsigned* st) {
    XcdBarrier b; b.bar = bar; b.x = xb_xcc_id(); b.st = st;
    if (threadIdx.x == 0) (void)xb_add(&bar[XB_XCNT(b.x)], 1u);
    return b;
}
__device__ __forceinline__ void xcd_barrier_complete(unsigned* bar, unsigned x, unsigned& nloc, unsigned& nx) {
    const unsigned G = gridDim.x * gridDim.y * gridDim.z;
    unsigned sum, cnt, mine, sp = 0u;
    for (;;) {
        sum = 0u; cnt = 0u; mine = 0u;
#pragma unroll
        for (unsigned j = 0; j < 16; ++j) { const unsigned c = xb_ld(&bar[XB_XCNT(j)]); sum += c; cnt += (c > 0u) ? 1u : 0u; mine = (j == x) ? c : mine; }
        if (sum == G) break;
        __builtin_amdgcn_s_sleep(1);
        if ((++sp & 255u) == 0u) { if (xb_ld(&bar[XB_TMO])) break; if (sp > XB_SPIN_CAP) { atomicAdd(&bar[XB_TMO], 1u); break; } }
    }
    nloc = mine > 0u ? mine : 1u; nx = cnt > 0u ? cnt : 1u;
}
__device__ __forceinline__ void xcd_barrier(const XcdBarrier& b) {
    asm volatile("s_waitcnt vmcnt(0)" ::: "memory");
    __syncthreads();
    if (threadIdx.x == 0) {
        unsigned* bar = b.bar;
        __builtin_amdgcn_s_waitcnt(0);
        unsigned nloc = b.st[0], nx = b.st[1];
        if (nloc == 0u) { xcd_barrier_complete(bar, b.x, nloc, nx); b.st[0] = nloc; b.st[1] = nx; }
        const unsigned old = xb_add(&bar[XB_XSUB(b.x)], 1u);
        const unsigned gen = old / nloc;
        if (old + 1u == (gen + 1u) * nloc) {
            __builtin_amdgcn_fence(__ATOMIC_RELEASE, "agent");
            asm volatile("s_waitcnt vmcnt(0)" ::: "memory");
            const unsigned og = xb_add(&bar[XB_TOP], 1u);
            const unsigned tg = og / nx;
            if (og + 1u == (tg + 1u) * nx) xb_add(&bar[XB_TOPGEN], 1u);
            else XB_SPIN(xb_ld(&bar[XB_TOPGEN]) == tg, bar);
            __builtin_amdgcn_fence(__ATOMIC_ACQUIRE, "agent");
            xb_add(&bar[XB_XGEN(b.x)], 1u);
            asm volatile("s_waitcnt vmcnt(0)" ::: "memory");
        } else {
            XB_SPIN(xb_ld(&bar[XB_XGEN(b.x)]) == gen, bar);
            __builtin_amdgcn_fence(__ATOMIC_ACQUIRE, "agent");
            asm volatile("s_waitcnt vmcnt(0)" ::: "memory");
        }
    }
    __syncthreads();
}

__device__ __forceinline__ float wave_sum(float v) {
#pragma unroll
    for (int o = 1; o < 64; o <<= 1) v += __shfl_xor(v, o);
    return v;
}
__device__ __forceinline__ void p0_transpose_item(const float* W, int ldw, int K, int N, bf16* WT, const float* kscale, bool remap, LAS float* scr, int item, int lane, float f8scale = 0.f, bool upmap = false) {
    const int nblk = N / 64, kb = item / nblk, nb = item % nblk, k0 = 32 * kb, n0 = 64 * nb;
    int sn0 = (remap && n0 >= 1536) ? n0 + 8 : n0;
    if (upmap) { const int within = n0 & 255, pt = n0 >> 8; sn0 = within < 128 ? 128 * pt + within : 2816 + 128 * pt + (within - 128); }
    float v[32];
#pragma unroll
    for (int i = 0; i < 32; ++i) v[i] = W[(size_t)(k0 + i) * ldw + sn0 + lane];
#pragma unroll
    for (int i = 0; i < 32; ++i) { float x = v[i]; if (kscale) x *= kscale[k0 + i]; scr[i * 65 + lane] = x; }
    LDS_WAIT(); asm volatile("" ::: "memory");
    const int kq = lane & 3;
#pragma unroll
    for (int j = 0; j < 4; ++j) { const int n = (lane >> 2) + 16 * j; const LAS float* sp = scr + (8 * kq) * 65 + n;
        if (f8scale != 0.f) { const unsigned lo = pg8::pk4_fp8(sp[0 * 65] * f8scale, sp[1 * 65] * f8scale, sp[2 * 65] * f8scale, sp[3 * 65] * f8scale), hi = pg8::pk4_fp8(sp[4 * 65] * f8scale, sp[5 * 65] * f8scale, sp[6 * 65] * f8scale, sp[7 * 65] * f8scale);
            *(GAS unsigned long long*)((unsigned char*)WT + (size_t)(n0 + n) * K + k0 + 8 * kq) = (unsigned long long)lo | ((unsigned long long)hi << 32); }
        else { v4u o; o.x = pk2(sp[0 * 65], sp[1 * 65]); o.y = pk2(sp[2 * 65], sp[3 * 65]); o.z = pk2(sp[4 * 65], sp[5 * 65]); o.w = pk2(sp[6 * 65], sp[7 * 65]);
            *(GAS v4u*)(WT + (size_t)(n0 + n) * K + k0 + 8 * kq) = o; } }
    LDS_WAIT(); asm volatile("" ::: "memory");
}

struct Args { const float* in[19]; float* out; unsigned char* ws; };
__device__ __forceinline__ float skip_thr(const unsigned* qk8, int moba) {
    const unsigned* p = qk8 + 4 * moba;
    const float qn = sqrtf(__uint_as_float(__hip_atomic_load(p, RLX_AGENT)) + __uint_as_float(__hip_atomic_load(p + 1, RLX_AGENT))), kn = sqrtf(__uint_as_float(__hip_atomic_load(p + 2, RLX_AGENT)) + __uint_as_float(__hip_atomic_load(p + 3, RLX_AGENT)));
    return 2.0f * qn * kn * 1.02f + 40.0f;
}
__device__ __forceinline__ bool moba_skip(int h, int j, int n, float thr) { return __builtin_amdgcn_exp2f(-(float)(h + 1)) * LOG2E * (float)(256 * (j - n - 1) + 1) >= thr; }

namespace attn_body {
using hb16=__hip_bfloat16;
using bf16x8=__attribute__((ext_vector_type(8)))short;
using s16x4=__attribute__((ext_vector_type(4)))short;
using f32x16=__attribute__((ext_vector_type(16)))float;
using u32x4=__attribute__((ext_vector_type(4)))unsigned;
constexpr int PITCH=3072;
constexpr int NW=8,QBLK=32,QB=QBLK*NW,KVBLK=64;
__device__ __forceinline__ int crow(int r,int hi){return (r&3)+8*(r>>2)+4*hi;}
#define SBAR() __builtin_amdgcn_sched_barrier(0)
__device__ __forceinline__ void cmask(f32x16&p0,f32x16&p1,int jb,int qrel,int hi){
  const float NEG=-INFINITY; int kb=64*jb+4*hi;
  #pragma unroll
  for(int r=0;r<16;++r){int kv=kb+(r&3)+8*(r>>2); if(kv>qrel)p0[r]=NEG; if(kv+32>qrel)p1[r]=NEG;}
}
constexpr int NSLOT=3, SLOTB=9216;
constexpr int LDS_K=0, LDS_V=NSLOT*SLOTB, LDS_WS=2*NSLOT*SLOTB, LDS_OST=LDS_WS+NW*64*4, LDS_BYTES=LDS_OST+NW*4096;
__device__ __forceinline__ void glds16(const void*gsrc,unsigned lds_dst){unsigned keep;
  asm volatile("s_mov_b32 %0, m0\n\ts_mov_b32 m0, %2\n\ts_nop 0\n\tglobal_load_lds_dwordx4 %1, off\n\ts_mov_b32 m0, %0":"=&s"(keep):"v"(gsrc),"s"(lds_dst):"memory");}
__device__ __forceinline__ void glds16x(const void*gsrc,unsigned lds_dst){unsigned keep;unsigned long long ex;
  asm volatile("s_mov_b32 %0, m0\n\ts_mov_b64 %1, exec\n\ts_mov_b64 exec, 0xff\n\ts_mov_b32 m0, %3\n\ts_nop 0\n\tglobal_load_lds_dwordx4 %2, off\n\ts_mov_b64 exec, %1\n\ts_mov_b32 m0, %0":"=&s"(keep),"=&s"(ex):"v"(gsrc),"s"(lds_dst):"memory");}
__device__ __forceinline__ float max3f(float a,float b,float c){float r;asm("v_max3_f32 %0, %1, %2, %3":"=v"(r):"v"(a),"v"(b),"v"(c));return r;}
__device__ __forceinline__ float max2f(float a,float b){float r;asm("v_max_f32_e32 %0, %1, %2":"=v"(r):"v"(a),"v"(b));return r;}
__device__ __forceinline__ float fsub_s(float a,float b){float r;asm("v_sub_f32_e32 %0, %1, %2":"=v"(r):"v"(a),"v"(b));return r;}
typedef float f32x2_t __attribute__((ext_vector_type(2))); typedef __bf16 bf16x2_t __attribute__((ext_vector_type(2)));
__device__ __forceinline__ unsigned cvtpk_s(float lo,float hi){f32x2_t v={lo,hi};bf16x2_t b=__builtin_convertvector(v,bf16x2_t);return __builtin_bit_cast(unsigned,b);}
__device__ __forceinline__ float rbf(float x){return __builtin_bit_cast(float,cvtpk_s(x,0.f)<<16);}
#define WAIT_BAR(N) asm volatile("s_waitcnt vmcnt(" #N ") lgkmcnt(0)\n\ts_barrier":::"memory")

__device__ __forceinline__ void qkt(f32x16&p0,f32x16&p1,const char*Kslot,const bf16x8*qr,int r32,int hi){
  const char*kb=Kslot+hi*1024+r32*16; const f32x16 zf={};
  #pragma unroll
  for(int d0=0;d0<4;++d0){
    const bf16x8 b0=*reinterpret_cast<const bf16x8*>(kb+d0*2048);
    const bf16x8 b1=*reinterpret_cast<const bf16x8*>(kb+d0*2048+512);
    if(d0==0){p0=__builtin_amdgcn_mfma_f32_32x32x16_bf16(b0,qr[0],zf,0,0,0);p1=__builtin_amdgcn_mfma_f32_32x32x16_bf16(b1,qr[0],zf,0,0,0);}
    else{p0=__builtin_amdgcn_mfma_f32_32x32x16_bf16(b0,qr[d0],p0,0,0,0);p1=__builtin_amdgcn_mfma_f32_32x32x16_bf16(b1,qr[d0],p1,0,0,0);}}
  const char*kx=Kslot+8192+r32*16;
  const bf16x8 x0=*reinterpret_cast<const bf16x8*>(kx), x1=*reinterpret_cast<const bf16x8*>(kx+512);
  p0=__builtin_amdgcn_mfma_f32_32x32x16_bf16(x0,qr[4],p0,0,0,0);p1=__builtin_amdgcn_mfma_f32_32x32x16_bf16(x1,qr[4],p1,0,0,0);
}
typedef __attribute__((address_space(3))) const char* lds_cptr;
typedef short v4i16_t __attribute__((ext_vector_type(4)));
__device__ __forceinline__ void kload10(bf16x8*kf,lds_cptr kp,lds_cptr kx){
  kf[0]=*(const __attribute__((address_space(3))) bf16x8*)(kp);      kf[1]=*(const __attribute__((address_space(3))) bf16x8*)(kp+512);
  kf[2]=*(const __attribute__((address_space(3))) bf16x8*)(kp+2048); kf[3]=*(const __attribute__((address_space(3))) bf16x8*)(kp+2560);
  kf[4]=*(const __attribute__((address_space(3))) bf16x8*)(kp+4096); kf[5]=*(const __attribute__((address_space(3))) bf16x8*)(kp+4608);
  kf[6]=*(const __attribute__((address_space(3))) bf16x8*)(kp+6144); kf[7]=*(const __attribute__((address_space(3))) bf16x8*)(kp+6656);
  kf[8]=*(const __attribute__((address_space(3))) bf16x8*)(kx);      kf[9]=*(const __attribute__((address_space(3))) bf16x8*)(kx+512);
}
__device__ __forceinline__ void kload2(bf16x8*kf,lds_cptr kp,int j){ kf[2*j]=*(const __attribute__((address_space(3))) bf16x8*)(kp+j*2048); kf[2*j+1]=*(const __attribute__((address_space(3))) bf16x8*)(kp+j*2048+512); }
__device__ __forceinline__ s16x4 vtr(lds_cptr p){ return __builtin_bit_cast(s16x4,__builtin_amdgcn_ds_read_tr16_b64_v4i16((__attribute__((address_space(3))) v4i16_t*)p)); }
__device__ __forceinline__ float rowmax(const f32x16&p0,const f32x16&p1){
  float a=max3f(p0[0],p0[1],p1[0]),b=max3f(p0[2],p0[3],p1[1]);a=max3f(a,p1[2],p1[3]);
  #pragma unroll
  for(int r=4;r<16;r+=4){a=max3f(a,p0[r],p0[r+1]);b=max3f(b,p0[r+2],p0[r+3]);a=max3f(a,p1[r],p1[r+1]);b=max3f(b,p1[r+2],p1[r+3]);}
  const float m=max2f(a,b);
  auto rr=__builtin_amdgcn_permlane32_swap(__float_as_uint(m),__float_as_uint(m),false,false);
  return max2f(__uint_as_float(rr[0]),__uint_as_float(rr[1]));
}
__device__ __forceinline__ void pv(f32x16*o,int vb,bf16x8 pa0,bf16x8 pa1,bf16x8 pa2,bf16x8 pa3){
  #pragma unroll
  for(int d0=0;d0<2;++d0){s16x4 lo[4],hi[4];
    #pragma unroll
    for(int ks=0;ks<4;++ks){
      asm volatile("ds_read_b64_tr_b16 %0,%1 offset:%c2":"=&v"(lo[ks]):"v"(vb),"i"(d0*4096+ks*1024):"memory");
      asm volatile("ds_read_b64_tr_b16 %0,%1 offset:%c2":"=&v"(hi[ks]):"v"(vb),"i"(d0*4096+ks*1024+512):"memory");}
    asm volatile("s_waitcnt lgkmcnt(0)":::"memory");SBAR();
    #define PK(k) (bf16x8){lo[k][0],lo[k][1],lo[k][2],lo[k][3],hi[k][0],hi[k][1],hi[k][2],hi[k][3]}
    o[d0]=__builtin_amdgcn_mfma_f32_32x32x16_bf16(pa0,PK(0),o[d0],0,0,0);
    o[d0]=__builtin_amdgcn_mfma_f32_32x32x16_bf16(pa1,PK(1),o[d0],0,0,0);
    o[d0]=__builtin_amdgcn_mfma_f32_32x32x16_bf16(pa2,PK(2),o[d0],0,0,0);
    o[d0]=__builtin_amdgcn_mfma_f32_32x32x16_bf16(pa3,PK(3),o[d0],0,0,0);
    #undef PK
  }
}

template<int THRL> __device__ __forceinline__ void attn_unit(char*shm,const int KIND,const hb16*Qc,int qrow,int oslot,const hb16*__restrict__ Kt0,const hb16*__restrict__ Vt0,const hb16*__restrict__ KXt0,int NT,int band0,hb16*Oc,hb16*PO,float*PML){
  const int tid=threadIdx.x,lane=tid&63,r32=lane&31,hi=lane>>5; const int wid=__builtin_amdgcn_readfirstlane(tid>>6);
  const unsigned lds0=(unsigned)(uintptr_t)shm;
  float*wsf=(float*)(shm+LDS_WS)+wid*64;
  const hb16*ksrc=Kt0+(long)lane*PITCH+wid*8;
  const hb16*vsrc=Vt0+(long)(16*(wid&3)+(lane>>2))*PITCH+(wid>>2)*32+(lane&3)*8;
  const hb16*xsrc=KXt0+(long)(8*wid+(lane&7))*8;
  const unsigned kdst=lds0+LDS_K+wid*1024, vdst=lds0+LDS_V+wid*1024, xdst=lds0+LDS_K+8192+wid*128;
  #define DMA_K(t,slot) do{ glds16(ksrc+(long)(t)*KVBLK*PITCH,(unsigned)__builtin_amdgcn_readfirstlane(kdst+(slot))); glds16x(xsrc+(long)(t)*KVBLK*8,(unsigned)__builtin_amdgcn_readfirstlane(xdst+(slot))); }while(0)
  #define DMA_V(t,slot) glds16(vsrc+(long)(t)*KVBLK*PITCH,(unsigned)__builtin_amdgcn_readfirstlane(vdst+(slot)))
  const int vb0=(int)(lds0+LDS_V)+((lane>>4)&1)*32+(lane&3)*8+(4*hi+((lane&15)>>2))*64;
  const char*Kbase=shm+LDS_K; bf16x8 kf[10];
  const lds_cptr shm3=(lds_cptr)shm; const lds_cptr kp0=shm3+LDS_K+hi*1024+r32*16; const lds_cptr kx0=shm3+LDS_K+8192+r32*16; const lds_cptr vp0=shm3+LDS_V+((lane>>4)&1)*32+(lane&3)*8+(4*hi+((lane&15)>>2))*64;
  DMA_K(0,0);DMA_V(0,0);DMA_K(1,SLOTB);
  bf16x8 qr[5];
  { const hb16*Qw=Qc+(long)qrow*PITCH;
    #pragma unroll
    for(int d0=0;d0<4;++d0)qr[d0]=*reinterpret_cast<const bf16x8*>(&Qw[d0*16+hi*8]); }
  float mhat=0.f,l_reg=0.f;f32x16 o[2];o[0]=f32x16{};o[1]=f32x16{};
  #define SETQX(mh_,ml_) do{ const unsigned bh_=cvtpk_s(-(mh_),-(ml_)); u32x4 qx_; qx_.x=0x3F803F80u; qx_.y=0x3F80u|(bh_<<16); qx_.z=(bh_>>16); qx_.w=0u; if(hi){qx_.x=0u;qx_.y=0u;qx_.z=0u;} qr[4]=__builtin_bit_cast(bf16x8,qx_); asm volatile("":"+v"(qr[4])); }while(0)
  #define MOVEREF(gain) const float mraw_=mhat+(gain); const float mh_=rbf(mraw_); const float ml_=rbf(mraw_-mh_); const float mnew_=mh_+ml_; const float dl=mnew_-mhat; mhat=mnew_; SETQX(mh_,ml_);
  SETQX(0.f,0.f);
  const int qrel=wid*QBLK+r32;
  #define CMASK(P0,P1,t) do{int jb_=(t)-band0; if(jb_>=0)cmask(P0,P1,jb_,qrel,hi);}while(0)
  bool resc=false;
  #define START(P0,P1) do{ const float rm=rowmax(P0,P1); resc=false; \
    { MOVEREF(rm) \
      _Pragma("unroll") for(int r=0;r<16;++r){P0[r]=fsub_s(P0[r],dl);P1[r]=fsub_s(P1[r],dl);} } \
    _Pragma("unroll") for(int r=0;r<16;++r)P0[r]=__builtin_amdgcn_exp2f(P0[r]); }while(0)
  #define RESC() do{ if(resc){ asm volatile("s_waitcnt lgkmcnt(0)":::"memory"); \
      _Pragma("unroll") for(int d_=0;d_<2;++d_) _Pragma("unroll") for(int r=0;r<16;++r)o[d_][r]*=wsf[crow(r,hi)]; } }while(0)
  f32x16 pA0,pA1,pB0,pB1;
  int sl_prev=0,sl_cur=0,sl_next=SLOTB;
  #define ROT() do{sl_prev=sl_cur;sl_cur=sl_next;sl_next=(sl_next==(NSLOT-1)*SLOTB)?0:sl_next+SLOTB;}while(0)
  DMA_K(2,2*SLOTB);
  WAIT_BAR(5);
  qkt(pA0,pA1,Kbase,qr,r32,hi);asm volatile("s_nop 15\n\ts_nop 7":"+v"(pA0),"+v"(pA1));CMASK(pA0,pA1,0);
  START(pA0,pA1);
  _Pragma("unroll") for(int r=0;r<16;++r)pA1[r]=__builtin_amdgcn_exp2f(pA1[r]);
  WAIT_BAR(0);
  DMA_K(3,0);DMA_V(1,SLOTB);
  ROT();
  kload10(kf,kp0+sl_cur,kx0+sl_cur);
  WAIT_BAR(3);
  s16x4 vlo[8],vhi[8]; u32x4 pw0,pw1,pw2,pw3; const f32x16 zf={};
  #define PKW(P,B) cvtpk_s(P[B],P[B+1])
  #define PAF(k) __builtin_bit_cast(bf16x8,pw##k)
  #define VFR(i) (bf16x8){vlo[i][0],vlo[i][1],vlo[i][2],vlo[i][3],vhi[i][0],vhi[i][1],vhi[i][2],vhi[i][3]}
  #define PIN(x) asm volatile("":"+v"(x))
  #define MX3(a,b,c) __builtin_fmaxf(__builtin_fmaxf((a),(b)),(c))
  #define GAPA(MF,A0,A1,A2,A3,W0,W1,PW) do{ MF; sacc+=A0; sacc+=A1; sacc+=A2; sacc+=A3; PIN(sacc); W0; W1; PIN(PW); SBAR(); }while(0)
  #define EX(v) __builtin_amdgcn_exp2f(v)
  #define GAPB(MF,X,B) do{ MF; X[B]=EX(X[B]); X[B+1]=EX(X[B+1]); X[B+2]=EX(X[B+2]); X[B+3]=EX(X[B+3]); PIN(X); SBAR(); }while(0)
  #define VRD(i) do{ vlo[i]=vtr(vp_+(((i)>>2)*4096+((i)&3)*1024)); vhi[i]=vtr(vp_+(((i)>>2)*4096+((i)&3)*1024+512)); }while(0)
  #define KRD(G,j) do{ if(G){ kload2(kf,kp0+sl_next,j); SBAR(); } }while(0)
  #define KRDX(G) do{ if(G){ kf[8]=*(const __attribute__((address_space(3))) bf16x8*)(kx0+sl_next); kf[9]=*(const __attribute__((address_space(3))) bf16x8*)(kx0+sl_next+512); SBAR(); } }while(0)
  #define STEP(C0,C1,P0,P1,t,GK,GV,GL) do{ SBAR(); \
    const lds_cptr vp_=vp0+sl_prev; \
    VRD(0); SBAR(); float sacc=(P0[0]+P0[1]); \
    GAPA(C0=__builtin_amdgcn_mfma_f32_32x32x16_bf16(kf[0],qr[0],zf,0,0,0), P0[2],P0[3],P0[4],P0[5],     pw0[0]=PKW(P0,0), pw0[1]=PKW(P0,2), pw0); \
    VRD(4); SBAR(); GAPA(C1=__builtin_amdgcn_mfma_f32_32x32x16_bf16(kf[1],qr[0],zf,0,0,0), P0[6],P0[7],P0[8],P0[9],     pw0[2]=PKW(P0,4), pw0[3]=PKW(P0,6), pw0); \
    VRD(1); SBAR(); GAPA(C0=__builtin_amdgcn_mfma_f32_32x32x16_bf16(kf[2],qr[1],C0,0,0,0),   P0[10],P0[11],P0[12],P0[13], pw1[0]=PKW(P0,8), pw1[1]=PKW(P0,10), pw1); \
    VRD(5); SBAR(); GAPA(C1=__builtin_amdgcn_mfma_f32_32x32x16_bf16(kf[3],qr[1],C1,0,0,0),   P0[14],P0[15],P1[0],P1[1],   pw1[2]=PKW(P0,12),pw1[3]=PKW(P0,14), pw1); \
    VRD(2); SBAR(); GAPA(C0=__builtin_amdgcn_mfma_f32_32x32x16_bf16(kf[4],qr[2],C0,0,0,0),   P1[2],P1[3],P1[4],P1[5],     pw2[0]=PKW(P1,0), pw2[1]=PKW(P1,2), pw2); \
    VRD(6); SBAR(); GAPA(C1=__builtin_amdgcn_mfma_f32_32x32x16_bf16(kf[5],qr[2],C1,0,0,0),   P1[6],P1[7],P1[8],P1[9],     pw2[2]=PKW(P1,4), pw2[3]=PKW(P1,6), pw2); \
    VRD(3); SBAR(); GAPA(C0=__builtin_amdgcn_mfma_f32_32x32x16_bf16(kf[6],qr[3],C0,0,0,0),   P1[10],P1[11],P1[12],P1[13], pw3[0]=PKW(P1,8), pw3[1]=PKW(P1,10), pw3); \
    VRD(7); SBAR(); GAPA(C1=__builtin_amdgcn_mfma_f32_32x32x16_bf16(kf[7],qr[3],C1,0,0,0),   P1[14],P1[15],0.f,0.f,       pw3[2]=PKW(P1,12),pw3[3]=PKW(P1,14), pw3); \
    C0=__builtin_amdgcn_mfma_f32_32x32x16_bf16(kf[8],qr[4],C0,0,0,0); SBAR(); \
    C1=__builtin_amdgcn_mfma_f32_32x32x16_bf16(kf[9],qr[4],C1,0,0,0); SBAR(); \
    l_reg+=sacc; \
    if(GK){DMA_K((t)+3,sl_cur);} if(GV){DMA_V((t)+1,sl_next);} \
    CMASK(C0,C1,t); \
    { float a=MX3(C0[0],C0[1],C1[0]),b=MX3(C0[2],C0[3],C1[1]); a=MX3(a,C1[2],C1[3]); \
      _Pragma("unroll") for(int r=4;r<16;r+=4){a=MX3(a,C0[r],C0[r+1]);b=MX3(b,C0[r+2],C0[r+3]);a=MX3(a,C1[r],C1[r+1]);b=MX3(b,C1[r+2],C1[r+3]);} \
      float rm=__builtin_fmaxf(a,b); { auto rr=__builtin_amdgcn_permlane32_swap(__float_as_uint(rm),__float_as_uint(rm),false,false); rm=__builtin_fmaxf(__uint_as_float(rr[0]),__uint_as_float(rr[1])); } \
      resc=false; \
      if(__builtin_expect(__any(rm>(float)THRL),0)){ MOVEREF(__builtin_fmaxf(rm,0.f)) \
        _Pragma("unroll") for(int r=0;r<16;++r){C0[r]-=dl;C1[r]-=dl;} \
        const float f=__builtin_amdgcn_exp2f(-dl); l_reg*=f; if(hi==0)wsf[r32]=f; resc=true; } } \
    SBAR(); \
    GAPB(o[0]=__builtin_amdgcn_mfma_f32_32x32x16_bf16(PAF(0),VFR(0),o[0],0,0,0), C0,0); \
    GAPB(o[1]=__builtin_amdgcn_mfma_f32_32x32x16_bf16(PAF(0),VFR(4),o[1],0,0,0), C0,4); \
    KRD(GL,0); GAPB(o[0]=__builtin_amdgcn_mfma_f32_32x32x16_bf16(PAF(1),VFR(1),o[0],0,0,0), C0,8); \
    KRD(GL,1); GAPB(o[1]=__builtin_amdgcn_mfma_f32_32x32x16_bf16(PAF(1),VFR(5),o[1],0,0,0), C0,12); \
    KRD(GL,2); GAPB(o[0]=__builtin_amdgcn_mfma_f32_32x32x16_bf16(PAF(2),VFR(2),o[0],0,0,0), C1,0); \
    KRD(GL,3); GAPB(o[1]=__builtin_amdgcn_mfma_f32_32x32x16_bf16(PAF(2),VFR(6),o[1],0,0,0), C1,4); \
    KRDX(GL); GAPB(o[0]=__builtin_amdgcn_mfma_f32_32x32x16_bf16(PAF(3),VFR(3),o[0],0,0,0), C1,8); \
    GAPB(o[1]=__builtin_amdgcn_mfma_f32_32x32x16_bf16(PAF(3),VFR(7),o[1],0,0,0), C1,12); \
    }while(0)
  int t=1;
  for(;t+5<NT&&t+1<band0;t+=2){
    #undef CMASK
    #define CMASK(P0,P1,t) do{}while(0)
    STEP(pB0,pB1,pA0,pA1,t,true,true,true);     WAIT_BAR(3); RESC(); ROT();
    STEP(pA0,pA1,pB0,pB1,t+1,true,true,true);   WAIT_BAR(3); RESC(); ROT();
  }
  #undef CMASK
  #define CMASK(P0,P1,t) do{int jb_=(t)-band0; if(jb_>=0)cmask(P0,P1,jb_,qrel,hi);}while(0)
  #define ENDW(tt) do{ if((tt)+3<NT){WAIT_BAR(3);} else if((tt)+2<NT){WAIT_BAR(1);} else {WAIT_BAR(0);} }while(0)
  for(;t+1<NT;t+=2){
    STEP(pB0,pB1,pA0,pA1,t,(t+3<NT),(t+1<NT),(t+1<NT));       ENDW(t);   RESC(); ROT();
    STEP(pA0,pA1,pB0,pB1,t+1,(t+4<NT),(t+2<NT),(t+2<NT));     ENDW(t+1); RESC(); ROT();
  }
  STEP(pB0,pB1,pA0,pA1,NT-1,false,false,false); RESC();
  { float sacc=pB0[0]+pB0[1]; _Pragma("unroll") for(int r=2;r<16;++r)sacc+=pB0[r]; _Pragma("unroll") for(int r=0;r<16;++r)sacc+=pB1[r]; l_reg+=sacc;
    pw0=(u32x4){PKW(pB0,0),PKW(pB0,2),PKW(pB0,4),PKW(pB0,6)};pw1=(u32x4){PKW(pB0,8),PKW(pB0,10),PKW(pB0,12),PKW(pB0,14)};pw2=(u32x4){PKW(pB1,0),PKW(pB1,2),PKW(pB1,4),PKW(pB1,6)};pw3=(u32x4){PKW(pB1,8),PKW(pB1,10),PKW(pB1,12),PKW(pB1,14)};
    SBAR(); pv(o,vb0+sl_cur,PAF(0),PAF(1),PAF(2),PAF(3)); }
  #undef PKW
  #undef PAF
  #undef VFR
  #undef PIN
  #undef MX3
  #undef GAPA
  #undef GAPB
  #undef EX
  #undef VRD
  #undef KRD
  #undef KRDX
  #undef STEP
  #undef ENDW
  {auto rr=__builtin_amdgcn_permlane32_swap(__float_as_uint(l_reg),__float_as_uint(l_reg),false,false);l_reg=__uint_as_float(rr[0])+__uint_as_float(rr[1]);}
  if(hi==0)wsf[32+r32]=l_reg;asm volatile("s_waitcnt lgkmcnt(0)":::"memory");
  float rli[16];
  #pragma unroll
  for(int r=0;r<16;++r)rli[r]=__builtin_amdgcn_rcpf(wsf[32+crow(r,hi)]);
  if(KIND==1){ if(hi==0&&oslot>=0){ f32x2_t ml={mhat,l_reg}; *(f32x2_t*)(PML+(long)oslot*2)=ml; } }
  { hb16*stg=(hb16*)(shm+LDS_OST)+wid*2048;
    #pragma unroll
    for(int r=0;r<16;++r){const int orow=crow(r,hi);
      #pragma unroll
      for(int d0=0;d0<2;++d0)stg[orow*64+d0*32+r32]=__float2bfloat16(o[d0][r]*rli[r]);}
    asm volatile("s_waitcnt lgkmcnt(0)":::"memory");
    #pragma unroll
    for(int i=0;i<4;++i){const int row=i*8+(lane>>3),ch=lane&7; const u32x4 v=*(const u32x4*)(stg+row*64+ch*8);
      if(KIND==0){ const int gr=__shfl(qrow,row); *(u32x4*)(Oc+(long)gr*PITCH+ch*8)=v; }
      else { const int gs=__shfl(oslot,row); if(gs>=0) *(u32x4*)(PO+(long)gs*64+ch*8)=v; } } }
  asm volatile("s_waitcnt lgkmcnt(0)\n\ts_barrier":::"memory");
  #undef DMA_K
  #undef DMA_V
  #undef CMASK
  #undef START
  #undef RESC
  #undef ROT
  #undef SETQX
  #undef MOVEREF
}
constexpr int MB_K=0, MB_V=4*SLOTB, MB_WS=MB_V+4*8192, MB_OST=MB_WS+NW*64*4, MB_BYTES=MB_OST+NW*4096;
template<int THRL> __device__ __forceinline__ void moba_item(char*shm,const hb16*Qc,const int browbase,const int h,const int nblk,const unsigned*lst,const int cnt,const int g0,const int g1,
    const hb16*Kt0,const hb16*KXt0,hb16*PO,float*PML){
  const int tid=threadIdx.x,lane=tid&63,r32=lane&31,hi=lane>>5; const int wid=__builtin_amdgcn_readfirstlane(tid>>6);
  const unsigned lds0=(unsigned)(uintptr_t)shm;
  float*wsf=(float*)(shm+MB_WS)+wid*64;
  asm volatile("s_waitcnt lgkmcnt(0)\n\ts_barrier":::"memory");
  { const hb16*ksrc=Kt0+(long)lane*PITCH+wid*8; const hb16*vsrc=Kt0+512+(long)(16*(wid&3)+(lane>>2))*PITCH+(wid>>2)*32+(lane&3)*8; const hb16*xsrc=KXt0+(long)(8*wid+(lane&7))*8;
    #pragma unroll
    for(int t=0;t<4;++t){ glds16(ksrc+(long)t*KVBLK*PITCH,(unsigned)__builtin_amdgcn_readfirstlane(lds0+MB_K+t*SLOTB+wid*1024)); glds16x(xsrc+(long)t*KVBLK*8,(unsigned)__builtin_amdgcn_readfirstlane(lds0+MB_K+t*SLOTB+8192+wid*128));
      glds16(vsrc+(long)t*KVBLK*PITCH,(unsigned)__builtin_amdgcn_readfirstlane(lds0+MB_V+t*8192+wid*1024)); } }
  asm volatile("s_waitcnt vmcnt(0)\n\ts_barrier":::"memory");
  const int vb0=(int)(lds0+MB_V)+((lane>>4)&1)*32+(lane&3)*8+(4*hi+((lane&15)>>2))*64;
  #define SETQX(mh_,ml_) do{ const unsigned bh_=cvtpk_s(-(mh_),-(ml_)); u32x4 qx_; qx_.x=0x3F803F80u; qx_.y=0x3F80u|(bh_<<16); qx_.z=(bh_>>16); qx_.w=0u; if(hi){qx_.x=0u;qx_.y=0u;qx_.z=0u;} qr[4]=__builtin_bit_cast(bf16x8,qx_); asm volatile("":"+v"(qr[4])); }while(0)
  #define MOVEREF(gain) const float mraw_=mhat+(gain); const float mh_=rbf(mraw_); const float ml_=rbf(mraw_-mh_); const float mnew_=mh_+ml_; const float dl=mnew_-mhat; mhat=mnew_; SETQX(mh_,ml_);
  #define LENT(gg) (((gg)>=8&&(gg)<g1)?lst[((gg)-8)*32+r32]:0u)
  #define GROW(gg,ee) (((gg)<8)?(browbase+nblk*256+(gg)*32+r32):(browbase+(int)((ee)&0x1fffu)))
  unsigned e_cur=LENT(g0+wid), e_nxt=LENT(g0+wid+NW);
  bf16x8 qn[4];
  { const hb16*Qw=Qc+(long)GROW(g0+wid,e_cur)*PITCH;
    #pragma unroll
    for(int d0=0;d0<4;++d0)qn[d0]=*reinterpret_cast<const bf16x8*>(&Qw[d0*16+hi*8]); }
  for(int g=g0+wid;g<g1;g+=NW){
    const bool own=g<8; const int qrow=GROW(g,e_cur); int oslot;
    if(own) oslot=(qrow*8+h)*4+3; else oslot=((g-8)*32+r32<cnt)?(qrow*8+h)*4+(int)((e_cur>>16)&3u):-1;
    bf16x8 qr[5];
    #pragma unroll
    for(int d0=0;d0<4;++d0)qr[d0]=qn[d0];
    { const int gn=(g+NW<g1)?g+NW:g; const unsigned en=(g+NW<g1)?e_nxt:e_cur; const hb16*Qw=Qc+(long)GROW(gn,en)*PITCH;
      #pragma unroll
      for(int d0=0;d0<4;++d0)qn[d0]=*reinterpret_cast<const bf16x8*>(&Qw[d0*16+hi*8]); }
    const unsigned e_n2=LENT(g+2*NW); e_cur=e_nxt; e_nxt=e_n2;
    float mhat=0.f,l_reg=0.f;f32x16 o[2];o[0]=f32x16{};o[1]=f32x16{};
    SETQX(0.f,0.f);
    const int tlast=own?((32*g+31)>>6):3;
    #define PKW(P,B) cvtpk_s(P[B],P[B+1])
    #define PROC(P0,P1,T_,ISFIRST,MREF_) do{ \
      if(own&&64*(T_)+63>32*g)cmask(P0,P1,(T_),32*g+r32,hi);   \
      const float adj_=mhat-(MREF_); const float rm=rowmax(P0,P1)-adj_; float sub_=adj_; \
      if(ISFIRST){ MOVEREF(rm) sub_+=dl; } \
      else if(__any(rm>(float)THRL)){ MOVEREF(__builtin_fmaxf(rm,0.f)) sub_+=dl; \
        const float f=__builtin_amdgcn_exp2f(-dl); l_reg*=f; if(hi==0)wsf[r32]=f; asm volatile("s_waitcnt lgkmcnt(0)":::"memory"); \
        _Pragma("unroll") for(int d_=0;d_<2;++d_) _Pragma("unroll") for(int r=0;r<16;++r)o[d_][r]*=wsf[crow(r,hi)]; } \
      float sacc=0.f; \
      _Pragma("unroll") for(int r=0;r<16;++r){P0[r]=__builtin_amdgcn_exp2f(P0[r]-sub_);P1[r]=__builtin_amdgcn_exp2f(P1[r]-sub_);sacc+=P0[r]+P1[r];} \
      l_reg+=sacc; \
      const u32x4 pw0=(u32x4){PKW(P0,0),PKW(P0,2),PKW(P0,4),PKW(P0,6)},pw1=(u32x4){PKW(P0,8),PKW(P0,10),PKW(P0,12),PKW(P0,14)},pw2=(u32x4){PKW(P1,0),PKW(P1,2),PKW(P1,4),PKW(P1,6)},pw3=(u32x4){PKW(P1,8),PKW(P1,10),PKW(P1,12),PKW(P1,14)}; \
      pv(o,vb0+(T_)*8192,__builtin_bit_cast(bf16x8,pw0),__builtin_bit_cast(bf16x8,pw1),__builtin_bit_cast(bf16x8,pw2),__builtin_bit_cast(bf16x8,pw3)); }while(0)
    int t=0;
    for(;t+1<=tlast;t+=2){
      f32x16 a0,a1,b0,b1; const float mref=mhat;
      qkt(a0,a1,shm+MB_K+t*SLOTB,qr,r32,hi); qkt(b0,b1,shm+MB_K+(t+1)*SLOTB,qr,r32,hi);
      asm volatile("s_nop 15\n\ts_nop 7":"+v"(a0),"+v"(a1));
      PROC(a0,a1,t,t==0,mref);
      asm volatile("s_nop 7":"+v"(b0),"+v"(b1));
      PROC(b0,b1,t+1,false,mref);
    }
    if(t<=tlast){ f32x16 a0,a1; const float mref=mhat;
      qkt(a0,a1,shm+MB_K+t*SLOTB,qr,r32,hi); asm volatile("s_nop 15\n\ts_nop 7":"+v"(a0),"+v"(a1));
      PROC(a0,a1,t,t==0,mref); }
    #undef PROC
    #undef PKW
    {auto rr=__builtin_amdgcn_permlane32_swap(__float_as_uint(l_reg),__float_as_uint(l_reg),false,false);l_reg=__uint_as_float(rr[0])+__uint_as_float(rr[1]);}
    if(hi==0)wsf[32+r32]=l_reg;asm volatile("s_waitcnt lgkmcnt(0)":::"memory");
    float rli[16];
    #pragma unroll
    for(int r=0;r<16;++r)rli[r]=__builtin_amdgcn_rcpf(wsf[32+crow(r,hi)]);
    if(hi==0&&oslot>=0){ f32x2_t ml={mhat,l_reg}; *(f32x2_t*)(PML+(long)oslot*2)=ml; }
    { hb16*stg=(hb16*)(shm+MB_OST)+wid*2048;
      #pragma unroll
      for(int r=0;r<16;++r){const int orow=crow(r,hi);
        #pragma unroll
        for(int d0=0;d0<2;++d0)stg[orow*64+d0*32+r32]=__float2bfloat16(o[d0][r]*rli[r]);}
      asm volatile("s_waitcnt lgkmcnt(0)":::"memory");
      #pragma unroll
      for(int i=0;i<4;++i){const int row=i*8+(lane>>3),ch=lane&7; const u32x4 v=*(const u32x4*)(stg+row*64+ch*8);
        const int gs=__shfl(oslot,row); if(gs>=0) *(u32x4*)(PO+(long)gs*64+ch*8)=v; }
      asm volatile("s_waitcnt lgkmcnt(0)":::"memory"); }
  }
  #undef SETQX
  #undef MOVEREF
  #undef LENT
  #undef GROW
}
constexpr int ATTN_LDS_BYTES=(LDS_BYTES>MB_BYTES?LDS_BYTES:MB_BYTES);
#undef SBAR
#undef WAIT_BAR
}

struct WqkOrder {
    int G, c;
    __device__ __forceinline__ bool next(int i, pg8::Unit& u) const { const int L = i * G + c; if (L >= 128) return false; const int z = L >> 2, pn = L & 3, b = z >> 2, h = z & 3;
        u.skipb1 = 0; u.pm = b * 4 + h; u.pn = pn; u.aoff = ((size_t)(b * 256) * 2048 + h * 256) * 2; u.boff = ((size_t)(pn * 256) * 1024 + h * 256) * 2; return true; }
};
struct VwoOrder {
    int G, c;
    __device__ __forceinline__ bool next(int i, pg8::Unit& u) const { const int L = i * G + c; if (L >= 128) return false; const int z = L >> 2, pmq = L & 3, b = z >> 2, h = z & 3;
        u.skipb1 = 0; u.pm = b * 4 + pmq; u.pn = h; u.aoff = ((size_t)(pmq * 256) * 1024 + h * 256) * 2; u.boff = ((size_t)(b * 256) * 2048 + 1024 + h * 256) * 2; return true; }
};

#define DECL_PTRS const __attribute__((address_space(4))) Args* KA_; { auto p_ = __builtin_amdgcn_kernarg_segment_ptr(); asm volatile("" : "+s"(p_)); KA_ = (const __attribute__((address_space(4))) Args*)p_; } \
    int tidp_ = threadIdx.x; asm volatile("" : "+v"(tidp_)); const int tid = tidp_, lane = tid & 63; (void)lane; \
    unsigned char* ws = KA_->ws; gu32* ctl = (gu32*)(ws + WS_CTL); const float* x = KA_->in[0]; const float* mem = KA_->in[1]; const float* g_mix = KA_->in[2]; const float* w_in = KA_->in[3]; const float* b_forget = KA_->in[4]; const float* g_fox = KA_->in[5]; const float* g_moba = KA_->in[6]; const float* w_out = KA_->in[7]; const float* g_cross = KA_->in[8]; const float* g_mem = KA_->in[9]; const float* w_q_mem = KA_->in[10]; const float* w_kv_mem = KA_->in[11]; const float* w_o_mem = KA_->in[12]; const float* g_ffn = KA_->in[13]; const float* w_up = KA_->in[14]; const float* conv_w = KA_->in[15]; const float* conv_b = KA_->in[16]; const float* w_down = KA_->in[17]; const float* g_final = KA_->in[18]; float* out = KA_->out; float* LOGF = (float*)(ws + WS_LOGF); float* CC = (float*)(ws + WS_C); float* ABAR = (float*)(ws + WS_ABAR); float* KM = (float*)(ws + WS_KM); unsigned* SEL = (unsigned*)(ws + WS_SEL); float* SSQ1 = (float*)(ws + WS_SSQ1); float* SSQ2 = (float*)(ws + WS_SSQ2); float* SSQ3 = (float*)(ws + WS_SSQ3); bf16* MEMN = (bf16*)(ws + WS_MEMN); bf16* KV = (bf16*)(ws + WS_KV); bf16* WQS = (bf16*)(ws + WS_WQS); bf16* WOT = (bf16*)(ws + WS_WOT); bf16* WKVT = (bf16*)(ws + WS_WKVT); bf16* WINT = (bf16*)(ws + WS_WINT); bf16* WOUTT = (bf16*)(ws + WS_WOUTT); bf16* WUPT = (bf16*)(ws + WS_WUPT); unsigned char* WDT = ws + WS_WDT; unsigned char* ACT8 = ws + WS_ACT8; float* GHB = (float*)(ws + WS_GH); float* UHB = (float*)(ws + WS_UH); float* GTB = (float*)(ws + WS_GT); bf16* ZT = (bf16*)(ws + WS_ZT); bf16* WQK = (bf16*)(ws + WS_WQK); bf16* VWO = (bf16*)(ws + WS_VWO); bf16* A1 = (bf16*)(ws + WS_A1); bf16* QKV = (bf16*)(ws + WS_QKV); bf16* Y = (bf16*)(ws + WS_Y); bf16* HB1 = (bf16*)(ws + WS_HB1); bf16* PB = (bf16*)(ws + WS_P); bf16* HB2 = (bf16*)(ws + WS_HB2); bf16* GB = (bf16*)(ws + WS_G); bf16* UB = (bf16*)(ws + WS_U); bf16* PO = (bf16*)(ws + WS_PO); unsigned* LIST = (unsigned*)(ws + WS_LIST); float* PML = (float*)(ws + WS_PML); bf16* KXF = (bf16*)(ws + WS_KXF); bf16* KXM = (bf16*)(ws + WS_KXM); unsigned* CNT = (unsigned*)(ws + WS_CNT);
__global__ void __launch_bounds__(NWAVES * 64, 2) fwd(Args args) {
    extern __shared__ __attribute__((aligned(16))) unsigned char lds[];
    LAS unsigned char* L = (LAS unsigned char*)lds;
    LAS unsigned char* XL = L + XL_OFF;
    volatile LAS unsigned* MISC = (volatile LAS unsigned*)(L + MISC_OFF);
    const int tid = threadIdx.x, lane = tid & 63, wave = __builtin_amdgcn_readfirstlane(tid >> 6);
    const int G = gridDim.x, bx = blockIdx.x;
    const int gw = bx * NWAVES + wave, NGW = G * NWAVES;
    for (int u = tid; u < (LDS_BYTES - LDSCTL_OFF) / 4; u += NWAVES * 64) ((LAS unsigned*)(L + LDSCTL_OFF))[u] = 0u;
    __syncthreads();
    XcdBarrier bar; { DECL_PTRS; bar = xcd_barrier_post((unsigned*)(ctl + CW_BAR), MISC + 8); }

    { DECL_PTRS;
        LAS float* scr = (LAS float*)(L + RING_OFF + wave * 16384);
        constexpr int I_IN = (D / 32) * (NQKV / 64), I_OUT = (D / 32) * (D / 64), I_KV = (D / 32) * (2048 / 64), I_O = I_OUT, I_UP = (D / 32) * (2 * FF / 64), I_DN = (FF / 32) * (D / 64);
        constexpr int NITEMS = I_IN + I_OUT + I_KV + I_O + I_UP + I_DN;
        for (int it = gw; it < NITEMS; it += NGW) {
            int r = it;
            if (r < I_IN) { p0_transpose_item(w_in, INC, D, NQKV, WINT, nullptr, true, scr, r, lane); continue; } r -= I_IN;
            if (r < I_OUT) { p0_transpose_item(w_out, D, D, D, WOUTT, nullptr, false, scr, r, lane); continue; } r -= I_OUT;
            if (r < I_KV) { p0_transpose_item(w_kv_mem, 2048, D, 2048, WKVT, nullptr, false, scr, r, lane); continue; } r -= I_KV;
            if (r < I_O) { p0_transpose_item(w_o_mem, D, D, D, WOT, nullptr, false, scr, r, lane); continue; } r -= I_O;
            if (r < I_UP) { p0_transpose_item(w_up, 2 * FF, D, 2 * FF, WUPT, g_ffn, false, scr, r, lane, 0.f, true); continue; } r -= I_UP;
            p0_transpose_item(w_down, D, FF, D, (bf16*)WDT, nullptr, false, scr, r, lane, 64.0f);
        }
        for (int i = bx * 512 + tid; i < D * D / 4; i += G * 512) { const int kk = (i * 4) >> 10; const f32x4 v = *(const f32x4*)(w_q_mem + (size_t)i * 4) * (g_cross[kk] * (LOG2E / 16.0f));
            *(unsigned long long*)(WQS + (size_t)i * 4) = (unsigned long long)pk2(v[0], v[1]) | ((unsigned long long)pk2(v[2], v[3]) << 32); }
        for (int r = gw; r < NB * 256; r += NGW) { const GAS f32x4* xr = (const GAS f32x4*)(mem + (size_t)r * D) + lane; f32x4 v[4]; float s = 0.f;
#pragma unroll
            for (int j = 0; j < 4; ++j) { v[j] = xr[64 * j]; s += (v[j][0] * v[j][0] + v[j][1] * v[j][1]) + (v[j][2] * v[j][2] + v[j][3] * v[j][3]); }
            const float rs = __builtin_amdgcn_rsqf(wave_sum(s) * (1.f / D) + RMS_EPS);
            GAS unsigned long long* o8 = (GAS unsigned long long*)(MEMN + (size_t)r * D) + lane;
#pragma unroll
            for (int j = 0; j < 4; ++j) { const f32x4 gg = *((const f32x4*)g_mem + 64 * j + lane); const f32x4 a = v[j] * rs * gg; o8[64 * j] = (unsigned long long)pk2(a[0], a[1]) | ((unsigned long long)pk2(a[2], a[3]) << 32); } }
        __syncthreads();
        LAS float* part = (LAS float*)(L + RING_OFF + 32768);
        LAS float* wf = (LAS float*)(L + RING_OFF);
        for (int i = tid; i < 8 * 1024; i += 512) { const int h = i >> 10, kk = i & 1023; wf[i] = w_in[(size_t)kk * INC + C_F + h]; }
        __syncthreads();
        f32x4 gm[4];
#pragma unroll
        for (int j = 0; j < 4; ++j) gm[j] = *((const f32x4*)g_mix + 64 * j + lane);
        for (int blk = bx; blk < M / 256; blk += G) {
            f32x4 accm[4];
#pragma unroll
            for (int j = 0; j < 4; ++j) accm[j] = (f32x4){0.f, 0.f, 0.f, 0.f};
            f32x4 vn[2][4];
#pragma unroll
            for (int rr = 0; rr < 2; ++rr) { const GAS f32x4* xr = (const GAS f32x4*)(x + ((size_t)blk * 256 + wave * 32 + rr) * D) + lane;
#pragma unroll
                for (int j = 0; j < 4; ++j) vn[rr][j] = xr[64 * j]; }
            for (int i0 = 0; i0 < 32; i0 += 2) {
              f32x4 vv[2][4];
#pragma unroll
              for (int rr = 0; rr < 2; ++rr)
#pragma unroll
                  for (int j = 0; j < 4; ++j) vv[rr][j] = vn[rr][j];
              { const int inx = i0 + 2 < 32 ? i0 + 2 : i0;
#pragma unroll
                for (int rr = 0; rr < 2; ++rr) { const GAS f32x4* xr = (const GAS f32x4*)(x + ((size_t)blk * 256 + wave * 32 + inx + rr) * D) + lane;
#pragma unroll
                    for (int j = 0; j < 4; ++j) vn[rr][j] = xr[64 * j]; } }
#pragma unroll
              for (int rr = 0; rr < 2; ++rr) {
                const size_t r = (size_t)blk * 256 + wave * 32 + i0 + rr;
                f32x4 v[4]; float s = 0.f;
#pragma unroll
                for (int j = 0; j < 4; ++j) { v[j] = vv[rr][j]; s += (v[j][0] * v[j][0] + v[j][1] * v[j][1]) + (v[j][2] * v[j][2] + v[j][3] * v[j][3]); }
                const float rs = __builtin_amdgcn_rsqf(wave_sum(s) * (1.f / D) + RMS_EPS);
                GAS unsigned long long* o8 = (GAS unsigned long long*)(A1 + r * 2048) + lane;
                float fl[8];
#pragma unroll
                for (int h = 0; h < 8; ++h) fl[h] = 0.f;
#pragma unroll
                for (int j = 0; j < 4; ++j) { const f32x4 a = v[j] * rs * gm[j]; accm[j] += a;
                    const unsigned h0 = pk2(a[0], a[1]), h1 = pk2(a[2], a[3]);
                    o8[64 * j] = (unsigned long long)h0 | ((unsigned long long)h1 << 32);
                    const unsigned l0 = pk2(a[0] - bflo(h0), a[1] - bfhi(h0)), l1 = pk2(a[2] - bflo(h1), a[3] - bfhi(h1));
                    o8[256 + 64 * j] = (unsigned long long)l0 | ((unsigned long long)l1 << 32);
#pragma unroll
                    for (int h = 0; h < 8; ++h) { const f32x4 w = *((const LAS f32x4*)(wf + h * 1024) + 64 * j + lane); fl[h] += (a[0] * w[0] + a[1] * w[1]) + (a[2] * w[2] + a[3] * w[3]); } }
                float t4[4], t2[2], z;
                { const bool up = (lane & 32) != 0;
#pragma unroll
                  for (int k = 0; k < 4; ++k) { const float snd = up ? fl[k] : fl[k + 4]; const float rcv = __shfl_xor(snd, 32); t4[k] = (up ? fl[k + 4] : fl[k]) + rcv; } }
                { const bool up = (lane & 16) != 0;
#pragma unroll
                  for (int k = 0; k < 2; ++k) { const float snd = up ? t4[k] : t4[k + 2]; const float rcv = __shfl_xor(snd, 16); t2[k] = (up ? t4[k + 2] : t4[k]) + rcv; } }
                { const bool up = (lane & 8) != 0; const float snd = up ? t2[0] : t2[1]; const float rcv = __shfl_xor(snd, 8); z = (up ? t2[1] : t2[0]) + rcv; }
                z += __shfl_xor(z, 1); z += __shfl_xor(z, 2); z += __shfl_xor(z, 4);
                if ((lane & 7) == 0) { const int hh = 4 * (lane >> 5) + 2 * ((lane >> 4) & 1) + ((lane >> 3) & 1);
                    z += b_forget[hh];
                    LOGF[r * 8 + hh] = fminf(z, 0.f) - log1pf(__expf(-fabsf(z))); }
              }
            }
#pragma unroll
            for (int j = 0; j < 4; ++j) *((LAS f32x4*)(part + wave * 1024) + 64 * j + lane) = accm[j];
            __syncthreads();
            for (int col = tid; col < 1024; col += 512) { float s = 0.f;
#pragma unroll
                for (int w = 0; w < 8; ++w) s += part[w * 1024 + col];
                ABAR[(size_t)blk * 1024 + col] = s * (1.0f / 256.0f); }
            __syncthreads();
        }
    }
    xcd_barrier(bar);

#define WG_SIGNAL(word) do { asm volatile("s_waitcnt vmcnt(0)" ::: "memory"); __syncthreads(); if (tid == 0) { __builtin_amdgcn_fence(__ATOMIC_RELEASE, "agent"); asm volatile("s_waitcnt vmcnt(0)" ::: "memory"); \
        __hip_atomic_fetch_add((unsigned*)(ctl + (word)), 1u, RLX_AGENT); } } while (0)
#define WG_WAIT(word, n) do { if (tid == 0) { unsigned sp_ = 0u; while (__hip_atomic_load((unsigned*)(ctl + (word)), RLX_AGENT) < (unsigned)(n)) { __builtin_amdgcn_s_sleep(2); if (++sp_ > (1u << 22)) break; } } \
        __syncthreads(); __builtin_amdgcn_fence(__ATOMIC_ACQUIRE, "agent"); asm volatile("s_waitcnt vmcnt(0)" ::: "memory"); } while (0)
    { DECL_PTRS;
        LAS float* sc = (LAS float*)(L + RING_OFF);
        for (int w = bx; w < 64; w += G) {
            const int ib = w >> 3, jb = w & 7, r = tid >> 4, cq = tid & 15; LAS float* As = sc; LAS float* Bs = sc + 32 * 33;
            f32x4 acc = (f32x4){0.f, 0.f, 0.f, 0.f};
            for (int k0 = 0; k0 < 1024; k0 += 32) {
                { const int idx = tid * 2, row = idx >> 5, kk = idx & 31; const pg8::f32x2 a2 = *(const pg8::f32x2*)(ABAR + (size_t)(ib * 32 + row) * 1024 + k0 + kk); As[row * 33 + kk] = a2.x; As[row * 33 + kk + 1] = a2.y; }
                { const int idx = tid * 4, kk = idx >> 6, c = idx & 63; *(LAS f32x4*)(Bs + kk * 64 + c) = *(const f32x4*)(w_in + (size_t)(k0 + kk) * INC + C_KM + jb * 64 + c); }
                __syncthreads();
#pragma unroll 8
                for (int kk = 0; kk < 32; ++kk) acc += *(const LAS f32x4*)(Bs + kk * 64 + cq * 4) * As[r * 33 + kk];
                __syncthreads();
            }
            *(f32x4*)(KM + (size_t)(ib * 32 + r) * 512 + jb * 64 + cq * 4) = acc;
            WG_SIGNAL(CW_CNT_KM);
        }
        for (int w = (bx + G - 64) % G; w < 64; w += G) {
            const int b = w >> 3, h = w & 7; float v[16]; float run = 0.f;
#pragma unroll
            for (int i = 0; i < 16; ++i) { run += LOGF[((size_t)b * T + tid * 16 + i) * 8 + h]; v[i] = run; }
            float incl = run;
#pragma unroll
            for (int o = 1; o < 64; o <<= 1) { const float n = __shfl_up(incl, o); if (lane >= o) incl += n; }
            if (lane == 63) sc[wave] = incl;
            __syncthreads();
            float pre = incl - run;
            for (int ww = 0; ww < wave; ++ww) pre += sc[ww];
#pragma unroll
            for (int i = 0; i < 16; ++i) { const float cv = pre + v[i]; const size_t e = (size_t)w * T + tid * 16 + i; CC[e] = cv;
                const float bv = -cv * LOG2E; const unsigned h0 = f2bf(bv); const float r1 = bv - bf2f(h0); const unsigned h1 = f2bf(r1); const unsigned h2 = f2bf(r1 - bf2f(h1));
                *(v4u*)(KXF + e * 8) = (v4u){h0 | (h1 << 16), h2 | (0x3F80u << 16), 0x3F80u, 0u}; }
            if (w == 0) for (int j = tid; j < 8 * 256; j += 512) { const float bv = __builtin_amdgcn_exp2f(-(float)((j >> 8) + 1)) * LOG2E * (float)(j & 255);
                const unsigned h0 = f2bf(bv); const float r1 = bv - bf2f(h0); const unsigned h1 = f2bf(r1); const unsigned h2 = f2bf(r1 - bf2f(h1));
                *(v4u*)(KXM + (size_t)j * 8) = (v4u){h0 | (h1 << 16), h2 | (0x3F80u << 16), 0x3F80u, 0u}; }
            __syncthreads();
        }
        { const int ckv = (bx + G - 128) % G;
          pg8::Gemm g{MEMN, WKVT, D / 64, D * 2, D * 2, 0xffffffffu}; pg8::TileOrder S; S.init(NB * 256, 2048, G, ckv, D * 2, D * 2, 0, 1 << 30);
          pg8::EpiBf16 E{KV, 2048, 0u, 1.f, nullptr};
          pg8::gemm_phase<pg8::EpiBf16, pg8::TileOrder, true>(L + RING_OFF, XL, g, S, E);
          for (int Lk = ckv; Lk < 64; Lk += G) WG_SIGNAL(CW_CNT_KV); }
        if (bx < 64) WG_WAIT(CW_CNT_KM, 64);
        for (int w = bx; w < 64; w += G) {
            const int h = w >> 3, kq = w & 7, kk = kq * 128 + (tid & 127), ng = tid >> 7;
            for (int i = tid; i < 256 * 16; i += 512) { const int n = i >> 4, c4 = (i & 15) * 4; *(LAS f32x4*)(sc + n * 64 + c4) = *(const f32x4*)(KM + (size_t)n * 512 + h * 64 + c4); }
            f32x4 wq[16];
#pragma unroll
            for (int c = 0; c < 16; ++c) wq[c] = *(const f32x4*)(w_in + (size_t)kk * INC + C_QM + h * 64 + c * 4);
            __syncthreads();
            for (int i = 0; i < 64; ++i) { const int n = ng * 64 + i; const LAS f32x4* kp = (const LAS f32x4*)(sc + n * 64); float s0 = 0.f, s1 = 0.f;
#pragma unroll
                for (int c = 0; c < 16; c += 2) { const f32x4 ka = kp[c], kb = kp[c + 1];
                    s0 += (wq[c][0] * ka[0] + wq[c][1] * ka[1]) + (wq[c][2] * ka[2] + wq[c][3] * ka[3]); s1 += (wq[c + 1][0] * kb[0] + wq[c + 1][1] * kb[1]) + (wq[c + 1][2] * kb[2] + wq[c + 1][3] * kb[3]); }
                const float sv = s0 + s1; const unsigned hi = f2bf(sv); const unsigned lo = f2bf(sv - bf2f(hi));
                bf16* zr = ZT + ((size_t)(n >> 5) * 256 + 128 * ((n & 31) >> 4) + 32 * (h >> 1) + 16 * (h & 1) + (n & 15)) * 3072;     zr[kk] = (bf16)hi; zr[1024 + kk] = (bf16)hi; zr[2048 + kk] = (bf16)lo; }
            WG_SIGNAL(CW_CNT_Z);
        }
        { const int ckv = (bx + G - 128) % G;
          if (ckv < 64) WG_WAIT(CW_CNT_KV, 64);
          const int gx = G < 64 ? G : 64, cx = ckv < 64 ? ckv : (1 << 20);
          { pg8::Gemm g{KV, WQS, 4, 4096, 2048, 0xffffffffu}; WqkOrder S{gx, cx}; pg8::EpiF8 E{(unsigned char*)WQK, 1024, 32.0f};
            pg8::gemm_phase<pg8::EpiF8, WqkOrder, true>(L + RING_OFF, XL, g, S, E); }
          { pg8::Gemm g{WOT, KV, 4, 2048, 4096, 0xffffffffu}; VwoOrder S{gx, cx}; pg8::EpiF8 E{(unsigned char*)VWO, 1024, 4.0f};
            pg8::gemm_phase<pg8::EpiF8, VwoOrder, true>(L + RING_OFF, XL, g, S, E); } }
        { pg8::Gemm g{A1, WINT, D / 64, 4096, D * 2, 0xffffffffu}; pg8::TileOrder S; S.init(M, NQKV, G, bx, 4096, D * 2, 0, 1 << 30); S.deal = (G == 256) ? 1 : 0;
          pg8::EpiBf16 E{QKV, NQKV, 0xC3u, C2, (unsigned*)(ctl + CW_QKN)};
          pg8::gemm_phase<pg8::EpiBf16, pg8::TileOrder, true>(L + RING_OFF, XL, g, S, E); }
        WG_WAIT(CW_CNT_Z, 64);
        { pg8::Gemm g{A1, ZT, 3072 / 64, 4096, 6144, 4095u}; pg8::TileOrder S; S.init(M, 256, G, bx, 4096, 6144, (size_t)256 * 6144, 32); S.skipmode = 1;
          pg8::EpiGate E{SEL};
          pg8::gemm_phase<pg8::EpiGate, pg8::TileOrder, true, false, true>(L + RING_OFF, XL, g, S, E); }
    }
#undef WG_SIGNAL
#undef WG_WAIT
    xcd_barrier(bar);

    { DECL_PTRS;
        for (int e = bx + wave * G; e < 2048; e += 8 * G) {
            const int bh = e >> 5, qb = e & 31, b = bh >> 3, h = bh & 7; float dmin = 3.0e38f, qmax = 0.f;
#pragma unroll 2
            for (int rr = 0; rr < 4; ++rr) { const bf16* qp = QKV + ((size_t)b * T + qb * 256 + rr * 64 + lane) * NQKV + h * 64; float dot = 0.f, qn2 = 0.f;
#pragma unroll
                for (int c = 0; c < 8; ++c) { const v4u qw = *((const v4u*)qp + c), kw = *((const v4u*)(qp + 512) + c); const unsigned qq[4] = {qw.x, qw.y, qw.z, qw.w}, kk2[4] = {kw.x, kw.y, kw.z, kw.w};
#pragma unroll
                    for (int x4 = 0; x4 < 4; ++x4) { const float q0 = bflo(qq[x4]), q1 = bfhi(qq[x4]); dot += q0 * bflo(kk2[x4]) + q1 * bfhi(kk2[x4]); qn2 += q0 * q0 + q1 * q1; } }
                dmin = fminf(dmin, dot); qmax = fmaxf(qmax, qn2); }
#pragma unroll
            for (int o = 1; o < 64; o <<= 1) { dmin = fminf(dmin, __shfl_xor(dmin, o)); qmax = fmaxf(qmax, __shfl_xor(qmax, o)); }
            const unsigned* kp = (const unsigned*)(ctl + CW_QKN) + bh * 8 + 2;
            const float kn = sqrtf(__uint_as_float(__hip_atomic_load(kp, RLX_AGENT)) + __uint_as_float(__hip_atomic_load(kp + 1, RLX_AGENT)));
            const float thr = (sqrtf(qmax) * kn * 1.02f - dmin + 40.5f) * (1.0f / LOG2E);
            const float* crow_ = CC + (size_t)bh * T; const int t0 = qb * 256; const float target = crow_[t0] + thr;
            int lo = 0, hi2 = t0;
            while (hi2 > lo) { const int step = (hi2 - lo + 63) >> 6, pos = lo + lane * step; const bool pr = pos < hi2 && crow_[pos] >= target; const int k = __popcll(__ballot(pr));
                if (k == 0) hi2 = lo;
                else { const int cand = lo + k * step; lo = lo + (k - 1) * step + 1; if (cand < hi2) hi2 = cand; } }
            if (lane == 0) ((int*)(ctl + CW_T0TAB))[e] = (lo >> 6) & ~1; }
        for (int ws_ = bx + G * wave; ws_ < 2048; ws_ += 8 * G) {
            const int bh = (ws_ & 255) >> 2, n = (ws_ & 3) + 4 * (ws_ >> 8), trip = bh * 32 + n; const unsigned* selrow = SEL + (size_t)bh * T; unsigned base = 0u;
            const float mthr = skip_thr((const unsigned*)(ctl + CW_QKN) + bh * 8, 1); const int hh = bh & 7;
            for (int t0 = (n + 1) * 256; t0 < T; t0 += 512) {
                unsigned m[8];
#pragma unroll
                for (int j = 0; j < 8; ++j) { const int t = t0 + j * 64 + lane; m[j] = 0u; if (t < T) m[j] = selrow[t]; }
#pragma unroll
                for (int j = 0; j < 8; ++j) { const int t = t0 + j * 64 + lane; const bool hit = ((m[j] >> n) & 1u) && !moba_skip(hh, t >> 8, n, mthr);
                    const unsigned long long bal = __ballot(hit);
                    if (hit) { const unsigned pos = base + (unsigned)__popcll(bal & ((1ull << lane) - 1ull)); const unsigned k = (unsigned)__popc(m[j] & ((1u << n) - 1u));
                        LIST[(size_t)trip * 8192 + pos] = (unsigned)t | (k << 16); }
                    base += (unsigned)__popcll(bal); }
            }
            if (lane == 0) CNT[trip] = base;
        }
    }
    xcd_barrier(bar);

    { DECL_PTRS;
        LAS int* upre = (LAS int*)(L + RING_OFF + attn_body::ATTN_LDS_BYTES);
        LAS int* wsum = upre + 2052;
        { int c4[4]; int run = 0;
#pragma unroll
          for (int i = 0; i < 4; ++i) { const int wq = tid * 4 + i; c4[i] = run; run += (int)((8u + ((CNT[(wq & 63) * 32 + (wq >> 6)] + 31u) >> 5) + 31u) >> 5); }
          int incl = run;
#pragma unroll
          for (int o = 1; o < 64; o <<= 1) { const int nn = __shfl_up(incl, o); if (lane >= o) incl += nn; }
          if (lane == 63) wsum[wave] = incl;
          __syncthreads();
          int pre = incl - run;
          for (int ww = 0; ww < wave; ++ww) pre += wsum[ww];
#pragma unroll
          for (int i = 0; i < 4; ++i) upre[tid * 4 + i] = pre + c4[i];
          if (tid == 511) upre[2048] = pre + run;
          __syncthreads(); }
        const int ntot = 2048 + upre[2048];
        const attn_body::hb16* Qb = (const attn_body::hb16*)QKV;
        const int r32 = lane & 31;
        LAS unsigned* qnext = (LAS unsigned*)(wsum + 16);
        unsigned* qhead = (unsigned*)(ctl + CW_QUEUE);
        if (tid == 0) qnext[0] = atomicAdd(qhead, 1u);
        __syncthreads();
        for (;;) {
            const int u = (int)qnext[0];
            if (u >= ntot) break;
            __syncthreads();
            unsigned nxt_ = 0u; if (tid == 0) nxt_ = atomicAdd(qhead, 1u);
            if (u < 2048) {
                const int qb = 31 - (u >> 6), bh = u & 63;
                const int b = bh >> 3, h = bh & 7;
                const int T0 = ((const int*)(ctl + CW_T0TAB))[bh * 32 + qb];
                const int qrow = b * T + qb * 256 + wave * 32 + r32, NT = 4 * (qb + 1) - T0;
                const attn_body::hb16* Qc = Qb + h * 64; const attn_body::hb16* Kt0 = Qb + (size_t)(b * T + T0 * 64) * NQKV + 512 + h * 64;
                attn_body::attn_unit<8>((char*)lds + RING_OFF, 0, Qc, qrow, -1, Kt0, Kt0 + 512, (const attn_body::hb16*)KXF + ((size_t)bh * T + T0 * 64) * 8, NT, NT - 4, (attn_body::hb16*)QKV + (Qc - Qb), (attn_body::hb16*)PO, PML);
            } else {
                const int g = u - 2048; int lo = 0, hi2 = 2048;
                while (hi2 - lo > 1) { const int mid = (lo + hi2) >> 1; if (upre[mid] <= g) lo = mid; else hi2 = mid; }
                const int c = g - upre[lo], bh = lo & 63, n = lo >> 6, w = bh * 32 + n, b = bh >> 3, h = bh & 7; const int cnt = (int)CNT[w];
                const int ng = 8 + ((cnt + 31) >> 5), g0 = 32 * c, g1 = g0 + 32 < ng ? g0 + 32 : ng;
                const attn_body::hb16* Kt0 = Qb + (size_t)(b * T + n * 256) * NQKV + 2048 + h * 64;
                attn_body::moba_item<8>((char*)lds + RING_OFF, Qb + 1536 + h * 64, b * T, h, n, LIST + (size_t)w * 8192, cnt, g0, g1, Kt0, (const attn_body::hb16*)KXM + h * 256 * 8, (attn_body::hb16*)PO, PML);
            }
            if (tid == 0) qnext[0] = nxt_;
            __syncthreads();
        }
    }
    xcd_barrier(bar);

    { DECL_PTRS;
    const f32x4 ga0 = *((const f32x4*)g_fox + 2 * lane), ga1 = *((const f32x4*)g_fox + 2 * lane + 1), gb0 = *((const f32x4*)g_moba + 2 * lane), gb1 = *((const f32x4*)g_moba + 2 * lane + 1);
    const int h = lane >> 3, cc = lane & 7; const float s2 = __builtin_amdgcn_exp2f(-(float)(h + 1)) * LOG2E * 256.0f;
    float mthr[NB];
#pragma unroll
    for (int b = 0; b < NB; ++b) mthr[b] = skip_thr((const unsigned*)(ctl + CW_QKN) + (b * 8 + h) * 8, 1);
    v4u wan[2], pwn[2][4]; unsigned mmn[2]; pg8::f32x2 mln[2][4];
#define P3_LOAD(rbase) do { _Pragma("unroll") for (int rr = 0; rr < 2; ++rr) { const int r = (rbase) + rr, b = r >> 13, t = r & (T - 1); const size_t sb = ((size_t)r * 8 + h) * 4; \
            wan[rr] = *((const v4u*)(QKV + (size_t)r * NQKV) + lane); mmn[rr] = SEL[((size_t)(b * 8 + h)) * T + t]; \
            _Pragma("unroll") for (int k = 0; k < 4; ++k) { mln[rr][k] = *(const pg8::f32x2*)(PML + (sb + k) * 2); pwn[rr][k] = *((const v4u*)(PO + (sb + k) * 64) + cc); } } } while (0)
    if (gw * 2 < M) P3_LOAD(gw * 2);
    for (int r0 = gw * 2; r0 < M; r0 += NGW * 2) {
        v4u wa[2], pw[2][4]; unsigned mmv[2]; pg8::f32x2 ml[2][4];
#pragma unroll
        for (int rr = 0; rr < 2; ++rr) { wa[rr] = wan[rr]; mmv[rr] = mmn[rr];
#pragma unroll
            for (int k = 0; k < 4; ++k) { ml[rr][k] = mln[rr][k]; pw[rr][k] = pwn[rr][k]; } }
        { const int rn = r0 + NGW * 2 < M ? r0 + NGW * 2 : r0; P3_LOAD(rn); }
#pragma unroll
        for (int rr = 0; rr < 2; ++rr) { const int r = r0 + rr, t = r & (T - 1), own = t >> 8;
            const float a[8] = {bflo(wa[rr].x), bfhi(wa[rr].x), bflo(wa[rr].y), bfhi(wa[rr].y), bflo(wa[rr].z), bfhi(wa[rr].z), bflo(wa[rr].w), bfhi(wa[rr].w)};
            float c[8]; unsigned mm = mmv[rr]; const int cnt = __popc(mm);
            float mk[4], lk[4];
#pragma unroll
            for (int k = 0; k < 4; ++k) { mk[k] = ml[rr][k].x; lk[k] = ml[rr][k].y; }
            mk[3] += s2 * (float)own; float Mx = mk[3];
            bool vk[4]; vk[3] = true; float thb = mthr[0];
#pragma unroll
            for (int b = 1; b < NB; ++b) thb = ((r >> 13) == b) ? mthr[b] : thb;
#pragma unroll
            for (int k = 0; k < 3; ++k) { vk[k] = false; if (k < cnt) { const int nb = __ffs(mm) - 1; mm &= mm - 1u; vk[k] = !moba_skip(h, own, nb, thb); if (vk[k]) { mk[k] += s2 * (float)nb; Mx = fmaxf(Mx, mk[k]); } } }
            float W = 0.f;
#pragma unroll
            for (int i = 0; i < 8; ++i) c[i] = 0.f;
#pragma unroll
            for (int k = 0; k < 4; ++k) { if (vk[k]) { const float w = lk[k] * __builtin_amdgcn_exp2f(mk[k] - Mx); W += w; const v4u p = pw[rr][k];
                c[0] += w * bflo(p.x); c[1] += w * bfhi(p.x); c[2] += w * bflo(p.y); c[3] += w * bfhi(p.y); c[4] += w * bflo(p.z); c[5] += w * bfhi(p.z); c[6] += w * bflo(p.w); c[7] += w * bfhi(p.w); } }
            const float iw = 1.0f / W;
#pragma unroll
            for (int i = 0; i < 8; ++i) c[i] *= iw;
            float sa = 0.f, sb2 = 0.f;
#pragma unroll
            for (int i = 0; i < 8; ++i) { sa += a[i] * a[i]; sb2 += c[i] * c[i]; }
            const float ra = __builtin_amdgcn_rsqf(wave_sum(sa) * (1.f / 512.f) + RMS_EPS), rb = __builtin_amdgcn_rsqf(wave_sum(sb2) * (1.f / 512.f) + RMS_EPS);
            v4u oa, ob;
            oa.x = pk2(a[0] * ra * ga0[0], a[1] * ra * ga0[1]); oa.y = pk2(a[2] * ra * ga0[2], a[3] * ra * ga0[3]); oa.z = pk2(a[4] * ra * ga1[0], a[5] * ra * ga1[1]); oa.w = pk2(a[6] * ra * ga1[2], a[7] * ra * ga1[3]);
            ob.x = pk2(c[0] * rb * gb0[0], c[1] * rb * gb0[1]); ob.y = pk2(c[2] * rb * gb0[2], c[3] * rb * gb0[3]); ob.z = pk2(c[4] * rb * gb1[0], c[5] * rb * gb1[1]); ob.w = pk2(c[6] * rb * gb1[2], c[7] * rb * gb1[3]);
            *((v4u*)(Y + (size_t)r * D) + lane) = oa; *((v4u*)(Y + (size_t)r * D + 512) + lane) = ob; }
    } }
    xcd_barrier(bar);

#undef P3_LOAD
    { DECL_PTRS; pg8::Gemm g{Y, WOUTT, D / 64, D * 2, D * 2, 0xffffffffu}; pg8::TileOrder S; S.init(M, D, G, bx, D * 2, D * 2, 0, 1 << 30);
      pg8::EpiRes<false, false> E{x, nullptr, nullptr, HB1, ws + WS_HB1F, SSQ1, 1.0f};
      pg8::gemm_phase<pg8::EpiRes<false, false>, pg8::TileOrder, true>(L + RING_OFF, XL, g, S, E); }
    xcd_barrier(bar);

    { DECL_PTRS; pg8::Gemm g{ws + WS_HB1F, WQK, D / 128, D, D, 0xffffffffu}; pg8::TileOrder S; S.init(M, D, G, bx, D, D, (size_t)D * D, 32);
      pg8::EpiSoftmax E{(unsigned char*)PB, SSQ1, 1.0f / 32.0f};
      pg8::gemm_phase<pg8::EpiSoftmax, pg8::TileOrder, true, true>(L + RING_OFF, XL, g, S, E); }
    xcd_barrier(bar);

    { DECL_PTRS; pg8::Gemm g{PB, VWO, D / 128, D, D, 0xffffffffu}; pg8::TileOrder S; S.init(M, D, G, bx, D, D, (size_t)D * D, 32);
      pg8::EpiRes<true, false> E{nullptr, HB1, nullptr, HB2, nullptr, SSQ2, 1.0f / 1024.0f};
      pg8::gemm_phase<pg8::EpiRes<true, false>, pg8::TileOrder, true, true>(L + RING_OFF, XL, g, S, E); }
    xcd_barrier(bar);

    { DECL_PTRS; pg8::Gemm g{HB2, WUPT, D / 64, D * 2, D * 2, 0xffffffffu}; pg8::TileOrder S; S.init(M, 2 * FF, G, bx, D * 2, D * 2, 0, 1 << 30);
      pg8::EpiConv E{ACT8, SSQ2, conv_w, conv_b, GHB, UHB, GTB};
      pg8::gemm_phase<pg8::EpiConv, pg8::TileOrder, true>(L + RING_OFF, XL, g, S, E); }
    xcd_barrier(bar);

    { DECL_PTRS;
    for (int it = bx * 512 + tid; it < 256 * 22 * 2 * 32; it += G * 512) {
        const int c4 = (it & 31) * 4, rr = (it >> 5) & 1, tile = it >> 6, pm = tile / 22, pn = tile - pm * 22; const bool top = (pm & 31) == 0;
        const size_t sb = (size_t)tile * 256; const int col = pn * 128 + c4;
        const f32x4 g2 = *(const f32x4*)(GHB + sb + rr * 128 + c4), uu = *(const f32x4*)(UHB + sb + rr * 128 + c4);
        f32x4 g1 = (f32x4){0.f, 0.f, 0.f, 0.f}, g0 = (f32x4){0.f, 0.f, 0.f, 0.f};
        if (rr == 1) g1 = *(const f32x4*)(GHB + sb + c4); else if (!top) g1 = *(const f32x4*)(GTB + sb - 22 * 256 + 128 + c4);
        if (!top) g0 = *(const f32x4*)(GTB + sb - 22 * 256 + (rr == 1 ? 128 : 0) + c4);
        const f32x4 w0 = *(const f32x4*)(conv_w + col), w1 = *(const f32x4*)(conv_w + FF + col), w2 = *(const f32x4*)(conv_w + 2 * FF + col), cbv = *(const f32x4*)(conv_b + col);
        float res[4];
#pragma unroll
        for (int e = 0; e < 4; ++e) { const float gc = cbv[e] + w0[e] * g0[e] + w1[e] * g1[e] + w2[e] * g2[e]; res[e] = gc * __builtin_amdgcn_rcpf(1.0f + __builtin_amdgcn_exp2f(-LOG2E * gc)) * uu[e]; }
        *(unsigned*)(ACT8 + (size_t)(pm * 256 + rr) * FF + col) = pg8::pk4_fp8(res[0], res[1], res[2], res[3]);
    } }
    xcd_barrier(bar);

    { DECL_PTRS; pg8::Gemm g{ACT8, WDT, FF / 128, FF, FF, 0xffffffffu}; pg8::TileOrder S; S.init(M, D, G, bx, FF, FF, 0, 1 << 30);
      pg8::EpiResNorm E{HB2, out, g_final, 1.0f / 64.0f, SSQ3, (unsigned*)(ctl + CW_PANEL), (unsigned*)(ctl + CW_TMO2)};
      pg8::gemm_phase<pg8::EpiResNorm, pg8::TileOrder, true, true>(L + RING_OFF, XL, g, S, E); }
}

extern "C" void kernel_launch(void* const* d_in, const int* in_sizes, int n_in, void* d_out, int out_size, void* d_ws, size_t ws_size, hipStream_t stream) {
    static int grid = 0;
    if (grid == 0) {
        if (n_in != 19 || in_sizes[0] != M * D || out_size != M * D || ws_size < WS_END) { fprintf(stderr, "kernel_launch: unexpected problem shape (n_in %d, in0 %d, out %d, ws %zu); nothing launched\n", n_in, n_in > 0 ? in_sizes[0] : -1, out_size, ws_size); grid = -1; return; }
        int dev = 0, cus = 0, per_cu = 0;
        if (hipGetDevice(&dev) != hipSuccess || hipDeviceGetAttribute(&cus, hipDeviceAttributeMultiprocessorCount, dev) != hipSuccess) { grid = -1; return; }
        if (hipFuncSetAttribute((const void*)fwd, hipFuncAttributeMaxDynamicSharedMemorySize, LDS_BYTES) != hipSuccess) { fprintf(stderr, "kernel_launch: hipFuncSetAttribute failed\n"); grid = -1; return; }
        if (hipOccupancyMaxActiveBlocksPerMultiprocessor(&per_cu, (const void*)fwd, NWAVES * 64, LDS_BYTES) != hipSuccess || per_cu < 1) { fprintf(stderr, "kernel_launch: occupancy query reports %d\n", per_cu); }
        (void)hipGetLastError();
        grid = cus;
    }
    if (grid < 0) return;
    if (hipMemsetAsync((char*)d_ws + WS_CTL, 0, CTL_ZERO_BYTES, stream) != hipSuccess) return;
    Args a{};
    for (int i = 0; i < 19; ++i) a.in[i] = (const float*)d_in[i];
    a.out = (float*)d_out; a.ws = (unsigned char*)d_ws;
    hipLaunchKernelGGL(fwd, dim3(grid), dim3(NWAVES * 64), LDS_BYTES, stream, a);
}
```

```cpp
#include <hip/hip_runtime.h>
#include <hip/hip_bf16.h>
#include <cstdio>
#include <cstdint>

namespace pg8 {
#define PG8_LAS __attribute__((address_space(3)))
typedef unsigned short bf16_t;
typedef short bf16x8 __attribute__((ext_vector_type(8)));
typedef float f32x4 __attribute__((ext_vector_type(4)));
typedef float f32x2 __attribute__((ext_vector_type(2)));
typedef unsigned u32x4 __attribute__((ext_vector_type(4)));
typedef unsigned u32x2 __attribute__((ext_vector_type(2)));
typedef int i32x4 __attribute__((ext_vector_type(4)));
typedef int i32x8 __attribute__((ext_vector_type(8)));
constexpr int BM = 256, BK = 64, HALF = 128, HTB = HALF * BK * 2  , STAGE_BYTES = 8 * HTB, NXCD = 8, WGM = 8;

__host__ __device__ __forceinline__ int lds_byte(int r, int c) { const int st = (r >> 4) * 2 + (c >> 5), rr = r & 15, cc = c & 31, ob = rr * 64 + cc * 2; return st * 1024 + (ob ^ (((ob >> 9) & 1) << 5)); }
__host__ __device__ __forceinline__ void stage_rc(int b, int& R, int& C) { const int st = b / 1024, sb = b % 1024, swz = sb ^ (((sb >> 9) & 1) << 5); R = (st >> 1) * 16 + swz / 64; C = (st & 1) * 32 + (swz % 64) / 2; }
__host__ __device__ __forceinline__ int perm32(int rho) { const int n = rho >> 4, i = rho & 15; return 8 * (i >> 2) + 4 * n + (i & 3); }

struct Unit { int pm, pn; size_t aoff, boff; int skipb1; };
struct Gemm { const void* A; const void* Bt; int nt, lda, ldb; unsigned wrapmask; };

struct TileOrder {
    int nM, nN, nwg, G, c; size_t a_tile, b_tile, b_batch; int pmb;
    __device__ __forceinline__ void init(int M, int N, int G_, int c_, int lda_bytes, int ldb_bytes, size_t b_batch_bytes, int pm_per_batch) {
        nM = M / BM; nN = N / BM; nwg = nM * nN; G = G_; c = c_; deal = 0; skipmode = 0; a_tile = (size_t)BM * lda_bytes; b_tile = (size_t)BM * ldb_bytes; b_batch = b_batch_bytes; pmb = pm_per_batch; }
    int skipmode;
    int deal;
    __device__ __forceinline__ bool next(int i, Unit& u) const {
        long L = (long)i * G + c;
        if (deal == 1) { const int n = 11 + (c < 128 ? 1 : (c >= 192 ? 2 : 0)); if (i >= n) return false; if (i >= 11) L = c < 128 ? 2816 + c : 2944 + (i - 11) * 64 + (c - 192); }
        if (L >= nwg) return false;
        int wgid = (int)L; { const int q = nwg / NXCD, r = nwg % NXCD, xcd = wgid % NXCD, off = wgid / NXCD; wgid = (xcd < r ? xcd * (q + 1) : r * (q + 1) + (xcd - r) * q) + off; }
        const int nig = WGM * nN, gid = wgid / nig, fm = gid * WGM, gsz = (nM - fm) < WGM ? (nM - fm) : WGM;
        u.pm = fm + ((wgid % nig) % gsz); u.pn = (wgid % nig) / gsz;
        u.aoff = (size_t)u.pm * a_tile; u.boff = (size_t)u.pn * b_tile + (size_t)(u.pm / pmb) * b_batch; u.skipb1 = (skipmode && (u.pm & 31) <= 16) ? 1 : 0; return true;
    }
};

__device__ __forceinline__ unsigned cvt_pk_bf16(float lo, float hi) { unsigned r; asm volatile("v_cvt_pk_bf16_f32 %0, %1, %2" : "=v"(r) : "v"(lo), "v"(hi)); return r; }

typedef f32x4 AccT[2][2][4][2];

struct EpiBf16 {
    static constexpr bool PERM = true;
    bf16_t* O; int ldc; unsigned scalemask; float scale0; unsigned* nrm;
    __device__ __forceinline__ void operator()(AccT& acc, const Unit& u, int wr, int wc, int fr, int fq, PG8_LAS unsigned char*) const {
        const int row0 = u.pm * BM + wr * 64 + fr, col0 = u.pn * BM + wc * 32 + 8 * fq;
        const float sc = ((scalemask >> u.pn) & 1u) ? scale0 : 1.f;
        if (nrm && (u.pn < 4 || (u.pn >= 6 && u.pn < 10))) {
#pragma unroll
            for (int bj = 0; bj < 2; ++bj) { float mx = 0.f;
#pragma unroll
                for (int ai = 0; ai < 2; ++ai)
#pragma unroll
                    for (int m = 0; m < 4; ++m) { const f32x4 v0 = acc[ai][bj][m][0] * sc, v1 = acc[ai][bj][m][1] * sc;
                        float q = (v0[0] * v0[0] + v0[1] * v0[1]) + (v0[2] * v0[2] + v0[3] * v0[3]) + (v1[0] * v1[0] + v1[1] * v1[1]) + (v1[2] * v1[2] + v1[3] * v1[3]);
                        q += __shfl_xor(q, 16); q += __shfl_xor(q, 32); mx = fmaxf(mx, q); }
                mx = fmaxf(mx, __shfl_xor(mx, 1)); mx = fmaxf(mx, __shfl_xor(mx, 2)); mx = fmaxf(mx, __shfl_xor(mx, 4)); mx = fmaxf(mx, __shfl_xor(mx, 8));
                if (fr == 0 && fq == 0) { const int head = (u.pn & 1) * 4 + 2 * bj + (wc >> 1); const int grp = u.pn < 4 ? (u.pn >> 1) : (u.pn >> 1) - 1; atomicMax(nrm + (((u.pm >> 5) * 8 + head) * 4 + grp) * 2 + (wc & 1), __float_as_uint(mx)); } } }
#pragma unroll
        for (int ai = 0; ai < 2; ++ai)
#pragma unroll
            for (int m = 0; m < 4; ++m) { bf16_t* rowp = O + (size_t)(row0 + ai * HALF + m * 16) * ldc + col0;
#pragma unroll
                for (int bj = 0; bj < 2; ++bj) { const f32x4 v0 = acc[ai][bj][m][0] * sc, v1 = acc[ai][bj][m][1] * sc;
                    u32x4 w; w.x = cvt_pk_bf16(v0[0], v0[1]); w.y = cvt_pk_bf16(v0[2], v0[3]); w.z = cvt_pk_bf16(v1[0], v1[1]); w.w = cvt_pk_bf16(v1[2], v1[3]);
                    *(u32x4*)(rowp + bj * HALF) = w; } }
    }
};
__device__ __forceinline__ unsigned pk4_fp8(float a, float b, float c, float d) { a = __builtin_amdgcn_fmed3f(a, -448.f, 448.f); b = __builtin_amdgcn_fmed3f(b, -448.f, 448.f); c = __builtin_amdgcn_fmed3f(c, -448.f, 448.f); d = __builtin_amdgcn_fmed3f(d, -448.f, 448.f); int w = 0;
    w = __builtin_amdgcn_cvt_pk_fp8_f32(a, b, w, false); w = __builtin_amdgcn_cvt_pk_fp8_f32(c, d, w, true); return (unsigned)w; }
struct EpiF8 {
    static constexpr bool PERM = true;
    unsigned char* O; int ldc; float sc;
    __device__ __forceinline__ void operator()(AccT& acc, const Unit& u, int wr, int wc, int fr, int fq, PG8_LAS unsigned char*) const {
        const int row0 = u.pm * BM + wr * 64 + fr, col0 = u.pn * BM + wc * 32 + 8 * fq;
#pragma unroll
        for (int ai = 0; ai < 2; ++ai)
#pragma unroll
            for (int m = 0; m < 4; ++m) { unsigned char* rowp = O + (size_t)(row0 + ai * HALF + m * 16) * ldc + col0;
#pragma unroll
                for (int bj = 0; bj < 2; ++bj) { const f32x4 v0 = acc[ai][bj][m][0] * sc, v1 = acc[ai][bj][m][1] * sc;
                    *(u32x2*)(rowp + bj * HALF) = (u32x2){pk4_fp8(v0[0], v0[1], v0[2], v0[3]), pk4_fp8(v1[0], v1[1], v1[2], v1[3])}; } }
    }
};
__device__ __forceinline__ float rstd_from_slots(const float* slots) {
    const f32x4 a = *(const f32x4*)slots, b = *(const f32x4*)(slots + 4), c = *(const f32x4*)(slots + 8), d = *(const f32x4*)(slots + 12);
    const float s = ((a[0] + a[1]) + (a[2] + a[3])) + ((b[0] + b[1]) + (b[2] + b[3])) + ((c[0] + c[1]) + (c[2] + c[3])) + ((d[0] + d[1]) + (d[2] + d[3]));
    return __builtin_amdgcn_rsqf(s * (1.0f / 1024.0f) + 1e-6f);
}
#define PG8_DPP(old, src, ctrl) __builtin_bit_cast(float, __builtin_amdgcn_update_dpp(__builtin_bit_cast(int, (float)(old)), __builtin_bit_cast(int, (float)(src)), (ctrl), 0xf, 0xf, false))
struct EpiConv {
    static constexpr bool PERM = true;
    unsigned char* act; const float* ssq; const float* cw; const float* cbias; float* GH; float* UH; float* GT;
    __device__ __forceinline__ void operator()(AccT& acc, const Unit& u, int wr, int wc, int fr, int fq, PG8_LAS unsigned char* xl) const {
        PG8_LAS float* H = (PG8_LAS float*)xl;
        const int cl = wc * 32 + 8 * fq;
        const int row0 = u.pm * BM + wr * 64 + fr;
        PG8_LAS float* Sr = H + 1024;
        { const int t_ = threadIdx.x; if (t_ < 256) Sr[t_] = rstd_from_slots(ssq + (size_t)(u.pm * BM + t_) * 16); }
        asm volatile("s_waitcnt vmcnt(0) lgkmcnt(0)" ::: "memory"); __builtin_amdgcn_s_barrier(); asm volatile("" ::: "memory");
#pragma unroll
        for (int ai = 0; ai < 2; ++ai)
#pragma unroll
            for (int m = 0; m < 4; ++m) { const float rs = Sr[ai * HALF + wr * 64 + m * 16 + fr];
#pragma unroll
                for (int bj = 0; bj < 2; ++bj)
#pragma unroll
                    for (int n = 0; n < 2; ++n) acc[ai][bj][m][n] *= rs; }
        const size_t sb = ((size_t)(u.pm * 22 + u.pn) * 2) * 128 + cl;
        if (fr >= 14) {
#pragma unroll
            for (int ai = 0; ai < 2; ++ai)
#pragma unroll
                for (int n = 0; n < 2; ++n) *(PG8_LAS f32x4*)(H + ((ai * 2 + wr) * 2 + (fr - 14)) * 128 + cl + 4 * n) = acc[ai][0][3][n];
            if (wr == 1) {
#pragma unroll
                for (int n = 0; n < 2; ++n) *(f32x4*)(GT + sb + (fr - 14) * 128 + 4 * n) = acc[1][0][3][n]; } }
        if (wr == 0 && fr < 2) {
#pragma unroll
            for (int n = 0; n < 2; ++n) { *(f32x4*)(GH + sb + fr * 128 + 4 * n) = acc[0][0][0][n]; *(f32x4*)(UH + sb + fr * 128 + 4 * n) = acc[0][1][0][n]; } }
        asm volatile("s_waitcnt lgkmcnt(0)" ::: "memory"); __builtin_amdgcn_s_barrier(); asm volatile("" ::: "memory");
#pragma unroll
        for (int n = 0; n < 2; ++n) {
            const int c0 = u.pn * 128 + cl + 4 * n;
            const f32x4 w0 = *(const f32x4*)(cw + c0), w1 = *(const f32x4*)(cw + 2816 + c0), w2 = *(const f32x4*)(cw + 2 * 2816 + c0), cbv = *(const f32x4*)(cbias + c0);
#pragma unroll
            for (int ai = 0; ai < 2; ++ai) {
                const int hsrc = wr == 1 ? ai * 2 : (ai == 1 ? 1 : 0);
                const f32x4 h14 = *(const PG8_LAS f32x4*)(H + (hsrc * 2 + 0) * 128 + cl + 4 * n), h15 = *(const PG8_LAS f32x4*)(H + (hsrc * 2 + 1) * 128 + cl + 4 * n);
#pragma unroll
                for (int m = 3; m >= 0; --m) {
                    float res[4];
#pragma unroll
                    for (int i = 0; i < 4; ++i) { const float X = acc[ai][0][m][n][i];
                        float o1, o2;
                        if (m > 0) { const float Xp = acc[ai][0][m > 0 ? m - 1 : 0][n][i]; o1 = PG8_DPP(0.f, Xp, 0x121); o2 = PG8_DPP(0.f, Xp, 0x122); }
                        else { o1 = h15[i]; o2 = fr == 0 ? h14[i] : h15[i]; }
                        const float g1 = PG8_DPP(o1, X, 0x111), g0 = PG8_DPP(o2, X, 0x112);
                        const float gc = cbv[i] + w0[i] * g0 + w1[i] * g1 + w2[i] * X;
                        res[i] = gc * __builtin_amdgcn_rcpf(1.0f + __builtin_amdgcn_exp2f(-1.4426950408889634f * gc)) * acc[ai][1][m][n][i]; }
                    const int row = row0 + ai * HALF + m * 16;
                    if (!(ai == 0 && m == 0 && wr == 0 && fr < 2))
                        *(unsigned*)(act + (size_t)row * 2816 + c0) = pk4_fp8(res[0], res[1], res[2], res[3]);
                } } }
    }
};
template <bool BASEB, bool OUTF> struct EpiRes {
    static constexpr bool PERM = true;
    const float* base; const bf16_t* baseb; float* out; bf16_t* hb; unsigned char* hb8; float* ssq; float accs;
    __device__ __forceinline__ void operator()(AccT& acc, const Unit& u, int wr, int wc, int fr, int fq, PG8_LAS unsigned char*) const {
        const int row0 = u.pm * BM + wr * 64 + fr, col0 = u.pn * BM + wc * 32 + 8 * fq;
        constexpr int DEPTH = BASEB ? 3 : 2;
        u32x4 pb[12][2]; f32x4 pf[12][2][2];
#define PG8_RES_LOAD(it) do { const size_t o_ = (size_t)(row0 + ((it) >> 2) * HALF + ((it) & 3) * 16) * 1024 + col0; \
            if constexpr (BASEB) { pb[it][0] = *(const u32x4*)(baseb + o_); pb[it][1] = *(const u32x4*)(baseb + o_ + HALF); } \
            else { pf[it][0][0] = *(const f32x4*)(base + o_); pf[it][0][1] = *(const f32x4*)(base + o_ + 4); pf[it][1][0] = *(const f32x4*)(base + o_ + HALF); pf[it][1][1] = *(const f32x4*)(base + o_ + HALF + 4); } } while (0)
#pragma unroll
        for (int it = 0; it < DEPTH; ++it) PG8_RES_LOAD(it);
#pragma unroll
        for (int it = 0; it < 8; ++it) { const int ai = it >> 2, m = it & 3;
            if (it + DEPTH < 8) PG8_RES_LOAD(it + DEPTH);
            __builtin_amdgcn_sched_barrier(0);
            const int row = row0 + ai * HALF + m * 16; const size_t off = (size_t)row * 1024 + col0; float q = 0.f;
#pragma unroll
            for (int bj = 0; bj < 2; ++bj) {
                f32x4 b0, b1;
                if constexpr (BASEB) { const u32x4 bw = pb[it][bj];
                    b0 = (f32x4){__builtin_bit_cast(float, bw.x << 16), __builtin_bit_cast(float, bw.x & 0xffff0000u), __builtin_bit_cast(float, bw.y << 16), __builtin_bit_cast(float, bw.y & 0xffff0000u)};
                    b1 = (f32x4){__builtin_bit_cast(float, bw.z << 16), __builtin_bit_cast(float, bw.z & 0xffff0000u), __builtin_bit_cast(float, bw.w << 16), __builtin_bit_cast(float, bw.w & 0xffff0000u)}; }
                else { b0 = pf[it][bj][0]; b1 = pf[it][bj][1]; }
                const f32x4 v0 = acc[ai][bj][m][0] * accs + b0, v1 = acc[ai][bj][m][1] * accs + b1;
                if constexpr (OUTF) { *(f32x4*)(out + off + bj * HALF) = v0; *(f32x4*)(out + off + bj * HALF + 4) = v1; }
                q += (v0[0] * v0[0] + v0[1] * v0[1]) + (v0[2] * v0[2] + v0[3] * v0[3]) + (v1[0] * v1[0] + v1[1] * v1[1]) + (v1[2] * v1[2] + v1[3] * v1[3]);
                if (hb) { u32x4 w; w.x = cvt_pk_bf16(v0[0], v0[1]); w.y = cvt_pk_bf16(v0[2], v0[3]); w.z = cvt_pk_bf16(v1[0], v1[1]); w.w = cvt_pk_bf16(v1[2], v1[3]); *(u32x4*)(hb + off + bj * HALF) = w; }
                if (hb8) *(u32x2*)(hb8 + off + bj * HALF) = (u32x2){pk4_fp8(v0[0], v0[1], v0[2], v0[3]), pk4_fp8(v1[0], v1[1], v1[2], v1[3])}; }
            q += __shfl_xor(q, 16); q += __shfl_xor(q, 32);
            if (fq == 0) ssq[(size_t)row * 16 + u.pn * 4 + wc] = q;
            __builtin_amdgcn_sched_barrier(0); }
#undef PG8_RES_LOAD
    }
};
struct EpiResNorm {
    static constexpr bool PERM = true;
    const bf16_t* baseb; float* out; const float* gfin; float accs; float* xbuf; unsigned* cnt; unsigned* tmo;
    __device__ __forceinline__ void operator()(AccT& acc, const Unit& u, int wr, int wc, int fr, int fq, PG8_LAS unsigned char* xl) const {
        PG8_LAS float* Pp = (PG8_LAS float*)xl;
        PG8_LAS float* Sr = Pp + 1024;
        PG8_LAS unsigned* flag = (PG8_LAS unsigned*)(Sr + 256);
        const int tid = threadIdx.x, wid = tid >> 6, lane = tid & 63;
        const int row0 = u.pm * BM + wr * 64 + fr, col0 = u.pn * BM + wc * 32 + 8 * fq;
        u32x4 pb[12][2];
#define PG8_RN_LOAD(it) do { const size_t o_ = (size_t)(row0 + ((it) >> 2) * HALF + ((it) & 3) * 16) * 1024 + col0; pb[it][0] = *(const u32x4*)(baseb + o_); pb[it][1] = *(const u32x4*)(baseb + o_ + HALF); } while (0)
#pragma unroll
        for (int it = 0; it < 4; ++it) PG8_RN_LOAD(it);
#pragma unroll
        for (int it = 0; it < 8; ++it) { const int ai = it >> 2, m = it & 3;
                if (it + 4 < 8) PG8_RN_LOAD(it + 4);
                __builtin_amdgcn_sched_barrier(0);
                float q = 0.f;
#pragma unroll
                for (int bj = 0; bj < 2; ++bj) {
                    const u32x4 bw = pb[it][bj];
                    const f32x4 b0 = (f32x4){__builtin_bit_cast(float, bw.x << 16), __builtin_bit_cast(float, bw.x & 0xffff0000u), __builtin_bit_cast(float, bw.y << 16), __builtin_bit_cast(float, bw.y & 0xffff0000u)};
                    const f32x4 b1 = (f32x4){__builtin_bit_cast(float, bw.z << 16), __builtin_bit_cast(float, bw.z & 0xffff0000u), __builtin_bit_cast(float, bw.w << 16), __builtin_bit_cast(float, bw.w & 0xffff0000u)};
                    const f32x4 v0 = acc[ai][bj][m][0] * accs + b0, v1 = acc[ai][bj][m][1] * accs + b1; acc[ai][bj][m][0] = v0; acc[ai][bj][m][1] = v1;
                    q += (v0[0] * v0[0] + v0[1] * v0[1]) + (v0[2] * v0[2] + v0[3] * v0[3]) + (v1[0] * v1[0] + v1[1] * v1[1]) + (v1[2] * v1[2] + v1[3] * v1[3]); }
                q += __shfl_xor(q, 16); q += __shfl_xor(q, 32);
                if (fq == 0) Pp[(ai * HALF + wr * 64 + m * 16 + fr) * 4 + wc] = q;
                __builtin_amdgcn_sched_barrier(0); }
#undef PG8_RN_LOAD
        asm volatile("s_waitcnt lgkmcnt(0)" ::: "memory"); __builtin_amdgcn_s_barrier(); asm volatile("" ::: "memory");
        if (wid < 4) { const int r = wid * 64 + lane; const f32x4 p = *(const PG8_LAS f32x4*)(Pp + r * 4);
            __hip_atomic_store(xbuf + (size_t)(u.pm * BM + r) * 4 + u.pn, (p[0] + p[1]) + (p[2] + p[3]), __ATOMIC_RELAXED, __HIP_MEMORY_SCOPE_AGENT);
            asm volatile("s_waitcnt vmcnt(0)" ::: "memory");
            if (lane == 0) __hip_atomic_fetch_add(cnt + 64 * u.pm, 1u, __ATOMIC_RELAXED, __HIP_MEMORY_SCOPE_AGENT); }
        if (wid == 0) { unsigned sp = 0u; bool dead = false;
            for (;;) { if ((unsigned)__builtin_amdgcn_readfirstlane(__hip_atomic_load(cnt + 64 * u.pm, __ATOMIC_RELAXED, __HIP_MEMORY_SCOPE_AGENT)) >= 16u) break;
                if (++sp > (1u << 20)) { if (lane == 0) __hip_atomic_store(tmo, 1u, __ATOMIC_RELAXED, __HIP_MEMORY_SCOPE_AGENT); dead = true; break; }
                __builtin_amdgcn_s_sleep(2); }
            __builtin_amdgcn_fence(__ATOMIC_ACQUIRE, "agent");
            if (lane == 0) flag[0] = dead ? 1u : 0u; }
        asm volatile("s_waitcnt vmcnt(0) lgkmcnt(0)" ::: "memory"); __builtin_amdgcn_s_barrier(); asm volatile("" ::: "memory");
        if (wid < 4) { const int r = wid * 64 + lane; const float* xs = xbuf + (size_t)(u.pm * BM + r) * 4; float s = 0.f;
#pragma unroll
            for (int t = 0; t < 4; ++t) s += __hip_atomic_load(xs + t, __ATOMIC_RELAXED, __HIP_MEMORY_SCOPE_AGENT);
            Sr[r] = __builtin_amdgcn_rsqf(s * (1.0f / 1024.0f) + 1e-6f); }
        asm volatile("s_waitcnt vmcnt(0) lgkmcnt(0)" ::: "memory"); __builtin_amdgcn_s_barrier(); asm volatile("" ::: "memory");
        f32x4 gg[2][2];
#pragma unroll
        for (int bj = 0; bj < 2; ++bj) { gg[bj][0] = *(const f32x4*)(gfin + col0 + bj * HALF); gg[bj][1] = *(const f32x4*)(gfin + col0 + bj * HALF + 4); }
#pragma unroll
        for (int ai = 0; ai < 2; ++ai)
#pragma unroll
            for (int m = 0; m < 4; ++m) { const int rl = ai * HALF + wr * 64 + m * 16 + fr; const float rs = Sr[rl]; const size_t off = (size_t)(u.pm * BM + rl) * 1024 + col0;
#pragma unroll
                for (int bj = 0; bj < 2; ++bj) { *(f32x4*)(out + off + bj * HALF) = acc[ai][bj][m][0] * rs * gg[bj][0]; *(f32x4*)(out + off + bj * HALF + 4) = acc[ai][bj][m][1] * rs * gg[bj][1]; } }
    }
};
struct EpiSoftmax {
    static constexpr bool PERM = true;
    unsigned char* P; const float* ssq; float sscale;
    __device__ __forceinline__ void operator()(AccT& acc, const Unit& u, int wr, int wc, int fr, int fq, PG8_LAS unsigned char* xl) const {
        PG8_LAS f32x2* X = (PG8_LAS f32x2*)xl;
        const int row0 = u.pm * BM + wr * 64 + fr, col0 = u.pn * BM + wc * 32 + 8 * fq;
        float ml[2][4];
        f32x4 sl[8];
#pragma unroll
        for (int it = 0; it < 8; ++it) sl[it] = *(const f32x4*)(ssq + (size_t)(row0 + (it >> 2) * HALF + (it & 3) * 16) * 16 + fq * 4);
        __builtin_amdgcn_sched_barrier(0);
#pragma unroll
        for (int ai = 0; ai < 2; ++ai)
#pragma unroll
            for (int m = 0; m < 4; ++m) { float ps = (sl[ai * 4 + m][0] + sl[ai * 4 + m][1]) + (sl[ai * 4 + m][2] + sl[ai * 4 + m][3]); ps += __shfl_xor(ps, 16); ps += __shfl_xor(ps, 32);
                const float rs = __builtin_amdgcn_rsqf(ps * (1.0f / 1024.0f) + 1e-6f) * sscale;
                float mx = -3.0e38f;
#pragma unroll
                for (int bj = 0; bj < 2; ++bj)
#pragma unroll
                    for (int n = 0; n < 2; ++n) { f32x4 v = acc[ai][bj][m][n] * rs; acc[ai][bj][m][n] = v; mx = fmaxf(fmaxf(mx, fmaxf(v[0], v[1])), fmaxf(v[2], v[3])); }
                mx = fmaxf(mx, __shfl_xor(mx, 16)); mx = fmaxf(mx, __shfl_xor(mx, 32));
                float s = 0.f;
#pragma unroll
                for (int bj = 0; bj < 2; ++bj)
#pragma unroll
                    for (int n = 0; n < 2; ++n) { f32x4 v = acc[ai][bj][m][n];
                        v[0] = __builtin_amdgcn_exp2f(v[0] - mx); v[1] = __builtin_amdgcn_exp2f(v[1] - mx); v[2] = __builtin_amdgcn_exp2f(v[2] - mx); v[3] = __builtin_amdgcn_exp2f(v[3] - mx);
                        acc[ai][bj][m][n] = v; s += (v[0] + v[1]) + (v[2] + v[3]); }
                s += __shfl_xor(s, 16); s += __shfl_xor(s, 32);
                ml[ai][m] = mx;
                if (fq == 0) X[(ai * HALF + wr * 64 + m * 16 + fr) * 4 + wc] = (f32x2){mx, s}; }
        asm volatile("s_waitcnt lgkmcnt(0)" ::: "memory"); __builtin_amdgcn_s_barrier(); asm volatile("" ::: "memory");
#pragma unroll
        for (int ai = 0; ai < 2; ++ai)
#pragma unroll
            for (int m = 0; m < 4; ++m) { const int rl = ai * HALF + wr * 64 + m * 16 + fr; const int row = u.pm * BM + rl;
                const f32x2 a = X[rl * 4 + 0], b = X[rl * 4 + 1], c = X[rl * 4 + 2], d = X[rl * 4 + 3];
                const float Mx = fmaxf(fmaxf(a.x, b.x), fmaxf(c.x, d.x));
                const float L = a.y * __builtin_amdgcn_exp2f(a.x - Mx) + b.y * __builtin_amdgcn_exp2f(b.x - Mx) + c.y * __builtin_amdgcn_exp2f(c.x - Mx) + d.y * __builtin_amdgcn_exp2f(d.x - Mx);
                const float f = __builtin_amdgcn_exp2f(ml[ai][m] - Mx) * __builtin_amdgcn_rcpf(L) * 256.0f;
                unsigned char* rowp = P + (size_t)row * 1024 + col0;
#pragma unroll
                for (int bj = 0; bj < 2; ++bj) { const f32x4 v0 = acc[ai][bj][m][0] * f, v1 = acc[ai][bj][m][1] * f;
                    *(u32x2*)(rowp + bj * HALF) = (u32x2){pk4_fp8(v0[0], v0[1], v0[2], v0[3]), pk4_fp8(v1[0], v1[1], v1[2], v1[3])}; } }
    }
};
struct EpiGate {
    static constexpr bool PERM = false;
    unsigned* sel;
    __device__ __forceinline__ void operator()(AccT& acc, const Unit& u, int wr, int wc, int fr, int fq, PG8_LAS unsigned char*) const {
        const int own = u.pm & 31;
#pragma unroll
        for (int ai = 0; ai < 2; ++ai)
#pragma unroll
            for (int m = 0; m < 4; ++m) { const int row = u.pm * BM + ai * HALF + wr * 64 + m * 16 + fr;
#pragma unroll
                for (int n = 0; n < 2; ++n) { unsigned mask = 0u;
#pragma unroll
                    for (int round = 0; round < 3; ++round) { float bv = -3.0e38f; int bi = 32;
#pragma unroll
                        for (int bj = 0; bj < 2; ++bj)
#pragma unroll
                            for (int i = 0; i < 4; ++i) { const int nb = 16 * bj + 4 * fq + i; const float v = acc[ai][bj][m][n][i];
                                if (nb < own && !((mask >> nb) & 1u) && v > bv) { bv = v; bi = nb; } }
#pragma unroll
                        for (int off = 16; off <= 32; off <<= 1) { const float ov = __shfl_xor(bv, off); const int oi = __shfl_xor(bi, off); if (ov > bv || (ov == bv && oi < bi)) { bv = ov; bi = oi; } }
                        if (bi < 32) mask |= 1u << bi; }
                    if (fq == 0) sel[((size_t)((u.pm >> 5) * 8 + 2 * wc + n)) * 8192 + (row & 8191)] = mask; } }
    }
};

template <class Epi, class Sched, bool ALIGN_EPI, bool F8 = false, bool CANSKIP = false>
__device__ __forceinline__ void gemm_phase(PG8_LAS unsigned char* lds, PG8_LAS unsigned char* xl, const Gemm g, const Sched& S, const Epi& E) {
    int tid_ = threadIdx.x; asm volatile("" : "+v"(tid_));
    const int tid = tid_, wid = __builtin_amdgcn_readfirstlane(tid >> 6), lane = tid & 63, wr = wid >> 2, wc = wid & 3, fr = lane & 15, fq = lane >> 4;
    int nt = g.nt; asm volatile("" : "+s"(nt));
    unsigned voffA[2], voffB[2];
#pragma unroll
    for (int i = 0; i < 2; ++i) { int R, C; stage_rc(tid * 16 + i * 8192, R, C); const int Rb = Epi::PERM ? ((R & ~31) + perm32(R & 31)) : R;
        voffA[i] = (unsigned)(R * g.lda + C * 2); voffB[i] = (unsigned)(Rb * g.ldb + C * 2); }
    const size_t kstep = (size_t)(BK * 2);
    const size_t hstepA = (size_t)HALF * g.lda, hstepB = (size_t)HALF * g.ldb;
    const unsigned wmask = g.wrapmask;
    const unsigned ldsw = (unsigned)wid * 1024u;
    const int aoff = lds_byte(wr * 64 + fr, fq * 8), boff = lds_byte(wc * 32 + fr, fq * 8);
#define PG8_SA(b, h) (((b) * 2 + (h)) * HTB)
#define PG8_SB(b, h) ((4 + (b) * 2 + (h)) * HTB)
#define PG8_STAGE(bufoff, gbase, voff) do { _Pragma("unroll") for (int _i = 0; _i < 2; ++_i) \
        __builtin_amdgcn_global_load_lds((const unsigned*)((const char*)(gbase) + (voff)[_i]), (PG8_LAS unsigned*)(lds + (bufoff) + ldsw + _i * 8192), 16, 0, 0); } while (0)
#define PG8_LDA(dst, b, h) do { if constexpr (F8) { _Pragma("unroll") for (int m = 0; m < 4; ++m) { dst##8[m].lo = *(const PG8_LAS i32x4*)(lds + PG8_SA(b, h) + aoff + m * 2048); dst##8[m].hi = *(const PG8_LAS i32x4*)(lds + PG8_SA(b, h) + aoff + m * 2048 + 1024); } } \
        else { _Pragma("unroll") for (int m = 0; m < 4; ++m) _Pragma("unroll") for (int k = 0; k < 2; ++k) dst[m][k] = *(const PG8_LAS bf16x8*)(lds + PG8_SA(b, h) + aoff + m * 2048 + k * 1024); } } while (0)
#define PG8_LDB(dst, b, h) do { if constexpr (F8) { _Pragma("unroll") for (int n = 0; n < 2; ++n) { dst##8[n].lo = *(const PG8_LAS i32x4*)(lds + PG8_SB(b, h) + boff + n * 2048); dst##8[n].hi = *(const PG8_LAS i32x4*)(lds + PG8_SB(b, h) + boff + n * 2048 + 1024); } } \
        else { _Pragma("unroll") for (int n = 0; n < 2; ++n) _Pragma("unroll") for (int k = 0; k < 2; ++k) dst[n][k] = *(const PG8_LAS bf16x8*)(lds + PG8_SB(b, h) + boff + n * 2048 + k * 1024); } } while (0)
#define PG8_MMA(ai, bj, At, Bt) do { __builtin_amdgcn_s_setprio(1); \
        if constexpr (F8) { _Pragma("unroll") for (int m = 0; m < 4; ++m) _Pragma("unroll") for (int n = 0; n < 2; ++n) \
            asm volatile("v_mfma_f32_16x16x128_f8f6f4 %0, %1, %2, %0" : "+v"(acc[ai][bj][m][n]) : "v"(Bt##8[n]), "v"(At##8[m])); } \
        else { _Pragma("unroll") for (int m = 0; m < 4; ++m) _Pragma("unroll") for (int n = 0; n < 2; ++n) _Pragma("unroll") for (int k = 0; k < 2; ++k) \
            acc[ai][bj][m][n] = __builtin_amdgcn_mfma_f32_16x16x32_bf16(Bt[n][k], At[m][k], acc[ai][bj][m][n], 0, 0, 0); } \
        __builtin_amdgcn_s_setprio(0); } while (0)
#define PG8_WAIT_V(n) asm volatile("s_waitcnt vmcnt(" #n ")" ::: "memory")
#define PG8_WAIT_L(n) asm volatile("s_waitcnt lgkmcnt(" #n ")" ::: "memory")
#define PG8_BAR __builtin_amdgcn_s_barrier()
#define PG8_SCHED __builtin_amdgcn_sched_barrier(0)
    Unit cur, nxt; int ui = 0;
    if (!S.next(0, cur)) return;
    AccT acc;
    bf16x8 At[4][2], B0[2][2], B1[2][2]; i32x8 At8[4], B08[2], B18[2];
    const char* cA = (const char*)g.A + cur.aoff; const char* cB = (const char*)g.Bt + cur.boff;
    PG8_STAGE(PG8_SB(0, 0), cB, voffB); PG8_STAGE(PG8_SB(0, 1), cB + hstepB, voffB); PG8_STAGE(PG8_SA(0, 0), cA, voffA); PG8_STAGE(PG8_SA(0, 1), cA + hstepA, voffA);
    if (wr == 1) PG8_BAR;
    PG8_WAIT_V(2); PG8_BAR;
    PG8_STAGE(PG8_SB(1, 0), cB + kstep, voffB); PG8_STAGE(PG8_SA(1, 0), cA + kstep, voffA); PG8_STAGE(PG8_SB(1, 1), cB + hstepB + kstep, voffB);
    PG8_WAIT_V(6); PG8_BAR;
    { float z0; asm volatile("v_mov_b32 %0, 0" : "=v"(z0));
#pragma unroll
    for (int a = 0; a < 2; ++a)
#pragma unroll
        for (int b = 0; b < 2; ++b)
#pragma unroll
            for (int m = 0; m < 4; ++m)
#pragma unroll
                for (int n = 0; n < 2; ++n) acc[a][b][m][n] = (f32x4){z0, z0, z0, z0}; }
    for (;;) {
        const bool has_next = S.next(ui + 1, nxt);
        const char* nA = has_next ? (const char*)g.A + nxt.aoff : cA; const char* nB = has_next ? (const char*)g.Bt + nxt.boff : cB;
#pragma unroll 1
        for (int t = 0; t < nt; t += 2) {
            const bool last = (t == nt - 2);
            const char* a1 = cA + (size_t)((unsigned)(t * 128) & wmask) + kstep;
            const char* a2 = last ? nA : cA + (size_t)((unsigned)((t + 2) * 128) & wmask); const char* b2 = last ? nB : cB + (size_t)(t + 2) * kstep;
            const char* a3 = a2 + kstep; const char* b3 = b2 + kstep;
            PG8_LDB(B0, 0, 0); if (!(CANSKIP && cur.skipb1)) PG8_LDB(B1, 0, 1); PG8_SCHED; PG8_LDA(At, 0, 0); PG8_STAGE(PG8_SA(1, 1), a1 + hstepA, voffA);
            PG8_WAIT_V(8); PG8_WAIT_L(0); PG8_BAR; PG8_MMA(0, 0, At, B0); if (!(CANSKIP && cur.skipb1)) PG8_MMA(0, 1, At, B1); PG8_BAR; PG8_SCHED;
            PG8_LDA(At, 0, 1); PG8_STAGE(PG8_SB(0, 0), b2, voffB); PG8_STAGE(PG8_SB(0, 1), b2 + hstepB, voffB); PG8_STAGE(PG8_SA(0, 0), a2, voffA);
            PG8_WAIT_V(8); PG8_WAIT_L(0); PG8_BAR; PG8_MMA(1, 0, At, B0); if (!(CANSKIP && cur.skipb1)) PG8_MMA(1, 1, At, B1); PG8_BAR; PG8_SCHED;
            PG8_LDB(B0, 1, 0); if (!(CANSKIP && cur.skipb1)) PG8_LDB(B1, 1, 1); PG8_SCHED; PG8_LDA(At, 1, 0); PG8_STAGE(PG8_SA(0, 1), a2 + hstepA, voffA);
            PG8_WAIT_V(8); PG8_WAIT_L(0); PG8_BAR; PG8_MMA(0, 0, At, B0); if (!(CANSKIP && cur.skipb1)) PG8_MMA(0, 1, At, B1); PG8_BAR; PG8_SCHED;
            PG8_LDA(At, 1, 1); PG8_STAGE(PG8_SB(1, 0), b3, voffB); PG8_STAGE(PG8_SB(1, 1), b3 + hstepB, voffB); PG8_STAGE(PG8_SA(1, 0), a3, voffA);
            PG8_WAIT_V(8); PG8_WAIT_L(0); PG8_BAR; PG8_MMA(1, 0, At, B0); if (!(CANSKIP && cur.skipb1)) PG8_MMA(1, 1, At, B1); PG8_BAR; PG8_SCHED;
        }
        if constexpr (F8) asm volatile("s_nop 15\n\ts_nop 15" ::: "memory");
        if constexpr (ALIGN_EPI) { if (wr == 0) PG8_BAR; }
        E(acc, cur, wr, wc, fr, fq, xl);
        if (!has_next) break;
#pragma unroll
        for (int a = 0; a < 2; ++a)
#pragma unroll
            for (int b = 0; b < 2; ++b)
#pragma unroll
                for (int m = 0; m < 4; ++m)
#pragma unroll
                    for (int n = 0; n < 2; ++n) acc[a][b][m][n] = (f32x4){0.f, 0.f, 0.f, 0.f};
        cur = nxt; cA = nA; cB = nB; ++ui;
        if constexpr (ALIGN_EPI) { if (wr == 1) PG8_BAR; }
    }
    PG8_WAIT_V(0);
    if constexpr (!ALIGN_EPI) { if (wr == 0) PG8_BAR; }
    PG8_BAR;
#undef PG8_SA
#undef PG8_SB
#undef PG8_STAGE
#undef PG8_LDA
#undef PG8_LDB
#undef PG8_MMA
#undef PG8_WAIT_V
#undef PG8_WAIT_L
#undef PG8_BAR
#undef PG8_SCHED
}
}

constexpr int NWAVES = 8;
constexpr int NB = 8, T = 8192, D = 1024, M = NB * T;
constexpr int INC = 3080, NQKV = 3072, FF = 2816;
constexpr int C_F = 1536, C_QM = 1544, C_KM = 2056;
constexpr float LOG2E = 1.4426950408889634f;
constexpr float C2 = 0.125f * LOG2E;
constexpr float RMS_EPS = 1e-6f;

constexpr size_t MiB = 1u << 20;
constexpr size_t WS_CTL = 0, CTL_ZERO_BYTES = 1 * MiB;
constexpr size_t WS_LOGF = 2 * MiB, WS_C = 4 * MiB, WS_ABAR = 6 * MiB, WS_KM = 7 * MiB, WS_SEL = 8 * MiB;
constexpr size_t WS_SSQ1 = 10 * MiB, WS_SSQ2 = 14 * MiB, WS_SSQ3 = 18 * MiB;
constexpr size_t WS_MEMN = 22 * MiB, WS_KV = 26 * MiB, WS_WQS = 34 * MiB, WS_WOT = 36 * MiB, WS_WKVT = 38 * MiB, WS_WINT = 42 * MiB, WS_WOUTT = 48 * MiB;
constexpr size_t WS_WUPT = 50 * MiB, WS_WDT = 976 * MiB  , WS_ZT = 68 * MiB, WS_WQK = 80 * MiB, WS_VWO = 96 * MiB;
constexpr size_t WS_ACT8 = 240 * MiB;
constexpr size_t WS_GH = 416 * MiB, WS_UH = 424 * MiB, WS_GT = 432 * MiB;
constexpr size_t WS_A1 = 112 * MiB;
constexpr size_t WS_QKV = 368 * MiB;
constexpr size_t WS_Y = 752 * MiB, WS_HB1 = WS_A1 + 128 * MiB, WS_P = WS_QKV, WS_HB2 = WS_A1;
constexpr size_t WS_HB1F = WS_A1;
constexpr size_t WS_PO = WS_A1;
constexpr size_t WS_LIST = 880 * MiB, WS_PML = 944 * MiB, WS_KXF = 960 * MiB, WS_KXM = 968 * MiB, WS_CNT = 969 * MiB;
constexpr size_t WS_G = 240 * MiB, WS_U = 592 * MiB, WS_END = 1024 * MiB;
static_assert(WS_WUPT + (size_t)2 * FF * D * 2 <= WS_ZT && WS_ACT8 + (size_t)M * FF <= WS_GH && WS_WDT + (size_t)D * FF <= WS_END && WS_CNT + 8192 <= WS_WDT && WS_ZT + (size_t)8 * 256 * 3072 * 2 <= WS_WQK && WS_VWO + 16 * MiB <= WS_A1, "ws map");
static_assert(WS_G + (size_t)M * FF * 2 <= WS_U && WS_U + (size_t)M * FF * 2 <= WS_END && WS_Y + (size_t)M * D * 2 <= WS_LIST && WS_LIST + (size_t)2048 * 8192 * 4 <= WS_PML && WS_PML + (size_t)M * 32 * 8 <= WS_KXF && WS_KXF + (size_t)64 * 8192 * 16 <= WS_KXM, "ws map 2");
constexpr int CW_BAR = 4096;
constexpr int CW_QKN = 8192;
constexpr int CW_QUEUE = 12288;
constexpr int CW_T0TAB = 16384;
constexpr int CW_CNT_KM = 24576, CW_CNT_Z = 24640, CW_CNT_KV = 24704;
constexpr int CW_PANEL = 32768, CW_TMO2 = 20480;

constexpr int RING_OFF = 0, RING_BYTES = 131072;
constexpr int LDSCTL_OFF = RING_BYTES, MISC_OFF = LDSCTL_OFF + 320;
constexpr int XL_OFF = RING_BYTES + 512;
constexpr int LDS_BYTES = 147456;
static_assert(XL_OFF + 8192 <= LDS_BYTES, "LDS map");

#define GAS __attribute__((address_space(1)))
#define LAS __attribute__((address_space(3)))
typedef unsigned short bf16;
typedef unsigned v4u __attribute__((ext_vector_type(4)));
typedef float f32x4 __attribute__((ext_vector_type(4)));
typedef GAS unsigned gu32;
#define RLX_AGENT __ATOMIC_RELAXED, __HIP_MEMORY_SCOPE_AGENT
#define LDS_WAIT() asm volatile("s_waitcnt lgkmcnt(0)" ::: "memory")
__device__ __forceinline__ unsigned f2bf(float f) { unsigned u = __builtin_bit_cast(unsigned, f); return (u + 0x7fffu + ((u >> 16) & 1u)) >> 16; }
__device__ __forceinline__ unsigned pk2(float lo, float hi) { unsigned r; asm("v_cvt_pk_bf16_f32 %0, %1, %2" : "=v"(r) : "v"(lo), "v"(hi)); return r; }
__device__ __forceinline__ float bf2f(unsigned b) { return __builtin_bit_cast(float, b << 16); }
__device__ __forceinline__ float bflo(unsigned w) { return __builtin_bit_cast(float, w << 16); }
__device__ __forceinline__ float bfhi(unsigned w) { return __builtin_bit_cast(float, w & 0xffff0000u); }

#define XB_TMO      128
#define XB_XCNT(j)  (256  + 64 * (j))
#define XB_XSUB(j)  (1280 + 64 * (j))
#define XB_XGEN(j)  (2304 + 64 * (j))
#define XB_TOP      3328
#define XB_TOPGEN   3392
#define XCD_BAR_WORDS 3456
#define XB_SPIN_CAP (1u << 18)

__device__ __forceinline__ unsigned xb_ld(unsigned* p)              { return __hip_atomic_load(p, __ATOMIC_RELAXED, __HIP_MEMORY_SCOPE_AGENT); }
__device__ __forceinline__ unsigned xb_add(unsigned* p, unsigned v) { return __hip_atomic_fetch_add(p, v, __ATOMIC_RELAXED, __HIP_MEMORY_SCOPE_AGENT); }
__device__ __forceinline__ unsigned xb_xcc_id() { return (unsigned)__builtin_amdgcn_s_getreg((3 << 11) | 20) & 0xFu; }
#define XB_SPIN(cond, bar) do { unsigned _sp = 0; while (cond) { __builtin_amdgcn_s_sleep(1); \
    if ((++_sp & 255u) == 0u) { if (xb_ld(&(bar)[XB_TMO])) break; if (_sp > XB_SPIN_CAP) { atomicAdd(&(bar)[XB_TMO], 1u); break; } } } } while (0)

struct XcdBarrier { unsigned* bar; unsigned x; volatile LAS unsigned* st; };

__device__ __forceinline__ XcdBarrier xcd_barrier_post(unsigned* bar, volatile LAS unsigned* st) {
    XcdBarrier b; b.bar = bar; b.x = xb_xcc_id(); b.st = st;
    if (threadIdx.x == 0) (void)xb_add(&bar[XB_XCNT(b.x)], 1u);
    return b;
}
__device__ __forceinline__ void xcd_barrier_complete(unsigned* bar, unsigned x, unsigned& nloc, unsigned& nx) {
    const unsigned G = gridDim.x * gridDim.y * gridDim.z;
    unsigned sum, cnt, mine, sp = 0u;
    for (;;) {
        sum = 0u; cnt = 0u; mine = 0u;
#pragma unroll
        for (unsigned j = 0; j < 16; ++j) { const unsigned c = xb_ld(&bar[XB_XCNT(j)]); sum += c; cnt += (c > 0u) ? 1u : 0u; mine = (j == x) ? c : mine; }
        if (sum == G) break;
        __builtin_amdgcn_s_sleep(1);
        if ((++sp & 255u) == 0u) { if (xb_ld(&bar[XB_TMO])) break; if (sp > XB_SPIN_CAP) { atomicAdd(&bar[XB_TMO], 1u); break; } }
    }
    nloc = mine > 0u ? mine : 1u; nx = cnt > 0u ? cnt : 1u;
}
__device__ __forceinline__ void xcd_barrier(const XcdBarrier& b) {
    asm volatile("s_waitcnt vmcnt(0)" ::: "memory");
    __syncthreads();
    if (threadIdx.x == 0) {
        unsigned* bar = b.bar;
        __builtin_amdgcn_s_waitcnt(0);
        unsigned nloc = b.st[0], nx = b.st[1];
        if (nloc == 0u) { xcd_barrier_complete(bar, b.x, nloc, nx); b.st[0] = nloc; b.st[1] = nx; }
        const unsigned old = xb_add(&bar[XB_XSUB(b.x)], 1u);
        const unsigned gen = old / nloc;
        if (old + 1u == (gen + 1u) * nloc) {
            __builtin_amdgcn_fence(__ATOMIC_RELEASE, "agent");
            asm volatile("s_waitcnt vmcnt(0)" ::: "memory");
            const unsigned og = xb_add(&bar[XB_TOP], 1u);
            const unsigned tg = og / nx;
            if (og + 1u == (tg + 1u) * nx) xb_add(&bar[XB_TOPGEN], 1u);
            else XB_SPIN(xb_ld(&bar[XB_TOPGEN]) == tg, bar);
            __builtin_amdgcn_fence(__ATOMIC_ACQUIRE, "agent");
            xb_add(&bar[XB_XGEN(b.x)], 1u);
            asm volatile("s_waitcnt vmcnt(0)" ::: "memory");
        } else {
            XB_SPIN(xb_ld(&bar[XB_XGEN(b.x)]) == gen, bar);
            __builtin_amdgcn_fence(__ATOMIC_ACQUIRE, "agent");
            asm volatile("s_waitcnt vmcnt(0)" ::: "memory");
        }
    }
    __syncthreads();
}

__device__ __forceinline__ float wave_sum(float v) {
#pragma unroll
    for (int o = 1; o < 64; o <<= 1) v += __shfl_xor(v, o);
    return v;
}
__device__ __forceinline__ void p0_transpose_item(const float* W, int ldw, int K, int N, bf16* WT, const float* kscale, bool remap, LAS float* scr, int item, int lane, float f8scale = 0.f, bool upmap = false) {
    const int nblk = N / 64, kb = item / nblk, nb = item % nblk, k0 = 32 * kb, n0 = 64 * nb;
    int sn0 = (remap && n0 >= 1536) ? n0 + 8 : n0;
    if (upmap) { const int within = n0 & 255, pt = n0 >> 8; sn0 = within < 128 ? 128 * pt + within : 2816 + 128 * pt + (within - 128); }
    float v[32];
#pragma unroll
    for (int i = 0; i < 32; ++i) v[i] = W[(size_t)(k0 + i) * ldw + sn0 + lane];
#pragma unroll
    for (int i = 0; i < 32; ++i) { float x = v[i]; if (kscale) x *= kscale[k0 + i]; scr[i * 65 + lane] = x; }
    LDS_WAIT(); asm volatile("" ::: "memory");
    const int kq = lane & 3;
#pragma unroll
    for (int j = 0; j < 4; ++j) { const int n = (lane >> 2) + 16 * j; const LAS float* sp = scr + (8 * kq) * 65 + n;
        if (f8scale != 0.f) { const unsigned lo = pg8::pk4_fp8(sp[0 * 65] * f8scale, sp[1 * 65] * f8scale, sp[2 * 65] * f8scale, sp[3 * 65] * f8scale), hi = pg8::pk4_fp8(sp[4 * 65] * f8scale, sp[5 * 65] * f8scale, sp[6 * 65] * f8scale, sp[7 * 65] * f8scale);
            *(GAS unsigned long long*)((unsigned char*)WT + (size_t)(n0 + n) * K + k0 + 8 * kq) = (unsigned long long)lo | ((unsigned long long)hi << 32); }
        else { v4u o; o.x = pk2(sp[0 * 65], sp[1 * 65]); o.y = pk2(sp[2 * 65], sp[3 * 65]); o.z = pk2(sp[4 * 65], sp[5 * 65]); o.w = pk2(sp[6 * 65], sp[7 * 65]);
            *(GAS v4u*)(WT + (size_t)(n0 + n) * K + k0 + 8 * kq) = o; } }
    LDS_WAIT(); asm volatile("" ::: "memory");
}

struct Args { const float* in[19]; float* out; unsigned char* ws; };
__device__ __forceinline__ float skip_thr(const unsigned* qk8, int moba) {
    const unsigned* p = qk8 + 4 * moba;
    const float qn = sqrtf(__uint_as_float(__hip_atomic_load(p, RLX_AGENT)) + __uint_as_float(__hip_atomic_load(p + 1, RLX_AGENT))), kn = sqrtf(__uint_as_float(__hip_atomic_load(p + 2, RLX_AGENT)) + __uint_as_float(__hip_atomic_load(p + 3, RLX_AGENT)));
    return 2.0f * qn * kn * 1.02f + 40.0f;
}
__device__ __forceinline__ bool moba_skip(int h, int j, int n, float thr) { return __builtin_amdgcn_exp2f(-(float)(h + 1)) * LOG2E * (float)(256 * (j - n - 1) + 1) >= thr; }

namespace attn_body {
using hb16=__hip_bfloat16;
using bf16x8=__attribute__((ext_vector_type(8)))short;
using s16x4=__attribute__((ext_vector_type(4)))short;
using f32x16=__attribute__((ext_vector_type(16)))float;
using u32x4=__attribute__((ext_vector_type(4)))unsigned;
constexpr int PITCH=3072;
constexpr int NW=8,QBLK=32,QB=QBLK*NW,KVBLK=64;
__device__ __forceinline__ int crow(int r,int hi){return (r&3)+8*(r>>2)+4*hi;}
#define SBAR() __builtin_amdgcn_sched_barrier(0)
__device__ __forceinline__ void cmask(f32x16&p0,f32x16&p1,int jb,int qrel,int hi){
  const float NEG=-INFINITY; int kb=64*jb+4*hi;
  #pragma unroll
  for(int r=0;r<16;++r){int kv=kb+(r&3)+8*(r>>2); if(kv>qrel)p0[r]=NEG; if(kv+32>qrel)p1[r]=NEG;}
}
constexpr int NSLOT=3, SLOTB=9216;
constexpr int LDS_K=0, LDS_V=NSLOT*SLOTB, LDS_WS=2*NSLOT*SLOTB, LDS_OST=LDS_WS+NW*64*4, LDS_BYTES=LDS_OST+NW*4096;
__device__ __forceinline__ void glds16(const void*gsrc,unsigned lds_dst){unsigned keep;
  asm volatile("s_mov_b32 %0, m0\n\ts_mov_b32 m0, %2\n\ts_nop 0\n\tglobal_load_lds_dwordx4 %1, off\n\ts_mov_b32 m0, %0":"=&s"(keep):"v"(gsrc),"s"(lds_dst):"memory");}
__device__ __forceinline__ void glds16x(const void*gsrc,unsigned lds_dst){unsigned keep;unsigned long long ex;
  asm volatile("s_mov_b32 %0, m0\n\ts_mov_b64 %1, exec\n\ts_mov_b64 exec, 0xff\n\ts_mov_b32 m0, %3\n\ts_nop 0\n\tglobal_load_lds_dwordx4 %2, off\n\ts_mov_b64 exec, %1\n\ts_mov_b32 m0, %0":"=&s"(keep),"=&s"(ex):"v"(gsrc),"s"(lds_dst):"memory");}
__device__ __forceinline__ float max3f(float a,float b,float c){float r;asm("v_max3_f32 %0, %1, %2, %3":"=v"(r):"v"(a),"v"(b),"v"(c));return r;}
__device__ __forceinline__ float max2f(float a,float b){float r;asm("v_max_f32_e32 %0, %1, %2":"=v"(r):"v"(a),"v"(b));return r;}
__device__ __forceinline__ float fsub_s(float a,float b){float r;asm("v_sub_f32_e32 %0, %1, %2":"=v"(r):"v"(a),"v"(b));return r;}
typedef float f32x2_t __attribute__((ext_vector_type(2))); typedef __bf16 bf16x2_t __attribute__((ext_vector_type(2)));
__device__ __forceinline__ unsigned cvtpk_s(float lo,float hi){f32x2_t v={lo,hi};bf16x2_t b=__builtin_convertvector(v,bf16x2_t);return __builtin_bit_cast(unsigned,b);}
__device__ __forceinline__ float rbf(float x){return __builtin_bit_cast(float,cvtpk_s(x,0.f)<<16);}
#define WAIT_BAR(N) asm volatile("s_waitcnt vmcnt(" #N ") lgkmcnt(0)\n\ts_barrier":::"memory")

__device__ __forceinline__ void qkt(f32x16&p0,f32x16&p1,const char*Kslot,const bf16x8*qr,int r32,int hi){
  const char*kb=Kslot+hi*1024+r32*16; const f32x16 zf={};
  #pragma unroll
  for(int d0=0;d0<4;++d0){
    const bf16x8 b0=*reinterpret_cast<const bf16x8*>(kb+d0*2048);
    const bf16x8 b1=*reinterpret_cast<const bf16x8*>(kb+d0*2048+512);
    if(d0==0){p0=__builtin_amdgcn_mfma_f32_32x32x16_bf16(b0,qr[0],zf,0,0,0);p1=__builtin_amdgcn_mfma_f32_32x32x16_bf16(b1,qr[0],zf,0,0,0);}
    else{p0=__builtin_amdgcn_mfma_f32_32x32x16_bf16(b0,qr[d0],p0,0,0,0);p1=__builtin_amdgcn_mfma_f32_32x32x16_bf16(b1,qr[d0],p1,0,0,0);}}
  const char*kx=Kslot+8192+r32*16;
  const bf16x8 x0=*reinterpret_cast<const bf16x8*>(kx), x1=*reinterpret_cast<const bf16x8*>(kx+512);
  p0=__builtin_amdgcn_mfma_f32_32x32x16_bf16(x0,qr[4],p0,0,0,0);p1=__builtin_amdgcn_mfma_f32_32x32x16_bf16(x1,qr[4],p1,0,0,0);
}
typedef __attribute__((address_space(3))) const char* lds_cptr;
typedef short v4i16_t __attribute__((ext_vector_type(4)));
__device__ __forceinline__ void kload10(bf16x8*kf,lds_cptr kp,lds_cptr kx){
  kf[0]=*(const __attribute__((address_space(3))) bf16x8*)(kp);      kf[1]=*(const __attribute__((address_space(3))) bf16x8*)(kp+512);
  kf[2]=*(const __attribute__((address_space(3))) bf16x8*)(kp+2048); kf[3]=*(const __attribute__((address_space(3))) bf16x8*)(kp+2560);
  kf[4]=*(const __attribute__((address_space(3))) bf16x8*)(kp+4096); kf[5]=*(const __attribute__((address_space(3))) bf16x8*)(kp+4608);
  kf[6]=*(const __attribute__((address_space(3))) bf16x8*)(kp+6144); kf[7]=*(const __attribute__((address_space(3))) bf16x8*)(kp+6656);
  kf[8]=*(const __attribute__((address_space(3))) bf16x8*)(kx);      kf[9]=*(const __attribute__((address_space(3))) bf16x8*)(kx+512);
}
__device__ __forceinline__ void kload2(bf16x8*kf,lds_cptr kp,int j){ kf[2*j]=*(const __attribute__((address_space(3))) bf16x8*)(kp+j*2048); kf[2*j+1]=*(const __attribute__((address_space(3))) bf16x8*)(kp+j*2048+512); }
__device__ __forceinline__ s16x4 vtr(lds_cptr p){ return __builtin_bit_cast(s16x4,__builtin_amdgcn_ds_read_tr16_b64_v4i16((__attribute__((address_space(3))) v4i16_t*)p)); }
__device__ __forceinline__ float rowmax(const f32x16&p0,const f32x16&p1){
  float a=max3f(p0[0],p0[1],p1[0]),b=max3f(p0[2],p0[3],p1[1]);a=max3f(a,p1[2],p1[3]);
  #pragma unroll
  for(int r=4;r<16;r+=4){a=max3f(a,p0[r],p0[r+1]);b=max3f(b,p0[r+2],p0[r+3]);a=max3f(a,p1[r],p1[r+1]);b=max3f(b,p1[r+2],p1[r+3]);}
  const float m=max2f(a,b);
  auto rr=__builtin_amdgcn_permlane32_swap(__float_as_uint(m),__float_as_uint(m),false,false);
  return max2f(__uint_as_float(rr[0]),__uint_as_float(rr[1]));
}
__device__ __forceinline__ void pv(f32x16*o,int vb,bf16x8 pa0,bf16x8 pa1,bf16x8 pa2,bf16x8 pa3){
  #pragma unroll
  for(int d0=0;d0<2;++d0){s16x4 lo[4],hi[4];
    #pragma unroll
    for(int ks=0;ks<4;++ks){
      asm volatile("ds_read_b64_tr_b16 %0,%1 offset:%c2":"=&v"(lo[ks]):"v"(vb),"i"(d0*4096+ks*1024):"memory");
      asm volatile("ds_read_b64_tr_b16 %0,%1 offset:%c2":"=&v"(hi[ks]):"v"(vb),"i"(d0*4096+ks*1024+512):"memory");}
    asm volatile("s_waitcnt lgkmcnt(0)":::"memory");SBAR();
    #define PK(k) (bf16x8){lo[k][0],lo[k][1],lo[k][2],lo[k][3],hi[k][0],hi[k][1],hi[k][2],hi[k][3]}
    o[d0]=__builtin_amdgcn_mfma_f32_32x32x16_bf16(pa0,PK(0),o[d0],0,0,0);
    o[d0]=__builtin_amdgcn_mfma_f32_32x32x16_bf16(pa1,PK(1),o[d0],0,0,0);
    o[d0]=__builtin_amdgcn_mfma_f32_32x32x16_bf16(pa2,PK(2),o[d0],0,0,0);
    o[d0]=__builtin_amdgcn_mfma_f32_32x32x16_bf16(pa3,PK(3),o[d0],0,0,0);
    #undef PK
  }
}

template<int THRL> __device__ __forceinline__ void attn_unit(char*shm,const int KIND,const hb16*Qc,int qrow,int oslot,const hb16*__restrict__ Kt0,const hb16*__restrict__ Vt0,const hb16*__restrict__ KXt0,int NT,int band0,hb16*Oc,hb16*PO,float*PML){
  const int tid=threadIdx.x,lane=tid&63,r32=lane&31,hi=lane>>5; const int wid=__builtin_amdgcn_readfirstlane(tid>>6);
  const unsigned lds0=(unsigned)(uintptr_t)shm;
  float*wsf=(float*)(shm+LDS_WS)+wid*64;
  const hb16*ksrc=Kt0+(long)lane*PITCH+wid*8;
  const hb16*vsrc=Vt0+(long)(16*(wid&3)+(lane>>2))*PITCH+(wid>>2)*32+(lane&3)*8;
  const hb16*xsrc=KXt0+(long)(8*wid+(lane&7))*8;
  const unsigned kdst=lds0+LDS_K+wid*1024, vdst=lds0+LDS_V+wid*1024, xdst=lds0+LDS_K+8192+wid*128;
  #define DMA_K(t,slot) do{ glds16(ksrc+(long)(t)*KVBLK*PITCH,(unsigned)__builtin_amdgcn_readfirstlane(kdst+(slot))); glds16x(xsrc+(long)(t)*KVBLK*8,(unsigned)__builtin_amdgcn_readfirstlane(xdst+(slot))); }while(0)
  #define DMA_V(t,slot) glds16(vsrc+(long)(t)*KVBLK*PITCH,(unsigned)__builtin_amdgcn_readfirstlane(vdst+(slot)))
  const int vb0=(int)(lds0+LDS_V)+((lane>>4)&1)*32+(lane&3)*8+(4*hi+((lane&15)>>2))*64;
  const char*Kbase=shm+LDS_K; bf16x8 kf[10];
  const lds_cptr shm3=(lds_cptr)shm; const lds_cptr kp0=shm3+LDS_K+hi*1024+r32*16; const lds_cptr kx0=shm3+LDS_K+8192+r32*16; const lds_cptr vp0=shm3+LDS_V+((lane>>4)&1)*32+(lane&3)*8+(4*hi+((lane&15)>>2))*64;
  DMA_K(0,0);DMA_V(0,0);DMA_K(1,SLOTB);
  bf16x8 qr[5];
  { const hb16*Qw=Qc+(long)qrow*PITCH;
    #pragma unroll
    for(int d0=0;d0<4;++d0)qr[d0]=*reinterpret_cast<const bf16x8*>(&Qw[d0*16+hi*8]); }
  float mhat=0.f,l_reg=0.f;f32x16 o[2];o[0]=f32x16{};o[1]=f32x16{};
  #define SETQX(mh_,ml_) do{ const unsigned bh_=cvtpk_s(-(mh_),-(ml_)); u32x4 qx_; qx_.x=0x3F803F80u; qx_.y=0x3F80u|(bh_<<16); qx_.z=(bh_>>16); qx_.w=0u; if(hi){qx_.x=0u;qx_.y=0u;qx_.z=0u;} qr[4]=__builtin_bit_cast(bf16x8,qx_); asm volatile("":"+v"(qr[4])); }while(0)
  #define MOVEREF(gain) const float mraw_=mhat+(gain); const float mh_=rbf(mraw_); const float ml_=rbf(mraw_-mh_); const float mnew_=mh_+ml_; const float dl=mnew_-mhat; mhat=mnew_; SETQX(mh_,ml_);
  SETQX(0.f,0.f);
  const int qrel=wid*QBLK+r32;
  #define CMASK(P0,P1,t) do{int jb_=(t)-band0; if(jb_>=0)cmask(P0,P1,jb_,qrel,hi);}while(0)
  bool resc=false;
  #define START(P0,P1) do{ const float rm=rowmax(P0,P1); resc=false; \
    { MOVEREF(rm) \
      _Pragma("unroll") for(int r=0;r<16;++r){P0[r]=fsub_s(P0[r],dl);P1[r]=fsub_s(P1[r],dl);} } \
    _Pragma("unroll") for(int r=0;r<16;++r)P0[r]=__builtin_amdgcn_exp2f(P0[r]); }while(0)
  #define RESC() do{ if(resc){ asm volatile("s_waitcnt lgkmcnt(0)":::"memory"); \
      _Pragma("unroll") for(int d_=0;d_<2;++d_) _Pragma("unroll") for(int r=0;r<16;++r)o[d_][r]*=wsf[crow(r,hi)]; } }while(0)
  f32x16 pA0,pA1,pB0,pB1;
  int sl_prev=0,sl_cur=0,sl_next=SLOTB;
  #define ROT() do{sl_prev=sl_cur;sl_cur=sl_next;sl_next=(sl_next==(NSLOT-1)*SLOTB)?0:sl_next+SLOTB;}while(0)
  DMA_K(2,2*SLOTB);
  WAIT_BAR(5);
  qkt(pA0,pA1,Kbase,qr,r32,hi);asm volatile("s_nop 15\n\ts_nop 7":"+v"(pA0),"+v"(pA1));CMASK(pA0,pA1,0);
  START(pA0,pA1);
  _Pragma("unroll") for(int r=0;r<16;++r)pA1[r]=__builtin_amdgcn_exp2f(pA1[r]);
  WAIT_BAR(0);
  DMA_K(3,0);DMA_V(1,SLOTB);
  ROT();
  kload10(kf,kp0+sl_cur,kx0+sl_cur);
  WAIT_BAR(3);
  s16x4 vlo[8],vhi[8]; u32x4 pw0,pw1,pw2,pw3; const f32x16 zf={};
  #define PKW(P,B) cvtpk_s(P[B],P[B+1])
  #define PAF(k) __builtin_bit_cast(bf16x8,pw##k)
  #define VFR(i) (bf16x8){vlo[i][0],vlo[i][1],vlo[i][2],vlo[i][3],vhi[i][0],vhi[i][1],vhi[i][2],vhi[i][3]}
  #define PIN(x) asm volatile("":"+v"(x))
  #define MX3(a,b,c) __builtin_fmaxf(__builtin_fmaxf((a),(b)),(c))
  #define GAPA(MF,A0,A1,A2,A3,W0,W1,PW) do{ MF; sacc+=A0; sacc+=A1; sacc+=A2; sacc+=A3; PIN(sacc); W0; W1; PIN(PW); SBAR(); }while(0)
  #define EX(v) __builtin_amdgcn_exp2f(v)
  #define GAPB(MF,X,B) do{ MF; X[B]=EX(X[B]); X[B+1]=EX(X[B+1]); X[B+2]=EX(X[B+2]); X[B+3]=EX(X[B+3]); PIN(X); SBAR(); }while(0)
  #define VRD(i) do{ vlo[i]=vtr(vp_+(((i)>>2)*4096+((i)&3)*1024)); vhi[i]=vtr(vp_+(((i)>>2)*4096+((i)&3)*1024+512)); }while(0)
  #define KRD(G,j) do{ if(G){ kload2(kf,kp0+sl_next,j); SBAR(); } }while(0)
  #define KRDX(G) do{ if(G){ kf[8]=*(const __attribute__((address_space(3))) bf16x8*)(kx0+sl_next); kf[9]=*(const __attribute__((address_space(3))) bf16x8*)(kx0+sl_next+512); SBAR(); } }while(0)
  #define STEP(C0,C1,P0,P1,t,GK,GV,GL) do{ SBAR(); \
    const lds_cptr vp_=vp0+sl_prev; \
    VRD(0); SBAR(); float sacc=(P0[0]+P0[1]); \
    GAPA(C0=__builtin_amdgcn_mfma_f32_32x32x16_bf16(kf[0],qr[0],zf,0,0,0), P0[2],P0[3],P0[4],P0[5],     pw0[0]=PKW(P0,0), pw0[1]=PKW(P0,2), pw0); \
    VRD(4); SBAR(); GAPA(C1=__builtin_amdgcn_mfma_f32_32x32x16_bf16(kf[1],qr[0],zf,0,0,0), P0[6],P0[7],P0[8],P0[9],     pw0[2]=PKW(P0,4), pw0[3]=PKW(P0,6), pw0); \
    VRD(1); SBAR(); GAPA(C0=__builtin_amdgcn_mfma_f32_32x32x16_bf16(kf[2],qr[1],C0,0,0,0),   P0[10],P0[11],P0[12],P0[13], pw1[0]=PKW(P0,8), pw1[1]=PKW(P0,10), pw1); \
    VRD(5); SBAR(); GAPA(C1=__builtin_amdgcn_mfma_f32_32x32x16_bf16(kf[3],qr[1],C1,0,0,0),   P0[14],P0[15],P1[0],P1[1],   pw1[2]=PKW(P0,12),pw1[3]=PKW(P0,14), pw1); \
    VRD(2); SBAR(); GAPA(C0=__builtin_amdgcn_mfma_f32_32x32x16_bf16(kf[4],qr[2],C0,0,0,0),   P1[2],P1[3],P1[4],P1[5],     pw2[0]=PKW(P1,0), pw2[1]=PKW(P1,2), pw2); \
    VRD(6); SBAR(); GAPA(C1=__builtin_amdgcn_mfma_f32_32x32x16_bf16(kf[5],qr[2],C1,0,0,0),   P1[6],P1[7],P1[8],P1[9],     pw2[2]=PKW(P1,4), pw2[3]=PKW(P1,6), pw2); \
    VRD(3); SBAR(); GAPA(C0=__builtin_amdgcn_mfma_f32_32x32x16_bf16(kf[6],qr[3],C0,0,0,0),   P1[10],P1[11],P1[12],P1[13], pw3[0]=PKW(P1,8), pw3[1]=PKW(P1,10), pw3); \
    VRD(7); SBAR(); GAPA(C1=__builtin_amdgcn_mfma_f32_32x32x16_bf16(kf[7],qr[3],C1,0,0,0),   P1[14],P1[15],0.f,0.f,       pw3[2]=PKW(P1,12),pw3[3]=PKW(P1,14), pw3); \
    C0=__builtin_amdgcn_mfma_f32_32x32x16_bf16(kf[8],qr[4],C0,0,0,0); SBAR(); \
    C1=__builtin_amdgcn_mfma_f32_32x32x16_bf16(kf[9],qr[4],C1,0,0,0); SBAR(); \
    l_reg+=sacc; \
    if(GK){DMA_K((t)+3,sl_cur);} if(GV){DMA_V((t)+1,sl_next);} \
    CMASK(C0,C1,t); \
    { float a=MX3(C0[0],C0[1],C1[0]),b=MX3(C0[2],C0[3],C1[1]); a=MX3(a,C1[2],C1[3]); \
      _Pragma("unroll") for(int r=4;r<16;r+=4){a=MX3(a,C0[r],C0[r+1]);b=MX3(b,C0[r+2],C0[r+3]);a=MX3(a,C1[r],C1[r+1]);b=MX3(b,C1[r+2],C1[r+3]);} \
      float rm=__builtin_fmaxf(a,b); { auto rr=__builtin_amdgcn_permlane32_swap(__float_as_uint(rm),__float_as_uint(rm),false,false); rm=__builtin_fmaxf(__uint_as_float(rr[0]),__uint_as_float(rr[1])); } \
      resc=false; \
      if(__builtin_expect(__any(rm>(float)THRL),0)){ MOVEREF(__builtin_fmaxf(rm,0.f)) \
        _Pragma("unroll") for(int r=0;r<16;++r){C0[r]-=dl;C1[r]-=dl;} \
        const float f=__builtin_amdgcn_exp2f(-dl); l_reg*=f; if(hi==0)wsf[r32]=f; resc=true; } } \
    SBAR(); \
    GAPB(o[0]=__builtin_amdgcn_mfma_f32_32x32x16_bf16(PAF(0),VFR(0),o[0],0,0,0), C0,0); \
    GAPB(o[1]=__builtin_amdgcn_mfma_f32_32x32x16_bf16(PAF(0),VFR(4),o[1],0,0,0), C0,4); \
    KRD(GL,0); GAPB(o[0]=__builtin_amdgcn_mfma_f32_32x32x16_bf16(PAF(1),VFR(1),o[0],0,0,0), C0,8); \
    KRD(GL,1); GAPB(o[1]=__builtin_amdgcn_mfma_f32_32x32x16_bf16(PAF(1),VFR(5),o[1],0,0,0), C0,12); \
    KRD(GL,2); GAPB(o[0]=__builtin_amdgcn_mfma_f32_32x32x16_bf16(PAF(2),VFR(2),o[0],0,0,0), C1,0); \
    KRD(GL,3); GAPB(o[1]=__builtin_amdgcn_mfma_f32_32x32x16_bf16(PAF(2),VFR(6),o[1],0,0,0), C1,4); \
    KRDX(GL); GAPB(o[0]=__builtin_amdgcn_mfma_f32_32x32x16_bf16(PAF(3),VFR(3),o[0],0,0,0), C1,8); \
    GAPB(o[1]=__builtin_amdgcn_mfma_f32_32x32x16_bf16(PAF(3),VFR(7),o[1],0,0,0), C1,12); \
    }while(0)
  int t=1;
  for(;t+5<NT&&t+1<band0;t+=2){
    #undef CMASK
    #define CMASK(P0,P1,t) do{}while(0)
    STEP(pB0,pB1,pA0,pA1,t,true,true,true);     WAIT_BAR(3); RESC(); ROT();
    STEP(pA0,pA1,pB0,pB1,t+1,true,true,true);   WAIT_BAR(3); RESC(); ROT();
  }
  #undef CMASK
  #define CMASK(P0,P1,t) do{int jb_=(t)-band0; if(jb_>=0)cmask(P0,P1,jb_,qrel,hi);}while(0)
  #define ENDW(tt) do{ if((tt)+3<NT){WAIT_BAR(3);} else if((tt)+2<NT){WAIT_BAR(1);} else {WAIT_BAR(0);} }while(0)
  for(;t+1<NT;t+=2){
    STEP(pB0,pB1,pA0,pA1,t,(t+3<NT),(t+1<NT),(t+1<NT));       ENDW(t);   RESC(); ROT();
    STEP(pA0,pA1,pB0,pB1,t+1,(t+4<NT),(t+2<NT),(t+2<NT));     ENDW(t+1); RESC(); ROT();
  }
  STEP(pB0,pB1,pA0,pA1,NT-1,false,false,false); RESC();
  { float sacc=pB0[0]+pB0[1]; _Pragma("unroll") for(int r=2;r<16;++r)sacc+=pB0[r]; _Pragma("unroll") for(int r=0;r<16;++r)sacc+=pB1[r]; l_reg+=sacc;
    pw0=(u32x4){PKW(pB0,0),PKW(pB0,2),PKW(pB0,4),PKW(pB0,6)};pw1=(u32x4){PKW(pB0,8),PKW(pB0,10),PKW(pB0,12),PKW(pB0,14)};pw2=(u32x4){PKW(pB1,0),PKW(pB1,2),PKW(pB1,4),PKW(pB1,6)};pw3=(u32x4){PKW(pB1,8),PKW(pB1,10),PKW(pB1,12),PKW(pB1,14)};
    SBAR(); pv(o,vb0+sl_cur,PAF(0),PAF(1),PAF(2),PAF(3)); }
  #undef PKW
  #undef PAF
  #undef VFR
  #undef PIN
  #undef MX3
  #undef GAPA
  #undef GAPB
  #undef EX
  #undef VRD
  #undef KRD
  #undef KRDX
  #undef STEP
  #undef ENDW
  {auto rr=__builtin_amdgcn_permlane32_swap(__float_as_uint(l_reg),__float_as_uint(l_reg),false,false);l_reg=__uint_as_float(rr[0])+__uint_as_float(rr[1]);}
  if(hi==0)wsf[32+r32]=l_reg;asm volatile("s_waitcnt lgkmcnt(0)":::"memory");
  float rli[16];
  #pragma unroll
  for(int r=0;r<16;++r)rli[r]=__builtin_amdgcn_rcpf(wsf[32+crow(r,hi)]);
  if(KIND==1){ if(hi==0&&oslot>=0){ f32x2_t ml={mhat,l_reg}; *(f32x2_t*)(PML+(long)oslot*2)=ml; } }
  { hb16*stg=(hb16*)(shm+LDS_OST)+wid*2048;
    #pragma unroll
    for(int r=0;r<16;++r){const int orow=crow(r,hi);
      #pragma unroll
      for(int d0=0;d0<2;++d0)stg[orow*64+d0*32+r32]=__float2bfloat16(o[d0][r]*rli[r]);}
    asm volatile("s_waitcnt lgkmcnt(0)":::"memory");
    #pragma unroll
    for(int i=0;i<4;++i){const int row=i*8+(lane>>3),ch=lane&7; const u32x4 v=*(const u32x4*)(stg+row*64+ch*8);
      if(KIND==0){ const int gr=__shfl(qrow,row); *(u32x4*)(Oc+(long)gr*PITCH+ch*8)=v; }
      else { const int gs=__shfl(oslot,row); if(gs>=0) *(u32x4*)(PO+(long)gs*64+ch*8)=v; } } }
  asm volatile("s_waitcnt lgkmcnt(0)\n\ts_barrier":::"memory");
  #undef DMA_K
  #undef DMA_V
  #undef CMASK
  #undef START
  #undef RESC
  #undef ROT
  #undef SETQX
  #undef MOVEREF
}
constexpr int MB_K=0, MB_V=4*SLOTB, MB_WS=MB_V+4*8192, MB_OST=MB_WS+NW*64*4, MB_BYTES=MB_OST+NW*4096;
template<int THRL> __device__ __forceinline__ void moba_item(char*shm,const hb16*Qc,const int browbase,const int h,const int nblk,const unsigned*lst,const int cnt,const int g0,const int g1,
    const hb16*Kt0,const hb16*KXt0,hb16*PO,float*PML){
  const int tid=threadIdx.x,lane=tid&63,r32=lane&31,hi=lane>>5; const int wid=__builtin_amdgcn_readfirstlane(tid>>6);
  const unsigned lds0=(unsigned)(uintptr_t)shm;
  float*wsf=(float*)(shm+MB_WS)+wid*64;
  asm volatile("s_waitcnt lgkmcnt(0)\n\ts_barrier":::"memory");
  { const hb16*ksrc=Kt0+(long)lane*PITCH+wid*8; const hb16*vsrc=Kt0+512+(long)(16*(wid&3)+(lane>>2))*PITCH+(wid>>2)*32+(lane&3)*8; const hb16*xsrc=KXt0+(long)(8*wid+(lane&7))*8;
    #pragma unroll
    for(int t=0;t<4;++t){ glds16(ksrc+(long)t*KVBLK*PITCH,(unsigned)__builtin_amdgcn_readfirstlane(lds0+MB_K+t*SLOTB+wid*1024)); glds16x(xsrc+(long)t*KVBLK*8,(unsigned)__builtin_amdgcn_readfirstlane(lds0+MB_K+t*SLOTB+8192+wid*128));
      glds16(vsrc+(long)t*KVBLK*PITCH,(unsigned)__builtin_amdgcn_readfirstlane(lds0+MB_V+t*8192+wid*1024)); } }
  asm volatile("s_waitcnt vmcnt(0)\n\ts_barrier":::"memory");
  const int vb0=(int)(lds0+MB_V)+((lane>>4)&1)*32+(lane&3)*8+(4*hi+((lane&15)>>2))*64;
  #define SETQX(mh_,ml_) do{ const unsigned bh_=cvtpk_s(-(mh_),-(ml_)); u32x4 qx_; qx_.x=0x3F803F80u; qx_.y=0x3F80u|(bh_<<16); qx_.z=(bh_>>16); qx_.w=0u; if(hi){qx_.x=0u;qx_.y=0u;qx_.z=0u;} qr[4]=__builtin_bit_cast(bf16x8,qx_); asm volatile("":"+v"(qr[4])); }while(0)
  #define MOVEREF(gain) const float mraw_=mhat+(gain); const float mh_=rbf(mraw_); const float ml_=rbf(mraw_-mh_); const float mnew_=mh_+ml_; const float dl=mnew_-mhat; mhat=mnew_; SETQX(mh_,ml_);
  #define LENT(gg) (((gg)>=8&&(gg)<g1)?lst[((gg)-8)*32+r32]:0u)
  #define GROW(gg,ee) (((gg)<8)?(browbase+nblk*256+(gg)*32+r32):(browbase+(int)((ee)&0x1fffu)))
  unsigned e_cur=LENT(g0+wid), e_nxt=LENT(g0+wid+NW);
  bf16x8 qn[4];
  { const hb16*Qw=Qc+(long)GROW(g0+wid,e_cur)*PITCH;
    #pragma unroll
    for(int d0=0;d0<4;++d0)qn[d0]=*reinterpret_cast<const bf16x8*>(&Qw[d0*16+hi*8]); }
  for(int g=g0+wid;g<g1;g+=NW){
    const bool own=g<8; const int qrow=GROW(g,e_cur); int oslot;
    if(own) oslot=(qrow*8+h)*4+3; else oslot=((g-8)*32+r32<cnt)?(qrow*8+h)*4+(int)((e_cur>>16)&3u):-1;
    bf16x8 qr[5];
    #pragma unroll
    for(int d0=0;d0<4;++d0)qr[d0]=qn[d0];
    { const int gn=(g+NW<g1)?g+NW:g; const unsigned en=(g+NW<g1)?e_nxt:e_cur; const hb16*Qw=Qc+(long)GROW(gn,en)*PITCH;
      #pragma unroll
      for(int d0=0;d0<4;++d0)qn[d0]=*reinterpret_cast<const bf16x8*>(&Qw[d0*16+hi*8]); }
    const unsigned e_n2=LENT(g+2*NW); e_cur=e_nxt; e_nxt=e_n2;
    float mhat=0.f,l_reg=0.f;f32x16 o[2];o[0]=f32x16{};o[1]=f32x16{};
    SETQX(0.f,0.f);
    const int tlast=own?((32*g+31)>>6):3;
    #define PKW(P,B) cvtpk_s(P[B],P[B+1])
    #define PROC(P0,P1,T_,ISFIRST,MREF_) do{ \
      if(own&&64*(T_)+63>32*g)cmask(P0,P1,(T_),32*g+r32,hi);   \
      const float adj_=mhat-(MREF_); const float rm=rowmax(P0,P1)-adj_; float sub_=adj_; \
      if(ISFIRST){ MOVEREF(rm) sub_+=dl; } \
      else if(__any(rm>(float)THRL)){ MOVEREF(__builtin_fmaxf(rm,0.f)) sub_+=dl; \
        const float f=__builtin_amdgcn_exp2f(-dl); l_reg*=f; if(hi==0)wsf[r32]=f; asm volatile("s_waitcnt lgkmcnt(0)":::"memory"); \
        _Pragma("unroll") for(int d_=0;d_<2;++d_) _Pragma("unroll") for(int r=0;r<16;++r)o[d_][r]*=wsf[crow(r,hi)]; } \
      float sacc=0.f; \
      _Pragma("unroll") for(int r=0;r<16;++r){P0[r]=__builtin_amdgcn_exp2f(P0[r]-sub_);P1[r]=__builtin_amdgcn_exp2f(P1[r]-sub_);sacc+=P0[r]+P1[r];} \
      l_reg+=sacc; \
      const u32x4 pw0=(u32x4){PKW(P0,0),PKW(P0,2),PKW(P0,4),PKW(P0,6)},pw1=(u32x4){PKW(P0,8),PKW(P0,10),PKW(P0,12),PKW(P0,14)},pw2=(u32x4){PKW(P1,0),PKW(P1,2),PKW(P1,4),PKW(P1,6)},pw3=(u32x4){PKW(P1,8),PKW(P1,10),PKW(P1,12),PKW(P1,14)}; \
      pv(o,vb0+(T_)*8192,__builtin_bit_cast(bf16x8,pw0),__builtin_bit_cast(bf16x8,pw1),__builtin_bit_cast(bf16x8,pw2),__builtin_bit_cast(bf16x8,pw3)); }while(0)
    int t=0;
    for(;t+1<=tlast;t+=2){
      f32x16 a0,a1,b0,b1; const float mref=mhat;
      qkt(a0,a1,shm+MB_K+t*SLOTB,qr,r32,hi); qkt(b0,b1,shm+MB_K+(t+1)*SLOTB,qr,r32,hi);
      asm volatile("s_nop 15\n\ts_nop 7":"+v"(a0),"+v"(a1));
      PROC(a0,a1,t,t==0,mref);
      asm volatile("s_nop 7":"+v"(b0),"+v"(b1));
      PROC(b0,b1,t+1,false,mref);
    }
    if(t<=tlast){ f32x16 a0,a1; const float mref=mhat;
      qkt(a0,a1,shm+MB_K+t*SLOTB,qr,r32,hi); asm volatile("s_nop 15\n\ts_nop 7":"+v"(a0),"+v"(a1));
      PROC(a0,a1,t,t==0,mref); }
    #undef PROC
    #undef PKW
    {auto rr=__builtin_amdgcn_permlane32_swap(__float_as_uint(l_reg),__float_as_uint(l_reg),false,false);l_reg=__uint_as_float(rr[0])+__uint_as_float(rr[1]);}
    if(hi==0)wsf[32+r32]=l_reg;asm volatile("s_waitcnt lgkmcnt(0)":::"memory");
    float rli[16];
    #pragma unroll
    for(int r=0;r<16;++r)rli[r]=__builtin_amdgcn_rcpf(wsf[32+crow(r,hi)]);
    if(hi==0&&oslot>=0){ f32x2_t ml={mhat,l_reg}; *(f32x2_t*)(PML+(long)oslot*2)=ml; }
    { hb16*stg=(hb16*)(shm+MB_OST)+wid*2048;
      #pragma unroll
      for(int r=0;r<16;++r){const int orow=crow(r,hi);
        #pragma unroll
        for(int d0=0;d0<2;++d0)stg[orow*64+d0*32+r32]=__float2bfloat16(o[d0][r]*rli[r]);}
      asm volatile("s_waitcnt lgkmcnt(0)":::"memory");
      #pragma unroll
      for(int i=0;i<4;++i){const int row=i*8+(lane>>3),ch=lane&7; const u32x4 v=*(const u32x4*)(stg+row*64+ch*8);
        const int gs=__shfl(oslot,row); if(gs>=0) *(u32x4*)(PO+(long)gs*64+ch*8)=v; }
      asm volatile("s_waitcnt lgkmcnt(0)":::"memory"); }
  }
  #undef SETQX
  #undef MOVEREF
  #undef LENT
  #undef GROW
}
constexpr int ATTN_LDS_BYTES=(LDS_BYTES>MB_BYTES?LDS_BYTES:MB_BYTES);
#undef SBAR
#undef WAIT_BAR
}

struct WqkOrder {
    int G, c;
    __device__ __forceinline__ bool next(int i, pg8::Unit& u) const { const int L = i * G + c; if (L >= 128) return false; const int z = L >> 2, pn = L & 3, b = z >> 2, h = z & 3;
        u.skipb1 = 0; u.pm = b * 4 + h; u.pn = pn; u.aoff = ((size_t)(b * 256) * 2048 + h * 256) * 2; u.boff = ((size_t)(pn * 256) * 1024 + h * 256) * 2; return true; }
};
struct VwoOrder {
    int G, c;
    __device__ __forceinline__ bool next(int i, pg8::Unit& u) const { const int L = i * G + c; if (L >= 128) return false; const int z = L >> 2, pmq = L & 3, b = z >> 2, h = z & 3;
        u.skipb1 = 0; u.pm = b * 4 + pmq; u.pn = h; u.aoff = ((size_t)(pmq * 256) * 1024 + h * 256) * 2; u.boff = ((size_t)(b * 256) * 2048 + 1024 + h * 256) * 2; return true; }
};

#define DECL_PTRS const __attribute__((address_space(4))) Args* KA_; { auto p_ = __builtin_amdgcn_kernarg_segment_ptr(); asm volatile("" : "+s"(p_)); KA_ = (const __attribute__((address_space(4))) Args*)p_; } \
    int tidp_ = threadIdx.x; asm volatile("" : "+v"(tidp_)); const int tid = tidp_, lane = tid & 63; (void)lane; \
    unsigned char* ws = KA_->ws; gu32* ctl = (gu32*)(ws + WS_CTL); const float* x = KA_->in[0]; const float* mem = KA_->in[1]; const float* g_mix = KA_->in[2]; const float* w_in = KA_->in[3]; const float* b_forget = KA_->in[4]; const float* g_fox = KA_->in[5]; const float* g_moba = KA_->in[6]; const float* w_out = KA_->in[7]; const float* g_cross = KA_->in[8]; const float* g_mem = KA_->in[9]; const float* w_q_mem = KA_->in[10]; const float* w_kv_mem = KA_->in[11]; const float* w_o_mem = KA_->in[12]; const float* g_ffn = KA_->in[13]; const float* w_up = KA_->in[14]; const float* conv_w = KA_->in[15]; const float* conv_b = KA_->in[16]; const float* w_down = KA_->in[17]; const float* g_final = KA_->in[18]; float* out = KA_->out; float* LOGF = (float*)(ws + WS_LOGF); float* CC = (float*)(ws + WS_C); float* ABAR = (float*)(ws + WS_ABAR); float* KM = (float*)(ws + WS_KM); unsigned* SEL = (unsigned*)(ws + WS_SEL); float* SSQ1 = (float*)(ws + WS_SSQ1); float* SSQ2 = (float*)(ws + WS_SSQ2); float* SSQ3 = (float*)(ws + WS_SSQ3); bf16* MEMN = (bf16*)(ws + WS_MEMN); bf16* KV = (bf16*)(ws + WS_KV); bf16* WQS = (bf16*)(ws + WS_WQS); bf16* WOT = (bf16*)(ws + WS_WOT); bf16* WKVT = (bf16*)(ws + WS_WKVT); bf16* WINT = (bf16*)(ws + WS_WINT); bf16* WOUTT = (bf16*)(ws + WS_WOUTT); bf16* WUPT = (bf16*)(ws + WS_WUPT); unsigned char* WDT = ws + WS_WDT; unsigned char* ACT8 = ws + WS_ACT8; float* GHB = (float*)(ws + WS_GH); float* UHB = (float*)(ws + WS_UH); float* GTB = (float*)(ws + WS_GT); bf16* ZT = (bf16*)(ws + WS_ZT); bf16* WQK = (bf16*)(ws + WS_WQK); bf16* VWO = (bf16*)(ws + WS_VWO); bf16* A1 = (bf16*)(ws + WS_A1); bf16* QKV = (bf16*)(ws + WS_QKV); bf16* Y = (bf16*)(ws + WS_Y); bf16* HB1 = (bf16*)(ws + WS_HB1); bf16* PB = (bf16*)(ws + WS_P); bf16* HB2 = (bf16*)(ws + WS_HB2); bf16* GB = (bf16*)(ws + WS_G); bf16* UB = (bf16*)(ws + WS_U); bf16* PO = (bf16*)(ws + WS_PO); unsigned* LIST = (unsigned*)(ws + WS_LIST); float* PML = (float*)(ws + WS_PML); bf16* KXF = (bf16*)(ws + WS_KXF); bf16* KXM = (bf16*)(ws + WS_KXM); unsigned* CNT = (unsigned*)(ws + WS_CNT);
__global__ void __launch_bounds__(NWAVES * 64, 2) fwd(Args args) {
    extern __shared__ __attribute__((aligned(16))) unsigned char lds[];
    LAS unsigned char* L = (LAS unsigned char*)lds;
    LAS unsigned char* XL = L + XL_OFF;
    volatile LAS unsigned* MISC = (volatile LAS unsigned*)(L + MISC_OFF);
    const int tid = threadIdx.x, lane = tid & 63, wave = __builtin_amdgcn_readfirstlane(tid >> 6);
    const int G = gridDim.x, bx = blockIdx.x;
    const int gw = bx * NWAVES + wave, NGW = G * NWAVES;
    for (int u = tid; u < (LDS_BYTES - LDSCTL_OFF) / 4; u += NWAVES * 64) ((LAS unsigned*)(L + LDSCTL_OFF))[u] = 0u;
    __syncthreads();
    XcdBarrier bar; { DECL_PTRS; bar = xcd_barrier_post((unsigned*)(ctl + CW_BAR), MISC + 8); }

    { DECL_PTRS;
        LAS float* scr = (LAS float*)(L + RING_OFF + wave * 16384);
        constexpr int I_IN = (D / 32) * (NQKV / 64), I_OUT = (D / 32) * (D / 64), I_KV = (D / 32) * (2048 / 64), I_O = I_OUT, I_UP = (D / 32) * (2 * FF / 64), I_DN = (FF / 32) * (D / 64);
        constexpr int NITEMS = I_IN + I_OUT + I_KV + I_O + I_UP + I_DN;
        for (int it = gw; it < NITEMS; it += NGW) {
            int r = it;
            if (r < I_IN) { p0_transpose_item(w_in, INC, D, NQKV, WINT, nullptr, true, scr, r, lane); continue; } r -= I_IN;
            if (r < I_OUT) { p0_transpose_item(w_out, D, D, D, WOUTT, nullptr, false, scr, r, lane); continue; } r -= I_OUT;
            if (r < I_KV) { p0_transpose_item(w_kv_mem, 2048, D, 2048, WKVT, nullptr, false, scr, r, lane); continue; } r -= I_KV;
            if (r < I_O) { p0_transpose_item(w_o_mem, D, D, D, WOT, nullptr, false, scr, r, lane); continue; } r -= I_O;
            if (r < I_UP) { p0_transpose_item(w_up, 2 * FF, D, 2 * FF, WUPT, g_ffn, false, scr, r, lane, 0.f, true); continue; } r -= I_UP;
            p0_transpose_item(w_down, D, FF, D, (bf16*)WDT, nullptr, false, scr, r, lane, 64.0f);
        }
        for (int i = bx * 512 + tid; i < D * D / 4; i += G * 512) { const int kk = (i * 4) >> 10; const f32x4 v = *(const f32x4*)(w_q_mem + (size_t)i * 4) * (g_cross[kk] * (LOG2E / 16.0f));
            *(unsigned long long*)(WQS + (size_t)i * 4) = (unsigned long long)pk2(v[0], v[1]) | ((unsigned long long)pk2(v[2], v[3]) << 32); }
        for (int r = gw; r < NB * 256; r += NGW) { const GAS f32x4* xr = (const GAS f32x4*)(mem + (size_t)r * D) + lane; f32x4 v[4]; float s = 0.f;
#pragma unroll
            for (int j = 0; j < 4; ++j) { v[j] = xr[64 * j]; s += (v[j][0] * v[j][0] + v[j][1] * v[j][1]) + (v[j][2] * v[j][2] + v[j][3] * v[j][3]); }
            const float rs = __builtin_amdgcn_rsqf(wave_sum(s) * (1.f / D) + RMS_EPS);
            GAS unsigned long long* o8 = (GAS unsigned long long*)(MEMN + (size_t)r * D) + lane;
#pragma unroll
            for (int j = 0; j < 4; ++j) { const f32x4 gg = *((const f32x4*)g_mem + 64 * j + lane); const f32x4 a = v[j] * rs * gg; o8[64 * j] = (unsigned long long)pk2(a[0], a[1]) | ((unsigned long long)pk2(a[2], a[3]) << 32); } }
        __syncthreads();
        LAS float* part = (LAS float*)(L + RING_OFF + 32768);
        LAS float* wf = (LAS float*)(L + RING_OFF);
        for (int i = tid; i < 8 * 1024; i += 512) { const int h = i >> 10, kk = i & 1023; wf[i] = w_in[(size_t)kk * INC + C_F + h]; }
        __syncthreads();
        f32x4 gm[4];
#pragma unroll
        for (int j = 0; j < 4; ++j) gm[j] = *((const f32x4*)g_mix + 64 * j + lane);
        for (int blk = bx; blk < M / 256; blk += G) {
            f32x4 accm[4];
#pragma unroll
            for (int j = 0; j < 4; ++j) accm[j] = (f32x4){0.f, 0.f, 0.f, 0.f};
            f32x4 vn[2][4];
#pragma unroll
            for (int rr = 0; rr < 2; ++rr) { const GAS f32x4* xr = (const GAS f32x4*)(x + ((size_t)blk * 256 + wave * 32 + rr) * D) + lane;
#pragma unroll
                for (int j = 0; j < 4; ++j) vn[rr][j] = xr[64 * j]; }
            for (int i0 = 0; i0 < 32; i0 += 2) {
              f32x4 vv[2][4];
#pragma unroll
              for (int rr = 0; rr < 2; ++rr)
#pragma unroll
                  for (int j = 0; j < 4; ++j) vv[rr][j] = vn[rr][j];
              { const int inx = i0 + 2 < 32 ? i0 + 2 : i0;
#pragma unroll
                for (int rr = 0; rr < 2; ++rr) { const GAS f32x4* xr = (const GAS f32x4*)(x + ((size_t)blk * 256 + wave * 32 + inx + rr) * D) + lane;
#pragma unroll
                    for (int j = 0; j < 4; ++j) vn[rr][j] = xr[64 * j]; } }
#pragma unroll
              for (int rr = 0; rr < 2; ++rr) {
                const size_t r = (size_t)blk * 256 + wave * 32 + i0 + rr;
                f32x4 v[4]; float s = 0.f;
#pragma unroll
                for (int j = 0; j < 4; ++j) { v[j] = vv[rr][j]; s += (v[j][0] * v[j][0] + v[j][1] * v[j][1]) + (v[j][2] * v[j][2] + v[j][3] * v[j][3]); }
                const float rs = __builtin_amdgcn_rsqf(wave_sum(s) * (1.f / D) + RMS_EPS);
                GAS unsigned long long* o8 = (GAS unsigned long long*)(A1 + r * 2048) + lane;
                float fl[8];
#pragma unroll
                for (int h = 0; h < 8; ++h) fl[h] = 0.f;
#pragma unroll
                for (int j = 0; j < 4; ++j) { const f32x4 a = v[j] * rs * gm[j]; accm[j] += a;
                    const unsigned h0 = pk2(a[0], a[1]), h1 = pk2(a[2], a[3]);
                    o8[64 * j] = (unsigned long long)h0 | ((unsigned long long)h1 << 32);
                    const unsigned l0 = pk2(a[0] - bflo(h0), a[1] - bfhi(h0)), l1 = pk2(a[2] - bflo(h1), a[3] - bfhi(h1));
                    o8[256 + 64 * j] = (unsigned long long)l0 | ((unsigned long long)l1 << 32);
#pragma unroll
                    for (int h = 0; h < 8; ++h) { const f32x4 w = *((const LAS f32x4*)(wf + h * 1024) + 64 * j + lane); fl[h] += (a[0] * w[0] + a[1] * w[1]) + (a[2] * w[2] + a[3] * w[3]); } }
                float t4[4], t2[2], z;
                { const bool up = (lane & 32) != 0;
#pragma unroll
                  for (int k = 0; k < 4; ++k) { const float snd = up ? fl[k] : fl[k + 4]; const float rcv = __shfl_xor(snd, 32); t4[k] = (up ? fl[k + 4] : fl[k]) + rcv; } }
                { const bool up = (lane & 16) != 0;
#pragma unroll
                  for (int k = 0; k < 2; ++k) { const float snd = up ? t4[k] : t4[k + 2]; const float rcv = __shfl_xor(snd, 16); t2[k] = (up ? t4[k + 2] : t4[k]) + rcv; } }
                { const bool up = (lane & 8) != 0; const float snd = up ? t2[0] : t2[1]; const float rcv = __shfl_xor(snd, 8); z = (up ? t2[1] : t2[0]) + rcv; }
                z += __shfl_xor(z, 1); z += __shfl_xor(z, 2); z += __shfl_xor(z, 4);
                if ((lane & 7) == 0) { const int hh = 4 * (lane >> 5) + 2 * ((lane >> 4) & 1) + ((lane >> 3) & 1);
                    z += b_forget[hh];
                    LOGF[r * 8 + hh] = fminf(z, 0.f) - log1pf(__expf(-fabsf(z))); }
              }
            }
#pragma unroll
            for (int j = 0; j < 4; ++j) *((LAS f32x4*)(part + wave * 1024) + 64 * j + lane) = accm[j];
            __syncthreads();
            for (int col = tid; col < 1024; col += 512) { float s = 0.f;
#pragma unroll
                for (int w = 0; w < 8; ++w) s += part[w * 1024 + col];
                ABAR[(size_t)blk * 1024 + col] = s * (1.0f / 256.0f); }
            __syncthreads();
        }
    }
    xcd_barrier(bar);

#define WG_SIGNAL(word) do { asm volatile("s_waitcnt vmcnt(0)" ::: "memory"); __syncthreads(); if (tid == 0) { __builtin_amdgcn_fence(__ATOMIC_RELEASE, "agent"); asm volatile("s_waitcnt vmcnt(0)" ::: "memory"); \
        __hip_atomic_fetch_add((unsigned*)(ctl + (word)), 1u, RLX_AGENT); } } while (0)
#define WG_WAIT(word, n) do { if (tid == 0) { unsigned sp_ = 0u; while (__hip_atomic_load((unsigned*)(ctl + (word)), RLX_AGENT) < (unsigned)(n)) { __builtin_amdgcn_s_sleep(2); if (++sp_ > (1u << 22)) break; } } \
        __syncthreads(); __builtin_amdgcn_fence(__ATOMIC_ACQUIRE, "agent"); asm volatile("s_waitcnt vmcnt(0)" ::: "memory"); } while (0)
    { DECL_PTRS;
        LAS float* sc = (LAS float*)(L + RING_OFF);
        for (int w = bx; w < 64; w += G) {
            const int ib = w >> 3, jb = w & 7, r = tid >> 4, cq = tid & 15; LAS float* As = sc; LAS float* Bs = sc + 32 * 33;
            f32x4 acc = (f32x4){0.f, 0.f, 0.f, 0.f};
            for (int k0 = 0; k0 < 1024; k0 += 32) {
                { const int idx = tid * 2, row = idx >> 5, kk = idx & 31; const pg8::f32x2 a2 = *(const pg8::f32x2*)(ABAR + (size_t)(ib * 32 + row) * 1024 + k0 + kk); As[row * 33 + kk] = a2.x; As[row * 33 + kk + 1] = a2.y; }
                { const int idx = tid * 4, kk = idx >> 6, c = idx & 63; *(LAS f32x4*)(Bs + kk * 64 + c) = *(const f32x4*)(w_in + (size_t)(k0 + kk) * INC + C_KM + jb * 64 + c); }
                __syncthreads();
#pragma unroll 8
                for (int kk = 0; kk < 32; ++kk) acc += *(const LAS f32x4*)(Bs + kk * 64 + cq * 4) * As[r * 33 + kk];
                __syncthreads();
            }
            *(f32x4*)(KM + (size_t)(ib * 32 + r) * 512 + jb * 64 + cq * 4) = acc;
            WG_SIGNAL(CW_CNT_KM);
        }
        for (int w = (bx + G - 64) % G; w < 64; w += G) {
            const int b = w >> 3, h = w & 7; float v[16]; float run = 0.f;
#pragma unroll
            for (int i = 0; i < 16; ++i) { run += LOGF[((size_t)b * T + tid * 16 + i) * 8 + h]; v[i] = run; }
            float incl = run;
#pragma unroll
            for (int o = 1; o < 64; o <<= 1) { const float n = __shfl_up(incl, o); if (lane >= o) incl += n; }
            if (lane == 63) sc[wave] = incl;
            __syncthreads();
            float pre = incl - run;
            for (int ww = 0; ww < wave; ++ww) pre += sc[ww];
#pragma unroll
            for (int i = 0; i < 16; ++i) { const float cv = pre + v[i]; const size_t e = (size_t)w * T + tid * 16 + i; CC[e] = cv;
                const float bv = -cv * LOG2E; const unsigned h0 = f2bf(bv); const float r1 = bv - bf2f(h0); const unsigned h1 = f2bf(r1); const unsigned h2 = f2bf(r1 - bf2f(h1));
                *(v4u*)(KXF + e * 8) = (v4u){h0 | (h1 << 16), h2 | (0x3F80u << 16), 0x3F80u, 0u}; }
            if (w == 0) for (int j = tid; j < 8 * 256; j += 512) { const float bv = __builtin_amdgcn_exp2f(-(float)((j >> 8) + 1)) * LOG2E * (float)(j & 255);
                const unsigned h0 = f2bf(bv); const float r1 = bv - bf2f(h0); const unsigned h1 = f2bf(r1); const unsigned h2 = f2bf(r1 - bf2f(h1));
                *(v4u*)(KXM + (size_t)j * 8) = (v4u){h0 | (h1 << 16), h2 | (0x3F80u << 16), 0x3F80u, 0u}; }
            __syncthreads();
        }
        { const int ckv = (bx + G - 128) % G;
          pg8::Gemm g{MEMN, WKVT, D / 64, D * 2, D * 2, 0xffffffffu}; pg8::TileOrder S; S.init(NB * 256, 2048, G, ckv, D * 2, D * 2, 0, 1 << 30);
          pg8::EpiBf16 E{KV, 2048, 0u, 1.f, nullptr};
          pg8::gemm_phase<pg8::EpiBf16, pg8::TileOrder, true>(L + RING_OFF, XL, g, S, E);
          for (int Lk = ckv; Lk < 64; Lk += G) WG_SIGNAL(CW_CNT_KV); }
        if (bx < 64) WG_WAIT(CW_CNT_KM, 64);
        for (int w = bx; w < 64; w += G) {
            const int h = w >> 3, kq = w & 7, kk = kq * 128 + (tid & 127), ng = tid >> 7;
            for (int i = tid; i < 256 * 16; i += 512) { const int n = i >> 4, c4 = (i & 15) * 4; *(LAS f32x4*)(sc + n * 64 + c4) = *(const f32x4*)(KM + (size_t)n * 512 + h * 64 + c4); }
            f32x4 wq[16];
#pragma unroll
            for (int c = 0; c < 16; ++c) wq[c] = *(const f32x4*)(w_in + (size_t)kk * INC + C_QM + h * 64 + c * 4);
            __syncthreads();
            for (int i = 0; i < 64; ++i) { const int n = ng * 64 + i; const LAS f32x4* kp = (const LAS f32x4*)(sc + n * 64); float s0 = 0.f, s1 = 0.f;
#pragma unroll
                for (int c = 0; c < 16; c += 2) { const f32x4 ka = kp[c], kb = kp[c + 1];
                    s0 += (wq[c][0] * ka[0] + wq[c][1] * ka[1]) + (wq[c][2] * ka[2] + wq[c][3] * ka[3]); s1 += (wq[c + 1][0] * kb[0] + wq[c + 1][1] * kb[1]) + (wq[c + 1][2] * kb[2] + wq[c + 1][3] * kb[3]); }
                const float sv = s0 + s1; const unsigned hi = f2bf(sv); const unsigned lo = f2bf(sv - bf2f(hi));
                bf16* zr = ZT + ((size_t)(n >> 5) * 256 + 128 * ((n & 31) >> 4) + 32 * (h >> 1) + 16 * (h & 1) + (n & 15)) * 3072;     zr[kk] = (bf16)hi; zr[1024 + kk] = (bf16)hi; zr[2048 + kk] = (bf16)lo; }
            WG_SIGNAL(CW_CNT_Z);
        }
        { const int ckv = (bx + G - 128) % G;
          if (ckv < 64) WG_WAIT(CW_CNT_KV, 64);
          const int gx = G < 64 ? G : 64, cx = ckv < 64 ? ckv : (1 << 20);
          { pg8::Gemm g{KV, WQS, 4, 4096, 2048, 0xffffffffu}; WqkOrder S{gx, cx}; pg8::EpiF8 E{(unsigned char*)WQK, 1024, 32.0f};
            pg8::gemm_phase<pg8::EpiF8, WqkOrder, true>(L + RING_OFF, XL, g, S, E); }
          { pg8::Gemm g{WOT, KV, 4, 2048, 4096, 0xffffffffu}; VwoOrder S{gx, cx}; pg8::EpiF8 E{(unsigned char*)VWO, 1024, 4.0f};
            pg8::gemm_phase<pg8::EpiF8, VwoOrder, true>(L + RING_OFF, XL, g, S, E); } }
        { pg8::Gemm g{A1, WINT, D / 64, 4096, D * 2, 0xffffffffu}; pg8::TileOrder S; S.init(M, NQKV, G, bx, 4096, D * 2, 0, 1 << 30); S.deal = (G == 256) ? 1 : 0;
          pg8::EpiBf16 E{QKV, NQKV, 0xC3u, C2, (unsigned*)(ctl + CW_QKN)};
          pg8::gemm_phase<pg8::EpiBf16, pg8::TileOrder, true>(L + RING_OFF, XL, g, S, E); }
        WG_WAIT(CW_CNT_Z, 64);
        { pg8::Gemm g{A1, ZT, 3072 / 64, 4096, 6144, 4095u}; pg8::TileOrder S; S.init(M, 256, G, (G == 256) ? ((bx >= 136 && bx < 192) ? bx - 128 : ((bx >= 8 && bx < 64) ? bx + 128 : bx)) : bx, 4096, 6144, (size_t)256 * 6144, 32); S.skipmode = 1;
          pg8::EpiGate E{SEL};
          pg8::gemm_phase<pg8::EpiGate, pg8::TileOrder, true, false, true>(L + RING_OFF, XL, g, S, E); }
    }
#undef WG_SIGNAL
#undef WG_WAIT
    xcd_barrier(bar);

    { DECL_PTRS;
        for (int e = bx + wave * G; e < 2048; e += 8 * G) {
            const int bh = e >> 5, qb = e & 31, b = bh >> 3, h = bh & 7; float dmin = 3.0e38f, qmax = 0.f;
#pragma unroll 2
            for (int rr = 0; rr < 4; ++rr) { const bf16* qp = QKV + ((size_t)b * T + qb * 256 + rr * 64 + lane) * NQKV + h * 64; float dot = 0.f, qn2 = 0.f;
#pragma unroll
                for (int c = 0; c < 8; ++c) { const v4u qw = *((const v4u*)qp + c), kw = *((const v4u*)(qp + 512) + c); const unsigned qq[4] = {qw.x, qw.y, qw.z, qw.w}, kk2[4] = {kw.x, kw.y, kw.z, kw.w};
#pragma unroll
                    for (int x4 = 0; x4 < 4; ++x4) { const float q0 = bflo(qq[x4]), q1 = bfhi(qq[x4]); dot += q0 * bflo(kk2[x4]) + q1 * bfhi(kk2[x4]); qn2 += q0 * q0 + q1 * q1; } }
                dmin = fminf(dmin, dot); qmax = fmaxf(qmax, qn2); }
#pragma unroll
            for (int o = 1; o < 64; o <<= 1) { dmin = fminf(dmin, __shfl_xor(dmin, o)); qmax = fmaxf(qmax, __shfl_xor(qmax, o)); }
            const unsigned* kp = (const unsigned*)(ctl + CW_QKN) + bh * 8 + 2;
            const float kn = sqrtf(__uint_as_float(__hip_atomic_load(kp, RLX_AGENT)) + __uint_as_float(__hip_atomic_load(kp + 1, RLX_AGENT)));
            const float thr = (sqrtf(qmax) * kn * 1.02f - dmin + 40.5f) * (1.0f / LOG2E);
            const float* crow_ = CC + (size_t)bh * T; const int t0 = qb * 256; const float target = crow_[t0] + thr;
            int lo = 0, hi2 = t0;
            while (hi2 > lo) { const int step = (hi2 - lo + 63) >> 6, pos = lo + lane * step; const bool pr = pos < hi2 && crow_[pos] >= target; const int k = __popcll(__ballot(pr));
                if (k == 0) hi2 = lo;
                else { const int cand = lo + k * step; lo = lo + (k - 1) * step + 1; if (cand < hi2) hi2 = cand; } }
            if (lane == 0) ((int*)(ctl + CW_T0TAB))[e] = (lo >> 6) & ~1; }
        for (int ws_ = bx + G * wave; ws_ < 2048; ws_ += 8 * G) {
            const int bh = (ws_ & 255) >> 2, n = (ws_ & 3) + 4 * (ws_ >> 8), trip = bh * 32 + n; const unsigned* selrow = SEL + (size_t)bh * T; unsigned base = 0u;
            const float mthr = skip_thr((const unsigned*)(ctl + CW_QKN) + bh * 8, 1); const int hh = bh & 7;
            for (int t0 = (n + 1) * 256; t0 < T; t0 += 512) {
                unsigned m[8];
#pragma unroll
                for (int j = 0; j < 8; ++j) { const int t = t0 + j * 64 + lane; m[j] = 0u; if (t < T) m[j] = selrow[t]; }
#pragma unroll
                for (int j = 0; j < 8; ++j) { const int t = t0 + j * 64 + lane; const bool hit = ((m[j] >> n) & 1u) && !moba_skip(hh, t >> 8, n, mthr);
                    const unsigned long long bal = __ballot(hit);
                    if (hit) { const unsigned pos = base + (unsigned)__popcll(bal & ((1ull << lane) - 1ull)); const unsigned k = (unsigned)__popc(m[j] & ((1u << n) - 1u));
                        LIST[(size_t)trip * 8192 + pos] = (unsigned)t | (k << 16); }
                    base += (unsigned)__popcll(bal); }
            }
            if (lane == 0) CNT[trip] = base;
        }
    }
    xcd_barrier(bar);

    { DECL_PTRS;
        LAS int* upre = (LAS int*)(L + RING_OFF + attn_body::ATTN_LDS_BYTES);
        LAS int* wsum = upre + 2052;
        { int c4[4]; int run = 0;
#pragma unroll
          for (int i = 0; i < 4; ++i) { const int wq = tid * 4 + i; c4[i] = run; run += (int)((8u + ((CNT[(wq & 63) * 32 + (wq >> 6)] + 31u) >> 5) + 31u) >> 5); }
          int incl = run;
#pragma unroll
          for (int o = 1; o < 64; o <<= 1) { const int nn = __shfl_up(incl, o); if (lane >= o) incl += nn; }
          if (lane == 63) wsum[wave] = incl;
          __syncthreads();
          int pre = incl - run;
          for (int ww = 0; ww < wave; ++ww) pre += wsum[ww];
#pragma unroll
          for (int i = 0; i < 4; ++i) upre[tid * 4 + i] = pre + c4[i];
          if (tid == 511) upre[2048] = pre + run;
          __syncthreads(); }
        const int ntot = 2048 + upre[2048];
        const attn_body::hb16* Qb = (const attn_body::hb16*)QKV;
        const int r32 = lane & 31;
        LAS unsigned* qnext = (LAS unsigned*)(wsum + 16);
        unsigned* qhead = (unsigned*)(ctl + CW_QUEUE);
        if (tid == 0) qnext[0] = atomicAdd(qhead, 1u);
        __syncthreads();
        for (;;) {
            const int u = (int)qnext[0];
            if (u >= ntot) break;
            __syncthreads();
            unsigned nxt_ = 0u; if (tid == 0) nxt_ = atomicAdd(qhead, 1u);
            if (u < 2048) {
                const int qb = 31 - (u >> 6), bh = u & 63;
                const int b = bh >> 3, h = bh & 7;
                const int T0 = ((const int*)(ctl + CW_T0TAB))[bh * 32 + qb];
                const int qrow = b * T + qb * 256 + wave * 32 + r32, NT = 4 * (qb + 1) - T0;
                const attn_body::hb16* Qc = Qb + h * 64; const attn_body::hb16* Kt0 = Qb + (size_t)(b * T + T0 * 64) * NQKV + 512 + h * 64;
                attn_body::attn_unit<8>((char*)lds + RING_OFF, 0, Qc, qrow, -1, Kt0, Kt0 + 512, (const attn_body::hb16*)KXF + ((size_t)bh * T + T0 * 64) * 8, NT, NT - 4, (attn_body::hb16*)QKV + (Qc - Qb), (attn_body::hb16*)PO, PML);
            } else {
                const int g = u - 2048; int lo = 0, hi2 = 2048;
                while (hi2 - lo > 1) { const int mid = (lo + hi2) >> 1; if (upre[mid] <= g) lo = mid; else hi2 = mid; }
                const int c = g - upre[lo], bh = lo & 63, n = lo >> 6, w = bh * 32 + n, b = bh >> 3, h = bh & 7; const int cnt = (int)CNT[w];
                const int ng = 8 + ((cnt + 31) >> 5), g0 = 32 * c, g1 = g0 + 32 < ng ? g0 + 32 : ng;
                const attn_body::hb16* Kt0 = Qb + (size_t)(b * T + n * 256) * NQKV + 2048 + h * 64;
                attn_body::moba_item<8>((char*)lds + RING_OFF, Qb + 1536 + h * 64, b * T, h, n, LIST + (size_t)w * 8192, cnt, g0, g1, Kt0, (const attn_body::hb16*)KXM + h * 256 * 8, (attn_body::hb16*)PO, PML);
            }
            if (tid == 0) qnext[0] = nxt_;
            __syncthreads();
        }
    }
    xcd_barrier(bar);

    { DECL_PTRS;
    const f32x4 ga0 = *((const f32x4*)g_fox + 2 * lane), ga1 = *((const f32x4*)g_fox + 2 * lane + 1), gb0 = *((const f32x4*)g_moba + 2 * lane), gb1 = *((const f32x4*)g_moba + 2 * lane + 1);
    const int h = lane >> 3, cc = lane & 7; const float s2 = __builtin_amdgcn_exp2f(-(float)(h + 1)) * LOG2E * 256.0f;
    float mthr[NB];
#pragma unroll
    for (int b = 0; b < NB; ++b) mthr[b] = skip_thr((const unsigned*)(ctl + CW_QKN) + (b * 8 + h) * 8, 1);
    v4u wan[2], pwn[2][4]; unsigned mmn[2]; pg8::f32x2 mln[2][4];
#define P3_LOAD(rbase) do { _Pragma("unroll") for (int rr = 0; rr < 2; ++rr) { const int r = (rbase) + rr, b = r >> 13, t = r & (T - 1); const size_t sb = ((size_t)r * 8 + h) * 4; \
            wan[rr] = *((const v4u*)(QKV + (size_t)r * NQKV) + lane); mmn[rr] = SEL[((size_t)(b * 8 + h)) * T + t]; \
            _Pragma("unroll") for (int k = 0; k < 4; ++k) { mln[rr][k] = *(const pg8::f32x2*)(PML + (sb + k) * 2); pwn[rr][k] = *((const v4u*)(PO + (sb + k) * 64) + cc); } } } while (0)
    if (gw * 2 < M) P3_LOAD(gw * 2);
    for (int r0 = gw * 2; r0 < M; r0 += NGW * 2) {
        v4u wa[2], pw[2][4]; unsigned mmv[2]; pg8::f32x2 ml[2][4];
#pragma unroll
        for (int rr = 0; rr < 2; ++rr) { wa[rr] = wan[rr]; mmv[rr] = mmn[rr];
#pragma unroll
            for (int k = 0; k < 4; ++k) { ml[rr][k] = mln[rr][k]; pw[rr][k] = pwn[rr][k]; } }
        { const int rn = r0 + NGW * 2 < M ? r0 + NGW * 2 : r0; P3_LOAD(rn); }
#pragma unroll
        for (int rr = 0; rr < 2; ++rr) { const int r = r0 + rr, t = r & (T - 1), own = t >> 8;
            const float a[8] = {bflo(wa[rr].x), bfhi(wa[rr].x), bflo(wa[rr].y), bfhi(wa[rr].y), bflo(wa[rr].z), bfhi(wa[rr].z), bflo(wa[rr].w), bfhi(wa[rr].w)};
            float c[8]; unsigned mm = mmv[rr]; const int cnt = __popc(mm);
            float mk[4], lk[4];
#pragma unroll
            for (int k = 0; k < 4; ++k) { mk[k] = ml[rr][k].x; lk[k] = ml[rr][k].y; }
            mk[3] += s2 * (float)own; float Mx = mk[3];
            bool vk[4]; vk[3] = true; float thb = mthr[0];
#pragma unroll
            for (int b = 1; b < NB; ++b) thb = ((r >> 13) == b) ? mthr[b] : thb;
#pragma unroll
            for (int k = 0; k < 3; ++k) { vk[k] = false; if (k < cnt) { const int nb = __ffs(mm) - 1; mm &= mm - 1u; vk[k] = !moba_skip(h, own, nb, thb); if (vk[k]) { mk[k] += s2 * (float)nb; Mx = fmaxf(Mx, mk[k]); } } }
            float W = 0.f;
#pragma unroll
            for (int i = 0; i < 8; ++i) c[i] = 0.f;
#pragma unroll
            for (int k = 0; k < 4; ++k) { if (vk[k]) { const float w = lk[k] * __builtin_amdgcn_exp2f(mk[k] - Mx); W += w; const v4u p = pw[rr][k];
                c[0] += w * bflo(p.x); c[1] += w * bfhi(p.x); c[2] += w * bflo(p.y); c[3] += w * bfhi(p.y); c[4] += w * bflo(p.z); c[5] += w * bfhi(p.z); c[6] += w * bflo(p.w); c[7] += w * bfhi(p.w); } }
            const float iw = 1.0f / W;
#pragma unroll
            for (int i = 0; i < 8; ++i) c[i] *= iw;
            float sa = 0.f, sb2 = 0.f;
#pragma unroll
            for (int i = 0; i < 8; ++i) { sa += a[i] * a[i]; sb2 += c[i] * c[i]; }
            const float ra = __builtin_amdgcn_rsqf(wave_sum(sa) * (1.f / 512.f) + RMS_EPS), rb = __builtin_amdgcn_rsqf(wave_sum(sb2) * (1.f / 512.f) + RMS_EPS);
            v4u oa, ob;
            oa.x = pk2(a[0] * ra * ga0[0], a[1] * ra * ga0[1]); oa.y = pk2(a[2] * ra * ga0[2], a[3] * ra * ga0[3]); oa.z = pk2(a[4] * ra * ga1[0], a[5] * ra * ga1[1]); oa.w = pk2(a[6] * ra * ga1[2], a[7] * ra * ga1[3]);
            ob.x = pk2(c[0] * rb * gb0[0], c[1] * rb * gb0[1]); ob.y = pk2(c[2] * rb * gb0[2], c[3] * rb * gb0[3]); ob.z = pk2(c[4] * rb * gb1[0], c[5] * rb * gb1[1]); ob.w = pk2(c[6] * rb * gb1[2], c[7] * rb * gb1[3]);
            *((v4u*)(Y + (size_t)r * D) + lane) = oa; *((v4u*)(Y + (size_t)r * D + 512) + lane) = ob; }
    } }
    xcd_barrier(bar);

#undef P3_LOAD
    { DECL_PTRS; pg8::Gemm g{Y, WOUTT, D / 64, D * 2, D * 2, 0xffffffffu}; pg8::TileOrder S; S.init(M, D, G, bx, D * 2, D * 2, 0, 1 << 30);
      pg8::EpiRes<false, false> E{x, nullptr, nullptr, HB1, ws + WS_HB1F, SSQ1, 1.0f};
      pg8::gemm_phase<pg8::EpiRes<false, false>, pg8::TileOrder, true>(L + RING_OFF, XL, g, S, E); }
    xcd_barrier(bar);

    { DECL_PTRS; pg8::Gemm g{ws + WS_HB1F, WQK, D / 128, D, D, 0xffffffffu}; pg8::TileOrder S; S.init(M, D, G, bx, D, D, (size_t)D * D, 32);
      pg8::EpiSoftmax E{(unsigned char*)PB, SSQ1, 1.0f / 32.0f};
      pg8::gemm_phase<pg8::EpiSoftmax, pg8::TileOrder, true, true>(L + RING_OFF, XL, g, S, E); }
    xcd_barrier(bar);

    { DECL_PTRS; pg8::Gemm g{PB, VWO, D / 128, D, D, 0xffffffffu}; pg8::TileOrder S; S.init(M, D, G, bx, D, D, (size_t)D * D, 32);
      pg8::EpiRes<true, false> E{nullptr, HB1, nullptr, HB2, nullptr, SSQ2, 1.0f / 1024.0f};
      pg8::gemm_phase<pg8::EpiRes<true, false>, pg8::TileOrder, true, true>(L + RING_OFF, XL, g, S, E); }
    xcd_barrier(bar);

    { DECL_PTRS; pg8::Gemm g{HB2, WUPT, D / 64, D * 2, D * 2, 0xffffffffu}; pg8::TileOrder S; S.init(M, 2 * FF, G, bx, D * 2, D * 2, 0, 1 << 30);
      pg8::EpiConv E{ACT8, SSQ2, conv_w, conv_b, GHB, UHB, GTB};
      pg8::gemm_phase<pg8::EpiConv, pg8::TileOrder, true>(L + RING_OFF, XL, g, S, E); }
    xcd_barrier(bar);

    { DECL_PTRS;
    for (int it = bx * 512 + tid; it < 256 * 22 * 2 * 32; it += G * 512) {
        const int c4 = (it & 31) * 4, rr = (it >> 5) & 1, tile = it >> 6, pm = tile / 22, pn = tile - pm * 22; const bool top = (pm & 31) == 0;
        const size_t sb = (size_t)tile * 256; const int col = pn * 128 + c4;
        const f32x4 g2 = *(const f32x4*)(GHB + sb + rr * 128 + c4), uu = *(const f32x4*)(UHB + sb + rr * 128 + c4);
        f32x4 g1 = (f32x4){0.f, 0.f, 0.f, 0.f}, g0 = (f32x4){0.f, 0.f, 0.f, 0.f};
        if (rr == 1) g1 = *(const f32x4*)(GHB + sb + c4); else if (!top) g1 = *(const f32x4*)(GTB + sb - 22 * 256 + 128 + c4);
        if (!top) g0 = *(const f32x4*)(GTB + sb - 22 * 256 + (rr == 1 ? 128 : 0) + c4);
        const f32x4 w0 = *(const f32x4*)(conv_w + col), w1 = *(const f32x4*)(conv_w + FF + col), w2 = *(const f32x4*)(conv_w + 2 * FF + col), cbv = *(const f32x4*)(conv_b + col);
        float res[4];
#pragma unroll
        for (int e = 0; e < 4; ++e) { const float gc = cbv[e] + w0[e] * g0[e] + w1[e] * g1[e] + w2[e] * g2[e]; res[e] = gc * __builtin_amdgcn_rcpf(1.0f + __builtin_amdgcn_exp2f(-LOG2E * gc)) * uu[e]; }
        *(unsigned*)(ACT8 + (size_t)(pm * 256 + rr) * FF + col) = pg8::pk4_fp8(res[0], res[1], res[2], res[3]);
    } }
    xcd_barrier(bar);

    { DECL_PTRS; pg8::Gemm g{ACT8, WDT, FF / 128, FF, FF, 0xffffffffu}; pg8::TileOrder S; S.init(M, D, G, bx, FF, FF, 0, 1 << 30);
      pg8::EpiResNorm E{HB2, out, g_final, 1.0f / 64.0f, SSQ3, (unsigned*)(ctl + CW_PANEL), (unsigned*)(ctl + CW_TMO2)};
      pg8::gemm_phase<pg8::EpiResNorm, pg8::TileOrder, true, true>(L + RING_OFF, XL, g, S, E); }
}

extern "C" void kernel_launch(void* const* d_in, const int* in_sizes, int n_in, void* d_out, int out_size, void* d_ws, size_t ws_size, hipStream_t stream) {
    static int grid = 0;
    if (grid == 0) {
        if (n_in != 19 || in_sizes[0] != M * D || out_size != M * D || ws_size < WS_END) { fprintf(stderr, "kernel_launch: unexpected problem shape (n_in %d, in0 %d, out %d, ws %zu); nothing launched\n", n_in, n_in > 0 ? in_sizes[0] : -1, out_size, ws_size); grid = -1; return; }
        int dev = 0, cus = 0, per_cu = 0;
        if (hipGetDevice(&dev) != hipSuccess || hipDeviceGetAttribute(&cus, hipDeviceAttributeMultiprocessorCount, dev) != hipSuccess) { grid = -1; return; }
        if (hipFuncSetAttribute((const void*)fwd, hipFuncAttributeMaxDynamicSharedMemorySize, LDS_BYTES) != hipSuccess) { fprintf(stderr, "kernel_launch: hipFuncSetAttribute failed\n"); grid = -1; return; }
        if (hipOccupancyMaxActiveBlocksPerMultiprocessor(&per_cu, (const void*)fwd, NWAVES * 64, LDS_BYTES) != hipSuccess || per_cu < 1) { fprintf(stderr, "kernel_launch: occupancy query reports %d\n", per_cu); }
        (void)hipGetLastError();
        grid = cus;
    }
    if (grid < 0) return;
    if (hipMemsetAsync((char*)d_ws + WS_CTL, 0, CTL_ZERO_BYTES, stream) != hipSuccess) return;
    Args a{};
    for (int i = 0; i < 19; ++i) a.in[i] = (const float*)d_in[i];
    a.out = (float*)d_out; a.ws = (unsigned char*)d_ws;
    hipLaunchKernelGGL(fwd, dim3(grid), dim3(NWAVES * 64), LDS_BYTES, stream, a);
}
```

```cpp
#include <hip/hip_runtime.h>
#include <hip/hip_bf16.h>
#include <cstdio>
#include <cstdint>

namespace pg8 {
#define PG8_LAS __attribute__((address_space(3)))
typedef unsigned short bf16_t;
typedef short bf16x8 __attribute__((ext_vector_type(8)));
typedef float f32x4 __attribute__((ext_vector_type(4)));
typedef float f32x2 __attribute__((ext_vector_type(2)));
typedef unsigned u32x4 __attribute__((ext_vector_type(4)));
typedef unsigned u32x2 __attribute__((ext_vector_type(2)));
typedef int i32x4 __attribute__((ext_vector_type(4)));
typedef int i32x8 __attribute__((ext_vector_type(8)));
constexpr int BM = 256, BK = 64, HALF = 128, HTB = HALF * BK * 2  , STAGE_BYTES = 8 * HTB, NXCD = 8, WGM = 8;

__host__ __device__ __forceinline__ int lds_byte(int r, int c) { const int st = (r >> 4) * 2 + (c >> 5), rr = r & 15, cc = c & 31, ob = rr * 64 + cc * 2; return st * 1024 + (ob ^ (((ob >> 9) & 1) << 5)); }
__host__ __device__ __forceinline__ void stage_rc(int b, int& R, int& C) { const int st = b / 1024, sb = b % 1024, swz = sb ^ (((sb >> 9) & 1) << 5); R = (st >> 1) * 16 + swz / 64; C = (st & 1) * 32 + (swz % 64) / 2; }
__host__ __device__ __forceinline__ int perm32(int rho) { const int n = rho >> 4, i = rho & 15; return 8 * (i >> 2) + 4 * n + (i & 3); }

struct Unit { int pm, pn; size_t aoff, boff; int skipb1; };
struct Gemm { const void* A; const void* Bt; int nt, lda, ldb; unsigned wrapmask; };

struct TileOrder {
    int nM, nN, nwg, G, c; size_t a_tile, b_tile, b_batch; int pmb;
    __device__ __forceinline__ void init(int M, int N, int G_, int c_, int lda_bytes, int ldb_bytes, size_t b_batch_bytes, int pm_per_batch) {
        nM = M / BM; nN = N / BM; nwg = nM * nN; G = G_; c = c_; deal = 0; skipmode = 0; a_tile = (size_t)BM * lda_bytes; b_tile = (size_t)BM * ldb_bytes; b_batch = b_batch_bytes; pmb = pm_per_batch; }
    int skipmode;
    int deal;
    __device__ __forceinline__ bool next(int i, Unit& u) const {
        long L = (long)i * G + c;
        if (deal == 1) { const int n = 11 + (c < 128 ? 1 : (c >= 192 ? 2 : 0)); if (i >= n) return false; if (i >= 11) L = c < 128 ? 2816 + c : 2944 + (i - 11) * 64 + (c - 192); }
        if (L >= nwg) return false;
        int wgid = (int)L; { const int q = nwg / NXCD, r = nwg % NXCD, xcd = wgid % NXCD, off = wgid / NXCD; wgid = (xcd < r ? xcd * (q + 1) : r * (q + 1) + (xcd - r) * q) + off; }
        const int nig = WGM * nN, gid = wgid / nig, fm = gid * WGM, gsz = (nM - fm) < WGM ? (nM - fm) : WGM;
        u.pm = fm + ((wgid % nig) % gsz); u.pn = (wgid % nig) / gsz;
        u.aoff = (size_t)u.pm * a_tile; u.boff = (size_t)u.pn * b_tile + (size_t)(u.pm / pmb) * b_batch; u.skipb1 = (skipmode && (u.pm & 31) <= 16) ? 1 : 0; return true;
    }
};

__device__ __forceinline__ unsigned cvt_pk_bf16(float lo, float hi) { unsigned r; asm volatile("v_cvt_pk_bf16_f32 %0, %1, %2" : "=v"(r) : "v"(lo), "v"(hi)); return r; }

typedef f32x4 AccT[2][2][4][2];

struct EpiBf16 {
    static constexpr bool PERM = true;
    bf16_t* O; int ldc; unsigned scalemask; float scale0; unsigned* nrm;
    __device__ __forceinline__ void operator()(AccT& acc, const Unit& u, int wr, int wc, int fr, int fq, PG8_LAS unsigned char*) const {
        const int row0 = u.pm * BM + wr * 64 + fr, col0 = u.pn * BM + wc * 32 + 8 * fq;
        const float sc = ((scalemask >> u.pn) & 1u) ? scale0 : 1.f;
        if (nrm && (u.pn < 4 || (u.pn >= 6 && u.pn < 10))) {
#pragma unroll
            for (int bj = 0; bj < 2; ++bj) { float mx = 0.f;
#pragma unroll
                for (int ai = 0; ai < 2; ++ai)
#pragma unroll
                    for (int m = 0; m < 4; ++m) { const f32x4 v0 = acc[ai][bj][m][0] * sc, v1 = acc[ai][bj][m][1] * sc;
                        float q = (v0[0] * v0[0] + v0[1] * v0[1]) + (v0[2] * v0[2] + v0[3] * v0[3]) + (v1[0] * v1[0] + v1[1] * v1[1]) + (v1[2] * v1[2] + v1[3] * v1[3]);
                        q += __shfl_xor(q, 16); q += __shfl_xor(q, 32); mx = fmaxf(mx, q); }
                mx = fmaxf(mx, __shfl_xor(mx, 1)); mx = fmaxf(mx, __shfl_xor(mx, 2)); mx = fmaxf(mx, __shfl_xor(mx, 4)); mx = fmaxf(mx, __shfl_xor(mx, 8));
                if (fr == 0 && fq == 0) { const int head = (u.pn & 1) * 4 + 2 * bj + (wc >> 1); const int grp = u.pn < 4 ? (u.pn >> 1) : (u.pn >> 1) - 1; atomicMax(nrm + (((u.pm >> 5) * 8 + head) * 4 + grp) * 2 + (wc & 1), __float_as_uint(mx)); } } }
#pragma unroll
        for (int ai = 0; ai < 2; ++ai)
#pragma unroll
            for (int m = 0; m < 4; ++m) { bf16_t* rowp = O + (size_t)(row0 + ai * HALF + m * 16) * ldc + col0;
#pragma unroll
                for (int bj = 0; bj < 2; ++bj) { const f32x4 v0 = acc[ai][bj][m][0] * sc, v1 = acc[ai][bj][m][1] * sc;
                    u32x4 w; w.x = cvt_pk_bf16(v0[0], v0[1]); w.y = cvt_pk_bf16(v0[2], v0[3]); w.z = cvt_pk_bf16(v1[0], v1[1]); w.w = cvt_pk_bf16(v1[2], v1[3]);
                    *(u32x4*)(rowp + bj * HALF) = w; } }
    }
};
__device__ __forceinline__ unsigned pk4_fp8(float a, float b, float c, float d) { a = __builtin_amdgcn_fmed3f(a, -448.f, 448.f); b = __builtin_amdgcn_fmed3f(b, -448.f, 448.f); c = __builtin_amdgcn_fmed3f(c, -448.f, 448.f); d = __builtin_amdgcn_fmed3f(d, -448.f, 448.f); int w = 0;
    w = __builtin_amdgcn_cvt_pk_fp8_f32(a, b, w, false); w = __builtin_amdgcn_cvt_pk_fp8_f32(c, d, w, true); return (unsigned)w; }
struct EpiF8 {
    static constexpr bool PERM = true;
    unsigned char* O; int ldc; float sc;
    __device__ __forceinline__ void operator()(AccT& acc, const Unit& u, int wr, int wc, int fr, int fq, PG8_LAS unsigned char*) const {
        const int row0 = u.pm * BM + wr * 64 + fr, col0 = u.pn * BM + wc * 32 + 8 * fq;
#pragma unroll
        for (int ai = 0; ai < 2; ++ai)
#pragma unroll
            for (int m = 0; m < 4; ++m) { unsigned char* rowp = O + (size_t)(row0 + ai * HALF + m * 16) * ldc + col0;
#pragma unroll
                for (int bj = 0; bj < 2; ++bj) { const f32x4 v0 = acc[ai][bj][m][0] * sc, v1 = acc[ai][bj][m][1] * sc;
                    *(u32x2*)(rowp + bj * HALF) = (u32x2){pk4_fp8(v0[0], v0[1], v0[2], v0[3]), pk4_fp8(v1[0], v1[1], v1[2], v1[3])}; } }
    }
};
__device__ __forceinline__ float rstd_from_slots(const float* slots) {
    const f32x4 a = *(const f32x4*)slots, b = *(const f32x4*)(slots + 4), c = *(const f32x4*)(slots + 8), d = *(const f32x4*)(slots + 12);
    const float s = ((a[0] + a[1]) + (a[2] + a[3])) + ((b[0] + b[1]) + (b[2] + b[3])) + ((c[0] + c[1]) + (c[2] + c[3])) + ((d[0] + d[1]) + (d[2] + d[3]));
    return __builtin_amdgcn_rsqf(s * (1.0f / 1024.0f) + 1e-6f);
}
#define PG8_DPP(old, src, ctrl) __builtin_bit_cast(float, __builtin_amdgcn_update_dpp(__builtin_bit_cast(int, (float)(old)), __builtin_bit_cast(int, (float)(src)), (ctrl), 0xf, 0xf, false))
struct EpiConv {
    static constexpr bool PERM = true;
    unsigned char* act; const float* ssq; const float* cw; const float* cbias; float* GH; float* UH; float* GT;
    __device__ __forceinline__ void operator()(AccT& acc, const Unit& u, int wr, int wc, int fr, int fq, PG8_LAS unsigned char* xl) const {
        PG8_LAS float* H = (PG8_LAS float*)xl;
        const int cl = wc * 32 + 8 * fq;
        const int row0 = u.pm * BM + wr * 64 + fr;
        PG8_LAS float* Sr = H + 1024;
        { const int t_ = threadIdx.x; if (t_ < 256) Sr[t_] = rstd_from_slots(ssq + (size_t)(u.pm * BM + t_) * 16); }
        asm volatile("s_waitcnt vmcnt(0) lgkmcnt(0)" ::: "memory"); __builtin_amdgcn_s_barrier(); asm volatile("" ::: "memory");
#pragma unroll
        for (int ai = 0; ai < 2; ++ai)
#pragma unroll
            for (int m = 0; m < 4; ++m) { const float rs = Sr[ai * HALF + wr * 64 + m * 16 + fr];
#pragma unroll
                for (int bj = 0; bj < 2; ++bj)
#pragma unroll
                    for (int n = 0; n < 2; ++n) acc[ai][bj][m][n] *= rs; }
        const size_t sb = ((size_t)(u.pm * 22 + u.pn) * 2) * 128 + cl;
        if (fr >= 14) {
#pragma unroll
            for (int ai = 0; ai < 2; ++ai)
#pragma unroll
                for (int n = 0; n < 2; ++n) *(PG8_LAS f32x4*)(H + ((ai * 2 + wr) * 2 + (fr - 14)) * 128 + cl + 4 * n) = acc[ai][0][3][n];
            if (wr == 1) {
#pragma unroll
                for (int n = 0; n < 2; ++n) *(f32x4*)(GT + sb + (fr - 14) * 128 + 4 * n) = acc[1][0][3][n]; } }
        if (wr == 0 && fr < 2) {
#pragma unroll
            for (int n = 0; n < 2; ++n) { *(f32x4*)(GH + sb + fr * 128 + 4 * n) = acc[0][0][0][n]; *(f32x4*)(UH + sb + fr * 128 + 4 * n) = acc[0][1][0][n]; } }
        asm volatile("s_waitcnt lgkmcnt(0)" ::: "memory"); __builtin_amdgcn_s_barrier(); asm volatile("" ::: "memory");
#pragma unroll
        for (int n = 0; n < 2; ++n) {
            const int c0 = u.pn * 128 + cl + 4 * n;
            const f32x4 w0 = *(const f32x4*)(cw + c0), w1 = *(const f32x4*)(cw + 2816 + c0), w2 = *(const f32x4*)(cw + 2 * 2816 + c0), cbv = *(const f32x4*)(cbias + c0);
#pragma unroll
            for (int ai = 0; ai < 2; ++ai) {
                const int hsrc = wr == 1 ? ai * 2 : (ai == 1 ? 1 : 0);
                const f32x4 h14 = *(const PG8_LAS f32x4*)(H + (hsrc * 2 + 0) * 128 + cl + 4 * n), h15 = *(const PG8_LAS f32x4*)(H + (hsrc * 2 + 1) * 128 + cl + 4 * n);
#pragma unroll
                for (int m = 3; m >= 0; --m) {
                    float res[4];
#pragma unroll
                    for (int i = 0; i < 4; ++i) { const float X = acc[ai][0][m][n][i];
                        float o1, o2;
                        if (m > 0) { const float Xp = acc[ai][0][m > 0 ? m - 1 : 0][n][i]; o1 = PG8_DPP(0.f, Xp, 0x121); o2 = PG8_DPP(0.f, Xp, 0x122); }
                        else { o1 = h15[i]; o2 = fr == 0 ? h14[i] : h15[i]; }
                        const float g1 = PG8_DPP(o1, X, 0x111), g0 = PG8_DPP(o2, X, 0x112);
                        const float gc = cbv[i] + w0[i] * g0 + w1[i] * g1 + w2[i] * X;
                        res[i] = gc * __builtin_amdgcn_rcpf(1.0f + __builtin_amdgcn_exp2f(-1.4426950408889634f * gc)) * acc[ai][1][m][n][i]; }
                    const int row = row0 + ai * HALF + m * 16;
                    if (!(ai == 0 && m == 0 && wr == 0 && fr < 2))
                        *(unsigned*)(act + (size_t)row * 2816 + c0) = pk4_fp8(res[0], res[1], res[2], res[3]);
                } } }
    }
};
template <bool BASEB, bool OUTF> struct EpiRes {
    static constexpr bool PERM = true;
    const float* base; const bf16_t* baseb; float* out; bf16_t* hb; unsigned char* hb8; float* ssq; float accs;
    __device__ __forceinline__ void operator()(AccT& acc, const Unit& u, int wr, int wc, int fr, int fq, PG8_LAS unsigned char*) const {
        const int row0 = u.pm * BM + wr * 64 + fr, col0 = u.pn * BM + wc * 32 + 8 * fq;
        constexpr int DEPTH = BASEB ? 3 : 2;
        u32x4 pb[12][2]; f32x4 pf[12][2][2];
#define PG8_RES_LOAD(it) do { const size_t o_ = (size_t)(row0 + ((it) >> 2) * HALF + ((it) & 3) * 16) * 1024 + col0; \
            if constexpr (BASEB) { pb[it][0] = *(const u32x4*)(baseb + o_); pb[it][1] = *(const u32x4*)(baseb + o_ + HALF); } \
            else { pf[it][0][0] = *(const f32x4*)(base + o_); pf[it][0][1] = *(const f32x4*)(base + o_ + 4); pf[it][1][0] = *(const f32x4*)(base + o_ + HALF); pf[it][1][1] = *(const f32x4*)(base + o_ + HALF + 4); } } while (0)
#pragma unroll
        for (int it = 0; it < DEPTH; ++it) PG8_RES_LOAD(it);
#pragma unroll
        for (int it = 0; it < 8; ++it) { const int ai = it >> 2, m = it & 3;
            if (it + DEPTH < 8) PG8_RES_LOAD(it + DEPTH);
            __builtin_amdgcn_sched_barrier(0);
            const int row = row0 + ai * HALF + m * 16; const size_t off = (size_t)row * 1024 + col0; float q = 0.f;
#pragma unroll
            for (int bj = 0; bj < 2; ++bj) {
                f32x4 b0, b1;
                if constexpr (BASEB) { const u32x4 bw = pb[it][bj];
                    b0 = (f32x4){__builtin_bit_cast(float, bw.x << 16), __builtin_bit_cast(float, bw.x & 0xffff0000u), __builtin_bit_cast(float, bw.y << 16), __builtin_bit_cast(float, bw.y & 0xffff0000u)};
                    b1 = (f32x4){__builtin_bit_cast(float, bw.z << 16), __builtin_bit_cast(float, bw.z & 0xffff0000u), __builtin_bit_cast(float, bw.w << 16), __builtin_bit_cast(float, bw.w & 0xffff0000u)}; }
                else { b0 = pf[it][bj][0]; b1 = pf[it][bj][1]; }
                const f32x4 v0 = acc[ai][bj][m][0] * accs + b0, v1 = acc[ai][bj][m][1] * accs + b1;
                if constexpr (OUTF) { *(f32x4*)(out + off + bj * HALF) = v0; *(f32x4*)(out + off + bj * HALF + 4) = v1; }
                q += (v0[0] * v0[0] + v0[1] * v0[1]) + (v0[2] * v0[2] + v0[3] * v0[3]) + (v1[0] * v1[0] + v1[1] * v1[1]) + (v1[2] * v1[2] + v1[3] * v1[3]);
                if (hb) { u32x4 w; w.x = cvt_pk_bf16(v0[0], v0[1]); w.y = cvt_pk_bf16(v0[2], v0[3]); w.z = cvt_pk_bf16(v1[0], v1[1]); w.w = cvt_pk_bf16(v1[2], v1[3]); *(u32x4*)(hb + off + bj * HALF) = w; }
                if (hb8) *(u32x2*)(hb8 + off + bj * HALF) = (u32x2){pk4_fp8(v0[0], v0[1], v0[2], v0[3]), pk4_fp8(v1[0], v1[1], v1[2], v1[3])}; }
            q += __shfl_xor(q, 16); q += __shfl_xor(q, 32);
            if (fq == 0) ssq[(size_t)row * 16 + u.pn * 4 + wc] = q;
            __builtin_amdgcn_sched_barrier(0); }
#undef PG8_RES_LOAD
    }
};
struct EpiResNorm {
    static constexpr bool PERM = true;
    const bf16_t* baseb; float* out; const float* gfin; float accs; float* xbuf; unsigned* cnt; unsigned* tmo;
    __device__ __forceinline__ void operator()(AccT& acc, const Unit& u, int wr, int wc, int fr, int fq, PG8_LAS unsigned char* xl) const {
        PG8_LAS float* Pp = (PG8_LAS float*)xl;
        PG8_LAS float* Sr = Pp + 1024;
        PG8_LAS unsigned* flag = (PG8_LAS unsigned*)(Sr + 256);
        const int tid = threadIdx.x, wid = tid >> 6, lane = tid & 63;
        const int row0 = u.pm * BM + wr * 64 + fr, col0 = u.pn * BM + wc * 32 + 8 * fq;
        u32x4 pb[12][2];
#define PG8_RN_LOAD(it) do { const size_t o_ = (size_t)(row0 + ((it) >> 2) * HALF + ((it) & 3) * 16) * 1024 + col0; pb[it][0] = *(const u32x4*)(baseb + o_); pb[it][1] = *(const u32x4*)(baseb + o_ + HALF); } while (0)
#pragma unroll
        for (int it = 0; it < 4; ++it) PG8_RN_LOAD(it);
#pragma unroll
        for (int it = 0; it < 8; ++it) { const int ai = it >> 2, m = it & 3;
                if (it + 4 < 8) PG8_RN_LOAD(it + 4);
                __builtin_amdgcn_sched_barrier(0);
                float q = 0.f;
#pragma unroll
                for (int bj = 0; bj < 2; ++bj) {
                    const u32x4 bw = pb[it][bj];
                    const f32x4 b0 = (f32x4){__builtin_bit_cast(float, bw.x << 16), __builtin_bit_cast(float, bw.x & 0xffff0000u), __builtin_bit_cast(float, bw.y << 16), __builtin_bit_cast(float, bw.y & 0xffff0000u)};
                    const f32x4 b1 = (f32x4){__builtin_bit_cast(float, bw.z << 16), __builtin_bit_cast(float, bw.z & 0xffff0000u), __builtin_bit_cast(float, bw.w << 16), __builtin_bit_cast(float, bw.w & 0xffff0000u)};
                    const f32x4 v0 = acc[ai][bj][m][0] * accs + b0, v1 = acc[ai][bj][m][1] * accs + b1; acc[ai][bj][m][0] = v0; acc[ai][bj][m][1] = v1;
                    q += (v0[0] * v0[0] + v0[1] * v0[1]) + (v0[2] * v0[2] + v0[3] * v0[3]) + (v1[0] * v1[0] + v1[1] * v1[1]) + (v1[2] * v1[2] + v1[3] * v1[3]); }
                q += __shfl_xor(q, 16); q += __shfl_xor(q, 32);
                if (fq == 0) Pp[(ai * HALF + wr * 64 + m * 16 + fr) * 4 + wc] = q;
                __builtin_amdgcn_sched_barrier(0); }
#undef PG8_RN_LOAD
        asm volatile("s_waitcnt lgkmcnt(0)" ::: "memory"); __builtin_amdgcn_s_barrier(); asm volatile("" ::: "memory");
        if (wid < 4) { const int r = wid * 64 + lane; const f32x4 p = *(const PG8_LAS f32x4*)(Pp + r * 4);
            __hip_atomic_store(xbuf + (size_t)(u.pm * BM + r) * 4 + u.pn, (p[0] + p[1]) + (p[2] + p[3]), __ATOMIC_RELAXED, __HIP_MEMORY_SCOPE_AGENT);
            asm volatile("s_waitcnt vmcnt(0)" ::: "memory");
            if (lane == 0) __hip_atomic_fetch_add(cnt + 64 * u.pm, 1u, __ATOMIC_RELAXED, __HIP_MEMORY_SCOPE_AGENT); }
        if (wid == 0) { unsigned sp = 0u; bool dead = false;
            for (;;) { if ((unsigned)__builtin_amdgcn_readfirstlane(__hip_atomic_load(cnt + 64 * u.pm, __ATOMIC_RELAXED, __HIP_MEMORY_SCOPE_AGENT)) >= 16u) break;
                if (++sp > (1u << 20)) { if (lane == 0) __hip_atomic_store(tmo, 1u, __ATOMIC_RELAXED, __HIP_MEMORY_SCOPE_AGENT); dead = true; break; }
                __builtin_amdgcn_s_sleep(2); }
            __builtin_amdgcn_fence(__ATOMIC_ACQUIRE, "agent");
            if (lane == 0) flag[0] = dead ? 1u : 0u; }
        asm volatile("s_waitcnt vmcnt(0) lgkmcnt(0)" ::: "memory"); __builtin_amdgcn_s_barrier(); asm volatile("" ::: "memory");
        if (wid < 4) { const int r = wid * 64 + lane; const float* xs = xbuf + (size_t)(u.pm * BM + r) * 4; float s = 0.f;
#pragma unroll
            for (int t = 0; t < 4; ++t) s += __hip_atomic_load(xs + t, __ATOMIC_RELAXED, __HIP_MEMORY_SCOPE_AGENT);
            Sr[r] = __builtin_amdgcn_rsqf(s * (1.0f / 1024.0f) + 1e-6f); }
        asm volatile("s_waitcnt vmcnt(0) lgkmcnt(0)" ::: "memory"); __builtin_amdgcn_s_barrier(); asm volatile("" ::: "memory");
        f32x4 gg[2][2];
#pragma unroll
        for (int bj = 0; bj < 2; ++bj) { gg[bj][0] = *(const f32x4*)(gfin + col0 + bj * HALF); gg[bj][1] = *(const f32x4*)(gfin + col0 + bj * HALF + 4); }
#pragma unroll
        for (int ai = 0; ai < 2; ++ai)
#pragma unroll
            for (int m = 0; m < 4; ++m) { const int rl = ai * HALF + wr * 64 + m * 16 + fr; const float rs = Sr[rl]; const size_t off = (size_t)(u.pm * BM + rl) * 1024 + col0;
#pragma unroll
                for (int bj = 0; bj < 2; ++bj) { *(f32x4*)(out + off + bj * HALF) = acc[ai][bj][m][0] * rs * gg[bj][0]; *(f32x4*)(out + off + bj * HALF + 4) = acc[ai][bj][m][1] * rs * gg[bj][1]; } }
    }
};
struct EpiSoftmax {
    static constexpr bool PERM = true;
    unsigned char* P; const float* ssq; float sscale;
    __device__ __forceinline__ void operator()(AccT& acc, const Unit& u, int wr, int wc, int fr, int fq, PG8_LAS unsigned char* xl) const {
        PG8_LAS f32x2* X = (PG8_LAS f32x2*)xl;
        const int row0 = u.pm * BM + wr * 64 + fr, col0 = u.pn * BM + wc * 32 + 8 * fq;
        float ml[2][4];
        f32x4 sl[8];
#pragma unroll
        for (int it = 0; it < 8; ++it) sl[it] = *(const f32x4*)(ssq + (size_t)(row0 + (it >> 2) * HALF + (it & 3) * 16) * 16 + fq * 4);
        __builtin_amdgcn_sched_barrier(0);
#pragma unroll
        for (int ai = 0; ai < 2; ++ai)
#pragma unroll
            for (int m = 0; m < 4; ++m) { float ps = (sl[ai * 4 + m][0] + sl[ai * 4 + m][1]) + (sl[ai * 4 + m][2] + sl[ai * 4 + m][3]); ps += __shfl_xor(ps, 16); ps += __shfl_xor(ps, 32);
                const float rs = __builtin_amdgcn_rsqf(ps * (1.0f / 1024.0f) + 1e-6f) * sscale;
                float mx = -3.0e38f;
#pragma unroll
                for (int bj = 0; bj < 2; ++bj)
#pragma unroll
                    for (int n = 0; n < 2; ++n) { f32x4 v = acc[ai][bj][m][n] * rs; acc[ai][bj][m][n] = v; mx = fmaxf(fmaxf(mx, fmaxf(v[0], v[1])), fmaxf(v[2], v[3])); }
                mx = fmaxf(mx, __shfl_xor(mx, 16)); mx = fmaxf(mx, __shfl_xor(mx, 32));
                float s = 0.f;
#pragma unroll
                for (int bj = 0; bj < 2; ++bj)
#pragma unroll
                    for (int n = 0; n < 2; ++n) { f32x4 v = acc[ai][bj][m][n];
                        v[0] = __builtin_amdgcn_exp2f(v[0] - mx); v[1] = __builtin_amdgcn_exp2f(v[1] - mx); v[2] = __builtin_amdgcn_exp2f(v[2] - mx); v[3] = __builtin_amdgcn_exp2f(v[3] - mx);
                        acc[ai][bj][m][n] = v; s += (v[0] + v[1]) + (v[2] + v[3]); }
                s += __shfl_xor(s, 16); s += __shfl_xor(s, 32);
                ml[ai][m] = mx;
                if (fq == 0) X[(ai * HALF + wr * 64 + m * 16 + fr) * 4 + wc] = (f32x2){mx, s}; }
        asm volatile("s_waitcnt lgkmcnt(0)" ::: "memory"); __builtin_amdgcn_s_barrier(); asm volatile("" ::: "memory");
#pragma unroll
        for (int ai = 0; ai < 2; ++ai)
#pragma unroll
            for (int m = 0; m < 4; ++m) { const int rl = ai * HALF + wr * 64 + m * 16 + fr; const int row = u.pm * BM + rl;
                const f32x2 a = X[rl * 4 + 0], b = X[rl * 4 + 1], c = X[rl * 4 + 2], d = X[rl * 4 + 3];
                const float Mx = fmaxf(fmaxf(a.x, b.x), fmaxf(c.x, d.x));
                const float L = a.y * __builtin_amdgcn_exp2f(a.x - Mx) + b.y * __builtin_amdgcn_exp2f(b.x - Mx) + c.y * __builtin_amdgcn_exp2f(c.x - Mx) + d.y * __builtin_amdgcn_exp2f(d.x - Mx);
                const float f = __builtin_amdgcn_exp2f(ml[ai][m] - Mx) * __builtin_amdgcn_rcpf(L) * 256.0f;
                unsigned char* rowp = P + (size_t)row * 1024 + col0;
#pragma unroll
                for (int bj = 0; bj < 2; ++bj) { const f32x4 v0 = acc[ai][bj][m][0] * f, v1 = acc[ai][bj][m][1] * f;
                    *(u32x2*)(rowp + bj * HALF) = (u32x2){pk4_fp8(v0[0], v0[1], v0[2], v0[3]), pk4_fp8(v1[0], v1[1], v1[2], v1[3])}; } }
    }
};
struct EpiGate {
    static constexpr bool PERM = false;
    unsigned* sel;
    __device__ __forceinline__ void operator()(AccT& acc, const Unit& u, int wr, int wc, int fr, int fq, PG8_LAS unsigned char*) const {
        const int own = u.pm & 31;
#pragma unroll
        for (int ai = 0; ai < 2; ++ai)
#pragma unroll
            for (int m = 0; m < 4; ++m) { const int row = u.pm * BM + ai * HALF + wr * 64 + m * 16 + fr;
#pragma unroll
                for (int n = 0; n < 2; ++n) { unsigned mask = 0u;
#pragma unroll
                    for (int round = 0; round < 3; ++round) { float bv = -3.0e38f; int bi = 32;
#pragma unroll
                        for (int bj = 0; bj < 2; ++bj)
#pragma unroll
                            for (int i = 0; i < 4; ++i) { const int nb = 16 * bj + 4 * fq + i; const float v = acc[ai][bj][m][n][i];
                                if (nb < own && !((mask >> nb) & 1u) && v > bv) { bv = v; bi = nb; } }
#pragma unroll
                        for (int off = 16; off <= 32; off <<= 1) { const float ov = __shfl_xor(bv, off); const int oi = __shfl_xor(bi, off); if (ov > bv || (ov == bv && oi < bi)) { bv = ov; bi = oi; } }
                        if (bi < 32) mask |= 1u << bi; }
                    if (fq == 0) sel[((size_t)((u.pm >> 5) * 8 + 2 * wc + n)) * 8192 + (row & 8191)] = mask; } }
    }
};

template <class Epi, class Sched, bool ALIGN_EPI, bool F8 = false, bool CANSKIP = false>
__device__ __forceinline__ void gemm_phase(PG8_LAS unsigned char* lds, PG8_LAS unsigned char* xl, const Gemm g, const Sched& S, const Epi& E) {
    int tid_ = threadIdx.x; asm volatile("" : "+v"(tid_));
    const int tid = tid_, wid = __builtin_amdgcn_readfirstlane(tid >> 6), lane = tid & 63, wr = wid >> 2, wc = wid & 3, fr = lane & 15, fq = lane >> 4;
    int nt = g.nt; asm volatile("" : "+s"(nt));
    unsigned voffA[2], voffB[2];
#pragma unroll
    for (int i = 0; i < 2; ++i) { int R, C; stage_rc(tid * 16 + i * 8192, R, C); const int Rb = Epi::PERM ? ((R & ~31) + perm32(R & 31)) : R;
        voffA[i] = (unsigned)(R * g.lda + C * 2); voffB[i] = (unsigned)(Rb * g.ldb + C * 2); }
    const size_t kstep = (size_t)(BK * 2);
    const size_t hstepA = (size_t)HALF * g.lda, hstepB = (size_t)HALF * g.ldb;
    const unsigned wmask = g.wrapmask;
    const unsigned ldsw = (unsigned)wid * 1024u;
    const int aoff = lds_byte(wr * 64 + fr, fq * 8), boff = lds_byte(wc * 32 + fr, fq * 8);
#define PG8_SA(b, h) (((b) * 2 + (h)) * HTB)
#define PG8_SB(b, h) ((4 + (b) * 2 + (h)) * HTB)
#define PG8_STAGE(bufoff, gbase, voff) do { _Pragma("unroll") for (int _i = 0; _i < 2; ++_i) \
        __builtin_amdgcn_global_load_lds((const unsigned*)((const char*)(gbase) + (voff)[_i]), (PG8_LAS unsigned*)(lds + (bufoff) + ldsw + _i * 8192), 16, 0, 0); } while (0)
#define PG8_LDA(dst, b, h) do { if constexpr (F8) { _Pragma("unroll") for (int m = 0; m < 4; ++m) { dst##8[m].lo = *(const PG8_LAS i32x4*)(lds + PG8_SA(b, h) + aoff + m * 2048); dst##8[m].hi = *(const PG8_LAS i32x4*)(lds + PG8_SA(b, h) + aoff + m * 2048 + 1024); } } \
        else { _Pragma("unroll") for (int m = 0; m < 4; ++m) _Pragma("unroll") for (int k = 0; k < 2; ++k) dst[m][k] = *(const PG8_LAS bf16x8*)(lds + PG8_SA(b, h) + aoff + m * 2048 + k * 1024); } } while (0)
#define PG8_LDB(dst, b, h) do { if constexpr (F8) { _Pragma("unroll") for (int n = 0; n < 2; ++n) { dst##8[n].lo = *(const PG8_LAS i32x4*)(lds + PG8_SB(b, h) + boff + n * 2048); dst##8[n].hi = *(const PG8_LAS i32x4*)(lds + PG8_SB(b, h) + boff + n * 2048 + 1024); } } \
        else { _Pragma("unroll") for (int n = 0; n < 2; ++n) _Pragma("unroll") for (int k = 0; k < 2; ++k) dst[n][k] = *(const PG8_LAS bf16x8*)(lds + PG8_SB(b, h) + boff + n * 2048 + k * 1024); } } while (0)
#define PG8_MMA(ai, bj, At, Bt) do { __builtin_amdgcn_s_setprio(1); \
        if constexpr (F8) { _Pragma("unroll") for (int m = 0; m < 4; ++m) _Pragma("unroll") for (int n = 0; n < 2; ++n) \
            asm volatile("v_mfma_f32_16x16x128_f8f6f4 %0, %1, %2, %0" : "+v"(acc[ai][bj][m][n]) : "v"(Bt##8[n]), "v"(At##8[m])); } \
        else { _Pragma("unroll") for (int m = 0; m < 4; ++m) _Pragma("unroll") for (int n = 0; n < 2; ++n) _Pragma("unroll") for (int k = 0; k < 2; ++k) \
            acc[ai][bj][m][n] = __builtin_amdgcn_mfma_f32_16x16x32_bf16(Bt[n][k], At[m][k], acc[ai][bj][m][n], 0, 0, 0); } \
        __builtin_amdgcn_s_setprio(0); } while (0)
#define PG8_WAIT_V(n) asm volatile("s_waitcnt vmcnt(" #n ")" ::: "memory")
#define PG8_WAIT_L(n) asm volatile("s_waitcnt lgkmcnt(" #n ")" ::: "memory")
#define PG8_BAR __builtin_amdgcn_s_barrier()
#define PG8_SCHED __builtin_amdgcn_sched_barrier(0)
    Unit cur, nxt; int ui = 0;
    if (!S.next(0, cur)) return;
    AccT acc;
    bf16x8 At[4][2], B0[2][2], B1[2][2]; i32x8 At8[4], B08[2], B18[2];
    const char* cA = (const char*)g.A + cur.aoff; const char* cB = (const char*)g.Bt + cur.boff;
    PG8_STAGE(PG8_SB(0, 0), cB, voffB); PG8_STAGE(PG8_SB(0, 1), cB + hstepB, voffB); PG8_STAGE(PG8_SA(0, 0), cA, voffA); PG8_STAGE(PG8_SA(0, 1), cA + hstepA, voffA);
    if (wr == 1) PG8_BAR;
    PG8_WAIT_V(2); PG8_BAR;
    PG8_STAGE(PG8_SB(1, 0), cB + kstep, voffB); PG8_STAGE(PG8_SA(1, 0), cA + kstep, voffA); PG8_STAGE(PG8_SB(1, 1), cB + hstepB + kstep, voffB);
    PG8_WAIT_V(6); PG8_BAR;
    { float z0; asm volatile("v_mov_b32 %0, 0" : "=v"(z0));
#pragma unroll
    for (int a = 0; a < 2; ++a)
#pragma unroll
        for (int b = 0; b < 2; ++b)
#pragma unroll
            for (int m = 0; m < 4; ++m)
#pragma unroll
                for (int n = 0; n < 2; ++n) acc[a][b][m][n] = (f32x4){z0, z0, z0, z0}; }
    for (;;) {
        const bool has_next = S.next(ui + 1, nxt);
        const char* nA = has_next ? (const char*)g.A + nxt.aoff : cA; const char* nB = has_next ? (const char*)g.Bt + nxt.boff : cB;
#pragma unroll 1
        for (int t = 0; t < nt; t += 2) {
            const bool last = (t == nt - 2);
            const char* a1 = cA + (size_t)((unsigned)(t * 128) & wmask) + kstep;
            const char* a2 = last ? nA : cA + (size_t)((unsigned)((t + 2) * 128) & wmask); const char* b2 = last ? nB : cB + (size_t)(t + 2) * kstep;
            const char* a3 = a2 + kstep; const char* b3 = b2 + kstep;
            PG8_LDB(B0, 0, 0); if (!(CANSKIP && cur.skipb1)) PG8_LDB(B1, 0, 1); PG8_SCHED; PG8_LDA(At, 0, 0); PG8_STAGE(PG8_SA(1, 1), a1 + hstepA, voffA);
            PG8_WAIT_V(8); PG8_WAIT_L(0); PG8_BAR; PG8_MMA(0, 0, At, B0); if (!(CANSKIP && cur.skipb1)) PG8_MMA(0, 1, At, B1); PG8_BAR; PG8_SCHED;
            PG8_LDA(At, 0, 1); PG8_STAGE(PG8_SB(0, 0), b2, voffB); PG8_STAGE(PG8_SB(0, 1), b2 + hstepB, voffB); PG8_STAGE(PG8_SA(0, 0), a2, voffA);
            PG8_WAIT_V(8); PG8_WAIT_L(0); PG8_BAR; PG8_MMA(1, 0, At, B0); if (!(CANSKIP && cur.skipb1)) PG8_MMA(1, 1, At, B1); PG8_BAR; PG8_SCHED;
            PG8_LDB(B0, 1, 0); if (!(CANSKIP && cur.skipb1)) PG8_LDB(B1, 1, 1); PG8_SCHED; PG8_LDA(At, 1, 0); PG8_STAGE(PG8_SA(0, 1), a2 + hstepA, voffA);
            PG8_WAIT_V(8); PG8_WAIT_L(0); PG8_BAR; PG8_MMA(0, 0, At, B0); if (!(CANSKIP && cur.skipb1)) PG8_MMA(0, 1, At, B1); PG8_BAR; PG8_SCHED;
            PG8_LDA(At, 1, 1); PG8_STAGE(PG8_SB(1, 0), b3, voffB); PG8_STAGE(PG8_SB(1, 1), b3 + hstepB, voffB); PG8_STAGE(PG8_SA(1, 0), a3, voffA);
            PG8_WAIT_V(8); PG8_WAIT_L(0); PG8_BAR; PG8_MMA(1, 0, At, B0); if (!(CANSKIP && cur.skipb1)) PG8_MMA(1, 1, At, B1); PG8_BAR; PG8_SCHED;
        }
        if constexpr (F8) asm volatile("s_nop 15\n\ts_nop 15" ::: "memory");
        if constexpr (ALIGN_EPI) { if (wr == 0) PG8_BAR; }
        E(acc, cur, wr, wc, fr, fq, xl);
        if (!has_next) break;
#pragma unroll
        for (int a = 0; a < 2; ++a)
#pragma unroll
            for (int b = 0; b < 2; ++b)
#pragma unroll
                for (int m = 0; m < 4; ++m)
#pragma unroll
                    for (int n = 0; n < 2; ++n) acc[a][b][m][n] = (f32x4){0.f, 0.f, 0.f, 0.f};
        cur = nxt; cA = nA; cB = nB; ++ui;
        if constexpr (ALIGN_EPI) { if (wr == 1) PG8_BAR; }
    }
    PG8_WAIT_V(0);
    if constexpr (!ALIGN_EPI) { if (wr == 0) PG8_BAR; }
    PG8_BAR;
#undef PG8_SA
#undef PG8_SB
#undef PG8_STAGE
#undef PG8_LDA
#undef PG8_LDB
#undef PG8_MMA
#undef PG8_WAIT_V
#undef PG8_WAIT_L
#undef PG8_BAR
#undef PG8_SCHED
}
}

constexpr int NWAVES = 8;
constexpr int NB = 8, T = 8192, D = 1024, M = NB * T;
constexpr int INC = 3080, NQKV = 3072, FF = 2816;
constexpr int C_F = 1536, C_QM = 1544, C_KM = 2056;
constexpr float LOG2E = 1.4426950408889634f;
constexpr float C2 = 0.125f * LOG2E;
constexpr float RMS_EPS = 1e-6f;

constexpr size_t MiB = 1u << 20;
constexpr size_t WS_CTL = 0, CTL_ZERO_BYTES = 1 * MiB;
constexpr size_t WS_LOGF = 2 * MiB, WS_C = 4 * MiB, WS_ABAR = 6 * MiB, WS_KM = 7 * MiB, WS_SEL = 8 * MiB;
constexpr size_t WS_SSQ1 = 10 * MiB, WS_SSQ2 = 14 * MiB, WS_SSQ3 = 18 * MiB;
constexpr size_t WS_MEMN = 22 * MiB, WS_KV = 26 * MiB, WS_WQS = 34 * MiB, WS_WOT = 36 * MiB, WS_WKVT = 38 * MiB, WS_WINT = 42 * MiB, WS_WOUTT = 48 * MiB;
constexpr size_t WS_WUPT = 50 * MiB, WS_WDT = 976 * MiB  , WS_ZT = 68 * MiB, WS_WQK = 80 * MiB, WS_VWO = 96 * MiB;
constexpr size_t WS_ACT8 = 240 * MiB;
constexpr size_t WS_GH = 416 * MiB, WS_UH = 424 * MiB, WS_GT = 432 * MiB;
constexpr size_t WS_A1 = 112 * MiB;
constexpr size_t WS_QKV = 368 * MiB;
constexpr size_t WS_Y = 752 * MiB, WS_HB1 = WS_A1 + 128 * MiB, WS_P = WS_QKV, WS_HB2 = WS_A1;
constexpr size_t WS_HB1F = WS_A1;
constexpr size_t WS_PO = WS_A1;
constexpr size_t WS_LIST = 880 * MiB, WS_PML = 944 * MiB, WS_KXF = 960 * MiB, WS_KXM = 968 * MiB, WS_CNT = 969 * MiB;
constexpr size_t WS_G = 240 * MiB, WS_U = 592 * MiB, WS_END = 1024 * MiB;
static_assert(WS_WUPT + (size_t)2 * FF * D * 2 <= WS_ZT && WS_ACT8 + (size_t)M * FF <= WS_GH && WS_WDT + (size_t)D * FF <= WS_END && WS_CNT + 8192 <= WS_WDT && WS_ZT + (size_t)8 * 256 * 3072 * 2 <= WS_WQK && WS_VWO + 16 * MiB <= WS_A1, "ws map");
static_assert(WS_G + (size_t)M * FF * 2 <= WS_U && WS_U + (size_t)M * FF * 2 <= WS_END && WS_Y + (size_t)M * D * 2 <= WS_LIST && WS_LIST + (size_t)2048 * 8192 * 4 <= WS_PML && WS_PML + (size_t)M * 32 * 8 <= WS_KXF && WS_KXF + (size_t)64 * 8192 * 16 <= WS_KXM, "ws map 2");
constexpr int CW_BAR = 4096;
constexpr int CW_QKN = 8192;
constexpr int CW_QUEUE = 12288;
constexpr int CW_T0TAB = 16384;
constexpr int CW_CNT_KM = 24576, CW_CNT_Z = 24640, CW_CNT_KV = 24704;
constexpr int CW_PANEL = 32768, CW_TMO2 = 20480;

constexpr int RING_OFF = 0, RING_BYTES = 131072;
constexpr int LDSCTL_OFF = RING_BYTES, MISC_OFF = LDSCTL_OFF + 320;
constexpr int XL_OFF = RING_BYTES + 512;
constexpr int LDS_BYTES = 147456;
static_assert(XL_OFF + 8192 <= LDS_BYTES, "LDS map");

#define GAS __attribute__((address_space(1)))
#define LAS __attribute__((address_space(3)))
typedef unsigned short bf16;
typedef unsigned v4u __attribute__((ext_vector_type(4)));
typedef float f32x4 __attribute__((ext_vector_type(4)));
typedef GAS unsigned gu32;
#define RLX_AGENT __ATOMIC_RELAXED, __HIP_MEMORY_SCOPE_AGENT
#define LDS_WAIT() asm volatile("s_waitcnt lgkmcnt(0)" ::: "memory")
__device__ __forceinline__ unsigned f2bf(float f) { unsigned u = __builtin_bit_cast(unsigned, f); return (u + 0x7fffu + ((u >> 16) & 1u)) >> 16; }
__device__ __forceinline__ unsigned pk2(float lo, float hi) { unsigned r; asm("v_cvt_pk_bf16_f32 %0, %1, %2" : "=v"(r) : "v"(lo), "v"(hi)); return r; }
__device__ __forceinline__ float bf2f(unsigned b) { return __builtin_bit_cast(float, b << 16); }
__device__ __forceinline__ float bflo(unsigned w) { return __builtin_bit_cast(float, w << 16); }
__device__ __forceinline__ float bfhi(unsigned w) { return __builtin_bit_cast(float, w & 0xffff0000u); }

#define XB_TMO      128
#define XB_XCNT(j)  (256  + 64 * (j))
#define XB_XSUB(j)  (1280 + 64 * (j))
#define XB_XGEN(j)  (2304 + 64 * (j))
#define XB_TOP      3328
#define XB_TOPGEN   3392
#define XCD_BAR_WORDS 3456
#define XB_SPIN_CAP (1u << 18)

__device__ __forceinline__ unsigned xb_ld(unsigned* p)              { return __hip_atomic_load(p, __ATOMIC_RELAXED, __HIP_MEMORY_SCOPE_AGENT); }
__device__ __forceinline__ unsigned xb_add(unsigned* p, unsigned v) { return __hip_atomic_fetch_add(p, v, __ATOMIC_RELAXED, __HIP_MEMORY_SCOPE_AGENT); }
__device__ __forceinline__ unsigned xb_xcc_id() { return (unsigned)__builtin_amdgcn_s_getreg((3 << 11) | 20) & 0xFu; }
#define XB_SPIN(cond, bar) do { unsigned _sp = 0; while (cond) { __builtin_amdgcn_s_sleep(1); \
    if ((++_sp & 255u) == 0u) { if (xb_ld(&(bar)[XB_TMO])) break; if (_sp > XB_SPIN_CAP) { atomicAdd(&(bar)[XB_TMO], 1u); break; } } } } while (0)

struct XcdBarrier { unsigned* bar; unsigned x; volatile LAS unsigned* st; };

__device__ __forceinline__ XcdBarrier xcd_barrier_post(unsigned* bar, volatile LAS unsigned* st) {
    XcdBarrier b; b.bar = bar; b.x = xb_xcc_id(); b.st = st;
    if (threadIdx.x == 0) (void)xb_add(&bar[XB_XCNT(b.x)], 1u);
    return b;
}
__device__ __forceinline__ void xcd_barrier_complete(unsigned* bar, unsigned x, unsigned& nloc, unsigned& nx) {
    const unsigned G = gridDim.x * gridDim.y * gridDim.z;
    unsigned sum, cnt, mine, sp = 0u;
    for (;;) {
        sum = 0u; cnt = 0u; mine = 0u;
#pragma unroll
        for (unsigned j = 0; j < 16; ++j) { const unsigned c = xb_ld(&bar[XB_XCNT(j)]); sum += c; cnt += (c > 0u) ? 1u : 0u; mine = (j == x) ? c : mine; }
        if (sum == G) break;
        __builtin_amdgcn_s_sleep(1);
        if ((++sp & 255u) == 0u) { if (xb_ld(&bar[XB_TMO])) break; if (sp > XB_SPIN_CAP) { atomicAdd(&bar[XB_TMO], 1u); break; } }
    }
    nloc = mine > 0u ? mine : 1u; nx = cnt > 0u ? cnt : 1u;
}
__device__ __forceinline__ void xcd_barrier(const XcdBarrier& b) {
    asm volatile("s_waitcnt vmcnt(0)" ::: "memory");
    __syncthreads();
    if (threadIdx.x == 0) {
        unsigned* bar = b.bar;
        __builtin_amdgcn_s_waitcnt(0);
        unsigned nloc = b.st[0], nx = b.st[1];
        if (nloc == 0u) { xcd_barrier_complete(bar, b.x, nloc, nx); b.st[0] = nloc; b.st[1] = nx; }
        const unsigned old = xb_add(&bar[XB_XSUB(b.x)], 1u);
        const unsigned gen = old / nloc;
        if (old + 1u == (gen + 1u) * nloc) {
            __builtin_amdgcn_fence(__ATOMIC_RELEASE, "agent");
            asm volatile("s_waitcnt vmcnt(0)" ::: "memory");
            const unsigned og = xb_add(&bar[XB_TOP], 1u);
            const unsigned tg = og / nx;
            if (og + 1u == (tg + 1u) * nx) xb_add(&bar[XB_TOPGEN], 1u);
            else XB_SPIN(xb_ld(&bar[XB_TOPGEN]) == tg, bar);
            __builtin_amdgcn_fence(__ATOMIC_ACQUIRE, "agent");
            xb_add(&bar[XB_XGEN(b.x)], 1u);
            asm volatile("s_waitcnt vmcnt(0)" ::: "memory");
        } else {
            XB_SPIN(xb_ld(&bar[XB_XGEN(b.x)]) == gen, bar);
            __builtin_amdgcn_fence(__ATOMIC_ACQUIRE, "agent");
            asm volatile("s_waitcnt vmcnt(0)" ::: "memory");
        }
    }
    __syncthreads();
}

__device__ __forceinline__ float wave_sum(float v) {
#pragma unroll
    for (int o = 1; o < 64; o <<= 1) v += __shfl_xor(v, o);
    return v;
}
__device__ __forceinline__ void p0_transpose_item(const float* W, int ldw, int K, int N, bf16* WT, const float* kscale, bool remap, LAS float* scr, int item, int lane, float f8scale = 0.f, bool upmap = false) {
    const int nblk = N / 64, kb = item / nblk, nb = item % nblk, k0 = 32 * kb, n0 = 64 * nb;
    int sn0 = (remap && n0 >= 1536) ? n0 + 8 : n0;
    if (upmap) { const int within = n0 & 255, pt = n0 >> 8; sn0 = within < 128 ? 128 * pt + within : 2816 + 128 * pt + (within - 128); }
    float v[32];
#pragma unroll
    for (int i = 0; i < 32; ++i) v[i] = W[(size_t)(k0 + i) * ldw + sn0 + lane];
#pragma unroll
    for (int i = 0; i < 32; ++i) { float x = v[i]; if (kscale) x *= kscale[k0 + i]; scr[i * 65 + lane] = x; }
    LDS_WAIT(); asm volatile("" ::: "memory");
    const int kq = lane & 3;
#pragma unroll
    for (int j = 0; j < 4; ++j) { const int n = (lane >> 2) + 16 * j; const LAS float* sp = scr + (8 * kq) * 65 + n;
        if (f8scale != 0.f) { const unsigned lo = pg8::pk4_fp8(sp[0 * 65] * f8scale, sp[1 * 65] * f8scale, sp[2 * 65] * f8scale, sp[3 * 65] * f8scale), hi = pg8::pk4_fp8(sp[4 * 65] * f8scale, sp[5 * 65] * f8scale, sp[6 * 65] * f8scale, sp[7 * 65] * f8scale);
            *(GAS unsigned long long*)((unsigned char*)WT + (size_t)(n0 + n) * K + k0 + 8 * kq) = (unsigned long long)lo | ((unsigned long long)hi << 32); }
        else { v4u o; o.x = pk2(sp[0 * 65], sp[1 * 65]); o.y = pk2(sp[2 * 65], sp[3 * 65]); o.z = pk2(sp[4 * 65], sp[5 * 65]); o.w = pk2(sp[6 * 65], sp[7 * 65]);
            *(GAS v4u*)(WT + (size_t)(n0 + n) * K + k0 + 8 * kq) = o; } }
    LDS_WAIT(); asm volatile("" ::: "memory");
}

struct Args { const float* in[19]; float* out; unsigned char* ws; };
__device__ __forceinline__ float skip_thr(const unsigned* qk8, int moba) {
    const unsigned* p = qk8 + 4 * moba;
    const float qn = sqrtf(__uint_as_float(__hip_atomic_load(p, RLX_AGENT)) + __uint_as_float(__hip_atomic_load(p + 1, RLX_AGENT))), kn = sqrtf(__uint_as_float(__hip_atomic_load(p + 2, RLX_AGENT)) + __uint_as_float(__hip_atomic_load(p + 3, RLX_AGENT)));
    return 2.0f * qn * kn * 1.02f + 29.0f;
}
__device__ __forceinline__ bool moba_skip(int h, int j, int n, float thr) { return __builtin_amdgcn_exp2f(-(float)(h + 1)) * LOG2E * (float)(256 * (j - n - 1) + 1) >= thr; }

namespace attn_body {
using hb16=__hip_bfloat16;
using bf16x8=__attribute__((ext_vector_type(8)))short;
using s16x4=__attribute__((ext_vector_type(4)))short;
using f32x16=__attribute__((ext_vector_type(16)))float;
using u32x4=__attribute__((ext_vector_type(4)))unsigned;
constexpr int PITCH=3072;
constexpr int NW=8,QBLK=32,QB=QBLK*NW,KVBLK=64;
__device__ __forceinline__ int crow(int r,int hi){return (r&3)+8*(r>>2)+4*hi;}
#define SBAR() __builtin_amdgcn_sched_barrier(0)
__device__ __forceinline__ void cmask(f32x16&p0,f32x16&p1,int jb,int qrel,int hi){
  const float NEG=-INFINITY; int kb=64*jb+4*hi;
  #pragma unroll
  for(int r=0;r<16;++r){int kv=kb+(r&3)+8*(r>>2); if(kv>qrel)p0[r]=NEG; if(kv+32>qrel)p1[r]=NEG;}
}
constexpr int NSLOT=3, SLOTB=9216;
constexpr int LDS_K=0, LDS_V=NSLOT*SLOTB, LDS_WS=2*NSLOT*SLOTB, LDS_OST=LDS_WS+NW*64*4, LDS_BYTES=LDS_OST+NW*4096;
__device__ __forceinline__ void glds16(const void*gsrc,unsigned lds_dst){unsigned keep;
  asm volatile("s_mov_b32 %0, m0\n\ts_mov_b32 m0, %2\n\ts_nop 0\n\tglobal_load_lds_dwordx4 %1, off\n\ts_mov_b32 m0, %0":"=&s"(keep):"v"(gsrc),"s"(lds_dst):"memory");}
__device__ __forceinline__ void glds16x(const void*gsrc,unsigned lds_dst){unsigned keep;unsigned long long ex;
  asm volatile("s_mov_b32 %0, m0\n\ts_mov_b64 %1, exec\n\ts_mov_b64 exec, 0xff\n\ts_mov_b32 m0, %3\n\ts_nop 0\n\tglobal_load_lds_dwordx4 %2, off\n\ts_mov_b64 exec, %1\n\ts_mov_b32 m0, %0":"=&s"(keep),"=&s"(ex):"v"(gsrc),"s"(lds_dst):"memory");}
__device__ __forceinline__ float max3f(float a,float b,float c){float r;asm("v_max3_f32 %0, %1, %2, %3":"=v"(r):"v"(a),"v"(b),"v"(c));return r;}
__device__ __forceinline__ float max2f(float a,float b){float r;asm("v_max_f32_e32 %0, %1, %2":"=v"(r):"v"(a),"v"(b));return r;}
__device__ __forceinline__ float fsub_s(float a,float b){float r;asm("v_sub_f32_e32 %0, %1, %2":"=v"(r):"v"(a),"v"(b));return r;}
typedef float f32x2_t __attribute__((ext_vector_type(2))); typedef __bf16 bf16x2_t __attribute__((ext_vector_type(2)));
__device__ __forceinline__ unsigned cvtpk_s(float lo,float hi){f32x2_t v={lo,hi};bf16x2_t b=__builtin_convertvector(v,bf16x2_t);return __builtin_bit_cast(unsigned,b);}
__device__ __forceinline__ float rbf(float x){return __builtin_bit_cast(float,cvtpk_s(x,0.f)<<16);}
#define WAIT_BAR(N) asm volatile("s_waitcnt vmcnt(" #N ") lgkmcnt(0)\n\ts_barrier":::"memory")

__device__ __forceinline__ void qkt(f32x16&p0,f32x16&p1,const char*Kslot,const bf16x8*qr,int r32,int hi){
  const char*kb=Kslot+hi*1024+r32*16; const f32x16 zf={};
  #pragma unroll
  for(int d0=0;d0<4;++d0){
    const bf16x8 b0=*reinterpret_cast<const bf16x8*>(kb+d0*2048);
    const bf16x8 b1=*reinterpret_cast<const bf16x8*>(kb+d0*2048+512);
    if(d0==0){p0=__builtin_amdgcn_mfma_f32_32x32x16_bf16(b0,qr[0],zf,0,0,0);p1=__builtin_amdgcn_mfma_f32_32x32x16_bf16(b1,qr[0],zf,0,0,0);}
    else{p0=__builtin_amdgcn_mfma_f32_32x32x16_bf16(b0,qr[d0],p0,0,0,0);p1=__builtin_amdgcn_mfma_f32_32x32x16_bf16(b1,qr[d0],p1,0,0,0);}}
  const char*kx=Kslot+8192+r32*16;
  const bf16x8 x0=*reinterpret_cast<const bf16x8*>(kx), x1=*reinterpret_cast<const bf16x8*>(kx+512);
  p0=__builtin_amdgcn_mfma_f32_32x32x16_bf16(x0,qr[4],p0,0,0,0);p1=__builtin_amdgcn_mfma_f32_32x32x16_bf16(x1,qr[4],p1,0,0,0);
}
typedef __attribute__((address_space(3))) const char* lds_cptr;
typedef short v4i16_t __attribute__((ext_vector_type(4)));
__device__ __forceinline__ void kload10(bf16x8*kf,lds_cptr kp,lds_cptr kx){
  kf[0]=*(const __attribute__((address_space(3))) bf16x8*)(kp);      kf[1]=*(const __attribute__((address_space(3))) bf16x8*)(kp+512);
  kf[2]=*(const __attribute__((address_space(3))) bf16x8*)(kp+2048); kf[3]=*(const __attribute__((address_space(3))) bf16x8*)(kp+2560);
  kf[4]=*(const __attribute__((address_space(3))) bf16x8*)(kp+4096); kf[5]=*(const __attribute__((address_space(3))) bf16x8*)(kp+4608);
  kf[6]=*(const __attribute__((address_space(3))) bf16x8*)(kp+6144); kf[7]=*(const __attribute__((address_space(3))) bf16x8*)(kp+6656);
  kf[8]=*(const __attribute__((address_space(3))) bf16x8*)(kx);      kf[9]=*(const __attribute__((address_space(3))) bf16x8*)(kx+512);
}
__device__ __forceinline__ void kload2(bf16x8*kf,lds_cptr kp,int j){ kf[2*j]=*(const __attribute__((address_space(3))) bf16x8*)(kp+j*2048); kf[2*j+1]=*(const __attribute__((address_space(3))) bf16x8*)(kp+j*2048+512); }
__device__ __forceinline__ s16x4 vtr(lds_cptr p){ return __builtin_bit_cast(s16x4,__builtin_amdgcn_ds_read_tr16_b64_v4i16((__attribute__((address_space(3))) v4i16_t*)p)); }
__device__ __forceinline__ float rowmax(const f32x16&p0,const f32x16&p1){
  float a=max3f(p0[0],p0[1],p1[0]),b=max3f(p0[2],p0[3],p1[1]);a=max3f(a,p1[2],p1[3]);
  #pragma unroll
  for(int r=4;r<16;r+=4){a=max3f(a,p0[r],p0[r+1]);b=max3f(b,p0[r+2],p0[r+3]);a=max3f(a,p1[r],p1[r+1]);b=max3f(b,p1[r+2],p1[r+3]);}
  const float m=max2f(a,b);
  auto rr=__builtin_amdgcn_permlane32_swap(__float_as_uint(m),__float_as_uint(m),false,false);
  return max2f(__uint_as_float(rr[0]),__uint_as_float(rr[1]));
}
__device__ __forceinline__ void pv(f32x16*o,int vb,bf16x8 pa0,bf16x8 pa1,bf16x8 pa2,bf16x8 pa3){
  #pragma unroll
  for(int d0=0;d0<2;++d0){s16x4 lo[4],hi[4];
    #pragma unroll
    for(int ks=0;ks<4;++ks){
      asm volatile("ds_read_b64_tr_b16 %0,%1 offset:%c2":"=&v"(lo[ks]):"v"(vb),"i"(d0*4096+ks*1024):"memory");
      asm volatile("ds_read_b64_tr_b16 %0,%1 offset:%c2":"=&v"(hi[ks]):"v"(vb),"i"(d0*4096+ks*1024+512):"memory");}
    asm volatile("s_waitcnt lgkmcnt(0)":::"memory");SBAR();
    #define PK(k) (bf16x8){lo[k][0],lo[k][1],lo[k][2],lo[k][3],hi[k][0],hi[k][1],hi[k][2],hi[k][3]}
    o[d0]=__builtin_amdgcn_mfma_f32_32x32x16_bf16(pa0,PK(0),o[d0],0,0,0);
    o[d0]=__builtin_amdgcn_mfma_f32_32x32x16_bf16(pa1,PK(1),o[d0],0,0,0);
    o[d0]=__builtin_amdgcn_mfma_f32_32x32x16_bf16(pa2,PK(2),o[d0],0,0,0);
    o[d0]=__builtin_amdgcn_mfma_f32_32x32x16_bf16(pa3,PK(3),o[d0],0,0,0);
    #undef PK
  }
}

template<int THRL> __device__ __forceinline__ void attn_unit(char*shm,const int KIND,const hb16*Qc,int qrow,int oslot,const hb16*__restrict__ Kt0,const hb16*__restrict__ Vt0,const hb16*__restrict__ KXt0,int NT,int band0,hb16*Oc,hb16*PO,float*PML){
  const int tid=threadIdx.x,lane=tid&63,r32=lane&31,hi=lane>>5; const int wid=__builtin_amdgcn_readfirstlane(tid>>6);
  const unsigned lds0=(unsigned)(uintptr_t)shm;
  float*wsf=(float*)(shm+LDS_WS)+wid*64;
  const hb16*ksrc=Kt0+(long)lane*PITCH+wid*8;
  const hb16*vsrc=Vt0+(long)(16*(wid&3)+(lane>>2))*PITCH+(wid>>2)*32+(lane&3)*8;
  const hb16*xsrc=KXt0+(long)(8*wid+(lane&7))*8;
  const unsigned kdst=lds0+LDS_K+wid*1024, vdst=lds0+LDS_V+wid*1024, xdst=lds0+LDS_K+8192+wid*128;
  #define DMA_K(t,slot) do{ glds16(ksrc+(long)(t)*KVBLK*PITCH,(unsigned)__builtin_amdgcn_readfirstlane(kdst+(slot))); glds16x(xsrc+(long)(t)*KVBLK*8,(unsigned)__builtin_amdgcn_readfirstlane(xdst+(slot))); }while(0)
  #define DMA_V(t,slot) glds16(vsrc+(long)(t)*KVBLK*PITCH,(unsigned)__builtin_amdgcn_readfirstlane(vdst+(slot)))
  const int vb0=(int)(lds0+LDS_V)+((lane>>4)&1)*32+(lane&3)*8+(4*hi+((lane&15)>>2))*64;
  const char*Kbase=shm+LDS_K; bf16x8 kf[10];
  const lds_cptr shm3=(lds_cptr)shm; const lds_cptr kp0=shm3+LDS_K+hi*1024+r32*16; const lds_cptr kx0=shm3+LDS_K+8192+r32*16; const lds_cptr vp0=shm3+LDS_V+((lane>>4)&1)*32+(lane&3)*8+(4*hi+((lane&15)>>2))*64;
  DMA_K(0,0);DMA_V(0,0);DMA_K(1,SLOTB);
  bf16x8 qr[5];
  { const hb16*Qw=Qc+(long)qrow*PITCH;
    #pragma unroll
    for(int d0=0;d0<4;++d0)qr[d0]=*reinterpret_cast<const bf16x8*>(&Qw[d0*16+hi*8]); }
  float mhat=0.f,l_reg=0.f;f32x16 o[2];o[0]=f32x16{};o[1]=f32x16{};
  #define SETQX(mh_,ml_) do{ const unsigned bh_=cvtpk_s(-(mh_),-(ml_)); u32x4 qx_; qx_.x=0x3F803F80u; qx_.y=0x3F80u|(bh_<<16); qx_.z=(bh_>>16); qx_.w=0u; if(hi){qx_.x=0u;qx_.y=0u;qx_.z=0u;} qr[4]=__builtin_bit_cast(bf16x8,qx_); asm volatile("":"+v"(qr[4])); }while(0)
  #define MOVEREF(gain) const float mraw_=mhat+(gain); const float mh_=rbf(mraw_); const float ml_=rbf(mraw_-mh_); const float mnew_=mh_+ml_; const float dl=mnew_-mhat; mhat=mnew_; SETQX(mh_,ml_);
  SETQX(0.f,0.f);
  const int qrel=wid*QBLK+r32;
  #define CMASK(P0,P1,t) do{int jb_=(t)-band0; if(jb_>=0)cmask(P0,P1,jb_,qrel,hi);}while(0)
  bool resc=false;
  #define START(P0,P1) do{ const float rm=rowmax(P0,P1); resc=false; \
    { MOVEREF(rm) \
      _Pragma("unroll") for(int r=0;r<16;++r){P0[r]=fsub_s(P0[r],dl);P1[r]=fsub_s(P1[r],dl);} } \
    _Pragma("unroll") for(int r=0;r<16;++r)P0[r]=__builtin_amdgcn_exp2f(P0[r]); }while(0)
  #define RESC() do{ if(resc){ asm volatile("s_waitcnt lgkmcnt(0)":::"memory"); \
      _Pragma("unroll") for(int d_=0;d_<2;++d_) _Pragma("unroll") for(int r=0;r<16;++r)o[d_][r]*=wsf[crow(r,hi)]; } }while(0)
  f32x16 pA0,pA1,pB0,pB1;
  int sl_prev=0,sl_cur=0,sl_next=SLOTB;
  #define ROT() do{sl_prev=sl_cur;sl_cur=sl_next;sl_next=(sl_next==(NSLOT-1)*SLOTB)?0:sl_next+SLOTB;}while(0)
  DMA_K(2,2*SLOTB);
  WAIT_BAR(5);
  qkt(pA0,pA1,Kbase,qr,r32,hi);asm volatile("s_nop 15\n\ts_nop 7":"+v"(pA0),"+v"(pA1));CMASK(pA0,pA1,0);
  START(pA0,pA1);
  _Pragma("unroll") for(int r=0;r<16;++r)pA1[r]=__builtin_amdgcn_exp2f(pA1[r]);
  WAIT_BAR(0);
  DMA_K(3,0);DMA_V(1,SLOTB);
  ROT();
  kload10(kf,kp0+sl_cur,kx0+sl_cur);
  WAIT_BAR(3);
  s16x4 vlo[8],vhi[8]; u32x4 pw0,pw1,pw2,pw3; const f32x16 zf={};
  #define PKW(P,B) cvtpk_s(P[B],P[B+1])
  #define PAF(k) __builtin_bit_cast(bf16x8,pw##k)
  #define VFR(i) (bf16x8){vlo[i][0],vlo[i][1],vlo[i][2],vlo[i][3],vhi[i][0],vhi[i][1],vhi[i][2],vhi[i][3]}
  #define PIN(x) asm volatile("":"+v"(x))
  #define MX3(a,b,c) __builtin_fmaxf(__builtin_fmaxf((a),(b)),(c))
  #define GAPA(MF,A0,A1,A2,A3,W0,W1,PW) do{ MF; sacc+=A0; sacc+=A1; sacc+=A2; sacc+=A3; PIN(sacc); W0; W1; PIN(PW); SBAR(); }while(0)
  #define EX(v) __builtin_amdgcn_exp2f(v)
  #define GAPB(MF,X,B) do{ MF; X[B]=EX(X[B]); X[B+1]=EX(X[B+1]); X[B+2]=EX(X[B+2]); X[B+3]=EX(X[B+3]); PIN(X); SBAR(); }while(0)
  #define VRD(i) do{ vlo[i]=vtr(vp_+(((i)>>2)*4096+((i)&3)*1024)); vhi[i]=vtr(vp_+(((i)>>2)*4096+((i)&3)*1024+512)); }while(0)
  #define KRD(G,j) do{ if(G){ kload2(kf,kp0+sl_next,j); SBAR(); } }while(0)
  #define KRDX(G) do{ if(G){ kf[8]=*(const __attribute__((address_space(3))) bf16x8*)(kx0+sl_next); kf[9]=*(const __attribute__((address_space(3))) bf16x8*)(kx0+sl_next+512); SBAR(); } }while(0)
  #define STEP(C0,C1,P0,P1,t,GK,GV,GL) do{ SBAR(); \
    const lds_cptr vp_=vp0+sl_prev; \
    VRD(0); SBAR(); float sacc=(P0[0]+P0[1]); \
    GAPA(C0=__builtin_amdgcn_mfma_f32_32x32x16_bf16(kf[0],qr[0],zf,0,0,0), P0[2],P0[3],P0[4],P0[5],     pw0[0]=PKW(P0,0), pw0[1]=PKW(P0,2), pw0); \
    VRD(4); SBAR(); GAPA(C1=__builtin_amdgcn_mfma_f32_32x32x16_bf16(kf[1],qr[0],zf,0,0,0), P0[6],P0[7],P0[8],P0[9],     pw0[2]=PKW(P0,4), pw0[3]=PKW(P0,6), pw0); \
    VRD(1); SBAR(); GAPA(C0=__builtin_amdgcn_mfma_f32_32x32x16_bf16(kf[2],qr[1],C0,0,0,0),   P0[10],P0[11],P0[12],P0[13], pw1[0]=PKW(P0,8), pw1[1]=PKW(P0,10), pw1); \
    VRD(5); SBAR(); GAPA(C1=__builtin_amdgcn_mfma_f32_32x32x16_bf16(kf[3],qr[1],C1,0,0,0),   P0[14],P0[15],P1[0],P1[1],   pw1[2]=PKW(P0,12),pw1[3]=PKW(P0,14), pw1); \
    VRD(2); SBAR(); GAPA(C0=__builtin_amdgcn_mfma_f32_32x32x16_bf16(kf[4],qr[2],C0,0,0,0),   P1[2],P1[3],P1[4],P1[5],     pw2[0]=PKW(P1,0), pw2[1]=PKW(P1,2), pw2); \
    VRD(6); SBAR(); GAPA(C1=__builtin_amdgcn_mfma_f32_32x32x16_bf16(kf[5],qr[2],C1,0,0,0),   P1[6],P1[7],P1[8],P1[9],     pw2[2]=PKW(P1,4), pw2[3]=PKW(P1,6), pw2); \
    VRD(3); SBAR(); GAPA(C0=__builtin_amdgcn_mfma_f32_32x32x16_bf16(kf[6],qr[3],C0,0,0,0),   P1[10],P1[11],P1[12],P1[13], pw3[0]=PKW(P1,8), pw3[1]=PKW(P1,10), pw3); \
    VRD(7); SBAR(); GAPA(C1=__builtin_amdgcn_mfma_f32_32x32x16_bf16(kf[7],qr[3],C1,0,0,0),   P1[14],P1[15],0.f,0.f,       pw3[2]=PKW(P1,12),pw3[3]=PKW(P1,14), pw3); \
    C0=__builtin_amdgcn_mfma_f32_32x32x16_bf16(kf[8],qr[4],C0,0,0,0); SBAR(); \
    C1=__builtin_amdgcn_mfma_f32_32x32x16_bf16(kf[9],qr[4],C1,0,0,0); SBAR(); \
    l_reg+=sacc; \
    if(GK){DMA_K((t)+3,sl_cur);} if(GV){DMA_V((t)+1,sl_next);} \
    CMASK(C0,C1,t); \
    { float a=MX3(C0[0],C0[1],C1[0]),b=MX3(C0[2],C0[3],C1[1]); a=MX3(a,C1[2],C1[3]); \
      _Pragma("unroll") for(int r=4;r<16;r+=4){a=MX3(a,C0[r],C0[r+1]);b=MX3(b,C0[r+2],C0[r+3]);a=MX3(a,C1[r],C1[r+1]);b=MX3(b,C1[r+2],C1[r+3]);} \
      float rm=__builtin_fmaxf(a,b); { auto rr=__builtin_amdgcn_permlane32_swap(__float_as_uint(rm),__float_as_uint(rm),false,false); rm=__builtin_fmaxf(__uint_as_float(rr[0]),__uint_as_float(rr[1])); } \
      resc=false; \
      if(__builtin_expect(__any(rm>(float)THRL),0)){ MOVEREF(__builtin_fmaxf(rm,0.f)) \
        _Pragma("unroll") for(int r=0;r<16;++r){C0[r]-=dl;C1[r]-=dl;} \
        const float f=__builtin_amdgcn_exp2f(-dl); l_reg*=f; if(hi==0)wsf[r32]=f; resc=true; } } \
    SBAR(); \
    GAPB(o[0]=__builtin_amdgcn_mfma_f32_32x32x16_bf16(PAF(0),VFR(0),o[0],0,0,0), C0,0); \
    GAPB(o[1]=__builtin_amdgcn_mfma_f32_32x32x16_bf16(PAF(0),VFR(4),o[1],0,0,0), C0,4); \
    KRD(GL,0); GAPB(o[0]=__builtin_amdgcn_mfma_f32_32x32x16_bf16(PAF(1),VFR(1),o[0],0,0,0), C0,8); \
    KRD(GL,1); GAPB(o[1]=__builtin_amdgcn_mfma_f32_32x32x16_bf16(PAF(1),VFR(5),o[1],0,0,0), C0,12); \
    KRD(GL,2); GAPB(o[0]=__builtin_amdgcn_mfma_f32_32x32x16_bf16(PAF(2),VFR(2),o[0],0,0,0), C1,0); \
    KRD(GL,3); GAPB(o[1]=__builtin_amdgcn_mfma_f32_32x32x16_bf16(PAF(2),VFR(6),o[1],0,0,0), C1,4); \
    KRDX(GL); GAPB(o[0]=__builtin_amdgcn_mfma_f32_32x32x16_bf16(PAF(3),VFR(3),o[0],0,0,0), C1,8); \
    GAPB(o[1]=__builtin_amdgcn_mfma_f32_32x32x16_bf16(PAF(3),VFR(7),o[1],0,0,0), C1,12); \
    }while(0)
  int t=1;
  for(;t+5<NT&&t+1<band0;t+=2){
    #undef CMASK
    #define CMASK(P0,P1,t) do{}while(0)
    STEP(pB0,pB1,pA0,pA1,t,true,true,true);     WAIT_BAR(3); RESC(); ROT();
    STEP(pA0,pA1,pB0,pB1,t+1,true,true,true);   WAIT_BAR(3); RESC(); ROT();
  }
  #undef CMASK
  #define CMASK(P0,P1,t) do{int jb_=(t)-band0; if(jb_>=0)cmask(P0,P1,jb_,qrel,hi);}while(0)
  #define ENDW(tt) do{ if((tt)+3<NT){WAIT_BAR(3);} else if((tt)+2<NT){WAIT_BAR(1);} else {WAIT_BAR(0);} }while(0)
  for(;t+1<NT;t+=2){
    STEP(pB0,pB1,pA0,pA1,t,(t+3<NT),(t+1<NT),(t+1<NT));       ENDW(t);   RESC(); ROT();
    STEP(pA0,pA1,pB0,pB1,t+1,(t+4<NT),(t+2<NT),(t+2<NT));     ENDW(t+1); RESC(); ROT();
  }
  STEP(pB0,pB1,pA0,pA1,NT-1,false,false,false); RESC();
  { float sacc=pB0[0]+pB0[1]; _Pragma("unroll") for(int r=2;r<16;++r)sacc+=pB0[r]; _Pragma("unroll") for(int r=0;r<16;++r)sacc+=pB1[r]; l_reg+=sacc;
    pw0=(u32x4){PKW(pB0,0),PKW(pB0,2),PKW(pB0,4),PKW(pB0,6)};pw1=(u32x4){PKW(pB0,8),PKW(pB0,10),PKW(pB0,12),PKW(pB0,14)};pw2=(u32x4){PKW(pB1,0),PKW(pB1,2),PKW(pB1,4),PKW(pB1,6)};pw3=(u32x4){PKW(pB1,8),PKW(pB1,10),PKW(pB1,12),PKW(pB1,14)};
    SBAR(); pv(o,vb0+sl_cur,PAF(0),PAF(1),PAF(2),PAF(3)); }
  #undef PKW
  #undef PAF
  #undef VFR
  #undef PIN
  #undef MX3
  #undef GAPA
  #undef GAPB
  #undef EX
  #undef VRD
  #undef KRD
  #undef KRDX
  #undef STEP
  #undef ENDW
  {auto rr=__builtin_amdgcn_permlane32_swap(__float_as_uint(l_reg),__float_as_uint(l_reg),false,false);l_reg=__uint_as_float(rr[0])+__uint_as_float(rr[1]);}
  if(hi==0)wsf[32+r32]=l_reg;asm volatile("s_waitcnt lgkmcnt(0)":::"memory");
  float rli[16];
  #pragma unroll
  for(int r=0;r<16;++r)rli[r]=__builtin_amdgcn_rcpf(wsf[32+crow(r,hi)]);
  if(KIND==1){ if(hi==0&&oslot>=0){ f32x2_t ml={mhat,l_reg}; *(f32x2_t*)(PML+(long)oslot*2)=ml; } }
  { hb16*stg=(hb16*)(shm+LDS_OST)+wid*2048;
    #pragma unroll
    for(int r=0;r<16;++r){const int orow=crow(r,hi);
      #pragma unroll
      for(int d0=0;d0<2;++d0)stg[orow*64+d0*32+r32]=__float2bfloat16(o[d0][r]*rli[r]);}
    asm volatile("s_waitcnt lgkmcnt(0)":::"memory");
    #pragma unroll
    for(int i=0;i<4;++i){const int row=i*8+(lane>>3),ch=lane&7; const u32x4 v=*(const u32x4*)(stg+row*64+ch*8);
      if(KIND==0){ const int gr=__shfl(qrow,row); *(u32x4*)(Oc+(long)gr*PITCH+ch*8)=v; }
      else { const int gs=__shfl(oslot,row); if(gs>=0) *(u32x4*)(PO+(long)gs*64+ch*8)=v; } } }
  asm volatile("s_waitcnt lgkmcnt(0)\n\ts_barrier":::"memory");
  #undef DMA_K
  #undef DMA_V
  #undef CMASK
  #undef START
  #undef RESC
  #undef ROT
  #undef SETQX
  #undef MOVEREF
}
constexpr int MB_K=0, MB_V=4*SLOTB, MB_WS=MB_V+4*8192, MB_OST=MB_WS+NW*64*4, MB_BYTES=MB_OST+NW*4096;
template<int THRL> __device__ __forceinline__ void moba_item(char*shm,const hb16*Qc,const int browbase,const int h,const int nblk,const unsigned*lst,const int cnt,const int g0,const int g1,
    const hb16*Kt0,const hb16*KXt0,hb16*PO,float*PML){
  const int tid=threadIdx.x,lane=tid&63,r32=lane&31,hi=lane>>5; const int wid=__builtin_amdgcn_readfirstlane(tid>>6);
  const unsigned lds0=(unsigned)(uintptr_t)shm;
  float*wsf=(float*)(shm+MB_WS)+wid*64;
  asm volatile("s_waitcnt lgkmcnt(0)\n\ts_barrier":::"memory");
  { const hb16*ksrc=Kt0+(long)lane*PITCH+wid*8; const hb16*vsrc=Kt0+512+(long)(16*(wid&3)+(lane>>2))*PITCH+(wid>>2)*32+(lane&3)*8; const hb16*xsrc=KXt0+(long)(8*wid+(lane&7))*8;
    #pragma unroll
    for(int t=0;t<4;++t){ glds16(ksrc+(long)t*KVBLK*PITCH,(unsigned)__builtin_amdgcn_readfirstlane(lds0+MB_K+t*SLOTB+wid*1024)); glds16x(xsrc+(long)t*KVBLK*8,(unsigned)__builtin_amdgcn_readfirstlane(lds0+MB_K+t*SLOTB+8192+wid*128));
      glds16(vsrc+(long)t*KVBLK*PITCH,(unsigned)__builtin_amdgcn_readfirstlane(lds0+MB_V+t*8192+wid*1024)); } }
  asm volatile("s_waitcnt vmcnt(0)\n\ts_barrier":::"memory");
  const int vb0=(int)(lds0+MB_V)+((lane>>4)&1)*32+(lane&3)*8+(4*hi+((lane&15)>>2))*64;
  #define SETQX(mh_,ml_) do{ const unsigned bh_=cvtpk_s(-(mh_),-(ml_)); u32x4 qx_; qx_.x=0x3F803F80u; qx_.y=0x3F80u|(bh_<<16); qx_.z=(bh_>>16); qx_.w=0u; if(hi){qx_.x=0u;qx_.y=0u;qx_.z=0u;} qr[4]=__builtin_bit_cast(bf16x8,qx_); asm volatile("":"+v"(qr[4])); }while(0)
  #define MOVEREF(gain) const float mraw_=mhat+(gain); const float mh_=rbf(mraw_); const float ml_=rbf(mraw_-mh_); const float mnew_=mh_+ml_; const float dl=mnew_-mhat; mhat=mnew_; SETQX(mh_,ml_);
  #define LENT(gg) (((gg)>=8&&(gg)<g1)?lst[((gg)-8)*32+r32]:0u)
  #define GROW(gg,ee) (((gg)<8)?(browbase+nblk*256+(gg)*32+r32):(browbase+(int)((ee)&0x1fffu)))
  unsigned e_cur=LENT(g0+wid), e_nxt=LENT(g0+wid+NW);
  bf16x8 qn[4];
  { const hb16*Qw=Qc+(long)GROW(g0+wid,e_cur)*PITCH;
    #pragma unroll
    for(int d0=0;d0<4;++d0)qn[d0]=*reinterpret_cast<const bf16x8*>(&Qw[d0*16+hi*8]); }
  for(int g=g0+wid;g<g1;g+=NW){
    const bool own=g<8; const int qrow=GROW(g,e_cur); int oslot;
    if(own) oslot=(qrow*8+h)*4+3; else oslot=((g-8)*32+r32<cnt)?(qrow*8+h)*4+(int)((e_cur>>16)&3u):-1;
    bf16x8 qr[5];
    #pragma unroll
    for(int d0=0;d0<4;++d0)qr[d0]=qn[d0];
    { const int gn=(g+NW<g1)?g+NW:g; const unsigned en=(g+NW<g1)?e_nxt:e_cur; const hb16*Qw=Qc+(long)GROW(gn,en)*PITCH;
      #pragma unroll
      for(int d0=0;d0<4;++d0)qn[d0]=*reinterpret_cast<const bf16x8*>(&Qw[d0*16+hi*8]); }
    const unsigned e_n2=LENT(g+2*NW); e_cur=e_nxt; e_nxt=e_n2;
    float mhat=0.f,l_reg=0.f;f32x16 o[2];o[0]=f32x16{};o[1]=f32x16{};
    SETQX(0.f,0.f);
    const int tlast=own?((32*g+31)>>6):3;
    #define PKW(P,B) cvtpk_s(P[B],P[B+1])
    #define PROC(P0,P1,T_,ISFIRST,MREF_) do{ \
      if(own&&64*(T_)+63>32*g)cmask(P0,P1,(T_),32*g+r32,hi);   \
      const float adj_=mhat-(MREF_); const float rm=rowmax(P0,P1)-adj_; float sub_=adj_; \
      if(ISFIRST){ MOVEREF(rm) sub_+=dl; } \
      else if(__any(rm>(float)THRL)){ MOVEREF(__builtin_fmaxf(rm,0.f)) sub_+=dl; \
        const float f=__builtin_amdgcn_exp2f(-dl); l_reg*=f; if(hi==0)wsf[r32]=f; asm volatile("s_waitcnt lgkmcnt(0)":::"memory"); \
        _Pragma("unroll") for(int d_=0;d_<2;++d_) _Pragma("unroll") for(int r=0;r<16;++r)o[d_][r]*=wsf[crow(r,hi)]; } \
      float sacc=0.f; \
      _Pragma("unroll") for(int r=0;r<16;++r){P0[r]=__builtin_amdgcn_exp2f(P0[r]-sub_);P1[r]=__builtin_amdgcn_exp2f(P1[r]-sub_);sacc+=P0[r]+P1[r];} \
      l_reg+=sacc; \
      const u32x4 pw0=(u32x4){PKW(P0,0),PKW(P0,2),PKW(P0,4),PKW(P0,6)},pw1=(u32x4){PKW(P0,8),PKW(P0,10),PKW(P0,12),PKW(P0,14)},pw2=(u32x4){PKW(P1,0),PKW(P1,2),PKW(P1,4),PKW(P1,6)},pw3=(u32x4){PKW(P1,8),PKW(P1,10),PKW(P1,12),PKW(P1,14)}; \
      pv(o,vb0+(T_)*8192,__builtin_bit_cast(bf16x8,pw0),__builtin_bit_cast(bf16x8,pw1),__builtin_bit_cast(bf16x8,pw2),__builtin_bit_cast(bf16x8,pw3)); }while(0)
    int t=0;
    for(;t+1<=tlast;t+=2){
      f32x16 a0,a1,b0,b1; const float mref=mhat;
      qkt(a0,a1,shm+MB_K+t*SLOTB,qr,r32,hi); qkt(b0,b1,shm+MB_K+(t+1)*SLOTB,qr,r32,hi);
      asm volatile("s_nop 15\n\ts_nop 7":"+v"(a0),"+v"(a1));
      PROC(a0,a1,t,t==0,mref);
      asm volatile("s_nop 7":"+v"(b0),"+v"(b1));
      PROC(b0,b1,t+1,false,mref);
    }
    if(t<=tlast){ f32x16 a0,a1; const float mref=mhat;
      qkt(a0,a1,shm+MB_K+t*SLOTB,qr,r32,hi); asm volatile("s_nop 15\n\ts_nop 7":"+v"(a0),"+v"(a1));
      PROC(a0,a1,t,t==0,mref); }
    #undef PROC
    #undef PKW
    {auto rr=__builtin_amdgcn_permlane32_swap(__float_as_uint(l_reg),__float_as_uint(l_reg),false,false);l_reg=__uint_as_float(rr[0])+__uint_as_float(rr[1]);}
    if(hi==0)wsf[32+r32]=l_reg;asm volatile("s_waitcnt lgkmcnt(0)":::"memory");
    float rli[16];
    #pragma unroll
    for(int r=0;r<16;++r)rli[r]=__builtin_amdgcn_rcpf(wsf[32+crow(r,hi)]);
    if(hi==0&&oslot>=0){ f32x2_t ml={mhat,l_reg}; *(f32x2_t*)(PML+(long)oslot*2)=ml; }
    { hb16*stg=(hb16*)(shm+MB_OST)+wid*2048;
      #pragma unroll
      for(int r=0;r<16;++r){const int orow=crow(r,hi);
        #pragma unroll
        for(int d0=0;d0<2;++d0)stg[orow*64+d0*32+r32]=__float2bfloat16(o[d0][r]*rli[r]);}
      asm volatile("s_waitcnt lgkmcnt(0)":::"memory");
      #pragma unroll
      for(int i=0;i<4;++i){const int row=i*8+(lane>>3),ch=lane&7; const u32x4 v=*(const u32x4*)(stg+row*64+ch*8);
        const int gs=__shfl(oslot,row); if(gs>=0) *(u32x4*)(PO+(long)gs*64+ch*8)=v; }
      asm volatile("s_waitcnt lgkmcnt(0)":::"memory"); }
  }
  #undef SETQX
  #undef MOVEREF
  #undef LENT
  #undef GROW
}
constexpr int ATTN_LDS_BYTES=(LDS_BYTES>MB_BYTES?LDS_BYTES:MB_BYTES);
#undef SBAR
#undef WAIT_BAR
}

struct WqkOrder {
    int G, c;
    __device__ __forceinline__ bool next(int i, pg8::Unit& u) const { const int L = i * G + c; if (L >= 128) return false; const int z = L >> 2, pn = L & 3, b = z >> 2, h = z & 3;
        u.skipb1 = 0; u.pm = b * 4 + h; u.pn = pn; u.aoff = ((size_t)(b * 256) * 2048 + h * 256) * 2; u.boff = ((size_t)(pn * 256) * 1024 + h * 256) * 2; return true; }
};
struct VwoOrder {
    int G, c;
    __device__ __forceinline__ bool next(int i, pg8::Unit& u) const { const int L = i * G + c; if (L >= 128) return false; const int z = L >> 2, pmq = L & 3, b = z >> 2, h = z & 3;
        u.skipb1 = 0; u.pm = b * 4 + pmq; u.pn = h; u.aoff = ((size_t)(pmq * 256) * 1024 + h * 256) * 2; u.boff = ((size_t)(b * 256) * 2048 + 1024 + h * 256) * 2; return true; }
};

#define DECL_PTRS const __attribute__((address_space(4))) Args* KA_; { auto p_ = __builtin_amdgcn_kernarg_segment_ptr(); asm volatile("" : "+s"(p_)); KA_ = (const __attribute__((address_space(4))) Args*)p_; } \
    int tidp_ = threadIdx.x; asm volatile("" : "+v"(tidp_)); const int tid = tidp_, lane = tid & 63; (void)lane; \
    unsigned char* ws = KA_->ws; gu32* ctl = (gu32*)(ws + WS_CTL); const float* x = KA_->in[0]; const float* mem = KA_->in[1]; const float* g_mix = KA_->in[2]; const float* w_in = KA_->in[3]; const float* b_forget = KA_->in[4]; const float* g_fox = KA_->in[5]; const float* g_moba = KA_->in[6]; const float* w_out = KA_->in[7]; const float* g_cross = KA_->in[8]; const float* g_mem = KA_->in[9]; const float* w_q_mem = KA_->in[10]; const float* w_kv_mem = KA_->in[11]; const float* w_o_mem = KA_->in[12]; const float* g_ffn = KA_->in[13]; const float* w_up = KA_->in[14]; const float* conv_w = KA_->in[15]; const float* conv_b = KA_->in[16]; const float* w_down = KA_->in[17]; const float* g_final = KA_->in[18]; float* out = KA_->out; float* LOGF = (float*)(ws + WS_LOGF); float* CC = (float*)(ws + WS_C); float* ABAR = (float*)(ws + WS_ABAR); float* KM = (float*)(ws + WS_KM); unsigned* SEL = (unsigned*)(ws + WS_SEL); float* SSQ1 = (float*)(ws + WS_SSQ1); float* SSQ2 = (float*)(ws + WS_SSQ2); float* SSQ3 = (float*)(ws + WS_SSQ3); bf16* MEMN = (bf16*)(ws + WS_MEMN); bf16* KV = (bf16*)(ws + WS_KV); bf16* WQS = (bf16*)(ws + WS_WQS); bf16* WOT = (bf16*)(ws + WS_WOT); bf16* WKVT = (bf16*)(ws + WS_WKVT); bf16* WINT = (bf16*)(ws + WS_WINT); bf16* WOUTT = (bf16*)(ws + WS_WOUTT); bf16* WUPT = (bf16*)(ws + WS_WUPT); unsigned char* WDT = ws + WS_WDT; unsigned char* ACT8 = ws + WS_ACT8; float* GHB = (float*)(ws + WS_GH); float* UHB = (float*)(ws + WS_UH); float* GTB = (float*)(ws + WS_GT); bf16* ZT = (bf16*)(ws + WS_ZT); bf16* WQK = (bf16*)(ws + WS_WQK); bf16* VWO = (bf16*)(ws + WS_VWO); bf16* A1 = (bf16*)(ws + WS_A1); bf16* QKV = (bf16*)(ws + WS_QKV); bf16* Y = (bf16*)(ws + WS_Y); bf16* HB1 = (bf16*)(ws + WS_HB1); bf16* PB = (bf16*)(ws + WS_P); bf16* HB2 = (bf16*)(ws + WS_HB2); bf16* GB = (bf16*)(ws + WS_G); bf16* UB = (bf16*)(ws + WS_U); bf16* PO = (bf16*)(ws + WS_PO); unsigned* LIST = (unsigned*)(ws + WS_LIST); float* PML = (float*)(ws + WS_PML); bf16* KXF = (bf16*)(ws + WS_KXF); bf16* KXM = (bf16*)(ws + WS_KXM); unsigned* CNT = (unsigned*)(ws + WS_CNT);
__global__ void __launch_bounds__(NWAVES * 64, 2) fwd(Args args) {
    extern __shared__ __attribute__((aligned(16))) unsigned char lds[];
    LAS unsigned char* L = (LAS unsigned char*)lds;
    LAS unsigned char* XL = L + XL_OFF;
    volatile LAS unsigned* MISC = (volatile LAS unsigned*)(L + MISC_OFF);
    const int tid = threadIdx.x, lane = tid & 63, wave = __builtin_amdgcn_readfirstlane(tid >> 6);
    const int G = gridDim.x, bx = blockIdx.x;
    const int gw = bx * NWAVES + wave, NGW = G * NWAVES;
    for (int u = tid; u < (LDS_BYTES - LDSCTL_OFF) / 4; u += NWAVES * 64) ((LAS unsigned*)(L + LDSCTL_OFF))[u] = 0u;
    __syncthreads();
    XcdBarrier bar; { DECL_PTRS; bar = xcd_barrier_post((unsigned*)(ctl + CW_BAR), MISC + 8); }

    { DECL_PTRS;
        LAS float* scr = (LAS float*)(L + RING_OFF + wave * 16384);
        constexpr int I_IN = (D / 32) * (NQKV / 64), I_OUT = (D / 32) * (D / 64), I_KV = (D / 32) * (2048 / 64), I_O = I_OUT, I_UP = (D / 32) * (2 * FF / 64), I_DN = (FF / 32) * (D / 64);
        constexpr int NITEMS = I_IN + I_OUT + I_KV + I_O + I_UP + I_DN;
        for (int it = gw; it < NITEMS; it += NGW) {
            int r = it;
            if (r < I_IN) { p0_transpose_item(w_in, INC, D, NQKV, WINT, nullptr, true, scr, r, lane); continue; } r -= I_IN;
            if (r < I_OUT) { p0_transpose_item(w_out, D, D, D, WOUTT, nullptr, false, scr, r, lane); continue; } r -= I_OUT;
            if (r < I_KV) { p0_transpose_item(w_kv_mem, 2048, D, 2048, WKVT, nullptr, false, scr, r, lane); continue; } r -= I_KV;
            if (r < I_O) { p0_transpose_item(w_o_mem, D, D, D, WOT, nullptr, false, scr, r, lane); continue; } r -= I_O;
            if (r < I_UP) { p0_transpose_item(w_up, 2 * FF, D, 2 * FF, WUPT, g_ffn, false, scr, r, lane, 0.f, true); continue; } r -= I_UP;
            p0_transpose_item(w_down, D, FF, D, (bf16*)WDT, nullptr, false, scr, r, lane, 64.0f);
        }
        for (int i = bx * 512 + tid; i < D * D / 4; i += G * 512) { const int kk = (i * 4) >> 10; const f32x4 v = *(const f32x4*)(w_q_mem + (size_t)i * 4) * (g_cross[kk] * (LOG2E / 16.0f));
            *(unsigned long long*)(WQS + (size_t)i * 4) = (unsigned long long)pk2(v[0], v[1]) | ((unsigned long long)pk2(v[2], v[3]) << 32); }
        for (int r = gw; r < NB * 256; r += NGW) { const GAS f32x4* xr = (const GAS f32x4*)(mem + (size_t)r * D) + lane; f32x4 v[4]; float s = 0.f;
#pragma unroll
            for (int j = 0; j < 4; ++j) { v[j] = xr[64 * j]; s += (v[j][0] * v[j][0] + v[j][1] * v[j][1]) + (v[j][2] * v[j][2] + v[j][3] * v[j][3]); }
            const float rs = __builtin_amdgcn_rsqf(wave_sum(s) * (1.f / D) + RMS_EPS);
            GAS unsigned long long* o8 = (GAS unsigned long long*)(MEMN + (size_t)r * D) + lane;
#pragma unroll
            for (int j = 0; j < 4; ++j) { const f32x4 gg = *((const f32x4*)g_mem + 64 * j + lane); const f32x4 a = v[j] * rs * gg; o8[64 * j] = (unsigned long long)pk2(a[0], a[1]) | ((unsigned long long)pk2(a[2], a[3]) << 32); } }
        __syncthreads();
        LAS float* part = (LAS float*)(L + RING_OFF + 32768);
        LAS float* wf = (LAS float*)(L + RING_OFF);
        for (int i = tid; i < 8 * 1024; i += 512) { const int h = i >> 10, kk = i & 1023; wf[i] = w_in[(size_t)kk * INC + C_F + h]; }
        __syncthreads();
        f32x4 gm[4];
#pragma unroll
        for (int j = 0; j < 4; ++j) gm[j] = *((const f32x4*)g_mix + 64 * j + lane);
        for (int blk = bx; blk < M / 256; blk += G) {
            f32x4 accm[4];
#pragma unroll
            for (int j = 0; j < 4; ++j) accm[j] = (f32x4){0.f, 0.f, 0.f, 0.f};
            f32x4 vn[2][4];
#pragma unroll
            for (int rr = 0; rr < 2; ++rr) { const GAS f32x4* xr = (const GAS f32x4*)(x + ((size_t)blk * 256 + wave * 32 + rr) * D) + lane;
#pragma unroll
                for (int j = 0; j < 4; ++j) vn[rr][j] = xr[64 * j]; }
            for (int i0 = 0; i0 < 32; i0 += 2) {
              f32x4 vv[2][4];
#pragma unroll
              for (int rr = 0; rr < 2; ++rr)
#pragma unroll
                  for (int j = 0; j < 4; ++j) vv[rr][j] = vn[rr][j];
              { const int inx = i0 + 2 < 32 ? i0 + 2 : i0;
#pragma unroll
                for (int rr = 0; rr < 2; ++rr) { const GAS f32x4* xr = (const GAS f32x4*)(x + ((size_t)blk * 256 + wave * 32 + inx + rr) * D) + lane;
#pragma unroll
                    for (int j = 0; j < 4; ++j) vn[rr][j] = xr[64 * j]; } }
#pragma unroll
              for (int rr = 0; rr < 2; ++rr) {
                const size_t r = (size_t)blk * 256 + wave * 32 + i0 + rr;
                f32x4 v[4]; float s = 0.f;
#pragma unroll
                for (int j = 0; j < 4; ++j) { v[j] = vv[rr][j]; s += (v[j][0] * v[j][0] + v[j][1] * v[j][1]) + (v[j][2] * v[j][2] + v[j][3] * v[j][3]); }
                const float rs = __builtin_amdgcn_rsqf(wave_sum(s) * (1.f / D) + RMS_EPS);
                GAS unsigned long long* o8 = (GAS unsigned long long*)(A1 + r * 2048) + lane;
                float fl[8];
#pragma unroll
                for (int h = 0; h < 8; ++h) fl[h] = 0.f;
#pragma unroll
                for (int j = 0; j < 4; ++j) { const f32x4 a = v[j] * rs * gm[j]; accm[j] += a;
                    const unsigned h0 = pk2(a[0], a[1]), h1 = pk2(a[2], a[3]);
                    o8[64 * j] = (unsigned long long)h0 | ((unsigned long long)h1 << 32);
                    const unsigned l0 = pk2(a[0] - bflo(h0), a[1] - bfhi(h0)), l1 = pk2(a[2] - bflo(h1), a[3] - bfhi(h1));
                    o8[256 + 64 * j] = (unsigned long long)l0 | ((unsigned long long)l1 << 32);
#pragma unroll
                    for (int h = 0; h < 8; ++h) { const f32x4 w = *((const LAS f32x4*)(wf + h * 1024) + 64 * j + lane); fl[h] += (a[0] * w[0] + a[1] * w[1]) + (a[2] * w[2] + a[3] * w[3]); } }
                float t4[4], t2[2], z;
                { const bool up = (lane & 32) != 0;
#pragma unroll
                  for (int k = 0; k < 4; ++k) { const float snd = up ? fl[k] : fl[k + 4]; const float rcv = __shfl_xor(snd, 32); t4[k] = (up ? fl[k + 4] : fl[k]) + rcv; } }
                { const bool up = (lane & 16) != 0;
#pragma unroll
                  for (int k = 0; k < 2; ++k) { const float snd = up ? t4[k] : t4[k + 2]; const float rcv = __shfl_xor(snd, 16); t2[k] = (up ? t4[k + 2] : t4[k]) + rcv; } }
                { const bool up = (lane & 8) != 0; const float snd = up ? t2[0] : t2[1]; const float rcv = __shfl_xor(snd, 8); z = (up ? t2[1] : t2[0]) + rcv; }
                z += __shfl_xor(z, 1); z += __shfl_xor(z, 2); z += __shfl_xor(z, 4);
                if ((lane & 7) == 0) { const int hh = 4 * (lane >> 5) + 2 * ((lane >> 4) & 1) + ((lane >> 3) & 1);
                    z += b_forget[hh];
                    LOGF[r * 8 + hh] = fminf(z, 0.f) - log1pf(__expf(-fabsf(z))); }
              }
            }
#pragma unroll
            for (int j = 0; j < 4; ++j) *((LAS f32x4*)(part + wave * 1024) + 64 * j + lane) = accm[j];
            __syncthreads();
            for (int col = tid; col < 1024; col += 512) { float s = 0.f;
#pragma unroll
                for (int w = 0; w < 8; ++w) s += part[w * 1024 + col];
                ABAR[(size_t)blk * 1024 + col] = s * (1.0f / 256.0f); }
            __syncthreads();
        }
    }
    xcd_barrier(bar);

#define WG_SIGNAL(word) do { asm volatile("s_waitcnt vmcnt(0)" ::: "memory"); __syncthreads(); if (tid == 0) { __builtin_amdgcn_fence(__ATOMIC_RELEASE, "agent"); asm volatile("s_waitcnt vmcnt(0)" ::: "memory"); \
        __hip_atomic_fetch_add((unsigned*)(ctl + (word)), 1u, RLX_AGENT); } } while (0)
#define WG_WAIT(word, n) do { if (tid == 0) { unsigned sp_ = 0u; while (__hip_atomic_load((unsigned*)(ctl + (word)), RLX_AGENT) < (unsigned)(n)) { __builtin_amdgcn_s_sleep(2); if (++sp_ > (1u << 22)) break; } } \
        __syncthreads(); __builtin_amdgcn_fence(__ATOMIC_ACQUIRE, "agent"); asm volatile("s_waitcnt vmcnt(0)" ::: "memory"); } while (0)
    { DECL_PTRS;
        LAS float* sc = (LAS float*)(L + RING_OFF);
        for (int w = bx; w < 64; w += G) {
            const int ib = w >> 3, jb = w & 7, r = tid >> 4, cq = tid & 15; LAS float* As = sc; LAS float* Bs = sc + 32 * 33;
            f32x4 acc = (f32x4){0.f, 0.f, 0.f, 0.f};
            for (int k0 = 0; k0 < 1024; k0 += 32) {
                { const int idx = tid * 2, row = idx >> 5, kk = idx & 31; const pg8::f32x2 a2 = *(const pg8::f32x2*)(ABAR + (size_t)(ib * 32 + row) * 1024 + k0 + kk); As[row * 33 + kk] = a2.x; As[row * 33 + kk + 1] = a2.y; }
                { const int idx = tid * 4, kk = idx >> 6, c = idx & 63; *(LAS f32x4*)(Bs + kk * 64 + c) = *(const f32x4*)(w_in + (size_t)(k0 + kk) * INC + C_KM + jb * 64 + c); }
                __syncthreads();
#pragma unroll 8
                for (int kk = 0; kk < 32; ++kk) acc += *(const LAS f32x4*)(Bs + kk * 64 + cq * 4) * As[r * 33 + kk];
                __syncthreads();
            }
            *(f32x4*)(KM + (size_t)(ib * 32 + r) * 512 + jb * 64 + cq * 4) = acc;
            WG_SIGNAL(CW_CNT_KM);
        }
        for (int w = (bx + G - 64) % G; w < 64; w += G) {
            const int b = w >> 3, h = w & 7; float v[16]; float run = 0.f;
#pragma unroll
            for (int i = 0; i < 16; ++i) { run += LOGF[((size_t)b * T + tid * 16 + i) * 8 + h]; v[i] = run; }
            float incl = run;
#pragma unroll
            for (int o = 1; o < 64; o <<= 1) { const float n = __shfl_up(incl, o); if (lane >= o) incl += n; }
            if (lane == 63) sc[wave] = incl;
            __syncthreads();
            float pre = incl - run;
            for (int ww = 0; ww < wave; ++ww) pre += sc[ww];
#pragma unroll
            for (int i = 0; i < 16; ++i) { const float cv = pre + v[i]; const size_t e = (size_t)w * T + tid * 16 + i; CC[e] = cv;
                const float bv = -cv * LOG2E; const unsigned h0 = f2bf(bv); const float r1 = bv - bf2f(h0); const unsigned h1 = f2bf(r1); const unsigned h2 = f2bf(r1 - bf2f(h1));
                *(v4u*)(KXF + e * 8) = (v4u){h0 | (h1 << 16), h2 | (0x3F80u << 16), 0x3F80u, 0u}; }
            if (w == 0) for (int j = tid; j < 8 * 256; j += 512) { const float bv = __builtin_amdgcn_exp2f(-(float)((j >> 8) + 1)) * LOG2E * (float)(j & 255);
                const unsigned h0 = f2bf(bv); const float r1 = bv - bf2f(h0); const unsigned h1 = f2bf(r1); const unsigned h2 = f2bf(r1 - bf2f(h1));
                *(v4u*)(KXM + (size_t)j * 8) = (v4u){h0 | (h1 << 16), h2 | (0x3F80u << 16), 0x3F80u, 0u}; }
            __syncthreads();
        }
        { const int ckv = (bx + G - 128) % G;
          pg8::Gemm g{MEMN, WKVT, D / 64, D * 2, D * 2, 0xffffffffu}; pg8::TileOrder S; S.init(NB * 256, 2048, G, ckv, D * 2, D * 2, 0, 1 << 30);
          pg8::EpiBf16 E{KV, 2048, 0u, 1.f, nullptr};
          pg8::gemm_phase<pg8::EpiBf16, pg8::TileOrder, true>(L + RING_OFF, XL, g, S, E);
          for (int Lk = ckv; Lk < 64; Lk += G) WG_SIGNAL(CW_CNT_KV); }
        if (bx < 64) WG_WAIT(CW_CNT_KM, 64);
        for (int w = bx; w < 64; w += G) {
            const int h = w >> 3, kq = w & 7, kk = kq * 128 + (tid & 127), ng = tid >> 7;
            for (int i = tid; i < 256 * 16; i += 512) { const int n = i >> 4, c4 = (i & 15) * 4; *(LAS f32x4*)(sc + n * 64 + c4) = *(const f32x4*)(KM + (size_t)n * 512 + h * 64 + c4); }
            f32x4 wq[16];
#pragma unroll
            for (int c = 0; c < 16; ++c) wq[c] = *(const f32x4*)(w_in + (size_t)kk * INC + C_QM + h * 64 + c * 4);
            __syncthreads();
            for (int i = 0; i < 64; ++i) { const int n = ng * 64 + i; const LAS f32x4* kp = (const LAS f32x4*)(sc + n * 64); float s0 = 0.f, s1 = 0.f;
#pragma unroll
                for (int c = 0; c < 16; c += 2) { const f32x4 ka = kp[c], kb = kp[c + 1];
                    s0 += (wq[c][0] * ka[0] + wq[c][1] * ka[1]) + (wq[c][2] * ka[2] + wq[c][3] * ka[3]); s1 += (wq[c + 1][0] * kb[0] + wq[c + 1][1] * kb[1]) + (wq[c + 1][2] * kb[2] + wq[c + 1][3] * kb[3]); }
                const float sv = s0 + s1; const unsigned hi = f2bf(sv); const unsigned lo = f2bf(sv - bf2f(hi));
                bf16* zr = ZT + ((size_t)(n >> 5) * 256 + 128 * ((n & 31) >> 4) + 32 * (h >> 1) + 16 * (h & 1) + (n & 15)) * 3072;     zr[kk] = (bf16)hi; zr[1024 + kk] = (bf16)hi; zr[2048 + kk] = (bf16)lo; }
            WG_SIGNAL(CW_CNT_Z);
        }
        { const int ckv = (bx + G - 128) % G;
          if (ckv < 64) WG_WAIT(CW_CNT_KV, 64);
          const int gx = G < 64 ? G : 64, cx = ckv < 64 ? ckv : (1 << 20);
          { pg8::Gemm g{KV, WQS, 4, 4096, 2048, 0xffffffffu}; WqkOrder S{gx, cx}; pg8::EpiF8 E{(unsigned char*)WQK, 1024, 32.0f};
            pg8::gemm_phase<pg8::EpiF8, WqkOrder, true>(L + RING_OFF, XL, g, S, E); }
          { pg8::Gemm g{WOT, KV, 4, 2048, 4096, 0xffffffffu}; VwoOrder S{gx, cx}; pg8::EpiF8 E{(unsigned char*)VWO, 1024, 4.0f};
            pg8::gemm_phase<pg8::EpiF8, VwoOrder, true>(L + RING_OFF, XL, g, S, E); } }
        { pg8::Gemm g{A1, WINT, D / 64, 4096, D * 2, 0xffffffffu}; pg8::TileOrder S; S.init(M, NQKV, G, bx, 4096, D * 2, 0, 1 << 30); S.deal = (G == 256) ? 1 : 0;
          pg8::EpiBf16 E{QKV, NQKV, 0xC3u, C2, (unsigned*)(ctl + CW_QKN)};
          pg8::gemm_phase<pg8::EpiBf16, pg8::TileOrder, true>(L + RING_OFF, XL, g, S, E); }
        WG_WAIT(CW_CNT_Z, 64);
        { pg8::Gemm g{A1, ZT, 3072 / 64, 4096, 6144, 4095u}; pg8::TileOrder S; S.init(M, 256, G, (G == 256) ? ((bx >= 136 && bx < 192) ? bx - 128 : ((bx >= 8 && bx < 64) ? bx + 128 : bx)) : bx, 4096, 6144, (size_t)256 * 6144, 32); S.skipmode = 1;
          pg8::EpiGate E{SEL};
          pg8::gemm_phase<pg8::EpiGate, pg8::TileOrder, true, false, true>(L + RING_OFF, XL, g, S, E); }
    }
#undef WG_SIGNAL
#undef WG_WAIT
    xcd_barrier(bar);

    { DECL_PTRS;
        for (int e = bx + wave * G; e < 2048; e += 8 * G) {
            const int bh = e >> 5, qb = e & 31, b = bh >> 3, h = bh & 7; float dmin = 3.0e38f, qmax = 0.f;
#pragma unroll 2
            for (int rr = 0; rr < 4; ++rr) { const bf16* qp = QKV + ((size_t)b * T + qb * 256 + rr * 64 + lane) * NQKV + h * 64; float dot = 0.f, qn2 = 0.f;
#pragma unroll
                for (int c = 0; c < 8; ++c) { const v4u qw = *((const v4u*)qp + c), kw = *((const v4u*)(qp + 512) + c); const unsigned qq[4] = {qw.x, qw.y, qw.z, qw.w}, kk2[4] = {kw.x, kw.y, kw.z, kw.w};
#pragma unroll
                    for (int x4 = 0; x4 < 4; ++x4) { const float q0 = bflo(qq[x4]), q1 = bfhi(qq[x4]); dot += q0 * bflo(kk2[x4]) + q1 * bfhi(kk2[x4]); qn2 += q0 * q0 + q1 * q1; } }
                dmin = fminf(dmin, dot); qmax = fmaxf(qmax, qn2); }
#pragma unroll
            for (int o = 1; o < 64; o <<= 1) { dmin = fminf(dmin, __shfl_xor(dmin, o)); qmax = fmaxf(qmax, __shfl_xor(qmax, o)); }
            const unsigned* kp = (const unsigned*)(ctl + CW_QKN) + bh * 8 + 2;
            const float kn = sqrtf(__uint_as_float(__hip_atomic_load(kp, RLX_AGENT)) + __uint_as_float(__hip_atomic_load(kp + 1, RLX_AGENT)));
            const float thr = (sqrtf(qmax) * kn * 1.02f - dmin + 29.5f) * (1.0f / LOG2E);
            const float* crow_ = CC + (size_t)bh * T; const int t0 = qb * 256; const float target = crow_[t0] + thr;
            int lo = 0, hi2 = t0;
            while (hi2 > lo) { const int step = (hi2 - lo + 63) >> 6, pos = lo + lane * step; const bool pr = pos < hi2 && crow_[pos] >= target; const int k = __popcll(__ballot(pr));
                if (k == 0) hi2 = lo;
                else { const int cand = lo + k * step; lo = lo + (k - 1) * step + 1; if (cand < hi2) hi2 = cand; } }
            if (lane == 0) ((int*)(ctl + CW_T0TAB))[e] = (lo >> 6) & ~1; }
        for (int ws_ = bx + G * wave; ws_ < 2048; ws_ += 8 * G) {
            const int bh = (ws_ & 255) >> 2, n = (ws_ & 3) + 4 * (ws_ >> 8), trip = bh * 32 + n; const unsigned* selrow = SEL + (size_t)bh * T; unsigned base = 0u;
            const float mthr = skip_thr((const unsigned*)(ctl + CW_QKN) + bh * 8, 1); const int hh = bh & 7;
            for (int t0 = (n + 1) * 256; t0 < T; t0 += 512) {
                unsigned m[8];
#pragma unroll
                for (int j = 0; j < 8; ++j) { const int t = t0 + j * 64 + lane; m[j] = 0u; if (t < T) m[j] = selrow[t]; }
#pragma unroll
                for (int j = 0; j < 8; ++j) { const int t = t0 + j * 64 + lane; const bool hit = ((m[j] >> n) & 1u) && !moba_skip(hh, t >> 8, n, mthr);
                    const unsigned long long bal = __ballot(hit);
                    if (hit) { const unsigned pos = base + (unsigned)__popcll(bal & ((1ull << lane) - 1ull)); const unsigned k = (unsigned)__popc(m[j] & ((1u << n) - 1u));
                        LIST[(size_t)trip * 8192 + pos] = (unsigned)t | (k << 16); }
                    base += (unsigned)__popcll(bal); }
            }
            if (lane == 0) CNT[trip] = base;
        }
    }
    xcd_barrier(bar);

    { DECL_PTRS;
        LAS int* upre = (LAS int*)(L + RING_OFF + attn_body::ATTN_LDS_BYTES);
        LAS int* wsum = upre + 2052;
        { int c4[4]; int run = 0;
#pragma unroll
          for (int i = 0; i < 4; ++i) { const int wq = tid * 4 + i; c4[i] = run; run += (int)((8u + ((CNT[(wq & 63) * 32 + (wq >> 6)] + 31u) >> 5) + 31u) >> 5); }
          int incl = run;
#pragma unroll
          for (int o = 1; o < 64; o <<= 1) { const int nn = __shfl_up(incl, o); if (lane >= o) incl += nn; }
          if (lane == 63) wsum[wave] = incl;
          __syncthreads();
          int pre = incl - run;
          for (int ww = 0; ww < wave; ++ww) pre += wsum[ww];
#pragma unroll
          for (int i = 0; i < 4; ++i) upre[tid * 4 + i] = pre + c4[i];
          if (tid == 511) upre[2048] = pre + run;
          __syncthreads(); }
        const int ntot = 2048 + upre[2048];
        const attn_body::hb16* Qb = (const attn_body::hb16*)QKV;
        const int r32 = lane & 31;
        LAS unsigned* qnext = (LAS unsigned*)(wsum + 16);
        unsigned* qhead = (unsigned*)(ctl + CW_QUEUE);
        if (tid == 0) qnext[0] = atomicAdd(qhead, 1u);
        __syncthreads();
        for (;;) {
            const int u = (int)qnext[0];
            if (u >= ntot) break;
            __syncthreads();
            unsigned nxt_ = 0u; if (tid == 0) nxt_ = atomicAdd(qhead, 1u);
            if (u < 2048) {
                const int qb = 31 - (u >> 6), bh = u & 63;
                const int b = bh >> 3, h = bh & 7;
                const int T0 = ((const int*)(ctl + CW_T0TAB))[bh * 32 + qb];
                const int qrow = b * T + qb * 256 + wave * 32 + r32, NT = 4 * (qb + 1) - T0;
                const attn_body::hb16* Qc = Qb + h * 64; const attn_body::hb16* Kt0 = Qb + (size_t)(b * T + T0 * 64) * NQKV + 512 + h * 64;
                attn_body::attn_unit<8>((char*)lds + RING_OFF, 0, Qc, qrow, -1, Kt0, Kt0 + 512, (const attn_body::hb16*)KXF + ((size_t)bh * T + T0 * 64) * 8, NT, NT - 4, (attn_body::hb16*)QKV + (Qc - Qb), (attn_body::hb16*)PO, PML);
            } else {
                const int g = u - 2048; int lo = 0, hi2 = 2048;
                while (hi2 - lo > 1) { const int mid = (lo + hi2) >> 1; if (upre[mid] <= g) lo = mid; else hi2 = mid; }
                const int c = g - upre[lo], bh = lo & 63, n = lo >> 6, w = bh * 32 + n, b = bh >> 3, h = bh & 7; const int cnt = (int)CNT[w];
                const int ng = 8 + ((cnt + 31) >> 5), g0 = 32 * c, g1 = g0 + 32 < ng ? g0 + 32 : ng;
                const attn_body::hb16* Kt0 = Qb + (size_t)(b * T + n * 256) * NQKV + 2048 + h * 64;
                attn_body::moba_item<8>((char*)lds + RING_OFF, Qb + 1536 + h * 64, b * T, h, n, LIST + (size_t)w * 8192, cnt, g0, g1, Kt0, (const attn_body::hb16*)KXM + h * 256 * 8, (attn_body::hb16*)PO, PML);
            }
            if (tid == 0) qnext[0] = nxt_;
            __syncthreads();
        }
    }
    xcd_barrier(bar);

    { DECL_PTRS;
    const f32x4 ga0 = *((const f32x4*)g_fox + 2 * lane), ga1 = *((const f32x4*)g_fox + 2 * lane + 1), gb0 = *((const f32x4*)g_moba + 2 * lane), gb1 = *((const f32x4*)g_moba + 2 * lane + 1);
    const int h = lane >> 3, cc = lane & 7; const float s2 = __builtin_amdgcn_exp2f(-(float)(h + 1)) * LOG2E * 256.0f;
    float mthr[NB];
#pragma unroll
    for (int b = 0; b < NB; ++b) mthr[b] = skip_thr((const unsigned*)(ctl + CW_QKN) + (b * 8 + h) * 8, 1);
    v4u wan[2], pwn[2][4]; unsigned mmn[2]; pg8::f32x2 mln[2][4];
#define P3_LOAD(rbase) do { _Pragma("unroll") for (int rr = 0; rr < 2; ++rr) { const int r = (rbase) + rr, b = r >> 13, t = r & (T - 1); const size_t sb = ((size_t)r * 8 + h) * 4; \
            wan[rr] = *((const v4u*)(QKV + (size_t)r * NQKV) + lane); mmn[rr] = SEL[((size_t)(b * 8 + h)) * T + t]; \
            _Pragma("unroll") for (int k = 0; k < 4; ++k) { mln[rr][k] = *(const pg8::f32x2*)(PML + (sb + k) * 2); pwn[rr][k] = *((const v4u*)(PO + (sb + k) * 64) + cc); } } } while (0)
    if (gw * 2 < M) P3_LOAD(gw * 2);
    for (int r0 = gw * 2; r0 < M; r0 += NGW * 2) {
        v4u wa[2], pw[2][4]; unsigned mmv[2]; pg8::f32x2 ml[2][4];
#pragma unroll
        for (int rr = 0; rr < 2; ++rr) { wa[rr] = wan[rr]; mmv[rr] = mmn[rr];
#pragma unroll
            for (int k = 0; k < 4; ++k) { ml[rr][k] = mln[rr][k]; pw[rr][k] = pwn[rr][k]; } }
        { const int rn = r0 + NGW * 2 < M ? r0 + NGW * 2 : r0; P3_LOAD(rn); }
#pragma unroll
        for (int rr = 0; rr < 2; ++rr) { const int r = r0 + rr, t = r & (T - 1), own = t >> 8;
            const float a[8] = {bflo(wa[rr].x), bfhi(wa[rr].x), bflo(wa[rr].y), bfhi(wa[rr].y), bflo(wa[rr].z), bfhi(wa[rr].z), bflo(wa[rr].w), bfhi(wa[rr].w)};
            float c[8]; unsigned mm = mmv[rr]; const int cnt = __popc(mm);
            float mk[4], lk[4];
#pragma unroll
            for (int k = 0; k < 4; ++k) { mk[k] = ml[rr][k].x; lk[k] = ml[rr][k].y; }
            mk[3] += s2 * (float)own; float Mx = mk[3];
            bool vk[4]; vk[3] = true; float thb = mthr[0];
#pragma unroll
            for (int b = 1; b < NB; ++b) thb = ((r >> 13) == b) ? mthr[b] : thb;
#pragma unroll
            for (int k = 0; k < 3; ++k) { vk[k] = false; if (k < cnt) { const int nb = __ffs(mm) - 1; mm &= mm - 1u; vk[k] = !moba_skip(h, own, nb, thb); if (vk[k]) { mk[k] += s2 * (float)nb; Mx = fmaxf(Mx, mk[k]); } } }
            float W = 0.f;
#pragma unroll
            for (int i = 0; i < 8; ++i) c[i] = 0.f;
#pragma unroll
            for (int k = 0; k < 4; ++k) { if (vk[k]) { const float w = lk[k] * __builtin_amdgcn_exp2f(mk[k] - Mx); W += w; const v4u p = pw[rr][k];
                c[0] += w * bflo(p.x); c[1] += w * bfhi(p.x); c[2] += w * bflo(p.y); c[3] += w * bfhi(p.y); c[4] += w * bflo(p.z); c[5] += w * bfhi(p.z); c[6] += w * bflo(p.w); c[7] += w * bfhi(p.w); } }
            const float iw = 1.0f / W;
#pragma unroll
            for (int i = 0; i < 8; ++i) c[i] *= iw;
            float sa = 0.f, sb2 = 0.f;
#pragma unroll
            for (int i = 0; i < 8; ++i) { sa += a[i] * a[i]; sb2 += c[i] * c[i]; }
            const float ra = __builtin_amdgcn_rsqf(wave_sum(sa) * (1.f / 512.f) + RMS_EPS), rb = __builtin_amdgcn_rsqf(wave_sum(sb2) * (1.f / 512.f) + RMS_EPS);
            v4u oa, ob;
            oa.x = pk2(a[0] * ra * ga0[0], a[1] * ra * ga0[1]); oa.y = pk2(a[2] * ra * ga0[2], a[3] * ra * ga0[3]); oa.z = pk2(a[4] * ra * ga1[0], a[5] * ra * ga1[1]); oa.w = pk2(a[6] * ra * ga1[2], a[7] * ra * ga1[3]);
            ob.x = pk2(c[0] * rb * gb0[0], c[1] * rb * gb0[1]); ob.y = pk2(c[2] * rb * gb0[2], c[3] * rb * gb0[3]); ob.z = pk2(c[4] * rb * gb1[0], c[5] * rb * gb1[1]); ob.w = pk2(c[6] * rb * gb1[2], c[7] * rb * gb1[3]);
            *((v4u*)(Y + (size_t)r * D) + lane) = oa; *((v4u*)(Y + (size_t)r * D + 512) + lane) = ob; }
    } }
    xcd_barrier(bar);

#undef P3_LOAD
    { DECL_PTRS; pg8::Gemm g{Y, WOUTT, D / 64, D * 2, D * 2, 0xffffffffu}; pg8::TileOrder S; S.init(M, D, G, bx, D * 2, D * 2, 0, 1 << 30);
      pg8::EpiRes<false, false> E{x, nullptr, nullptr, HB1, ws + WS_HB1F, SSQ1, 1.0f};
      pg8::gemm_phase<pg8::EpiRes<false, false>, pg8::TileOrder, true>(L + RING_OFF, XL, g, S, E); }
    xcd_barrier(bar);

    { DECL_PTRS; pg8::Gemm g{ws + WS_HB1F, WQK, D / 128, D, D, 0xffffffffu}; pg8::TileOrder S; S.init(M, D, G, bx, D, D, (size_t)D * D, 32);
      pg8::EpiSoftmax E{(unsigned char*)PB, SSQ1, 1.0f / 32.0f};
      pg8::gemm_phase<pg8::EpiSoftmax, pg8::TileOrder, true, true>(L + RING_OFF, XL, g, S, E); }
    xcd_barrier(bar);

    { DECL_PTRS; pg8::Gemm g{PB, VWO, D / 128, D, D, 0xffffffffu}; pg8::TileOrder S; S.init(M, D, G, bx, D, D, (size_t)D * D, 32);
      pg8::EpiRes<true, false> E{nullptr, HB1, nullptr, HB2, nullptr, SSQ2, 1.0f / 1024.0f};
      pg8::gemm_phase<pg8::EpiRes<true, false>, pg8::TileOrder, true, true>(L + RING_OFF, XL, g, S, E); }
    xcd_barrier(bar);

    { DECL_PTRS; pg8::Gemm g{HB2, WUPT, D / 64, D * 2, D * 2, 0xffffffffu}; pg8::TileOrder S; S.init(M, 2 * FF, G, bx, D * 2, D * 2, 0, 1 << 30);
      pg8::EpiConv E{ACT8, SSQ2, conv_w, conv_b, GHB, UHB, GTB};
      pg8::gemm_phase<pg8::EpiConv, pg8::TileOrder, true>(L + RING_OFF, XL, g, S, E); }
    xcd_barrier(bar);

    { DECL_PTRS;
    for (int it = bx * 512 + tid; it < 256 * 22 * 2 * 32; it += G * 512) {
        const int c4 = (it & 31) * 4, rr = (it >> 5) & 1, tile = it >> 6, pm = tile / 22, pn = tile - pm * 22; const bool top = (pm & 31) == 0;
        const size_t sb = (size_t)tile * 256; const int col = pn * 128 + c4;
        const f32x4 g2 = *(const f32x4*)(GHB + sb + rr * 128 + c4), uu = *(const f32x4*)(UHB + sb + rr * 128 + c4);
        f32x4 g1 = (f32x4){0.f, 0.f, 0.f, 0.f}, g0 = (f32x4){0.f, 0.f, 0.f, 0.f};
        if (rr == 1) g1 = *(const f32x4*)(GHB + sb + c4); else if (!top) g1 = *(const f32x4*)(GTB + sb - 22 * 256 + 128 + c4);
        if (!top) g0 = *(const f32x4*)(GTB + sb - 22 * 256 + (rr == 1 ? 128 : 0) + c4);
        const f32x4 w0 = *(const f32x4*)(conv_w + col), w1 = *(const f32x4*)(conv_w + FF + col), w2 = *(const f32x4*)(conv_w + 2 * FF + col), cbv = *(const f32x4*)(conv_b + col);
        float res[4];
#pragma unroll
        for (int e = 0; e < 4; ++e) { const float gc = cbv[e] + w0[e] * g0[e] + w1[e] * g1[e] + w2[e] * g2[e]; res[e] = gc * __builtin_amdgcn_rcpf(1.0f + __builtin_amdgcn_exp2f(-LOG2E * gc)) * uu[e]; }
        *(unsigned*)(ACT8 + (size_t)(pm * 256 + rr) * FF + col) = pg8::pk4_fp8(res[0], res[1], res[2], res[3]);
    } }
    xcd_barrier(bar);

    { DECL_PTRS; pg8::Gemm g{ACT8, WDT, FF / 128, FF, FF, 0xffffffffu}; pg8::TileOrder S; S.init(M, D, G, bx, FF, FF, 0, 1 << 30);
      pg8::EpiResNorm E{HB2, out, g_final, 1.0f / 64.0f, SSQ3, (unsigned*)(ctl + CW_PANEL), (unsigned*)(ctl + CW_TMO2)};
      pg8::gemm_phase<pg8::EpiResNorm, pg8::TileOrder, true, true>(L + RING_OFF, XL, g, S, E); }
}

extern "C" void kernel_launch(void* const* d_in, const int* in_sizes, int n_in, void* d_out, int out_size, void* d_ws, size_t ws_size, hipStream_t stream) {
    static int grid = 0;
    if (grid == 0) {
        if (n_in != 19 || in_sizes[0] != M * D || out_size != M * D || ws_size < WS_END) { fprintf(stderr, "kernel_launch: unexpected problem shape (n_in %d, in0 %d, out %d, ws %zu); nothing launched\n", n_in, n_in > 0 ? in_sizes[0] : -1, out_size, ws_size); grid = -1; return; }
        int dev = 0, cus = 0, per_cu = 0;
        if (hipGetDevice(&dev) != hipSuccess || hipDeviceGetAttribute(&cus, hipDeviceAttributeMultiprocessorCount, dev) != hipSuccess) { grid = -1; return; }
        if (hipFuncSetAttribute((const void*)fwd, hipFuncAttributeMaxDynamicSharedMemorySize, LDS_BYTES) != hipSuccess) { fprintf(stderr, "kernel_launch: hipFuncSetAttribute failed\n"); grid = -1; return; }
        if (hipOccupancyMaxActiveBlocksPerMultiprocessor(&per_cu, (const void*)fwd, NWAVES * 64, LDS_BYTES) != hipSuccess || per_cu < 1) { fprintf(stderr, "kernel_launch: occupancy query reports %d\n", per_cu); }
        (void)hipGetLastError();
        grid = cus;
    }
    if (grid < 0) return;
    if (hipMemsetAsync((char*)d_ws + WS_CTL, 0, CTL_ZERO_BYTES, stream) != hipSuccess) return;
    Args a{};
    for (int i = 0; i < 19; ++i) a.in[i] = (const float*)d_in[i];
    a.out = (float*)d_out; a.ws = (unsigned char*)d_ws;
    hipLaunchKernelGGL(fwd, dim3(grid), dim3(NWAVES * 64), LDS_BYTES, stream, a);
}
```
